# Optimizing an MI355X kernel written in HIP

```python
import math
import jax
import jax.numpy as jnp
from jax import lax
import numpy as np

D_MODEL = 1024
BATCH = 16
SEQ = 2048
DEPTH = 4
DEC_BATCH = 8
DEC_SEQ = 4096
PAST_LEN = 128

HEAD_DIM = 64
ROPE_THETA = 10000.0
Q_BLOCK = 128
LN_EPS = 1e-5
RMS_EPS = 1e-6
NEG_INF = -1e30

A_HEADS = 4
A_HALF = HEAD_DIM // 2
A_W = A_HEADS * HEAD_DIM

B_HEADS = 6
B_Q_RANK = 256
B_KV_RANK = 128
B_NOPE = 64
B_ROPE = 32
B_V = 64
B_W = B_HEADS * B_V

C_GROUPS = ((128, 1), (512, 4), (2048, 16))
C_HPG = 2
C_HEADS = C_HPG * len(C_GROUPS)
C_W = C_HEADS * HEAD_DIM

COL_A = 3 * A_W
COL_B = B_Q_RANK + B_KV_RANK + B_ROPE
COL_C = 3 * C_W
IN_COLS = COL_A + COL_B + COL_C
MIX_W = A_W + B_W + C_W

N_GROUPS = 4
EXPERTS_PER_GROUP = 8
N_EXPERTS = N_GROUPS * EXPERTS_PER_GROUP
TOP_K_INNER = 2
D_EXPERT = 512
MOE_BLOCK = 128

DN_ALPHA = (2 * DEPTH) ** 0.25
DN_BETA = (8 * DEPTH) ** -0.25

kernel_name = 'hybrid_diff_mla_dilated_hmoe_encoder'


def rope_tables(seq, dim):
    inv_freq = 1.0 / (ROPE_THETA ** (jnp.arange(0, dim, 2, dtype=jnp.float32) / dim))
    ang = jnp.arange(seq, dtype=jnp.float32)[:, None] * inv_freq[None, :]
    return jnp.cos(ang), jnp.sin(ang)


def apply_rope(x, cos, sin):
    shape = (1, x.shape[1]) + (1,) * (x.ndim - 3) + (cos.shape[-1],)
    c = cos.reshape(shape).astype(x.dtype)
    s = sin.reshape(shape).astype(x.dtype)
    x1, x2 = jnp.split(x, 2, axis=-1)
    return jnp.concatenate([x1 * c - x2 * s, x1 * s + x2 * c], axis=-1)


def layer_norm(x, g, b):
    xf = x.astype(jnp.float32)
    mu = jnp.mean(xf, axis=-1, keepdims=True)
    var = jnp.mean(jnp.square(xf - mu), axis=-1, keepdims=True)
    return ((xf - mu) * lax.rsqrt(var + LN_EPS) * g.astype(jnp.float32) + b.astype(jnp.float32)).astype(x.dtype)


def rms_norm(x, g):
    xf = x.astype(jnp.float32)
    ms = jnp.mean(jnp.square(xf), axis=-1, keepdims=True)
    return (xf * lax.rsqrt(ms + RMS_EPS) * g.astype(jnp.float32)).astype(x.dtype)


def to_query_blocks(t):
    b, s = t.shape[:2]
    return jnp.moveaxis(t.reshape((b, s // Q_BLOCK, Q_BLOCK) + t.shape[2:]), 1, 0)


def from_query_blocks(o):
    o = jnp.moveaxis(o, 0, 1)
    return o.reshape((o.shape[0], o.shape[1] * o.shape[2]) + o.shape[3:])


def differential_attention(q, k, v, lam):
    q = q * (A_HALF ** -0.5)

    def block(qb):
        s = jnp.einsum('bqhcd,bkhcd->bchqk', qb, k, preferred_element_type=jnp.float32)
        p = jax.nn.softmax(s, axis=-1)
        w = (p[:, 0] - lam * p[:, 1]).astype(v.dtype)
        return jnp.einsum('bhqk,bkhd->bqhd', w, v)

    return from_query_blocks(lax.map(block, to_query_blocks(q)))


def latent_attention(q_nope, q_rope, k_nope, k_rope, v):
    scale = (B_NOPE + B_ROPE) ** -0.5

    def block(args):
        qn, qr = args
        s = (jnp.einsum('bqhd,bkhd->bhqk', qn, k_nope, preferred_element_type=jnp.float32)
             + jnp.einsum('bqhr,bkr->bhqk', qr, k_rope, preferred_element_type=jnp.float32)) * scale
        p = jax.nn.softmax(s, axis=-1).astype(v.dtype)
        return jnp.einsum('bhqk,bkhd->bqhd', p, v)

    return from_query_blocks(lax.map(block, (to_query_blocks(q_nope), to_query_blocks(q_rope))))


def dilated_window_attention(q, k, v, r, side):
    b, s_len, h, d = q.shape
    L = s_len // r
    nb = -(-L // side)
    lp = nb * side

    def to_sub(t):
        return jnp.swapaxes(t.reshape(b, L, r, h, d), 1, 2).reshape(b * r, L, h, d)

    def from_sub(t):
        rest = t.shape[2:]
        return jnp.swapaxes(t.reshape((b, r, L) + rest), 1, 2).reshape((b, s_len) + rest)

    qs = to_sub(q * (d ** -0.5))
    qs = jnp.pad(qs, ((0, 0), (0, lp - L), (0, 0), (0, 0))).reshape(b * r, nb, side, h, d)
    pad_kv = ((0, 0), (side, lp - L + side), (0, 0), (0, 0))

    def windows(t):
        tb = jnp.pad(to_sub(t), pad_kv).reshape(b * r, nb + 2, side, h, d)
        return jnp.concatenate([tb[:, :-2], tb[:, 1:-1], tb[:, 2:]], axis=2)

    kw, vw = windows(k), windows(v)
    s = jnp.einsum('bnqhd,bnkhd->bnhqk', qs, kw, preferred_element_type=jnp.float32)
    qi = jnp.arange(side)[:, None]
    kt = jnp.arange(3 * side)[None, :]
    rel = kt - side - qi
    kidx = jnp.arange(nb)[:, None, None] * side + kt[None] - side
    valid = (jnp.abs(rel) <= side)[None] & (kidx >= 0) & (kidx < L)
    s = jnp.where(valid[None, :, None], s, NEG_INF)
    lse = jax.nn.logsumexp(s, axis=-1)
    p = jnp.exp(s - lse[..., None]).astype(v.dtype)
    o = jnp.einsum('bnhqk,bnkhd->bnqhd', p, vw).reshape(b * r, lp, h, d)[:, :L]
    lse = jnp.swapaxes(lse, 2, 3).reshape(b * r, lp, h)[:, :L]
    return from_sub(o), from_sub(lse)


def dilated_mixture_attention(q, k, v):
    outs, lses = [], []
    for g, (window, dil) in enumerate(C_GROUPS):
        hs = slice(g * C_HPG, (g + 1) * C_HPG)
        o, l = dilated_window_attention(q[:, :, hs], k[:, :, hs], v[:, :, hs], dil, window // (2 * dil))
        outs.append(o)
        lses.append(l)
    alpha = jax.nn.softmax(jnp.stack(lses), axis=0)
    return jnp.concatenate([o * a[..., None].astype(o.dtype) for o, a in zip(outs, alpha)], axis=2)


def expert_dispatch(xf, eid, ew, w1, w3, w2):
    n, d = xf.shape
    a = n * TOP_K_INNER
    e_flat = eid.reshape(a).astype(jnp.int32)
    order = jnp.argsort(e_flat)
    e_sorted = e_flat[order]
    counts = jnp.bincount(e_flat, length=N_EXPERTS).astype(jnp.int32)
    padded = (counts + MOE_BLOCK - 1) // MOE_BLOCK * MOE_BLOCK
    pad_end = jnp.cumsum(padded)
    pad_start = pad_end - padded
    start = jnp.cumsum(counts) - counts
    dest = pad_start[e_sorted] + jnp.arange(a, dtype=jnp.int32) - start[e_sorted]
    n_blocks = -(-(a + N_EXPERTS * (MOE_BLOCK - 1)) // MOE_BLOCK)
    p_len = n_blocks * MOE_BLOCK
    slot_tok = jnp.full((p_len,), n, jnp.int32).at[dest].set((order // TOP_K_INNER).astype(jnp.int32))
    slot_w = jnp.zeros((p_len,), xf.dtype).at[dest].set(ew.reshape(a)[order].astype(xf.dtype))
    blk_start = jnp.arange(n_blocks, dtype=jnp.int32) * MOE_BLOCK
    blk_exp = jnp.minimum(jnp.searchsorted(pad_end, blk_start, side='right'), N_EXPERTS - 1)
    x_pad = jnp.concatenate([xf, jnp.zeros((1, d), xf.dtype)], axis=0)

    def run(args):
        tok, e = args
        xb = x_pad[tok]
        hid = jax.nn.silu(xb @ w1[e]) * (xb @ w3[e])
        return hid @ w2[e]

    yb = lax.map(run, (slot_tok.reshape(n_blocks, MOE_BLOCK), blk_exp)).reshape(p_len, d)
    y = jnp.zeros((n + 1, d), xf.dtype).at[slot_tok].add(yb * slot_w[:, None])
    return y[:n]


def hierarchical_moe(x, w_coarse, w_fine, w1, w3, w2):
    b, s, d = x.shape
    xf = x.reshape(b * s, d)
    cl = jnp.einsum('nd,dg->ng', xf, w_coarse).astype(jnp.float32)
    cp = jax.nn.softmax(cl, axis=-1)
    grp = jnp.argmax(cl, axis=-1)
    pg = jnp.take_along_axis(cp, grp[:, None], axis=1)[:, 0]
    fl = jnp.einsum('nd,gde->nge', xf, w_fine).astype(jnp.float32)
    fl = jnp.take_along_axis(fl, grp[:, None, None], axis=1)[:, 0]
    tv, ti = lax.top_k(fl, TOP_K_INNER)
    tw = jax.nn.softmax(tv, axis=-1) * pg[:, None]
    eid = grp[:, None] * EXPERTS_PER_GROUP + ti
    return expert_dispatch(xf, eid, tw, w1, w3, w2).reshape(b, s, d)


def encoder_layer(x, layer_idx, rope_a, rope_b, rope_c, w_in, lam_vecs, subln_g, q_norm_g, w_uq,
                  kv_norm_g, w_ukv, w_out, ln1_g, ln1_b, w_coarse, w_fine, w1, w3, w2, ln2_g, ln2_b):
    b, s, _ = x.shape
    h = x @ w_in
    h_a, h_b, h_c = jnp.split(h, [COL_A, COL_A + COL_B], axis=-1)

    qa, ka, va = jnp.split(h_a, 3, axis=-1)
    qa = apply_rope(qa.reshape(b, s, A_HEADS, 2, A_HALF), *rope_a)
    ka = apply_rope(ka.reshape(b, s, A_HEADS, 2, A_HALF), *rope_a)
    va = va.reshape(b, s, A_HEADS, HEAD_DIM)
    lam_init = 0.8 - 0.6 * math.exp(-0.3 * layer_idx)
    lv = lam_vecs.astype(jnp.float32)
    lam = jnp.exp(jnp.sum(lv[0] * lv[1])) - jnp.exp(jnp.sum(lv[2] * lv[3])) + lam_init
    oa = rms_norm(differential_attention(qa, ka, va, lam), subln_g) * (1.0 - lam_init)

    c_q, c_kv, k_rope = jnp.split(h_b, [B_Q_RANK, B_Q_RANK + B_KV_RANK], axis=-1)
    qb = (rms_norm(c_q, q_norm_g) @ w_uq).reshape(b, s, B_HEADS, B_NOPE + B_ROPE)
    q_nope, q_rope = jnp.split(qb, [B_NOPE], axis=-1)
    kvb = (rms_norm(c_kv, kv_norm_g) @ w_ukv).reshape(b, s, B_HEADS, B_NOPE + B_V)
    k_nope, vb = jnp.split(kvb, [B_NOPE], axis=-1)
    ob = latent_attention(q_nope, apply_rope(q_rope, *rope_b), k_nope, apply_rope(k_rope, *rope_b), vb)

    qc, kc, vc = [t.reshape(b, s, C_HEADS, HEAD_DIM) for t in jnp.split(h_c, 3, axis=-1)]
    oc = dilated_mixture_attention(apply_rope(qc, *rope_c), apply_rope(kc, *rope_c), vc)

    mix = jnp.concatenate([oa.reshape(b, s, A_W), ob.reshape(b, s, B_W), oc.reshape(b, s, C_W)], axis=-1) @ w_out
    x = layer_norm(DN_ALPHA * x + mix, ln1_g, ln1_b)
    x = layer_norm(DN_ALPHA * x + hierarchical_moe(x, w_coarse, w_fine, w1, w3, w2), ln2_g, ln2_b)
    return x


def setup_inputs(seed: int = 0) -> dict:
    key = jax.random.key(seed)
    ks = jax.random.split(key, 20)
    f32 = jnp.float32

    def nrm(k, shape, scale):
        return jax.random.normal(k, shape, f32) * scale

    in_scale = np.concatenate([
        np.ones(2 * A_W), np.full(A_W, DN_BETA),
        np.ones(COL_B),
        np.ones(2 * C_W), np.full(C_W, DN_BETA)]).astype(np.float32)
    ukv_scale = np.tile(np.concatenate([np.ones(B_NOPE), np.full(B_V, DN_BETA)]), B_HEADS).astype(np.float32)
    return {
        'x_prompt': nrm(ks[0], (BATCH, SEQ, D_MODEL), 1.0),
        'x_sample': nrm(ks[1], (DEC_BATCH, DEC_SEQ, D_MODEL), 1.0),
        'w_in': nrm(ks[2], (DEPTH, D_MODEL, IN_COLS), D_MODEL ** -0.5) * in_scale,
        'diff_lambda': nrm(ks[3], (DEPTH, 4, A_HALF), 0.1),
        'diff_subln': 1.0 + nrm(ks[4], (DEPTH, HEAD_DIM), 0.1),
        'mla_q_norm': 1.0 + nrm(ks[5], (DEPTH, B_Q_RANK), 0.1),
        'mla_w_uq': nrm(ks[6], (DEPTH, B_Q_RANK, B_HEADS * (B_NOPE + B_ROPE)), B_Q_RANK ** -0.5),
        'mla_kv_norm': 1.0 + nrm(ks[7], (DEPTH, B_KV_RANK), 0.1),
        'mla_w_ukv': nrm(ks[8], (DEPTH, B_KV_RANK, B_HEADS * (B_NOPE + B_V)), B_KV_RANK ** -0.5) * ukv_scale,
        'w_out': nrm(ks[9], (DEPTH, MIX_W, D_MODEL), MIX_W ** -0.5 * DN_BETA),
        'ln1_g': 1.0 + nrm(ks[10], (DEPTH, D_MODEL), 0.1),
        'ln1_b': nrm(ks[11], (DEPTH, D_MODEL), 0.02),
        'moe_w_coarse': nrm(ks[12], (DEPTH, D_MODEL, N_GROUPS), D_MODEL ** -0.5),
        'moe_w_fine': nrm(ks[13], (DEPTH, N_GROUPS, D_MODEL, EXPERTS_PER_GROUP), D_MODEL ** -0.5),
        'moe_w1': nrm(ks[14], (DEPTH, N_EXPERTS, D_MODEL, D_EXPERT), D_MODEL ** -0.5),
        'moe_w3': nrm(ks[15], (DEPTH, N_EXPERTS, D_MODEL, D_EXPERT), D_MODEL ** -0.5 * DN_BETA),
        'moe_w2': nrm(ks[16], (DEPTH, N_EXPERTS, D_EXPERT, D_MODEL), D_EXPERT ** -0.5 * DN_BETA),
        'ln2_g': 1.0 + nrm(ks[17], (DEPTH, D_MODEL), 0.1),
        'ln2_b': nrm(ks[18], (DEPTH, D_MODEL), 0.02),
    }


def reference(x_prompt, x_sample, w_in, diff_lambda, diff_subln, mla_q_norm, mla_w_uq, mla_kv_norm,
              mla_w_ukv, w_out, ln1_g, ln1_b, moe_w_coarse, moe_w_fine, moe_w1, moe_w3, moe_w2, ln2_g, ln2_b):
    def trunk(x):
        s = x.shape[1]
        rope_a = rope_tables(s, A_HALF)
        rope_b = rope_tables(s, B_ROPE)
        rope_c = rope_tables(s, HEAD_DIM)
        for l in range(DEPTH):
            x = encoder_layer(x, l, rope_a, rope_b, rope_c, w_in[l], diff_lambda[l], diff_subln[l],
                              mla_q_norm[l], mla_w_uq[l], mla_kv_norm[l], mla_w_ukv[l], w_out[l],
                              ln1_g[l], ln1_b[l], moe_w_coarse[l], moe_w_fine[l], moe_w1[l], moe_w3[l],
                              moe_w2[l], ln2_g[l], ln2_b[l])
        return x

    y_prompt = trunk(x_prompt)
    y_sample = trunk(x_sample)
    return (y_prompt, y_sample)
```

```cpp
#include <hip/hip_runtime.h>
#include <cstdio>
#include <cstdint>

#ifndef MK_ONE_LAUNCH
#define MK_ONE_LAUNCH 1
#endif

#define GAS __attribute__((address_space(1)))
#define LAS __attribute__((address_space(3)))
typedef unsigned short bf16_t;
typedef short bf16x8 __attribute__((ext_vector_type(8)));
typedef float f32x4 __attribute__((ext_vector_type(4)));
typedef float f32x2 __attribute__((ext_vector_type(2)));
typedef float f32x16 __attribute__((ext_vector_type(16)));
typedef unsigned u32x4 __attribute__((ext_vector_type(4)));
typedef unsigned u32x2 __attribute__((ext_vector_type(2)));
typedef GAS unsigned gu32;
#define RLX_AGENT __ATOMIC_RELAXED, __HIP_MEMORY_SCOPE_AGENT
#define LDS_WAIT() asm volatile("s_waitcnt lgkmcnt(0)" ::: "memory")
#define VM_WAIT() asm volatile("s_waitcnt vmcnt(0)" ::: "memory")
#define MFMA32(a, b, c) __builtin_amdgcn_mfma_f32_32x32x16_bf16(a, b, c, 0, 0, 0)

__device__ __forceinline__ unsigned f2bf(float f) { unsigned u = __builtin_bit_cast(unsigned, f); return (u + 0x7fffu + ((u >> 16) & 1u)) >> 16; }
__device__ __forceinline__ unsigned pk2(float lo, float hi) { return f2bf(lo) | (f2bf(hi) << 16); }
__device__ __forceinline__ float bf2f(unsigned short b) { return __builtin_bit_cast(float, (unsigned)b << 16); }
__device__ __forceinline__ int crow(int r, int hi) { return (r & 3) + 8 * (r >> 2) + 4 * hi; }
__device__ __forceinline__ float wave_sum(float v) {
#pragma unroll
    for (int o = 1; o < 64; o <<= 1) v += __shfl_xor(v, o);
    return v;
}
__device__ __forceinline__ float fast_exp2(float x) { return __builtin_amdgcn_exp2f(x); }

constexpr int NTOK = 65536, DM = 1024, DEPTH = 4;
constexpr int NTOK_P = 32768;
constexpr int HP = 2560;
constexpr int HC_AQ = 0, HC_AK = 256, HC_AV = 512, HC_CQ_LAT = 768, HC_CKV = 1024, HC_KROPE = 1152, HC_CQ = 1280, HC_CK = 1664, HC_CV = 2048;
constexpr int QBP = 768, KVP = 768;
constexpr int MIX_A = 0, MIX_B = 256, MIX_C = 640;
constexpr int NEXP = 32, DEXP = 512;
constexpr float LOG2E = 1.4426950408889634f;
constexpr float SC_A = 0.17677669529663687f * LOG2E;
constexpr float SC_B = 0.10206207261596575f * LOG2E;
constexpr float SC_C = 0.125f * LOG2E;
constexpr float DN_ALPHA = 1.681792830507429f;
constexpr float LN_EPS = 1e-5f, RMS_EPS = 1e-6f;

constexpr size_t MiB = 1u << 20;
constexpr size_t WS_CTL = 0, CTL_ZERO_BYTES = 1 * MiB;
constexpr size_t WS_ROPE32 = 4 * MiB;
constexpr size_t WS_ROPE64 = 5 * MiB;
constexpr size_t WS_WIN = 8 * MiB;
constexpr size_t WS_WOUT = 28 * MiB;
constexpr size_t WS_WUQ = 36 * MiB;
constexpr size_t WS_WUKV = 38 * MiB;
constexpr size_t WS_W13 = 40 * MiB;
constexpr size_t WS_W2 = 104 * MiB;
constexpr size_t WS_XB = 136 * MiB;
constexpr size_t WS_H = 264 * MiB;
constexpr size_t WS_QB = 584 * MiB;
constexpr size_t WS_KVB = 680 * MiB;
constexpr size_t WS_MIX = 776 * MiB;
constexpr size_t WS_RSTD = 904 * MiB;
constexpr size_t WS_LSEC = 905 * MiB;
constexpr size_t WS_TW = 907 * MiB;
constexpr size_t WS_LIST = 908 * MiB;
constexpr size_t WS_END = 924 * MiB;
constexpr size_t WS_HID = WS_H;
constexpr size_t WS_YB = WS_H + 136 * MiB;
static_assert(WS_YB + 256 * MiB <= WS_KVB + 96 * MiB, "YB overlay");
constexpr int LIST_CAP = 131072;
constexpr int CW_TMO = 0;
constexpr int CW_CNT = 64;
constexpr int CW_BAR = 4096;

constexpr int RING_BYTES = 131072;
constexpr int MISC_OFF = RING_BYTES + 320;
constexpr int LDS_BYTES = 147456;
constexpr int NWAVES = 8, NTHREADS = 512;

#define XB_TMO      128
#define XB_XCNT(j)  (256  + 64 * (j))
#define XB_XSUB(j)  (1280 + 64 * (j))
#define XB_XGEN(j)  (2304 + 64 * (j))
#define XB_TOP      3328
#define XB_TOPGEN   3392
#define XCD_BAR_WORDS 3456
#define XB_SPIN_CAP (1u << 22)
__device__ __forceinline__ unsigned xb_ld(unsigned* p)              { return __hip_atomic_load(p, __ATOMIC_RELAXED, __HIP_MEMORY_SCOPE_AGENT); }
__device__ __forceinline__ unsigned xb_add(unsigned* p, unsigned v) { return __hip_atomic_fetch_add(p, v, __ATOMIC_RELAXED, __HIP_MEMORY_SCOPE_AGENT); }
__device__ __forceinline__ unsigned xb_xcc_id() { return (unsigned)__builtin_amdgcn_s_getreg((3 << 11) | 20) & 0xFu; }
#define XB_SPIN(cond, bar) do { unsigned _sp = 0; while (cond) { __builtin_amdgcn_s_sleep(1); \
    if ((++_sp & 255u) == 0u) { if (xb_ld(&(bar)[XB_TMO])) break; if (_sp > XB_SPIN_CAP) { atomicAdd(&(bar)[XB_TMO], 1u); break; } } } } while (0)
struct XcdBarrier { unsigned* bar; unsigned x; volatile LAS unsigned* st; };
__device__ __forceinline__ XcdBarrier xcd_barrier_post(unsigned* bar, volatile LAS unsigned* st) {
    XcdBarrier b; b.bar = bar; b.x = xb_xcc_id(); b.st = st;
    if (threadIdx.x == 0) (void)xb_add(&bar[XB_XCNT(b.x)], 1u);
    return b;
}
__device__ __forceinline__ void xcd_barrier_complete(unsigned* bar, unsigned x, unsigned& nloc, unsigned& nx) {
    const unsigned G = gridDim.x * gridDim.y * gridDim.z;
    unsigned sum, cnt, mine, sp = 0u;
    for (;;) {
        sum = 0u; cnt = 0u; mine = 0u;
#pragma unroll
        for (unsigned j = 0; j < 16; ++j) { const unsigned c = xb_ld(&bar[XB_XCNT(j)]); sum += c; cnt += (c > 0u) ? 1u : 0u; mine = (j == x) ? c : mine; }
        if (sum == G) break;
        __builtin_amdgcn_s_sleep(1);
        if ((++sp & 255u) == 0u) { if (xb_ld(&bar[XB_TMO])) break; if (sp > XB_SPIN_CAP) { atomicAdd(&bar[XB_TMO], 1u); break; } }
    }
    nloc = mine > 0u ? mine : 1u; nx = cnt > 0u ? cnt : 1u;
}
__device__ __forceinline__ void xcd_barrier(const XcdBarrier& b) {
    asm volatile("s_waitcnt vmcnt(0)" ::: "memory");
    __syncthreads();
    if (threadIdx.x == 0) {
        unsigned* bar = b.bar;
        __builtin_amdgcn_s_waitcnt(0);
        unsigned nloc = b.st[0], nx = b.st[1];
        if (nloc == 0u) { xcd_barrier_complete(bar, b.x, nloc, nx); b.st[0] = nloc; b.st[1] = nx; }
        const unsigned old = xb_add(&bar[XB_XSUB(b.x)], 1u);
        const unsigned gen = old / nloc;
        if (old + 1u == (gen + 1u) * nloc) {
            __builtin_amdgcn_fence(__ATOMIC_RELEASE, "agent");
            asm volatile("s_waitcnt vmcnt(0)" ::: "memory");
            const unsigned og = xb_add(&bar[XB_TOP], 1u);
            const unsigned tg = og / nx;
            if (og + 1u == (tg + 1u) * nx) xb_add(&bar[XB_TOPGEN], 1u);
            else XB_SPIN(xb_ld(&bar[XB_TOPGEN]) == tg, bar);
            __builtin_amdgcn_fence(__ATOMIC_ACQUIRE, "agent");
            xb_add(&bar[XB_XGEN(b.x)], 1u);
            asm volatile("s_waitcnt vmcnt(0)" ::: "memory");
        } else {
            XB_SPIN(xb_ld(&bar[XB_XGEN(b.x)]) == gen, bar);
            __builtin_amdgcn_fence(__ATOMIC_ACQUIRE, "agent");
            asm volatile("s_waitcnt vmcnt(0)" ::: "memory");
        }
    }
    __syncthreads();
}

struct Args {
    const float* x_prompt; const float* x_sample; const float* w_in; const float* diff_lambda; const float* diff_subln; const float* mla_q_norm; const float* mla_w_uq;
    const float* mla_kv_norm; const float* mla_w_ukv; const float* w_out; const float* ln1_g; const float* ln1_b; const float* moe_w_coarse; const float* moe_w_fine;
    const float* moe_w1; const float* moe_w3; const float* moe_w2; const float* ln2_g; const float* ln2_b;
    float* out; unsigned char* ws; int ph_lo, ph_hi, use_bar, pad;
};
struct Frame {
    LAS unsigned char* lds; unsigned char* ldsg;
    int tid, lane, wave, G, gw, NGW;
    gu32* ctl; unsigned char* ws;
};
__device__ __forceinline__ void launder(Frame& F) {
    int t = F.tid; asm volatile("" : "+v"(t)); F.tid = t; F.lane = t & 63; F.wave = __builtin_amdgcn_readfirstlane(t >> 6);
    int b = (int)blockIdx.x; asm volatile("" : "+s"(b)); F.gw = b * NWAVES + F.wave;
    unsigned char* w = F.ws; asm volatile("" : "+s"(w)); F.ws = w; F.ctl = (gu32*)(w + WS_CTL);
}
struct SeqInfo { int base, len, pos; };
__device__ __forceinline__ SeqInfo seqinfo(int m) { SeqInfo s; if (m < NTOK_P) { s.base = m & ~2047; s.len = 2048; } else { s.base = m & ~4095; s.len = 4096; } s.pos = m - s.base; return s; }

template <class ColMap>
__device__ __forceinline__ void transpose_item(const float* W, int N, bf16_t* WT, int ldd, LAS float* scr, int k0, int n0, const ColMap& cm, const float* kscale, int lane) {
    const int sc = cm(n0 + (lane & 31));
#pragma unroll 8
    for (int i = 0; i < 32; ++i) { const int kk = 2 * i + (lane >> 5); float v = 0.f; if (sc >= 0) { v = W[(size_t)(k0 + kk) * N + sc]; if (kscale) v *= kscale[k0 + kk]; } scr[kk * 33 + (lane & 31)] = v; }
    LDS_WAIT(); asm volatile("" ::: "memory");
    const int c = lane & 7;
#pragma unroll
    for (int j = 0; j < 4; ++j) { const int n = (lane >> 3) + 8 * j; const LAS float* s = scr + (8 * c) * 33 + n;
        u32x4 o; o.x = pk2(s[0 * 33], s[1 * 33]); o.y = pk2(s[2 * 33], s[3 * 33]); o.z = pk2(s[4 * 33], s[5 * 33]); o.w = pk2(s[6 * 33], s[7 * 33]);
        *(u32x4*)(WT + (size_t)(n0 + n) * ldd + k0 + 8 * c) = o; }
    LDS_WAIT(); asm volatile("" ::: "memory");
}
struct WinMap {
    __device__ __forceinline__ int operator()(int n) const {
        if (n < 512) { const int t = n & 31; return (n & ~31) + (t >> 1) + 16 * (t & 1); }
        if (n < 1152) return n;
        if (n < 1184) { const int t = n - 1152; return 1152 + (t >> 1) + 16 * (t & 1); }
        if (n < 1280) return -1;
        if (n < 2048) { const int u = n - 1280, t = u & 63; return 1184 + (u & ~63) + (t >> 1) + 32 * (t & 1); }
        if (n < 2432) return 1952 + (n - 2048);
        return -1;
    }
};
struct UqMap { __device__ __forceinline__ int operator()(int n) const { if (n >= 576) return -1; const int h = n / 96, t = n - 96 * h; if (t < 64) return n; const int u = t - 64; return 96 * h + 64 + (u >> 1) + 16 * (u & 1); } };
struct IdMap { __device__ __forceinline__ int operator()(int n) const { return n; } };
struct W13Map { __device__ __forceinline__ int operator()(int n) const { return (n >> 8) * 128 + (n & 127); } };

__device__ __forceinline__ void p0_prologue(Frame& F, const Args& a) {
    LAS float* scr = (LAS float*)(F.lds + F.wave * 16384);
    { float2* r32 = (float2*)(F.ws + WS_ROPE32); float2* r64 = (float2*)(F.ws + WS_ROPE64);
      for (int i = F.gw * 64 + F.lane; i < 4096 * 16; i += F.NGW * 64) { const int pos = i >> 4, j = i & 15; const float inv = 1.0f / powf(10000.0f, (float)(2 * j) / 32.0f); const float ang = (float)pos * inv; r32[i] = make_float2(cosf(ang), sinf(ang)); }
      for (int i = F.gw * 64 + F.lane; i < 4096 * 32; i += F.NGW * 64) { const int pos = i >> 5, j = i & 31; const float inv = 1.0f / powf(10000.0f, (float)(2 * j) / 64.0f); const float ang = (float)pos * inv; r64[i] = make_float2(cosf(ang), sinf(ang)); } }
    constexpr int I_WIN = (1024 / 64) * (2560 / 32), I_WOUT = (1024 / 64) * (1024 / 32), I_UQ = (256 / 64) * (768 / 32), I_UKV = (256 / 64) * (768 / 32);
    constexpr int PER_L = I_WIN + I_WOUT + I_UQ + I_UKV;
    for (int it = F.gw; it < DEPTH * PER_L; it += F.NGW) {
        const int l = it / PER_L; int r = it - l * PER_L;
        if (r < I_WIN) { const int kb = r / 80, nb = r % 80; transpose_item(a.w_in + (size_t)l * 1024 * 2336, 2336, (bf16_t*)(F.ws + WS_WIN) + (size_t)l * 2560 * 1024, 1024, scr, kb * 64, nb * 32, WinMap(), nullptr, F.lane); continue; } r -= I_WIN;
        if (r < I_WOUT) { const int kb = r / 32, nb = r % 32; transpose_item(a.w_out + (size_t)l * 1024 * 1024, 1024, (bf16_t*)(F.ws + WS_WOUT) + (size_t)l * 1024 * 1024, 1024, scr, kb * 64, nb * 32, IdMap(), nullptr, F.lane); continue; } r -= I_WOUT;
        if (r < I_UQ) { const int kb = r / 24, nb = r % 24; transpose_item(a.mla_w_uq + (size_t)l * 256 * 576, 576, (bf16_t*)(F.ws + WS_WUQ) + (size_t)l * 768 * 256, 256, scr, kb * 64, nb * 32, UqMap(), a.mla_q_norm + l * 256, F.lane); continue; } r -= I_UQ;
        { const int kb = r / 24, nb = r % 24; bf16_t* dst = (bf16_t*)(F.ws + WS_WUKV) + (size_t)l * 768 * 256;
          if (kb < 2) transpose_item(a.mla_w_ukv + (size_t)l * 128 * 768, 768, dst, 256, scr, kb * 64, nb * 32, IdMap(), a.mla_kv_norm + l * 128, F.lane);
          else { const int c = F.lane & 7;
#pragma unroll
              for (int j = 0; j < 4; ++j) { const int n = (F.lane >> 3) + 8 * j; *(u32x4*)(dst + (size_t)(nb * 32 + n) * 256 + kb * 64 + 8 * c) = (u32x4){0u, 0u, 0u, 0u}; } } }
    }
    bf16_t* XB = (bf16_t*)(F.ws + WS_XB);
    for (int m = F.gw; m < NTOK; m += F.NGW) {
        const float* src = (m < NTOK_P) ? a.x_prompt + (size_t)m * DM : a.x_sample + (size_t)(m - NTOK_P) * DM;
#pragma unroll
        for (int j = 0; j < 4; ++j) { const f32x4 v = *((const f32x4*)src + F.lane + 64 * j); *((f32x4*)(a.out + (size_t)m * DM) + F.lane + 64 * j) = v;
            u32x2 w; w.x = pk2(v.x, v.y); w.y = pk2(v.z, v.w); *((u32x2*)(XB + (size_t)m * DM) + F.lane + 64 * j) = w; }
    }
}

template <class Epi, class RowMap>
__device__ __forceinline__ void sg_tile(const bf16_t* A, int lda, const bf16_t* B0, const bf16_t* B1, int ldb, int K, int m0, int c0, const Epi& E, const RowMap& RM, int lane) {
    const int r32 = lane & 31, hi = lane >> 5;
    const bf16_t* ap = A + (size_t)RM.src(m0 + r32) * lda + 8 * hi;
    const bf16_t* b0p = B0 + (size_t)r32 * ldb + 8 * hi;
    const bf16_t* b1p = B1 + (size_t)r32 * ldb + 8 * hi;
    f32x16 acc0 = {}, acc1 = {};
#pragma unroll 4
    for (int k = 0; k < K; k += 16) {
        const bf16x8 af = *(const bf16x8*)(ap + k), bf0 = *(const bf16x8*)(b0p + k), bf1 = *(const bf16x8*)(b1p + k);
        acc0 = MFMA32(bf0, af, acc0); acc1 = MFMA32(bf1, af, acc1);
    }
#pragma unroll
    for (int g = 0; g < 4; ++g) { const f32x4 v0 = {acc0[4 * g], acc0[4 * g + 1], acc0[4 * g + 2], acc0[4 * g + 3]}, v1 = {acc1[4 * g], acc1[4 * g + 1], acc1[4 * g + 2], acc1[4 * g + 3]};
        E.put(m0 + r32, c0, 8 * g + 4 * hi, v0, v1); }
}
struct IdRows { __device__ __forceinline__ int src(int m) const { return m; } };

__device__ __forceinline__ void store_bf4(bf16_t* p, f32x4 v) { u32x2 w; w.x = pk2(v.x, v.y); w.y = pk2(v.z, v.w); *(u32x2*)p = w; }
struct EpiH {
    bf16_t* H; const float2* rope32; const float2* rope64;
    __device__ __forceinline__ void put4(int row, int col, f32x4 v) const {
        const int pos = seqinfo(row).pos;
        if (col < 512 || (col >= HC_KROPE && col < HC_KROPE + 32)) {
            const int j0 = (col & 31) >> 1; const f32x4 cs = *(const f32x4*)(rope32 + pos * 16 + j0);
            f32x4 o; o.x = v.x * cs.x - v.y * cs.y; o.y = v.x * cs.y + v.y * cs.x; o.z = v.z * cs.z - v.w * cs.w; o.w = v.z * cs.w + v.w * cs.z;
            if (col < 256) o = o * SC_A; v = o;
        } else if (col >= HC_CQ && col < HC_CV) {
            const int j0 = ((col - HC_CQ) & 63) >> 1; const f32x4 cs = *(const f32x4*)(rope64 + pos * 32 + j0);
            f32x4 o; o.x = v.x * cs.x - v.y * cs.y; o.y = v.x * cs.y + v.y * cs.x; o.z = v.z * cs.z - v.w * cs.w; o.w = v.z * cs.w + v.w * cs.z;
            if (col < HC_CK) o = o * SC_C; v = o;
        }
        store_bf4(H + (size_t)row * HP + col, v);
    }
    __device__ __forceinline__ void put(int row, int c0, int cc, f32x4 v0, f32x4 v1) const { put4(row, c0 + cc, v0); put4(row, c0 + 32 + cc, v1); }
};
struct EpiUQ {
    bf16_t* Q; const float* rstd; const float2* rope32;
    __device__ __forceinline__ void put4(int row, int col, f32x4 v) const {
        if (col >= 576) return;
        v = v * rstd[2 * row];
        const int t = col % 96;
        if (t >= 64) { const int pos = seqinfo(row).pos; const int j0 = (t - 64) >> 1; const f32x4 cs = *(const f32x4*)(rope32 + pos * 16 + j0);
            f32x4 o; o.x = v.x * cs.x - v.y * cs.y; o.y = v.x * cs.y + v.y * cs.x; o.z = v.z * cs.z - v.w * cs.w; o.w = v.z * cs.w + v.w * cs.z; v = o; }
        store_bf4(Q + (size_t)row * QBP + col, v * SC_B);
    }
    __device__ __forceinline__ void put(int row, int c0, int cc, f32x4 v0, f32x4 v1) const { put4(row, c0 + cc, v0); put4(row, c0 + 32 + cc, v1); }
};
struct EpiUKV {
    bf16_t* KV; const float* rstd;
    __device__ __forceinline__ void put4(int row, int col, f32x4 v) const { store_bf4(KV + (size_t)row * KVP + col, v * rstd[2 * row + 1]); }
    __device__ __forceinline__ void put(int row, int c0, int cc, f32x4 v0, f32x4 v1) const { put4(row, c0 + cc, v0); put4(row, c0 + 32 + cc, v1); }
};
struct EpiRes {
    float* X;
    __device__ __forceinline__ void put4(int row, int col, f32x4 v) const { f32x4* p = (f32x4*)(X + (size_t)row * DM + col); *p = *p * DN_ALPHA + v; }
    __device__ __forceinline__ void put(int row, int c0, int cc, f32x4 v0, f32x4 v1) const { put4(row, c0 + cc, v0); put4(row, c0 + 32 + cc, v1); }
};
__device__ __forceinline__ float silu_f(float x) { return x / (1.0f + __expf(-x)); }
struct EpiHid {
    bf16_t* HID;
    __device__ __forceinline__ void putp(int row, int col, f32x4 g, f32x4 u) const { f32x4 o; o.x = silu_f(g.x) * u.x; o.y = silu_f(g.y) * u.y; o.z = silu_f(g.z) * u.z; o.w = silu_f(g.w) * u.w; store_bf4(HID + (size_t)row * DEXP + col, o); }
    __device__ __forceinline__ void put(int row, int c0, int cc, f32x4 v0, f32x4 v1) const { putp(row, c0 + cc, v0, v1); }
};
struct EpiY {
    bf16_t* YB; const float* tw; const int* list; int seg0, cnt;
    __device__ __forceinline__ void put4(int row, int col, f32x4 v) const { const int r = row - seg0; if (r >= cnt) return; const int a = list[r]; store_bf4(YB + (size_t)a * DM + col, v * tw[a]); }
    __device__ __forceinline__ void put(int row, int c0, int cc, f32x4 v0, f32x4 v1) const { put4(row, c0 + cc, v0); put4(row, c0 + 32 + cc, v1); }
};

template <class Epi>
__device__ __forceinline__ void sg_phase(Frame& F, const bf16_t* A, int lda, const bf16_t* Bt, int ldb, int M, int N, int K, const Epi& E) {
    const int nN = N / 64, items = (M / 32) * nN;
    for (int it = F.gw; it < items; it += F.NGW) { const int mt = it / nN, nt = it - mt * nN;
        sg_tile(A, lda, Bt + (size_t)(nt * 64) * ldb, Bt + (size_t)(nt * 64 + 32) * ldb, ldb, K, mt * 32, nt * 64, E, IdRows(), F.lane); }
}

__device__ __forceinline__ void rowstat_pass(Frame& F) {
    const bf16_t* H = (const bf16_t*)(F.ws + WS_H); float* rstd = (float*)(F.ws + WS_RSTD);
    for (int m = F.gw; m < NTOK; m += F.NGW) {
        const bf16_t* hr = H + (size_t)m * HP;
        const u32x2 q = *((const u32x2*)(hr + HC_CQ_LAT) + F.lane);
        const unsigned kv = *((const unsigned*)(hr + HC_CKV) + F.lane);
        float a0 = bf2f(q.x & 0xffff), a1 = bf2f(q.x >> 16), a2 = bf2f(q.y & 0xffff), a3 = bf2f(q.y >> 16), b0 = bf2f(kv & 0xffff), b1 = bf2f(kv >> 16);
        const float sq = wave_sum(a0 * a0 + a1 * a1 + a2 * a2 + a3 * a3), sk = wave_sum(b0 * b0 + b1 * b1);
        if (F.lane == 0) { rstd[2 * m] = 1.0f / sqrtf(sq * (1.0f / 256.0f) + RMS_EPS); rstd[2 * m + 1] = 1.0f / sqrtf(sk * (1.0f / 128.0f) + RMS_EPS); }
    }
}
__device__ __forceinline__ void ln1_route_pass(Frame& F, const Args& a, int layer) {
    bf16_t* XB = (bf16_t*)(F.ws + WS_XB); float* tw = (float*)(F.ws + WS_TW); int* list = (int*)(F.ws + WS_LIST);
    const float* g = a.ln1_g + layer * DM; const float* bb = a.ln1_b + layer * DM;
    const float* wc = a.moe_w_coarse + (size_t)layer * DM * 4; const float* wf = a.moe_w_fine + (size_t)layer * 4 * DM * 8;
    for (int m = F.gw; m < NTOK; m += F.NGW) {
        float* xr = a.out + (size_t)m * DM;
        f32x4 v[4]; float s = 0.f;
#pragma unroll
        for (int j = 0; j < 4; ++j) { v[j] = *((const f32x4*)xr + F.lane + 64 * j); s += (v[j].x + v[j].y) + (v[j].z + v[j].w); }
        const float mean = wave_sum(s) * (1.f / DM); float s2 = 0.f;
#pragma unroll
        for (int j = 0; j < 4; ++j) { v[j] = v[j] - mean; s2 += (v[j].x * v[j].x + v[j].y * v[j].y) + (v[j].z * v[j].z + v[j].w * v[j].w); }
        const float rs = 1.f / sqrtf(wave_sum(s2) * (1.f / DM) + LN_EPS);
        float cl[4] = {0.f, 0.f, 0.f, 0.f};
#pragma unroll
        for (int j = 0; j < 4; ++j) { const int c = 4 * F.lane + 256 * j; const f32x4 gg = *(const f32x4*)(g + c), bv = *(const f32x4*)(bb + c); v[j] = v[j] * rs * gg + bv;
            *((f32x4*)xr + F.lane + 64 * j) = v[j]; u32x2 w; w.x = pk2(v[j].x, v[j].y); w.y = pk2(v[j].z, v[j].w); *((u32x2*)(XB + (size_t)m * DM) + F.lane + 64 * j) = w;
#pragma unroll
            for (int e = 0; e < 4; ++e) { const f32x4 w4 = *(const f32x4*)(wc + (size_t)(c + e) * 4); const float xe = v[j][e]; cl[0] += xe * w4.x; cl[1] += xe * w4.y; cl[2] += xe * w4.z; cl[3] += xe * w4.w; } }
#pragma unroll
        for (int e = 0; e < 4; ++e) cl[e] = wave_sum(cl[e]);
        int grp = 0; float cm = cl[0];
#pragma unroll
        for (int e = 1; e < 4; ++e) if (cl[e] > cm) { cm = cl[e]; grp = e; }
        float den = 0.f;
#pragma unroll
        for (int e = 0; e < 4; ++e) den += __expf(cl[e] - cm);
        const float pg = 1.0f / den;
        const float* wfg = wf + (size_t)grp * DM * 8;
        float fl[8] = {0.f, 0.f, 0.f, 0.f, 0.f, 0.f, 0.f, 0.f};
#pragma unroll
        for (int j = 0; j < 4; ++j) { const int c = 4 * F.lane + 256 * j;
#pragma unroll
            for (int e = 0; e < 4; ++e) { const f32x4 wa = *(const f32x4*)(wfg + (size_t)(c + e) * 8), wb = *(const f32x4*)(wfg + (size_t)(c + e) * 8 + 4); const float xe = v[j][e];
                fl[0] += xe * wa.x; fl[1] += xe * wa.y; fl[2] += xe * wa.z; fl[3] += xe * wa.w; fl[4] += xe * wb.x; fl[5] += xe * wb.y; fl[6] += xe * wb.z; fl[7] += xe * wb.w; } }
#pragma unroll
        for (int e = 0; e < 8; ++e) fl[e] = wave_sum(fl[e]);
        int i0 = 0; float v0 = fl[0];
#pragma unroll
        for (int e = 1; e < 8; ++e) if (fl[e] > v0) { v0 = fl[e]; i0 = e; }
        int i1 = -1; float v1 = -3.0e38f;
#pragma unroll
        for (int e = 0; e < 8; ++e) if (e != i0 && fl[e] > v1) { v1 = fl[e]; i1 = e; }
        const float e1 = __expf(v1 - v0), w0 = pg / (1.0f + e1), w1 = pg * e1 / (1.0f + e1);
        if (F.lane < 2) { const int e = grp * 8 + (F.lane == 0 ? i0 : i1); const int a_id = 2 * m + F.lane;
            const unsigned pos = __hip_atomic_fetch_add(F.ctl + CW_CNT + layer * 64 + e, 1u, RLX_AGENT);
            list[(size_t)e * LIST_CAP + pos] = a_id; tw[a_id] = (F.lane == 0) ? w0 : w1; }
    }
}
__device__ __forceinline__ void ln2_pass(Frame& F, const Args& a, int layer) {
    bf16_t* XB = (bf16_t*)(F.ws + WS_XB); const bf16_t* YB = (const bf16_t*)(F.ws + WS_YB);
    const float* g = a.ln2_g + layer * DM; const float* bb = a.ln2_b + layer * DM;
    for (int m = F.gw; m < NTOK; m += F.NGW) {
        float* xr = a.out + (size_t)m * DM; const bf16_t* y0 = YB + (size_t)(2 * m) * DM; const bf16_t* y1 = y0 + DM;
        f32x4 v[4]; float s = 0.f;
#pragma unroll
        for (int j = 0; j < 4; ++j) { v[j] = *((const f32x4*)xr + F.lane + 64 * j) * DN_ALPHA; const u32x2 p = *((const u32x2*)y0 + F.lane + 64 * j), q = *((const u32x2*)y1 + F.lane + 64 * j);
            v[j].x += bf2f(p.x & 0xffff) + bf2f(q.x & 0xffff); v[j].y += bf2f(p.x >> 16) + bf2f(q.x >> 16); v[j].z += bf2f(p.y & 0xffff) + bf2f(q.y & 0xffff); v[j].w += bf2f(p.y >> 16) + bf2f(q.y >> 16);
            s += (v[j].x + v[j].y) + (v[j].z + v[j].w); }
        const float mean = wave_sum(s) * (1.f / DM); float s2 = 0.f;
#pragma unroll
        for (int j = 0; j < 4; ++j) { v[j] = v[j] - mean; s2 += (v[j].x * v[j].x + v[j].y * v[j].y) + (v[j].z * v[j].z + v[j].w * v[j].w); }
        const float rs = 1.f / sqrtf(wave_sum(s2) * (1.f / DM) + LN_EPS);
#pragma unroll
        for (int j = 0; j < 4; ++j) { const int c = 4 * F.lane + 256 * j; const f32x4 gg = *(const f32x4*)(g + c), bv = *(const f32x4*)(bb + c); v[j] = v[j] * rs * gg + bv;
            *((f32x4*)xr + F.lane + 64 * j) = v[j]; u32x2 w; w.x = pk2(v[j].x, v[j].y); w.y = pk2(v[j].z, v[j].w); *((u32x2*)(XB + (size_t)m * DM) + F.lane + 64 * j) = w; }
    }
}
__device__ __forceinline__ void moe_convert(Frame& F, const Args& a, int layer) {
    LAS float* scr = (LAS float*)(F.lds + F.wave * 16384);
    constexpr int I_13 = (1024 / 64) * (1024 / 32), I_2 = (512 / 64) * (1024 / 32), PER_E = I_13 + I_2;
    for (int it = F.gw; it < NEXP * PER_E; it += F.NGW) {
        const int e = it / PER_E; int r = it - e * PER_E; const size_t le = (size_t)layer * NEXP + e;
        if (r < I_13) { const int kb = r / 32, nb = r % 32; const float* src = ((nb >> 2) & 1) ? a.moe_w3 : a.moe_w1;
            transpose_item(src + le * 1024 * 512, 512, (bf16_t*)(F.ws + WS_W13) + (size_t)e * 1024 * 1024, 1024, scr, kb * 64, nb * 32, W13Map(), nullptr, F.lane); }
        else { r -= I_13; const int kb = r / 32, nb = r % 32; transpose_item(a.moe_w2 + le * 512 * 1024, 1024, (bf16_t*)(F.ws + WS_W2) + (size_t)e * 1024 * 512, 512, scr, kb * 64, nb * 32, IdMap(), nullptr, F.lane); }
    }
}

struct RowSrc { const bf16_t* p; long pitch; };
constexpr int SA_P = 0, SA_V = 4096, SA_AL = 12288, SA_RL = 12544;
template <int NC0, int NC1, int MODE>
__device__ __forceinline__ void sattn_core(const bf16x8* qf, RowSrc k0, RowSrc k1, RowSrc vs, int kb_lo, int kb_hi, int qidx0, float lse_ref, LAS unsigned char* scr, int lane, f32x16* o, float& lse_out) {
    const int r32 = lane & 31, hi = lane >> 5;
    LAS bf16_t* Pb = (LAS bf16_t*)(scr + SA_P); LAS bf16_t* Vb = (LAS bf16_t*)(scr + SA_V); LAS float* Al = (LAS float*)(scr + SA_AL);
    float m = -1.0e30f, l = 0.f;
    if (MODE != 1) { o[0] = f32x16{}; o[1] = f32x16{}; }
    for (int kb = kb_lo; kb < kb_hi; ++kb) {
        const long key = (long)kb * 32 + r32;
        f32x16 s = {};
#pragma unroll
        for (int c = 0; c < NC0; ++c) { const bf16x8 kf = *(const bf16x8*)(k0.p + key * k0.pitch + 16 * c + 8 * hi); s = MFMA32(kf, qf[c], s); }
#pragma unroll
        for (int c = 0; c < NC1; ++c) { const bf16x8 kf = *(const bf16x8*)(k1.p + key * k1.pitch + 16 * c + 8 * hi); s = MFMA32(kf, qf[NC0 + c], s); }
        bool valid[16];
#pragma unroll
        for (int r = 0; r < 16; ++r) { if (MODE == 0) valid[r] = true; else { const int d = kb * 32 + crow(r, hi) - (qidx0 + r32); valid[r] = (d <= 64 && d >= -64); } }
        float p[16];
        if (MODE == 2) {
#pragma unroll
            for (int r = 0; r < 16; ++r) p[r] = valid[r] ? fast_exp2(s[r] - lse_ref) : 0.f;
        } else {
            float mx = -1.0e30f;
#pragma unroll
            for (int r = 0; r < 16; ++r) if (valid[r]) mx = fmaxf(mx, s[r]);
            mx = fmaxf(mx, __shfl_xor(mx, 32));
            const float mn = fmaxf(m, mx), alpha = fast_exp2(m - mn); m = mn;
            float ps = 0.f;
#pragma unroll
            for (int r = 0; r < 16; ++r) { p[r] = valid[r] ? fast_exp2(s[r] - mn) : 0.f; ps += p[r]; }
            l = l * alpha + ps;
            if (MODE == 0) { if (hi == 0) Al[r32] = alpha; }
        }
        if (MODE != 1) {
#pragma unroll
            for (int g = 0; g < 4; ++g) { u32x2 w; w.x = pk2(p[4 * g], p[4 * g + 1]); w.y = pk2(p[4 * g + 2], p[4 * g + 3]); *(LAS u32x2*)(Pb + r32 * 40 + 8 * g + 4 * hi) = w; }
#pragma unroll
            for (int i = 0; i < 4; ++i) { const int idx = i * 64 + lane, kr = idx >> 3, pc = idx & 7; *(LAS u32x4*)(Vb + kr * 72 + pc * 8) = *(const u32x4*)(vs.p + ((long)kb * 32 + kr) * vs.pitch + pc * 8); }
            LDS_WAIT();
            if (MODE == 0) {
#pragma unroll
                for (int r = 0; r < 16; ++r) { const float al = Al[crow(r, hi)]; o[0][r] *= al; o[1][r] *= al; }
            }
#pragma unroll
            for (int st = 0; st < 2; ++st) {
                const bf16x8 pf = *(const LAS bf16x8*)(Pb + r32 * 40 + 16 * st + 8 * hi);
#pragma unroll
                for (int db = 0; db < 2; ++db) { bf16x8 vf;
#pragma unroll
                    for (int j = 0; j < 8; ++j) vf[j] = (short)Vb[(16 * st + 8 * hi + j) * 72 + 32 * db + r32];
                    o[db] = MFMA32(pf, vf, o[db]); }
            }
            LDS_WAIT();
        }
    }
    if (MODE != 2) { l += __shfl_xor(l, 32); lse_out = m + __log2f(l); }
    if (MODE == 0) {
        LAS float* Rl = (LAS float*)(scr + SA_RL);
        if (hi == 0) Rl[r32] = 1.0f / l;
        LDS_WAIT();
#pragma unroll
        for (int r = 0; r < 16; ++r) { const float rl = Rl[crow(r, hi)]; o[0][r] *= rl; o[1][r] *= rl; }
        LDS_WAIT();
    }
}

__device__ __forceinline__ void sattn_phase(Frame& F, const Args& a, int layer) {
    const bf16_t* H = (const bf16_t*)(F.ws + WS_H); const bf16_t* QB = (const bf16_t*)(F.ws + WS_QB); const bf16_t* KVB = (const bf16_t*)(F.ws + WS_KVB);
    bf16_t* MIX = (bf16_t*)(F.ws + WS_MIX); const float* lsec = (const float*)(F.ws + WS_LSEC);
    LAS unsigned char* scr = F.lds + F.wave * 16384;
    const int lane = F.lane, r32 = lane & 31, hi = lane >> 5;
    float lam, lam_init;
    { const float* lv = a.diff_lambda + layer * 128; float d1 = 0.f, d2 = 0.f;
      for (int i = 0; i < 32; ++i) { d1 += lv[i] * lv[32 + i]; d2 += lv[64 + i] * lv[96 + i]; }
      lam_init = 0.8f - 0.6f * expf(-0.3f * (float)layer); lam = expf(d1) - expf(d2) + lam_init; }
    constexpr int NRB = NTOK / 32;
    const int items = NRB * (4 + 6 + 6);
    for (int it = F.gw; it < items; it += F.NGW) {
        const int kind = it / NRB, rb = it - kind * NRB; const int m0 = rb * 32; const SeqInfo si = seqinfo(m0);
        if (kind < 4) {
            const int h = kind; f32x16 o0[2], o1[2]; float dummy;
            for (int c = 0; c < 2; ++c) {
                bf16x8 qf[2];
#pragma unroll
                for (int d0 = 0; d0 < 2; ++d0) qf[d0] = *(const bf16x8*)(H + (size_t)(m0 + r32) * HP + HC_AQ + h * 64 + c * 32 + 16 * d0 + 8 * hi);
                const RowSrc ks{H + (size_t)si.base * HP + HC_AK + h * 64 + c * 32, HP}, vs{H + (size_t)si.base * HP + HC_AV + h * 64, HP};
                sattn_core<2, 0, 0>(qf, ks, ks, vs, 0, si.len / 32, 0, 0.f, scr, lane, c == 0 ? o0 : o1, dummy);
            }
            const float* sg = a.diff_subln + layer * 64; const float g0 = sg[r32], g1 = sg[32 + r32];
#pragma unroll
            for (int r = 0; r < 16; ++r) { const float x0 = o0[0][r] - lam * o1[0][r], x1 = o0[1][r] - lam * o1[1][r]; float ss = x0 * x0 + x1 * x1;
                ss += __shfl_xor(ss, 1); ss += __shfl_xor(ss, 2); ss += __shfl_xor(ss, 4); ss += __shfl_xor(ss, 8); ss += __shfl_xor(ss, 16);
                const float rs = (1.0f - lam_init) / sqrtf(ss * (1.0f / 64.0f) + RMS_EPS);
                bf16_t* op = MIX + (size_t)(m0 + crow(r, hi)) * DM + MIX_A + h * 64 + r32;
                op[0] = (bf16_t)f2bf(x0 * rs * g0); op[32] = (bf16_t)f2bf(x1 * rs * g1); }
        } else if (kind < 10) {
            const int h = kind - 4; f32x16 o[2]; float dummy; bf16x8 qf[6];
#pragma unroll
            for (int d0 = 0; d0 < 6; ++d0) qf[d0] = *(const bf16x8*)(QB + (size_t)(m0 + r32) * QBP + h * 96 + 16 * d0 + 8 * hi);
            const RowSrc k0{KVB + (size_t)si.base * KVP + h * 128, KVP}, k1{H + (size_t)si.base * HP + HC_KROPE, HP}, vs{KVB + (size_t)si.base * KVP + h * 128 + 64, KVP};
            sattn_core<4, 2, 0>(qf, k0, k1, vs, 0, si.len / 32, 0, 0.f, scr, lane, o, dummy);
#pragma unroll
            for (int r = 0; r < 16; ++r) { bf16_t* op = MIX + (size_t)(m0 + crow(r, hi)) * DM + MIX_B + h * 64 + r32; op[0] = (bf16_t)f2bf(o[0][r]); op[32] = (bf16_t)f2bf(o[1][r]); }
        } else {
            const int gj = kind - 10, g = gj >> 1, hh = gj;
            const int dil = (g == 0) ? 1 : (g == 1 ? 4 : 16); const int L = si.len / dil, bpr = L / 32;
            const int w = (m0 - si.base) / 32, rho = w / bpr, ib = w - rho * bpr, i0 = ib * 32;
            const size_t qrow = (size_t)si.base + (size_t)(i0 + r32) * dil + rho;
            bf16x8 qf[4];
#pragma unroll
            for (int d0 = 0; d0 < 4; ++d0) qf[d0] = *(const bf16x8*)(H + qrow * HP + HC_CQ + hh * 64 + 16 * d0 + 8 * hi);
            const int j = gj & 1; const float l0 = lsec[(0 * (size_t)NTOK + qrow) * 2 + j], l1 = lsec[(1 * (size_t)NTOK + qrow) * 2 + j], l2 = lsec[(2 * (size_t)NTOK + qrow) * 2 + j];
            const float lm = fmaxf(l0, fmaxf(l1, l2)); const float lref = lm + __log2f(fast_exp2(l0 - lm) + fast_exp2(l1 - lm) + fast_exp2(l2 - lm));
            const RowSrc ks{H + ((size_t)si.base + rho) * HP + HC_CK + hh * 64, (long)HP * dil}, vs{H + ((size_t)si.base + rho) * HP + HC_CV + hh * 64, (long)HP * dil};
            int kb_lo = ib - 2, kb_hi = ib + 3; if (kb_lo < 0) kb_lo = 0; if (kb_hi > bpr) kb_hi = bpr;
            f32x16 o[2]; float dummy;
            sattn_core<4, 0, 2>(qf, ks, ks, vs, kb_lo, kb_hi, i0, lref, scr, lane, o, dummy);
#pragma unroll
            for (int r = 0; r < 16; ++r) { const size_t orow = (size_t)si.base + (size_t)(i0 + crow(r, hi)) * dil + rho; bf16_t* op = MIX + orow * DM + MIX_C + hh * 64 + r32; op[0] = (bf16_t)f2bf(o[0][r]); op[32] = (bf16_t)f2bf(o[1][r]); }
        }
    }
}
__device__ __forceinline__ void cstat_phase(Frame& F) {
    const bf16_t* H = (const bf16_t*)(F.ws + WS_H); float* lsec = (float*)(F.ws + WS_LSEC);
    LAS unsigned char* scr = F.lds + F.wave * 16384;
    const int lane = F.lane, r32 = lane & 31, hi = lane >> 5;
    constexpr int NRB = NTOK / 32;
    for (int it = F.gw; it < NRB * 6; it += F.NGW) {
        const int gj = it / NRB, rb = it - gj * NRB, g = gj >> 1, j = gj & 1; const int m0 = rb * 32; const SeqInfo si = seqinfo(m0);
        const int dil = (g == 0) ? 1 : (g == 1 ? 4 : 16); const int L = si.len / dil, bpr = L / 32;
        const int w = (m0 - si.base) / 32, rho = w / bpr, ib = w - rho * bpr, i0 = ib * 32;
        const size_t qrow = (size_t)si.base + (size_t)(i0 + r32) * dil + rho;
        bf16x8 qf[4];
#pragma unroll
        for (int d0 = 0; d0 < 4; ++d0) qf[d0] = *(const bf16x8*)(H + qrow * HP + HC_CQ + gj * 64 + 16 * d0 + 8 * hi);
        const RowSrc ks{H + ((size_t)si.base + rho) * HP + HC_CK + gj * 64, (long)HP * dil};
        int kb_lo = ib - 2, kb_hi = ib + 3; if (kb_lo < 0) kb_lo = 0; if (kb_hi > bpr) kb_hi = bpr;
        float lse; sattn_core<4, 0, 1>(qf, ks, ks, ks, kb_lo, kb_hi, i0, 0.f, scr, lane, nullptr, lse);
        if (hi == 0) lsec[((size_t)g * NTOK + qrow) * 2 + j] = lse;
    }
}

struct ListRows { const int* list; int seg0, cnt; __device__ __forceinline__ int src(int m) const { const int r = m - seg0; return (r < cnt) ? (list[r] >> 1) : 0; } };
__device__ __forceinline__ void moe_segments(Frame& F, int layer, LAS int* seg) {
    if (F.tid == 0) { int acc = 0; for (int e = 0; e < NEXP; ++e) { const int c = (int)__hip_atomic_load(F.ctl + CW_CNT + layer * 64 + e, RLX_AGENT); seg[e] = acc; seg[33 + e] = c; acc += (c + 255) & ~255; } seg[32] = acc; }
    __syncthreads();
}
__device__ __forceinline__ int seg_find(const LAS int* seg, int row) { int e = 0;
#pragma unroll
    for (int s = 16; s > 0; s >>= 1) if (seg[e + s] <= row) e += s;
    return e; }
__device__ __forceinline__ void moe_up_simple(Frame& F, int layer) {
    LAS int* seg = (LAS int*)(F.lds + RING_BYTES); moe_segments(F, layer, seg);
    const bf16_t* XB = (const bf16_t*)(F.ws + WS_XB); const bf16_t* W13 = (const bf16_t*)(F.ws + WS_W13); const int* list = (const int*)(F.ws + WS_LIST);
    const EpiHid E{(bf16_t*)(F.ws + WS_HID)};
    const int items = (seg[32] / 32) * 16;
    for (int it = F.gw; it < items; it += F.NGW) { const int mt = it >> 4, ct = it & 15, m0 = mt * 32, e = seg_find(seg, m0), c0 = ct * 32;
        const ListRows RM{list + (size_t)e * LIST_CAP, seg[e], seg[33 + e]};
        const bf16_t* Bg = W13 + (size_t)e * 1024 * 1024 + (size_t)((c0 >> 7) * 256 + (c0 & 127)) * 1024;
        sg_tile(XB, DM, Bg, Bg + (size_t)128 * 1024, 1024, 1024, m0, c0, E, RM, F.lane); }
    __syncthreads();
}
__device__ __forceinline__ void moe_down_simple(Frame& F, int layer) {
    LAS int* seg = (LAS int*)(F.lds + RING_BYTES); moe_segments(F, layer, seg);
    const bf16_t* HID = (const bf16_t*)(F.ws + WS_HID); const bf16_t* W2 = (const bf16_t*)(F.ws + WS_W2); const int* list = (const int*)(F.ws + WS_LIST);
    const int items = (seg[32] / 32) * 16;
    for (int it = F.gw; it < items; it += F.NGW) { const int mt = it >> 4, ct = it & 15, m0 = mt * 32, e = seg_find(seg, m0), c0 = ct * 64;
        const EpiY E{(bf16_t*)(F.ws + WS_YB), (const float*)(F.ws + WS_TW), list + (size_t)e * LIST_CAP, seg[e], seg[33 + e]};
        const bf16_t* B0 = W2 + (size_t)e * 1024 * 512 + (size_t)c0 * 512;
        sg_tile(HID, DEXP, B0, B0 + (size_t)32 * 512, 512, 512, m0, c0, E, IdRows(), F.lane); }
    __syncthreads();
}

constexpr int PH_PER_LAYER = 9, N_PHASES = 1 + DEPTH * PH_PER_LAYER;
__global__ void __launch_bounds__(NTHREADS, 2) fwd(Args args) {
    extern __shared__ __attribute__((aligned(16))) unsigned char lds[];
    Frame F;
    F.lds = (LAS unsigned char*)lds; F.ldsg = lds;
    F.tid = threadIdx.x; F.lane = F.tid & 63; F.wave = __builtin_amdgcn_readfirstlane(F.tid >> 6);
    F.G = gridDim.x; F.gw = blockIdx.x * NWAVES + F.wave; F.NGW = F.G * NWAVES;
    F.ws = args.ws; F.ctl = (gu32*)(args.ws + WS_CTL);
    volatile LAS unsigned* MISC = (volatile LAS unsigned*)(F.lds + MISC_OFF);
    for (int u = F.tid; u < (LDS_BYTES - RING_BYTES) / 4; u += NTHREADS) ((LAS unsigned*)(F.lds + RING_BYTES))[u] = 0u;
    __syncthreads();
    XcdBarrier bar; bar.bar = (unsigned*)(F.ctl + CW_BAR); bar.x = 0; bar.st = nullptr;
    if (args.use_bar) bar = xcd_barrier_post((unsigned*)(F.ctl + CW_BAR), MISC + 8);
    const int lo = args.ph_lo, hi = args.ph_hi;
#define IN(k) (lo <= (k) && (k) < hi && (launder(F), true))
#define SEAM(k) do { if (lo <= (k) && (k) + 1 < hi) xcd_barrier(bar); } while (0)
    if (IN(0)) { p0_prologue(F, args); }
    SEAM(0);
    for (int layer = 0; layer < DEPTH; ++layer) {
        const int pb = 1 + layer * PH_PER_LAYER;
        if (IN(pb + 0)) {   bf16_t* H = (bf16_t*)(F.ws + WS_H);
            const EpiH E{H, (const float2*)(F.ws + WS_ROPE32), (const float2*)(F.ws + WS_ROPE64)};
            sg_phase(F, (const bf16_t*)(F.ws + WS_XB), DM, (const bf16_t*)(F.ws + WS_WIN) + (size_t)layer * 2560 * 1024, 1024, NTOK, 2560, 1024, E);
        }
        SEAM(pb + 0);
        if (IN(pb + 1)) { rowstat_pass(F); cstat_phase(F); }
        SEAM(pb + 1);
        if (IN(pb + 2)) {
            bf16_t* H = (bf16_t*)(F.ws + WS_H);
            const EpiUQ Eq{(bf16_t*)(F.ws + WS_QB), (const float*)(F.ws + WS_RSTD), (const float2*)(F.ws + WS_ROPE32)};
            sg_phase(F, H + HC_CQ_LAT, HP, (const bf16_t*)(F.ws + WS_WUQ) + (size_t)layer * 768 * 256, 256, NTOK, 768, 256, Eq);
            const EpiUKV Ek{(bf16_t*)(F.ws + WS_KVB), (const float*)(F.ws + WS_RSTD)};
            sg_phase(F, H + HC_CKV, HP, (const bf16_t*)(F.ws + WS_WUKV) + (size_t)layer * 768 * 256, 256, NTOK, 768, 256, Ek);
        }
        SEAM(pb + 2);
        if (IN(pb + 3)) { sattn_phase(F, args, layer); }
        SEAM(pb + 3);
        if (IN(pb + 4)) {
            const EpiRes E{args.out};
            sg_phase(F, (const bf16_t*)(F.ws + WS_MIX), DM, (const bf16_t*)(F.ws + WS_WOUT) + (size_t)layer * 1024 * 1024, 1024, NTOK, 1024, 1024, E);
        }
        SEAM(pb + 4);
        if (IN(pb + 5)) { ln1_route_pass(F, args, layer); moe_convert(F, args, layer); }
        SEAM(pb + 5);
        if (IN(pb + 6)) { moe_up_simple(F, layer); }
        SEAM(pb + 6);
        if (IN(pb + 7)) { moe_down_simple(F, layer); }
        SEAM(pb + 7);
        if (IN(pb + 8)) { ln2_pass(F, args, layer); }
        SEAM(pb + 8);
    }
#undef IN
#undef SEAM
}

extern "C" void kernel_launch(void* const* d_in, const int* in_sizes, int n_in, void* d_out, int out_size, void* d_ws, size_t ws_size, hipStream_t stream) {
    static int grid = 0;
    if (grid == 0) {
        if (n_in != 19 || out_size != NTOK * DM || ws_size < WS_END) { fprintf(stderr, "kernel_launch: unexpected shapes (n_in %d out %d ws %zu)\n", n_in, out_size, ws_size); grid = -1; return; }
        int dev = 0, cus = 0, per_cu = 0;
        if (hipGetDevice(&dev) != hipSuccess || hipDeviceGetAttribute(&cus, hipDeviceAttributeMultiprocessorCount, dev) != hipSuccess) { grid = -1; return; }
        if (hipFuncSetAttribute((const void*)fwd, hipFuncAttributeMaxDynamicSharedMemorySize, LDS_BYTES) != hipSuccess) { grid = -1; return; }
        if (hipOccupancyMaxActiveBlocksPerMultiprocessor(&per_cu, (const void*)fwd, NTHREADS, LDS_BYTES) != hipSuccess || per_cu < 1) { fprintf(stderr, "kernel_launch: occupancy query says %d\n", per_cu); }
        (void)hipGetLastError();
        grid = cus;
    }
    if (grid < 0) return;
    if (hipMemsetAsync((char*)d_ws + WS_CTL, 0, CTL_ZERO_BYTES, stream) != hipSuccess) return;
    Args a{};
    a.x_prompt = (const float*)d_in[0]; a.x_sample = (const float*)d_in[1]; a.w_in = (const float*)d_in[2]; a.diff_lambda = (const float*)d_in[3]; a.diff_subln = (const float*)d_in[4];
    a.mla_q_norm = (const float*)d_in[5]; a.mla_w_uq = (const float*)d_in[6]; a.mla_kv_norm = (const float*)d_in[7]; a.mla_w_ukv = (const float*)d_in[8]; a.w_out = (const float*)d_in[9];
    a.ln1_g = (const float*)d_in[10]; a.ln1_b = (const float*)d_in[11]; a.moe_w_coarse = (const float*)d_in[12]; a.moe_w_fine = (const float*)d_in[13];
    a.moe_w1 = (const float*)d_in[14]; a.moe_w3 = (const float*)d_in[15]; a.moe_w2 = (const float*)d_in[16]; a.ln2_g = (const float*)d_in[17]; a.ln2_b = (const float*)d_in[18];
    a.out = (float*)d_out; a.ws = (unsigned char*)d_ws; a.pad = 0;
#if MK_ONE_LAUNCH
    a.ph_lo = 0; a.ph_hi = N_PHASES; a.use_bar = 1;
    hipLaunchKernelGGL(fwd, dim3(grid), dim3(NTHREADS), LDS_BYTES, stream, a);
#else
    for (int p = 0; p < N_PHASES; ++p) { a.ph_lo = p; a.ph_hi = p + 1; a.use_bar = 0; hipLaunchKernelGGL(fwd, dim3(grid), dim3(NTHREADS), LDS_BYTES, stream, a); }
#endif
}
```

```cpp
#include <hip/hip_runtime.h>
#include <cstdio>
#include <cstdint>

#ifndef OPT_GEMM
#define OPT_GEMM 1
#endif
#ifndef MK_ONE_LAUNCH
#define MK_ONE_LAUNCH 1
#endif

#define GAS __attribute__((address_space(1)))
#define LAS __attribute__((address_space(3)))
typedef unsigned short bf16_t;
typedef short bf16x8 __attribute__((ext_vector_type(8)));
typedef float f32x4 __attribute__((ext_vector_type(4)));
typedef float f32x2 __attribute__((ext_vector_type(2)));
typedef float f32x16 __attribute__((ext_vector_type(16)));
typedef unsigned u32x4 __attribute__((ext_vector_type(4)));
typedef unsigned u32x2 __attribute__((ext_vector_type(2)));
typedef GAS unsigned gu32;
#define RLX_AGENT __ATOMIC_RELAXED, __HIP_MEMORY_SCOPE_AGENT
#define LDS_WAIT() asm volatile("s_waitcnt lgkmcnt(0)" ::: "memory")
#define VM_WAIT() asm volatile("s_waitcnt vmcnt(0)" ::: "memory")
#define MFMA32(a, b, c) __builtin_amdgcn_mfma_f32_32x32x16_bf16(a, b, c, 0, 0, 0)

__device__ __forceinline__ unsigned f2bf(float f) { unsigned u = __builtin_bit_cast(unsigned, f); return (u + 0x7fffu + ((u >> 16) & 1u)) >> 16; }
__device__ __forceinline__ unsigned pk2(float lo, float hi) { return f2bf(lo) | (f2bf(hi) << 16); }
__device__ __forceinline__ float bf2f(unsigned short b) { return __builtin_bit_cast(float, (unsigned)b << 16); }
__device__ __forceinline__ int crow(int r, int hi) { return (r & 3) + 8 * (r >> 2) + 4 * hi; }
__device__ __forceinline__ float wave_sum(float v) {
#pragma unroll
    for (int o = 1; o < 64; o <<= 1) v += __shfl_xor(v, o);
    return v;
}
__device__ __forceinline__ float fast_exp2(float x) { return __builtin_amdgcn_exp2f(x); }

constexpr int NTOK = 65536, DM = 1024, DEPTH = 4;
constexpr int NTOK_P = 32768;
constexpr int HP = 2560;
constexpr int HC_AQ = 0, HC_AK = 256, HC_AV = 512, HC_CQ_LAT = 768, HC_CKV = 1024, HC_KROPE = 1152, HC_CQ = 1280, HC_CK = 1664, HC_CV = 2048;
constexpr int QBP = 768, KVP = 768;
constexpr int MIX_A = 0, MIX_B = 256, MIX_C = 640;
constexpr int NEXP = 32, DEXP = 512;
constexpr float LOG2E = 1.4426950408889634f;
constexpr float SC_A = 0.17677669529663687f * LOG2E;
constexpr float SC_B = 0.10206207261596575f * LOG2E;
constexpr float SC_C = 0.125f * LOG2E;
constexpr float DN_ALPHA = 1.681792830507429f;
constexpr float LN_EPS = 1e-5f, RMS_EPS = 1e-6f;

constexpr size_t MiB = 1u << 20;
constexpr size_t WS_CTL = 0, CTL_ZERO_BYTES = 1 * MiB;
constexpr size_t WS_ROPE32 = 4 * MiB;
constexpr size_t WS_ROPE64 = 5 * MiB;
constexpr size_t WS_WIN = 8 * MiB;
constexpr size_t WS_WOUT = 28 * MiB;
constexpr size_t WS_WUQ = 36 * MiB;
constexpr size_t WS_WUKV = 38 * MiB;
constexpr size_t WS_W13 = 40 * MiB;
constexpr size_t WS_W2 = 104 * MiB;
constexpr size_t WS_XB = 136 * MiB;
constexpr size_t WS_H = 264 * MiB;
constexpr size_t WS_QB = 584 * MiB;
constexpr size_t WS_KVB = 680 * MiB;
constexpr size_t WS_MIX = 776 * MiB;
constexpr size_t WS_RSTD = 904 * MiB;
constexpr size_t WS_LSEC = 905 * MiB;
constexpr size_t WS_TW = 907 * MiB;
constexpr size_t WS_LIST = 908 * MiB;
constexpr size_t WS_END = 924 * MiB;
constexpr size_t WS_HID = WS_H;
constexpr size_t WS_YB = WS_H + 136 * MiB;
static_assert(WS_YB + 256 * MiB <= WS_KVB + 96 * MiB, "YB overlay");
constexpr int LIST_CAP = 131072;
constexpr int CW_TMO = 0;
constexpr int CW_CNT = 64;
constexpr int CW_BAR = 4096;

constexpr int RING_BYTES = 131072;
constexpr int MISC_OFF = RING_BYTES + 320;
constexpr int LDS_BYTES = 147456;
constexpr int NWAVES = 8, NTHREADS = 512;

#define XB_TMO      128
#define XB_XCNT(j)  (256  + 64 * (j))
#define XB_XSUB(j)  (1280 + 64 * (j))
#define XB_XGEN(j)  (2304 + 64 * (j))
#define XB_TOP      3328
#define XB_TOPGEN   3392
#define XCD_BAR_WORDS 3456
#define XB_SPIN_CAP (1u << 22)
__device__ __forceinline__ unsigned xb_ld(unsigned* p)              { return __hip_atomic_load(p, __ATOMIC_RELAXED, __HIP_MEMORY_SCOPE_AGENT); }
__device__ __forceinline__ unsigned xb_add(unsigned* p, unsigned v) { return __hip_atomic_fetch_add(p, v, __ATOMIC_RELAXED, __HIP_MEMORY_SCOPE_AGENT); }
__device__ __forceinline__ unsigned xb_xcc_id() { return (unsigned)__builtin_amdgcn_s_getreg((3 << 11) | 20) & 0xFu; }
#define XB_SPIN(cond, bar) do { unsigned _sp = 0; while (cond) { __builtin_amdgcn_s_sleep(1); \
    if ((++_sp & 255u) == 0u) { if (xb_ld(&(bar)[XB_TMO])) break; if (_sp > XB_SPIN_CAP) { atomicAdd(&(bar)[XB_TMO], 1u); break; } } } } while (0)
struct XcdBarrier { unsigned* bar; unsigned x; volatile LAS unsigned* st; };
__device__ __forceinline__ XcdBarrier xcd_barrier_post(unsigned* bar, volatile LAS unsigned* st) {
    XcdBarrier b; b.bar = bar; b.x = xb_xcc_id(); b.st = st;
    if (threadIdx.x == 0) (void)xb_add(&bar[XB_XCNT(b.x)], 1u);
    return b;
}
__device__ __forceinline__ void xcd_barrier_complete(unsigned* bar, unsigned x, unsigned& nloc, unsigned& nx) {
    const unsigned G = gridDim.x * gridDim.y * gridDim.z;
    unsigned sum, cnt, mine, sp = 0u;
    for (;;) {
        sum = 0u; cnt = 0u; mine = 0u;
#pragma unroll
        for (unsigned j = 0; j < 16; ++j) { const unsigned c = xb_ld(&bar[XB_XCNT(j)]); sum += c; cnt += (c > 0u) ? 1u : 0u; mine = (j == x) ? c : mine; }
        if (sum == G) break;
        __builtin_amdgcn_s_sleep(1);
        if ((++sp & 255u) == 0u) { if (xb_ld(&bar[XB_TMO])) break; if (sp > XB_SPIN_CAP) { atomicAdd(&bar[XB_TMO], 1u); break; } }
    }
    nloc = mine > 0u ? mine : 1u; nx = cnt > 0u ? cnt : 1u;
}
__device__ __forceinline__ void xcd_barrier(const XcdBarrier& b) {
    asm volatile("s_waitcnt vmcnt(0)" ::: "memory");
    __syncthreads();
    if (threadIdx.x == 0) {
        unsigned* bar = b.bar;
        __builtin_amdgcn_s_waitcnt(0);
        unsigned nloc = b.st[0], nx = b.st[1];
        if (nloc == 0u) { xcd_barrier_complete(bar, b.x, nloc, nx); b.st[0] = nloc; b.st[1] = nx; }
        const unsigned old = xb_add(&bar[XB_XSUB(b.x)], 1u);
        const unsigned gen = old / nloc;
        if (old + 1u == (gen + 1u) * nloc) {
            __builtin_amdgcn_fence(__ATOMIC_RELEASE, "agent");
            asm volatile("s_waitcnt vmcnt(0)" ::: "memory");
            const unsigned og = xb_add(&bar[XB_TOP], 1u);
            const unsigned tg = og / nx;
            if (og + 1u == (tg + 1u) * nx) xb_add(&bar[XB_TOPGEN], 1u);
            else XB_SPIN(xb_ld(&bar[XB_TOPGEN]) == tg, bar);
            __builtin_amdgcn_fence(__ATOMIC_ACQUIRE, "agent");
            xb_add(&bar[XB_XGEN(b.x)], 1u);
            asm volatile("s_waitcnt vmcnt(0)" ::: "memory");
        } else {
            XB_SPIN(xb_ld(&bar[XB_XGEN(b.x)]) == gen, bar);
            __builtin_amdgcn_fence(__ATOMIC_ACQUIRE, "agent");
            asm volatile("s_waitcnt vmcnt(0)" ::: "memory");
        }
    }
    __syncthreads();
}

struct Args {
    const float* x_prompt; const float* x_sample; const float* w_in; const float* diff_lambda; const float* diff_subln; const float* mla_q_norm; const float* mla_w_uq;
    const float* mla_kv_norm; const float* mla_w_ukv; const float* w_out; const float* ln1_g; const float* ln1_b; const float* moe_w_coarse; const float* moe_w_fine;
    const float* moe_w1; const float* moe_w3; const float* moe_w2; const float* ln2_g; const float* ln2_b;
    float* out; unsigned char* ws; int ph_lo, ph_hi, use_bar, pad;
};
struct Frame {
    LAS unsigned char* lds; unsigned char* ldsg;
    int tid, lane, wave, G, gw, NGW, bid;
    gu32* ctl; unsigned char* ws;
};
__device__ __forceinline__ void launder(Frame& F) {
    int t = F.tid; asm volatile("" : "+v"(t)); F.tid = t; F.lane = t & 63; F.wave = __builtin_amdgcn_readfirstlane(t >> 6);
    int b = (int)blockIdx.x; asm volatile("" : "+s"(b)); F.bid = b; F.gw = b * NWAVES + F.wave;
    unsigned char* w = F.ws; asm volatile("" : "+s"(w)); F.ws = w; F.ctl = (gu32*)(w + WS_CTL);
}
struct SeqInfo { int base, len, pos; };
__device__ __forceinline__ SeqInfo seqinfo(int m) { SeqInfo s; if (m < NTOK_P) { s.base = m & ~2047; s.len = 2048; } else { s.base = m & ~4095; s.len = 4096; } s.pos = m - s.base; return s; }

template <class ColMap>
__device__ __forceinline__ void transpose_item(const float* W, int N, bf16_t* WT, int ldd, LAS float* scr, int k0, int n0, const ColMap& cm, const float* kscale, int lane) {
    const int sc = cm(n0 + (lane & 31));
#pragma unroll 8
    for (int i = 0; i < 32; ++i) { const int kk = 2 * i + (lane >> 5); float v = 0.f; if (sc >= 0) { v = W[(size_t)(k0 + kk) * N + sc]; if (kscale) v *= kscale[k0 + kk]; } scr[kk * 33 + (lane & 31)] = v; }
    LDS_WAIT(); asm volatile("" ::: "memory");
    const int c = lane & 7;
#pragma unroll
    for (int j = 0; j < 4; ++j) { const int n = (lane >> 3) + 8 * j; const LAS float* s = scr + (8 * c) * 33 + n;
        u32x4 o; o.x = pk2(s[0 * 33], s[1 * 33]); o.y = pk2(s[2 * 33], s[3 * 33]); o.z = pk2(s[4 * 33], s[5 * 33]); o.w = pk2(s[6 * 33], s[7 * 33]);
        *(u32x4*)(WT + (size_t)(n0 + n) * ldd + k0 + 8 * c) = o; }
    LDS_WAIT(); asm volatile("" ::: "memory");
}
struct WinMap {
    __device__ __forceinline__ int operator()(int n) const {
        if (n < 512) { const int t = n & 31; return (n & ~31) + (t >> 1) + 16 * (t & 1); }
        if (n < 1152) return n;
        if (n < 1184) { const int t = n - 1152; return 1152 + (t >> 1) + 16 * (t & 1); }
        if (n < 1280) return -1;
        if (n < 2048) { const int u = n - 1280, t = u & 63; return 1184 + (u & ~63) + (t >> 1) + 32 * (t & 1); }
        if (n < 2432) return 1952 + (n - 2048);
        return -1;
    }
};
struct UqMap { __device__ __forceinline__ int operator()(int n) const { if (n >= 576) return -1; const int h = n / 96, t = n - 96 * h; if (t < 64) return n; const int u = t - 64; return 96 * h + 64 + (u >> 1) + 16 * (u & 1); } };
struct IdMap { __device__ __forceinline__ int operator()(int n) const { return n; } };
struct W13Map { __device__ __forceinline__ int operator()(int n) const { return (n >> 8) * 128 + (n & 127); } };

__device__ __forceinline__ void p0_prologue(Frame& F, const Args& a) {
    LAS float* scr = (LAS float*)(F.lds + F.wave * 16384);
    { float2* r32 = (float2*)(F.ws + WS_ROPE32); float2* r64 = (float2*)(F.ws + WS_ROPE64);
      for (int i = F.gw * 64 + F.lane; i < 4096 * 16; i += F.NGW * 64) { const int pos = i >> 4, j = i & 15; const float inv = 1.0f / powf(10000.0f, (float)(2 * j) / 32.0f); const float ang = (float)pos * inv; r32[i] = make_float2(cosf(ang), sinf(ang)); }
      for (int i = F.gw * 64 + F.lane; i < 4096 * 32; i += F.NGW * 64) { const int pos = i >> 5, j = i & 31; const float inv = 1.0f / powf(10000.0f, (float)(2 * j) / 64.0f); const float ang = (float)pos * inv; r64[i] = make_float2(cosf(ang), sinf(ang)); } }
    constexpr int I_WIN = (1024 / 64) * (2560 / 32), I_WOUT = (1024 / 64) * (1024 / 32), I_UQ = (256 / 64) * (768 / 32), I_UKV = (256 / 64) * (768 / 32);
    constexpr int PER_L = I_WIN + I_WOUT + I_UQ + I_UKV;
    for (int it = F.gw; it < DEPTH * PER_L; it += F.NGW) {
        const int l = it / PER_L; int r = it - l * PER_L;
        if (r < I_WIN) { const int kb = r / 80, nb = r % 80; transpose_item(a.w_in + (size_t)l * 1024 * 2336, 2336, (bf16_t*)(F.ws + WS_WIN) + (size_t)l * 2560 * 1024, 1024, scr, kb * 64, nb * 32, WinMap(), nullptr, F.lane); continue; } r -= I_WIN;
        if (r < I_WOUT) { const int kb = r / 32, nb = r % 32; transpose_item(a.w_out + (size_t)l * 1024 * 1024, 1024, (bf16_t*)(F.ws + WS_WOUT) + (size_t)l * 1024 * 1024, 1024, scr, kb * 64, nb * 32, IdMap(), nullptr, F.lane); continue; } r -= I_WOUT;
        if (r < I_UQ) { const int kb = r / 24, nb = r % 24; transpose_item(a.mla_w_uq + (size_t)l * 256 * 576, 576, (bf16_t*)(F.ws + WS_WUQ) + (size_t)l * 768 * 256, 256, scr, kb * 64, nb * 32, UqMap(), a.mla_q_norm + l * 256, F.lane); continue; } r -= I_UQ;
        { const int kb = r / 24, nb = r % 24; bf16_t* dst = (bf16_t*)(F.ws + WS_WUKV) + (size_t)l * 768 * 256;
          if (kb < 2) transpose_item(a.mla_w_ukv + (size_t)l * 128 * 768, 768, dst, 256, scr, kb * 64, nb * 32, IdMap(), a.mla_kv_norm + l * 128, F.lane);
          else { const int c = F.lane & 7;
#pragma unroll
              for (int j = 0; j < 4; ++j) { const int n = (F.lane >> 3) + 8 * j; *(u32x4*)(dst + (size_t)(nb * 32 + n) * 256 + kb * 64 + 8 * c) = (u32x4){0u, 0u, 0u, 0u}; } } }
    }
    bf16_t* XB = (bf16_t*)(F.ws + WS_XB);
    for (int m = F.gw; m < NTOK; m += F.NGW) {
        const float* src = (m < NTOK_P) ? a.x_prompt + (size_t)m * DM : a.x_sample + (size_t)(m - NTOK_P) * DM;
#pragma unroll
        for (int j = 0; j < 4; ++j) { const f32x4 v = *((const f32x4*)src + F.lane + 64 * j); *((f32x4*)(a.out + (size_t)m * DM) + F.lane + 64 * j) = v;
            u32x2 w; w.x = pk2(v.x, v.y); w.y = pk2(v.z, v.w); *((u32x2*)(XB + (size_t)m * DM) + F.lane + 64 * j) = w; }
    }
}

template <class Epi, class RowMap>
__device__ __forceinline__ void sg_tile(const bf16_t* A, int lda, const bf16_t* B0, const bf16_t* B1, int ldb, int K, int m0, int c0, const Epi& E, const RowMap& RM, int lane) {
    const int r32 = lane & 31, hi = lane >> 5;
    const bf16_t* ap = A + (size_t)RM.src(m0 + r32) * lda + 8 * hi;
    const bf16_t* b0p = B0 + (size_t)r32 * ldb + 8 * hi;
    const bf16_t* b1p = B1 + (size_t)r32 * ldb + 8 * hi;
    f32x16 acc0 = {}, acc1 = {};
#pragma unroll 4
    for (int k = 0; k < K; k += 16) {
        const bf16x8 af = *(const bf16x8*)(ap + k), bf0 = *(const bf16x8*)(b0p + k), bf1 = *(const bf16x8*)(b1p + k);
        acc0 = MFMA32(bf0, af, acc0); acc1 = MFMA32(bf1, af, acc1);
    }
#pragma unroll
    for (int g = 0; g < 4; ++g) { const f32x4 v0 = {acc0[4 * g], acc0[4 * g + 1], acc0[4 * g + 2], acc0[4 * g + 3]}, v1 = {acc1[4 * g], acc1[4 * g + 1], acc1[4 * g + 2], acc1[4 * g + 3]};
        E.put(m0 + r32, c0, 8 * g + 4 * hi, v0, v1); }
}
struct IdRows { __device__ __forceinline__ int src(int m) const { return m; } };

__device__ __forceinline__ void store_bf8(bf16_t* p, f32x4 a, f32x4 b) { u32x4 w; w.x = pk2(a.x, a.y); w.y = pk2(a.z, a.w); w.z = pk2(b.x, b.y); w.w = pk2(b.z, b.w); *(u32x4*)p = w; }
__device__ __forceinline__ void store_bf4(bf16_t* p, f32x4 v) { u32x2 w; w.x = pk2(v.x, v.y); w.y = pk2(v.z, v.w); *(u32x2*)p = w; }
struct EpiH {
    static constexpr bool PERM = true;
    bf16_t* H; const float2* rope32; const float2* rope64;
    __device__ __forceinline__ f32x4 xf(int pos, int col, f32x4 v) const {
        if (col < 512 || (col >= HC_KROPE && col < HC_KROPE + 32)) {
            const int j0 = (col & 31) >> 1; const f32x4 cs = *(const f32x4*)(rope32 + pos * 16 + j0);
            f32x4 o; o.x = v.x * cs.x - v.y * cs.y; o.y = v.x * cs.y + v.y * cs.x; o.z = v.z * cs.z - v.w * cs.w; o.w = v.z * cs.w + v.w * cs.z;
            if (col < 256) o = o * SC_A; v = o;
        } else if (col >= HC_CQ && col < HC_CV) {
            const int j0 = ((col - HC_CQ) & 63) >> 1; const f32x4 cs = *(const f32x4*)(rope64 + pos * 32 + j0);
            f32x4 o; o.x = v.x * cs.x - v.y * cs.y; o.y = v.x * cs.y + v.y * cs.x; o.z = v.z * cs.z - v.w * cs.w; o.w = v.z * cs.w + v.w * cs.z;
            if (col < HC_CK) o = o * SC_C; v = o;
        }
        return v;
    }
    __device__ __forceinline__ void put4(int row, int col, f32x4 v) const { store_bf4(H + (size_t)row * HP + col, xf(seqinfo(row).pos, col, v)); }
    __device__ __forceinline__ void put(int row, int c0, int cc, f32x4 v0, f32x4 v1) const { put4(row, c0 + cc, v0); put4(row, c0 + 32 + cc, v1); }
    template <class U> __device__ __forceinline__ void put8(const U&, int row, int col, f32x4 v0, f32x4 v1) const { const int pos = seqinfo(row).pos; store_bf8(H + (size_t)row * HP + col, xf(pos, col, v0), xf(pos, col + 4, v1)); }
};
struct EpiUQ {
    static constexpr bool PERM = true;
    bf16_t* Q; const float* rstd; const float2* rope32;
    __device__ __forceinline__ f32x4 xf(int row, int col, f32x4 v, float rs) const {
        v = v * rs;
        const int t = col % 96;
        if (t >= 64) { const int pos = seqinfo(row).pos; const int j0 = (t - 64) >> 1; const f32x4 cs = *(const f32x4*)(rope32 + pos * 16 + j0);
            f32x4 o; o.x = v.x * cs.x - v.y * cs.y; o.y = v.x * cs.y + v.y * cs.x; o.z = v.z * cs.z - v.w * cs.w; o.w = v.z * cs.w + v.w * cs.z; v = o; }
        return v * SC_B;
    }
    __device__ __forceinline__ void put4(int row, int col, f32x4 v) const { if (col >= 576) return; store_bf4(Q + (size_t)row * QBP + col, xf(row, col, v, rstd[2 * row])); }
    template <class U> __device__ __forceinline__ void put8(const U&, int row, int col, f32x4 v0, f32x4 v1) const { if (col >= 576) return; const float rs = rstd[2 * row]; store_bf8(Q + (size_t)row * QBP + col, xf(row, col, v0, rs), xf(row, col + 4, v1, rs)); }
    __device__ __forceinline__ void put(int row, int c0, int cc, f32x4 v0, f32x4 v1) const { put4(row, c0 + cc, v0); put4(row, c0 + 32 + cc, v1); }
};
struct EpiUKV {
    static constexpr bool PERM = true;
    bf16_t* KV; const float* rstd;
    template <class U> __device__ __forceinline__ void put8(const U&, int row, int col, f32x4 v0, f32x4 v1) const { const float rs = rstd[2 * row + 1]; store_bf8(KV + (size_t)row * KVP + col, v0 * rs, v1 * rs); }
    __device__ __forceinline__ void put4(int row, int col, f32x4 v) const { store_bf4(KV + (size_t)row * KVP + col, v * rstd[2 * row + 1]); }
    __device__ __forceinline__ void put(int row, int c0, int cc, f32x4 v0, f32x4 v1) const { put4(row, c0 + cc, v0); put4(row, c0 + 32 + cc, v1); }
};
struct EpiRes {
    static constexpr bool PERM = false;
    float* X;
    template <class U> __device__ __forceinline__ void put4(const U&, int row, int col, f32x4 v) const { put4(row, col, v); }
    __device__ __forceinline__ void put4(int row, int col, f32x4 v) const { f32x4* p = (f32x4*)(X + (size_t)row * DM + col); *p = *p * DN_ALPHA + v; }
    __device__ __forceinline__ void put(int row, int c0, int cc, f32x4 v0, f32x4 v1) const { put4(row, c0 + cc, v0); put4(row, c0 + 32 + cc, v1); }
};
__device__ __forceinline__ float silu_f(float x) { return x / (1.0f + __expf(-x)); }
struct EpiHid {
    static constexpr bool PERM = true;
    bf16_t* HID;
    __device__ __forceinline__ f32x4 act(f32x4 g, f32x4 u) const { f32x4 o; o.x = silu_f(g.x) * u.x; o.y = silu_f(g.y) * u.y; o.z = silu_f(g.z) * u.z; o.w = silu_f(g.w) * u.w; return o; }
    template <class U> __device__ __forceinline__ void putp8(const U&, int row, int col, f32x4 g0, f32x4 g1, f32x4 u0, f32x4 u1) const { store_bf8(HID + (size_t)row * DEXP + col, act(g0, u0), act(g1, u1)); }
    __device__ __forceinline__ void putp(int row, int col, f32x4 g, f32x4 u) const { f32x4 o; o.x = silu_f(g.x) * u.x; o.y = silu_f(g.y) * u.y; o.z = silu_f(g.z) * u.z; o.w = silu_f(g.w) * u.w; store_bf4(HID + (size_t)row * DEXP + col, o); }
    __device__ __forceinline__ void put(int row, int c0, int cc, f32x4 v0, f32x4 v1) const { putp(row, c0 + cc, v0, v1); }
};
struct EpiY {
    bf16_t* YB; const float* tw; const int* list; int seg0, cnt;
    __device__ __forceinline__ void put4(int row, int col, f32x4 v) const { const int r = row - seg0; if (r >= cnt) return; const int a = list[r]; store_bf4(YB + (size_t)a * DM + col, v * tw[a]); }
    __device__ __forceinline__ void put(int row, int c0, int cc, f32x4 v0, f32x4 v1) const { put4(row, c0 + cc, v0); put4(row, c0 + 32 + cc, v1); }
};

struct EpiYO {
    static constexpr bool PERM = true;
    bf16_t* YB; const float* tw; const int* list; const LAS int* seg;
    template <class U> __device__ __forceinline__ void put8(const U& u, int row, int col, f32x4 v0, f32x4 v1) const {
        const int r = row - __builtin_amdgcn_readfirstlane(seg[u.e]); if (r >= __builtin_amdgcn_readfirstlane(seg[33 + u.e])) return; const int a = list[(size_t)u.e * LIST_CAP + r]; const float w = tw[a]; store_bf8(YB + (size_t)a * DM + col, v0 * w, v1 * w); }
};
template <class Epi>
__device__ __forceinline__ void sg_phase(Frame& F, const bf16_t* A, int lda, const bf16_t* Bt, int ldb, int M, int N, int K, const Epi& E) {
    const int nN = N / 64, items = (M / 32) * nN;
    for (int it = F.gw; it < items; it += F.NGW) { const int mt = it / nN, nt = it - mt * nN;
        sg_tile(A, lda, Bt + (size_t)(nt * 64) * ldb, Bt + (size_t)(nt * 64 + 32) * ldb, ldb, K, mt * 32, nt * 64, E, IdRows(), F.lane); }
}


namespace pg8 {
constexpr int BM = 256, BK = 64, HALF = 128, HTB = HALF * BK * 2, NXCD = 8, WGM = 8;
__host__ __device__ __forceinline__ int lds_byte(int r, int c) { const int st = (r >> 4) * 2 + (c >> 5), rr = r & 15, cc = c & 31, ob = rr * 64 + cc * 2; return st * 1024 + (ob ^ (((ob >> 9) & 1) << 5)); }
__host__ __device__ __forceinline__ void stage_rc(int b, int& R, int& C) { const int st = b / 1024, sb = b % 1024, swz = sb ^ (((sb >> 9) & 1) << 5); R = (st >> 1) * 16 + swz / 64; C = (st & 1) * 32 + (swz % 64) / 2; }
__host__ __device__ __forceinline__ int perm32(int rho) { const int n = rho >> 4, i = rho & 15; return 8 * (i >> 2) + 4 * n + (i & 3); }
struct Unit { int pm, pn, e; const char* a; const char* b; };
__device__ __forceinline__ bool order_next(int i, int G, int c, int nM, int nN, int& pm, int& pn) {
    const int nwg = nM * nN; const long L = (long)i * G + c; if (L >= nwg) return false;
    int wgid = (int)L; { const int q = nwg / NXCD, r = nwg % NXCD, xcd = wgid % NXCD, off = wgid / NXCD; wgid = (xcd < r ? xcd * (q + 1) : r * (q + 1) + (xcd - r) * q) + off; }
    const int nig = WGM * nN, gid = wgid / nig, fm = gid * WGM, gsz = (nM - fm) < WGM ? (nM - fm) : WGM;
    pm = fm + ((wgid % nig) % gsz); pn = (wgid % nig) / gsz; return true;
}
struct DenseSched {
    const char* A; const char* Bt; int nM, nN, G, c; size_t tstepA, tstepB;
    __device__ __forceinline__ void init(const bf16_t* A_, int lda, const bf16_t* Bt_, int M, int N, int K, int G_, int c_) { A = (const char*)A_; Bt = (const char*)Bt_; nM = M / BM; nN = N / BM; G = G_; c = c_; tstepA = (size_t)BM * lda * 2; tstepB = (size_t)BM * K * 2; }
    __device__ __forceinline__ bool next(int i, Unit& u) const { if (!order_next(i, G, c, nM, nN, u.pm, u.pn)) return false; u.e = 0; u.a = A + (size_t)u.pm * tstepA; u.b = Bt + (size_t)u.pn * tstepB; return true; }
    __device__ __forceinline__ unsigned arow(const Unit&, int) const { return 0u; }
};
template <class Epi, bool PAIR> struct EpiApply;
template <class Epi, class Sched, bool GATHER, bool PAIR>
__device__ __forceinline__ void gemm_phase(LAS unsigned char* lds, int tid, int K, int lda, const Sched& S, const Epi& E) {
    const int wid = __builtin_amdgcn_readfirstlane(tid >> 6), lane = tid & 63, wr = wid >> 2, wc = wid & 3, fr = lane & 15, fq = lane >> 4;
    const int nt = K / BK;
    unsigned voffA[2], voffB[2]; int RA[2], CA[2];
#pragma unroll
    for (int i = 0; i < 2; ++i) { int R, C; stage_rc(tid * 16 + i * 8192, R, C); const int Rb = Epi::PERM ? ((R & ~31) + perm32(R & 31)) : R; RA[i] = R; CA[i] = C;
        voffA[i] = (unsigned)(R * lda + C) * 2u; voffB[i] = (unsigned)(Rb * K + C) * 2u; }
    const size_t kstep = (size_t)(BK * 2);
    const size_t hstepA = (size_t)HALF * lda * 2, hstepB = (size_t)HALF * K * 2;
    const unsigned ldsw = (unsigned)wid * 1024u;
    const int aoff = lds_byte(wr * 64 + fr, fq * 8), boff = lds_byte(wc * 32 + fr, fq * 8);
#define PG8_SA(b, h) (((b) * 2 + (h)) * HTB)
#define PG8_SB(b, h) ((4 + (b) * 2 + (h)) * HTB)
#define PG8_STAGE(bufoff, gbase, voff) do { _Pragma("unroll") for (int _i = 0; _i < 2; ++_i) \
        __builtin_amdgcn_global_load_lds((const unsigned*)((const char*)(gbase) + (voff)[_i]), (LAS unsigned*)(lds + (bufoff) + ldsw + _i * 8192), 16, 0, 0); } while (0)
#define PG8_STAGE_A(bufoff, ab, vg, h, koff) do { if (GATHER) { PG8_STAGE(bufoff, (ab) + (koff), (vg)[h]); } else { PG8_STAGE(bufoff, (ab) + (h) * hstepA + (koff), voffA); } } while (0)
#define PG8_LDA(dst, b, h) do { _Pragma("unroll") for (int m = 0; m < 4; ++m) _Pragma("unroll") for (int k = 0; k < 2; ++k) dst[m][k] = *(const LAS bf16x8*)(lds + PG8_SA(b, h) + aoff + m * 2048 + k * 1024); } while (0)
#define PG8_LDB(dst, b, h) do { _Pragma("unroll") for (int n = 0; n < 2; ++n) _Pragma("unroll") for (int k = 0; k < 2; ++k) dst[n][k] = *(const LAS bf16x8*)(lds + PG8_SB(b, h) + boff + n * 2048 + k * 1024); } while (0)
#define PG8_MMA(ai, bj, At, Bt) do { __builtin_amdgcn_s_setprio(1); _Pragma("unroll") for (int m = 0; m < 4; ++m) _Pragma("unroll") for (int n = 0; n < 2; ++n) _Pragma("unroll") for (int k = 0; k < 2; ++k) \
        acc[ai][bj][m][n] = __builtin_amdgcn_mfma_f32_16x16x32_bf16(Bt[n][k], At[m][k], acc[ai][bj][m][n], 0, 0, 0); __builtin_amdgcn_s_setprio(0); } while (0)
#define PG8_WAIT_V(n) asm volatile("s_waitcnt vmcnt(" #n ")" ::: "memory")
#define PG8_WAIT_L(n) asm volatile("s_waitcnt lgkmcnt(" #n ")" ::: "memory")
#define PG8_BAR __builtin_amdgcn_s_barrier()
#define PG8_SCHED __builtin_amdgcn_sched_barrier(0)
    Unit cur, nxt; int ui = 0;
    if (!S.next(0, cur)) return;
    f32x4 acc[2][2][4][2];
#pragma unroll
    for (int a = 0; a < 2; ++a)
#pragma unroll
        for (int b = 0; b < 2; ++b)
#pragma unroll
            for (int m = 0; m < 4; ++m)
#pragma unroll
                for (int n = 0; n < 2; ++n) acc[a][b][m][n] = (f32x4){0.f, 0.f, 0.f, 0.f};
    bf16x8 At[4][2], B0[2][2], B1[2][2];
    unsigned vgc[2][2] = {{0u, 0u}, {0u, 0u}}, vgn[2][2] = {{0u, 0u}, {0u, 0u}};
    if (GATHER) {
#pragma unroll
        for (int h = 0; h < 2; ++h)
#pragma unroll
            for (int i = 0; i < 2; ++i) vgc[h][i] = S.arow(cur, h * HALF + RA[i]) * (unsigned)(lda * 2) + (unsigned)CA[i] * 2u;
    }
    const char* cA = cur.a; const char* cB = cur.b;
    PG8_STAGE(PG8_SB(0, 0), cB, voffB); PG8_STAGE(PG8_SB(0, 1), cB + hstepB, voffB); PG8_STAGE_A(PG8_SA(0, 0), cA, vgc, 0, 0); PG8_STAGE_A(PG8_SA(0, 1), cA, vgc, 1, 0);
    if (wr == 1) PG8_BAR;
    PG8_WAIT_V(2); PG8_BAR;
    PG8_STAGE(PG8_SB(1, 0), cB + kstep, voffB); PG8_STAGE_A(PG8_SA(1, 0), cA, vgc, 0, kstep); PG8_STAGE(PG8_SB(1, 1), cB + hstepB + kstep, voffB);
    PG8_WAIT_V(6); PG8_BAR;
    for (;;) {
        const bool has_next = S.next(ui + 1, nxt);
        const char* nA = has_next ? nxt.a : cA; const char* nB = has_next ? nxt.b : cB;
        if (GATHER) {
#pragma unroll
            for (int h = 0; h < 2; ++h)
#pragma unroll
                for (int i = 0; i < 2; ++i) vgn[h][i] = has_next ? (S.arow(nxt, h * HALF + RA[i]) * (unsigned)(lda * 2) + (unsigned)CA[i] * 2u) : vgc[h][i];
        }
#pragma clang loop unroll(disable)
        for (int t = 0; t < nt; t += 2) {
            const bool last = (t == nt - 2);
            const size_t k1 = (size_t)(t + 1) * kstep;
            const char* a2 = last ? nA : cA; const char* b2 = last ? nB : cB + (size_t)(t + 2) * kstep; const size_t ka2 = last ? 0 : (size_t)(t + 2) * kstep;
            const char* b3 = b2 + kstep; const size_t ka3 = ka2 + kstep;
            unsigned v2[2][2];
#pragma unroll
            for (int h = 0; h < 2; ++h)
#pragma unroll
                for (int i = 0; i < 2; ++i) v2[h][i] = last ? vgn[h][i] : vgc[h][i];
            PG8_LDB(B0, 0, 0); PG8_LDB(B1, 0, 1); PG8_SCHED; PG8_LDA(At, 0, 0); PG8_STAGE_A(PG8_SA(1, 1), cA, vgc, 1, k1);
            PG8_WAIT_V(8); PG8_WAIT_L(0); PG8_BAR; PG8_MMA(0, 0, At, B0); PG8_MMA(0, 1, At, B1); PG8_BAR; PG8_SCHED;
            PG8_LDA(At, 0, 1); PG8_STAGE(PG8_SB(0, 0), b2, voffB); PG8_STAGE(PG8_SB(0, 1), b2 + hstepB, voffB); PG8_STAGE_A(PG8_SA(0, 0), a2, v2, 0, ka2);
            PG8_WAIT_V(8); PG8_WAIT_L(0); PG8_BAR; PG8_MMA(1, 0, At, B0); PG8_MMA(1, 1, At, B1); PG8_BAR; PG8_SCHED;
            PG8_LDB(B0, 1, 0); PG8_LDB(B1, 1, 1); PG8_SCHED; PG8_LDA(At, 1, 0); PG8_STAGE_A(PG8_SA(0, 1), a2, v2, 1, ka2);
            PG8_WAIT_V(8); PG8_WAIT_L(0); PG8_BAR; PG8_MMA(0, 0, At, B0); PG8_MMA(0, 1, At, B1); PG8_BAR; PG8_SCHED;
            PG8_LDA(At, 1, 1); PG8_STAGE(PG8_SB(1, 0), b3, voffB); PG8_STAGE(PG8_SB(1, 1), b3 + hstepB, voffB); PG8_STAGE_A(PG8_SA(1, 0), a2, v2, 0, ka3);
            PG8_WAIT_V(8); PG8_WAIT_L(0); PG8_BAR; PG8_MMA(1, 0, At, B0); PG8_MMA(1, 1, At, B1); PG8_BAR; PG8_SCHED;
        }
        if (wr == 0) PG8_BAR;
        { int fr_ = fr, fq_ = fq; asm volatile("" : "+v"(fr_), "+v"(fq_));
          EpiApply<Epi, PAIR>::run(E, acc, cur, wr, wc, fr_, fq_); }
        if (!has_next) break;
#pragma unroll
        for (int a = 0; a < 2; ++a)
#pragma unroll
            for (int b = 0; b < 2; ++b)
#pragma unroll
                for (int m = 0; m < 4; ++m)
#pragma unroll
                    for (int n = 0; n < 2; ++n) acc[a][b][m][n] = (f32x4){0.f, 0.f, 0.f, 0.f};
        cur = nxt; cA = nA; cB = nB; ++ui;
        if (GATHER) {
#pragma unroll
            for (int h = 0; h < 2; ++h)
#pragma unroll
                for (int i = 0; i < 2; ++i) vgc[h][i] = vgn[h][i];
        }
        if (wr == 1) PG8_BAR;
    }
    PG8_WAIT_V(0);
    PG8_BAR;
#undef PG8_SA
#undef PG8_SB
#undef PG8_STAGE
#undef PG8_STAGE_A
#undef PG8_LDA
#undef PG8_LDB
#undef PG8_MMA
#undef PG8_WAIT_V
#undef PG8_WAIT_L
#undef PG8_BAR
#undef PG8_SCHED
}
template <class Epi> struct EpiApply<Epi, false> {
    static __device__ __forceinline__ void run(const Epi& E, const f32x4 (&acc)[2][2][4][2], const Unit& u, int wr, int wc, int fr, int fq) {
#pragma unroll
        for (int ai = 0; ai < 2; ++ai)
#pragma unroll
            for (int m = 0; m < 4; ++m) { const int row = u.pm * BM + ai * HALF + wr * 64 + m * 16 + fr;
#pragma unroll
                for (int bj = 0; bj < 2; ++bj) {
                    if constexpr (Epi::PERM) E.put8(u, row, u.pn * BM + bj * HALF + wc * 32 + 8 * fq, acc[ai][bj][m][0], acc[ai][bj][m][1]);
                    else { E.put4(u, row, u.pn * BM + bj * HALF + wc * 32 + 4 * fq, acc[ai][bj][m][0]); E.put4(u, row, u.pn * BM + bj * HALF + wc * 32 + 16 + 4 * fq, acc[ai][bj][m][1]); } }
                asm volatile("" ::: "memory"); }
    }
};
template <class Epi> struct EpiApply<Epi, true> {
    static __device__ __forceinline__ void run(const Epi& E, const f32x4 (&acc)[2][2][4][2], const Unit& u, int wr, int wc, int fr, int fq) {
#pragma unroll
        for (int ai = 0; ai < 2; ++ai)
#pragma unroll
            for (int m = 0; m < 4; ++m) { const int row = u.pm * BM + ai * HALF + wr * 64 + m * 16 + fr;
                E.putp8(u, row, u.pn * HALF + wc * 32 + 8 * fq, acc[ai][0][m][0], acc[ai][0][m][1], acc[ai][1][m][0], acc[ai][1][m][1]); asm volatile("" ::: "memory"); }
    }
};
}

__device__ __forceinline__ void rowstat_pass(Frame& F) {
    const bf16_t* H = (const bf16_t*)(F.ws + WS_H); float* rstd = (float*)(F.ws + WS_RSTD);
    for (int m = F.gw; m < NTOK; m += F.NGW) {
        const bf16_t* hr = H + (size_t)m * HP;
        const u32x2 q = *((const u32x2*)(hr + HC_CQ_LAT) + F.lane);
        const unsigned kv = *((const unsigned*)(hr + HC_CKV) + F.lane);
        float a0 = bf2f(q.x & 0xffff), a1 = bf2f(q.x >> 16), a2 = bf2f(q.y & 0xffff), a3 = bf2f(q.y >> 16), b0 = bf2f(kv & 0xffff), b1 = bf2f(kv >> 16);
        const float sq = wave_sum(a0 * a0 + a1 * a1 + a2 * a2 + a3 * a3), sk = wave_sum(b0 * b0 + b1 * b1);
        if (F.lane == 0) { rstd[2 * m] = 1.0f / sqrtf(sq * (1.0f / 256.0f) + RMS_EPS); rstd[2 * m + 1] = 1.0f / sqrtf(sk * (1.0f / 128.0f) + RMS_EPS); }
    }
}
__device__ __forceinline__ void ln1_route_pass(Frame& F, const Args& a, int layer) {
    bf16_t* XB = (bf16_t*)(F.ws + WS_XB); float* tw = (float*)(F.ws + WS_TW); int* list = (int*)(F.ws + WS_LIST);
    const float* g = a.ln1_g + layer * DM; const float* bb = a.ln1_b + layer * DM;
    const float* wc = a.moe_w_coarse + (size_t)layer * DM * 4; const float* wf = a.moe_w_fine + (size_t)layer * 4 * DM * 8;
    for (int m = F.gw; m < NTOK; m += F.NGW) {
        float* xr = a.out + (size_t)m * DM;
        f32x4 v[4]; float s = 0.f;
#pragma unroll
        for (int j = 0; j < 4; ++j) { v[j] = *((const f32x4*)xr + F.lane + 64 * j); s += (v[j].x + v[j].y) + (v[j].z + v[j].w); }
        const float mean = wave_sum(s) * (1.f / DM); float s2 = 0.f;
#pragma unroll
        for (int j = 0; j < 4; ++j) { v[j] = v[j] - mean; s2 += (v[j].x * v[j].x + v[j].y * v[j].y) + (v[j].z * v[j].z + v[j].w * v[j].w); }
        const float rs = 1.f / sqrtf(wave_sum(s2) * (1.f / DM) + LN_EPS);
        float cl[4] = {0.f, 0.f, 0.f, 0.f};
#pragma unroll
        for (int j = 0; j < 4; ++j) { const int c = 4 * F.lane + 256 * j; const f32x4 gg = *(const f32x4*)(g + c), bv = *(const f32x4*)(bb + c); v[j] = v[j] * rs * gg + bv;
            *((f32x4*)xr + F.lane + 64 * j) = v[j]; u32x2 w; w.x = pk2(v[j].x, v[j].y); w.y = pk2(v[j].z, v[j].w); *((u32x2*)(XB + (size_t)m * DM) + F.lane + 64 * j) = w;
#pragma unroll
            for (int e = 0; e < 4; ++e) { const f32x4 w4 = *(const f32x4*)(wc + (size_t)(c + e) * 4); const float xe = v[j][e]; cl[0] += xe * w4.x; cl[1] += xe * w4.y; cl[2] += xe * w4.z; cl[3] += xe * w4.w; } }
#pragma unroll
        for (int e = 0; e < 4; ++e) cl[e] = wave_sum(cl[e]);
        int grp = 0; float cm = cl[0];
#pragma unroll
        for (int e = 1; e < 4; ++e) if (cl[e] > cm) { cm = cl[e]; grp = e; }
        float den = 0.f;
#pragma unroll
        for (int e = 0; e < 4; ++e) den += __expf(cl[e] - cm);
        const float pg = 1.0f / den;
        const float* wfg = wf + (size_t)grp * DM * 8;
        float fl[8] = {0.f, 0.f, 0.f, 0.f, 0.f, 0.f, 0.f, 0.f};
#pragma unroll
        for (int j = 0; j < 4; ++j) { const int c = 4 * F.lane + 256 * j;
#pragma unroll
            for (int e = 0; e < 4; ++e) { const f32x4 wa = *(const f32x4*)(wfg + (size_t)(c + e) * 8), wb = *(const f32x4*)(wfg + (size_t)(c + e) * 8 + 4); const float xe = v[j][e];
                fl[0] += xe * wa.x; fl[1] += xe * wa.y; fl[2] += xe * wa.z; fl[3] += xe * wa.w; fl[4] += xe * wb.x; fl[5] += xe * wb.y; fl[6] += xe * wb.z; fl[7] += xe * wb.w; } }
#pragma unroll
        for (int e = 0; e < 8; ++e) fl[e] = wave_sum(fl[e]);
        int i0 = 0; float v0 = fl[0];
#pragma unroll
        for (int e = 1; e < 8; ++e) if (fl[e] > v0) { v0 = fl[e]; i0 = e; }
        int i1 = -1; float v1 = -3.0e38f;
#pragma unroll
        for (int e = 0; e < 8; ++e) if (e != i0 && fl[e] > v1) { v1 = fl[e]; i1 = e; }
        const float e1 = __expf(v1 - v0), w0 = pg / (1.0f + e1), w1 = pg * e1 / (1.0f + e1);
        if (F.lane < 2) { const int e = grp * 8 + (F.lane == 0 ? i0 : i1); const int a_id = 2 * m + F.lane;
            const unsigned pos = __hip_atomic_fetch_add(F.ctl + CW_CNT + layer * 64 + e, 1u, RLX_AGENT);
            list[(size_t)e * LIST_CAP + pos] = a_id; tw[a_id] = (F.lane == 0) ? w0 : w1; }
    }
}
__device__ __forceinline__ void ln2_pass(Frame& F, const Args& a, int layer) {
    bf16_t* XB = (bf16_t*)(F.ws + WS_XB); const bf16_t* YB = (const bf16_t*)(F.ws + WS_YB);
    const float* g = a.ln2_g + layer * DM; const float* bb = a.ln2_b + layer * DM;
    for (int m = F.gw; m < NTOK; m += F.NGW) {
        float* xr = a.out + (size_t)m * DM; const bf16_t* y0 = YB + (size_t)(2 * m) * DM; const bf16_t* y1 = y0 + DM;
        f32x4 v[4]; float s = 0.f;
#pragma unroll
        for (int j = 0; j < 4; ++j) { v[j] = *((const f32x4*)xr + F.lane + 64 * j) * DN_ALPHA; const u32x2 p = *((const u32x2*)y0 + F.lane + 64 * j), q = *((const u32x2*)y1 + F.lane + 64 * j);
            v[j].x += bf2f(p.x & 0xffff) + bf2f(q.x & 0xffff); v[j].y += bf2f(p.x >> 16) + bf2f(q.x >> 16); v[j].z += bf2f(p.y & 0xffff) + bf2f(q.y & 0xffff); v[j].w += bf2f(p.y >> 16) + bf2f(q.y >> 16);
            s += (v[j].x + v[j].y) + (v[j].z + v[j].w); }
        const float mean = wave_sum(s) * (1.f / DM); float s2 = 0.f;
#pragma unroll
        for (int j = 0; j < 4; ++j) { v[j] = v[j] - mean; s2 += (v[j].x * v[j].x + v[j].y * v[j].y) + (v[j].z * v[j].z + v[j].w * v[j].w); }
        const float rs = 1.f / sqrtf(wave_sum(s2) * (1.f / DM) + LN_EPS);
#pragma unroll
        for (int j = 0; j < 4; ++j) { const int c = 4 * F.lane + 256 * j; const f32x4 gg = *(const f32x4*)(g + c), bv = *(const f32x4*)(bb + c); v[j] = v[j] * rs * gg + bv;
            *((f32x4*)xr + F.lane + 64 * j) = v[j]; u32x2 w; w.x = pk2(v[j].x, v[j].y); w.y = pk2(v[j].z, v[j].w); *((u32x2*)(XB + (size_t)m * DM) + F.lane + 64 * j) = w; }
    }
}
__device__ __forceinline__ void moe_convert(Frame& F, const Args& a, int layer) {
    LAS float* scr = (LAS float*)(F.lds + F.wave * 16384);
    constexpr int I_13 = (1024 / 64) * (1024 / 32), I_2 = (512 / 64) * (1024 / 32), PER_E = I_13 + I_2;
    for (int it = F.gw; it < NEXP * PER_E; it += F.NGW) {
        const int e = it / PER_E; int r = it - e * PER_E; const size_t le = (size_t)layer * NEXP + e;
        if (r < I_13) { const int kb = r / 32, nb = r % 32; const float* src = ((nb >> 2) & 1) ? a.moe_w3 : a.moe_w1;
            transpose_item(src + le * 1024 * 512, 512, (bf16_t*)(F.ws + WS_W13) + (size_t)e * 1024 * 1024, 1024, scr, kb * 64, nb * 32, W13Map(), nullptr, F.lane); }
        else { r -= I_13; const int kb = r / 32, nb = r % 32; transpose_item(a.moe_w2 + le * 512 * 1024, 1024, (bf16_t*)(F.ws + WS_W2) + (size_t)e * 1024 * 512, 512, scr, kb * 64, nb * 32, IdMap(), nullptr, F.lane); }
    }
}

struct RowSrc { const bf16_t* p; long pitch; };
constexpr int SA_P = 0, SA_V = 4096, SA_AL = 12288, SA_RL = 12544;
template <int NC0, int NC1, int MODE>
__device__ __forceinline__ void sattn_core(const bf16x8* qf, RowSrc k0, RowSrc k1, RowSrc vs, int kb_lo, int kb_hi, int qidx0, float lse_ref, LAS unsigned char* scr, int lane, f32x16* o, float& lse_out) {
    const int r32 = lane & 31, hi = lane >> 5;
    LAS bf16_t* Pb = (LAS bf16_t*)(scr + SA_P); LAS bf16_t* Vb = (LAS bf16_t*)(scr + SA_V); LAS float* Al = (LAS float*)(scr + SA_AL);
    float m = -1.0e30f, l = 0.f;
    if (MODE != 1) { o[0] = f32x16{}; o[1] = f32x16{}; }
    for (int kb = kb_lo; kb < kb_hi; ++kb) {
        const long key = (long)kb * 32 + r32;
        f32x16 s = {};
#pragma unroll
        for (int c = 0; c < NC0; ++c) { const bf16x8 kf = *(const bf16x8*)(k0.p + key * k0.pitch + 16 * c + 8 * hi); s = MFMA32(kf, qf[c], s); }
#pragma unroll
        for (int c = 0; c < NC1; ++c) { const bf16x8 kf = *(const bf16x8*)(k1.p + key * k1.pitch + 16 * c + 8 * hi); s = MFMA32(kf, qf[NC0 + c], s); }
        bool valid[16];
#pragma unroll
        for (int r = 0; r < 16; ++r) { if (MODE == 0) valid[r] = true; else { const int d = kb * 32 + crow(r, hi) - (qidx0 + r32); valid[r] = (d <= 64 && d >= -64); } }
        float p[16];
        if (MODE == 2) {
#pragma unroll
            for (int r = 0; r < 16; ++r) p[r] = valid[r] ? fast_exp2(s[r] - lse_ref) : 0.f;
        } else {
            float mx = -1.0e30f;
#pragma unroll
            for (int r = 0; r < 16; ++r) if (valid[r]) mx = fmaxf(mx, s[r]);
            mx = fmaxf(mx, __shfl_xor(mx, 32));
            const float mn = fmaxf(m, mx), alpha = fast_exp2(m - mn); m = mn;
            float ps = 0.f;
#pragma unroll
            for (int r = 0; r < 16; ++r) { p[r] = valid[r] ? fast_exp2(s[r] - mn) : 0.f; ps += p[r]; }
            l = l * alpha + ps;
            if (MODE == 0) { if (hi == 0) Al[r32] = alpha; }
        }
        if (MODE != 1) {
#pragma unroll
            for (int g = 0; g < 4; ++g) { u32x2 w; w.x = pk2(p[4 * g], p[4 * g + 1]); w.y = pk2(p[4 * g + 2], p[4 * g + 3]); *(LAS u32x2*)(Pb + r32 * 40 + 8 * g + 4 * hi) = w; }
#pragma unroll
            for (int i = 0; i < 4; ++i) { const int idx = i * 64 + lane, kr = idx >> 3, pc = idx & 7; *(LAS u32x4*)(Vb + kr * 72 + pc * 8) = *(const u32x4*)(vs.p + ((long)kb * 32 + kr) * vs.pitch + pc * 8); }
            LDS_WAIT();
            if (MODE == 0) {
#pragma unroll
                for (int r = 0; r < 16; ++r) { const float al = Al[crow(r, hi)]; o[0][r] *= al; o[1][r] *= al; }
            }
#pragma unroll
            for (int st = 0; st < 2; ++st) {
                const bf16x8 pf = *(const LAS bf16x8*)(Pb + r32 * 40 + 16 * st + 8 * hi);
#pragma unroll
                for (int db = 0; db < 2; ++db) { bf16x8 vf;
#pragma unroll
                    for (int j = 0; j < 8; ++j) vf[j] = (short)Vb[(16 * st + 8 * hi + j) * 72 + 32 * db + r32];
                    o[db] = MFMA32(pf, vf, o[db]); }
            }
            LDS_WAIT();
        }
    }
    if (MODE != 2) { l += __shfl_xor(l, 32); lse_out = m + __log2f(l); }
    if (MODE == 0) {
        LAS float* Rl = (LAS float*)(scr + SA_RL);
        if (hi == 0) Rl[r32] = 1.0f / l;
        LDS_WAIT();
#pragma unroll
        for (int r = 0; r < 16; ++r) { const float rl = Rl[crow(r, hi)]; o[0][r] *= rl; o[1][r] *= rl; }
        LDS_WAIT();
    }
}

__device__ __forceinline__ void sattn_phase(Frame& F, const Args& a, int layer) {
    const bf16_t* H = (const bf16_t*)(F.ws + WS_H); const bf16_t* QB = (const bf16_t*)(F.ws + WS_QB); const bf16_t* KVB = (const bf16_t*)(F.ws + WS_KVB);
    bf16_t* MIX = (bf16_t*)(F.ws + WS_MIX); const float* lsec = (const float*)(F.ws + WS_LSEC);
    LAS unsigned char* scr = F.lds + F.wave * 16384;
    const int lane = F.lane, r32 = lane & 31, hi = lane >> 5;
    float lam, lam_init;
    { const float* lv = a.diff_lambda + layer * 128; float d1 = 0.f, d2 = 0.f;
      for (int i = 0; i < 32; ++i) { d1 += lv[i] * lv[32 + i]; d2 += lv[64 + i] * lv[96 + i]; }
      lam_init = 0.8f - 0.6f * expf(-0.3f * (float)layer); lam = expf(d1) - expf(d2) + lam_init; }
    constexpr int NRB = NTOK / 32;
    const int items = NRB * (4 + 6 + 6);
    for (int it = F.gw; it < items; it += F.NGW) {
        const int kind = it / NRB, rb = it - kind * NRB; const int m0 = rb * 32; const SeqInfo si = seqinfo(m0);
        if (kind < 4) {
            const int h = kind; f32x16 o0[2], o1[2]; float dummy;
            for (int c = 0; c < 2; ++c) {
                bf16x8 qf[2];
#pragma unroll
                for (int d0 = 0; d0 < 2; ++d0) qf[d0] = *(const bf16x8*)(H + (size_t)(m0 + r32) * HP + HC_AQ + h * 64 + c * 32 + 16 * d0 + 8 * hi);
                const RowSrc ks{H + (size_t)si.base * HP + HC_AK + h * 64 + c * 32, HP}, vs{H + (size_t)si.base * HP + HC_AV + h * 64, HP};
                sattn_core<2, 0, 0>(qf, ks, ks, vs, 0, si.len / 32, 0, 0.f, scr, lane, c == 0 ? o0 : o1, dummy);
            }
            const float* sg = a.diff_subln + layer * 64; const float g0 = sg[r32], g1 = sg[32 + r32];
#pragma unroll
            for (int r = 0; r < 16; ++r) { const float x0 = o0[0][r] - lam * o1[0][r], x1 = o0[1][r] - lam * o1[1][r]; float ss = x0 * x0 + x1 * x1;
                ss += __shfl_xor(ss, 1); ss += __shfl_xor(ss, 2); ss += __shfl_xor(ss, 4); ss += __shfl_xor(ss, 8); ss += __shfl_xor(ss, 16);
                const float rs = (1.0f - lam_init) / sqrtf(ss * (1.0f / 64.0f) + RMS_EPS);
                bf16_t* op = MIX + (size_t)(m0 + crow(r, hi)) * DM + MIX_A + h * 64 + r32;
                op[0] = (bf16_t)f2bf(x0 * rs * g0); op[32] = (bf16_t)f2bf(x1 * rs * g1); }
        } else if (kind < 10) {
            const int h = kind - 4; f32x16 o[2]; float dummy; bf16x8 qf[6];
#pragma unroll
            for (int d0 = 0; d0 < 6; ++d0) qf[d0] = *(const bf16x8*)(QB + (size_t)(m0 + r32) * QBP + h * 96 + 16 * d0 + 8 * hi);
            const RowSrc k0{KVB + (size_t)si.base * KVP + h * 128, KVP}, k1{H + (size_t)si.base * HP + HC_KROPE, HP}, vs{KVB + (size_t)si.base * KVP + h * 128 + 64, KVP};
            sattn_core<4, 2, 0>(qf, k0, k1, vs, 0, si.len / 32, 0, 0.f, scr, lane, o, dummy);
#pragma unroll
            for (int r = 0; r < 16; ++r) { bf16_t* op = MIX + (size_t)(m0 + crow(r, hi)) * DM + MIX_B + h * 64 + r32; op[0] = (bf16_t)f2bf(o[0][r]); op[32] = (bf16_t)f2bf(o[1][r]); }
        } else {
            const int gj = kind - 10, g = gj >> 1, hh = gj;
            const int dil = (g == 0) ? 1 : (g == 1 ? 4 : 16); const int L = si.len / dil, bpr = L / 32;
            const int w = (m0 - si.base) / 32, rho = w / bpr, ib = w - rho * bpr, i0 = ib * 32;
            const size_t qrow = (size_t)si.base + (size_t)(i0 + r32) * dil + rho;
            bf16x8 qf[4];
#pragma unroll
            for (int d0 = 0; d0 < 4; ++d0) qf[d0] = *(const bf16x8*)(H + qrow * HP + HC_CQ + hh * 64 + 16 * d0 + 8 * hi);
            const int j = gj & 1; const float l0 = lsec[(0 * (size_t)NTOK + qrow) * 2 + j], l1 = lsec[(1 * (size_t)NTOK + qrow) * 2 + j], l2 = lsec[(2 * (size_t)NTOK + qrow) * 2 + j];
            const float lm = fmaxf(l0, fmaxf(l1, l2)); const float lref = lm + __log2f(fast_exp2(l0 - lm) + fast_exp2(l1 - lm) + fast_exp2(l2 - lm));
            const RowSrc ks{H + ((size_t)si.base + rho) * HP + HC_CK + hh * 64, (long)HP * dil}, vs{H + ((size_t)si.base + rho) * HP + HC_CV + hh * 64, (long)HP * dil};
            int kb_lo = ib - 2, kb_hi = ib + 3; if (kb_lo < 0) kb_lo = 0; if (kb_hi > bpr) kb_hi = bpr;
            f32x16 o[2]; float dummy;
            sattn_core<4, 0, 2>(qf, ks, ks, vs, kb_lo, kb_hi, i0, lref, scr, lane, o, dummy);
#pragma unroll
            for (int r = 0; r < 16; ++r) { const size_t orow = (size_t)si.base + (size_t)(i0 + crow(r, hi)) * dil + rho; bf16_t* op = MIX + orow * DM + MIX_C + hh * 64 + r32; op[0] = (bf16_t)f2bf(o[0][r]); op[32] = (bf16_t)f2bf(o[1][r]); }
        }
    }
}
__device__ __forceinline__ void cstat_phase(Frame& F) {
    const bf16_t* H = (const bf16_t*)(F.ws + WS_H); float* lsec = (float*)(F.ws + WS_LSEC);
    LAS unsigned char* scr = F.lds + F.wave * 16384;
    const int lane = F.lane, r32 = lane & 31, hi = lane >> 5;
    constexpr int NRB = NTOK / 32;
    for (int it = F.gw; it < NRB * 6; it += F.NGW) {
        const int gj = it / NRB, rb = it - gj * NRB, g = gj >> 1, j = gj & 1; const int m0 = rb * 32; const SeqInfo si = seqinfo(m0);
        const int dil = (g == 0) ? 1 : (g == 1 ? 4 : 16); const int L = si.len / dil, bpr = L / 32;
        const int w = (m0 - si.base) / 32, rho = w / bpr, ib = w - rho * bpr, i0 = ib * 32;
        const size_t qrow = (size_t)si.base + (size_t)(i0 + r32) * dil + rho;
        bf16x8 qf[4];
#pragma unroll
        for (int d0 = 0; d0 < 4; ++d0) qf[d0] = *(const bf16x8*)(H + qrow * HP + HC_CQ + gj * 64 + 16 * d0 + 8 * hi);
        const RowSrc ks{H + ((size_t)si.base + rho) * HP + HC_CK + gj * 64, (long)HP * dil};
        int kb_lo = ib - 2, kb_hi = ib + 3; if (kb_lo < 0) kb_lo = 0; if (kb_hi > bpr) kb_hi = bpr;
        float lse; sattn_core<4, 0, 1>(qf, ks, ks, ks, kb_lo, kb_hi, i0, 0.f, scr, lane, nullptr, lse);
        if (hi == 0) lsec[((size_t)g * NTOK + qrow) * 2 + j] = lse;
    }
}

struct ListRows { const int* list; int seg0, cnt; __device__ __forceinline__ int src(int m) const { const int r = m - seg0; return (r < cnt) ? (list[r] >> 1) : 0; } };
__device__ __forceinline__ void moe_segments(Frame& F, int layer, LAS int* seg) {
    if (F.tid == 0) { int acc = 0; for (int e = 0; e < NEXP; ++e) { const int c = (int)__hip_atomic_load(F.ctl + CW_CNT + layer * 64 + e, RLX_AGENT); seg[e] = acc; seg[33 + e] = c; acc += (c + 255) & ~255; } seg[32] = acc; }
    __syncthreads();
}
__device__ __forceinline__ int seg_find(const LAS int* seg, int row) { int e = 0;
#pragma unroll
    for (int s = 16; s > 0; s >>= 1) if (seg[e + s] <= row) e += s;
    return e; }
__device__ __forceinline__ void moe_up_simple(Frame& F, int layer) {
    LAS int* seg = (LAS int*)(F.lds + RING_BYTES); moe_segments(F, layer, seg);
    const bf16_t* XB = (const bf16_t*)(F.ws + WS_XB); const bf16_t* W13 = (const bf16_t*)(F.ws + WS_W13); const int* list = (const int*)(F.ws + WS_LIST);
    const EpiHid E{(bf16_t*)(F.ws + WS_HID)};
    const int items = (seg[32] / 32) * 16;
    for (int it = F.gw; it < items; it += F.NGW) { const int mt = it >> 4, ct = it & 15, m0 = mt * 32, e = seg_find(seg, m0), c0 = ct * 32;
        const ListRows RM{list + (size_t)e * LIST_CAP, seg[e], seg[33 + e]};
        const bf16_t* Bg = W13 + (size_t)e * 1024 * 1024 + (size_t)((c0 >> 7) * 256 + (c0 & 127)) * 1024;
        sg_tile(XB, DM, Bg, Bg + (size_t)128 * 1024, 1024, 1024, m0, c0, E, RM, F.lane); }
    __syncthreads();
}
__device__ __forceinline__ void moe_down_simple(Frame& F, int layer) {
    LAS int* seg = (LAS int*)(F.lds + RING_BYTES); moe_segments(F, layer, seg);
    const bf16_t* HID = (const bf16_t*)(F.ws + WS_HID); const bf16_t* W2 = (const bf16_t*)(F.ws + WS_W2); const int* list = (const int*)(F.ws + WS_LIST);
    const int items = (seg[32] / 32) * 16;
    for (int it = F.gw; it < items; it += F.NGW) { const int mt = it >> 4, ct = it & 15, m0 = mt * 32, e = seg_find(seg, m0), c0 = ct * 64;
        const EpiY E{(bf16_t*)(F.ws + WS_YB), (const float*)(F.ws + WS_TW), list + (size_t)e * LIST_CAP, seg[e], seg[33 + e]};
        const bf16_t* B0 = W2 + (size_t)e * 1024 * 512 + (size_t)c0 * 512;
        sg_tile(HID, DEXP, B0, B0 + (size_t)32 * 512, 512, 512, m0, c0, E, IdRows(), F.lane); }
    __syncthreads();
}


struct MoeUpSched {
    const char* XB; const char* W13; const LAS int* seg; const int* list; int nM, G, c;
    __device__ __forceinline__ bool next(int i, pg8::Unit& u) const { if (!pg8::order_next(i, G, c, nM, 4, u.pm, u.pn)) return false; u.e = __builtin_amdgcn_readfirstlane(seg_find(seg, u.pm * 256)); u.a = XB; u.b = W13 + ((size_t)u.e * 1024 + (size_t)u.pn * 256) * 2048; return true; }
    __device__ __forceinline__ unsigned arow(const pg8::Unit& u, int r) const { const int rr = u.pm * 256 + r - __builtin_amdgcn_readfirstlane(seg[u.e]); return (rr < __builtin_amdgcn_readfirstlane(seg[33 + u.e])) ? (unsigned)(list[(size_t)u.e * LIST_CAP + rr] >> 1) : 0u; }
};
struct MoeDownSched {
    const char* HID; const char* W2; const LAS int* seg; int nM, G, c;
    __device__ __forceinline__ bool next(int i, pg8::Unit& u) const { if (!pg8::order_next(i, G, c, nM, 4, u.pm, u.pn)) return false; u.e = __builtin_amdgcn_readfirstlane(seg_find(seg, u.pm * 256)); u.a = HID + (size_t)u.pm * 256 * DEXP * 2; u.b = W2 + ((size_t)u.e * 1024 + (size_t)u.pn * 256) * 1024; return true; }
    __device__ __forceinline__ unsigned arow(const pg8::Unit&, int) const { return 0u; }
};
__device__ __forceinline__ void moe_up_opt(Frame& F, int layer) {
    LAS int* seg = (LAS int*)(F.lds + RING_BYTES); moe_segments(F, layer, seg);
    const MoeUpSched S{(const char*)(F.ws + WS_XB), (const char*)(F.ws + WS_W13), seg, (const int*)(F.ws + WS_LIST), __builtin_amdgcn_readfirstlane(seg[32]) / 256, F.G, F.bid};
    const EpiHid E{(bf16_t*)(F.ws + WS_HID)};
    pg8::gemm_phase<EpiHid, MoeUpSched, true, true>(F.lds, F.tid, 1024, DM, S, E);
    __syncthreads();
}
__device__ __forceinline__ void moe_down_opt(Frame& F, int layer) {
    LAS int* seg = (LAS int*)(F.lds + RING_BYTES); moe_segments(F, layer, seg);
    const MoeDownSched S{(const char*)(F.ws + WS_HID), (const char*)(F.ws + WS_W2), seg, __builtin_amdgcn_readfirstlane(seg[32]) / 256, F.G, F.bid};
    const EpiYO E{(bf16_t*)(F.ws + WS_YB), (const float*)(F.ws + WS_TW), (const int*)(F.ws + WS_LIST), seg};
    pg8::gemm_phase<EpiYO, MoeDownSched, false, false>(F.lds, F.tid, DEXP, DEXP, S, E);
    __syncthreads();
}
template <class Epi>
__device__ __forceinline__ void og_phase(Frame& F, const bf16_t* A, int lda, const bf16_t* Bt, int M, int N, int K, const Epi& E) {
    pg8::DenseSched S; S.init(A, lda, Bt, M, N, K, F.G, F.bid);
    pg8::gemm_phase<Epi, pg8::DenseSched, false, false>(F.lds, F.tid, K, lda, S, E);
}

constexpr int PH_PER_LAYER = 9, N_PHASES = 1 + DEPTH * PH_PER_LAYER;
__global__ void __launch_bounds__(NTHREADS, 2) fwd(Args args) {
    extern __shared__ __attribute__((aligned(16))) unsigned char lds[];
    Frame F;
    F.lds = (LAS unsigned char*)lds; F.ldsg = lds;
    F.tid = threadIdx.x; F.lane = F.tid & 63; F.wave = __builtin_amdgcn_readfirstlane(F.tid >> 6);
    F.G = gridDim.x; F.bid = blockIdx.x; F.gw = blockIdx.x * NWAVES + F.wave; F.NGW = F.G * NWAVES;
    F.ws = args.ws; F.ctl = (gu32*)(args.ws + WS_CTL);
    volatile LAS unsigned* MISC = (volatile LAS unsigned*)(F.lds + MISC_OFF);
    for (int u = F.tid; u < (LDS_BYTES - RING_BYTES) / 4; u += NTHREADS) ((LAS unsigned*)(F.lds + RING_BYTES))[u] = 0u;
    __syncthreads();
    XcdBarrier bar; bar.bar = (unsigned*)(F.ctl + CW_BAR); bar.x = 0; bar.st = nullptr;
    if (args.use_bar) bar = xcd_barrier_post((unsigned*)(F.ctl + CW_BAR), MISC + 8);
    const int lo = args.ph_lo, hi = args.ph_hi;
#ifndef PH_MASK
#define PH_MASK 0x3ff
#endif
#define IN(k) (lo <= (k) && (k) < hi && (launder(F), true))
#define SEAM(k) do { if (lo <= (k) && (k) + 1 < hi) xcd_barrier(bar); } while (0)
    if ((PH_MASK & 1) && IN(0)) { p0_prologue(F, args); }
    SEAM(0);
    for (int layer = 0; layer < DEPTH; ++layer) {
        const int pb = 1 + layer * PH_PER_LAYER;
        if ((PH_MASK & (2 << 0)) && IN(pb + 0)) {   bf16_t* H = (bf16_t*)(F.ws + WS_H);
            const EpiH E{H, (const float2*)(F.ws + WS_ROPE32), (const float2*)(F.ws + WS_ROPE64)};
#if OPT_GEMM
            og_phase(F, (const bf16_t*)(F.ws + WS_XB), DM, (const bf16_t*)(F.ws + WS_WIN) + (size_t)layer * 2560 * 1024, NTOK, 2560, 1024, E);
#else
            sg_phase(F, (const bf16_t*)(F.ws + WS_XB), DM, (const bf16_t*)(F.ws + WS_WIN) + (size_t)layer * 2560 * 1024, 1024, NTOK, 2560, 1024, E);
#endif
        }
        SEAM(pb + 0);
        if ((PH_MASK & (2 << 1)) && IN(pb + 1)) { rowstat_pass(F); cstat_phase(F); }
        SEAM(pb + 1);
        if ((PH_MASK & (2 << 2)) && IN(pb + 2)) {
            bf16_t* H = (bf16_t*)(F.ws + WS_H);
            const EpiUQ Eq{(bf16_t*)(F.ws + WS_QB), (const float*)(F.ws + WS_RSTD), (const float2*)(F.ws + WS_ROPE32)};
#if OPT_GEMM
            og_phase(F, H + HC_CQ_LAT, HP, (const bf16_t*)(F.ws + WS_WUQ) + (size_t)layer * 768 * 256, NTOK, 768, 256, Eq);
            launder(F);
#else
            sg_phase(F, H + HC_CQ_LAT, HP, (const bf16_t*)(F.ws + WS_WUQ) + (size_t)layer * 768 * 256, 256, NTOK, 768, 256, Eq);
#endif
            const EpiUKV Ek{(bf16_t*)(F.ws + WS_KVB), (const float*)(F.ws + WS_RSTD)};
#if OPT_GEMM
            og_phase(F, H + HC_CKV, HP, (const bf16_t*)(F.ws + WS_WUKV) + (size_t)layer * 768 * 256, NTOK, 768, 256, Ek);
#else
            sg_phase(F, H + HC_CKV, HP, (const bf16_t*)(F.ws + WS_WUKV) + (size_t)layer * 768 * 256, 256, NTOK, 768, 256, Ek);
#endif
        }
        SEAM(pb + 2);
        if ((PH_MASK & (2 << 3)) && IN(pb + 3)) { sattn_phase(F, args, layer); }
        SEAM(pb + 3);
        if ((PH_MASK & (2 << 4)) && IN(pb + 4)) {
            const EpiRes E{args.out};
#if OPT_GEMM
            og_phase(F, (const bf16_t*)(F.ws + WS_MIX), DM, (const bf16_t*)(F.ws + WS_WOUT) + (size_t)layer * 1024 * 1024, NTOK, 1024, 1024, E);
#else
            sg_phase(F, (const bf16_t*)(F.ws + WS_MIX), DM, (const bf16_t*)(F.ws + WS_WOUT) + (size_t)layer * 1024 * 1024, 1024, NTOK, 1024, 1024, E);
#endif
        }
        SEAM(pb + 4);
        if ((PH_MASK & (2 << 5)) && IN(pb + 5)) { ln1_route_pass(F, args, layer); moe_convert(F, args, layer); }
        SEAM(pb + 5);
#if OPT_GEMM
        if ((PH_MASK & (2 << 6)) && IN(pb + 6)) { moe_up_opt(F, layer); }
#else
        if ((PH_MASK & (2 << 6)) && IN(pb + 6)) { moe_up_simple(F, layer); }
#endif
        SEAM(pb + 6);
#if OPT_GEMM
        if ((PH_MASK & (2 << 7)) && IN(pb + 7)) { moe_down_opt(F, layer); }
#else
        if ((PH_MASK & (2 << 7)) && IN(pb + 7)) { moe_down_simple(F, layer); }
#endif
        SEAM(pb + 7);
        if ((PH_MASK & (2 << 8)) && IN(pb + 8)) { ln2_pass(F, args, layer); }
        SEAM(pb + 8);
    }
#undef IN
#undef SEAM
}

extern "C" void kernel_launch(void* const* d_in, const int* in_sizes, int n_in, void* d_out, int out_size, void* d_ws, size_t ws_size, hipStream_t stream) {
    static int grid = 0;
    if (grid == 0) {
        if (n_in != 19 || out_size != NTOK * DM || ws_size < WS_END) { fprintf(stderr, "kernel_launch: unexpected shapes (n_in %d out %d ws %zu)\n", n_in, out_size, ws_size); grid = -1; return; }
        int dev = 0, cus = 0, per_cu = 0;
        if (hipGetDevice(&dev) != hipSuccess || hipDeviceGetAttribute(&cus, hipDeviceAttributeMultiprocessorCount, dev) != hipSuccess) { grid = -1; return; }
        if (hipFuncSetAttribute((const void*)fwd, hipFuncAttributeMaxDynamicSharedMemorySize, LDS_BYTES) != hipSuccess) { grid = -1; return; }
        if (hipOccupancyMaxActiveBlocksPerMultiprocessor(&per_cu, (const void*)fwd, NTHREADS, LDS_BYTES) != hipSuccess || per_cu < 1) { fprintf(stderr, "kernel_launch: occupancy query says %d\n", per_cu); }
        (void)hipGetLastError();
        grid = cus;
    }
    if (grid < 0) return;
    if (hipMemsetAsync((char*)d_ws + WS_CTL, 0, CTL_ZERO_BYTES, stream) != hipSuccess) return;
    Args a{};
    a.x_prompt = (const float*)d_in[0]; a.x_sample = (const float*)d_in[1]; a.w_in = (const float*)d_in[2]; a.diff_lambda = (const float*)d_in[3]; a.diff_subln = (const float*)d_in[4];
    a.mla_q_norm = (const float*)d_in[5]; a.mla_w_uq = (const float*)d_in[6]; a.mla_kv_norm = (const float*)d_in[7]; a.mla_w_ukv = (const float*)d_in[8]; a.w_out = (const float*)d_in[9];
    a.ln1_g = (const float*)d_in[10]; a.ln1_b = (const float*)d_in[11]; a.moe_w_coarse = (const float*)d_in[12]; a.moe_w_fine = (const float*)d_in[13];
    a.moe_w1 = (const float*)d_in[14]; a.moe_w3 = (const float*)d_in[15]; a.moe_w2 = (const float*)d_in[16]; a.ln2_g = (const float*)d_in[17]; a.ln2_b = (const float*)d_in[18];
    a.out = (float*)d_out; a.ws = (unsigned char*)d_ws; a.pad = 0;
#if MK_ONE_LAUNCH
    a.ph_lo = 0; a.ph_hi = N_PHASES; a.use_bar = 1;
    hipLaunchKernelGGL(fwd, dim3(grid), dim3(NTHREADS), LDS_BYTES, stream, a);
#else
    for (int p = 0; p < N_PHASES; ++p) { a.ph_lo = p; a.ph_hi = p + 1; a.use_bar = 0; hipLaunchKernelGGL(fwd, dim3(grid), dim3(NTHREADS), LDS_BYTES, stream, a); }
#endif
}
```

```cpp
#include <hip/hip_runtime.h>
#include <cstdio>
#include <cstdint>

#ifndef OPT_ATTN
#define OPT_ATTN 1
#endif
#ifndef OPT_GEMM
#define OPT_GEMM 1
#endif
#ifndef MK_ONE_LAUNCH
#define MK_ONE_LAUNCH 1
#endif

#define GAS __attribute__((address_space(1)))
#define LAS __attribute__((address_space(3)))
typedef unsigned short bf16_t;
typedef short bf16x8 __attribute__((ext_vector_type(8)));
typedef float f32x4 __attribute__((ext_vector_type(4)));
typedef float f32x2 __attribute__((ext_vector_type(2)));
typedef float f32x16 __attribute__((ext_vector_type(16)));
typedef unsigned u32x4 __attribute__((ext_vector_type(4)));
typedef unsigned u32x2 __attribute__((ext_vector_type(2)));
typedef GAS unsigned gu32;
#define RLX_AGENT __ATOMIC_RELAXED, __HIP_MEMORY_SCOPE_AGENT
#define LDS_WAIT() asm volatile("s_waitcnt lgkmcnt(0)" ::: "memory")
#define VM_WAIT() asm volatile("s_waitcnt vmcnt(0)" ::: "memory")
#define MFMA32(a, b, c) __builtin_amdgcn_mfma_f32_32x32x16_bf16(a, b, c, 0, 0, 0)

__device__ __forceinline__ unsigned f2bf(float f) { unsigned u = __builtin_bit_cast(unsigned, f); return (u + 0x7fffu + ((u >> 16) & 1u)) >> 16; }
__device__ __forceinline__ unsigned pk2(float lo, float hi) { return f2bf(lo) | (f2bf(hi) << 16); }
__device__ __forceinline__ float bf2f(unsigned short b) { return __builtin_bit_cast(float, (unsigned)b << 16); }
__device__ __forceinline__ int crow(int r, int hi) { return (r & 3) + 8 * (r >> 2) + 4 * hi; }
__device__ __forceinline__ float wave_sum(float v) {
#pragma unroll
    for (int o = 1; o < 64; o <<= 1) v += __shfl_xor(v, o);
    return v;
}
__device__ __forceinline__ float fast_exp2(float x) { return __builtin_amdgcn_exp2f(x); }

constexpr int NTOK = 65536, DM = 1024, DEPTH = 4;
constexpr int NTOK_P = 32768;
constexpr int HP = 2560;
constexpr int HC_AQ = 0, HC_AK = 256, HC_AV = 512, HC_CQ_LAT = 768, HC_CKV = 1024, HC_KROPE = 1152, HC_CQ = 1280, HC_CK = 1664, HC_CV = 2048;
constexpr int QBP = 768, KVP = 768;
constexpr int MIX_A = 0, MIX_B = 256, MIX_C = 640;
constexpr int NEXP = 32, DEXP = 512;
constexpr float LOG2E = 1.4426950408889634f;
constexpr float SC_A = 0.17677669529663687f * LOG2E;
constexpr float SC_B = 0.10206207261596575f * LOG2E;
constexpr float SC_C = 0.125f * LOG2E;
constexpr float DN_ALPHA = 1.681792830507429f;
constexpr float LN_EPS = 1e-5f, RMS_EPS = 1e-6f;

constexpr size_t MiB = 1u << 20;
constexpr size_t WS_CTL = 0, CTL_ZERO_BYTES = 1 * MiB;
constexpr size_t WS_ROPE32 = 4 * MiB;
constexpr size_t WS_ROPE64 = 5 * MiB;
constexpr size_t WS_WIN = 8 * MiB;
constexpr size_t WS_WOUT = 28 * MiB;
constexpr size_t WS_WUQ = 36 * MiB;
constexpr size_t WS_WUKV = 38 * MiB;
constexpr size_t WS_W13 = 40 * MiB;
constexpr size_t WS_W2 = 104 * MiB;
constexpr size_t WS_XB = 136 * MiB;
constexpr size_t WS_H = 264 * MiB;
constexpr size_t WS_QB = 584 * MiB;
constexpr size_t WS_KVB = 680 * MiB;
constexpr size_t WS_MIX = 776 * MiB;
constexpr size_t WS_RSTD = 904 * MiB;
constexpr size_t WS_LSEC = 905 * MiB;
constexpr size_t WS_TW = 907 * MiB;
constexpr size_t WS_LIST = 908 * MiB;
constexpr size_t WS_END = 924 * MiB;
constexpr size_t WS_HID = WS_H;
constexpr size_t WS_YB = WS_H + 136 * MiB;
static_assert(WS_YB + 256 * MiB <= WS_KVB + 96 * MiB, "YB overlay");
constexpr int LIST_CAP = 131072;
constexpr int CW_TMO = 0;
constexpr int CW_CNT = 64;
constexpr int CW_BAR = 4096;

constexpr int RING_BYTES = 131072;
constexpr int MISC_OFF = RING_BYTES + 320;
constexpr int LDS_BYTES = 147456;
constexpr int NWAVES = 8, NTHREADS = 512;

#define XB_TMO      128
#define XB_XCNT(j)  (256  + 64 * (j))
#define XB_XSUB(j)  (1280 + 64 * (j))
#define XB_XGEN(j)  (2304 + 64 * (j))
#define XB_TOP      3328
#define XB_TOPGEN   3392
#define XCD_BAR_WORDS 3456
#define XB_SPIN_CAP (1u << 22)
__device__ __forceinline__ unsigned xb_ld(unsigned* p)              { return __hip_atomic_load(p, __ATOMIC_RELAXED, __HIP_MEMORY_SCOPE_AGENT); }
__device__ __forceinline__ unsigned xb_add(unsigned* p, unsigned v) { return __hip_atomic_fetch_add(p, v, __ATOMIC_RELAXED, __HIP_MEMORY_SCOPE_AGENT); }
__device__ __forceinline__ unsigned xb_xcc_id() { return (unsigned)__builtin_amdgcn_s_getreg((3 << 11) | 20) & 0xFu; }
#define XB_SPIN(cond, bar) do { unsigned _sp = 0; while (cond) { __builtin_amdgcn_s_sleep(1); \
    if ((++_sp & 255u) == 0u) { if (xb_ld(&(bar)[XB_TMO])) break; if (_sp > XB_SPIN_CAP) { atomicAdd(&(bar)[XB_TMO], 1u); break; } } } } while (0)
struct XcdBarrier { unsigned* bar; unsigned x; volatile LAS unsigned* st; };
__device__ __forceinline__ XcdBarrier xcd_barrier_post(unsigned* bar, volatile LAS unsigned* st) {
    XcdBarrier b; b.bar = bar; b.x = xb_xcc_id(); b.st = st;
    if (threadIdx.x == 0) (void)xb_add(&bar[XB_XCNT(b.x)], 1u);
    return b;
}
__device__ __forceinline__ void xcd_barrier_complete(unsigned* bar, unsigned x, unsigned& nloc, unsigned& nx) {
    const unsigned G = gridDim.x * gridDim.y * gridDim.z;
    unsigned sum, cnt, mine, sp = 0u;
    for (;;) {
        sum = 0u; cnt = 0u; mine = 0u;
#pragma unroll
        for (unsigned j = 0; j < 16; ++j) { const unsigned c = xb_ld(&bar[XB_XCNT(j)]); sum += c; cnt += (c > 0u) ? 1u : 0u; mine = (j == x) ? c : mine; }
        if (sum == G) break;
        __builtin_amdgcn_s_sleep(1);
        if ((++sp & 255u) == 0u) { if (xb_ld(&bar[XB_TMO])) break; if (sp > XB_SPIN_CAP) { atomicAdd(&bar[XB_TMO], 1u); break; } }
    }
    nloc = mine > 0u ? mine : 1u; nx = cnt > 0u ? cnt : 1u;
}
__device__ __forceinline__ void xcd_barrier(const XcdBarrier& b) {
    asm volatile("s_waitcnt vmcnt(0)" ::: "memory");
    __syncthreads();
    if (threadIdx.x == 0) {
        unsigned* bar = b.bar;
        __builtin_amdgcn_s_waitcnt(0);
        unsigned nloc = b.st[0], nx = b.st[1];
        if (nloc == 0u) { xcd_barrier_complete(bar, b.x, nloc, nx); b.st[0] = nloc; b.st[1] = nx; }
        const unsigned old = xb_add(&bar[XB_XSUB(b.x)], 1u);
        const unsigned gen = old / nloc;
        if (old + 1u == (gen + 1u) * nloc) {
            __builtin_amdgcn_fence(__ATOMIC_RELEASE, "agent");
            asm volatile("s_waitcnt vmcnt(0)" ::: "memory");
            const unsigned og = xb_add(&bar[XB_TOP], 1u);
            const unsigned tg = og / nx;
            if (og + 1u == (tg + 1u) * nx) xb_add(&bar[XB_TOPGEN], 1u);
            else XB_SPIN(xb_ld(&bar[XB_TOPGEN]) == tg, bar);
            __builtin_amdgcn_fence(__ATOMIC_ACQUIRE, "agent");
            xb_add(&bar[XB_XGEN(b.x)], 1u);
            asm volatile("s_waitcnt vmcnt(0)" ::: "memory");
        } else {
            XB_SPIN(xb_ld(&bar[XB_XGEN(b.x)]) == gen, bar);
            __builtin_amdgcn_fence(__ATOMIC_ACQUIRE, "agent");
            asm volatile("s_waitcnt vmcnt(0)" ::: "memory");
        }
    }
    __syncthreads();
}

struct Args {
    const float* x_prompt; const float* x_sample; const float* w_in; const float* diff_lambda; const float* diff_subln; const float* mla_q_norm; const float* mla_w_uq;
    const float* mla_kv_norm; const float* mla_w_ukv; const float* w_out; const float* ln1_g; const float* ln1_b; const float* moe_w_coarse; const float* moe_w_fine;
    const float* moe_w1; const float* moe_w3; const float* moe_w2; const float* ln2_g; const float* ln2_b;
    float* out; unsigned char* ws; int ph_lo, ph_hi, use_bar, pad;
};
struct Frame {
    LAS unsigned char* lds; unsigned char* ldsg;
    int tid, lane, wave, G, gw, NGW, bid;
    gu32* ctl; unsigned char* ws;
};
__device__ __forceinline__ void launder(Frame& F) {
    int t = F.tid; asm volatile("" : "+v"(t)); F.tid = t; F.lane = t & 63; F.wave = __builtin_amdgcn_readfirstlane(t >> 6);
    int b = (int)blockIdx.x; asm volatile("" : "+s"(b)); F.bid = b; F.gw = b * NWAVES + F.wave;
    unsigned char* w = F.ws; asm volatile("" : "+s"(w)); F.ws = w; F.ctl = (gu32*)(w + WS_CTL);
}
struct SeqInfo { int base, len, pos; };
__device__ __forceinline__ SeqInfo seqinfo(int m) { SeqInfo s; if (m < NTOK_P) { s.base = m & ~2047; s.len = 2048; } else { s.base = m & ~4095; s.len = 4096; } s.pos = m - s.base; return s; }

template <class ColMap>
__device__ __forceinline__ void transpose_item(const float* W, int N, bf16_t* WT, int ldd, LAS float* scr, int k0, int n0, const ColMap& cm, const float* kscale, int lane) {
    const int sc = cm(n0 + (lane & 31));
#pragma unroll 8
    for (int i = 0; i < 32; ++i) { const int kk = 2 * i + (lane >> 5); float v = 0.f; if (sc >= 0) { v = W[(size_t)(k0 + kk) * N + sc]; if (kscale) v *= kscale[k0 + kk]; } scr[kk * 33 + (lane & 31)] = v; }
    LDS_WAIT(); asm volatile("" ::: "memory");
    const int c = lane & 7;
#pragma unroll
    for (int j = 0; j < 4; ++j) { const int n = (lane >> 3) + 8 * j; const LAS float* s = scr + (8 * c) * 33 + n;
        u32x4 o; o.x = pk2(s[0 * 33], s[1 * 33]); o.y = pk2(s[2 * 33], s[3 * 33]); o.z = pk2(s[4 * 33], s[5 * 33]); o.w = pk2(s[6 * 33], s[7 * 33]);
        *(u32x4*)(WT + (size_t)(n0 + n) * ldd + k0 + 8 * c) = o; }
    LDS_WAIT(); asm volatile("" ::: "memory");
}
struct WinMap {
    __device__ __forceinline__ int operator()(int n) const {
        if (n < 512) { const int t = n & 31; return (n & ~31) + (t >> 1) + 16 * (t & 1); }
        if (n < 1152) return n;
        if (n < 1184) { const int t = n - 1152; return 1152 + (t >> 1) + 16 * (t & 1); }
        if (n < 1280) return -1;
        if (n < 2048) { const int u = n - 1280, t = u & 63; return 1184 + (u & ~63) + (t >> 1) + 32 * (t & 1); }
        if (n < 2432) return 1952 + (n - 2048);
        return -1;
    }
};
struct UqMap { __device__ __forceinline__ int operator()(int n) const { if (n >= 576) return -1; const int h = n / 96, t = n - 96 * h; if (t < 64) return n; const int u = t - 64; return 96 * h + 64 + (u >> 1) + 16 * (u & 1); } };
struct IdMap { __device__ __forceinline__ int operator()(int n) const { return n; } };
struct W13Map { __device__ __forceinline__ int operator()(int n) const { return (n >> 8) * 128 + (n & 127); } };

__device__ __forceinline__ void p0_prologue(Frame& F, const Args& a) {
    LAS float* scr = (LAS float*)(F.lds + F.wave * 16384);
    { float2* r32 = (float2*)(F.ws + WS_ROPE32); float2* r64 = (float2*)(F.ws + WS_ROPE64);
      for (int i = F.gw * 64 + F.lane; i < 4096 * 16; i += F.NGW * 64) { const int pos = i >> 4, j = i & 15; const float inv = 1.0f / powf(10000.0f, (float)(2 * j) / 32.0f); const float ang = (float)pos * inv; r32[i] = make_float2(cosf(ang), sinf(ang)); }
      for (int i = F.gw * 64 + F.lane; i < 4096 * 32; i += F.NGW * 64) { const int pos = i >> 5, j = i & 31; const float inv = 1.0f / powf(10000.0f, (float)(2 * j) / 64.0f); const float ang = (float)pos * inv; r64[i] = make_float2(cosf(ang), sinf(ang)); } }
    constexpr int I_WIN = (1024 / 64) * (2560 / 32), I_WOUT = (1024 / 64) * (1024 / 32), I_UQ = (256 / 64) * (768 / 32), I_UKV = (256 / 64) * (768 / 32);
    constexpr int PER_L = I_WIN + I_WOUT + I_UQ + I_UKV;
    for (int it = F.gw; it < DEPTH * PER_L; it += F.NGW) {
        const int l = it / PER_L; int r = it - l * PER_L;
        if (r < I_WIN) { const int kb = r / 80, nb = r % 80; transpose_item(a.w_in + (size_t)l * 1024 * 2336, 2336, (bf16_t*)(F.ws + WS_WIN) + (size_t)l * 2560 * 1024, 1024, scr, kb * 64, nb * 32, WinMap(), nullptr, F.lane); continue; } r -= I_WIN;
        if (r < I_WOUT) { const int kb = r / 32, nb = r % 32; transpose_item(a.w_out + (size_t)l * 1024 * 1024, 1024, (bf16_t*)(F.ws + WS_WOUT) + (size_t)l * 1024 * 1024, 1024, scr, kb * 64, nb * 32, IdMap(), nullptr, F.lane); continue; } r -= I_WOUT;
        if (r < I_UQ) { const int kb = r / 24, nb = r % 24; transpose_item(a.mla_w_uq + (size_t)l * 256 * 576, 576, (bf16_t*)(F.ws + WS_WUQ) + (size_t)l * 768 * 256, 256, scr, kb * 64, nb * 32, UqMap(), a.mla_q_norm + l * 256, F.lane); continue; } r -= I_UQ;
        { const int kb = r / 24, nb = r % 24; bf16_t* dst = (bf16_t*)(F.ws + WS_WUKV) + (size_t)l * 768 * 256;
          if (kb < 2) transpose_item(a.mla_w_ukv + (size_t)l * 128 * 768, 768, dst, 256, scr, kb * 64, nb * 32, IdMap(), a.mla_kv_norm + l * 128, F.lane);
          else { const int c = F.lane & 7;
#pragma unroll
              for (int j = 0; j < 4; ++j) { const int n = (F.lane >> 3) + 8 * j; *(u32x4*)(dst + (size_t)(nb * 32 + n) * 256 + kb * 64 + 8 * c) = (u32x4){0u, 0u, 0u, 0u}; } } }
    }
    bf16_t* XB = (bf16_t*)(F.ws + WS_XB);
    for (int m = F.gw; m < NTOK; m += F.NGW) {
        const float* src = (m < NTOK_P) ? a.x_prompt + (size_t)m * DM : a.x_sample + (size_t)(m - NTOK_P) * DM;
#pragma unroll
        for (int j = 0; j < 4; ++j) { const f32x4 v = *((const f32x4*)src + F.lane + 64 * j); *((f32x4*)(a.out + (size_t)m * DM) + F.lane + 64 * j) = v;
            u32x2 w; w.x = pk2(v.x, v.y); w.y = pk2(v.z, v.w); *((u32x2*)(XB + (size_t)m * DM) + F.lane + 64 * j) = w; }
    }
}

template <class Epi, class RowMap>
__device__ __forceinline__ void sg_tile(const bf16_t* A, int lda, const bf16_t* B0, const bf16_t* B1, int ldb, int K, int m0, int c0, const Epi& E, const RowMap& RM, int lane) {
    const int r32 = lane & 31, hi = lane >> 5;
    const bf16_t* ap = A + (size_t)RM.src(m0 + r32) * lda + 8 * hi;
    const bf16_t* b0p = B0 + (size_t)r32 * ldb + 8 * hi;
    const bf16_t* b1p = B1 + (size_t)r32 * ldb + 8 * hi;
    f32x16 acc0 = {}, acc1 = {};
#pragma unroll 4
    for (int k = 0; k < K; k += 16) {
        const bf16x8 af = *(const bf16x8*)(ap + k), bf0 = *(const bf16x8*)(b0p + k), bf1 = *(const bf16x8*)(b1p + k);
        acc0 = MFMA32(bf0, af, acc0); acc1 = MFMA32(bf1, af, acc1);
    }
#pragma unroll
    for (int g = 0; g < 4; ++g) { const f32x4 v0 = {acc0[4 * g], acc0[4 * g + 1], acc0[4 * g + 2], acc0[4 * g + 3]}, v1 = {acc1[4 * g], acc1[4 * g + 1], acc1[4 * g + 2], acc1[4 * g + 3]};
        E.put(m0 + r32, c0, 8 * g + 4 * hi, v0, v1); }
}
struct IdRows { __device__ __forceinline__ int src(int m) const { return m; } };

__device__ __forceinline__ void store_bf8(bf16_t* p, f32x4 a, f32x4 b) { u32x4 w; w.x = pk2(a.x, a.y); w.y = pk2(a.z, a.w); w.z = pk2(b.x, b.y); w.w = pk2(b.z, b.w); *(u32x4*)p = w; }
__device__ __forceinline__ void store_bf4(bf16_t* p, f32x4 v) { u32x2 w; w.x = pk2(v.x, v.y); w.y = pk2(v.z, v.w); *(u32x2*)p = w; }
struct EpiH {
    static constexpr bool PERM = true;
    bf16_t* H; const float2* rope32; const float2* rope64;
    __device__ __forceinline__ f32x4 xf(int pos, int col, f32x4 v) const {
        if (col < 512 || (col >= HC_KROPE && col < HC_KROPE + 32)) {
            const int j0 = (col & 31) >> 1; const f32x4 cs = *(const f32x4*)(rope32 + pos * 16 + j0);
            f32x4 o; o.x = v.x * cs.x - v.y * cs.y; o.y = v.x * cs.y + v.y * cs.x; o.z = v.z * cs.z - v.w * cs.w; o.w = v.z * cs.w + v.w * cs.z;
            if (col < 256) o = o * SC_A; v = o;
        } else if (col >= HC_CQ && col < HC_CV) {
            const int j0 = ((col - HC_CQ) & 63) >> 1; const f32x4 cs = *(const f32x4*)(rope64 + pos * 32 + j0);
            f32x4 o; o.x = v.x * cs.x - v.y * cs.y; o.y = v.x * cs.y + v.y * cs.x; o.z = v.z * cs.z - v.w * cs.w; o.w = v.z * cs.w + v.w * cs.z;
            if (col < HC_CK) o = o * SC_C; v = o;
        }
        return v;
    }
    __device__ __forceinline__ void put4(int row, int col, f32x4 v) const { store_bf4(H + (size_t)row * HP + col, xf(seqinfo(row).pos, col, v)); }
    __device__ __forceinline__ void put(int row, int c0, int cc, f32x4 v0, f32x4 v1) const { put4(row, c0 + cc, v0); put4(row, c0 + 32 + cc, v1); }
    template <class U> __device__ __forceinline__ void put8(const U&, int row, int col, f32x4 v0, f32x4 v1) const { const int pos = seqinfo(row).pos; store_bf8(H + (size_t)row * HP + col, xf(pos, col, v0), xf(pos, col + 4, v1)); }
};
struct EpiUQ {
    static constexpr bool PERM = true;
    bf16_t* Q; const float* rstd; const float2* rope32;
    __device__ __forceinline__ f32x4 xf(int row, int col, f32x4 v, float rs) const {
        v = v * rs;
        const int t = col % 96;
        if (t >= 64) { const int pos = seqinfo(row).pos; const int j0 = (t - 64) >> 1; const f32x4 cs = *(const f32x4*)(rope32 + pos * 16 + j0);
            f32x4 o; o.x = v.x * cs.x - v.y * cs.y; o.y = v.x * cs.y + v.y * cs.x; o.z = v.z * cs.z - v.w * cs.w; o.w = v.z * cs.w + v.w * cs.z; v = o; }
        return v * SC_B;
    }
    __device__ __forceinline__ void put4(int row, int col, f32x4 v) const { if (col >= 576) return; store_bf4(Q + (size_t)row * QBP + col, xf(row, col, v, rstd[2 * row])); }
    template <class U> __device__ __forceinline__ void put8(const U&, int row, int col, f32x4 v0, f32x4 v1) const { if (col >= 576) return; const float rs = rstd[2 * row]; store_bf8(Q + (size_t)row * QBP + col, xf(row, col, v0, rs), xf(row, col + 4, v1, rs)); }
    __device__ __forceinline__ void put(int row, int c0, int cc, f32x4 v0, f32x4 v1) const { put4(row, c0 + cc, v0); put4(row, c0 + 32 + cc, v1); }
};
struct EpiUKV {
    static constexpr bool PERM = true;
    bf16_t* KV; const float* rstd;
    template <class U> __device__ __forceinline__ void put8(const U&, int row, int col, f32x4 v0, f32x4 v1) const { const float rs = rstd[2 * row + 1]; store_bf8(KV + (size_t)row * KVP + col, v0 * rs, v1 * rs); }
    __device__ __forceinline__ void put4(int row, int col, f32x4 v) const { store_bf4(KV + (size_t)row * KVP + col, v * rstd[2 * row + 1]); }
    __device__ __forceinline__ void put(int row, int c0, int cc, f32x4 v0, f32x4 v1) const { put4(row, c0 + cc, v0); put4(row, c0 + 32 + cc, v1); }
};
struct EpiRes {
    static constexpr bool PERM = false;
    float* X;
    template <class U> __device__ __forceinline__ void put4(const U&, int row, int col, f32x4 v) const { put4(row, col, v); }
    __device__ __forceinline__ void put4(int row, int col, f32x4 v) const { f32x4* p = (f32x4*)(X + (size_t)row * DM + col); *p = *p * DN_ALPHA + v; }
    __device__ __forceinline__ void put(int row, int c0, int cc, f32x4 v0, f32x4 v1) const { put4(row, c0 + cc, v0); put4(row, c0 + 32 + cc, v1); }
};
__device__ __forceinline__ float silu_f(float x) { return x / (1.0f + __expf(-x)); }
struct EpiHid {
    static constexpr bool PERM = true;
    bf16_t* HID;
    __device__ __forceinline__ f32x4 act(f32x4 g, f32x4 u) const { f32x4 o; o.x = silu_f(g.x) * u.x; o.y = silu_f(g.y) * u.y; o.z = silu_f(g.z) * u.z; o.w = silu_f(g.w) * u.w; return o; }
    template <class U> __device__ __forceinline__ void putp8(const U&, int row, int col, f32x4 g0, f32x4 g1, f32x4 u0, f32x4 u1) const { store_bf8(HID + (size_t)row * DEXP + col, act(g0, u0), act(g1, u1)); }
    __device__ __forceinline__ void putp(int row, int col, f32x4 g, f32x4 u) const { f32x4 o; o.x = silu_f(g.x) * u.x; o.y = silu_f(g.y) * u.y; o.z = silu_f(g.z) * u.z; o.w = silu_f(g.w) * u.w; store_bf4(HID + (size_t)row * DEXP + col, o); }
    __device__ __forceinline__ void put(int row, int c0, int cc, f32x4 v0, f32x4 v1) const { putp(row, c0 + cc, v0, v1); }
};
struct EpiY {
    bf16_t* YB; const float* tw; const int* list; int seg0, cnt;
    __device__ __forceinline__ void put4(int row, int col, f32x4 v) const { const int r = row - seg0; if (r >= cnt) return; const int a = list[r]; store_bf4(YB + (size_t)a * DM + col, v * tw[a]); }
    __device__ __forceinline__ void put(int row, int c0, int cc, f32x4 v0, f32x4 v1) const { put4(row, c0 + cc, v0); put4(row, c0 + 32 + cc, v1); }
};

struct EpiYO {
    static constexpr bool PERM = true;
    bf16_t* YB; const float* tw; const int* list; const LAS int* seg;
    template <class U> __device__ __forceinline__ void put8(const U& u, int row, int col, f32x4 v0, f32x4 v1) const {
        const int r = row - __builtin_amdgcn_readfirstlane(seg[u.e]); if (r >= __builtin_amdgcn_readfirstlane(seg[33 + u.e])) return; const int a = list[(size_t)u.e * LIST_CAP + r]; const float w = tw[a]; store_bf8(YB + (size_t)a * DM + col, v0 * w, v1 * w); }
};
template <class Epi>
__device__ __forceinline__ void sg_phase(Frame& F, const bf16_t* A, int lda, const bf16_t* Bt, int ldb, int M, int N, int K, const Epi& E) {
    const int nN = N / 64, items = (M / 32) * nN;
    for (int it = F.gw; it < items; it += F.NGW) { const int mt = it / nN, nt = it - mt * nN;
        sg_tile(A, lda, Bt + (size_t)(nt * 64) * ldb, Bt + (size_t)(nt * 64 + 32) * ldb, ldb, K, mt * 32, nt * 64, E, IdRows(), F.lane); }
}


namespace pg8 {
constexpr int BM = 256, BK = 64, HALF = 128, HTB = HALF * BK * 2, NXCD = 8, WGM = 8;
__host__ __device__ __forceinline__ int lds_byte(int r, int c) { const int st = (r >> 4) * 2 + (c >> 5), rr = r & 15, cc = c & 31, ob = rr * 64 + cc * 2; return st * 1024 + (ob ^ (((ob >> 9) & 1) << 5)); }
__host__ __device__ __forceinline__ void stage_rc(int b, int& R, int& C) { const int st = b / 1024, sb = b % 1024, swz = sb ^ (((sb >> 9) & 1) << 5); R = (st >> 1) * 16 + swz / 64; C = (st & 1) * 32 + (swz % 64) / 2; }
__host__ __device__ __forceinline__ int perm32(int rho) { const int n = rho >> 4, i = rho & 15; return 8 * (i >> 2) + 4 * n + (i & 3); }
struct Unit { int pm, pn, e; const char* a; const char* b; };
__device__ __forceinline__ bool order_next(int i, int G, int c, int nM, int nN, int& pm, int& pn) {
    const int nwg = nM * nN; const long L = (long)i * G + c; if (L >= nwg) return false;
    int wgid = (int)L; { const int q = nwg / NXCD, r = nwg % NXCD, xcd = wgid % NXCD, off = wgid / NXCD; wgid = (xcd < r ? xcd * (q + 1) : r * (q + 1) + (xcd - r) * q) + off; }
    const int nig = WGM * nN, gid = wgid / nig, fm = gid * WGM, gsz = (nM - fm) < WGM ? (nM - fm) : WGM;
    pm = fm + ((wgid % nig) % gsz); pn = (wgid % nig) / gsz; return true;
}
struct DenseSched {
    const char* A; const char* Bt; int nM, nN, G, c; size_t tstepA, tstepB;
    __device__ __forceinline__ void init(const bf16_t* A_, int lda, const bf16_t* Bt_, int M, int N, int K, int G_, int c_) { A = (const char*)A_; Bt = (const char*)Bt_; nM = M / BM; nN = N / BM; G = G_; c = c_; tstepA = (size_t)BM * lda * 2; tstepB = (size_t)BM * K * 2; }
    __device__ __forceinline__ bool next(int i, Unit& u) const { if (!order_next(i, G, c, nM, nN, u.pm, u.pn)) return false; u.e = 0; u.a = A + (size_t)u.pm * tstepA; u.b = Bt + (size_t)u.pn * tstepB; return true; }
    __device__ __forceinline__ unsigned arow(const Unit&, int) const { return 0u; }
};
template <class Epi, bool PAIR> struct EpiApply;
template <class Epi, class Sched, bool GATHER, bool PAIR>
__device__ __forceinline__ void gemm_phase(LAS unsigned char* lds, int tid, int K, int lda, const Sched& S, const Epi& E) {
    const int wid = __builtin_amdgcn_readfirstlane(tid >> 6), lane = tid & 63, wr = wid >> 2, wc = wid & 3, fr = lane & 15, fq = lane >> 4;
    const int nt = K / BK;
    unsigned voffA[2], voffB[2]; int RA[2], CA[2];
#pragma unroll
    for (int i = 0; i < 2; ++i) { int R, C; stage_rc(tid * 16 + i * 8192, R, C); const int Rb = Epi::PERM ? ((R & ~31) + perm32(R & 31)) : R; RA[i] = R; CA[i] = C;
        voffA[i] = (unsigned)(R * lda + C) * 2u; voffB[i] = (unsigned)(Rb * K + C) * 2u; }
    const size_t kstep = (size_t)(BK * 2);
    const size_t hstepA = (size_t)HALF * lda * 2, hstepB = (size_t)HALF * K * 2;
    const unsigned ldsw = (unsigned)wid * 1024u;
    const int aoff = lds_byte(wr * 64 + fr, fq * 8), boff = lds_byte(wc * 32 + fr, fq * 8);
#define PG8_SA(b, h) (((b) * 2 + (h)) * HTB)
#define PG8_SB(b, h) ((4 + (b) * 2 + (h)) * HTB)
#define PG8_STAGE(bufoff, gbase, voff) do { _Pragma("unroll") for (int _i = 0; _i < 2; ++_i) \
        __builtin_amdgcn_global_load_lds((const unsigned*)((const char*)(gbase) + (voff)[_i]), (LAS unsigned*)(lds + (bufoff) + ldsw + _i * 8192), 16, 0, 0); } while (0)
#define PG8_STAGE_A(bufoff, ab, vg, h, koff) do { if (GATHER) { PG8_STAGE(bufoff, (ab) + (koff), (vg)[h]); } else { PG8_STAGE(bufoff, (ab) + (h) * hstepA + (koff), voffA); } } while (0)
#define PG8_LDA(dst, b, h) do { _Pragma("unroll") for (int m = 0; m < 4; ++m) _Pragma("unroll") for (int k = 0; k < 2; ++k) dst[m][k] = *(const LAS bf16x8*)(lds + PG8_SA(b, h) + aoff + m * 2048 + k * 1024); } while (0)
#define PG8_LDB(dst, b, h) do { _Pragma("unroll") for (int n = 0; n < 2; ++n) _Pragma("unroll") for (int k = 0; k < 2; ++k) dst[n][k] = *(const LAS bf16x8*)(lds + PG8_SB(b, h) + boff + n * 2048 + k * 1024); } while (0)
#define PG8_MMA(ai, bj, At, Bt) do { __builtin_amdgcn_s_setprio(1); _Pragma("unroll") for (int m = 0; m < 4; ++m) _Pragma("unroll") for (int n = 0; n < 2; ++n) _Pragma("unroll") for (int k = 0; k < 2; ++k) \
        acc[ai][bj][m][n] = __builtin_amdgcn_mfma_f32_16x16x32_bf16(Bt[n][k], At[m][k], acc[ai][bj][m][n], 0, 0, 0); __builtin_amdgcn_s_setprio(0); } while (0)
#define PG8_WAIT_V(n) asm volatile("s_waitcnt vmcnt(" #n ")" ::: "memory")
#define PG8_WAIT_L(n) asm volatile("s_waitcnt lgkmcnt(" #n ")" ::: "memory")
#define PG8_BAR __builtin_amdgcn_s_barrier()
#define PG8_SCHED __builtin_amdgcn_sched_barrier(0)
    Unit cur, nxt; int ui = 0;
    if (!S.next(0, cur)) return;
    f32x4 acc[2][2][4][2];
#pragma unroll
    for (int a = 0; a < 2; ++a)
#pragma unroll
        for (int b = 0; b < 2; ++b)
#pragma unroll
            for (int m = 0; m < 4; ++m)
#pragma unroll
                for (int n = 0; n < 2; ++n) acc[a][b][m][n] = (f32x4){0.f, 0.f, 0.f, 0.f};
    bf16x8 At[4][2], B0[2][2], B1[2][2];
    unsigned vgc[2][2] = {{0u, 0u}, {0u, 0u}}, vgn[2][2] = {{0u, 0u}, {0u, 0u}};
    if (GATHER) {
#pragma unroll
        for (int h = 0; h < 2; ++h)
#pragma unroll
            for (int i = 0; i < 2; ++i) vgc[h][i] = S.arow(cur, h * HALF + RA[i]) * (unsigned)(lda * 2) + (unsigned)CA[i] * 2u;
    }
    const char* cA = cur.a; const char* cB = cur.b;
    PG8_STAGE(PG8_SB(0, 0), cB, voffB); PG8_STAGE(PG8_SB(0, 1), cB + hstepB, voffB); PG8_STAGE_A(PG8_SA(0, 0), cA, vgc, 0, 0); PG8_STAGE_A(PG8_SA(0, 1), cA, vgc, 1, 0);
    if (wr == 1) PG8_BAR;
    PG8_WAIT_V(2); PG8_BAR;
    PG8_STAGE(PG8_SB(1, 0), cB + kstep, voffB); PG8_STAGE_A(PG8_SA(1, 0), cA, vgc, 0, kstep); PG8_STAGE(PG8_SB(1, 1), cB + hstepB + kstep, voffB);
    PG8_WAIT_V(6); PG8_BAR;
    for (;;) {
        const bool has_next = S.next(ui + 1, nxt);
        const char* nA = has_next ? nxt.a : cA; const char* nB = has_next ? nxt.b : cB;
        if (GATHER) {
#pragma unroll
            for (int h = 0; h < 2; ++h)
#pragma unroll
                for (int i = 0; i < 2; ++i) vgn[h][i] = has_next ? (S.arow(nxt, h * HALF + RA[i]) * (unsigned)(lda * 2) + (unsigned)CA[i] * 2u) : vgc[h][i];
        }
#pragma clang loop unroll(disable)
        for (int t = 0; t < nt; t += 2) {
            const bool last = (t == nt - 2);
            const size_t k1 = (size_t)(t + 1) * kstep;
            const char* a2 = last ? nA : cA; const char* b2 = last ? nB : cB + (size_t)(t + 2) * kstep; const size_t ka2 = last ? 0 : (size_t)(t + 2) * kstep;
            const char* b3 = b2 + kstep; const size_t ka3 = ka2 + kstep;
            unsigned v2[2][2];
#pragma unroll
            for (int h = 0; h < 2; ++h)
#pragma unroll
                for (int i = 0; i < 2; ++i) v2[h][i] = last ? vgn[h][i] : vgc[h][i];
            PG8_LDB(B0, 0, 0); PG8_LDB(B1, 0, 1); PG8_SCHED; PG8_LDA(At, 0, 0); PG8_STAGE_A(PG8_SA(1, 1), cA, vgc, 1, k1);
            PG8_WAIT_V(8); PG8_WAIT_L(0); PG8_BAR; PG8_MMA(0, 0, At, B0); PG8_MMA(0, 1, At, B1); PG8_BAR; PG8_SCHED;
            PG8_LDA(At, 0, 1); PG8_STAGE(PG8_SB(0, 0), b2, voffB); PG8_STAGE(PG8_SB(0, 1), b2 + hstepB, voffB); PG8_STAGE_A(PG8_SA(0, 0), a2, v2, 0, ka2);
            PG8_WAIT_V(8); PG8_WAIT_L(0); PG8_BAR; PG8_MMA(1, 0, At, B0); PG8_MMA(1, 1, At, B1); PG8_BAR; PG8_SCHED;
            PG8_LDB(B0, 1, 0); PG8_LDB(B1, 1, 1); PG8_SCHED; PG8_LDA(At, 1, 0); PG8_STAGE_A(PG8_SA(0, 1), a2, v2, 1, ka2);
            PG8_WAIT_V(8); PG8_WAIT_L(0); PG8_BAR; PG8_MMA(0, 0, At, B0); PG8_MMA(0, 1, At, B1); PG8_BAR; PG8_SCHED;
            PG8_LDA(At, 1, 1); PG8_STAGE(PG8_SB(1, 0), b3, voffB); PG8_STAGE(PG8_SB(1, 1), b3 + hstepB, voffB); PG8_STAGE_A(PG8_SA(1, 0), a2, v2, 0, ka3);
            PG8_WAIT_V(8); PG8_WAIT_L(0); PG8_BAR; PG8_MMA(1, 0, At, B0); PG8_MMA(1, 1, At, B1); PG8_BAR; PG8_SCHED;
        }
        if (wr == 0) PG8_BAR;
        { int fr_ = fr, fq_ = fq; asm volatile("" : "+v"(fr_), "+v"(fq_));
          EpiApply<Epi, PAIR>::run(E, acc, cur, wr, wc, fr_, fq_); }
        if (!has_next) break;
#pragma unroll
        for (int a = 0; a < 2; ++a)
#pragma unroll
            for (int b = 0; b < 2; ++b)
#pragma unroll
                for (int m = 0; m < 4; ++m)
#pragma unroll
                    for (int n = 0; n < 2; ++n) acc[a][b][m][n] = (f32x4){0.f, 0.f, 0.f, 0.f};
        cur = nxt; cA = nA; cB = nB; ++ui;
        if (GATHER) {
#pragma unroll
            for (int h = 0; h < 2; ++h)
#pragma unroll
                for (int i = 0; i < 2; ++i) vgc[h][i] = vgn[h][i];
        }
        if (wr == 1) PG8_BAR;
    }
    PG8_WAIT_V(0);
    PG8_BAR;
#undef PG8_SA
#undef PG8_SB
#undef PG8_STAGE
#undef PG8_STAGE_A
#undef PG8_LDA
#undef PG8_LDB
#undef PG8_MMA
#undef PG8_WAIT_V
#undef PG8_WAIT_L
#undef PG8_BAR
#undef PG8_SCHED
}
template <class Epi> struct EpiApply<Epi, false> {
    static __device__ __forceinline__ void run(const Epi& E, const f32x4 (&acc)[2][2][4][2], const Unit& u, int wr, int wc, int fr, int fq) {
#pragma unroll
        for (int ai = 0; ai < 2; ++ai)
#pragma unroll
            for (int m = 0; m < 4; ++m) { const int row = u.pm * BM + ai * HALF + wr * 64 + m * 16 + fr;
#pragma unroll
                for (int bj = 0; bj < 2; ++bj) {
                    if constexpr (Epi::PERM) E.put8(u, row, u.pn * BM + bj * HALF + wc * 32 + 8 * fq, acc[ai][bj][m][0], acc[ai][bj][m][1]);
                    else { E.put4(u, row, u.pn * BM + bj * HALF + wc * 32 + 4 * fq, acc[ai][bj][m][0]); E.put4(u, row, u.pn * BM + bj * HALF + wc * 32 + 16 + 4 * fq, acc[ai][bj][m][1]); } }
                asm volatile("" ::: "memory"); }
    }
};
template <class Epi> struct EpiApply<Epi, true> {
    static __device__ __forceinline__ void run(const Epi& E, const f32x4 (&acc)[2][2][4][2], const Unit& u, int wr, int wc, int fr, int fq) {
#pragma unroll
        for (int ai = 0; ai < 2; ++ai)
#pragma unroll
            for (int m = 0; m < 4; ++m) { const int row = u.pm * BM + ai * HALF + wr * 64 + m * 16 + fr;
                E.putp8(u, row, u.pn * HALF + wc * 32 + 8 * fq, acc[ai][0][m][0], acc[ai][0][m][1], acc[ai][1][m][0], acc[ai][1][m][1]); asm volatile("" ::: "memory"); }
    }
};
}

__device__ __forceinline__ void rowstat_pass(Frame& F) {
    const bf16_t* H = (const bf16_t*)(F.ws + WS_H); float* rstd = (float*)(F.ws + WS_RSTD);
    for (int m = F.gw; m < NTOK; m += F.NGW) {
        const bf16_t* hr = H + (size_t)m * HP;
        const u32x2 q = *((const u32x2*)(hr + HC_CQ_LAT) + F.lane);
        const unsigned kv = *((const unsigned*)(hr + HC_CKV) + F.lane);
        float a0 = bf2f(q.x & 0xffff), a1 = bf2f(q.x >> 16), a2 = bf2f(q.y & 0xffff), a3 = bf2f(q.y >> 16), b0 = bf2f(kv & 0xffff), b1 = bf2f(kv >> 16);
        const float sq = wave_sum(a0 * a0 + a1 * a1 + a2 * a2 + a3 * a3), sk = wave_sum(b0 * b0 + b1 * b1);
        if (F.lane == 0) { rstd[2 * m] = 1.0f / sqrtf(sq * (1.0f / 256.0f) + RMS_EPS); rstd[2 * m + 1] = 1.0f / sqrtf(sk * (1.0f / 128.0f) + RMS_EPS); }
    }
}
__device__ __forceinline__ void ln1_route_pass(Frame& F, const Args& a, int layer) {
    bf16_t* XB = (bf16_t*)(F.ws + WS_XB); float* tw = (float*)(F.ws + WS_TW); int* list = (int*)(F.ws + WS_LIST);
    const float* g = a.ln1_g + layer * DM; const float* bb = a.ln1_b + layer * DM;
    const float* wc = a.moe_w_coarse + (size_t)layer * DM * 4; const float* wf = a.moe_w_fine + (size_t)layer * 4 * DM * 8;
    for (int m = F.gw; m < NTOK; m += F.NGW) {
        float* xr = a.out + (size_t)m * DM;
        f32x4 v[4]; float s = 0.f;
#pragma unroll
        for (int j = 0; j < 4; ++j) { v[j] = *((const f32x4*)xr + F.lane + 64 * j); s += (v[j].x + v[j].y) + (v[j].z + v[j].w); }
        const float mean = wave_sum(s) * (1.f / DM); float s2 = 0.f;
#pragma unroll
        for (int j = 0; j < 4; ++j) { v[j] = v[j] - mean; s2 += (v[j].x * v[j].x + v[j].y * v[j].y) + (v[j].z * v[j].z + v[j].w * v[j].w); }
        const float rs = 1.f / sqrtf(wave_sum(s2) * (1.f / DM) + LN_EPS);
        float cl[4] = {0.f, 0.f, 0.f, 0.f};
#pragma unroll
        for (int j = 0; j < 4; ++j) { const int c = 4 * F.lane + 256 * j; const f32x4 gg = *(const f32x4*)(g + c), bv = *(const f32x4*)(bb + c); v[j] = v[j] * rs * gg + bv;
            *((f32x4*)xr + F.lane + 64 * j) = v[j]; u32x2 w; w.x = pk2(v[j].x, v[j].y); w.y = pk2(v[j].z, v[j].w); *((u32x2*)(XB + (size_t)m * DM) + F.lane + 64 * j) = w;
#pragma unroll
            for (int e = 0; e < 4; ++e) { const f32x4 w4 = *(const f32x4*)(wc + (size_t)(c + e) * 4); const float xe = v[j][e]; cl[0] += xe * w4.x; cl[1] += xe * w4.y; cl[2] += xe * w4.z; cl[3] += xe * w4.w; } }
#pragma unroll
        for (int e = 0; e < 4; ++e) cl[e] = wave_sum(cl[e]);
        int grp = 0; float cm = cl[0];
#pragma unroll
        for (int e = 1; e < 4; ++e) if (cl[e] > cm) { cm = cl[e]; grp = e; }
        float den = 0.f;
#pragma unroll
        for (int e = 0; e < 4; ++e) den += __expf(cl[e] - cm);
        const float pg = 1.0f / den;
        const float* wfg = wf + (size_t)grp * DM * 8;
        float fl[8] = {0.f, 0.f, 0.f, 0.f, 0.f, 0.f, 0.f, 0.f};
#pragma unroll
        for (int j = 0; j < 4; ++j) { const int c = 4 * F.lane + 256 * j;
#pragma unroll
            for (int e = 0; e < 4; ++e) { const f32x4 wa = *(const f32x4*)(wfg + (size_t)(c + e) * 8), wb = *(const f32x4*)(wfg + (size_t)(c + e) * 8 + 4); const float xe = v[j][e];
                fl[0] += xe * wa.x; fl[1] += xe * wa.y; fl[2] += xe * wa.z; fl[3] += xe * wa.w; fl[4] += xe * wb.x; fl[5] += xe * wb.y; fl[6] += xe * wb.z; fl[7] += xe * wb.w; } }
#pragma unroll
        for (int e = 0; e < 8; ++e) fl[e] = wave_sum(fl[e]);
        int i0 = 0; float v0 = fl[0];
#pragma unroll
        for (int e = 1; e < 8; ++e) if (fl[e] > v0) { v0 = fl[e]; i0 = e; }
        int i1 = -1; float v1 = -3.0e38f;
#pragma unroll
        for (int e = 0; e < 8; ++e) if (e != i0 && fl[e] > v1) { v1 = fl[e]; i1 = e; }
        const float e1 = __expf(v1 - v0), w0 = pg / (1.0f + e1), w1 = pg * e1 / (1.0f + e1);
        if (F.lane < 2) { const int e = grp * 8 + (F.lane == 0 ? i0 : i1); const int a_id = 2 * m + F.lane;
            const unsigned pos = __hip_atomic_fetch_add(F.ctl + CW_CNT + layer * 64 + e, 1u, RLX_AGENT);
            list[(size_t)e * LIST_CAP + pos] = a_id; tw[a_id] = (F.lane == 0) ? w0 : w1; }
    }
}
__device__ __forceinline__ void ln2_pass(Frame& F, const Args& a, int layer) {
    bf16_t* XB = (bf16_t*)(F.ws + WS_XB); const bf16_t* YB = (const bf16_t*)(F.ws + WS_YB);
    const float* g = a.ln2_g + layer * DM; const float* bb = a.ln2_b + layer * DM;
    for (int m = F.gw; m < NTOK; m += F.NGW) {
        float* xr = a.out + (size_t)m * DM; const bf16_t* y0 = YB + (size_t)(2 * m) * DM; const bf16_t* y1 = y0 + DM;
        f32x4 v[4]; float s = 0.f;
#pragma unroll
        for (int j = 0; j < 4; ++j) { v[j] = *((const f32x4*)xr + F.lane + 64 * j) * DN_ALPHA; const u32x2 p = *((const u32x2*)y0 + F.lane + 64 * j), q = *((const u32x2*)y1 + F.lane + 64 * j);
            v[j].x += bf2f(p.x & 0xffff) + bf2f(q.x & 0xffff); v[j].y += bf2f(p.x >> 16) + bf2f(q.x >> 16); v[j].z += bf2f(p.y & 0xffff) + bf2f(q.y & 0xffff); v[j].w += bf2f(p.y >> 16) + bf2f(q.y >> 16);
            s += (v[j].x + v[j].y) + (v[j].z + v[j].w); }
        const float mean = wave_sum(s) * (1.f / DM); float s2 = 0.f;
#pragma unroll
        for (int j = 0; j < 4; ++j) { v[j] = v[j] - mean; s2 += (v[j].x * v[j].x + v[j].y * v[j].y) + (v[j].z * v[j].z + v[j].w * v[j].w); }
        const float rs = 1.f / sqrtf(wave_sum(s2) * (1.f / DM) + LN_EPS);
#pragma unroll
        for (int j = 0; j < 4; ++j) { const int c = 4 * F.lane + 256 * j; const f32x4 gg = *(const f32x4*)(g + c), bv = *(const f32x4*)(bb + c); v[j] = v[j] * rs * gg + bv;
            *((f32x4*)xr + F.lane + 64 * j) = v[j]; u32x2 w; w.x = pk2(v[j].x, v[j].y); w.y = pk2(v[j].z, v[j].w); *((u32x2*)(XB + (size_t)m * DM) + F.lane + 64 * j) = w; }
    }
}
__device__ __forceinline__ void moe_convert(Frame& F, const Args& a, int layer) {
    LAS float* scr = (LAS float*)(F.lds + F.wave * 16384);
    constexpr int I_13 = (1024 / 64) * (1024 / 32), I_2 = (512 / 64) * (1024 / 32), PER_E = I_13 + I_2;
    for (int it = F.gw; it < NEXP * PER_E; it += F.NGW) {
        const int e = it / PER_E; int r = it - e * PER_E; const size_t le = (size_t)layer * NEXP + e;
        if (r < I_13) { const int kb = r / 32, nb = r % 32; const float* src = ((nb >> 2) & 1) ? a.moe_w3 : a.moe_w1;
            transpose_item(src + le * 1024 * 512, 512, (bf16_t*)(F.ws + WS_W13) + (size_t)e * 1024 * 1024, 1024, scr, kb * 64, nb * 32, W13Map(), nullptr, F.lane); }
        else { r -= I_13; const int kb = r / 32, nb = r % 32; transpose_item(a.moe_w2 + le * 512 * 1024, 1024, (bf16_t*)(F.ws + WS_W2) + (size_t)e * 1024 * 512, 512, scr, kb * 64, nb * 32, IdMap(), nullptr, F.lane); }
    }
}

struct RowSrc { const bf16_t* p; long pitch; };
constexpr int SA_P = 0, SA_V = 4096, SA_AL = 12288, SA_RL = 12544;
template <int NC0, int NC1, int MODE>
__device__ __forceinline__ void sattn_core(const bf16x8* qf, RowSrc k0, RowSrc k1, RowSrc vs, int kb_lo, int kb_hi, int qidx0, float lse_ref, LAS unsigned char* scr, int lane, f32x16* o, float& lse_out) {
    const int r32 = lane & 31, hi = lane >> 5;
    LAS bf16_t* Pb = (LAS bf16_t*)(scr + SA_P); LAS bf16_t* Vb = (LAS bf16_t*)(scr + SA_V); LAS float* Al = (LAS float*)(scr + SA_AL);
    float m = -1.0e30f, l = 0.f;
    if (MODE != 1) { o[0] = f32x16{}; o[1] = f32x16{}; }
    for (int kb = kb_lo; kb < kb_hi; ++kb) {
        const long key = (long)kb * 32 + r32;
        f32x16 s = {};
#pragma unroll
        for (int c = 0; c < NC0; ++c) { const bf16x8 kf = *(const bf16x8*)(k0.p + key * k0.pitch + 16 * c + 8 * hi); s = MFMA32(kf, qf[c], s); }
#pragma unroll
        for (int c = 0; c < NC1; ++c) { const bf16x8 kf = *(const bf16x8*)(k1.p + key * k1.pitch + 16 * c + 8 * hi); s = MFMA32(kf, qf[NC0 + c], s); }
        bool valid[16];
#pragma unroll
        for (int r = 0; r < 16; ++r) { if (MODE == 0) valid[r] = true; else { const int d = kb * 32 + crow(r, hi) - (qidx0 + r32); valid[r] = (d <= 64 && d >= -64); } }
        float p[16];
        if (MODE == 2) {
#pragma unroll
            for (int r = 0; r < 16; ++r) p[r] = valid[r] ? fast_exp2(s[r] - lse_ref) : 0.f;
        } else {
            float mx = -1.0e30f;
#pragma unroll
            for (int r = 0; r < 16; ++r) if (valid[r]) mx = fmaxf(mx, s[r]);
            mx = fmaxf(mx, __shfl_xor(mx, 32));
            const float mn = fmaxf(m, mx), alpha = fast_exp2(m - mn); m = mn;
            float ps = 0.f;
#pragma unroll
            for (int r = 0; r < 16; ++r) { p[r] = valid[r] ? fast_exp2(s[r] - mn) : 0.f; ps += p[r]; }
            l = l * alpha + ps;
            if (MODE == 0) { if (hi == 0) Al[r32] = alpha; }
        }
        if (MODE != 1) {
#pragma unroll
            for (int g = 0; g < 4; ++g) { u32x2 w; w.x = pk2(p[4 * g], p[4 * g + 1]); w.y = pk2(p[4 * g + 2], p[4 * g + 3]); *(LAS u32x2*)(Pb + r32 * 40 + 8 * g + 4 * hi) = w; }
#pragma unroll
            for (int i = 0; i < 4; ++i) { const int idx = i * 64 + lane, kr = idx >> 3, pc = idx & 7; *(LAS u32x4*)(Vb + kr * 72 + pc * 8) = *(const u32x4*)(vs.p + ((long)kb * 32 + kr) * vs.pitch + pc * 8); }
            LDS_WAIT();
            if (MODE == 0) {
#pragma unroll
                for (int r = 0; r < 16; ++r) { const float al = Al[crow(r, hi)]; o[0][r] *= al; o[1][r] *= al; }
            }
#pragma unroll
            for (int st = 0; st < 2; ++st) {
                const bf16x8 pf = *(const LAS bf16x8*)(Pb + r32 * 40 + 16 * st + 8 * hi);
#pragma unroll
                for (int db = 0; db < 2; ++db) { bf16x8 vf;
#pragma unroll
                    for (int j = 0; j < 8; ++j) vf[j] = (short)Vb[(16 * st + 8 * hi + j) * 72 + 32 * db + r32];
                    o[db] = MFMA32(pf, vf, o[db]); }
            }
            LDS_WAIT();
        }
    }
    if (MODE != 2) { l += __shfl_xor(l, 32); lse_out = m + __log2f(l); }
    if (MODE == 0) {
        LAS float* Rl = (LAS float*)(scr + SA_RL);
        if (hi == 0) Rl[r32] = 1.0f / l;
        LDS_WAIT();
#pragma unroll
        for (int r = 0; r < 16; ++r) { const float rl = Rl[crow(r, hi)]; o[0][r] *= rl; o[1][r] *= rl; }
        LDS_WAIT();
    }
}

__device__ __forceinline__ void sattn_phase(Frame& F, const Args& a, int layer, int kind_lo) {
    const bf16_t* H = (const bf16_t*)(F.ws + WS_H); const bf16_t* QB = (const bf16_t*)(F.ws + WS_QB); const bf16_t* KVB = (const bf16_t*)(F.ws + WS_KVB);
    bf16_t* MIX = (bf16_t*)(F.ws + WS_MIX); const float* lsec = (const float*)(F.ws + WS_LSEC);
    LAS unsigned char* scr = F.lds + F.wave * 16384;
    const int lane = F.lane, r32 = lane & 31, hi = lane >> 5;
    float lam, lam_init;
    { const float* lv = a.diff_lambda + layer * 128; float d1 = 0.f, d2 = 0.f;
      for (int i = 0; i < 32; ++i) { d1 += lv[i] * lv[32 + i]; d2 += lv[64 + i] * lv[96 + i]; }
      lam_init = 0.8f - 0.6f * expf(-0.3f * (float)layer); lam = expf(d1) - expf(d2) + lam_init; }
    constexpr int NRB = NTOK / 32;
    const int items = NRB * (4 + 6 + 6);
    for (int it = kind_lo * NRB + F.gw; it < items; it += F.NGW) {
        const int kind = it / NRB, rb = it - kind * NRB; const int m0 = rb * 32; const SeqInfo si = seqinfo(m0);
        if (kind < 4) {
            const int h = kind; f32x16 o0[2], o1[2]; float dummy;
            for (int c = 0; c < 2; ++c) {
                bf16x8 qf[2];
#pragma unroll
                for (int d0 = 0; d0 < 2; ++d0) qf[d0] = *(const bf16x8*)(H + (size_t)(m0 + r32) * HP + HC_AQ + h * 64 + c * 32 + 16 * d0 + 8 * hi);
                const RowSrc ks{H + (size_t)si.base * HP + HC_AK + h * 64 + c * 32, HP}, vs{H + (size_t)si.base * HP + HC_AV + h * 64, HP};
                sattn_core<2, 0, 0>(qf, ks, ks, vs, 0, si.len / 32, 0, 0.f, scr, lane, c == 0 ? o0 : o1, dummy);
            }
            const float* sg = a.diff_subln + layer * 64; const float g0 = sg[r32], g1 = sg[32 + r32];
#pragma unroll
            for (int r = 0; r < 16; ++r) { const float x0 = o0[0][r] - lam * o1[0][r], x1 = o0[1][r] - lam * o1[1][r]; float ss = x0 * x0 + x1 * x1;
                ss += __shfl_xor(ss, 1); ss += __shfl_xor(ss, 2); ss += __shfl_xor(ss, 4); ss += __shfl_xor(ss, 8); ss += __shfl_xor(ss, 16);
                const float rs = (1.0f - lam_init) / sqrtf(ss * (1.0f / 64.0f) + RMS_EPS);
                bf16_t* op = MIX + (size_t)(m0 + crow(r, hi)) * DM + MIX_A + h * 64 + r32;
                op[0] = (bf16_t)f2bf(x0 * rs * g0); op[32] = (bf16_t)f2bf(x1 * rs * g1); }
        } else if (kind < 10) {
            const int h = kind - 4; f32x16 o[2]; float dummy; bf16x8 qf[6];
#pragma unroll
            for (int d0 = 0; d0 < 6; ++d0) qf[d0] = *(const bf16x8*)(QB + (size_t)(m0 + r32) * QBP + h * 96 + 16 * d0 + 8 * hi);
            const RowSrc k0{KVB + (size_t)si.base * KVP + h * 128, KVP}, k1{H + (size_t)si.base * HP + HC_KROPE, HP}, vs{KVB + (size_t)si.base * KVP + h * 128 + 64, KVP};
            sattn_core<4, 2, 0>(qf, k0, k1, vs, 0, si.len / 32, 0, 0.f, scr, lane, o, dummy);
#pragma unroll
            for (int r = 0; r < 16; ++r) { bf16_t* op = MIX + (size_t)(m0 + crow(r, hi)) * DM + MIX_B + h * 64 + r32; op[0] = (bf16_t)f2bf(o[0][r]); op[32] = (bf16_t)f2bf(o[1][r]); }
        } else {
            const int gj = kind - 10, g = gj >> 1, hh = gj;
            const int dil = (g == 0) ? 1 : (g == 1 ? 4 : 16); const int L = si.len / dil, bpr = L / 32;
            const int w = (m0 - si.base) / 32, rho = w / bpr, ib = w - rho * bpr, i0 = ib * 32;
            const size_t qrow = (size_t)si.base + (size_t)(i0 + r32) * dil + rho;
            bf16x8 qf[4];
#pragma unroll
            for (int d0 = 0; d0 < 4; ++d0) qf[d0] = *(const bf16x8*)(H + qrow * HP + HC_CQ + hh * 64 + 16 * d0 + 8 * hi);
            const int j = gj & 1; const float l0 = lsec[(0 * (size_t)NTOK + qrow) * 2 + j], l1 = lsec[(1 * (size_t)NTOK + qrow) * 2 + j], l2 = lsec[(2 * (size_t)NTOK + qrow) * 2 + j];
            const float lm = fmaxf(l0, fmaxf(l1, l2)); const float lref = lm + __log2f(fast_exp2(l0 - lm) + fast_exp2(l1 - lm) + fast_exp2(l2 - lm));
            const RowSrc ks{H + ((size_t)si.base + rho) * HP + HC_CK + hh * 64, (long)HP * dil}, vs{H + ((size_t)si.base + rho) * HP + HC_CV + hh * 64, (long)HP * dil};
            int kb_lo = ib - 2, kb_hi = ib + 3; if (kb_lo < 0) kb_lo = 0; if (kb_hi > bpr) kb_hi = bpr;
            f32x16 o[2]; float dummy;
            sattn_core<4, 0, 2>(qf, ks, ks, vs, kb_lo, kb_hi, i0, lref, scr, lane, o, dummy);
#pragma unroll
            for (int r = 0; r < 16; ++r) { const size_t orow = (size_t)si.base + (size_t)(i0 + crow(r, hi)) * dil + rho; bf16_t* op = MIX + orow * DM + MIX_C + hh * 64 + r32; op[0] = (bf16_t)f2bf(o[0][r]); op[32] = (bf16_t)f2bf(o[1][r]); }
        }
    }
}
__device__ __forceinline__ void cstat_phase(Frame& F) {
    const bf16_t* H = (const bf16_t*)(F.ws + WS_H); float* lsec = (float*)(F.ws + WS_LSEC);
    LAS unsigned char* scr = F.lds + F.wave * 16384;
    const int lane = F.lane, r32 = lane & 31, hi = lane >> 5;
    constexpr int NRB = NTOK / 32;
    for (int it = F.gw; it < NRB * 6; it += F.NGW) {
        const int gj = it / NRB, rb = it - gj * NRB, g = gj >> 1, j = gj & 1; const int m0 = rb * 32; const SeqInfo si = seqinfo(m0);
        const int dil = (g == 0) ? 1 : (g == 1 ? 4 : 16); const int L = si.len / dil, bpr = L / 32;
        const int w = (m0 - si.base) / 32, rho = w / bpr, ib = w - rho * bpr, i0 = ib * 32;
        const size_t qrow = (size_t)si.base + (size_t)(i0 + r32) * dil + rho;
        bf16x8 qf[4];
#pragma unroll
        for (int d0 = 0; d0 < 4; ++d0) qf[d0] = *(const bf16x8*)(H + qrow * HP + HC_CQ + gj * 64 + 16 * d0 + 8 * hi);
        const RowSrc ks{H + ((size_t)si.base + rho) * HP + HC_CK + gj * 64, (long)HP * dil};
        int kb_lo = ib - 2, kb_hi = ib + 3; if (kb_lo < 0) kb_lo = 0; if (kb_hi > bpr) kb_hi = bpr;
        float lse; sattn_core<4, 0, 1>(qf, ks, ks, ks, kb_lo, kb_hi, i0, 0.f, scr, lane, nullptr, lse);
        if (hi == 0) lsec[((size_t)g * NTOK + qrow) * 2 + j] = lse;
    }
}


namespace at {
typedef short s16x4 __attribute__((ext_vector_type(4)));
typedef short v4i16_t __attribute__((ext_vector_type(4)));
typedef LAS const unsigned char* lds_cptr;
constexpr int LDS_K = 0, KSLOT_MAX = 12288, LDS_V = 3 * KSLOT_MAX, VSLOT = 8192, LDS_WS = LDS_V + 3 * VSLOT, LDS_OST = LDS_WS + 8 * 256, LDS_TOTAL = LDS_OST + 8 * 8192;
static_assert(LDS_TOTAL <= RING_BYTES, "attention LDS");
constexpr float THR = 8.0f;
__device__ __forceinline__ void glds16(const void* g, unsigned lds_dst) {
    unsigned keep; asm volatile("s_mov_b32 %0, m0\n\ts_mov_b32 m0, %2\n\ts_nop 0\n\tglobal_load_lds_dwordx4 %1, off\n\ts_mov_b32 m0, %0" : "=&s"(keep) : "v"(g), "s"(lds_dst) : "memory"); }
__device__ __forceinline__ s16x4 vtr(lds_cptr p) { return __builtin_bit_cast(s16x4, __builtin_amdgcn_ds_read_tr16_b64_v4i16((LAS v4i16_t*)p)); }
__device__ __forceinline__ unsigned cvtpk(float lo, float hi) { typedef float f2 __attribute__((ext_vector_type(2))); typedef __bf16 b2 __attribute__((ext_vector_type(2))); f2 v = {lo, hi}; b2 b = __builtin_convertvector(v, b2); return __builtin_bit_cast(unsigned, b); }
#define AT_MX3(a, b, c) __builtin_fmaxf(__builtin_fmaxf((a), (b)), (c))
__device__ __forceinline__ float rowmax(const f32x16& p0, const f32x16& p1) {
    float a = AT_MX3(p0[0], p0[1], p1[0]), b = AT_MX3(p0[2], p0[3], p1[1]); a = AT_MX3(a, p1[2], p1[3]);
#pragma unroll
    for (int r = 4; r < 16; r += 4) { a = AT_MX3(a, p0[r], p0[r + 1]); b = AT_MX3(b, p0[r + 2], p0[r + 3]); a = AT_MX3(a, p1[r], p1[r + 1]); b = AT_MX3(b, p1[r + 2], p1[r + 3]); }
    float m = __builtin_fmaxf(a, b); auto rr = __builtin_amdgcn_permlane32_swap(__float_as_uint(m), __float_as_uint(m), false, false);
    return __builtin_fmaxf(__uint_as_float(rr[0]), __uint_as_float(rr[1])); }
#define AT_WAIT_BAR(N) asm volatile("s_waitcnt vmcnt(" #N ") lgkmcnt(0)\n\ts_barrier" ::: "memory")

struct Src { const bf16_t* p; long pitch; };
template <int NC, int NK0, int NK1>
__device__ __forceinline__ void stream(LAS unsigned char* lds, int tid, const bf16_t* qrow, Src k0, Src k1, Src vs, int NT, f32x16& o0, f32x16& o1, float& lsum) {
    asm volatile("" : "+v"(tid));
    constexpr int SLOTK = 2 * NC * 1024, NDMA = (NK1 > 0) ? 3 : 2;
    const int lane = tid & 63, r32 = lane & 31, hi = lane >> 5; const int wid = __builtin_amdgcn_readfirstlane(tid >> 6), wr = wid >> 2;
    const unsigned lds0 = (unsigned)(uintptr_t)lds;
    LAS float* wsf = (LAS float*)(lds + LDS_WS) + wid * 64;
    const bf16_t* ksA = k0.p + (long)lane * k0.pitch + (wid % NK0) * 8;
    const bf16_t* ksB = (NK1 > 0) ? k1.p + (long)lane * k1.pitch + (wid % (NK1 > 0 ? NK1 : 1)) * 8 : k0.p;
    const bf16_t* vsp = vs.p + (long)(16 * (wid & 3) + (lane >> 2)) * vs.pitch + (wid >> 2) * 32 + (lane & 3) * 8;
    const unsigned kdA = lds0 + LDS_K + (wid % NK0) * 1024, kdB = lds0 + LDS_K + (NK0 + (wid % (NK1 > 0 ? NK1 : 1))) * 1024, vd = lds0 + LDS_V + wid * 1024;
    const long ktA = 64 * k0.pitch, ktB = 64 * k1.pitch, vt = 64 * vs.pitch;
#define AT_DMA_K(t, slot) do { glds16(ksA + (long)(t) * ktA, (unsigned)__builtin_amdgcn_readfirstlane(kdA + (slot) * SLOTK)); if (NK1 > 0) glds16(ksB + (long)(t) * ktB, (unsigned)__builtin_amdgcn_readfirstlane(kdB + (slot) * SLOTK)); } while (0)
#define AT_DMA_V(t, slot) glds16(vsp + (long)(t) * vt, (unsigned)__builtin_amdgcn_readfirstlane(vd + (slot) * VSLOT))
    const lds_cptr kp0 = (lds_cptr)lds + LDS_K + hi * 1024 + r32 * 16;
    const lds_cptr vp0 = (lds_cptr)lds + LDS_V + ((lane >> 4) & 1) * 32 + (lane & 3) * 8 + (4 * hi + ((lane & 15) >> 2)) * 64;
    AT_DMA_K(0, 0); AT_DMA_V(0, 0); if (NT > 1) AT_DMA_K(1, 1);
    bf16x8 qr[NC];
#pragma unroll
    for (int d0 = 0; d0 < NC; ++d0) qr[d0] = *(const bf16x8*)(qrow + 16 * d0 + 8 * hi);
    float mhat = 0.f, l = 0.f; f32x16 oa = {}, ob = {}, negm = {}, S0, S1; u32x4 pw0, pw1, pw2, pw3;
    asm volatile("" : "+v"(negm));
    AT_WAIT_BAR(0);
    int kc = 0, kn1 = 1, kn2 = 2, vpv = 2, vcu = 0, vnx = 1;
#define AT_QK(slot) do { const lds_cptr kp_ = kp0 + (slot) * SLOTK; \
        _Pragma("unroll") for (int d0 = 0; d0 < NC; ++d0) { const bf16x8 ka = *(const LAS bf16x8*)(kp_ + d0 * 2048), kb = *(const LAS bf16x8*)(kp_ + d0 * 2048 + 512); \
            if (d0 == 0) { S0 = MFMA32(ka, qr[0], negm); S1 = MFMA32(kb, qr[0], negm); } else { S0 = MFMA32(ka, qr[d0], S0); S1 = MFMA32(kb, qr[d0], S1); } } } while (0)
#define AT_VF(i) ({ const s16x4 lo_ = vtr(vp_ + (((i) >> 2) * 4096 + ((i) & 3) * 1024)), hi_ = vtr(vp_ + (((i) >> 2) * 4096 + ((i) & 3) * 1024 + 512)); (bf16x8){lo_[0], lo_[1], lo_[2], lo_[3], hi_[0], hi_[1], hi_[2], hi_[3]}; })
#define AT_PV(slot) do { const lds_cptr vp_ = vp0 + (slot) * VSLOT; \
        oa = MFMA32(__builtin_bit_cast(bf16x8, pw0), AT_VF(0), oa); ob = MFMA32(__builtin_bit_cast(bf16x8, pw0), AT_VF(4), ob); \
        oa = MFMA32(__builtin_bit_cast(bf16x8, pw1), AT_VF(1), oa); ob = MFMA32(__builtin_bit_cast(bf16x8, pw1), AT_VF(5), ob); \
        oa = MFMA32(__builtin_bit_cast(bf16x8, pw2), AT_VF(2), oa); ob = MFMA32(__builtin_bit_cast(bf16x8, pw2), AT_VF(6), ob); \
        oa = MFMA32(__builtin_bit_cast(bf16x8, pw3), AT_VF(3), oa); ob = MFMA32(__builtin_bit_cast(bf16x8, pw3), AT_VF(7), ob); } while (0)
#define AT_SM(first) do { const float rm_ = rowmax(S0, S1); \
        if ((first) || __any(rm_ > THR)) { const float dl_ = (first) ? rm_ : __builtin_fmaxf(rm_, 0.f); mhat += dl_; \
            _Pragma("unroll") for (int r = 0; r < 16; ++r) { S0[r] -= dl_; S1[r] -= dl_; negm[r] = -mhat; } asm volatile("" : "+v"(negm)); \
            if (!(first)) { const float f_ = fast_exp2(-dl_); l *= f_; if (hi == 0) wsf[r32] = f_; LDS_WAIT(); \
                _Pragma("unroll") for (int r = 0; r < 16; ++r) { const float g_ = wsf[crow(r, hi)]; oa[r] *= g_; ob[r] *= g_; } LDS_WAIT(); } } \
        float sacc_ = 0.f; \
        _Pragma("unroll") for (int r = 0; r < 16; ++r) { S0[r] = fast_exp2(S0[r]); S1[r] = fast_exp2(S1[r]); sacc_ += S0[r] + S1[r]; } l += sacc_; \
        pw0 = (u32x4){cvtpk(S0[0], S0[1]), cvtpk(S0[2], S0[3]), cvtpk(S0[4], S0[5]), cvtpk(S0[6], S0[7])}; pw1 = (u32x4){cvtpk(S0[8], S0[9]), cvtpk(S0[10], S0[11]), cvtpk(S0[12], S0[13]), cvtpk(S0[14], S0[15])}; \
        pw2 = (u32x4){cvtpk(S1[0], S1[1]), cvtpk(S1[2], S1[3]), cvtpk(S1[4], S1[5]), cvtpk(S1[6], S1[7])}; pw3 = (u32x4){cvtpk(S1[8], S1[9]), cvtpk(S1[10], S1[11]), cvtpk(S1[12], S1[13]), cvtpk(S1[14], S1[15])}; } while (0)
    for (int t = 0; t < NT; ++t) {
        if (t + 2 < NT) AT_DMA_K(t + 2, kn2);
        if (t + 1 < NT) AT_DMA_V(t + 1, vnx);
        if (wr == 0) { if (t > 0) AT_PV(vpv); AT_QK(kc); AT_SM(t == 0); }
        else { if (t > 0) { AT_SM(t == 1); AT_PV(vpv); } AT_QK(kc); }
        if (t + 2 < NT) { if (NDMA == 3) AT_WAIT_BAR(3); else AT_WAIT_BAR(2); } else AT_WAIT_BAR(0);
        { const int a_ = kc; kc = kn1; kn1 = kn2; kn2 = a_; const int b_ = vpv; vpv = vcu; vcu = vnx; vnx = b_; }
    }
    if (wr == 1) AT_SM(NT == 1);
    AT_PV(vpv);
    { auto rr = __builtin_amdgcn_permlane32_swap(__float_as_uint(l), __float_as_uint(l), false, false); l = __uint_as_float(rr[0]) + __uint_as_float(rr[1]); }
    o0 = oa; o1 = ob; lsum = l;
#undef AT_DMA_K
#undef AT_DMA_V
#undef AT_QK
#undef AT_VF
#undef AT_PV
#undef AT_SM
}
__device__ __forceinline__ void normalise(LAS unsigned char* lds, int tid, f32x16& o0, f32x16& o1, float lsum) {
    const int lane = tid & 63, r32 = lane & 31, hi = lane >> 5; const int wid = __builtin_amdgcn_readfirstlane(tid >> 6);
    LAS float* wsf = (LAS float*)(lds + LDS_WS) + wid * 64;
    if (hi == 0) wsf[32 + r32] = 1.0f / lsum; LDS_WAIT();
#pragma unroll
    for (int r = 0; r < 16; ++r) { const float g = wsf[32 + crow(r, hi)]; o0[r] *= g; o1[r] *= g; }
    LDS_WAIT();
}
}

struct AttnUnitId { int kind, seq, head, qb; };
__device__ __forceinline__ bool attn_unit_at(int i, int G, int bid, AttnUnitId& u) {
    const long L = (long)i * G + bid; if (L >= 2560) return false; int o = (int)L;
    int kind, longs, nh;
    if (o < 512) { kind = 0; longs = 1; nh = 4; } else if (o < 1024) { kind = 0; longs = 0; nh = 4; o -= 512; } else if (o < 1792) { kind = 1; longs = 1; nh = 6; o -= 1024; } else { kind = 1; longs = 0; nh = 6; o -= 1792; }
    const int nqb = longs ? 16 : 8;
    int pair, qb;
    if (G == 256) { const int rnd = o >> 8, b = o & 255, x = b & 7, c = b >> 3;
        const int ppr = 32 / nqb; pair = x + 8 * (rnd * ppr + c / nqb); qb = c % nqb; }
    else { pair = o / nqb; qb = o % nqb; }
    u.kind = kind; u.head = pair % nh; const int sq = pair / nh; u.seq = longs ? 16 + sq : sq; u.qb = qb; return true;
}
__device__ __forceinline__ void attn_ab_phase(Frame& F, const Args& a, int layer) {
    const bf16_t* H = (const bf16_t*)(F.ws + WS_H); const bf16_t* QB = (const bf16_t*)(F.ws + WS_QB); const bf16_t* KVB = (const bf16_t*)(F.ws + WS_KVB);
    bf16_t* MIX = (bf16_t*)(F.ws + WS_MIX);
    const int wid = F.wave;
    float lam, lam_init;
    { const float* lv = a.diff_lambda + layer * 128; float d1 = 0.f, d2 = 0.f;
      for (int i = 0; i < 32; ++i) { d1 += lv[i] * lv[32 + i]; d2 += lv[64 + i] * lv[96 + i]; }
      lam_init = 0.8f - 0.6f * expf(-0.3f * (float)layer); lam = expf(d1) - expf(d2) + lam_init; }
    AttnUnitId u;
    for (int i = 0; attn_unit_at(i, F.G, F.bid, u); ++i) {
        int tid = F.tid; asm volatile("" : "+v"(tid)); const int lane = tid & 63, r32 = lane & 31, hi = lane >> 5;
        const int len = (u.seq < 16) ? 2048 : 4096, base = (u.seq < 16) ? u.seq * 2048 : NTOK_P + (u.seq - 16) * 4096, NT = len / 64;
        const int m0 = base + u.qb * 256 + wid * 32;
        LAS bf16_t* sb = (LAS bf16_t*)(F.lds + at::LDS_OST + wid * 8192);
        LAS float* sf = (LAS float*)sb;
        if (u.kind == 0) {
            f32x16 q0, q1; float ls;
            { f32x16 p0, p1; const at::Src ks{H + (size_t)base * HP + HC_AK + u.head * 64, HP}, vs{H + (size_t)base * HP + HC_AV + u.head * 64, HP};
              at::stream<2, 4, 0>(F.lds, tid, H + (size_t)(m0 + r32) * HP + HC_AQ + u.head * 64, ks, ks, vs, NT, p0, p1, ls); at::normalise(F.lds, tid, p0, p1, ls);
#pragma unroll
              for (int r = 0; r < 16; ++r) { const int row = crow(r, hi); sf[row * 64 + r32] = p0[r]; sf[row * 64 + 32 + r32] = p1[r]; }
              AT_WAIT_BAR(0); }
            { const at::Src ks{H + (size_t)base * HP + HC_AK + u.head * 64 + 32, HP}, vs{H + (size_t)base * HP + HC_AV + u.head * 64, HP};
              at::stream<2, 4, 0>(F.lds, tid, H + (size_t)(m0 + r32) * HP + HC_AQ + u.head * 64 + 32, ks, ks, vs, NT, q0, q1, ls); at::normalise(F.lds, tid, q0, q1, ls); }
            float xa[16], xb[16];
#pragma unroll
            for (int r = 0; r < 16; ++r) { const int row = crow(r, hi); xa[r] = sf[row * 64 + r32] - lam * q0[r]; xb[r] = sf[row * 64 + 32 + r32] - lam * q1[r]; }
            LDS_WAIT();
            const float* sg = a.diff_subln + layer * 64; const float g0 = sg[r32] * (1.0f - lam_init), g1 = sg[32 + r32] * (1.0f - lam_init);
#pragma unroll
            for (int r = 0; r < 16; ++r) { const float x0 = xa[r], x1 = xb[r]; float ss = x0 * x0 + x1 * x1;
                ss += __shfl_xor(ss, 1); ss += __shfl_xor(ss, 2); ss += __shfl_xor(ss, 4); ss += __shfl_xor(ss, 8); ss += __shfl_xor(ss, 16);
                const float rs = 1.0f / sqrtf(ss * (1.0f / 64.0f) + RMS_EPS); const int row = crow(r, hi);
                sb[row * 64 + r32] = (bf16_t)f2bf(x0 * rs * g0); sb[row * 64 + 32 + r32] = (bf16_t)f2bf(x1 * rs * g1); }
            LDS_WAIT();
#pragma unroll
            for (int it = 0; it < 4; ++it) { const int row = it * 8 + (lane >> 3), ch = lane & 7; *(u32x4*)(MIX + (size_t)(m0 + row) * DM + MIX_A + u.head * 64 + ch * 8) = *(const LAS u32x4*)(sb + row * 64 + ch * 8); }
        } else {
            f32x16 p0, p1; float ls;
            const at::Src k0{KVB + (size_t)base * KVP + u.head * 128, KVP}, k1{H + (size_t)base * HP + HC_KROPE, HP}, vs{KVB + (size_t)base * KVP + u.head * 128 + 64, KVP};
            at::stream<6, 8, 4>(F.lds, tid, QB + (size_t)(m0 + r32) * QBP + u.head * 96, k0, k1, vs, NT, p0, p1, ls); at::normalise(F.lds, tid, p0, p1, ls);
#pragma unroll
            for (int r = 0; r < 16; ++r) { const int row = crow(r, hi); sb[row * 64 + r32] = (bf16_t)f2bf(p0[r]); sb[row * 64 + 32 + r32] = (bf16_t)f2bf(p1[r]); }
            LDS_WAIT();
#pragma unroll
            for (int it = 0; it < 4; ++it) { const int row = it * 8 + (lane >> 3), ch = lane & 7; *(u32x4*)(MIX + (size_t)(m0 + row) * DM + MIX_B + u.head * 64 + ch * 8) = *(const LAS u32x4*)(sb + row * 64 + ch * 8); }
        }
        AT_WAIT_BAR(0);
    }
}

struct ListRows { const int* list; int seg0, cnt; __device__ __forceinline__ int src(int m) const { const int r = m - seg0; return (r < cnt) ? (list[r] >> 1) : 0; } };
__device__ __forceinline__ void moe_segments(Frame& F, int layer, LAS int* seg) {
    if (F.tid == 0) { int acc = 0; for (int e = 0; e < NEXP; ++e) { const int c = (int)__hip_atomic_load(F.ctl + CW_CNT + layer * 64 + e, RLX_AGENT); seg[e] = acc; seg[33 + e] = c; acc += (c + 255) & ~255; } seg[32] = acc; }
    __syncthreads();
}
__device__ __forceinline__ int seg_find(const LAS int* seg, int row) { int e = 0;
#pragma unroll
    for (int s = 16; s > 0; s >>= 1) if (seg[e + s] <= row) e += s;
    return e; }
__device__ __forceinline__ void moe_up_simple(Frame& F, int layer) {
    LAS int* seg = (LAS int*)(F.lds + RING_BYTES); moe_segments(F, layer, seg);
    const bf16_t* XB = (const bf16_t*)(F.ws + WS_XB); const bf16_t* W13 = (const bf16_t*)(F.ws + WS_W13); const int* list = (const int*)(F.ws + WS_LIST);
    const EpiHid E{(bf16_t*)(F.ws + WS_HID)};
    const int items = (seg[32] / 32) * 16;
    for (int it = F.gw; it < items; it += F.NGW) { const int mt = it >> 4, ct = it & 15, m0 = mt * 32, e = seg_find(seg, m0), c0 = ct * 32;
        const ListRows RM{list + (size_t)e * LIST_CAP, seg[e], seg[33 + e]};
        const bf16_t* Bg = W13 + (size_t)e * 1024 * 1024 + (size_t)((c0 >> 7) * 256 + (c0 & 127)) * 1024;
        sg_tile(XB, DM, Bg, Bg + (size_t)128 * 1024, 1024, 1024, m0, c0, E, RM, F.lane); }
    __syncthreads();
}
__device__ __forceinline__ void moe_down_simple(Frame& F, int layer) {
    LAS int* seg = (LAS int*)(F.lds + RING_BYTES); moe_segments(F, layer, seg);
    const bf16_t* HID = (const bf16_t*)(F.ws + WS_HID); const bf16_t* W2 = (const bf16_t*)(F.ws + WS_W2); const int* list = (const int*)(F.ws + WS_LIST);
    const int items = (seg[32] / 32) * 16;
    for (int it = F.gw; it < items; it += F.NGW) { const int mt = it >> 4, ct = it & 15, m0 = mt * 32, e = seg_find(seg, m0), c0 = ct * 64;
        const EpiY E{(bf16_t*)(F.ws + WS_YB), (const float*)(F.ws + WS_TW), list + (size_t)e * LIST_CAP, seg[e], seg[33 + e]};
        const bf16_t* B0 = W2 + (size_t)e * 1024 * 512 + (size_t)c0 * 512;
        sg_tile(HID, DEXP, B0, B0 + (size_t)32 * 512, 512, 512, m0, c0, E, IdRows(), F.lane); }
    __syncthreads();
}


struct MoeUpSched {
    const char* XB; const char* W13; const LAS int* seg; const int* list; int nM, G, c;
    __device__ __forceinline__ bool next(int i, pg8::Unit& u) const { if (!pg8::order_next(i, G, c, nM, 4, u.pm, u.pn)) return false; u.e = __builtin_amdgcn_readfirstlane(seg_find(seg, u.pm * 256)); u.a = XB; u.b = W13 + ((size_t)u.e * 1024 + (size_t)u.pn * 256) * 2048; return true; }
    __device__ __forceinline__ unsigned arow(const pg8::Unit& u, int r) const { const int rr = u.pm * 256 + r - __builtin_amdgcn_readfirstlane(seg[u.e]); return (rr < __builtin_amdgcn_readfirstlane(seg[33 + u.e])) ? (unsigned)(list[(size_t)u.e * LIST_CAP + rr] >> 1) : 0u; }
};
struct MoeDownSched {
    const char* HID; const char* W2; const LAS int* seg; int nM, G, c;
    __device__ __forceinline__ bool next(int i, pg8::Unit& u) const { if (!pg8::order_next(i, G, c, nM, 4, u.pm, u.pn)) return false; u.e = __builtin_amdgcn_readfirstlane(seg_find(seg, u.pm * 256)); u.a = HID + (size_t)u.pm * 256 * DEXP * 2; u.b = W2 + ((size_t)u.e * 1024 + (size_t)u.pn * 256) * 1024; return true; }
    __device__ __forceinline__ unsigned arow(const pg8::Unit&, int) const { return 0u; }
};
__device__ __forceinline__ void moe_up_opt(Frame& F, int layer) {
    LAS int* seg = (LAS int*)(F.lds + RING_BYTES); moe_segments(F, layer, seg);
    const MoeUpSched S{(const char*)(F.ws + WS_XB), (const char*)(F.ws + WS_W13), seg, (const int*)(F.ws + WS_LIST), __builtin_amdgcn_readfirstlane(seg[32]) / 256, F.G, F.bid};
    const EpiHid E{(bf16_t*)(F.ws + WS_HID)};
    pg8::gemm_phase<EpiHid, MoeUpSched, true, true>(F.lds, F.tid, 1024, DM, S, E);
    __syncthreads();
}
__device__ __forceinline__ void moe_down_opt(Frame& F, int layer) {
    LAS int* seg = (LAS int*)(F.lds + RING_BYTES); moe_segments(F, layer, seg);
    const MoeDownSched S{(const char*)(F.ws + WS_HID), (const char*)(F.ws + WS_W2), seg, __builtin_amdgcn_readfirstlane(seg[32]) / 256, F.G, F.bid};
    const EpiYO E{(bf16_t*)(F.ws + WS_YB), (const float*)(F.ws + WS_TW), (const int*)(F.ws + WS_LIST), seg};
    pg8::gemm_phase<EpiYO, MoeDownSched, false, false>(F.lds, F.tid, DEXP, DEXP, S, E);
    __syncthreads();
}
template <class Epi>
__device__ __forceinline__ void og_phase(Frame& F, const bf16_t* A, int lda, const bf16_t* Bt, int M, int N, int K, const Epi& E) {
    pg8::DenseSched S; S.init(A, lda, Bt, M, N, K, F.G, F.bid);
    pg8::gemm_phase<Epi, pg8::DenseSched, false, false>(F.lds, F.tid, K, lda, S, E);
}

constexpr int PH_PER_LAYER = 9, N_PHASES = 1 + DEPTH * PH_PER_LAYER;
__global__ void __launch_bounds__(NTHREADS, 2) fwd(Args args) {
    extern __shared__ __attribute__((aligned(16))) unsigned char lds[];
    Frame F;
    F.lds = (LAS unsigned char*)lds; F.ldsg = lds;
    F.tid = threadIdx.x; F.lane = F.tid & 63; F.wave = __builtin_amdgcn_readfirstlane(F.tid >> 6);
    F.G = gridDim.x; F.bid = blockIdx.x; F.gw = blockIdx.x * NWAVES + F.wave; F.NGW = F.G * NWAVES;
    F.ws = args.ws; F.ctl = (gu32*)(args.ws + WS_CTL);
    volatile LAS unsigned* MISC = (volatile LAS unsigned*)(F.lds + MISC_OFF);
    for (int u = F.tid; u < (LDS_BYTES - RING_BYTES) / 4; u += NTHREADS) ((LAS unsigned*)(F.lds + RING_BYTES))[u] = 0u;
    __syncthreads();
    XcdBarrier bar; bar.bar = (unsigned*)(F.ctl + CW_BAR); bar.x = 0; bar.st = nullptr;
    if (args.use_bar) bar = xcd_barrier_post((unsigned*)(F.ctl + CW_BAR), MISC + 8);
    const int lo = args.ph_lo, hi = args.ph_hi;
#ifndef PH_MASK
#define PH_MASK 0x3ff
#endif
#define IN(k) (lo <= (k) && (k) < hi && (launder(F), true))
#define SEAM(k) do { if (lo <= (k) && (k) + 1 < hi) xcd_barrier(bar); } while (0)
    if ((PH_MASK & 1) && IN(0)) { p0_prologue(F, args); }
    SEAM(0);
    for (int layer = 0; layer < DEPTH; ++layer) {
        const int pb = 1 + layer * PH_PER_LAYER;
        if ((PH_MASK & (2 << 0)) && IN(pb + 0)) {   bf16_t* H = (bf16_t*)(F.ws + WS_H);
            const EpiH E{H, (const float2*)(F.ws + WS_ROPE32), (const float2*)(F.ws + WS_ROPE64)};
#if OPT_GEMM
            og_phase(F, (const bf16_t*)(F.ws + WS_XB), DM, (const bf16_t*)(F.ws + WS_WIN) + (size_t)layer * 2560 * 1024, NTOK, 2560, 1024, E);
#else
            sg_phase(F, (const bf16_t*)(F.ws + WS_XB), DM, (const bf16_t*)(F.ws + WS_WIN) + (size_t)layer * 2560 * 1024, 1024, NTOK, 2560, 1024, E);
#endif
        }
        SEAM(pb + 0);
        if ((PH_MASK & (2 << 1)) && IN(pb + 1)) { rowstat_pass(F); cstat_phase(F); }
        SEAM(pb + 1);
        if ((PH_MASK & (2 << 2)) && IN(pb + 2)) {
            bf16_t* H = (bf16_t*)(F.ws + WS_H);
            const EpiUQ Eq{(bf16_t*)(F.ws + WS_QB), (const float*)(F.ws + WS_RSTD), (const float2*)(F.ws + WS_ROPE32)};
#if OPT_GEMM
            og_phase(F, H + HC_CQ_LAT, HP, (const bf16_t*)(F.ws + WS_WUQ) + (size_t)layer * 768 * 256, NTOK, 768, 256, Eq);
            launder(F);
#else
            sg_phase(F, H + HC_CQ_LAT, HP, (const bf16_t*)(F.ws + WS_WUQ) + (size_t)layer * 768 * 256, 256, NTOK, 768, 256, Eq);
#endif
            const EpiUKV Ek{(bf16_t*)(F.ws + WS_KVB), (const float*)(F.ws + WS_RSTD)};
#if OPT_GEMM
            og_phase(F, H + HC_CKV, HP, (const bf16_t*)(F.ws + WS_WUKV) + (size_t)layer * 768 * 256, NTOK, 768, 256, Ek);
#else
            sg_phase(F, H + HC_CKV, HP, (const bf16_t*)(F.ws + WS_WUKV) + (size_t)layer * 768 * 256, 256, NTOK, 768, 256, Ek);
#endif
        }
        SEAM(pb + 2);
        if ((PH_MASK & (2 << 3)) && IN(pb + 3)) {
#if OPT_ATTN
            attn_ab_phase(F, args, layer); launder(F); sattn_phase(F, args, layer, 10);
#else
            sattn_phase(F, args, layer, 0);
#endif
        }
        SEAM(pb + 3);
        if ((PH_MASK & (2 << 4)) && IN(pb + 4)) {
            const EpiRes E{args.out};
#if OPT_GEMM
            og_phase(F, (const bf16_t*)(F.ws + WS_MIX), DM, (const bf16_t*)(F.ws + WS_WOUT) + (size_t)layer * 1024 * 1024, NTOK, 1024, 1024, E);
#else
            sg_phase(F, (const bf16_t*)(F.ws + WS_MIX), DM, (const bf16_t*)(F.ws + WS_WOUT) + (size_t)layer * 1024 * 1024, 1024, NTOK, 1024, 1024, E);
#endif
        }
        SEAM(pb + 4);
        if ((PH_MASK & (2 << 5)) && IN(pb + 5)) { ln1_route_pass(F, args, layer); moe_convert(F, args, layer); }
        SEAM(pb + 5);
#if OPT_GEMM
        if ((PH_MASK & (2 << 6)) && IN(pb + 6)) { moe_up_opt(F, layer); }
#else
        if ((PH_MASK & (2 << 6)) && IN(pb + 6)) { moe_up_simple(F, layer); }
#endif
        SEAM(pb + 6);
#if OPT_GEMM
        if ((PH_MASK & (2 << 7)) && IN(pb + 7)) { moe_down_opt(F, layer); }
#else
        if ((PH_MASK & (2 << 7)) && IN(pb + 7)) { moe_down_simple(F, layer); }
#endif
        SEAM(pb + 7);
        if ((PH_MASK & (2 << 8)) && IN(pb + 8)) { ln2_pass(F, args, layer); }
        SEAM(pb + 8);
    }
#undef IN
#undef SEAM
}

extern "C" void kernel_launch(void* const* d_in, const int* in_sizes, int n_in, void* d_out, int out_size, void* d_ws, size_t ws_size, hipStream_t stream) {
    static int grid = 0;
    if (grid == 0) {
        if (n_in != 19 || out_size != NTOK * DM || ws_size < WS_END) { fprintf(stderr, "kernel_launch: unexpected shapes (n_in %d out %d ws %zu)\n", n_in, out_size, ws_size); grid = -1; return; }
        int dev = 0, cus = 0, per_cu = 0;
        if (hipGetDevice(&dev) != hipSuccess || hipDeviceGetAttribute(&cus, hipDeviceAttributeMultiprocessorCount, dev) != hipSuccess) { grid = -1; return; }
        if (hipFuncSetAttribute((const void*)fwd, hipFuncAttributeMaxDynamicSharedMemorySize, LDS_BYTES) != hipSuccess) { grid = -1; return; }
        if (hipOccupancyMaxActiveBlocksPerMultiprocessor(&per_cu, (const void*)fwd, NTHREADS, LDS_BYTES) != hipSuccess || per_cu < 1) { fprintf(stderr, "kernel_launch: occupancy query says %d\n", per_cu); }
        (void)hipGetLastError();
        grid = cus;
    }
    if (grid < 0) return;
    if (hipMemsetAsync((char*)d_ws + WS_CTL, 0, CTL_ZERO_BYTES, stream) != hipSuccess) return;
    Args a{};
    a.x_prompt = (const float*)d_in[0]; a.x_sample = (const float*)d_in[1]; a.w_in = (const float*)d_in[2]; a.diff_lambda = (const float*)d_in[3]; a.diff_subln = (const float*)d_in[4];
    a.mla_q_norm = (const float*)d_in[5]; a.mla_w_uq = (const float*)d_in[6]; a.mla_kv_norm = (const float*)d_in[7]; a.mla_w_ukv = (const float*)d_in[8]; a.w_out = (const float*)d_in[9];
    a.ln1_g = (const float*)d_in[10]; a.ln1_b = (const float*)d_in[11]; a.moe_w_coarse = (const float*)d_in[12]; a.moe_w_fine = (const float*)d_in[13];
    a.moe_w1 = (const float*)d_in[14]; a.moe_w3 = (const float*)d_in[15]; a.moe_w2 = (const float*)d_in[16]; a.ln2_g = (const float*)d_in[17]; a.ln2_b = (const float*)d_in[18];
    a.out = (float*)d_out; a.ws = (unsigned char*)d_ws; a.pad = 0;
#if MK_ONE_LAUNCH
    a.ph_lo = 0; a.ph_hi = N_PHASES; a.use_bar = 1;
    hipLaunchKernelGGL(fwd, dim3(grid), dim3(NTHREADS), LDS_BYTES, stream, a);
#else
    for (int p = 0; p < N_PHASES; ++p) { a.ph_lo = p; a.ph_hi = p + 1; a.use_bar = 0; hipLaunchKernelGGL(fwd, dim3(grid), dim3(NTHREADS), LDS_BYTES, stream, a); }
#endif
}
```

```cpp
#include <hip/hip_runtime.h>
#include <cstdio>
#include <cstdint>

#ifndef OPT_ATTN
#define OPT_ATTN 1
#endif
#ifndef OPT_GEMM
#define OPT_GEMM 1
#endif
#ifndef MK_ONE_LAUNCH
#define MK_ONE_LAUNCH 1
#endif

#define GAS __attribute__((address_space(1)))
#define LAS __attribute__((address_space(3)))
typedef unsigned short bf16_t;
typedef short bf16x8 __attribute__((ext_vector_type(8)));
typedef float f32x4 __attribute__((ext_vector_type(4)));
typedef float f32x2 __attribute__((ext_vector_type(2)));
typedef float f32x16 __attribute__((ext_vector_type(16)));
typedef unsigned u32x4 __attribute__((ext_vector_type(4)));
typedef unsigned u32x2 __attribute__((ext_vector_type(2)));
typedef GAS unsigned gu32;
#define RLX_AGENT __ATOMIC_RELAXED, __HIP_MEMORY_SCOPE_AGENT
#define LDS_WAIT() asm volatile("s_waitcnt lgkmcnt(0)" ::: "memory")
#define VM_WAIT() asm volatile("s_waitcnt vmcnt(0)" ::: "memory")
#define MFMA32(a, b, c) __builtin_amdgcn_mfma_f32_32x32x16_bf16(a, b, c, 0, 0, 0)

__device__ __forceinline__ unsigned f2bf(float f) { unsigned u = __builtin_bit_cast(unsigned, f); return (u + 0x7fffu + ((u >> 16) & 1u)) >> 16; }
__device__ __forceinline__ unsigned pk2(float lo, float hi) { return f2bf(lo) | (f2bf(hi) << 16); }
__device__ __forceinline__ float bf2f(unsigned short b) { return __builtin_bit_cast(float, (unsigned)b << 16); }
__device__ __forceinline__ int crow(int r, int hi) { return (r & 3) + 8 * (r >> 2) + 4 * hi; }
template <int K> __device__ __forceinline__ float shx(float v) { static_assert(K < 32, "xor 32: use xsum32 / xmax32 / xpair32"); return __uint_as_float((unsigned)__builtin_amdgcn_ds_swizzle((int)__float_as_uint(v), (K << 10) | 0x1f)); }
__device__ __forceinline__ float xsum32(float v) { auto rr = __builtin_amdgcn_permlane32_swap(__float_as_uint(v), __float_as_uint(v), false, false); return __uint_as_float(rr[0]) + __uint_as_float(rr[1]); }
__device__ __forceinline__ float xmax32(float v) { auto rr = __builtin_amdgcn_permlane32_swap(__float_as_uint(v), __float_as_uint(v), false, false); return fmaxf(__uint_as_float(rr[0]), __uint_as_float(rr[1])); }
__device__ __forceinline__ float xpair32(float lo, float hi) { auto rr = __builtin_amdgcn_permlane32_swap(__float_as_uint(lo), __float_as_uint(hi), false, false); return __uint_as_float(rr[0]) + __uint_as_float(rr[1]); }
__device__ __forceinline__ float wave_sum(float v) {
    v += shx<1>(v); v += shx<2>(v); v += shx<4>(v); v += shx<8>(v); v += shx<16>(v);
    return xsum32(v);
}
__device__ __forceinline__ float fast_exp2(float x) { return __builtin_amdgcn_exp2f(x); }

constexpr int NTOK = 65536, DM = 1024, DEPTH = 4;
constexpr int NTOK_P = 32768;
constexpr int HP = 2560;
constexpr int HC_AQ = 0, HC_AK = 256, HC_AV = 512, HC_CQ_LAT = 768, HC_CKV = 1024, HC_KROPE = 1152, HC_CQ = 1280, HC_CK = 1664, HC_CV = 2048;
constexpr int QBP = 768, KVP = 768;
constexpr int MIX_A = 0, MIX_B = 256, MIX_C = 640;
constexpr int NEXP = 32, DEXP = 512;
constexpr float LOG2E = 1.4426950408889634f;
constexpr float SC_A = 0.17677669529663687f * LOG2E;
constexpr float SC_B = 0.10206207261596575f * LOG2E;
constexpr float SC_C = 0.125f * LOG2E;
constexpr float DN_ALPHA = 1.681792830507429f;
constexpr float LN_EPS = 1e-5f, RMS_EPS = 1e-6f;

constexpr size_t MiB = 1u << 20;
constexpr size_t WS_CTL = 0, CTL_ZERO_BYTES = 1 * MiB;
constexpr size_t WS_ROPE32 = 4 * MiB;
constexpr size_t WS_ROPE64 = 5 * MiB;
constexpr size_t WS_WIN = 8 * MiB;
constexpr size_t WS_WOUT = 28 * MiB;
constexpr size_t WS_WUQ = 36 * MiB;
constexpr size_t WS_WUKV = 38 * MiB;
constexpr size_t WS_W13 = 40 * MiB;
constexpr size_t WS_W2 = 104 * MiB;
constexpr size_t WS_XB = 136 * MiB;
constexpr size_t WS_H = 264 * MiB;
constexpr size_t WS_QB = 584 * MiB;
constexpr size_t WS_KVB = 680 * MiB;
constexpr size_t WS_MIX = 776 * MiB;
constexpr size_t WS_RSTD = 904 * MiB;
constexpr size_t WS_LSEC = 905 * MiB;
constexpr size_t WS_TW = 907 * MiB;
constexpr size_t WS_LIST = 908 * MiB;
constexpr size_t WS_END = 924 * MiB;
constexpr size_t WS_HID = WS_H;
constexpr size_t WS_YB = WS_H + 136 * MiB;
static_assert(WS_YB + 256 * MiB <= WS_KVB + 96 * MiB, "YB overlay");
constexpr int LIST_CAP = 131072;
constexpr int CW_TMO = 0;
constexpr int CW_CNT = 64;
constexpr int CW_BAR = 4096;

constexpr int RING_BYTES = 131072;
constexpr int MISC_OFF = RING_BYTES + 320;
constexpr int LDS_BYTES = 147456;
constexpr int NWAVES = 8, NTHREADS = 512;

#define XB_TMO      128
#define XB_XCNT(j)  (256  + 64 * (j))
#define XB_XSUB(j)  (1280 + 64 * (j))
#define XB_XGEN(j)  (2304 + 64 * (j))
#define XB_TOP      3328
#define XB_TOPGEN   3392
#define XCD_BAR_WORDS 3456
#define XB_SPIN_CAP (1u << 22)
__device__ __forceinline__ unsigned xb_ld(unsigned* p)              { return __hip_atomic_load(p, __ATOMIC_RELAXED, __HIP_MEMORY_SCOPE_AGENT); }
__device__ __forceinline__ unsigned xb_add(unsigned* p, unsigned v) { return __hip_atomic_fetch_add(p, v, __ATOMIC_RELAXED, __HIP_MEMORY_SCOPE_AGENT); }
__device__ __forceinline__ unsigned xb_xcc_id() { return (unsigned)__builtin_amdgcn_s_getreg((3 << 11) | 20) & 0xFu; }
#define XB_SPIN(cond, bar) do { unsigned _sp = 0; while (cond) { __builtin_amdgcn_s_sleep(1); \
    if ((++_sp & 255u) == 0u) { if (xb_ld(&(bar)[XB_TMO])) break; if (_sp > XB_SPIN_CAP) { atomicAdd(&(bar)[XB_TMO], 1u); break; } } } } while (0)
struct XcdBarrier { unsigned* bar; unsigned x; volatile LAS unsigned* st; };
__device__ __forceinline__ XcdBarrier xcd_barrier_post(unsigned* bar, volatile LAS unsigned* st) {
    XcdBarrier b; b.bar = bar; b.x = xb_xcc_id(); b.st = st;
    if (threadIdx.x == 0) (void)xb_add(&bar[XB_XCNT(b.x)], 1u);
    return b;
}
__device__ __forceinline__ void xcd_barrier_complete(unsigned* bar, unsigned x, unsigned& nloc, unsigned& nx) {
    const unsigned G = gridDim.x * gridDim.y * gridDim.z;
    unsigned sum, cnt, mine, sp = 0u;
    for (;;) {
        sum = 0u; cnt = 0u; mine = 0u;
#pragma unroll
        for (unsigned j = 0; j < 16; ++j) { const unsigned c = xb_ld(&bar[XB_XCNT(j)]); sum += c; cnt += (c > 0u) ? 1u : 0u; mine = (j == x) ? c : mine; }
        if (sum == G) break;
        __builtin_amdgcn_s_sleep(1);
        if ((++sp & 255u) == 0u) { if (xb_ld(&bar[XB_TMO])) break; if (sp > XB_SPIN_CAP) { atomicAdd(&bar[XB_TMO], 1u); break; } }
    }
    nloc = mine > 0u ? mine : 1u; nx = cnt > 0u ? cnt : 1u;
}
__device__ __forceinline__ void xcd_barrier(const XcdBarrier& b) {
    asm volatile("s_waitcnt vmcnt(0)" ::: "memory");
    __syncthreads();
    if (threadIdx.x == 0) {
        unsigned* bar = b.bar;
        __builtin_amdgcn_s_waitcnt(0);
        unsigned nloc = b.st[0], nx = b.st[1];
        if (nloc == 0u) { xcd_barrier_complete(bar, b.x, nloc, nx); b.st[0] = nloc; b.st[1] = nx; }
        const unsigned old = xb_add(&bar[XB_XSUB(b.x)], 1u);
        const unsigned gen = old / nloc;
        if (old + 1u == (gen + 1u) * nloc) {
            __builtin_amdgcn_fence(__ATOMIC_RELEASE, "agent");
            asm volatile("s_waitcnt vmcnt(0)" ::: "memory");
            const unsigned og = xb_add(&bar[XB_TOP], 1u);
            const unsigned tg = og / nx;
            if (og + 1u == (tg + 1u) * nx) xb_add(&bar[XB_TOPGEN], 1u);
            else XB_SPIN(xb_ld(&bar[XB_TOPGEN]) == tg, bar);
            __builtin_amdgcn_fence(__ATOMIC_ACQUIRE, "agent");
            xb_add(&bar[XB_XGEN(b.x)], 1u);
            asm volatile("s_waitcnt vmcnt(0)" ::: "memory");
        } else {
            XB_SPIN(xb_ld(&bar[XB_XGEN(b.x)]) == gen, bar);
            __builtin_amdgcn_fence(__ATOMIC_ACQUIRE, "agent");
            asm volatile("s_waitcnt vmcnt(0)" ::: "memory");
        }
    }
    __syncthreads();
}

struct Args {
    const float* x_prompt; const float* x_sample; const float* w_in; const float* diff_lambda; const float* diff_subln; const float* mla_q_norm; const float* mla_w_uq;
    const float* mla_kv_norm; const float* mla_w_ukv; const float* w_out; const float* ln1_g; const float* ln1_b; const float* moe_w_coarse; const float* moe_w_fine;
    const float* moe_w1; const float* moe_w3; const float* moe_w2; const float* ln2_g; const float* ln2_b;
    float* out; unsigned char* ws; int ph_lo, ph_hi, use_bar, pad;
};
struct Frame {
    LAS unsigned char* lds; unsigned char* ldsg;
    int tid, lane, wave, G, gw, NGW, bid;
    gu32* ctl; unsigned char* ws;
};
__device__ __forceinline__ void launder(Frame& F) {
    int wv = F.wave; asm volatile("" : "+s"(wv)); F.wave = wv;
    int t; asm volatile("v_mbcnt_lo_u32_b32 %0, -1, 0\n\tv_mbcnt_hi_u32_b32 %0, -1, %0" : "=v"(t)); F.lane = t; F.tid = wv * 64 + t;
    int b = (int)blockIdx.x; asm volatile("" : "+s"(b)); F.bid = b; F.gw = b * NWAVES + F.wave;
    unsigned char* w = F.ws; asm volatile("" : "+s"(w)); F.ws = w; F.ctl = (gu32*)(w + WS_CTL);
}
struct SeqInfo { int base, len, pos; };
__device__ __forceinline__ SeqInfo seqinfo(int m) { SeqInfo s; if (m < NTOK_P) { s.base = m & ~2047; s.len = 2048; } else { s.base = m & ~4095; s.len = 4096; } s.pos = m - s.base; return s; }

template <class ColMap>
__device__ __forceinline__ void transpose_item(const float* W, int N, bf16_t* WT, int ldd, LAS float* scr, int k0, int n0, const ColMap& cm, const float* kscale, int lane) {
    const int sc = cm(n0 + (lane & 31));
#pragma unroll 8
    for (int i = 0; i < 32; ++i) { const int kk = 2 * i + (lane >> 5); float v = 0.f; if (sc >= 0) { v = W[(size_t)(k0 + kk) * N + sc]; if (kscale) v *= kscale[k0 + kk]; } scr[kk * 33 + (lane & 31)] = v; }
    LDS_WAIT(); asm volatile("" ::: "memory");
    const int c = lane & 7;
#pragma unroll
    for (int j = 0; j < 4; ++j) { const int n = (lane >> 3) + 8 * j; const LAS float* s = scr + (8 * c) * 33 + n;
        u32x4 o; o.x = pk2(s[0 * 33], s[1 * 33]); o.y = pk2(s[2 * 33], s[3 * 33]); o.z = pk2(s[4 * 33], s[5 * 33]); o.w = pk2(s[6 * 33], s[7 * 33]);
        *(u32x4*)(WT + (size_t)(n0 + n) * ldd + k0 + 8 * c) = o; }
    LDS_WAIT(); asm volatile("" ::: "memory");
}
__device__ __forceinline__ void transpose_item_v4(const float* Wsrc, int N, bf16_t* WTdst, int ldd, LAS float* scr, int lane) {
    const int c4 = (lane & 7) * 4, kr = lane >> 3;
    f32x4 t[8];
#pragma unroll
    for (int i = 0; i < 8; ++i) t[i] = *(const f32x4*)(Wsrc + (size_t)(i * 8 + kr) * N + c4);
#pragma unroll
    for (int i = 0; i < 8; ++i) { const int kk = i * 8 + kr; scr[(c4 + 0) * 65 + kk] = t[i].x; scr[(c4 + 1) * 65 + kk] = t[i].y; scr[(c4 + 2) * 65 + kk] = t[i].z; scr[(c4 + 3) * 65 + kk] = t[i].w; }
    LDS_WAIT(); asm volatile("" ::: "memory");
    const int c = lane & 7;
#pragma unroll
    for (int j = 0; j < 4; ++j) { const int n = (lane >> 3) + 8 * j; const LAS float* p = scr + n * 65 + 8 * c;
        u32x4 o; o.x = pk2(p[0], p[1]); o.y = pk2(p[2], p[3]); o.z = pk2(p[4], p[5]); o.w = pk2(p[6], p[7]);
        *(u32x4*)(WTdst + (size_t)n * ldd + 8 * c) = o; }
    LDS_WAIT(); asm volatile("" ::: "memory");
}
struct WinMap {
    __device__ __forceinline__ int operator()(int n) const {
        if (n < 512) { const int t = n & 31; return (n & ~31) + (t >> 1) + 16 * (t & 1); }
        if (n < 1152) return n;
        if (n < 1184) { const int t = n - 1152; return 1152 + (t >> 1) + 16 * (t & 1); }
        if (n < 1280) return -1;
        if (n < 2048) { const int u = n - 1280, t = u & 63; return 1184 + (u & ~63) + (t >> 1) + 32 * (t & 1); }
        if (n < 2432) return 1952 + (n - 2048);
        return -1;
    }
};
struct UqMap { __device__ __forceinline__ int operator()(int n) const { if (n >= 576) return -1; const int h = n / 96, t = n - 96 * h; if (t < 64) return n; const int u = t - 64; return 96 * h + 64 + (u >> 1) + 16 * (u & 1); } };
struct IdMap { __device__ __forceinline__ int operator()(int n) const { return n; } };
struct W13Map { __device__ __forceinline__ int operator()(int n) const { return (n >> 8) * 128 + (n & 127); } };

__device__ __forceinline__ void p0_prologue(Frame& F, const Args& a) {
    LAS float* scr = (LAS float*)(F.lds + F.wave * 16384);
    { float2* r32 = (float2*)(F.ws + WS_ROPE32); float2* r64 = (float2*)(F.ws + WS_ROPE64);
      for (int i = F.gw * 64 + F.lane; i < 4096 * 16; i += F.NGW * 64) { const int pos = i >> 4, j = i & 15; const float inv = 1.0f / powf(10000.0f, (float)(2 * j) / 32.0f); const float ang = (float)pos * inv; r32[i] = make_float2(cosf(ang), sinf(ang)); }
      for (int i = F.gw * 64 + F.lane; i < 4096 * 32; i += F.NGW * 64) { const int pos = i >> 5, j = i & 31; const float inv = 1.0f / powf(10000.0f, (float)(2 * j) / 64.0f); const float ang = (float)pos * inv; r64[i] = make_float2(cosf(ang), sinf(ang)); } }
    constexpr int I_WIN = (1024 / 64) * (2560 / 32), I_WOUT = (1024 / 64) * (1024 / 32), I_UQ = (256 / 64) * (768 / 32), I_UKV = (256 / 64) * (768 / 32);
    constexpr int PER_L = I_WIN + I_WOUT + I_UQ + I_UKV;
    for (int it = F.gw; it < DEPTH * PER_L; it += F.NGW) {
        const int l = it / PER_L; int r = it - l * PER_L;
        if (r < I_WIN) { const int kb = r / 80, nb = r % 80; transpose_item(a.w_in + (size_t)l * 1024 * 2336, 2336, (bf16_t*)(F.ws + WS_WIN) + (size_t)l * 2560 * 1024, 1024, scr, kb * 64, nb * 32, WinMap(), nullptr, F.lane); continue; } r -= I_WIN;
        if (r < I_WOUT) { const int kb = r / 32, nb = r % 32; transpose_item(a.w_out + (size_t)l * 1024 * 1024, 1024, (bf16_t*)(F.ws + WS_WOUT) + (size_t)l * 1024 * 1024, 1024, scr, kb * 64, nb * 32, IdMap(), nullptr, F.lane); continue; } r -= I_WOUT;
        if (r < I_UQ) { const int kb = r / 24, nb = r % 24; transpose_item(a.mla_w_uq + (size_t)l * 256 * 576, 576, (bf16_t*)(F.ws + WS_WUQ) + (size_t)l * 768 * 256, 256, scr, kb * 64, nb * 32, UqMap(), a.mla_q_norm + l * 256, F.lane); continue; } r -= I_UQ;
        { const int kb = r / 24, nb = r % 24; bf16_t* dst = (bf16_t*)(F.ws + WS_WUKV) + (size_t)l * 768 * 256;
          if (kb < 2) transpose_item(a.mla_w_ukv + (size_t)l * 128 * 768, 768, dst, 256, scr, kb * 64, nb * 32, IdMap(), a.mla_kv_norm + l * 128, F.lane);
          else { const int c = F.lane & 7;
#pragma unroll
              for (int j = 0; j < 4; ++j) { const int n = (F.lane >> 3) + 8 * j; *(u32x4*)(dst + (size_t)(nb * 32 + n) * 256 + kb * 64 + 8 * c) = (u32x4){0u, 0u, 0u, 0u}; } } }
    }
    bf16_t* XB = (bf16_t*)(F.ws + WS_XB);
    for (int m = F.gw; m < NTOK; m += F.NGW) {
        const float* src = (m < NTOK_P) ? a.x_prompt + (size_t)m * DM : a.x_sample + (size_t)(m - NTOK_P) * DM;
#pragma unroll
        for (int j = 0; j < 4; ++j) { const f32x4 v = *((const f32x4*)src + F.lane + 64 * j); *((f32x4*)(a.out + (size_t)m * DM) + F.lane + 64 * j) = v;
            u32x2 w; w.x = pk2(v.x, v.y); w.y = pk2(v.z, v.w); *((u32x2*)(XB + (size_t)m * DM) + F.lane + 64 * j) = w; }
    }
}

template <class Epi, class RowMap>
__device__ __forceinline__ void sg_tile(const bf16_t* A, int lda, const bf16_t* B0, const bf16_t* B1, int ldb, int K, int m0, int c0, const Epi& E, const RowMap& RM, int lane) {
    const int r32 = lane & 31, hi = lane >> 5;
    const bf16_t* ap = A + (size_t)RM.src(m0 + r32) * lda + 8 * hi;
    const bf16_t* b0p = B0 + (size_t)r32 * ldb + 8 * hi;
    const bf16_t* b1p = B1 + (size_t)r32 * ldb + 8 * hi;
    f32x16 acc0 = {}, acc1 = {};
#pragma unroll 4
    for (int k = 0; k < K; k += 16) {
        const bf16x8 af = *(const bf16x8*)(ap + k), bf0 = *(const bf16x8*)(b0p + k), bf1 = *(const bf16x8*)(b1p + k);
        acc0 = MFMA32(bf0, af, acc0); acc1 = MFMA32(bf1, af, acc1);
    }
#pragma unroll
    for (int g = 0; g < 4; ++g) { const f32x4 v0 = {acc0[4 * g], acc0[4 * g + 1], acc0[4 * g + 2], acc0[4 * g + 3]}, v1 = {acc1[4 * g], acc1[4 * g + 1], acc1[4 * g + 2], acc1[4 * g + 3]};
        E.put(m0 + r32, c0, 8 * g + 4 * hi, v0, v1); }
}
struct IdRows { __device__ __forceinline__ int src(int m) const { return m; } };

__device__ __forceinline__ void store_bf8(bf16_t* p, f32x4 a, f32x4 b) { u32x4 w; w.x = pk2(a.x, a.y); w.y = pk2(a.z, a.w); w.z = pk2(b.x, b.y); w.w = pk2(b.z, b.w); *(u32x4*)p = w; }
__device__ __forceinline__ void store_bf4(bf16_t* p, f32x4 v) { u32x2 w; w.x = pk2(v.x, v.y); w.y = pk2(v.z, v.w); *(u32x2*)p = w; }
struct EpiH {
    static constexpr bool PERM = true;
    bf16_t* H; const float2* rope32; const float2* rope64;
    __device__ __forceinline__ f32x4 xf(int pos, int col, f32x4 v) const {
        if (col < 512 || (col >= HC_KROPE && col < HC_KROPE + 32)) {
            const int j0 = (col & 31) >> 1; const f32x4 cs = *(const f32x4*)(rope32 + pos * 16 + j0);
            f32x4 o; o.x = v.x * cs.x - v.y * cs.y; o.y = v.x * cs.y + v.y * cs.x; o.z = v.z * cs.z - v.w * cs.w; o.w = v.z * cs.w + v.w * cs.z;
            if (col < 256) o = o * SC_A; v = o;
        } else if (col >= HC_CQ && col < HC_CV) {
            const int j0 = ((col - HC_CQ) & 63) >> 1; const f32x4 cs = *(const f32x4*)(rope64 + pos * 32 + j0);
            f32x4 o; o.x = v.x * cs.x - v.y * cs.y; o.y = v.x * cs.y + v.y * cs.x; o.z = v.z * cs.z - v.w * cs.w; o.w = v.z * cs.w + v.w * cs.z;
            if (col < HC_CK) o = o * SC_C; v = o;
        }
        return v;
    }
    __device__ __forceinline__ void put4(int row, int col, f32x4 v) const { store_bf4(H + (size_t)row * HP + col, xf(seqinfo(row).pos, col, v)); }
    __device__ __forceinline__ void put(int row, int c0, int cc, f32x4 v0, f32x4 v1) const { put4(row, c0 + cc, v0); put4(row, c0 + 32 + cc, v1); }
    template <class U> __device__ __forceinline__ void put8(const U&, int row, int col, f32x4 v0, f32x4 v1) const { const int pos = seqinfo(row).pos; store_bf8(H + (size_t)row * HP + col, xf(pos, col, v0), xf(pos, col + 4, v1)); }
};
struct EpiUQ {
    static constexpr bool PERM = true;
    bf16_t* Q; const float* rstd; const float2* rope32;
    __device__ __forceinline__ f32x4 xf(int row, int col, f32x4 v, float rs) const {
        v = v * rs;
        const int t = col % 96;
        if (t >= 64) { const int pos = seqinfo(row).pos; const int j0 = (t - 64) >> 1; const f32x4 cs = *(const f32x4*)(rope32 + pos * 16 + j0);
            f32x4 o; o.x = v.x * cs.x - v.y * cs.y; o.y = v.x * cs.y + v.y * cs.x; o.z = v.z * cs.z - v.w * cs.w; o.w = v.z * cs.w + v.w * cs.z; v = o; }
        return v * SC_B;
    }
    __device__ __forceinline__ void put4(int row, int col, f32x4 v) const { if (col >= 576) return; store_bf4(Q + (size_t)row * QBP + col, xf(row, col, v, rstd[2 * row])); }
    template <class U> __device__ __forceinline__ void put8(const U&, int row, int col, f32x4 v0, f32x4 v1) const { if (col >= 576) return; const float rs = rstd[2 * row]; store_bf8(Q + (size_t)row * QBP + col, xf(row, col, v0, rs), xf(row, col + 4, v1, rs)); }
    __device__ __forceinline__ void put(int row, int c0, int cc, f32x4 v0, f32x4 v1) const { put4(row, c0 + cc, v0); put4(row, c0 + 32 + cc, v1); }
};
struct EpiUKV {
    static constexpr bool PERM = true;
    bf16_t* KV; const float* rstd;
    template <class U> __device__ __forceinline__ void put8(const U&, int row, int col, f32x4 v0, f32x4 v1) const { const float rs = rstd[2 * row + 1]; store_bf8(KV + (size_t)row * KVP + col, v0 * rs, v1 * rs); }
    __device__ __forceinline__ void put4(int row, int col, f32x4 v) const { store_bf4(KV + (size_t)row * KVP + col, v * rstd[2 * row + 1]); }
    __device__ __forceinline__ void put(int row, int c0, int cc, f32x4 v0, f32x4 v1) const { put4(row, c0 + cc, v0); put4(row, c0 + 32 + cc, v1); }
};
struct EpiRes {
    static constexpr bool PERM = false;
    float* X;
    template <class U> __device__ __forceinline__ void put4(const U&, int row, int col, f32x4 v) const { put4(row, col, v); }
    __device__ __forceinline__ void put4(int row, int col, f32x4 v) const { f32x4* p = (f32x4*)(X + (size_t)row * DM + col); *p = *p * DN_ALPHA + v; }
    __device__ __forceinline__ void put(int row, int c0, int cc, f32x4 v0, f32x4 v1) const { put4(row, c0 + cc, v0); put4(row, c0 + 32 + cc, v1); }
};
__device__ __forceinline__ float silu_f(float x) { return x / (1.0f + __expf(-x)); }
struct EpiHid {
    static constexpr bool PERM = true;
    bf16_t* HID;
    __device__ __forceinline__ f32x4 act(f32x4 g, f32x4 u) const { f32x4 o; o.x = silu_f(g.x) * u.x; o.y = silu_f(g.y) * u.y; o.z = silu_f(g.z) * u.z; o.w = silu_f(g.w) * u.w; return o; }
    template <class U> __device__ __forceinline__ void putp8(const U&, int row, int col, f32x4 g0, f32x4 g1, f32x4 u0, f32x4 u1) const { store_bf8(HID + (size_t)row * DEXP + col, act(g0, u0), act(g1, u1)); }
    __device__ __forceinline__ void putp(int row, int col, f32x4 g, f32x4 u) const { f32x4 o; o.x = silu_f(g.x) * u.x; o.y = silu_f(g.y) * u.y; o.z = silu_f(g.z) * u.z; o.w = silu_f(g.w) * u.w; store_bf4(HID + (size_t)row * DEXP + col, o); }
    __device__ __forceinline__ void put(int row, int c0, int cc, f32x4 v0, f32x4 v1) const { putp(row, c0 + cc, v0, v1); }
};
struct EpiY {
    bf16_t* YB; const float* tw; const int* list; int seg0, cnt;
    __device__ __forceinline__ void put4(int row, int col, f32x4 v) const { const int r = row - seg0; if (r >= cnt) return; const int a = list[r]; store_bf4(YB + (size_t)a * DM + col, v * tw[a]); }
    __device__ __forceinline__ void put(int row, int c0, int cc, f32x4 v0, f32x4 v1) const { put4(row, c0 + cc, v0); put4(row, c0 + 32 + cc, v1); }
};

struct EpiYO {
    static constexpr bool PERM = true;
    bf16_t* YB; const float* tw; const int* list; const LAS int* seg;
    template <class U> __device__ __forceinline__ void put8(const U& u, int row, int col, f32x4 v0, f32x4 v1) const {
        const int r = row - __builtin_amdgcn_readfirstlane(seg[u.e]); if (r >= __builtin_amdgcn_readfirstlane(seg[33 + u.e])) return; const int a = list[(size_t)u.e * LIST_CAP + r]; const float w = tw[a]; store_bf8(YB + (size_t)a * DM + col, v0 * w, v1 * w); }
};
template <class Epi>
__device__ __forceinline__ void sg_phase(Frame& F, const bf16_t* A, int lda, const bf16_t* Bt, int ldb, int M, int N, int K, const Epi& E) {
    const int nN = N / 64, items = (M / 32) * nN;
    for (int it = F.gw; it < items; it += F.NGW) { const int mt = it / nN, nt = it - mt * nN;
        sg_tile(A, lda, Bt + (size_t)(nt * 64) * ldb, Bt + (size_t)(nt * 64 + 32) * ldb, ldb, K, mt * 32, nt * 64, E, IdRows(), F.lane); }
}


namespace pg8 {
constexpr int BM = 256, BK = 64, HALF = 128, HTB = HALF * BK * 2, NXCD = 8, WGM = 8;
__host__ __device__ __forceinline__ int lds_byte(int r, int c) { const int st = (r >> 4) * 2 + (c >> 5), rr = r & 15, cc = c & 31, ob = rr * 64 + cc * 2; return st * 1024 + (ob ^ (((ob >> 9) & 1) << 5)); }
__host__ __device__ __forceinline__ void stage_rc(int b, int& R, int& C) { const int st = b / 1024, sb = b % 1024, swz = sb ^ (((sb >> 9) & 1) << 5); R = (st >> 1) * 16 + swz / 64; C = (st & 1) * 32 + (swz % 64) / 2; }
__host__ __device__ __forceinline__ int perm32(int rho) { const int n = rho >> 4, i = rho & 15; return 8 * (i >> 2) + 4 * n + (i & 3); }
struct Unit { int pm, pn, e; const char* a; const char* b; };
__device__ __forceinline__ bool order_next(int i, int G, int c, int nM, int nN, int& pm, int& pn) {
    const int nwg = nM * nN; const long L = (long)i * G + c; if (L >= nwg) return false;
    int wgid = (int)L; { const int q = nwg / NXCD, r = nwg % NXCD, xcd = wgid % NXCD, off = wgid / NXCD; wgid = (xcd < r ? xcd * (q + 1) : r * (q + 1) + (xcd - r) * q) + off; }
    const int nig = WGM * nN, gid = wgid / nig, fm = gid * WGM, gsz = (nM - fm) < WGM ? (nM - fm) : WGM;
    pm = fm + ((wgid % nig) % gsz); pn = (wgid % nig) / gsz; return true;
}
struct DenseSched {
    const char* A; const char* Bt; int nM, nN, G, c; size_t tstepA, tstepB;
    __device__ __forceinline__ void init(const bf16_t* A_, int lda, const bf16_t* Bt_, int M, int N, int K, int G_, int c_) { A = (const char*)A_; Bt = (const char*)Bt_; nM = M / BM; nN = N / BM; G = G_; c = c_; tstepA = (size_t)BM * lda * 2; tstepB = (size_t)BM * K * 2; }
    __device__ __forceinline__ bool next(int i, Unit& u) const { if (!order_next(i, G, c, nM, nN, u.pm, u.pn)) return false; u.e = 0; u.a = A + (size_t)u.pm * tstepA; u.b = Bt + (size_t)u.pn * tstepB; return true; }
    __device__ __forceinline__ unsigned arow(const Unit&, int) const { return 0u; }
};
template <class Epi, bool PAIR> struct EpiApply;
template <class Epi, class Sched, bool GATHER, bool PAIR>
__device__ __forceinline__ void gemm_phase(LAS unsigned char* lds, int tid, int K, int lda, const Sched& S, const Epi& E) {
    const int wid = __builtin_amdgcn_readfirstlane(tid >> 6), lane = tid & 63, wr = wid >> 2, wc = wid & 3, fr = lane & 15, fq = lane >> 4;
    const int nt = K / BK;
    unsigned voffA[2], voffB[2]; int RA[2], CA[2];
#pragma unroll
    for (int i = 0; i < 2; ++i) { int R, C; stage_rc(tid * 16 + i * 8192, R, C); const int Rb = Epi::PERM ? ((R & ~31) + perm32(R & 31)) : R; RA[i] = R; CA[i] = C;
        voffA[i] = (unsigned)(R * lda + C) * 2u; voffB[i] = (unsigned)(Rb * K + C) * 2u; }
    const size_t kstep = (size_t)(BK * 2);
    const size_t hstepA = (size_t)HALF * lda * 2, hstepB = (size_t)HALF * K * 2;
    const unsigned ldsw = (unsigned)wid * 1024u;
    const int aoff = lds_byte(wr * 64 + fr, fq * 8), boff = lds_byte(wc * 32 + fr, fq * 8);
#define PG8_SA(b, h) (((b) * 2 + (h)) * HTB)
#define PG8_SB(b, h) ((4 + (b) * 2 + (h)) * HTB)
#define PG8_STAGE(bufoff, gbase, voff) do { _Pragma("unroll") for (int _i = 0; _i < 2; ++_i) \
        __builtin_amdgcn_global_load_lds((const unsigned*)((const char*)(gbase) + (voff)[_i]), (LAS unsigned*)(lds + (bufoff) + ldsw + _i * 8192), 16, 0, 0); } while (0)
#define PG8_STAGE_A(bufoff, ab, vg, h, koff) do { if (GATHER) { PG8_STAGE(bufoff, (ab) + (koff), (vg)[h]); } else { PG8_STAGE(bufoff, (ab) + (h) * hstepA + (koff), voffA); } } while (0)
#define PG8_LDA(dst, b, h) do { _Pragma("unroll") for (int m = 0; m < 4; ++m) _Pragma("unroll") for (int k = 0; k < 2; ++k) dst[m][k] = *(const LAS bf16x8*)(lds + PG8_SA(b, h) + aoff + m * 2048 + k * 1024); } while (0)
#define PG8_LDB(dst, b, h) do { _Pragma("unroll") for (int n = 0; n < 2; ++n) _Pragma("unroll") for (int k = 0; k < 2; ++k) dst[n][k] = *(const LAS bf16x8*)(lds + PG8_SB(b, h) + boff + n * 2048 + k * 1024); } while (0)
#define PG8_MMA(ai, bj, At, Bt) do { __builtin_amdgcn_s_setprio(1); _Pragma("unroll") for (int m = 0; m < 4; ++m) _Pragma("unroll") for (int n = 0; n < 2; ++n) _Pragma("unroll") for (int k = 0; k < 2; ++k) \
        acc[ai][bj][m][n] = __builtin_amdgcn_mfma_f32_16x16x32_bf16(Bt[n][k], At[m][k], acc[ai][bj][m][n], 0, 0, 0); __builtin_amdgcn_s_setprio(0); } while (0)
#define PG8_WAIT_V(n) asm volatile("s_waitcnt vmcnt(" #n ")" ::: "memory")
#define PG8_WAIT_L(n) asm volatile("s_waitcnt lgkmcnt(" #n ")" ::: "memory")
#define PG8_BAR __builtin_amdgcn_s_barrier()
#define PG8_SCHED __builtin_amdgcn_sched_barrier(0)
    Unit cur, nxt; int ui = 0;
    if (!S.next(0, cur)) return;
    f32x4 acc[2][2][4][2];
#pragma unroll
    for (int a = 0; a < 2; ++a)
#pragma unroll
        for (int b = 0; b < 2; ++b)
#pragma unroll
            for (int m = 0; m < 4; ++m)
#pragma unroll
                for (int n = 0; n < 2; ++n) acc[a][b][m][n] = (f32x4){0.f, 0.f, 0.f, 0.f};
    bf16x8 At[4][2], B0[2][2], B1[2][2];
    unsigned vgc[2][2] = {{0u, 0u}, {0u, 0u}}, vgn[2][2] = {{0u, 0u}, {0u, 0u}};
    if (GATHER) {
#pragma unroll
        for (int h = 0; h < 2; ++h)
#pragma unroll
            for (int i = 0; i < 2; ++i) vgc[h][i] = S.arow(cur, h * HALF + RA[i]) * (unsigned)(lda * 2) + (unsigned)CA[i] * 2u;
    }
    const char* cA = cur.a; const char* cB = cur.b;
    PG8_STAGE(PG8_SB(0, 0), cB, voffB); PG8_STAGE(PG8_SB(0, 1), cB + hstepB, voffB); PG8_STAGE_A(PG8_SA(0, 0), cA, vgc, 0, 0); PG8_STAGE_A(PG8_SA(0, 1), cA, vgc, 1, 0);
    if (wr == 1) PG8_BAR;
    PG8_WAIT_V(2); PG8_BAR;
    PG8_STAGE(PG8_SB(1, 0), cB + kstep, voffB); PG8_STAGE_A(PG8_SA(1, 0), cA, vgc, 0, kstep); PG8_STAGE(PG8_SB(1, 1), cB + hstepB + kstep, voffB);
    PG8_WAIT_V(6); PG8_BAR;
    for (;;) {
        const bool has_next = S.next(ui + 1, nxt);
        const char* nA = has_next ? nxt.a : cA; const char* nB = has_next ? nxt.b : cB;
        if (GATHER) {
#pragma unroll
            for (int h = 0; h < 2; ++h)
#pragma unroll
                for (int i = 0; i < 2; ++i) vgn[h][i] = has_next ? (S.arow(nxt, h * HALF + RA[i]) * (unsigned)(lda * 2) + (unsigned)CA[i] * 2u) : vgc[h][i];
        }
#pragma clang loop unroll(disable)
        for (int t = 0; t < nt; t += 2) {
            const bool last = (t == nt - 2);
            const size_t k1 = (size_t)(t + 1) * kstep;
            const char* a2 = last ? nA : cA; const char* b2 = last ? nB : cB + (size_t)(t + 2) * kstep; const size_t ka2 = last ? 0 : (size_t)(t + 2) * kstep;
            const char* b3 = b2 + kstep; const size_t ka3 = ka2 + kstep;
            unsigned v2[2][2];
#pragma unroll
            for (int h = 0; h < 2; ++h)
#pragma unroll
                for (int i = 0; i < 2; ++i) v2[h][i] = last ? vgn[h][i] : vgc[h][i];
            PG8_LDB(B0, 0, 0); PG8_LDB(B1, 0, 1); PG8_SCHED; PG8_LDA(At, 0, 0); PG8_STAGE_A(PG8_SA(1, 1), cA, vgc, 1, k1);
            PG8_WAIT_V(8); PG8_WAIT_L(0); PG8_BAR; PG8_MMA(0, 0, At, B0); PG8_MMA(0, 1, At, B1); PG8_BAR; PG8_SCHED;
            PG8_LDA(At, 0, 1); PG8_STAGE(PG8_SB(0, 0), b2, voffB); PG8_STAGE(PG8_SB(0, 1), b2 + hstepB, voffB); PG8_STAGE_A(PG8_SA(0, 0), a2, v2, 0, ka2);
            PG8_WAIT_V(8); PG8_WAIT_L(0); PG8_BAR; PG8_MMA(1, 0, At, B0); PG8_MMA(1, 1, At, B1); PG8_BAR; PG8_SCHED;
            PG8_LDB(B0, 1, 0); PG8_LDB(B1, 1, 1); PG8_SCHED; PG8_LDA(At, 1, 0); PG8_STAGE_A(PG8_SA(0, 1), a2, v2, 1, ka2);
            PG8_WAIT_V(8); PG8_WAIT_L(0); PG8_BAR; PG8_MMA(0, 0, At, B0); PG8_MMA(0, 1, At, B1); PG8_BAR; PG8_SCHED;
            PG8_LDA(At, 1, 1); PG8_STAGE(PG8_SB(1, 0), b3, voffB); PG8_STAGE(PG8_SB(1, 1), b3 + hstepB, voffB); PG8_STAGE_A(PG8_SA(1, 0), a2, v2, 0, ka3);
            PG8_WAIT_V(8); PG8_WAIT_L(0); PG8_BAR; PG8_MMA(1, 0, At, B0); PG8_MMA(1, 1, At, B1); PG8_BAR; PG8_SCHED;
        }
        if (wr == 0) PG8_BAR;
        { int fr_ = fr, fq_ = fq; asm volatile("" : "+v"(fr_), "+v"(fq_));
          EpiApply<Epi, PAIR>::run(E, acc, cur, wr, wc, fr_, fq_); }
        if (!has_next) break;
#pragma unroll
        for (int a = 0; a < 2; ++a)
#pragma unroll
            for (int b = 0; b < 2; ++b)
#pragma unroll
                for (int m = 0; m < 4; ++m)
#pragma unroll
                    for (int n = 0; n < 2; ++n) acc[a][b][m][n] = (f32x4){0.f, 0.f, 0.f, 0.f};
        cur = nxt; cA = nA; cB = nB; ++ui;
        if (GATHER) {
#pragma unroll
            for (int h = 0; h < 2; ++h)
#pragma unroll
                for (int i = 0; i < 2; ++i) vgc[h][i] = vgn[h][i];
        }
        if (wr == 1) PG8_BAR;
    }
    PG8_WAIT_V(0);
    PG8_BAR;
#undef PG8_SA
#undef PG8_SB
#undef PG8_STAGE
#undef PG8_STAGE_A
#undef PG8_LDA
#undef PG8_LDB
#undef PG8_MMA
#undef PG8_WAIT_V
#undef PG8_WAIT_L
#undef PG8_BAR
#undef PG8_SCHED
}
template <class Epi> struct EpiApply<Epi, false> {
    static __device__ __forceinline__ void run(const Epi& E, const f32x4 (&acc)[2][2][4][2], const Unit& u, int wr, int wc, int fr, int fq) {
#pragma unroll
        for (int ai = 0; ai < 2; ++ai)
#pragma unroll
            for (int m = 0; m < 4; ++m) { const int row = u.pm * BM + ai * HALF + wr * 64 + m * 16 + fr;
#pragma unroll
                for (int bj = 0; bj < 2; ++bj) {
                    if constexpr (Epi::PERM) E.put8(u, row, u.pn * BM + bj * HALF + wc * 32 + 8 * fq, acc[ai][bj][m][0], acc[ai][bj][m][1]);
                    else { E.put4(u, row, u.pn * BM + bj * HALF + wc * 32 + 4 * fq, acc[ai][bj][m][0]); E.put4(u, row, u.pn * BM + bj * HALF + wc * 32 + 16 + 4 * fq, acc[ai][bj][m][1]); } }
                asm volatile("" ::: "memory"); }
    }
};
template <class Epi> struct EpiApply<Epi, true> {
    static __device__ __forceinline__ void run(const Epi& E, const f32x4 (&acc)[2][2][4][2], const Unit& u, int wr, int wc, int fr, int fq) {
#pragma unroll
        for (int ai = 0; ai < 2; ++ai)
#pragma unroll
            for (int m = 0; m < 4; ++m) { const int row = u.pm * BM + ai * HALF + wr * 64 + m * 16 + fr;
                E.putp8(u, row, u.pn * HALF + wc * 32 + 8 * fq, acc[ai][0][m][0], acc[ai][0][m][1], acc[ai][1][m][0], acc[ai][1][m][1]); asm volatile("" ::: "memory"); }
    }
};
}

__device__ __forceinline__ void rowstat_pass(Frame& F) {
    const bf16_t* H = (const bf16_t*)(F.ws + WS_H); float* rstd = (float*)(F.ws + WS_RSTD);
    for (int m = F.gw; m < NTOK; m += F.NGW) {
        const bf16_t* hr = H + (size_t)m * HP;
        const u32x2 q = *((const u32x2*)(hr + HC_CQ_LAT) + F.lane);
        const unsigned kv = *((const unsigned*)(hr + HC_CKV) + F.lane);
        float a0 = bf2f(q.x & 0xffff), a1 = bf2f(q.x >> 16), a2 = bf2f(q.y & 0xffff), a3 = bf2f(q.y >> 16), b0 = bf2f(kv & 0xffff), b1 = bf2f(kv >> 16);
        const float sq = wave_sum(a0 * a0 + a1 * a1 + a2 * a2 + a3 * a3), sk = wave_sum(b0 * b0 + b1 * b1);
        if (F.lane == 0) { rstd[2 * m] = 1.0f / sqrtf(sq * (1.0f / 256.0f) + RMS_EPS); rstd[2 * m + 1] = 1.0f / sqrtf(sk * (1.0f / 128.0f) + RMS_EPS); }
    }
}
__device__ __forceinline__ void red8(float (&v)[8], int lane) {
    float a[4], b[2], c;
#pragma unroll
    for (int i = 0; i < 4; ++i) a[i] = xpair32(v[i], v[i + 4]);
    { const bool up = (lane & 16) != 0;
#pragma unroll
      for (int i = 0; i < 2; ++i) { const float send = up ? a[i] : a[i + 2], keep = up ? a[i + 2] : a[i]; b[i] = keep + shx<16>(send); } }
    { const bool up = (lane & 8) != 0; const float send = up ? b[0] : b[1], keep = up ? b[1] : b[0]; c = keep + shx<8>(send); }
    c += shx<4>(c); c += shx<2>(c); c += shx<1>(c);
#pragma unroll
    for (int i = 0; i < 8; ++i) v[i] = __uint_as_float(__builtin_amdgcn_readlane(__float_as_uint(c), ((i >> 2) & 1) * 32 + ((i >> 1) & 1) * 16 + (i & 1) * 8));
}
__device__ __forceinline__ void red4(float (&v)[4], int lane) {
    float a[2], c;
#pragma unroll
    for (int i = 0; i < 2; ++i) a[i] = xpair32(v[i], v[i + 2]);
    { const bool up = (lane & 16) != 0; const float send = up ? a[0] : a[1], keep = up ? a[1] : a[0]; c = keep + shx<16>(send); }
    c += shx<8>(c); c += shx<4>(c); c += shx<2>(c); c += shx<1>(c);
#pragma unroll
    for (int i = 0; i < 4; ++i) v[i] = __uint_as_float(__builtin_amdgcn_readlane(__float_as_uint(c), ((i >> 1) & 1) * 32 + (i & 1) * 16));
}
__device__ __forceinline__ void ln1_route_pass(Frame& F, const Args& a, int layer) {
    bf16_t* XB = (bf16_t*)(F.ws + WS_XB); float* tw = (float*)(F.ws + WS_TW); int* list = (int*)(F.ws + WS_LIST);
    const float* g = a.ln1_g + layer * DM; const float* bb = a.ln1_b + layer * DM;
    const float* wc = a.moe_w_coarse + (size_t)layer * DM * 4; const float* wf = a.moe_w_fine + (size_t)layer * 4 * DM * 8;
    for (int q = F.tid; q < 4 * 1024 * 2; q += NTHREADS) { const int hf = q & 1, k = (q >> 1) & 1023, gg = q >> 11; const int l = (k & 255) >> 2, e = k & 3, j = k >> 8;
        *(LAS f32x4*)(F.lds + (size_t)(gg * 2048 + ((j * 4 + e) * 2 + hf) * 64 + l) * 16) = *((const f32x4*)wf + q); }
    f32x4 wcr[4][4];
#pragma unroll
    for (int j = 0; j < 4; ++j)
#pragma unroll
        for (int e = 0; e < 4; ++e) wcr[j][e] = *(const f32x4*)(wc + (size_t)(4 * F.lane + 256 * j + e) * 4);
    __syncthreads();
    f32x4 vn[2][4];
#pragma unroll
    for (int rr = 0; rr < 2; ++rr) { const int mm = F.gw + rr * F.NGW; if (mm < NTOK) {
#pragma unroll
        for (int j = 0; j < 4; ++j) vn[rr][j] = *((const f32x4*)(a.out + (size_t)mm * DM) + F.lane + 64 * j); } }
    for (int m0 = F.gw; m0 < NTOK; m0 += 2 * F.NGW) {
        f32x4 vc[2][4];
#pragma unroll
        for (int rr = 0; rr < 2; ++rr)
#pragma unroll
            for (int j = 0; j < 4; ++j) vc[rr][j] = vn[rr][j];
#pragma unroll
        for (int rr = 0; rr < 2; ++rr) { const int mm = m0 + (2 + rr) * F.NGW; if (mm < NTOK) {
#pragma unroll
            for (int j = 0; j < 4; ++j) vn[rr][j] = *((const f32x4*)(a.out + (size_t)mm * DM) + F.lane + 64 * j); } }
#pragma unroll
      for (int rr = 0; rr < 2; ++rr) { const int m = m0 + rr * F.NGW; if (m < NTOK) {
        float* xr = a.out + (size_t)m * DM;
        f32x4 v[4]; float s = 0.f;
#pragma unroll
        for (int j = 0; j < 4; ++j) { v[j] = vc[rr][j]; s += (v[j].x + v[j].y) + (v[j].z + v[j].w); }
        const float mean = wave_sum(s) * (1.f / DM); float s2 = 0.f;
#pragma unroll
        for (int j = 0; j < 4; ++j) { v[j] = v[j] - mean; s2 += (v[j].x * v[j].x + v[j].y * v[j].y) + (v[j].z * v[j].z + v[j].w * v[j].w); }
        const float rs = 1.f / sqrtf(wave_sum(s2) * (1.f / DM) + LN_EPS);
        float cl[4] = {0.f, 0.f, 0.f, 0.f};
#pragma unroll
        for (int j = 0; j < 4; ++j) { const int c = 4 * F.lane + 256 * j; const f32x4 gg = *(const f32x4*)(g + c), bv = *(const f32x4*)(bb + c); v[j] = v[j] * rs * gg + bv;
            *((f32x4*)xr + F.lane + 64 * j) = v[j]; u32x2 w; w.x = pk2(v[j].x, v[j].y); w.y = pk2(v[j].z, v[j].w); *((u32x2*)(XB + (size_t)m * DM) + F.lane + 64 * j) = w;
#pragma unroll
            for (int e = 0; e < 4; ++e) { const f32x4 w4 = wcr[j][e]; const float xe = v[j][e]; cl[0] += xe * w4.x; cl[1] += xe * w4.y; cl[2] += xe * w4.z; cl[3] += xe * w4.w; } }
        red4(cl, F.lane);
        int grp = 0; float cm = cl[0];
#pragma unroll
        for (int e = 1; e < 4; ++e) if (cl[e] > cm) { cm = cl[e]; grp = e; }
        float den = 0.f;
#pragma unroll
        for (int e = 0; e < 4; ++e) den += __expf(cl[e] - cm);
        const float pg = 1.0f / den;
        grp = __builtin_amdgcn_readfirstlane(grp);
        const LAS f32x4* wl = (const LAS f32x4*)(F.lds) + grp * 2048 + F.lane;
        float fl[8] = {0.f, 0.f, 0.f, 0.f, 0.f, 0.f, 0.f, 0.f};
#pragma unroll
        for (int j = 0; j < 4; ++j)
#pragma unroll
            for (int e = 0; e < 4; ++e) { const f32x4 wa = wl[((j * 4 + e) * 2) * 64], wb = wl[((j * 4 + e) * 2 + 1) * 64]; const float xe = v[j][e];
                fl[0] += xe * wa.x; fl[1] += xe * wa.y; fl[2] += xe * wa.z; fl[3] += xe * wa.w; fl[4] += xe * wb.x; fl[5] += xe * wb.y; fl[6] += xe * wb.z; fl[7] += xe * wb.w; }
        red8(fl, F.lane);
        int i0 = 0; float v0 = fl[0];
#pragma unroll
        for (int e = 1; e < 8; ++e) if (fl[e] > v0) { v0 = fl[e]; i0 = e; }
        int i1 = -1; float v1 = -3.0e38f;
#pragma unroll
        for (int e = 0; e < 8; ++e) if (e != i0 && fl[e] > v1) { v1 = fl[e]; i1 = e; }
        const float e1 = __expf(v1 - v0), w0 = pg / (1.0f + e1), w1 = pg * e1 / (1.0f + e1);
        if (F.lane < 2) { const int e = grp * 8 + (F.lane == 0 ? i0 : i1); const int a_id = 2 * m + F.lane;
            const unsigned pos = __hip_atomic_fetch_add(F.ctl + CW_CNT + layer * 64 + e, 1u, RLX_AGENT);
            list[(size_t)e * LIST_CAP + pos] = a_id; tw[a_id] = (F.lane == 0) ? w0 : w1; }
          } }
    }
    __syncthreads();
}
__device__ __forceinline__ void ln2_pass(Frame& F, const Args& a, int layer) {
    bf16_t* XB = (bf16_t*)(F.ws + WS_XB); const bf16_t* YB = (const bf16_t*)(F.ws + WS_YB);
    const float* g = a.ln2_g + layer * DM; const float* bb = a.ln2_b + layer * DM;
    f32x4 xn[2][4]; u32x2 pn[2][4], qn[2][4];
#define LN2_LOAD(rr, mm) do { const bf16_t* y0_ = YB + (size_t)(2 * (mm)) * DM; _Pragma("unroll") for (int j = 0; j < 4; ++j) { xn[rr][j] = *((const f32x4*)(a.out + (size_t)(mm) * DM) + F.lane + 64 * j); \
        pn[rr][j] = *((const u32x2*)y0_ + F.lane + 64 * j); qn[rr][j] = *((const u32x2*)(y0_ + DM) + F.lane + 64 * j); } } while (0)
#pragma unroll
    for (int rr = 0; rr < 2; ++rr) { const int mm = F.gw + rr * F.NGW; if (mm < NTOK) LN2_LOAD(rr, mm); }
    for (int m0 = F.gw; m0 < NTOK; m0 += 2 * F.NGW) {
        f32x4 xc[2][4]; u32x2 pc[2][4], qc[2][4];
#pragma unroll
        for (int rr = 0; rr < 2; ++rr)
#pragma unroll
            for (int j = 0; j < 4; ++j) { xc[rr][j] = xn[rr][j]; pc[rr][j] = pn[rr][j]; qc[rr][j] = qn[rr][j]; }
#pragma unroll
        for (int rr = 0; rr < 2; ++rr) { const int mm = m0 + (2 + rr) * F.NGW; if (mm < NTOK) LN2_LOAD(rr, mm); }
#pragma unroll
        for (int rr = 0; rr < 2; ++rr) { const int m = m0 + rr * F.NGW; if (m < NTOK) {
            float* xr = a.out + (size_t)m * DM;
            f32x4 v[4]; float s = 0.f;
#pragma unroll
            for (int j = 0; j < 4; ++j) { v[j] = xc[rr][j] * DN_ALPHA; const u32x2 p = pc[rr][j], q = qc[rr][j];
                v[j].x += bf2f(p.x & 0xffff) + bf2f(q.x & 0xffff); v[j].y += bf2f(p.x >> 16) + bf2f(q.x >> 16); v[j].z += bf2f(p.y & 0xffff) + bf2f(q.y & 0xffff); v[j].w += bf2f(p.y >> 16) + bf2f(q.y >> 16);
                s += (v[j].x + v[j].y) + (v[j].z + v[j].w); }
            const float mean = wave_sum(s) * (1.f / DM); float s2 = 0.f;
#pragma unroll
            for (int j = 0; j < 4; ++j) { v[j] = v[j] - mean; s2 += (v[j].x * v[j].x + v[j].y * v[j].y) + (v[j].z * v[j].z + v[j].w * v[j].w); }
            const float rs = 1.f / sqrtf(wave_sum(s2) * (1.f / DM) + LN_EPS);
#pragma unroll
            for (int j = 0; j < 4; ++j) { const int c = 4 * F.lane + 256 * j; const f32x4 gg = *(const f32x4*)(g + c), bv = *(const f32x4*)(bb + c); v[j] = v[j] * rs * gg + bv;
                *((f32x4*)xr + F.lane + 64 * j) = v[j]; u32x2 w; w.x = pk2(v[j].x, v[j].y); w.y = pk2(v[j].z, v[j].w); *((u32x2*)(XB + (size_t)m * DM) + F.lane + 64 * j) = w; }
        } }
    }
#undef LN2_LOAD
}
__device__ __forceinline__ void moe_convert(Frame& F, const Args& a, int layer) {
    LAS float* scr = (LAS float*)(F.lds + F.wave * 16384);
    constexpr int I_13 = (1024 / 64) * (1024 / 32), I_2 = (512 / 64) * (1024 / 32), PER_E = I_13 + I_2;
    for (int it = F.gw; it < NEXP * PER_E; it += F.NGW) {
        const int e = it / PER_E; int r = it - e * PER_E; const size_t le = (size_t)layer * NEXP + e;
        if (r < I_13) { const int kb = r / 32, nb = r % 32; const float* src = ((nb >> 2) & 1) ? a.moe_w3 : a.moe_w1;
            const int sc0 = ((32 * nb) >> 8) * 128 + ((32 * nb) & 127);
            transpose_item_v4(src + le * 1024 * 512 + (size_t)(kb * 64) * 512 + sc0, 512, (bf16_t*)(F.ws + WS_W13) + (size_t)e * 1024 * 1024 + (size_t)(nb * 32) * 1024 + kb * 64, 1024, scr, F.lane); }
        else { r -= I_13; const int kb = r / 32, nb = r % 32;
            transpose_item_v4(a.moe_w2 + le * 512 * 1024 + (size_t)(kb * 64) * 1024 + nb * 32, 1024, (bf16_t*)(F.ws + WS_W2) + (size_t)e * 1024 * 512 + (size_t)(nb * 32) * 512 + kb * 64, 512, scr, F.lane); }
    }
}

struct RowSrc { const bf16_t* p; long pitch; };
constexpr int SA_P = 0, SA_V = 4096, SA_AL = 12288, SA_RL = 12544;
template <int NC0, int NC1, int MODE>
__device__ __forceinline__ void sattn_core(const bf16x8* qf, RowSrc k0, RowSrc k1, RowSrc vs, int kb_lo, int kb_hi, int qidx0, float lse_ref, LAS unsigned char* scr, int lane, f32x16* o, float& lse_out) {
    const int r32 = lane & 31, hi = lane >> 5;
    LAS bf16_t* Pb = (LAS bf16_t*)(scr + SA_P); LAS bf16_t* Vb = (LAS bf16_t*)(scr + SA_V); LAS float* Al = (LAS float*)(scr + SA_AL);
    float m = -1.0e30f, l = 0.f;
    if (MODE != 1) { o[0] = f32x16{}; o[1] = f32x16{}; }
    for (int kb = kb_lo; kb < kb_hi; ++kb) {
        const long key = (long)kb * 32 + r32;
        f32x16 s = {};
#pragma unroll
        for (int c = 0; c < NC0; ++c) { const bf16x8 kf = *(const bf16x8*)(k0.p + key * k0.pitch + 16 * c + 8 * hi); s = MFMA32(kf, qf[c], s); }
#pragma unroll
        for (int c = 0; c < NC1; ++c) { const bf16x8 kf = *(const bf16x8*)(k1.p + key * k1.pitch + 16 * c + 8 * hi); s = MFMA32(kf, qf[NC0 + c], s); }
        bool valid[16];
#pragma unroll
        for (int r = 0; r < 16; ++r) { if (MODE == 0) valid[r] = true; else { const int d = kb * 32 + crow(r, hi) - (qidx0 + r32); valid[r] = (d <= 64 && d >= -64); } }
        float p[16];
        if (MODE == 2) {
#pragma unroll
            for (int r = 0; r < 16; ++r) p[r] = valid[r] ? fast_exp2(s[r] - lse_ref) : 0.f;
        } else {
            float mx = -1.0e30f;
#pragma unroll
            for (int r = 0; r < 16; ++r) if (valid[r]) mx = fmaxf(mx, s[r]);
            mx = xmax32(mx);
            const float mn = fmaxf(m, mx), alpha = fast_exp2(m - mn); m = mn;
            float ps = 0.f;
#pragma unroll
            for (int r = 0; r < 16; ++r) { p[r] = valid[r] ? fast_exp2(s[r] - mn) : 0.f; ps += p[r]; }
            l = l * alpha + ps;
            if (MODE == 0) { if (hi == 0) Al[r32] = alpha; }
        }
        if (MODE != 1) {
#pragma unroll
            for (int g = 0; g < 4; ++g) { u32x2 w; w.x = pk2(p[4 * g], p[4 * g + 1]); w.y = pk2(p[4 * g + 2], p[4 * g + 3]); *(LAS u32x2*)(Pb + r32 * 40 + 8 * g + 4 * hi) = w; }
#pragma unroll
            for (int i = 0; i < 4; ++i) { const int idx = i * 64 + lane, kr = idx >> 3, pc = idx & 7; *(LAS u32x4*)(Vb + kr * 72 + pc * 8) = *(const u32x4*)(vs.p + ((long)kb * 32 + kr) * vs.pitch + pc * 8); }
            LDS_WAIT();
            if (MODE == 0) {
#pragma unroll
                for (int r = 0; r < 16; ++r) { const float al = Al[crow(r, hi)]; o[0][r] *= al; o[1][r] *= al; }
            }
#pragma unroll
            for (int st = 0; st < 2; ++st) {
                const bf16x8 pf = *(const LAS bf16x8*)(Pb + r32 * 40 + 16 * st + 8 * hi);
#pragma unroll
                for (int db = 0; db < 2; ++db) { bf16x8 vf;
#pragma unroll
                    for (int j = 0; j < 8; ++j) vf[j] = (short)Vb[(16 * st + 8 * hi + j) * 72 + 32 * db + r32];
                    o[db] = MFMA32(pf, vf, o[db]); }
            }
            LDS_WAIT();
        }
    }
    if (MODE != 2) { l = xsum32(l); lse_out = m + __log2f(l); }
    if (MODE == 0) {
        LAS float* Rl = (LAS float*)(scr + SA_RL);
        if (hi == 0) Rl[r32] = 1.0f / l;
        LDS_WAIT();
#pragma unroll
        for (int r = 0; r < 16; ++r) { const float rl = Rl[crow(r, hi)]; o[0][r] *= rl; o[1][r] *= rl; }
        LDS_WAIT();
    }
}

__device__ __forceinline__ void sattn_phase(Frame& F, const Args& a, int layer, int kind_lo) {
    const bf16_t* H = (const bf16_t*)(F.ws + WS_H); const bf16_t* QB = (const bf16_t*)(F.ws + WS_QB); const bf16_t* KVB = (const bf16_t*)(F.ws + WS_KVB);
    bf16_t* MIX = (bf16_t*)(F.ws + WS_MIX); const float* lsec = (const float*)(F.ws + WS_LSEC);
    LAS unsigned char* scr = F.lds + F.wave * 16384;
    const int lane = F.lane, r32 = lane & 31, hi = lane >> 5;
    float lam, lam_init;
    { const float* lv = a.diff_lambda + layer * 128; float d1 = 0.f, d2 = 0.f;
      for (int i = 0; i < 32; ++i) { d1 += lv[i] * lv[32 + i]; d2 += lv[64 + i] * lv[96 + i]; }
      lam_init = 0.8f - 0.6f * expf(-0.3f * (float)layer); lam = expf(d1) - expf(d2) + lam_init; }
    constexpr int NRB = NTOK / 32;
    const int items = NRB * (4 + 6 + 6);
    for (int it = kind_lo * NRB + F.gw; it < items; it += F.NGW) {
        const int kind = it / NRB, rb = it - kind * NRB; const int m0 = rb * 32; const SeqInfo si = seqinfo(m0);
#if !OPT_ATTN
        if (kind < 4) {
            const int h = kind; f32x16 o0[2], o1[2]; float dummy;
            for (int c = 0; c < 2; ++c) {
                bf16x8 qf[2];
#pragma unroll
                for (int d0 = 0; d0 < 2; ++d0) qf[d0] = *(const bf16x8*)(H + (size_t)(m0 + r32) * HP + HC_AQ + h * 64 + c * 32 + 16 * d0 + 8 * hi);
                const RowSrc ks{H + (size_t)si.base * HP + HC_AK + h * 64 + c * 32, HP}, vs{H + (size_t)si.base * HP + HC_AV + h * 64, HP};
                sattn_core<2, 0, 0>(qf, ks, ks, vs, 0, si.len / 32, 0, 0.f, scr, lane, c == 0 ? o0 : o1, dummy);
            }
            const float* sg = a.diff_subln + layer * 64; const float g0 = sg[r32], g1 = sg[32 + r32];
#pragma unroll
            for (int r = 0; r < 16; ++r) { const float x0 = o0[0][r] - lam * o1[0][r], x1 = o0[1][r] - lam * o1[1][r]; float ss = x0 * x0 + x1 * x1;
                ss += shx<1>(ss); ss += shx<2>(ss); ss += shx<4>(ss); ss += shx<8>(ss); ss += shx<16>(ss);
                const float rs = (1.0f - lam_init) / sqrtf(ss * (1.0f / 64.0f) + RMS_EPS);
                bf16_t* op = MIX + (size_t)(m0 + crow(r, hi)) * DM + MIX_A + h * 64 + r32;
                op[0] = (bf16_t)f2bf(x0 * rs * g0); op[32] = (bf16_t)f2bf(x1 * rs * g1); }
        } else if (kind < 10) {
            const int h = kind - 4; f32x16 o[2]; float dummy; bf16x8 qf[6];
#pragma unroll
            for (int d0 = 0; d0 < 6; ++d0) qf[d0] = *(const bf16x8*)(QB + (size_t)(m0 + r32) * QBP + h * 96 + 16 * d0 + 8 * hi);
            const RowSrc k0{KVB + (size_t)si.base * KVP + h * 128, KVP}, k1{H + (size_t)si.base * HP + HC_KROPE, HP}, vs{KVB + (size_t)si.base * KVP + h * 128 + 64, KVP};
            sattn_core<4, 2, 0>(qf, k0, k1, vs, 0, si.len / 32, 0, 0.f, scr, lane, o, dummy);
#pragma unroll
            for (int r = 0; r < 16; ++r) { bf16_t* op = MIX + (size_t)(m0 + crow(r, hi)) * DM + MIX_B + h * 64 + r32; op[0] = (bf16_t)f2bf(o[0][r]); op[32] = (bf16_t)f2bf(o[1][r]); }
        } else
#endif
        {
            const int gj = kind - 10, g = gj >> 1, hh = gj;
            const int dil = (g == 0) ? 1 : (g == 1 ? 4 : 16); const int L = si.len / dil, bpr = L / 32;
            const int w = (m0 - si.base) / 32, rho = w / bpr, ib = w - rho * bpr, i0 = ib * 32;
            const size_t qrow = (size_t)si.base + (size_t)(i0 + r32) * dil + rho;
            bf16x8 qf[4];
#pragma unroll
            for (int d0 = 0; d0 < 4; ++d0) qf[d0] = *(const bf16x8*)(H + qrow * HP + HC_CQ + hh * 64 + 16 * d0 + 8 * hi);
            const int j = gj & 1; const float l0 = lsec[(0 * (size_t)NTOK + qrow) * 2 + j], l1 = lsec[(1 * (size_t)NTOK + qrow) * 2 + j], l2 = lsec[(2 * (size_t)NTOK + qrow) * 2 + j];
            const float lm = fmaxf(l0, fmaxf(l1, l2)); const float lref = lm + __log2f(fast_exp2(l0 - lm) + fast_exp2(l1 - lm) + fast_exp2(l2 - lm));
            const RowSrc ks{H + ((size_t)si.base + rho) * HP + HC_CK + hh * 64, (long)HP * dil}, vs{H + ((size_t)si.base + rho) * HP + HC_CV + hh * 64, (long)HP * dil};
            int kb_lo = ib - 2, kb_hi = ib + 3; if (kb_lo < 0) kb_lo = 0; if (kb_hi > bpr) kb_hi = bpr;
            f32x16 o[2]; float dummy;
            sattn_core<4, 0, 2>(qf, ks, ks, vs, kb_lo, kb_hi, i0, lref, scr, lane, o, dummy);
#pragma unroll
            for (int r = 0; r < 16; ++r) { const size_t orow = (size_t)si.base + (size_t)(i0 + crow(r, hi)) * dil + rho; bf16_t* op = MIX + orow * DM + MIX_C + hh * 64 + r32; op[0] = (bf16_t)f2bf(o[0][r]); op[32] = (bf16_t)f2bf(o[1][r]); }
        }
    }
}
__device__ __forceinline__ void cstat_phase(Frame& F) {
    const bf16_t* H = (const bf16_t*)(F.ws + WS_H); float* lsec = (float*)(F.ws + WS_LSEC);
    LAS unsigned char* scr = F.lds + F.wave * 16384;
    const int lane = F.lane, r32 = lane & 31, hi = lane >> 5;
    constexpr int NRB = NTOK / 32;
    for (int it = F.gw; it < NRB * 6; it += F.NGW) {
        const int gj = it / NRB, rb = it - gj * NRB, g = gj >> 1, j = gj & 1; const int m0 = rb * 32; const SeqInfo si = seqinfo(m0);
        const int dil = (g == 0) ? 1 : (g == 1 ? 4 : 16); const int L = si.len / dil, bpr = L / 32;
        const int w = (m0 - si.base) / 32, rho = w / bpr, ib = w - rho * bpr, i0 = ib * 32;
        const size_t qrow = (size_t)si.base + (size_t)(i0 + r32) * dil + rho;
        bf16x8 qf[4];
#pragma unroll
        for (int d0 = 0; d0 < 4; ++d0) qf[d0] = *(const bf16x8*)(H + qrow * HP + HC_CQ + gj * 64 + 16 * d0 + 8 * hi);
        const RowSrc ks{H + ((size_t)si.base + rho) * HP + HC_CK + gj * 64, (long)HP * dil};
        int kb_lo = ib - 2, kb_hi = ib + 3; if (kb_lo < 0) kb_lo = 0; if (kb_hi > bpr) kb_hi = bpr;
        float lse; sattn_core<4, 0, 1>(qf, ks, ks, ks, kb_lo, kb_hi, i0, 0.f, scr, lane, nullptr, lse);
        if (hi == 0) lsec[((size_t)g * NTOK + qrow) * 2 + j] = lse;
    }
}


namespace at {
typedef short s16x4 __attribute__((ext_vector_type(4)));
typedef short v4i16_t __attribute__((ext_vector_type(4)));
typedef LAS const unsigned char* lds_cptr;
constexpr int LDS_K = 0, KSLOT_MAX = 12288, LDS_V = 3 * KSLOT_MAX, VSLOT = 8192, LDS_WS = LDS_V + 3 * VSLOT, LDS_OST = LDS_WS + 8 * 256, LDS_TOTAL = LDS_OST + 8 * 8192;
static_assert(LDS_TOTAL <= RING_BYTES, "attention LDS");
constexpr float THR = 8.0f;
__device__ __forceinline__ void glds16(const void* g, unsigned lds_dst) {
    unsigned keep; asm volatile("s_mov_b32 %0, m0\n\ts_mov_b32 m0, %2\n\ts_nop 0\n\tglobal_load_lds_dwordx4 %1, off\n\ts_mov_b32 m0, %0" : "=&s"(keep) : "v"(g), "s"(lds_dst) : "memory"); }
__device__ __forceinline__ s16x4 vtr(lds_cptr p) { return __builtin_bit_cast(s16x4, __builtin_amdgcn_ds_read_tr16_b64_v4i16((LAS v4i16_t*)p)); }
__device__ __forceinline__ unsigned cvtpk(float lo, float hi) { typedef float f2 __attribute__((ext_vector_type(2))); typedef __bf16 b2 __attribute__((ext_vector_type(2))); f2 v = {lo, hi}; b2 b = __builtin_convertvector(v, b2); return __builtin_bit_cast(unsigned, b); }
#define AT_MX3(a, b, c) __builtin_fmaxf(__builtin_fmaxf((a), (b)), (c))
__device__ __forceinline__ float rowmax(const f32x16& p0, const f32x16& p1) {
    float a = AT_MX3(p0[0], p0[1], p1[0]), b = AT_MX3(p0[2], p0[3], p1[1]); a = AT_MX3(a, p1[2], p1[3]);
#pragma unroll
    for (int r = 4; r < 16; r += 4) { a = AT_MX3(a, p0[r], p0[r + 1]); b = AT_MX3(b, p0[r + 2], p0[r + 3]); a = AT_MX3(a, p1[r], p1[r + 1]); b = AT_MX3(b, p1[r + 2], p1[r + 3]); }
    float m = __builtin_fmaxf(a, b); auto rr = __builtin_amdgcn_permlane32_swap(__float_as_uint(m), __float_as_uint(m), false, false);
    return __builtin_fmaxf(__uint_as_float(rr[0]), __uint_as_float(rr[1])); }
#define AT_WAIT_BAR(N) asm volatile("s_waitcnt vmcnt(" #N ") lgkmcnt(0)\n\ts_barrier" ::: "memory")

struct Src { const bf16_t* p; long pitch; };
template <int NC, int NK0, int NK1>
__device__ __forceinline__ void stream(LAS unsigned char* lds, int tid, const bf16_t* qrow, Src k0, Src k1, Src vs, int NT, f32x16& o0, f32x16& o1, float& lsum) {
    asm volatile("" : "+v"(tid));
    constexpr int SLOTK = 2 * NC * 1024, NDMA = (NK1 > 0) ? 3 : 2;
    const int lane = tid & 63, r32 = lane & 31, hi = lane >> 5; const int wid = __builtin_amdgcn_readfirstlane(tid >> 6);
    const unsigned lds0 = (unsigned)(uintptr_t)lds;
    LAS float* wsf = (LAS float*)(lds + LDS_WS) + wid * 64;
    const bf16_t* ksA = k0.p + (long)lane * k0.pitch + (wid % NK0) * 8;
    const bf16_t* ksB = (NK1 > 0) ? k1.p + (long)lane * k1.pitch + (wid % (NK1 > 0 ? NK1 : 1)) * 8 : k0.p;
    const bf16_t* vsp = vs.p + (long)(16 * (wid & 3) + (lane >> 2)) * vs.pitch + (wid >> 2) * 32 + (lane & 3) * 8;
    const unsigned kdA = lds0 + LDS_K + (wid % NK0) * 1024, kdB = lds0 + LDS_K + (NK0 + (wid % (NK1 > 0 ? NK1 : 1))) * 1024, vd = lds0 + LDS_V + wid * 1024;
    const long ktA = 64 * k0.pitch, ktB = 64 * k1.pitch, vt = 64 * vs.pitch;
#define AT_DMA_K(t, slot) do { glds16(ksA + (long)(t) * ktA, (unsigned)__builtin_amdgcn_readfirstlane(kdA + (slot) * SLOTK)); if (NK1 > 0) glds16(ksB + (long)(t) * ktB, (unsigned)__builtin_amdgcn_readfirstlane(kdB + (slot) * SLOTK)); } while (0)
#define AT_DMA_V(t, slot) glds16(vsp + (long)(t) * vt, (unsigned)__builtin_amdgcn_readfirstlane(vd + (slot) * VSLOT))
    const lds_cptr kp0 = (lds_cptr)lds + LDS_K + hi * 1024 + r32 * 16;
    const lds_cptr vp0 = (lds_cptr)lds + LDS_V + ((lane >> 4) & 1) * 32 + (lane & 3) * 8 + (4 * hi + ((lane & 15) >> 2)) * 64;
    AT_DMA_K(0, 0); AT_DMA_V(0, 0); if (NT > 1) AT_DMA_K(1, 1);
    bf16x8 qr[NC];
#pragma unroll
    for (int d0 = 0; d0 < NC; ++d0) qr[d0] = *(const bf16x8*)(qrow + 16 * d0 + 8 * hi);
    float mhat = 0.f, l = 0.f; f32x16 oa = {}, ob = {}, negm = {}, S0, S1; u32x4 pw0, pw1, pw2, pw3;
    asm volatile("" : "+v"(negm));
    AT_WAIT_BAR(0);
    __builtin_amdgcn_s_waitcnt(0);
#pragma unroll
    for (int d0 = 0; d0 < NC; ++d0) asm volatile("" : "+v"(qr[d0]));
    constexpr bool QLDS = (NC > 2);
    const lds_cptr qb = (lds_cptr)lds + LDS_OST + wid * 8192 + lane * 16;
    if (QLDS) {
#pragma unroll
        for (int d0 = 0; d0 < NC; ++d0) *(LAS bf16x8*)(lds + LDS_OST + wid * 8192 + lane * 16 + d0 * 1024) = qr[d0];
        LDS_WAIT();
    }
    int kc = 0, kn1 = 1, kn2 = 2, vpv = 2, vcu = 0, vnx = 1;
    bf16x8 kf[2 * NC], vf[8];
#define AT_SB() __builtin_amdgcn_sched_barrier(0)
#define AT_KRD(kp_, d0) do { kf[2 * (d0)] = *(const LAS bf16x8*)((kp_) + (d0) * 2048); kf[2 * (d0) + 1] = *(const LAS bf16x8*)((kp_) + (d0) * 2048 + 512); if (QLDS) qr[d0] = *(const LAS bf16x8*)(qb + (d0) * 1024); } while (0)
#define AT_KHEAD(slot) do { const lds_cptr kp_ = kp0 + (slot) * SLOTK; AT_KRD(kp_, 0); } while (0)
#define AT_VF(i) ({ const s16x4 lo_ = vtr(vp_ + (((i) >> 2) * 4096 + ((i) & 3) * 1024)), hi_ = vtr(vp_ + (((i) >> 2) * 4096 + ((i) & 3) * 1024 + 512)); (bf16x8){lo_[0], lo_[1], lo_[2], lo_[3], hi_[0], hi_[1], hi_[2], hi_[3]}; })
#define AT_VHEAD(slot) do { const lds_cptr vp_ = vp0 + (slot) * VSLOT; vf[0] = AT_VF(0); vf[4] = AT_VF(4); } while (0)
#define AT_QKM(slot) do { const lds_cptr kp_ = kp0 + (slot) * SLOTK; \
        _Pragma("unroll") for (int d0 = 0; d0 < NC; ++d0) { if (d0 + 1 < NC) AT_KRD(kp_, d0 + 1); \
            if (d0 == 0) { S0 = MFMA32(kf[0], qr[0], negm); S1 = MFMA32(kf[1], qr[0], negm); } else { S0 = MFMA32(kf[2 * d0], qr[d0], S0); S1 = MFMA32(kf[2 * d0 + 1], qr[d0], S1); } AT_SB(); } } while (0)
#define AT_PVM(slot) do { const lds_cptr vp_ = vp0 + (slot) * VSLOT; \
        vf[1] = AT_VF(1); vf[5] = AT_VF(5); oa = MFMA32(__builtin_bit_cast(bf16x8, pw0), vf[0], oa); ob = MFMA32(__builtin_bit_cast(bf16x8, pw0), vf[4], ob); AT_SB(); \
        vf[2] = AT_VF(2); vf[6] = AT_VF(6); oa = MFMA32(__builtin_bit_cast(bf16x8, pw1), vf[1], oa); ob = MFMA32(__builtin_bit_cast(bf16x8, pw1), vf[5], ob); AT_SB(); \
        vf[3] = AT_VF(3); vf[7] = AT_VF(7); oa = MFMA32(__builtin_bit_cast(bf16x8, pw2), vf[2], oa); ob = MFMA32(__builtin_bit_cast(bf16x8, pw2), vf[6], ob); AT_SB(); \
        oa = MFMA32(__builtin_bit_cast(bf16x8, pw3), vf[3], oa); ob = MFMA32(__builtin_bit_cast(bf16x8, pw3), vf[7], ob); AT_SB(); } while (0)
#define AT_SM(first) do { const float rm_ = rowmax(S0, S1); \
        if ((first) || __any(rm_ > THR)) { const float dl_ = (first) ? rm_ : __builtin_fmaxf(rm_, 0.f); mhat += dl_; \
            _Pragma("unroll") for (int r = 0; r < 16; ++r) { S0[r] -= dl_; S1[r] -= dl_; negm[r] = -mhat; } asm volatile("" : "+v"(negm)); \
            if (!(first)) { const float f_ = fast_exp2(-dl_); l *= f_; if (hi == 0) wsf[r32] = f_; LDS_WAIT(); \
                _Pragma("unroll") for (int r = 0; r < 16; ++r) { const float g_ = wsf[crow(r, hi)]; oa[r] *= g_; ob[r] *= g_; } LDS_WAIT(); } } \
        float sacc_ = 0.f; \
        _Pragma("unroll") for (int r = 0; r < 16; ++r) { S0[r] = fast_exp2(S0[r]); S1[r] = fast_exp2(S1[r]); sacc_ += S0[r] + S1[r]; } l += sacc_; \
        pw0 = (u32x4){cvtpk(S0[0], S0[1]), cvtpk(S0[2], S0[3]), cvtpk(S0[4], S0[5]), cvtpk(S0[6], S0[7])}; pw1 = (u32x4){cvtpk(S0[8], S0[9]), cvtpk(S0[10], S0[11]), cvtpk(S0[12], S0[13]), cvtpk(S0[14], S0[15])}; \
        pw2 = (u32x4){cvtpk(S1[0], S1[1]), cvtpk(S1[2], S1[3]), cvtpk(S1[4], S1[5]), cvtpk(S1[6], S1[7])}; pw3 = (u32x4){cvtpk(S1[8], S1[9]), cvtpk(S1[10], S1[11]), cvtpk(S1[12], S1[13]), cvtpk(S1[14], S1[15])}; } while (0)
#define AT_STEP_WAIT(t) do { if ((t) + 2 < NT) { if (NDMA == 3) AT_WAIT_BAR(3); else AT_WAIT_BAR(2); } else AT_WAIT_BAR(0); } while (0)
#define AT_ROT() do { const int a_ = kc; kc = kn1; kn1 = kn2; kn2 = a_; const int b_ = vpv; vpv = vcu; vcu = vnx; vnx = b_; } while (0)
    AT_DMA_K(2, kn2); AT_DMA_V(1, vnx);
    AT_KHEAD(kc); AT_SB();
    AT_QKM(kc); AT_SM(true);
    AT_STEP_WAIT(0); AT_ROT();
    for (int t = 1; t < NT; ++t) {
        if (t + 2 < NT) AT_DMA_K(t + 2, kn2);
        if (t + 1 < NT) AT_DMA_V(t + 1, vnx);
        AT_VHEAD(vpv); AT_KHEAD(kc); AT_SB();
        AT_PVM(vpv); AT_QKM(kc);
        AT_SM(false);
        AT_STEP_WAIT(t); AT_ROT();
    }
    AT_VHEAD(vpv); AT_SB(); AT_PVM(vpv);
    { auto rr = __builtin_amdgcn_permlane32_swap(__float_as_uint(l), __float_as_uint(l), false, false); l = __uint_as_float(rr[0]) + __uint_as_float(rr[1]); }
    o0 = oa; o1 = ob; lsum = l;
#undef AT_DMA_K
#undef AT_DMA_V
#undef AT_SB
#undef AT_KRD
#undef AT_KHEAD
#undef AT_VF
#undef AT_VHEAD
#undef AT_QKM
#undef AT_PVM
#undef AT_SM
#undef AT_STEP_WAIT
#undef AT_ROT
}
__device__ __forceinline__ void normalise(LAS unsigned char* lds, int tid, f32x16& o0, f32x16& o1, float lsum) {
    const int lane = tid & 63, r32 = lane & 31, hi = lane >> 5; const int wid = __builtin_amdgcn_readfirstlane(tid >> 6);
    LAS float* wsf = (LAS float*)(lds + LDS_WS) + wid * 64;
    if (hi == 0) wsf[32 + r32] = 1.0f / lsum; LDS_WAIT();
#pragma unroll
    for (int r = 0; r < 16; ++r) { const float g = wsf[32 + crow(r, hi)]; o0[r] *= g; o1[r] *= g; }
    LDS_WAIT();
}
}

struct AttnUnitId { int kind, seq, head, qb; };
__device__ __forceinline__ bool attn_unit_at(int i, int G, int bid, AttnUnitId& u) {
    const long L = (long)i * G + bid; if (L >= 2560) return false; int o = (int)L;
    int kind, longs, nh;
    if (o < 512) { kind = 0; longs = 1; nh = 4; } else if (o < 1024) { kind = 0; longs = 0; nh = 4; o -= 512; } else if (o < 1792) { kind = 1; longs = 1; nh = 6; o -= 1024; } else { kind = 1; longs = 0; nh = 6; o -= 1792; }
    const int nqb = longs ? 16 : 8;
    int pair, qb;
    if (G == 256) { const int rnd = o >> 8, b = o & 255, x = b & 7, c = b >> 3;
        const int ppr = 32 / nqb; pair = x + 8 * (rnd * ppr + c / nqb); qb = c % nqb; }
    else { pair = o / nqb; qb = o % nqb; }
    u.kind = kind; u.head = pair % nh; const int sq = pair / nh; u.seq = longs ? 16 + sq : sq; u.qb = qb; return true;
}
__device__ __forceinline__ void attn_ab_phase(Frame& F, const Args& a, int layer, int kmask = 3) {
    const bf16_t* H = (const bf16_t*)(F.ws + WS_H); const bf16_t* QB = (const bf16_t*)(F.ws + WS_QB); const bf16_t* KVB = (const bf16_t*)(F.ws + WS_KVB);
    bf16_t* MIX = (bf16_t*)(F.ws + WS_MIX);
    const int wid = F.wave;
    float lam, lam_init;
    { const float* lv = a.diff_lambda + layer * 128; float d1 = 0.f, d2 = 0.f;
      for (int i = 0; i < 32; ++i) { d1 += lv[i] * lv[32 + i]; d2 += lv[64 + i] * lv[96 + i]; }
      lam_init = 0.8f - 0.6f * expf(-0.3f * (float)layer); lam = expf(d1) - expf(d2) + lam_init;
      lam = __uint_as_float(__builtin_amdgcn_readfirstlane(__float_as_uint(lam))); lam_init = __uint_as_float(__builtin_amdgcn_readfirstlane(__float_as_uint(lam_init))); }
    AttnUnitId u;
    for (int i = 0; attn_unit_at(i, F.G, F.bid, u); ++i) {
        if (!((kmask >> u.kind) & 1)) continue;
        int tid = F.tid; asm volatile("" : "+v"(tid)); const int lane = tid & 63, r32 = lane & 31, hi = lane >> 5;
        const int len = (u.seq < 16) ? 2048 : 4096, base = (u.seq < 16) ? u.seq * 2048 : NTOK_P + (u.seq - 16) * 4096, NT = len / 64;
        const int m0 = base + u.qb * 256 + wid * 32;
        LAS bf16_t* sb = (LAS bf16_t*)(F.lds + at::LDS_OST + wid * 8192);
        LAS float* sf = (LAS float*)sb;
        if (u.kind == 0) {
            f32x16 q0, q1; float ls;
            { f32x16 p0, p1; const at::Src ks{H + (size_t)base * HP + HC_AK + u.head * 64, HP}, vs{H + (size_t)base * HP + HC_AV + u.head * 64, HP};
              at::stream<2, 4, 0>(F.lds, tid, H + (size_t)(m0 + r32) * HP + HC_AQ + u.head * 64, ks, ks, vs, NT, p0, p1, ls); at::normalise(F.lds, tid, p0, p1, ls);
#pragma unroll
              for (int r = 0; r < 16; ++r) { const int row = crow(r, hi); sf[row * 64 + r32] = p0[r]; sf[row * 64 + 32 + r32] = p1[r]; }
              AT_WAIT_BAR(0); }
            { const at::Src ks{H + (size_t)base * HP + HC_AK + u.head * 64 + 32, HP}, vs{H + (size_t)base * HP + HC_AV + u.head * 64, HP};
              at::stream<2, 4, 0>(F.lds, tid, H + (size_t)(m0 + r32) * HP + HC_AQ + u.head * 64 + 32, ks, ks, vs, NT, q0, q1, ls); at::normalise(F.lds, tid, q0, q1, ls); }
            float xa[16], xb[16];
#pragma unroll
            for (int r = 0; r < 16; ++r) { const int row = crow(r, hi); xa[r] = sf[row * 64 + r32] - lam * q0[r]; xb[r] = sf[row * 64 + 32 + r32] - lam * q1[r]; }
            LDS_WAIT();
            const float* sg = a.diff_subln + layer * 64; const float g0 = sg[r32] * (1.0f - lam_init), g1 = sg[32 + r32] * (1.0f - lam_init);
#pragma unroll
            for (int r = 0; r < 16; ++r) { const float x0 = xa[r], x1 = xb[r]; float ss = x0 * x0 + x1 * x1;
                ss += shx<1>(ss); ss += shx<2>(ss); ss += shx<4>(ss); ss += shx<8>(ss); ss += shx<16>(ss);
                const float rs = 1.0f / sqrtf(ss * (1.0f / 64.0f) + RMS_EPS); const int row = crow(r, hi);
                sb[row * 64 + r32] = (bf16_t)f2bf(x0 * rs * g0); sb[row * 64 + 32 + r32] = (bf16_t)f2bf(x1 * rs * g1); }
            LDS_WAIT();
#pragma unroll
            for (int it = 0; it < 4; ++it) { const int row = it * 8 + (lane >> 3), ch = lane & 7; *(u32x4*)(MIX + (size_t)(m0 + row) * DM + MIX_A + u.head * 64 + ch * 8) = *(const LAS u32x4*)(sb + row * 64 + ch * 8); }
        } else {
            f32x16 p0, p1; float ls;
            const at::Src k0{KVB + (size_t)base * KVP + u.head * 128, KVP}, k1{H + (size_t)base * HP + HC_KROPE, HP}, vs{KVB + (size_t)base * KVP + u.head * 128 + 64, KVP};
            at::stream<6, 8, 4>(F.lds, tid, QB + (size_t)(m0 + r32) * QBP + u.head * 96, k0, k1, vs, NT, p0, p1, ls); at::normalise(F.lds, tid, p0, p1, ls);
#pragma unroll
            for (int r = 0; r < 16; ++r) { const int row = crow(r, hi); sb[row * 64 + r32] = (bf16_t)f2bf(p0[r]); sb[row * 64 + 32 + r32] = (bf16_t)f2bf(p1[r]); }
            LDS_WAIT();
#pragma unroll
            for (int it = 0; it < 4; ++it) { const int row = it * 8 + (lane >> 3), ch = lane & 7; *(u32x4*)(MIX + (size_t)(m0 + row) * DM + MIX_B + u.head * 64 + ch * 8) = *(const LAS u32x4*)(sb + row * 64 + ch * 8); }
        }
        AT_WAIT_BAR(0);
    }
}

struct ListRows { const int* list; int seg0, cnt; __device__ __forceinline__ int src(int m) const { const int r = m - seg0; return (r < cnt) ? (list[r] >> 1) : 0; } };
__device__ __forceinline__ void moe_segments(Frame& F, int layer, LAS int* seg) {
    if (F.tid == 0) { int acc = 0; for (int e = 0; e < NEXP; ++e) { const int c = (int)__hip_atomic_load(F.ctl + CW_CNT + layer * 64 + e, RLX_AGENT); seg[e] = acc; seg[33 + e] = c; acc += (c + 255) & ~255; } seg[32] = acc; }
    __syncthreads();
}
__device__ __forceinline__ int seg_find(const LAS int* seg, int row) { int e = 0;
#pragma unroll
    for (int s = 16; s > 0; s >>= 1) if (seg[e + s] <= row) e += s;
    return e; }
__device__ __forceinline__ void moe_up_simple(Frame& F, int layer) {
    LAS int* seg = (LAS int*)(F.lds + RING_BYTES); moe_segments(F, layer, seg);
    const bf16_t* XB = (const bf16_t*)(F.ws + WS_XB); const bf16_t* W13 = (const bf16_t*)(F.ws + WS_W13); const int* list = (const int*)(F.ws + WS_LIST);
    const EpiHid E{(bf16_t*)(F.ws + WS_HID)};
    const int items = (seg[32] / 32) * 16;
    for (int it = F.gw; it < items; it += F.NGW) { const int mt = it >> 4, ct = it & 15, m0 = mt * 32, e = seg_find(seg, m0), c0 = ct * 32;
        const ListRows RM{list + (size_t)e * LIST_CAP, seg[e], seg[33 + e]};
        const bf16_t* Bg = W13 + (size_t)e * 1024 * 1024 + (size_t)((c0 >> 7) * 256 + (c0 & 127)) * 1024;
        sg_tile(XB, DM, Bg, Bg + (size_t)128 * 1024, 1024, 1024, m0, c0, E, RM, F.lane); }
    __syncthreads();
}
__device__ __forceinline__ void moe_down_simple(Frame& F, int layer) {
    LAS int* seg = (LAS int*)(F.lds + RING_BYTES); moe_segments(F, layer, seg);
    const bf16_t* HID = (const bf16_t*)(F.ws + WS_HID); const bf16_t* W2 = (const bf16_t*)(F.ws + WS_W2); const int* list = (const int*)(F.ws + WS_LIST);
    const int items = (seg[32] / 32) * 16;
    for (int it = F.gw; it < items; it += F.NGW) { const int mt = it >> 4, ct = it & 15, m0 = mt * 32, e = seg_find(seg, m0), c0 = ct * 64;
        const EpiY E{(bf16_t*)(F.ws + WS_YB), (const float*)(F.ws + WS_TW), list + (size_t)e * LIST_CAP, seg[e], seg[33 + e]};
        const bf16_t* B0 = W2 + (size_t)e * 1024 * 512 + (size_t)c0 * 512;
        sg_tile(HID, DEXP, B0, B0 + (size_t)32 * 512, 512, 512, m0, c0, E, IdRows(), F.lane); }
    __syncthreads();
}


struct MoeUpSched {
    const char* XB; const char* W13; const LAS int* seg; const int* list; int nM, G, c;
    __device__ __forceinline__ bool next(int i, pg8::Unit& u) const { if (!pg8::order_next(i, G, c, nM, 4, u.pm, u.pn)) return false; u.e = __builtin_amdgcn_readfirstlane(seg_find(seg, u.pm * 256)); u.a = XB; u.b = W13 + ((size_t)u.e * 1024 + (size_t)u.pn * 256) * 2048; return true; }
    __device__ __forceinline__ unsigned arow(const pg8::Unit& u, int r) const { const int rr = u.pm * 256 + r - __builtin_amdgcn_readfirstlane(seg[u.e]); return (rr < __builtin_amdgcn_readfirstlane(seg[33 + u.e])) ? (unsigned)(list[(size_t)u.e * LIST_CAP + rr] >> 1) : 0u; }
};
struct MoeDownSched {
    const char* HID; const char* W2; const LAS int* seg; int nM, G, c;
    __device__ __forceinline__ bool next(int i, pg8::Unit& u) const { if (!pg8::order_next(i, G, c, nM, 4, u.pm, u.pn)) return false; u.e = __builtin_amdgcn_readfirstlane(seg_find(seg, u.pm * 256)); u.a = HID + (size_t)u.pm * 256 * DEXP * 2; u.b = W2 + ((size_t)u.e * 1024 + (size_t)u.pn * 256) * 1024; return true; }
    __device__ __forceinline__ unsigned arow(const pg8::Unit&, int) const { return 0u; }
};
__device__ __forceinline__ void moe_up_opt(Frame& F, int layer) {
    LAS int* seg = (LAS int*)(F.lds + RING_BYTES); moe_segments(F, layer, seg);
    const MoeUpSched S{(const char*)(F.ws + WS_XB), (const char*)(F.ws + WS_W13), seg, (const int*)(F.ws + WS_LIST), __builtin_amdgcn_readfirstlane(seg[32]) / 256, F.G, F.bid};
    const EpiHid E{(bf16_t*)(F.ws + WS_HID)};
    pg8::gemm_phase<EpiHid, MoeUpSched, true, true>(F.lds, F.tid, 1024, DM, S, E);
    __syncthreads();
}
__device__ __forceinline__ void moe_down_opt(Frame& F, int layer) {
    LAS int* seg = (LAS int*)(F.lds + RING_BYTES); moe_segments(F, layer, seg);
    const MoeDownSched S{(const char*)(F.ws + WS_HID), (const char*)(F.ws + WS_W2), seg, __builtin_amdgcn_readfirstlane(seg[32]) / 256, F.G, F.bid};
    const EpiYO E{(bf16_t*)(F.ws + WS_YB), (const float*)(F.ws + WS_TW), (const int*)(F.ws + WS_LIST), seg};
    pg8::gemm_phase<EpiYO, MoeDownSched, false, false>(F.lds, F.tid, DEXP, DEXP, S, E);
    __syncthreads();
}
template <class Epi>
__device__ __forceinline__ void og_phase(Frame& F, const bf16_t* A, int lda, const bf16_t* Bt, int M, int N, int K, const Epi& E) {
    pg8::DenseSched S; S.init(A, lda, Bt, M, N, K, F.G, F.bid);
    pg8::gemm_phase<Epi, pg8::DenseSched, false, false>(F.lds, F.tid, K, lda, S, E);
}

constexpr int PH_PER_LAYER = 9, N_PHASES = 1 + DEPTH * PH_PER_LAYER;
__global__ void __launch_bounds__(NTHREADS, 2) fwd(Args args) {
    extern __shared__ __attribute__((aligned(16))) unsigned char lds[];
    Frame F;
    F.lds = (LAS unsigned char*)lds; F.ldsg = lds;
    F.tid = threadIdx.x; F.lane = F.tid & 63; F.wave = __builtin_amdgcn_readfirstlane(F.tid >> 6);
    F.G = gridDim.x; F.bid = blockIdx.x; F.gw = blockIdx.x * NWAVES + F.wave; F.NGW = F.G * NWAVES;
    F.ws = args.ws; F.ctl = (gu32*)(args.ws + WS_CTL);
    volatile LAS unsigned* MISC = (volatile LAS unsigned*)(F.lds + MISC_OFF);
    for (int u = F.tid; u < (LDS_BYTES - RING_BYTES) / 4; u += NTHREADS) ((LAS unsigned*)(F.lds + RING_BYTES))[u] = 0u;
    __syncthreads();
    XcdBarrier bar; bar.bar = (unsigned*)(F.ctl + CW_BAR); bar.x = 0; bar.st = nullptr;
    if (args.use_bar) bar = xcd_barrier_post((unsigned*)(F.ctl + CW_BAR), MISC + 8);
    const int lo = args.ph_lo, hi = args.ph_hi;
#ifndef PH_MASK
#define PH_MASK 0x3ff
#endif
#define IN(k) (lo <= (k) && (k) < hi && (launder(F), true))
#define SEAM(k) do { if (lo <= (k) && (k) + 1 < hi) xcd_barrier(bar); } while (0)
    if ((PH_MASK & 1) && IN(0)) { p0_prologue(F, args);
#ifdef PROBE_DUP_P0
        launder(F); p0_prologue(F, args);
#endif
    }
    SEAM(0);
    for (int layer = 0; layer < DEPTH; ++layer) {
        const int pb = 1 + layer * PH_PER_LAYER;
        if ((PH_MASK & (2 << 0)) && IN(pb + 0)) {   bf16_t* H = (bf16_t*)(F.ws + WS_H);
            const EpiH E{H, (const float2*)(F.ws + WS_ROPE32), (const float2*)(F.ws + WS_ROPE64)};
#if OPT_GEMM
            og_phase(F, (const bf16_t*)(F.ws + WS_XB), DM, (const bf16_t*)(F.ws + WS_WIN) + (size_t)layer * 2560 * 1024, NTOK, 2560, 1024, E);
#ifdef PROBE_DUP_GEMM
            launder(F); og_phase(F, (const bf16_t*)(F.ws + WS_XB), DM, (const bf16_t*)(F.ws + WS_WIN) + (size_t)layer * 2560 * 1024, NTOK, 2560, 1024, E);
#endif
#else
            sg_phase(F, (const bf16_t*)(F.ws + WS_XB), DM, (const bf16_t*)(F.ws + WS_WIN) + (size_t)layer * 2560 * 1024, 1024, NTOK, 2560, 1024, E);
#endif
        }
        SEAM(pb + 0);
        if ((PH_MASK & (2 << 1)) && IN(pb + 1)) { rowstat_pass(F); cstat_phase(F);
#ifdef PROBE_DUP_CSTAT
            launder(F); rowstat_pass(F); cstat_phase(F);
#endif
        }
        SEAM(pb + 1);
        if ((PH_MASK & (2 << 2)) && IN(pb + 2)) {
            bf16_t* H = (bf16_t*)(F.ws + WS_H);
            const EpiUQ Eq{(bf16_t*)(F.ws + WS_QB), (const float*)(F.ws + WS_RSTD), (const float2*)(F.ws + WS_ROPE32)};
#if OPT_GEMM
            og_phase(F, H + HC_CQ_LAT, HP, (const bf16_t*)(F.ws + WS_WUQ) + (size_t)layer * 768 * 256, NTOK, 768, 256, Eq);
            launder(F);
#else
            sg_phase(F, H + HC_CQ_LAT, HP, (const bf16_t*)(F.ws + WS_WUQ) + (size_t)layer * 768 * 256, 256, NTOK, 768, 256, Eq);
#endif
            const EpiUKV Ek{(bf16_t*)(F.ws + WS_KVB), (const float*)(F.ws + WS_RSTD)};
#if OPT_GEMM
            og_phase(F, H + HC_CKV, HP, (const bf16_t*)(F.ws + WS_WUKV) + (size_t)layer * 768 * 256, NTOK, 768, 256, Ek);
#ifdef PROBE_DUP_UP
            launder(F); og_phase(F, H + HC_CQ_LAT, HP, (const bf16_t*)(F.ws + WS_WUQ) + (size_t)layer * 768 * 256, NTOK, 768, 256, Eq);
            launder(F); og_phase(F, H + HC_CKV, HP, (const bf16_t*)(F.ws + WS_WUKV) + (size_t)layer * 768 * 256, NTOK, 768, 256, Ek);
#endif
#else
            sg_phase(F, H + HC_CKV, HP, (const bf16_t*)(F.ws + WS_WUKV) + (size_t)layer * 768 * 256, 256, NTOK, 768, 256, Ek);
#endif
        }
        SEAM(pb + 2);
        if ((PH_MASK & (2 << 3)) && IN(pb + 3)) {
#if OPT_ATTN
            attn_ab_phase(F, args, layer); launder(F);
#ifdef PROBE_DUP_ATTN
            attn_ab_phase(F, args, layer, PROBE_DUP_ATTN); launder(F);
#endif
            sattn_phase(F, args, layer, 10);
#ifdef PROBE_DUP_CFIN
            launder(F); sattn_phase(F, args, layer, 10);
#endif
#else
            sattn_phase(F, args, layer, 0);
#endif
        }
        SEAM(pb + 3);
        if ((PH_MASK & (2 << 4)) && IN(pb + 4)) {
            const EpiRes E{args.out};
#if OPT_GEMM
            og_phase(F, (const bf16_t*)(F.ws + WS_MIX), DM, (const bf16_t*)(F.ws + WS_WOUT) + (size_t)layer * 1024 * 1024, NTOK, 1024, 1024, E);
#else
            sg_phase(F, (const bf16_t*)(F.ws + WS_MIX), DM, (const bf16_t*)(F.ws + WS_WOUT) + (size_t)layer * 1024 * 1024, 1024, NTOK, 1024, 1024, E);
#endif
        }
        SEAM(pb + 4);
        if ((PH_MASK & (2 << 5)) && IN(pb + 5)) { ln1_route_pass(F, args, layer); moe_convert(F, args, layer);
#ifdef PROBE_DUP_CONV
            launder(F); moe_convert(F, args, layer);
#endif
        }
        SEAM(pb + 5);
#if OPT_GEMM
        if ((PH_MASK & (2 << 6)) && IN(pb + 6)) { moe_up_opt(F, layer);
#ifdef PROBE_DUP_MOE
            launder(F); moe_up_opt(F, layer);
#endif
        }
#else
        if ((PH_MASK & (2 << 6)) && IN(pb + 6)) { moe_up_simple(F, layer); }
#endif
        SEAM(pb + 6);
#if OPT_GEMM
        if ((PH_MASK & (2 << 7)) && IN(pb + 7)) { moe_down_opt(F, layer);
#ifdef PROBE_DUP_MOE
            launder(F); moe_down_opt(F, layer);
#endif
        }
#else
        if ((PH_MASK & (2 << 7)) && IN(pb + 7)) { moe_down_simple(F, layer); }
#endif
        SEAM(pb + 7);
        if ((PH_MASK & (2 << 8)) && IN(pb + 8)) { ln2_pass(F, args, layer); }
        SEAM(pb + 8);
    }
#undef IN
#undef SEAM
}

extern "C" void kernel_launch(void* const* d_in, const int* in_sizes, int n_in, void* d_out, int out_size, void* d_ws, size_t ws_size, hipStream_t stream) {
    static int grid = 0;
    if (grid == 0) {
        if (n_in != 19 || out_size != NTOK * DM || ws_size < WS_END) { fprintf(stderr, "kernel_launch: unexpected shapes (n_in %d out %d ws %zu)\n", n_in, out_size, ws_size); grid = -1; return; }
        int dev = 0, cus = 0, per_cu = 0;
        if (hipGetDevice(&dev) != hipSuccess || hipDeviceGetAttribute(&cus, hipDeviceAttributeMultiprocessorCount, dev) != hipSuccess) { grid = -1; return; }
        if (hipFuncSetAttribute((const void*)fwd, hipFuncAttributeMaxDynamicSharedMemorySize, LDS_BYTES) != hipSuccess) { grid = -1; return; }
        if (hipOccupancyMaxActiveBlocksPerMultiprocessor(&per_cu, (const void*)fwd, NTHREADS, LDS_BYTES) != hipSuccess || per_cu < 1) { fprintf(stderr, "kernel_launch: occupancy query says %d\n", per_cu); }
        (void)hipGetLastError();
        grid = cus;
    }
    if (grid < 0) return;
    if (hipMemsetAsync((char*)d_ws + WS_CTL, 0, CTL_ZERO_BYTES, stream) != hipSuccess) return;
    Args a{};
    a.x_prompt = (const float*)d_in[0]; a.x_sample = (const float*)d_in[1]; a.w_in = (const float*)d_in[2]; a.diff_lambda = (const float*)d_in[3]; a.diff_subln = (const float*)d_in[4];
    a.mla_q_norm = (const float*)d_in[5]; a.mla_w_uq = (const float*)d_in[6]; a.mla_kv_norm = (const float*)d_in[7]; a.mla_w_ukv = (const float*)d_in[8]; a.w_out = (const float*)d_in[9];
    a.ln1_g = (const float*)d_in[10]; a.ln1_b = (const float*)d_in[11]; a.moe_w_coarse = (const float*)d_in[12]; a.moe_w_fine = (const float*)d_in[13];
    a.moe_w1 = (const float*)d_in[14]; a.moe_w3 = (const float*)d_in[15]; a.moe_w2 = (const float*)d_in[16]; a.ln2_g = (const float*)d_in[17]; a.ln2_b = (const float*)d_in[18];
    a.out = (float*)d_out; a.ws = (unsigned char*)d_ws; a.pad = 0;
#if MK_ONE_LAUNCH
    a.ph_lo = 0; a.ph_hi = N_PHASES; a.use_bar = 1;
    hipLaunchKernelGGL(fwd, dim3(grid), dim3(NTHREADS), LDS_BYTES, stream, a);
#else
    for (int p = 0; p < N_PHASES; ++p) { a.ph_lo = p; a.ph_hi = p + 1; a.use_bar = 0; hipLaunchKernelGGL(fwd, dim3(grid), dim3(NTHREADS), LDS_BYTES, stream, a); }
#endif
}
```

```cpp
#include <hip/hip_runtime.h>
#include <cstdio>
#include <cstdint>

#ifndef OPT_ATTN
#define OPT_ATTN 1
#endif
#ifndef OPT_GEMM
#define OPT_GEMM 1
#endif
#ifndef MK_ONE_LAUNCH
#define MK_ONE_LAUNCH 1
#endif

#define GAS __attribute__((address_space(1)))
#define LAS __attribute__((address_space(3)))
typedef unsigned short bf16_t;
typedef short bf16x8 __attribute__((ext_vector_type(8)));
typedef float f32x4 __attribute__((ext_vector_type(4)));
typedef float f32x2 __attribute__((ext_vector_type(2)));
typedef float f32x16 __attribute__((ext_vector_type(16)));
typedef unsigned u32x4 __attribute__((ext_vector_type(4)));
typedef unsigned u32x2 __attribute__((ext_vector_type(2)));
typedef GAS unsigned gu32;
#define RLX_AGENT __ATOMIC_RELAXED, __HIP_MEMORY_SCOPE_AGENT
#define LDS_WAIT() asm volatile("s_waitcnt lgkmcnt(0)" ::: "memory")
#define VM_WAIT() asm volatile("s_waitcnt vmcnt(0)" ::: "memory")
#define MFMA32(a, b, c) __builtin_amdgcn_mfma_f32_32x32x16_bf16(a, b, c, 0, 0, 0)

__device__ __forceinline__ unsigned f2bf(float f) { unsigned u = __builtin_bit_cast(unsigned, f); return (u + 0x7fffu + ((u >> 16) & 1u)) >> 16; }
__device__ __forceinline__ unsigned pk2(float lo, float hi) { return f2bf(lo) | (f2bf(hi) << 16); }
__device__ __forceinline__ float bf2f(unsigned short b) { return __builtin_bit_cast(float, (unsigned)b << 16); }
__device__ __forceinline__ int crow(int r, int hi) { return (r & 3) + 8 * (r >> 2) + 4 * hi; }
template <int K> __device__ __forceinline__ float shx(float v) { static_assert(K < 32, "xor 32: use xsum32 / xmax32 / xpair32"); return __uint_as_float((unsigned)__builtin_amdgcn_ds_swizzle((int)__float_as_uint(v), (K << 10) | 0x1f)); }
__device__ __forceinline__ float xsum32(float v) { auto rr = __builtin_amdgcn_permlane32_swap(__float_as_uint(v), __float_as_uint(v), false, false); return __uint_as_float(rr[0]) + __uint_as_float(rr[1]); }
__device__ __forceinline__ float xmax32(float v) { auto rr = __builtin_amdgcn_permlane32_swap(__float_as_uint(v), __float_as_uint(v), false, false); return fmaxf(__uint_as_float(rr[0]), __uint_as_float(rr[1])); }
__device__ __forceinline__ float xpair32(float lo, float hi) { auto rr = __builtin_amdgcn_permlane32_swap(__float_as_uint(lo), __float_as_uint(hi), false, false); return __uint_as_float(rr[0]) + __uint_as_float(rr[1]); }
__device__ __forceinline__ float wave_sum(float v) {
    v += shx<1>(v); v += shx<2>(v); v += shx<4>(v); v += shx<8>(v); v += shx<16>(v);
    return xsum32(v);
}
__device__ __forceinline__ float fast_exp2(float x) { return __builtin_amdgcn_exp2f(x); }

constexpr int NTOK = 65536, DM = 1024, DEPTH = 4;
constexpr int NTOK_P = 32768;
constexpr int HP = 2560;
constexpr int HC_AQ = 0, HC_AK = 256, HC_AV = 512, HC_CQ_LAT = 768, HC_CKV = 1024, HC_KROPE = 1152, HC_CQ = 1280, HC_CK = 1664, HC_CV = 2048;
constexpr int QBP = 768, KVP = 768;
constexpr int MIX_A = 0, MIX_B = 256, MIX_C = 640;
constexpr int NEXP = 32, DEXP = 512;
constexpr float LOG2E = 1.4426950408889634f;
constexpr float SC_A = 0.17677669529663687f * LOG2E;
constexpr float SC_B = 0.10206207261596575f * LOG2E;
constexpr float SC_C = 0.125f * LOG2E;
constexpr float DN_ALPHA = 1.681792830507429f;
constexpr float LN_EPS = 1e-5f, RMS_EPS = 1e-6f;

constexpr size_t MiB = 1u << 20;
constexpr size_t WS_CTL = 0, CTL_ZERO_BYTES = 1 * MiB;
constexpr size_t WS_ROPE32 = 4 * MiB;
constexpr size_t WS_ROPE64 = 5 * MiB;
constexpr size_t WS_WIN = 8 * MiB;
constexpr size_t WS_WOUT = 28 * MiB;
constexpr size_t WS_WUQ = 36 * MiB;
constexpr size_t WS_WUKV = 38 * MiB;
constexpr size_t WS_W13 = 40 * MiB;
constexpr size_t WS_W2 = 104 * MiB;
constexpr size_t WS_XB = 136 * MiB;
constexpr size_t WS_H = 264 * MiB;
constexpr size_t WS_QB = 584 * MiB;
constexpr size_t WS_KVB = 680 * MiB;
constexpr size_t WS_MIX = 776 * MiB;
constexpr size_t WS_RSTD = 904 * MiB;
constexpr size_t WS_LSEC = 905 * MiB;
constexpr size_t WS_TW = 907 * MiB;
constexpr size_t WS_LIST = 908 * MiB;
constexpr size_t WS_END = 924 * MiB;
constexpr size_t WS_HID = WS_H;
constexpr size_t WS_YB = WS_H + 136 * MiB;
static_assert(WS_YB + 256 * MiB <= WS_KVB + 96 * MiB, "YB overlay");
constexpr int LIST_CAP = 131072;
constexpr int CW_TMO = 0;
constexpr int CW_CNT = 64;
constexpr int CW_BAR = 4096;

constexpr int RING_BYTES = 131072;
constexpr int MISC_OFF = RING_BYTES + 320;
constexpr int LDS_BYTES = 147456;
constexpr int NWAVES = 8, NTHREADS = 512;

#define XB_TMO      128
#define XB_XCNT(j)  (256  + 64 * (j))
#define XB_XSUB(j)  (1280 + 64 * (j))
#define XB_XGEN(j)  (2304 + 64 * (j))
#define XB_TOP      3328
#define XB_TOPGEN   3392
#define XCD_BAR_WORDS 3456
#define XB_SPIN_CAP (1u << 22)
__device__ __forceinline__ unsigned xb_ld(unsigned* p)              { return __hip_atomic_load(p, __ATOMIC_RELAXED, __HIP_MEMORY_SCOPE_AGENT); }
__device__ __forceinline__ unsigned xb_add(unsigned* p, unsigned v) { return __hip_atomic_fetch_add(p, v, __ATOMIC_RELAXED, __HIP_MEMORY_SCOPE_AGENT); }
__device__ __forceinline__ unsigned xb_xcc_id() { return (unsigned)__builtin_amdgcn_s_getreg((3 << 11) | 20) & 0xFu; }
#define XB_SPIN(cond, bar) do { unsigned _sp = 0; while (cond) { __builtin_amdgcn_s_sleep(1); \
    if ((++_sp & 255u) == 0u) { if (xb_ld(&(bar)[XB_TMO])) break; if (_sp > XB_SPIN_CAP) { atomicAdd(&(bar)[XB_TMO], 1u); break; } } } } while (0)
struct XcdBarrier { unsigned* bar; unsigned x; volatile LAS unsigned* st; };
__device__ __forceinline__ XcdBarrier xcd_barrier_post(unsigned* bar, volatile LAS unsigned* st) {
    XcdBarrier b; b.bar = bar; b.x = xb_xcc_id(); b.st = st;
    if (threadIdx.x == 0) (void)xb_add(&bar[XB_XCNT(b.x)], 1u);
    return b;
}
__device__ __forceinline__ void xcd_barrier_complete(unsigned* bar, unsigned x, unsigned& nloc, unsigned& nx) {
    const unsigned G = gridDim.x * gridDim.y * gridDim.z;
    unsigned sum, cnt, mine, sp = 0u;
    for (;;) {
        sum = 0u; cnt = 0u; mine = 0u;
#pragma unroll
        for (unsigned j = 0; j < 16; ++j) { const unsigned c = xb_ld(&bar[XB_XCNT(j)]); sum += c; cnt += (c > 0u) ? 1u : 0u; mine = (j == x) ? c : mine; }
        if (sum == G) break;
        __builtin_amdgcn_s_sleep(1);
        if ((++sp & 255u) == 0u) { if (xb_ld(&bar[XB_TMO])) break; if (sp > XB_SPIN_CAP) { atomicAdd(&bar[XB_TMO], 1u); break; } }
    }
    nloc = mine > 0u ? mine : 1u; nx = cnt > 0u ? cnt : 1u;
}
__device__ __forceinline__ void xcd_barrier(const XcdBarrier& b) {
    asm volatile("s_waitcnt vmcnt(0)" ::: "memory");
    __syncthreads();
    if (threadIdx.x == 0) {
        unsigned* bar = b.bar;
        __builtin_amdgcn_s_waitcnt(0);
        unsigned nloc = b.st[0], nx = b.st[1];
        if (nloc == 0u) { xcd_barrier_complete(bar, b.x, nloc, nx); b.st[0] = nloc; b.st[1] = nx; }
        const unsigned old = xb_add(&bar[XB_XSUB(b.x)], 1u);
        const unsigned gen = old / nloc;
        if (old + 1u == (gen + 1u) * nloc) {
            __builtin_amdgcn_fence(__ATOMIC_RELEASE, "agent");
            asm volatile("s_waitcnt vmcnt(0)" ::: "memory");
            const unsigned og = xb_add(&bar[XB_TOP], 1u);
            const unsigned tg = og / nx;
            if (og + 1u == (tg + 1u) * nx) xb_add(&bar[XB_TOPGEN], 1u);
            else XB_SPIN(xb_ld(&bar[XB_TOPGEN]) == tg, bar);
            __builtin_amdgcn_fence(__ATOMIC_ACQUIRE, "agent");
            xb_add(&bar[XB_XGEN(b.x)], 1u);
            asm volatile("s_waitcnt vmcnt(0)" ::: "memory");
        } else {
            XB_SPIN(xb_ld(&bar[XB_XGEN(b.x)]) == gen, bar);
            __builtin_amdgcn_fence(__ATOMIC_ACQUIRE, "agent");
            asm volatile("s_waitcnt vmcnt(0)" ::: "memory");
        }
    }
    __syncthreads();
}

struct Args {
    const float* x_prompt; const float* x_sample; const float* w_in; const float* diff_lambda; const float* diff_subln; const float* mla_q_norm; const float* mla_w_uq;
    const float* mla_kv_norm; const float* mla_w_ukv; const float* w_out; const float* ln1_g; const float* ln1_b; const float* moe_w_coarse; const float* moe_w_fine;
    const float* moe_w1; const float* moe_w3; const float* moe_w2; const float* ln2_g; const float* ln2_b;
    float* out; unsigned char* ws; int ph_lo, ph_hi, use_bar, pad;
};
struct Frame {
    LAS unsigned char* lds; unsigned char* ldsg;
    int tid, lane, wave, G, gw, NGW, bid;
    gu32* ctl; unsigned char* ws;
};
__device__ __forceinline__ void launder(Frame& F) {
    int wv = F.wave; asm volatile("" : "+s"(wv)); F.wave = wv;
    int t; asm volatile("v_mbcnt_lo_u32_b32 %0, -1, 0\n\tv_mbcnt_hi_u32_b32 %0, -1, %0" : "=v"(t)); F.lane = t; F.tid = wv * 64 + t;
    int b = (int)blockIdx.x; asm volatile("" : "+s"(b)); F.bid = b; F.gw = b * NWAVES + F.wave;
    unsigned char* w = F.ws; asm volatile("" : "+s"(w)); F.ws = w; F.ctl = (gu32*)(w + WS_CTL);
}
struct SeqInfo { int base, len, pos; };
__device__ __forceinline__ SeqInfo seqinfo(int m) { SeqInfo s; if (m < NTOK_P) { s.base = m & ~2047; s.len = 2048; } else { s.base = m & ~4095; s.len = 4096; } s.pos = m - s.base; return s; }

template <class ColMap>
__device__ __forceinline__ void transpose_item(const float* W, int N, bf16_t* WT, int ldd, LAS float* scr, int k0, int n0, const ColMap& cm, const float* kscale, int lane) {
    const int sc = cm(n0 + (lane & 31));
#pragma unroll 8
    for (int i = 0; i < 32; ++i) { const int kk = 2 * i + (lane >> 5); float v = 0.f; if (sc >= 0) { v = W[(size_t)(k0 + kk) * N + sc]; if (kscale) v *= kscale[k0 + kk]; } scr[kk * 33 + (lane & 31)] = v; }
    LDS_WAIT(); asm volatile("" ::: "memory");
    const int c = lane & 7;
#pragma unroll
    for (int j = 0; j < 4; ++j) { const int n = (lane >> 3) + 8 * j; const LAS float* s = scr + (8 * c) * 33 + n;
        u32x4 o; o.x = pk2(s[0 * 33], s[1 * 33]); o.y = pk2(s[2 * 33], s[3 * 33]); o.z = pk2(s[4 * 33], s[5 * 33]); o.w = pk2(s[6 * 33], s[7 * 33]);
        *(u32x4*)(WT + (size_t)(n0 + n) * ldd + k0 + 8 * c) = o; }
    LDS_WAIT(); asm volatile("" ::: "memory");
}
__device__ __forceinline__ void transpose_item_v4(const float* Wsrc, int N, bf16_t* WTdst, int ldd, LAS float* scr, int lane) {
    const int c4 = (lane & 7) * 4, kr = lane >> 3;
    f32x4 t[8];
#pragma unroll
    for (int i = 0; i < 8; ++i) t[i] = *(const f32x4*)(Wsrc + (size_t)(i * 8 + kr) * N + c4);
#pragma unroll
    for (int i = 0; i < 8; ++i) { const int kk = i * 8 + kr; scr[(c4 + 0) * 65 + kk] = t[i].x; scr[(c4 + 1) * 65 + kk] = t[i].y; scr[(c4 + 2) * 65 + kk] = t[i].z; scr[(c4 + 3) * 65 + kk] = t[i].w; }
    LDS_WAIT(); asm volatile("" ::: "memory");
    const int c = lane & 7;
#pragma unroll
    for (int j = 0; j < 4; ++j) { const int n = (lane >> 3) + 8 * j; const LAS float* p = scr + n * 65 + 8 * c;
        u32x4 o; o.x = pk2(p[0], p[1]); o.y = pk2(p[2], p[3]); o.z = pk2(p[4], p[5]); o.w = pk2(p[6], p[7]);
        *(u32x4*)(WTdst + (size_t)n * ldd + 8 * c) = o; }
    LDS_WAIT(); asm volatile("" ::: "memory");
}
struct WinMap {
    __device__ __forceinline__ int operator()(int n) const {
        if (n < 512) { const int t = n & 31; return (n & ~31) + (t >> 1) + 16 * (t & 1); }
        if (n < 1152) return n;
        if (n < 1184) { const int t = n - 1152; return 1152 + (t >> 1) + 16 * (t & 1); }
        if (n < 1280) return -1;
        if (n < 2048) { const int u = n - 1280, t = u & 63; return 1184 + (u & ~63) + (t >> 1) + 32 * (t & 1); }
        if (n < 2432) return 1952 + (n - 2048);
        return -1;
    }
};
struct UqMap { __device__ __forceinline__ int operator()(int n) const { if (n >= 576) return -1; const int h = n / 96, t = n - 96 * h; if (t < 64) return n; const int u = t - 64; return 96 * h + 64 + (u >> 1) + 16 * (u & 1); } };
struct IdMap { __device__ __forceinline__ int operator()(int n) const { return n; } };
struct W13Map { __device__ __forceinline__ int operator()(int n) const { return (n >> 8) * 128 + (n & 127); } };

__device__ __forceinline__ void p0_prologue(Frame& F, const Args& a) {
    LAS float* scr = (LAS float*)(F.lds + F.wave * 16384);
    { float2* r32 = (float2*)(F.ws + WS_ROPE32); float2* r64 = (float2*)(F.ws + WS_ROPE64);
      for (int i = F.gw * 64 + F.lane; i < 4096 * 16; i += F.NGW * 64) { const int pos = i >> 4, j = i & 15; const float inv = 1.0f / powf(10000.0f, (float)(2 * j) / 32.0f); const float ang = (float)pos * inv; r32[i] = make_float2(cosf(ang), sinf(ang)); }
      for (int i = F.gw * 64 + F.lane; i < 4096 * 32; i += F.NGW * 64) { const int pos = i >> 5, j = i & 31; const float inv = 1.0f / powf(10000.0f, (float)(2 * j) / 64.0f); const float ang = (float)pos * inv; r64[i] = make_float2(cosf(ang), sinf(ang)); } }
    constexpr int I_WIN = (1024 / 64) * (2560 / 32), I_WOUT = (1024 / 64) * (1024 / 32), I_UQ = (256 / 64) * (768 / 32), I_UKV = (256 / 64) * (768 / 32);
    constexpr int PER_L = I_WIN + I_WOUT + I_UQ + I_UKV;
    for (int it = F.gw; it < DEPTH * PER_L; it += F.NGW) {
        const int l = it / PER_L; int r = it - l * PER_L;
        if (r < I_WIN) { const int kb = r / 80, nb = r % 80; transpose_item(a.w_in + (size_t)l * 1024 * 2336, 2336, (bf16_t*)(F.ws + WS_WIN) + (size_t)l * 2560 * 1024, 1024, scr, kb * 64, nb * 32, WinMap(), nullptr, F.lane); continue; } r -= I_WIN;
        if (r < I_WOUT) { const int kb = r / 32, nb = r % 32; transpose_item(a.w_out + (size_t)l * 1024 * 1024, 1024, (bf16_t*)(F.ws + WS_WOUT) + (size_t)l * 1024 * 1024, 1024, scr, kb * 64, nb * 32, IdMap(), nullptr, F.lane); continue; } r -= I_WOUT;
        if (r < I_UQ) { const int kb = r / 24, nb = r % 24; transpose_item(a.mla_w_uq + (size_t)l * 256 * 576, 576, (bf16_t*)(F.ws + WS_WUQ) + (size_t)l * 768 * 256, 256, scr, kb * 64, nb * 32, UqMap(), a.mla_q_norm + l * 256, F.lane); continue; } r -= I_UQ;
        { const int kb = r / 24, nb = r % 24; bf16_t* dst = (bf16_t*)(F.ws + WS_WUKV) + (size_t)l * 768 * 256;
          if (kb < 2) transpose_item(a.mla_w_ukv + (size_t)l * 128 * 768, 768, dst, 256, scr, kb * 64, nb * 32, IdMap(), a.mla_kv_norm + l * 128, F.lane);
          else { const int c = F.lane & 7;
#pragma unroll
              for (int j = 0; j < 4; ++j) { const int n = (F.lane >> 3) + 8 * j; *(u32x4*)(dst + (size_t)(nb * 32 + n) * 256 + kb * 64 + 8 * c) = (u32x4){0u, 0u, 0u, 0u}; } } }
    }
    bf16_t* XB = (bf16_t*)(F.ws + WS_XB);
    for (int m = F.gw; m < NTOK; m += F.NGW) {
        const float* src = (m < NTOK_P) ? a.x_prompt + (size_t)m * DM : a.x_sample + (size_t)(m - NTOK_P) * DM;
#pragma unroll
        for (int j = 0; j < 4; ++j) { const f32x4 v = *((const f32x4*)src + F.lane + 64 * j);
            u32x2 w; w.x = pk2(v.x, v.y); w.y = pk2(v.z, v.w); *((u32x2*)(XB + (size_t)m * DM) + F.lane + 64 * j) = w; }
    }
}

template <class Epi, class RowMap>
__device__ __forceinline__ void sg_tile(const bf16_t* A, int lda, const bf16_t* B0, const bf16_t* B1, int ldb, int K, int m0, int c0, const Epi& E, const RowMap& RM, int lane) {
    const int r32 = lane & 31, hi = lane >> 5;
    const bf16_t* ap = A + (size_t)RM.src(m0 + r32) * lda + 8 * hi;
    const bf16_t* b0p = B0 + (size_t)r32 * ldb + 8 * hi;
    const bf16_t* b1p = B1 + (size_t)r32 * ldb + 8 * hi;
    f32x16 acc0 = {}, acc1 = {};
#pragma unroll 4
    for (int k = 0; k < K; k += 16) {
        const bf16x8 af = *(const bf16x8*)(ap + k), bf0 = *(const bf16x8*)(b0p + k), bf1 = *(const bf16x8*)(b1p + k);
        acc0 = MFMA32(bf0, af, acc0); acc1 = MFMA32(bf1, af, acc1);
    }
#pragma unroll
    for (int g = 0; g < 4; ++g) { const f32x4 v0 = {acc0[4 * g], acc0[4 * g + 1], acc0[4 * g + 2], acc0[4 * g + 3]}, v1 = {acc1[4 * g], acc1[4 * g + 1], acc1[4 * g + 2], acc1[4 * g + 3]};
        E.put(m0 + r32, c0, 8 * g + 4 * hi, v0, v1); }
}
struct IdRows { __device__ __forceinline__ int src(int m) const { return m; } };

__device__ __forceinline__ void store_bf8(bf16_t* p, f32x4 a, f32x4 b) { u32x4 w; w.x = pk2(a.x, a.y); w.y = pk2(a.z, a.w); w.z = pk2(b.x, b.y); w.w = pk2(b.z, b.w); *(u32x4*)p = w; }
__device__ __forceinline__ void store_bf4(bf16_t* p, f32x4 v) { u32x2 w; w.x = pk2(v.x, v.y); w.y = pk2(v.z, v.w); *(u32x2*)p = w; }
struct EpiH {
    static constexpr bool PERM = true;
    bf16_t* H; const float2* rope32; const float2* rope64;
    __device__ __forceinline__ f32x4 xf(int pos, int col, f32x4 v) const {
        if (col < 512 || (col >= HC_KROPE && col < HC_KROPE + 32)) {
            const int j0 = (col & 31) >> 1; const f32x4 cs = *(const f32x4*)(rope32 + pos * 16 + j0);
            f32x4 o; o.x = v.x * cs.x - v.y * cs.y; o.y = v.x * cs.y + v.y * cs.x; o.z = v.z * cs.z - v.w * cs.w; o.w = v.z * cs.w + v.w * cs.z;
            if (col < 256) o = o * SC_A; v = o;
        } else if (col >= HC_CQ && col < HC_CV) {
            const int j0 = ((col - HC_CQ) & 63) >> 1; const f32x4 cs = *(const f32x4*)(rope64 + pos * 32 + j0);
            f32x4 o; o.x = v.x * cs.x - v.y * cs.y; o.y = v.x * cs.y + v.y * cs.x; o.z = v.z * cs.z - v.w * cs.w; o.w = v.z * cs.w + v.w * cs.z;
            if (col < HC_CK) o = o * SC_C; v = o;
        }
        return v;
    }
    __device__ __forceinline__ void put4(int row, int col, f32x4 v) const { store_bf4(H + (size_t)row * HP + col, xf(seqinfo(row).pos, col, v)); }
    __device__ __forceinline__ void put(int row, int c0, int cc, f32x4 v0, f32x4 v1) const { put4(row, c0 + cc, v0); put4(row, c0 + 32 + cc, v1); }
    template <class U> __device__ __forceinline__ void put8(const U&, int row, int col, f32x4 v0, f32x4 v1) const { const int pos = seqinfo(row).pos; store_bf8(H + (size_t)row * HP + col, xf(pos, col, v0), xf(pos, col + 4, v1)); }
};
struct EpiUQ {
    static constexpr bool PERM = true;
    bf16_t* Q; const float* rstd; const float2* rope32;
    __device__ __forceinline__ f32x4 xf(int row, int col, f32x4 v, float rs) const {
        v = v * rs;
        const int t = col % 96;
        if (t >= 64) { const int pos = seqinfo(row).pos; const int j0 = (t - 64) >> 1; const f32x4 cs = *(const f32x4*)(rope32 + pos * 16 + j0);
            f32x4 o; o.x = v.x * cs.x - v.y * cs.y; o.y = v.x * cs.y + v.y * cs.x; o.z = v.z * cs.z - v.w * cs.w; o.w = v.z * cs.w + v.w * cs.z; v = o; }
        return v * SC_B;
    }
    __device__ __forceinline__ void put4(int row, int col, f32x4 v) const { if (col >= 576) return; store_bf4(Q + (size_t)row * QBP + col, xf(row, col, v, rstd[2 * row])); }
    template <class U> __device__ __forceinline__ void put8(const U&, int row, int col, f32x4 v0, f32x4 v1) const { if (col >= 576) return; const float rs = rstd[2 * row]; store_bf8(Q + (size_t)row * QBP + col, xf(row, col, v0, rs), xf(row, col + 4, v1, rs)); }
    __device__ __forceinline__ void put(int row, int c0, int cc, f32x4 v0, f32x4 v1) const { put4(row, c0 + cc, v0); put4(row, c0 + 32 + cc, v1); }
};
struct EpiUKV {
    static constexpr bool PERM = true;
    bf16_t* KV; const float* rstd;
    template <class U> __device__ __forceinline__ void put8(const U&, int row, int col, f32x4 v0, f32x4 v1) const { const float rs = rstd[2 * row + 1]; store_bf8(KV + (size_t)row * KVP + col, v0 * rs, v1 * rs); }
    __device__ __forceinline__ void put4(int row, int col, f32x4 v) const { store_bf4(KV + (size_t)row * KVP + col, v * rstd[2 * row + 1]); }
    __device__ __forceinline__ void put(int row, int c0, int cc, f32x4 v0, f32x4 v1) const { put4(row, c0 + cc, v0); put4(row, c0 + 32 + cc, v1); }
};
struct EpiRes {
    static constexpr bool PERM = false;
    float* X; const float* xp; const float* xs; float* D;
    template <class U> __device__ __forceinline__ void put4(const U&, int row, int col, f32x4 v) const { put4(row, col, v); }
    __device__ __forceinline__ void put4(int row, int col, f32x4 v) const {
        const f32x4* p = (const f32x4*)(X + (size_t)row * DM + col);
        const f32x4 r = xp ? *(const f32x4*)(((row < NTOK_P) ? xp + (size_t)row * DM : xs + (size_t)(row - NTOK_P) * DM) + col) : *p;
        *(f32x4*)(D + (size_t)row * DM + col) = r * DN_ALPHA + v; }
    __device__ __forceinline__ void put(int row, int c0, int cc, f32x4 v0, f32x4 v1) const { put4(row, c0 + cc, v0); put4(row, c0 + 32 + cc, v1); }
};
__device__ __forceinline__ float silu_f(float x) { return x / (1.0f + __expf(-x)); }
struct EpiHid {
    static constexpr bool PERM = true;
    bf16_t* HID;
    __device__ __forceinline__ f32x4 act(f32x4 g, f32x4 u) const { f32x4 o; o.x = silu_f(g.x) * u.x; o.y = silu_f(g.y) * u.y; o.z = silu_f(g.z) * u.z; o.w = silu_f(g.w) * u.w; return o; }
    template <class U> __device__ __forceinline__ void putp8(const U&, int row, int col, f32x4 g0, f32x4 g1, f32x4 u0, f32x4 u1) const { store_bf8(HID + (size_t)row * DEXP + col, act(g0, u0), act(g1, u1)); }
    __device__ __forceinline__ void putp(int row, int col, f32x4 g, f32x4 u) const { f32x4 o; o.x = silu_f(g.x) * u.x; o.y = silu_f(g.y) * u.y; o.z = silu_f(g.z) * u.z; o.w = silu_f(g.w) * u.w; store_bf4(HID + (size_t)row * DEXP + col, o); }
    __device__ __forceinline__ void put(int row, int c0, int cc, f32x4 v0, f32x4 v1) const { putp(row, c0 + cc, v0, v1); }
};
struct EpiY {
    bf16_t* YB; const float* tw; const int* list; int seg0, cnt;
    __device__ __forceinline__ void put4(int row, int col, f32x4 v) const { const int r = row - seg0; if (r >= cnt) return; const int a = list[r]; store_bf4(YB + (size_t)a * DM + col, v * tw[a]); }
    __device__ __forceinline__ void put(int row, int c0, int cc, f32x4 v0, f32x4 v1) const { put4(row, c0 + cc, v0); put4(row, c0 + 32 + cc, v1); }
};

struct EpiYO {
    static constexpr bool PERM = true;
    bf16_t* YB; const float* tw; const int* list; const LAS int* seg;
    template <class U> __device__ __forceinline__ void put8(const U& u, int row, int col, f32x4 v0, f32x4 v1) const {
        const int r = row - __builtin_amdgcn_readfirstlane(seg[u.e]); if (r >= __builtin_amdgcn_readfirstlane(seg[33 + u.e])) return; const int a = list[(size_t)u.e * LIST_CAP + r]; const float w = tw[a]; store_bf8(YB + (size_t)a * DM + col, v0 * w, v1 * w); }
};
template <class Epi>
__device__ __forceinline__ void sg_phase(Frame& F, const bf16_t* A, int lda, const bf16_t* Bt, int ldb, int M, int N, int K, const Epi& E) {
    const int nN = N / 64, items = (M / 32) * nN;
    for (int it = F.gw; it < items; it += F.NGW) { const int mt = it / nN, nt = it - mt * nN;
        sg_tile(A, lda, Bt + (size_t)(nt * 64) * ldb, Bt + (size_t)(nt * 64 + 32) * ldb, ldb, K, mt * 32, nt * 64, E, IdRows(), F.lane); }
}


namespace pg8 {
constexpr int BM = 256, BK = 64, HALF = 128, HTB = HALF * BK * 2, NXCD = 8, WGM = 8;
__host__ __device__ __forceinline__ int lds_byte(int r, int c) { const int st = (r >> 4) * 2 + (c >> 5), rr = r & 15, cc = c & 31, ob = rr * 64 + cc * 2; return st * 1024 + (ob ^ (((ob >> 9) & 1) << 5)); }
__host__ __device__ __forceinline__ void stage_rc(int b, int& R, int& C) { const int st = b / 1024, sb = b % 1024, swz = sb ^ (((sb >> 9) & 1) << 5); R = (st >> 1) * 16 + swz / 64; C = (st & 1) * 32 + (swz % 64) / 2; }
__host__ __device__ __forceinline__ int perm32(int rho) { const int n = rho >> 4, i = rho & 15; return 8 * (i >> 2) + 4 * n + (i & 3); }
struct Unit { int pm, pn, e; const char* a; const char* b; };
__device__ __forceinline__ bool order_next(int i, int G, int c, int nM, int nN, int& pm, int& pn) {
    const int nwg = nM * nN; const long L = (long)i * G + c; if (L >= nwg) return false;
    int wgid = (int)L; { const int q = nwg / NXCD, r = nwg % NXCD, xcd = wgid % NXCD, off = wgid / NXCD; wgid = (xcd < r ? xcd * (q + 1) : r * (q + 1) + (xcd - r) * q) + off; }
    const int nig = WGM * nN, gid = wgid / nig, fm = gid * WGM, gsz = (nM - fm) < WGM ? (nM - fm) : WGM;
    pm = fm + ((wgid % nig) % gsz); pn = (wgid % nig) / gsz; return true;
}
struct DenseSched {
    const char* A; const char* Bt; int nM, nN, G, c; size_t tstepA, tstepB;
    __device__ __forceinline__ void init(const bf16_t* A_, int lda, const bf16_t* Bt_, int M, int N, int K, int G_, int c_) { A = (const char*)A_; Bt = (const char*)Bt_; nM = M / BM; nN = N / BM; G = G_; c = c_; tstepA = (size_t)BM * lda * 2; tstepB = (size_t)BM * K * 2; }
    __device__ __forceinline__ bool next(int i, Unit& u) const { if (!order_next(i, G, c, nM, nN, u.pm, u.pn)) return false; u.e = 0; u.a = A + (size_t)u.pm * tstepA; u.b = Bt + (size_t)u.pn * tstepB; return true; }
    __device__ __forceinline__ unsigned arow(const Unit&, int) const { return 0u; }
};
template <class Epi, bool PAIR> struct EpiApply;
template <class Epi, class Sched, bool GATHER, bool PAIR>
__device__ __forceinline__ void gemm_phase(LAS unsigned char* lds, int tid, int K, int lda, const Sched& S, const Epi& E) {
    const int wid = __builtin_amdgcn_readfirstlane(tid >> 6), lane = tid & 63, wr = wid >> 2, wc = wid & 3, fr = lane & 15, fq = lane >> 4;
    const int nt = K / BK;
    unsigned voffA[2], voffB[2]; int RA[2], CA[2];
#pragma unroll
    for (int i = 0; i < 2; ++i) { int R, C; stage_rc(tid * 16 + i * 8192, R, C); const int Rb = Epi::PERM ? ((R & ~31) + perm32(R & 31)) : R; RA[i] = R; CA[i] = C;
        voffA[i] = (unsigned)(R * lda + C) * 2u; voffB[i] = (unsigned)(Rb * K + C) * 2u; }
    const size_t kstep = (size_t)(BK * 2);
    const size_t hstepA = (size_t)HALF * lda * 2, hstepB = (size_t)HALF * K * 2;
    const unsigned ldsw = (unsigned)wid * 1024u;
    const int aoff = lds_byte(wr * 64 + fr, fq * 8), boff = lds_byte(wc * 32 + fr, fq * 8);
#define PG8_SA(b, h) (((b) * 2 + (h)) * HTB)
#define PG8_SB(b, h) ((4 + (b) * 2 + (h)) * HTB)
#define PG8_STAGE(bufoff, gbase, voff) do { _Pragma("unroll") for (int _i = 0; _i < 2; ++_i) \
        __builtin_amdgcn_global_load_lds((const unsigned*)((const char*)(gbase) + (voff)[_i]), (LAS unsigned*)(lds + (bufoff) + ldsw + _i * 8192), 16, 0, 0); } while (0)
#define PG8_STAGE_A(bufoff, ab, vg, h, koff) do { if (GATHER) { PG8_STAGE(bufoff, (ab) + (koff), (vg)[h]); } else { PG8_STAGE(bufoff, (ab) + (h) * hstepA + (koff), voffA); } } while (0)
#define PG8_LDA(dst, b, h) do { _Pragma("unroll") for (int m = 0; m < 4; ++m) _Pragma("unroll") for (int k = 0; k < 2; ++k) dst[m][k] = *(const LAS bf16x8*)(lds + PG8_SA(b, h) + aoff + m * 2048 + k * 1024); } while (0)
#define PG8_LDB(dst, b, h) do { _Pragma("unroll") for (int n = 0; n < 2; ++n) _Pragma("unroll") for (int k = 0; k < 2; ++k) dst[n][k] = *(const LAS bf16x8*)(lds + PG8_SB(b, h) + boff + n * 2048 + k * 1024); } while (0)
#define PG8_MMA(ai, bj, At, Bt) do { __builtin_amdgcn_s_setprio(1); _Pragma("unroll") for (int m = 0; m < 4; ++m) _Pragma("unroll") for (int n = 0; n < 2; ++n) _Pragma("unroll") for (int k = 0; k < 2; ++k) \
        acc[ai][bj][m][n] = __builtin_amdgcn_mfma_f32_16x16x32_bf16(Bt[n][k], At[m][k], acc[ai][bj][m][n], 0, 0, 0); __builtin_amdgcn_s_setprio(0); } while (0)
#define PG8_WAIT_V(n) asm volatile("s_waitcnt vmcnt(" #n ")" ::: "memory")
#define PG8_WAIT_L(n) asm volatile("s_waitcnt lgkmcnt(" #n ")" ::: "memory")
#define PG8_BAR __builtin_amdgcn_s_barrier()
#define PG8_SCHED __builtin_amdgcn_sched_barrier(0)
    Unit cur, nxt; int ui = 0;
    if (!S.next(0, cur)) return;
    f32x4 acc[2][2][4][2];
#pragma unroll
    for (int a = 0; a < 2; ++a)
#pragma unroll
        for (int b = 0; b < 2; ++b)
#pragma unroll
            for (int m = 0; m < 4; ++m)
#pragma unroll
                for (int n = 0; n < 2; ++n) acc[a][b][m][n] = (f32x4){0.f, 0.f, 0.f, 0.f};
    bf16x8 At[4][2], B0[2][2], B1[2][2];
    unsigned vgc[2][2] = {{0u, 0u}, {0u, 0u}}, vgn[2][2] = {{0u, 0u}, {0u, 0u}};
    if (GATHER) {
#pragma unroll
        for (int h = 0; h < 2; ++h)
#pragma unroll
            for (int i = 0; i < 2; ++i) vgc[h][i] = S.arow(cur, h * HALF + RA[i]) * (unsigned)(lda * 2) + (unsigned)CA[i] * 2u;
    }
    const char* cA = cur.a; const char* cB = cur.b;
    PG8_STAGE(PG8_SB(0, 0), cB, voffB); PG8_STAGE(PG8_SB(0, 1), cB + hstepB, voffB); PG8_STAGE_A(PG8_SA(0, 0), cA, vgc, 0, 0); PG8_STAGE_A(PG8_SA(0, 1), cA, vgc, 1, 0);
    if (wr == 1) PG8_BAR;
    PG8_WAIT_V(2); PG8_BAR;
    PG8_STAGE(PG8_SB(1, 0), cB + kstep, voffB); PG8_STAGE_A(PG8_SA(1, 0), cA, vgc, 0, kstep); PG8_STAGE(PG8_SB(1, 1), cB + hstepB + kstep, voffB);
    PG8_WAIT_V(6); PG8_BAR;
    for (;;) {
        const bool has_next = S.next(ui + 1, nxt);
        const char* nA = has_next ? nxt.a : cA; const char* nB = has_next ? nxt.b : cB;
        if (GATHER) {
#pragma unroll
            for (int h = 0; h < 2; ++h)
#pragma unroll
                for (int i = 0; i < 2; ++i) vgn[h][i] = has_next ? (S.arow(nxt, h * HALF + RA[i]) * (unsigned)(lda * 2) + (unsigned)CA[i] * 2u) : vgc[h][i];
        }
#pragma clang loop unroll(disable)
        for (int t = 0; t < nt; t += 2) {
            const bool last = (t == nt - 2);
            const size_t k1 = (size_t)(t + 1) * kstep;
            const char* a2 = last ? nA : cA; const char* b2 = last ? nB : cB + (size_t)(t + 2) * kstep; const size_t ka2 = last ? 0 : (size_t)(t + 2) * kstep;
            const char* b3 = b2 + kstep; const size_t ka3 = ka2 + kstep;
            unsigned v2[2][2];
#pragma unroll
            for (int h = 0; h < 2; ++h)
#pragma unroll
                for (int i = 0; i < 2; ++i) v2[h][i] = last ? vgn[h][i] : vgc[h][i];
            PG8_LDB(B0, 0, 0); PG8_LDB(B1, 0, 1); PG8_SCHED; PG8_LDA(At, 0, 0); PG8_STAGE_A(PG8_SA(1, 1), cA, vgc, 1, k1);
            PG8_WAIT_V(8); PG8_WAIT_L(0); PG8_BAR; PG8_MMA(0, 0, At, B0); PG8_MMA(0, 1, At, B1); PG8_BAR; PG8_SCHED;
            PG8_LDA(At, 0, 1); PG8_STAGE(PG8_SB(0, 0), b2, voffB); PG8_STAGE(PG8_SB(0, 1), b2 + hstepB, voffB); PG8_STAGE_A(PG8_SA(0, 0), a2, v2, 0, ka2);
            PG8_WAIT_V(8); PG8_WAIT_L(0); PG8_BAR; PG8_MMA(1, 0, At, B0); PG8_MMA(1, 1, At, B1); PG8_BAR; PG8_SCHED;
            PG8_LDB(B0, 1, 0); PG8_LDB(B1, 1, 1); PG8_SCHED; PG8_LDA(At, 1, 0); PG8_STAGE_A(PG8_SA(0, 1), a2, v2, 1, ka2);
            PG8_WAIT_V(8); PG8_WAIT_L(0); PG8_BAR; PG8_MMA(0, 0, At, B0); PG8_MMA(0, 1, At, B1); PG8_BAR; PG8_SCHED;
            PG8_LDA(At, 1, 1); PG8_STAGE(PG8_SB(1, 0), b3, voffB); PG8_STAGE(PG8_SB(1, 1), b3 + hstepB, voffB); PG8_STAGE_A(PG8_SA(1, 0), a2, v2, 0, ka3);
            PG8_WAIT_V(8); PG8_WAIT_L(0); PG8_BAR; PG8_MMA(1, 0, At, B0); PG8_MMA(1, 1, At, B1); PG8_BAR; PG8_SCHED;
        }
        if (wr == 0) PG8_BAR;
        { int fr_ = fr, fq_ = fq; asm volatile("" : "+v"(fr_), "+v"(fq_));
          EpiApply<Epi, PAIR>::run(E, acc, cur, wr, wc, fr_, fq_); }
        if (!has_next) break;
#pragma unroll
        for (int a = 0; a < 2; ++a)
#pragma unroll
            for (int b = 0; b < 2; ++b)
#pragma unroll
                for (int m = 0; m < 4; ++m)
#pragma unroll
                    for (int n = 0; n < 2; ++n) acc[a][b][m][n] = (f32x4){0.f, 0.f, 0.f, 0.f};
        cur = nxt; cA = nA; cB = nB; ++ui;
        if (GATHER) {
#pragma unroll
            for (int h = 0; h < 2; ++h)
#pragma unroll
                for (int i = 0; i < 2; ++i) vgc[h][i] = vgn[h][i];
        }
        if (wr == 1) PG8_BAR;
    }
    PG8_WAIT_V(0);
    PG8_BAR;
#undef PG8_SA
#undef PG8_SB
#undef PG8_STAGE
#undef PG8_STAGE_A
#undef PG8_LDA
#undef PG8_LDB
#undef PG8_MMA
#undef PG8_WAIT_V
#undef PG8_WAIT_L
#undef PG8_BAR
#undef PG8_SCHED
}
template <class Epi> struct EpiApply<Epi, false> {
    static __device__ __forceinline__ void run(const Epi& E, const f32x4 (&acc)[2][2][4][2], const Unit& u, int wr, int wc, int fr, int fq) {
#pragma unroll
        for (int ai = 0; ai < 2; ++ai)
#pragma unroll
            for (int m = 0; m < 4; ++m) { const int row = u.pm * BM + ai * HALF + wr * 64 + m * 16 + fr;
#pragma unroll
                for (int bj = 0; bj < 2; ++bj) {
                    if constexpr (Epi::PERM) E.put8(u, row, u.pn * BM + bj * HALF + wc * 32 + 8 * fq, acc[ai][bj][m][0], acc[ai][bj][m][1]);
                    else { E.put4(u, row, u.pn * BM + bj * HALF + wc * 32 + 4 * fq, acc[ai][bj][m][0]); E.put4(u, row, u.pn * BM + bj * HALF + wc * 32 + 16 + 4 * fq, acc[ai][bj][m][1]); } }
            }
    }
};
template <class Epi> struct EpiApply<Epi, true> {
    static __device__ __forceinline__ void run(const Epi& E, const f32x4 (&acc)[2][2][4][2], const Unit& u, int wr, int wc, int fr, int fq) {
#pragma unroll
        for (int ai = 0; ai < 2; ++ai)
#pragma unroll
            for (int m = 0; m < 4; ++m) { const int row = u.pm * BM + ai * HALF + wr * 64 + m * 16 + fr;
                E.putp8(u, row, u.pn * HALF + wc * 32 + 8 * fq, acc[ai][0][m][0], acc[ai][0][m][1], acc[ai][1][m][0], acc[ai][1][m][1]); }
    }
};
}

__device__ __forceinline__ void rowstat_pass(Frame& F) {
    const bf16_t* H = (const bf16_t*)(F.ws + WS_H); float* rstd = (float*)(F.ws + WS_RSTD);
    for (int m = F.gw; m < NTOK; m += F.NGW) {
        const bf16_t* hr = H + (size_t)m * HP;
        const u32x2 q = *((const u32x2*)(hr + HC_CQ_LAT) + F.lane);
        const unsigned kv = *((const unsigned*)(hr + HC_CKV) + F.lane);
        float a0 = bf2f(q.x & 0xffff), a1 = bf2f(q.x >> 16), a2 = bf2f(q.y & 0xffff), a3 = bf2f(q.y >> 16), b0 = bf2f(kv & 0xffff), b1 = bf2f(kv >> 16);
        const float sq = wave_sum(a0 * a0 + a1 * a1 + a2 * a2 + a3 * a3), sk = wave_sum(b0 * b0 + b1 * b1);
        if (F.lane == 0) { rstd[2 * m] = 1.0f / sqrtf(sq * (1.0f / 256.0f) + RMS_EPS); rstd[2 * m + 1] = 1.0f / sqrtf(sk * (1.0f / 128.0f) + RMS_EPS); }
    }
}
__device__ __forceinline__ void red8(float (&v)[8], int lane) {
    float a[4], b[2], c;
#pragma unroll
    for (int i = 0; i < 4; ++i) a[i] = xpair32(v[i], v[i + 4]);
    { const bool up = (lane & 16) != 0;
#pragma unroll
      for (int i = 0; i < 2; ++i) { const float send = up ? a[i] : a[i + 2], keep = up ? a[i + 2] : a[i]; b[i] = keep + shx<16>(send); } }
    { const bool up = (lane & 8) != 0; const float send = up ? b[0] : b[1], keep = up ? b[1] : b[0]; c = keep + shx<8>(send); }
    c += shx<4>(c); c += shx<2>(c); c += shx<1>(c);
#pragma unroll
    for (int i = 0; i < 8; ++i) v[i] = __uint_as_float(__builtin_amdgcn_readlane(__float_as_uint(c), ((i >> 2) & 1) * 32 + ((i >> 1) & 1) * 16 + (i & 1) * 8));
}
__device__ __forceinline__ void red4(float (&v)[4], int lane) {
    float a[2], c;
#pragma unroll
    for (int i = 0; i < 2; ++i) a[i] = xpair32(v[i], v[i + 2]);
    { const bool up = (lane & 16) != 0; const float send = up ? a[0] : a[1], keep = up ? a[1] : a[0]; c = keep + shx<16>(send); }
    c += shx<8>(c); c += shx<4>(c); c += shx<2>(c); c += shx<1>(c);
#pragma unroll
    for (int i = 0; i < 4; ++i) v[i] = __uint_as_float(__builtin_amdgcn_readlane(__float_as_uint(c), ((i >> 1) & 1) * 32 + (i & 1) * 16));
}
__device__ __forceinline__ void ln1_route_pass(Frame& F, const Args& a, int layer, float* dstf = nullptr) {
    bf16_t* XB = (bf16_t*)(F.ws + WS_XB); float* tw = (float*)(F.ws + WS_TW); int* list = (int*)(F.ws + WS_LIST);
    const float* g = a.ln1_g + layer * DM; const float* bb = a.ln1_b + layer * DM;
    const float* wc = a.moe_w_coarse + (size_t)layer * DM * 4; const float* wf = a.moe_w_fine + (size_t)layer * 4 * DM * 8;
    for (int q = F.tid; q < 4 * 1024 * 2; q += NTHREADS) { const int hf = q & 1, k = (q >> 1) & 1023, gg = q >> 11; const int l = (k & 255) >> 2, e = k & 3, j = k >> 8;
        *(LAS f32x4*)(F.lds + (size_t)(gg * 2048 + ((j * 4 + e) * 2 + hf) * 64 + l) * 16) = *((const f32x4*)wf + q); }
    f32x4 wcr[4][4];
#pragma unroll
    for (int j = 0; j < 4; ++j)
#pragma unroll
        for (int e = 0; e < 4; ++e) wcr[j][e] = *(const f32x4*)(wc + (size_t)(4 * F.lane + 256 * j + e) * 4);
    __syncthreads();
    f32x4 vn[2][4];
#pragma unroll
    for (int rr = 0; rr < 2; ++rr) { const int mm = F.gw + rr * F.NGW; if (mm < NTOK) {
#pragma unroll
        for (int j = 0; j < 4; ++j) vn[rr][j] = *((const f32x4*)(a.out + (size_t)mm * DM) + F.lane + 64 * j); } }
    for (int m0 = F.gw; m0 < NTOK; m0 += 2 * F.NGW) {
        f32x4 vc[2][4];
#pragma unroll
        for (int rr = 0; rr < 2; ++rr)
#pragma unroll
            for (int j = 0; j < 4; ++j) vc[rr][j] = vn[rr][j];
#pragma unroll
        for (int rr = 0; rr < 2; ++rr) { const int mm = m0 + (2 + rr) * F.NGW; if (mm < NTOK) {
#pragma unroll
            for (int j = 0; j < 4; ++j) vn[rr][j] = *((const f32x4*)(a.out + (size_t)mm * DM) + F.lane + 64 * j); } }
#pragma unroll
      for (int rr = 0; rr < 2; ++rr) { const int m = m0 + rr * F.NGW; if (m < NTOK) {
        f32x4 v[4]; float s = 0.f;
#pragma unroll
        for (int j = 0; j < 4; ++j) { v[j] = vc[rr][j]; s += (v[j].x + v[j].y) + (v[j].z + v[j].w); }
        const float mean = wave_sum(s) * (1.f / DM); float s2 = 0.f;
#pragma unroll
        for (int j = 0; j < 4; ++j) { v[j] = v[j] - mean; s2 += (v[j].x * v[j].x + v[j].y * v[j].y) + (v[j].z * v[j].z + v[j].w * v[j].w); }
        const float rs = 1.f / sqrtf(wave_sum(s2) * (1.f / DM) + LN_EPS);
        float cl[4] = {0.f, 0.f, 0.f, 0.f};
#pragma unroll
        for (int j = 0; j < 4; ++j) { const int c = 4 * F.lane + 256 * j; const f32x4 gg = *(const f32x4*)(g + c), bv = *(const f32x4*)(bb + c); v[j] = v[j] * rs * gg + bv;
            u32x2 w; w.x = pk2(v[j].x, v[j].y); w.y = pk2(v[j].z, v[j].w); *((u32x2*)(XB + (size_t)m * DM) + F.lane + 64 * j) = w;
#pragma unroll
            for (int e = 0; e < 4; ++e) { const f32x4 w4 = wcr[j][e]; const float xe = v[j][e]; cl[0] += xe * w4.x; cl[1] += xe * w4.y; cl[2] += xe * w4.z; cl[3] += xe * w4.w; } }
        red4(cl, F.lane);
        int grp = 0; float cm = cl[0];
#pragma unroll
        for (int e = 1; e < 4; ++e) if (cl[e] > cm) { cm = cl[e]; grp = e; }
        float den = 0.f;
#pragma unroll
        for (int e = 0; e < 4; ++e) den += __expf(cl[e] - cm);
        const float pg = 1.0f / den;
        grp = __builtin_amdgcn_readfirstlane(grp);
        const LAS f32x4* wl = (const LAS f32x4*)(F.lds) + grp * 2048 + F.lane;
        float fl[8] = {0.f, 0.f, 0.f, 0.f, 0.f, 0.f, 0.f, 0.f};
#pragma unroll
        for (int j = 0; j < 4; ++j)
#pragma unroll
            for (int e = 0; e < 4; ++e) { const f32x4 wa = wl[((j * 4 + e) * 2) * 64], wb = wl[((j * 4 + e) * 2 + 1) * 64]; const float xe = v[j][e];
                fl[0] += xe * wa.x; fl[1] += xe * wa.y; fl[2] += xe * wa.z; fl[3] += xe * wa.w; fl[4] += xe * wb.x; fl[5] += xe * wb.y; fl[6] += xe * wb.z; fl[7] += xe * wb.w; }
        red8(fl, F.lane);
        int i0 = 0; float v0 = fl[0];
#pragma unroll
        for (int e = 1; e < 8; ++e) if (fl[e] > v0) { v0 = fl[e]; i0 = e; }
        int i1 = -1; float v1 = -3.0e38f;
#pragma unroll
        for (int e = 0; e < 8; ++e) if (e != i0 && fl[e] > v1) { v1 = fl[e]; i1 = e; }
        const float e1 = __expf(v1 - v0), w0 = pg / (1.0f + e1), w1 = pg * e1 / (1.0f + e1);
        if (F.lane < 2 && !dstf) { const int e = grp * 8 + (F.lane == 0 ? i0 : i1); const int a_id = 2 * m + F.lane;
            const unsigned pos = __hip_atomic_fetch_add(F.ctl + CW_CNT + layer * 64 + e, 1u, RLX_AGENT);
            list[(size_t)e * LIST_CAP + pos] = a_id; tw[a_id] = (F.lane == 0) ? w0 : w1; }
          } }
    }
    __syncthreads();
}
__device__ __forceinline__ void ln2_pass(Frame& F, const Args& a, int layer) {
    bf16_t* XB = (bf16_t*)(F.ws + WS_XB); const bf16_t* YB = (const bf16_t*)(F.ws + WS_YB);
    const float* g = a.ln2_g + layer * DM; const float* bb = a.ln2_b + layer * DM; const float* g1 = a.ln1_g + layer * DM; const float* b1 = a.ln1_b + layer * DM;
    f32x4 xn[2][4]; u32x2 pn[2][4], qn[2][4];
#define LN2_LOAD(rr, mm) do { const bf16_t* y0_ = YB + (size_t)(2 * (mm)) * DM; _Pragma("unroll") for (int j = 0; j < 4; ++j) { xn[rr][j] = *((const f32x4*)(a.out + (size_t)(mm) * DM) + F.lane + 64 * j); \
        pn[rr][j] = *((const u32x2*)y0_ + F.lane + 64 * j); qn[rr][j] = *((const u32x2*)(y0_ + DM) + F.lane + 64 * j); } } while (0)
#pragma unroll
    for (int rr = 0; rr < 2; ++rr) { const int mm = F.gw + rr * F.NGW; if (mm < NTOK) LN2_LOAD(rr, mm); }
    for (int m0 = F.gw; m0 < NTOK; m0 += 2 * F.NGW) {
        f32x4 xc[2][4]; u32x2 pc[2][4], qc[2][4];
#pragma unroll
        for (int rr = 0; rr < 2; ++rr)
#pragma unroll
            for (int j = 0; j < 4; ++j) { xc[rr][j] = xn[rr][j]; pc[rr][j] = pn[rr][j]; qc[rr][j] = qn[rr][j]; }
#pragma unroll
        for (int rr = 0; rr < 2; ++rr) { const int mm = m0 + (2 + rr) * F.NGW; if (mm < NTOK) LN2_LOAD(rr, mm); }
#pragma unroll
        for (int rr = 0; rr < 2; ++rr) { const int m = m0 + rr * F.NGW; if (m < NTOK) {
            float* xr = a.out + (size_t)m * DM;
            f32x4 v[4]; float s = 0.f;
            { float s1 = 0.f;
#pragma unroll
              for (int j = 0; j < 4; ++j) { v[j] = xc[rr][j]; s1 += (v[j].x + v[j].y) + (v[j].z + v[j].w); }
              const float mean1 = wave_sum(s1) * (1.f / DM); float q1 = 0.f;
#pragma unroll
              for (int j = 0; j < 4; ++j) { v[j] = v[j] - mean1; q1 += (v[j].x * v[j].x + v[j].y * v[j].y) + (v[j].z * v[j].z + v[j].w * v[j].w); }
              const float rs1 = 1.f / sqrtf(wave_sum(q1) * (1.f / DM) + LN_EPS);
#pragma unroll
              for (int j = 0; j < 4; ++j) { const int c = 4 * F.lane + 256 * j; xc[rr][j] = v[j] * rs1 * *(const f32x4*)(g1 + c) + *(const f32x4*)(b1 + c); } }
#pragma unroll
            for (int j = 0; j < 4; ++j) { v[j] = xc[rr][j] * DN_ALPHA; const u32x2 p = pc[rr][j], q = qc[rr][j];
                v[j].x += bf2f(p.x & 0xffff) + bf2f(q.x & 0xffff); v[j].y += bf2f(p.x >> 16) + bf2f(q.x >> 16); v[j].z += bf2f(p.y & 0xffff) + bf2f(q.y & 0xffff); v[j].w += bf2f(p.y >> 16) + bf2f(q.y >> 16);
                s += (v[j].x + v[j].y) + (v[j].z + v[j].w); }
            const float mean = wave_sum(s) * (1.f / DM); float s2 = 0.f;
#pragma unroll
            for (int j = 0; j < 4; ++j) { v[j] = v[j] - mean; s2 += (v[j].x * v[j].x + v[j].y * v[j].y) + (v[j].z * v[j].z + v[j].w * v[j].w); }
            const float rs = 1.f / sqrtf(wave_sum(s2) * (1.f / DM) + LN_EPS);
#pragma unroll
            for (int j = 0; j < 4; ++j) { const int c = 4 * F.lane + 256 * j; const f32x4 gg = *(const f32x4*)(g + c), bv = *(const f32x4*)(bb + c); v[j] = v[j] * rs * gg + bv;
                *((f32x4*)xr + F.lane + 64 * j) = v[j]; u32x2 w; w.x = pk2(v[j].x, v[j].y); w.y = pk2(v[j].z, v[j].w); *((u32x2*)(XB + (size_t)m * DM) + F.lane + 64 * j) = w; }
        } }
    }
#undef LN2_LOAD
}
__device__ __forceinline__ void moe_convert(Frame& F, const Args& a, int layer) {
    LAS float* scr = (LAS float*)(F.lds + F.wave * 16384);
    constexpr int I_13 = (1024 / 64) * (1024 / 32), I_2 = (512 / 64) * (1024 / 32), PER_E = I_13 + I_2;
    for (int it = F.gw; it < NEXP * PER_E; it += F.NGW) {
        const int e = it / PER_E; int r = it - e * PER_E; const size_t le = (size_t)layer * NEXP + e;
        if (r < I_13) { const int kb = r / 32, nb = r % 32; const float* src = ((nb >> 2) & 1) ? a.moe_w3 : a.moe_w1;
            const int sc0 = ((32 * nb) >> 8) * 128 + ((32 * nb) & 127);
            transpose_item_v4(src + le * 1024 * 512 + (size_t)(kb * 64) * 512 + sc0, 512, (bf16_t*)(F.ws + WS_W13) + (size_t)e * 1024 * 1024 + (size_t)(nb * 32) * 1024 + kb * 64, 1024, scr, F.lane); }
        else { r -= I_13; const int kb = r / 32, nb = r % 32;
            transpose_item_v4(a.moe_w2 + le * 512 * 1024 + (size_t)(kb * 64) * 1024 + nb * 32, 1024, (bf16_t*)(F.ws + WS_W2) + (size_t)e * 1024 * 512 + (size_t)(nb * 32) * 512 + kb * 64, 512, scr, F.lane); }
    }
}

struct RowSrc { const bf16_t* p; long pitch; };
constexpr int SA_P = 0, SA_V = 4096, SA_AL = 12288, SA_RL = 12544;
template <int NC0, int NC1, int MODE>
__device__ __forceinline__ void sattn_core(const bf16x8* qf, RowSrc k0, RowSrc k1, RowSrc vs, int kb_lo, int kb_hi, int qidx0, float lse_ref, LAS unsigned char* scr, int lane, f32x16* o, float& lse_out) {
    const int r32 = lane & 31, hi = lane >> 5;
    LAS bf16_t* Pb = (LAS bf16_t*)(scr + SA_P); LAS bf16_t* Vb = (LAS bf16_t*)(scr + SA_V); LAS float* Al = (LAS float*)(scr + SA_AL);
    float m = -1.0e30f, l = 0.f;
    if (MODE != 1) { o[0] = f32x16{}; o[1] = f32x16{}; }
    for (int kb = kb_lo; kb < kb_hi; ++kb) {
        const long key = (long)kb * 32 + r32;
        f32x16 s = {};
#pragma unroll
        for (int c = 0; c < NC0; ++c) { const bf16x8 kf = *(const bf16x8*)(k0.p + key * k0.pitch + 16 * c + 8 * hi); s = MFMA32(kf, qf[c], s); }
#pragma unroll
        for (int c = 0; c < NC1; ++c) { const bf16x8 kf = *(const bf16x8*)(k1.p + key * k1.pitch + 16 * c + 8 * hi); s = MFMA32(kf, qf[NC0 + c], s); }
        bool valid[16];
#pragma unroll
        for (int r = 0; r < 16; ++r) { if (MODE == 0) valid[r] = true; else { const int d = kb * 32 + crow(r, hi) - (qidx0 + r32); valid[r] = (d <= 64 && d >= -64); } }
        float p[16];
        if (MODE == 2) {
#pragma unroll
            for (int r = 0; r < 16; ++r) p[r] = valid[r] ? fast_exp2(s[r] - lse_ref) : 0.f;
        } else {
            float mx = -1.0e30f;
#pragma unroll
            for (int r = 0; r < 16; ++r) if (valid[r]) mx = fmaxf(mx, s[r]);
            mx = xmax32(mx);
            const float mn = fmaxf(m, mx), alpha = fast_exp2(m - mn); m = mn;
            float ps = 0.f;
#pragma unroll
            for (int r = 0; r < 16; ++r) { p[r] = valid[r] ? fast_exp2(s[r] - mn) : 0.f; ps += p[r]; }
            l = l * alpha + ps;
            if (MODE == 0) { if (hi == 0) Al[r32] = alpha; }
        }
        if (MODE != 1) {
#pragma unroll
            for (int g = 0; g < 4; ++g) { u32x2 w; w.x = pk2(p[4 * g], p[4 * g + 1]); w.y = pk2(p[4 * g + 2], p[4 * g + 3]); *(LAS u32x2*)(Pb + r32 * 40 + 8 * g + 4 * hi) = w; }
#pragma unroll
            for (int i = 0; i < 4; ++i) { const int idx = i * 64 + lane, kr = idx >> 3, pc = idx & 7; *(LAS u32x4*)(Vb + kr * 72 + pc * 8) = *(const u32x4*)(vs.p + ((long)kb * 32 + kr) * vs.pitch + pc * 8); }
            LDS_WAIT();
            if (MODE == 0) {
#pragma unroll
                for (int r = 0; r < 16; ++r) { const float al = Al[crow(r, hi)]; o[0][r] *= al; o[1][r] *= al; }
            }
#pragma unroll
            for (int st = 0; st < 2; ++st) {
                const bf16x8 pf = *(const LAS bf16x8*)(Pb + r32 * 40 + 16 * st + 8 * hi);
#pragma unroll
                for (int db = 0; db < 2; ++db) { bf16x8 vf;
#pragma unroll
                    for (int j = 0; j < 8; ++j) vf[j] = (short)Vb[(16 * st + 8 * hi + j) * 72 + 32 * db + r32];
                    o[db] = MFMA32(pf, vf, o[db]); }
            }
            LDS_WAIT();
        }
    }
    if (MODE != 2) { l = xsum32(l); lse_out = m + __log2f(l); }
    if (MODE == 0) {
        LAS float* Rl = (LAS float*)(scr + SA_RL);
        if (hi == 0) Rl[r32] = 1.0f / l;
        LDS_WAIT();
#pragma unroll
        for (int r = 0; r < 16; ++r) { const float rl = Rl[crow(r, hi)]; o[0][r] *= rl; o[1][r] *= rl; }
        LDS_WAIT();
    }
}

__device__ __forceinline__ void sattn_phase(Frame& F, const Args& a, int layer, int kind_lo) {
    const bf16_t* H = (const bf16_t*)(F.ws + WS_H); const bf16_t* QB = (const bf16_t*)(F.ws + WS_QB); const bf16_t* KVB = (const bf16_t*)(F.ws + WS_KVB);
    bf16_t* MIX = (bf16_t*)(F.ws + WS_MIX); const float* lsec = (const float*)(F.ws + WS_LSEC);
    LAS unsigned char* scr = F.lds + F.wave * 16384;
    const int lane = F.lane, r32 = lane & 31, hi = lane >> 5;
    float lam, lam_init;
    { const float* lv = a.diff_lambda + layer * 128; float d1 = 0.f, d2 = 0.f;
      for (int i = 0; i < 32; ++i) { d1 += lv[i] * lv[32 + i]; d2 += lv[64 + i] * lv[96 + i]; }
      lam_init = 0.8f - 0.6f * expf(-0.3f * (float)layer); lam = expf(d1) - expf(d2) + lam_init; }
    constexpr int NRB = NTOK / 32;
    const int items = NRB * (4 + 6 + 6);
    for (int it = kind_lo * NRB + F.gw; it < items; it += F.NGW) {
        const int kind = it / NRB, rb = it - kind * NRB; const int m0 = rb * 32; const SeqInfo si = seqinfo(m0);
#if !OPT_ATTN
        if (kind < 4) {
            const int h = kind; f32x16 o0[2], o1[2]; float dummy;
            for (int c = 0; c < 2; ++c) {
                bf16x8 qf[2];
#pragma unroll
                for (int d0 = 0; d0 < 2; ++d0) qf[d0] = *(const bf16x8*)(H + (size_t)(m0 + r32) * HP + HC_AQ + h * 64 + c * 32 + 16 * d0 + 8 * hi);
                const RowSrc ks{H + (size_t)si.base * HP + HC_AK + h * 64 + c * 32, HP}, vs{H + (size_t)si.base * HP + HC_AV + h * 64, HP};
                sattn_core<2, 0, 0>(qf, ks, ks, vs, 0, si.len / 32, 0, 0.f, scr, lane, c == 0 ? o0 : o1, dummy);
            }
            const float* sg = a.diff_subln + layer * 64; const float g0 = sg[r32], g1 = sg[32 + r32];
#pragma unroll
            for (int r = 0; r < 16; ++r) { const float x0 = o0[0][r] - lam * o1[0][r], x1 = o0[1][r] - lam * o1[1][r]; float ss = x0 * x0 + x1 * x1;
                ss += shx<1>(ss); ss += shx<2>(ss); ss += shx<4>(ss); ss += shx<8>(ss); ss += shx<16>(ss);
                const float rs = (1.0f - lam_init) / sqrtf(ss * (1.0f / 64.0f) + RMS_EPS);
                bf16_t* op = MIX + (size_t)(m0 + crow(r, hi)) * DM + MIX_A + h * 64 + r32;
                op[0] = (bf16_t)f2bf(x0 * rs * g0); op[32] = (bf16_t)f2bf(x1 * rs * g1); }
        } else if (kind < 10) {
            const int h = kind - 4; f32x16 o[2]; float dummy; bf16x8 qf[6];
#pragma unroll
            for (int d0 = 0; d0 < 6; ++d0) qf[d0] = *(const bf16x8*)(QB + (size_t)(m0 + r32) * QBP + h * 96 + 16 * d0 + 8 * hi);
            const RowSrc k0{KVB + (size_t)si.base * KVP + h * 128, KVP}, k1{H + (size_t)si.base * HP + HC_KROPE, HP}, vs{KVB + (size_t)si.base * KVP + h * 128 + 64, KVP};
            sattn_core<4, 2, 0>(qf, k0, k1, vs, 0, si.len / 32, 0, 0.f, scr, lane, o, dummy);
#pragma unroll
            for (int r = 0; r < 16; ++r) { bf16_t* op = MIX + (size_t)(m0 + crow(r, hi)) * DM + MIX_B + h * 64 + r32; op[0] = (bf16_t)f2bf(o[0][r]); op[32] = (bf16_t)f2bf(o[1][r]); }
        } else
#endif
        {
            const int gj = kind - 10, g = gj >> 1, hh = gj;
            const int dil = (g == 0) ? 1 : (g == 1 ? 4 : 16); const int L = si.len / dil, bpr = L / 32;
            const int w = (m0 - si.base) / 32, rho = w / bpr, ib = w - rho * bpr, i0 = ib * 32;
            const size_t qrow = (size_t)si.base + (size_t)(i0 + r32) * dil + rho;
            bf16x8 qf[4];
#pragma unroll
            for (int d0 = 0; d0 < 4; ++d0) qf[d0] = *(const bf16x8*)(H + qrow * HP + HC_CQ + hh * 64 + 16 * d0 + 8 * hi);
            const int j = gj & 1; const float l0 = lsec[(0 * (size_t)NTOK + qrow) * 2 + j], l1 = lsec[(1 * (size_t)NTOK + qrow) * 2 + j], l2 = lsec[(2 * (size_t)NTOK + qrow) * 2 + j];
            const float lm = fmaxf(l0, fmaxf(l1, l2)); const float lref = lm + __log2f(fast_exp2(l0 - lm) + fast_exp2(l1 - lm) + fast_exp2(l2 - lm));
            const RowSrc ks{H + ((size_t)si.base + rho) * HP + HC_CK + hh * 64, (long)HP * dil}, vs{H + ((size_t)si.base + rho) * HP + HC_CV + hh * 64, (long)HP * dil};
            int kb_lo = ib - 2, kb_hi = ib + 3; if (kb_lo < 0) kb_lo = 0; if (kb_hi > bpr) kb_hi = bpr;
            f32x16 o[2]; float dummy;
            sattn_core<4, 0, 2>(qf, ks, ks, vs, kb_lo, kb_hi, i0, lref, scr, lane, o, dummy);
#pragma unroll
            for (int r = 0; r < 16; ++r) { const size_t orow = (size_t)si.base + (size_t)(i0 + crow(r, hi)) * dil + rho; bf16_t* op = MIX + orow * DM + MIX_C + hh * 64 + r32; op[0] = (bf16_t)f2bf(o[0][r]); op[32] = (bf16_t)f2bf(o[1][r]); }
        }
    }
}
__device__ __forceinline__ void cstat_phase(Frame& F) {
    const bf16_t* H = (const bf16_t*)(F.ws + WS_H); float* lsec = (float*)(F.ws + WS_LSEC);
    LAS unsigned char* scr = F.lds + F.wave * 16384;
    const int lane = F.lane, r32 = lane & 31, hi = lane >> 5;
    constexpr int NRB = NTOK / 32;
    for (int it = F.gw; it < NRB * 6; it += F.NGW) {
        const int gj = it / NRB, rb = it - gj * NRB, g = gj >> 1, j = gj & 1; const int m0 = rb * 32; const SeqInfo si = seqinfo(m0);
        const int dil = (g == 0) ? 1 : (g == 1 ? 4 : 16); const int L = si.len / dil, bpr = L / 32;
        const int w = (m0 - si.base) / 32, rho = w / bpr, ib = w - rho * bpr, i0 = ib * 32;
        const size_t qrow = (size_t)si.base + (size_t)(i0 + r32) * dil + rho;
        bf16x8 qf[4];
#pragma unroll
        for (int d0 = 0; d0 < 4; ++d0) qf[d0] = *(const bf16x8*)(H + qrow * HP + HC_CQ + gj * 64 + 16 * d0 + 8 * hi);
        const RowSrc ks{H + ((size_t)si.base + rho) * HP + HC_CK + gj * 64, (long)HP * dil};
        int kb_lo = ib - 2, kb_hi = ib + 3; if (kb_lo < 0) kb_lo = 0; if (kb_hi > bpr) kb_hi = bpr;
        float lse; sattn_core<4, 0, 1>(qf, ks, ks, ks, kb_lo, kb_hi, i0, 0.f, scr, lane, nullptr, lse);
        if (hi == 0) lsec[((size_t)g * NTOK + qrow) * 2 + j] = lse;
    }
}


namespace at {
typedef short s16x4 __attribute__((ext_vector_type(4)));
typedef short v4i16_t __attribute__((ext_vector_type(4)));
typedef LAS const unsigned char* lds_cptr;
constexpr int LDS_K = 0, KSLOT_MAX = 12288, LDS_V = 3 * KSLOT_MAX, VSLOT = 8192, LDS_WS = LDS_V + 3 * VSLOT, LDS_OST = LDS_WS + 8 * 256, LDS_TOTAL = LDS_OST + 8 * 8192;
static_assert(LDS_TOTAL <= RING_BYTES, "attention LDS");
constexpr float THR = 8.0f;
__device__ __forceinline__ void glds16(const void* g, unsigned lds_dst) {
    unsigned keep; asm volatile("s_mov_b32 %0, m0\n\ts_mov_b32 m0, %2\n\ts_nop 0\n\tglobal_load_lds_dwordx4 %1, off\n\ts_mov_b32 m0, %0" : "=&s"(keep) : "v"(g), "s"(lds_dst) : "memory"); }
__device__ __forceinline__ s16x4 vtr(lds_cptr p) { return __builtin_bit_cast(s16x4, __builtin_amdgcn_ds_read_tr16_b64_v4i16((LAS v4i16_t*)p)); }
__device__ __forceinline__ unsigned cvtpk(float lo, float hi) { typedef float f2 __attribute__((ext_vector_type(2))); typedef __bf16 b2 __attribute__((ext_vector_type(2))); f2 v = {lo, hi}; b2 b = __builtin_convertvector(v, b2); return __builtin_bit_cast(unsigned, b); }
#define AT_MX3(a, b, c) __builtin_fmaxf(__builtin_fmaxf((a), (b)), (c))
__device__ __forceinline__ float rowmax(const f32x16& p0, const f32x16& p1) {
    float a = AT_MX3(p0[0], p0[1], p1[0]), b = AT_MX3(p0[2], p0[3], p1[1]); a = AT_MX3(a, p1[2], p1[3]);
#pragma unroll
    for (int r = 4; r < 16; r += 4) { a = AT_MX3(a, p0[r], p0[r + 1]); b = AT_MX3(b, p0[r + 2], p0[r + 3]); a = AT_MX3(a, p1[r], p1[r + 1]); b = AT_MX3(b, p1[r + 2], p1[r + 3]); }
    float m = __builtin_fmaxf(a, b); auto rr = __builtin_amdgcn_permlane32_swap(__float_as_uint(m), __float_as_uint(m), false, false);
    return __builtin_fmaxf(__uint_as_float(rr[0]), __uint_as_float(rr[1])); }
#define AT_WAIT_BAR(N) asm volatile("s_waitcnt vmcnt(" #N ") lgkmcnt(0)\n\ts_barrier" ::: "memory")

struct Src { const bf16_t* p; long pitch; };
template <int NC, int NK0, int NK1>
__device__ __forceinline__ void stream(LAS unsigned char* lds, int tid, const bf16_t* qrow, Src k0, Src k1, Src vs, int NT, f32x16& o0, f32x16& o1, float& lsum) {
    asm volatile("" : "+v"(tid));
    constexpr int SLOTK = 2 * NC * 1024;
    const int lane = tid & 63, r32 = lane & 31, hi = lane >> 5; const int wid = __builtin_amdgcn_readfirstlane(tid >> 6);
    const unsigned lds0 = (unsigned)(uintptr_t)lds;
    LAS float* wsf = (LAS float*)(lds + LDS_WS) + wid * 64;
    constexpr int P0 = NK0 * 16;
    const bool hasA = (NK0 == 8) || (wid < 4), hasB = (NK1 > 0) && (wid < 4);
    const int pA = (NK0 == 8) ? wid : (wid & 3);
    const int rowA = (NK0 == 8) ? pA * 8 + (lane >> 3) : pA * 16 + (lane >> 2);
    const int chA = (NK0 == 8) ? ((lane & 7) ^ ((lane >> 3) & 7)) : ((lane & 3) ^ ((lane >> 4) & 3));
    const bf16_t* ksA = k0.p + (long)rowA * k0.pitch + chA * 8;
    const int rowB = (wid & 3) * 16 + (lane >> 2), chB = (lane & 3) ^ ((lane >> 4) & 3);
    const bf16_t* ksB = (NK1 > 0) ? k1.p + (long)rowB * k1.pitch + chB * 8 : k0.p;
    const bf16_t* vsp = vs.p + (long)(16 * (wid & 3) + (lane >> 2)) * vs.pitch + (wid >> 2) * 32 + (lane & 3) * 8;
    const unsigned kdA = lds0 + LDS_K + pA * 1024, kdB = lds0 + LDS_K + (NK0 + (wid & 3)) * 1024, vd = lds0 + LDS_V + wid * 1024;
    const long ktA = 64 * k0.pitch, ktB = 64 * k1.pitch, vt = 64 * vs.pitch;
    const int nd = (hasA ? 1 : 0) + (hasB ? 1 : 0) + 1;
#define AT_DMA_K(t, slot) do { if (hasA) glds16(ksA + (long)(t) * ktA, (unsigned)__builtin_amdgcn_readfirstlane(kdA + (slot) * SLOTK)); if (hasB) glds16(ksB + (long)(t) * ktB, (unsigned)__builtin_amdgcn_readfirstlane(kdB + (slot) * SLOTK)); } while (0)
#define AT_DMA_V(t, slot) glds16(vsp + (long)(t) * vt, (unsigned)__builtin_amdgcn_readfirstlane(vd + (slot) * VSLOT))
    lds_cptr kb[NC];
#pragma unroll
    for (int d0 = 0; d0 < NC; ++d0) { const int c = 2 * d0 + hi;
        if (2 * d0 < NK0) kb[d0] = (lds_cptr)lds + LDS_K + r32 * P0 + ((NK0 == 8) ? (c ^ (r32 & 7)) : (c ^ ((r32 >> 2) & 3))) * 16;
        else kb[d0] = (lds_cptr)lds + LDS_K + NK0 * 1024 + r32 * 64 + ((c - NK0) ^ ((r32 >> 2) & 3)) * 16; }
    const lds_cptr vp0 = (lds_cptr)lds + LDS_V + ((lane >> 4) & 1) * 32 + (lane & 3) * 8 + (4 * hi + ((lane & 15) >> 2)) * 64;
    AT_DMA_K(0, 0); AT_DMA_V(0, 0); if (NT > 1) AT_DMA_K(1, 1);
    bf16x8 qr[NC];
#pragma unroll
    for (int d0 = 0; d0 < NC; ++d0) qr[d0] = *(const bf16x8*)(qrow + 16 * d0 + 8 * hi);
    float mhat = 0.f, l = 0.f; f32x16 oa = {}, ob = {}, negm = {}, S0, S1; u32x4 pw0, pw1, pw2, pw3;
    asm volatile("" : "+v"(negm));
    AT_WAIT_BAR(0);
    __builtin_amdgcn_s_waitcnt(0);
#pragma unroll
    for (int d0 = 0; d0 < NC; ++d0) asm volatile("" : "+v"(qr[d0]));
    constexpr bool QLDS = (NC > 2);
    const lds_cptr qb = (lds_cptr)lds + LDS_OST + wid * 8192 + lane * 16;
    if (QLDS) {
#pragma unroll
        for (int d0 = 0; d0 < NC; ++d0) *(LAS bf16x8*)(lds + LDS_OST + wid * 8192 + lane * 16 + d0 * 1024) = qr[d0];
        LDS_WAIT();
    }
    int kc = 0, kn1 = 1, kn2 = 2, vpv = 2, vcu = 0, vnx = 1;
    bf16x8 kf[2 * NC], vf[8];
#define AT_SB() __builtin_amdgcn_sched_barrier(0)
#define AT_KRD(so_, d0) do { kf[2 * (d0)] = *(const LAS bf16x8*)(kb[d0] + (so_)); kf[2 * (d0) + 1] = *(const LAS bf16x8*)(kb[d0] + (so_) + 32 * ((2 * (d0) < NK0) ? P0 : 64)); if (QLDS) qr[d0] = *(const LAS bf16x8*)(qb + (d0) * 1024); } while (0)
#define AT_KHEAD(slot) do { const int kp_ = (slot) * SLOTK; AT_KRD(kp_, 0); } while (0)
#define AT_VF(i) ({ const s16x4 lo_ = vtr(vp_ + (((i) >> 2) * 4096 + ((i) & 3) * 1024)), hi_ = vtr(vp_ + (((i) >> 2) * 4096 + ((i) & 3) * 1024 + 512)); (bf16x8){lo_[0], lo_[1], lo_[2], lo_[3], hi_[0], hi_[1], hi_[2], hi_[3]}; })
#define AT_VHEAD(slot) do { const lds_cptr vp_ = vp0 + (slot) * VSLOT; vf[0] = AT_VF(0); vf[4] = AT_VF(4); } while (0)
#define AT_QKM(slot) do { const int kp_ = (slot) * SLOTK; \
        _Pragma("unroll") for (int d0 = 0; d0 < NC; ++d0) { if (d0 + 1 < NC) AT_KRD(kp_, d0 + 1); \
            if (d0 == 0) { S0 = MFMA32(kf[0], qr[0], negm); S1 = MFMA32(kf[1], qr[0], negm); } else { S0 = MFMA32(kf[2 * d0], qr[d0], S0); S1 = MFMA32(kf[2 * d0 + 1], qr[d0], S1); } AT_SB(); } } while (0)
#define AT_PVM(slot) do { const lds_cptr vp_ = vp0 + (slot) * VSLOT; \
        vf[1] = AT_VF(1); vf[5] = AT_VF(5); oa = MFMA32(__builtin_bit_cast(bf16x8, pw0), vf[0], oa); ob = MFMA32(__builtin_bit_cast(bf16x8, pw0), vf[4], ob); AT_SB(); \
        vf[2] = AT_VF(2); vf[6] = AT_VF(6); oa = MFMA32(__builtin_bit_cast(bf16x8, pw1), vf[1], oa); ob = MFMA32(__builtin_bit_cast(bf16x8, pw1), vf[5], ob); AT_SB(); \
        vf[3] = AT_VF(3); vf[7] = AT_VF(7); oa = MFMA32(__builtin_bit_cast(bf16x8, pw2), vf[2], oa); ob = MFMA32(__builtin_bit_cast(bf16x8, pw2), vf[6], ob); AT_SB(); \
        oa = MFMA32(__builtin_bit_cast(bf16x8, pw3), vf[3], oa); ob = MFMA32(__builtin_bit_cast(bf16x8, pw3), vf[7], ob); AT_SB(); } while (0)
    bool resc = false; u32x4 qw0, qw1, qw2, qw3; float sacc = 0.f;
#define AT_PIN(x) asm volatile("" : "+v"(x))
#define AT_DECIDE(first) do { const float rm_ = rowmax(S0, S1); resc = false; \
        if ((first) || __any(rm_ > THR)) { const float dl_ = (first) ? rm_ : __builtin_fmaxf(rm_, 0.f); mhat += dl_; \
            _Pragma("unroll") for (int r = 0; r < 16; ++r) { S0[r] -= dl_; S1[r] -= dl_; negm[r] = -mhat; } asm volatile("" : "+v"(negm)); \
            if (!(first)) { const float f_ = fast_exp2(-dl_); l *= f_; if (hi == 0) wsf[r32] = f_; resc = true; } } } while (0)
#define AT_RESC() do { if (resc) { LDS_WAIT(); \
        _Pragma("unroll") for (int r = 0; r < 16; ++r) { const float g_ = wsf[crow(r, hi)]; oa[r] *= g_; ob[r] *= g_; } LDS_WAIT(); } } while (0)
#define AT_EXP8(S, b, Q) do { \
        _Pragma("unroll") for (int r = 0; r < 8; ++r) S[(b) + r] = fast_exp2(S[(b) + r]); \
        sacc += (S[(b)] + S[(b) + 1]) + (S[(b) + 2] + S[(b) + 3]); sacc += (S[(b) + 4] + S[(b) + 5]) + (S[(b) + 6] + S[(b) + 7]); \
        Q = (u32x4){cvtpk(S[(b)], S[(b) + 1]), cvtpk(S[(b) + 2], S[(b) + 3]), cvtpk(S[(b) + 4], S[(b) + 5]), cvtpk(S[(b) + 6], S[(b) + 7])}; AT_PIN(Q); AT_PIN(sacc); } while (0)
#define AT_EXPALL() do { sacc = 0.f; AT_EXP8(S0, 0, qw0); AT_EXP8(S0, 8, qw1); AT_EXP8(S1, 0, qw2); AT_EXP8(S1, 8, qw3); l += sacc; pw0 = qw0; pw1 = qw1; pw2 = qw2; pw3 = qw3; } while (0)
#define AT_PV_EXP(slot) do { const lds_cptr vp_ = vp0 + (slot) * VSLOT; sacc = 0.f; \
        vf[1] = AT_VF(1); vf[5] = AT_VF(5); oa = MFMA32(__builtin_bit_cast(bf16x8, pw0), vf[0], oa); ob = MFMA32(__builtin_bit_cast(bf16x8, pw0), vf[4], ob); AT_EXP8(S0, 0, qw0); AT_SB(); \
        vf[2] = AT_VF(2); vf[6] = AT_VF(6); oa = MFMA32(__builtin_bit_cast(bf16x8, pw1), vf[1], oa); ob = MFMA32(__builtin_bit_cast(bf16x8, pw1), vf[5], ob); AT_EXP8(S0, 8, qw1); AT_SB(); \
        vf[3] = AT_VF(3); vf[7] = AT_VF(7); oa = MFMA32(__builtin_bit_cast(bf16x8, pw2), vf[2], oa); ob = MFMA32(__builtin_bit_cast(bf16x8, pw2), vf[6], ob); AT_EXP8(S1, 0, qw2); AT_SB(); \
        oa = MFMA32(__builtin_bit_cast(bf16x8, pw3), vf[3], oa); ob = MFMA32(__builtin_bit_cast(bf16x8, pw3), vf[7], ob); AT_EXP8(S1, 8, qw3); AT_SB(); \
        l += sacc; } while (0)
#define AT_STEP_WAIT(t) do { if ((t) + 2 < NT) { if (nd == 3) AT_WAIT_BAR(3); else if (nd == 2) AT_WAIT_BAR(2); else AT_WAIT_BAR(1); } else AT_WAIT_BAR(0); } while (0)
#define AT_ROT() do { const int a_ = kc; kc = kn1; kn1 = kn2; kn2 = a_; const int b_ = vpv; vpv = vcu; vcu = vnx; vnx = b_; } while (0)
    AT_DMA_K(2, kn2); AT_DMA_V(1, vnx);
    AT_KHEAD(kc); AT_SB();
    AT_QKM(kc); AT_DECIDE(true); AT_EXPALL();
    AT_STEP_WAIT(0); AT_ROT();
    for (int t = 1; t < NT; ++t) {
        if (t + 2 < NT) AT_DMA_K(t + 2, kn2);
        if (t + 1 < NT) AT_DMA_V(t + 1, vnx);
        AT_KHEAD(kc); AT_VHEAD(vpv); AT_SB();
        AT_QKM(kc);
        AT_DECIDE(false); AT_SB();
        AT_PV_EXP(vpv);
        AT_RESC();
        pw0 = qw0; pw1 = qw1; pw2 = qw2; pw3 = qw3;
        AT_STEP_WAIT(t); AT_ROT();
    }
    AT_VHEAD(vpv); AT_SB(); AT_PVM(vpv);
    { auto rr = __builtin_amdgcn_permlane32_swap(__float_as_uint(l), __float_as_uint(l), false, false); l = __uint_as_float(rr[0]) + __uint_as_float(rr[1]); }
    o0 = oa; o1 = ob; lsum = l;
#undef AT_DMA_K
#undef AT_DMA_V
#undef AT_SB
#undef AT_KRD
#undef AT_KHEAD
#undef AT_VF
#undef AT_VHEAD
#undef AT_QKM
#undef AT_PVM
#undef AT_PIN
#undef AT_DECIDE
#undef AT_RESC
#undef AT_EXP8
#undef AT_EXPALL
#undef AT_PV_EXP
#undef AT_STEP_WAIT
#undef AT_ROT
}
__device__ __forceinline__ void normalise(LAS unsigned char* lds, int tid, f32x16& o0, f32x16& o1, float lsum) {
    const int lane = tid & 63, r32 = lane & 31, hi = lane >> 5; const int wid = __builtin_amdgcn_readfirstlane(tid >> 6);
    LAS float* wsf = (LAS float*)(lds + LDS_WS) + wid * 64;
    if (hi == 0) wsf[32 + r32] = 1.0f / lsum; LDS_WAIT();
#pragma unroll
    for (int r = 0; r < 16; ++r) { const float g = wsf[32 + crow(r, hi)]; o0[r] *= g; o1[r] *= g; }
    LDS_WAIT();
}
}

struct AttnUnitId { int kind, seq, head, qb; };
__device__ __forceinline__ bool attn_unit_at(int i, int G, int bid, AttnUnitId& u) {
    const long L = (long)i * G + bid; if (L >= 2560) return false; int o = (int)L;
    int kind, longs, nh;
    if (o < 512) { kind = 0; longs = 1; nh = 4; } else if (o < 1024) { kind = 0; longs = 0; nh = 4; o -= 512; } else if (o < 1792) { kind = 1; longs = 1; nh = 6; o -= 1024; } else { kind = 1; longs = 0; nh = 6; o -= 1792; }
    const int nqb = longs ? 16 : 8;
    int pair, qb;
    if (G == 256) { const int rnd = o >> 8, b = o & 255, x = b & 7, c = b >> 3;
        const int ppr = 32 / nqb; pair = x + 8 * (rnd * ppr + c / nqb); qb = c % nqb; }
    else { pair = o / nqb; qb = o % nqb; }
    u.kind = kind; u.head = pair % nh; const int sq = pair / nh; u.seq = longs ? 16 + sq : sq; u.qb = qb; return true;
}
__device__ __forceinline__ void attn_ab_phase(Frame& F, const Args& a, int layer, int kmask = 3) {
    const bf16_t* H = (const bf16_t*)(F.ws + WS_H); const bf16_t* QB = (const bf16_t*)(F.ws + WS_QB); const bf16_t* KVB = (const bf16_t*)(F.ws + WS_KVB);
    bf16_t* MIX = (bf16_t*)(F.ws + WS_MIX);
    const int wid = F.wave;
    float lam, lam_init;
    { const float* lv = a.diff_lambda + layer * 128; float d1 = 0.f, d2 = 0.f;
      for (int i = 0; i < 32; ++i) { d1 += lv[i] * lv[32 + i]; d2 += lv[64 + i] * lv[96 + i]; }
      lam_init = 0.8f - 0.6f * expf(-0.3f * (float)layer); lam = expf(d1) - expf(d2) + lam_init;
      lam = __uint_as_float(__builtin_amdgcn_readfirstlane(__float_as_uint(lam))); lam_init = __uint_as_float(__builtin_amdgcn_readfirstlane(__float_as_uint(lam_init))); }
    AttnUnitId u;
    for (int i = 0; attn_unit_at(i, F.G, F.bid, u); ++i) {
        if (!((kmask >> u.kind) & 1)) continue;
        int tid = F.tid; asm volatile("" : "+v"(tid)); const int lane = tid & 63, r32 = lane & 31, hi = lane >> 5;
        const int len = (u.seq < 16) ? 2048 : 4096, base = (u.seq < 16) ? u.seq * 2048 : NTOK_P + (u.seq - 16) * 4096, NT = len / 64;
        const int m0 = base + u.qb * 256 + wid * 32;
        LAS bf16_t* sb = (LAS bf16_t*)(F.lds + at::LDS_OST + wid * 8192);
        LAS float* sf = (LAS float*)sb;
        if (u.kind == 0) {
            f32x16 q0, q1; float ls;
            { f32x16 p0, p1; const at::Src ks{H + (size_t)base * HP + HC_AK + u.head * 64, HP}, vs{H + (size_t)base * HP + HC_AV + u.head * 64, HP};
              at::stream<2, 4, 0>(F.lds, tid, H + (size_t)(m0 + r32) * HP + HC_AQ + u.head * 64, ks, ks, vs, NT, p0, p1, ls); at::normalise(F.lds, tid, p0, p1, ls);
#pragma unroll
              for (int r = 0; r < 16; ++r) { const int row = crow(r, hi); sf[row * 64 + r32] = p0[r]; sf[row * 64 + 32 + r32] = p1[r]; }
              AT_WAIT_BAR(0); }
            { const at::Src ks{H + (size_t)base * HP + HC_AK + u.head * 64 + 32, HP}, vs{H + (size_t)base * HP + HC_AV + u.head * 64, HP};
              at::stream<2, 4, 0>(F.lds, tid, H + (size_t)(m0 + r32) * HP + HC_AQ + u.head * 64 + 32, ks, ks, vs, NT, q0, q1, ls); at::normalise(F.lds, tid, q0, q1, ls); }
            float xa[16], xb[16];
#pragma unroll
            for (int r = 0; r < 16; ++r) { const int row = crow(r, hi); xa[r] = sf[row * 64 + r32] - lam * q0[r]; xb[r] = sf[row * 64 + 32 + r32] - lam * q1[r]; }
            LDS_WAIT();
            const float* sg = a.diff_subln + layer * 64; const float g0 = sg[r32] * (1.0f - lam_init), g1 = sg[32 + r32] * (1.0f - lam_init);
#pragma unroll
            for (int r = 0; r < 16; ++r) { const float x0 = xa[r], x1 = xb[r]; float ss = x0 * x0 + x1 * x1;
                ss += shx<1>(ss); ss += shx<2>(ss); ss += shx<4>(ss); ss += shx<8>(ss); ss += shx<16>(ss);
                const float rs = 1.0f / sqrtf(ss * (1.0f / 64.0f) + RMS_EPS); const int row = crow(r, hi);
                sb[row * 64 + r32] = (bf16_t)f2bf(x0 * rs * g0); sb[row * 64 + 32 + r32] = (bf16_t)f2bf(x1 * rs * g1); }
            LDS_WAIT();
#pragma unroll
            for (int it = 0; it < 4; ++it) { const int row = it * 8 + (lane >> 3), ch = lane & 7; *(u32x4*)(MIX + (size_t)(m0 + row) * DM + MIX_A + u.head * 64 + ch * 8) = *(const LAS u32x4*)(sb + row * 64 + ch * 8); }
        } else {
            f32x16 p0, p1; float ls;
            const at::Src k0{KVB + (size_t)base * KVP + u.head * 128, KVP}, k1{H + (size_t)base * HP + HC_KROPE, HP}, vs{KVB + (size_t)base * KVP + u.head * 128 + 64, KVP};
            at::stream<6, 8, 4>(F.lds, tid, QB + (size_t)(m0 + r32) * QBP + u.head * 96, k0, k1, vs, NT, p0, p1, ls); at::normalise(F.lds, tid, p0, p1, ls);
#pragma unroll
            for (int r = 0; r < 16; ++r) { const int row = crow(r, hi); sb[row * 64 + r32] = (bf16_t)f2bf(p0[r]); sb[row * 64 + 32 + r32] = (bf16_t)f2bf(p1[r]); }
            LDS_WAIT();
#pragma unroll
            for (int it = 0; it < 4; ++it) { const int row = it * 8 + (lane >> 3), ch = lane & 7; *(u32x4*)(MIX + (size_t)(m0 + row) * DM + MIX_B + u.head * 64 + ch * 8) = *(const LAS u32x4*)(sb + row * 64 + ch * 8); }
        }
        AT_WAIT_BAR(0);
    }
}

struct ListRows { const int* list; int seg0, cnt; __device__ __forceinline__ int src(int m) const { const int r = m - seg0; return (r < cnt) ? (list[r] >> 1) : 0; } };
__device__ __forceinline__ void moe_segments(Frame& F, int layer, LAS int* seg) {
    if (F.tid == 0) { int acc = 0; for (int e = 0; e < NEXP; ++e) { const int c = (int)__hip_atomic_load(F.ctl + CW_CNT + layer * 64 + e, RLX_AGENT); seg[e] = acc; seg[33 + e] = c; acc += (c + 255) & ~255; } seg[32] = acc; }
    __syncthreads();
}
__device__ __forceinline__ int seg_find(const LAS int* seg, int row) { int e = 0;
#pragma unroll
    for (int s = 16; s > 0; s >>= 1) if (seg[e + s] <= row) e += s;
    return e; }
__device__ __forceinline__ void moe_up_simple(Frame& F, int layer) {
    LAS int* seg = (LAS int*)(F.lds + RING_BYTES); moe_segments(F, layer, seg);
    const bf16_t* XB = (const bf16_t*)(F.ws + WS_XB); const bf16_t* W13 = (const bf16_t*)(F.ws + WS_W13); const int* list = (const int*)(F.ws + WS_LIST);
    const EpiHid E{(bf16_t*)(F.ws + WS_HID)};
    const int items = (seg[32] / 32) * 16;
    for (int it = F.gw; it < items; it += F.NGW) { const int mt = it >> 4, ct = it & 15, m0 = mt * 32, e = seg_find(seg, m0), c0 = ct * 32;
        const ListRows RM{list + (size_t)e * LIST_CAP, seg[e], seg[33 + e]};
        const bf16_t* Bg = W13 + (size_t)e * 1024 * 1024 + (size_t)((c0 >> 7) * 256 + (c0 & 127)) * 1024;
        sg_tile(XB, DM, Bg, Bg + (size_t)128 * 1024, 1024, 1024, m0, c0, E, RM, F.lane); }
    __syncthreads();
}
__device__ __forceinline__ void moe_down_simple(Frame& F, int layer) {
    LAS int* seg = (LAS int*)(F.lds + RING_BYTES); moe_segments(F, layer, seg);
    const bf16_t* HID = (const bf16_t*)(F.ws + WS_HID); const bf16_t* W2 = (const bf16_t*)(F.ws + WS_W2); const int* list = (const int*)(F.ws + WS_LIST);
    const int items = (seg[32] / 32) * 16;
    for (int it = F.gw; it < items; it += F.NGW) { const int mt = it >> 4, ct = it & 15, m0 = mt * 32, e = seg_find(seg, m0), c0 = ct * 64;
        const EpiY E{(bf16_t*)(F.ws + WS_YB), (const float*)(F.ws + WS_TW), list + (size_t)e * LIST_CAP, seg[e], seg[33 + e]};
        const bf16_t* B0 = W2 + (size_t)e * 1024 * 512 + (size_t)c0 * 512;
        sg_tile(HID, DEXP, B0, B0 + (size_t)32 * 512, 512, 512, m0, c0, E, IdRows(), F.lane); }
    __syncthreads();
}


struct MoeUpSched {
    const char* XB; const char* W13; const LAS int* seg; const int* list; int nM, G, c;
    __device__ __forceinline__ bool next(int i, pg8::Unit& u) const { if (!pg8::order_next(i, G, c, nM, 4, u.pm, u.pn)) return false; u.e = __builtin_amdgcn_readfirstlane(seg_find(seg, u.pm * 256)); u.a = XB; u.b = W13 + ((size_t)u.e * 1024 + (size_t)u.pn * 256) * 2048; return true; }
    __device__ __forceinline__ unsigned arow(const pg8::Unit& u, int r) const { const int rr = u.pm * 256 + r - __builtin_amdgcn_readfirstlane(seg[u.e]); return (rr < __builtin_amdgcn_readfirstlane(seg[33 + u.e])) ? (unsigned)(list[(size_t)u.e * LIST_CAP + rr] >> 1) : 0u; }
};
struct MoeDownSched {
    const char* HID; const char* W2; const LAS int* seg; int nM, G, c;
    __device__ __forceinline__ bool next(int i, pg8::Unit& u) const { if (!pg8::order_next(i, G, c, nM, 4, u.pm, u.pn)) return false; u.e = __builtin_amdgcn_readfirstlane(seg_find(seg, u.pm * 256)); u.a = HID + (size_t)u.pm * 256 * DEXP * 2; u.b = W2 + ((size_t)u.e * 1024 + (size_t)u.pn * 256) * 1024; return true; }
    __device__ __forceinline__ unsigned arow(const pg8::Unit&, int) const { return 0u; }
};
__device__ __forceinline__ void moe_up_opt(Frame& F, int layer) {
    LAS int* seg = (LAS int*)(F.lds + RING_BYTES); moe_segments(F, layer, seg);
    const MoeUpSched S{(const char*)(F.ws + WS_XB), (const char*)(F.ws + WS_W13), seg, (const int*)(F.ws + WS_LIST), __builtin_amdgcn_readfirstlane(seg[32]) / 256, F.G, F.bid};
    const EpiHid E{(bf16_t*)(F.ws + WS_HID)};
    pg8::gemm_phase<EpiHid, MoeUpSched, true, true>(F.lds, F.tid, 1024, DM, S, E);
    __syncthreads();
}
__device__ __forceinline__ void moe_down_opt(Frame& F, int layer) {
    LAS int* seg = (LAS int*)(F.lds + RING_BYTES); moe_segments(F, layer, seg);
    const MoeDownSched S{(const char*)(F.ws + WS_HID), (const char*)(F.ws + WS_W2), seg, __builtin_amdgcn_readfirstlane(seg[32]) / 256, F.G, F.bid};
    const EpiYO E{(bf16_t*)(F.ws + WS_YB), (const float*)(F.ws + WS_TW), (const int*)(F.ws + WS_LIST), seg};
    pg8::gemm_phase<EpiYO, MoeDownSched, false, false>(F.lds, F.tid, DEXP, DEXP, S, E);
    __syncthreads();
}
template <class Epi>
__device__ __forceinline__ void og_phase(Frame& F, const bf16_t* A, int lda, const bf16_t* Bt, int M, int N, int K, const Epi& E) {
    pg8::DenseSched S; S.init(A, lda, Bt, M, N, K, F.G, F.bid);
    pg8::gemm_phase<Epi, pg8::DenseSched, false, false>(F.lds, F.tid, K, lda, S, E);
}

constexpr int PH_PER_LAYER = 9, N_PHASES = 1 + DEPTH * PH_PER_LAYER;
__global__ void __launch_bounds__(NTHREADS, 2) fwd(Args args) {
    extern __shared__ __attribute__((aligned(16))) unsigned char lds[];
    Frame F;
    F.lds = (LAS unsigned char*)lds; F.ldsg = lds;
    F.tid = threadIdx.x; F.lane = F.tid & 63; F.wave = __builtin_amdgcn_readfirstlane(F.tid >> 6);
    F.G = gridDim.x; F.bid = blockIdx.x; F.gw = blockIdx.x * NWAVES + F.wave; F.NGW = F.G * NWAVES;
    F.ws = args.ws; F.ctl = (gu32*)(args.ws + WS_CTL);
    volatile LAS unsigned* MISC = (volatile LAS unsigned*)(F.lds + MISC_OFF);
    for (int u = F.tid; u < (LDS_BYTES - RING_BYTES) / 4; u += NTHREADS) ((LAS unsigned*)(F.lds + RING_BYTES))[u] = 0u;
    __syncthreads();
    XcdBarrier bar; bar.bar = (unsigned*)(F.ctl + CW_BAR); bar.x = 0; bar.st = nullptr;
    if (args.use_bar) bar = xcd_barrier_post((unsigned*)(F.ctl + CW_BAR), MISC + 8);
    const int lo = args.ph_lo, hi = args.ph_hi;
#ifndef PH_MASK
#define PH_MASK 0x3ff
#endif
#define IN(k) (lo <= (k) && (k) < hi && (launder(F), true))
#define SEAM(k) do { if (lo <= (k) && (k) + 1 < hi) xcd_barrier(bar); } while (0)
    if ((PH_MASK & 1) && IN(0)) { p0_prologue(F, args);
#ifdef PROBE_DUP_P0
        launder(F); p0_prologue(F, args);
#endif
    }
    SEAM(0);
    for (int layer = 0; layer < DEPTH; ++layer) {
        const int pb = 1 + layer * PH_PER_LAYER;
        if ((PH_MASK & (2 << 0)) && IN(pb + 0)) {   bf16_t* H = (bf16_t*)(F.ws + WS_H);
            const EpiH E{H, (const float2*)(F.ws + WS_ROPE32), (const float2*)(F.ws + WS_ROPE64)};
#if OPT_GEMM
            og_phase(F, (const bf16_t*)(F.ws + WS_XB), DM, (const bf16_t*)(F.ws + WS_WIN) + (size_t)layer * 2560 * 1024, NTOK, 2560, 1024, E);
#ifdef PROBE_DUP_GEMM
            launder(F); og_phase(F, (const bf16_t*)(F.ws + WS_XB), DM, (const bf16_t*)(F.ws + WS_WIN) + (size_t)layer * 2560 * 1024, NTOK, 2560, 1024, E);
#endif
#else
            sg_phase(F, (const bf16_t*)(F.ws + WS_XB), DM, (const bf16_t*)(F.ws + WS_WIN) + (size_t)layer * 2560 * 1024, 1024, NTOK, 2560, 1024, E);
#endif
        }
        SEAM(pb + 0);
        if ((PH_MASK & (2 << 1)) && IN(pb + 1)) { rowstat_pass(F); cstat_phase(F);
#ifdef PROBE_DUP_CSTAT
            launder(F); rowstat_pass(F); cstat_phase(F);
#endif
        }
        SEAM(pb + 1);
        if ((PH_MASK & (2 << 2)) && IN(pb + 2)) {
            bf16_t* H = (bf16_t*)(F.ws + WS_H);
            const EpiUQ Eq{(bf16_t*)(F.ws + WS_QB), (const float*)(F.ws + WS_RSTD), (const float2*)(F.ws + WS_ROPE32)};
#if OPT_GEMM
            og_phase(F, H + HC_CQ_LAT, HP, (const bf16_t*)(F.ws + WS_WUQ) + (size_t)layer * 768 * 256, NTOK, 768, 256, Eq);
            launder(F);
#else
            sg_phase(F, H + HC_CQ_LAT, HP, (const bf16_t*)(F.ws + WS_WUQ) + (size_t)layer * 768 * 256, 256, NTOK, 768, 256, Eq);
#endif
            const EpiUKV Ek{(bf16_t*)(F.ws + WS_KVB), (const float*)(F.ws + WS_RSTD)};
#if OPT_GEMM
            og_phase(F, H + HC_CKV, HP, (const bf16_t*)(F.ws + WS_WUKV) + (size_t)layer * 768 * 256, NTOK, 768, 256, Ek);
#ifdef PROBE_DUP_UP
            launder(F); og_phase(F, H + HC_CQ_LAT, HP, (const bf16_t*)(F.ws + WS_WUQ) + (size_t)layer * 768 * 256, NTOK, 768, 256, Eq);
            launder(F); og_phase(F, H + HC_CKV, HP, (const bf16_t*)(F.ws + WS_WUKV) + (size_t)layer * 768 * 256, NTOK, 768, 256, Ek);
#endif
#else
            sg_phase(F, H + HC_CKV, HP, (const bf16_t*)(F.ws + WS_WUKV) + (size_t)layer * 768 * 256, 256, NTOK, 768, 256, Ek);
#endif
        }
        SEAM(pb + 2);
        if ((PH_MASK & (2 << 3)) && IN(pb + 3)) {
#if OPT_ATTN
            attn_ab_phase(F, args, layer); launder(F);
#ifdef PROBE_DUP_ATTN
            attn_ab_phase(F, args, layer, PROBE_DUP_ATTN); launder(F);
#endif
            sattn_phase(F, args, layer, 10);
#ifdef PROBE_DUP_CFIN
            launder(F); sattn_phase(F, args, layer, 10);
#endif
#else
            sattn_phase(F, args, layer, 0);
#endif
        }
        SEAM(pb + 3);
        if ((PH_MASK & (2 << 4)) && IN(pb + 4)) {
#ifdef PROBE_DUP_WOUT
            { const EpiRes E0{args.out, layer == 0 ? args.x_prompt : nullptr, args.x_sample, (float*)(F.ws + WS_H)};
              og_phase(F, (const bf16_t*)(F.ws + WS_MIX), DM, (const bf16_t*)(F.ws + WS_WOUT) + (size_t)layer * 1024 * 1024, NTOK, 1024, 1024, E0); launder(F); }
#endif
            const EpiRes E{args.out, layer == 0 ? args.x_prompt : nullptr, args.x_sample, args.out};
#if OPT_GEMM
            og_phase(F, (const bf16_t*)(F.ws + WS_MIX), DM, (const bf16_t*)(F.ws + WS_WOUT) + (size_t)layer * 1024 * 1024, NTOK, 1024, 1024, E);
#else
            sg_phase(F, (const bf16_t*)(F.ws + WS_MIX), DM, (const bf16_t*)(F.ws + WS_WOUT) + (size_t)layer * 1024 * 1024, 1024, NTOK, 1024, 1024, E);
#endif
        }
        SEAM(pb + 4);
        if ((PH_MASK & (2 << 5)) && IN(pb + 5)) {
#ifdef PROBE_DUP_LN1
            ln1_route_pass(F, args, layer, (float*)(F.ws + WS_H)); launder(F);
#endif
            ln1_route_pass(F, args, layer); moe_convert(F, args, layer);
#ifdef PROBE_DUP_CONV
            launder(F); moe_convert(F, args, layer);
#endif
        }
        SEAM(pb + 5);
#if OPT_GEMM
        if ((PH_MASK & (2 << 6)) && IN(pb + 6)) { moe_up_opt(F, layer);
#ifdef PROBE_DUP_MOE
            launder(F); moe_up_opt(F, layer);
#endif
        }
#else
        if ((PH_MASK & (2 << 6)) && IN(pb + 6)) { moe_up_simple(F, layer); }
#endif
        SEAM(pb + 6);
#if OPT_GEMM
        if ((PH_MASK & (2 << 7)) && IN(pb + 7)) { moe_down_opt(F, layer);
#ifdef PROBE_DUP_MOE
            launder(F); moe_down_opt(F, layer);
#endif
        }
#else
        if ((PH_MASK & (2 << 7)) && IN(pb + 7)) { moe_down_simple(F, layer); }
#endif
        SEAM(pb + 7);
        if ((PH_MASK & (2 << 8)) && IN(pb + 8)) { ln2_pass(F, args, layer); }
        SEAM(pb + 8);
    }
#undef IN
#undef SEAM
}

extern "C" void kernel_launch(void* const* d_in, const int* in_sizes, int n_in, void* d_out, int out_size, void* d_ws, size_t ws_size, hipStream_t stream) {
    static int grid = 0;
    if (grid == 0) {
        if (n_in != 19 || out_size != NTOK * DM || ws_size < WS_END) { fprintf(stderr, "kernel_launch: unexpected shapes (n_in %d out %d ws %zu)\n", n_in, out_size, ws_size); grid = -1; return; }
        int dev = 0, cus = 0, per_cu = 0;
        if (hipGetDevice(&dev) != hipSuccess || hipDeviceGetAttribute(&cus, hipDeviceAttributeMultiprocessorCount, dev) != hipSuccess) { grid = -1; return; }
        if (hipFuncSetAttribute((const void*)fwd, hipFuncAttributeMaxDynamicSharedMemorySize, LDS_BYTES) != hipSuccess) { grid = -1; return; }
        if (hipOccupancyMaxActiveBlocksPerMultiprocessor(&per_cu, (const void*)fwd, NTHREADS, LDS_BYTES) != hipSuccess || per_cu < 1) { fprintf(stderr, "kernel_launch: occupancy query says %d\n", per_cu); }
        (void)hipGetLastError();
        grid = cus;
    }
    if (grid < 0) return;
    if (hipMemsetAsync((char*)d_ws + WS_CTL, 0, CTL_ZERO_BYTES, stream) != hipSuccess) return;
    Args a{};
    a.x_prompt = (const float*)d_in[0]; a.x_sample = (const float*)d_in[1]; a.w_in = (const float*)d_in[2]; a.diff_lambda = (const float*)d_in[3]; a.diff_subln = (const float*)d_in[4];
    a.mla_q_norm = (const float*)d_in[5]; a.mla_w_uq = (const float*)d_in[6]; a.mla_kv_norm = (const float*)d_in[7]; a.mla_w_ukv = (const float*)d_in[8]; a.w_out = (const float*)d_in[9];
    a.ln1_g = (const float*)d_in[10]; a.ln1_b = (const float*)d_in[11]; a.moe_w_coarse = (const float*)d_in[12]; a.moe_w_fine = (const float*)d_in[13];
    a.moe_w1 = (const float*)d_in[14]; a.moe_w3 = (const float*)d_in[15]; a.moe_w2 = (const float*)d_in[16]; a.ln2_g = (const float*)d_in[17]; a.ln2_b = (const float*)d_in[18];
    a.out = (float*)d_out; a.ws = (unsigned char*)d_ws; a.pad = 0;
#if MK_ONE_LAUNCH
    a.ph_lo = 0; a.ph_hi = N_PHASES; a.use_bar = 1;
    hipLaunchKernelGGL(fwd, dim3(grid), dim3(NTHREADS), LDS_BYTES, stream, a);
#else
    for (int p = 0; p < N_PHASES; ++p) { a.ph_lo = p; a.ph_hi = p + 1; a.use_bar = 0; hipLaunchKernelGGL(fwd, dim3(grid), dim3(NTHREADS), LDS_BYTES, stream, a); }
#endif
}
```

```cpp
#include <hip/hip_runtime.h>
#include <cstdio>
#include <cstdint>

#ifndef OPT_ATTN
#define OPT_ATTN 1
#endif
#ifndef OPT_GEMM
#define OPT_GEMM 1
#endif
#ifndef MK_ONE_LAUNCH
#define MK_ONE_LAUNCH 1
#endif

#define GAS __attribute__((address_space(1)))
#define LAS __attribute__((address_space(3)))
typedef unsigned short bf16_t;
typedef short bf16x8 __attribute__((ext_vector_type(8)));
typedef float f32x4 __attribute__((ext_vector_type(4)));
typedef float f32x2 __attribute__((ext_vector_type(2)));
typedef float f32x16 __attribute__((ext_vector_type(16)));
typedef unsigned u32x4 __attribute__((ext_vector_type(4)));
typedef unsigned u32x2 __attribute__((ext_vector_type(2)));
typedef GAS unsigned gu32;
#define RLX_AGENT __ATOMIC_RELAXED, __HIP_MEMORY_SCOPE_AGENT
#define LDS_WAIT() asm volatile("s_waitcnt lgkmcnt(0)" ::: "memory")
#define VM_WAIT() asm volatile("s_waitcnt vmcnt(0)" ::: "memory")
#define MFMA32(a, b, c) __builtin_amdgcn_mfma_f32_32x32x16_bf16(a, b, c, 0, 0, 0)

__device__ __forceinline__ unsigned f2bf(float f) { unsigned u = __builtin_bit_cast(unsigned, f); return (u + 0x7fffu + ((u >> 16) & 1u)) >> 16; }
__device__ __forceinline__ unsigned pk2(float lo, float hi) { return f2bf(lo) | (f2bf(hi) << 16); }
__device__ __forceinline__ float bf2f(unsigned short b) { return __builtin_bit_cast(float, (unsigned)b << 16); }
__device__ __forceinline__ int crow(int r, int hi) { return (r & 3) + 8 * (r >> 2) + 4 * hi; }
template <int K> __device__ __forceinline__ float shx(float v) { static_assert(K < 32, "xor 32: use xsum32 / xmax32 / xpair32"); return __uint_as_float((unsigned)__builtin_amdgcn_ds_swizzle((int)__float_as_uint(v), (K << 10) | 0x1f)); }
__device__ __forceinline__ float xsum32(float v) { auto rr = __builtin_amdgcn_permlane32_swap(__float_as_uint(v), __float_as_uint(v), false, false); return __uint_as_float(rr[0]) + __uint_as_float(rr[1]); }
__device__ __forceinline__ float xmax32(float v) { auto rr = __builtin_amdgcn_permlane32_swap(__float_as_uint(v), __float_as_uint(v), false, false); return fmaxf(__uint_as_float(rr[0]), __uint_as_float(rr[1])); }
__device__ __forceinline__ float xpair32(float lo, float hi) { auto rr = __builtin_amdgcn_permlane32_swap(__float_as_uint(lo), __float_as_uint(hi), false, false); return __uint_as_float(rr[0]) + __uint_as_float(rr[1]); }
__device__ __forceinline__ float wave_sum(float v) {
    v += shx<1>(v); v += shx<2>(v); v += shx<4>(v); v += shx<8>(v); v += shx<16>(v);
    return xsum32(v);
}
__device__ __forceinline__ float fast_exp2(float x) { return __builtin_amdgcn_exp2f(x); }

constexpr int NTOK = 65536, DM = 1024, DEPTH = 4;
constexpr int NTOK_P = 32768;
constexpr int HP = 2560;
constexpr int HC_AQ = 0, HC_AK = 256, HC_AV = 512, HC_CQ_LAT = 768, HC_CKV = 1024, HC_KROPE = 1152, HC_CQ = 1280, HC_CK = 1664, HC_CV = 2048;
constexpr int QBP = 768, KVP = 768;
constexpr int MIX_A = 0, MIX_B = 256, MIX_C = 640;
constexpr int NEXP = 32, DEXP = 512;
constexpr float LOG2E = 1.4426950408889634f;
constexpr float SC_A = 0.17677669529663687f * LOG2E;
constexpr float SC_B = 0.10206207261596575f * LOG2E;
constexpr float SC_C = 0.125f * LOG2E;
constexpr float DN_ALPHA = 1.681792830507429f;
constexpr float LN_EPS = 1e-5f, RMS_EPS = 1e-6f;

constexpr size_t MiB = 1u << 20;
constexpr size_t WS_CTL = 0, CTL_ZERO_BYTES = 1 * MiB;
constexpr size_t WS_ROPE32 = 4 * MiB;
constexpr size_t WS_ROPE64 = 5 * MiB;
constexpr size_t WS_WIN = 8 * MiB;
constexpr size_t WS_WOUT = 28 * MiB;
constexpr size_t WS_WUQ = 36 * MiB;
constexpr size_t WS_WUKV = 38 * MiB;
constexpr size_t WS_W13 = 40 * MiB;
constexpr size_t WS_W2 = 104 * MiB;
constexpr size_t WS_XB = 136 * MiB;
constexpr size_t WS_H = 264 * MiB;
constexpr size_t WS_QB = 584 * MiB;
constexpr size_t WS_KVB = 680 * MiB;
constexpr size_t WS_MIX = 776 * MiB;
constexpr size_t WS_RSTD = 904 * MiB;
constexpr size_t WS_LSEC = 905 * MiB;
constexpr size_t WS_TW = 907 * MiB;
constexpr size_t WS_LIST = 908 * MiB;
constexpr size_t WS_END = 924 * MiB;
constexpr size_t WS_HID = WS_H;
constexpr size_t WS_YB = WS_H + 136 * MiB;
static_assert(WS_YB + 256 * MiB <= WS_KVB + 96 * MiB, "YB overlay");
constexpr int LIST_CAP = 131072;
constexpr int CW_TMO = 0;
constexpr int CW_CNT = 64;
constexpr int CW_BAR = 4096;

constexpr int RING_BYTES = 131072;
constexpr int MISC_OFF = RING_BYTES + 320;
constexpr int LDS_BYTES = 147456;
constexpr int NWAVES = 8, NTHREADS = 512;

#define XB_TMO      128
#define XB_XCNT(j)  (256  + 64 * (j))
#define XB_XSUB(j)  (1280 + 64 * (j))
#define XB_XGEN(j)  (2304 + 64 * (j))
#define XB_TOP      3328
#define XB_TOPGEN   3392
#define XCD_BAR_WORDS 3456
#define XB_SPIN_CAP (1u << 22)
__device__ __forceinline__ unsigned xb_ld(unsigned* p)              { return __hip_atomic_load(p, __ATOMIC_RELAXED, __HIP_MEMORY_SCOPE_AGENT); }
__device__ __forceinline__ unsigned xb_add(unsigned* p, unsigned v) { return __hip_atomic_fetch_add(p, v, __ATOMIC_RELAXED, __HIP_MEMORY_SCOPE_AGENT); }
__device__ __forceinline__ unsigned xb_xcc_id() { return (unsigned)__builtin_amdgcn_s_getreg((3 << 11) | 20) & 0xFu; }
#define XB_SPIN(cond, bar) do { unsigned _sp = 0; while (cond) { __builtin_amdgcn_s_sleep(1); \
    if ((++_sp & 255u) == 0u) { if (xb_ld(&(bar)[XB_TMO])) break; if (_sp > XB_SPIN_CAP) { atomicAdd(&(bar)[XB_TMO], 1u); break; } } } } while (0)
struct XcdBarrier { unsigned* bar; unsigned x; volatile LAS unsigned* st; };
__device__ __forceinline__ XcdBarrier xcd_barrier_post(unsigned* bar, volatile LAS unsigned* st) {
    XcdBarrier b; b.bar = bar; b.x = xb_xcc_id(); b.st = st;
    if (threadIdx.x == 0) (void)xb_add(&bar[XB_XCNT(b.x)], 1u);
    return b;
}
__device__ __forceinline__ void xcd_barrier_complete(unsigned* bar, unsigned x, unsigned& nloc, unsigned& nx) {
    const unsigned G = gridDim.x * gridDim.y * gridDim.z;
    unsigned sum, cnt, mine, sp = 0u;
    for (;;) {
        sum = 0u; cnt = 0u; mine = 0u;
#pragma unroll
        for (unsigned j = 0; j < 16; ++j) { const unsigned c = xb_ld(&bar[XB_XCNT(j)]); sum += c; cnt += (c > 0u) ? 1u : 0u; mine = (j == x) ? c : mine; }
        if (sum == G) break;
        __builtin_amdgcn_s_sleep(1);
        if ((++sp & 255u) == 0u) { if (xb_ld(&bar[XB_TMO])) break; if (sp > XB_SPIN_CAP) { atomicAdd(&bar[XB_TMO], 1u); break; } }
    }
    nloc = mine > 0u ? mine : 1u; nx = cnt > 0u ? cnt : 1u;
}
__device__ __forceinline__ void xcd_barrier(const XcdBarrier& b) {
    asm volatile("s_waitcnt vmcnt(0)" ::: "memory");
    __syncthreads();
    if (threadIdx.x == 0) {
        unsigned* bar = b.bar;
        __builtin_amdgcn_s_waitcnt(0);
        unsigned nloc = b.st[0], nx = b.st[1];
        if (nloc == 0u) { xcd_barrier_complete(bar, b.x, nloc, nx); b.st[0] = nloc; b.st[1] = nx; }
        const unsigned old = xb_add(&bar[XB_XSUB(b.x)], 1u);
        const unsigned gen = old / nloc;
        if (old + 1u == (gen + 1u) * nloc) {
            __builtin_amdgcn_fence(__ATOMIC_RELEASE, "agent");
            asm volatile("s_waitcnt vmcnt(0)" ::: "memory");
            const unsigned og = xb_add(&bar[XB_TOP], 1u);
            const unsigned tg = og / nx;
            if (og + 1u == (tg + 1u) * nx) xb_add(&bar[XB_TOPGEN], 1u);
            else XB_SPIN(xb_ld(&bar[XB_TOPGEN]) == tg, bar);
            __builtin_amdgcn_fence(__ATOMIC_ACQUIRE, "agent");
            xb_add(&bar[XB_XGEN(b.x)], 1u);
            asm volatile("s_waitcnt vmcnt(0)" ::: "memory");
        } else {
            XB_SPIN(xb_ld(&bar[XB_XGEN(b.x)]) == gen, bar);
            __builtin_amdgcn_fence(__ATOMIC_ACQUIRE, "agent");
            asm volatile("s_waitcnt vmcnt(0)" ::: "memory");
        }
    }
    __syncthreads();
}

struct Args {
    const float* x_prompt; const float* x_sample; const float* w_in; const float* diff_lambda; const float* diff_subln; const float* mla_q_norm; const float* mla_w_uq;
    const float* mla_kv_norm; const float* mla_w_ukv; const float* w_out; const float* ln1_g; const float* ln1_b; const float* moe_w_coarse; const float* moe_w_fine;
    const float* moe_w1; const float* moe_w3; const float* moe_w2; const float* ln2_g; const float* ln2_b;
    float* out; unsigned char* ws; int ph_lo, ph_hi, use_bar, pad;
};
struct Frame {
    LAS unsigned char* lds; unsigned char* ldsg;
    int tid, lane, wave, G, gw, NGW, bid;
    gu32* ctl; unsigned char* ws;
};
__device__ __forceinline__ void launder(Frame& F) {
    int wv = F.wave; asm volatile("" : "+s"(wv)); F.wave = wv;
    int t; asm volatile("v_mbcnt_lo_u32_b32 %0, -1, 0\n\tv_mbcnt_hi_u32_b32 %0, -1, %0" : "=v"(t)); F.lane = t; F.tid = wv * 64 + t;
    int b = (int)blockIdx.x; asm volatile("" : "+s"(b)); F.bid = b; F.gw = b * NWAVES + F.wave;
    unsigned char* w = F.ws; asm volatile("" : "+s"(w)); F.ws = w; F.ctl = (gu32*)(w + WS_CTL);
}
struct SeqInfo { int base, len, pos; };
__device__ __forceinline__ SeqInfo seqinfo(int m) { SeqInfo s; if (m < NTOK_P) { s.base = m & ~2047; s.len = 2048; } else { s.base = m & ~4095; s.len = 4096; } s.pos = m - s.base; return s; }

template <class ColMap>
__device__ __forceinline__ void transpose_item(const float* W, int N, bf16_t* WT, int ldd, LAS float* scr, int k0, int n0, const ColMap& cm, const float* kscale, int lane) {
    const int sc = cm(n0 + (lane & 31));
#pragma unroll 8
    for (int i = 0; i < 32; ++i) { const int kk = 2 * i + (lane >> 5); float v = 0.f; if (sc >= 0) { v = W[(size_t)(k0 + kk) * N + sc]; if (kscale) v *= kscale[k0 + kk]; } scr[kk * 33 + (lane & 31)] = v; }
    LDS_WAIT(); asm volatile("" ::: "memory");
    const int c = lane & 7;
#pragma unroll
    for (int j = 0; j < 4; ++j) { const int n = (lane >> 3) + 8 * j; const LAS float* s = scr + (8 * c) * 33 + n;
        u32x4 o; o.x = pk2(s[0 * 33], s[1 * 33]); o.y = pk2(s[2 * 33], s[3 * 33]); o.z = pk2(s[4 * 33], s[5 * 33]); o.w = pk2(s[6 * 33], s[7 * 33]);
        *(u32x4*)(WT + (size_t)(n0 + n) * ldd + k0 + 8 * c) = o; }
    LDS_WAIT(); asm volatile("" ::: "memory");
}
__device__ __forceinline__ void transpose_item_v4(const float* Wsrc, int N, bf16_t* WTdst, int ldd, LAS float* scr, int lane) {
    const int c4 = (lane & 7) * 4, kr = lane >> 3;
    f32x4 t[8];
#pragma unroll
    for (int i = 0; i < 8; ++i) t[i] = *(const f32x4*)(Wsrc + (size_t)(i * 8 + kr) * N + c4);
#pragma unroll
    for (int i = 0; i < 8; ++i) { const int kk = i * 8 + kr; scr[(c4 + 0) * 65 + kk] = t[i].x; scr[(c4 + 1) * 65 + kk] = t[i].y; scr[(c4 + 2) * 65 + kk] = t[i].z; scr[(c4 + 3) * 65 + kk] = t[i].w; }
    LDS_WAIT(); asm volatile("" ::: "memory");
    const int c = lane & 7;
#pragma unroll
    for (int j = 0; j < 4; ++j) { const int n = (lane >> 3) + 8 * j; const LAS float* p = scr + n * 65 + 8 * c;
        u32x4 o; o.x = pk2(p[0], p[1]); o.y = pk2(p[2], p[3]); o.z = pk2(p[4], p[5]); o.w = pk2(p[6], p[7]);
        *(u32x4*)(WTdst + (size_t)n * ldd + 8 * c) = o; }
    LDS_WAIT(); asm volatile("" ::: "memory");
}
struct WinMap {
    __device__ __forceinline__ int operator()(int n) const {
        if (n < 512) { const int t = n & 31; return (n & ~31) + (t >> 1) + 16 * (t & 1); }
        if (n < 1152) return n;
        if (n < 1184) { const int t = n - 1152; return 1152 + (t >> 1) + 16 * (t & 1); }
        if (n < 1280) return -1;
        if (n < 2048) { const int u = n - 1280, t = u & 63; return 1184 + (u & ~63) + (t >> 1) + 32 * (t & 1); }
        if (n < 2432) return 1952 + (n - 2048);
        return -1;
    }
};
struct UqMap { __device__ __forceinline__ int operator()(int n) const { if (n >= 576) return -1; const int h = n / 96, t = n - 96 * h; if (t < 64) return n; const int u = t - 64; return 96 * h + 64 + (u >> 1) + 16 * (u & 1); } };
struct IdMap { __device__ __forceinline__ int operator()(int n) const { return n; } };
struct W13Map { __device__ __forceinline__ int operator()(int n) const { return (n >> 8) * 128 + (n & 127); } };

__device__ __forceinline__ void p0_prologue(Frame& F, const Args& a) {
    LAS float* scr = (LAS float*)(F.lds + F.wave * 16384);
    { float2* r32 = (float2*)(F.ws + WS_ROPE32); float2* r64 = (float2*)(F.ws + WS_ROPE64);
      for (int i = F.gw * 64 + F.lane; i < 4096 * 16; i += F.NGW * 64) { const int pos = i >> 4, j = i & 15; const float inv = 1.0f / powf(10000.0f, (float)(2 * j) / 32.0f); const float ang = (float)pos * inv; r32[i] = make_float2(cosf(ang), sinf(ang)); }
      for (int i = F.gw * 64 + F.lane; i < 4096 * 32; i += F.NGW * 64) { const int pos = i >> 5, j = i & 31; const float inv = 1.0f / powf(10000.0f, (float)(2 * j) / 64.0f); const float ang = (float)pos * inv; r64[i] = make_float2(cosf(ang), sinf(ang)); } }
    constexpr int I_WIN = (1024 / 64) * (2560 / 32), I_WOUT = (1024 / 64) * (1024 / 32), I_UQ = (256 / 64) * (768 / 32), I_UKV = (256 / 64) * (768 / 32);
    constexpr int PER_L = I_WIN + I_WOUT + I_UQ + I_UKV;
    for (int it = F.gw; it < DEPTH * PER_L; it += F.NGW) {
        const int l = it / PER_L; int r = it - l * PER_L;
        if (r < I_WIN) { const int kb = r / 80, nb = r % 80; transpose_item(a.w_in + (size_t)l * 1024 * 2336, 2336, (bf16_t*)(F.ws + WS_WIN) + (size_t)l * 2560 * 1024, 1024, scr, kb * 64, nb * 32, WinMap(), nullptr, F.lane); continue; } r -= I_WIN;
        if (r < I_WOUT) { const int kb = r / 32, nb = r % 32; transpose_item(a.w_out + (size_t)l * 1024 * 1024, 1024, (bf16_t*)(F.ws + WS_WOUT) + (size_t)l * 1024 * 1024, 1024, scr, kb * 64, nb * 32, IdMap(), nullptr, F.lane); continue; } r -= I_WOUT;
        if (r < I_UQ) { const int kb = r / 24, nb = r % 24; transpose_item(a.mla_w_uq + (size_t)l * 256 * 576, 576, (bf16_t*)(F.ws + WS_WUQ) + (size_t)l * 768 * 256, 256, scr, kb * 64, nb * 32, UqMap(), a.mla_q_norm + l * 256, F.lane); continue; } r -= I_UQ;
        { const int kb = r / 24, nb = r % 24; bf16_t* dst = (bf16_t*)(F.ws + WS_WUKV) + (size_t)l * 768 * 256;
          if (kb < 2) transpose_item(a.mla_w_ukv + (size_t)l * 128 * 768, 768, dst, 256, scr, kb * 64, nb * 32, IdMap(), a.mla_kv_norm + l * 128, F.lane);
          else { const int c = F.lane & 7;
#pragma unroll
              for (int j = 0; j < 4; ++j) { const int n = (F.lane >> 3) + 8 * j; *(u32x4*)(dst + (size_t)(nb * 32 + n) * 256 + kb * 64 + 8 * c) = (u32x4){0u, 0u, 0u, 0u}; } } }
    }
    bf16_t* XB = (bf16_t*)(F.ws + WS_XB);
    for (int m = F.gw; m < NTOK; m += F.NGW) {
        const float* src = (m < NTOK_P) ? a.x_prompt + (size_t)m * DM : a.x_sample + (size_t)(m - NTOK_P) * DM;
#pragma unroll
        for (int j = 0; j < 4; ++j) { const f32x4 v = *((const f32x4*)src + F.lane + 64 * j);
            u32x2 w; w.x = pk2(v.x, v.y); w.y = pk2(v.z, v.w); *((u32x2*)(XB + (size_t)m * DM) + F.lane + 64 * j) = w; }
    }
}

template <class Epi, class RowMap>
__device__ __forceinline__ void sg_tile(const bf16_t* A, int lda, const bf16_t* B0, const bf16_t* B1, int ldb, int K, int m0, int c0, const Epi& E, const RowMap& RM, int lane) {
    const int r32 = lane & 31, hi = lane >> 5;
    const bf16_t* ap = A + (size_t)RM.src(m0 + r32) * lda + 8 * hi;
    const bf16_t* b0p = B0 + (size_t)r32 * ldb + 8 * hi;
    const bf16_t* b1p = B1 + (size_t)r32 * ldb + 8 * hi;
    f32x16 acc0 = {}, acc1 = {};
#pragma unroll 4
    for (int k = 0; k < K; k += 16) {
        const bf16x8 af = *(const bf16x8*)(ap + k), bf0 = *(const bf16x8*)(b0p + k), bf1 = *(const bf16x8*)(b1p + k);
        acc0 = MFMA32(bf0, af, acc0); acc1 = MFMA32(bf1, af, acc1);
    }
#pragma unroll
    for (int g = 0; g < 4; ++g) { const f32x4 v0 = {acc0[4 * g], acc0[4 * g + 1], acc0[4 * g + 2], acc0[4 * g + 3]}, v1 = {acc1[4 * g], acc1[4 * g + 1], acc1[4 * g + 2], acc1[4 * g + 3]};
        E.put(m0 + r32, c0, 8 * g + 4 * hi, v0, v1); }
}
struct IdRows { __device__ __forceinline__ int src(int m) const { return m; } };

__device__ __forceinline__ void store_bf8(bf16_t* p, f32x4 a, f32x4 b) { u32x4 w; w.x = pk2(a.x, a.y); w.y = pk2(a.z, a.w); w.z = pk2(b.x, b.y); w.w = pk2(b.z, b.w); *(u32x4*)p = w; }
__device__ __forceinline__ void store_bf4(bf16_t* p, f32x4 v) { u32x2 w; w.x = pk2(v.x, v.y); w.y = pk2(v.z, v.w); *(u32x2*)p = w; }
struct EpiH {
    static constexpr bool PERM = true;
    bf16_t* H; const float2* rope32; const float2* rope64;
    __device__ __forceinline__ f32x4 xf(int pos, int col, f32x4 v) const {
        if (col < 512 || (col >= HC_KROPE && col < HC_KROPE + 32)) {
            const int j0 = (col & 31) >> 1; const f32x4 cs = *(const f32x4*)(rope32 + pos * 16 + j0);
            f32x4 o; o.x = v.x * cs.x - v.y * cs.y; o.y = v.x * cs.y + v.y * cs.x; o.z = v.z * cs.z - v.w * cs.w; o.w = v.z * cs.w + v.w * cs.z;
            if (col < 256) o = o * SC_A; v = o;
        } else if (col >= HC_CQ && col < HC_CV) {
            const int j0 = ((col - HC_CQ) & 63) >> 1; const f32x4 cs = *(const f32x4*)(rope64 + pos * 32 + j0);
            f32x4 o; o.x = v.x * cs.x - v.y * cs.y; o.y = v.x * cs.y + v.y * cs.x; o.z = v.z * cs.z - v.w * cs.w; o.w = v.z * cs.w + v.w * cs.z;
            if (col < HC_CK) o = o * SC_C; v = o;
        }
        return v;
    }
    __device__ __forceinline__ void put4(int row, int col, f32x4 v) const { store_bf4(H + (size_t)row * HP + col, xf(seqinfo(row).pos, col, v)); }
    __device__ __forceinline__ void put(int row, int c0, int cc, f32x4 v0, f32x4 v1) const { put4(row, c0 + cc, v0); put4(row, c0 + 32 + cc, v1); }
    template <class U> __device__ __forceinline__ void put8(const U&, int row, int col, f32x4 v0, f32x4 v1) const { const int pos = seqinfo(row).pos; store_bf8(H + (size_t)row * HP + col, xf(pos, col, v0), xf(pos, col + 4, v1)); }
};
struct EpiUQ {
    static constexpr bool PERM = true;
    bf16_t* Q; const float* rstd; const float2* rope32;
    __device__ __forceinline__ f32x4 xf(int row, int col, f32x4 v, float rs) const {
        v = v * rs;
        const int t = col % 96;
        if (t >= 64) { const int pos = seqinfo(row).pos; const int j0 = (t - 64) >> 1; const f32x4 cs = *(const f32x4*)(rope32 + pos * 16 + j0);
            f32x4 o; o.x = v.x * cs.x - v.y * cs.y; o.y = v.x * cs.y + v.y * cs.x; o.z = v.z * cs.z - v.w * cs.w; o.w = v.z * cs.w + v.w * cs.z; v = o; }
        return v * SC_B;
    }
    __device__ __forceinline__ void put4(int row, int col, f32x4 v) const { if (col >= 576) return; store_bf4(Q + (size_t)row * QBP + col, xf(row, col, v, rstd[2 * row])); }
    template <class U> __device__ __forceinline__ void put8(const U&, int row, int col, f32x4 v0, f32x4 v1) const { if (col >= 576) return; const float rs = rstd[2 * row]; store_bf8(Q + (size_t)row * QBP + col, xf(row, col, v0, rs), xf(row, col + 4, v1, rs)); }
    __device__ __forceinline__ void put(int row, int c0, int cc, f32x4 v0, f32x4 v1) const { put4(row, c0 + cc, v0); put4(row, c0 + 32 + cc, v1); }
};
struct EpiUKV {
    static constexpr bool PERM = true;
    bf16_t* KV; const float* rstd;
    template <class U> __device__ __forceinline__ void put8(const U&, int row, int col, f32x4 v0, f32x4 v1) const { const float rs = rstd[2 * row + 1]; store_bf8(KV + (size_t)row * KVP + col, v0 * rs, v1 * rs); }
    __device__ __forceinline__ void put4(int row, int col, f32x4 v) const { store_bf4(KV + (size_t)row * KVP + col, v * rstd[2 * row + 1]); }
    __device__ __forceinline__ void put(int row, int c0, int cc, f32x4 v0, f32x4 v1) const { put4(row, c0 + cc, v0); put4(row, c0 + 32 + cc, v1); }
};
struct EpiRes {
    static constexpr bool PERM = false;
    float* X; const float* xp; const float* xs; float* D;
    template <class U> __device__ __forceinline__ void put4(const U&, int row, int col, f32x4 v) const { put4(row, col, v); }
    __device__ __forceinline__ void put4(int row, int col, f32x4 v) const {
        const f32x4* p = (const f32x4*)(X + (size_t)row * DM + col);
        const f32x4 r = xp ? *(const f32x4*)(((row < NTOK_P) ? xp + (size_t)row * DM : xs + (size_t)(row - NTOK_P) * DM) + col) : *p;
        *(f32x4*)(D + (size_t)row * DM + col) = r * DN_ALPHA + v; }
    __device__ __forceinline__ void put(int row, int c0, int cc, f32x4 v0, f32x4 v1) const { put4(row, c0 + cc, v0); put4(row, c0 + 32 + cc, v1); }
};
__device__ __forceinline__ float silu_f(float x) { return x / (1.0f + __expf(-x)); }
struct EpiHid {
    static constexpr bool PERM = true;
    bf16_t* HID;
    __device__ __forceinline__ f32x4 act(f32x4 g, f32x4 u) const { f32x4 o; o.x = silu_f(g.x) * u.x; o.y = silu_f(g.y) * u.y; o.z = silu_f(g.z) * u.z; o.w = silu_f(g.w) * u.w; return o; }
    template <class U> __device__ __forceinline__ void putp8(const U&, int row, int col, f32x4 g0, f32x4 g1, f32x4 u0, f32x4 u1) const { store_bf8(HID + (size_t)row * DEXP + col, act(g0, u0), act(g1, u1)); }
    __device__ __forceinline__ void putp(int row, int col, f32x4 g, f32x4 u) const { f32x4 o; o.x = silu_f(g.x) * u.x; o.y = silu_f(g.y) * u.y; o.z = silu_f(g.z) * u.z; o.w = silu_f(g.w) * u.w; store_bf4(HID + (size_t)row * DEXP + col, o); }
    __device__ __forceinline__ void put(int row, int c0, int cc, f32x4 v0, f32x4 v1) const { putp(row, c0 + cc, v0, v1); }
};
struct EpiY {
    bf16_t* YB; const float* tw; const int* list; int seg0, cnt;
    __device__ __forceinline__ void put4(int row, int col, f32x4 v) const { const int r = row - seg0; if (r >= cnt) return; const int a = list[r]; store_bf4(YB + (size_t)a * DM + col, v * tw[a]); }
    __device__ __forceinline__ void put(int row, int c0, int cc, f32x4 v0, f32x4 v1) const { put4(row, c0 + cc, v0); put4(row, c0 + 32 + cc, v1); }
};

struct EpiYO {
    static constexpr bool PERM = true;
    bf16_t* YB; const float* tw; const int* list; const LAS int* seg;
    template <class U> __device__ __forceinline__ void put8(const U& u, int row, int col, f32x4 v0, f32x4 v1) const {
        const int r = row - __builtin_amdgcn_readfirstlane(seg[u.e]); if (r >= __builtin_amdgcn_readfirstlane(seg[33 + u.e])) return; const int a = list[(size_t)u.e * LIST_CAP + r]; const float w = tw[a]; store_bf8(YB + (size_t)a * DM + col, v0 * w, v1 * w); }
};
template <class Epi>
__device__ __forceinline__ void sg_phase(Frame& F, const bf16_t* A, int lda, const bf16_t* Bt, int ldb, int M, int N, int K, const Epi& E) {
    const int nN = N / 64, items = (M / 32) * nN;
    for (int it = F.gw; it < items; it += F.NGW) { const int mt = it / nN, nt = it - mt * nN;
        sg_tile(A, lda, Bt + (size_t)(nt * 64) * ldb, Bt + (size_t)(nt * 64 + 32) * ldb, ldb, K, mt * 32, nt * 64, E, IdRows(), F.lane); }
}


namespace pg8 {
constexpr int BM = 256, BK = 64, HALF = 128, HTB = HALF * BK * 2, NXCD = 8, WGM = 8;
__host__ __device__ __forceinline__ int lds_byte(int r, int c) { const int st = (r >> 4) * 2 + (c >> 5), rr = r & 15, cc = c & 31, ob = rr * 64 + cc * 2; return st * 1024 + (ob ^ (((ob >> 9) & 1) << 5)); }
__host__ __device__ __forceinline__ void stage_rc(int b, int& R, int& C) { const int st = b / 1024, sb = b % 1024, swz = sb ^ (((sb >> 9) & 1) << 5); R = (st >> 1) * 16 + swz / 64; C = (st & 1) * 32 + (swz % 64) / 2; }
__host__ __device__ __forceinline__ int perm32(int rho) { const int n = rho >> 4, i = rho & 15; return 8 * (i >> 2) + 4 * n + (i & 3); }
struct Unit { int pm, pn, e; const char* a; const char* b; };
__device__ __forceinline__ bool order_next(int i, int G, int c, int nM, int nN, int& pm, int& pn) {
    const int nwg = nM * nN; const long L = (long)i * G + c; if (L >= nwg) return false;
    int wgid = (int)L; { const int q = nwg / NXCD, r = nwg % NXCD, xcd = wgid % NXCD, off = wgid / NXCD; wgid = (xcd < r ? xcd * (q + 1) : r * (q + 1) + (xcd - r) * q) + off; }
    const int nig = WGM * nN, gid = wgid / nig, fm = gid * WGM, gsz = (nM - fm) < WGM ? (nM - fm) : WGM;
    pm = fm + ((wgid % nig) % gsz); pn = (wgid % nig) / gsz; return true;
}
struct DenseSched {
    const char* A; const char* Bt; int nM, nN, G, c; size_t tstepA, tstepB;
    __device__ __forceinline__ void init(const bf16_t* A_, int lda, const bf16_t* Bt_, int M, int N, int K, int G_, int c_) { A = (const char*)A_; Bt = (const char*)Bt_; nM = M / BM; nN = N / BM; G = G_; c = c_; tstepA = (size_t)BM * lda * 2; tstepB = (size_t)BM * K * 2; }
    __device__ __forceinline__ bool next(int i, Unit& u) const { if (!order_next(i, G, c, nM, nN, u.pm, u.pn)) return false; u.e = 0; u.a = A + (size_t)u.pm * tstepA; u.b = Bt + (size_t)u.pn * tstepB; return true; }
    __device__ __forceinline__ unsigned arow(const Unit&, int) const { return 0u; }
};
struct PanelSched {
    const char* A; const char* Bt; int pm, nN; size_t tstepB;
    __device__ __forceinline__ void init(const bf16_t* A_, int lda, const bf16_t* Bt_, int pm_, int N, int K) { pm = pm_; nN = N / BM; A = (const char*)A_ + (size_t)pm_ * BM * lda * 2; Bt = (const char*)Bt_; tstepB = (size_t)BM * K * 2; }
    __device__ __forceinline__ bool next(int i, Unit& u) const { if (i >= nN) return false; u.pm = pm; int pn = i + (pm % nN); if (pn >= nN) pn -= nN; u.pn = pn; u.e = 0; u.a = A; u.b = Bt + (size_t)pn * tstepB; return true; }
    __device__ __forceinline__ unsigned arow(const Unit&, int) const { return 0u; }
};
template <class Epi, bool PAIR> struct EpiApply;
template <class Epi, class Sched, bool GATHER, bool PAIR>
__device__ __forceinline__ void gemm_phase(LAS unsigned char* lds, int tid, int K, int lda, const Sched& S, const Epi& E) {
    const int wid = __builtin_amdgcn_readfirstlane(tid >> 6), lane = tid & 63, wr = wid >> 2, wc = wid & 3, fr = lane & 15, fq = lane >> 4;
    const int nt = K / BK;
    unsigned voffA[2], voffB[2]; int RA[2], CA[2];
#pragma unroll
    for (int i = 0; i < 2; ++i) { int R, C; stage_rc(tid * 16 + i * 8192, R, C); const int Rb = Epi::PERM ? ((R & ~31) + perm32(R & 31)) : R; RA[i] = R; CA[i] = C;
        voffA[i] = (unsigned)(R * lda + C) * 2u; voffB[i] = (unsigned)(Rb * K + C) * 2u; }
    const size_t kstep = (size_t)(BK * 2);
    const size_t hstepA = (size_t)HALF * lda * 2, hstepB = (size_t)HALF * K * 2;
    const unsigned ldsw = (unsigned)wid * 1024u;
    const int aoff = lds_byte(wr * 64 + fr, fq * 8), boff = lds_byte(wc * 32 + fr, fq * 8);
#define PG8_SA(b, h) (((b) * 2 + (h)) * HTB)
#define PG8_SB(b, h) ((4 + (b) * 2 + (h)) * HTB)
#define PG8_STAGE(bufoff, gbase, voff) do { _Pragma("unroll") for (int _i = 0; _i < 2; ++_i) \
        __builtin_amdgcn_global_load_lds((const unsigned*)((const char*)(gbase) + (voff)[_i]), (LAS unsigned*)(lds + (bufoff) + ldsw + _i * 8192), 16, 0, 0); } while (0)
#define PG8_STAGE_A(bufoff, ab, vg, h, koff) do { if (GATHER) { PG8_STAGE(bufoff, (ab) + (koff), (vg)[h]); } else { PG8_STAGE(bufoff, (ab) + (h) * hstepA + (koff), voffA); } } while (0)
#define PG8_LDA(dst, b, h) do { _Pragma("unroll") for (int m = 0; m < 4; ++m) _Pragma("unroll") for (int k = 0; k < 2; ++k) dst[m][k] = *(const LAS bf16x8*)(lds + PG8_SA(b, h) + aoff + m * 2048 + k * 1024); } while (0)
#define PG8_LDB(dst, b, h) do { _Pragma("unroll") for (int n = 0; n < 2; ++n) _Pragma("unroll") for (int k = 0; k < 2; ++k) dst[n][k] = *(const LAS bf16x8*)(lds + PG8_SB(b, h) + boff + n * 2048 + k * 1024); } while (0)
#define PG8_MMA(ai, bj, At, Bt) do { __builtin_amdgcn_s_setprio(1); _Pragma("unroll") for (int m = 0; m < 4; ++m) _Pragma("unroll") for (int n = 0; n < 2; ++n) _Pragma("unroll") for (int k = 0; k < 2; ++k) \
        acc[ai][bj][m][n] = __builtin_amdgcn_mfma_f32_16x16x32_bf16(Bt[n][k], At[m][k], acc[ai][bj][m][n], 0, 0, 0); __builtin_amdgcn_s_setprio(0); } while (0)
#define PG8_WAIT_V(n) asm volatile("s_waitcnt vmcnt(" #n ")" ::: "memory")
#define PG8_WAIT_L(n) asm volatile("s_waitcnt lgkmcnt(" #n ")" ::: "memory")
#define PG8_BAR __builtin_amdgcn_s_barrier()
#define PG8_SCHED __builtin_amdgcn_sched_barrier(0)
    Unit cur, nxt; int ui = 0;
    if (!S.next(0, cur)) return;
    f32x4 acc[2][2][4][2];
#pragma unroll
    for (int a = 0; a < 2; ++a)
#pragma unroll
        for (int b = 0; b < 2; ++b)
#pragma unroll
            for (int m = 0; m < 4; ++m)
#pragma unroll
                for (int n = 0; n < 2; ++n) acc[a][b][m][n] = (f32x4){0.f, 0.f, 0.f, 0.f};
    bf16x8 At[4][2], B0[2][2], B1[2][2];
    unsigned vgc[2][2] = {{0u, 0u}, {0u, 0u}}, vgn[2][2] = {{0u, 0u}, {0u, 0u}};
    if (GATHER) {
#pragma unroll
        for (int h = 0; h < 2; ++h)
#pragma unroll
            for (int i = 0; i < 2; ++i) vgc[h][i] = S.arow(cur, h * HALF + RA[i]) * (unsigned)(lda * 2) + (unsigned)CA[i] * 2u;
    }
    const char* cA = cur.a; const char* cB = cur.b;
    PG8_STAGE(PG8_SB(0, 0), cB, voffB); PG8_STAGE(PG8_SB(0, 1), cB + hstepB, voffB); PG8_STAGE_A(PG8_SA(0, 0), cA, vgc, 0, 0); PG8_STAGE_A(PG8_SA(0, 1), cA, vgc, 1, 0);
    if (wr == 1) PG8_BAR;
    PG8_WAIT_V(2); PG8_BAR;
    PG8_STAGE(PG8_SB(1, 0), cB + kstep, voffB); PG8_STAGE_A(PG8_SA(1, 0), cA, vgc, 0, kstep); PG8_STAGE(PG8_SB(1, 1), cB + hstepB + kstep, voffB);
    PG8_WAIT_V(6); PG8_BAR;
    for (;;) {
        const bool has_next = S.next(ui + 1, nxt);
        const char* nA = has_next ? nxt.a : cA; const char* nB = has_next ? nxt.b : cB;
        if (GATHER) {
#pragma unroll
            for (int h = 0; h < 2; ++h)
#pragma unroll
                for (int i = 0; i < 2; ++i) vgn[h][i] = has_next ? (S.arow(nxt, h * HALF + RA[i]) * (unsigned)(lda * 2) + (unsigned)CA[i] * 2u) : vgc[h][i];
        }
#pragma clang loop unroll(disable)
        for (int t = 0; t < nt; t += 2) {
            const bool last = (t == nt - 2);
            const size_t k1 = (size_t)(t + 1) * kstep;
            const char* a2 = last ? nA : cA; const char* b2 = last ? nB : cB + (size_t)(t + 2) * kstep; const size_t ka2 = last ? 0 : (size_t)(t + 2) * kstep;
            const char* b3 = b2 + kstep; const size_t ka3 = ka2 + kstep;
            unsigned v2[2][2];
#pragma unroll
            for (int h = 0; h < 2; ++h)
#pragma unroll
                for (int i = 0; i < 2; ++i) v2[h][i] = last ? vgn[h][i] : vgc[h][i];
            PG8_LDB(B0, 0, 0); PG8_LDB(B1, 0, 1); PG8_SCHED; PG8_LDA(At, 0, 0); PG8_STAGE_A(PG8_SA(1, 1), cA, vgc, 1, k1);
            PG8_WAIT_V(8); PG8_WAIT_L(0); PG8_BAR; PG8_MMA(0, 0, At, B0); PG8_MMA(0, 1, At, B1); PG8_BAR; PG8_SCHED;
            PG8_LDA(At, 0, 1); PG8_STAGE(PG8_SB(0, 0), b2, voffB); PG8_STAGE(PG8_SB(0, 1), b2 + hstepB, voffB); PG8_STAGE_A(PG8_SA(0, 0), a2, v2, 0, ka2);
            PG8_WAIT_V(8); PG8_WAIT_L(0); PG8_BAR; PG8_MMA(1, 0, At, B0); PG8_MMA(1, 1, At, B1); PG8_BAR; PG8_SCHED;
            PG8_LDB(B0, 1, 0); PG8_LDB(B1, 1, 1); PG8_SCHED; PG8_LDA(At, 1, 0); PG8_STAGE_A(PG8_SA(0, 1), a2, v2, 1, ka2);
            PG8_WAIT_V(8); PG8_WAIT_L(0); PG8_BAR; PG8_MMA(0, 0, At, B0); PG8_MMA(0, 1, At, B1); PG8_BAR; PG8_SCHED;
            PG8_LDA(At, 1, 1); PG8_STAGE(PG8_SB(1, 0), b3, voffB); PG8_STAGE(PG8_SB(1, 1), b3 + hstepB, voffB); PG8_STAGE_A(PG8_SA(1, 0), a2, v2, 0, ka3);
            PG8_WAIT_V(8); PG8_WAIT_L(0); PG8_BAR; PG8_MMA(1, 0, At, B0); PG8_MMA(1, 1, At, B1); PG8_BAR; PG8_SCHED;
        }
        if (wr == 0) PG8_BAR;
        { int fr_ = fr, fq_ = fq; asm volatile("" : "+v"(fr_), "+v"(fq_));
          EpiApply<Epi, PAIR>::run(E, acc, cur, wr, wc, fr_, fq_); }
        if (!has_next) break;
#pragma unroll
        for (int a = 0; a < 2; ++a)
#pragma unroll
            for (int b = 0; b < 2; ++b)
#pragma unroll
                for (int m = 0; m < 4; ++m)
#pragma unroll
                    for (int n = 0; n < 2; ++n) acc[a][b][m][n] = (f32x4){0.f, 0.f, 0.f, 0.f};
        cur = nxt; cA = nA; cB = nB; ++ui;
        if (GATHER) {
#pragma unroll
            for (int h = 0; h < 2; ++h)
#pragma unroll
                for (int i = 0; i < 2; ++i) vgc[h][i] = vgn[h][i];
        }
        if (wr == 1) PG8_BAR;
    }
    PG8_WAIT_V(0);
    PG8_BAR;
#undef PG8_SA
#undef PG8_SB
#undef PG8_STAGE
#undef PG8_STAGE_A
#undef PG8_LDA
#undef PG8_LDB
#undef PG8_MMA
#undef PG8_WAIT_V
#undef PG8_WAIT_L
#undef PG8_BAR
#undef PG8_SCHED
}
template <class Epi> struct EpiApply<Epi, false> {
    static __device__ __forceinline__ void run(const Epi& E, const f32x4 (&acc)[2][2][4][2], const Unit& u, int wr, int wc, int fr, int fq) {
#pragma unroll
        for (int ai = 0; ai < 2; ++ai)
#pragma unroll
            for (int m = 0; m < 4; ++m) { const int row = u.pm * BM + ai * HALF + wr * 64 + m * 16 + fr;
#pragma unroll
                for (int bj = 0; bj < 2; ++bj) {
                    if constexpr (Epi::PERM) E.put8(u, row, u.pn * BM + bj * HALF + wc * 32 + 8 * fq, acc[ai][bj][m][0], acc[ai][bj][m][1]);
                    else { E.put4(u, row, u.pn * BM + bj * HALF + wc * 32 + 4 * fq, acc[ai][bj][m][0]); E.put4(u, row, u.pn * BM + bj * HALF + wc * 32 + 16 + 4 * fq, acc[ai][bj][m][1]); } }
            }
    }
};
template <class Epi> struct EpiApply<Epi, true> {
    static __device__ __forceinline__ void run(const Epi& E, const f32x4 (&acc)[2][2][4][2], const Unit& u, int wr, int wc, int fr, int fq) {
#pragma unroll
        for (int ai = 0; ai < 2; ++ai)
#pragma unroll
            for (int m = 0; m < 4; ++m) { const int row = u.pm * BM + ai * HALF + wr * 64 + m * 16 + fr;
                E.putp8(u, row, u.pn * HALF + wc * 32 + 8 * fq, acc[ai][0][m][0], acc[ai][0][m][1], acc[ai][1][m][0], acc[ai][1][m][1]); }
    }
};
}

__device__ __forceinline__ void rowstat_pass(Frame& F, int r_first, int r_stride, int r_end) {
    const bf16_t* H = (const bf16_t*)(F.ws + WS_H); float* rstd = (float*)(F.ws + WS_RSTD);
    for (int m = r_first; m < r_end; m += r_stride) {
        const bf16_t* hr = H + (size_t)m * HP;
        const u32x2 q = *((const u32x2*)(hr + HC_CQ_LAT) + F.lane);
        const unsigned kv = *((const unsigned*)(hr + HC_CKV) + F.lane);
        float a0 = bf2f(q.x & 0xffff), a1 = bf2f(q.x >> 16), a2 = bf2f(q.y & 0xffff), a3 = bf2f(q.y >> 16), b0 = bf2f(kv & 0xffff), b1 = bf2f(kv >> 16);
        const float sq = wave_sum(a0 * a0 + a1 * a1 + a2 * a2 + a3 * a3), sk = wave_sum(b0 * b0 + b1 * b1);
        if (F.lane == 0) { rstd[2 * m] = 1.0f / sqrtf(sq * (1.0f / 256.0f) + RMS_EPS); rstd[2 * m + 1] = 1.0f / sqrtf(sk * (1.0f / 128.0f) + RMS_EPS); }
    }
}
__device__ __forceinline__ void red8(float (&v)[8], int lane) {
    float a[4], b[2], c;
#pragma unroll
    for (int i = 0; i < 4; ++i) a[i] = xpair32(v[i], v[i + 4]);
    { const bool up = (lane & 16) != 0;
#pragma unroll
      for (int i = 0; i < 2; ++i) { const float send = up ? a[i] : a[i + 2], keep = up ? a[i + 2] : a[i]; b[i] = keep + shx<16>(send); } }
    { const bool up = (lane & 8) != 0; const float send = up ? b[0] : b[1], keep = up ? b[1] : b[0]; c = keep + shx<8>(send); }
    c += shx<4>(c); c += shx<2>(c); c += shx<1>(c);
#pragma unroll
    for (int i = 0; i < 8; ++i) v[i] = __uint_as_float(__builtin_amdgcn_readlane(__float_as_uint(c), ((i >> 2) & 1) * 32 + ((i >> 1) & 1) * 16 + (i & 1) * 8));
}
__device__ __forceinline__ void red4(float (&v)[4], int lane) {
    float a[2], c;
#pragma unroll
    for (int i = 0; i < 2; ++i) a[i] = xpair32(v[i], v[i + 2]);
    { const bool up = (lane & 16) != 0; const float send = up ? a[0] : a[1], keep = up ? a[1] : a[0]; c = keep + shx<16>(send); }
    c += shx<8>(c); c += shx<4>(c); c += shx<2>(c); c += shx<1>(c);
#pragma unroll
    for (int i = 0; i < 4; ++i) v[i] = __uint_as_float(__builtin_amdgcn_readlane(__float_as_uint(c), ((i >> 1) & 1) * 32 + (i & 1) * 16));
}
__device__ __forceinline__ void ln1_route_pass(Frame& F, const Args& a, int layer, int r_first, int r_stride, int r_end) {
    bf16_t* XB = (bf16_t*)(F.ws + WS_XB); float* tw = (float*)(F.ws + WS_TW); int* list = (int*)(F.ws + WS_LIST);
    const float* g = a.ln1_g + layer * DM; const float* bb = a.ln1_b + layer * DM;
    const float* wc = a.moe_w_coarse + (size_t)layer * DM * 4; const float* wf = a.moe_w_fine + (size_t)layer * 4 * DM * 8;
    for (int q = F.tid; q < 4 * 1024 * 2; q += NTHREADS) { const int hf = q & 1, k = (q >> 1) & 1023, gg = q >> 11; const int l = (k & 255) >> 2, e = k & 3, j = k >> 8;
        *(LAS f32x4*)(F.lds + (size_t)(gg * 2048 + ((j * 4 + e) * 2 + hf) * 64 + l) * 16) = *((const f32x4*)wf + q); }
    f32x4 wcr[4][4];
#pragma unroll
    for (int j = 0; j < 4; ++j)
#pragma unroll
        for (int e = 0; e < 4; ++e) wcr[j][e] = *(const f32x4*)(wc + (size_t)(4 * F.lane + 256 * j + e) * 4);
    __syncthreads();
    f32x4 vn[2][4];
#pragma unroll
    for (int rr = 0; rr < 2; ++rr) { const int mm = r_first + rr * r_stride; if (mm < r_end) {
#pragma unroll
        for (int j = 0; j < 4; ++j) vn[rr][j] = *((const f32x4*)(a.out + (size_t)mm * DM) + F.lane + 64 * j); } }
    for (int m0 = r_first; m0 < r_end; m0 += 2 * r_stride) {
        f32x4 vc[2][4];
#pragma unroll
        for (int rr = 0; rr < 2; ++rr)
#pragma unroll
            for (int j = 0; j < 4; ++j) vc[rr][j] = vn[rr][j];
#pragma unroll
        for (int rr = 0; rr < 2; ++rr) { const int mm = m0 + (2 + rr) * r_stride; if (mm < r_end) {
#pragma unroll
            for (int j = 0; j < 4; ++j) vn[rr][j] = *((const f32x4*)(a.out + (size_t)mm * DM) + F.lane + 64 * j); } }
#pragma unroll
      for (int rr = 0; rr < 2; ++rr) { const int m = m0 + rr * r_stride; if (m < r_end) {
        f32x4 v[4]; float s = 0.f;
#pragma unroll
        for (int j = 0; j < 4; ++j) { v[j] = vc[rr][j]; s += (v[j].x + v[j].y) + (v[j].z + v[j].w); }
        const float mean = wave_sum(s) * (1.f / DM); float s2 = 0.f;
#pragma unroll
        for (int j = 0; j < 4; ++j) { v[j] = v[j] - mean; s2 += (v[j].x * v[j].x + v[j].y * v[j].y) + (v[j].z * v[j].z + v[j].w * v[j].w); }
        const float rs = 1.f / sqrtf(wave_sum(s2) * (1.f / DM) + LN_EPS);
        float cl[4] = {0.f, 0.f, 0.f, 0.f};
#pragma unroll
        for (int j = 0; j < 4; ++j) { const int c = 4 * F.lane + 256 * j; const f32x4 gg = *(const f32x4*)(g + c), bv = *(const f32x4*)(bb + c); v[j] = v[j] * rs * gg + bv;
            u32x2 w; w.x = pk2(v[j].x, v[j].y); w.y = pk2(v[j].z, v[j].w); *((u32x2*)(XB + (size_t)m * DM) + F.lane + 64 * j) = w;
#pragma unroll
            for (int e = 0; e < 4; ++e) { const f32x4 w4 = wcr[j][e]; const float xe = v[j][e]; cl[0] += xe * w4.x; cl[1] += xe * w4.y; cl[2] += xe * w4.z; cl[3] += xe * w4.w; } }
        red4(cl, F.lane);
        int grp = 0; float cm = cl[0];
#pragma unroll
        for (int e = 1; e < 4; ++e) if (cl[e] > cm) { cm = cl[e]; grp = e; }
        float den = 0.f;
#pragma unroll
        for (int e = 0; e < 4; ++e) den += __expf(cl[e] - cm);
        const float pg = 1.0f / den;
        grp = __builtin_amdgcn_readfirstlane(grp);
        const LAS f32x4* wl = (const LAS f32x4*)(F.lds) + grp * 2048 + F.lane;
        float fl[8] = {0.f, 0.f, 0.f, 0.f, 0.f, 0.f, 0.f, 0.f};
#pragma unroll
        for (int j = 0; j < 4; ++j)
#pragma unroll
            for (int e = 0; e < 4; ++e) { const f32x4 wa = wl[((j * 4 + e) * 2) * 64], wb = wl[((j * 4 + e) * 2 + 1) * 64]; const float xe = v[j][e];
                fl[0] += xe * wa.x; fl[1] += xe * wa.y; fl[2] += xe * wa.z; fl[3] += xe * wa.w; fl[4] += xe * wb.x; fl[5] += xe * wb.y; fl[6] += xe * wb.z; fl[7] += xe * wb.w; }
        red8(fl, F.lane);
        int i0 = 0; float v0 = fl[0];
#pragma unroll
        for (int e = 1; e < 8; ++e) if (fl[e] > v0) { v0 = fl[e]; i0 = e; }
        int i1 = -1; float v1 = -3.0e38f;
#pragma unroll
        for (int e = 0; e < 8; ++e) if (e != i0 && fl[e] > v1) { v1 = fl[e]; i1 = e; }
        const float e1 = __expf(v1 - v0), w0 = pg / (1.0f + e1), w1 = pg * e1 / (1.0f + e1);
        if (F.lane < 2) { const int e = grp * 8 + (F.lane == 0 ? i0 : i1); const int a_id = 2 * m + F.lane;
            const unsigned pos = __hip_atomic_fetch_add(F.ctl + CW_CNT + layer * 64 + e, 1u, RLX_AGENT);
            list[(size_t)e * LIST_CAP + pos] = a_id; tw[a_id] = (F.lane == 0) ? w0 : w1; }
          } }
    }
    __syncthreads();
}
__device__ __forceinline__ void ln2_pass(Frame& F, const Args& a, int layer, int r_first, int r_stride, int r_end) {
    bf16_t* XB = (bf16_t*)(F.ws + WS_XB); const bf16_t* YB = (const bf16_t*)(F.ws + WS_YB);
    const float* g = a.ln2_g + layer * DM; const float* bb = a.ln2_b + layer * DM; const float* g1 = a.ln1_g + layer * DM; const float* b1 = a.ln1_b + layer * DM;
    f32x4 xn[2][4]; u32x2 pn[2][4], qn[2][4];
#define LN2_LOAD(rr, mm) do { const bf16_t* y0_ = YB + (size_t)(2 * (mm)) * DM; _Pragma("unroll") for (int j = 0; j < 4; ++j) { xn[rr][j] = *((const f32x4*)(a.out + (size_t)(mm) * DM) + F.lane + 64 * j); \
        pn[rr][j] = *((const u32x2*)y0_ + F.lane + 64 * j); qn[rr][j] = *((const u32x2*)(y0_ + DM) + F.lane + 64 * j); } } while (0)
#pragma unroll
    for (int rr = 0; rr < 2; ++rr) { const int mm = r_first + rr * r_stride; if (mm < r_end) LN2_LOAD(rr, mm); }
    for (int m0 = r_first; m0 < r_end; m0 += 2 * r_stride) {
        f32x4 xc[2][4]; u32x2 pc[2][4], qc[2][4];
#pragma unroll
        for (int rr = 0; rr < 2; ++rr)
#pragma unroll
            for (int j = 0; j < 4; ++j) { xc[rr][j] = xn[rr][j]; pc[rr][j] = pn[rr][j]; qc[rr][j] = qn[rr][j]; }
#pragma unroll
        for (int rr = 0; rr < 2; ++rr) { const int mm = m0 + (2 + rr) * r_stride; if (mm < r_end) LN2_LOAD(rr, mm); }
#pragma unroll
        for (int rr = 0; rr < 2; ++rr) { const int m = m0 + rr * r_stride; if (m < r_end) {
            float* xr = a.out + (size_t)m * DM;
            f32x4 v[4]; float s = 0.f;
            { float s1 = 0.f;
#pragma unroll
              for (int j = 0; j < 4; ++j) { v[j] = xc[rr][j]; s1 += (v[j].x + v[j].y) + (v[j].z + v[j].w); }
              const float mean1 = wave_sum(s1) * (1.f / DM); float q1 = 0.f;
#pragma unroll
              for (int j = 0; j < 4; ++j) { v[j] = v[j] - mean1; q1 += (v[j].x * v[j].x + v[j].y * v[j].y) + (v[j].z * v[j].z + v[j].w * v[j].w); }
              const float rs1 = 1.f / sqrtf(wave_sum(q1) * (1.f / DM) + LN_EPS);
#pragma unroll
              for (int j = 0; j < 4; ++j) { const int c = 4 * F.lane + 256 * j; xc[rr][j] = v[j] * rs1 * *(const f32x4*)(g1 + c) + *(const f32x4*)(b1 + c); } }
#pragma unroll
            for (int j = 0; j < 4; ++j) { v[j] = xc[rr][j] * DN_ALPHA; const u32x2 p = pc[rr][j], q = qc[rr][j];
                v[j].x += bf2f(p.x & 0xffff) + bf2f(q.x & 0xffff); v[j].y += bf2f(p.x >> 16) + bf2f(q.x >> 16); v[j].z += bf2f(p.y & 0xffff) + bf2f(q.y & 0xffff); v[j].w += bf2f(p.y >> 16) + bf2f(q.y >> 16);
                s += (v[j].x + v[j].y) + (v[j].z + v[j].w); }
            const float mean = wave_sum(s) * (1.f / DM); float s2 = 0.f;
#pragma unroll
            for (int j = 0; j < 4; ++j) { v[j] = v[j] - mean; s2 += (v[j].x * v[j].x + v[j].y * v[j].y) + (v[j].z * v[j].z + v[j].w * v[j].w); }
            const float rs = 1.f / sqrtf(wave_sum(s2) * (1.f / DM) + LN_EPS);
#pragma unroll
            for (int j = 0; j < 4; ++j) { const int c = 4 * F.lane + 256 * j; const f32x4 gg = *(const f32x4*)(g + c), bv = *(const f32x4*)(bb + c); v[j] = v[j] * rs * gg + bv;
                *((f32x4*)xr + F.lane + 64 * j) = v[j]; u32x2 w; w.x = pk2(v[j].x, v[j].y); w.y = pk2(v[j].z, v[j].w); *((u32x2*)(XB + (size_t)m * DM) + F.lane + 64 * j) = w; }
        } }
    }
#undef LN2_LOAD
}
__device__ __forceinline__ void moe_convert(Frame& F, const Args& a, int layer) {
    LAS float* scr = (LAS float*)(F.lds + F.wave * 16384);
    constexpr int I_13 = (1024 / 64) * (1024 / 32), I_2 = (512 / 64) * (1024 / 32), PER_E = I_13 + I_2;
    for (int it = F.gw; it < NEXP * PER_E; it += F.NGW) {
        const int e = it / PER_E; int r = it - e * PER_E; const size_t le = (size_t)layer * NEXP + e;
        if (r < I_13) { const int kb = r / 32, nb = r % 32; const float* src = ((nb >> 2) & 1) ? a.moe_w3 : a.moe_w1;
            const int sc0 = ((32 * nb) >> 8) * 128 + ((32 * nb) & 127);
            transpose_item_v4(src + le * 1024 * 512 + (size_t)(kb * 64) * 512 + sc0, 512, (bf16_t*)(F.ws + WS_W13) + (size_t)e * 1024 * 1024 + (size_t)(nb * 32) * 1024 + kb * 64, 1024, scr, F.lane); }
        else { r -= I_13; const int kb = r / 32, nb = r % 32;
            transpose_item_v4(a.moe_w2 + le * 512 * 1024 + (size_t)(kb * 64) * 1024 + nb * 32, 1024, (bf16_t*)(F.ws + WS_W2) + (size_t)e * 1024 * 512 + (size_t)(nb * 32) * 512 + kb * 64, 512, scr, F.lane); }
    }
}

typedef short at_s16x4 __attribute__((ext_vector_type(4)));
typedef LAS const unsigned char* at_lds_cptr;
__device__ __forceinline__ at_s16x4 at_vtr(at_lds_cptr p) { return __builtin_bit_cast(at_s16x4, __builtin_amdgcn_ds_read_tr16_b64_v4i16((LAS at_s16x4*)p)); }
struct RowSrc { const bf16_t* p; long pitch; };
constexpr int SA_P = 0, SA_V = 4096, SA_AL = 12288, SA_RL = 12544;
template <int NC0, int NC1, int MODE>
__device__ __forceinline__ void sattn_core(const bf16x8* qf, RowSrc k0, RowSrc k1, RowSrc vs, int kb_lo, int kb_hi, int qidx0, float lse_ref, LAS unsigned char* scr, int lane, f32x16* o, float& lse_out) {
    const int r32 = lane & 31, hi = lane >> 5;
    LAS bf16_t* Pb = (LAS bf16_t*)(scr + SA_P); LAS bf16_t* Vb = (LAS bf16_t*)(scr + SA_V); LAS float* Al = (LAS float*)(scr + SA_AL);
    float m = -1.0e30f, l = 0.f;
    if (MODE != 1) { o[0] = f32x16{}; o[1] = f32x16{}; }
    bf16x8 kn[NC0 + NC1]; u32x4 vn[4];
#define SA_LOAD(kb_) do { const long key_ = (long)(kb_) * 32 + r32; \
        _Pragma("unroll") for (int c = 0; c < NC0; ++c) kn[c] = *(const bf16x8*)(k0.p + key_ * k0.pitch + 16 * c + 8 * hi); \
        _Pragma("unroll") for (int c = 0; c < NC1; ++c) kn[NC0 + c] = *(const bf16x8*)(k1.p + key_ * k1.pitch + 16 * c + 8 * hi); \
        if (MODE != 1) { _Pragma("unroll") for (int i = 0; i < 4; ++i) { const int idx = i * 64 + lane, kr = idx >> 3, pc = idx & 7; vn[i] = *(const u32x4*)(vs.p + ((long)(kb_) * 32 + kr) * vs.pitch + pc * 8); } } } while (0)
    if (kb_lo < kb_hi) SA_LOAD(kb_lo);
    const at_lds_cptr vtb = (at_lds_cptr)(scr + SA_V) + ((8 * hi + ((lane & 15) >> 2)) * 72 + 16 * ((lane >> 4) & 1) + 4 * (lane & 3)) * 2;
    for (int kb = kb_lo; kb < kb_hi; ++kb) {
        bf16x8 kc[NC0 + NC1]; u32x4 vc[4];
#pragma unroll
        for (int c = 0; c < NC0 + NC1; ++c) kc[c] = kn[c];
#pragma unroll
        for (int i = 0; i < 4; ++i) vc[i] = vn[i];
        if (kb + 1 < kb_hi) SA_LOAD(kb + 1);
        f32x16 s = {};
#pragma unroll
        for (int c = 0; c < NC0 + NC1; ++c) s = MFMA32(kc[c], qf[c], s);
        bool valid[16];
#pragma unroll
        for (int r = 0; r < 16; ++r) { if (MODE == 0) valid[r] = true; else { const int d = kb * 32 + crow(r, hi) - (qidx0 + r32); valid[r] = (d <= 64 && d >= -64); } }
        float p[16];
        if (MODE == 2) {
#pragma unroll
            for (int r = 0; r < 16; ++r) p[r] = valid[r] ? fast_exp2(s[r] - lse_ref) : 0.f;
        } else {
            float mx = -1.0e30f;
#pragma unroll
            for (int r = 0; r < 16; ++r) if (valid[r]) mx = fmaxf(mx, s[r]);
            mx = xmax32(mx);
            const float mn = fmaxf(m, mx), alpha = fast_exp2(m - mn); m = mn;
            float ps = 0.f;
#pragma unroll
            for (int r = 0; r < 16; ++r) { p[r] = valid[r] ? fast_exp2(s[r] - mn) : 0.f; ps += p[r]; }
            l = l * alpha + ps;
            if (MODE == 0) { if (hi == 0) Al[r32] = alpha; }
        }
        if (MODE != 1) {
#pragma unroll
            for (int g = 0; g < 4; ++g) { u32x2 w; w.x = pk2(p[4 * g], p[4 * g + 1]); w.y = pk2(p[4 * g + 2], p[4 * g + 3]); *(LAS u32x2*)(Pb + r32 * 40 + 8 * g + 4 * hi) = w; }
#pragma unroll
            for (int i = 0; i < 4; ++i) { const int idx = i * 64 + lane, kr = idx >> 3, pc = idx & 7; *(LAS u32x4*)(Vb + kr * 72 + pc * 8) = vc[i]; }
            LDS_WAIT();
            if (MODE == 0) {
#pragma unroll
                for (int r = 0; r < 16; ++r) { const float al = Al[crow(r, hi)]; o[0][r] *= al; o[1][r] *= al; }
            }
#pragma unroll
            for (int st = 0; st < 2; ++st) {
                const bf16x8 pf = *(const LAS bf16x8*)(Pb + r32 * 40 + 16 * st + 8 * hi);
#pragma unroll
                for (int db = 0; db < 2; ++db) {
                    const at_s16x4 lo_ = at_vtr(vtb + (16 * st * 72 + 32 * db) * 2), hi_ = at_vtr(vtb + ((16 * st + 4) * 72 + 32 * db) * 2);
                    const bf16x8 vf = {lo_[0], lo_[1], lo_[2], lo_[3], hi_[0], hi_[1], hi_[2], hi_[3]};
                    o[db] = MFMA32(pf, vf, o[db]); }
            }
            LDS_WAIT();
        }
    }
#undef SA_LOAD
    if (MODE != 2) { l = xsum32(l); lse_out = m + __log2f(l); }
    if (MODE == 0) {
        LAS float* Rl = (LAS float*)(scr + SA_RL);
        if (hi == 0) Rl[r32] = 1.0f / l;
        LDS_WAIT();
#pragma unroll
        for (int r = 0; r < 16; ++r) { const float rl = Rl[crow(r, hi)]; o[0][r] *= rl; o[1][r] *= rl; }
        LDS_WAIT();
    }
}

__device__ __forceinline__ void sattn_phase(Frame& F, const Args& a, int layer, int kind_lo) {
    const bf16_t* H = (const bf16_t*)(F.ws + WS_H); const bf16_t* QB = (const bf16_t*)(F.ws + WS_QB); const bf16_t* KVB = (const bf16_t*)(F.ws + WS_KVB);
    bf16_t* MIX = (bf16_t*)(F.ws + WS_MIX); const float* lsec = (const float*)(F.ws + WS_LSEC);
    LAS unsigned char* scr = F.lds + F.wave * 16384;
    const int lane = F.lane, r32 = lane & 31, hi = lane >> 5;
    float lam, lam_init;
    { const float* lv = a.diff_lambda + layer * 128; float d1 = 0.f, d2 = 0.f;
      for (int i = 0; i < 32; ++i) { d1 += lv[i] * lv[32 + i]; d2 += lv[64 + i] * lv[96 + i]; }
      lam_init = 0.8f - 0.6f * expf(-0.3f * (float)layer); lam = expf(d1) - expf(d2) + lam_init; }
    constexpr int NRB = NTOK / 32;
    const int items = NRB * (4 + 6 + 6);
    for (int it = kind_lo * NRB + F.gw; it < items; it += F.NGW) {
        const int kind = it / NRB, rb = it - kind * NRB; const int m0 = rb * 32; const SeqInfo si = seqinfo(m0);
#if !OPT_ATTN
        if (kind < 4) {
            const int h = kind; f32x16 o0[2], o1[2]; float dummy;
            for (int c = 0; c < 2; ++c) {
                bf16x8 qf[2];
#pragma unroll
                for (int d0 = 0; d0 < 2; ++d0) qf[d0] = *(const bf16x8*)(H + (size_t)(m0 + r32) * HP + HC_AQ + h * 64 + c * 32 + 16 * d0 + 8 * hi);
                const RowSrc ks{H + (size_t)si.base * HP + HC_AK + h * 64 + c * 32, HP}, vs{H + (size_t)si.base * HP + HC_AV + h * 64, HP};
                sattn_core<2, 0, 0>(qf, ks, ks, vs, 0, si.len / 32, 0, 0.f, scr, lane, c == 0 ? o0 : o1, dummy);
            }
            const float* sg = a.diff_subln + layer * 64; const float g0 = sg[r32], g1 = sg[32 + r32];
#pragma unroll
            for (int r = 0; r < 16; ++r) { const float x0 = o0[0][r] - lam * o1[0][r], x1 = o0[1][r] - lam * o1[1][r]; float ss = x0 * x0 + x1 * x1;
                ss += shx<1>(ss); ss += shx<2>(ss); ss += shx<4>(ss); ss += shx<8>(ss); ss += shx<16>(ss);
                const float rs = (1.0f - lam_init) / sqrtf(ss * (1.0f / 64.0f) + RMS_EPS);
                bf16_t* op = MIX + (size_t)(m0 + crow(r, hi)) * DM + MIX_A + h * 64 + r32;
                op[0] = (bf16_t)f2bf(x0 * rs * g0); op[32] = (bf16_t)f2bf(x1 * rs * g1); }
        } else if (kind < 10) {
            const int h = kind - 4; f32x16 o[2]; float dummy; bf16x8 qf[6];
#pragma unroll
            for (int d0 = 0; d0 < 6; ++d0) qf[d0] = *(const bf16x8*)(QB + (size_t)(m0 + r32) * QBP + h * 96 + 16 * d0 + 8 * hi);
            const RowSrc k0{KVB + (size_t)si.base * KVP + h * 128, KVP}, k1{H + (size_t)si.base * HP + HC_KROPE, HP}, vs{KVB + (size_t)si.base * KVP + h * 128 + 64, KVP};
            sattn_core<4, 2, 0>(qf, k0, k1, vs, 0, si.len / 32, 0, 0.f, scr, lane, o, dummy);
#pragma unroll
            for (int r = 0; r < 16; ++r) { bf16_t* op = MIX + (size_t)(m0 + crow(r, hi)) * DM + MIX_B + h * 64 + r32; op[0] = (bf16_t)f2bf(o[0][r]); op[32] = (bf16_t)f2bf(o[1][r]); }
        } else
#endif
        {
            const int gj = kind - 10, g = gj >> 1, hh = gj;
            const int dil = (g == 0) ? 1 : (g == 1 ? 4 : 16); const int L = si.len / dil, bpr = L / 32;
            const int w = (m0 - si.base) / 32, rho = w / bpr, ib = w - rho * bpr, i0 = ib * 32;
            const size_t qrow = (size_t)si.base + (size_t)(i0 + r32) * dil + rho;
            bf16x8 qf[4];
#pragma unroll
            for (int d0 = 0; d0 < 4; ++d0) qf[d0] = *(const bf16x8*)(H + qrow * HP + HC_CQ + hh * 64 + 16 * d0 + 8 * hi);
            const int j = gj & 1; const float l0 = lsec[(0 * (size_t)NTOK + qrow) * 2 + j], l1 = lsec[(1 * (size_t)NTOK + qrow) * 2 + j], l2 = lsec[(2 * (size_t)NTOK + qrow) * 2 + j];
            const float lm = fmaxf(l0, fmaxf(l1, l2)); const float lref = lm + __log2f(fast_exp2(l0 - lm) + fast_exp2(l1 - lm) + fast_exp2(l2 - lm));
            const RowSrc ks{H + ((size_t)si.base + rho) * HP + HC_CK + hh * 64, (long)HP * dil}, vs{H + ((size_t)si.base + rho) * HP + HC_CV + hh * 64, (long)HP * dil};
            int kb_lo = ib - 2, kb_hi = ib + 3; if (kb_lo < 0) kb_lo = 0; if (kb_hi > bpr) kb_hi = bpr;
            f32x16 o[2]; float dummy;
            sattn_core<4, 0, 2>(qf, ks, ks, vs, kb_lo, kb_hi, i0, lref, scr, lane, o, dummy);
#pragma unroll
            for (int r = 0; r < 16; ++r) { const size_t orow = (size_t)si.base + (size_t)(i0 + crow(r, hi)) * dil + rho; bf16_t* op = MIX + orow * DM + MIX_C + hh * 64 + r32; op[0] = (bf16_t)f2bf(o[0][r]); op[32] = (bf16_t)f2bf(o[1][r]); }
        }
    }
}
__device__ __forceinline__ void cstat_phase(Frame& F) {
    const bf16_t* H = (const bf16_t*)(F.ws + WS_H); float* lsec = (float*)(F.ws + WS_LSEC);
    LAS unsigned char* scr = F.lds + F.wave * 16384;
    const int lane = F.lane, r32 = lane & 31, hi = lane >> 5;
    constexpr int NRB = NTOK / 32;
    for (int it = F.gw; it < NRB * 6; it += F.NGW) {
        const int gj = it / NRB, rb = it - gj * NRB, g = gj >> 1, j = gj & 1; const int m0 = rb * 32; const SeqInfo si = seqinfo(m0);
        const int dil = (g == 0) ? 1 : (g == 1 ? 4 : 16); const int L = si.len / dil, bpr = L / 32;
        const int w = (m0 - si.base) / 32, rho = w / bpr, ib = w - rho * bpr, i0 = ib * 32;
        const size_t qrow = (size_t)si.base + (size_t)(i0 + r32) * dil + rho;
        bf16x8 qf[4];
#pragma unroll
        for (int d0 = 0; d0 < 4; ++d0) qf[d0] = *(const bf16x8*)(H + qrow * HP + HC_CQ + gj * 64 + 16 * d0 + 8 * hi);
        const RowSrc ks{H + ((size_t)si.base + rho) * HP + HC_CK + gj * 64, (long)HP * dil};
        int kb_lo = ib - 2, kb_hi = ib + 3; if (kb_lo < 0) kb_lo = 0; if (kb_hi > bpr) kb_hi = bpr;
        float lse; sattn_core<4, 0, 1>(qf, ks, ks, ks, kb_lo, kb_hi, i0, 0.f, scr, lane, nullptr, lse);
        if (hi == 0) lsec[((size_t)g * NTOK + qrow) * 2 + j] = lse;
    }
}


namespace at {
typedef short s16x4 __attribute__((ext_vector_type(4)));
typedef short v4i16_t __attribute__((ext_vector_type(4)));
typedef LAS const unsigned char* lds_cptr;
constexpr int LDS_K = 0, KSLOT_MAX = 12288, LDS_V = 3 * KSLOT_MAX, VSLOT = 8192, LDS_WS = LDS_V + 3 * VSLOT, LDS_OST = LDS_WS + 8 * 256, LDS_TOTAL = LDS_OST + 8 * 8192;
static_assert(LDS_TOTAL <= RING_BYTES, "attention LDS");
constexpr float THR = 8.0f;
__device__ __forceinline__ void glds16(const void* g, unsigned lds_dst) {
    unsigned keep; asm volatile("s_mov_b32 %0, m0\n\ts_mov_b32 m0, %2\n\ts_nop 0\n\tglobal_load_lds_dwordx4 %1, off\n\ts_mov_b32 m0, %0" : "=&s"(keep) : "v"(g), "s"(lds_dst) : "memory"); }
__device__ __forceinline__ s16x4 vtr(lds_cptr p) { return __builtin_bit_cast(s16x4, __builtin_amdgcn_ds_read_tr16_b64_v4i16((LAS v4i16_t*)p)); }
__device__ __forceinline__ unsigned cvtpk(float lo, float hi) { typedef float f2 __attribute__((ext_vector_type(2))); typedef __bf16 b2 __attribute__((ext_vector_type(2))); f2 v = {lo, hi}; b2 b = __builtin_convertvector(v, b2); return __builtin_bit_cast(unsigned, b); }
#define AT_MX3(a, b, c) __builtin_fmaxf(__builtin_fmaxf((a), (b)), (c))
__device__ __forceinline__ float rowmax(const f32x16& p0, const f32x16& p1) {
    float a = AT_MX3(p0[0], p0[1], p1[0]), b = AT_MX3(p0[2], p0[3], p1[1]); a = AT_MX3(a, p1[2], p1[3]);
#pragma unroll
    for (int r = 4; r < 16; r += 4) { a = AT_MX3(a, p0[r], p0[r + 1]); b = AT_MX3(b, p0[r + 2], p0[r + 3]); a = AT_MX3(a, p1[r], p1[r + 1]); b = AT_MX3(b, p1[r + 2], p1[r + 3]); }
    float m = __builtin_fmaxf(a, b); auto rr = __builtin_amdgcn_permlane32_swap(__float_as_uint(m), __float_as_uint(m), false, false);
    return __builtin_fmaxf(__uint_as_float(rr[0]), __uint_as_float(rr[1])); }
#define AT_WAIT_BAR(N) asm volatile("s_waitcnt vmcnt(" #N ") lgkmcnt(0)\n\ts_barrier" ::: "memory")

struct Src { const bf16_t* p; long pitch; };
template <int NC, int NK0, int NK1>
__device__ __forceinline__ void stream(LAS unsigned char* lds, int tid, const bf16_t* qrow, Src k0, Src k1, Src vs, int NT, f32x16& o0, f32x16& o1, float& lsum) {
    asm volatile("" : "+v"(tid));
    constexpr int SLOTK = 2 * NC * 1024;
    const int lane = tid & 63, r32 = lane & 31, hi = lane >> 5; const int wid = __builtin_amdgcn_readfirstlane(tid >> 6);
    const unsigned lds0 = (unsigned)(uintptr_t)lds;
    LAS float* wsf = (LAS float*)(lds + LDS_WS) + wid * 64;
    constexpr int P0 = NK0 * 16;
    const bool hasA = (NK0 == 8) || (wid < 4), hasB = (NK1 > 0) && (wid < 4);
    const int pA = (NK0 == 8) ? wid : (wid & 3);
    const int rowA = (NK0 == 8) ? pA * 8 + (lane >> 3) : pA * 16 + (lane >> 2);
    const int chA = (NK0 == 8) ? ((lane & 7) ^ ((lane >> 3) & 7)) : ((lane & 3) ^ ((lane >> 4) & 3));
    const bf16_t* ksA = k0.p + (long)rowA * k0.pitch + chA * 8;
    const int rowB = (wid & 3) * 16 + (lane >> 2), chB = (lane & 3) ^ ((lane >> 4) & 3);
    const bf16_t* ksB = (NK1 > 0) ? k1.p + (long)rowB * k1.pitch + chB * 8 : k0.p;
    const bf16_t* vsp = vs.p + (long)(16 * (wid & 3) + (lane >> 2)) * vs.pitch + (wid >> 2) * 32 + (lane & 3) * 8;
    const unsigned kdA = lds0 + LDS_K + pA * 1024, kdB = lds0 + LDS_K + (NK0 + (wid & 3)) * 1024, vd = lds0 + LDS_V + wid * 1024;
    const long ktA = 64 * k0.pitch, ktB = 64 * k1.pitch, vt = 64 * vs.pitch;
    const int nd = (hasA ? 1 : 0) + (hasB ? 1 : 0) + 1;
#define AT_DMA_K(t, slot) do { if (hasA) glds16(ksA + (long)(t) * ktA, (unsigned)__builtin_amdgcn_readfirstlane(kdA + (slot) * SLOTK)); if (hasB) glds16(ksB + (long)(t) * ktB, (unsigned)__builtin_amdgcn_readfirstlane(kdB + (slot) * SLOTK)); } while (0)
#define AT_DMA_V(t, slot) glds16(vsp + (long)(t) * vt, (unsigned)__builtin_amdgcn_readfirstlane(vd + (slot) * VSLOT))
    lds_cptr kb[NC];
#pragma unroll
    for (int d0 = 0; d0 < NC; ++d0) { const int c = 2 * d0 + hi;
        if (2 * d0 < NK0) kb[d0] = (lds_cptr)lds + LDS_K + r32 * P0 + ((NK0 == 8) ? (c ^ (r32 & 7)) : (c ^ ((r32 >> 2) & 3))) * 16;
        else kb[d0] = (lds_cptr)lds + LDS_K + NK0 * 1024 + r32 * 64 + ((c - NK0) ^ ((r32 >> 2) & 3)) * 16; }
    const lds_cptr vp0 = (lds_cptr)lds + LDS_V + ((lane >> 4) & 1) * 32 + (lane & 3) * 8 + (4 * hi + ((lane & 15) >> 2)) * 64;
    AT_DMA_K(0, 0); AT_DMA_V(0, 0); if (NT > 1) AT_DMA_K(1, 1);
    bf16x8 qr[NC];
#pragma unroll
    for (int d0 = 0; d0 < NC; ++d0) qr[d0] = *(const bf16x8*)(qrow + 16 * d0 + 8 * hi);
    float mhat = 0.f, l = 0.f; f32x16 oa = {}, ob = {}, negm = {}, S0, S1; u32x4 pw0, pw1, pw2, pw3;
    asm volatile("" : "+v"(negm));
    AT_WAIT_BAR(0);
    __builtin_amdgcn_s_waitcnt(0);
#pragma unroll
    for (int d0 = 0; d0 < NC; ++d0) asm volatile("" : "+v"(qr[d0]));
    constexpr bool QLDS = (NC > 2);
    const lds_cptr qb = (lds_cptr)lds + LDS_OST + wid * 8192 + lane * 16;
    if (QLDS) {
#pragma unroll
        for (int d0 = 0; d0 < NC; ++d0) *(LAS bf16x8*)(lds + LDS_OST + wid * 8192 + lane * 16 + d0 * 1024) = qr[d0];
        LDS_WAIT();
    }
    int kc = 0, kn1 = 1, kn2 = 2, vpv = 2, vcu = 0, vnx = 1;
    bf16x8 kf[2 * NC], vf[8];
#define AT_SB() __builtin_amdgcn_sched_barrier(0)
#define AT_KRD(so_, d0) do { kf[2 * (d0)] = *(const LAS bf16x8*)(kb[d0] + (so_)); kf[2 * (d0) + 1] = *(const LAS bf16x8*)(kb[d0] + (so_) + 32 * ((2 * (d0) < NK0) ? P0 : 64)); if (QLDS) qr[d0] = *(const LAS bf16x8*)(qb + (d0) * 1024); } while (0)
#define AT_KHEAD(slot) do { const int kp_ = (slot) * SLOTK; AT_KRD(kp_, 0); } while (0)
#define AT_VF(i) ({ const s16x4 lo_ = vtr(vp_ + (((i) >> 2) * 4096 + ((i) & 3) * 1024)), hi_ = vtr(vp_ + (((i) >> 2) * 4096 + ((i) & 3) * 1024 + 512)); (bf16x8){lo_[0], lo_[1], lo_[2], lo_[3], hi_[0], hi_[1], hi_[2], hi_[3]}; })
#define AT_VHEAD(slot) do { const lds_cptr vp_ = vp0 + (slot) * VSLOT; vf[0] = AT_VF(0); vf[4] = AT_VF(4); } while (0)
#define AT_QKM(slot) do { const int kp_ = (slot) * SLOTK; \
        _Pragma("unroll") for (int d0 = 0; d0 < NC; ++d0) { if (d0 + 1 < NC) AT_KRD(kp_, d0 + 1); \
            if (d0 == 0) { S0 = MFMA32(kf[0], qr[0], negm); S1 = MFMA32(kf[1], qr[0], negm); } else { S0 = MFMA32(kf[2 * d0], qr[d0], S0); S1 = MFMA32(kf[2 * d0 + 1], qr[d0], S1); } AT_SB(); } } while (0)
#define AT_PVM(slot) do { const lds_cptr vp_ = vp0 + (slot) * VSLOT; \
        vf[1] = AT_VF(1); vf[5] = AT_VF(5); oa = MFMA32(__builtin_bit_cast(bf16x8, pw0), vf[0], oa); ob = MFMA32(__builtin_bit_cast(bf16x8, pw0), vf[4], ob); AT_SB(); \
        vf[2] = AT_VF(2); vf[6] = AT_VF(6); oa = MFMA32(__builtin_bit_cast(bf16x8, pw1), vf[1], oa); ob = MFMA32(__builtin_bit_cast(bf16x8, pw1), vf[5], ob); AT_SB(); \
        vf[3] = AT_VF(3); vf[7] = AT_VF(7); oa = MFMA32(__builtin_bit_cast(bf16x8, pw2), vf[2], oa); ob = MFMA32(__builtin_bit_cast(bf16x8, pw2), vf[6], ob); AT_SB(); \
        oa = MFMA32(__builtin_bit_cast(bf16x8, pw3), vf[3], oa); ob = MFMA32(__builtin_bit_cast(bf16x8, pw3), vf[7], ob); AT_SB(); } while (0)
    bool resc = false; u32x4 qw0, qw1, qw2, qw3; float sacc = 0.f;
#define AT_PIN(x) asm volatile("" : "+v"(x))
#define AT_DECIDE(first) do { const float rm_ = rowmax(S0, S1); resc = false; \
        if ((first) || __any(rm_ > THR)) { const float dl_ = (first) ? rm_ : __builtin_fmaxf(rm_, 0.f); mhat += dl_; \
            _Pragma("unroll") for (int r = 0; r < 16; ++r) { S0[r] -= dl_; S1[r] -= dl_; negm[r] = -mhat; } asm volatile("" : "+v"(negm)); \
            if (!(first)) { const float f_ = fast_exp2(-dl_); l *= f_; if (hi == 0) wsf[r32] = f_; resc = true; } } } while (0)
#define AT_RESC() do { if (resc) { LDS_WAIT(); \
        _Pragma("unroll") for (int r = 0; r < 16; ++r) { const float g_ = wsf[crow(r, hi)]; oa[r] *= g_; ob[r] *= g_; } LDS_WAIT(); } } while (0)
#define AT_EXP8(S, b, Q) do { \
        _Pragma("unroll") for (int r = 0; r < 8; ++r) S[(b) + r] = fast_exp2(S[(b) + r]); \
        sacc += (S[(b)] + S[(b) + 1]) + (S[(b) + 2] + S[(b) + 3]); sacc += (S[(b) + 4] + S[(b) + 5]) + (S[(b) + 6] + S[(b) + 7]); \
        Q = (u32x4){cvtpk(S[(b)], S[(b) + 1]), cvtpk(S[(b) + 2], S[(b) + 3]), cvtpk(S[(b) + 4], S[(b) + 5]), cvtpk(S[(b) + 6], S[(b) + 7])}; AT_PIN(Q); AT_PIN(sacc); } while (0)
#define AT_EXPALL() do { sacc = 0.f; AT_EXP8(S0, 0, qw0); AT_EXP8(S0, 8, qw1); AT_EXP8(S1, 0, qw2); AT_EXP8(S1, 8, qw3); l += sacc; pw0 = qw0; pw1 = qw1; pw2 = qw2; pw3 = qw3; } while (0)
#define AT_PV_EXP(slot) do { const lds_cptr vp_ = vp0 + (slot) * VSLOT; sacc = 0.f; \
        vf[1] = AT_VF(1); vf[5] = AT_VF(5); oa = MFMA32(__builtin_bit_cast(bf16x8, pw0), vf[0], oa); ob = MFMA32(__builtin_bit_cast(bf16x8, pw0), vf[4], ob); AT_EXP8(S0, 0, qw0); AT_SB(); \
        vf[2] = AT_VF(2); vf[6] = AT_VF(6); oa = MFMA32(__builtin_bit_cast(bf16x8, pw1), vf[1], oa); ob = MFMA32(__builtin_bit_cast(bf16x8, pw1), vf[5], ob); AT_EXP8(S0, 8, qw1); AT_SB(); \
        vf[3] = AT_VF(3); vf[7] = AT_VF(7); oa = MFMA32(__builtin_bit_cast(bf16x8, pw2), vf[2], oa); ob = MFMA32(__builtin_bit_cast(bf16x8, pw2), vf[6], ob); AT_EXP8(S1, 0, qw2); AT_SB(); \
        oa = MFMA32(__builtin_bit_cast(bf16x8, pw3), vf[3], oa); ob = MFMA32(__builtin_bit_cast(bf16x8, pw3), vf[7], ob); AT_EXP8(S1, 8, qw3); AT_SB(); \
        l += sacc; } while (0)
#define AT_STEP_WAIT(t) do { if ((t) + 2 < NT) { if (nd == 3) AT_WAIT_BAR(3); else if (nd == 2) AT_WAIT_BAR(2); else AT_WAIT_BAR(1); } else AT_WAIT_BAR(0); } while (0)
#define AT_ROT() do { const int a_ = kc; kc = kn1; kn1 = kn2; kn2 = a_; const int b_ = vpv; vpv = vcu; vcu = vnx; vnx = b_; } while (0)
    AT_DMA_K(2, kn2); AT_DMA_V(1, vnx);
    AT_KHEAD(kc); AT_SB();
    AT_QKM(kc); AT_DECIDE(true); AT_EXPALL();
    AT_STEP_WAIT(0); AT_ROT();
    for (int t = 1; t < NT; ++t) {
        if (t + 2 < NT) AT_DMA_K(t + 2, kn2);
        if (t + 1 < NT) AT_DMA_V(t + 1, vnx);
        AT_KHEAD(kc); AT_VHEAD(vpv); AT_SB();
        AT_QKM(kc);
        AT_DECIDE(false); AT_SB();
        AT_PV_EXP(vpv);
        AT_RESC();
        pw0 = qw0; pw1 = qw1; pw2 = qw2; pw3 = qw3;
        AT_STEP_WAIT(t); AT_ROT();
    }
    AT_VHEAD(vpv); AT_SB(); AT_PVM(vpv);
    { auto rr = __builtin_amdgcn_permlane32_swap(__float_as_uint(l), __float_as_uint(l), false, false); l = __uint_as_float(rr[0]) + __uint_as_float(rr[1]); }
    o0 = oa; o1 = ob; lsum = l;
#undef AT_DMA_K
#undef AT_DMA_V
#undef AT_SB
#undef AT_KRD
#undef AT_KHEAD
#undef AT_VF
#undef AT_VHEAD
#undef AT_QKM
#undef AT_PVM
#undef AT_PIN
#undef AT_DECIDE
#undef AT_RESC
#undef AT_EXP8
#undef AT_EXPALL
#undef AT_PV_EXP
#undef AT_STEP_WAIT
#undef AT_ROT
}
__device__ __forceinline__ void normalise(LAS unsigned char* lds, int tid, f32x16& o0, f32x16& o1, float lsum) {
    const int lane = tid & 63, r32 = lane & 31, hi = lane >> 5; const int wid = __builtin_amdgcn_readfirstlane(tid >> 6);
    LAS float* wsf = (LAS float*)(lds + LDS_WS) + wid * 64;
    if (hi == 0) wsf[32 + r32] = 1.0f / lsum; LDS_WAIT();
#pragma unroll
    for (int r = 0; r < 16; ++r) { const float g = wsf[32 + crow(r, hi)]; o0[r] *= g; o1[r] *= g; }
    LDS_WAIT();
}
}

struct AttnUnitId { int kind, seq, head, qb; };
__device__ __forceinline__ bool attn_unit_at(int i, int G, int bid, AttnUnitId& u) {
    const long L = (long)i * G + bid; if (L >= 2560) return false; int o = (int)L;
    int kind, longs, nh;
    if (o < 512) { kind = 0; longs = 1; nh = 4; } else if (o < 1024) { kind = 0; longs = 0; nh = 4; o -= 512; } else if (o < 1792) { kind = 1; longs = 1; nh = 6; o -= 1024; } else { kind = 1; longs = 0; nh = 6; o -= 1792; }
    const int nqb = longs ? 16 : 8;
    int pair, qb;
    if (G == 256) { const int rnd = o >> 8, b = o & 255, x = b & 7, c = b >> 3;
        const int ppr = 32 / nqb; pair = x + 8 * (rnd * ppr + c / nqb); qb = c % nqb; }
    else { pair = o / nqb; qb = o % nqb; }
    u.kind = kind; u.head = pair % nh; const int sq = pair / nh; u.seq = longs ? 16 + sq : sq; u.qb = qb; return true;
}
__device__ __forceinline__ void attn_ab_phase(Frame& F, const Args& a, int layer, int kmask = 3) {
    const bf16_t* H = (const bf16_t*)(F.ws + WS_H); const bf16_t* QB = (const bf16_t*)(F.ws + WS_QB); const bf16_t* KVB = (const bf16_t*)(F.ws + WS_KVB);
    bf16_t* MIX = (bf16_t*)(F.ws + WS_MIX);
    const int wid = F.wave;
    float lam, lam_init;
    { const float* lv = a.diff_lambda + layer * 128; float d1 = 0.f, d2 = 0.f;
      for (int i = 0; i < 32; ++i) { d1 += lv[i] * lv[32 + i]; d2 += lv[64 + i] * lv[96 + i]; }
      lam_init = 0.8f - 0.6f * expf(-0.3f * (float)layer); lam = expf(d1) - expf(d2) + lam_init;
      lam = __uint_as_float(__builtin_amdgcn_readfirstlane(__float_as_uint(lam))); lam_init = __uint_as_float(__builtin_amdgcn_readfirstlane(__float_as_uint(lam_init))); }
    AttnUnitId u;
    for (int i = 0; attn_unit_at(i, F.G, F.bid, u); ++i) {
        if (!((kmask >> u.kind) & 1)) continue;
        int tid = F.tid; asm volatile("" : "+v"(tid)); const int lane = tid & 63, r32 = lane & 31, hi = lane >> 5;
        const int len = (u.seq < 16) ? 2048 : 4096, base = (u.seq < 16) ? u.seq * 2048 : NTOK_P + (u.seq - 16) * 4096, NT = len / 64;
        const int m0 = base + u.qb * 256 + wid * 32;
        LAS bf16_t* sb = (LAS bf16_t*)(F.lds + at::LDS_OST + wid * 8192);
        LAS float* sf = (LAS float*)sb;
        if (u.kind == 0) {
            f32x16 q0, q1; float ls;
            { f32x16 p0, p1; const at::Src ks{H + (size_t)base * HP + HC_AK + u.head * 64, HP}, vs{H + (size_t)base * HP + HC_AV + u.head * 64, HP};
              at::stream<2, 4, 0>(F.lds, tid, H + (size_t)(m0 + r32) * HP + HC_AQ + u.head * 64, ks, ks, vs, NT, p0, p1, ls); at::normalise(F.lds, tid, p0, p1, ls);
#pragma unroll
              for (int r = 0; r < 16; ++r) { const int row = crow(r, hi); sf[row * 64 + r32] = p0[r]; sf[row * 64 + 32 + r32] = p1[r]; }
              AT_WAIT_BAR(0); }
            { const at::Src ks{H + (size_t)base * HP + HC_AK + u.head * 64 + 32, HP}, vs{H + (size_t)base * HP + HC_AV + u.head * 64, HP};
              at::stream<2, 4, 0>(F.lds, tid, H + (size_t)(m0 + r32) * HP + HC_AQ + u.head * 64 + 32, ks, ks, vs, NT, q0, q1, ls); at::normalise(F.lds, tid, q0, q1, ls); }
            float xa[16], xb[16];
#pragma unroll
            for (int r = 0; r < 16; ++r) { const int row = crow(r, hi); xa[r] = sf[row * 64 + r32] - lam * q0[r]; xb[r] = sf[row * 64 + 32 + r32] - lam * q1[r]; }
            LDS_WAIT();
            const float* sg = a.diff_subln + layer * 64; const float g0 = sg[r32] * (1.0f - lam_init), g1 = sg[32 + r32] * (1.0f - lam_init);
#pragma unroll
            for (int r = 0; r < 16; ++r) { const float x0 = xa[r], x1 = xb[r]; float ss = x0 * x0 + x1 * x1;
                ss += shx<1>(ss); ss += shx<2>(ss); ss += shx<4>(ss); ss += shx<8>(ss); ss += shx<16>(ss);
                const float rs = 1.0f / sqrtf(ss * (1.0f / 64.0f) + RMS_EPS); const int row = crow(r, hi);
                sb[row * 64 + r32] = (bf16_t)f2bf(x0 * rs * g0); sb[row * 64 + 32 + r32] = (bf16_t)f2bf(x1 * rs * g1); }
            LDS_WAIT();
#pragma unroll
            for (int it = 0; it < 4; ++it) { const int row = it * 8 + (lane >> 3), ch = lane & 7; *(u32x4*)(MIX + (size_t)(m0 + row) * DM + MIX_A + u.head * 64 + ch * 8) = *(const LAS u32x4*)(sb + row * 64 + ch * 8); }
        } else {
            f32x16 p0, p1; float ls;
            const at::Src k0{KVB + (size_t)base * KVP + u.head * 128, KVP}, k1{H + (size_t)base * HP + HC_KROPE, HP}, vs{KVB + (size_t)base * KVP + u.head * 128 + 64, KVP};
            at::stream<6, 8, 4>(F.lds, tid, QB + (size_t)(m0 + r32) * QBP + u.head * 96, k0, k1, vs, NT, p0, p1, ls); at::normalise(F.lds, tid, p0, p1, ls);
#pragma unroll
            for (int r = 0; r < 16; ++r) { const int row = crow(r, hi); sb[row * 64 + r32] = (bf16_t)f2bf(p0[r]); sb[row * 64 + 32 + r32] = (bf16_t)f2bf(p1[r]); }
            LDS_WAIT();
#pragma unroll
            for (int it = 0; it < 4; ++it) { const int row = it * 8 + (lane >> 3), ch = lane & 7; *(u32x4*)(MIX + (size_t)(m0 + row) * DM + MIX_B + u.head * 64 + ch * 8) = *(const LAS u32x4*)(sb + row * 64 + ch * 8); }
        }
        AT_WAIT_BAR(0);
    }
}

struct ListRows { const int* list; int seg0, cnt; __device__ __forceinline__ int src(int m) const { const int r = m - seg0; return (r < cnt) ? (list[r] >> 1) : 0; } };
__device__ __forceinline__ void moe_segments(Frame& F, int layer, LAS int* seg) {
    if (F.tid == 0) { int acc = 0; for (int e = 0; e < NEXP; ++e) { const int c = (int)__hip_atomic_load(F.ctl + CW_CNT + layer * 64 + e, RLX_AGENT); seg[e] = acc; seg[33 + e] = c; acc += (c + 255) & ~255; } seg[32] = acc; }
    __syncthreads();
}
__device__ __forceinline__ int seg_find(const LAS int* seg, int row) { int e = 0;
#pragma unroll
    for (int s = 16; s > 0; s >>= 1) if (seg[e + s] <= row) e += s;
    return e; }
__device__ __forceinline__ void moe_up_simple(Frame& F, int layer) {
    LAS int* seg = (LAS int*)(F.lds + RING_BYTES); moe_segments(F, layer, seg);
    const bf16_t* XB = (const bf16_t*)(F.ws + WS_XB); const bf16_t* W13 = (const bf16_t*)(F.ws + WS_W13); const int* list = (const int*)(F.ws + WS_LIST);
    const EpiHid E{(bf16_t*)(F.ws + WS_HID)};
    const int items = (seg[32] / 32) * 16;
    for (int it = F.gw; it < items; it += F.NGW) { const int mt = it >> 4, ct = it & 15, m0 = mt * 32, e = seg_find(seg, m0), c0 = ct * 32;
        const ListRows RM{list + (size_t)e * LIST_CAP, seg[e], seg[33 + e]};
        const bf16_t* Bg = W13 + (size_t)e * 1024 * 1024 + (size_t)((c0 >> 7) * 256 + (c0 & 127)) * 1024;
        sg_tile(XB, DM, Bg, Bg + (size_t)128 * 1024, 1024, 1024, m0, c0, E, RM, F.lane); }
    __syncthreads();
}
__device__ __forceinline__ void moe_down_simple(Frame& F, int layer) {
    LAS int* seg = (LAS int*)(F.lds + RING_BYTES); moe_segments(F, layer, seg);
    const bf16_t* HID = (const bf16_t*)(F.ws + WS_HID); const bf16_t* W2 = (const bf16_t*)(F.ws + WS_W2); const int* list = (const int*)(F.ws + WS_LIST);
    const int items = (seg[32] / 32) * 16;
    for (int it = F.gw; it < items; it += F.NGW) { const int mt = it >> 4, ct = it & 15, m0 = mt * 32, e = seg_find(seg, m0), c0 = ct * 64;
        const EpiY E{(bf16_t*)(F.ws + WS_YB), (const float*)(F.ws + WS_TW), list + (size_t)e * LIST_CAP, seg[e], seg[33 + e]};
        const bf16_t* B0 = W2 + (size_t)e * 1024 * 512 + (size_t)c0 * 512;
        sg_tile(HID, DEXP, B0, B0 + (size_t)32 * 512, 512, 512, m0, c0, E, IdRows(), F.lane); }
    __syncthreads();
}


struct MoeUpSched {
    const char* XB; const char* W13; const LAS int* seg; const int* list; int nM, G, c;
    __device__ __forceinline__ bool next(int i, pg8::Unit& u) const { if (!pg8::order_next(i, G, c, nM, 4, u.pm, u.pn)) return false; u.e = __builtin_amdgcn_readfirstlane(seg_find(seg, u.pm * 256)); u.a = XB; u.b = W13 + ((size_t)u.e * 1024 + (size_t)u.pn * 256) * 2048; return true; }
    __device__ __forceinline__ unsigned arow(const pg8::Unit& u, int r) const { const int rr = u.pm * 256 + r - __builtin_amdgcn_readfirstlane(seg[u.e]); return (rr < __builtin_amdgcn_readfirstlane(seg[33 + u.e])) ? (unsigned)(list[(size_t)u.e * LIST_CAP + rr] >> 1) : 0u; }
};
struct MoeDownSched {
    const char* HID; const char* W2; const LAS int* seg; int nM, G, c;
    __device__ __forceinline__ bool next(int i, pg8::Unit& u) const { if (!pg8::order_next(i, G, c, nM, 4, u.pm, u.pn)) return false; u.e = __builtin_amdgcn_readfirstlane(seg_find(seg, u.pm * 256)); u.a = HID + (size_t)u.pm * 256 * DEXP * 2; u.b = W2 + ((size_t)u.e * 1024 + (size_t)u.pn * 256) * 1024; return true; }
    __device__ __forceinline__ unsigned arow(const pg8::Unit&, int) const { return 0u; }
};
__device__ __forceinline__ void moe_up_opt(Frame& F, int layer) {
    LAS int* seg = (LAS int*)(F.lds + RING_BYTES); moe_segments(F, layer, seg);
    const MoeUpSched S{(const char*)(F.ws + WS_XB), (const char*)(F.ws + WS_W13), seg, (const int*)(F.ws + WS_LIST), __builtin_amdgcn_readfirstlane(seg[32]) / 256, F.G, F.bid};
    const EpiHid E{(bf16_t*)(F.ws + WS_HID)};
    pg8::gemm_phase<EpiHid, MoeUpSched, true, true>(F.lds, F.tid, 1024, DM, S, E);
    __syncthreads();
}
__device__ __forceinline__ void moe_down_opt(Frame& F, int layer) {
    LAS int* seg = (LAS int*)(F.lds + RING_BYTES); moe_segments(F, layer, seg);
    const MoeDownSched S{(const char*)(F.ws + WS_HID), (const char*)(F.ws + WS_W2), seg, __builtin_amdgcn_readfirstlane(seg[32]) / 256, F.G, F.bid};
    const EpiYO E{(bf16_t*)(F.ws + WS_YB), (const float*)(F.ws + WS_TW), (const int*)(F.ws + WS_LIST), seg};
    pg8::gemm_phase<EpiYO, MoeDownSched, false, false>(F.lds, F.tid, DEXP, DEXP, S, E);
    __syncthreads();
}
template <class Epi>
__device__ __forceinline__ void pg_phase(Frame& F, const bf16_t* A, int lda, const bf16_t* Bt, int panel, int N, int K, const Epi& E) {
    pg8::PanelSched S; S.init(A, lda, Bt, panel, N, K);
    pg8::gemm_phase<Epi, pg8::PanelSched, false, false>(F.lds, F.tid, K, lda, S, E);
}
__device__ __forceinline__ void local_sync(Frame& F) {
    asm volatile("s_waitcnt vmcnt(0) lgkmcnt(0)" ::: "memory");
    __syncthreads();
    if (F.tid == 0) { __builtin_amdgcn_fence(__ATOMIC_ACQUIRE, "agent"); asm volatile("s_waitcnt vmcnt(0)" ::: "memory"); }
    __syncthreads();
}
template <class Epi>
__device__ __forceinline__ void og_phase(Frame& F, const bf16_t* A, int lda, const bf16_t* Bt, int M, int N, int K, const Epi& E) {
    pg8::DenseSched S; S.init(A, lda, Bt, M, N, K, F.G, F.bid);
    pg8::gemm_phase<Epi, pg8::DenseSched, false, false>(F.lds, F.tid, K, lda, S, E);
}

#ifndef PANEL_PROG
#define PANEL_PROG 1
#endif
#if PANEL_PROG
constexpr int PH_PER_LAYER = 6, N_PHASES = 2 + DEPTH * PH_PER_LAYER;
#else
constexpr int PH_PER_LAYER = 9, N_PHASES = 1 + DEPTH * PH_PER_LAYER;
#endif
__global__ void __launch_bounds__(NTHREADS, 2) fwd(Args args) {
    extern __shared__ __attribute__((aligned(16))) unsigned char lds[];
    Frame F;
    F.lds = (LAS unsigned char*)lds; F.ldsg = lds;
    F.tid = threadIdx.x; F.lane = F.tid & 63; F.wave = __builtin_amdgcn_readfirstlane(F.tid >> 6);
    F.G = gridDim.x; F.bid = blockIdx.x; F.gw = blockIdx.x * NWAVES + F.wave; F.NGW = F.G * NWAVES;
    F.ws = args.ws; F.ctl = (gu32*)(args.ws + WS_CTL);
    volatile LAS unsigned* MISC = (volatile LAS unsigned*)(F.lds + MISC_OFF);
    for (int u = F.tid; u < (LDS_BYTES - RING_BYTES) / 4; u += NTHREADS) ((LAS unsigned*)(F.lds + RING_BYTES))[u] = 0u;
    __syncthreads();
    XcdBarrier bar; bar.bar = (unsigned*)(F.ctl + CW_BAR); bar.x = 0; bar.st = nullptr;
    if (args.use_bar) bar = xcd_barrier_post((unsigned*)(F.ctl + CW_BAR), MISC + 8);
    const int lo = args.ph_lo, hi = args.ph_hi;
#ifndef PH_MASK
#define PH_MASK 0x3ff
#endif
#define IN(k) (lo <= (k) && (k) < hi && (launder(F), true))
#define SEAM(k) do { if (lo <= (k) && (k) + 1 < hi) xcd_barrier(bar); } while (0)
    if ((PH_MASK & 1) && IN(0)) { p0_prologue(F, args);
#ifdef PROBE_DUP_P0
        launder(F); p0_prologue(F, args);
#endif
    }
    SEAM(0);
#if PANEL_PROG
    for (int layer = 0; layer < DEPTH; ++layer) {
        const int pb = 1 + layer * PH_PER_LAYER;
        if (IN(pb + 0)) {
            for (int panel = F.bid; panel < NTOK / 256; panel += F.G) {
                const int r0 = panel * 256;
                if (layer > 0) { ln2_pass(F, args, layer - 1, r0 + F.wave, NWAVES, r0 + 256); local_sync(F); launder(F); }
                { bf16_t* H = (bf16_t*)(F.ws + WS_H); const EpiH E{H, (const float2*)(F.ws + WS_ROPE32), (const float2*)(F.ws + WS_ROPE64)};
                  pg_phase(F, (const bf16_t*)(F.ws + WS_XB), DM, (const bf16_t*)(F.ws + WS_WIN) + (size_t)layer * 2560 * 1024, panel, 2560, 1024, E); }
                local_sync(F); launder(F);
                rowstat_pass(F, r0 + F.wave, NWAVES, r0 + 256);
                local_sync(F); launder(F);
                { bf16_t* H = (bf16_t*)(F.ws + WS_H); const EpiUQ Eq{(bf16_t*)(F.ws + WS_QB), (const float*)(F.ws + WS_RSTD), (const float2*)(F.ws + WS_ROPE32)};
                  pg_phase(F, H + HC_CQ_LAT, HP, (const bf16_t*)(F.ws + WS_WUQ) + (size_t)layer * 768 * 256, panel, 768, 256, Eq); }
                launder(F);
                { bf16_t* H = (bf16_t*)(F.ws + WS_H); const EpiUKV Ek{(bf16_t*)(F.ws + WS_KVB), (const float*)(F.ws + WS_RSTD)};
                  pg_phase(F, H + HC_CKV, HP, (const bf16_t*)(F.ws + WS_WUKV) + (size_t)layer * 768 * 256, panel, 768, 256, Ek); }
                launder(F);
            }
        }
        SEAM(pb + 0);
        if (IN(pb + 1)) { cstat_phase(F); }
        SEAM(pb + 1);
        if (IN(pb + 2)) { attn_ab_phase(F, args, layer); launder(F); sattn_phase(F, args, layer, 10); }
        SEAM(pb + 2);
        if (IN(pb + 3)) {
            for (int panel = F.bid; panel < NTOK / 256; panel += F.G) {
                const int r0 = panel * 256;
                { const EpiRes E{args.out, layer == 0 ? args.x_prompt : nullptr, args.x_sample, args.out};
                  pg_phase(F, (const bf16_t*)(F.ws + WS_MIX), DM, (const bf16_t*)(F.ws + WS_WOUT) + (size_t)layer * 1024 * 1024, panel, 1024, 1024, E); }
                local_sync(F); launder(F);
                ln1_route_pass(F, args, layer, r0 + F.wave, NWAVES, r0 + 256);
                launder(F);
            }
            moe_convert(F, args, layer);
        }
        SEAM(pb + 3);
        if (IN(pb + 4)) { moe_up_opt(F, layer); }
        SEAM(pb + 4);
        if (IN(pb + 5)) { moe_down_opt(F, layer); }
        SEAM(pb + 5);
    }
    if (IN(1 + DEPTH * PH_PER_LAYER)) { ln2_pass(F, args, DEPTH - 1, F.gw, F.NGW, NTOK); }
#else
    for (int layer = 0; layer < DEPTH; ++layer) {
        const int pb = 1 + layer * PH_PER_LAYER;
        if ((PH_MASK & (2 << 0)) && IN(pb + 0)) {   bf16_t* H = (bf16_t*)(F.ws + WS_H);
            const EpiH E{H, (const float2*)(F.ws + WS_ROPE32), (const float2*)(F.ws + WS_ROPE64)};
#if OPT_GEMM
            og_phase(F, (const bf16_t*)(F.ws + WS_XB), DM, (const bf16_t*)(F.ws + WS_WIN) + (size_t)layer * 2560 * 1024, NTOK, 2560, 1024, E);
#ifdef PROBE_DUP_GEMM
            launder(F); og_phase(F, (const bf16_t*)(F.ws + WS_XB), DM, (const bf16_t*)(F.ws + WS_WIN) + (size_t)layer * 2560 * 1024, NTOK, 2560, 1024, E);
#endif
#else
            sg_phase(F, (const bf16_t*)(F.ws + WS_XB), DM, (const bf16_t*)(F.ws + WS_WIN) + (size_t)layer * 2560 * 1024, 1024, NTOK, 2560, 1024, E);
#endif
        }
        SEAM(pb + 0);
        if ((PH_MASK & (2 << 1)) && IN(pb + 1)) { rowstat_pass(F, F.gw, F.NGW, NTOK); cstat_phase(F);
#ifdef PROBE_DUP_CSTAT
            launder(F); rowstat_pass(F, F.gw, F.NGW, NTOK); cstat_phase(F);
#endif
        }
        SEAM(pb + 1);
        if ((PH_MASK & (2 << 2)) && IN(pb + 2)) {
            bf16_t* H = (bf16_t*)(F.ws + WS_H);
            const EpiUQ Eq{(bf16_t*)(F.ws + WS_QB), (const float*)(F.ws + WS_RSTD), (const float2*)(F.ws + WS_ROPE32)};
#if OPT_GEMM
            og_phase(F, H + HC_CQ_LAT, HP, (const bf16_t*)(F.ws + WS_WUQ) + (size_t)layer * 768 * 256, NTOK, 768, 256, Eq);
            launder(F);
#else
            sg_phase(F, H + HC_CQ_LAT, HP, (const bf16_t*)(F.ws + WS_WUQ) + (size_t)layer * 768 * 256, 256, NTOK, 768, 256, Eq);
#endif
            const EpiUKV Ek{(bf16_t*)(F.ws + WS_KVB), (const float*)(F.ws + WS_RSTD)};
#if OPT_GEMM
            og_phase(F, H + HC_CKV, HP, (const bf16_t*)(F.ws + WS_WUKV) + (size_t)layer * 768 * 256, NTOK, 768, 256, Ek);
#ifdef PROBE_DUP_UP
            launder(F); og_phase(F, H + HC_CQ_LAT, HP, (const bf16_t*)(F.ws + WS_WUQ) + (size_t)layer * 768 * 256, NTOK, 768, 256, Eq);
            launder(F); og_phase(F, H + HC_CKV, HP, (const bf16_t*)(F.ws + WS_WUKV) + (size_t)layer * 768 * 256, NTOK, 768, 256, Ek);
#endif
#else
            sg_phase(F, H + HC_CKV, HP, (const bf16_t*)(F.ws + WS_WUKV) + (size_t)layer * 768 * 256, 256, NTOK, 768, 256, Ek);
#endif
        }
        SEAM(pb + 2);
        if ((PH_MASK & (2 << 3)) && IN(pb + 3)) {
#if OPT_ATTN
            attn_ab_phase(F, args, layer); launder(F);
#ifdef PROBE_DUP_ATTN
            attn_ab_phase(F, args, layer, PROBE_DUP_ATTN); launder(F);
#endif
            sattn_phase(F, args, layer, 10);
#ifdef PROBE_DUP_CFIN
            launder(F); sattn_phase(F, args, layer, 10);
#endif
#else
            sattn_phase(F, args, layer, 0);
#endif
        }
        SEAM(pb + 3);
        if ((PH_MASK & (2 << 4)) && IN(pb + 4)) {
#ifdef PROBE_DUP_WOUT
            { const EpiRes E0{args.out, layer == 0 ? args.x_prompt : nullptr, args.x_sample, (float*)(F.ws + WS_H)};
              og_phase(F, (const bf16_t*)(F.ws + WS_MIX), DM, (const bf16_t*)(F.ws + WS_WOUT) + (size_t)layer * 1024 * 1024, NTOK, 1024, 1024, E0); launder(F); }
#endif
            const EpiRes E{args.out, layer == 0 ? args.x_prompt : nullptr, args.x_sample, args.out};
#if OPT_GEMM
            og_phase(F, (const bf16_t*)(F.ws + WS_MIX), DM, (const bf16_t*)(F.ws + WS_WOUT) + (size_t)layer * 1024 * 1024, NTOK, 1024, 1024, E);
#else
            sg_phase(F, (const bf16_t*)(F.ws + WS_MIX), DM, (const bf16_t*)(F.ws + WS_WOUT) + (size_t)layer * 1024 * 1024, 1024, NTOK, 1024, 1024, E);
#endif
        }
        SEAM(pb + 4);
        if ((PH_MASK & (2 << 5)) && IN(pb + 5)) {
#ifdef PROBE_DUP_LN1
#endif
            ln1_route_pass(F, args, layer, F.gw, F.NGW, NTOK); moe_convert(F, args, layer);
#ifdef PROBE_DUP_CONV
            launder(F); moe_convert(F, args, layer);
#endif
        }
        SEAM(pb + 5);
#if OPT_GEMM
        if ((PH_MASK & (2 << 6)) && IN(pb + 6)) { moe_up_opt(F, layer);
#ifdef PROBE_DUP_MOE
            launder(F); moe_up_opt(F, layer);
#endif
        }
#else
        if ((PH_MASK & (2 << 6)) && IN(pb + 6)) { moe_up_simple(F, layer); }
#endif
        SEAM(pb + 6);
#if OPT_GEMM
        if ((PH_MASK & (2 << 7)) && IN(pb + 7)) { moe_down_opt(F, layer);
#ifdef PROBE_DUP_MOE
            launder(F); moe_down_opt(F, layer);
#endif
        }
#else
        if ((PH_MASK & (2 << 7)) && IN(pb + 7)) { moe_down_simple(F, layer); }
#endif
        SEAM(pb + 7);
        if ((PH_MASK & (2 << 8)) && IN(pb + 8)) { ln2_pass(F, args, layer, F.gw, F.NGW, NTOK); }
        SEAM(pb + 8);
    }
#endif
#undef IN
#undef SEAM
}

extern "C" void kernel_launch(void* const* d_in, const int* in_sizes, int n_in, void* d_out, int out_size, void* d_ws, size_t ws_size, hipStream_t stream) {
    static int grid = 0;
    if (grid == 0) {
        if (n_in != 19 || out_size != NTOK * DM || ws_size < WS_END) { fprintf(stderr, "kernel_launch: unexpected shapes (n_in %d out %d ws %zu)\n", n_in, out_size, ws_size); grid = -1; return; }
        int dev = 0, cus = 0, per_cu = 0;
        if (hipGetDevice(&dev) != hipSuccess || hipDeviceGetAttribute(&cus, hipDeviceAttributeMultiprocessorCount, dev) != hipSuccess) { grid = -1; return; }
        if (hipFuncSetAttribute((const void*)fwd, hipFuncAttributeMaxDynamicSharedMemorySize, LDS_BYTES) != hipSuccess) { grid = -1; return; }
        if (hipOccupancyMaxActiveBlocksPerMultiprocessor(&per_cu, (const void*)fwd, NTHREADS, LDS_BYTES) != hipSuccess || per_cu < 1) { fprintf(stderr, "kernel_launch: occupancy query says %d\n", per_cu); }
        (void)hipGetLastError();
        grid = cus;
    }
    if (grid < 0) return;
    if (hipMemsetAsync((char*)d_ws + WS_CTL, 0, CTL_ZERO_BYTES, stream) != hipSuccess) return;
    Args a{};
    a.x_prompt = (const float*)d_in[0]; a.x_sample = (const float*)d_in[1]; a.w_in = (const float*)d_in[2]; a.diff_lambda = (const float*)d_in[3]; a.diff_subln = (const float*)d_in[4];
    a.mla_q_norm = (const float*)d_in[5]; a.mla_w_uq = (const float*)d_in[6]; a.mla_kv_norm = (const float*)d_in[7]; a.mla_w_ukv = (const float*)d_in[8]; a.w_out = (const float*)d_in[9];
    a.ln1_g = (const float*)d_in[10]; a.ln1_b = (const float*)d_in[11]; a.moe_w_coarse = (const float*)d_in[12]; a.moe_w_fine = (const float*)d_in[13];
    a.moe_w1 = (const float*)d_in[14]; a.moe_w3 = (const float*)d_in[15]; a.moe_w2 = (const float*)d_in[16]; a.ln2_g = (const float*)d_in[17]; a.ln2_b = (const float*)d_in[18];
    a.out = (float*)d_out; a.ws = (unsigned char*)d_ws; a.pad = 0;
#if MK_ONE_LAUNCH
    a.ph_lo = 0; a.ph_hi = N_PHASES; a.use_bar = 1;
    hipLaunchKernelGGL(fwd, dim3(grid), dim3(NTHREADS), LDS_BYTES, stream, a);
#else
    for (int p = 0; p < N_PHASES; ++p) { a.ph_lo = p; a.ph_hi = p + 1; a.use_bar = 0; hipLaunchKernelGGL(fwd, dim3(grid), dim3(NTHREADS), LDS_BYTES, stream, a); }
#endif
}
```

```cpp
#include <hip/hip_runtime.h>
#include <cstdio>
#include <cstdint>

#ifndef OPT_ATTN
#define OPT_ATTN 1
#endif
#ifndef OPT_GEMM
#define OPT_GEMM 1
#endif
#ifndef MK_ONE_LAUNCH
#define MK_ONE_LAUNCH 1
#endif

#define GAS __attribute__((address_space(1)))
#define LAS __attribute__((address_space(3)))
typedef unsigned short bf16_t;
typedef short bf16x8 __attribute__((ext_vector_type(8)));
typedef float f32x4 __attribute__((ext_vector_type(4)));
typedef float f32x2 __attribute__((ext_vector_type(2)));
typedef float f32x16 __attribute__((ext_vector_type(16)));
typedef unsigned u32x4 __attribute__((ext_vector_type(4)));
typedef unsigned u32x2 __attribute__((ext_vector_type(2)));
typedef GAS unsigned gu32;
#define RLX_AGENT __ATOMIC_RELAXED, __HIP_MEMORY_SCOPE_AGENT
#define LDS_WAIT() asm volatile("s_waitcnt lgkmcnt(0)" ::: "memory")
#define VM_WAIT() asm volatile("s_waitcnt vmcnt(0)" ::: "memory")
#define MFMA32(a, b, c) __builtin_amdgcn_mfma_f32_32x32x16_bf16(a, b, c, 0, 0, 0)

__device__ __forceinline__ unsigned f2bf(float f) { unsigned u = __builtin_bit_cast(unsigned, f); return (u + 0x7fffu + ((u >> 16) & 1u)) >> 16; }
__device__ __forceinline__ unsigned pk2(float lo, float hi) { return f2bf(lo) | (f2bf(hi) << 16); }
__device__ __forceinline__ float bf2f(unsigned short b) { return __builtin_bit_cast(float, (unsigned)b << 16); }
__device__ __forceinline__ int crow(int r, int hi) { return (r & 3) + 8 * (r >> 2) + 4 * hi; }
template <int K> __device__ __forceinline__ float shx(float v) { static_assert(K < 32, "xor 32: use xsum32 / xmax32 / xpair32"); return __uint_as_float((unsigned)__builtin_amdgcn_ds_swizzle((int)__float_as_uint(v), (K << 10) | 0x1f)); }
__device__ __forceinline__ float xsum32(float v) { auto rr = __builtin_amdgcn_permlane32_swap(__float_as_uint(v), __float_as_uint(v), false, false); return __uint_as_float(rr[0]) + __uint_as_float(rr[1]); }
__device__ __forceinline__ float xmax32(float v) { auto rr = __builtin_amdgcn_permlane32_swap(__float_as_uint(v), __float_as_uint(v), false, false); return fmaxf(__uint_as_float(rr[0]), __uint_as_float(rr[1])); }
__device__ __forceinline__ float xpair32(float lo, float hi) { auto rr = __builtin_amdgcn_permlane32_swap(__float_as_uint(lo), __float_as_uint(hi), false, false); return __uint_as_float(rr[0]) + __uint_as_float(rr[1]); }
__device__ __forceinline__ float wave_sum(float v) {
    v += shx<1>(v); v += shx<2>(v); v += shx<4>(v); v += shx<8>(v); v += shx<16>(v);
    return xsum32(v);
}
__device__ __forceinline__ float fast_exp2(float x) { return __builtin_amdgcn_exp2f(x); }

constexpr int NTOK = 65536, DM = 1024, DEPTH = 4;
constexpr int NTOK_P = 32768;
constexpr int HP = 2560;
constexpr int HC_AQ = 0, HC_AK = 256, HC_AV = 512, HC_CQ_LAT = 768, HC_CKV = 1024, HC_KROPE = 1152, HC_CQ = 1280, HC_CK = 1664, HC_CV = 2048;
constexpr int QBP = 768, KVP = 768;
constexpr int MIX_A = 0, MIX_B = 256, MIX_C = 640;
constexpr int NEXP = 32, DEXP = 512;
constexpr float LOG2E = 1.4426950408889634f;
constexpr float SC_A = 0.17677669529663687f * LOG2E;
constexpr float SC_B = 0.10206207261596575f * LOG2E;
constexpr float SC_C = 0.125f * LOG2E;
constexpr float DN_ALPHA = 1.681792830507429f;
constexpr float LN_EPS = 1e-5f, RMS_EPS = 1e-6f;

constexpr size_t MiB = 1u << 20;
constexpr size_t WS_CTL = 0, CTL_ZERO_BYTES = 1 * MiB;
constexpr size_t WS_ROPE32 = 4 * MiB;
constexpr size_t WS_ROPE64 = 5 * MiB;
constexpr size_t WS_WIN = 8 * MiB;
constexpr size_t WS_WOUT = 28 * MiB;
constexpr size_t WS_WUQ = 36 * MiB;
constexpr size_t WS_WUKV = 38 * MiB;
constexpr size_t WS_W13 = 40 * MiB;
constexpr size_t WS_W2 = 104 * MiB;
constexpr size_t WS_XB = 136 * MiB;
constexpr size_t WS_H = 264 * MiB;
constexpr size_t WS_QB = 584 * MiB;
constexpr size_t WS_KVB = 680 * MiB;
constexpr size_t WS_MIX = 776 * MiB;
constexpr size_t WS_RSTD = 904 * MiB;
constexpr size_t WS_LSEC = 905 * MiB;
constexpr size_t WS_TW = 907 * MiB;
constexpr size_t WS_LIST = 908 * MiB;
constexpr size_t WS_END = 924 * MiB;
constexpr size_t WS_HID = WS_H;
constexpr size_t WS_YB = WS_H + 136 * MiB;
static_assert(WS_YB + 256 * MiB <= WS_KVB + 96 * MiB, "YB overlay");
constexpr int LIST_CAP = 131072;
constexpr int CW_TMO = 0;
constexpr int CW_CNT = 64;
constexpr int CW_BAR = 4096;

constexpr int RING_BYTES = 131072;
constexpr int MISC_OFF = RING_BYTES + 320;
constexpr int LDS_BYTES = 147456;
constexpr int NWAVES = 8, NTHREADS = 512;

#define XB_TMO      128
#define XB_XCNT(j)  (256  + 64 * (j))
#define XB_XSUB(j)  (1280 + 64 * (j))
#define XB_XGEN(j)  (2304 + 64 * (j))
#define XB_TOP      3328
#define XB_TOPGEN   3392
#define XCD_BAR_WORDS 3456
#define XB_SPIN_CAP (1u << 22)
__device__ __forceinline__ unsigned xb_ld(unsigned* p)              { return __hip_atomic_load(p, __ATOMIC_RELAXED, __HIP_MEMORY_SCOPE_AGENT); }
__device__ __forceinline__ unsigned xb_add(unsigned* p, unsigned v) { return __hip_atomic_fetch_add(p, v, __ATOMIC_RELAXED, __HIP_MEMORY_SCOPE_AGENT); }
__device__ __forceinline__ unsigned xb_xcc_id() { return (unsigned)__builtin_amdgcn_s_getreg((3 << 11) | 20) & 0xFu; }
#define XB_SPIN(cond, bar) do { unsigned _sp = 0; while (cond) { __builtin_amdgcn_s_sleep(1); \
    if ((++_sp & 255u) == 0u) { if (xb_ld(&(bar)[XB_TMO])) break; if (_sp > XB_SPIN_CAP) { atomicAdd(&(bar)[XB_TMO], 1u); break; } } } } while (0)
struct XcdBarrier { unsigned* bar; unsigned x; volatile LAS unsigned* st; };
__device__ __forceinline__ XcdBarrier xcd_barrier_post(unsigned* bar, volatile LAS unsigned* st) {
    XcdBarrier b; b.bar = bar; b.x = xb_xcc_id(); b.st = st;
    if (threadIdx.x == 0) (void)xb_add(&bar[XB_XCNT(b.x)], 1u);
    return b;
}
__device__ __forceinline__ void xcd_barrier_complete(unsigned* bar, unsigned x, unsigned& nloc, unsigned& nx) {
    const unsigned G = gridDim.x * gridDim.y * gridDim.z;
    unsigned sum, cnt, mine, sp = 0u;
    for (;;) {
        sum = 0u; cnt = 0u; mine = 0u;
#pragma unroll
        for (unsigned j = 0; j < 16; ++j) { const unsigned c = xb_ld(&bar[XB_XCNT(j)]); sum += c; cnt += (c > 0u) ? 1u : 0u; mine = (j == x) ? c : mine; }
        if (sum == G) break;
        __builtin_amdgcn_s_sleep(1);
        if ((++sp & 255u) == 0u) { if (xb_ld(&bar[XB_TMO])) break; if (sp > XB_SPIN_CAP) { atomicAdd(&bar[XB_TMO], 1u); break; } }
    }
    nloc = mine > 0u ? mine : 1u; nx = cnt > 0u ? cnt : 1u;
}
__device__ __forceinline__ void xcd_barrier(const XcdBarrier& b) {
    asm volatile("s_waitcnt vmcnt(0)" ::: "memory");
    __syncthreads();
    if (threadIdx.x == 0) {
        unsigned* bar = b.bar;
        __builtin_amdgcn_s_waitcnt(0);
        unsigned nloc = b.st[0], nx = b.st[1];
        if (nloc == 0u) { xcd_barrier_complete(bar, b.x, nloc, nx); b.st[0] = nloc; b.st[1] = nx; }
        const unsigned old = xb_add(&bar[XB_XSUB(b.x)], 1u);
        const unsigned gen = old / nloc;
        if (old + 1u == (gen + 1u) * nloc) {
            __builtin_amdgcn_fence(__ATOMIC_RELEASE, "agent");
            asm volatile("s_waitcnt vmcnt(0)" ::: "memory");
            const unsigned og = xb_add(&bar[XB_TOP], 1u);
            const unsigned tg = og / nx;
            if (og + 1u == (tg + 1u) * nx) xb_add(&bar[XB_TOPGEN], 1u);
            else XB_SPIN(xb_ld(&bar[XB_TOPGEN]) == tg, bar);
            __builtin_amdgcn_fence(__ATOMIC_ACQUIRE, "agent");
            xb_add(&bar[XB_XGEN(b.x)], 1u);
            asm volatile("s_waitcnt vmcnt(0)" ::: "memory");
        } else {
            XB_SPIN(xb_ld(&bar[XB_XGEN(b.x)]) == gen, bar);
            __builtin_amdgcn_fence(__ATOMIC_ACQUIRE, "agent");
            asm volatile("s_waitcnt vmcnt(0)" ::: "memory");
        }
    }
    __syncthreads();
}

struct Args {
    const float* x_prompt; const float* x_sample; const float* w_in; const float* diff_lambda; const float* diff_subln; const float* mla_q_norm; const float* mla_w_uq;
    const float* mla_kv_norm; const float* mla_w_ukv; const float* w_out; const float* ln1_g; const float* ln1_b; const float* moe_w_coarse; const float* moe_w_fine;
    const float* moe_w1; const float* moe_w3; const float* moe_w2; const float* ln2_g; const float* ln2_b;
    float* out; unsigned char* ws; int ph_lo, ph_hi, use_bar, pad;
};
struct Frame {
    LAS unsigned char* lds; unsigned char* ldsg;
    int tid, lane, wave, G, gw, NGW, bid;
    gu32* ctl; unsigned char* ws;
};
__device__ __forceinline__ void launder(Frame& F) {
    int wv = F.wave; asm volatile("" : "+s"(wv)); F.wave = wv;
    int t; asm volatile("v_mbcnt_lo_u32_b32 %0, -1, 0\n\tv_mbcnt_hi_u32_b32 %0, -1, %0" : "=v"(t)); F.lane = t; F.tid = wv * 64 + t;
    int b = (int)blockIdx.x; asm volatile("" : "+s"(b)); F.bid = b; F.gw = b * NWAVES + F.wave;
    unsigned char* w = F.ws; asm volatile("" : "+s"(w)); F.ws = w; F.ctl = (gu32*)(w + WS_CTL);
}
struct SeqInfo { int base, len, pos; };
__device__ __forceinline__ SeqInfo seqinfo(int m) { SeqInfo s; if (m < NTOK_P) { s.base = m & ~2047; s.len = 2048; } else { s.base = m & ~4095; s.len = 4096; } s.pos = m - s.base; return s; }

template <class ColMap>
__device__ __forceinline__ void transpose_item(const float* W, int N, bf16_t* WT, int ldd, LAS float* scr, int k0, int n0, const ColMap& cm, const float* kscale, int lane) {
    const int sc = cm(n0 + (lane & 31));
#pragma unroll 8
    for (int i = 0; i < 32; ++i) { const int kk = 2 * i + (lane >> 5); float v = 0.f; if (sc >= 0) { v = W[(size_t)(k0 + kk) * N + sc]; if (kscale) v *= kscale[k0 + kk]; } scr[kk * 33 + (lane & 31)] = v; }
    LDS_WAIT(); asm volatile("" ::: "memory");
    const int c = lane & 7;
#pragma unroll
    for (int j = 0; j < 4; ++j) { const int n = (lane >> 3) + 8 * j; const LAS float* s = scr + (8 * c) * 33 + n;
        u32x4 o; o.x = pk2(s[0 * 33], s[1 * 33]); o.y = pk2(s[2 * 33], s[3 * 33]); o.z = pk2(s[4 * 33], s[5 * 33]); o.w = pk2(s[6 * 33], s[7 * 33]);
        *(u32x4*)(WT + (size_t)(n0 + n) * ldd + k0 + 8 * c) = o; }
    LDS_WAIT(); asm volatile("" ::: "memory");
}
__device__ __forceinline__ void transpose_item_v4(const float* Wsrc, int N, bf16_t* WTdst, int ldd, LAS float* scr, int lane) {
    const int c4 = (lane & 7) * 4, kr = lane >> 3;
    f32x4 t[8];
#pragma unroll
    for (int i = 0; i < 8; ++i) t[i] = *(const f32x4*)(Wsrc + (size_t)(i * 8 + kr) * N + c4);
#pragma unroll
    for (int i = 0; i < 8; ++i) { const int kk = i * 8 + kr; scr[(c4 + 0) * 65 + kk] = t[i].x; scr[(c4 + 1) * 65 + kk] = t[i].y; scr[(c4 + 2) * 65 + kk] = t[i].z; scr[(c4 + 3) * 65 + kk] = t[i].w; }
    LDS_WAIT(); asm volatile("" ::: "memory");
    const int c = lane & 7;
#pragma unroll
    for (int j = 0; j < 4; ++j) { const int n = (lane >> 3) + 8 * j; const LAS float* p = scr + n * 65 + 8 * c;
        u32x4 o; o.x = pk2(p[0], p[1]); o.y = pk2(p[2], p[3]); o.z = pk2(p[4], p[5]); o.w = pk2(p[6], p[7]);
        *(u32x4*)(WTdst + (size_t)n * ldd + 8 * c) = o; }
    LDS_WAIT(); asm volatile("" ::: "memory");
}
struct WinMap {
    __device__ __forceinline__ int operator()(int n) const {
        if (n < 512) { const int t = n & 31; return (n & ~31) + (t >> 1) + 16 * (t & 1); }
        if (n < 1152) return n;
        if (n < 1184) { const int t = n - 1152; return 1152 + (t >> 1) + 16 * (t & 1); }
        if (n < 1280) return -1;
        if (n < 2048) { const int u = n - 1280, t = u & 63; return 1184 + (u & ~63) + (t >> 1) + 32 * (t & 1); }
        if (n < 2432) return 1952 + (n - 2048);
        return -1;
    }
};
struct UqMap { __device__ __forceinline__ int operator()(int n) const { if (n >= 576) return -1; const int h = n / 96, t = n - 96 * h; if (t < 64) return n; const int u = t - 64; return 96 * h + 64 + (u >> 1) + 16 * (u & 1); } };
struct IdMap { __device__ __forceinline__ int operator()(int n) const { return n; } };
struct W13Map { __device__ __forceinline__ int operator()(int n) const { return (n >> 8) * 128 + (n & 127); } };

__device__ __forceinline__ void p0_prologue(Frame& F, const Args& a) {
    LAS float* scr = (LAS float*)(F.lds + F.wave * 16384);
    { float2* r32 = (float2*)(F.ws + WS_ROPE32); float2* r64 = (float2*)(F.ws + WS_ROPE64);
      for (int i = F.gw * 64 + F.lane; i < 4096 * 16; i += F.NGW * 64) { const int pos = i >> 4, j = i & 15; const float inv = 1.0f / powf(10000.0f, (float)(2 * j) / 32.0f); const float ang = (float)pos * inv; r32[i] = make_float2(cosf(ang), sinf(ang)); }
      for (int i = F.gw * 64 + F.lane; i < 4096 * 32; i += F.NGW * 64) { const int pos = i >> 5, j = i & 31; const float inv = 1.0f / powf(10000.0f, (float)(2 * j) / 64.0f); const float ang = (float)pos * inv; r64[i] = make_float2(cosf(ang), sinf(ang)); } }
    constexpr int I_WIN = (1024 / 64) * (2560 / 32), I_WOUT = (1024 / 64) * (1024 / 32), I_UQ = (256 / 64) * (768 / 32), I_UKV = (256 / 64) * (768 / 32);
    constexpr int PER_L = I_WIN + I_WOUT + I_UQ + I_UKV;
    for (int it = F.gw; it < DEPTH * PER_L; it += F.NGW) {
        const int l = it / PER_L; int r = it - l * PER_L;
        if (r < I_WIN) { const int kb = r / 80, nb = r % 80; transpose_item(a.w_in + (size_t)l * 1024 * 2336, 2336, (bf16_t*)(F.ws + WS_WIN) + (size_t)l * 2560 * 1024, 1024, scr, kb * 64, nb * 32, WinMap(), nullptr, F.lane); continue; } r -= I_WIN;
        if (r < I_WOUT) { const int kb = r / 32, nb = r % 32; transpose_item(a.w_out + (size_t)l * 1024 * 1024, 1024, (bf16_t*)(F.ws + WS_WOUT) + (size_t)l * 1024 * 1024, 1024, scr, kb * 64, nb * 32, IdMap(), nullptr, F.lane); continue; } r -= I_WOUT;
        if (r < I_UQ) { const int kb = r / 24, nb = r % 24; transpose_item(a.mla_w_uq + (size_t)l * 256 * 576, 576, (bf16_t*)(F.ws + WS_WUQ) + (size_t)l * 768 * 256, 256, scr, kb * 64, nb * 32, UqMap(), a.mla_q_norm + l * 256, F.lane); continue; } r -= I_UQ;
        { const int kb = r / 24, nb = r % 24; bf16_t* dst = (bf16_t*)(F.ws + WS_WUKV) + (size_t)l * 768 * 256;
          if (kb < 2) transpose_item(a.mla_w_ukv + (size_t)l * 128 * 768, 768, dst, 256, scr, kb * 64, nb * 32, IdMap(), a.mla_kv_norm + l * 128, F.lane);
          else { const int c = F.lane & 7;
#pragma unroll
              for (int j = 0; j < 4; ++j) { const int n = (F.lane >> 3) + 8 * j; *(u32x4*)(dst + (size_t)(nb * 32 + n) * 256 + kb * 64 + 8 * c) = (u32x4){0u, 0u, 0u, 0u}; } } }
    }
    bf16_t* XB = (bf16_t*)(F.ws + WS_XB);
    for (int m = F.gw; m < NTOK; m += F.NGW) {
        const float* src = (m < NTOK_P) ? a.x_prompt + (size_t)m * DM : a.x_sample + (size_t)(m - NTOK_P) * DM;
#pragma unroll
        for (int j = 0; j < 4; ++j) { const f32x4 v = *((const f32x4*)src + F.lane + 64 * j);
            u32x2 w; w.x = pk2(v.x, v.y); w.y = pk2(v.z, v.w); *((u32x2*)(XB + (size_t)m * DM) + F.lane + 64 * j) = w; }
    }
}

template <class Epi, class RowMap>
__device__ __forceinline__ void sg_tile(const bf16_t* A, int lda, const bf16_t* B0, const bf16_t* B1, int ldb, int K, int m0, int c0, const Epi& E, const RowMap& RM, int lane) {
    const int r32 = lane & 31, hi = lane >> 5;
    const bf16_t* ap = A + (size_t)RM.src(m0 + r32) * lda + 8 * hi;
    const bf16_t* b0p = B0 + (size_t)r32 * ldb + 8 * hi;
    const bf16_t* b1p = B1 + (size_t)r32 * ldb + 8 * hi;
    f32x16 acc0 = {}, acc1 = {};
#pragma unroll 4
    for (int k = 0; k < K; k += 16) {
        const bf16x8 af = *(const bf16x8*)(ap + k), bf0 = *(const bf16x8*)(b0p + k), bf1 = *(const bf16x8*)(b1p + k);
        acc0 = MFMA32(bf0, af, acc0); acc1 = MFMA32(bf1, af, acc1);
    }
#pragma unroll
    for (int g = 0; g < 4; ++g) { const f32x4 v0 = {acc0[4 * g], acc0[4 * g + 1], acc0[4 * g + 2], acc0[4 * g + 3]}, v1 = {acc1[4 * g], acc1[4 * g + 1], acc1[4 * g + 2], acc1[4 * g + 3]};
        E.put(m0 + r32, c0, 8 * g + 4 * hi, v0, v1); }
}
struct IdRows { __device__ __forceinline__ int src(int m) const { return m; } };

__device__ __forceinline__ void store_bf8(bf16_t* p, f32x4 a, f32x4 b) { u32x4 w; w.x = pk2(a.x, a.y); w.y = pk2(a.z, a.w); w.z = pk2(b.x, b.y); w.w = pk2(b.z, b.w); *(u32x4*)p = w; }
__device__ __forceinline__ void store_bf4(bf16_t* p, f32x4 v) { u32x2 w; w.x = pk2(v.x, v.y); w.y = pk2(v.z, v.w); *(u32x2*)p = w; }
struct EpiH {
    static constexpr bool PERM = true;
    bf16_t* H; const float2* rope32; const float2* rope64;
    __device__ __forceinline__ f32x4 xf(int pos, int col, f32x4 v) const {
        if (col < 512 || (col >= HC_KROPE && col < HC_KROPE + 32)) {
            const int j0 = (col & 31) >> 1; const f32x4 cs = *(const f32x4*)(rope32 + pos * 16 + j0);
            f32x4 o; o.x = v.x * cs.x - v.y * cs.y; o.y = v.x * cs.y + v.y * cs.x; o.z = v.z * cs.z - v.w * cs.w; o.w = v.z * cs.w + v.w * cs.z;
            if (col < 256) o = o * SC_A; v = o;
        } else if (col >= HC_CQ && col < HC_CV) {
            const int j0 = ((col - HC_CQ) & 63) >> 1; const f32x4 cs = *(const f32x4*)(rope64 + pos * 32 + j0);
            f32x4 o; o.x = v.x * cs.x - v.y * cs.y; o.y = v.x * cs.y + v.y * cs.x; o.z = v.z * cs.z - v.w * cs.w; o.w = v.z * cs.w + v.w * cs.z;
            if (col < HC_CK) o = o * SC_C; v = o;
        }
        return v;
    }
    __device__ __forceinline__ void put4(int row, int col, f32x4 v) const { store_bf4(H + (size_t)row * HP + col, xf(seqinfo(row).pos, col, v)); }
    __device__ __forceinline__ void put(int row, int c0, int cc, f32x4 v0, f32x4 v1) const { put4(row, c0 + cc, v0); put4(row, c0 + 32 + cc, v1); }
    template <class U> __device__ __forceinline__ void put8(const U&, int row, int col, f32x4 v0, f32x4 v1) const { const int pos = seqinfo(row).pos; store_bf8(H + (size_t)row * HP + col, xf(pos, col, v0), xf(pos, col + 4, v1)); }
    struct Pre { f32x4 c0, c1; };
    __device__ __forceinline__ static f32x4 rot(f32x4 v, f32x4 cs) { f32x4 o; o.x = v.x * cs.x - v.y * cs.y; o.y = v.x * cs.y + v.y * cs.x; o.z = v.z * cs.z - v.w * cs.w; o.w = v.z * cs.w + v.w * cs.z; return o; }
    template <class U> __device__ __forceinline__ Pre pre(const U&, int row, int col) const { Pre p; p.c0 = (f32x4){0.f, 0.f, 0.f, 0.f}; p.c1 = p.c0; const int pos = seqinfo(row).pos;
        if (col < 512 || (col >= HC_KROPE && col < HC_KROPE + 32)) { const f32x4* t = (const f32x4*)(rope32 + pos * 16 + ((col & 31) >> 1)); p.c0 = t[0]; p.c1 = t[1]; }
        else if (col >= HC_CQ && col < HC_CV) { const f32x4* t = (const f32x4*)(rope64 + pos * 32 + (((col - HC_CQ) & 63) >> 1)); p.c0 = t[0]; p.c1 = t[1]; }
        return p; }
    template <class U> __device__ __forceinline__ void fin8(const U&, int row, int col, f32x4 v0, f32x4 v1, const Pre& p) const {
        if (col < 512 || (col >= HC_KROPE && col < HC_KROPE + 32)) { v0 = rot(v0, p.c0); v1 = rot(v1, p.c1); if (col < 256) { v0 = v0 * SC_A; v1 = v1 * SC_A; } }
        else if (col >= HC_CQ && col < HC_CV) { v0 = rot(v0, p.c0); v1 = rot(v1, p.c1); if (col < HC_CK) { v0 = v0 * SC_C; v1 = v1 * SC_C; } }
        store_bf8(H + (size_t)row * HP + col, v0, v1); }
};
struct EpiUQ {
    static constexpr bool PERM = true;
    bf16_t* Q; const float* rstd; const float2* rope32;
    __device__ __forceinline__ f32x4 xf(int row, int col, f32x4 v, float rs) const {
        v = v * rs;
        const int t = col % 96;
        if (t >= 64) { const int pos = seqinfo(row).pos; const int j0 = (t - 64) >> 1; const f32x4 cs = *(const f32x4*)(rope32 + pos * 16 + j0);
            f32x4 o; o.x = v.x * cs.x - v.y * cs.y; o.y = v.x * cs.y + v.y * cs.x; o.z = v.z * cs.z - v.w * cs.w; o.w = v.z * cs.w + v.w * cs.z; v = o; }
        return v * SC_B;
    }
    __device__ __forceinline__ void put4(int row, int col, f32x4 v) const { if (col >= 576) return; store_bf4(Q + (size_t)row * QBP + col, xf(row, col, v, rstd[2 * row])); }
    template <class U> __device__ __forceinline__ void put8(const U&, int row, int col, f32x4 v0, f32x4 v1) const { if (col >= 576) return; const float rs = rstd[2 * row]; store_bf8(Q + (size_t)row * QBP + col, xf(row, col, v0, rs), xf(row, col + 4, v1, rs)); }
    __device__ __forceinline__ void put(int row, int c0, int cc, f32x4 v0, f32x4 v1) const { put4(row, c0 + cc, v0); put4(row, c0 + 32 + cc, v1); }
    struct Pre { float rs; f32x4 c0, c1; };
    template <class U> __device__ __forceinline__ Pre pre(const U&, int row, int col) const { Pre p; p.rs = rstd[2 * row]; p.c0 = (f32x4){0.f, 0.f, 0.f, 0.f}; p.c1 = p.c0;
        if (col < 576 && (col % 96) >= 64) { const f32x4* t = (const f32x4*)(rope32 + seqinfo(row).pos * 16 + (((col % 96) - 64) >> 1)); p.c0 = t[0]; p.c1 = t[1]; }
        return p; }
    template <class U> __device__ __forceinline__ void fin8(const U&, int row, int col, f32x4 v0, f32x4 v1, const Pre& p) const { if (col >= 576) return;
        v0 = v0 * p.rs; v1 = v1 * p.rs; if ((col % 96) >= 64) { v0 = EpiH::rot(v0, p.c0); v1 = EpiH::rot(v1, p.c1); }
        store_bf8(Q + (size_t)row * QBP + col, v0 * SC_B, v1 * SC_B); }
};
struct EpiUKV {
    static constexpr bool PERM = true;
    bf16_t* KV; const float* rstd;
    template <class U> __device__ __forceinline__ void put8(const U&, int row, int col, f32x4 v0, f32x4 v1) const { const float rs = rstd[2 * row + 1]; store_bf8(KV + (size_t)row * KVP + col, v0 * rs, v1 * rs); }
    __device__ __forceinline__ void put4(int row, int col, f32x4 v) const { store_bf4(KV + (size_t)row * KVP + col, v * rstd[2 * row + 1]); }
    __device__ __forceinline__ void put(int row, int c0, int cc, f32x4 v0, f32x4 v1) const { put4(row, c0 + cc, v0); put4(row, c0 + 32 + cc, v1); }
    struct Pre { float rs; };
    template <class U> __device__ __forceinline__ Pre pre(const U&, int row, int) const { Pre p; p.rs = rstd[2 * row + 1]; return p; }
    template <class U> __device__ __forceinline__ void fin8(const U&, int row, int col, f32x4 v0, f32x4 v1, const Pre& p) const { store_bf8(KV + (size_t)row * KVP + col, v0 * p.rs, v1 * p.rs); }
};
struct EpiRes {
    static constexpr bool PERM = false;
    float* X; const float* xp; const float* xs; float* D;
    template <class U> __device__ __forceinline__ void put4(const U&, int row, int col, f32x4 v) const { put4(row, col, v); }
    __device__ __forceinline__ void put4(int row, int col, f32x4 v) const {
        const f32x4* p = (const f32x4*)(X + (size_t)row * DM + col);
        const f32x4 r = xp ? *(const f32x4*)(((row < NTOK_P) ? xp + (size_t)row * DM : xs + (size_t)(row - NTOK_P) * DM) + col) : *p;
        *(f32x4*)(D + (size_t)row * DM + col) = r * DN_ALPHA + v; }
    __device__ __forceinline__ void put(int row, int c0, int cc, f32x4 v0, f32x4 v1) const { put4(row, c0 + cc, v0); put4(row, c0 + 32 + cc, v1); }
    struct Pre { f32x4 a, b; };
    template <class U> __device__ __forceinline__ Pre pre(const U&, int row, int col) const { Pre p;
        const float* src = xp ? ((row < NTOK_P) ? xp + (size_t)row * DM : xs + (size_t)(row - NTOK_P) * DM) : X + (size_t)row * DM;
        p.a = *(const f32x4*)(src + col); p.b = *(const f32x4*)(src + col + 16); return p; }
    template <class U> __device__ __forceinline__ void fin4x2(const U&, int row, int col, f32x4 v0, f32x4 v1, const Pre& p) const {
        *(f32x4*)(D + (size_t)row * DM + col) = p.a * DN_ALPHA + v0; *(f32x4*)(D + (size_t)row * DM + col + 16) = p.b * DN_ALPHA + v1; }
};
__device__ __forceinline__ float silu_f(float x) { return x / (1.0f + __expf(-x)); }
struct EpiHid {
    static constexpr bool PERM = true;
    bf16_t* HID;
    __device__ __forceinline__ f32x4 act(f32x4 g, f32x4 u) const { f32x4 o; o.x = silu_f(g.x) * u.x; o.y = silu_f(g.y) * u.y; o.z = silu_f(g.z) * u.z; o.w = silu_f(g.w) * u.w; return o; }
    template <class U> __device__ __forceinline__ void putp8(const U&, int row, int col, f32x4 g0, f32x4 g1, f32x4 u0, f32x4 u1) const { store_bf8(HID + (size_t)row * DEXP + col, act(g0, u0), act(g1, u1)); }
    __device__ __forceinline__ void putp(int row, int col, f32x4 g, f32x4 u) const { f32x4 o; o.x = silu_f(g.x) * u.x; o.y = silu_f(g.y) * u.y; o.z = silu_f(g.z) * u.z; o.w = silu_f(g.w) * u.w; store_bf4(HID + (size_t)row * DEXP + col, o); }
    __device__ __forceinline__ void put(int row, int c0, int cc, f32x4 v0, f32x4 v1) const { putp(row, c0 + cc, v0, v1); }
};
struct EpiY {
    bf16_t* YB; const float* tw; const int* list; int seg0, cnt;
    __device__ __forceinline__ void put4(int row, int col, f32x4 v) const { const int r = row - seg0; if (r >= cnt) return; const int a = list[r]; store_bf4(YB + (size_t)a * DM + col, v * tw[a]); }
    __device__ __forceinline__ void put(int row, int c0, int cc, f32x4 v0, f32x4 v1) const { put4(row, c0 + cc, v0); put4(row, c0 + 32 + cc, v1); }
};

struct EpiYO {
    static constexpr bool PERM = true;
    bf16_t* YB; const float* tw; const int* list; const LAS int* seg;
    template <class U> __device__ __forceinline__ void put8(const U& u, int row, int col, f32x4 v0, f32x4 v1) const {
        const int r = row - __builtin_amdgcn_readfirstlane(seg[u.e]); if (r >= __builtin_amdgcn_readfirstlane(seg[33 + u.e])) return; const int a = list[(size_t)u.e * LIST_CAP + r]; const float w = tw[a]; store_bf8(YB + (size_t)a * DM + col, v0 * w, v1 * w); }
    struct Pre { int a; float w; };
    template <class U> __device__ __forceinline__ Pre pre(const U& u, int row, int) const { Pre p; p.a = -1; p.w = 0.f;
        const int r = row - __builtin_amdgcn_readfirstlane(seg[u.e]); if (r < __builtin_amdgcn_readfirstlane(seg[33 + u.e])) { p.a = list[(size_t)u.e * LIST_CAP + r]; p.w = tw[p.a]; } return p; }
    template <class U> __device__ __forceinline__ void fin8(const U&, int, int col, f32x4 v0, f32x4 v1, const Pre& p) const { if (p.a >= 0) store_bf8(YB + (size_t)p.a * DM + col, v0 * p.w, v1 * p.w); }
};
template <class Epi>
__device__ __forceinline__ void sg_phase(Frame& F, const bf16_t* A, int lda, const bf16_t* Bt, int ldb, int M, int N, int K, const Epi& E) {
    const int nN = N / 64, items = (M / 32) * nN;
    for (int it = F.gw; it < items; it += F.NGW) { const int mt = it / nN, nt = it - mt * nN;
        sg_tile(A, lda, Bt + (size_t)(nt * 64) * ldb, Bt + (size_t)(nt * 64 + 32) * ldb, ldb, K, mt * 32, nt * 64, E, IdRows(), F.lane); }
}


namespace pg8 {
constexpr int BM = 256, BK = 64, HALF = 128, HTB = HALF * BK * 2, NXCD = 8, WGM = 8;
__host__ __device__ __forceinline__ int lds_byte(int r, int c) { const int st = (r >> 4) * 2 + (c >> 5), rr = r & 15, cc = c & 31, ob = rr * 64 + cc * 2; return st * 1024 + (ob ^ (((ob >> 9) & 1) << 5)); }
__host__ __device__ __forceinline__ void stage_rc(int b, int& R, int& C) { const int st = b / 1024, sb = b % 1024, swz = sb ^ (((sb >> 9) & 1) << 5); R = (st >> 1) * 16 + swz / 64; C = (st & 1) * 32 + (swz % 64) / 2; }
__host__ __device__ __forceinline__ int perm32(int rho) { const int n = rho >> 4, i = rho & 15; return 8 * (i >> 2) + 4 * n + (i & 3); }
struct Unit { int pm, pn, e; const char* a; const char* b; };
__device__ __forceinline__ bool order_next(int i, int G, int c, int nM, int nN, int& pm, int& pn) {
    const int nwg = nM * nN; const long L = (long)i * G + c; if (L >= nwg) return false;
    int wgid = (int)L; { const int q = nwg / NXCD, r = nwg % NXCD, xcd = wgid % NXCD, off = wgid / NXCD; wgid = (xcd < r ? xcd * (q + 1) : r * (q + 1) + (xcd - r) * q) + off; }
    const int nig = WGM * nN, gid = wgid / nig, fm = gid * WGM, gsz = (nM - fm) < WGM ? (nM - fm) : WGM;
    pm = fm + ((wgid % nig) % gsz); pn = (wgid % nig) / gsz; return true;
}
struct DenseSched {
    const char* A; const char* Bt; int nM, nN, G, c; size_t tstepA, tstepB;
    __device__ __forceinline__ void init(const bf16_t* A_, int lda, const bf16_t* Bt_, int M, int N, int K, int G_, int c_) { A = (const char*)A_; Bt = (const char*)Bt_; nM = M / BM; nN = N / BM; G = G_; c = c_; tstepA = (size_t)BM * lda * 2; tstepB = (size_t)BM * K * 2; }
    __device__ __forceinline__ bool next(int i, Unit& u) const { if (!order_next(i, G, c, nM, nN, u.pm, u.pn)) return false; u.e = 0; u.a = A + (size_t)u.pm * tstepA; u.b = Bt + (size_t)u.pn * tstepB; return true; }
    __device__ __forceinline__ unsigned arow(const Unit&, int) const { return 0u; }
};
struct PanelSched {
    const char* A; const char* Bt; int pm, nN; size_t tstepB;
    __device__ __forceinline__ void init(const bf16_t* A_, int lda, const bf16_t* Bt_, int pm_, int N, int K) { pm = pm_; nN = N / BM; A = (const char*)A_ + (size_t)pm_ * BM * lda * 2; Bt = (const char*)Bt_; tstepB = (size_t)BM * K * 2; }
    __device__ __forceinline__ bool next(int i, Unit& u) const { if (i >= nN) return false; u.pm = pm; int pn = i + (pm % nN); if (pn >= nN) pn -= nN; u.pn = pn; u.e = 0; u.a = A; u.b = Bt + (size_t)pn * tstepB; return true; }
    __device__ __forceinline__ unsigned arow(const Unit&, int) const { return 0u; }
};
template <class Epi, bool PAIR> struct EpiApply;
template <class Epi, class Sched, bool GATHER, bool PAIR>
__device__ __forceinline__ void gemm_phase(LAS unsigned char* lds, int tid, int K, int lda, const Sched& S, const Epi& E) {
    const int wid = __builtin_amdgcn_readfirstlane(tid >> 6), lane = tid & 63, wr = wid >> 2, wc = wid & 3, fr = lane & 15, fq = lane >> 4;
    const int nt = K / BK;
    unsigned voffA[2], voffB[2]; int RA[2], CA[2];
#pragma unroll
    for (int i = 0; i < 2; ++i) { int R, C; stage_rc(tid * 16 + i * 8192, R, C); const int Rb = Epi::PERM ? ((R & ~31) + perm32(R & 31)) : R; RA[i] = R; CA[i] = C;
        voffA[i] = (unsigned)(R * lda + C) * 2u; voffB[i] = (unsigned)(Rb * K + C) * 2u; }
    const size_t kstep = (size_t)(BK * 2);
    const size_t hstepA = (size_t)HALF * lda * 2, hstepB = (size_t)HALF * K * 2;
    const unsigned ldsw = (unsigned)wid * 1024u;
    const int aoff = lds_byte(wr * 64 + fr, fq * 8), boff = lds_byte(wc * 32 + fr, fq * 8);
#define PG8_SA(b, h) (((b) * 2 + (h)) * HTB)
#define PG8_SB(b, h) ((4 + (b) * 2 + (h)) * HTB)
#define PG8_STAGE(bufoff, gbase, voff) do { _Pragma("unroll") for (int _i = 0; _i < 2; ++_i) \
        __builtin_amdgcn_global_load_lds((const unsigned*)((const char*)(gbase) + (voff)[_i]), (LAS unsigned*)(lds + (bufoff) + ldsw + _i * 8192), 16, 0, 0); } while (0)
#define PG8_STAGE_A(bufoff, ab, vg, h, koff) do { if (GATHER) { PG8_STAGE(bufoff, (ab) + (koff), (vg)[h]); } else { PG8_STAGE(bufoff, (ab) + (h) * hstepA + (koff), voffA); } } while (0)
#define PG8_LDA(dst, b, h) do { _Pragma("unroll") for (int m = 0; m < 4; ++m) _Pragma("unroll") for (int k = 0; k < 2; ++k) dst[m][k] = *(const LAS bf16x8*)(lds + PG8_SA(b, h) + aoff + m * 2048 + k * 1024); } while (0)
#define PG8_LDB(dst, b, h) do { _Pragma("unroll") for (int n = 0; n < 2; ++n) _Pragma("unroll") for (int k = 0; k < 2; ++k) dst[n][k] = *(const LAS bf16x8*)(lds + PG8_SB(b, h) + boff + n * 2048 + k * 1024); } while (0)
#define PG8_MMA(ai, bj, At, Bt) do { __builtin_amdgcn_s_setprio(1); _Pragma("unroll") for (int m = 0; m < 4; ++m) _Pragma("unroll") for (int n = 0; n < 2; ++n) _Pragma("unroll") for (int k = 0; k < 2; ++k) \
        acc[ai][bj][m][n] = __builtin_amdgcn_mfma_f32_16x16x32_bf16(Bt[n][k], At[m][k], acc[ai][bj][m][n], 0, 0, 0); __builtin_amdgcn_s_setprio(0); } while (0)
#define PG8_WAIT_V(n) asm volatile("s_waitcnt vmcnt(" #n ")" ::: "memory")
#define PG8_WAIT_L(n) asm volatile("s_waitcnt lgkmcnt(" #n ")" ::: "memory")
#define PG8_BAR __builtin_amdgcn_s_barrier()
#define PG8_SCHED __builtin_amdgcn_sched_barrier(0)
    Unit cur, nxt; int ui = 0;
    if (!S.next(0, cur)) return;
    f32x4 acc[2][2][4][2];
#pragma unroll
    for (int a = 0; a < 2; ++a)
#pragma unroll
        for (int b = 0; b < 2; ++b)
#pragma unroll
            for (int m = 0; m < 4; ++m)
#pragma unroll
                for (int n = 0; n < 2; ++n) acc[a][b][m][n] = (f32x4){0.f, 0.f, 0.f, 0.f};
    bf16x8 At[4][2], B0[2][2], B1[2][2];
    unsigned vgc[2][2] = {{0u, 0u}, {0u, 0u}}, vgn[2][2] = {{0u, 0u}, {0u, 0u}};
    if (GATHER) {
#pragma unroll
        for (int h = 0; h < 2; ++h)
#pragma unroll
            for (int i = 0; i < 2; ++i) vgc[h][i] = S.arow(cur, h * HALF + RA[i]) * (unsigned)(lda * 2) + (unsigned)CA[i] * 2u;
    }
    const char* cA = cur.a; const char* cB = cur.b;
    PG8_STAGE(PG8_SB(0, 0), cB, voffB); PG8_STAGE(PG8_SB(0, 1), cB + hstepB, voffB); PG8_STAGE_A(PG8_SA(0, 0), cA, vgc, 0, 0); PG8_STAGE_A(PG8_SA(0, 1), cA, vgc, 1, 0);
    if (wr == 1) PG8_BAR;
    PG8_WAIT_V(2); PG8_BAR;
    PG8_STAGE(PG8_SB(1, 0), cB + kstep, voffB); PG8_STAGE_A(PG8_SA(1, 0), cA, vgc, 0, kstep); PG8_STAGE(PG8_SB(1, 1), cB + hstepB + kstep, voffB);
    PG8_WAIT_V(6); PG8_BAR;
    for (;;) {
        const bool has_next = S.next(ui + 1, nxt);
        const char* nA = has_next ? nxt.a : cA; const char* nB = has_next ? nxt.b : cB;
        if (GATHER) {
#pragma unroll
            for (int h = 0; h < 2; ++h)
#pragma unroll
                for (int i = 0; i < 2; ++i) vgn[h][i] = has_next ? (S.arow(nxt, h * HALF + RA[i]) * (unsigned)(lda * 2) + (unsigned)CA[i] * 2u) : vgc[h][i];
        }
#pragma clang loop unroll(disable)
        for (int t = 0; t < nt; t += 2) {
            const bool last = (t == nt - 2);
            const size_t k1 = (size_t)(t + 1) * kstep;
            const char* a2 = last ? nA : cA; const char* b2 = last ? nB : cB + (size_t)(t + 2) * kstep; const size_t ka2 = last ? 0 : (size_t)(t + 2) * kstep;
            const char* b3 = b2 + kstep; const size_t ka3 = ka2 + kstep;
            unsigned v2[2][2];
#pragma unroll
            for (int h = 0; h < 2; ++h)
#pragma unroll
                for (int i = 0; i < 2; ++i) v2[h][i] = last ? vgn[h][i] : vgc[h][i];
            PG8_LDB(B0, 0, 0); PG8_LDB(B1, 0, 1); PG8_SCHED; PG8_LDA(At, 0, 0); PG8_STAGE_A(PG8_SA(1, 1), cA, vgc, 1, k1);
            PG8_WAIT_V(8); PG8_WAIT_L(0); PG8_BAR; PG8_MMA(0, 0, At, B0); PG8_MMA(0, 1, At, B1); PG8_BAR; PG8_SCHED;
            PG8_LDA(At, 0, 1); PG8_STAGE(PG8_SB(0, 0), b2, voffB); PG8_STAGE(PG8_SB(0, 1), b2 + hstepB, voffB); PG8_STAGE_A(PG8_SA(0, 0), a2, v2, 0, ka2);
            PG8_WAIT_V(8); PG8_WAIT_L(0); PG8_BAR; PG8_MMA(1, 0, At, B0); PG8_MMA(1, 1, At, B1); PG8_BAR; PG8_SCHED;
            PG8_LDB(B0, 1, 0); PG8_LDB(B1, 1, 1); PG8_SCHED; PG8_LDA(At, 1, 0); PG8_STAGE_A(PG8_SA(0, 1), a2, v2, 1, ka2);
            PG8_WAIT_V(8); PG8_WAIT_L(0); PG8_BAR; PG8_MMA(0, 0, At, B0); PG8_MMA(0, 1, At, B1); PG8_BAR; PG8_SCHED;
            PG8_LDA(At, 1, 1); PG8_STAGE(PG8_SB(1, 0), b3, voffB); PG8_STAGE(PG8_SB(1, 1), b3 + hstepB, voffB); PG8_STAGE_A(PG8_SA(1, 0), a2, v2, 0, ka3);
            PG8_WAIT_V(8); PG8_WAIT_L(0); PG8_BAR; PG8_MMA(1, 0, At, B0); PG8_MMA(1, 1, At, B1); PG8_BAR; PG8_SCHED;
        }
        if (wr == 0) PG8_BAR;
        { int fr_ = fr, fq_ = fq; asm volatile("" : "+v"(fr_), "+v"(fq_));
          EpiApply<Epi, PAIR>::run(E, acc, cur, wr, wc, fr_, fq_); }
        if (!has_next) break;
#pragma unroll
        for (int a = 0; a < 2; ++a)
#pragma unroll
            for (int b = 0; b < 2; ++b)
#pragma unroll
                for (int m = 0; m < 4; ++m)
#pragma unroll
                    for (int n = 0; n < 2; ++n) acc[a][b][m][n] = (f32x4){0.f, 0.f, 0.f, 0.f};
        cur = nxt; cA = nA; cB = nB; ++ui;
        if (GATHER) {
#pragma unroll
            for (int h = 0; h < 2; ++h)
#pragma unroll
                for (int i = 0; i < 2; ++i) vgc[h][i] = vgn[h][i];
        }
        if (wr == 1) PG8_BAR;
    }
    PG8_WAIT_V(0);
    PG8_BAR;
#undef PG8_SA
#undef PG8_SB
#undef PG8_STAGE
#undef PG8_STAGE_A
#undef PG8_LDA
#undef PG8_LDB
#undef PG8_MMA
#undef PG8_WAIT_V
#undef PG8_WAIT_L
#undef PG8_BAR
#undef PG8_SCHED
}
template <class Epi> struct EpiApply<Epi, false> {
    static __device__ __forceinline__ void run(const Epi& E, const f32x4 (&acc)[2][2][4][2], const Unit& u, int wr, int wc, int fr, int fq) {
#pragma unroll
        for (int ai = 0; ai < 2; ++ai) {
            typename Epi::Pre pre[4][2];
#pragma unroll
            for (int m = 0; m < 4; ++m) { const int row = u.pm * BM + ai * HALF + wr * 64 + m * 16 + fr;
#pragma unroll
                for (int bj = 0; bj < 2; ++bj) pre[m][bj] = E.pre(u, row, u.pn * BM + bj * HALF + wc * 32 + (Epi::PERM ? 8 : 4) * fq); }
#pragma unroll
            for (int m = 0; m < 4; ++m) { const int row = u.pm * BM + ai * HALF + wr * 64 + m * 16 + fr;
#pragma unroll
                for (int bj = 0; bj < 2; ++bj) {
                    if constexpr (Epi::PERM) E.fin8(u, row, u.pn * BM + bj * HALF + wc * 32 + 8 * fq, acc[ai][bj][m][0], acc[ai][bj][m][1], pre[m][bj]);
                    else E.fin4x2(u, row, u.pn * BM + bj * HALF + wc * 32 + 4 * fq, acc[ai][bj][m][0], acc[ai][bj][m][1], pre[m][bj]); } }
        }
    }
};
template <class Epi> struct EpiApply<Epi, true> {
    static __device__ __forceinline__ void run(const Epi& E, const f32x4 (&acc)[2][2][4][2], const Unit& u, int wr, int wc, int fr, int fq) {
#pragma unroll
        for (int ai = 0; ai < 2; ++ai)
#pragma unroll
            for (int m = 0; m < 4; ++m) { const int row = u.pm * BM + ai * HALF + wr * 64 + m * 16 + fr;
                E.putp8(u, row, u.pn * HALF + wc * 32 + 8 * fq, acc[ai][0][m][0], acc[ai][0][m][1], acc[ai][1][m][0], acc[ai][1][m][1]); }
    }
};
}

__device__ __forceinline__ void rowstat_pass(Frame& F, int r_first, int r_stride, int r_end) {
    const bf16_t* H = (const bf16_t*)(F.ws + WS_H); float* rstd = (float*)(F.ws + WS_RSTD);
    for (int m = r_first; m < r_end; m += r_stride) {
        const bf16_t* hr = H + (size_t)m * HP;
        const u32x2 q = *((const u32x2*)(hr + HC_CQ_LAT) + F.lane);
        const unsigned kv = *((const unsigned*)(hr + HC_CKV) + F.lane);
        float a0 = bf2f(q.x & 0xffff), a1 = bf2f(q.x >> 16), a2 = bf2f(q.y & 0xffff), a3 = bf2f(q.y >> 16), b0 = bf2f(kv & 0xffff), b1 = bf2f(kv >> 16);
        const float sq = wave_sum(a0 * a0 + a1 * a1 + a2 * a2 + a3 * a3), sk = wave_sum(b0 * b0 + b1 * b1);
        if (F.lane == 0) { rstd[2 * m] = 1.0f / sqrtf(sq * (1.0f / 256.0f) + RMS_EPS); rstd[2 * m + 1] = 1.0f / sqrtf(sk * (1.0f / 128.0f) + RMS_EPS); }
    }
}
__device__ __forceinline__ void red8(float (&v)[8], int lane) {
    float a[4], b[2], c;
#pragma unroll
    for (int i = 0; i < 4; ++i) a[i] = xpair32(v[i], v[i + 4]);
    { const bool up = (lane & 16) != 0;
#pragma unroll
      for (int i = 0; i < 2; ++i) { const float send = up ? a[i] : a[i + 2], keep = up ? a[i + 2] : a[i]; b[i] = keep + shx<16>(send); } }
    { const bool up = (lane & 8) != 0; const float send = up ? b[0] : b[1], keep = up ? b[1] : b[0]; c = keep + shx<8>(send); }
    c += shx<4>(c); c += shx<2>(c); c += shx<1>(c);
#pragma unroll
    for (int i = 0; i < 8; ++i) v[i] = __uint_as_float(__builtin_amdgcn_readlane(__float_as_uint(c), ((i >> 2) & 1) * 32 + ((i >> 1) & 1) * 16 + (i & 1) * 8));
}
__device__ __forceinline__ void red4(float (&v)[4], int lane) {
    float a[2], c;
#pragma unroll
    for (int i = 0; i < 2; ++i) a[i] = xpair32(v[i], v[i + 2]);
    { const bool up = (lane & 16) != 0; const float send = up ? a[0] : a[1], keep = up ? a[1] : a[0]; c = keep + shx<16>(send); }
    c += shx<8>(c); c += shx<4>(c); c += shx<2>(c); c += shx<1>(c);
#pragma unroll
    for (int i = 0; i < 4; ++i) v[i] = __uint_as_float(__builtin_amdgcn_readlane(__float_as_uint(c), ((i >> 1) & 1) * 32 + (i & 1) * 16));
}
__device__ __forceinline__ void ln1_route_pass(Frame& F, const Args& a, int layer, int r_first, int r_stride, int r_end) {
    bf16_t* XB = (bf16_t*)(F.ws + WS_XB); float* tw = (float*)(F.ws + WS_TW); int* list = (int*)(F.ws + WS_LIST);
    const float* g = a.ln1_g + layer * DM; const float* bb = a.ln1_b + layer * DM;
    const float* wc = a.moe_w_coarse + (size_t)layer * DM * 4; const float* wf = a.moe_w_fine + (size_t)layer * 4 * DM * 8;
    for (int q = F.tid; q < 4 * 1024 * 2; q += NTHREADS) { const int hf = q & 1, k = (q >> 1) & 1023, gg = q >> 11; const int l = (k & 255) >> 2, e = k & 3, j = k >> 8;
        *(LAS f32x4*)(F.lds + (size_t)(gg * 2048 + ((j * 4 + e) * 2 + hf) * 64 + l) * 16) = *((const f32x4*)wf + q); }
    f32x4 wcr[4][4];
#pragma unroll
    for (int j = 0; j < 4; ++j)
#pragma unroll
        for (int e = 0; e < 4; ++e) wcr[j][e] = *(const f32x4*)(wc + (size_t)(4 * F.lane + 256 * j + e) * 4);
    __syncthreads();
    f32x4 vn[2][4];
#pragma unroll
    for (int rr = 0; rr < 2; ++rr) { const int mm = r_first + rr * r_stride; if (mm < r_end) {
#pragma unroll
        for (int j = 0; j < 4; ++j) vn[rr][j] = *((const f32x4*)(a.out + (size_t)mm * DM) + F.lane + 64 * j); } }
    for (int m0 = r_first; m0 < r_end; m0 += 2 * r_stride) {
        f32x4 vc[2][4];
#pragma unroll
        for (int rr = 0; rr < 2; ++rr)
#pragma unroll
            for (int j = 0; j < 4; ++j) vc[rr][j] = vn[rr][j];
#pragma unroll
        for (int rr = 0; rr < 2; ++rr) { const int mm = m0 + (2 + rr) * r_stride; if (mm < r_end) {
#pragma unroll
            for (int j = 0; j < 4; ++j) vn[rr][j] = *((const f32x4*)(a.out + (size_t)mm * DM) + F.lane + 64 * j); } }
#pragma unroll
      for (int rr = 0; rr < 2; ++rr) { const int m = m0 + rr * r_stride; if (m < r_end) {
        f32x4 v[4]; float s = 0.f;
#pragma unroll
        for (int j = 0; j < 4; ++j) { v[j] = vc[rr][j]; s += (v[j].x + v[j].y) + (v[j].z + v[j].w); }
        const float mean = wave_sum(s) * (1.f / DM); float s2 = 0.f;
#pragma unroll
        for (int j = 0; j < 4; ++j) { v[j] = v[j] - mean; s2 += (v[j].x * v[j].x + v[j].y * v[j].y) + (v[j].z * v[j].z + v[j].w * v[j].w); }
        const float rs = 1.f / sqrtf(wave_sum(s2) * (1.f / DM) + LN_EPS);
        float cl[4] = {0.f, 0.f, 0.f, 0.f};
#pragma unroll
        for (int j = 0; j < 4; ++j) { const int c = 4 * F.lane + 256 * j; const f32x4 gg = *(const f32x4*)(g + c), bv = *(const f32x4*)(bb + c); v[j] = v[j] * rs * gg + bv;
            u32x2 w; w.x = pk2(v[j].x, v[j].y); w.y = pk2(v[j].z, v[j].w); *((u32x2*)(XB + (size_t)m * DM) + F.lane + 64 * j) = w;
#pragma unroll
            for (int e = 0; e < 4; ++e) { const f32x4 w4 = wcr[j][e]; const float xe = v[j][e]; cl[0] += xe * w4.x; cl[1] += xe * w4.y; cl[2] += xe * w4.z; cl[3] += xe * w4.w; } }
        red4(cl, F.lane);
        int grp = 0; float cm = cl[0];
#pragma unroll
        for (int e = 1; e < 4; ++e) if (cl[e] > cm) { cm = cl[e]; grp = e; }
        float den = 0.f;
#pragma unroll
        for (int e = 0; e < 4; ++e) den += __expf(cl[e] - cm);
        const float pg = 1.0f / den;
        grp = __builtin_amdgcn_readfirstlane(grp);
        const LAS f32x4* wl = (const LAS f32x4*)(F.lds) + grp * 2048 + F.lane;
        float fl[8] = {0.f, 0.f, 0.f, 0.f, 0.f, 0.f, 0.f, 0.f};
#pragma unroll
        for (int j = 0; j < 4; ++j)
#pragma unroll
            for (int e = 0; e < 4; ++e) { const f32x4 wa = wl[((j * 4 + e) * 2) * 64], wb = wl[((j * 4 + e) * 2 + 1) * 64]; const float xe = v[j][e];
                fl[0] += xe * wa.x; fl[1] += xe * wa.y; fl[2] += xe * wa.z; fl[3] += xe * wa.w; fl[4] += xe * wb.x; fl[5] += xe * wb.y; fl[6] += xe * wb.z; fl[7] += xe * wb.w; }
        red8(fl, F.lane);
        int i0 = 0; float v0 = fl[0];
#pragma unroll
        for (int e = 1; e < 8; ++e) if (fl[e] > v0) { v0 = fl[e]; i0 = e; }
        int i1 = -1; float v1 = -3.0e38f;
#pragma unroll
        for (int e = 0; e < 8; ++e) if (e != i0 && fl[e] > v1) { v1 = fl[e]; i1 = e; }
        const float e1 = __expf(v1 - v0), w0 = pg / (1.0f + e1), w1 = pg * e1 / (1.0f + e1);
        if (F.lane < 2) { const int e = grp * 8 + (F.lane == 0 ? i0 : i1); const int a_id = 2 * m + F.lane;
            const unsigned pos = __hip_atomic_fetch_add(F.ctl + CW_CNT + layer * 64 + e, 1u, RLX_AGENT);
            list[(size_t)e * LIST_CAP + pos] = a_id; tw[a_id] = (F.lane == 0) ? w0 : w1; }
          } }
    }
    __syncthreads();
}
__device__ __forceinline__ void ln2_pass(Frame& F, const Args& a, int layer, int r_first, int r_stride, int r_end) {
    bf16_t* XB = (bf16_t*)(F.ws + WS_XB); const bf16_t* YB = (const bf16_t*)(F.ws + WS_YB);
    const float* g = a.ln2_g + layer * DM; const float* bb = a.ln2_b + layer * DM; const float* g1 = a.ln1_g + layer * DM; const float* b1 = a.ln1_b + layer * DM;
    f32x4 xn[2][4]; u32x2 pn[2][4], qn[2][4];
#define LN2_LOAD(rr, mm) do { const bf16_t* y0_ = YB + (size_t)(2 * (mm)) * DM; _Pragma("unroll") for (int j = 0; j < 4; ++j) { xn[rr][j] = *((const f32x4*)(a.out + (size_t)(mm) * DM) + F.lane + 64 * j); \
        pn[rr][j] = *((const u32x2*)y0_ + F.lane + 64 * j); qn[rr][j] = *((const u32x2*)(y0_ + DM) + F.lane + 64 * j); } } while (0)
#pragma unroll
    for (int rr = 0; rr < 2; ++rr) { const int mm = r_first + rr * r_stride; if (mm < r_end) LN2_LOAD(rr, mm); }
    for (int m0 = r_first; m0 < r_end; m0 += 2 * r_stride) {
        f32x4 xc[2][4]; u32x2 pc[2][4], qc[2][4];
#pragma unroll
        for (int rr = 0; rr < 2; ++rr)
#pragma unroll
            for (int j = 0; j < 4; ++j) { xc[rr][j] = xn[rr][j]; pc[rr][j] = pn[rr][j]; qc[rr][j] = qn[rr][j]; }
#pragma unroll
        for (int rr = 0; rr < 2; ++rr) { const int mm = m0 + (2 + rr) * r_stride; if (mm < r_end) LN2_LOAD(rr, mm); }
#pragma unroll
        for (int rr = 0; rr < 2; ++rr) { const int m = m0 + rr * r_stride; if (m < r_end) {
            float* xr = a.out + (size_t)m * DM;
            f32x4 v[4]; float s = 0.f;
            { float s1 = 0.f;
#pragma unroll
              for (int j = 0; j < 4; ++j) { v[j] = xc[rr][j]; s1 += (v[j].x + v[j].y) + (v[j].z + v[j].w); }
              const float mean1 = wave_sum(s1) * (1.f / DM); float q1 = 0.f;
#pragma unroll
              for (int j = 0; j < 4; ++j) { v[j] = v[j] - mean1; q1 += (v[j].x * v[j].x + v[j].y * v[j].y) + (v[j].z * v[j].z + v[j].w * v[j].w); }
              const float rs1 = 1.f / sqrtf(wave_sum(q1) * (1.f / DM) + LN_EPS);
#pragma unroll
              for (int j = 0; j < 4; ++j) { const int c = 4 * F.lane + 256 * j; xc[rr][j] = v[j] * rs1 * *(const f32x4*)(g1 + c) + *(const f32x4*)(b1 + c); } }
#pragma unroll
            for (int j = 0; j < 4; ++j) { v[j] = xc[rr][j] * DN_ALPHA; const u32x2 p = pc[rr][j], q = qc[rr][j];
                v[j].x += bf2f(p.x & 0xffff) + bf2f(q.x & 0xffff); v[j].y += bf2f(p.x >> 16) + bf2f(q.x >> 16); v[j].z += bf2f(p.y & 0xffff) + bf2f(q.y & 0xffff); v[j].w += bf2f(p.y >> 16) + bf2f(q.y >> 16);
                s += (v[j].x + v[j].y) + (v[j].z + v[j].w); }
            const float mean = wave_sum(s) * (1.f / DM); float s2 = 0.f;
#pragma unroll
            for (int j = 0; j < 4; ++j) { v[j] = v[j] - mean; s2 += (v[j].x * v[j].x + v[j].y * v[j].y) + (v[j].z * v[j].z + v[j].w * v[j].w); }
            const float rs = 1.f / sqrtf(wave_sum(s2) * (1.f / DM) + LN_EPS);
#pragma unroll
            for (int j = 0; j < 4; ++j) { const int c = 4 * F.lane + 256 * j; const f32x4 gg = *(const f32x4*)(g + c), bv = *(const f32x4*)(bb + c); v[j] = v[j] * rs * gg + bv;
                *((f32x4*)xr + F.lane + 64 * j) = v[j]; u32x2 w; w.x = pk2(v[j].x, v[j].y); w.y = pk2(v[j].z, v[j].w); *((u32x2*)(XB + (size_t)m * DM) + F.lane + 64 * j) = w; }
        } }
    }
#undef LN2_LOAD
}
__device__ __forceinline__ void moe_convert(Frame& F, const Args& a, int layer) {
    LAS float* scr = (LAS float*)(F.lds + F.wave * 16384);
    constexpr int I_13 = (1024 / 64) * (1024 / 32), I_2 = (512 / 64) * (1024 / 32), PER_E = I_13 + I_2;
    for (int it = F.gw; it < NEXP * PER_E; it += F.NGW) {
        const int e = it / PER_E; int r = it - e * PER_E; const size_t le = (size_t)layer * NEXP + e;
        if (r < I_13) { const int kb = r / 32, nb = r % 32; const float* src = ((nb >> 2) & 1) ? a.moe_w3 : a.moe_w1;
            const int sc0 = ((32 * nb) >> 8) * 128 + ((32 * nb) & 127);
            transpose_item_v4(src + le * 1024 * 512 + (size_t)(kb * 64) * 512 + sc0, 512, (bf16_t*)(F.ws + WS_W13) + (size_t)e * 1024 * 1024 + (size_t)(nb * 32) * 1024 + kb * 64, 1024, scr, F.lane); }
        else { r -= I_13; const int kb = r / 32, nb = r % 32;
            transpose_item_v4(a.moe_w2 + le * 512 * 1024 + (size_t)(kb * 64) * 1024 + nb * 32, 1024, (bf16_t*)(F.ws + WS_W2) + (size_t)e * 1024 * 512 + (size_t)(nb * 32) * 512 + kb * 64, 512, scr, F.lane); }
    }
}

typedef short at_s16x4 __attribute__((ext_vector_type(4)));
typedef LAS const unsigned char* at_lds_cptr;
__device__ __forceinline__ at_s16x4 at_vtr(at_lds_cptr p) { return __builtin_bit_cast(at_s16x4, __builtin_amdgcn_ds_read_tr16_b64_v4i16((LAS at_s16x4*)p)); }
struct RowSrc { const bf16_t* p; long pitch; };
constexpr int SA_P = 0, SA_V = 4096, SA_AL = 12288, SA_RL = 12544;
template <int NC0, int NC1, int MODE>
__device__ __forceinline__ void sattn_core(const bf16x8* qf, RowSrc k0, RowSrc k1, RowSrc vs, int kb_lo, int kb_hi, int qidx0, float lse_ref, LAS unsigned char* scr, int lane, f32x16* o, float& lse_out) {
    const int r32 = lane & 31, hi = lane >> 5;
    LAS bf16_t* Pb = (LAS bf16_t*)(scr + SA_P); LAS bf16_t* Vb = (LAS bf16_t*)(scr + SA_V); LAS float* Al = (LAS float*)(scr + SA_AL);
    float m = -1.0e30f, l = 0.f;
    if (MODE != 1) { o[0] = f32x16{}; o[1] = f32x16{}; }
    bf16x8 kn[NC0 + NC1]; u32x4 vn[4];
#define SA_LOAD(kb_) do { const long key_ = (long)(kb_) * 32 + r32; \
        _Pragma("unroll") for (int c = 0; c < NC0; ++c) kn[c] = *(const bf16x8*)(k0.p + key_ * k0.pitch + 16 * c + 8 * hi); \
        _Pragma("unroll") for (int c = 0; c < NC1; ++c) kn[NC0 + c] = *(const bf16x8*)(k1.p + key_ * k1.pitch + 16 * c + 8 * hi); \
        if (MODE != 1) { _Pragma("unroll") for (int i = 0; i < 4; ++i) { const int idx = i * 64 + lane, kr = idx >> 3, pc = idx & 7; vn[i] = *(const u32x4*)(vs.p + ((long)(kb_) * 32 + kr) * vs.pitch + pc * 8); } } } while (0)
    if (kb_lo < kb_hi) SA_LOAD(kb_lo);
    const at_lds_cptr vtb = (at_lds_cptr)(scr + SA_V) + ((8 * hi + ((lane & 15) >> 2)) * 72 + 16 * ((lane >> 4) & 1) + 4 * (lane & 3)) * 2;
    for (int kb = kb_lo; kb < kb_hi; ++kb) {
        bf16x8 kc[NC0 + NC1]; u32x4 vc[4];
#pragma unroll
        for (int c = 0; c < NC0 + NC1; ++c) kc[c] = kn[c];
#pragma unroll
        for (int i = 0; i < 4; ++i) vc[i] = vn[i];
        if (kb + 1 < kb_hi) SA_LOAD(kb + 1);
        f32x16 s = {};
#pragma unroll
        for (int c = 0; c < NC0 + NC1; ++c) s = MFMA32(kc[c], qf[c], s);
        bool valid[16];
#pragma unroll
        for (int r = 0; r < 16; ++r) { if (MODE == 0) valid[r] = true; else { const int d = kb * 32 + crow(r, hi) - (qidx0 + r32); valid[r] = (d <= 64 && d >= -64); } }
        float p[16];
        if (MODE == 2) {
#pragma unroll
            for (int r = 0; r < 16; ++r) p[r] = valid[r] ? fast_exp2(s[r] - lse_ref) : 0.f;
        } else {
            float mx = -1.0e30f;
#pragma unroll
            for (int r = 0; r < 16; ++r) if (valid[r]) mx = fmaxf(mx, s[r]);
            mx = xmax32(mx);
            const float mn = fmaxf(m, mx), alpha = fast_exp2(m - mn); m = mn;
            float ps = 0.f;
#pragma unroll
            for (int r = 0; r < 16; ++r) { p[r] = valid[r] ? fast_exp2(s[r] - mn) : 0.f; ps += p[r]; }
            l = l * alpha + ps;
            if (MODE == 0) { if (hi == 0) Al[r32] = alpha; }
        }
        if (MODE != 1) {
#pragma unroll
            for (int g = 0; g < 4; ++g) { u32x2 w; w.x = pk2(p[4 * g], p[4 * g + 1]); w.y = pk2(p[4 * g + 2], p[4 * g + 3]); *(LAS u32x2*)(Pb + r32 * 40 + 8 * g + 4 * hi) = w; }
#pragma unroll
            for (int i = 0; i < 4; ++i) { const int idx = i * 64 + lane, kr = idx >> 3, pc = idx & 7; *(LAS u32x4*)(Vb + kr * 72 + pc * 8) = vc[i]; }
            LDS_WAIT();
            if (MODE == 0) {
#pragma unroll
                for (int r = 0; r < 16; ++r) { const float al = Al[crow(r, hi)]; o[0][r] *= al; o[1][r] *= al; }
            }
#pragma unroll
            for (int st = 0; st < 2; ++st) {
                const bf16x8 pf = *(const LAS bf16x8*)(Pb + r32 * 40 + 16 * st + 8 * hi);
#pragma unroll
                for (int db = 0; db < 2; ++db) {
                    const at_s16x4 lo_ = at_vtr(vtb + (16 * st * 72 + 32 * db) * 2), hi_ = at_vtr(vtb + ((16 * st + 4) * 72 + 32 * db) * 2);
                    const bf16x8 vf = {lo_[0], lo_[1], lo_[2], lo_[3], hi_[0], hi_[1], hi_[2], hi_[3]};
                    o[db] = MFMA32(pf, vf, o[db]); }
            }
            LDS_WAIT();
        }
    }
#undef SA_LOAD
    if (MODE != 2) { l = xsum32(l); lse_out = m + __log2f(l); }
    if (MODE == 0) {
        LAS float* Rl = (LAS float*)(scr + SA_RL);
        if (hi == 0) Rl[r32] = 1.0f / l;
        LDS_WAIT();
#pragma unroll
        for (int r = 0; r < 16; ++r) { const float rl = Rl[crow(r, hi)]; o[0][r] *= rl; o[1][r] *= rl; }
        LDS_WAIT();
    }
}

__device__ __forceinline__ void sattn_phase(Frame& F, const Args& a, int layer, int kind_lo) {
    const bf16_t* H = (const bf16_t*)(F.ws + WS_H); const bf16_t* QB = (const bf16_t*)(F.ws + WS_QB); const bf16_t* KVB = (const bf16_t*)(F.ws + WS_KVB);
    bf16_t* MIX = (bf16_t*)(F.ws + WS_MIX); const float* lsec = (const float*)(F.ws + WS_LSEC);
    LAS unsigned char* scr = F.lds + F.wave * 16384;
    const int lane = F.lane, r32 = lane & 31, hi = lane >> 5;
    float lam, lam_init;
    { const float* lv = a.diff_lambda + layer * 128; float d1 = 0.f, d2 = 0.f;
      for (int i = 0; i < 32; ++i) { d1 += lv[i] * lv[32 + i]; d2 += lv[64 + i] * lv[96 + i]; }
      lam_init = 0.8f - 0.6f * expf(-0.3f * (float)layer); lam = expf(d1) - expf(d2) + lam_init; }
    constexpr int NRB = NTOK / 32;
    const int items = NRB * (4 + 6 + 6);
    for (int it = kind_lo * NRB + F.gw; it < items; it += F.NGW) {
        const int kind = it / NRB, rb = it - kind * NRB; const int m0 = rb * 32; const SeqInfo si = seqinfo(m0);
#if !OPT_ATTN
        if (kind < 4) {
            const int h = kind; f32x16 o0[2], o1[2]; float dummy;
            for (int c = 0; c < 2; ++c) {
                bf16x8 qf[2];
#pragma unroll
                for (int d0 = 0; d0 < 2; ++d0) qf[d0] = *(const bf16x8*)(H + (size_t)(m0 + r32) * HP + HC_AQ + h * 64 + c * 32 + 16 * d0 + 8 * hi);
                const RowSrc ks{H + (size_t)si.base * HP + HC_AK + h * 64 + c * 32, HP}, vs{H + (size_t)si.base * HP + HC_AV + h * 64, HP};
                sattn_core<2, 0, 0>(qf, ks, ks, vs, 0, si.len / 32, 0, 0.f, scr, lane, c == 0 ? o0 : o1, dummy);
            }
            const float* sg = a.diff_subln + layer * 64; const float g0 = sg[r32], g1 = sg[32 + r32];
#pragma unroll
            for (int r = 0; r < 16; ++r) { const float x0 = o0[0][r] - lam * o1[0][r], x1 = o0[1][r] - lam * o1[1][r]; float ss = x0 * x0 + x1 * x1;
                ss += shx<1>(ss); ss += shx<2>(ss); ss += shx<4>(ss); ss += shx<8>(ss); ss += shx<16>(ss);
                const float rs = (1.0f - lam_init) / sqrtf(ss * (1.0f / 64.0f) + RMS_EPS);
                bf16_t* op = MIX + (size_t)(m0 + crow(r, hi)) * DM + MIX_A + h * 64 + r32;
                op[0] = (bf16_t)f2bf(x0 * rs * g0); op[32] = (bf16_t)f2bf(x1 * rs * g1); }
        } else if (kind < 10) {
            const int h = kind - 4; f32x16 o[2]; float dummy; bf16x8 qf[6];
#pragma unroll
            for (int d0 = 0; d0 < 6; ++d0) qf[d0] = *(const bf16x8*)(QB + (size_t)(m0 + r32) * QBP + h * 96 + 16 * d0 + 8 * hi);
            const RowSrc k0{KVB + (size_t)si.base * KVP + h * 128, KVP}, k1{H + (size_t)si.base * HP + HC_KROPE, HP}, vs{KVB + (size_t)si.base * KVP + h * 128 + 64, KVP};
            sattn_core<4, 2, 0>(qf, k0, k1, vs, 0, si.len / 32, 0, 0.f, scr, lane, o, dummy);
#pragma unroll
            for (int r = 0; r < 16; ++r) { bf16_t* op = MIX + (size_t)(m0 + crow(r, hi)) * DM + MIX_B + h * 64 + r32; op[0] = (bf16_t)f2bf(o[0][r]); op[32] = (bf16_t)f2bf(o[1][r]); }
        } else
#endif
        {
            const int gj = kind - 10, g = gj >> 1, hh = gj;
            const int dil = (g == 0) ? 1 : (g == 1 ? 4 : 16); const int L = si.len / dil, bpr = L / 32;
            const int w = (m0 - si.base) / 32, rho = w / bpr, ib = w - rho * bpr, i0 = ib * 32;
            const size_t qrow = (size_t)si.base + (size_t)(i0 + r32) * dil + rho;
            bf16x8 qf[4];
#pragma unroll
            for (int d0 = 0; d0 < 4; ++d0) qf[d0] = *(const bf16x8*)(H + qrow * HP + HC_CQ + hh * 64 + 16 * d0 + 8 * hi);
            const int j = gj & 1; const float l0 = lsec[(0 * (size_t)NTOK + qrow) * 2 + j], l1 = lsec[(1 * (size_t)NTOK + qrow) * 2 + j], l2 = lsec[(2 * (size_t)NTOK + qrow) * 2 + j];
            const float lm = fmaxf(l0, fmaxf(l1, l2)); const float lref = lm + __log2f(fast_exp2(l0 - lm) + fast_exp2(l1 - lm) + fast_exp2(l2 - lm));
            const RowSrc ks{H + ((size_t)si.base + rho) * HP + HC_CK + hh * 64, (long)HP * dil}, vs{H + ((size_t)si.base + rho) * HP + HC_CV + hh * 64, (long)HP * dil};
            int kb_lo = ib - 2, kb_hi = ib + 3; if (kb_lo < 0) kb_lo = 0; if (kb_hi > bpr) kb_hi = bpr;
            f32x16 o[2]; float dummy;
            sattn_core<4, 0, 2>(qf, ks, ks, vs, kb_lo, kb_hi, i0, lref, scr, lane, o, dummy);
#pragma unroll
            for (int r = 0; r < 16; ++r) { const size_t orow = (size_t)si.base + (size_t)(i0 + crow(r, hi)) * dil + rho; bf16_t* op = MIX + orow * DM + MIX_C + hh * 64 + r32; op[0] = (bf16_t)f2bf(o[0][r]); op[32] = (bf16_t)f2bf(o[1][r]); }
        }
    }
}
__device__ __forceinline__ void cstat_phase(Frame& F) {
    const bf16_t* H = (const bf16_t*)(F.ws + WS_H); float* lsec = (float*)(F.ws + WS_LSEC);
    LAS unsigned char* scr = F.lds + F.wave * 16384;
    const int lane = F.lane, r32 = lane & 31, hi = lane >> 5;
    constexpr int NRB = NTOK / 32;
    for (int it = F.gw; it < NRB * 6; it += F.NGW) {
        const int gj = it / NRB, rb = it - gj * NRB, g = gj >> 1, j = gj & 1; const int m0 = rb * 32; const SeqInfo si = seqinfo(m0);
        const int dil = (g == 0) ? 1 : (g == 1 ? 4 : 16); const int L = si.len / dil, bpr = L / 32;
        const int w = (m0 - si.base) / 32, rho = w / bpr, ib = w - rho * bpr, i0 = ib * 32;
        const size_t qrow = (size_t)si.base + (size_t)(i0 + r32) * dil + rho;
        bf16x8 qf[4];
#pragma unroll
        for (int d0 = 0; d0 < 4; ++d0) qf[d0] = *(const bf16x8*)(H + qrow * HP + HC_CQ + gj * 64 + 16 * d0 + 8 * hi);
        const RowSrc ks{H + ((size_t)si.base + rho) * HP + HC_CK + gj * 64, (long)HP * dil};
        int kb_lo = ib - 2, kb_hi = ib + 3; if (kb_lo < 0) kb_lo = 0; if (kb_hi > bpr) kb_hi = bpr;
        float lse; sattn_core<4, 0, 1>(qf, ks, ks, ks, kb_lo, kb_hi, i0, 0.f, scr, lane, nullptr, lse);
        if (hi == 0) lsec[((size_t)g * NTOK + qrow) * 2 + j] = lse;
    }
}


namespace at {
typedef short s16x4 __attribute__((ext_vector_type(4)));
typedef short v4i16_t __attribute__((ext_vector_type(4)));
typedef LAS const unsigned char* lds_cptr;
constexpr int LDS_K = 0, KSLOT_MAX = 12288, LDS_V = 3 * KSLOT_MAX, VSLOT = 8192, LDS_WS = LDS_V + 3 * VSLOT, LDS_OST = LDS_WS + 8 * 256, LDS_TOTAL = LDS_OST + 8 * 8192;
static_assert(LDS_TOTAL <= RING_BYTES, "attention LDS");
constexpr float THR = 8.0f;
__device__ __forceinline__ void glds16(const void* g, unsigned lds_dst) {
    unsigned keep; asm volatile("s_mov_b32 %0, m0\n\ts_mov_b32 m0, %2\n\ts_nop 0\n\tglobal_load_lds_dwordx4 %1, off\n\ts_mov_b32 m0, %0" : "=&s"(keep) : "v"(g), "s"(lds_dst) : "memory"); }
__device__ __forceinline__ s16x4 vtr(lds_cptr p) { return __builtin_bit_cast(s16x4, __builtin_amdgcn_ds_read_tr16_b64_v4i16((LAS v4i16_t*)p)); }
__device__ __forceinline__ unsigned cvtpk(float lo, float hi) { typedef float f2 __attribute__((ext_vector_type(2))); typedef __bf16 b2 __attribute__((ext_vector_type(2))); f2 v = {lo, hi}; b2 b = __builtin_convertvector(v, b2); return __builtin_bit_cast(unsigned, b); }
#define AT_MX3(a, b, c) __builtin_fmaxf(__builtin_fmaxf((a), (b)), (c))
__device__ __forceinline__ float rowmax(const f32x16& p0, const f32x16& p1) {
    float a = AT_MX3(p0[0], p0[1], p1[0]), b = AT_MX3(p0[2], p0[3], p1[1]); a = AT_MX3(a, p1[2], p1[3]);
#pragma unroll
    for (int r = 4; r < 16; r += 4) { a = AT_MX3(a, p0[r], p0[r + 1]); b = AT_MX3(b, p0[r + 2], p0[r + 3]); a = AT_MX3(a, p1[r], p1[r + 1]); b = AT_MX3(b, p1[r + 2], p1[r + 3]); }
    float m = __builtin_fmaxf(a, b); auto rr = __builtin_amdgcn_permlane32_swap(__float_as_uint(m), __float_as_uint(m), false, false);
    return __builtin_fmaxf(__uint_as_float(rr[0]), __uint_as_float(rr[1])); }
#define AT_WAIT_BAR(N) asm volatile("s_waitcnt vmcnt(" #N ") lgkmcnt(0)\n\ts_barrier" ::: "memory")

struct Src { const bf16_t* p; long pitch; };
template <int NC, int NK0, int NK1>
__device__ __forceinline__ void stream(LAS unsigned char* lds, int tid, const bf16_t* qrow, Src k0, Src k1, Src vs, int NT, f32x16& o0, f32x16& o1, float& lsum) {
    asm volatile("" : "+v"(tid));
    constexpr int SLOTK = 2 * NC * 1024;
    const int lane = tid & 63, r32 = lane & 31, hi = lane >> 5; const int wid = __builtin_amdgcn_readfirstlane(tid >> 6);
    const unsigned lds0 = (unsigned)(uintptr_t)lds;
    LAS float* wsf = (LAS float*)(lds + LDS_WS) + wid * 64;
    constexpr int P0 = NK0 * 16;
    const bool hasA = (NK0 == 8) || (wid < 4), hasB = (NK1 > 0) && (wid < 4);
    const int pA = (NK0 == 8) ? wid : (wid & 3);
    const int rowA = (NK0 == 8) ? pA * 8 + (lane >> 3) : pA * 16 + (lane >> 2);
    const int chA = (NK0 == 8) ? ((lane & 7) ^ ((lane >> 3) & 7)) : ((lane & 3) ^ ((lane >> 4) & 3));
    const bf16_t* ksA = k0.p + (long)rowA * k0.pitch + chA * 8;
    const int rowB = (wid & 3) * 16 + (lane >> 2), chB = (lane & 3) ^ ((lane >> 4) & 3);
    const bf16_t* ksB = (NK1 > 0) ? k1.p + (long)rowB * k1.pitch + chB * 8 : k0.p;
    const bf16_t* vsp = vs.p + (long)(16 * (wid & 3) + (lane >> 2)) * vs.pitch + (wid >> 2) * 32 + (lane & 3) * 8;
    const unsigned kdA = lds0 + LDS_K + pA * 1024, kdB = lds0 + LDS_K + (NK0 + (wid & 3)) * 1024, vd = lds0 + LDS_V + wid * 1024;
    const long ktA = 64 * k0.pitch, ktB = 64 * k1.pitch, vt = 64 * vs.pitch;
    const int nd = (hasA ? 1 : 0) + (hasB ? 1 : 0) + 1;
#define AT_DMA_K(t, slot) do { if (hasA) glds16(ksA + (long)(t) * ktA, (unsigned)__builtin_amdgcn_readfirstlane(kdA + (slot) * SLOTK)); if (hasB) glds16(ksB + (long)(t) * ktB, (unsigned)__builtin_amdgcn_readfirstlane(kdB + (slot) * SLOTK)); } while (0)
#define AT_DMA_V(t, slot) glds16(vsp + (long)(t) * vt, (unsigned)__builtin_amdgcn_readfirstlane(vd + (slot) * VSLOT))
    lds_cptr kb[NC];
#pragma unroll
    for (int d0 = 0; d0 < NC; ++d0) { const int c = 2 * d0 + hi;
        if (2 * d0 < NK0) kb[d0] = (lds_cptr)lds + LDS_K + r32 * P0 + ((NK0 == 8) ? (c ^ (r32 & 7)) : (c ^ ((r32 >> 2) & 3))) * 16;
        else kb[d0] = (lds_cptr)lds + LDS_K + NK0 * 1024 + r32 * 64 + ((c - NK0) ^ ((r32 >> 2) & 3)) * 16; }
    const lds_cptr vp0 = (lds_cptr)lds + LDS_V + ((lane >> 4) & 1) * 32 + (lane & 3) * 8 + (4 * hi + ((lane & 15) >> 2)) * 64;
    AT_DMA_K(0, 0); AT_DMA_V(0, 0); if (NT > 1) AT_DMA_K(1, 1);
    bf16x8 qr[NC];
#pragma unroll
    for (int d0 = 0; d0 < NC; ++d0) qr[d0] = *(const bf16x8*)(qrow + 16 * d0 + 8 * hi);
    float mhat = 0.f, l = 0.f; f32x16 oa = {}, ob = {}, negm = {}, S0, S1; u32x4 pw0, pw1, pw2, pw3;
    asm volatile("" : "+v"(negm));
    AT_WAIT_BAR(0);
    __builtin_amdgcn_s_waitcnt(0);
#pragma unroll
    for (int d0 = 0; d0 < NC; ++d0) asm volatile("" : "+v"(qr[d0]));
    constexpr bool QLDS = (NC > 2);
    const lds_cptr qb = (lds_cptr)lds + LDS_OST + wid * 8192 + lane * 16;
    if (QLDS) {
#pragma unroll
        for (int d0 = 0; d0 < NC; ++d0) *(LAS bf16x8*)(lds + LDS_OST + wid * 8192 + lane * 16 + d0 * 1024) = qr[d0];
        LDS_WAIT();
    }
    int kc = 0, kn1 = 1, kn2 = 2, vpv = 2, vcu = 0, vnx = 1;
    bf16x8 kf[2 * NC], vf[8];
#define AT_SB() __builtin_amdgcn_sched_barrier(0)
#define AT_KRD(so_, d0) do { kf[2 * (d0)] = *(const LAS bf16x8*)(kb[d0] + (so_)); kf[2 * (d0) + 1] = *(const LAS bf16x8*)(kb[d0] + (so_) + 32 * ((2 * (d0) < NK0) ? P0 : 64)); if (QLDS) qr[d0] = *(const LAS bf16x8*)(qb + (d0) * 1024); } while (0)
#define AT_KHEAD(slot) do { const int kp_ = (slot) * SLOTK; AT_KRD(kp_, 0); } while (0)
#define AT_VF(i) ({ const s16x4 lo_ = vtr(vp_ + (((i) >> 2) * 4096 + ((i) & 3) * 1024)), hi_ = vtr(vp_ + (((i) >> 2) * 4096 + ((i) & 3) * 1024 + 512)); (bf16x8){lo_[0], lo_[1], lo_[2], lo_[3], hi_[0], hi_[1], hi_[2], hi_[3]}; })
#define AT_VHEAD(slot) do { const lds_cptr vp_ = vp0 + (slot) * VSLOT; vf[0] = AT_VF(0); vf[4] = AT_VF(4); } while (0)
#define AT_QKM(slot) do { const int kp_ = (slot) * SLOTK; \
        _Pragma("unroll") for (int d0 = 0; d0 < NC; ++d0) { if (d0 + 1 < NC) AT_KRD(kp_, d0 + 1); \
            if (d0 == 0) { S0 = MFMA32(kf[0], qr[0], negm); S1 = MFMA32(kf[1], qr[0], negm); } else { S0 = MFMA32(kf[2 * d0], qr[d0], S0); S1 = MFMA32(kf[2 * d0 + 1], qr[d0], S1); } AT_SB(); } } while (0)
#define AT_PVM(slot) do { const lds_cptr vp_ = vp0 + (slot) * VSLOT; \
        vf[1] = AT_VF(1); vf[5] = AT_VF(5); oa = MFMA32(__builtin_bit_cast(bf16x8, pw0), vf[0], oa); ob = MFMA32(__builtin_bit_cast(bf16x8, pw0), vf[4], ob); AT_SB(); \
        vf[2] = AT_VF(2); vf[6] = AT_VF(6); oa = MFMA32(__builtin_bit_cast(bf16x8, pw1), vf[1], oa); ob = MFMA32(__builtin_bit_cast(bf16x8, pw1), vf[5], ob); AT_SB(); \
        vf[3] = AT_VF(3); vf[7] = AT_VF(7); oa = MFMA32(__builtin_bit_cast(bf16x8, pw2), vf[2], oa); ob = MFMA32(__builtin_bit_cast(bf16x8, pw2), vf[6], ob); AT_SB(); \
        oa = MFMA32(__builtin_bit_cast(bf16x8, pw3), vf[3], oa); ob = MFMA32(__builtin_bit_cast(bf16x8, pw3), vf[7], ob); AT_SB(); } while (0)
    bool resc = false; u32x4 qw0, qw1, qw2, qw3; float sacc = 0.f;
#define AT_PIN(x) asm volatile("" : "+v"(x))
#define AT_DECIDE(first) do { const float rm_ = rowmax(S0, S1); resc = false; \
        if ((first) || __any(rm_ > THR)) { const float dl_ = (first) ? rm_ : __builtin_fmaxf(rm_, 0.f); mhat += dl_; \
            _Pragma("unroll") for (int r = 0; r < 16; ++r) { S0[r] -= dl_; S1[r] -= dl_; negm[r] = -mhat; } asm volatile("" : "+v"(negm)); \
            if (!(first)) { const float f_ = fast_exp2(-dl_); l *= f_; if (hi == 0) wsf[r32] = f_; resc = true; } } } while (0)
#define AT_RESC() do { if (resc) { LDS_WAIT(); \
        _Pragma("unroll") for (int r = 0; r < 16; ++r) { const float g_ = wsf[crow(r, hi)]; oa[r] *= g_; ob[r] *= g_; } LDS_WAIT(); } } while (0)
#define AT_EXP8(S, b, Q) do { \
        _Pragma("unroll") for (int r = 0; r < 8; ++r) S[(b) + r] = fast_exp2(S[(b) + r]); \
        sacc += (S[(b)] + S[(b) + 1]) + (S[(b) + 2] + S[(b) + 3]); sacc += (S[(b) + 4] + S[(b) + 5]) + (S[(b) + 6] + S[(b) + 7]); \
        Q = (u32x4){cvtpk(S[(b)], S[(b) + 1]), cvtpk(S[(b) + 2], S[(b) + 3]), cvtpk(S[(b) + 4], S[(b) + 5]), cvtpk(S[(b) + 6], S[(b) + 7])}; AT_PIN(Q); AT_PIN(sacc); } while (0)
#define AT_EXPALL() do { sacc = 0.f; AT_EXP8(S0, 0, qw0); AT_EXP8(S0, 8, qw1); AT_EXP8(S1, 0, qw2); AT_EXP8(S1, 8, qw3); l += sacc; pw0 = qw0; pw1 = qw1; pw2 = qw2; pw3 = qw3; } while (0)
#define AT_PV_EXP(slot, C0, C1, C2, C3, N0, N1, N2, N3) do { const lds_cptr vp_ = vp0 + (slot) * VSLOT; sacc = 0.f; \
        vf[1] = AT_VF(1); vf[5] = AT_VF(5); oa = MFMA32(__builtin_bit_cast(bf16x8, C0), vf[0], oa); ob = MFMA32(__builtin_bit_cast(bf16x8, C0), vf[4], ob); AT_EXP8(S0, 0, N0); AT_SB(); \
        vf[2] = AT_VF(2); vf[6] = AT_VF(6); oa = MFMA32(__builtin_bit_cast(bf16x8, C1), vf[1], oa); ob = MFMA32(__builtin_bit_cast(bf16x8, C1), vf[5], ob); AT_EXP8(S0, 8, N1); AT_SB(); \
        vf[3] = AT_VF(3); vf[7] = AT_VF(7); oa = MFMA32(__builtin_bit_cast(bf16x8, C2), vf[2], oa); ob = MFMA32(__builtin_bit_cast(bf16x8, C2), vf[6], ob); AT_EXP8(S1, 0, N2); AT_SB(); \
        oa = MFMA32(__builtin_bit_cast(bf16x8, C3), vf[3], oa); ob = MFMA32(__builtin_bit_cast(bf16x8, C3), vf[7], ob); AT_EXP8(S1, 8, N3); AT_SB(); \
        l += sacc; } while (0)
#define AT_STEP_WAIT(t) do { if ((t) + 2 < NT) { if (nd == 3) AT_WAIT_BAR(3); else if (nd == 2) AT_WAIT_BAR(2); else AT_WAIT_BAR(1); } else AT_WAIT_BAR(0); } while (0)
#define AT_ROT() do { const int a_ = kc; kc = kn1; kn1 = kn2; kn2 = a_; const int b_ = vpv; vpv = vcu; vcu = vnx; vnx = b_; } while (0)
    AT_DMA_K(2, kn2); AT_DMA_V(1, vnx);
    AT_KHEAD(kc); AT_SB();
    AT_QKM(kc); AT_DECIDE(true); AT_EXPALL();
    AT_STEP_WAIT(0); AT_ROT();
#define AT_STEP(t, C0, C1, C2, C3, N0, N1, N2, N3) do { \
        if ((t) + 2 < NT) AT_DMA_K((t) + 2, kn2); \
        if ((t) + 1 < NT) AT_DMA_V((t) + 1, vnx); \
        AT_KHEAD(kc); AT_VHEAD(vpv); AT_SB(); \
        AT_QKM(kc); \
        AT_DECIDE(false); AT_SB(); \
        AT_PV_EXP(vpv, C0, C1, C2, C3, N0, N1, N2, N3); \
        AT_RESC(); \
        AT_STEP_WAIT(t); AT_ROT(); } while (0)
    int t = 1;
    for (; t + 1 < NT; t += 2) { AT_STEP(t, pw0, pw1, pw2, pw3, qw0, qw1, qw2, qw3); AT_STEP(t + 1, qw0, qw1, qw2, qw3, pw0, pw1, pw2, pw3); }
    if (t < NT) { AT_STEP(t, pw0, pw1, pw2, pw3, qw0, qw1, qw2, qw3); pw0 = qw0; pw1 = qw1; pw2 = qw2; pw3 = qw3; }
#undef AT_STEP
    AT_VHEAD(vpv); AT_SB(); AT_PVM(vpv);
    { auto rr = __builtin_amdgcn_permlane32_swap(__float_as_uint(l), __float_as_uint(l), false, false); l = __uint_as_float(rr[0]) + __uint_as_float(rr[1]); }
    o0 = oa; o1 = ob; lsum = l;
#undef AT_DMA_K
#undef AT_DMA_V
#undef AT_SB
#undef AT_KRD
#undef AT_KHEAD
#undef AT_VF
#undef AT_VHEAD
#undef AT_QKM
#undef AT_PVM
#undef AT_PIN
#undef AT_DECIDE
#undef AT_RESC
#undef AT_EXP8
#undef AT_EXPALL
#undef AT_PV_EXP
#undef AT_STEP_WAIT
#undef AT_ROT
}
__device__ __forceinline__ void normalise(LAS unsigned char* lds, int tid, f32x16& o0, f32x16& o1, float lsum) {
    const int lane = tid & 63, r32 = lane & 31, hi = lane >> 5; const int wid = __builtin_amdgcn_readfirstlane(tid >> 6);
    LAS float* wsf = (LAS float*)(lds + LDS_WS) + wid * 64;
    if (hi == 0) wsf[32 + r32] = 1.0f / lsum; LDS_WAIT();
#pragma unroll
    for (int r = 0; r < 16; ++r) { const float g = wsf[32 + crow(r, hi)]; o0[r] *= g; o1[r] *= g; }
    LDS_WAIT();
}
}

struct AttnUnitId { int kind, seq, head, qb; };
__device__ __forceinline__ bool attn_unit_at(int i, int G, int bid, AttnUnitId& u) {
    const long L = (long)i * G + bid; if (L >= 2560) return false; int o = (int)L;
    int kind, longs, nh;
    if (o < 512) { kind = 0; longs = 1; nh = 4; } else if (o < 1024) { kind = 0; longs = 0; nh = 4; o -= 512; } else if (o < 1792) { kind = 1; longs = 1; nh = 6; o -= 1024; } else { kind = 1; longs = 0; nh = 6; o -= 1792; }
    const int nqb = longs ? 16 : 8;
    int pair, qb;
    if (G == 256) { const int rnd = o >> 8, b = o & 255, x = b & 7, c = b >> 3;
        const int ppr = 32 / nqb; pair = x + 8 * (rnd * ppr + c / nqb); qb = c % nqb; }
    else { pair = o / nqb; qb = o % nqb; }
    u.kind = kind; u.head = pair % nh; const int sq = pair / nh; u.seq = longs ? 16 + sq : sq; u.qb = qb; return true;
}
__device__ __forceinline__ void attn_ab_phase(Frame& F, const Args& a, int layer, int kmask = 3) {
    const bf16_t* H = (const bf16_t*)(F.ws + WS_H); const bf16_t* QB = (const bf16_t*)(F.ws + WS_QB); const bf16_t* KVB = (const bf16_t*)(F.ws + WS_KVB);
    bf16_t* MIX = (bf16_t*)(F.ws + WS_MIX);
    const int wid = F.wave;
    float lam, lam_init;
    { const float* lv = a.diff_lambda + layer * 128; float d1 = 0.f, d2 = 0.f;
      for (int i = 0; i < 32; ++i) { d1 += lv[i] * lv[32 + i]; d2 += lv[64 + i] * lv[96 + i]; }
      lam_init = 0.8f - 0.6f * expf(-0.3f * (float)layer); lam = expf(d1) - expf(d2) + lam_init;
      lam = __uint_as_float(__builtin_amdgcn_readfirstlane(__float_as_uint(lam))); lam_init = __uint_as_float(__builtin_amdgcn_readfirstlane(__float_as_uint(lam_init))); }
    AttnUnitId u;
    for (int i = 0; attn_unit_at(i, F.G, F.bid, u); ++i) {
        if (!((kmask >> u.kind) & 1)) continue;
        int tid = F.tid; asm volatile("" : "+v"(tid)); const int lane = tid & 63, r32 = lane & 31, hi = lane >> 5;
        const int len = (u.seq < 16) ? 2048 : 4096, base = (u.seq < 16) ? u.seq * 2048 : NTOK_P + (u.seq - 16) * 4096, NT = len / 64;
        const int m0 = base + u.qb * 256 + wid * 32;
        LAS bf16_t* sb = (LAS bf16_t*)(F.lds + at::LDS_OST + wid * 8192);
        LAS float* sf = (LAS float*)sb;
        if (u.kind == 0) {
            f32x16 q0, q1; float ls;
            { f32x16 p0, p1; const at::Src ks{H + (size_t)base * HP + HC_AK + u.head * 64, HP}, vs{H + (size_t)base * HP + HC_AV + u.head * 64, HP};
              at::stream<2, 4, 0>(F.lds, tid, H + (size_t)(m0 + r32) * HP + HC_AQ + u.head * 64, ks, ks, vs, NT, p0, p1, ls); at::normalise(F.lds, tid, p0, p1, ls);
#pragma unroll
              for (int r = 0; r < 16; ++r) { const int row = crow(r, hi); sf[row * 64 + r32] = p0[r]; sf[row * 64 + 32 + r32] = p1[r]; }
              AT_WAIT_BAR(0); }
            { const at::Src ks{H + (size_t)base * HP + HC_AK + u.head * 64 + 32, HP}, vs{H + (size_t)base * HP + HC_AV + u.head * 64, HP};
              at::stream<2, 4, 0>(F.lds, tid, H + (size_t)(m0 + r32) * HP + HC_AQ + u.head * 64 + 32, ks, ks, vs, NT, q0, q1, ls); at::normalise(F.lds, tid, q0, q1, ls); }
            float xa[16], xb[16];
#pragma unroll
            for (int r = 0; r < 16; ++r) { const int row = crow(r, hi); xa[r] = sf[row * 64 + r32] - lam * q0[r]; xb[r] = sf[row * 64 + 32 + r32] - lam * q1[r]; }
            LDS_WAIT();
            const float* sg = a.diff_subln + layer * 64; const float g0 = sg[r32] * (1.0f - lam_init), g1 = sg[32 + r32] * (1.0f - lam_init);
#pragma unroll
            for (int r = 0; r < 16; ++r) { const float x0 = xa[r], x1 = xb[r]; float ss = x0 * x0 + x1 * x1;
                ss += shx<1>(ss); ss += shx<2>(ss); ss += shx<4>(ss); ss += shx<8>(ss); ss += shx<16>(ss);
                const float rs = 1.0f / sqrtf(ss * (1.0f / 64.0f) + RMS_EPS); const int row = crow(r, hi);
                sb[row * 64 + r32] = (bf16_t)f2bf(x0 * rs * g0); sb[row * 64 + 32 + r32] = (bf16_t)f2bf(x1 * rs * g1); }
            LDS_WAIT();
#pragma unroll
            for (int it = 0; it < 4; ++it) { const int row = it * 8 + (lane >> 3), ch = lane & 7; *(u32x4*)(MIX + (size_t)(m0 + row) * DM + MIX_A + u.head * 64 + ch * 8) = *(const LAS u32x4*)(sb + row * 64 + ch * 8); }
        } else {
            f32x16 p0, p1; float ls;
            const at::Src k0{KVB + (size_t)base * KVP + u.head * 128, KVP}, k1{H + (size_t)base * HP + HC_KROPE, HP}, vs{KVB + (size_t)base * KVP + u.head * 128 + 64, KVP};
            at::stream<6, 8, 4>(F.lds, tid, QB + (size_t)(m0 + r32) * QBP + u.head * 96, k0, k1, vs, NT, p0, p1, ls); at::normalise(F.lds, tid, p0, p1, ls);
#pragma unroll
            for (int r = 0; r < 16; ++r) { const int row = crow(r, hi); sb[row * 64 + r32] = (bf16_t)f2bf(p0[r]); sb[row * 64 + 32 + r32] = (bf16_t)f2bf(p1[r]); }
            LDS_WAIT();
#pragma unroll
            for (int it = 0; it < 4; ++it) { const int row = it * 8 + (lane >> 3), ch = lane & 7; *(u32x4*)(MIX + (size_t)(m0 + row) * DM + MIX_B + u.head * 64 + ch * 8) = *(const LAS u32x4*)(sb + row * 64 + ch * 8); }
        }
        AT_WAIT_BAR(0);
    }
}

struct ListRows { const int* list; int seg0, cnt; __device__ __forceinline__ int src(int m) const { const int r = m - seg0; return (r < cnt) ? (list[r] >> 1) : 0; } };
__device__ __forceinline__ void moe_segments(Frame& F, int layer, LAS int* seg) {
    if (F.tid == 0) { int acc = 0; for (int e = 0; e < NEXP; ++e) { const int c = (int)__hip_atomic_load(F.ctl + CW_CNT + layer * 64 + e, RLX_AGENT); seg[e] = acc; seg[33 + e] = c; acc += (c + 255) & ~255; } seg[32] = acc; }
    __syncthreads();
}
__device__ __forceinline__ int seg_find(const LAS int* seg, int row) { int e = 0;
#pragma unroll
    for (int s = 16; s > 0; s >>= 1) if (seg[e + s] <= row) e += s;
    return e; }
__device__ __forceinline__ void moe_up_simple(Frame& F, int layer) {
    LAS int* seg = (LAS int*)(F.lds + RING_BYTES); moe_segments(F, layer, seg);
    const bf16_t* XB = (const bf16_t*)(F.ws + WS_XB); const bf16_t* W13 = (const bf16_t*)(F.ws + WS_W13); const int* list = (const int*)(F.ws + WS_LIST);
    const EpiHid E{(bf16_t*)(F.ws + WS_HID)};
    const int items = (seg[32] / 32) * 16;
    for (int it = F.gw; it < items; it += F.NGW) { const int mt = it >> 4, ct = it & 15, m0 = mt * 32, e = seg_find(seg, m0), c0 = ct * 32;
        const ListRows RM{list + (size_t)e * LIST_CAP, seg[e], seg[33 + e]};
        const bf16_t* Bg = W13 + (size_t)e * 1024 * 1024 + (size_t)((c0 >> 7) * 256 + (c0 & 127)) * 1024;
        sg_tile(XB, DM, Bg, Bg + (size_t)128 * 1024, 1024, 1024, m0, c0, E, RM, F.lane); }
    __syncthreads();
}
__device__ __forceinline__ void moe_down_simple(Frame& F, int layer) {
    LAS int* seg = (LAS int*)(F.lds + RING_BYTES); moe_segments(F, layer, seg);
    const bf16_t* HID = (const bf16_t*)(F.ws + WS_HID); const bf16_t* W2 = (const bf16_t*)(F.ws + WS_W2); const int* list = (const int*)(F.ws + WS_LIST);
    const int items = (seg[32] / 32) * 16;
    for (int it = F.gw; it < items; it += F.NGW) { const int mt = it >> 4, ct = it & 15, m0 = mt * 32, e = seg_find(seg, m0), c0 = ct * 64;
        const EpiY E{(bf16_t*)(F.ws + WS_YB), (const float*)(F.ws + WS_TW), list + (size_t)e * LIST_CAP, seg[e], seg[33 + e]};
        const bf16_t* B0 = W2 + (size_t)e * 1024 * 512 + (size_t)c0 * 512;
        sg_tile(HID, DEXP, B0, B0 + (size_t)32 * 512, 512, 512, m0, c0, E, IdRows(), F.lane); }
    __syncthreads();
}


struct MoeUpSched {
    const char* XB; const char* W13; const LAS int* seg; const int* list; int nM, G, c;
    __device__ __forceinline__ bool next(int i, pg8::Unit& u) const { if (!pg8::order_next(i, G, c, nM, 4, u.pm, u.pn)) return false; u.e = __builtin_amdgcn_readfirstlane(seg_find(seg, u.pm * 256)); u.a = XB; u.b = W13 + ((size_t)u.e * 1024 + (size_t)u.pn * 256) * 2048; return true; }
    __device__ __forceinline__ unsigned arow(const pg8::Unit& u, int r) const { const int rr = u.pm * 256 + r - __builtin_amdgcn_readfirstlane(seg[u.e]); return (rr < __builtin_amdgcn_readfirstlane(seg[33 + u.e])) ? (unsigned)(list[(size_t)u.e * LIST_CAP + rr] >> 1) : 0u; }
};
struct MoeDownSched {
    const char* HID; const char* W2; const LAS int* seg; int nM, G, c;
    __device__ __forceinline__ bool next(int i, pg8::Unit& u) const { if (!pg8::order_next(i, G, c, nM, 4, u.pm, u.pn)) return false; u.e = __builtin_amdgcn_readfirstlane(seg_find(seg, u.pm * 256)); u.a = HID + (size_t)u.pm * 256 * DEXP * 2; u.b = W2 + ((size_t)u.e * 1024 + (size_t)u.pn * 256) * 1024; return true; }
    __device__ __forceinline__ unsigned arow(const pg8::Unit&, int) const { return 0u; }
};
__device__ __forceinline__ void moe_up_opt(Frame& F, int layer) {
    LAS int* seg = (LAS int*)(F.lds + RING_BYTES); moe_segments(F, layer, seg);
    const MoeUpSched S{(const char*)(F.ws + WS_XB), (const char*)(F.ws + WS_W13), seg, (const int*)(F.ws + WS_LIST), __builtin_amdgcn_readfirstlane(seg[32]) / 256, F.G, F.bid};
    const EpiHid E{(bf16_t*)(F.ws + WS_HID)};
    pg8::gemm_phase<EpiHid, MoeUpSched, true, true>(F.lds, F.tid, 1024, DM, S, E);
    __syncthreads();
}
__device__ __forceinline__ void moe_down_opt(Frame& F, int layer) {
    LAS int* seg = (LAS int*)(F.lds + RING_BYTES); moe_segments(F, layer, seg);
    const MoeDownSched S{(const char*)(F.ws + WS_HID), (const char*)(F.ws + WS_W2), seg, __builtin_amdgcn_readfirstlane(seg[32]) / 256, F.G, F.bid};
    const EpiYO E{(bf16_t*)(F.ws + WS_YB), (const float*)(F.ws + WS_TW), (const int*)(F.ws + WS_LIST), seg};
    pg8::gemm_phase<EpiYO, MoeDownSched, false, false>(F.lds, F.tid, DEXP, DEXP, S, E);
    __syncthreads();
}
template <class Epi>
__device__ __forceinline__ void pg_phase(Frame& F, const bf16_t* A, int lda, const bf16_t* Bt, int panel, int N, int K, const Epi& E) {
    pg8::PanelSched S; S.init(A, lda, Bt, panel, N, K);
    pg8::gemm_phase<Epi, pg8::PanelSched, false, false>(F.lds, F.tid, K, lda, S, E);
}
__device__ __forceinline__ void local_sync(Frame& F) {
    asm volatile("s_waitcnt vmcnt(0) lgkmcnt(0)" ::: "memory");
    __syncthreads();
    if (F.tid == 0) { __builtin_amdgcn_fence(__ATOMIC_ACQUIRE, "agent"); asm volatile("s_waitcnt vmcnt(0)" ::: "memory"); }
    __syncthreads();
}
template <class Epi>
__device__ __forceinline__ void og_phase(Frame& F, const bf16_t* A, int lda, const bf16_t* Bt, int M, int N, int K, const Epi& E) {
    pg8::DenseSched S; S.init(A, lda, Bt, M, N, K, F.G, F.bid);
    pg8::gemm_phase<Epi, pg8::DenseSched, false, false>(F.lds, F.tid, K, lda, S, E);
}

#ifndef PANEL_PROG
#define PANEL_PROG 1
#endif
#if PANEL_PROG
constexpr int PH_PER_LAYER = 6, N_PHASES = 2 + DEPTH * PH_PER_LAYER;
#else
constexpr int PH_PER_LAYER = 9, N_PHASES = 1 + DEPTH * PH_PER_LAYER;
#endif
__global__ void __launch_bounds__(NTHREADS, 2) fwd(Args args) {
    extern __shared__ __attribute__((aligned(16))) unsigned char lds[];
    Frame F;
    F.lds = (LAS unsigned char*)lds; F.ldsg = lds;
    F.tid = threadIdx.x; F.lane = F.tid & 63; F.wave = __builtin_amdgcn_readfirstlane(F.tid >> 6);
    F.G = gridDim.x; F.bid = blockIdx.x; F.gw = blockIdx.x * NWAVES + F.wave; F.NGW = F.G * NWAVES;
    F.ws = args.ws; F.ctl = (gu32*)(args.ws + WS_CTL);
    volatile LAS unsigned* MISC = (volatile LAS unsigned*)(F.lds + MISC_OFF);
    for (int u = F.tid; u < (LDS_BYTES - RING_BYTES) / 4; u += NTHREADS) ((LAS unsigned*)(F.lds + RING_BYTES))[u] = 0u;
    __syncthreads();
    XcdBarrier bar; bar.bar = (unsigned*)(F.ctl + CW_BAR); bar.x = 0; bar.st = nullptr;
    if (args.use_bar) bar = xcd_barrier_post((unsigned*)(F.ctl + CW_BAR), MISC + 8);
    const int lo = args.ph_lo, hi = args.ph_hi;
#ifndef PH_MASK
#define PH_MASK 0x3ff
#endif
#define IN(k) (lo <= (k) && (k) < hi && (launder(F), true))
#define SEAM(k) do { if (lo <= (k) && (k) + 1 < hi) xcd_barrier(bar); } while (0)
    if ((PH_MASK & 1) && IN(0)) { p0_prologue(F, args);
#ifdef PROBE_DUP_P0
        launder(F); p0_prologue(F, args);
#endif
    }
    SEAM(0);
#if PANEL_PROG
    for (int layer = 0; layer < DEPTH; ++layer) {
        const int pb = 1 + layer * PH_PER_LAYER;
        if (IN(pb + 0)) {
            for (int panel = F.bid; panel < NTOK / 256; panel += F.G) {
                const int r0 = panel * 256;
                if (layer > 0) { ln2_pass(F, args, layer - 1, r0 + F.wave, NWAVES, r0 + 256); local_sync(F); launder(F); }
                { bf16_t* H = (bf16_t*)(F.ws + WS_H); const EpiH E{H, (const float2*)(F.ws + WS_ROPE32), (const float2*)(F.ws + WS_ROPE64)};
                  pg_phase(F, (const bf16_t*)(F.ws + WS_XB), DM, (const bf16_t*)(F.ws + WS_WIN) + (size_t)layer * 2560 * 1024, panel, 2560, 1024, E); }
                local_sync(F); launder(F);
                rowstat_pass(F, r0 + F.wave, NWAVES, r0 + 256);
                local_sync(F); launder(F);
                { bf16_t* H = (bf16_t*)(F.ws + WS_H); const EpiUQ Eq{(bf16_t*)(F.ws + WS_QB), (const float*)(F.ws + WS_RSTD), (const float2*)(F.ws + WS_ROPE32)};
                  pg_phase(F, H + HC_CQ_LAT, HP, (const bf16_t*)(F.ws + WS_WUQ) + (size_t)layer * 768 * 256, panel, 768, 256, Eq); }
                launder(F);
                { bf16_t* H = (bf16_t*)(F.ws + WS_H); const EpiUKV Ek{(bf16_t*)(F.ws + WS_KVB), (const float*)(F.ws + WS_RSTD)};
                  pg_phase(F, H + HC_CKV, HP, (const bf16_t*)(F.ws + WS_WUKV) + (size_t)layer * 768 * 256, panel, 768, 256, Ek); }
                launder(F);
            }
        }
        SEAM(pb + 0);
        if (IN(pb + 1)) { cstat_phase(F); }
        SEAM(pb + 1);
        if (IN(pb + 2)) { attn_ab_phase(F, args, layer); launder(F); sattn_phase(F, args, layer, 10); }
        SEAM(pb + 2);
        if (IN(pb + 3)) {
            for (int panel = F.bid; panel < NTOK / 256; panel += F.G) {
                const int r0 = panel * 256;
                { const EpiRes E{args.out, layer == 0 ? args.x_prompt : nullptr, args.x_sample, args.out};
                  pg_phase(F, (const bf16_t*)(F.ws + WS_MIX), DM, (const bf16_t*)(F.ws + WS_WOUT) + (size_t)layer * 1024 * 1024, panel, 1024, 1024, E); }
                local_sync(F); launder(F);
                ln1_route_pass(F, args, layer, r0 + F.wave, NWAVES, r0 + 256);
                launder(F);
            }
            moe_convert(F, args, layer);
        }
        SEAM(pb + 3);
        if (IN(pb + 4)) { moe_up_opt(F, layer);
#ifdef PROBE_DUP_MOE
            launder(F); moe_up_opt(F, layer);
#endif
        }
        SEAM(pb + 4);
        if (IN(pb + 5)) { moe_down_opt(F, layer);
#ifdef PROBE_DUP_MOE
            launder(F); moe_down_opt(F, layer);
#endif
        }
        SEAM(pb + 5);
    }
    if (IN(1 + DEPTH * PH_PER_LAYER)) { ln2_pass(F, args, DEPTH - 1, F.gw, F.NGW, NTOK); }
#else
    for (int layer = 0; layer < DEPTH; ++layer) {
        const int pb = 1 + layer * PH_PER_LAYER;
        if ((PH_MASK & (2 << 0)) && IN(pb + 0)) {   bf16_t* H = (bf16_t*)(F.ws + WS_H);
            const EpiH E{H, (const float2*)(F.ws + WS_ROPE32), (const float2*)(F.ws + WS_ROPE64)};
#if OPT_GEMM
            og_phase(F, (const bf16_t*)(F.ws + WS_XB), DM, (const bf16_t*)(F.ws + WS_WIN) + (size_t)layer * 2560 * 1024, NTOK, 2560, 1024, E);
#ifdef PROBE_DUP_GEMM
            launder(F); og_phase(F, (const bf16_t*)(F.ws + WS_XB), DM, (const bf16_t*)(F.ws + WS_WIN) + (size_t)layer * 2560 * 1024, NTOK, 2560, 1024, E);
#endif
#else
            sg_phase(F, (const bf16_t*)(F.ws + WS_XB), DM, (const bf16_t*)(F.ws + WS_WIN) + (size_t)layer * 2560 * 1024, 1024, NTOK, 2560, 1024, E);
#endif
        }
        SEAM(pb + 0);
        if ((PH_MASK & (2 << 1)) && IN(pb + 1)) { rowstat_pass(F, F.gw, F.NGW, NTOK); cstat_phase(F);
#ifdef PROBE_DUP_CSTAT
            launder(F); rowstat_pass(F, F.gw, F.NGW, NTOK); cstat_phase(F);
#endif
        }
        SEAM(pb + 1);
        if ((PH_MASK & (2 << 2)) && IN(pb + 2)) {
            bf16_t* H = (bf16_t*)(F.ws + WS_H);
            const EpiUQ Eq{(bf16_t*)(F.ws + WS_QB), (const float*)(F.ws + WS_RSTD), (const float2*)(F.ws + WS_ROPE32)};
#if OPT_GEMM
            og_phase(F, H + HC_CQ_LAT, HP, (const bf16_t*)(F.ws + WS_WUQ) + (size_t)layer * 768 * 256, NTOK, 768, 256, Eq);
            launder(F);
#else
            sg_phase(F, H + HC_CQ_LAT, HP, (const bf16_t*)(F.ws + WS_WUQ) + (size_t)layer * 768 * 256, 256, NTOK, 768, 256, Eq);
#endif
            const EpiUKV Ek{(bf16_t*)(F.ws + WS_KVB), (const float*)(F.ws + WS_RSTD)};
#if OPT_GEMM
            og_phase(F, H + HC_CKV, HP, (const bf16_t*)(F.ws + WS_WUKV) + (size_t)layer * 768 * 256, NTOK, 768, 256, Ek);
#ifdef PROBE_DUP_UP
            launder(F); og_phase(F, H + HC_CQ_LAT, HP, (const bf16_t*)(F.ws + WS_WUQ) + (size_t)layer * 768 * 256, NTOK, 768, 256, Eq);
            launder(F); og_phase(F, H + HC_CKV, HP, (const bf16_t*)(F.ws + WS_WUKV) + (size_t)layer * 768 * 256, NTOK, 768, 256, Ek);
#endif
#else
            sg_phase(F, H + HC_CKV, HP, (const bf16_t*)(F.ws + WS_WUKV) + (size_t)layer * 768 * 256, 256, NTOK, 768, 256, Ek);
#endif
        }
        SEAM(pb + 2);
        if ((PH_MASK & (2 << 3)) && IN(pb + 3)) {
#if OPT_ATTN
            attn_ab_phase(F, args, layer); launder(F);
#ifdef PROBE_DUP_ATTN
            attn_ab_phase(F, args, layer, PROBE_DUP_ATTN); launder(F);
#endif
            sattn_phase(F, args, layer, 10);
#ifdef PROBE_DUP_CFIN
            launder(F); sattn_phase(F, args, layer, 10);
#endif
#else
            sattn_phase(F, args, layer, 0);
#endif
        }
        SEAM(pb + 3);
        if ((PH_MASK & (2 << 4)) && IN(pb + 4)) {
#ifdef PROBE_DUP_WOUT
            { const EpiRes E0{args.out, layer == 0 ? args.x_prompt : nullptr, args.x_sample, (float*)(F.ws + WS_H)};
              og_phase(F, (const bf16_t*)(F.ws + WS_MIX), DM, (const bf16_t*)(F.ws + WS_WOUT) + (size_t)layer * 1024 * 1024, NTOK, 1024, 1024, E0); launder(F); }
#endif
            const EpiRes E{args.out, layer == 0 ? args.x_prompt : nullptr, args.x_sample, args.out};
#if OPT_GEMM
            og_phase(F, (const bf16_t*)(F.ws + WS_MIX), DM, (const bf16_t*)(F.ws + WS_WOUT) + (size_t)layer * 1024 * 1024, NTOK, 1024, 1024, E);
#else
            sg_phase(F, (const bf16_t*)(F.ws + WS_MIX), DM, (const bf16_t*)(F.ws + WS_WOUT) + (size_t)layer * 1024 * 1024, 1024, NTOK, 1024, 1024, E);
#endif
        }
        SEAM(pb + 4);
        if ((PH_MASK & (2 << 5)) && IN(pb + 5)) {
#ifdef PROBE_DUP_LN1
#endif
            ln1_route_pass(F, args, layer, F.gw, F.NGW, NTOK); moe_convert(F, args, layer);
#ifdef PROBE_DUP_CONV
            launder(F); moe_convert(F, args, layer);
#endif
        }
        SEAM(pb + 5);
#if OPT_GEMM
        if ((PH_MASK & (2 << 6)) && IN(pb + 6)) { moe_up_opt(F, layer);
#ifdef PROBE_DUP_MOE
            launder(F); moe_up_opt(F, layer);
#endif
        }
#else
        if ((PH_MASK & (2 << 6)) && IN(pb + 6)) { moe_up_simple(F, layer); }
#endif
        SEAM(pb + 6);
#if OPT_GEMM
        if ((PH_MASK & (2 << 7)) && IN(pb + 7)) { moe_down_opt(F, layer);
#ifdef PROBE_DUP_MOE
            launder(F); moe_down_opt(F, layer);
#endif
        }
#else
        if ((PH_MASK & (2 << 7)) && IN(pb + 7)) { moe_down_simple(F, layer); }
#endif
        SEAM(pb + 7);
        if ((PH_MASK & (2 << 8)) && IN(pb + 8)) { ln2_pass(F, args, layer, F.gw, F.NGW, NTOK); }
        SEAM(pb + 8);
    }
#endif
#undef IN
#undef SEAM
}

extern "C" void kernel_launch(void* const* d_in, const int* in_sizes, int n_in, void* d_out, int out_size, void* d_ws, size_t ws_size, hipStream_t stream) {
    static int grid = 0;
    if (grid == 0) {
        if (n_in != 19 || out_size != NTOK * DM || ws_size < WS_END) { fprintf(stderr, "kernel_launch: unexpected shapes (n_in %d out %d ws %zu)\n", n_in, out_size, ws_size); grid = -1; return; }
        int dev = 0, cus = 0, per_cu = 0;
        if (hipGetDevice(&dev) != hipSuccess || hipDeviceGetAttribute(&cus, hipDeviceAttributeMultiprocessorCount, dev) != hipSuccess) { grid = -1; return; }
        if (hipFuncSetAttribute((const void*)fwd, hipFuncAttributeMaxDynamicSharedMemorySize, LDS_BYTES) != hipSuccess) { grid = -1; return; }
        if (hipOccupancyMaxActiveBlocksPerMultiprocessor(&per_cu, (const void*)fwd, NTHREADS, LDS_BYTES) != hipSuccess || per_cu < 1) { fprintf(stderr, "kernel_launch: occupancy query says %d\n", per_cu); }
        (void)hipGetLastError();
        grid = cus;
    }
    if (grid < 0) return;
    if (hipMemsetAsync((char*)d_ws + WS_CTL, 0, CTL_ZERO_BYTES, stream) != hipSuccess) return;
    Args a{};
    a.x_prompt = (const float*)d_in[0]; a.x_sample = (const float*)d_in[1]; a.w_in = (const float*)d_in[2]; a.diff_lambda = (const float*)d_in[3]; a.diff_subln = (const float*)d_in[4];
    a.mla_q_norm = (const float*)d_in[5]; a.mla_w_uq = (const float*)d_in[6]; a.mla_kv_norm = (const float*)d_in[7]; a.mla_w_ukv = (const float*)d_in[8]; a.w_out = (const float*)d_in[9];
    a.ln1_g = (const float*)d_in[10]; a.ln1_b = (const float*)d_in[11]; a.moe_w_coarse = (const float*)d_in[12]; a.moe_w_fine = (const float*)d_in[13];
    a.moe_w1 = (const float*)d_in[14]; a.moe_w3 = (const float*)d_in[15]; a.moe_w2 = (const float*)d_in[16]; a.ln2_g = (const float*)d_in[17]; a.ln2_b = (const float*)d_in[18];
    a.out = (float*)d_out; a.ws = (unsigned char*)d_ws; a.pad = 0;
#if MK_ONE_LAUNCH
    a.ph_lo = 0; a.ph_hi = N_PHASES; a.use_bar = 1;
    hipLaunchKernelGGL(fwd, dim3(grid), dim3(NTHREADS), LDS_BYTES, stream, a);
#else
    for (int p = 0; p < N_PHASES; ++p) { a.ph_lo = p; a.ph_hi = p + 1; a.use_bar = 0; hipLaunchKernelGGL(fwd, dim3(grid), dim3(NTHREADS), LDS_BYTES, stream, a); }
#endif
}
```

```cpp
#include <hip/hip_runtime.h>
#include <cstdio>
#include <cstdint>

#ifndef OPT_ATTN
#define OPT_ATTN 1
#endif
#ifndef OPT_GEMM
#define OPT_GEMM 1
#endif
#ifndef MK_ONE_LAUNCH
#define MK_ONE_LAUNCH 1
#endif

#define GAS __attribute__((address_space(1)))
#define LAS __attribute__((address_space(3)))
typedef unsigned short bf16_t;
typedef short bf16x8 __attribute__((ext_vector_type(8)));
typedef float f32x4 __attribute__((ext_vector_type(4)));
typedef float f32x2 __attribute__((ext_vector_type(2)));
typedef float f32x16 __attribute__((ext_vector_type(16)));
typedef unsigned u32x4 __attribute__((ext_vector_type(4)));
typedef unsigned u32x2 __attribute__((ext_vector_type(2)));
typedef GAS unsigned gu32;
#define RLX_AGENT __ATOMIC_RELAXED, __HIP_MEMORY_SCOPE_AGENT
#define LDS_WAIT() asm volatile("s_waitcnt lgkmcnt(0)" ::: "memory")
#define VM_WAIT() asm volatile("s_waitcnt vmcnt(0)" ::: "memory")
#define MFMA32(a, b, c) __builtin_amdgcn_mfma_f32_32x32x16_bf16(a, b, c, 0, 0, 0)

__device__ __forceinline__ unsigned f2bf(float f) { unsigned u = __builtin_bit_cast(unsigned, f); return (u + 0x7fffu + ((u >> 16) & 1u)) >> 16; }
__device__ __forceinline__ unsigned pk2(float lo, float hi) { return f2bf(lo) | (f2bf(hi) << 16); }
__device__ __forceinline__ float bf2f(unsigned short b) { return __builtin_bit_cast(float, (unsigned)b << 16); }
__device__ __forceinline__ int crow(int r, int hi) { return (r & 3) + 8 * (r >> 2) + 4 * hi; }
template <int K> __device__ __forceinline__ float shx(float v) { static_assert(K < 32, "xor 32: use xsum32 / xmax32 / xpair32"); return __uint_as_float((unsigned)__builtin_amdgcn_ds_swizzle((int)__float_as_uint(v), (K << 10) | 0x1f)); }
__device__ __forceinline__ float xsum32(float v) { auto rr = __builtin_amdgcn_permlane32_swap(__float_as_uint(v), __float_as_uint(v), false, false); return __uint_as_float(rr[0]) + __uint_as_float(rr[1]); }
__device__ __forceinline__ float xmax32(float v) { auto rr = __builtin_amdgcn_permlane32_swap(__float_as_uint(v), __float_as_uint(v), false, false); return fmaxf(__uint_as_float(rr[0]), __uint_as_float(rr[1])); }
__device__ __forceinline__ float xpair32(float lo, float hi) { auto rr = __builtin_amdgcn_permlane32_swap(__float_as_uint(lo), __float_as_uint(hi), false, false); return __uint_as_float(rr[0]) + __uint_as_float(rr[1]); }
__device__ __forceinline__ float wave_sum(float v) {
    v += shx<1>(v); v += shx<2>(v); v += shx<4>(v); v += shx<8>(v); v += shx<16>(v);
    return xsum32(v);
}
__device__ __forceinline__ float fast_exp2(float x) { return __builtin_amdgcn_exp2f(x); }

constexpr int NTOK = 65536, DM = 1024, DEPTH = 4;
constexpr int NTOK_P = 32768;
constexpr int HP = 2560;
constexpr int HC_AQ = 0, HC_AK = 256, HC_AV = 512, HC_CQ_LAT = 768, HC_CKV = 1024, HC_KROPE = 1152, HC_CQ = 1280, HC_CK = 1664, HC_CV = 2048;
constexpr int QBP = 768, KVP = 768;
constexpr int MIX_A = 0, MIX_B = 256, MIX_C = 640;
constexpr int NEXP = 32, DEXP = 512;
constexpr float LOG2E = 1.4426950408889634f;
constexpr float SC_A = 0.17677669529663687f * LOG2E;
constexpr float SC_B = 0.10206207261596575f * LOG2E;
constexpr float SC_C = 0.125f * LOG2E;
constexpr float DN_ALPHA = 1.681792830507429f;
constexpr float LN_EPS = 1e-5f, RMS_EPS = 1e-6f;

constexpr size_t MiB = 1u << 20;
constexpr size_t WS_CTL = 0, CTL_ZERO_BYTES = 1 * MiB;
constexpr size_t WS_ROPE32 = 4 * MiB;
constexpr size_t WS_ROPE64 = 5 * MiB;
constexpr size_t WS_WIN = 8 * MiB;
constexpr size_t WS_WOUT = 28 * MiB;
constexpr size_t WS_WUQ = 36 * MiB;
constexpr size_t WS_WUKV = 38 * MiB;
constexpr size_t WS_W13 = 40 * MiB;
constexpr size_t WS_W2 = 104 * MiB;
constexpr size_t WS_XB = 136 * MiB;
constexpr size_t WS_H = 264 * MiB;
constexpr size_t WS_QB = 584 * MiB;
constexpr size_t WS_KVB = 680 * MiB;
constexpr size_t WS_MIX = 776 * MiB;
constexpr size_t WS_RSTD = 904 * MiB;
constexpr size_t WS_LSEC = 905 * MiB;
constexpr size_t WS_TW = 907 * MiB;
constexpr size_t WS_LIST = 908 * MiB;
constexpr size_t WS_END = 924 * MiB;
constexpr size_t WS_HID = WS_H;
constexpr size_t WS_YB = WS_H + 136 * MiB;
static_assert(WS_YB + 256 * MiB <= WS_KVB + 96 * MiB, "YB overlay");
constexpr int LIST_CAP = 131072;
constexpr int CW_TMO = 0;
constexpr int CW_CNT = 64;
constexpr int CW_BAR = 4096;

constexpr int RING_BYTES = 131072;
constexpr int MISC_OFF = RING_BYTES + 320;
constexpr int LDS_BYTES = 147456;
constexpr int NWAVES = 8, NTHREADS = 512;

#define XB_TMO      128
#define XB_XCNT(j)  (256  + 64 * (j))
#define XB_XSUB(j)  (1280 + 64 * (j))
#define XB_XGEN(j)  (2304 + 64 * (j))
#define XB_TOP      3328
#define XB_TOPGEN   3392
#define XCD_BAR_WORDS 3456
#define XB_SPIN_CAP (1u << 22)
__device__ __forceinline__ unsigned xb_ld(unsigned* p)              { return __hip_atomic_load(p, __ATOMIC_RELAXED, __HIP_MEMORY_SCOPE_AGENT); }
__device__ __forceinline__ unsigned xb_add(unsigned* p, unsigned v) { return __hip_atomic_fetch_add(p, v, __ATOMIC_RELAXED, __HIP_MEMORY_SCOPE_AGENT); }
__device__ __forceinline__ unsigned xb_xcc_id() { return (unsigned)__builtin_amdgcn_s_getreg((3 << 11) | 20) & 0xFu; }
#define XB_SPIN(cond, bar) do { unsigned _sp = 0; while (cond) { __builtin_amdgcn_s_sleep(1); \
    if ((++_sp & 255u) == 0u) { if (xb_ld(&(bar)[XB_TMO])) break; if (_sp > XB_SPIN_CAP) { atomicAdd(&(bar)[XB_TMO], 1u); break; } } } } while (0)
struct XcdBarrier { unsigned* bar; unsigned x; volatile LAS unsigned* st; };
__device__ __forceinline__ XcdBarrier xcd_barrier_post(unsigned* bar, volatile LAS unsigned* st) {
    XcdBarrier b; b.bar = bar; b.x = xb_xcc_id(); b.st = st;
    if (threadIdx.x == 0) (void)xb_add(&bar[XB_XCNT(b.x)], 1u);
    return b;
}
__device__ __forceinline__ void xcd_barrier_complete(unsigned* bar, unsigned x, unsigned& nloc, unsigned& nx) {
    const unsigned G = gridDim.x * gridDim.y * gridDim.z;
    unsigned sum, cnt, mine, sp = 0u;
    for (;;) {
        sum = 0u; cnt = 0u; mine = 0u;
#pragma unroll
        for (unsigned j = 0; j < 16; ++j) { const unsigned c = xb_ld(&bar[XB_XCNT(j)]); sum += c; cnt += (c > 0u) ? 1u : 0u; mine = (j == x) ? c : mine; }
        if (sum == G) break;
        __builtin_amdgcn_s_sleep(1);
        if ((++sp & 255u) == 0u) { if (xb_ld(&bar[XB_TMO])) break; if (sp > XB_SPIN_CAP) { atomicAdd(&bar[XB_TMO], 1u); break; } }
    }
    nloc = mine > 0u ? mine : 1u; nx = cnt > 0u ? cnt : 1u;
}
__device__ __forceinline__ void xcd_barrier(const XcdBarrier& b) {
    asm volatile("s_waitcnt vmcnt(0)" ::: "memory");
    __syncthreads();
    if (threadIdx.x == 0) {
        unsigned* bar = b.bar;
        __builtin_amdgcn_s_waitcnt(0);
        unsigned nloc = b.st[0], nx = b.st[1];
        if (nloc == 0u) { xcd_barrier_complete(bar, b.x, nloc, nx); b.st[0] = nloc; b.st[1] = nx; }
        const unsigned old = xb_add(&bar[XB_XSUB(b.x)], 1u);
        const unsigned gen = old / nloc;
        if (old + 1u == (gen + 1u) * nloc) {
            __builtin_amdgcn_fence(__ATOMIC_RELEASE, "agent");
            asm volatile("s_waitcnt vmcnt(0)" ::: "memory");
            const unsigned og = xb_add(&bar[XB_TOP], 1u);
            const unsigned tg = og / nx;
            if (og + 1u == (tg + 1u) * nx) xb_add(&bar[XB_TOPGEN], 1u);
            else XB_SPIN(xb_ld(&bar[XB_TOPGEN]) == tg, bar);
            __builtin_amdgcn_fence(__ATOMIC_ACQUIRE, "agent");
            xb_add(&bar[XB_XGEN(b.x)], 1u);
            asm volatile("s_waitcnt vmcnt(0)" ::: "memory");
        } else {
            XB_SPIN(xb_ld(&bar[XB_XGEN(b.x)]) == gen, bar);
            __builtin_amdgcn_fence(__ATOMIC_ACQUIRE, "agent");
            asm volatile("s_waitcnt vmcnt(0)" ::: "memory");
        }
    }
    __syncthreads();
}

struct Args {
    const float* x_prompt; const float* x_sample; const float* w_in; const float* diff_lambda; const float* diff_subln; const float* mla_q_norm; const float* mla_w_uq;
    const float* mla_kv_norm; const float* mla_w_ukv; const float* w_out; const float* ln1_g; const float* ln1_b; const float* moe_w_coarse; const float* moe_w_fine;
    const float* moe_w1; const float* moe_w3; const float* moe_w2; const float* ln2_g; const float* ln2_b;
    float* out; unsigned char* ws; int ph_lo, ph_hi, use_bar, pad;
};
struct Frame {
    LAS unsigned char* lds; unsigned char* ldsg;
    int tid, lane, wave, G, gw, NGW, bid;
    gu32* ctl; unsigned char* ws;
};
__device__ __forceinline__ void launder(Frame& F) {
    int wv = F.wave; asm volatile("" : "+s"(wv)); F.wave = wv;
    int t; asm volatile("v_mbcnt_lo_u32_b32 %0, -1, 0\n\tv_mbcnt_hi_u32_b32 %0, -1, %0" : "=v"(t)); F.lane = t; F.tid = wv * 64 + t;
    int b = (int)blockIdx.x; asm volatile("" : "+s"(b)); F.bid = b; F.gw = b * NWAVES + F.wave;
    unsigned char* w = F.ws; asm volatile("" : "+s"(w)); F.ws = w; F.ctl = (gu32*)(w + WS_CTL);
}
struct SeqInfo { int base, len, pos; };
__device__ __forceinline__ SeqInfo seqinfo(int m) { SeqInfo s; if (m < NTOK_P) { s.base = m & ~2047; s.len = 2048; } else { s.base = m & ~4095; s.len = 4096; } s.pos = m - s.base; return s; }

template <class ColMap>
__device__ __forceinline__ void transpose_item(const float* W, int N, bf16_t* WT, int ldd, LAS float* scr, int k0, int n0, const ColMap& cm, const float* kscale, int lane) {
    const int sc = cm(n0 + (lane & 31));
#pragma unroll 8
    for (int i = 0; i < 32; ++i) { const int kk = 2 * i + (lane >> 5); float v = 0.f; if (sc >= 0) { v = W[(size_t)(k0 + kk) * N + sc]; if (kscale) v *= kscale[k0 + kk]; } scr[kk * 33 + (lane & 31)] = v; }
    LDS_WAIT(); asm volatile("" ::: "memory");
    const int c = lane & 7;
#pragma unroll
    for (int j = 0; j < 4; ++j) { const int n = (lane >> 3) + 8 * j; const LAS float* s = scr + (8 * c) * 33 + n;
        u32x4 o; o.x = pk2(s[0 * 33], s[1 * 33]); o.y = pk2(s[2 * 33], s[3 * 33]); o.z = pk2(s[4 * 33], s[5 * 33]); o.w = pk2(s[6 * 33], s[7 * 33]);
        *(u32x4*)(WT + (size_t)(n0 + n) * ldd + k0 + 8 * c) = o; }
    LDS_WAIT(); asm volatile("" ::: "memory");
}
__device__ __forceinline__ void transpose_item_v4(const float* Wsrc, int N, bf16_t* WTdst, int ldd, LAS float* scr, int lane) {
    const int c4 = (lane & 7) * 4, kr = lane >> 3;
    f32x4 t[8];
#pragma unroll
    for (int i = 0; i < 8; ++i) t[i] = *(const f32x4*)(Wsrc + (size_t)(i * 8 + kr) * N + c4);
#pragma unroll
    for (int i = 0; i < 8; ++i) { const int kk = i * 8 + kr; scr[(c4 + 0) * 65 + kk] = t[i].x; scr[(c4 + 1) * 65 + kk] = t[i].y; scr[(c4 + 2) * 65 + kk] = t[i].z; scr[(c4 + 3) * 65 + kk] = t[i].w; }
    LDS_WAIT(); asm volatile("" ::: "memory");
    const int c = lane & 7;
#pragma unroll
    for (int j = 0; j < 4; ++j) { const int n = (lane >> 3) + 8 * j; const LAS float* p = scr + n * 65 + 8 * c;
        u32x4 o; o.x = pk2(p[0], p[1]); o.y = pk2(p[2], p[3]); o.z = pk2(p[4], p[5]); o.w = pk2(p[6], p[7]);
        *(u32x4*)(WTdst + (size_t)n * ldd + 8 * c) = o; }
    LDS_WAIT(); asm volatile("" ::: "memory");
}
struct WinMap {
    __device__ __forceinline__ int operator()(int n) const {
        if (n < 512) { const int t = n & 31; return (n & ~31) + (t >> 1) + 16 * (t & 1); }
        if (n < 1152) return n;
        if (n < 1184) { const int t = n - 1152; return 1152 + (t >> 1) + 16 * (t & 1); }
        if (n < 1280) return -1;
        if (n < 2048) { const int u = n - 1280, t = u & 63; return 1184 + (u & ~63) + (t >> 1) + 32 * (t & 1); }
        if (n < 2432) return 1952 + (n - 2048);
        return -1;
    }
};
struct UqMap { __device__ __forceinline__ int operator()(int n) const { if (n >= 576) return -1; const int h = n / 96, t = n - 96 * h; if (t < 64) return n; const int u = t - 64; return 96 * h + 64 + (u >> 1) + 16 * (u & 1); } };
struct IdMap { __device__ __forceinline__ int operator()(int n) const { return n; } };
struct W13Map { __device__ __forceinline__ int operator()(int n) const { return (n >> 8) * 128 + (n & 127); } };

__device__ __forceinline__ void p0_prologue(Frame& F, const Args& a) {
    LAS float* scr = (LAS float*)(F.lds + F.wave * 16384);
    { float2* r32 = (float2*)(F.ws + WS_ROPE32); float2* r64 = (float2*)(F.ws + WS_ROPE64);
      for (int i = F.gw * 64 + F.lane; i < 4096 * 16; i += F.NGW * 64) { const int pos = i >> 4, j = i & 15; const float inv = 1.0f / powf(10000.0f, (float)(2 * j) / 32.0f); const float ang = (float)pos * inv; r32[i] = make_float2(cosf(ang), sinf(ang)); }
      for (int i = F.gw * 64 + F.lane; i < 4096 * 32; i += F.NGW * 64) { const int pos = i >> 5, j = i & 31; const float inv = 1.0f / powf(10000.0f, (float)(2 * j) / 64.0f); const float ang = (float)pos * inv; r64[i] = make_float2(cosf(ang), sinf(ang)); } }
    constexpr int I_WIN = (1024 / 64) * (2560 / 32), I_WOUT = (1024 / 64) * (1024 / 32), I_UQ = (256 / 64) * (768 / 32), I_UKV = (256 / 64) * (768 / 32);
    constexpr int PER_L = I_WIN + I_WOUT + I_UQ + I_UKV;
    for (int it = F.gw; it < DEPTH * PER_L; it += F.NGW) {
        const int l = it / PER_L; int r = it - l * PER_L;
        if (r < I_WIN) { const int kb = r / 80, nb = r % 80; transpose_item(a.w_in + (size_t)l * 1024 * 2336, 2336, (bf16_t*)(F.ws + WS_WIN) + (size_t)l * 2560 * 1024, 1024, scr, kb * 64, nb * 32, WinMap(), nullptr, F.lane); continue; } r -= I_WIN;
        if (r < I_WOUT) { const int kb = r / 32, nb = r % 32; transpose_item(a.w_out + (size_t)l * 1024 * 1024, 1024, (bf16_t*)(F.ws + WS_WOUT) + (size_t)l * 1024 * 1024, 1024, scr, kb * 64, nb * 32, IdMap(), nullptr, F.lane); continue; } r -= I_WOUT;
        if (r < I_UQ) { const int kb = r / 24, nb = r % 24; transpose_item(a.mla_w_uq + (size_t)l * 256 * 576, 576, (bf16_t*)(F.ws + WS_WUQ) + (size_t)l * 768 * 256, 256, scr, kb * 64, nb * 32, UqMap(), a.mla_q_norm + l * 256, F.lane); continue; } r -= I_UQ;
        { const int kb = r / 24, nb = r % 24; bf16_t* dst = (bf16_t*)(F.ws + WS_WUKV) + (size_t)l * 768 * 256;
          if (kb < 2) transpose_item(a.mla_w_ukv + (size_t)l * 128 * 768, 768, dst, 256, scr, kb * 64, nb * 32, IdMap(), a.mla_kv_norm + l * 128, F.lane);
          else { const int c = F.lane & 7;
#pragma unroll
              for (int j = 0; j < 4; ++j) { const int n = (F.lane >> 3) + 8 * j; *(u32x4*)(dst + (size_t)(nb * 32 + n) * 256 + kb * 64 + 8 * c) = (u32x4){0u, 0u, 0u, 0u}; } } }
    }
    bf16_t* XB = (bf16_t*)(F.ws + WS_XB);
    for (int m = F.gw; m < NTOK; m += F.NGW) {
        const float* src = (m < NTOK_P) ? a.x_prompt + (size_t)m * DM : a.x_sample + (size_t)(m - NTOK_P) * DM;
#pragma unroll
        for (int j = 0; j < 4; ++j) { const f32x4 v = *((const f32x4*)src + F.lane + 64 * j);
            u32x2 w; w.x = pk2(v.x, v.y); w.y = pk2(v.z, v.w); *((u32x2*)(XB + (size_t)m * DM) + F.lane + 64 * j) = w; }
    }
}

template <class Epi, class RowMap>
__device__ __forceinline__ void sg_tile(const bf16_t* A, int lda, const bf16_t* B0, const bf16_t* B1, int ldb, int K, int m0, int c0, const Epi& E, const RowMap& RM, int lane) {
    const int r32 = lane & 31, hi = lane >> 5;
    const bf16_t* ap = A + (size_t)RM.src(m0 + r32) * lda + 8 * hi;
    const bf16_t* b0p = B0 + (size_t)r32 * ldb + 8 * hi;
    const bf16_t* b1p = B1 + (size_t)r32 * ldb + 8 * hi;
    f32x16 acc0 = {}, acc1 = {};
#pragma unroll 4
    for (int k = 0; k < K; k += 16) {
        const bf16x8 af = *(const bf16x8*)(ap + k), bf0 = *(const bf16x8*)(b0p + k), bf1 = *(const bf16x8*)(b1p + k);
        acc0 = MFMA32(bf0, af, acc0); acc1 = MFMA32(bf1, af, acc1);
    }
#pragma unroll
    for (int g = 0; g < 4; ++g) { const f32x4 v0 = {acc0[4 * g], acc0[4 * g + 1], acc0[4 * g + 2], acc0[4 * g + 3]}, v1 = {acc1[4 * g], acc1[4 * g + 1], acc1[4 * g + 2], acc1[4 * g + 3]};
        E.put(m0 + r32, c0, 8 * g + 4 * hi, v0, v1); }
}
struct IdRows { __device__ __forceinline__ int src(int m) const { return m; } };

__device__ __forceinline__ void store_bf8(bf16_t* p, f32x4 a, f32x4 b) { u32x4 w; w.x = pk2(a.x, a.y); w.y = pk2(a.z, a.w); w.z = pk2(b.x, b.y); w.w = pk2(b.z, b.w); *(u32x4*)p = w; }
__device__ __forceinline__ void store_bf4(bf16_t* p, f32x4 v) { u32x2 w; w.x = pk2(v.x, v.y); w.y = pk2(v.z, v.w); *(u32x2*)p = w; }
struct EpiH {
    static constexpr bool PERM = true;
    bf16_t* H; const float2* rope32; const float2* rope64;
    __device__ __forceinline__ f32x4 xf(int pos, int col, f32x4 v) const {
        if (col < 512 || (col >= HC_KROPE && col < HC_KROPE + 32)) {
            const int j0 = (col & 31) >> 1; const f32x4 cs = *(const f32x4*)(rope32 + pos * 16 + j0);
            f32x4 o; o.x = v.x * cs.x - v.y * cs.y; o.y = v.x * cs.y + v.y * cs.x; o.z = v.z * cs.z - v.w * cs.w; o.w = v.z * cs.w + v.w * cs.z;
            if (col < 256) o = o * SC_A; v = o;
        } else if (col >= HC_CQ && col < HC_CV) {
            const int j0 = ((col - HC_CQ) & 63) >> 1; const f32x4 cs = *(const f32x4*)(rope64 + pos * 32 + j0);
            f32x4 o; o.x = v.x * cs.x - v.y * cs.y; o.y = v.x * cs.y + v.y * cs.x; o.z = v.z * cs.z - v.w * cs.w; o.w = v.z * cs.w + v.w * cs.z;
            if (col < HC_CK) o = o * SC_C; v = o;
        }
        return v;
    }
    __device__ __forceinline__ void put4(int row, int col, f32x4 v) const { store_bf4(H + (size_t)row * HP + col, xf(seqinfo(row).pos, col, v)); }
    __device__ __forceinline__ void put(int row, int c0, int cc, f32x4 v0, f32x4 v1) const { put4(row, c0 + cc, v0); put4(row, c0 + 32 + cc, v1); }
    template <class U> __device__ __forceinline__ void put8(const U&, int row, int col, f32x4 v0, f32x4 v1) const { const int pos = seqinfo(row).pos; store_bf8(H + (size_t)row * HP + col, xf(pos, col, v0), xf(pos, col + 4, v1)); }
    struct Pre { f32x4 c0, c1; };
    __device__ __forceinline__ static f32x4 rot(f32x4 v, f32x4 cs) { f32x4 o; o.x = v.x * cs.x - v.y * cs.y; o.y = v.x * cs.y + v.y * cs.x; o.z = v.z * cs.z - v.w * cs.w; o.w = v.z * cs.w + v.w * cs.z; return o; }
    template <class U> __device__ __forceinline__ Pre pre(const U&, int row, int col) const { Pre p; p.c0 = (f32x4){0.f, 0.f, 0.f, 0.f}; p.c1 = p.c0; const int pos = seqinfo(row).pos;
        if (col < 512 || (col >= HC_KROPE && col < HC_KROPE + 32)) { const f32x4* t = (const f32x4*)(rope32 + pos * 16 + ((col & 31) >> 1)); p.c0 = t[0]; p.c1 = t[1]; }
        else if (col >= HC_CQ && col < HC_CV) { const f32x4* t = (const f32x4*)(rope64 + pos * 32 + (((col - HC_CQ) & 63) >> 1)); p.c0 = t[0]; p.c1 = t[1]; }
        return p; }
    template <class U> __device__ __forceinline__ void fin8(const U&, int row, int col, f32x4 v0, f32x4 v1, const Pre& p) const {
        if (col < 512 || (col >= HC_KROPE && col < HC_KROPE + 32)) { v0 = rot(v0, p.c0); v1 = rot(v1, p.c1); if (col < 256) { v0 = v0 * SC_A; v1 = v1 * SC_A; } }
        else if (col >= HC_CQ && col < HC_CV) { v0 = rot(v0, p.c0); v1 = rot(v1, p.c1); if (col < HC_CK) { v0 = v0 * SC_C; v1 = v1 * SC_C; } }
        store_bf8(H + (size_t)row * HP + col, v0, v1); }
};
struct EpiUQ {
    static constexpr bool PERM = true;
    bf16_t* Q; const float* rstd; const float2* rope32;
    __device__ __forceinline__ f32x4 xf(int row, int col, f32x4 v, float rs) const {
        v = v * rs;
        const int t = col % 96;
        if (t >= 64) { const int pos = seqinfo(row).pos; const int j0 = (t - 64) >> 1; const f32x4 cs = *(const f32x4*)(rope32 + pos * 16 + j0);
            f32x4 o; o.x = v.x * cs.x - v.y * cs.y; o.y = v.x * cs.y + v.y * cs.x; o.z = v.z * cs.z - v.w * cs.w; o.w = v.z * cs.w + v.w * cs.z; v = o; }
        return v * SC_B;
    }
    __device__ __forceinline__ void put4(int row, int col, f32x4 v) const { if (col >= 576) return; store_bf4(Q + (size_t)row * QBP + col, xf(row, col, v, rstd[2 * row])); }
    template <class U> __device__ __forceinline__ void put8(const U&, int row, int col, f32x4 v0, f32x4 v1) const { if (col >= 576) return; const float rs = rstd[2 * row]; store_bf8(Q + (size_t)row * QBP + col, xf(row, col, v0, rs), xf(row, col + 4, v1, rs)); }
    __device__ __forceinline__ void put(int row, int c0, int cc, f32x4 v0, f32x4 v1) const { put4(row, c0 + cc, v0); put4(row, c0 + 32 + cc, v1); }
    struct Pre { float rs; f32x4 c0, c1; };
    template <class U> __device__ __forceinline__ Pre pre(const U&, int row, int col) const { Pre p; p.rs = rstd[2 * row]; p.c0 = (f32x4){0.f, 0.f, 0.f, 0.f}; p.c1 = p.c0;
        if (col < 576 && (col % 96) >= 64) { const f32x4* t = (const f32x4*)(rope32 + seqinfo(row).pos * 16 + (((col % 96) - 64) >> 1)); p.c0 = t[0]; p.c1 = t[1]; }
        return p; }
    template <class U> __device__ __forceinline__ void fin8(const U&, int row, int col, f32x4 v0, f32x4 v1, const Pre& p) const { if (col >= 576) return;
        v0 = v0 * p.rs; v1 = v1 * p.rs; if ((col % 96) >= 64) { v0 = EpiH::rot(v0, p.c0); v1 = EpiH::rot(v1, p.c1); }
        store_bf8(Q + (size_t)row * QBP + col, v0 * SC_B, v1 * SC_B); }
};
struct EpiUKV {
    static constexpr bool PERM = true;
    bf16_t* KV; const float* rstd;
    template <class U> __device__ __forceinline__ void put8(const U&, int row, int col, f32x4 v0, f32x4 v1) const { const float rs = rstd[2 * row + 1]; store_bf8(KV + (size_t)row * KVP + col, v0 * rs, v1 * rs); }
    __device__ __forceinline__ void put4(int row, int col, f32x4 v) const { store_bf4(KV + (size_t)row * KVP + col, v * rstd[2 * row + 1]); }
    __device__ __forceinline__ void put(int row, int c0, int cc, f32x4 v0, f32x4 v1) const { put4(row, c0 + cc, v0); put4(row, c0 + 32 + cc, v1); }
    struct Pre { float rs; };
    template <class U> __device__ __forceinline__ Pre pre(const U&, int row, int) const { Pre p; p.rs = rstd[2 * row + 1]; return p; }
    template <class U> __device__ __forceinline__ void fin8(const U&, int row, int col, f32x4 v0, f32x4 v1, const Pre& p) const { store_bf8(KV + (size_t)row * KVP + col, v0 * p.rs, v1 * p.rs); }
};
struct EpiRes {
    static constexpr bool PERM = false;
    float* X; const float* xp; const float* xs; float* D;
    template <class U> __device__ __forceinline__ void put4(const U&, int row, int col, f32x4 v) const { put4(row, col, v); }
    __device__ __forceinline__ void put4(int row, int col, f32x4 v) const {
        const f32x4* p = (const f32x4*)(X + (size_t)row * DM + col);
        const f32x4 r = xp ? *(const f32x4*)(((row < NTOK_P) ? xp + (size_t)row * DM : xs + (size_t)(row - NTOK_P) * DM) + col) : *p;
        *(f32x4*)(D + (size_t)row * DM + col) = r * DN_ALPHA + v; }
    __device__ __forceinline__ void put(int row, int c0, int cc, f32x4 v0, f32x4 v1) const { put4(row, c0 + cc, v0); put4(row, c0 + 32 + cc, v1); }
    struct Pre { f32x4 a, b; };
    template <class U> __device__ __forceinline__ Pre pre(const U&, int row, int col) const { Pre p;
        const float* src = xp ? ((row < NTOK_P) ? xp + (size_t)row * DM : xs + (size_t)(row - NTOK_P) * DM) : X + (size_t)row * DM;
        p.a = *(const f32x4*)(src + col); p.b = *(const f32x4*)(src + col + 16); return p; }
    template <class U> __device__ __forceinline__ void fin4x2(const U&, int row, int col, f32x4 v0, f32x4 v1, const Pre& p) const {
        *(f32x4*)(D + (size_t)row * DM + col) = p.a * DN_ALPHA + v0; *(f32x4*)(D + (size_t)row * DM + col + 16) = p.b * DN_ALPHA + v1; }
};
__device__ __forceinline__ float silu_f(float x) { return x / (1.0f + __expf(-x)); }
struct EpiHid {
    static constexpr bool PERM = true;
    bf16_t* HID;
    __device__ __forceinline__ f32x4 act(f32x4 g, f32x4 u) const { f32x4 o; o.x = silu_f(g.x) * u.x; o.y = silu_f(g.y) * u.y; o.z = silu_f(g.z) * u.z; o.w = silu_f(g.w) * u.w; return o; }
    template <class U> __device__ __forceinline__ void putp8(const U&, int row, int col, f32x4 g0, f32x4 g1, f32x4 u0, f32x4 u1) const { store_bf8(HID + (size_t)row * DEXP + col, act(g0, u0), act(g1, u1)); }
    __device__ __forceinline__ void putp(int row, int col, f32x4 g, f32x4 u) const { f32x4 o; o.x = silu_f(g.x) * u.x; o.y = silu_f(g.y) * u.y; o.z = silu_f(g.z) * u.z; o.w = silu_f(g.w) * u.w; store_bf4(HID + (size_t)row * DEXP + col, o); }
    __device__ __forceinline__ void put(int row, int c0, int cc, f32x4 v0, f32x4 v1) const { putp(row, c0 + cc, v0, v1); }
};
struct EpiY {
    bf16_t* YB; const float* tw; const int* list; int seg0, cnt;
    __device__ __forceinline__ void put4(int row, int col, f32x4 v) const { const int r = row - seg0; if (r >= cnt) return; const int a = list[r]; store_bf4(YB + (size_t)a * DM + col, v * tw[a]); }
    __device__ __forceinline__ void put(int row, int c0, int cc, f32x4 v0, f32x4 v1) const { put4(row, c0 + cc, v0); put4(row, c0 + 32 + cc, v1); }
};

struct EpiYO {
    static constexpr bool PERM = true;
    bf16_t* YB; const float* tw; const int* list; const LAS int* seg;
    template <class U> __device__ __forceinline__ void put8(const U& u, int row, int col, f32x4 v0, f32x4 v1) const {
        const int r = row - __builtin_amdgcn_readfirstlane(seg[u.e]); if (r >= __builtin_amdgcn_readfirstlane(seg[33 + u.e])) return; const int a = list[(size_t)u.e * LIST_CAP + r]; const float w = tw[a]; store_bf8(YB + (size_t)a * DM + col, v0 * w, v1 * w); }
    struct Pre { int a; float w; };
    template <class U> __device__ __forceinline__ Pre pre(const U& u, int row, int) const { Pre p; p.a = -1; p.w = 0.f;
        const int r = row - __builtin_amdgcn_readfirstlane(seg[u.e]); if (r < __builtin_amdgcn_readfirstlane(seg[33 + u.e])) { p.a = list[(size_t)u.e * LIST_CAP + r]; p.w = tw[p.a]; } return p; }
    template <class U> __device__ __forceinline__ void fin8(const U&, int, int col, f32x4 v0, f32x4 v1, const Pre& p) const { if (p.a >= 0) store_bf8(YB + (size_t)p.a * DM + col, v0 * p.w, v1 * p.w); }
};
template <class Epi>
__device__ __forceinline__ void sg_phase(Frame& F, const bf16_t* A, int lda, const bf16_t* Bt, int ldb, int M, int N, int K, const Epi& E) {
    const int nN = N / 64, items = (M / 32) * nN;
    for (int it = F.gw; it < items; it += F.NGW) { const int mt = it / nN, nt = it - mt * nN;
        sg_tile(A, lda, Bt + (size_t)(nt * 64) * ldb, Bt + (size_t)(nt * 64 + 32) * ldb, ldb, K, mt * 32, nt * 64, E, IdRows(), F.lane); }
}


namespace pg8 {
constexpr int BM = 256, BK = 64, HALF = 128, HTB = HALF * BK * 2, NXCD = 8, WGM = 8;
__host__ __device__ __forceinline__ int lds_byte(int r, int c) { const int st = (r >> 4) * 2 + (c >> 5), rr = r & 15, cc = c & 31, ob = rr * 64 + cc * 2; return st * 1024 + (ob ^ (((ob >> 9) & 1) << 5)); }
__host__ __device__ __forceinline__ void stage_rc(int b, int& R, int& C) { const int st = b / 1024, sb = b % 1024, swz = sb ^ (((sb >> 9) & 1) << 5); R = (st >> 1) * 16 + swz / 64; C = (st & 1) * 32 + (swz % 64) / 2; }
__host__ __device__ __forceinline__ int perm32(int rho) { const int n = rho >> 4, i = rho & 15; return 8 * (i >> 2) + 4 * n + (i & 3); }
struct Unit { int pm, pn, e; const char* a; const char* b; };
__device__ __forceinline__ bool order_next(int i, int G, int c, int nM, int nN, int& pm, int& pn) {
    const int nwg = nM * nN; const long L = (long)i * G + c; if (L >= nwg) return false;
    int wgid = (int)L; { const int q = nwg / NXCD, r = nwg % NXCD, xcd = wgid % NXCD, off = wgid / NXCD; wgid = (xcd < r ? xcd * (q + 1) : r * (q + 1) + (xcd - r) * q) + off; }
    const int nig = WGM * nN, gid = wgid / nig, fm = gid * WGM, gsz = (nM - fm) < WGM ? (nM - fm) : WGM;
    pm = fm + ((wgid % nig) % gsz); pn = (wgid % nig) / gsz; return true;
}
struct DenseSched {
    const char* A; const char* Bt; int nM, nN, G, c; size_t tstepA, tstepB;
    __device__ __forceinline__ void init(const bf16_t* A_, int lda, const bf16_t* Bt_, int M, int N, int K, int G_, int c_) { A = (const char*)A_; Bt = (const char*)Bt_; nM = M / BM; nN = N / BM; G = G_; c = c_; tstepA = (size_t)BM * lda * 2; tstepB = (size_t)BM * K * 2; }
    __device__ __forceinline__ bool next(int i, Unit& u) const { if (!order_next(i, G, c, nM, nN, u.pm, u.pn)) return false; u.e = 0; u.a = A + (size_t)u.pm * tstepA; u.b = Bt + (size_t)u.pn * tstepB; return true; }
    __device__ __forceinline__ unsigned arow(const Unit&, int) const { return 0u; }
};
struct PanelSched {
    const char* A; const char* Bt; int pm, nN; size_t tstepB;
    __device__ __forceinline__ void init(const bf16_t* A_, int lda, const bf16_t* Bt_, int pm_, int N, int K) { pm = pm_; nN = N / BM; A = (const char*)A_ + (size_t)pm_ * BM * lda * 2; Bt = (const char*)Bt_; tstepB = (size_t)BM * K * 2; }
    __device__ __forceinline__ bool next(int i, Unit& u) const { if (i >= nN) return false; u.pm = pm; int pn = i + (pm % nN); if (pn >= nN) pn -= nN; u.pn = pn; u.e = 0; u.a = A; u.b = Bt + (size_t)pn * tstepB; return true; }
    __device__ __forceinline__ unsigned arow(const Unit&, int) const { return 0u; }
};
template <class Epi, bool PAIR> struct EpiApply;
template <class Epi, class Sched, bool GATHER, bool PAIR>
__device__ __forceinline__ void gemm_phase(LAS unsigned char* lds, int tid, int K, int lda, const Sched& S, const Epi& E) {
    const int wid = __builtin_amdgcn_readfirstlane(tid >> 6), lane = tid & 63, wr = wid >> 2, wc = wid & 3, fr = lane & 15, fq = lane >> 4;
    const int nt = K / BK;
    unsigned voffA[2], voffB[2]; int RA[2], CA[2];
#pragma unroll
    for (int i = 0; i < 2; ++i) { int R, C; stage_rc(tid * 16 + i * 8192, R, C); const int Rb = Epi::PERM ? ((R & ~31) + perm32(R & 31)) : R; RA[i] = R; CA[i] = C;
        voffA[i] = (unsigned)(R * lda + C) * 2u; voffB[i] = (unsigned)(Rb * K + C) * 2u; }
    const size_t kstep = (size_t)(BK * 2);
    const size_t hstepA = (size_t)HALF * lda * 2, hstepB = (size_t)HALF * K * 2;
    const unsigned ldsw = (unsigned)wid * 1024u;
    const int aoff = lds_byte(wr * 64 + fr, fq * 8), boff = lds_byte(wc * 32 + fr, fq * 8);
#define PG8_SA(b, h) (((b) * 2 + (h)) * HTB)
#define PG8_SB(b, h) ((4 + (b) * 2 + (h)) * HTB)
#define PG8_STAGE(bufoff, gbase, voff) do { _Pragma("unroll") for (int _i = 0; _i < 2; ++_i) \
        __builtin_amdgcn_global_load_lds((const unsigned*)((const char*)(gbase) + (voff)[_i]), (LAS unsigned*)(lds + (bufoff) + ldsw + _i * 8192), 16, 0, 0); } while (0)
#define PG8_STAGE_A(bufoff, ab, vg, h, koff) do { if (GATHER) { PG8_STAGE(bufoff, (ab) + (koff), (vg)[h]); } else { PG8_STAGE(bufoff, (ab) + (h) * hstepA + (koff), voffA); } } while (0)
#define PG8_LDA(dst, b, h) do { _Pragma("unroll") for (int m = 0; m < 4; ++m) _Pragma("unroll") for (int k = 0; k < 2; ++k) dst[m][k] = *(const LAS bf16x8*)(lds + PG8_SA(b, h) + aoff + m * 2048 + k * 1024); } while (0)
#define PG8_LDB(dst, b, h) do { _Pragma("unroll") for (int n = 0; n < 2; ++n) _Pragma("unroll") for (int k = 0; k < 2; ++k) dst[n][k] = *(const LAS bf16x8*)(lds + PG8_SB(b, h) + boff + n * 2048 + k * 1024); } while (0)
#define PG8_MMA(ai, bj, At, Bt) do { __builtin_amdgcn_s_setprio(1); _Pragma("unroll") for (int m = 0; m < 4; ++m) _Pragma("unroll") for (int n = 0; n < 2; ++n) _Pragma("unroll") for (int k = 0; k < 2; ++k) \
        acc[ai][bj][m][n] = __builtin_amdgcn_mfma_f32_16x16x32_bf16(Bt[n][k], At[m][k], acc[ai][bj][m][n], 0, 0, 0); __builtin_amdgcn_s_setprio(0); } while (0)
#define PG8_WAIT_V(n) asm volatile("s_waitcnt vmcnt(" #n ")" ::: "memory")
#define PG8_WAIT_L(n) asm volatile("s_waitcnt lgkmcnt(" #n ")" ::: "memory")
#define PG8_BAR __builtin_amdgcn_s_barrier()
#define PG8_SCHED __builtin_amdgcn_sched_barrier(0)
    Unit cur, nxt; int ui = 0;
    if (!S.next(0, cur)) return;
    f32x4 acc[2][2][4][2];
#pragma unroll
    for (int a = 0; a < 2; ++a)
#pragma unroll
        for (int b = 0; b < 2; ++b)
#pragma unroll
            for (int m = 0; m < 4; ++m)
#pragma unroll
                for (int n = 0; n < 2; ++n) acc[a][b][m][n] = (f32x4){0.f, 0.f, 0.f, 0.f};
    bf16x8 At[4][2], B0[2][2], B1[2][2];
    unsigned vgc[2][2] = {{0u, 0u}, {0u, 0u}}, vgn[2][2] = {{0u, 0u}, {0u, 0u}};
    if (GATHER) {
#pragma unroll
        for (int h = 0; h < 2; ++h)
#pragma unroll
            for (int i = 0; i < 2; ++i) vgc[h][i] = S.arow(cur, h * HALF + RA[i]) * (unsigned)(lda * 2) + (unsigned)CA[i] * 2u;
    }
    const char* cA = cur.a; const char* cB = cur.b;
    PG8_STAGE(PG8_SB(0, 0), cB, voffB); PG8_STAGE(PG8_SB(0, 1), cB + hstepB, voffB); PG8_STAGE_A(PG8_SA(0, 0), cA, vgc, 0, 0); PG8_STAGE_A(PG8_SA(0, 1), cA, vgc, 1, 0);
    if (wr == 1) PG8_BAR;
    PG8_WAIT_V(2); PG8_BAR;
    PG8_STAGE(PG8_SB(1, 0), cB + kstep, voffB); PG8_STAGE_A(PG8_SA(1, 0), cA, vgc, 0, kstep); PG8_STAGE(PG8_SB(1, 1), cB + hstepB + kstep, voffB);
    PG8_WAIT_V(6); PG8_BAR;
    for (;;) {
        const bool has_next = S.next(ui + 1, nxt);
        const char* nA = has_next ? nxt.a : cA; const char* nB = has_next ? nxt.b : cB;
        if (GATHER) {
#pragma unroll
            for (int h = 0; h < 2; ++h)
#pragma unroll
                for (int i = 0; i < 2; ++i) vgn[h][i] = has_next ? (S.arow(nxt, h * HALF + RA[i]) * (unsigned)(lda * 2) + (unsigned)CA[i] * 2u) : vgc[h][i];
        }
#pragma clang loop unroll(disable)
        for (int t = 0; t < nt; t += 2) {
            const bool last = (t == nt - 2);
            const size_t k1 = (size_t)(t + 1) * kstep;
            const char* a2 = last ? nA : cA; const char* b2 = last ? nB : cB + (size_t)(t + 2) * kstep; const size_t ka2 = last ? 0 : (size_t)(t + 2) * kstep;
            const char* b3 = b2 + kstep; const size_t ka3 = ka2 + kstep;
            unsigned v2[2][2];
#pragma unroll
            for (int h = 0; h < 2; ++h)
#pragma unroll
                for (int i = 0; i < 2; ++i) v2[h][i] = last ? vgn[h][i] : vgc[h][i];
            PG8_LDB(B0, 0, 0); PG8_LDB(B1, 0, 1); PG8_SCHED; PG8_LDA(At, 0, 0); PG8_STAGE_A(PG8_SA(1, 1), cA, vgc, 1, k1);
            PG8_WAIT_V(8); PG8_WAIT_L(0); PG8_BAR; PG8_MMA(0, 0, At, B0); PG8_MMA(0, 1, At, B1); PG8_BAR; PG8_SCHED;
            PG8_LDA(At, 0, 1); PG8_STAGE(PG8_SB(0, 0), b2, voffB); PG8_STAGE(PG8_SB(0, 1), b2 + hstepB, voffB); PG8_STAGE_A(PG8_SA(0, 0), a2, v2, 0, ka2);
            PG8_WAIT_V(8); PG8_WAIT_L(0); PG8_BAR; PG8_MMA(1, 0, At, B0); PG8_MMA(1, 1, At, B1); PG8_BAR; PG8_SCHED;
            PG8_LDB(B0, 1, 0); PG8_LDB(B1, 1, 1); PG8_SCHED; PG8_LDA(At, 1, 0); PG8_STAGE_A(PG8_SA(0, 1), a2, v2, 1, ka2);
            PG8_WAIT_V(8); PG8_WAIT_L(0); PG8_BAR; PG8_MMA(0, 0, At, B0); PG8_MMA(0, 1, At, B1); PG8_BAR; PG8_SCHED;
            PG8_LDA(At, 1, 1); PG8_STAGE(PG8_SB(1, 0), b3, voffB); PG8_STAGE(PG8_SB(1, 1), b3 + hstepB, voffB); PG8_STAGE_A(PG8_SA(1, 0), a2, v2, 0, ka3);
            PG8_WAIT_V(8); PG8_WAIT_L(0); PG8_BAR; PG8_MMA(1, 0, At, B0); PG8_MMA(1, 1, At, B1); PG8_BAR; PG8_SCHED;
        }
        if (wr == 0) PG8_BAR;
        { int fr_ = fr, fq_ = fq; asm volatile("" : "+v"(fr_), "+v"(fq_));
          EpiApply<Epi, PAIR>::run(E, acc, cur, wr, wc, fr_, fq_); }
        if (!has_next) break;
#pragma unroll
        for (int a = 0; a < 2; ++a)
#pragma unroll
            for (int b = 0; b < 2; ++b)
#pragma unroll
                for (int m = 0; m < 4; ++m)
#pragma unroll
                    for (int n = 0; n < 2; ++n) acc[a][b][m][n] = (f32x4){0.f, 0.f, 0.f, 0.f};
        cur = nxt; cA = nA; cB = nB; ++ui;
        if (GATHER) {
#pragma unroll
            for (int h = 0; h < 2; ++h)
#pragma unroll
                for (int i = 0; i < 2; ++i) vgc[h][i] = vgn[h][i];
        }
        if (wr == 1) PG8_BAR;
    }
    PG8_WAIT_V(0);
    PG8_BAR;
#undef PG8_SA
#undef PG8_SB
#undef PG8_STAGE
#undef PG8_STAGE_A
#undef PG8_LDA
#undef PG8_LDB
#undef PG8_MMA
#undef PG8_WAIT_V
#undef PG8_WAIT_L
#undef PG8_BAR
#undef PG8_SCHED
}
template <class Epi> struct EpiApply<Epi, false> {
    static __device__ __forceinline__ void run(const Epi& E, const f32x4 (&acc)[2][2][4][2], const Unit& u, int wr, int wc, int fr, int fq) {
#pragma unroll
        for (int ai = 0; ai < 2; ++ai) {
            typename Epi::Pre pre[4][2];
#pragma unroll
            for (int m = 0; m < 4; ++m) { const int row = u.pm * BM + ai * HALF + wr * 64 + m * 16 + fr;
#pragma unroll
                for (int bj = 0; bj < 2; ++bj) pre[m][bj] = E.pre(u, row, u.pn * BM + bj * HALF + wc * 32 + (Epi::PERM ? 8 : 4) * fq); }
#pragma unroll
            for (int m = 0; m < 4; ++m) { const int row = u.pm * BM + ai * HALF + wr * 64 + m * 16 + fr;
#pragma unroll
                for (int bj = 0; bj < 2; ++bj) {
                    if constexpr (Epi::PERM) E.fin8(u, row, u.pn * BM + bj * HALF + wc * 32 + 8 * fq, acc[ai][bj][m][0], acc[ai][bj][m][1], pre[m][bj]);
                    else E.fin4x2(u, row, u.pn * BM + bj * HALF + wc * 32 + 4 * fq, acc[ai][bj][m][0], acc[ai][bj][m][1], pre[m][bj]); } }
        }
    }
};
template <class Epi> struct EpiApply<Epi, true> {
    static __device__ __forceinline__ void run(const Epi& E, const f32x4 (&acc)[2][2][4][2], const Unit& u, int wr, int wc, int fr, int fq) {
#pragma unroll
        for (int ai = 0; ai < 2; ++ai)
#pragma unroll
            for (int m = 0; m < 4; ++m) { const int row = u.pm * BM + ai * HALF + wr * 64 + m * 16 + fr;
                E.putp8(u, row, u.pn * HALF + wc * 32 + 8 * fq, acc[ai][0][m][0], acc[ai][0][m][1], acc[ai][1][m][0], acc[ai][1][m][1]); }
    }
};
}

__device__ __forceinline__ void rowstat_pass(Frame& F, int r_first, int r_stride, int r_end) {
    const bf16_t* H = (const bf16_t*)(F.ws + WS_H); float* rstd = (float*)(F.ws + WS_RSTD);
    for (int m = r_first; m < r_end; m += r_stride) {
        const bf16_t* hr = H + (size_t)m * HP;
        const u32x2 q = *((const u32x2*)(hr + HC_CQ_LAT) + F.lane);
        const unsigned kv = *((const unsigned*)(hr + HC_CKV) + F.lane);
        float a0 = bf2f(q.x & 0xffff), a1 = bf2f(q.x >> 16), a2 = bf2f(q.y & 0xffff), a3 = bf2f(q.y >> 16), b0 = bf2f(kv & 0xffff), b1 = bf2f(kv >> 16);
        const float sq = wave_sum(a0 * a0 + a1 * a1 + a2 * a2 + a3 * a3), sk = wave_sum(b0 * b0 + b1 * b1);
        if (F.lane == 0) { rstd[2 * m] = 1.0f / sqrtf(sq * (1.0f / 256.0f) + RMS_EPS); rstd[2 * m + 1] = 1.0f / sqrtf(sk * (1.0f / 128.0f) + RMS_EPS); }
    }
}
__device__ __forceinline__ void red8(float (&v)[8], int lane) {
    float a[4], b[2], c;
#pragma unroll
    for (int i = 0; i < 4; ++i) a[i] = xpair32(v[i], v[i + 4]);
    { const bool up = (lane & 16) != 0;
#pragma unroll
      for (int i = 0; i < 2; ++i) { const float send = up ? a[i] : a[i + 2], keep = up ? a[i + 2] : a[i]; b[i] = keep + shx<16>(send); } }
    { const bool up = (lane & 8) != 0; const float send = up ? b[0] : b[1], keep = up ? b[1] : b[0]; c = keep + shx<8>(send); }
    c += shx<4>(c); c += shx<2>(c); c += shx<1>(c);
#pragma unroll
    for (int i = 0; i < 8; ++i) v[i] = __uint_as_float(__builtin_amdgcn_readlane(__float_as_uint(c), ((i >> 2) & 1) * 32 + ((i >> 1) & 1) * 16 + (i & 1) * 8));
}
__device__ __forceinline__ void red4(float (&v)[4], int lane) {
    float a[2], c;
#pragma unroll
    for (int i = 0; i < 2; ++i) a[i] = xpair32(v[i], v[i + 2]);
    { const bool up = (lane & 16) != 0; const float send = up ? a[0] : a[1], keep = up ? a[1] : a[0]; c = keep + shx<16>(send); }
    c += shx<8>(c); c += shx<4>(c); c += shx<2>(c); c += shx<1>(c);
#pragma unroll
    for (int i = 0; i < 4; ++i) v[i] = __uint_as_float(__builtin_amdgcn_readlane(__float_as_uint(c), ((i >> 1) & 1) * 32 + (i & 1) * 16));
}
__device__ __forceinline__ void ln1_route_pass(Frame& F, const Args& a, int layer, int r_first, int r_stride, int r_end) {
    bf16_t* XB = (bf16_t*)(F.ws + WS_XB); float* tw = (float*)(F.ws + WS_TW); int* list = (int*)(F.ws + WS_LIST);
    const float* g = a.ln1_g + layer * DM; const float* bb = a.ln1_b + layer * DM;
    const float* wc = a.moe_w_coarse + (size_t)layer * DM * 4; const float* wf = a.moe_w_fine + (size_t)layer * 4 * DM * 8;
    for (int q = F.tid; q < 4 * 1024 * 2; q += NTHREADS) { const int hf = q & 1, k = (q >> 1) & 1023, gg = q >> 11; const int l = (k & 255) >> 2, e = k & 3, j = k >> 8;
        *(LAS f32x4*)(F.lds + (size_t)(gg * 2048 + ((j * 4 + e) * 2 + hf) * 64 + l) * 16) = *((const f32x4*)wf + q); }
    f32x4 wcr[4][4];
#pragma unroll
    for (int j = 0; j < 4; ++j)
#pragma unroll
        for (int e = 0; e < 4; ++e) wcr[j][e] = *(const f32x4*)(wc + (size_t)(4 * F.lane + 256 * j + e) * 4);
    __syncthreads();
    f32x4 vn[2][4];
#pragma unroll
    for (int rr = 0; rr < 2; ++rr) { const int mm = r_first + rr * r_stride; if (mm < r_end) {
#pragma unroll
        for (int j = 0; j < 4; ++j) vn[rr][j] = *((const f32x4*)(a.out + (size_t)mm * DM) + F.lane + 64 * j); } }
    for (int m0 = r_first; m0 < r_end; m0 += 2 * r_stride) {
        f32x4 vc[2][4];
#pragma unroll
        for (int rr = 0; rr < 2; ++rr)
#pragma unroll
            for (int j = 0; j < 4; ++j) vc[rr][j] = vn[rr][j];
#pragma unroll
        for (int rr = 0; rr < 2; ++rr) { const int mm = m0 + (2 + rr) * r_stride; if (mm < r_end) {
#pragma unroll
            for (int j = 0; j < 4; ++j) vn[rr][j] = *((const f32x4*)(a.out + (size_t)mm * DM) + F.lane + 64 * j); } }
#pragma unroll
      for (int rr = 0; rr < 2; ++rr) { const int m = m0 + rr * r_stride; if (m < r_end) {
        f32x4 v[4]; float s = 0.f;
#pragma unroll
        for (int j = 0; j < 4; ++j) { v[j] = vc[rr][j]; s += (v[j].x + v[j].y) + (v[j].z + v[j].w); }
        const float mean = wave_sum(s) * (1.f / DM); float s2 = 0.f;
#pragma unroll
        for (int j = 0; j < 4; ++j) { v[j] = v[j] - mean; s2 += (v[j].x * v[j].x + v[j].y * v[j].y) + (v[j].z * v[j].z + v[j].w * v[j].w); }
        const float rs = 1.f / sqrtf(wave_sum(s2) * (1.f / DM) + LN_EPS);
        float cl[4] = {0.f, 0.f, 0.f, 0.f};
#pragma unroll
        for (int j = 0; j < 4; ++j) { const int c = 4 * F.lane + 256 * j; const f32x4 gg = *(const f32x4*)(g + c), bv = *(const f32x4*)(bb + c); v[j] = v[j] * rs * gg + bv;
            u32x2 w; w.x = pk2(v[j].x, v[j].y); w.y = pk2(v[j].z, v[j].w); *((u32x2*)(XB + (size_t)m * DM) + F.lane + 64 * j) = w;
#pragma unroll
            for (int e = 0; e < 4; ++e) { const f32x4 w4 = wcr[j][e]; const float xe = v[j][e]; cl[0] += xe * w4.x; cl[1] += xe * w4.y; cl[2] += xe * w4.z; cl[3] += xe * w4.w; } }
        red4(cl, F.lane);
        int grp = 0; float cm = cl[0];
#pragma unroll
        for (int e = 1; e < 4; ++e) if (cl[e] > cm) { cm = cl[e]; grp = e; }
        float den = 0.f;
#pragma unroll
        for (int e = 0; e < 4; ++e) den += __expf(cl[e] - cm);
        const float pg = 1.0f / den;
        grp = __builtin_amdgcn_readfirstlane(grp);
        const LAS f32x4* wl = (const LAS f32x4*)(F.lds) + grp * 2048 + F.lane;
        float fl[8] = {0.f, 0.f, 0.f, 0.f, 0.f, 0.f, 0.f, 0.f};
#pragma unroll
        for (int j = 0; j < 4; ++j)
#pragma unroll
            for (int e = 0; e < 4; ++e) { const f32x4 wa = wl[((j * 4 + e) * 2) * 64], wb = wl[((j * 4 + e) * 2 + 1) * 64]; const float xe = v[j][e];
                fl[0] += xe * wa.x; fl[1] += xe * wa.y; fl[2] += xe * wa.z; fl[3] += xe * wa.w; fl[4] += xe * wb.x; fl[5] += xe * wb.y; fl[6] += xe * wb.z; fl[7] += xe * wb.w; }
        red8(fl, F.lane);
        int i0 = 0; float v0 = fl[0];
#pragma unroll
        for (int e = 1; e < 8; ++e) if (fl[e] > v0) { v0 = fl[e]; i0 = e; }
        int i1 = -1; float v1 = -3.0e38f;
#pragma unroll
        for (int e = 0; e < 8; ++e) if (e != i0 && fl[e] > v1) { v1 = fl[e]; i1 = e; }
        const float e1 = __expf(v1 - v0), w0 = pg / (1.0f + e1), w1 = pg * e1 / (1.0f + e1);
        if (F.lane < 2) { const int e = grp * 8 + (F.lane == 0 ? i0 : i1); const int a_id = 2 * m + F.lane;
            const unsigned pos = __hip_atomic_fetch_add(F.ctl + CW_CNT + layer * 64 + e, 1u, RLX_AGENT);
            list[(size_t)e * LIST_CAP + pos] = a_id; tw[a_id] = (F.lane == 0) ? w0 : w1; }
          } }
    }
    __syncthreads();
}
__device__ __forceinline__ void ln2_pass(Frame& F, const Args& a, int layer, int r_first, int r_stride, int r_end) {
    bf16_t* XB = (bf16_t*)(F.ws + WS_XB); const bf16_t* YB = (const bf16_t*)(F.ws + WS_YB);
    const float* g = a.ln2_g + layer * DM; const float* bb = a.ln2_b + layer * DM; const float* g1 = a.ln1_g + layer * DM; const float* b1 = a.ln1_b + layer * DM;
    f32x4 xn[2][4]; u32x2 pn[2][4], qn[2][4];
#define LN2_LOAD(rr, mm) do { const bf16_t* y0_ = YB + (size_t)(2 * (mm)) * DM; _Pragma("unroll") for (int j = 0; j < 4; ++j) { xn[rr][j] = *((const f32x4*)(a.out + (size_t)(mm) * DM) + F.lane + 64 * j); \
        pn[rr][j] = *((const u32x2*)y0_ + F.lane + 64 * j); qn[rr][j] = *((const u32x2*)(y0_ + DM) + F.lane + 64 * j); } } while (0)
#pragma unroll
    for (int rr = 0; rr < 2; ++rr) { const int mm = r_first + rr * r_stride; if (mm < r_end) LN2_LOAD(rr, mm); }
    for (int m0 = r_first; m0 < r_end; m0 += 2 * r_stride) {
        f32x4 xc[2][4]; u32x2 pc[2][4], qc[2][4];
#pragma unroll
        for (int rr = 0; rr < 2; ++rr)
#pragma unroll
            for (int j = 0; j < 4; ++j) { xc[rr][j] = xn[rr][j]; pc[rr][j] = pn[rr][j]; qc[rr][j] = qn[rr][j]; }
#pragma unroll
        for (int rr = 0; rr < 2; ++rr) { const int mm = m0 + (2 + rr) * r_stride; if (mm < r_end) LN2_LOAD(rr, mm); }
#pragma unroll
        for (int rr = 0; rr < 2; ++rr) { const int m = m0 + rr * r_stride; if (m < r_end) {
            float* xr = a.out + (size_t)m * DM;
            f32x4 v[4]; float s = 0.f;
            { float s1 = 0.f;
#pragma unroll
              for (int j = 0; j < 4; ++j) { v[j] = xc[rr][j]; s1 += (v[j].x + v[j].y) + (v[j].z + v[j].w); }
              const float mean1 = wave_sum(s1) * (1.f / DM); float q1 = 0.f;
#pragma unroll
              for (int j = 0; j < 4; ++j) { v[j] = v[j] - mean1; q1 += (v[j].x * v[j].x + v[j].y * v[j].y) + (v[j].z * v[j].z + v[j].w * v[j].w); }
              const float rs1 = 1.f / sqrtf(wave_sum(q1) * (1.f / DM) + LN_EPS);
#pragma unroll
              for (int j = 0; j < 4; ++j) { const int c = 4 * F.lane + 256 * j; xc[rr][j] = v[j] * rs1 * *(const f32x4*)(g1 + c) + *(const f32x4*)(b1 + c); } }
#pragma unroll
            for (int j = 0; j < 4; ++j) { v[j] = xc[rr][j] * DN_ALPHA; const u32x2 p = pc[rr][j], q = qc[rr][j];
                v[j].x += bf2f(p.x & 0xffff) + bf2f(q.x & 0xffff); v[j].y += bf2f(p.x >> 16) + bf2f(q.x >> 16); v[j].z += bf2f(p.y & 0xffff) + bf2f(q.y & 0xffff); v[j].w += bf2f(p.y >> 16) + bf2f(q.y >> 16);
                s += (v[j].x + v[j].y) + (v[j].z + v[j].w); }
            const float mean = wave_sum(s) * (1.f / DM); float s2 = 0.f;
#pragma unroll
            for (int j = 0; j < 4; ++j) { v[j] = v[j] - mean; s2 += (v[j].x * v[j].x + v[j].y * v[j].y) + (v[j].z * v[j].z + v[j].w * v[j].w); }
            const float rs = 1.f / sqrtf(wave_sum(s2) * (1.f / DM) + LN_EPS);
#pragma unroll
            for (int j = 0; j < 4; ++j) { const int c = 4 * F.lane + 256 * j; const f32x4 gg = *(const f32x4*)(g + c), bv = *(const f32x4*)(bb + c); v[j] = v[j] * rs * gg + bv;
                *((f32x4*)xr + F.lane + 64 * j) = v[j]; u32x2 w; w.x = pk2(v[j].x, v[j].y); w.y = pk2(v[j].z, v[j].w); *((u32x2*)(XB + (size_t)m * DM) + F.lane + 64 * j) = w; }
        } }
    }
#undef LN2_LOAD
}
__device__ __forceinline__ void moe_convert(Frame& F, const Args& a, int layer) {
    LAS float* scr = (LAS float*)(F.lds + F.wave * 16384);
    constexpr int I_13 = (1024 / 64) * (1024 / 32), I_2 = (512 / 64) * (1024 / 32), PER_E = I_13 + I_2;
    for (int it = F.gw; it < NEXP * PER_E; it += F.NGW) {
        const int e = it / PER_E; int r = it - e * PER_E; const size_t le = (size_t)layer * NEXP + e;
        if (r < I_13) { const int kb = r / 32, nb = r % 32; const float* src = ((nb >> 2) & 1) ? a.moe_w3 : a.moe_w1;
            const int sc0 = ((32 * nb) >> 8) * 128 + ((32 * nb) & 127);
            transpose_item_v4(src + le * 1024 * 512 + (size_t)(kb * 64) * 512 + sc0, 512, (bf16_t*)(F.ws + WS_W13) + (size_t)e * 1024 * 1024 + (size_t)(nb * 32) * 1024 + kb * 64, 1024, scr, F.lane); }
        else { r -= I_13; const int kb = r / 32, nb = r % 32;
            transpose_item_v4(a.moe_w2 + le * 512 * 1024 + (size_t)(kb * 64) * 1024 + nb * 32, 1024, (bf16_t*)(F.ws + WS_W2) + (size_t)e * 1024 * 512 + (size_t)(nb * 32) * 512 + kb * 64, 512, scr, F.lane); }
    }
}

typedef short at_s16x4 __attribute__((ext_vector_type(4)));
typedef LAS const unsigned char* at_lds_cptr;
__device__ __forceinline__ at_s16x4 at_vtr(at_lds_cptr p) { return __builtin_bit_cast(at_s16x4, __builtin_amdgcn_ds_read_tr16_b64_v4i16((LAS at_s16x4*)p)); }
struct RowSrc { const bf16_t* p; long pitch; };
constexpr int SA_P = 0, SA_V = 4096, SA_AL = 12288, SA_RL = 12544;
template <int NC0, int NC1, int MODE>
__device__ __forceinline__ void sattn_core(const bf16x8* qf, RowSrc k0, RowSrc k1, RowSrc vs, int kb_lo, int kb_hi, int qidx0, float lse_ref, LAS unsigned char* scr, int lane, f32x16* o, float& lse_out) {
    const int r32 = lane & 31, hi = lane >> 5;
    LAS bf16_t* Pb = (LAS bf16_t*)(scr + SA_P); LAS bf16_t* Vb = (LAS bf16_t*)(scr + SA_V); LAS float* Al = (LAS float*)(scr + SA_AL);
    float m = -1.0e30f, l = 0.f;
    if (MODE != 1) { o[0] = f32x16{}; o[1] = f32x16{}; }
    bf16x8 kn[NC0 + NC1]; u32x4 vn[4];
#define SA_LOAD(kb_) do { const long key_ = (long)(kb_) * 32 + r32; \
        _Pragma("unroll") for (int c = 0; c < NC0; ++c) kn[c] = *(const bf16x8*)(k0.p + key_ * k0.pitch + 16 * c + 8 * hi); \
        _Pragma("unroll") for (int c = 0; c < NC1; ++c) kn[NC0 + c] = *(const bf16x8*)(k1.p + key_ * k1.pitch + 16 * c + 8 * hi); \
        if (MODE != 1) { _Pragma("unroll") for (int i = 0; i < 4; ++i) { const int idx = i * 64 + lane, kr = idx >> 3, pc = idx & 7; vn[i] = *(const u32x4*)(vs.p + ((long)(kb_) * 32 + kr) * vs.pitch + pc * 8); } } } while (0)
    if (kb_lo < kb_hi) SA_LOAD(kb_lo);
    const at_lds_cptr vtb = (at_lds_cptr)(scr + SA_V) + ((8 * hi + ((lane & 15) >> 2)) * 72 + 16 * ((lane >> 4) & 1) + 4 * (lane & 3)) * 2;
    for (int kb = kb_lo; kb < kb_hi; ++kb) {
        bf16x8 kc[NC0 + NC1]; u32x4 vc[4];
#pragma unroll
        for (int c = 0; c < NC0 + NC1; ++c) kc[c] = kn[c];
#pragma unroll
        for (int i = 0; i < 4; ++i) vc[i] = vn[i];
        if (kb + 1 < kb_hi) SA_LOAD(kb + 1);
        f32x16 s = {};
#pragma unroll
        for (int c = 0; c < NC0 + NC1; ++c) s = MFMA32(kc[c], qf[c], s);
        bool valid[16];
#pragma unroll
        for (int r = 0; r < 16; ++r) { if (MODE == 0) valid[r] = true; else { const int d = kb * 32 + crow(r, hi) - (qidx0 + r32); valid[r] = (d <= 64 && d >= -64); } }
        float p[16];
        if (MODE == 2) {
#pragma unroll
            for (int r = 0; r < 16; ++r) p[r] = valid[r] ? fast_exp2(s[r] - lse_ref) : 0.f;
        } else {
            float mx = -1.0e30f;
#pragma unroll
            for (int r = 0; r < 16; ++r) if (valid[r]) mx = fmaxf(mx, s[r]);
            mx = xmax32(mx);
            const float mn = fmaxf(m, mx), alpha = fast_exp2(m - mn); m = mn;
            float ps = 0.f;
#pragma unroll
            for (int r = 0; r < 16; ++r) { p[r] = valid[r] ? fast_exp2(s[r] - mn) : 0.f; ps += p[r]; }
            l = l * alpha + ps;
            if (MODE == 0) { if (hi == 0) Al[r32] = alpha; }
        }
        if (MODE != 1) {
#pragma unroll
            for (int g = 0; g < 4; ++g) { u32x2 w; w.x = pk2(p[4 * g], p[4 * g + 1]); w.y = pk2(p[4 * g + 2], p[4 * g + 3]); *(LAS u32x2*)(Pb + r32 * 40 + 8 * g + 4 * hi) = w; }
#pragma unroll
            for (int i = 0; i < 4; ++i) { const int idx = i * 64 + lane, kr = idx >> 3, pc = idx & 7; *(LAS u32x4*)(Vb + kr * 72 + pc * 8) = vc[i]; }
            LDS_WAIT();
            if (MODE == 0) {
#pragma unroll
                for (int r = 0; r < 16; ++r) { const float al = Al[crow(r, hi)]; o[0][r] *= al; o[1][r] *= al; }
            }
#pragma unroll
            for (int st = 0; st < 2; ++st) {
                const bf16x8 pf = *(const LAS bf16x8*)(Pb + r32 * 40 + 16 * st + 8 * hi);
#pragma unroll
                for (int db = 0; db < 2; ++db) {
                    const at_s16x4 lo_ = at_vtr(vtb + (16 * st * 72 + 32 * db) * 2), hi_ = at_vtr(vtb + ((16 * st + 4) * 72 + 32 * db) * 2);
                    const bf16x8 vf = {lo_[0], lo_[1], lo_[2], lo_[3], hi_[0], hi_[1], hi_[2], hi_[3]};
                    o[db] = MFMA32(pf, vf, o[db]); }
            }
            LDS_WAIT();
        }
    }
#undef SA_LOAD
    if (MODE != 2) { l = xsum32(l); lse_out = m + __log2f(l); }
    if (MODE == 0) {
        LAS float* Rl = (LAS float*)(scr + SA_RL);
        if (hi == 0) Rl[r32] = 1.0f / l;
        LDS_WAIT();
#pragma unroll
        for (int r = 0; r < 16; ++r) { const float rl = Rl[crow(r, hi)]; o[0][r] *= rl; o[1][r] *= rl; }
        LDS_WAIT();
    }
}

__device__ __forceinline__ void sattn_phase(Frame& F, const Args& a, int layer, int kind_lo) {
    const bf16_t* H = (const bf16_t*)(F.ws + WS_H); const bf16_t* QB = (const bf16_t*)(F.ws + WS_QB); const bf16_t* KVB = (const bf16_t*)(F.ws + WS_KVB);
    bf16_t* MIX = (bf16_t*)(F.ws + WS_MIX); const float* lsec = (const float*)(F.ws + WS_LSEC);
    LAS unsigned char* scr = F.lds + F.wave * 16384;
    const int lane = F.lane, r32 = lane & 31, hi = lane >> 5;
    float lam, lam_init;
    { const float* lv = a.diff_lambda + layer * 128; float d1 = 0.f, d2 = 0.f;
      for (int i = 0; i < 32; ++i) { d1 += lv[i] * lv[32 + i]; d2 += lv[64 + i] * lv[96 + i]; }
      lam_init = 0.8f - 0.6f * expf(-0.3f * (float)layer); lam = expf(d1) - expf(d2) + lam_init; }
    constexpr int NRB = NTOK / 32;
    const int items = NRB * (4 + 6 + 6);
    for (int it = kind_lo * NRB + F.gw; it < items; it += F.NGW) {
        const int kind = it / NRB, rb = it - kind * NRB; const int m0 = rb * 32; const SeqInfo si = seqinfo(m0);
#if !OPT_ATTN
        if (kind < 4) {
            const int h = kind; f32x16 o0[2], o1[2]; float dummy;
            for (int c = 0; c < 2; ++c) {
                bf16x8 qf[2];
#pragma unroll
                for (int d0 = 0; d0 < 2; ++d0) qf[d0] = *(const bf16x8*)(H + (size_t)(m0 + r32) * HP + HC_AQ + h * 64 + c * 32 + 16 * d0 + 8 * hi);
                const RowSrc ks{H + (size_t)si.base * HP + HC_AK + h * 64 + c * 32, HP}, vs{H + (size_t)si.base * HP + HC_AV + h * 64, HP};
                sattn_core<2, 0, 0>(qf, ks, ks, vs, 0, si.len / 32, 0, 0.f, scr, lane, c == 0 ? o0 : o1, dummy);
            }
            const float* sg = a.diff_subln + layer * 64; const float g0 = sg[r32], g1 = sg[32 + r32];
#pragma unroll
            for (int r = 0; r < 16; ++r) { const float x0 = o0[0][r] - lam * o1[0][r], x1 = o0[1][r] - lam * o1[1][r]; float ss = x0 * x0 + x1 * x1;
                ss += shx<1>(ss); ss += shx<2>(ss); ss += shx<4>(ss); ss += shx<8>(ss); ss += shx<16>(ss);
                const float rs = (1.0f - lam_init) / sqrtf(ss * (1.0f / 64.0f) + RMS_EPS);
                bf16_t* op = MIX + (size_t)(m0 + crow(r, hi)) * DM + MIX_A + h * 64 + r32;
                op[0] = (bf16_t)f2bf(x0 * rs * g0); op[32] = (bf16_t)f2bf(x1 * rs * g1); }
        } else if (kind < 10) {
            const int h = kind - 4; f32x16 o[2]; float dummy; bf16x8 qf[6];
#pragma unroll
            for (int d0 = 0; d0 < 6; ++d0) qf[d0] = *(const bf16x8*)(QB + (size_t)(m0 + r32) * QBP + h * 96 + 16 * d0 + 8 * hi);
            const RowSrc k0{KVB + (size_t)si.base * KVP + h * 128, KVP}, k1{H + (size_t)si.base * HP + HC_KROPE, HP}, vs{KVB + (size_t)si.base * KVP + h * 128 + 64, KVP};
            sattn_core<4, 2, 0>(qf, k0, k1, vs, 0, si.len / 32, 0, 0.f, scr, lane, o, dummy);
#pragma unroll
            for (int r = 0; r < 16; ++r) { bf16_t* op = MIX + (size_t)(m0 + crow(r, hi)) * DM + MIX_B + h * 64 + r32; op[0] = (bf16_t)f2bf(o[0][r]); op[32] = (bf16_t)f2bf(o[1][r]); }
        } else
#endif
        {
            const int gj = kind - 10, g = gj >> 1, hh = gj;
            const int dil = (g == 0) ? 1 : (g == 1 ? 4 : 16); const int L = si.len / dil, bpr = L / 32;
            const int w = (m0 - si.base) / 32, rho = w / bpr, ib = w - rho * bpr, i0 = ib * 32;
            const size_t qrow = (size_t)si.base + (size_t)(i0 + r32) * dil + rho;
            bf16x8 qf[4];
#pragma unroll
            for (int d0 = 0; d0 < 4; ++d0) qf[d0] = *(const bf16x8*)(H + qrow * HP + HC_CQ + hh * 64 + 16 * d0 + 8 * hi);
            const int j = gj & 1; const float l0 = lsec[(0 * (size_t)NTOK + qrow) * 2 + j], l1 = lsec[(1 * (size_t)NTOK + qrow) * 2 + j], l2 = lsec[(2 * (size_t)NTOK + qrow) * 2 + j];
            const float lm = fmaxf(l0, fmaxf(l1, l2)); const float lref = lm + __log2f(fast_exp2(l0 - lm) + fast_exp2(l1 - lm) + fast_exp2(l2 - lm));
            const RowSrc ks{H + ((size_t)si.base + rho) * HP + HC_CK + hh * 64, (long)HP * dil}, vs{H + ((size_t)si.base + rho) * HP + HC_CV + hh * 64, (long)HP * dil};
            int kb_lo = ib - 2, kb_hi = ib + 3; if (kb_lo < 0) kb_lo = 0; if (kb_hi > bpr) kb_hi = bpr;
            f32x16 o[2]; float dummy;
            sattn_core<4, 0, 2>(qf, ks, ks, vs, kb_lo, kb_hi, i0, lref, scr, lane, o, dummy);
#pragma unroll
            for (int r = 0; r < 16; ++r) { const size_t orow = (size_t)si.base + (size_t)(i0 + crow(r, hi)) * dil + rho; bf16_t* op = MIX + orow * DM + MIX_C + hh * 64 + r32; op[0] = (bf16_t)f2bf(o[0][r]); op[32] = (bf16_t)f2bf(o[1][r]); }
        }
    }
}
__device__ __forceinline__ void cstat_phase(Frame& F) {
    const bf16_t* H = (const bf16_t*)(F.ws + WS_H); float* lsec = (float*)(F.ws + WS_LSEC);
    LAS unsigned char* scr = F.lds + F.wave * 16384;
    const int lane = F.lane, r32 = lane & 31, hi = lane >> 5;
    constexpr int NRB = NTOK / 32;
    for (int it = F.gw; it < NRB * 6; it += F.NGW) {
        const int gj = it / NRB, rb = it - gj * NRB, g = gj >> 1, j = gj & 1; const int m0 = rb * 32; const SeqInfo si = seqinfo(m0);
        const int dil = (g == 0) ? 1 : (g == 1 ? 4 : 16); const int L = si.len / dil, bpr = L / 32;
        const int w = (m0 - si.base) / 32, rho = w / bpr, ib = w - rho * bpr, i0 = ib * 32;
        const size_t qrow = (size_t)si.base + (size_t)(i0 + r32) * dil + rho;
        bf16x8 qf[4];
#pragma unroll
        for (int d0 = 0; d0 < 4; ++d0) qf[d0] = *(const bf16x8*)(H + qrow * HP + HC_CQ + gj * 64 + 16 * d0 + 8 * hi);
        const RowSrc ks{H + ((size_t)si.base + rho) * HP + HC_CK + gj * 64, (long)HP * dil};
        int kb_lo = ib - 2, kb_hi = ib + 3; if (kb_lo < 0) kb_lo = 0; if (kb_hi > bpr) kb_hi = bpr;
        float lse; sattn_core<4, 0, 1>(qf, ks, ks, ks, kb_lo, kb_hi, i0, 0.f, scr, lane, nullptr, lse);
        if (hi == 0) lsec[((size_t)g * NTOK + qrow) * 2 + j] = lse;
    }
}


namespace at {
typedef short s16x4 __attribute__((ext_vector_type(4)));
typedef short v4i16_t __attribute__((ext_vector_type(4)));
typedef LAS const unsigned char* lds_cptr;
constexpr int LDS_K = 0, KSLOT_MAX = 12288, LDS_V = 3 * KSLOT_MAX, VSLOT = 8192, LDS_WS = LDS_V + 3 * VSLOT, LDS_OST = LDS_WS + 8 * 256, LDS_TOTAL = LDS_OST + 8 * 8192;
static_assert(LDS_TOTAL <= RING_BYTES, "attention LDS");
constexpr float THR = 8.0f;
__device__ __forceinline__ void glds16(const void* g, unsigned lds_dst) {
    unsigned keep; asm volatile("s_mov_b32 %0, m0\n\ts_mov_b32 m0, %2\n\ts_nop 0\n\tglobal_load_lds_dwordx4 %1, off\n\ts_mov_b32 m0, %0" : "=&s"(keep) : "v"(g), "s"(lds_dst) : "memory"); }
__device__ __forceinline__ s16x4 vtr(lds_cptr p) { return __builtin_bit_cast(s16x4, __builtin_amdgcn_ds_read_tr16_b64_v4i16((LAS v4i16_t*)p)); }
__device__ __forceinline__ unsigned cvtpk(float lo, float hi) { typedef float f2 __attribute__((ext_vector_type(2))); typedef __bf16 b2 __attribute__((ext_vector_type(2))); f2 v = {lo, hi}; b2 b = __builtin_convertvector(v, b2); return __builtin_bit_cast(unsigned, b); }
#define AT_MX3(a, b, c) __builtin_fmaxf(__builtin_fmaxf((a), (b)), (c))
__device__ __forceinline__ float rowmax(const f32x16& p0, const f32x16& p1) {
    float a = AT_MX3(p0[0], p0[1], p1[0]), b = AT_MX3(p0[2], p0[3], p1[1]); a = AT_MX3(a, p1[2], p1[3]);
#pragma unroll
    for (int r = 4; r < 16; r += 4) { a = AT_MX3(a, p0[r], p0[r + 1]); b = AT_MX3(b, p0[r + 2], p0[r + 3]); a = AT_MX3(a, p1[r], p1[r + 1]); b = AT_MX3(b, p1[r + 2], p1[r + 3]); }
    float m = __builtin_fmaxf(a, b); auto rr = __builtin_amdgcn_permlane32_swap(__float_as_uint(m), __float_as_uint(m), false, false);
    return __builtin_fmaxf(__uint_as_float(rr[0]), __uint_as_float(rr[1])); }
#define AT_WAIT_BAR(N) asm volatile("s_waitcnt vmcnt(" #N ") lgkmcnt(0)\n\ts_barrier" ::: "memory")

struct Src { const bf16_t* p; long pitch; };
template <int NC, int NK0, int NK1>
__device__ __forceinline__ void stream(LAS unsigned char* lds, int tid, const bf16_t* qrow, Src k0, Src k1, Src vs, int NT, f32x16& o0, f32x16& o1, float& lsum) {
    asm volatile("" : "+v"(tid));
    constexpr int SLOTK = 2 * NC * 1024;
    const int lane = tid & 63, r32 = lane & 31, hi = lane >> 5; const int wid = __builtin_amdgcn_readfirstlane(tid >> 6);
    const unsigned lds0 = (unsigned)(uintptr_t)lds;
    LAS float* wsf = (LAS float*)(lds + LDS_WS) + wid * 64;
    constexpr int P0 = NK0 * 16;
    const bool hasA = (NK0 == 8) || (wid < 4), hasB = (NK1 > 0) && (wid < 4);
    const int pA = (NK0 == 8) ? wid : (wid & 3);
    const int rowA = (NK0 == 8) ? pA * 8 + (lane >> 3) : pA * 16 + (lane >> 2);
    const int chA = (NK0 == 8) ? ((lane & 7) ^ ((4 * pA + (lane >> 4)) & 7)) : ((lane & 3) ^ ((lane >> 4) & 3));
    const bf16_t* ksA = k0.p + (long)rowA * k0.pitch + chA * 8;
    const int rowB = (wid & 3) * 16 + (lane >> 2), chB = (lane & 3) ^ ((lane >> 4) & 3);
    const bf16_t* ksB = (NK1 > 0) ? k1.p + (long)rowB * k1.pitch + chB * 8 : k0.p;
    const bf16_t* vsp = vs.p + (long)(16 * (wid & 3) + (lane >> 2)) * vs.pitch + (wid >> 2) * 32 + (lane & 3) * 8;
    const unsigned kdA = lds0 + LDS_K + pA * 1024, kdB = lds0 + LDS_K + (NK0 + (wid & 3)) * 1024, vd = lds0 + LDS_V + wid * 1024;
    const long ktA = 64 * k0.pitch, ktB = 64 * k1.pitch, vt = 64 * vs.pitch;
    const int nd = (hasA ? 1 : 0) + (hasB ? 1 : 0) + 1;
#define AT_DMA_K(t, slot) do { if (hasA) glds16(ksA + (long)(t) * ktA, (unsigned)__builtin_amdgcn_readfirstlane(kdA + (slot) * SLOTK)); if (hasB) glds16(ksB + (long)(t) * ktB, (unsigned)__builtin_amdgcn_readfirstlane(kdB + (slot) * SLOTK)); } while (0)
#define AT_DMA_V(t, slot) glds16(vsp + (long)(t) * vt, (unsigned)__builtin_amdgcn_readfirstlane(vd + (slot) * VSLOT))
    lds_cptr kb[NC];
#pragma unroll
    for (int d0 = 0; d0 < NC; ++d0) { const int c = 2 * d0 + hi;
        if (2 * d0 < NK0) kb[d0] = (lds_cptr)lds + LDS_K + r32 * P0 + ((NK0 == 8) ? (c ^ ((r32 >> 1) & 7)) : (c ^ ((r32 >> 2) & 3))) * 16;
        else kb[d0] = (lds_cptr)lds + LDS_K + NK0 * 1024 + r32 * 64 + ((c - NK0) ^ ((r32 >> 2) & 3)) * 16; }
    const lds_cptr vp0 = (lds_cptr)lds + LDS_V + ((lane >> 4) & 1) * 32 + (lane & 3) * 8 + (4 * hi + ((lane & 15) >> 2)) * 64;
    AT_DMA_K(0, 0); AT_DMA_V(0, 0); if (NT > 1) AT_DMA_K(1, 1);
    bf16x8 qr[NC];
#pragma unroll
    for (int d0 = 0; d0 < NC; ++d0) qr[d0] = *(const bf16x8*)(qrow + 16 * d0 + 8 * hi);
    float mhat = 0.f, l = 0.f; f32x16 oa = {}, ob = {}, negm = {}, S0, S1; u32x4 pw0, pw1, pw2, pw3;
    asm volatile("" : "+v"(negm));
    AT_WAIT_BAR(0);
    __builtin_amdgcn_s_waitcnt(0);
#pragma unroll
    for (int d0 = 0; d0 < NC; ++d0) asm volatile("" : "+v"(qr[d0]));
    constexpr bool QLDS = (NC > 2);
    const lds_cptr qb = (lds_cptr)lds + LDS_OST + wid * 8192 + lane * 16;
    if (QLDS) {
#pragma unroll
        for (int d0 = 0; d0 < NC; ++d0) *(LAS bf16x8*)(lds + LDS_OST + wid * 8192 + lane * 16 + d0 * 1024) = qr[d0];
        LDS_WAIT();
    }
    int kc = 0, kn1 = 1, kn2 = 2, vpv = 2, vcu = 0, vnx = 1;
    bf16x8 kf[2 * NC], vf[8];
#define AT_SB() __builtin_amdgcn_sched_barrier(0)
#define AT_KRD(so_, d0) do { kf[2 * (d0)] = *(const LAS bf16x8*)(kb[d0] + (so_)); kf[2 * (d0) + 1] = *(const LAS bf16x8*)(kb[d0] + (so_) + 32 * ((2 * (d0) < NK0) ? P0 : 64)); if (QLDS) qr[d0] = *(const LAS bf16x8*)(qb + (d0) * 1024); } while (0)
#define AT_KHEAD(slot) do { const int kp_ = (slot) * SLOTK; AT_KRD(kp_, 0); } while (0)
#define AT_VF(i) ({ const s16x4 lo_ = vtr(vp_ + (((i) >> 2) * 4096 + ((i) & 3) * 1024)), hi_ = vtr(vp_ + (((i) >> 2) * 4096 + ((i) & 3) * 1024 + 512)); (bf16x8){lo_[0], lo_[1], lo_[2], lo_[3], hi_[0], hi_[1], hi_[2], hi_[3]}; })
#define AT_VHEAD(slot) do { const lds_cptr vp_ = vp0 + (slot) * VSLOT; vf[0] = AT_VF(0); vf[4] = AT_VF(4); } while (0)
#define AT_QKM(slot) do { const int kp_ = (slot) * SLOTK; \
        _Pragma("unroll") for (int d0 = 0; d0 < NC; ++d0) { if (d0 + 1 < NC) AT_KRD(kp_, d0 + 1); \
            if (d0 == 0) { S0 = MFMA32(kf[0], qr[0], negm); S1 = MFMA32(kf[1], qr[0], negm); } else { S0 = MFMA32(kf[2 * d0], qr[d0], S0); S1 = MFMA32(kf[2 * d0 + 1], qr[d0], S1); } AT_SB(); } } while (0)
#define AT_PVM(slot) do { const lds_cptr vp_ = vp0 + (slot) * VSLOT; \
        vf[1] = AT_VF(1); vf[5] = AT_VF(5); oa = MFMA32(__builtin_bit_cast(bf16x8, pw0), vf[0], oa); ob = MFMA32(__builtin_bit_cast(bf16x8, pw0), vf[4], ob); AT_SB(); \
        vf[2] = AT_VF(2); vf[6] = AT_VF(6); oa = MFMA32(__builtin_bit_cast(bf16x8, pw1), vf[1], oa); ob = MFMA32(__builtin_bit_cast(bf16x8, pw1), vf[5], ob); AT_SB(); \
        vf[3] = AT_VF(3); vf[7] = AT_VF(7); oa = MFMA32(__builtin_bit_cast(bf16x8, pw2), vf[2], oa); ob = MFMA32(__builtin_bit_cast(bf16x8, pw2), vf[6], ob); AT_SB(); \
        oa = MFMA32(__builtin_bit_cast(bf16x8, pw3), vf[3], oa); ob = MFMA32(__builtin_bit_cast(bf16x8, pw3), vf[7], ob); AT_SB(); } while (0)
    bool resc = false; u32x4 qw0, qw1, qw2, qw3; float sacc = 0.f;
#define AT_PIN(x) asm volatile("" : "+v"(x))
#define AT_DECIDE(first) do { const float rm_ = rowmax(S0, S1); resc = false; \
        if ((first) || __any(rm_ > THR)) { const float dl_ = (first) ? rm_ : __builtin_fmaxf(rm_, 0.f); mhat += dl_; \
            _Pragma("unroll") for (int r = 0; r < 16; ++r) { S0[r] -= dl_; S1[r] -= dl_; negm[r] = -mhat; } asm volatile("" : "+v"(negm)); \
            if (!(first)) { const float f_ = fast_exp2(-dl_); l *= f_; if (hi == 0) wsf[r32] = f_; resc = true; } } } while (0)
#define AT_RESC() do { if (resc) { LDS_WAIT(); \
        _Pragma("unroll") for (int r = 0; r < 16; ++r) { const float g_ = wsf[crow(r, hi)]; oa[r] *= g_; ob[r] *= g_; } LDS_WAIT(); } } while (0)
#define AT_EXP8(S, b, Q) do { \
        _Pragma("unroll") for (int r = 0; r < 8; ++r) S[(b) + r] = fast_exp2(S[(b) + r]); \
        sacc += (S[(b)] + S[(b) + 1]) + (S[(b) + 2] + S[(b) + 3]); sacc += (S[(b) + 4] + S[(b) + 5]) + (S[(b) + 6] + S[(b) + 7]); \
        Q = (u32x4){cvtpk(S[(b)], S[(b) + 1]), cvtpk(S[(b) + 2], S[(b) + 3]), cvtpk(S[(b) + 4], S[(b) + 5]), cvtpk(S[(b) + 6], S[(b) + 7])}; AT_PIN(Q); AT_PIN(sacc); } while (0)
#define AT_EXPALL() do { sacc = 0.f; AT_EXP8(S0, 0, qw0); AT_EXP8(S0, 8, qw1); AT_EXP8(S1, 0, qw2); AT_EXP8(S1, 8, qw3); l += sacc; pw0 = qw0; pw1 = qw1; pw2 = qw2; pw3 = qw3; } while (0)
#define AT_PV_EXP(slot, C0, C1, C2, C3, N0, N1, N2, N3) do { const lds_cptr vp_ = vp0 + (slot) * VSLOT; sacc = 0.f; \
        vf[1] = AT_VF(1); vf[5] = AT_VF(5); oa = MFMA32(__builtin_bit_cast(bf16x8, C0), vf[0], oa); ob = MFMA32(__builtin_bit_cast(bf16x8, C0), vf[4], ob); AT_EXP8(S0, 0, N0); AT_SB(); \
        vf[2] = AT_VF(2); vf[6] = AT_VF(6); oa = MFMA32(__builtin_bit_cast(bf16x8, C1), vf[1], oa); ob = MFMA32(__builtin_bit_cast(bf16x8, C1), vf[5], ob); AT_EXP8(S0, 8, N1); AT_SB(); \
        vf[3] = AT_VF(3); vf[7] = AT_VF(7); oa = MFMA32(__builtin_bit_cast(bf16x8, C2), vf[2], oa); ob = MFMA32(__builtin_bit_cast(bf16x8, C2), vf[6], ob); AT_EXP8(S1, 0, N2); AT_SB(); \
        oa = MFMA32(__builtin_bit_cast(bf16x8, C3), vf[3], oa); ob = MFMA32(__builtin_bit_cast(bf16x8, C3), vf[7], ob); AT_EXP8(S1, 8, N3); AT_SB(); \
        l += sacc; } while (0)
#define AT_STEP_WAIT(t) do { if ((t) + 2 < NT) { if (nd == 3) AT_WAIT_BAR(3); else if (nd == 2) AT_WAIT_BAR(2); else AT_WAIT_BAR(1); } else AT_WAIT_BAR(0); } while (0)
#define AT_ROT() do { const int a_ = kc; kc = kn1; kn1 = kn2; kn2 = a_; const int b_ = vpv; vpv = vcu; vcu = vnx; vnx = b_; } while (0)
    AT_DMA_K(2, kn2); AT_DMA_V(1, vnx);
    AT_KHEAD(kc); AT_SB();
    AT_QKM(kc); AT_DECIDE(true); AT_EXPALL();
    AT_STEP_WAIT(0); AT_ROT();
#define AT_STEP(t, C0, C1, C2, C3, N0, N1, N2, N3) do { \
        if ((t) + 2 < NT) AT_DMA_K((t) + 2, kn2); \
        if ((t) + 1 < NT) AT_DMA_V((t) + 1, vnx); \
        AT_KHEAD(kc); AT_VHEAD(vpv); AT_SB(); \
        AT_QKM(kc); \
        AT_DECIDE(false); AT_SB(); \
        AT_PV_EXP(vpv, C0, C1, C2, C3, N0, N1, N2, N3); \
        AT_RESC(); \
        AT_STEP_WAIT(t); AT_ROT(); } while (0)
    int t = 1;
    for (; t + 1 < NT; t += 2) { AT_STEP(t, pw0, pw1, pw2, pw3, qw0, qw1, qw2, qw3); AT_STEP(t + 1, qw0, qw1, qw2, qw3, pw0, pw1, pw2, pw3); }
    if (t < NT) { AT_STEP(t, pw0, pw1, pw2, pw3, qw0, qw1, qw2, qw3); pw0 = qw0; pw1 = qw1; pw2 = qw2; pw3 = qw3; }
#undef AT_STEP
    AT_VHEAD(vpv); AT_SB(); AT_PVM(vpv);
    { auto rr = __builtin_amdgcn_permlane32_swap(__float_as_uint(l), __float_as_uint(l), false, false); l = __uint_as_float(rr[0]) + __uint_as_float(rr[1]); }
    o0 = oa; o1 = ob; lsum = l;
#undef AT_DMA_K
#undef AT_DMA_V
#undef AT_SB
#undef AT_KRD
#undef AT_KHEAD
#undef AT_VF
#undef AT_VHEAD
#undef AT_QKM
#undef AT_PVM
#undef AT_PIN
#undef AT_DECIDE
#undef AT_RESC
#undef AT_EXP8
#undef AT_EXPALL
#undef AT_PV_EXP
#undef AT_STEP_WAIT
#undef AT_ROT
}
__device__ __forceinline__ void normalise(LAS unsigned char* lds, int tid, f32x16& o0, f32x16& o1, float lsum) {
    const int lane = tid & 63, r32 = lane & 31, hi = lane >> 5; const int wid = __builtin_amdgcn_readfirstlane(tid >> 6);
    LAS float* wsf = (LAS float*)(lds + LDS_WS) + wid * 64;
    if (hi == 0) wsf[32 + r32] = 1.0f / lsum; LDS_WAIT();
#pragma unroll
    for (int r = 0; r < 16; ++r) { const float g = wsf[32 + crow(r, hi)]; o0[r] *= g; o1[r] *= g; }
    LDS_WAIT();
}
}

struct AttnUnitId { int kind, seq, head, qb; };
__device__ __forceinline__ bool attn_unit_at(int i, int G, int bid, AttnUnitId& u) {
    const long L = (long)i * G + bid; if (L >= 2560) return false; int o = (int)L;
    int kind, longs, nh;
    if (o < 512) { kind = 0; longs = 1; nh = 4; } else if (o < 1024) { kind = 0; longs = 0; nh = 4; o -= 512; } else if (o < 1792) { kind = 1; longs = 1; nh = 6; o -= 1024; } else { kind = 1; longs = 0; nh = 6; o -= 1792; }
    const int nqb = longs ? 16 : 8;
    int pair, qb;
    if (G == 256) { const int rnd = o >> 8, b = o & 255, x = b & 7, c = b >> 3;
        const int ppr = 32 / nqb; pair = x + 8 * (rnd * ppr + c / nqb); qb = c % nqb; }
    else { pair = o / nqb; qb = o % nqb; }
    u.kind = kind; u.head = pair % nh; const int sq = pair / nh; u.seq = longs ? 16 + sq : sq; u.qb = qb; return true;
}
__device__ __forceinline__ void attn_ab_phase(Frame& F, const Args& a, int layer, int kmask = 3) {
    const bf16_t* H = (const bf16_t*)(F.ws + WS_H); const bf16_t* QB = (const bf16_t*)(F.ws + WS_QB); const bf16_t* KVB = (const bf16_t*)(F.ws + WS_KVB);
    bf16_t* MIX = (bf16_t*)(F.ws + WS_MIX);
    const int wid = F.wave;
    float lam, lam_init;
    { const float* lv = a.diff_lambda + layer * 128; float d1 = 0.f, d2 = 0.f;
      for (int i = 0; i < 32; ++i) { d1 += lv[i] * lv[32 + i]; d2 += lv[64 + i] * lv[96 + i]; }
      lam_init = 0.8f - 0.6f * expf(-0.3f * (float)layer); lam = expf(d1) - expf(d2) + lam_init;
      lam = __uint_as_float(__builtin_amdgcn_readfirstlane(__float_as_uint(lam))); lam_init = __uint_as_float(__builtin_amdgcn_readfirstlane(__float_as_uint(lam_init))); }
    AttnUnitId u;
    for (int i = 0; attn_unit_at(i, F.G, F.bid, u); ++i) {
        if (!((kmask >> u.kind) & 1)) continue;
        int tid = F.tid; asm volatile("" : "+v"(tid)); const int lane = tid & 63, r32 = lane & 31, hi = lane >> 5;
        const int len = (u.seq < 16) ? 2048 : 4096, base = (u.seq < 16) ? u.seq * 2048 : NTOK_P + (u.seq - 16) * 4096, NT = len / 64;
        const int m0 = base + u.qb * 256 + wid * 32;
        LAS bf16_t* sb = (LAS bf16_t*)(F.lds + at::LDS_OST + wid * 8192);
        LAS float* sf = (LAS float*)sb;
        if (u.kind == 0) {
            f32x16 q0, q1; float ls;
            { f32x16 p0, p1; const at::Src ks{H + (size_t)base * HP + HC_AK + u.head * 64, HP}, vs{H + (size_t)base * HP + HC_AV + u.head * 64, HP};
              at::stream<2, 4, 0>(F.lds, tid, H + (size_t)(m0 + r32) * HP + HC_AQ + u.head * 64, ks, ks, vs, NT, p0, p1, ls); at::normalise(F.lds, tid, p0, p1, ls);
#pragma unroll
              for (int r = 0; r < 16; ++r) { const int row = crow(r, hi); sf[row * 64 + r32] = p0[r]; sf[row * 64 + 32 + r32] = p1[r]; }
              AT_WAIT_BAR(0); }
            { const at::Src ks{H + (size_t)base * HP + HC_AK + u.head * 64 + 32, HP}, vs{H + (size_t)base * HP + HC_AV + u.head * 64, HP};
              at::stream<2, 4, 0>(F.lds, tid, H + (size_t)(m0 + r32) * HP + HC_AQ + u.head * 64 + 32, ks, ks, vs, NT, q0, q1, ls); at::normalise(F.lds, tid, q0, q1, ls); }
            float xa[16], xb[16];
#pragma unroll
            for (int r = 0; r < 16; ++r) { const int row = crow(r, hi); xa[r] = sf[row * 64 + r32] - lam * q0[r]; xb[r] = sf[row * 64 + 32 + r32] - lam * q1[r]; }
            LDS_WAIT();
            const float* sg = a.diff_subln + layer * 64; const float g0 = sg[r32] * (1.0f - lam_init), g1 = sg[32 + r32] * (1.0f - lam_init);
#pragma unroll
            for (int r = 0; r < 16; ++r) { const float x0 = xa[r], x1 = xb[r]; float ss = x0 * x0 + x1 * x1;
                ss += shx<1>(ss); ss += shx<2>(ss); ss += shx<4>(ss); ss += shx<8>(ss); ss += shx<16>(ss);
                const float rs = 1.0f / sqrtf(ss * (1.0f / 64.0f) + RMS_EPS); const int row = crow(r, hi);
                sb[row * 64 + r32] = (bf16_t)f2bf(x0 * rs * g0); sb[row * 64 + 32 + r32] = (bf16_t)f2bf(x1 * rs * g1); }
            LDS_WAIT();
#pragma unroll
            for (int it = 0; it < 4; ++it) { const int row = it * 8 + (lane >> 3), ch = lane & 7; *(u32x4*)(MIX + (size_t)(m0 + row) * DM + MIX_A + u.head * 64 + ch * 8) = *(const LAS u32x4*)(sb + row * 64 + ch * 8); }
        } else {
            f32x16 p0, p1; float ls;
            const at::Src k0{KVB + (size_t)base * KVP + u.head * 128, KVP}, k1{H + (size_t)base * HP + HC_KROPE, HP}, vs{KVB + (size_t)base * KVP + u.head * 128 + 64, KVP};
            at::stream<6, 8, 4>(F.lds, tid, QB + (size_t)(m0 + r32) * QBP + u.head * 96, k0, k1, vs, NT, p0, p1, ls); at::normalise(F.lds, tid, p0, p1, ls);
#pragma unroll
            for (int r = 0; r < 16; ++r) { const int row = crow(r, hi); sb[row * 64 + r32] = (bf16_t)f2bf(p0[r]); sb[row * 64 + 32 + r32] = (bf16_t)f2bf(p1[r]); }
            LDS_WAIT();
#pragma unroll
            for (int it = 0; it < 4; ++it) { const int row = it * 8 + (lane >> 3), ch = lane & 7; *(u32x4*)(MIX + (size_t)(m0 + row) * DM + MIX_B + u.head * 64 + ch * 8) = *(const LAS u32x4*)(sb + row * 64 + ch * 8); }
        }
        AT_WAIT_BAR(0);
    }
}

struct ListRows { const int* list; int seg0, cnt; __device__ __forceinline__ int src(int m) const { const int r = m - seg0; return (r < cnt) ? (list[r] >> 1) : 0; } };
__device__ __forceinline__ void moe_segments(Frame& F, int layer, LAS int* seg) {
    if (F.tid == 0) { int acc = 0; for (int e = 0; e < NEXP; ++e) { const int c = (int)__hip_atomic_load(F.ctl + CW_CNT + layer * 64 + e, RLX_AGENT); seg[e] = acc; seg[33 + e] = c; acc += (c + 255) & ~255; } seg[32] = acc; }
    __syncthreads();
}
__device__ __forceinline__ int seg_find(const LAS int* seg, int row) { int e = 0;
#pragma unroll
    for (int s = 16; s > 0; s >>= 1) if (seg[e + s] <= row) e += s;
    return e; }
__device__ __forceinline__ void moe_up_simple(Frame& F, int layer) {
    LAS int* seg = (LAS int*)(F.lds + RING_BYTES); moe_segments(F, layer, seg);
    const bf16_t* XB = (const bf16_t*)(F.ws + WS_XB); const bf16_t* W13 = (const bf16_t*)(F.ws + WS_W13); const int* list = (const int*)(F.ws + WS_LIST);
    const EpiHid E{(bf16_t*)(F.ws + WS_HID)};
    const int items = (seg[32] / 32) * 16;
    for (int it = F.gw; it < items; it += F.NGW) { const int mt = it >> 4, ct = it & 15, m0 = mt * 32, e = seg_find(seg, m0), c0 = ct * 32;
        const ListRows RM{list + (size_t)e * LIST_CAP, seg[e], seg[33 + e]};
        const bf16_t* Bg = W13 + (size_t)e * 1024 * 1024 + (size_t)((c0 >> 7) * 256 + (c0 & 127)) * 1024;
        sg_tile(XB, DM, Bg, Bg + (size_t)128 * 1024, 1024, 1024, m0, c0, E, RM, F.lane); }
    __syncthreads();
}
__device__ __forceinline__ void moe_down_simple(Frame& F, int layer) {
    LAS int* seg = (LAS int*)(F.lds + RING_BYTES); moe_segments(F, layer, seg);
    const bf16_t* HID = (const bf16_t*)(F.ws + WS_HID); const bf16_t* W2 = (const bf16_t*)(F.ws + WS_W2); const int* list = (const int*)(F.ws + WS_LIST);
    const int items = (seg[32] / 32) * 16;
    for (int it = F.gw; it < items; it += F.NGW) { const int mt = it >> 4, ct = it & 15, m0 = mt * 32, e = seg_find(seg, m0), c0 = ct * 64;
        const EpiY E{(bf16_t*)(F.ws + WS_YB), (const float*)(F.ws + WS_TW), list + (size_t)e * LIST_CAP, seg[e], seg[33 + e]};
        const bf16_t* B0 = W2 + (size_t)e * 1024 * 512 + (size_t)c0 * 512;
        sg_tile(HID, DEXP, B0, B0 + (size_t)32 * 512, 512, 512, m0, c0, E, IdRows(), F.lane); }
    __syncthreads();
}


struct MoeUpSched {
    const char* XB; const char* W13; const LAS int* seg; const int* list; int nM, G, c;
    __device__ __forceinline__ bool next(int i, pg8::Unit& u) const { if (!pg8::order_next(i, G, c, nM, 4, u.pm, u.pn)) return false; u.e = __builtin_amdgcn_readfirstlane(seg_find(seg, u.pm * 256)); u.a = XB; u.b = W13 + ((size_t)u.e * 1024 + (size_t)u.pn * 256) * 2048; return true; }
    __device__ __forceinline__ unsigned arow(const pg8::Unit& u, int r) const { const int rr = u.pm * 256 + r - __builtin_amdgcn_readfirstlane(seg[u.e]); return (rr < __builtin_amdgcn_readfirstlane(seg[33 + u.e])) ? (unsigned)(list[(size_t)u.e * LIST_CAP + rr] >> 1) : 0u; }
};
struct MoeDownSched {
    const char* HID; const char* W2; const LAS int* seg; int nM, G, c;
    __device__ __forceinline__ bool next(int i, pg8::Unit& u) const { if (!pg8::order_next(i, G, c, nM, 4, u.pm, u.pn)) return false; u.e = __builtin_amdgcn_readfirstlane(seg_find(seg, u.pm * 256)); u.a = HID + (size_t)u.pm * 256 * DEXP * 2; u.b = W2 + ((size_t)u.e * 1024 + (size_t)u.pn * 256) * 1024; return true; }
    __device__ __forceinline__ unsigned arow(const pg8::Unit&, int) const { return 0u; }
};
__device__ __forceinline__ void moe_up_opt(Frame& F, int layer) {
    LAS int* seg = (LAS int*)(F.lds + RING_BYTES); moe_segments(F, layer, seg);
    const MoeUpSched S{(const char*)(F.ws + WS_XB), (const char*)(F.ws + WS_W13), seg, (const int*)(F.ws + WS_LIST), __builtin_amdgcn_readfirstlane(seg[32]) / 256, F.G, F.bid};
    const EpiHid E{(bf16_t*)(F.ws + WS_HID)};
    pg8::gemm_phase<EpiHid, MoeUpSched, true, true>(F.lds, F.tid, 1024, DM, S, E);
    __syncthreads();
}
__device__ __forceinline__ void moe_down_opt(Frame& F, int layer) {
    LAS int* seg = (LAS int*)(F.lds + RING_BYTES); moe_segments(F, layer, seg);
    const MoeDownSched S{(const char*)(F.ws + WS_HID), (const char*)(F.ws + WS_W2), seg, __builtin_amdgcn_readfirstlane(seg[32]) / 256, F.G, F.bid};
    const EpiYO E{(bf16_t*)(F.ws + WS_YB), (const float*)(F.ws + WS_TW), (const int*)(F.ws + WS_LIST), seg};
    pg8::gemm_phase<EpiYO, MoeDownSched, false, false>(F.lds, F.tid, DEXP, DEXP, S, E);
    __syncthreads();
}
template <class Epi>
__device__ __forceinline__ void pg_phase(Frame& F, const bf16_t* A, int lda, const bf16_t* Bt, int panel, int N, int K, const Epi& E) {
    pg8::PanelSched S; S.init(A, lda, Bt, panel, N, K);
    pg8::gemm_phase<Epi, pg8::PanelSched, false, false>(F.lds, F.tid, K, lda, S, E);
}
__device__ __forceinline__ void local_sync(Frame& F) {
    asm volatile("s_waitcnt vmcnt(0) lgkmcnt(0)" ::: "memory");
    __syncthreads();
    if (F.tid == 0) { __builtin_amdgcn_fence(__ATOMIC_ACQUIRE, "agent"); asm volatile("s_waitcnt vmcnt(0)" ::: "memory"); }
    __syncthreads();
}
template <class Epi>
__device__ __forceinline__ void og_phase(Frame& F, const bf16_t* A, int lda, const bf16_t* Bt, int M, int N, int K, const Epi& E) {
    pg8::DenseSched S; S.init(A, lda, Bt, M, N, K, F.G, F.bid);
    pg8::gemm_phase<Epi, pg8::DenseSched, false, false>(F.lds, F.tid, K, lda, S, E);
}

#ifndef PANEL_PROG
#define PANEL_PROG 1
#endif
#if PANEL_PROG
constexpr int PH_PER_LAYER = 6, N_PHASES = 2 + DEPTH * PH_PER_LAYER;
#else
constexpr int PH_PER_LAYER = 9, N_PHASES = 1 + DEPTH * PH_PER_LAYER;
#endif
__global__ void __launch_bounds__(NTHREADS, 2) fwd(Args args) {
    extern __shared__ __attribute__((aligned(16))) unsigned char lds[];
    Frame F;
    F.lds = (LAS unsigned char*)lds; F.ldsg = lds;
    F.tid = threadIdx.x; F.lane = F.tid & 63; F.wave = __builtin_amdgcn_readfirstlane(F.tid >> 6);
    F.G = gridDim.x; F.bid = blockIdx.x; F.gw = blockIdx.x * NWAVES + F.wave; F.NGW = F.G * NWAVES;
    F.ws = args.ws; F.ctl = (gu32*)(args.ws + WS_CTL);
    volatile LAS unsigned* MISC = (volatile LAS unsigned*)(F.lds + MISC_OFF);
    for (int u = F.tid; u < (LDS_BYTES - RING_BYTES) / 4; u += NTHREADS) ((LAS unsigned*)(F.lds + RING_BYTES))[u] = 0u;
    __syncthreads();
    XcdBarrier bar; bar.bar = (unsigned*)(F.ctl + CW_BAR); bar.x = 0; bar.st = nullptr;
    if (args.use_bar) bar = xcd_barrier_post((unsigned*)(F.ctl + CW_BAR), MISC + 8);
    const int lo = args.ph_lo, hi = args.ph_hi;
#ifndef PH_MASK
#define PH_MASK 0x3ff
#endif
#define IN(k) (lo <= (k) && (k) < hi && (launder(F), true))
#define SEAM(k) do { if (lo <= (k) && (k) + 1 < hi) xcd_barrier(bar); } while (0)
    if ((PH_MASK & 1) && IN(0)) { p0_prologue(F, args);
#ifdef PROBE_DUP_P0
        launder(F); p0_prologue(F, args);
#endif
    }
    SEAM(0);
#if PANEL_PROG
    for (int layer = 0; layer < DEPTH; ++layer) {
        const int pb = 1 + layer * PH_PER_LAYER;
        if (IN(pb + 0)) {
            for (int panel = F.bid; panel < NTOK / 256; panel += F.G) {
                const int r0 = panel * 256;
                if (layer > 0) { ln2_pass(F, args, layer - 1, r0 + F.wave, NWAVES, r0 + 256); local_sync(F); launder(F); }
                { bf16_t* H = (bf16_t*)(F.ws + WS_H); const EpiH E{H, (const float2*)(F.ws + WS_ROPE32), (const float2*)(F.ws + WS_ROPE64)};
                  pg_phase(F, (const bf16_t*)(F.ws + WS_XB), DM, (const bf16_t*)(F.ws + WS_WIN) + (size_t)layer * 2560 * 1024, panel, 2560, 1024, E); }
                local_sync(F); launder(F);
                rowstat_pass(F, r0 + F.wave, NWAVES, r0 + 256);
                local_sync(F); launder(F);
                { bf16_t* H = (bf16_t*)(F.ws + WS_H); const EpiUQ Eq{(bf16_t*)(F.ws + WS_QB), (const float*)(F.ws + WS_RSTD), (const float2*)(F.ws + WS_ROPE32)};
                  pg_phase(F, H + HC_CQ_LAT, HP, (const bf16_t*)(F.ws + WS_WUQ) + (size_t)layer * 768 * 256, panel, 768, 256, Eq); }
                launder(F);
                { bf16_t* H = (bf16_t*)(F.ws + WS_H); const EpiUKV Ek{(bf16_t*)(F.ws + WS_KVB), (const float*)(F.ws + WS_RSTD)};
                  pg_phase(F, H + HC_CKV, HP, (const bf16_t*)(F.ws + WS_WUKV) + (size_t)layer * 768 * 256, panel, 768, 256, Ek); }
                launder(F);
            }
        }
        SEAM(pb + 0);
        if (IN(pb + 1)) { cstat_phase(F); }
        SEAM(pb + 1);
        if (IN(pb + 2)) { attn_ab_phase(F, args, layer); launder(F); sattn_phase(F, args, layer, 10); }
        SEAM(pb + 2);
        if (IN(pb + 3)) {
            for (int panel = F.bid; panel < NTOK / 256; panel += F.G) {
                const int r0 = panel * 256;
                { const EpiRes E{args.out, layer == 0 ? args.x_prompt : nullptr, args.x_sample, args.out};
                  pg_phase(F, (const bf16_t*)(F.ws + WS_MIX), DM, (const bf16_t*)(F.ws + WS_WOUT) + (size_t)layer * 1024 * 1024, panel, 1024, 1024, E); }
                local_sync(F); launder(F);
                ln1_route_pass(F, args, layer, r0 + F.wave, NWAVES, r0 + 256);
                launder(F);
            }
            moe_convert(F, args, layer);
        }
        SEAM(pb + 3);
        if (IN(pb + 4)) { moe_up_opt(F, layer);
#ifdef PROBE_DUP_MOE
            launder(F); moe_up_opt(F, layer);
#endif
        }
        SEAM(pb + 4);
        if (IN(pb + 5)) { moe_down_opt(F, layer);
#ifdef PROBE_DUP_MOE
            launder(F); moe_down_opt(F, layer);
#endif
        }
        SEAM(pb + 5);
    }
    if (IN(1 + DEPTH * PH_PER_LAYER)) { ln2_pass(F, args, DEPTH - 1, F.gw, F.NGW, NTOK); }
#else
    for (int layer = 0; layer < DEPTH; ++layer) {
        const int pb = 1 + layer * PH_PER_LAYER;
        if ((PH_MASK & (2 << 0)) && IN(pb + 0)) {   bf16_t* H = (bf16_t*)(F.ws + WS_H);
            const EpiH E{H, (const float2*)(F.ws + WS_ROPE32), (const float2*)(F.ws + WS_ROPE64)};
#if OPT_GEMM
            og_phase(F, (const bf16_t*)(F.ws + WS_XB), DM, (const bf16_t*)(F.ws + WS_WIN) + (size_t)layer * 2560 * 1024, NTOK, 2560, 1024, E);
#ifdef PROBE_DUP_GEMM
            launder(F); og_phase(F, (const bf16_t*)(F.ws + WS_XB), DM, (const bf16_t*)(F.ws + WS_WIN) + (size_t)layer * 2560 * 1024, NTOK, 2560, 1024, E);
#endif
#else
            sg_phase(F, (const bf16_t*)(F.ws + WS_XB), DM, (const bf16_t*)(F.ws + WS_WIN) + (size_t)layer * 2560 * 1024, 1024, NTOK, 2560, 1024, E);
#endif
        }
        SEAM(pb + 0);
        if ((PH_MASK & (2 << 1)) && IN(pb + 1)) { rowstat_pass(F, F.gw, F.NGW, NTOK); cstat_phase(F);
#ifdef PROBE_DUP_CSTAT
            launder(F); rowstat_pass(F, F.gw, F.NGW, NTOK); cstat_phase(F);
#endif
        }
        SEAM(pb + 1);
        if ((PH_MASK & (2 << 2)) && IN(pb + 2)) {
            bf16_t* H = (bf16_t*)(F.ws + WS_H);
            const EpiUQ Eq{(bf16_t*)(F.ws + WS_QB), (const float*)(F.ws + WS_RSTD), (const float2*)(F.ws + WS_ROPE32)};
#if OPT_GEMM
            og_phase(F, H + HC_CQ_LAT, HP, (const bf16_t*)(F.ws + WS_WUQ) + (size_t)layer * 768 * 256, NTOK, 768, 256, Eq);
            launder(F);
#else
            sg_phase(F, H + HC_CQ_LAT, HP, (const bf16_t*)(F.ws + WS_WUQ) + (size_t)layer * 768 * 256, 256, NTOK, 768, 256, Eq);
#endif
            const EpiUKV Ek{(bf16_t*)(F.ws + WS_KVB), (const float*)(F.ws + WS_RSTD)};
#if OPT_GEMM
            og_phase(F, H + HC_CKV, HP, (const bf16_t*)(F.ws + WS_WUKV) + (size_t)layer * 768 * 256, NTOK, 768, 256, Ek);
#ifdef PROBE_DUP_UP
            launder(F); og_phase(F, H + HC_CQ_LAT, HP, (const bf16_t*)(F.ws + WS_WUQ) + (size_t)layer * 768 * 256, NTOK, 768, 256, Eq);
            launder(F); og_phase(F, H + HC_CKV, HP, (const bf16_t*)(F.ws + WS_WUKV) + (size_t)layer * 768 * 256, NTOK, 768, 256, Ek);
#endif
#else
            sg_phase(F, H + HC_CKV, HP, (const bf16_t*)(F.ws + WS_WUKV) + (size_t)layer * 768 * 256, 256, NTOK, 768, 256, Ek);
#endif
        }
        SEAM(pb + 2);
        if ((PH_MASK & (2 << 3)) && IN(pb + 3)) {
#if OPT_ATTN
            attn_ab_phase(F, args, layer); launder(F);
#ifdef PROBE_DUP_ATTN
            attn_ab_phase(F, args, layer, PROBE_DUP_ATTN); launder(F);
#endif
            sattn_phase(F, args, layer, 10);
#ifdef PROBE_DUP_CFIN
            launder(F); sattn_phase(F, args, layer, 10);
#endif
#else
            sattn_phase(F, args, layer, 0);
#endif
        }
        SEAM(pb + 3);
        if ((PH_MASK & (2 << 4)) && IN(pb + 4)) {
#ifdef PROBE_DUP_WOUT
            { const EpiRes E0{args.out, layer == 0 ? args.x_prompt : nullptr, args.x_sample, (float*)(F.ws + WS_H)};
              og_phase(F, (const bf16_t*)(F.ws + WS_MIX), DM, (const bf16_t*)(F.ws + WS_WOUT) + (size_t)layer * 1024 * 1024, NTOK, 1024, 1024, E0); launder(F); }
#endif
            const EpiRes E{args.out, layer == 0 ? args.x_prompt : nullptr, args.x_sample, args.out};
#if OPT_GEMM
            og_phase(F, (const bf16_t*)(F.ws + WS_MIX), DM, (const bf16_t*)(F.ws + WS_WOUT) + (size_t)layer * 1024 * 1024, NTOK, 1024, 1024, E);
#else
            sg_phase(F, (const bf16_t*)(F.ws + WS_MIX), DM, (const bf16_t*)(F.ws + WS_WOUT) + (size_t)layer * 1024 * 1024, 1024, NTOK, 1024, 1024, E);
#endif
        }
        SEAM(pb + 4);
        if ((PH_MASK & (2 << 5)) && IN(pb + 5)) {
#ifdef PROBE_DUP_LN1
#endif
            ln1_route_pass(F, args, layer, F.gw, F.NGW, NTOK); moe_convert(F, args, layer);
#ifdef PROBE_DUP_CONV
            launder(F); moe_convert(F, args, layer);
#endif
        }
        SEAM(pb + 5);
#if OPT_GEMM
        if ((PH_MASK & (2 << 6)) && IN(pb + 6)) { moe_up_opt(F, layer);
#ifdef PROBE_DUP_MOE
            launder(F); moe_up_opt(F, layer);
#endif
        }
#else
        if ((PH_MASK & (2 << 6)) && IN(pb + 6)) { moe_up_simple(F, layer); }
#endif
        SEAM(pb + 6);
#if OPT_GEMM
        if ((PH_MASK & (2 << 7)) && IN(pb + 7)) { moe_down_opt(F, layer);
#ifdef PROBE_DUP_MOE
            launder(F); moe_down_opt(F, layer);
#endif
        }
#else
        if ((PH_MASK & (2 << 7)) && IN(pb + 7)) { moe_down_simple(F, layer); }
#endif
        SEAM(pb + 7);
        if ((PH_MASK & (2 << 8)) && IN(pb + 8)) { ln2_pass(F, args, layer, F.gw, F.NGW, NTOK); }
        SEAM(pb + 8);
    }
#endif
#undef IN
#undef SEAM
}

extern "C" void kernel_launch(void* const* d_in, const int* in_sizes, int n_in, void* d_out, int out_size, void* d_ws, size_t ws_size, hipStream_t stream) {
    static int grid = 0;
    if (grid == 0) {
        if (n_in != 19 || out_size != NTOK * DM || ws_size < WS_END) { fprintf(stderr, "kernel_launch: unexpected shapes (n_in %d out %d ws %zu)\n", n_in, out_size, ws_size); grid = -1; return; }
        int dev = 0, cus = 0, per_cu = 0;
        if (hipGetDevice(&dev) != hipSuccess || hipDeviceGetAttribute(&cus, hipDeviceAttributeMultiprocessorCount, dev) != hipSuccess) { grid = -1; return; }
        if (hipFuncSetAttribute((const void*)fwd, hipFuncAttributeMaxDynamicSharedMemorySize, LDS_BYTES) != hipSuccess) { grid = -1; return; }
        if (hipOccupancyMaxActiveBlocksPerMultiprocessor(&per_cu, (const void*)fwd, NTHREADS, LDS_BYTES) != hipSuccess || per_cu < 1) { fprintf(stderr, "kernel_launch: occupancy query says %d\n", per_cu); }
        (void)hipGetLastError();
        grid = cus;
    }
    if (grid < 0) return;
    if (hipMemsetAsync((char*)d_ws + WS_CTL, 0, CTL_ZERO_BYTES, stream) != hipSuccess) return;
    Args a{};
    a.x_prompt = (const float*)d_in[0]; a.x_sample = (const float*)d_in[1]; a.w_in = (const float*)d_in[2]; a.diff_lambda = (const float*)d_in[3]; a.diff_subln = (const float*)d_in[4];
    a.mla_q_norm = (const float*)d_in[5]; a.mla_w_uq = (const float*)d_in[6]; a.mla_kv_norm = (const float*)d_in[7]; a.mla_w_ukv = (const float*)d_in[8]; a.w_out = (const float*)d_in[9];
    a.ln1_g = (const float*)d_in[10]; a.ln1_b = (const float*)d_in[11]; a.moe_w_coarse = (const float*)d_in[12]; a.moe_w_fine = (const float*)d_in[13];
    a.moe_w1 = (const float*)d_in[14]; a.moe_w3 = (const float*)d_in[15]; a.moe_w2 = (const float*)d_in[16]; a.ln2_g = (const float*)d_in[17]; a.ln2_b = (const float*)d_in[18];
    a.out = (float*)d_out; a.ws = (unsigned char*)d_ws; a.pad = 0;
#if MK_ONE_LAUNCH
    a.ph_lo = 0; a.ph_hi = N_PHASES; a.use_bar = 1;
    hipLaunchKernelGGL(fwd, dim3(grid), dim3(NTHREADS), LDS_BYTES, stream, a);
#else
    for (int p = 0; p < N_PHASES; ++p) { a.ph_lo = p; a.ph_hi = p + 1; a.use_bar = 0; hipLaunchKernelGGL(fwd, dim3(grid), dim3(NTHREADS), LDS_BYTES, stream, a); }
#endif
}
```

```cpp
#include <hip/hip_runtime.h>
#include <cstdio>
#include <cstdint>

#ifndef OPT_ATTN
#define OPT_ATTN 1
#endif
#ifndef OPT_GEMM
#define OPT_GEMM 1
#endif
#ifndef MK_ONE_LAUNCH
#define MK_ONE_LAUNCH 1
#endif

#define GAS __attribute__((address_space(1)))
#define LAS __attribute__((address_space(3)))
typedef unsigned short bf16_t;
typedef short bf16x8 __attribute__((ext_vector_type(8)));
typedef float f32x4 __attribute__((ext_vector_type(4)));
typedef float f32x2 __attribute__((ext_vector_type(2)));
typedef float f32x16 __attribute__((ext_vector_type(16)));
typedef unsigned u32x4 __attribute__((ext_vector_type(4)));
typedef unsigned u32x2 __attribute__((ext_vector_type(2)));
typedef GAS unsigned gu32;
#define RLX_AGENT __ATOMIC_RELAXED, __HIP_MEMORY_SCOPE_AGENT
#define LDS_WAIT() asm volatile("s_waitcnt lgkmcnt(0)" ::: "memory")
#define VM_WAIT() asm volatile("s_waitcnt vmcnt(0)" ::: "memory")
#define MFMA32(a, b, c) __builtin_amdgcn_mfma_f32_32x32x16_bf16(a, b, c, 0, 0, 0)

__device__ __forceinline__ unsigned f2bf(float f) { unsigned u = __builtin_bit_cast(unsigned, f); return (u + 0x7fffu + ((u >> 16) & 1u)) >> 16; }
__device__ __forceinline__ unsigned pk2(float lo, float hi) { return f2bf(lo) | (f2bf(hi) << 16); }
__device__ __forceinline__ float bf2f(unsigned short b) { return __builtin_bit_cast(float, (unsigned)b << 16); }
__device__ __forceinline__ int crow(int r, int hi) { return (r & 3) + 8 * (r >> 2) + 4 * hi; }
template <int K> __device__ __forceinline__ float shx(float v) { static_assert(K < 32, "xor 32: use xsum32 / xmax32 / xpair32"); return __uint_as_float((unsigned)__builtin_amdgcn_ds_swizzle((int)__float_as_uint(v), (K << 10) | 0x1f)); }
__device__ __forceinline__ float xsum32(float v) { auto rr = __builtin_amdgcn_permlane32_swap(__float_as_uint(v), __float_as_uint(v), false, false); return __uint_as_float(rr[0]) + __uint_as_float(rr[1]); }
__device__ __forceinline__ float xmax32(float v) { auto rr = __builtin_amdgcn_permlane32_swap(__float_as_uint(v), __float_as_uint(v), false, false); return fmaxf(__uint_as_float(rr[0]), __uint_as_float(rr[1])); }
__device__ __forceinline__ float xpair32(float lo, float hi) { auto rr = __builtin_amdgcn_permlane32_swap(__float_as_uint(lo), __float_as_uint(hi), false, false); return __uint_as_float(rr[0]) + __uint_as_float(rr[1]); }
__device__ __forceinline__ float wave_sum(float v) {
    v += shx<1>(v); v += shx<2>(v); v += shx<4>(v); v += shx<8>(v); v += shx<16>(v);
    return xsum32(v);
}
__device__ __forceinline__ float fast_exp2(float x) { return __builtin_amdgcn_exp2f(x); }

constexpr int NTOK = 65536, DM = 1024, DEPTH = 4;
constexpr int NTOK_P = 32768;
constexpr int HP = 2560;
constexpr int HC_AQ = 0, HC_AK = 256, HC_AV = 512, HC_CQ_LAT = 768, HC_CKV = 1024, HC_KROPE = 1152, HC_CQ = 1280, HC_CK = 1664, HC_CV = 2048;
constexpr int QBP = 768, KVP = 768;
constexpr int MIX_A = 0, MIX_B = 256, MIX_C = 640;
constexpr int NEXP = 32, DEXP = 512;
constexpr float LOG2E = 1.4426950408889634f;
constexpr float SC_A = 0.17677669529663687f * LOG2E;
constexpr float SC_B = 0.10206207261596575f * LOG2E;
constexpr float SC_C = 0.125f * LOG2E;
constexpr float DN_ALPHA = 1.681792830507429f;
constexpr float LN_EPS = 1e-5f, RMS_EPS = 1e-6f;

constexpr size_t MiB = 1u << 20;
constexpr size_t WS_CTL = 0, CTL_ZERO_BYTES = 64 * 1024;
constexpr size_t WS_ROPE32 = 4 * MiB;
constexpr size_t WS_ROPE64 = 5 * MiB;
constexpr size_t WS_WIN = 8 * MiB;
constexpr size_t WS_WOUT = 28 * MiB;
constexpr size_t WS_WUQ = 36 * MiB;
constexpr size_t WS_WUKV = 38 * MiB;
constexpr size_t WS_W13 = 40 * MiB;
constexpr size_t WS_W2 = 104 * MiB;
constexpr size_t WS_XB = 136 * MiB;
constexpr size_t WS_H = 264 * MiB;
constexpr size_t WS_QB = 584 * MiB;
constexpr size_t WS_KVB = 680 * MiB;
constexpr size_t WS_MIX = 776 * MiB;
constexpr size_t WS_RSTD = 904 * MiB;
constexpr size_t WS_LSEC = 905 * MiB;
constexpr size_t WS_TW = 907 * MiB;
constexpr size_t WS_LIST = 908 * MiB;
constexpr size_t WS_END = 924 * MiB;
constexpr size_t WS_HID = WS_H;
constexpr size_t WS_YB = WS_H + 136 * MiB;
static_assert(WS_YB + 256 * MiB <= WS_KVB + 96 * MiB, "YB overlay");
constexpr int LIST_CAP = 131072;
constexpr int CW_TMO = 0;
constexpr int CW_CNT = 64;
constexpr int CW_BAR = 4096;

constexpr int RING_BYTES = 131072;
constexpr int MISC_OFF = RING_BYTES + 320;
constexpr int LDS_BYTES = 147456;
constexpr int NWAVES = 8, NTHREADS = 512;

#define XB_TMO      128
#define XB_XCNT(j)  (256  + 64 * (j))
#define XB_XSUB(j)  (1280 + 64 * (j))
#define XB_XGEN(j)  (2304 + 64 * (j))
#define XB_TOP      3328
#define XB_TOPGEN   3392
#define XCD_BAR_WORDS 3456
#define XB_SPIN_CAP (1u << 22)
__device__ __forceinline__ unsigned xb_ld(unsigned* p)              { return __hip_atomic_load(p, __ATOMIC_RELAXED, __HIP_MEMORY_SCOPE_AGENT); }
__device__ __forceinline__ unsigned xb_add(unsigned* p, unsigned v) { return __hip_atomic_fetch_add(p, v, __ATOMIC_RELAXED, __HIP_MEMORY_SCOPE_AGENT); }
__device__ __forceinline__ unsigned xb_xcc_id() { return (unsigned)__builtin_amdgcn_s_getreg((3 << 11) | 20) & 0xFu; }
#define XB_SPIN(cond, bar) do { unsigned _sp = 0; while (cond) { __builtin_amdgcn_s_sleep(1); \
    if ((++_sp & 255u) == 0u) { if (xb_ld(&(bar)[XB_TMO])) break; if (_sp > XB_SPIN_CAP) { atomicAdd(&(bar)[XB_TMO], 1u); break; } } } } while (0)
struct XcdBarrier { unsigned* bar; unsigned x; volatile LAS unsigned* st; };
__device__ __forceinline__ XcdBarrier xcd_barrier_post(unsigned* bar, volatile LAS unsigned* st) {
    XcdBarrier b; b.bar = bar; b.x = xb_xcc_id(); b.st = st;
    if (threadIdx.x == 0) (void)xb_add(&bar[XB_XCNT(b.x)], 1u);
    return b;
}
__device__ __forceinline__ void xcd_barrier_complete(unsigned* bar, unsigned x, unsigned& nloc, unsigned& nx) {
    const unsigned G = gridDim.x * gridDim.y * gridDim.z;
    unsigned sum, cnt, mine, sp = 0u;
    for (;;) {
        sum = 0u; cnt = 0u; mine = 0u;
#pragma unroll
        for (unsigned j = 0; j < 16; ++j) { const unsigned c = xb_ld(&bar[XB_XCNT(j)]); sum += c; cnt += (c > 0u) ? 1u : 0u; mine = (j == x) ? c : mine; }
        if (sum == G) break;
        __builtin_amdgcn_s_sleep(1);
        if ((++sp & 255u) == 0u) { if (xb_ld(&bar[XB_TMO])) break; if (sp > XB_SPIN_CAP) { atomicAdd(&bar[XB_TMO], 1u); break; } }
    }
    nloc = mine > 0u ? mine : 1u; nx = cnt > 0u ? cnt : 1u;
}
__device__ __forceinline__ void xcd_barrier(const XcdBarrier& b) {
    asm volatile("s_waitcnt vmcnt(0)" ::: "memory");
    __syncthreads();
    if (threadIdx.x == 0) {
        unsigned* bar = b.bar;
        __builtin_amdgcn_s_waitcnt(0);
        unsigned nloc = b.st[0], nx = b.st[1];
        if (nloc == 0u) { xcd_barrier_complete(bar, b.x, nloc, nx); b.st[0] = nloc; b.st[1] = nx; }
        const unsigned old = xb_add(&bar[XB_XSUB(b.x)], 1u);
        const unsigned gen = old / nloc;
        if (old + 1u == (gen + 1u) * nloc) {
            __builtin_amdgcn_fence(__ATOMIC_RELEASE, "agent");
            asm volatile("s_waitcnt vmcnt(0)" ::: "memory");
            const unsigned og = xb_add(&bar[XB_TOP], 1u);
            const unsigned tg = og / nx;
            if (og + 1u == (tg + 1u) * nx) xb_add(&bar[XB_TOPGEN], 1u);
            else XB_SPIN(xb_ld(&bar[XB_TOPGEN]) == tg, bar);
            __builtin_amdgcn_fence(__ATOMIC_ACQUIRE, "agent");
            xb_add(&bar[XB_XGEN(b.x)], 1u);
            asm volatile("s_waitcnt vmcnt(0)" ::: "memory");
        } else {
            XB_SPIN(xb_ld(&bar[XB_XGEN(b.x)]) == gen, bar);
            __builtin_amdgcn_fence(__ATOMIC_ACQUIRE, "agent");
            asm volatile("s_waitcnt vmcnt(0)" ::: "memory");
        }
    }
    __syncthreads();
}

struct Args {
    const float* x_prompt; const float* x_sample; const float* w_in; const float* diff_lambda; const float* diff_subln; const float* mla_q_norm; const float* mla_w_uq;
    const float* mla_kv_norm; const float* mla_w_ukv; const float* w_out; const float* ln1_g; const float* ln1_b; const float* moe_w_coarse; const float* moe_w_fine;
    const float* moe_w1; const float* moe_w3; const float* moe_w2; const float* ln2_g; const float* ln2_b;
    float* out; unsigned char* ws; int ph_lo, ph_hi, use_bar, pad;
};
struct Frame {
    LAS unsigned char* lds; unsigned char* ldsg;
    int tid, lane, wave, G, gw, NGW, bid;
    gu32* ctl; unsigned char* ws;
};
__device__ __forceinline__ void launder(Frame& F) {
    int wv = F.wave; asm volatile("" : "+s"(wv)); F.wave = wv;
    int t; asm volatile("v_mbcnt_lo_u32_b32 %0, -1, 0\n\tv_mbcnt_hi_u32_b32 %0, -1, %0" : "=v"(t)); F.lane = t; F.tid = wv * 64 + t;
    int b = (int)blockIdx.x; asm volatile("" : "+s"(b)); F.bid = b; F.gw = b * NWAVES + F.wave;
    unsigned char* w = F.ws; asm volatile("" : "+s"(w)); F.ws = w; F.ctl = (gu32*)(w + WS_CTL);
}
struct SeqInfo { int base, len, pos; };
__device__ __forceinline__ SeqInfo seqinfo(int m) { SeqInfo s; if (m < NTOK_P) { s.base = m & ~2047; s.len = 2048; } else { s.base = m & ~4095; s.len = 4096; } s.pos = m - s.base; return s; }

template <class ColMap>
__device__ __forceinline__ void transpose_item(const float* W, int N, bf16_t* WT, int ldd, LAS float* scr, int k0, int n0, const ColMap& cm, const float* kscale, int lane) {
    const int sc = cm(n0 + (lane & 31));
#pragma unroll 8
    for (int i = 0; i < 32; ++i) { const int kk = 2 * i + (lane >> 5); float v = 0.f; if (sc >= 0) { v = W[(size_t)(k0 + kk) * N + sc]; if (kscale) v *= kscale[k0 + kk]; } scr[kk * 33 + (lane & 31)] = v; }
    LDS_WAIT(); asm volatile("" ::: "memory");
    const int c = lane & 7;
#pragma unroll
    for (int j = 0; j < 4; ++j) { const int n = (lane >> 3) + 8 * j; const LAS float* s = scr + (8 * c) * 33 + n;
        u32x4 o; o.x = pk2(s[0 * 33], s[1 * 33]); o.y = pk2(s[2 * 33], s[3 * 33]); o.z = pk2(s[4 * 33], s[5 * 33]); o.w = pk2(s[6 * 33], s[7 * 33]);
        *(u32x4*)(WT + (size_t)(n0 + n) * ldd + k0 + 8 * c) = o; }
    LDS_WAIT(); asm volatile("" ::: "memory");
}
__device__ __forceinline__ void transpose_item_v4(const float* Wsrc, int N, bf16_t* WTdst, int ldd, LAS float* scr, int lane) {
    const int c4 = (lane & 7) * 4, kr = lane >> 3;
    f32x4 t[8];
#pragma unroll
    for (int i = 0; i < 8; ++i) t[i] = *(const f32x4*)(Wsrc + (size_t)(i * 8 + kr) * N + c4);
#pragma unroll
    for (int i = 0; i < 8; ++i) { const int kk = i * 8 + kr; scr[(c4 + 0) * 65 + kk] = t[i].x; scr[(c4 + 1) * 65 + kk] = t[i].y; scr[(c4 + 2) * 65 + kk] = t[i].z; scr[(c4 + 3) * 65 + kk] = t[i].w; }
    LDS_WAIT(); asm volatile("" ::: "memory");
    const int c = lane & 7;
#pragma unroll
    for (int j = 0; j < 4; ++j) { const int n = (lane >> 3) + 8 * j; const LAS float* p = scr + n * 65 + 8 * c;
        u32x4 o; o.x = pk2(p[0], p[1]); o.y = pk2(p[2], p[3]); o.z = pk2(p[4], p[5]); o.w = pk2(p[6], p[7]);
        *(u32x4*)(WTdst + (size_t)n * ldd + 8 * c) = o; }
    LDS_WAIT(); asm volatile("" ::: "memory");
}
struct WinMap {
    __device__ __forceinline__ int operator()(int n) const {
        if (n < 512) { const int t = n & 31; return (n & ~31) + (t >> 1) + 16 * (t & 1); }
        if (n < 1152) return n;
        if (n < 1184) { const int t = n - 1152; return 1152 + (t >> 1) + 16 * (t & 1); }
        if (n < 1280) return -1;
        if (n < 2048) { const int u = n - 1280, t = u & 63; return 1184 + (u & ~63) + (t >> 1) + 32 * (t & 1); }
        if (n < 2432) return 1952 + (n - 2048);
        return -1;
    }
};
struct UqMap { __device__ __forceinline__ int operator()(int n) const { if (n >= 576) return -1; const int h = n / 96, t = n - 96 * h; if (t < 64) return n; const int u = t - 64; return 96 * h + 64 + (u >> 1) + 16 * (u & 1); } };
struct IdMap { __device__ __forceinline__ int operator()(int n) const { return n; } };
struct W13Map { __device__ __forceinline__ int operator()(int n) const { return (n >> 8) * 128 + (n & 127); } };

__device__ __forceinline__ void p0_prologue(Frame& F, const Args& a) {
    LAS float* scr = (LAS float*)(F.lds + F.wave * 16384);
    { float2* r32 = (float2*)(F.ws + WS_ROPE32); float2* r64 = (float2*)(F.ws + WS_ROPE64);
      for (int i = F.gw * 64 + F.lane; i < 4096 * 16; i += F.NGW * 64) { const int pos = i >> 4, j = i & 15; const float inv = 1.0f / powf(10000.0f, (float)(2 * j) / 32.0f); const float ang = (float)pos * inv; r32[i] = make_float2(cosf(ang), sinf(ang)); }
      for (int i = F.gw * 64 + F.lane; i < 4096 * 32; i += F.NGW * 64) { const int pos = i >> 5, j = i & 31; const float inv = 1.0f / powf(10000.0f, (float)(2 * j) / 64.0f); const float ang = (float)pos * inv; r64[i] = make_float2(cosf(ang), sinf(ang)); } }
    constexpr int I_WIN = (1024 / 64) * (2560 / 32), I_WOUT = (1024 / 64) * (1024 / 32), I_UQ = (256 / 64) * (768 / 32), I_UKV = (256 / 64) * (768 / 32);
    constexpr int PER_L = I_WIN + I_WOUT + I_UQ + I_UKV;
    for (int it = F.gw; it < DEPTH * PER_L; it += F.NGW) {
        const int l = it / PER_L; int r = it - l * PER_L;
        if (r < I_WIN) { const int kb = r / 80, nb = r % 80; transpose_item(a.w_in + (size_t)l * 1024 * 2336, 2336, (bf16_t*)(F.ws + WS_WIN) + (size_t)l * 2560 * 1024, 1024, scr, kb * 64, nb * 32, WinMap(), nullptr, F.lane); continue; } r -= I_WIN;
        if (r < I_WOUT) { const int kb = r / 32, nb = r % 32; transpose_item(a.w_out + (size_t)l * 1024 * 1024, 1024, (bf16_t*)(F.ws + WS_WOUT) + (size_t)l * 1024 * 1024, 1024, scr, kb * 64, nb * 32, IdMap(), nullptr, F.lane); continue; } r -= I_WOUT;
        if (r < I_UQ) { const int kb = r / 24, nb = r % 24; transpose_item(a.mla_w_uq + (size_t)l * 256 * 576, 576, (bf16_t*)(F.ws + WS_WUQ) + (size_t)l * 768 * 256, 256, scr, kb * 64, nb * 32, UqMap(), a.mla_q_norm + l * 256, F.lane); continue; } r -= I_UQ;
        { const int kb = r / 24, nb = r % 24; bf16_t* dst = (bf16_t*)(F.ws + WS_WUKV) + (size_t)l * 768 * 256;
          if (kb < 2) transpose_item(a.mla_w_ukv + (size_t)l * 128 * 768, 768, dst, 256, scr, kb * 64, nb * 32, IdMap(), a.mla_kv_norm + l * 128, F.lane);
          else { const int c = F.lane & 7;
#pragma unroll
              for (int j = 0; j < 4; ++j) { const int n = (F.lane >> 3) + 8 * j; *(u32x4*)(dst + (size_t)(nb * 32 + n) * 256 + kb * 64 + 8 * c) = (u32x4){0u, 0u, 0u, 0u}; } } }
    }
    bf16_t* XB = (bf16_t*)(F.ws + WS_XB);
    for (int m = F.gw; m < NTOK; m += F.NGW) {
        const float* src = (m < NTOK_P) ? a.x_prompt + (size_t)m * DM : a.x_sample + (size_t)(m - NTOK_P) * DM;
#pragma unroll
        for (int j = 0; j < 4; ++j) { const f32x4 v = *((const f32x4*)src + F.lane + 64 * j);
            u32x2 w; w.x = pk2(v.x, v.y); w.y = pk2(v.z, v.w); *((u32x2*)(XB + (size_t)m * DM) + F.lane + 64 * j) = w; }
    }
}

template <class Epi, class RowMap>
__device__ __forceinline__ void sg_tile(const bf16_t* A, int lda, const bf16_t* B0, const bf16_t* B1, int ldb, int K, int m0, int c0, const Epi& E, const RowMap& RM, int lane) {
    const int r32 = lane & 31, hi = lane >> 5;
    const bf16_t* ap = A + (size_t)RM.src(m0 + r32) * lda + 8 * hi;
    const bf16_t* b0p = B0 + (size_t)r32 * ldb + 8 * hi;
    const bf16_t* b1p = B1 + (size_t)r32 * ldb + 8 * hi;
    f32x16 acc0 = {}, acc1 = {};
#pragma unroll 4
    for (int k = 0; k < K; k += 16) {
        const bf16x8 af = *(const bf16x8*)(ap + k), bf0 = *(const bf16x8*)(b0p + k), bf1 = *(const bf16x8*)(b1p + k);
        acc0 = MFMA32(bf0, af, acc0); acc1 = MFMA32(bf1, af, acc1);
    }
#pragma unroll
    for (int g = 0; g < 4; ++g) { const f32x4 v0 = {acc0[4 * g], acc0[4 * g + 1], acc0[4 * g + 2], acc0[4 * g + 3]}, v1 = {acc1[4 * g], acc1[4 * g + 1], acc1[4 * g + 2], acc1[4 * g + 3]};
        E.put(m0 + r32, c0, 8 * g + 4 * hi, v0, v1); }
}
struct IdRows { __device__ __forceinline__ int src(int m) const { return m; } };

__device__ __forceinline__ void store_bf8(bf16_t* p, f32x4 a, f32x4 b) { u32x4 w; w.x = pk2(a.x, a.y); w.y = pk2(a.z, a.w); w.z = pk2(b.x, b.y); w.w = pk2(b.z, b.w); *(u32x4*)p = w; }
__device__ __forceinline__ void store_bf4(bf16_t* p, f32x4 v) { u32x2 w; w.x = pk2(v.x, v.y); w.y = pk2(v.z, v.w); *(u32x2*)p = w; }
struct EpiH {
    static constexpr bool PERM = true;
    bf16_t* H; const float2* rope32; const float2* rope64;
    __device__ __forceinline__ f32x4 xf(int pos, int col, f32x4 v) const {
        if (col < 512 || (col >= HC_KROPE && col < HC_KROPE + 32)) {
            const int j0 = (col & 31) >> 1; const f32x4 cs = *(const f32x4*)(rope32 + pos * 16 + j0);
            f32x4 o; o.x = v.x * cs.x - v.y * cs.y; o.y = v.x * cs.y + v.y * cs.x; o.z = v.z * cs.z - v.w * cs.w; o.w = v.z * cs.w + v.w * cs.z;
            if (col < 256) o = o * SC_A; v = o;
        } else if (col >= HC_CQ && col < HC_CV) {
            const int j0 = ((col - HC_CQ) & 63) >> 1; const f32x4 cs = *(const f32x4*)(rope64 + pos * 32 + j0);
            f32x4 o; o.x = v.x * cs.x - v.y * cs.y; o.y = v.x * cs.y + v.y * cs.x; o.z = v.z * cs.z - v.w * cs.w; o.w = v.z * cs.w + v.w * cs.z;
            if (col < HC_CK) o = o * SC_C; v = o;
        }
        return v;
    }
    __device__ __forceinline__ void put4(int row, int col, f32x4 v) const { store_bf4(H + (size_t)row * HP + col, xf(seqinfo(row).pos, col, v)); }
    __device__ __forceinline__ void put(int row, int c0, int cc, f32x4 v0, f32x4 v1) const { put4(row, c0 + cc, v0); put4(row, c0 + 32 + cc, v1); }
    template <class U> __device__ __forceinline__ void put8(const U&, int row, int col, f32x4 v0, f32x4 v1) const { const int pos = seqinfo(row).pos; store_bf8(H + (size_t)row * HP + col, xf(pos, col, v0), xf(pos, col + 4, v1)); }
    struct Pre { f32x4 c0, c1; };
    __device__ __forceinline__ static f32x4 rot(f32x4 v, f32x4 cs) { f32x4 o; o.x = v.x * cs.x - v.y * cs.y; o.y = v.x * cs.y + v.y * cs.x; o.z = v.z * cs.z - v.w * cs.w; o.w = v.z * cs.w + v.w * cs.z; return o; }
    template <class U> __device__ __forceinline__ Pre pre(const U&, int row, int col) const { Pre p; p.c0 = (f32x4){0.f, 0.f, 0.f, 0.f}; p.c1 = p.c0; const int pos = seqinfo(row).pos;
        if (col < 512 || (col >= HC_KROPE && col < HC_KROPE + 32)) { const f32x4* t = (const f32x4*)(rope32 + pos * 16 + ((col & 31) >> 1)); p.c0 = t[0]; p.c1 = t[1]; }
        else if (col >= HC_CQ && col < HC_CV) { const f32x4* t = (const f32x4*)(rope64 + pos * 32 + (((col - HC_CQ) & 63) >> 1)); p.c0 = t[0]; p.c1 = t[1]; }
        return p; }
    template <class U> __device__ __forceinline__ void fin8(const U&, int row, int col, f32x4 v0, f32x4 v1, const Pre& p) const {
        if (col < 512 || (col >= HC_KROPE && col < HC_KROPE + 32)) { v0 = rot(v0, p.c0); v1 = rot(v1, p.c1); if (col < 256) { v0 = v0 * SC_A; v1 = v1 * SC_A; } }
        else if (col >= HC_CQ && col < HC_CV) { v0 = rot(v0, p.c0); v1 = rot(v1, p.c1); if (col < HC_CK) { v0 = v0 * SC_C; v1 = v1 * SC_C; } }
        store_bf8(H + (size_t)row * HP + col, v0, v1); }
};
struct EpiUQ {
    static constexpr bool PERM = true;
    bf16_t* Q; const float* rstd; const float2* rope32;
    __device__ __forceinline__ f32x4 xf(int row, int col, f32x4 v, float rs) const {
        v = v * rs;
        const int t = col % 96;
        if (t >= 64) { const int pos = seqinfo(row).pos; const int j0 = (t - 64) >> 1; const f32x4 cs = *(const f32x4*)(rope32 + pos * 16 + j0);
            f32x4 o; o.x = v.x * cs.x - v.y * cs.y; o.y = v.x * cs.y + v.y * cs.x; o.z = v.z * cs.z - v.w * cs.w; o.w = v.z * cs.w + v.w * cs.z; v = o; }
        return v * SC_B;
    }
    __device__ __forceinline__ void put4(int row, int col, f32x4 v) const { if (col >= 576) return; store_bf4(Q + (size_t)row * QBP + col, xf(row, col, v, rstd[2 * row])); }
    template <class U> __device__ __forceinline__ void put8(const U&, int row, int col, f32x4 v0, f32x4 v1) const { if (col >= 576) return; const float rs = rstd[2 * row]; store_bf8(Q + (size_t)row * QBP + col, xf(row, col, v0, rs), xf(row, col + 4, v1, rs)); }
    __device__ __forceinline__ void put(int row, int c0, int cc, f32x4 v0, f32x4 v1) const { put4(row, c0 + cc, v0); put4(row, c0 + 32 + cc, v1); }
    struct Pre { float rs; f32x4 c0, c1; };
    template <class U> __device__ __forceinline__ Pre pre(const U&, int row, int col) const { Pre p; p.rs = rstd[2 * row]; p.c0 = (f32x4){0.f, 0.f, 0.f, 0.f}; p.c1 = p.c0;
        if (col < 576 && (col % 96) >= 64) { const f32x4* t = (const f32x4*)(rope32 + seqinfo(row).pos * 16 + (((col % 96) - 64) >> 1)); p.c0 = t[0]; p.c1 = t[1]; }
        return p; }
    template <class U> __device__ __forceinline__ void fin8(const U&, int row, int col, f32x4 v0, f32x4 v1, const Pre& p) const { if (col >= 576) return;
        v0 = v0 * p.rs; v1 = v1 * p.rs; if ((col % 96) >= 64) { v0 = EpiH::rot(v0, p.c0); v1 = EpiH::rot(v1, p.c1); }
        store_bf8(Q + (size_t)row * QBP + col, v0 * SC_B, v1 * SC_B); }
};
struct EpiUKV {
    static constexpr bool PERM = true;
    bf16_t* KV; const float* rstd;
    template <class U> __device__ __forceinline__ void put8(const U&, int row, int col, f32x4 v0, f32x4 v1) const { const float rs = rstd[2 * row + 1]; store_bf8(KV + (size_t)row * KVP + col, v0 * rs, v1 * rs); }
    __device__ __forceinline__ void put4(int row, int col, f32x4 v) const { store_bf4(KV + (size_t)row * KVP + col, v * rstd[2 * row + 1]); }
    __device__ __forceinline__ void put(int row, int c0, int cc, f32x4 v0, f32x4 v1) const { put4(row, c0 + cc, v0); put4(row, c0 + 32 + cc, v1); }
    struct Pre { float rs; };
    template <class U> __device__ __forceinline__ Pre pre(const U&, int row, int) const { Pre p; p.rs = rstd[2 * row + 1]; return p; }
    template <class U> __device__ __forceinline__ void fin8(const U&, int row, int col, f32x4 v0, f32x4 v1, const Pre& p) const { store_bf8(KV + (size_t)row * KVP + col, v0 * p.rs, v1 * p.rs); }
};
struct EpiRes {
    static constexpr bool PERM = false;
    float* X; const float* xp; const float* xs; float* D;
    template <class U> __device__ __forceinline__ void put4(const U&, int row, int col, f32x4 v) const { put4(row, col, v); }
    __device__ __forceinline__ void put4(int row, int col, f32x4 v) const {
        const f32x4* p = (const f32x4*)(X + (size_t)row * DM + col);
        const f32x4 r = xp ? *(const f32x4*)(((row < NTOK_P) ? xp + (size_t)row * DM : xs + (size_t)(row - NTOK_P) * DM) + col) : *p;
        *(f32x4*)(D + (size_t)row * DM + col) = r * DN_ALPHA + v; }
    __device__ __forceinline__ void put(int row, int c0, int cc, f32x4 v0, f32x4 v1) const { put4(row, c0 + cc, v0); put4(row, c0 + 32 + cc, v1); }
    struct Pre { f32x4 a, b; };
    template <class U> __device__ __forceinline__ Pre pre(const U&, int row, int col) const { Pre p;
        const float* src = xp ? ((row < NTOK_P) ? xp + (size_t)row * DM : xs + (size_t)(row - NTOK_P) * DM) : X + (size_t)row * DM;
        p.a = *(const f32x4*)(src + col); p.b = *(const f32x4*)(src + col + 16); return p; }
    template <class U> __device__ __forceinline__ void fin4x2(const U&, int row, int col, f32x4 v0, f32x4 v1, const Pre& p) const {
        *(f32x4*)(D + (size_t)row * DM + col) = p.a * DN_ALPHA + v0; *(f32x4*)(D + (size_t)row * DM + col + 16) = p.b * DN_ALPHA + v1; }
};
__device__ __forceinline__ float silu_f(float x) { return x / (1.0f + __expf(-x)); }
struct EpiHid {
    static constexpr bool PERM = true;
    bf16_t* HID;
    __device__ __forceinline__ f32x4 act(f32x4 g, f32x4 u) const { f32x4 o; o.x = silu_f(g.x) * u.x; o.y = silu_f(g.y) * u.y; o.z = silu_f(g.z) * u.z; o.w = silu_f(g.w) * u.w; return o; }
    template <class U> __device__ __forceinline__ void putp8(const U&, int row, int col, f32x4 g0, f32x4 g1, f32x4 u0, f32x4 u1) const { store_bf8(HID + (size_t)row * DEXP + col, act(g0, u0), act(g1, u1)); }
    __device__ __forceinline__ void putp(int row, int col, f32x4 g, f32x4 u) const { f32x4 o; o.x = silu_f(g.x) * u.x; o.y = silu_f(g.y) * u.y; o.z = silu_f(g.z) * u.z; o.w = silu_f(g.w) * u.w; store_bf4(HID + (size_t)row * DEXP + col, o); }
    __device__ __forceinline__ void put(int row, int c0, int cc, f32x4 v0, f32x4 v1) const { putp(row, c0 + cc, v0, v1); }
};
struct EpiY {
    bf16_t* YB; const float* tw; const int* list; int seg0, cnt;
    __device__ __forceinline__ void put4(int row, int col, f32x4 v) const { const int r = row - seg0; if (r >= cnt) return; const int a = list[r]; store_bf4(YB + (size_t)a * DM + col, v * tw[a]); }
    __device__ __forceinline__ void put(int row, int c0, int cc, f32x4 v0, f32x4 v1) const { put4(row, c0 + cc, v0); put4(row, c0 + 32 + cc, v1); }
};

struct EpiYO {
    static constexpr bool PERM = true;
    bf16_t* YB; const float* tw; const int* list; const LAS int* seg;
    template <class U> __device__ __forceinline__ void put8(const U& u, int row, int col, f32x4 v0, f32x4 v1) const {
        const int r = row - __builtin_amdgcn_readfirstlane(seg[u.e]); if (r >= __builtin_amdgcn_readfirstlane(seg[33 + u.e])) return; const int a = list[(size_t)u.e * LIST_CAP + r]; const float w = tw[a]; store_bf8(YB + (size_t)a * DM + col, v0 * w, v1 * w); }
    struct Pre { int a; float w; };
    template <class U> __device__ __forceinline__ Pre pre(const U& u, int row, int) const { Pre p; p.a = -1; p.w = 0.f;
        const int r = row - __builtin_amdgcn_readfirstlane(seg[u.e]); if (r < __builtin_amdgcn_readfirstlane(seg[33 + u.e])) { p.a = list[(size_t)u.e * LIST_CAP + r]; p.w = tw[p.a]; } return p; }
    template <class U> __device__ __forceinline__ void fin8(const U&, int, int col, f32x4 v0, f32x4 v1, const Pre& p) const { if (p.a >= 0) store_bf8(YB + (size_t)p.a * DM + col, v0 * p.w, v1 * p.w); }
};
template <class Epi>
__device__ __forceinline__ void sg_phase(Frame& F, const bf16_t* A, int lda, const bf16_t* Bt, int ldb, int M, int N, int K, const Epi& E) {
    const int nN = N / 64, items = (M / 32) * nN;
    for (int it = F.gw; it < items; it += F.NGW) { const int mt = it / nN, nt = it - mt * nN;
        sg_tile(A, lda, Bt + (size_t)(nt * 64) * ldb, Bt + (size_t)(nt * 64 + 32) * ldb, ldb, K, mt * 32, nt * 64, E, IdRows(), F.lane); }
}


namespace pg8 {
constexpr int BM = 256, BK = 64, HALF = 128, HTB = HALF * BK * 2, NXCD = 8, WGM = 8;
__host__ __device__ __forceinline__ int lds_byte(int r, int c) { const int st = (r >> 4) * 2 + (c >> 5), rr = r & 15, cc = c & 31, ob = rr * 64 + cc * 2; return st * 1024 + (ob ^ (((ob >> 9) & 1) << 5)); }
__host__ __device__ __forceinline__ void stage_rc(int b, int& R, int& C) { const int st = b / 1024, sb = b % 1024, swz = sb ^ (((sb >> 9) & 1) << 5); R = (st >> 1) * 16 + swz / 64; C = (st & 1) * 32 + (swz % 64) / 2; }
__host__ __device__ __forceinline__ int perm32(int rho) { const int n = rho >> 4, i = rho & 15; return 8 * (i >> 2) + 4 * n + (i & 3); }
struct Unit { int pm, pn, e; const char* a; const char* b; };
__device__ __forceinline__ bool order_next(int i, int G, int c, int nM, int nN, int& pm, int& pn) {
    const int nwg = nM * nN; const long L = (long)i * G + c; if (L >= nwg) return false;
    int wgid = (int)L; { const int q = nwg / NXCD, r = nwg % NXCD, xcd = wgid % NXCD, off = wgid / NXCD; wgid = (xcd < r ? xcd * (q + 1) : r * (q + 1) + (xcd - r) * q) + off; }
    const int nig = WGM * nN, gid = wgid / nig, fm = gid * WGM, gsz = (nM - fm) < WGM ? (nM - fm) : WGM;
    pm = fm + ((wgid % nig) % gsz); pn = (wgid % nig) / gsz; return true;
}
struct DenseSched {
    const char* A; const char* Bt; int nM, nN, G, c; size_t tstepA, tstepB;
    __device__ __forceinline__ void init(const bf16_t* A_, int lda, const bf16_t* Bt_, int M, int N, int K, int G_, int c_) { A = (const char*)A_; Bt = (const char*)Bt_; nM = M / BM; nN = N / BM; G = G_; c = c_; tstepA = (size_t)BM * lda * 2; tstepB = (size_t)BM * K * 2; }
    __device__ __forceinline__ bool next(int i, Unit& u) const { if (!order_next(i, G, c, nM, nN, u.pm, u.pn)) return false; u.e = 0; u.a = A + (size_t)u.pm * tstepA; u.b = Bt + (size_t)u.pn * tstepB; return true; }
    __device__ __forceinline__ unsigned arow(const Unit&, int) const { return 0u; }
};
struct PanelSched {
    const char* A; const char* Bt; int pm, nN; size_t tstepB;
    __device__ __forceinline__ void init(const bf16_t* A_, int lda, const bf16_t* Bt_, int pm_, int N, int K) { pm = pm_; nN = N / BM; A = (const char*)A_ + (size_t)pm_ * BM * lda * 2; Bt = (const char*)Bt_; tstepB = (size_t)BM * K * 2; }
    __device__ __forceinline__ bool next(int i, Unit& u) const { if (i >= nN) return false; u.pm = pm; int pn = i + (pm % nN); if (pn >= nN) pn -= nN; u.pn = pn; u.e = 0; u.a = A; u.b = Bt + (size_t)pn * tstepB; return true; }
    __device__ __forceinline__ unsigned arow(const Unit&, int) const { return 0u; }
};
template <class Epi, bool PAIR> struct EpiApply;
template <class Epi, class Sched, bool GATHER, bool PAIR>
__device__ __forceinline__ void gemm_phase(LAS unsigned char* lds, int tid, int K, int lda, const Sched& S, const Epi& E) {
    const int wid = __builtin_amdgcn_readfirstlane(tid >> 6), lane = tid & 63, wr = wid >> 2, wc = wid & 3, fr = lane & 15, fq = lane >> 4;
    const int nt = K / BK;
    unsigned voffA[2], voffB[2]; int RA[2], CA[2];
#pragma unroll
    for (int i = 0; i < 2; ++i) { int R, C; stage_rc(tid * 16 + i * 8192, R, C); const int Rb = Epi::PERM ? ((R & ~31) + perm32(R & 31)) : R; RA[i] = R; CA[i] = C;
        voffA[i] = (unsigned)(R * lda + C) * 2u; voffB[i] = (unsigned)(Rb * K + C) * 2u; }
    const size_t kstep = (size_t)(BK * 2);
    const size_t hstepA = (size_t)HALF * lda * 2, hstepB = (size_t)HALF * K * 2;
    const unsigned ldsw = (unsigned)wid * 1024u;
    const int aoff = lds_byte(wr * 64 + fr, fq * 8), boff = lds_byte(wc * 32 + fr, fq * 8);
#define PG8_SA(b, h) (((b) * 2 + (h)) * HTB)
#define PG8_SB(b, h) ((4 + (b) * 2 + (h)) * HTB)
#define PG8_STAGE(bufoff, gbase, voff) do { _Pragma("unroll") for (int _i = 0; _i < 2; ++_i) \
        __builtin_amdgcn_global_load_lds((const unsigned*)((const char*)(gbase) + (voff)[_i]), (LAS unsigned*)(lds + (bufoff) + ldsw + _i * 8192), 16, 0, 0); } while (0)
#define PG8_STAGE_A(bufoff, ab, vg, h, koff) do { if (GATHER) { PG8_STAGE(bufoff, (ab) + (koff), (vg)[h]); } else { PG8_STAGE(bufoff, (ab) + (h) * hstepA + (koff), voffA); } } while (0)
#define PG8_LDA(dst, b, h) do { _Pragma("unroll") for (int m = 0; m < 4; ++m) _Pragma("unroll") for (int k = 0; k < 2; ++k) dst[m][k] = *(const LAS bf16x8*)(lds + PG8_SA(b, h) + aoff + m * 2048 + k * 1024); } while (0)
#define PG8_LDB(dst, b, h) do { _Pragma("unroll") for (int n = 0; n < 2; ++n) _Pragma("unroll") for (int k = 0; k < 2; ++k) dst[n][k] = *(const LAS bf16x8*)(lds + PG8_SB(b, h) + boff + n * 2048 + k * 1024); } while (0)
#define PG8_MMA(ai, bj, At, Bt) do { __builtin_amdgcn_s_setprio(1); _Pragma("unroll") for (int m = 0; m < 4; ++m) _Pragma("unroll") for (int n = 0; n < 2; ++n) _Pragma("unroll") for (int k = 0; k < 2; ++k) \
        acc[ai][bj][m][n] = __builtin_amdgcn_mfma_f32_16x16x32_bf16(Bt[n][k], At[m][k], acc[ai][bj][m][n], 0, 0, 0); __builtin_amdgcn_s_setprio(0); } while (0)
#define PG8_WAIT_V(n) asm volatile("s_waitcnt vmcnt(" #n ")" ::: "memory")
#define PG8_WAIT_L(n) asm volatile("s_waitcnt lgkmcnt(" #n ")" ::: "memory")
#define PG8_BAR __builtin_amdgcn_s_barrier()
#define PG8_SCHED __builtin_amdgcn_sched_barrier(0)
    Unit cur, nxt; int ui = 0;
    if (!S.next(0, cur)) return;
    f32x4 acc[2][2][4][2];
#pragma unroll
    for (int a = 0; a < 2; ++a)
#pragma unroll
        for (int b = 0; b < 2; ++b)
#pragma unroll
            for (int m = 0; m < 4; ++m)
#pragma unroll
                for (int n = 0; n < 2; ++n) acc[a][b][m][n] = (f32x4){0.f, 0.f, 0.f, 0.f};
    bf16x8 At[4][2], B0[2][2], B1[2][2];
    unsigned vgc[2][2] = {{0u, 0u}, {0u, 0u}}, vgn[2][2] = {{0u, 0u}, {0u, 0u}};
    if (GATHER) {
#pragma unroll
        for (int h = 0; h < 2; ++h)
#pragma unroll
            for (int i = 0; i < 2; ++i) vgc[h][i] = S.arow(cur, h * HALF + RA[i]) * (unsigned)(lda * 2) + (unsigned)CA[i] * 2u;
    }
    const char* cA = cur.a; const char* cB = cur.b;
    PG8_STAGE(PG8_SB(0, 0), cB, voffB); PG8_STAGE(PG8_SB(0, 1), cB + hstepB, voffB); PG8_STAGE_A(PG8_SA(0, 0), cA, vgc, 0, 0); PG8_STAGE_A(PG8_SA(0, 1), cA, vgc, 1, 0);
    if (wr == 1) PG8_BAR;
    PG8_WAIT_V(2); PG8_BAR;
    PG8_STAGE(PG8_SB(1, 0), cB + kstep, voffB); PG8_STAGE_A(PG8_SA(1, 0), cA, vgc, 0, kstep); PG8_STAGE(PG8_SB(1, 1), cB + hstepB + kstep, voffB);
    PG8_WAIT_V(6); PG8_BAR;
    for (;;) {
        const bool has_next = S.next(ui + 1, nxt);
        const char* nA = has_next ? nxt.a : cA; const char* nB = has_next ? nxt.b : cB;
        if (GATHER) {
#pragma unroll
            for (int h = 0; h < 2; ++h)
#pragma unroll
                for (int i = 0; i < 2; ++i) vgn[h][i] = has_next ? (S.arow(nxt, h * HALF + RA[i]) * (unsigned)(lda * 2) + (unsigned)CA[i] * 2u) : vgc[h][i];
        }
#pragma clang loop unroll(disable)
        for (int t = 0; t < nt; t += 2) {
            const bool last = (t == nt - 2);
            const size_t k1 = (size_t)(t + 1) * kstep;
            const char* a2 = last ? nA : cA; const char* b2 = last ? nB : cB + (size_t)(t + 2) * kstep; const size_t ka2 = last ? 0 : (size_t)(t + 2) * kstep;
            const char* b3 = b2 + kstep; const size_t ka3 = ka2 + kstep;
            unsigned v2[2][2];
#pragma unroll
            for (int h = 0; h < 2; ++h)
#pragma unroll
                for (int i = 0; i < 2; ++i) v2[h][i] = last ? vgn[h][i] : vgc[h][i];
            PG8_LDB(B0, 0, 0); PG8_LDB(B1, 0, 1); PG8_SCHED; PG8_LDA(At, 0, 0); PG8_STAGE_A(PG8_SA(1, 1), cA, vgc, 1, k1);
            PG8_WAIT_V(8); PG8_WAIT_L(0); PG8_BAR; PG8_MMA(0, 0, At, B0); PG8_MMA(0, 1, At, B1); PG8_BAR; PG8_SCHED;
            PG8_LDA(At, 0, 1); PG8_STAGE(PG8_SB(0, 0), b2, voffB); PG8_STAGE(PG8_SB(0, 1), b2 + hstepB, voffB); PG8_STAGE_A(PG8_SA(0, 0), a2, v2, 0, ka2);
            PG8_WAIT_V(8); PG8_WAIT_L(0); PG8_BAR; PG8_MMA(1, 0, At, B0); PG8_MMA(1, 1, At, B1); PG8_BAR; PG8_SCHED;
            PG8_LDB(B0, 1, 0); PG8_LDB(B1, 1, 1); PG8_SCHED; PG8_LDA(At, 1, 0); PG8_STAGE_A(PG8_SA(0, 1), a2, v2, 1, ka2);
            PG8_WAIT_V(8); PG8_WAIT_L(0); PG8_BAR; PG8_MMA(0, 0, At, B0); PG8_MMA(0, 1, At, B1); PG8_BAR; PG8_SCHED;
            PG8_LDA(At, 1, 1); PG8_STAGE(PG8_SB(1, 0), b3, voffB); PG8_STAGE(PG8_SB(1, 1), b3 + hstepB, voffB); PG8_STAGE_A(PG8_SA(1, 0), a2, v2, 0, ka3);
            PG8_WAIT_V(8); PG8_WAIT_L(0); PG8_BAR; PG8_MMA(1, 0, At, B0); PG8_MMA(1, 1, At, B1); PG8_BAR; PG8_SCHED;
        }
        if (wr == 0) PG8_BAR;
        { int fr_ = fr, fq_ = fq; asm volatile("" : "+v"(fr_), "+v"(fq_));
          EpiApply<Epi, PAIR>::run(E, acc, cur, wr, wc, fr_, fq_); }
        if (!has_next) break;
#pragma unroll
        for (int a = 0; a < 2; ++a)
#pragma unroll
            for (int b = 0; b < 2; ++b)
#pragma unroll
                for (int m = 0; m < 4; ++m)
#pragma unroll
                    for (int n = 0; n < 2; ++n) acc[a][b][m][n] = (f32x4){0.f, 0.f, 0.f, 0.f};
        cur = nxt; cA = nA; cB = nB; ++ui;
        if (GATHER) {
#pragma unroll
            for (int h = 0; h < 2; ++h)
#pragma unroll
                for (int i = 0; i < 2; ++i) vgc[h][i] = vgn[h][i];
        }
        if (wr == 1) PG8_BAR;
    }
    PG8_WAIT_V(0);
    PG8_BAR;
#undef PG8_SA
#undef PG8_SB
#undef PG8_STAGE
#undef PG8_STAGE_A
#undef PG8_LDA
#undef PG8_LDB
#undef PG8_MMA
#undef PG8_WAIT_V
#undef PG8_WAIT_L
#undef PG8_BAR
#undef PG8_SCHED
}
template <class Epi> struct EpiApply<Epi, false> {
    static __device__ __forceinline__ void run(const Epi& E, const f32x4 (&acc)[2][2][4][2], const Unit& u, int wr, int wc, int fr, int fq) {
#pragma unroll
        for (int ai = 0; ai < 2; ++ai) {
            typename Epi::Pre pre[4][2];
#pragma unroll
            for (int m = 0; m < 4; ++m) { const int row = u.pm * BM + ai * HALF + wr * 64 + m * 16 + fr;
#pragma unroll
                for (int bj = 0; bj < 2; ++bj) pre[m][bj] = E.pre(u, row, u.pn * BM + bj * HALF + wc * 32 + (Epi::PERM ? 8 : 4) * fq); }
#pragma unroll
            for (int m = 0; m < 4; ++m) { const int row = u.pm * BM + ai * HALF + wr * 64 + m * 16 + fr;
#pragma unroll
                for (int bj = 0; bj < 2; ++bj) {
                    if constexpr (Epi::PERM) E.fin8(u, row, u.pn * BM + bj * HALF + wc * 32 + 8 * fq, acc[ai][bj][m][0], acc[ai][bj][m][1], pre[m][bj]);
                    else E.fin4x2(u, row, u.pn * BM + bj * HALF + wc * 32 + 4 * fq, acc[ai][bj][m][0], acc[ai][bj][m][1], pre[m][bj]); } }
        }
    }
};
template <class Epi> struct EpiApply<Epi, true> {
    static __device__ __forceinline__ void run(const Epi& E, const f32x4 (&acc)[2][2][4][2], const Unit& u, int wr, int wc, int fr, int fq) {
#pragma unroll
        for (int ai = 0; ai < 2; ++ai)
#pragma unroll
            for (int m = 0; m < 4; ++m) { const int row = u.pm * BM + ai * HALF + wr * 64 + m * 16 + fr;
                E.putp8(u, row, u.pn * HALF + wc * 32 + 8 * fq, acc[ai][0][m][0], acc[ai][0][m][1], acc[ai][1][m][0], acc[ai][1][m][1]); }
    }
};
}

__device__ __forceinline__ void rowstat_pass(Frame& F, int r_first, int r_stride, int r_end) {
    const bf16_t* H = (const bf16_t*)(F.ws + WS_H); float* rstd = (float*)(F.ws + WS_RSTD);
    for (int m = r_first; m < r_end; m += r_stride) {
        const bf16_t* hr = H + (size_t)m * HP;
        const u32x2 q = *((const u32x2*)(hr + HC_CQ_LAT) + F.lane);
        const unsigned kv = *((const unsigned*)(hr + HC_CKV) + F.lane);
        float a0 = bf2f(q.x & 0xffff), a1 = bf2f(q.x >> 16), a2 = bf2f(q.y & 0xffff), a3 = bf2f(q.y >> 16), b0 = bf2f(kv & 0xffff), b1 = bf2f(kv >> 16);
        const float sq = wave_sum(a0 * a0 + a1 * a1 + a2 * a2 + a3 * a3), sk = wave_sum(b0 * b0 + b1 * b1);
        if (F.lane == 0) { rstd[2 * m] = 1.0f / sqrtf(sq * (1.0f / 256.0f) + RMS_EPS); rstd[2 * m + 1] = 1.0f / sqrtf(sk * (1.0f / 128.0f) + RMS_EPS); }
    }
}
__device__ __forceinline__ void red8(float (&v)[8], int lane) {
    float a[4], b[2], c;
#pragma unroll
    for (int i = 0; i < 4; ++i) a[i] = xpair32(v[i], v[i + 4]);
    { const bool up = (lane & 16) != 0;
#pragma unroll
      for (int i = 0; i < 2; ++i) { const float send = up ? a[i] : a[i + 2], keep = up ? a[i + 2] : a[i]; b[i] = keep + shx<16>(send); } }
    { const bool up = (lane & 8) != 0; const float send = up ? b[0] : b[1], keep = up ? b[1] : b[0]; c = keep + shx<8>(send); }
    c += shx<4>(c); c += shx<2>(c); c += shx<1>(c);
#pragma unroll
    for (int i = 0; i < 8; ++i) v[i] = __uint_as_float(__builtin_amdgcn_readlane(__float_as_uint(c), ((i >> 2) & 1) * 32 + ((i >> 1) & 1) * 16 + (i & 1) * 8));
}
__device__ __forceinline__ void red4(float (&v)[4], int lane) {
    float a[2], c;
#pragma unroll
    for (int i = 0; i < 2; ++i) a[i] = xpair32(v[i], v[i + 2]);
    { const bool up = (lane & 16) != 0; const float send = up ? a[0] : a[1], keep = up ? a[1] : a[0]; c = keep + shx<16>(send); }
    c += shx<8>(c); c += shx<4>(c); c += shx<2>(c); c += shx<1>(c);
#pragma unroll
    for (int i = 0; i < 4; ++i) v[i] = __uint_as_float(__builtin_amdgcn_readlane(__float_as_uint(c), ((i >> 1) & 1) * 32 + (i & 1) * 16));
}
__device__ __forceinline__ void ln1_route_pass(Frame& F, const Args& a, int layer, int r_first, int r_stride, int r_end) {
    bf16_t* XB = (bf16_t*)(F.ws + WS_XB); float* tw = (float*)(F.ws + WS_TW); int* list = (int*)(F.ws + WS_LIST);
    const float* g = a.ln1_g + layer * DM; const float* bb = a.ln1_b + layer * DM;
    const float* wc = a.moe_w_coarse + (size_t)layer * DM * 4; const float* wf = a.moe_w_fine + (size_t)layer * 4 * DM * 8;
    for (int q = F.tid; q < 4 * 1024 * 2; q += NTHREADS) { const int hf = q & 1, k = (q >> 1) & 1023, gg = q >> 11; const int l = (k & 255) >> 2, e = k & 3, j = k >> 8;
        *(LAS f32x4*)(F.lds + (size_t)(gg * 2048 + ((j * 4 + e) * 2 + hf) * 64 + l) * 16) = *((const f32x4*)wf + q); }
    f32x4 wcr[4][4];
#pragma unroll
    for (int j = 0; j < 4; ++j)
#pragma unroll
        for (int e = 0; e < 4; ++e) wcr[j][e] = *(const f32x4*)(wc + (size_t)(4 * F.lane + 256 * j + e) * 4);
    __syncthreads();
    f32x4 vn[2][4];
#pragma unroll
    for (int rr = 0; rr < 2; ++rr) { const int mm = r_first + rr * r_stride; if (mm < r_end) {
#pragma unroll
        for (int j = 0; j < 4; ++j) vn[rr][j] = *((const f32x4*)(a.out + (size_t)mm * DM) + F.lane + 64 * j); } }
    for (int m0 = r_first; m0 < r_end; m0 += 2 * r_stride) {
        f32x4 vc[2][4];
#pragma unroll
        for (int rr = 0; rr < 2; ++rr)
#pragma unroll
            for (int j = 0; j < 4; ++j) vc[rr][j] = vn[rr][j];
#pragma unroll
        for (int rr = 0; rr < 2; ++rr) { const int mm = m0 + (2 + rr) * r_stride; if (mm < r_end) {
#pragma unroll
            for (int j = 0; j < 4; ++j) vn[rr][j] = *((const f32x4*)(a.out + (size_t)mm * DM) + F.lane + 64 * j); } }
#pragma unroll
      for (int rr = 0; rr < 2; ++rr) { const int m = m0 + rr * r_stride; if (m < r_end) {
        f32x4 v[4]; float s = 0.f;
#pragma unroll
        for (int j = 0; j < 4; ++j) { v[j] = vc[rr][j]; s += (v[j].x + v[j].y) + (v[j].z + v[j].w); }
        const float mean = wave_sum(s) * (1.f / DM); float s2 = 0.f;
#pragma unroll
        for (int j = 0; j < 4; ++j) { v[j] = v[j] - mean; s2 += (v[j].x * v[j].x + v[j].y * v[j].y) + (v[j].z * v[j].z + v[j].w * v[j].w); }
        const float rs = 1.f / sqrtf(wave_sum(s2) * (1.f / DM) + LN_EPS);
        float cl[4] = {0.f, 0.f, 0.f, 0.f};
#pragma unroll
        for (int j = 0; j < 4; ++j) { const int c = 4 * F.lane + 256 * j; const f32x4 gg = *(const f32x4*)(g + c), bv = *(const f32x4*)(bb + c); v[j] = v[j] * rs * gg + bv;
            u32x2 w; w.x = pk2(v[j].x, v[j].y); w.y = pk2(v[j].z, v[j].w); *((u32x2*)(XB + (size_t)m * DM) + F.lane + 64 * j) = w;
#pragma unroll
            for (int e = 0; e < 4; ++e) { const f32x4 w4 = wcr[j][e]; const float xe = v[j][e]; cl[0] += xe * w4.x; cl[1] += xe * w4.y; cl[2] += xe * w4.z; cl[3] += xe * w4.w; } }
        red4(cl, F.lane);
        int grp = 0; float cm = cl[0];
#pragma unroll
        for (int e = 1; e < 4; ++e) if (cl[e] > cm) { cm = cl[e]; grp = e; }
        float den = 0.f;
#pragma unroll
        for (int e = 0; e < 4; ++e) den += __expf(cl[e] - cm);
        const float pg = 1.0f / den;
        grp = __builtin_amdgcn_readfirstlane(grp);
        const LAS f32x4* wl = (const LAS f32x4*)(F.lds) + grp * 2048 + F.lane;
        float fl[8] = {0.f, 0.f, 0.f, 0.f, 0.f, 0.f, 0.f, 0.f};
#pragma unroll
        for (int j = 0; j < 4; ++j)
#pragma unroll
            for (int e = 0; e < 4; ++e) { const f32x4 wa = wl[((j * 4 + e) * 2) * 64], wb = wl[((j * 4 + e) * 2 + 1) * 64]; const float xe = v[j][e];
                fl[0] += xe * wa.x; fl[1] += xe * wa.y; fl[2] += xe * wa.z; fl[3] += xe * wa.w; fl[4] += xe * wb.x; fl[5] += xe * wb.y; fl[6] += xe * wb.z; fl[7] += xe * wb.w; }
        red8(fl, F.lane);
        int i0 = 0; float v0 = fl[0];
#pragma unroll
        for (int e = 1; e < 8; ++e) if (fl[e] > v0) { v0 = fl[e]; i0 = e; }
        int i1 = -1; float v1 = -3.0e38f;
#pragma unroll
        for (int e = 0; e < 8; ++e) if (e != i0 && fl[e] > v1) { v1 = fl[e]; i1 = e; }
        const float e1 = __expf(v1 - v0), w0 = pg / (1.0f + e1), w1 = pg * e1 / (1.0f + e1);
        if (F.lane < 2) { const int e = grp * 8 + (F.lane == 0 ? i0 : i1); const int a_id = 2 * m + F.lane;
            const unsigned pos = __hip_atomic_fetch_add(F.ctl + CW_CNT + layer * 64 + e, 1u, RLX_AGENT);
            list[(size_t)e * LIST_CAP + pos] = a_id; tw[a_id] = (F.lane == 0) ? w0 : w1; }
          } }
    }
    __syncthreads();
}
__device__ __forceinline__ void ln2_pass(Frame& F, const Args& a, int layer, int r_first, int r_stride, int r_end) {
    bf16_t* XB = (bf16_t*)(F.ws + WS_XB); const bf16_t* YB = (const bf16_t*)(F.ws + WS_YB);
    const float* g = a.ln2_g + layer * DM; const float* bb = a.ln2_b + layer * DM; const float* g1 = a.ln1_g + layer * DM; const float* b1 = a.ln1_b + layer * DM;
    f32x4 xn[2][4]; u32x2 pn[2][4], qn[2][4];
#define LN2_LOAD(rr, mm) do { const bf16_t* y0_ = YB + (size_t)(2 * (mm)) * DM; _Pragma("unroll") for (int j = 0; j < 4; ++j) { xn[rr][j] = *((const f32x4*)(a.out + (size_t)(mm) * DM) + F.lane + 64 * j); \
        pn[rr][j] = *((const u32x2*)y0_ + F.lane + 64 * j); qn[rr][j] = *((const u32x2*)(y0_ + DM) + F.lane + 64 * j); } } while (0)
#pragma unroll
    for (int rr = 0; rr < 2; ++rr) { const int mm = r_first + rr * r_stride; if (mm < r_end) LN2_LOAD(rr, mm); }
    for (int m0 = r_first; m0 < r_end; m0 += 2 * r_stride) {
        f32x4 xc[2][4]; u32x2 pc[2][4], qc[2][4];
#pragma unroll
        for (int rr = 0; rr < 2; ++rr)
#pragma unroll
            for (int j = 0; j < 4; ++j) { xc[rr][j] = xn[rr][j]; pc[rr][j] = pn[rr][j]; qc[rr][j] = qn[rr][j]; }
#pragma unroll
        for (int rr = 0; rr < 2; ++rr) { const int mm = m0 + (2 + rr) * r_stride; if (mm < r_end) LN2_LOAD(rr, mm); }
#pragma unroll
        for (int rr = 0; rr < 2; ++rr) { const int m = m0 + rr * r_stride; if (m < r_end) {
            float* xr = a.out + (size_t)m * DM;
            f32x4 v[4]; float s = 0.f;
            { float s1 = 0.f;
#pragma unroll
              for (int j = 0; j < 4; ++j) { v[j] = xc[rr][j]; s1 += (v[j].x + v[j].y) + (v[j].z + v[j].w); }
              const float mean1 = wave_sum(s1) * (1.f / DM); float q1 = 0.f;
#pragma unroll
              for (int j = 0; j < 4; ++j) { v[j] = v[j] - mean1; q1 += (v[j].x * v[j].x + v[j].y * v[j].y) + (v[j].z * v[j].z + v[j].w * v[j].w); }
              const float rs1 = 1.f / sqrtf(wave_sum(q1) * (1.f / DM) + LN_EPS);
#pragma unroll
              for (int j = 0; j < 4; ++j) { const int c = 4 * F.lane + 256 * j; xc[rr][j] = v[j] * rs1 * *(const f32x4*)(g1 + c) + *(const f32x4*)(b1 + c); } }
#pragma unroll
            for (int j = 0; j < 4; ++j) { v[j] = xc[rr][j] * DN_ALPHA; const u32x2 p = pc[rr][j], q = qc[rr][j];
                v[j].x += bf2f(p.x & 0xffff) + bf2f(q.x & 0xffff); v[j].y += bf2f(p.x >> 16) + bf2f(q.x >> 16); v[j].z += bf2f(p.y & 0xffff) + bf2f(q.y & 0xffff); v[j].w += bf2f(p.y >> 16) + bf2f(q.y >> 16);
                s += (v[j].x + v[j].y) + (v[j].z + v[j].w); }
            const float mean = wave_sum(s) * (1.f / DM); float s2 = 0.f;
#pragma unroll
            for (int j = 0; j < 4; ++j) { v[j] = v[j] - mean; s2 += (v[j].x * v[j].x + v[j].y * v[j].y) + (v[j].z * v[j].z + v[j].w * v[j].w); }
            const float rs = 1.f / sqrtf(wave_sum(s2) * (1.f / DM) + LN_EPS);
#pragma unroll
            for (int j = 0; j < 4; ++j) { const int c = 4 * F.lane + 256 * j; const f32x4 gg = *(const f32x4*)(g + c), bv = *(const f32x4*)(bb + c); v[j] = v[j] * rs * gg + bv;
                *((f32x4*)xr + F.lane + 64 * j) = v[j]; u32x2 w; w.x = pk2(v[j].x, v[j].y); w.y = pk2(v[j].z, v[j].w); *((u32x2*)(XB + (size_t)m * DM) + F.lane + 64 * j) = w; }
        } }
    }
#undef LN2_LOAD
}
__device__ __forceinline__ void moe_convert(Frame& F, const Args& a, int layer) {
    LAS float* scr = (LAS float*)(F.lds + F.wave * 16384);
    constexpr int I_13 = (1024 / 64) * (1024 / 32), I_2 = (512 / 64) * (1024 / 32), PER_E = I_13 + I_2;
    for (int it = F.gw; it < NEXP * PER_E; it += F.NGW) {
        const int e = it / PER_E; int r = it - e * PER_E; const size_t le = (size_t)layer * NEXP + e;
        if (r < I_13) { const int kb = r / 32, nb = r % 32; const float* src = ((nb >> 2) & 1) ? a.moe_w3 : a.moe_w1;
            const int sc0 = ((32 * nb) >> 8) * 128 + ((32 * nb) & 127);
            transpose_item_v4(src + le * 1024 * 512 + (size_t)(kb * 64) * 512 + sc0, 512, (bf16_t*)(F.ws + WS_W13) + (size_t)e * 1024 * 1024 + (size_t)(nb * 32) * 1024 + kb * 64, 1024, scr, F.lane); }
        else { r -= I_13; const int kb = r / 32, nb = r % 32;
            transpose_item_v4(a.moe_w2 + le * 512 * 1024 + (size_t)(kb * 64) * 1024 + nb * 32, 1024, (bf16_t*)(F.ws + WS_W2) + (size_t)e * 1024 * 512 + (size_t)(nb * 32) * 512 + kb * 64, 512, scr, F.lane); }
    }
}

typedef short at_s16x4 __attribute__((ext_vector_type(4)));
typedef LAS const unsigned char* at_lds_cptr;
__device__ __forceinline__ at_s16x4 at_vtr(at_lds_cptr p) { return __builtin_bit_cast(at_s16x4, __builtin_amdgcn_ds_read_tr16_b64_v4i16((LAS at_s16x4*)p)); }
struct RowSrc { const bf16_t* p; long pitch; };
constexpr int SA_P = 0, SA_V = 4096, SA_AL = 12288, SA_RL = 12544;
template <int NC0, int NC1, int MODE>
__device__ __forceinline__ void sattn_core(const bf16x8* qf, RowSrc k0, RowSrc k1, RowSrc vs, int kb_lo, int kb_hi, int qidx0, float lse_ref, LAS unsigned char* scr, int lane, f32x16* o, float& lse_out) {
    const int r32 = lane & 31, hi = lane >> 5;
    LAS bf16_t* Pb = (LAS bf16_t*)(scr + SA_P); LAS bf16_t* Vb = (LAS bf16_t*)(scr + SA_V); LAS float* Al = (LAS float*)(scr + SA_AL);
    float m = -1.0e30f, l = 0.f;
    if (MODE != 1) { o[0] = f32x16{}; o[1] = f32x16{}; }
    bf16x8 kn[NC0 + NC1]; u32x4 vn[4];
#define SA_LOAD(kb_) do { const long key_ = (long)(kb_) * 32 + r32; \
        _Pragma("unroll") for (int c = 0; c < NC0; ++c) kn[c] = *(const bf16x8*)(k0.p + key_ * k0.pitch + 16 * c + 8 * hi); \
        _Pragma("unroll") for (int c = 0; c < NC1; ++c) kn[NC0 + c] = *(const bf16x8*)(k1.p + key_ * k1.pitch + 16 * c + 8 * hi); \
        if (MODE != 1) { _Pragma("unroll") for (int i = 0; i < 4; ++i) { const int idx = i * 64 + lane, kr = idx >> 3, pc = idx & 7; vn[i] = *(const u32x4*)(vs.p + ((long)(kb_) * 32 + kr) * vs.pitch + pc * 8); } } } while (0)
    if (kb_lo < kb_hi) SA_LOAD(kb_lo);
    const at_lds_cptr vtb = (at_lds_cptr)(scr + SA_V) + ((8 * hi + ((lane & 15) >> 2)) * 72 + 16 * ((lane >> 4) & 1) + 4 * (lane & 3)) * 2;
    for (int kb = kb_lo; kb < kb_hi; ++kb) {
        bf16x8 kc[NC0 + NC1]; u32x4 vc[4];
#pragma unroll
        for (int c = 0; c < NC0 + NC1; ++c) kc[c] = kn[c];
#pragma unroll
        for (int i = 0; i < 4; ++i) vc[i] = vn[i];
        if (kb + 1 < kb_hi) SA_LOAD(kb + 1);
        f32x16 s = {};
#pragma unroll
        for (int c = 0; c < NC0 + NC1; ++c) s = MFMA32(kc[c], qf[c], s);
        bool valid[16];
#pragma unroll
        for (int r = 0; r < 16; ++r) { if (MODE == 0) valid[r] = true; else { const int d = kb * 32 + crow(r, hi) - (qidx0 + r32); valid[r] = (d <= 64 && d >= -64); } }
        float p[16];
        if (MODE == 2) {
#pragma unroll
            for (int r = 0; r < 16; ++r) p[r] = valid[r] ? fast_exp2(s[r] - lse_ref) : 0.f;
        } else {
            float mx = -1.0e30f;
#pragma unroll
            for (int r = 0; r < 16; ++r) if (valid[r]) mx = fmaxf(mx, s[r]);
            mx = xmax32(mx);
            const float mn = fmaxf(m, mx), alpha = fast_exp2(m - mn); m = mn;
            float ps = 0.f;
#pragma unroll
            for (int r = 0; r < 16; ++r) { p[r] = valid[r] ? fast_exp2(s[r] - mn) : 0.f; ps += p[r]; }
            l = l * alpha + ps;
            if (MODE == 0) { if (hi == 0) Al[r32] = alpha; }
        }
        if (MODE != 1) {
#pragma unroll
            for (int g = 0; g < 4; ++g) { u32x2 w; w.x = pk2(p[4 * g], p[4 * g + 1]); w.y = pk2(p[4 * g + 2], p[4 * g + 3]); *(LAS u32x2*)(Pb + r32 * 40 + 8 * g + 4 * hi) = w; }
#pragma unroll
            for (int i = 0; i < 4; ++i) { const int idx = i * 64 + lane, kr = idx >> 3, pc = idx & 7; *(LAS u32x4*)(Vb + kr * 72 + pc * 8) = vc[i]; }
            LDS_WAIT();
            if (MODE == 0) {
#pragma unroll
                for (int r = 0; r < 16; ++r) { const float al = Al[crow(r, hi)]; o[0][r] *= al; o[1][r] *= al; }
            }
#pragma unroll
            for (int st = 0; st < 2; ++st) {
                const bf16x8 pf = *(const LAS bf16x8*)(Pb + r32 * 40 + 16 * st + 8 * hi);
#pragma unroll
                for (int db = 0; db < 2; ++db) {
                    const at_s16x4 lo_ = at_vtr(vtb + (16 * st * 72 + 32 * db) * 2), hi_ = at_vtr(vtb + ((16 * st + 4) * 72 + 32 * db) * 2);
                    const bf16x8 vf = {lo_[0], lo_[1], lo_[2], lo_[3], hi_[0], hi_[1], hi_[2], hi_[3]};
                    o[db] = MFMA32(pf, vf, o[db]); }
            }
            LDS_WAIT();
        }
    }
#undef SA_LOAD
    if (MODE != 2) { l = xsum32(l); lse_out = m + __log2f(l); }
    if (MODE == 0) {
        LAS float* Rl = (LAS float*)(scr + SA_RL);
        if (hi == 0) Rl[r32] = 1.0f / l;
        LDS_WAIT();
#pragma unroll
        for (int r = 0; r < 16; ++r) { const float rl = Rl[crow(r, hi)]; o[0][r] *= rl; o[1][r] *= rl; }
        LDS_WAIT();
    }
}

__device__ __forceinline__ void sattn_phase(Frame& F, const Args& a, int layer, int kind_lo) {
    const bf16_t* H = (const bf16_t*)(F.ws + WS_H); const bf16_t* QB = (const bf16_t*)(F.ws + WS_QB); const bf16_t* KVB = (const bf16_t*)(F.ws + WS_KVB);
    bf16_t* MIX = (bf16_t*)(F.ws + WS_MIX); const float* lsec = (const float*)(F.ws + WS_LSEC);
    LAS unsigned char* scr = F.lds + F.wave * 16384;
    const int lane = F.lane, r32 = lane & 31, hi = lane >> 5;
    float lam, lam_init;
    { const float* lv = a.diff_lambda + layer * 128; float d1 = 0.f, d2 = 0.f;
      for (int i = 0; i < 32; ++i) { d1 += lv[i] * lv[32 + i]; d2 += lv[64 + i] * lv[96 + i]; }
      lam_init = 0.8f - 0.6f * expf(-0.3f * (float)layer); lam = expf(d1) - expf(d2) + lam_init; }
    constexpr int NRB = NTOK / 32;
    const int items = NRB * (4 + 6 + 6);
    for (int it = kind_lo * NRB + F.gw; it < items; it += F.NGW) {
        const int kind = it / NRB, rb = it - kind * NRB; const int m0 = rb * 32; const SeqInfo si = seqinfo(m0);
#if !OPT_ATTN
        if (kind < 4) {
            const int h = kind; f32x16 o0[2], o1[2]; float dummy;
            for (int c = 0; c < 2; ++c) {
                bf16x8 qf[2];
#pragma unroll
                for (int d0 = 0; d0 < 2; ++d0) qf[d0] = *(const bf16x8*)(H + (size_t)(m0 + r32) * HP + HC_AQ + h * 64 + c * 32 + 16 * d0 + 8 * hi);
                const RowSrc ks{H + (size_t)si.base * HP + HC_AK + h * 64 + c * 32, HP}, vs{H + (size_t)si.base * HP + HC_AV + h * 64, HP};
                sattn_core<2, 0, 0>(qf, ks, ks, vs, 0, si.len / 32, 0, 0.f, scr, lane, c == 0 ? o0 : o1, dummy);
            }
            const float* sg = a.diff_subln + layer * 64; const float g0 = sg[r32], g1 = sg[32 + r32];
#pragma unroll
            for (int r = 0; r < 16; ++r) { const float x0 = o0[0][r] - lam * o1[0][r], x1 = o0[1][r] - lam * o1[1][r]; float ss = x0 * x0 + x1 * x1;
                ss += shx<1>(ss); ss += shx<2>(ss); ss += shx<4>(ss); ss += shx<8>(ss); ss += shx<16>(ss);
                const float rs = (1.0f - lam_init) / sqrtf(ss * (1.0f / 64.0f) + RMS_EPS);
                bf16_t* op = MIX + (size_t)(m0 + crow(r, hi)) * DM + MIX_A + h * 64 + r32;
                op[0] = (bf16_t)f2bf(x0 * rs * g0); op[32] = (bf16_t)f2bf(x1 * rs * g1); }
        } else if (kind < 10) {
            const int h = kind - 4; f32x16 o[2]; float dummy; bf16x8 qf[6];
#pragma unroll
            for (int d0 = 0; d0 < 6; ++d0) qf[d0] = *(const bf16x8*)(QB + (size_t)(m0 + r32) * QBP + h * 96 + 16 * d0 + 8 * hi);
            const RowSrc k0{KVB + (size_t)si.base * KVP + h * 128, KVP}, k1{H + (size_t)si.base * HP + HC_KROPE, HP}, vs{KVB + (size_t)si.base * KVP + h * 128 + 64, KVP};
            sattn_core<4, 2, 0>(qf, k0, k1, vs, 0, si.len / 32, 0, 0.f, scr, lane, o, dummy);
#pragma unroll
            for (int r = 0; r < 16; ++r) { bf16_t* op = MIX + (size_t)(m0 + crow(r, hi)) * DM + MIX_B + h * 64 + r32; op[0] = (bf16_t)f2bf(o[0][r]); op[32] = (bf16_t)f2bf(o[1][r]); }
        } else
#endif
        {
            const int gj = kind - 10, g = gj >> 1, hh = gj;
            const int dil = (g == 0) ? 1 : (g == 1 ? 4 : 16); const int L = si.len / dil, bpr = L / 32;
            const int w = (m0 - si.base) / 32, rho = w / bpr, ib = w - rho * bpr, i0 = ib * 32;
            const size_t qrow = (size_t)si.base + (size_t)(i0 + r32) * dil + rho;
            bf16x8 qf[4];
#pragma unroll
            for (int d0 = 0; d0 < 4; ++d0) qf[d0] = *(const bf16x8*)(H + qrow * HP + HC_CQ + hh * 64 + 16 * d0 + 8 * hi);
            const int j = gj & 1; const float l0 = lsec[(0 * (size_t)NTOK + qrow) * 2 + j], l1 = lsec[(1 * (size_t)NTOK + qrow) * 2 + j], l2 = lsec[(2 * (size_t)NTOK + qrow) * 2 + j];
            const float lm = fmaxf(l0, fmaxf(l1, l2)); const float lref = lm + __log2f(fast_exp2(l0 - lm) + fast_exp2(l1 - lm) + fast_exp2(l2 - lm));
            const RowSrc ks{H + ((size_t)si.base + rho) * HP + HC_CK + hh * 64, (long)HP * dil}, vs{H + ((size_t)si.base + rho) * HP + HC_CV + hh * 64, (long)HP * dil};
            int kb_lo = ib - 2, kb_hi = ib + 3; if (kb_lo < 0) kb_lo = 0; if (kb_hi > bpr) kb_hi = bpr;
            f32x16 o[2]; float dummy;
            sattn_core<4, 0, 2>(qf, ks, ks, vs, kb_lo, kb_hi, i0, lref, scr, lane, o, dummy);
#pragma unroll
            for (int r = 0; r < 16; ++r) { const size_t orow = (size_t)si.base + (size_t)(i0 + crow(r, hi)) * dil + rho; bf16_t* op = MIX + orow * DM + MIX_C + hh * 64 + r32; op[0] = (bf16_t)f2bf(o[0][r]); op[32] = (bf16_t)f2bf(o[1][r]); }
        }
    }
}
__device__ __forceinline__ void cstat_phase(Frame& F) {
    const bf16_t* H = (const bf16_t*)(F.ws + WS_H); float* lsec = (float*)(F.ws + WS_LSEC);
    LAS unsigned char* scr = F.lds + F.wave * 16384;
    const int lane = F.lane, r32 = lane & 31, hi = lane >> 5;
    constexpr int NRB = NTOK / 32;
    for (int it = F.gw; it < NRB * 6; it += F.NGW) {
        const int gj = it / NRB, rb = it - gj * NRB, g = gj >> 1, j = gj & 1; const int m0 = rb * 32; const SeqInfo si = seqinfo(m0);
        const int dil = (g == 0) ? 1 : (g == 1 ? 4 : 16); const int L = si.len / dil, bpr = L / 32;
        const int w = (m0 - si.base) / 32, rho = w / bpr, ib = w - rho * bpr, i0 = ib * 32;
        const size_t qrow = (size_t)si.base + (size_t)(i0 + r32) * dil + rho;
        bf16x8 qf[4];
#pragma unroll
        for (int d0 = 0; d0 < 4; ++d0) qf[d0] = *(const bf16x8*)(H + qrow * HP + HC_CQ + gj * 64 + 16 * d0 + 8 * hi);
        const RowSrc ks{H + ((size_t)si.base + rho) * HP + HC_CK + gj * 64, (long)HP * dil};
        int kb_lo = ib - 2, kb_hi = ib + 3; if (kb_lo < 0) kb_lo = 0; if (kb_hi > bpr) kb_hi = bpr;
        float lse; sattn_core<4, 0, 1>(qf, ks, ks, ks, kb_lo, kb_hi, i0, 0.f, scr, lane, nullptr, lse);
        if (hi == 0) lsec[((size_t)g * NTOK + qrow) * 2 + j] = lse;
    }
}


namespace at {
typedef short s16x4 __attribute__((ext_vector_type(4)));
typedef short v4i16_t __attribute__((ext_vector_type(4)));
typedef LAS const unsigned char* lds_cptr;
constexpr int LDS_K = 0, KSLOT_MAX = 12288, LDS_V = 3 * KSLOT_MAX, VSLOT = 8192, LDS_WS = LDS_V + 3 * VSLOT, LDS_OST = LDS_WS + 8 * 256, LDS_TOTAL = LDS_OST + 8 * 8192;
static_assert(LDS_TOTAL <= RING_BYTES, "attention LDS");
constexpr float THR = 8.0f;
__device__ __forceinline__ void glds16(const void* g, unsigned lds_dst) {
    unsigned keep; asm volatile("s_mov_b32 %0, m0\n\ts_mov_b32 m0, %2\n\ts_nop 0\n\tglobal_load_lds_dwordx4 %1, off\n\ts_mov_b32 m0, %0" : "=&s"(keep) : "v"(g), "s"(lds_dst) : "memory"); }
__device__ __forceinline__ s16x4 vtr(lds_cptr p) { return __builtin_bit_cast(s16x4, __builtin_amdgcn_ds_read_tr16_b64_v4i16((LAS v4i16_t*)p)); }
__device__ __forceinline__ unsigned cvtpk(float lo, float hi) { typedef float f2 __attribute__((ext_vector_type(2))); typedef __bf16 b2 __attribute__((ext_vector_type(2))); f2 v = {lo, hi}; b2 b = __builtin_convertvector(v, b2); return __builtin_bit_cast(unsigned, b); }
#define AT_MX3(a, b, c) __builtin_fmaxf(__builtin_fmaxf((a), (b)), (c))
__device__ __forceinline__ float rowmax(const f32x16& p0, const f32x16& p1) {
    float a = AT_MX3(p0[0], p0[1], p1[0]), b = AT_MX3(p0[2], p0[3], p1[1]); a = AT_MX3(a, p1[2], p1[3]);
#pragma unroll
    for (int r = 4; r < 16; r += 4) { a = AT_MX3(a, p0[r], p0[r + 1]); b = AT_MX3(b, p0[r + 2], p0[r + 3]); a = AT_MX3(a, p1[r], p1[r + 1]); b = AT_MX3(b, p1[r + 2], p1[r + 3]); }
    float m = __builtin_fmaxf(a, b); auto rr = __builtin_amdgcn_permlane32_swap(__float_as_uint(m), __float_as_uint(m), false, false);
    return __builtin_fmaxf(__uint_as_float(rr[0]), __uint_as_float(rr[1])); }
#define AT_WAIT_BAR(N) asm volatile("s_waitcnt vmcnt(" #N ") lgkmcnt(0)\n\ts_barrier" ::: "memory")

struct Src { const bf16_t* p; long pitch; };
template <int NC, int NK0, int NK1>
__device__ __forceinline__ void stream(LAS unsigned char* lds, int tid, const bf16_t* qrow, Src k0, Src k1, Src vs, int NT, f32x16& o0, f32x16& o1, float& lsum) {
    asm volatile("" : "+v"(tid));
    constexpr int SLOTK = 2 * NC * 1024;
    const int lane = tid & 63, r32 = lane & 31, hi = lane >> 5; const int wid = __builtin_amdgcn_readfirstlane(tid >> 6);
    const unsigned lds0 = (unsigned)(uintptr_t)lds;
    LAS float* wsf = (LAS float*)(lds + LDS_WS) + wid * 64;
    constexpr int P0 = NK0 * 16;
    const bool hasA = (NK0 == 8) || (wid < 4), hasB = (NK1 > 0) && (wid < 4);
    const int pA = (NK0 == 8) ? wid : (wid & 3);
    const int rowA = (NK0 == 8) ? pA * 8 + (lane >> 3) : pA * 16 + (lane >> 2);
    const int chA = (NK0 == 8) ? ((lane & 7) ^ ((4 * pA + (lane >> 4)) & 7)) : ((lane & 3) ^ ((lane >> 4) & 3));
    const bf16_t* ksA = k0.p + (long)rowA * k0.pitch + chA * 8;
    const int rowB = (wid & 3) * 16 + (lane >> 2), chB = (lane & 3) ^ ((lane >> 4) & 3);
    const bf16_t* ksB = (NK1 > 0) ? k1.p + (long)rowB * k1.pitch + chB * 8 : k0.p;
    const bf16_t* vsp = vs.p + (long)(16 * (wid & 3) + (lane >> 2)) * vs.pitch + (wid >> 2) * 32 + (lane & 3) * 8;
    const unsigned kdA = lds0 + LDS_K + pA * 1024, kdB = lds0 + LDS_K + (NK0 + (wid & 3)) * 1024, vd = lds0 + LDS_V + wid * 1024;
    const long ktA = 64 * k0.pitch, ktB = 64 * k1.pitch, vt = 64 * vs.pitch;
    const int nd = (hasA ? 1 : 0) + (hasB ? 1 : 0) + 1;
#define AT_DMA_K(t, slot) do { if (hasA) glds16(ksA + (long)(t) * ktA, (unsigned)__builtin_amdgcn_readfirstlane(kdA + (slot) * SLOTK)); if (hasB) glds16(ksB + (long)(t) * ktB, (unsigned)__builtin_amdgcn_readfirstlane(kdB + (slot) * SLOTK)); } while (0)
#define AT_DMA_V(t, slot) glds16(vsp + (long)(t) * vt, (unsigned)__builtin_amdgcn_readfirstlane(vd + (slot) * VSLOT))
    lds_cptr kb[NC];
#pragma unroll
    for (int d0 = 0; d0 < NC; ++d0) { const int c = 2 * d0 + hi;
        if (2 * d0 < NK0) kb[d0] = (lds_cptr)lds + LDS_K + r32 * P0 + ((NK0 == 8) ? (c ^ ((r32 >> 1) & 7)) : (c ^ ((r32 >> 2) & 3))) * 16;
        else kb[d0] = (lds_cptr)lds + LDS_K + NK0 * 1024 + r32 * 64 + ((c - NK0) ^ ((r32 >> 2) & 3)) * 16; }
    const lds_cptr vp0 = (lds_cptr)lds + LDS_V + ((lane >> 4) & 1) * 32 + (lane & 3) * 8 + (4 * hi + ((lane & 15) >> 2)) * 64;
    AT_DMA_K(0, 0); AT_DMA_V(0, 0); if (NT > 1) AT_DMA_K(1, 1);
    bf16x8 qr[NC];
#pragma unroll
    for (int d0 = 0; d0 < NC; ++d0) qr[d0] = *(const bf16x8*)(qrow + 16 * d0 + 8 * hi);
    float mhat = 0.f, l = 0.f; f32x16 oa = {}, ob = {}, negm = {}, S0, S1; u32x4 pw0, pw1, pw2, pw3;
    asm volatile("" : "+v"(negm));
    AT_WAIT_BAR(0);
    __builtin_amdgcn_s_waitcnt(0);
#pragma unroll
    for (int d0 = 0; d0 < NC; ++d0) asm volatile("" : "+v"(qr[d0]));
    constexpr bool QLDS = (NC > 2);
    const lds_cptr qb = (lds_cptr)lds + LDS_OST + wid * 8192 + lane * 16;
    if (QLDS) {
#pragma unroll
        for (int d0 = 0; d0 < NC; ++d0) *(LAS bf16x8*)(lds + LDS_OST + wid * 8192 + lane * 16 + d0 * 1024) = qr[d0];
        LDS_WAIT();
    }
    int kc = 0, kn1 = 1, kn2 = 2, vpv = 2, vcu = 0, vnx = 1;
    bf16x8 kf[2 * NC], vf[8];
#define AT_SB() __builtin_amdgcn_sched_barrier(0)
#define AT_KRD(so_, d0) do { kf[2 * (d0)] = *(const LAS bf16x8*)(kb[d0] + (so_)); kf[2 * (d0) + 1] = *(const LAS bf16x8*)(kb[d0] + (so_) + 32 * ((2 * (d0) < NK0) ? P0 : 64)); if (QLDS) qr[d0] = *(const LAS bf16x8*)(qb + (d0) * 1024); } while (0)
#define AT_KHEAD(slot) do { const int kp_ = (slot) * SLOTK; AT_KRD(kp_, 0); } while (0)
#define AT_VF(i) ({ const s16x4 lo_ = vtr(vp_ + (((i) >> 2) * 4096 + ((i) & 3) * 1024)), hi_ = vtr(vp_ + (((i) >> 2) * 4096 + ((i) & 3) * 1024 + 512)); (bf16x8){lo_[0], lo_[1], lo_[2], lo_[3], hi_[0], hi_[1], hi_[2], hi_[3]}; })
#define AT_VHEAD(slot) do { const lds_cptr vp_ = vp0 + (slot) * VSLOT; vf[0] = AT_VF(0); vf[4] = AT_VF(4); } while (0)
#define AT_QKM(slot) do { const int kp_ = (slot) * SLOTK; \
        _Pragma("unroll") for (int d0 = 0; d0 < NC; ++d0) { if (d0 + 1 < NC) AT_KRD(kp_, d0 + 1); \
            if (d0 == 0) { S0 = MFMA32(kf[0], qr[0], negm); S1 = MFMA32(kf[1], qr[0], negm); } else { S0 = MFMA32(kf[2 * d0], qr[d0], S0); S1 = MFMA32(kf[2 * d0 + 1], qr[d0], S1); } AT_SB(); } } while (0)
#define AT_PVM(slot) do { const lds_cptr vp_ = vp0 + (slot) * VSLOT; \
        vf[1] = AT_VF(1); vf[5] = AT_VF(5); oa = MFMA32(__builtin_bit_cast(bf16x8, pw0), vf[0], oa); ob = MFMA32(__builtin_bit_cast(bf16x8, pw0), vf[4], ob); AT_SB(); \
        vf[2] = AT_VF(2); vf[6] = AT_VF(6); oa = MFMA32(__builtin_bit_cast(bf16x8, pw1), vf[1], oa); ob = MFMA32(__builtin_bit_cast(bf16x8, pw1), vf[5], ob); AT_SB(); \
        vf[3] = AT_VF(3); vf[7] = AT_VF(7); oa = MFMA32(__builtin_bit_cast(bf16x8, pw2), vf[2], oa); ob = MFMA32(__builtin_bit_cast(bf16x8, pw2), vf[6], ob); AT_SB(); \
        oa = MFMA32(__builtin_bit_cast(bf16x8, pw3), vf[3], oa); ob = MFMA32(__builtin_bit_cast(bf16x8, pw3), vf[7], ob); AT_SB(); } while (0)
    bool resc = false; u32x4 qw0, qw1, qw2, qw3; float sacc = 0.f;
#define AT_PIN(x) asm volatile("" : "+v"(x))
#define AT_DECIDE(first) do { const float rm_ = rowmax(S0, S1); resc = false; \
        if ((first) || __any(rm_ > THR)) { const float dl_ = (first) ? rm_ : __builtin_fmaxf(rm_, 0.f); mhat += dl_; \
            _Pragma("unroll") for (int r = 0; r < 16; ++r) { S0[r] -= dl_; S1[r] -= dl_; negm[r] = -mhat; } asm volatile("" : "+v"(negm)); \
            if (!(first)) { const float f_ = fast_exp2(-dl_); l *= f_; if (hi == 0) wsf[r32] = f_; resc = true; } } } while (0)
#define AT_RESC() do { if (resc) { LDS_WAIT(); \
        _Pragma("unroll") for (int r = 0; r < 16; ++r) { const float g_ = wsf[crow(r, hi)]; oa[r] *= g_; ob[r] *= g_; } LDS_WAIT(); } } while (0)
#define AT_EXP8(S, b, Q) do { \
        _Pragma("unroll") for (int r = 0; r < 8; ++r) S[(b) + r] = fast_exp2(S[(b) + r]); \
        sacc += (S[(b)] + S[(b) + 1]) + (S[(b) + 2] + S[(b) + 3]); sacc += (S[(b) + 4] + S[(b) + 5]) + (S[(b) + 6] + S[(b) + 7]); \
        Q = (u32x4){cvtpk(S[(b)], S[(b) + 1]), cvtpk(S[(b) + 2], S[(b) + 3]), cvtpk(S[(b) + 4], S[(b) + 5]), cvtpk(S[(b) + 6], S[(b) + 7])}; AT_PIN(Q); AT_PIN(sacc); } while (0)
#define AT_EXPALL() do { sacc = 0.f; AT_EXP8(S0, 0, qw0); AT_EXP8(S0, 8, qw1); AT_EXP8(S1, 0, qw2); AT_EXP8(S1, 8, qw3); l += sacc; pw0 = qw0; pw1 = qw1; pw2 = qw2; pw3 = qw3; } while (0)
#define AT_PV_EXP(slot, C0, C1, C2, C3, N0, N1, N2, N3) do { const lds_cptr vp_ = vp0 + (slot) * VSLOT; sacc = 0.f; \
        vf[1] = AT_VF(1); vf[5] = AT_VF(5); oa = MFMA32(__builtin_bit_cast(bf16x8, C0), vf[0], oa); ob = MFMA32(__builtin_bit_cast(bf16x8, C0), vf[4], ob); AT_EXP8(S0, 0, N0); AT_SB(); \
        vf[2] = AT_VF(2); vf[6] = AT_VF(6); oa = MFMA32(__builtin_bit_cast(bf16x8, C1), vf[1], oa); ob = MFMA32(__builtin_bit_cast(bf16x8, C1), vf[5], ob); AT_EXP8(S0, 8, N1); AT_SB(); \
        vf[3] = AT_VF(3); vf[7] = AT_VF(7); oa = MFMA32(__builtin_bit_cast(bf16x8, C2), vf[2], oa); ob = MFMA32(__builtin_bit_cast(bf16x8, C2), vf[6], ob); AT_EXP8(S1, 0, N2); AT_SB(); \
        oa = MFMA32(__builtin_bit_cast(bf16x8, C3), vf[3], oa); ob = MFMA32(__builtin_bit_cast(bf16x8, C3), vf[7], ob); AT_EXP8(S1, 8, N3); AT_SB(); \
        l += sacc; } while (0)
#define AT_STEP_WAIT(t) do { if ((t) + 2 < NT) { if (nd == 3) AT_WAIT_BAR(3); else if (nd == 2) AT_WAIT_BAR(2); else AT_WAIT_BAR(1); } else AT_WAIT_BAR(0); } while (0)
#define AT_ROT() do { const int a_ = kc; kc = kn1; kn1 = kn2; kn2 = a_; const int b_ = vpv; vpv = vcu; vcu = vnx; vnx = b_; } while (0)
    AT_DMA_K(2, kn2); AT_DMA_V(1, vnx);
    AT_KHEAD(kc); AT_SB();
    AT_QKM(kc); AT_DECIDE(true); AT_EXPALL();
    AT_STEP_WAIT(0); AT_ROT();
#define AT_STEP(t, C0, C1, C2, C3, N0, N1, N2, N3) do { \
        if ((t) + 2 < NT) AT_DMA_K((t) + 2, kn2); \
        if ((t) + 1 < NT) AT_DMA_V((t) + 1, vnx); \
        AT_KHEAD(kc); AT_VHEAD(vpv); AT_SB(); \
        AT_QKM(kc); \
        AT_DECIDE(false); AT_SB(); \
        AT_PV_EXP(vpv, C0, C1, C2, C3, N0, N1, N2, N3); \
        AT_RESC(); \
        AT_STEP_WAIT(t); AT_ROT(); } while (0)
    int t = 1;
    for (; t + 1 < NT; t += 2) { AT_STEP(t, pw0, pw1, pw2, pw3, qw0, qw1, qw2, qw3); AT_STEP(t + 1, qw0, qw1, qw2, qw3, pw0, pw1, pw2, pw3); }
    if (t < NT) { AT_STEP(t, pw0, pw1, pw2, pw3, qw0, qw1, qw2, qw3); pw0 = qw0; pw1 = qw1; pw2 = qw2; pw3 = qw3; }
#undef AT_STEP
    AT_VHEAD(vpv); AT_SB(); AT_PVM(vpv);
    { auto rr = __builtin_amdgcn_permlane32_swap(__float_as_uint(l), __float_as_uint(l), false, false); l = __uint_as_float(rr[0]) + __uint_as_float(rr[1]); }
    o0 = oa; o1 = ob; lsum = l;
#undef AT_DMA_K
#undef AT_DMA_V
#undef AT_SB
#undef AT_KRD
#undef AT_KHEAD
#undef AT_VF
#undef AT_VHEAD
#undef AT_QKM
#undef AT_PVM
#undef AT_PIN
#undef AT_DECIDE
#undef AT_RESC
#undef AT_EXP8
#undef AT_EXPALL
#undef AT_PV_EXP
#undef AT_STEP_WAIT
#undef AT_ROT
}
__device__ __forceinline__ void normalise(LAS unsigned char* lds, int tid, f32x16& o0, f32x16& o1, float lsum) {
    const int lane = tid & 63, r32 = lane & 31, hi = lane >> 5; const int wid = __builtin_amdgcn_readfirstlane(tid >> 6);
    LAS float* wsf = (LAS float*)(lds + LDS_WS) + wid * 64;
    if (hi == 0) wsf[32 + r32] = 1.0f / lsum; LDS_WAIT();
#pragma unroll
    for (int r = 0; r < 16; ++r) { const float g = wsf[32 + crow(r, hi)]; o0[r] *= g; o1[r] *= g; }
    LDS_WAIT();
}
}

struct AttnUnitId { int kind, seq, head, qb; };
__device__ __forceinline__ bool attn_unit_at(int i, int G, int bid, AttnUnitId& u) {
    const long L = (long)i * G + bid; if (L >= 2560) return false; int o = (int)L;
    int kind, longs, nh;
    if (o < 512) { kind = 0; longs = 1; nh = 4; } else if (o < 1024) { kind = 0; longs = 0; nh = 4; o -= 512; } else if (o < 1792) { kind = 1; longs = 1; nh = 6; o -= 1024; } else { kind = 1; longs = 0; nh = 6; o -= 1792; }
    const int nqb = longs ? 16 : 8;
    int pair, qb;
    if (G == 256) { const int rnd = o >> 8, b = o & 255, x = b & 7, c = b >> 3;
        const int ppr = 32 / nqb; pair = x + 8 * (rnd * ppr + c / nqb); qb = c % nqb; }
    else { pair = o / nqb; qb = o % nqb; }
    u.kind = kind; u.head = pair % nh; const int sq = pair / nh; u.seq = longs ? 16 + sq : sq; u.qb = qb; return true;
}
__device__ __forceinline__ void attn_ab_phase(Frame& F, const Args& a, int layer, int kmask = 3) {
    const bf16_t* H = (const bf16_t*)(F.ws + WS_H); const bf16_t* QB = (const bf16_t*)(F.ws + WS_QB); const bf16_t* KVB = (const bf16_t*)(F.ws + WS_KVB);
    bf16_t* MIX = (bf16_t*)(F.ws + WS_MIX);
    const int wid = F.wave;
    float lam, lam_init;
    { const float* lv = a.diff_lambda + layer * 128; float d1 = 0.f, d2 = 0.f;
      for (int i = 0; i < 32; ++i) { d1 += lv[i] * lv[32 + i]; d2 += lv[64 + i] * lv[96 + i]; }
      lam_init = 0.8f - 0.6f * expf(-0.3f * (float)layer); lam = expf(d1) - expf(d2) + lam_init;
      lam = __uint_as_float(__builtin_amdgcn_readfirstlane(__float_as_uint(lam))); lam_init = __uint_as_float(__builtin_amdgcn_readfirstlane(__float_as_uint(lam_init))); }
    AttnUnitId u;
    for (int i = 0; attn_unit_at(i, F.G, F.bid, u); ++i) {
        if (!((kmask >> u.kind) & 1)) continue;
        int tid = F.tid; asm volatile("" : "+v"(tid)); const int lane = tid & 63, r32 = lane & 31, hi = lane >> 5;
        const int len = (u.seq < 16) ? 2048 : 4096, base = (u.seq < 16) ? u.seq * 2048 : NTOK_P + (u.seq - 16) * 4096, NT = len / 64;
        const int m0 = base + u.qb * 256 + wid * 32;
        LAS bf16_t* sb = (LAS bf16_t*)(F.lds + at::LDS_OST + wid * 8192);
        LAS float* sf = (LAS float*)sb;
        if (u.kind == 0) {
            f32x16 q0, q1; float ls;
            { f32x16 p0, p1; const at::Src ks{H + (size_t)base * HP + HC_AK + u.head * 64, HP}, vs{H + (size_t)base * HP + HC_AV + u.head * 64, HP};
              at::stream<2, 4, 0>(F.lds, tid, H + (size_t)(m0 + r32) * HP + HC_AQ + u.head * 64, ks, ks, vs, NT, p0, p1, ls); at::normalise(F.lds, tid, p0, p1, ls);
#pragma unroll
              for (int r = 0; r < 16; ++r) { const int row = crow(r, hi); sf[row * 64 + r32] = p0[r]; sf[row * 64 + 32 + r32] = p1[r]; }
              AT_WAIT_BAR(0); }
            { const at::Src ks{H + (size_t)base * HP + HC_AK + u.head * 64 + 32, HP}, vs{H + (size_t)base * HP + HC_AV + u.head * 64, HP};
              at::stream<2, 4, 0>(F.lds, tid, H + (size_t)(m0 + r32) * HP + HC_AQ + u.head * 64 + 32, ks, ks, vs, NT, q0, q1, ls); at::normalise(F.lds, tid, q0, q1, ls); }
            float xa[16], xb[16];
#pragma unroll
            for (int r = 0; r < 16; ++r) { const int row = crow(r, hi); xa[r] = sf[row * 64 + r32] - lam * q0[r]; xb[r] = sf[row * 64 + 32 + r32] - lam * q1[r]; }
            LDS_WAIT();
            const float* sg = a.diff_subln + layer * 64; const float g0 = sg[r32] * (1.0f - lam_init), g1 = sg[32 + r32] * (1.0f - lam_init);
#pragma unroll
            for (int r = 0; r < 16; ++r) { const float x0 = xa[r], x1 = xb[r]; float ss = x0 * x0 + x1 * x1;
                ss += shx<1>(ss); ss += shx<2>(ss); ss += shx<4>(ss); ss += shx<8>(ss); ss += shx<16>(ss);
                const float rs = 1.0f / sqrtf(ss * (1.0f / 64.0f) + RMS_EPS); const int row = crow(r, hi);
                sb[row * 64 + r32] = (bf16_t)f2bf(x0 * rs * g0); sb[row * 64 + 32 + r32] = (bf16_t)f2bf(x1 * rs * g1); }
            LDS_WAIT();
#pragma unroll
            for (int it = 0; it < 4; ++it) { const int row = it * 8 + (lane >> 3), ch = lane & 7; *(u32x4*)(MIX + (size_t)(m0 + row) * DM + MIX_A + u.head * 64 + ch * 8) = *(const LAS u32x4*)(sb + row * 64 + ch * 8); }
        } else {
            f32x16 p0, p1; float ls;
            const at::Src k0{KVB + (size_t)base * KVP + u.head * 128, KVP}, k1{H + (size_t)base * HP + HC_KROPE, HP}, vs{KVB + (size_t)base * KVP + u.head * 128 + 64, KVP};
            at::stream<6, 8, 4>(F.lds, tid, QB + (size_t)(m0 + r32) * QBP + u.head * 96, k0, k1, vs, NT, p0, p1, ls); at::normalise(F.lds, tid, p0, p1, ls);
#pragma unroll
            for (int r = 0; r < 16; ++r) { const int row = crow(r, hi); sb[row * 64 + r32] = (bf16_t)f2bf(p0[r]); sb[row * 64 + 32 + r32] = (bf16_t)f2bf(p1[r]); }
            LDS_WAIT();
#pragma unroll
            for (int it = 0; it < 4; ++it) { const int row = it * 8 + (lane >> 3), ch = lane & 7; *(u32x4*)(MIX + (size_t)(m0 + row) * DM + MIX_B + u.head * 64 + ch * 8) = *(const LAS u32x4*)(sb + row * 64 + ch * 8); }
        }
        AT_WAIT_BAR(0);
    }
}

struct ListRows { const int* list; int seg0, cnt; __device__ __forceinline__ int src(int m) const { const int r = m - seg0; return (r < cnt) ? (list[r] >> 1) : 0; } };
__device__ __forceinline__ void moe_segments(Frame& F, int layer, LAS int* seg) {
    if (F.tid == 0) { int acc = 0; for (int e = 0; e < NEXP; ++e) { const int c = (int)__hip_atomic_load(F.ctl + CW_CNT + layer * 64 + e, RLX_AGENT); seg[e] = acc; seg[33 + e] = c; acc += (c + 255) & ~255; } seg[32] = acc; }
    __syncthreads();
}
__device__ __forceinline__ int seg_find(const LAS int* seg, int row) { int e = 0;
#pragma unroll
    for (int s = 16; s > 0; s >>= 1) if (seg[e + s] <= row) e += s;
    return e; }
__device__ __forceinline__ void moe_up_simple(Frame& F, int layer) {
    LAS int* seg = (LAS int*)(F.lds + RING_BYTES); moe_segments(F, layer, seg);
    const bf16_t* XB = (const bf16_t*)(F.ws + WS_XB); const bf16_t* W13 = (const bf16_t*)(F.ws + WS_W13); const int* list = (const int*)(F.ws + WS_LIST);
    const EpiHid E{(bf16_t*)(F.ws + WS_HID)};
    const int items = (seg[32] / 32) * 16;
    for (int it = F.gw; it < items; it += F.NGW) { const int mt = it >> 4, ct = it & 15, m0 = mt * 32, e = seg_find(seg, m0), c0 = ct * 32;
        const ListRows RM{list + (size_t)e * LIST_CAP, seg[e], seg[33 + e]};
        const bf16_t* Bg = W13 + (size_t)e * 1024 * 1024 + (size_t)((c0 >> 7) * 256 + (c0 & 127)) * 1024;
        sg_tile(XB, DM, Bg, Bg + (size_t)128 * 1024, 1024, 1024, m0, c0, E, RM, F.lane); }
    __syncthreads();
}
__device__ __forceinline__ void moe_down_simple(Frame& F, int layer) {
    LAS int* seg = (LAS int*)(F.lds + RING_BYTES); moe_segments(F, layer, seg);
    const bf16_t* HID = (const bf16_t*)(F.ws + WS_HID); const bf16_t* W2 = (const bf16_t*)(F.ws + WS_W2); const int* list = (const int*)(F.ws + WS_LIST);
    const int items = (seg[32] / 32) * 16;
    for (int it = F.gw; it < items; it += F.NGW) { const int mt = it >> 4, ct = it & 15, m0 = mt * 32, e = seg_find(seg, m0), c0 = ct * 64;
        const EpiY E{(bf16_t*)(F.ws + WS_YB), (const float*)(F.ws + WS_TW), list + (size_t)e * LIST_CAP, seg[e], seg[33 + e]};
        const bf16_t* B0 = W2 + (size_t)e * 1024 * 512 + (size_t)c0 * 512;
        sg_tile(HID, DEXP, B0, B0 + (size_t)32 * 512, 512, 512, m0, c0, E, IdRows(), F.lane); }
    __syncthreads();
}


struct MoeUpSched {
    const char* XB; const char* W13; const LAS int* seg; const int* list; int nM, G, c;
    __device__ __forceinline__ bool next(int i, pg8::Unit& u) const { if (!pg8::order_next(i, G, c, nM, 4, u.pm, u.pn)) return false; u.e = __builtin_amdgcn_readfirstlane(seg_find(seg, u.pm * 256)); u.a = XB; u.b = W13 + ((size_t)u.e * 1024 + (size_t)u.pn * 256) * 2048; return true; }
    __device__ __forceinline__ unsigned arow(const pg8::Unit& u, int r) const { const int rr = u.pm * 256 + r - __builtin_amdgcn_readfirstlane(seg[u.e]); return (rr < __builtin_amdgcn_readfirstlane(seg[33 + u.e])) ? (unsigned)(list[(size_t)u.e * LIST_CAP + rr] >> 1) : 0u; }
};
struct MoeDownSched {
    const char* HID; const char* W2; const LAS int* seg; int nM, G, c;
    __device__ __forceinline__ bool next(int i, pg8::Unit& u) const { if (!pg8::order_next(i, G, c, nM, 4, u.pm, u.pn)) return false; u.e = __builtin_amdgcn_readfirstlane(seg_find(seg, u.pm * 256)); u.a = HID + (size_t)u.pm * 256 * DEXP * 2; u.b = W2 + ((size_t)u.e * 1024 + (size_t)u.pn * 256) * 1024; return true; }
    __device__ __forceinline__ unsigned arow(const pg8::Unit&, int) const { return 0u; }
};
__device__ __forceinline__ void moe_up_opt(Frame& F, int layer) {
    LAS int* seg = (LAS int*)(F.lds + RING_BYTES); moe_segments(F, layer, seg);
    const MoeUpSched S{(const char*)(F.ws + WS_XB), (const char*)(F.ws + WS_W13), seg, (const int*)(F.ws + WS_LIST), __builtin_amdgcn_readfirstlane(seg[32]) / 256, F.G, F.bid};
    const EpiHid E{(bf16_t*)(F.ws + WS_HID)};
    pg8::gemm_phase<EpiHid, MoeUpSched, true, true>(F.lds, F.tid, 1024, DM, S, E);
    __syncthreads();
}
__device__ __forceinline__ void moe_down_opt(Frame& F, int layer) {
    LAS int* seg = (LAS int*)(F.lds + RING_BYTES); moe_segments(F, layer, seg);
    const MoeDownSched S{(const char*)(F.ws + WS_HID), (const char*)(F.ws + WS_W2), seg, __builtin_amdgcn_readfirstlane(seg[32]) / 256, F.G, F.bid};
    const EpiYO E{(bf16_t*)(F.ws + WS_YB), (const float*)(F.ws + WS_TW), (const int*)(F.ws + WS_LIST), seg};
    pg8::gemm_phase<EpiYO, MoeDownSched, false, false>(F.lds, F.tid, DEXP, DEXP, S, E);
    __syncthreads();
}
template <class Epi>
__device__ __forceinline__ void pg_phase(Frame& F, const bf16_t* A, int lda, const bf16_t* Bt, int panel, int N, int K, const Epi& E) {
    pg8::PanelSched S; S.init(A, lda, Bt, panel, N, K);
    pg8::gemm_phase<Epi, pg8::PanelSched, false, false>(F.lds, F.tid, K, lda, S, E);
}
__device__ __forceinline__ void local_sync(Frame& F) {
    asm volatile("s_waitcnt vmcnt(0) lgkmcnt(0)" ::: "memory");
    __syncthreads();
    if (F.tid == 0) { __builtin_amdgcn_fence(__ATOMIC_ACQUIRE, "agent"); asm volatile("s_waitcnt vmcnt(0)" ::: "memory"); }
    __syncthreads();
}
template <class Epi>
__device__ __forceinline__ void og_phase(Frame& F, const bf16_t* A, int lda, const bf16_t* Bt, int M, int N, int K, const Epi& E) {
    pg8::DenseSched S; S.init(A, lda, Bt, M, N, K, F.G, F.bid);
    pg8::gemm_phase<Epi, pg8::DenseSched, false, false>(F.lds, F.tid, K, lda, S, E);
}

#ifndef PANEL_PROG
#define PANEL_PROG 1
#endif
#if PANEL_PROG
constexpr int PH_PER_LAYER = 6, N_PHASES = 2 + DEPTH * PH_PER_LAYER;
#else
constexpr int PH_PER_LAYER = 9, N_PHASES = 1 + DEPTH * PH_PER_LAYER;
#endif
__global__ void __launch_bounds__(NTHREADS, 2) fwd(Args args) {
    extern __shared__ __attribute__((aligned(16))) unsigned char lds[];
    Frame F;
    F.lds = (LAS unsigned char*)lds; F.ldsg = lds;
    F.tid = threadIdx.x; F.lane = F.tid & 63; F.wave = __builtin_amdgcn_readfirstlane(F.tid >> 6);
    F.G = gridDim.x; F.bid = blockIdx.x; F.gw = blockIdx.x * NWAVES + F.wave; F.NGW = F.G * NWAVES;
    F.ws = args.ws; F.ctl = (gu32*)(args.ws + WS_CTL);
    volatile LAS unsigned* MISC = (volatile LAS unsigned*)(F.lds + MISC_OFF);
    for (int u = F.tid; u < (LDS_BYTES - RING_BYTES) / 4; u += NTHREADS) ((LAS unsigned*)(F.lds + RING_BYTES))[u] = 0u;
    __syncthreads();
    XcdBarrier bar; bar.bar = (unsigned*)(F.ctl + CW_BAR); bar.x = 0; bar.st = nullptr;
    if (args.use_bar) bar = xcd_barrier_post((unsigned*)(F.ctl + CW_BAR), MISC + 8);
    const int lo = args.ph_lo, hi = args.ph_hi;
#ifndef PH_MASK
#define PH_MASK 0x3ff
#endif
#define IN(k) (lo <= (k) && (k) < hi && (launder(F), true))
#define SEAM(k) do { if (lo <= (k) && (k) + 1 < hi) xcd_barrier(bar); } while (0)
    if ((PH_MASK & 1) && IN(0)) { p0_prologue(F, args);
#ifdef PROBE_DUP_P0
        launder(F); p0_prologue(F, args);
#endif
    }
    SEAM(0);
#if PANEL_PROG
    for (int layer = 0; layer < DEPTH; ++layer) {
        const int pb = 1 + layer * PH_PER_LAYER;
        if (IN(pb + 0)) {
            for (int panel = F.bid; panel < NTOK / 256; panel += F.G) {
                const int r0 = panel * 256;
                if (layer > 0) { ln2_pass(F, args, layer - 1, r0 + F.wave, NWAVES, r0 + 256); local_sync(F); launder(F); }
                { bf16_t* H = (bf16_t*)(F.ws + WS_H); const EpiH E{H, (const float2*)(F.ws + WS_ROPE32), (const float2*)(F.ws + WS_ROPE64)};
                  pg_phase(F, (const bf16_t*)(F.ws + WS_XB), DM, (const bf16_t*)(F.ws + WS_WIN) + (size_t)layer * 2560 * 1024, panel, 2560, 1024, E); }
                local_sync(F); launder(F);
                rowstat_pass(F, r0 + F.wave, NWAVES, r0 + 256);
                local_sync(F); launder(F);
                { bf16_t* H = (bf16_t*)(F.ws + WS_H); const EpiUQ Eq{(bf16_t*)(F.ws + WS_QB), (const float*)(F.ws + WS_RSTD), (const float2*)(F.ws + WS_ROPE32)};
                  pg_phase(F, H + HC_CQ_LAT, HP, (const bf16_t*)(F.ws + WS_WUQ) + (size_t)layer * 768 * 256, panel, 768, 256, Eq); }
                launder(F);
                { bf16_t* H = (bf16_t*)(F.ws + WS_H); const EpiUKV Ek{(bf16_t*)(F.ws + WS_KVB), (const float*)(F.ws + WS_RSTD)};
                  pg_phase(F, H + HC_CKV, HP, (const bf16_t*)(F.ws + WS_WUKV) + (size_t)layer * 768 * 256, panel, 768, 256, Ek); }
                launder(F);
            }
        }
        SEAM(pb + 0);
        if (IN(pb + 1)) { cstat_phase(F); }
        SEAM(pb + 1);
        if (IN(pb + 2)) { attn_ab_phase(F, args, layer); launder(F); sattn_phase(F, args, layer, 10); }
        SEAM(pb + 2);
        if (IN(pb + 3)) {
            for (int panel = F.bid; panel < NTOK / 256; panel += F.G) {
                const int r0 = panel * 256;
                { const EpiRes E{args.out, layer == 0 ? args.x_prompt : nullptr, args.x_sample, args.out};
                  pg_phase(F, (const bf16_t*)(F.ws + WS_MIX), DM, (const bf16_t*)(F.ws + WS_WOUT) + (size_t)layer * 1024 * 1024, panel, 1024, 1024, E); }
                local_sync(F); launder(F);
                ln1_route_pass(F, args, layer, r0 + F.wave, NWAVES, r0 + 256);
                launder(F);
            }
            moe_convert(F, args, layer);
        }
        SEAM(pb + 3);
        if (IN(pb + 4)) { moe_up_opt(F, layer);
#ifdef PROBE_DUP_MOE
            launder(F); moe_up_opt(F, layer);
#endif
        }
        SEAM(pb + 4);
        if (IN(pb + 5)) { moe_down_opt(F, layer);
#ifdef PROBE_DUP_MOE
            launder(F); moe_down_opt(F, layer);
#endif
        }
        SEAM(pb + 5);
    }
    if (IN(1 + DEPTH * PH_PER_LAYER)) { ln2_pass(F, args, DEPTH - 1, F.gw, F.NGW, NTOK); }
#else
    for (int layer = 0; layer < DEPTH; ++layer) {
        const int pb = 1 + layer * PH_PER_LAYER;
        if ((PH_MASK & (2 << 0)) && IN(pb + 0)) {   bf16_t* H = (bf16_t*)(F.ws + WS_H);
            const EpiH E{H, (const float2*)(F.ws + WS_ROPE32), (const float2*)(F.ws + WS_ROPE64)};
#if OPT_GEMM
            og_phase(F, (const bf16_t*)(F.ws + WS_XB), DM, (const bf16_t*)(F.ws + WS_WIN) + (size_t)layer * 2560 * 1024, NTOK, 2560, 1024, E);
#ifdef PROBE_DUP_GEMM
            launder(F); og_phase(F, (const bf16_t*)(F.ws + WS_XB), DM, (const bf16_t*)(F.ws + WS_WIN) + (size_t)layer * 2560 * 1024, NTOK, 2560, 1024, E);
#endif
#else
            sg_phase(F, (const bf16_t*)(F.ws + WS_XB), DM, (const bf16_t*)(F.ws + WS_WIN) + (size_t)layer * 2560 * 1024, 1024, NTOK, 2560, 1024, E);
#endif
        }
        SEAM(pb + 0);
        if ((PH_MASK & (2 << 1)) && IN(pb + 1)) { rowstat_pass(F, F.gw, F.NGW, NTOK); cstat_phase(F);
#ifdef PROBE_DUP_CSTAT
            launder(F); rowstat_pass(F, F.gw, F.NGW, NTOK); cstat_phase(F);
#endif
        }
        SEAM(pb + 1);
        if ((PH_MASK & (2 << 2)) && IN(pb + 2)) {
            bf16_t* H = (bf16_t*)(F.ws + WS_H);
            const EpiUQ Eq{(bf16_t*)(F.ws + WS_QB), (const float*)(F.ws + WS_RSTD), (const float2*)(F.ws + WS_ROPE32)};
#if OPT_GEMM
            og_phase(F, H + HC_CQ_LAT, HP, (const bf16_t*)(F.ws + WS_WUQ) + (size_t)layer * 768 * 256, NTOK, 768, 256, Eq);
            launder(F);
#else
            sg_phase(F, H + HC_CQ_LAT, HP, (const bf16_t*)(F.ws + WS_WUQ) + (size_t)layer * 768 * 256, 256, NTOK, 768, 256, Eq);
#endif
            const EpiUKV Ek{(bf16_t*)(F.ws + WS_KVB), (const float*)(F.ws + WS_RSTD)};
#if OPT_GEMM
            og_phase(F, H + HC_CKV, HP, (const bf16_t*)(F.ws + WS_WUKV) + (size_t)layer * 768 * 256, NTOK, 768, 256, Ek);
#ifdef PROBE_DUP_UP
            launder(F); og_phase(F, H + HC_CQ_LAT, HP, (const bf16_t*)(F.ws + WS_WUQ) + (size_t)layer * 768 * 256, NTOK, 768, 256, Eq);
            launder(F); og_phase(F, H + HC_CKV, HP, (const bf16_t*)(F.ws + WS_WUKV) + (size_t)layer * 768 * 256, NTOK, 768, 256, Ek);
#endif
#else
            sg_phase(F, H + HC_CKV, HP, (const bf16_t*)(F.ws + WS_WUKV) + (size_t)layer * 768 * 256, 256, NTOK, 768, 256, Ek);
#endif
        }
        SEAM(pb + 2);
        if ((PH_MASK & (2 << 3)) && IN(pb + 3)) {
#if OPT_ATTN
            attn_ab_phase(F, args, layer); launder(F);
#ifdef PROBE_DUP_ATTN
            attn_ab_phase(F, args, layer, PROBE_DUP_ATTN); launder(F);
#endif
            sattn_phase(F, args, layer, 10);
#ifdef PROBE_DUP_CFIN
            launder(F); sattn_phase(F, args, layer, 10);
#endif
#else
            sattn_phase(F, args, layer, 0);
#endif
        }
        SEAM(pb + 3);
        if ((PH_MASK & (2 << 4)) && IN(pb + 4)) {
#ifdef PROBE_DUP_WOUT
            { const EpiRes E0{args.out, layer == 0 ? args.x_prompt : nullptr, args.x_sample, (float*)(F.ws + WS_H)};
              og_phase(F, (const bf16_t*)(F.ws + WS_MIX), DM, (const bf16_t*)(F.ws + WS_WOUT) + (size_t)layer * 1024 * 1024, NTOK, 1024, 1024, E0); launder(F); }
#endif
            const EpiRes E{args.out, layer == 0 ? args.x_prompt : nullptr, args.x_sample, args.out};
#if OPT_GEMM
            og_phase(F, (const bf16_t*)(F.ws + WS_MIX), DM, (const bf16_t*)(F.ws + WS_WOUT) + (size_t)layer * 1024 * 1024, NTOK, 1024, 1024, E);
#else
            sg_phase(F, (const bf16_t*)(F.ws + WS_MIX), DM, (const bf16_t*)(F.ws + WS_WOUT) + (size_t)layer * 1024 * 1024, 1024, NTOK, 1024, 1024, E);
#endif
        }
        SEAM(pb + 4);
        if ((PH_MASK & (2 << 5)) && IN(pb + 5)) {
#ifdef PROBE_DUP_LN1
#endif
            ln1_route_pass(F, args, layer, F.gw, F.NGW, NTOK); moe_convert(F, args, layer);
#ifdef PROBE_DUP_CONV
            launder(F); moe_convert(F, args, layer);
#endif
        }
        SEAM(pb + 5);
#if OPT_GEMM
        if ((PH_MASK & (2 << 6)) && IN(pb + 6)) { moe_up_opt(F, layer);
#ifdef PROBE_DUP_MOE
            launder(F); moe_up_opt(F, layer);
#endif
        }
#else
        if ((PH_MASK & (2 << 6)) && IN(pb + 6)) { moe_up_simple(F, layer); }
#endif
        SEAM(pb + 6);
#if OPT_GEMM
        if ((PH_MASK & (2 << 7)) && IN(pb + 7)) { moe_down_opt(F, layer);
#ifdef PROBE_DUP_MOE
            launder(F); moe_down_opt(F, layer);
#endif
        }
#else
        if ((PH_MASK & (2 << 7)) && IN(pb + 7)) { moe_down_simple(F, layer); }
#endif
        SEAM(pb + 7);
        if ((PH_MASK & (2 << 8)) && IN(pb + 8)) { ln2_pass(F, args, layer, F.gw, F.NGW, NTOK); }
        SEAM(pb + 8);
    }
#endif
#undef IN
#undef SEAM
}

extern "C" void kernel_launch(void* const* d_in, const int* in_sizes, int n_in, void* d_out, int out_size, void* d_ws, size_t ws_size, hipStream_t stream) {
    static int grid = 0;
    if (grid == 0) {
        if (n_in != 19 || out_size != NTOK * DM || ws_size < WS_END) { fprintf(stderr, "kernel_launch: unexpected shapes (n_in %d out %d ws %zu)\n", n_in, out_size, ws_size); grid = -1; return; }
        int dev = 0, cus = 0, per_cu = 0;
        if (hipGetDevice(&dev) != hipSuccess || hipDeviceGetAttribute(&cus, hipDeviceAttributeMultiprocessorCount, dev) != hipSuccess) { grid = -1; return; }
        if (hipFuncSetAttribute((const void*)fwd, hipFuncAttributeMaxDynamicSharedMemorySize, LDS_BYTES) != hipSuccess) { grid = -1; return; }
        if (hipOccupancyMaxActiveBlocksPerMultiprocessor(&per_cu, (const void*)fwd, NTHREADS, LDS_BYTES) != hipSuccess || per_cu < 1) { fprintf(stderr, "kernel_launch: occupancy query says %d\n", per_cu); }
        (void)hipGetLastError();
        grid = cus;
    }
    if (grid < 0) return;
    if (hipMemsetAsync((char*)d_ws + WS_CTL, 0, CTL_ZERO_BYTES, stream) != hipSuccess) return;
    Args a{};
    a.x_prompt = (const float*)d_in[0]; a.x_sample = (const float*)d_in[1]; a.w_in = (const float*)d_in[2]; a.diff_lambda = (const float*)d_in[3]; a.diff_subln = (const float*)d_in[4];
    a.mla_q_norm = (const float*)d_in[5]; a.mla_w_uq = (const float*)d_in[6]; a.mla_kv_norm = (const float*)d_in[7]; a.mla_w_ukv = (const float*)d_in[8]; a.w_out = (const float*)d_in[9];
    a.ln1_g = (const float*)d_in[10]; a.ln1_b = (const float*)d_in[11]; a.moe_w_coarse = (const float*)d_in[12]; a.moe_w_fine = (const float*)d_in[13];
    a.moe_w1 = (const float*)d_in[14]; a.moe_w3 = (const float*)d_in[15]; a.moe_w2 = (const float*)d_in[16]; a.ln2_g = (const float*)d_in[17]; a.ln2_b = (const float*)d_in[18];
    a.out = (float*)d_out; a.ws = (unsigned char*)d_ws; a.pad = 0;
#if MK_ONE_LAUNCH
    a.ph_lo = 0; a.ph_hi = N_PHASES; a.use_bar = 1;
    hipLaunchKernelGGL(fwd, dim3(grid), dim3(NTHREADS), LDS_BYTES, stream, a);
#else
    for (int p = 0; p < N_PHASES; ++p) { a.ph_lo = p; a.ph_hi = p + 1; a.use_bar = 0; hipLaunchKernelGGL(fwd, dim3(grid), dim3(NTHREADS), LDS_BYTES, stream, a); }
#endif
}
```

```cpp
#include <hip/hip_runtime.h>
#include <cstdio>
#include <cstdint>

#ifndef OPT_ATTN
#define OPT_ATTN 1
#endif
#ifndef OPT_GEMM
#define OPT_GEMM 1
#endif
#ifndef MK_ONE_LAUNCH
#define MK_ONE_LAUNCH 1
#endif

#define GAS __attribute__((address_space(1)))
#define LAS __attribute__((address_space(3)))
typedef unsigned short bf16_t;
typedef short bf16x8 __attribute__((ext_vector_type(8)));
typedef float f32x4 __attribute__((ext_vector_type(4)));
typedef float f32x2 __attribute__((ext_vector_type(2)));
typedef float f32x16 __attribute__((ext_vector_type(16)));
typedef unsigned u32x4 __attribute__((ext_vector_type(4)));
typedef unsigned u32x2 __attribute__((ext_vector_type(2)));
typedef GAS unsigned gu32;
#define RLX_AGENT __ATOMIC_RELAXED, __HIP_MEMORY_SCOPE_AGENT
#define LDS_WAIT() asm volatile("s_waitcnt lgkmcnt(0)" ::: "memory")
#define VM_WAIT() asm volatile("s_waitcnt vmcnt(0)" ::: "memory")
#define MFMA32(a, b, c) __builtin_amdgcn_mfma_f32_32x32x16_bf16(a, b, c, 0, 0, 0)

__device__ __forceinline__ unsigned f2bf(float f) { unsigned u = __builtin_bit_cast(unsigned, f); return (u + 0x7fffu + ((u >> 16) & 1u)) >> 16; }
__device__ __forceinline__ unsigned pk2(float lo, float hi) { return f2bf(lo) | (f2bf(hi) << 16); }
__device__ __forceinline__ float bf2f(unsigned short b) { return __builtin_bit_cast(float, (unsigned)b << 16); }
__device__ __forceinline__ int crow(int r, int hi) { return (r & 3) + 8 * (r >> 2) + 4 * hi; }
template <int K> __device__ __forceinline__ float shx(float v) { static_assert(K < 32, "xor 32: use xsum32 / xmax32 / xpair32"); return __uint_as_float((unsigned)__builtin_amdgcn_ds_swizzle((int)__float_as_uint(v), (K << 10) | 0x1f)); }
__device__ __forceinline__ float xsum32(float v) { auto rr = __builtin_amdgcn_permlane32_swap(__float_as_uint(v), __float_as_uint(v), false, false); return __uint_as_float(rr[0]) + __uint_as_float(rr[1]); }
__device__ __forceinline__ float xmax32(float v) { auto rr = __builtin_amdgcn_permlane32_swap(__float_as_uint(v), __float_as_uint(v), false, false); return fmaxf(__uint_as_float(rr[0]), __uint_as_float(rr[1])); }
__device__ __forceinline__ float xpair32(float lo, float hi) { auto rr = __builtin_amdgcn_permlane32_swap(__float_as_uint(lo), __float_as_uint(hi), false, false); return __uint_as_float(rr[0]) + __uint_as_float(rr[1]); }
__device__ __forceinline__ float wave_sum(float v) {
    v += shx<1>(v); v += shx<2>(v); v += shx<4>(v); v += shx<8>(v); v += shx<16>(v);
    return xsum32(v);
}
__device__ __forceinline__ float fast_exp2(float x) { return __builtin_amdgcn_exp2f(x); }

constexpr int NTOK = 65536, DM = 1024, DEPTH = 4;
constexpr int NTOK_P = 32768;
constexpr int HP = 2560;
constexpr int HC_AQ = 0, HC_AK = 256, HC_AV = 512, HC_CQ_LAT = 768, HC_CKV = 1024, HC_KROPE = 1152, HC_CQ = 1280, HC_CK = 1664, HC_CV = 2048;
constexpr int QBP = 768, KVP = 768;
constexpr int MIX_A = 0, MIX_B = 256, MIX_C = 640;
constexpr int NEXP = 32, DEXP = 512;
constexpr float LOG2E = 1.4426950408889634f;
constexpr float SC_A = 0.17677669529663687f * LOG2E;
constexpr float SC_B = 0.10206207261596575f * LOG2E;
constexpr float SC_C = 0.125f * LOG2E;
constexpr float DN_ALPHA = 1.681792830507429f;
constexpr float LN_EPS = 1e-5f, RMS_EPS = 1e-6f;

constexpr size_t MiB = 1u << 20;
constexpr size_t WS_CTL = 0, CTL_ZERO_BYTES = 64 * 1024;
constexpr size_t WS_ROPE32 = 4 * MiB;
constexpr size_t WS_ROPE64 = 5 * MiB;
constexpr size_t WS_WIN = 8 * MiB;
constexpr size_t WS_WOUT = 28 * MiB;
constexpr size_t WS_WUQ = 36 * MiB;
constexpr size_t WS_WUKV = 38 * MiB;
constexpr size_t WS_W13 = 40 * MiB;
constexpr size_t WS_W2 = 104 * MiB;
constexpr size_t WS_XB = 136 * MiB;
constexpr size_t WS_H = 264 * MiB;
constexpr size_t WS_QB = 584 * MiB;
constexpr size_t WS_KVB = 680 * MiB;
constexpr size_t WS_MIX = 776 * MiB;
constexpr size_t WS_RSTD = 904 * MiB;
constexpr size_t WS_LSEC = 905 * MiB;
constexpr size_t WS_TW = 907 * MiB;
constexpr size_t WS_LIST = 908 * MiB;
constexpr size_t WS_END = 924 * MiB;
constexpr size_t WS_HID = WS_H;
constexpr size_t WS_YB = WS_H + 136 * MiB;
static_assert(WS_YB + 256 * MiB <= WS_KVB + 96 * MiB, "YB overlay");
constexpr int LIST_CAP = 131072;
constexpr int CW_TMO = 0;
constexpr int CW_CNT = 64;
constexpr int CW_BAR = 4096;

constexpr int RING_BYTES = 131072;
constexpr int MISC_OFF = RING_BYTES + 320;
constexpr int LDS_BYTES = 147456;
constexpr int NWAVES = 8, NTHREADS = 512;

#define XB_TMO      128
#define XB_XCNT(j)  (256  + 64 * (j))
#define XB_XSUB(j)  (1280 + 64 * (j))
#define XB_XGEN(j)  (2304 + 64 * (j))
#define XB_TOP      3328
#define XB_TOPGEN   3392
#define XCD_BAR_WORDS 3456
#define XB_SPIN_CAP (1u << 22)
__device__ __forceinline__ unsigned xb_ld(unsigned* p)              { return __hip_atomic_load(p, __ATOMIC_RELAXED, __HIP_MEMORY_SCOPE_AGENT); }
__device__ __forceinline__ unsigned xb_add(unsigned* p, unsigned v) { return __hip_atomic_fetch_add(p, v, __ATOMIC_RELAXED, __HIP_MEMORY_SCOPE_AGENT); }
__device__ __forceinline__ unsigned xb_xcc_id() { return (unsigned)__builtin_amdgcn_s_getreg((3 << 11) | 20) & 0xFu; }
#define XB_SPIN(cond, bar) do { unsigned _sp = 0; while (cond) { __builtin_amdgcn_s_sleep(1); \
    if ((++_sp & 255u) == 0u) { if (xb_ld(&(bar)[XB_TMO])) break; if (_sp > XB_SPIN_CAP) { atomicAdd(&(bar)[XB_TMO], 1u); break; } } } } while (0)
struct XcdBarrier { unsigned* bar; unsigned x; volatile LAS unsigned* st; };
__device__ __forceinline__ XcdBarrier xcd_barrier_post(unsigned* bar, volatile LAS unsigned* st) {
    XcdBarrier b; b.bar = bar; b.x = xb_xcc_id(); b.st = st;
    if (threadIdx.x == 0) (void)xb_add(&bar[XB_XCNT(b.x)], 1u);
    return b;
}
__device__ __forceinline__ void xcd_barrier_complete(unsigned* bar, unsigned x, unsigned& nloc, unsigned& nx) {
    const unsigned G = gridDim.x * gridDim.y * gridDim.z;
    unsigned sum, cnt, mine, sp = 0u;
    for (;;) {
        sum = 0u; cnt = 0u; mine = 0u;
#pragma unroll
        for (unsigned j = 0; j < 16; ++j) { const unsigned c = xb_ld(&bar[XB_XCNT(j)]); sum += c; cnt += (c > 0u) ? 1u : 0u; mine = (j == x) ? c : mine; }
        if (sum == G) break;
        __builtin_amdgcn_s_sleep(1);
        if ((++sp & 255u) == 0u) { if (xb_ld(&bar[XB_TMO])) break; if (sp > XB_SPIN_CAP) { atomicAdd(&bar[XB_TMO], 1u); break; } }
    }
    nloc = mine > 0u ? mine : 1u; nx = cnt > 0u ? cnt : 1u;
}
__device__ __forceinline__ void xcd_barrier(const XcdBarrier& b) {
    asm volatile("s_waitcnt vmcnt(0)" ::: "memory");
    __syncthreads();
    if (threadIdx.x == 0) {
        unsigned* bar = b.bar;
        __builtin_amdgcn_s_waitcnt(0);
        unsigned nloc = b.st[0], nx = b.st[1];
        if (nloc == 0u) { xcd_barrier_complete(bar, b.x, nloc, nx); b.st[0] = nloc; b.st[1] = nx; }
        const unsigned old = xb_add(&bar[XB_XSUB(b.x)], 1u);
        const unsigned gen = old / nloc;
        if (old + 1u == (gen + 1u) * nloc) {
            __builtin_amdgcn_fence(__ATOMIC_RELEASE, "agent");
            asm volatile("s_waitcnt vmcnt(0)" ::: "memory");
            const unsigned og = xb_add(&bar[XB_TOP], 1u);
            const unsigned tg = og / nx;
            if (og + 1u == (tg + 1u) * nx) xb_add(&bar[XB_TOPGEN], 1u);
            else XB_SPIN(xb_ld(&bar[XB_TOPGEN]) == tg, bar);
            __builtin_amdgcn_fence(__ATOMIC_ACQUIRE, "agent");
            xb_add(&bar[XB_XGEN(b.x)], 1u);
            asm volatile("s_waitcnt vmcnt(0)" ::: "memory");
        } else {
            XB_SPIN(xb_ld(&bar[XB_XGEN(b.x)]) == gen, bar);
            __builtin_amdgcn_fence(__ATOMIC_ACQUIRE, "agent");
            asm volatile("s_waitcnt vmcnt(0)" ::: "memory");
        }
    }
    __syncthreads();
}

struct Args {
    const float* x_prompt; const float* x_sample; const float* w_in; const float* diff_lambda; const float* diff_subln; const float* mla_q_norm; const float* mla_w_uq;
    const float* mla_kv_norm; const float* mla_w_ukv; const float* w_out; const float* ln1_g; const float* ln1_b; const float* moe_w_coarse; const float* moe_w_fine;
    const float* moe_w1; const float* moe_w3; const float* moe_w2; const float* ln2_g; const float* ln2_b;
    float* out; unsigned char* ws; int ph_lo, ph_hi, use_bar, pad;
};
struct Frame {
    LAS unsigned char* lds; unsigned char* ldsg;
    int tid, lane, wave, G, gw, NGW, bid;
    gu32* ctl; unsigned char* ws;
};
__device__ __forceinline__ void launder(Frame& F) {
    int wv = F.wave; asm volatile("" : "+s"(wv)); F.wave = wv;
    int t; asm volatile("v_mbcnt_lo_u32_b32 %0, -1, 0\n\tv_mbcnt_hi_u32_b32 %0, -1, %0" : "=v"(t)); F.lane = t; F.tid = wv * 64 + t;
    int b = (int)blockIdx.x; asm volatile("" : "+s"(b)); F.bid = b; F.gw = b * NWAVES + F.wave;
    unsigned char* w = F.ws; asm volatile("" : "+s"(w)); F.ws = w; F.ctl = (gu32*)(w + WS_CTL);
}
struct SeqInfo { int base, len, pos; };
__device__ __forceinline__ SeqInfo seqinfo(int m) { SeqInfo s; if (m < NTOK_P) { s.base = m & ~2047; s.len = 2048; } else { s.base = m & ~4095; s.len = 4096; } s.pos = m - s.base; return s; }

template <class ColMap>
__device__ __forceinline__ void transpose_item(const float* W, int N, bf16_t* WT, int ldd, LAS float* scr, int k0, int n0, const ColMap& cm, const float* kscale, int lane) {
    const int sc = cm(n0 + (lane & 31));
#pragma unroll 8
    for (int i = 0; i < 32; ++i) { const int kk = 2 * i + (lane >> 5); float v = 0.f; if (sc >= 0) { v = W[(size_t)(k0 + kk) * N + sc]; if (kscale) v *= kscale[k0 + kk]; } scr[kk * 33 + (lane & 31)] = v; }
    LDS_WAIT(); asm volatile("" ::: "memory");
    const int c = lane & 7;
#pragma unroll
    for (int j = 0; j < 4; ++j) { const int n = (lane >> 3) + 8 * j; const LAS float* s = scr + (8 * c) * 33 + n;
        u32x4 o; o.x = pk2(s[0 * 33], s[1 * 33]); o.y = pk2(s[2 * 33], s[3 * 33]); o.z = pk2(s[4 * 33], s[5 * 33]); o.w = pk2(s[6 * 33], s[7 * 33]);
        *(u32x4*)(WT + (size_t)(n0 + n) * ldd + k0 + 8 * c) = o; }
    LDS_WAIT(); asm volatile("" ::: "memory");
}
__device__ __forceinline__ void transpose_item_v4(const float* Wsrc, int N, bf16_t* WTdst, int ldd, LAS float* scr, int lane) {
    const int c4 = (lane & 7) * 4, kr = lane >> 3;
    f32x4 t[8];
#pragma unroll
    for (int i = 0; i < 8; ++i) t[i] = *(const f32x4*)(Wsrc + (size_t)(i * 8 + kr) * N + c4);
#pragma unroll
    for (int i = 0; i < 8; ++i) { const int kk = i * 8 + kr; scr[(c4 + 0) * 65 + kk] = t[i].x; scr[(c4 + 1) * 65 + kk] = t[i].y; scr[(c4 + 2) * 65 + kk] = t[i].z; scr[(c4 + 3) * 65 + kk] = t[i].w; }
    LDS_WAIT(); asm volatile("" ::: "memory");
    const int c = lane & 7;
#pragma unroll
    for (int j = 0; j < 4; ++j) { const int n = (lane >> 3) + 8 * j; const LAS float* p = scr + n * 65 + 8 * c;
        u32x4 o; o.x = pk2(p[0], p[1]); o.y = pk2(p[2], p[3]); o.z = pk2(p[4], p[5]); o.w = pk2(p[6], p[7]);
        *(u32x4*)(WTdst + (size_t)n * ldd + 8 * c) = o; }
    LDS_WAIT(); asm volatile("" ::: "memory");
}
struct WinMap {
    __device__ __forceinline__ int operator()(int n) const {
        if (n < 512) { const int t = n & 31; return (n & ~31) + (t >> 1) + 16 * (t & 1); }
        if (n < 1152) return n;
        if (n < 1184) { const int t = n - 1152; return 1152 + (t >> 1) + 16 * (t & 1); }
        if (n < 1280) return -1;
        if (n < 2048) { const int u = n - 1280, t = u & 63; return 1184 + (u & ~63) + (t >> 1) + 32 * (t & 1); }
        if (n < 2432) return 1952 + (n - 2048);
        return -1;
    }
};
struct UqMap { __device__ __forceinline__ int operator()(int n) const { if (n >= 576) return -1; const int h = n / 96, t = n - 96 * h; if (t < 64) return n; const int u = t - 64; return 96 * h + 64 + (u >> 1) + 16 * (u & 1); } };
struct IdMap { __device__ __forceinline__ int operator()(int n) const { return n; } };
struct W13Map { __device__ __forceinline__ int operator()(int n) const { return (n >> 8) * 128 + (n & 127); } };

__device__ __forceinline__ void p0_prologue(Frame& F, const Args& a) {
    LAS float* scr = (LAS float*)(F.lds + F.wave * 16384);
    { float2* r32 = (float2*)(F.ws + WS_ROPE32); float2* r64 = (float2*)(F.ws + WS_ROPE64);
      for (int i = F.gw * 64 + F.lane; i < 4096 * 16; i += F.NGW * 64) { const int pos = i >> 4, j = i & 15; const float inv = 1.0f / powf(10000.0f, (float)(2 * j) / 32.0f); const float ang = (float)pos * inv; r32[i] = make_float2(cosf(ang), sinf(ang)); }
      for (int i = F.gw * 64 + F.lane; i < 4096 * 32; i += F.NGW * 64) { const int pos = i >> 5, j = i & 31; const float inv = 1.0f / powf(10000.0f, (float)(2 * j) / 64.0f); const float ang = (float)pos * inv; r64[i] = make_float2(cosf(ang), sinf(ang)); } }
    constexpr int I_WIN = (1024 / 64) * (2560 / 32), I_WOUT = (1024 / 64) * (1024 / 32), I_UQ = (256 / 64) * (768 / 32), I_UKV = (256 / 64) * (768 / 32);
    constexpr int PER_L = I_WIN + I_WOUT + I_UQ + I_UKV;
    for (int it = F.gw; it < DEPTH * PER_L; it += F.NGW) {
        const int l = it / PER_L; int r = it - l * PER_L;
        if (r < I_WIN) { const int kb = r / 80, nb = r % 80; transpose_item(a.w_in + (size_t)l * 1024 * 2336, 2336, (bf16_t*)(F.ws + WS_WIN) + (size_t)l * 2560 * 1024, 1024, scr, kb * 64, nb * 32, WinMap(), nullptr, F.lane); continue; } r -= I_WIN;
        if (r < I_WOUT) { const int kb = r / 32, nb = r % 32; transpose_item(a.w_out + (size_t)l * 1024 * 1024, 1024, (bf16_t*)(F.ws + WS_WOUT) + (size_t)l * 1024 * 1024, 1024, scr, kb * 64, nb * 32, IdMap(), nullptr, F.lane); continue; } r -= I_WOUT;
        if (r < I_UQ) { const int kb = r / 24, nb = r % 24; transpose_item(a.mla_w_uq + (size_t)l * 256 * 576, 576, (bf16_t*)(F.ws + WS_WUQ) + (size_t)l * 768 * 256, 256, scr, kb * 64, nb * 32, UqMap(), a.mla_q_norm + l * 256, F.lane); continue; } r -= I_UQ;
        { const int kb = r / 24, nb = r % 24; bf16_t* dst = (bf16_t*)(F.ws + WS_WUKV) + (size_t)l * 768 * 256;
          if (kb < 2) transpose_item(a.mla_w_ukv + (size_t)l * 128 * 768, 768, dst, 256, scr, kb * 64, nb * 32, IdMap(), a.mla_kv_norm + l * 128, F.lane);
          else { const int c = F.lane & 7;
#pragma unroll
              for (int j = 0; j < 4; ++j) { const int n = (F.lane >> 3) + 8 * j; *(u32x4*)(dst + (size_t)(nb * 32 + n) * 256 + kb * 64 + 8 * c) = (u32x4){0u, 0u, 0u, 0u}; } } }
    }
    bf16_t* XB = (bf16_t*)(F.ws + WS_XB);
    for (int m = F.gw; m < NTOK; m += F.NGW) {
        const float* src = (m < NTOK_P) ? a.x_prompt + (size_t)m * DM : a.x_sample + (size_t)(m - NTOK_P) * DM;
#pragma unroll
        for (int j = 0; j < 4; ++j) { const f32x4 v = *((const f32x4*)src + F.lane + 64 * j);
            u32x2 w; w.x = pk2(v.x, v.y); w.y = pk2(v.z, v.w); *((u32x2*)(XB + (size_t)m * DM) + F.lane + 64 * j) = w; }
    }
}

template <class Epi, class RowMap>
__device__ __forceinline__ void sg_tile(const bf16_t* A, int lda, const bf16_t* B0, const bf16_t* B1, int ldb, int K, int m0, int c0, const Epi& E, const RowMap& RM, int lane) {
    const int r32 = lane & 31, hi = lane >> 5;
    const bf16_t* ap = A + (size_t)RM.src(m0 + r32) * lda + 8 * hi;
    const bf16_t* b0p = B0 + (size_t)r32 * ldb + 8 * hi;
    const bf16_t* b1p = B1 + (size_t)r32 * ldb + 8 * hi;
    f32x16 acc0 = {}, acc1 = {};
#pragma unroll 4
    for (int k = 0; k < K; k += 16) {
        const bf16x8 af = *(const bf16x8*)(ap + k), bf0 = *(const bf16x8*)(b0p + k), bf1 = *(const bf16x8*)(b1p + k);
        acc0 = MFMA32(bf0, af, acc0); acc1 = MFMA32(bf1, af, acc1);
    }
#pragma unroll
    for (int g = 0; g < 4; ++g) { const f32x4 v0 = {acc0[4 * g], acc0[4 * g + 1], acc0[4 * g + 2], acc0[4 * g + 3]}, v1 = {acc1[4 * g], acc1[4 * g + 1], acc1[4 * g + 2], acc1[4 * g + 3]};
        E.put(m0 + r32, c0, 8 * g + 4 * hi, v0, v1); }
}
struct IdRows { __device__ __forceinline__ int src(int m) const { return m; } };

__device__ __forceinline__ void store_bf8(bf16_t* p, f32x4 a, f32x4 b) { u32x4 w; w.x = pk2(a.x, a.y); w.y = pk2(a.z, a.w); w.z = pk2(b.x, b.y); w.w = pk2(b.z, b.w); *(u32x4*)p = w; }
__device__ __forceinline__ void store_bf4(bf16_t* p, f32x4 v) { u32x2 w; w.x = pk2(v.x, v.y); w.y = pk2(v.z, v.w); *(u32x2*)p = w; }
struct EpiH {
    static constexpr bool PERM = true;
    bf16_t* H; const float2* rope32; const float2* rope64;
    __device__ __forceinline__ f32x4 xf(int pos, int col, f32x4 v) const {
        if (col < 512 || (col >= HC_KROPE && col < HC_KROPE + 32)) {
            const int j0 = (col & 31) >> 1; const f32x4 cs = *(const f32x4*)(rope32 + pos * 16 + j0);
            f32x4 o; o.x = v.x * cs.x - v.y * cs.y; o.y = v.x * cs.y + v.y * cs.x; o.z = v.z * cs.z - v.w * cs.w; o.w = v.z * cs.w + v.w * cs.z;
            if (col < 256) o = o * SC_A; v = o;
        } else if (col >= HC_CQ && col < HC_CV) {
            const int j0 = ((col - HC_CQ) & 63) >> 1; const f32x4 cs = *(const f32x4*)(rope64 + pos * 32 + j0);
            f32x4 o; o.x = v.x * cs.x - v.y * cs.y; o.y = v.x * cs.y + v.y * cs.x; o.z = v.z * cs.z - v.w * cs.w; o.w = v.z * cs.w + v.w * cs.z;
            if (col < HC_CK) o = o * SC_C; v = o;
        }
        return v;
    }
    __device__ __forceinline__ void put4(int row, int col, f32x4 v) const { store_bf4(H + (size_t)row * HP + col, xf(seqinfo(row).pos, col, v)); }
    __device__ __forceinline__ void put(int row, int c0, int cc, f32x4 v0, f32x4 v1) const { put4(row, c0 + cc, v0); put4(row, c0 + 32 + cc, v1); }
    template <class U> __device__ __forceinline__ void put8(const U&, int row, int col, f32x4 v0, f32x4 v1) const { const int pos = seqinfo(row).pos; store_bf8(H + (size_t)row * HP + col, xf(pos, col, v0), xf(pos, col + 4, v1)); }
    struct Pre { f32x4 c0, c1; };
    __device__ __forceinline__ static f32x4 rot(f32x4 v, f32x4 cs) { f32x4 o; o.x = v.x * cs.x - v.y * cs.y; o.y = v.x * cs.y + v.y * cs.x; o.z = v.z * cs.z - v.w * cs.w; o.w = v.z * cs.w + v.w * cs.z; return o; }
    template <class U> __device__ __forceinline__ Pre pre(const U&, int row, int col) const { Pre p; p.c0 = (f32x4){0.f, 0.f, 0.f, 0.f}; p.c1 = p.c0; const int pos = seqinfo(row).pos;
        if (col < 512 || (col >= HC_KROPE && col < HC_KROPE + 32)) { const f32x4* t = (const f32x4*)(rope32 + pos * 16 + ((col & 31) >> 1)); p.c0 = t[0]; p.c1 = t[1]; }
        else if (col >= HC_CQ && col < HC_CV) { const f32x4* t = (const f32x4*)(rope64 + pos * 32 + (((col - HC_CQ) & 63) >> 1)); p.c0 = t[0]; p.c1 = t[1]; }
        return p; }
    template <class U> __device__ __forceinline__ void fin8(const U&, int row, int col, f32x4 v0, f32x4 v1, const Pre& p) const {
        if (col < 512 || (col >= HC_KROPE && col < HC_KROPE + 32)) { v0 = rot(v0, p.c0); v1 = rot(v1, p.c1); if (col < 256) { v0 = v0 * SC_A; v1 = v1 * SC_A; } }
        else if (col >= HC_CQ && col < HC_CV) { v0 = rot(v0, p.c0); v1 = rot(v1, p.c1); if (col < HC_CK) { v0 = v0 * SC_C; v1 = v1 * SC_C; } }
        store_bf8(H + (size_t)row * HP + col, v0, v1); }
};
struct EpiUQ {
    static constexpr bool PERM = true;
    bf16_t* Q; const float* rstd; const float2* rope32;
    __device__ __forceinline__ f32x4 xf(int row, int col, f32x4 v, float rs) const {
        v = v * rs;
        const int t = col % 96;
        if (t >= 64) { const int pos = seqinfo(row).pos; const int j0 = (t - 64) >> 1; const f32x4 cs = *(const f32x4*)(rope32 + pos * 16 + j0);
            f32x4 o; o.x = v.x * cs.x - v.y * cs.y; o.y = v.x * cs.y + v.y * cs.x; o.z = v.z * cs.z - v.w * cs.w; o.w = v.z * cs.w + v.w * cs.z; v = o; }
        return v * SC_B;
    }
    __device__ __forceinline__ void put4(int row, int col, f32x4 v) const { if (col >= 576) return; store_bf4(Q + (size_t)row * QBP + col, xf(row, col, v, rstd[2 * row])); }
    template <class U> __device__ __forceinline__ void put8(const U&, int row, int col, f32x4 v0, f32x4 v1) const { if (col >= 576) return; const float rs = rstd[2 * row]; store_bf8(Q + (size_t)row * QBP + col, xf(row, col, v0, rs), xf(row, col + 4, v1, rs)); }
    __device__ __forceinline__ void put(int row, int c0, int cc, f32x4 v0, f32x4 v1) const { put4(row, c0 + cc, v0); put4(row, c0 + 32 + cc, v1); }
    struct Pre { float rs; f32x4 c0, c1; };
    template <class U> __device__ __forceinline__ Pre pre(const U&, int row, int col) const { Pre p; p.rs = rstd[2 * row]; p.c0 = (f32x4){0.f, 0.f, 0.f, 0.f}; p.c1 = p.c0;
        if (col < 576 && (col % 96) >= 64) { const f32x4* t = (const f32x4*)(rope32 + seqinfo(row).pos * 16 + (((col % 96) - 64) >> 1)); p.c0 = t[0]; p.c1 = t[1]; }
        return p; }
    template <class U> __device__ __forceinline__ void fin8(const U&, int row, int col, f32x4 v0, f32x4 v1, const Pre& p) const { if (col >= 576) return;
        v0 = v0 * p.rs; v1 = v1 * p.rs; if ((col % 96) >= 64) { v0 = EpiH::rot(v0, p.c0); v1 = EpiH::rot(v1, p.c1); }
        store_bf8(Q + (size_t)row * QBP + col, v0 * SC_B, v1 * SC_B); }
};
struct EpiUKV {
    static constexpr bool PERM = true;
    bf16_t* KV; const float* rstd;
    template <class U> __device__ __forceinline__ void put8(const U&, int row, int col, f32x4 v0, f32x4 v1) const { const float rs = rstd[2 * row + 1]; store_bf8(KV + (size_t)row * KVP + col, v0 * rs, v1 * rs); }
    __device__ __forceinline__ void put4(int row, int col, f32x4 v) const { store_bf4(KV + (size_t)row * KVP + col, v * rstd[2 * row + 1]); }
    __device__ __forceinline__ void put(int row, int c0, int cc, f32x4 v0, f32x4 v1) const { put4(row, c0 + cc, v0); put4(row, c0 + 32 + cc, v1); }
    struct Pre { float rs; };
    template <class U> __device__ __forceinline__ Pre pre(const U&, int row, int) const { Pre p; p.rs = rstd[2 * row + 1]; return p; }
    template <class U> __device__ __forceinline__ void fin8(const U&, int row, int col, f32x4 v0, f32x4 v1, const Pre& p) const { store_bf8(KV + (size_t)row * KVP + col, v0 * p.rs, v1 * p.rs); }
};
struct EpiRes {
    static constexpr bool PERM = false;
    float* X; const float* xp; const float* xs; float* D;
    template <class U> __device__ __forceinline__ void put4(const U&, int row, int col, f32x4 v) const { put4(row, col, v); }
    __device__ __forceinline__ void put4(int row, int col, f32x4 v) const {
        const f32x4* p = (const f32x4*)(X + (size_t)row * DM + col);
        const f32x4 r = xp ? *(const f32x4*)(((row < NTOK_P) ? xp + (size_t)row * DM : xs + (size_t)(row - NTOK_P) * DM) + col) : *p;
        *(f32x4*)(D + (size_t)row * DM + col) = r * DN_ALPHA + v; }
    __device__ __forceinline__ void put(int row, int c0, int cc, f32x4 v0, f32x4 v1) const { put4(row, c0 + cc, v0); put4(row, c0 + 32 + cc, v1); }
    struct Pre { f32x4 a, b; };
    template <class U> __device__ __forceinline__ Pre pre(const U&, int row, int col) const { Pre p;
        const float* src = xp ? ((row < NTOK_P) ? xp + (size_t)row * DM : xs + (size_t)(row - NTOK_P) * DM) : X + (size_t)row * DM;
        p.a = *(const f32x4*)(src + col); p.b = *(const f32x4*)(src + col + 16); return p; }
    template <class U> __device__ __forceinline__ void fin4x2(const U&, int row, int col, f32x4 v0, f32x4 v1, const Pre& p) const {
        *(f32x4*)(D + (size_t)row * DM + col) = p.a * DN_ALPHA + v0; *(f32x4*)(D + (size_t)row * DM + col + 16) = p.b * DN_ALPHA + v1; }
};
__device__ __forceinline__ float silu_f(float x) { return x / (1.0f + __expf(-x)); }
struct EpiHid {
    static constexpr bool PERM = true;
    bf16_t* HID;
    __device__ __forceinline__ f32x4 act(f32x4 g, f32x4 u) const { f32x4 o; o.x = silu_f(g.x) * u.x; o.y = silu_f(g.y) * u.y; o.z = silu_f(g.z) * u.z; o.w = silu_f(g.w) * u.w; return o; }
    template <class U> __device__ __forceinline__ void putp8(const U&, int row, int col, f32x4 g0, f32x4 g1, f32x4 u0, f32x4 u1) const { store_bf8(HID + (size_t)row * DEXP + col, act(g0, u0), act(g1, u1)); }
    __device__ __forceinline__ void putp(int row, int col, f32x4 g, f32x4 u) const { f32x4 o; o.x = silu_f(g.x) * u.x; o.y = silu_f(g.y) * u.y; o.z = silu_f(g.z) * u.z; o.w = silu_f(g.w) * u.w; store_bf4(HID + (size_t)row * DEXP + col, o); }
    __device__ __forceinline__ void put(int row, int c0, int cc, f32x4 v0, f32x4 v1) const { putp(row, c0 + cc, v0, v1); }
};
struct EpiY {
    bf16_t* YB; const float* tw; const int* list; int seg0, cnt;
    __device__ __forceinline__ void put4(int row, int col, f32x4 v) const { const int r = row - seg0; if (r >= cnt) return; const int a = list[r]; store_bf4(YB + (size_t)a * DM + col, v * tw[a]); }
    __device__ __forceinline__ void put(int row, int c0, int cc, f32x4 v0, f32x4 v1) const { put4(row, c0 + cc, v0); put4(row, c0 + 32 + cc, v1); }
};

struct EpiYO {
    static constexpr bool PERM = true;
    bf16_t* YB; const float* tw; const int* list; const LAS int* seg;
    template <class U> __device__ __forceinline__ void put8(const U& u, int row, int col, f32x4 v0, f32x4 v1) const {
        const int r = row - __builtin_amdgcn_readfirstlane(seg[u.e]); if (r >= __builtin_amdgcn_readfirstlane(seg[33 + u.e])) return; const int a = list[(size_t)u.e * LIST_CAP + r]; const float w = tw[a]; store_bf8(YB + (size_t)a * DM + col, v0 * w, v1 * w); }
    struct Pre { int a; float w; };
    template <class U> __device__ __forceinline__ Pre pre(const U& u, int row, int) const { Pre p; p.a = -1; p.w = 0.f;
        const int r = row - __builtin_amdgcn_readfirstlane(seg[u.e]); if (r < __builtin_amdgcn_readfirstlane(seg[33 + u.e])) { p.a = list[(size_t)u.e * LIST_CAP + r]; p.w = tw[p.a]; } return p; }
    template <class U> __device__ __forceinline__ void fin8(const U&, int, int col, f32x4 v0, f32x4 v1, const Pre& p) const { if (p.a >= 0) store_bf8(YB + (size_t)p.a * DM + col, v0 * p.w, v1 * p.w); }
};
template <class Epi>
__device__ __forceinline__ void sg_phase(Frame& F, const bf16_t* A, int lda, const bf16_t* Bt, int ldb, int M, int N, int K, const Epi& E) {
    const int nN = N / 64, items = (M / 32) * nN;
    for (int it = F.gw; it < items; it += F.NGW) { const int mt = it / nN, nt = it - mt * nN;
        sg_tile(A, lda, Bt + (size_t)(nt * 64) * ldb, Bt + (size_t)(nt * 64 + 32) * ldb, ldb, K, mt * 32, nt * 64, E, IdRows(), F.lane); }
}


namespace pg8 {
constexpr int BM = 256, BK = 64, HALF = 128, HTB = HALF * BK * 2, NXCD = 8, WGM = 8;
__host__ __device__ __forceinline__ int lds_byte(int r, int c) { const int st = (r >> 4) * 2 + (c >> 5), rr = r & 15, cc = c & 31, ob = rr * 64 + cc * 2; return st * 1024 + (ob ^ (((ob >> 9) & 1) << 5)); }
__host__ __device__ __forceinline__ void stage_rc(int b, int& R, int& C) { const int st = b / 1024, sb = b % 1024, swz = sb ^ (((sb >> 9) & 1) << 5); R = (st >> 1) * 16 + swz / 64; C = (st & 1) * 32 + (swz % 64) / 2; }
__host__ __device__ __forceinline__ int perm32(int rho) { const int n = rho >> 4, i = rho & 15; return 8 * (i >> 2) + 4 * n + (i & 3); }
struct Unit { int pm, pn, e; const char* a; const char* b; };
__device__ __forceinline__ bool order_next(int i, int G, int c, int nM, int nN, int& pm, int& pn) {
    const int nwg = nM * nN; const long L = (long)i * G + c; if (L >= nwg) return false;
    int wgid = (int)L; { const int q = nwg / NXCD, r = nwg % NXCD, xcd = wgid % NXCD, off = wgid / NXCD; wgid = (xcd < r ? xcd * (q + 1) : r * (q + 1) + (xcd - r) * q) + off; }
    const int nig = WGM * nN, gid = wgid / nig, fm = gid * WGM, gsz = (nM - fm) < WGM ? (nM - fm) : WGM;
    pm = fm + ((wgid % nig) % gsz); pn = (wgid % nig) / gsz; return true;
}
struct DenseSched {
    const char* A; const char* Bt; int nM, nN, G, c; size_t tstepA, tstepB;
    __device__ __forceinline__ void init(const bf16_t* A_, int lda, const bf16_t* Bt_, int M, int N, int K, int G_, int c_) { A = (const char*)A_; Bt = (const char*)Bt_; nM = M / BM; nN = N / BM; G = G_; c = c_; tstepA = (size_t)BM * lda * 2; tstepB = (size_t)BM * K * 2; }
    __device__ __forceinline__ bool next(int i, Unit& u) const { if (!order_next(i, G, c, nM, nN, u.pm, u.pn)) return false; u.e = 0; u.a = A + (size_t)u.pm * tstepA; u.b = Bt + (size_t)u.pn * tstepB; return true; }
    __device__ __forceinline__ unsigned arow(const Unit&, int) const { return 0u; }
};
struct PanelSched {
    const char* A; const char* Bt; int pm, nN; size_t tstepB;
    __device__ __forceinline__ void init(const bf16_t* A_, int lda, const bf16_t* Bt_, int pm_, int N, int K) { pm = pm_; nN = N / BM; A = (const char*)A_ + (size_t)pm_ * BM * lda * 2; Bt = (const char*)Bt_; tstepB = (size_t)BM * K * 2; }
    __device__ __forceinline__ bool next(int i, Unit& u) const { if (i >= nN) return false; u.pm = pm; int pn = i + (pm % nN); if (pn >= nN) pn -= nN; u.pn = pn; u.e = 0; u.a = A; u.b = Bt + (size_t)pn * tstepB; return true; }
    __device__ __forceinline__ unsigned arow(const Unit&, int) const { return 0u; }
};
template <class Epi, bool PAIR> struct EpiApply;
template <class Epi, class Sched, bool GATHER, bool PAIR>
__device__ __forceinline__ void gemm_phase(LAS unsigned char* lds, int tid, int K, int lda, const Sched& S, const Epi& E) {
    const int wid = __builtin_amdgcn_readfirstlane(tid >> 6), lane = tid & 63, wr = wid >> 2, wc = wid & 3, fr = lane & 15, fq = lane >> 4;
    const int nt = K / BK;
    unsigned voffA[2], voffB[2]; int RA[2], CA[2];
#pragma unroll
    for (int i = 0; i < 2; ++i) { int R, C; stage_rc(tid * 16 + i * 8192, R, C); const int Rb = Epi::PERM ? ((R & ~31) + perm32(R & 31)) : R; RA[i] = R; CA[i] = C;
        voffA[i] = (unsigned)(R * lda + C) * 2u; voffB[i] = (unsigned)(Rb * K + C) * 2u; }
    const size_t kstep = (size_t)(BK * 2);
    const size_t hstepA = (size_t)HALF * lda * 2, hstepB = (size_t)HALF * K * 2;
    const unsigned ldsw = (unsigned)wid * 1024u;
    const int aoff = lds_byte(wr * 64 + fr, fq * 8), boff = lds_byte(wc * 32 + fr, fq * 8);
#define PG8_SA(b, h) (((b) * 2 + (h)) * HTB)
#define PG8_SB(b, h) ((4 + (b) * 2 + (h)) * HTB)
#define PG8_STAGE(bufoff, gbase, voff) do { _Pragma("unroll") for (int _i = 0; _i < 2; ++_i) \
        __builtin_amdgcn_global_load_lds((const unsigned*)((const char*)(gbase) + (voff)[_i]), (LAS unsigned*)(lds + (bufoff) + ldsw + _i * 8192), 16, 0, 0); } while (0)
#define PG8_STAGE_A(bufoff, ab, vg, h, koff) do { if (GATHER) { PG8_STAGE(bufoff, (ab) + (koff), (vg)[h]); } else { PG8_STAGE(bufoff, (ab) + (h) * hstepA + (koff), voffA); } } while (0)
#define PG8_LDA(dst, b, h) do { _Pragma("unroll") for (int m = 0; m < 4; ++m) _Pragma("unroll") for (int k = 0; k < 2; ++k) dst[m][k] = *(const LAS bf16x8*)(lds + PG8_SA(b, h) + aoff + m * 2048 + k * 1024); } while (0)
#define PG8_LDB(dst, b, h) do { _Pragma("unroll") for (int n = 0; n < 2; ++n) _Pragma("unroll") for (int k = 0; k < 2; ++k) dst[n][k] = *(const LAS bf16x8*)(lds + PG8_SB(b, h) + boff + n * 2048 + k * 1024); } while (0)
#define PG8_MMA(ai, bj, At, Bt) do { __builtin_amdgcn_s_setprio(1); _Pragma("unroll") for (int m = 0; m < 4; ++m) _Pragma("unroll") for (int n = 0; n < 2; ++n) _Pragma("unroll") for (int k = 0; k < 2; ++k) \
        acc[ai][bj][m][n] = __builtin_amdgcn_mfma_f32_16x16x32_bf16(Bt[n][k], At[m][k], acc[ai][bj][m][n], 0, 0, 0); __builtin_amdgcn_s_setprio(0); } while (0)
#define PG8_WAIT_V(n) asm volatile("s_waitcnt vmcnt(" #n ")" ::: "memory")
#define PG8_WAIT_L(n) asm volatile("s_waitcnt lgkmcnt(" #n ")" ::: "memory")
#define PG8_BAR __builtin_amdgcn_s_barrier()
#define PG8_SCHED __builtin_amdgcn_sched_barrier(0)
    Unit cur, nxt; int ui = 0;
    if (!S.next(0, cur)) return;
    f32x4 acc[2][2][4][2];
#pragma unroll
    for (int a = 0; a < 2; ++a)
#pragma unroll
        for (int b = 0; b < 2; ++b)
#pragma unroll
            for (int m = 0; m < 4; ++m)
#pragma unroll
                for (int n = 0; n < 2; ++n) acc[a][b][m][n] = (f32x4){0.f, 0.f, 0.f, 0.f};
    bf16x8 At[4][2], B0[2][2], B1[2][2];
    unsigned vgc[2][2] = {{0u, 0u}, {0u, 0u}}, vgn[2][2] = {{0u, 0u}, {0u, 0u}};
    if (GATHER) {
#pragma unroll
        for (int h = 0; h < 2; ++h)
#pragma unroll
            for (int i = 0; i < 2; ++i) vgc[h][i] = S.arow(cur, h * HALF + RA[i]) * (unsigned)(lda * 2) + (unsigned)CA[i] * 2u;
    }
    const char* cA = cur.a; const char* cB = cur.b;
    PG8_STAGE(PG8_SB(0, 0), cB, voffB); PG8_STAGE(PG8_SB(0, 1), cB + hstepB, voffB); PG8_STAGE_A(PG8_SA(0, 0), cA, vgc, 0, 0); PG8_STAGE_A(PG8_SA(0, 1), cA, vgc, 1, 0);
    if (wr == 1) PG8_BAR;
    PG8_WAIT_V(2); PG8_BAR;
    PG8_STAGE(PG8_SB(1, 0), cB + kstep, voffB); PG8_STAGE_A(PG8_SA(1, 0), cA, vgc, 0, kstep); PG8_STAGE(PG8_SB(1, 1), cB + hstepB + kstep, voffB);
    PG8_WAIT_V(6); PG8_BAR;
    for (;;) {
        const bool has_next = S.next(ui + 1, nxt);
        const char* nA = has_next ? nxt.a : cA; const char* nB = has_next ? nxt.b : cB;
        if (GATHER) {
#pragma unroll
            for (int h = 0; h < 2; ++h)
#pragma unroll
                for (int i = 0; i < 2; ++i) vgn[h][i] = has_next ? (S.arow(nxt, h * HALF + RA[i]) * (unsigned)(lda * 2) + (unsigned)CA[i] * 2u) : vgc[h][i];
        }
#pragma clang loop unroll(disable)
        for (int t = 0; t < nt; t += 2) {
            const bool last = (t == nt - 2);
            const size_t k1 = (size_t)(t + 1) * kstep;
            const char* a2 = last ? nA : cA; const char* b2 = last ? nB : cB + (size_t)(t + 2) * kstep; const size_t ka2 = last ? 0 : (size_t)(t + 2) * kstep;
            const char* b3 = b2 + kstep; const size_t ka3 = ka2 + kstep;
            unsigned v2[2][2];
#pragma unroll
            for (int h = 0; h < 2; ++h)
#pragma unroll
                for (int i = 0; i < 2; ++i) v2[h][i] = last ? vgn[h][i] : vgc[h][i];
            PG8_LDB(B0, 0, 0); PG8_LDB(B1, 0, 1); PG8_SCHED; PG8_LDA(At, 0, 0); PG8_STAGE_A(PG8_SA(1, 1), cA, vgc, 1, k1);
            PG8_WAIT_V(8); PG8_WAIT_L(0); PG8_BAR; PG8_MMA(0, 0, At, B0); PG8_MMA(0, 1, At, B1); PG8_BAR; PG8_SCHED;
            PG8_LDA(At, 0, 1); PG8_STAGE(PG8_SB(0, 0), b2, voffB); PG8_STAGE(PG8_SB(0, 1), b2 + hstepB, voffB); PG8_STAGE_A(PG8_SA(0, 0), a2, v2, 0, ka2);
            PG8_WAIT_V(8); PG8_WAIT_L(0); PG8_BAR; PG8_MMA(1, 0, At, B0); PG8_MMA(1, 1, At, B1); PG8_BAR; PG8_SCHED;
            PG8_LDB(B0, 1, 0); PG8_LDB(B1, 1, 1); PG8_SCHED; PG8_LDA(At, 1, 0); PG8_STAGE_A(PG8_SA(0, 1), a2, v2, 1, ka2);
            PG8_WAIT_V(8); PG8_WAIT_L(0); PG8_BAR; PG8_MMA(0, 0, At, B0); PG8_MMA(0, 1, At, B1); PG8_BAR; PG8_SCHED;
            PG8_LDA(At, 1, 1); PG8_STAGE(PG8_SB(1, 0), b3, voffB); PG8_STAGE(PG8_SB(1, 1), b3 + hstepB, voffB); PG8_STAGE_A(PG8_SA(1, 0), a2, v2, 0, ka3);
            PG8_WAIT_V(8); PG8_WAIT_L(0); PG8_BAR; PG8_MMA(1, 0, At, B0); PG8_MMA(1, 1, At, B1); PG8_BAR; PG8_SCHED;
        }
        if (wr == 0) PG8_BAR;
        { int fr_ = fr, fq_ = fq; asm volatile("" : "+v"(fr_), "+v"(fq_));
          EpiApply<Epi, PAIR>::run(E, acc, cur, wr, wc, fr_, fq_); }
        if (!has_next) break;
#pragma unroll
        for (int a = 0; a < 2; ++a)
#pragma unroll
            for (int b = 0; b < 2; ++b)
#pragma unroll
                for (int m = 0; m < 4; ++m)
#pragma unroll
                    for (int n = 0; n < 2; ++n) acc[a][b][m][n] = (f32x4){0.f, 0.f, 0.f, 0.f};
        cur = nxt; cA = nA; cB = nB; ++ui;
        if (GATHER) {
#pragma unroll
            for (int h = 0; h < 2; ++h)
#pragma unroll
                for (int i = 0; i < 2; ++i) vgc[h][i] = vgn[h][i];
        }
        if (wr == 1) PG8_BAR;
    }
    PG8_WAIT_V(0);
    PG8_BAR;
#undef PG8_SA
#undef PG8_SB
#undef PG8_STAGE
#undef PG8_STAGE_A
#undef PG8_LDA
#undef PG8_LDB
#undef PG8_MMA
#undef PG8_WAIT_V
#undef PG8_WAIT_L
#undef PG8_BAR
#undef PG8_SCHED
}
template <class Epi> struct EpiApply<Epi, false> {
    static __device__ __forceinline__ void run(const Epi& E, const f32x4 (&acc)[2][2][4][2], const Unit& u, int wr, int wc, int fr, int fq) {
#pragma unroll
        for (int ai = 0; ai < 2; ++ai) {
            typename Epi::Pre pre[4][2];
#pragma unroll
            for (int m = 0; m < 4; ++m) { const int row = u.pm * BM + ai * HALF + wr * 64 + m * 16 + fr;
#pragma unroll
                for (int bj = 0; bj < 2; ++bj) pre[m][bj] = E.pre(u, row, u.pn * BM + bj * HALF + wc * 32 + (Epi::PERM ? 8 : 4) * fq); }
#pragma unroll
            for (int m = 0; m < 4; ++m) { const int row = u.pm * BM + ai * HALF + wr * 64 + m * 16 + fr;
#pragma unroll
                for (int bj = 0; bj < 2; ++bj) {
                    if constexpr (Epi::PERM) E.fin8(u, row, u.pn * BM + bj * HALF + wc * 32 + 8 * fq, acc[ai][bj][m][0], acc[ai][bj][m][1], pre[m][bj]);
                    else E.fin4x2(u, row, u.pn * BM + bj * HALF + wc * 32 + 4 * fq, acc[ai][bj][m][0], acc[ai][bj][m][1], pre[m][bj]); } }
        }
    }
};
template <class Epi> struct EpiApply<Epi, true> {
    static __device__ __forceinline__ void run(const Epi& E, const f32x4 (&acc)[2][2][4][2], const Unit& u, int wr, int wc, int fr, int fq) {
#pragma unroll
        for (int ai = 0; ai < 2; ++ai)
#pragma unroll
            for (int m = 0; m < 4; ++m) { const int row = u.pm * BM + ai * HALF + wr * 64 + m * 16 + fr;
                E.putp8(u, row, u.pn * HALF + wc * 32 + 8 * fq, acc[ai][0][m][0], acc[ai][0][m][1], acc[ai][1][m][0], acc[ai][1][m][1]); }
    }
};
}

__device__ __forceinline__ void rowstat_pass(Frame& F, int r_first, int r_stride, int r_end) {
    const bf16_t* H = (const bf16_t*)(F.ws + WS_H); float* rstd = (float*)(F.ws + WS_RSTD);
    for (int m = r_first; m < r_end; m += r_stride) {
        const bf16_t* hr = H + (size_t)m * HP;
        const u32x2 q = *((const u32x2*)(hr + HC_CQ_LAT) + F.lane);
        const unsigned kv = *((const unsigned*)(hr + HC_CKV) + F.lane);
        float a0 = bf2f(q.x & 0xffff), a1 = bf2f(q.x >> 16), a2 = bf2f(q.y & 0xffff), a3 = bf2f(q.y >> 16), b0 = bf2f(kv & 0xffff), b1 = bf2f(kv >> 16);
        const float sq = wave_sum(a0 * a0 + a1 * a1 + a2 * a2 + a3 * a3), sk = wave_sum(b0 * b0 + b1 * b1);
        if (F.lane == 0) { rstd[2 * m] = 1.0f / sqrtf(sq * (1.0f / 256.0f) + RMS_EPS); rstd[2 * m + 1] = 1.0f / sqrtf(sk * (1.0f / 128.0f) + RMS_EPS); }
    }
}
__device__ __forceinline__ void red8(float (&v)[8], int lane) {
    float a[4], b[2], c;
#pragma unroll
    for (int i = 0; i < 4; ++i) a[i] = xpair32(v[i], v[i + 4]);
    { const bool up = (lane & 16) != 0;
#pragma unroll
      for (int i = 0; i < 2; ++i) { const float send = up ? a[i] : a[i + 2], keep = up ? a[i + 2] : a[i]; b[i] = keep + shx<16>(send); } }
    { const bool up = (lane & 8) != 0; const float send = up ? b[0] : b[1], keep = up ? b[1] : b[0]; c = keep + shx<8>(send); }
    c += shx<4>(c); c += shx<2>(c); c += shx<1>(c);
#pragma unroll
    for (int i = 0; i < 8; ++i) v[i] = __uint_as_float(__builtin_amdgcn_readlane(__float_as_uint(c), ((i >> 2) & 1) * 32 + ((i >> 1) & 1) * 16 + (i & 1) * 8));
}
__device__ __forceinline__ void red4(float (&v)[4], int lane) {
    float a[2], c;
#pragma unroll
    for (int i = 0; i < 2; ++i) a[i] = xpair32(v[i], v[i + 2]);
    { const bool up = (lane & 16) != 0; const float send = up ? a[0] : a[1], keep = up ? a[1] : a[0]; c = keep + shx<16>(send); }
    c += shx<8>(c); c += shx<4>(c); c += shx<2>(c); c += shx<1>(c);
#pragma unroll
    for (int i = 0; i < 4; ++i) v[i] = __uint_as_float(__builtin_amdgcn_readlane(__float_as_uint(c), ((i >> 1) & 1) * 32 + (i & 1) * 16));
}
__device__ __forceinline__ void ln1_route_pass(Frame& F, const Args& a, int layer, int r_first, int r_stride, int r_end) {
    bf16_t* XB = (bf16_t*)(F.ws + WS_XB); float* tw = (float*)(F.ws + WS_TW); int* list = (int*)(F.ws + WS_LIST);
    const float* g = a.ln1_g + layer * DM; const float* bb = a.ln1_b + layer * DM;
    const float* wc = a.moe_w_coarse + (size_t)layer * DM * 4; const float* wf = a.moe_w_fine + (size_t)layer * 4 * DM * 8;
    for (int q = F.tid; q < 4 * 1024 * 2; q += NTHREADS) { const int hf = q & 1, k = (q >> 1) & 1023, gg = q >> 11; const int l = (k & 255) >> 2, e = k & 3, j = k >> 8;
        *(LAS f32x4*)(F.lds + (size_t)(gg * 2048 + ((j * 4 + e) * 2 + hf) * 64 + l) * 16) = *((const f32x4*)wf + q); }
    f32x4 wcr[4][4];
#pragma unroll
    for (int j = 0; j < 4; ++j)
#pragma unroll
        for (int e = 0; e < 4; ++e) wcr[j][e] = *(const f32x4*)(wc + (size_t)(4 * F.lane + 256 * j + e) * 4);
    __syncthreads();
    f32x4 vn[2][4];
#pragma unroll
    for (int rr = 0; rr < 2; ++rr) { const int mm = r_first + rr * r_stride; if (mm < r_end) {
#pragma unroll
        for (int j = 0; j < 4; ++j) vn[rr][j] = *((const f32x4*)(a.out + (size_t)mm * DM) + F.lane + 64 * j); } }
    for (int m0 = r_first; m0 < r_end; m0 += 2 * r_stride) {
        f32x4 vc[2][4];
#pragma unroll
        for (int rr = 0; rr < 2; ++rr)
#pragma unroll
            for (int j = 0; j < 4; ++j) vc[rr][j] = vn[rr][j];
#pragma unroll
        for (int rr = 0; rr < 2; ++rr) { const int mm = m0 + (2 + rr) * r_stride; if (mm < r_end) {
#pragma unroll
            for (int j = 0; j < 4; ++j) vn[rr][j] = *((const f32x4*)(a.out + (size_t)mm * DM) + F.lane + 64 * j); } }
#pragma unroll
      for (int rr = 0; rr < 2; ++rr) { const int m = m0 + rr * r_stride; if (m < r_end) {
        f32x4 v[4]; float s = 0.f;
#pragma unroll
        for (int j = 0; j < 4; ++j) { v[j] = vc[rr][j]; s += (v[j].x + v[j].y) + (v[j].z + v[j].w); }
        const float mean = wave_sum(s) * (1.f / DM); float s2 = 0.f;
#pragma unroll
        for (int j = 0; j < 4; ++j) { v[j] = v[j] - mean; s2 += (v[j].x * v[j].x + v[j].y * v[j].y) + (v[j].z * v[j].z + v[j].w * v[j].w); }
        const float rs = 1.f / sqrtf(wave_sum(s2) * (1.f / DM) + LN_EPS);
        float cl[4] = {0.f, 0.f, 0.f, 0.f};
#pragma unroll
        for (int j = 0; j < 4; ++j) { const int c = 4 * F.lane + 256 * j; const f32x4 gg = *(const f32x4*)(g + c), bv = *(const f32x4*)(bb + c); v[j] = v[j] * rs * gg + bv;
            u32x2 w; w.x = pk2(v[j].x, v[j].y); w.y = pk2(v[j].z, v[j].w); *((u32x2*)(XB + (size_t)m * DM) + F.lane + 64 * j) = w;
#pragma unroll
            for (int e = 0; e < 4; ++e) { const f32x4 w4 = wcr[j][e]; const float xe = v[j][e]; cl[0] += xe * w4.x; cl[1] += xe * w4.y; cl[2] += xe * w4.z; cl[3] += xe * w4.w; } }
        red4(cl, F.lane);
        int grp = 0; float cm = cl[0];
#pragma unroll
        for (int e = 1; e < 4; ++e) if (cl[e] > cm) { cm = cl[e]; grp = e; }
        float den = 0.f;
#pragma unroll
        for (int e = 0; e < 4; ++e) den += __expf(cl[e] - cm);
        const float pg = 1.0f / den;
        grp = __builtin_amdgcn_readfirstlane(grp);
        const LAS f32x4* wl = (const LAS f32x4*)(F.lds) + grp * 2048 + F.lane;
        float fl[8] = {0.f, 0.f, 0.f, 0.f, 0.f, 0.f, 0.f, 0.f};
#pragma unroll
        for (int j = 0; j < 4; ++j)
#pragma unroll
            for (int e = 0; e < 4; ++e) { const f32x4 wa = wl[((j * 4 + e) * 2) * 64], wb = wl[((j * 4 + e) * 2 + 1) * 64]; const float xe = v[j][e];
                fl[0] += xe * wa.x; fl[1] += xe * wa.y; fl[2] += xe * wa.z; fl[3] += xe * wa.w; fl[4] += xe * wb.x; fl[5] += xe * wb.y; fl[6] += xe * wb.z; fl[7] += xe * wb.w; }
        red8(fl, F.lane);
        int i0 = 0; float v0 = fl[0];
#pragma unroll
        for (int e = 1; e < 8; ++e) if (fl[e] > v0) { v0 = fl[e]; i0 = e; }
        int i1 = -1; float v1 = -3.0e38f;
#pragma unroll
        for (int e = 0; e < 8; ++e) if (e != i0 && fl[e] > v1) { v1 = fl[e]; i1 = e; }
        const float e1 = __expf(v1 - v0), w0 = pg / (1.0f + e1), w1 = pg * e1 / (1.0f + e1);
        if (F.lane < 2) { const int e = grp * 8 + (F.lane == 0 ? i0 : i1); const int a_id = 2 * m + F.lane;
            const unsigned pos = __hip_atomic_fetch_add(F.ctl + CW_CNT + layer * 64 + e, 1u, RLX_AGENT);
            list[(size_t)e * LIST_CAP + pos] = a_id; tw[a_id] = (F.lane == 0) ? w0 : w1; }
          } }
    }
    __syncthreads();
}
__device__ __forceinline__ void ln2_pass(Frame& F, const Args& a, int layer, int r_first, int r_stride, int r_end) {
    bf16_t* XB = (bf16_t*)(F.ws + WS_XB); const bf16_t* YB = (const bf16_t*)(F.ws + WS_YB);
    const float* g = a.ln2_g + layer * DM; const float* bb = a.ln2_b + layer * DM; const float* g1 = a.ln1_g + layer * DM; const float* b1 = a.ln1_b + layer * DM;
    f32x4 xn[2][4]; u32x2 pn[2][4], qn[2][4];
#define LN2_LOAD(rr, mm) do { const bf16_t* y0_ = YB + (size_t)(2 * (mm)) * DM; _Pragma("unroll") for (int j = 0; j < 4; ++j) { xn[rr][j] = *((const f32x4*)(a.out + (size_t)(mm) * DM) + F.lane + 64 * j); \
        pn[rr][j] = *((const u32x2*)y0_ + F.lane + 64 * j); qn[rr][j] = *((const u32x2*)(y0_ + DM) + F.lane + 64 * j); } } while (0)
#pragma unroll
    for (int rr = 0; rr < 2; ++rr) { const int mm = r_first + rr * r_stride; if (mm < r_end) LN2_LOAD(rr, mm); }
    for (int m0 = r_first; m0 < r_end; m0 += 2 * r_stride) {
        f32x4 xc[2][4]; u32x2 pc[2][4], qc[2][4];
#pragma unroll
        for (int rr = 0; rr < 2; ++rr)
#pragma unroll
            for (int j = 0; j < 4; ++j) { xc[rr][j] = xn[rr][j]; pc[rr][j] = pn[rr][j]; qc[rr][j] = qn[rr][j]; }
#pragma unroll
        for (int rr = 0; rr < 2; ++rr) { const int mm = m0 + (2 + rr) * r_stride; if (mm < r_end) LN2_LOAD(rr, mm); }
#pragma unroll
        for (int rr = 0; rr < 2; ++rr) { const int m = m0 + rr * r_stride; if (m < r_end) {
            float* xr = a.out + (size_t)m * DM;
            f32x4 v[4]; float s = 0.f;
            { float s1 = 0.f;
#pragma unroll
              for (int j = 0; j < 4; ++j) { v[j] = xc[rr][j]; s1 += (v[j].x + v[j].y) + (v[j].z + v[j].w); }
              const float mean1 = wave_sum(s1) * (1.f / DM); float q1 = 0.f;
#pragma unroll
              for (int j = 0; j < 4; ++j) { v[j] = v[j] - mean1; q1 += (v[j].x * v[j].x + v[j].y * v[j].y) + (v[j].z * v[j].z + v[j].w * v[j].w); }
              const float rs1 = 1.f / sqrtf(wave_sum(q1) * (1.f / DM) + LN_EPS);
#pragma unroll
              for (int j = 0; j < 4; ++j) { const int c = 4 * F.lane + 256 * j; xc[rr][j] = v[j] * rs1 * *(const f32x4*)(g1 + c) + *(const f32x4*)(b1 + c); } }
#pragma unroll
            for (int j = 0; j < 4; ++j) { v[j] = xc[rr][j] * DN_ALPHA; const u32x2 p = pc[rr][j], q = qc[rr][j];
                v[j].x += bf2f(p.x & 0xffff) + bf2f(q.x & 0xffff); v[j].y += bf2f(p.x >> 16) + bf2f(q.x >> 16); v[j].z += bf2f(p.y & 0xffff) + bf2f(q.y & 0xffff); v[j].w += bf2f(p.y >> 16) + bf2f(q.y >> 16);
                s += (v[j].x + v[j].y) + (v[j].z + v[j].w); }
            const float mean = wave_sum(s) * (1.f / DM); float s2 = 0.f;
#pragma unroll
            for (int j = 0; j < 4; ++j) { v[j] = v[j] - mean; s2 += (v[j].x * v[j].x + v[j].y * v[j].y) + (v[j].z * v[j].z + v[j].w * v[j].w); }
            const float rs = 1.f / sqrtf(wave_sum(s2) * (1.f / DM) + LN_EPS);
#pragma unroll
            for (int j = 0; j < 4; ++j) { const int c = 4 * F.lane + 256 * j; const f32x4 gg = *(const f32x4*)(g + c), bv = *(const f32x4*)(bb + c); v[j] = v[j] * rs * gg + bv;
                *((f32x4*)xr + F.lane + 64 * j) = v[j];
                if (layer + 1 < DEPTH) { u32x2 w; w.x = pk2(v[j].x, v[j].y); w.y = pk2(v[j].z, v[j].w); *((u32x2*)(XB + (size_t)m * DM) + F.lane + 64 * j) = w; } }
        } }
    }
#undef LN2_LOAD
}
__device__ __forceinline__ void moe_convert(Frame& F, const Args& a, int layer) {
    LAS float* scr = (LAS float*)(F.lds + F.wave * 16384);
    constexpr int I_13 = (1024 / 64) * (1024 / 32), I_2 = (512 / 64) * (1024 / 32), PER_E = I_13 + I_2;
    for (int it = F.gw; it < NEXP * PER_E; it += F.NGW) {
        const int e = it / PER_E; int r = it - e * PER_E; const size_t le = (size_t)layer * NEXP + e;
        if (r < I_13) { const int kb = r / 32, nb = r % 32; const float* src = ((nb >> 2) & 1) ? a.moe_w3 : a.moe_w1;
            const int sc0 = ((32 * nb) >> 8) * 128 + ((32 * nb) & 127);
            transpose_item_v4(src + le * 1024 * 512 + (size_t)(kb * 64) * 512 + sc0, 512, (bf16_t*)(F.ws + WS_W13) + (size_t)e * 1024 * 1024 + (size_t)(nb * 32) * 1024 + kb * 64, 1024, scr, F.lane); }
        else { r -= I_13; const int kb = r / 32, nb = r % 32;
            transpose_item_v4(a.moe_w2 + le * 512 * 1024 + (size_t)(kb * 64) * 1024 + nb * 32, 1024, (bf16_t*)(F.ws + WS_W2) + (size_t)e * 1024 * 512 + (size_t)(nb * 32) * 512 + kb * 64, 512, scr, F.lane); }
    }
}

typedef short at_s16x4 __attribute__((ext_vector_type(4)));
typedef LAS const unsigned char* at_lds_cptr;
__device__ __forceinline__ at_s16x4 at_vtr(at_lds_cptr p) { return __builtin_bit_cast(at_s16x4, __builtin_amdgcn_ds_read_tr16_b64_v4i16((LAS at_s16x4*)p)); }
struct RowSrc { const bf16_t* p; long pitch; };
constexpr int SA_P = 0, SA_V = 4096, SA_AL = 12288, SA_RL = 12544;
template <int NC0, int NC1, int MODE>
__device__ __forceinline__ void sattn_core(const bf16x8* qf, RowSrc k0, RowSrc k1, RowSrc vs, int kb_lo, int kb_hi, int qidx0, float lse_ref, LAS unsigned char* scr, int lane, f32x16* o, float& lse_out) {
    const int r32 = lane & 31, hi = lane >> 5;
    LAS bf16_t* Pb = (LAS bf16_t*)(scr + SA_P); LAS bf16_t* Vb = (LAS bf16_t*)(scr + SA_V); LAS float* Al = (LAS float*)(scr + SA_AL);
    float m = -1.0e30f, l = 0.f;
    if (MODE != 1) { o[0] = f32x16{}; o[1] = f32x16{}; }
    bf16x8 kn[NC0 + NC1]; u32x4 vn[4];
#define SA_LOAD(kb_) do { const long key_ = (long)(kb_) * 32 + r32; \
        _Pragma("unroll") for (int c = 0; c < NC0; ++c) kn[c] = *(const bf16x8*)(k0.p + key_ * k0.pitch + 16 * c + 8 * hi); \
        _Pragma("unroll") for (int c = 0; c < NC1; ++c) kn[NC0 + c] = *(const bf16x8*)(k1.p + key_ * k1.pitch + 16 * c + 8 * hi); \
        if (MODE != 1) { _Pragma("unroll") for (int i = 0; i < 4; ++i) { const int idx = i * 64 + lane, kr = idx >> 3, pc = idx & 7; vn[i] = *(const u32x4*)(vs.p + ((long)(kb_) * 32 + kr) * vs.pitch + pc * 8); } } } while (0)
    if (kb_lo < kb_hi) SA_LOAD(kb_lo);
    const at_lds_cptr vtb = (at_lds_cptr)(scr + SA_V) + ((8 * hi + ((lane & 15) >> 2)) * 72 + 16 * ((lane >> 4) & 1) + 4 * (lane & 3)) * 2;
    for (int kb = kb_lo; kb < kb_hi; ++kb) {
        bf16x8 kc[NC0 + NC1]; u32x4 vc[4];
#pragma unroll
        for (int c = 0; c < NC0 + NC1; ++c) kc[c] = kn[c];
#pragma unroll
        for (int i = 0; i < 4; ++i) vc[i] = vn[i];
        if (kb + 1 < kb_hi) SA_LOAD(kb + 1);
        f32x16 s = {};
#pragma unroll
        for (int c = 0; c < NC0 + NC1; ++c) s = MFMA32(kc[c], qf[c], s);
        bool valid[16];
#pragma unroll
        for (int r = 0; r < 16; ++r) { if (MODE == 0) valid[r] = true; else { const int d = kb * 32 + crow(r, hi) - (qidx0 + r32); valid[r] = (d <= 64 && d >= -64); } }
        float p[16];
        if (MODE == 2) {
#pragma unroll
            for (int r = 0; r < 16; ++r) p[r] = valid[r] ? fast_exp2(s[r] - lse_ref) : 0.f;
        } else {
            float mx = -1.0e30f;
#pragma unroll
            for (int r = 0; r < 16; ++r) if (valid[r]) mx = fmaxf(mx, s[r]);
            mx = xmax32(mx);
            const float mn = fmaxf(m, mx), alpha = fast_exp2(m - mn); m = mn;
            float ps = 0.f;
#pragma unroll
            for (int r = 0; r < 16; ++r) { p[r] = valid[r] ? fast_exp2(s[r] - mn) : 0.f; ps += p[r]; }
            l = l * alpha + ps;
            if (MODE == 0) { if (hi == 0) Al[r32] = alpha; }
        }
        if (MODE != 1) {
#pragma unroll
            for (int g = 0; g < 4; ++g) { u32x2 w; w.x = pk2(p[4 * g], p[4 * g + 1]); w.y = pk2(p[4 * g + 2], p[4 * g + 3]); *(LAS u32x2*)(Pb + r32 * 40 + 8 * g + 4 * hi) = w; }
#pragma unroll
            for (int i = 0; i < 4; ++i) { const int idx = i * 64 + lane, kr = idx >> 3, pc = idx & 7; *(LAS u32x4*)(Vb + kr * 72 + pc * 8) = vc[i]; }
            LDS_WAIT();
            if (MODE == 0) {
#pragma unroll
                for (int r = 0; r < 16; ++r) { const float al = Al[crow(r, hi)]; o[0][r] *= al; o[1][r] *= al; }
            }
#pragma unroll
            for (int st = 0; st < 2; ++st) {
                const bf16x8 pf = *(const LAS bf16x8*)(Pb + r32 * 40 + 16 * st + 8 * hi);
#pragma unroll
                for (int db = 0; db < 2; ++db) {
                    const at_s16x4 lo_ = at_vtr(vtb + (16 * st * 72 + 32 * db) * 2), hi_ = at_vtr(vtb + ((16 * st + 4) * 72 + 32 * db) * 2);
                    const bf16x8 vf = {lo_[0], lo_[1], lo_[2], lo_[3], hi_[0], hi_[1], hi_[2], hi_[3]};
                    o[db] = MFMA32(pf, vf, o[db]); }
            }
            LDS_WAIT();
        }
    }
#undef SA_LOAD
    if (MODE != 2) { l = xsum32(l); lse_out = m + __log2f(l); }
    if (MODE == 0) {
        LAS float* Rl = (LAS float*)(scr + SA_RL);
        if (hi == 0) Rl[r32] = 1.0f / l;
        LDS_WAIT();
#pragma unroll
        for (int r = 0; r < 16; ++r) { const float rl = Rl[crow(r, hi)]; o[0][r] *= rl; o[1][r] *= rl; }
        LDS_WAIT();
    }
}

__device__ __forceinline__ void sattn_phase(Frame& F, const Args& a, int layer, int kind_lo) {
    const bf16_t* H = (const bf16_t*)(F.ws + WS_H); const bf16_t* QB = (const bf16_t*)(F.ws + WS_QB); const bf16_t* KVB = (const bf16_t*)(F.ws + WS_KVB);
    bf16_t* MIX = (bf16_t*)(F.ws + WS_MIX); const float* lsec = (const float*)(F.ws + WS_LSEC);
    LAS unsigned char* scr = F.lds + F.wave * 16384;
    const int lane = F.lane, r32 = lane & 31, hi = lane >> 5;
    float lam, lam_init;
    { const float* lv = a.diff_lambda + layer * 128; float d1 = 0.f, d2 = 0.f;
      for (int i = 0; i < 32; ++i) { d1 += lv[i] * lv[32 + i]; d2 += lv[64 + i] * lv[96 + i]; }
      lam_init = 0.8f - 0.6f * expf(-0.3f * (float)layer); lam = expf(d1) - expf(d2) + lam_init; }
    constexpr int NRB = NTOK / 32;
    const int items = NRB * (4 + 6 + 6);
    for (int it = kind_lo * NRB + F.gw; it < items; it += F.NGW) {
        const int kind = it / NRB, rb = it - kind * NRB; const int m0 = rb * 32; const SeqInfo si = seqinfo(m0);
#if !OPT_ATTN
        if (kind < 4) {
            const int h = kind; f32x16 o0[2], o1[2]; float dummy;
            for (int c = 0; c < 2; ++c) {
                bf16x8 qf[2];
#pragma unroll
                for (int d0 = 0; d0 < 2; ++d0) qf[d0] = *(const bf16x8*)(H + (size_t)(m0 + r32) * HP + HC_AQ + h * 64 + c * 32 + 16 * d0 + 8 * hi);
                const RowSrc ks{H + (size_t)si.base * HP + HC_AK + h * 64 + c * 32, HP}, vs{H + (size_t)si.base * HP + HC_AV + h * 64, HP};
                sattn_core<2, 0, 0>(qf, ks, ks, vs, 0, si.len / 32, 0, 0.f, scr, lane, c == 0 ? o0 : o1, dummy);
            }
            const float* sg = a.diff_subln + layer * 64; const float g0 = sg[r32], g1 = sg[32 + r32];
#pragma unroll
            for (int r = 0; r < 16; ++r) { const float x0 = o0[0][r] - lam * o1[0][r], x1 = o0[1][r] - lam * o1[1][r]; float ss = x0 * x0 + x1 * x1;
                ss += shx<1>(ss); ss += shx<2>(ss); ss += shx<4>(ss); ss += shx<8>(ss); ss += shx<16>(ss);
                const float rs = (1.0f - lam_init) / sqrtf(ss * (1.0f / 64.0f) + RMS_EPS);
                bf16_t* op = MIX + (size_t)(m0 + crow(r, hi)) * DM + MIX_A + h * 64 + r32;
                op[0] = (bf16_t)f2bf(x0 * rs * g0); op[32] = (bf16_t)f2bf(x1 * rs * g1); }
        } else if (kind < 10) {
            const int h = kind - 4; f32x16 o[2]; float dummy; bf16x8 qf[6];
#pragma unroll
            for (int d0 = 0; d0 < 6; ++d0) qf[d0] = *(const bf16x8*)(QB + (size_t)(m0 + r32) * QBP + h * 96 + 16 * d0 + 8 * hi);
            const RowSrc k0{KVB + (size_t)si.base * KVP + h * 128, KVP}, k1{H + (size_t)si.base * HP + HC_KROPE, HP}, vs{KVB + (size_t)si.base * KVP + h * 128 + 64, KVP};
            sattn_core<4, 2, 0>(qf, k0, k1, vs, 0, si.len / 32, 0, 0.f, scr, lane, o, dummy);
#pragma unroll
            for (int r = 0; r < 16; ++r) { bf16_t* op = MIX + (size_t)(m0 + crow(r, hi)) * DM + MIX_B + h * 64 + r32; op[0] = (bf16_t)f2bf(o[0][r]); op[32] = (bf16_t)f2bf(o[1][r]); }
        } else
#endif
        {
            const int gj = kind - 10, g = gj >> 1, hh = gj;
            const int dil = (g == 0) ? 1 : (g == 1 ? 4 : 16); const int L = si.len / dil, bpr = L / 32;
            const int w = (m0 - si.base) / 32, rho = w / bpr, ib = w - rho * bpr, i0 = ib * 32;
            const size_t qrow = (size_t)si.base + (size_t)(i0 + r32) * dil + rho;
            bf16x8 qf[4];
#pragma unroll
            for (int d0 = 0; d0 < 4; ++d0) qf[d0] = *(const bf16x8*)(H + qrow * HP + HC_CQ + hh * 64 + 16 * d0 + 8 * hi);
            const int j = gj & 1; const float l0 = lsec[(0 * (size_t)NTOK + qrow) * 2 + j], l1 = lsec[(1 * (size_t)NTOK + qrow) * 2 + j], l2 = lsec[(2 * (size_t)NTOK + qrow) * 2 + j];
            const float lm = fmaxf(l0, fmaxf(l1, l2)); const float lref = lm + __log2f(fast_exp2(l0 - lm) + fast_exp2(l1 - lm) + fast_exp2(l2 - lm));
            const RowSrc ks{H + ((size_t)si.base + rho) * HP + HC_CK + hh * 64, (long)HP * dil}, vs{H + ((size_t)si.base + rho) * HP + HC_CV + hh * 64, (long)HP * dil};
            int kb_lo = ib - 2, kb_hi = ib + 3; if (kb_lo < 0) kb_lo = 0; if (kb_hi > bpr) kb_hi = bpr;
            f32x16 o[2]; float dummy;
            sattn_core<4, 0, 2>(qf, ks, ks, vs, kb_lo, kb_hi, i0, lref, scr, lane, o, dummy);
#pragma unroll
            for (int r = 0; r < 16; ++r) { const size_t orow = (size_t)si.base + (size_t)(i0 + crow(r, hi)) * dil + rho; bf16_t* op = MIX + orow * DM + MIX_C + hh * 64 + r32; op[0] = (bf16_t)f2bf(o[0][r]); op[32] = (bf16_t)f2bf(o[1][r]); }
        }
    }
}
__device__ __forceinline__ void cstat_phase(Frame& F) {
    const bf16_t* H = (const bf16_t*)(F.ws + WS_H); float* lsec = (float*)(F.ws + WS_LSEC);
    LAS unsigned char* scr = F.lds + F.wave * 16384;
    const int lane = F.lane, r32 = lane & 31, hi = lane >> 5;
    constexpr int NRB = NTOK / 32;
    for (int it = F.gw; it < NRB * 6; it += F.NGW) {
        const int gj = it / NRB, rb = it - gj * NRB, g = gj >> 1, j = gj & 1; const int m0 = rb * 32; const SeqInfo si = seqinfo(m0);
        const int dil = (g == 0) ? 1 : (g == 1 ? 4 : 16); const int L = si.len / dil, bpr = L / 32;
        const int w = (m0 - si.base) / 32, rho = w / bpr, ib = w - rho * bpr, i0 = ib * 32;
        const size_t qrow = (size_t)si.base + (size_t)(i0 + r32) * dil + rho;
        bf16x8 qf[4];
#pragma unroll
        for (int d0 = 0; d0 < 4; ++d0) qf[d0] = *(const bf16x8*)(H + qrow * HP + HC_CQ + gj * 64 + 16 * d0 + 8 * hi);
        const RowSrc ks{H + ((size_t)si.base + rho) * HP + HC_CK + gj * 64, (long)HP * dil};
        int kb_lo = ib - 2, kb_hi = ib + 3; if (kb_lo < 0) kb_lo = 0; if (kb_hi > bpr) kb_hi = bpr;
        float lse; sattn_core<4, 0, 1>(qf, ks, ks, ks, kb_lo, kb_hi, i0, 0.f, scr, lane, nullptr, lse);
        if (hi == 0) lsec[((size_t)g * NTOK + qrow) * 2 + j] = lse;
    }
}


namespace at {
typedef short s16x4 __attribute__((ext_vector_type(4)));
typedef short v4i16_t __attribute__((ext_vector_type(4)));
typedef LAS const unsigned char* lds_cptr;
constexpr int LDS_K = 0, KSLOT_MAX = 12288, LDS_V = 3 * KSLOT_MAX, VSLOT = 8192, LDS_WS = LDS_V + 3 * VSLOT, LDS_OST = LDS_WS + 8 * 256, LDS_TOTAL = LDS_OST + 8 * 8192;
static_assert(LDS_TOTAL <= RING_BYTES, "attention LDS");
constexpr float THR = 8.0f;
__device__ __forceinline__ void glds16(const void* g, unsigned lds_dst) {
    unsigned keep; asm volatile("s_mov_b32 %0, m0\n\ts_mov_b32 m0, %2\n\ts_nop 0\n\tglobal_load_lds_dwordx4 %1, off\n\ts_mov_b32 m0, %0" : "=&s"(keep) : "v"(g), "s"(lds_dst) : "memory"); }
__device__ __forceinline__ s16x4 vtr(lds_cptr p) { return __builtin_bit_cast(s16x4, __builtin_amdgcn_ds_read_tr16_b64_v4i16((LAS v4i16_t*)p)); }
__device__ __forceinline__ unsigned cvtpk(float lo, float hi) { typedef float f2 __attribute__((ext_vector_type(2))); typedef __bf16 b2 __attribute__((ext_vector_type(2))); f2 v = {lo, hi}; b2 b = __builtin_convertvector(v, b2); return __builtin_bit_cast(unsigned, b); }
#define AT_MX3(a, b, c) __builtin_fmaxf(__builtin_fmaxf((a), (b)), (c))
__device__ __forceinline__ float rowmax(const f32x16& p0, const f32x16& p1) {
    float a = AT_MX3(p0[0], p0[1], p1[0]), b = AT_MX3(p0[2], p0[3], p1[1]); a = AT_MX3(a, p1[2], p1[3]);
#pragma unroll
    for (int r = 4; r < 16; r += 4) { a = AT_MX3(a, p0[r], p0[r + 1]); b = AT_MX3(b, p0[r + 2], p0[r + 3]); a = AT_MX3(a, p1[r], p1[r + 1]); b = AT_MX3(b, p1[r + 2], p1[r + 3]); }
    float m = __builtin_fmaxf(a, b); auto rr = __builtin_amdgcn_permlane32_swap(__float_as_uint(m), __float_as_uint(m), false, false);
    return __builtin_fmaxf(__uint_as_float(rr[0]), __uint_as_float(rr[1])); }
#define AT_WAIT_BAR(N) asm volatile("s_waitcnt vmcnt(" #N ") lgkmcnt(0)\n\ts_barrier" ::: "memory")

struct Src { const bf16_t* p; long pitch; };
template <int NC, int NK0, int NK1>
__device__ __forceinline__ void stream(LAS unsigned char* lds, int tid, const bf16_t* qrow, Src k0, Src k1, Src vs, int NT, f32x16& o0, f32x16& o1, float& lsum) {
    asm volatile("" : "+v"(tid));
    constexpr int SLOTK = 2 * NC * 1024;
    const int lane = tid & 63, r32 = lane & 31, hi = lane >> 5; const int wid = __builtin_amdgcn_readfirstlane(tid >> 6);
    const unsigned lds0 = (unsigned)(uintptr_t)lds;
    LAS float* wsf = (LAS float*)(lds + LDS_WS) + wid * 64;
    constexpr int P0 = NK0 * 16;
    const bool hasA = (NK0 == 8) || (wid < 4), hasB = (NK1 > 0) && (wid < 4);
    const int pA = (NK0 == 8) ? wid : (wid & 3);
    const int rowA = (NK0 == 8) ? pA * 8 + (lane >> 3) : pA * 16 + (lane >> 2);
    const int chA = (NK0 == 8) ? ((lane & 7) ^ ((4 * pA + (lane >> 4)) & 7)) : ((lane & 3) ^ ((lane >> 4) & 3));
    const bf16_t* ksA = k0.p + (long)rowA * k0.pitch + chA * 8;
    const int rowB = (wid & 3) * 16 + (lane >> 2), chB = (lane & 3) ^ ((lane >> 4) & 3);
    const bf16_t* ksB = (NK1 > 0) ? k1.p + (long)rowB * k1.pitch + chB * 8 : k0.p;
    const bf16_t* vsp = vs.p + (long)(16 * (wid & 3) + (lane >> 2)) * vs.pitch + (wid >> 2) * 32 + (lane & 3) * 8;
    const unsigned kdA = lds0 + LDS_K + pA * 1024, kdB = lds0 + LDS_K + (NK0 + (wid & 3)) * 1024, vd = lds0 + LDS_V + wid * 1024;
    const long ktA = 64 * k0.pitch, ktB = 64 * k1.pitch, vt = 64 * vs.pitch;
    const int nd = (hasA ? 1 : 0) + (hasB ? 1 : 0) + 1;
#define AT_DMA_K(t, slot) do { if (hasA) glds16(ksA + (long)(t) * ktA, (unsigned)__builtin_amdgcn_readfirstlane(kdA + (slot) * SLOTK)); if (hasB) glds16(ksB + (long)(t) * ktB, (unsigned)__builtin_amdgcn_readfirstlane(kdB + (slot) * SLOTK)); } while (0)
#define AT_DMA_V(t, slot) glds16(vsp + (long)(t) * vt, (unsigned)__builtin_amdgcn_readfirstlane(vd + (slot) * VSLOT))
    lds_cptr kb[NC];
#pragma unroll
    for (int d0 = 0; d0 < NC; ++d0) { const int c = 2 * d0 + hi;
        if (2 * d0 < NK0) kb[d0] = (lds_cptr)lds + LDS_K + r32 * P0 + ((NK0 == 8) ? (c ^ ((r32 >> 1) & 7)) : (c ^ ((r32 >> 2) & 3))) * 16;
        else kb[d0] = (lds_cptr)lds + LDS_K + NK0 * 1024 + r32 * 64 + ((c - NK0) ^ ((r32 >> 2) & 3)) * 16; }
    const lds_cptr vp0 = (lds_cptr)lds + LDS_V + ((lane >> 4) & 1) * 32 + (lane & 3) * 8 + (4 * hi + ((lane & 15) >> 2)) * 64;
    AT_DMA_K(0, 0); AT_DMA_V(0, 0); if (NT > 1) AT_DMA_K(1, 1);
    bf16x8 qr[NC];
#pragma unroll
    for (int d0 = 0; d0 < NC; ++d0) qr[d0] = *(const bf16x8*)(qrow + 16 * d0 + 8 * hi);
    float mhat = 0.f, l = 0.f; f32x16 oa = {}, ob = {}, negm = {}, S0, S1; u32x4 pw0, pw1, pw2, pw3;
    asm volatile("" : "+v"(negm));
    AT_WAIT_BAR(0);
    __builtin_amdgcn_s_waitcnt(0);
#pragma unroll
    for (int d0 = 0; d0 < NC; ++d0) asm volatile("" : "+v"(qr[d0]));
    constexpr bool QLDS = (NC > 2);
    const lds_cptr qb = (lds_cptr)lds + LDS_OST + wid * 8192 + lane * 16;
    if (QLDS) {
#pragma unroll
        for (int d0 = 0; d0 < NC; ++d0) *(LAS bf16x8*)(lds + LDS_OST + wid * 8192 + lane * 16 + d0 * 1024) = qr[d0];
        LDS_WAIT();
    }
    int kc = 0, kn1 = 1, kn2 = 2, vpv = 2, vcu = 0, vnx = 1;
    bf16x8 kf[2 * NC], vf[8];
#define AT_SB() __builtin_amdgcn_sched_barrier(0)
#define AT_KRD(so_, d0) do { kf[2 * (d0)] = *(const LAS bf16x8*)(kb[d0] + (so_)); kf[2 * (d0) + 1] = *(const LAS bf16x8*)(kb[d0] + (so_) + 32 * ((2 * (d0) < NK0) ? P0 : 64)); if (QLDS) qr[d0] = *(const LAS bf16x8*)(qb + (d0) * 1024); } while (0)
#define AT_KHEAD(slot) do { const int kp_ = (slot) * SLOTK; AT_KRD(kp_, 0); } while (0)
#define AT_VF(i) ({ const s16x4 lo_ = vtr(vp_ + (((i) >> 2) * 4096 + ((i) & 3) * 1024)), hi_ = vtr(vp_ + (((i) >> 2) * 4096 + ((i) & 3) * 1024 + 512)); (bf16x8){lo_[0], lo_[1], lo_[2], lo_[3], hi_[0], hi_[1], hi_[2], hi_[3]}; })
#define AT_VHEAD(slot) do { const lds_cptr vp_ = vp0 + (slot) * VSLOT; vf[0] = AT_VF(0); vf[4] = AT_VF(4); } while (0)
#define AT_QKM(slot) do { const int kp_ = (slot) * SLOTK; \
        _Pragma("unroll") for (int d0 = 0; d0 < NC; ++d0) { if (d0 + 1 < NC) AT_KRD(kp_, d0 + 1); \
            if (d0 == 0) { S0 = MFMA32(kf[0], qr[0], negm); S1 = MFMA32(kf[1], qr[0], negm); } else { S0 = MFMA32(kf[2 * d0], qr[d0], S0); S1 = MFMA32(kf[2 * d0 + 1], qr[d0], S1); } AT_SB(); } } while (0)
#define AT_PVM(slot) do { const lds_cptr vp_ = vp0 + (slot) * VSLOT; \
        vf[1] = AT_VF(1); vf[5] = AT_VF(5); oa = MFMA32(__builtin_bit_cast(bf16x8, pw0), vf[0], oa); ob = MFMA32(__builtin_bit_cast(bf16x8, pw0), vf[4], ob); AT_SB(); \
        vf[2] = AT_VF(2); vf[6] = AT_VF(6); oa = MFMA32(__builtin_bit_cast(bf16x8, pw1), vf[1], oa); ob = MFMA32(__builtin_bit_cast(bf16x8, pw1), vf[5], ob); AT_SB(); \
        vf[3] = AT_VF(3); vf[7] = AT_VF(7); oa = MFMA32(__builtin_bit_cast(bf16x8, pw2), vf[2], oa); ob = MFMA32(__builtin_bit_cast(bf16x8, pw2), vf[6], ob); AT_SB(); \
        oa = MFMA32(__builtin_bit_cast(bf16x8, pw3), vf[3], oa); ob = MFMA32(__builtin_bit_cast(bf16x8, pw3), vf[7], ob); AT_SB(); } while (0)
    bool resc = false; u32x4 qw0, qw1, qw2, qw3; float sacc = 0.f;
#define AT_PIN(x) asm volatile("" : "+v"(x))
#define AT_DECIDE(first) do { const float rm_ = rowmax(S0, S1); resc = false; \
        if ((first) || __any(rm_ > THR)) { const float dl_ = (first) ? rm_ : __builtin_fmaxf(rm_, 0.f); mhat += dl_; \
            _Pragma("unroll") for (int r = 0; r < 16; ++r) { S0[r] -= dl_; S1[r] -= dl_; negm[r] = -mhat; } asm volatile("" : "+v"(negm)); \
            if (!(first)) { const float f_ = fast_exp2(-dl_); l *= f_; if (hi == 0) wsf[r32] = f_; resc = true; } } } while (0)
#define AT_RESC() do { if (resc) { LDS_WAIT(); \
        _Pragma("unroll") for (int r = 0; r < 16; ++r) { const float g_ = wsf[crow(r, hi)]; oa[r] *= g_; ob[r] *= g_; } LDS_WAIT(); } } while (0)
#define AT_EXP8(S, b, Q) do { \
        _Pragma("unroll") for (int r = 0; r < 8; ++r) S[(b) + r] = fast_exp2(S[(b) + r]); \
        sacc += (S[(b)] + S[(b) + 1]) + (S[(b) + 2] + S[(b) + 3]); sacc += (S[(b) + 4] + S[(b) + 5]) + (S[(b) + 6] + S[(b) + 7]); \
        Q = (u32x4){cvtpk(S[(b)], S[(b) + 1]), cvtpk(S[(b) + 2], S[(b) + 3]), cvtpk(S[(b) + 4], S[(b) + 5]), cvtpk(S[(b) + 6], S[(b) + 7])}; AT_PIN(Q); AT_PIN(sacc); } while (0)
#define AT_EXPALL() do { sacc = 0.f; AT_EXP8(S0, 0, qw0); AT_EXP8(S0, 8, qw1); AT_EXP8(S1, 0, qw2); AT_EXP8(S1, 8, qw3); l += sacc; pw0 = qw0; pw1 = qw1; pw2 = qw2; pw3 = qw3; } while (0)
#define AT_PV_EXP(slot, C0, C1, C2, C3, N0, N1, N2, N3) do { const lds_cptr vp_ = vp0 + (slot) * VSLOT; sacc = 0.f; \
        vf[1] = AT_VF(1); vf[5] = AT_VF(5); oa = MFMA32(__builtin_bit_cast(bf16x8, C0), vf[0], oa); ob = MFMA32(__builtin_bit_cast(bf16x8, C0), vf[4], ob); AT_EXP8(S0, 0, N0); AT_SB(); \
        vf[2] = AT_VF(2); vf[6] = AT_VF(6); oa = MFMA32(__builtin_bit_cast(bf16x8, C1), vf[1], oa); ob = MFMA32(__builtin_bit_cast(bf16x8, C1), vf[5], ob); AT_EXP8(S0, 8, N1); AT_SB(); \
        vf[3] = AT_VF(3); vf[7] = AT_VF(7); oa = MFMA32(__builtin_bit_cast(bf16x8, C2), vf[2], oa); ob = MFMA32(__builtin_bit_cast(bf16x8, C2), vf[6], ob); AT_EXP8(S1, 0, N2); AT_SB(); \
        oa = MFMA32(__builtin_bit_cast(bf16x8, C3), vf[3], oa); ob = MFMA32(__builtin_bit_cast(bf16x8, C3), vf[7], ob); AT_EXP8(S1, 8, N3); AT_SB(); \
        l += sacc; } while (0)
#define AT_STEP_WAIT(t) do { if ((t) + 2 < NT) { if (nd == 3) AT_WAIT_BAR(3); else if (nd == 2) AT_WAIT_BAR(2); else AT_WAIT_BAR(1); } else AT_WAIT_BAR(0); } while (0)
#define AT_ROT() do { const int a_ = kc; kc = kn1; kn1 = kn2; kn2 = a_; const int b_ = vpv; vpv = vcu; vcu = vnx; vnx = b_; } while (0)
    AT_DMA_K(2, kn2); AT_DMA_V(1, vnx);
    AT_KHEAD(kc); AT_SB();
    AT_QKM(kc); AT_DECIDE(true); AT_EXPALL();
    AT_STEP_WAIT(0); AT_ROT();
#define AT_STEP(t, C0, C1, C2, C3, N0, N1, N2, N3) do { \
        if ((t) + 2 < NT) AT_DMA_K((t) + 2, kn2); \
        if ((t) + 1 < NT) AT_DMA_V((t) + 1, vnx); \
        AT_KHEAD(kc); AT_VHEAD(vpv); AT_SB(); \
        AT_QKM(kc); \
        AT_DECIDE(false); AT_SB(); \
        AT_PV_EXP(vpv, C0, C1, C2, C3, N0, N1, N2, N3); \
        AT_RESC(); \
        AT_STEP_WAIT(t); AT_ROT(); } while (0)
    int t = 1;
    for (; t + 1 < NT; t += 2) { AT_STEP(t, pw0, pw1, pw2, pw3, qw0, qw1, qw2, qw3); AT_STEP(t + 1, qw0, qw1, qw2, qw3, pw0, pw1, pw2, pw3); }
    if (t < NT) { AT_STEP(t, pw0, pw1, pw2, pw3, qw0, qw1, qw2, qw3); pw0 = qw0; pw1 = qw1; pw2 = qw2; pw3 = qw3; }
#undef AT_STEP
    AT_VHEAD(vpv); AT_SB(); AT_PVM(vpv);
    { auto rr = __builtin_amdgcn_permlane32_swap(__float_as_uint(l), __float_as_uint(l), false, false); l = __uint_as_float(rr[0]) + __uint_as_float(rr[1]); }
    o0 = oa; o1 = ob; lsum = l;
#undef AT_DMA_K
#undef AT_DMA_V
#undef AT_SB
#undef AT_KRD
#undef AT_KHEAD
#undef AT_VF
#undef AT_VHEAD
#undef AT_QKM
#undef AT_PVM
#undef AT_PIN
#undef AT_DECIDE
#undef AT_RESC
#undef AT_EXP8
#undef AT_EXPALL
#undef AT_PV_EXP
#undef AT_STEP_WAIT
#undef AT_ROT
}
__device__ __forceinline__ void normalise(LAS unsigned char* lds, int tid, f32x16& o0, f32x16& o1, float lsum) {
    const int lane = tid & 63, r32 = lane & 31, hi = lane >> 5; const int wid = __builtin_amdgcn_readfirstlane(tid >> 6);
    LAS float* wsf = (LAS float*)(lds + LDS_WS) + wid * 64;
    if (hi == 0) wsf[32 + r32] = 1.0f / lsum; LDS_WAIT();
#pragma unroll
    for (int r = 0; r < 16; ++r) { const float g = wsf[32 + crow(r, hi)]; o0[r] *= g; o1[r] *= g; }
    LDS_WAIT();
}
}

struct AttnUnitId { int kind, seq, head, qb; };
__device__ __forceinline__ bool attn_unit_at(int i, int G, int bid, AttnUnitId& u) {
    const long L = (long)i * G + bid; if (L >= 2560) return false; int o = (int)L;
    int kind, longs, nh;
    if (o < 512) { kind = 0; longs = 1; nh = 4; } else if (o < 1024) { kind = 0; longs = 0; nh = 4; o -= 512; } else if (o < 1792) { kind = 1; longs = 1; nh = 6; o -= 1024; } else { kind = 1; longs = 0; nh = 6; o -= 1792; }
    const int nqb = longs ? 16 : 8;
    int pair, qb;
    if (G == 256) { const int rnd = o >> 8, b = o & 255, x = b & 7, c = b >> 3;
        const int ppr = 32 / nqb; pair = x + 8 * (rnd * ppr + c / nqb); qb = c % nqb; }
    else { pair = o / nqb; qb = o % nqb; }
    u.kind = kind; u.head = pair % nh; const int sq = pair / nh; u.seq = longs ? 16 + sq : sq; u.qb = qb; return true;
}
__device__ __forceinline__ void attn_ab_phase(Frame& F, const Args& a, int layer, int kmask = 3) {
    const bf16_t* H = (const bf16_t*)(F.ws + WS_H); const bf16_t* QB = (const bf16_t*)(F.ws + WS_QB); const bf16_t* KVB = (const bf16_t*)(F.ws + WS_KVB);
    bf16_t* MIX = (bf16_t*)(F.ws + WS_MIX);
    const int wid = F.wave;
    float lam, lam_init;
    { const float* lv = a.diff_lambda + layer * 128; float d1 = 0.f, d2 = 0.f;
      for (int i = 0; i < 32; ++i) { d1 += lv[i] * lv[32 + i]; d2 += lv[64 + i] * lv[96 + i]; }
      lam_init = 0.8f - 0.6f * expf(-0.3f * (float)layer); lam = expf(d1) - expf(d2) + lam_init;
      lam = __uint_as_float(__builtin_amdgcn_readfirstlane(__float_as_uint(lam))); lam_init = __uint_as_float(__builtin_amdgcn_readfirstlane(__float_as_uint(lam_init))); }
    AttnUnitId u;
    for (int i = 0; attn_unit_at(i, F.G, F.bid, u); ++i) {
        if (!((kmask >> u.kind) & 1)) continue;
        int tid = F.tid; asm volatile("" : "+v"(tid)); const int lane = tid & 63, r32 = lane & 31, hi = lane >> 5;
        const int len = (u.seq < 16) ? 2048 : 4096, base = (u.seq < 16) ? u.seq * 2048 : NTOK_P + (u.seq - 16) * 4096, NT = len / 64;
        const int m0 = base + u.qb * 256 + wid * 32;
        LAS bf16_t* sb = (LAS bf16_t*)(F.lds + at::LDS_OST + wid * 8192);
        LAS float* sf = (LAS float*)sb;
        if (u.kind == 0) {
            f32x16 q0, q1; float ls;
            { f32x16 p0, p1; const at::Src ks{H + (size_t)base * HP + HC_AK + u.head * 64, HP}, vs{H + (size_t)base * HP + HC_AV + u.head * 64, HP};
              at::stream<2, 4, 0>(F.lds, tid, H + (size_t)(m0 + r32) * HP + HC_AQ + u.head * 64, ks, ks, vs, NT, p0, p1, ls); at::normalise(F.lds, tid, p0, p1, ls);
#pragma unroll
              for (int r = 0; r < 16; ++r) { const int row = crow(r, hi); sf[row * 64 + r32] = p0[r]; sf[row * 64 + 32 + r32] = p1[r]; }
              AT_WAIT_BAR(0); }
            { const at::Src ks{H + (size_t)base * HP + HC_AK + u.head * 64 + 32, HP}, vs{H + (size_t)base * HP + HC_AV + u.head * 64, HP};
              at::stream<2, 4, 0>(F.lds, tid, H + (size_t)(m0 + r32) * HP + HC_AQ + u.head * 64 + 32, ks, ks, vs, NT, q0, q1, ls); at::normalise(F.lds, tid, q0, q1, ls); }
            float xa[16], xb[16];
#pragma unroll
            for (int r = 0; r < 16; ++r) { const int row = crow(r, hi); xa[r] = sf[row * 64 + r32] - lam * q0[r]; xb[r] = sf[row * 64 + 32 + r32] - lam * q1[r]; }
            LDS_WAIT();
            const float* sg = a.diff_subln + layer * 64; const float g0 = sg[r32] * (1.0f - lam_init), g1 = sg[32 + r32] * (1.0f - lam_init);
#pragma unroll
            for (int r = 0; r < 16; ++r) { const float x0 = xa[r], x1 = xb[r]; float ss = x0 * x0 + x1 * x1;
                ss += shx<1>(ss); ss += shx<2>(ss); ss += shx<4>(ss); ss += shx<8>(ss); ss += shx<16>(ss);
                const float rs = 1.0f / sqrtf(ss * (1.0f / 64.0f) + RMS_EPS); const int row = crow(r, hi);
                sb[row * 64 + r32] = (bf16_t)f2bf(x0 * rs * g0); sb[row * 64 + 32 + r32] = (bf16_t)f2bf(x1 * rs * g1); }
            LDS_WAIT();
#pragma unroll
            for (int it = 0; it < 4; ++it) { const int row = it * 8 + (lane >> 3), ch = lane & 7; *(u32x4*)(MIX + (size_t)(m0 + row) * DM + MIX_A + u.head * 64 + ch * 8) = *(const LAS u32x4*)(sb + row * 64 + ch * 8); }
        } else {
            f32x16 p0, p1; float ls;
            const at::Src k0{KVB + (size_t)base * KVP + u.head * 128, KVP}, k1{H + (size_t)base * HP + HC_KROPE, HP}, vs{KVB + (size_t)base * KVP + u.head * 128 + 64, KVP};
            at::stream<6, 8, 4>(F.lds, tid, QB + (size_t)(m0 + r32) * QBP + u.head * 96, k0, k1, vs, NT, p0, p1, ls); at::normalise(F.lds, tid, p0, p1, ls);
#pragma unroll
            for (int r = 0; r < 16; ++r) { const int row = crow(r, hi); sb[row * 64 + r32] = (bf16_t)f2bf(p0[r]); sb[row * 64 + 32 + r32] = (bf16_t)f2bf(p1[r]); }
            LDS_WAIT();
#pragma unroll
            for (int it = 0; it < 4; ++it) { const int row = it * 8 + (lane >> 3), ch = lane & 7; *(u32x4*)(MIX + (size_t)(m0 + row) * DM + MIX_B + u.head * 64 + ch * 8) = *(const LAS u32x4*)(sb + row * 64 + ch * 8); }
        }
        AT_WAIT_BAR(0);
    }
}

struct ListRows { const int* list; int seg0, cnt; __device__ __forceinline__ int src(int m) const { const int r = m - seg0; return (r < cnt) ? (list[r] >> 1) : 0; } };
__device__ __forceinline__ void moe_segments(Frame& F, int layer, LAS int* seg) {
    if (F.tid == 0) { int acc = 0; for (int e = 0; e < NEXP; ++e) { const int c = (int)__hip_atomic_load(F.ctl + CW_CNT + layer * 64 + e, RLX_AGENT); seg[e] = acc; seg[33 + e] = c; acc += (c + 255) & ~255; } seg[32] = acc; }
    __syncthreads();
}
__device__ __forceinline__ int seg_find(const LAS int* seg, int row) { int e = 0;
#pragma unroll
    for (int s = 16; s > 0; s >>= 1) if (seg[e + s] <= row) e += s;
    return e; }
__device__ __forceinline__ void moe_up_simple(Frame& F, int layer) {
    LAS int* seg = (LAS int*)(F.lds + RING_BYTES); moe_segments(F, layer, seg);
    const bf16_t* XB = (const bf16_t*)(F.ws + WS_XB); const bf16_t* W13 = (const bf16_t*)(F.ws + WS_W13); const int* list = (const int*)(F.ws + WS_LIST);
    const EpiHid E{(bf16_t*)(F.ws + WS_HID)};
    const int items = (seg[32] / 32) * 16;
    for (int it = F.gw; it < items; it += F.NGW) { const int mt = it >> 4, ct = it & 15, m0 = mt * 32, e = seg_find(seg, m0), c0 = ct * 32;
        const ListRows RM{list + (size_t)e * LIST_CAP, seg[e], seg[33 + e]};
        const bf16_t* Bg = W13 + (size_t)e * 1024 * 1024 + (size_t)((c0 >> 7) * 256 + (c0 & 127)) * 1024;
        sg_tile(XB, DM, Bg, Bg + (size_t)128 * 1024, 1024, 1024, m0, c0, E, RM, F.lane); }
    __syncthreads();
}
__device__ __forceinline__ void moe_down_simple(Frame& F, int layer) {
    LAS int* seg = (LAS int*)(F.lds + RING_BYTES); moe_segments(F, layer, seg);
    const bf16_t* HID = (const bf16_t*)(F.ws + WS_HID); const bf16_t* W2 = (const bf16_t*)(F.ws + WS_W2); const int* list = (const int*)(F.ws + WS_LIST);
    const int items = (seg[32] / 32) * 16;
    for (int it = F.gw; it < items; it += F.NGW) { const int mt = it >> 4, ct = it & 15, m0 = mt * 32, e = seg_find(seg, m0), c0 = ct * 64;
        const EpiY E{(bf16_t*)(F.ws + WS_YB), (const float*)(F.ws + WS_TW), list + (size_t)e * LIST_CAP, seg[e], seg[33 + e]};
        const bf16_t* B0 = W2 + (size_t)e * 1024 * 512 + (size_t)c0 * 512;
        sg_tile(HID, DEXP, B0, B0 + (size_t)32 * 512, 512, 512, m0, c0, E, IdRows(), F.lane); }
    __syncthreads();
}


struct MoeUpSched {
    const char* XB; const char* W13; const LAS int* seg; const int* list; int nM, G, c;
    __device__ __forceinline__ bool next(int i, pg8::Unit& u) const { if (!pg8::order_next(i, G, c, nM, 4, u.pm, u.pn)) return false; u.e = __builtin_amdgcn_readfirstlane(seg_find(seg, u.pm * 256)); u.a = XB; u.b = W13 + ((size_t)u.e * 1024 + (size_t)u.pn * 256) * 2048; return true; }
    __device__ __forceinline__ unsigned arow(const pg8::Unit& u, int r) const { const int rr = u.pm * 256 + r - __builtin_amdgcn_readfirstlane(seg[u.e]); return (rr < __builtin_amdgcn_readfirstlane(seg[33 + u.e])) ? (unsigned)(list[(size_t)u.e * LIST_CAP + rr] >> 1) : 0u; }
};
struct MoeDownSched {
    const char* HID; const char* W2; const LAS int* seg; int nM, G, c;
    __device__ __forceinline__ bool next(int i, pg8::Unit& u) const { if (!pg8::order_next(i, G, c, nM, 4, u.pm, u.pn)) return false; u.e = __builtin_amdgcn_readfirstlane(seg_find(seg, u.pm * 256)); u.a = HID + (size_t)u.pm * 256 * DEXP * 2; u.b = W2 + ((size_t)u.e * 1024 + (size_t)u.pn * 256) * 1024; return true; }
    __device__ __forceinline__ unsigned arow(const pg8::Unit&, int) const { return 0u; }
};
__device__ __forceinline__ void moe_up_opt(Frame& F, int layer) {
    LAS int* seg = (LAS int*)(F.lds + RING_BYTES); moe_segments(F, layer, seg);
    const MoeUpSched S{(const char*)(F.ws + WS_XB), (const char*)(F.ws + WS_W13), seg, (const int*)(F.ws + WS_LIST), __builtin_amdgcn_readfirstlane(seg[32]) / 256, F.G, F.bid};
    const EpiHid E{(bf16_t*)(F.ws + WS_HID)};
    pg8::gemm_phase<EpiHid, MoeUpSched, true, true>(F.lds, F.tid, 1024, DM, S, E);
    __syncthreads();
}
__device__ __forceinline__ void moe_down_opt(Frame& F, int layer) {
    LAS int* seg = (LAS int*)(F.lds + RING_BYTES); moe_segments(F, layer, seg);
    const MoeDownSched S{(const char*)(F.ws + WS_HID), (const char*)(F.ws + WS_W2), seg, __builtin_amdgcn_readfirstlane(seg[32]) / 256, F.G, F.bid};
    const EpiYO E{(bf16_t*)(F.ws + WS_YB), (const float*)(F.ws + WS_TW), (const int*)(F.ws + WS_LIST), seg};
    pg8::gemm_phase<EpiYO, MoeDownSched, false, false>(F.lds, F.tid, DEXP, DEXP, S, E);
    __syncthreads();
}
template <class Epi>
__device__ __forceinline__ void pg_phase(Frame& F, const bf16_t* A, int lda, const bf16_t* Bt, int panel, int N, int K, const Epi& E) {
    pg8::PanelSched S; S.init(A, lda, Bt, panel, N, K);
    pg8::gemm_phase<Epi, pg8::PanelSched, false, false>(F.lds, F.tid, K, lda, S, E);
}
__device__ __forceinline__ void local_sync(Frame& F) {
    asm volatile("s_waitcnt vmcnt(0) lgkmcnt(0)" ::: "memory");
    __syncthreads();
    if (F.tid == 0) { __builtin_amdgcn_fence(__ATOMIC_ACQUIRE, "agent"); asm volatile("s_waitcnt vmcnt(0)" ::: "memory"); }
    __syncthreads();
}
template <class Epi>
__device__ __forceinline__ void og_phase(Frame& F, const bf16_t* A, int lda, const bf16_t* Bt, int M, int N, int K, const Epi& E) {
    pg8::DenseSched S; S.init(A, lda, Bt, M, N, K, F.G, F.bid);
    pg8::gemm_phase<Epi, pg8::DenseSched, false, false>(F.lds, F.tid, K, lda, S, E);
}

#ifndef PANEL_PROG
#define PANEL_PROG 1
#endif
#if PANEL_PROG
constexpr int PH_PER_LAYER = 6, N_PHASES = 2 + DEPTH * PH_PER_LAYER;
#else
constexpr int PH_PER_LAYER = 9, N_PHASES = 1 + DEPTH * PH_PER_LAYER;
#endif
__global__ void __launch_bounds__(NTHREADS, 2) fwd(Args args) {
    extern __shared__ __attribute__((aligned(16))) unsigned char lds[];
    Frame F;
    F.lds = (LAS unsigned char*)lds; F.ldsg = lds;
    F.tid = threadIdx.x; F.lane = F.tid & 63; F.wave = __builtin_amdgcn_readfirstlane(F.tid >> 6);
    F.G = gridDim.x; F.bid = blockIdx.x; F.gw = blockIdx.x * NWAVES + F.wave; F.NGW = F.G * NWAVES;
    F.ws = args.ws; F.ctl = (gu32*)(args.ws + WS_CTL);
    volatile LAS unsigned* MISC = (volatile LAS unsigned*)(F.lds + MISC_OFF);
    for (int u = F.tid; u < (LDS_BYTES - RING_BYTES) / 4; u += NTHREADS) ((LAS unsigned*)(F.lds + RING_BYTES))[u] = 0u;
    __syncthreads();
    XcdBarrier bar; bar.bar = (unsigned*)(F.ctl + CW_BAR); bar.x = 0; bar.st = nullptr;
    if (args.use_bar) bar = xcd_barrier_post((unsigned*)(F.ctl + CW_BAR), MISC + 8);
    const int lo = args.ph_lo, hi = args.ph_hi;
#ifndef PH_MASK
#define PH_MASK 0x3ff
#endif
#define IN(k) (lo <= (k) && (k) < hi && (launder(F), true))
#define SEAM(k) do { if (lo <= (k) && (k) + 1 < hi) xcd_barrier(bar); } while (0)
    if ((PH_MASK & 1) && IN(0)) { p0_prologue(F, args);
#ifdef PROBE_DUP_P0
        launder(F); p0_prologue(F, args);
#endif
    }
    SEAM(0);
#if PANEL_PROG
    for (int layer = 0; layer < DEPTH; ++layer) {
        const int pb = 1 + layer * PH_PER_LAYER;
        if (IN(pb + 0)) {
            for (int panel = F.bid; panel < NTOK / 256; panel += F.G) {
                const int r0 = panel * 256;
                if (layer > 0) { ln2_pass(F, args, layer - 1, r0 + F.wave, NWAVES, r0 + 256); local_sync(F); launder(F); }
                { bf16_t* H = (bf16_t*)(F.ws + WS_H); const EpiH E{H, (const float2*)(F.ws + WS_ROPE32), (const float2*)(F.ws + WS_ROPE64)};
                  pg_phase(F, (const bf16_t*)(F.ws + WS_XB), DM, (const bf16_t*)(F.ws + WS_WIN) + (size_t)layer * 2560 * 1024, panel, 2560, 1024, E); }
                local_sync(F); launder(F);
                rowstat_pass(F, r0 + F.wave, NWAVES, r0 + 256);
                local_sync(F); launder(F);
                { bf16_t* H = (bf16_t*)(F.ws + WS_H); const EpiUQ Eq{(bf16_t*)(F.ws + WS_QB), (const float*)(F.ws + WS_RSTD), (const float2*)(F.ws + WS_ROPE32)};
                  pg_phase(F, H + HC_CQ_LAT, HP, (const bf16_t*)(F.ws + WS_WUQ) + (size_t)layer * 768 * 256, panel, 768, 256, Eq); }
                launder(F);
                { bf16_t* H = (bf16_t*)(F.ws + WS_H); const EpiUKV Ek{(bf16_t*)(F.ws + WS_KVB), (const float*)(F.ws + WS_RSTD)};
                  pg_phase(F, H + HC_CKV, HP, (const bf16_t*)(F.ws + WS_WUKV) + (size_t)layer * 768 * 256, panel, 768, 256, Ek); }
                launder(F);
            }
        }
        SEAM(pb + 0);
        if (IN(pb + 1)) { cstat_phase(F); }
        SEAM(pb + 1);
        if (IN(pb + 2)) { attn_ab_phase(F, args, layer); launder(F); sattn_phase(F, args, layer, 10); }
        SEAM(pb + 2);
        if (IN(pb + 3)) {
            for (int panel = F.bid; panel < NTOK / 256; panel += F.G) {
                const int r0 = panel * 256;
                { const EpiRes E{args.out, layer == 0 ? args.x_prompt : nullptr, args.x_sample, args.out};
                  pg_phase(F, (const bf16_t*)(F.ws + WS_MIX), DM, (const bf16_t*)(F.ws + WS_WOUT) + (size_t)layer * 1024 * 1024, panel, 1024, 1024, E); }
                local_sync(F); launder(F);
                ln1_route_pass(F, args, layer, r0 + F.wave, NWAVES, r0 + 256);
                launder(F);
            }
            moe_convert(F, args, layer);
        }
        SEAM(pb + 3);
        if (IN(pb + 4)) { moe_up_opt(F, layer);
#ifdef PROBE_DUP_MOE
            launder(F); moe_up_opt(F, layer);
#endif
        }
        SEAM(pb + 4);
        if (IN(pb + 5)) { moe_down_opt(F, layer);
#ifdef PROBE_DUP_MOE
            launder(F); moe_down_opt(F, layer);
#endif
        }
        SEAM(pb + 5);
    }
    if (IN(1 + DEPTH * PH_PER_LAYER)) { ln2_pass(F, args, DEPTH - 1, F.gw, F.NGW, NTOK); }
#else
    for (int layer = 0; layer < DEPTH; ++layer) {
        const int pb = 1 + layer * PH_PER_LAYER;
        if ((PH_MASK & (2 << 0)) && IN(pb + 0)) {   bf16_t* H = (bf16_t*)(F.ws + WS_H);
            const EpiH E{H, (const float2*)(F.ws + WS_ROPE32), (const float2*)(F.ws + WS_ROPE64)};
#if OPT_GEMM
            og_phase(F, (const bf16_t*)(F.ws + WS_XB), DM, (const bf16_t*)(F.ws + WS_WIN) + (size_t)layer * 2560 * 1024, NTOK, 2560, 1024, E);
#ifdef PROBE_DUP_GEMM
            launder(F); og_phase(F, (const bf16_t*)(F.ws + WS_XB), DM, (const bf16_t*)(F.ws + WS_WIN) + (size_t)layer * 2560 * 1024, NTOK, 2560, 1024, E);
#endif
#else
            sg_phase(F, (const bf16_t*)(F.ws + WS_XB), DM, (const bf16_t*)(F.ws + WS_WIN) + (size_t)layer * 2560 * 1024, 1024, NTOK, 2560, 1024, E);
#endif
        }
        SEAM(pb + 0);
        if ((PH_MASK & (2 << 1)) && IN(pb + 1)) { rowstat_pass(F, F.gw, F.NGW, NTOK); cstat_phase(F);
#ifdef PROBE_DUP_CSTAT
            launder(F); rowstat_pass(F, F.gw, F.NGW, NTOK); cstat_phase(F);
#endif
        }
        SEAM(pb + 1);
        if ((PH_MASK & (2 << 2)) && IN(pb + 2)) {
            bf16_t* H = (bf16_t*)(F.ws + WS_H);
            const EpiUQ Eq{(bf16_t*)(F.ws + WS_QB), (const float*)(F.ws + WS_RSTD), (const float2*)(F.ws + WS_ROPE32)};
#if OPT_GEMM
            og_phase(F, H + HC_CQ_LAT, HP, (const bf16_t*)(F.ws + WS_WUQ) + (size_t)layer * 768 * 256, NTOK, 768, 256, Eq);
            launder(F);
#else
            sg_phase(F, H + HC_CQ_LAT, HP, (const bf16_t*)(F.ws + WS_WUQ) + (size_t)layer * 768 * 256, 256, NTOK, 768, 256, Eq);
#endif
            const EpiUKV Ek{(bf16_t*)(F.ws + WS_KVB), (const float*)(F.ws + WS_RSTD)};
#if OPT_GEMM
            og_phase(F, H + HC_CKV, HP, (const bf16_t*)(F.ws + WS_WUKV) + (size_t)layer * 768 * 256, NTOK, 768, 256, Ek);
#ifdef PROBE_DUP_UP
            launder(F); og_phase(F, H + HC_CQ_LAT, HP, (const bf16_t*)(F.ws + WS_WUQ) + (size_t)layer * 768 * 256, NTOK, 768, 256, Eq);
            launder(F); og_phase(F, H + HC_CKV, HP, (const bf16_t*)(F.ws + WS_WUKV) + (size_t)layer * 768 * 256, NTOK, 768, 256, Ek);
#endif
#else
            sg_phase(F, H + HC_CKV, HP, (const bf16_t*)(F.ws + WS_WUKV) + (size_t)layer * 768 * 256, 256, NTOK, 768, 256, Ek);
#endif
        }
        SEAM(pb + 2);
        if ((PH_MASK & (2 << 3)) && IN(pb + 3)) {
#if OPT_ATTN
            attn_ab_phase(F, args, layer); launder(F);
#ifdef PROBE_DUP_ATTN
            attn_ab_phase(F, args, layer, PROBE_DUP_ATTN); launder(F);
#endif
            sattn_phase(F, args, layer, 10);
#ifdef PROBE_DUP_CFIN
            launder(F); sattn_phase(F, args, layer, 10);
#endif
#else
            sattn_phase(F, args, layer, 0);
#endif
        }
        SEAM(pb + 3);
        if ((PH_MASK & (2 << 4)) && IN(pb + 4)) {
#ifdef PROBE_DUP_WOUT
            { const EpiRes E0{args.out, layer == 0 ? args.x_prompt : nullptr, args.x_sample, (float*)(F.ws + WS_H)};
              og_phase(F, (const bf16_t*)(F.ws + WS_MIX), DM, (const bf16_t*)(F.ws + WS_WOUT) + (size_t)layer * 1024 * 1024, NTOK, 1024, 1024, E0); launder(F); }
#endif
            const EpiRes E{args.out, layer == 0 ? args.x_prompt : nullptr, args.x_sample, args.out};
#if OPT_GEMM
            og_phase(F, (const bf16_t*)(F.ws + WS_MIX), DM, (const bf16_t*)(F.ws + WS_WOUT) + (size_t)layer * 1024 * 1024, NTOK, 1024, 1024, E);
#else
            sg_phase(F, (const bf16_t*)(F.ws + WS_MIX), DM, (const bf16_t*)(F.ws + WS_WOUT) + (size_t)layer * 1024 * 1024, 1024, NTOK, 1024, 1024, E);
#endif
        }
        SEAM(pb + 4);
        if ((PH_MASK & (2 << 5)) && IN(pb + 5)) {
#ifdef PROBE_DUP_LN1
#endif
            ln1_route_pass(F, args, layer, F.gw, F.NGW, NTOK); moe_convert(F, args, layer);
#ifdef PROBE_DUP_CONV
            launder(F); moe_convert(F, args, layer);
#endif
        }
        SEAM(pb + 5);
#if OPT_GEMM
        if ((PH_MASK & (2 << 6)) && IN(pb + 6)) { moe_up_opt(F, layer);
#ifdef PROBE_DUP_MOE
            launder(F); moe_up_opt(F, layer);
#endif
        }
#else
        if ((PH_MASK & (2 << 6)) && IN(pb + 6)) { moe_up_simple(F, layer); }
#endif
        SEAM(pb + 6);
#if OPT_GEMM
        if ((PH_MASK & (2 << 7)) && IN(pb + 7)) { moe_down_opt(F, layer);
#ifdef PROBE_DUP_MOE
            launder(F); moe_down_opt(F, layer);
#endif
        }
#else
        if ((PH_MASK & (2 << 7)) && IN(pb + 7)) { moe_down_simple(F, layer); }
#endif
        SEAM(pb + 7);
        if ((PH_MASK & (2 << 8)) && IN(pb + 8)) { ln2_pass(F, args, layer, F.gw, F.NGW, NTOK); }
        SEAM(pb + 8);
    }
#endif
#undef IN
#undef SEAM
}

extern "C" void kernel_launch(void* const* d_in, const int* in_sizes, int n_in, void* d_out, int out_size, void* d_ws, size_t ws_size, hipStream_t stream) {
    static int grid = 0;
    if (grid == 0) {
        if (n_in != 19 || out_size != NTOK * DM || ws_size < WS_END) { fprintf(stderr, "kernel_launch: unexpected shapes (n_in %d out %d ws %zu)\n", n_in, out_size, ws_size); grid = -1; return; }
        int dev = 0, cus = 0, per_cu = 0;
        if (hipGetDevice(&dev) != hipSuccess || hipDeviceGetAttribute(&cus, hipDeviceAttributeMultiprocessorCount, dev) != hipSuccess) { grid = -1; return; }
        if (hipFuncSetAttribute((const void*)fwd, hipFuncAttributeMaxDynamicSharedMemorySize, LDS_BYTES) != hipSuccess) { grid = -1; return; }
        if (hipOccupancyMaxActiveBlocksPerMultiprocessor(&per_cu, (const void*)fwd, NTHREADS, LDS_BYTES) != hipSuccess || per_cu < 1) { fprintf(stderr, "kernel_launch: occupancy query says %d\n", per_cu); }
        (void)hipGetLastError();
        grid = cus;
    }
    if (grid < 0) return;
    if (hipMemsetAsync((char*)d_ws + WS_CTL, 0, CTL_ZERO_BYTES, stream) != hipSuccess) return;
    Args a{};
    a.x_prompt = (const float*)d_in[0]; a.x_sample = (const float*)d_in[1]; a.w_in = (const float*)d_in[2]; a.diff_lambda = (const float*)d_in[3]; a.diff_subln = (const float*)d_in[4];
    a.mla_q_norm = (const float*)d_in[5]; a.mla_w_uq = (const float*)d_in[6]; a.mla_kv_norm = (const float*)d_in[7]; a.mla_w_ukv = (const float*)d_in[8]; a.w_out = (const float*)d_in[9];
    a.ln1_g = (const float*)d_in[10]; a.ln1_b = (const float*)d_in[11]; a.moe_w_coarse = (const float*)d_in[12]; a.moe_w_fine = (const float*)d_in[13];
    a.moe_w1 = (const float*)d_in[14]; a.moe_w3 = (const float*)d_in[15]; a.moe_w2 = (const float*)d_in[16]; a.ln2_g = (const float*)d_in[17]; a.ln2_b = (const float*)d_in[18];
    a.out = (float*)d_out; a.ws = (unsigned char*)d_ws; a.pad = 0;
#if MK_ONE_LAUNCH
    a.ph_lo = 0; a.ph_hi = N_PHASES; a.use_bar = 1;
    hipLaunchKernelGGL(fwd, dim3(grid), dim3(NTHREADS), LDS_BYTES, stream, a);
#else
    for (int p = 0; p < N_PHASES; ++p) { a.ph_lo = p; a.ph_hi = p + 1; a.use_bar = 0; hipLaunchKernelGGL(fwd, dim3(grid), dim3(NTHREADS), LDS_BYTES, stream, a); }
#endif
}
```

```cpp
#include <hip/hip_runtime.h>
#include <cstdio>
#include <cstdint>

#ifndef OPT_ATTN
#define OPT_ATTN 1
#endif
#ifndef OPT_GEMM
#define OPT_GEMM 1
#endif
#ifndef MK_ONE_LAUNCH
#define MK_ONE_LAUNCH 1
#endif

#define GAS __attribute__((address_space(1)))
#define LAS __attribute__((address_space(3)))
typedef unsigned short bf16_t;
typedef short bf16x8 __attribute__((ext_vector_type(8)));
typedef float f32x4 __attribute__((ext_vector_type(4)));
typedef float f32x2 __attribute__((ext_vector_type(2)));
typedef float f32x16 __attribute__((ext_vector_type(16)));
typedef unsigned u32x4 __attribute__((ext_vector_type(4)));
typedef unsigned u32x2 __attribute__((ext_vector_type(2)));
typedef GAS unsigned gu32;
#define RLX_AGENT __ATOMIC_RELAXED, __HIP_MEMORY_SCOPE_AGENT
#define LDS_WAIT() asm volatile("s_waitcnt lgkmcnt(0)" ::: "memory")
#define VM_WAIT() asm volatile("s_waitcnt vmcnt(0)" ::: "memory")
#define MFMA32(a, b, c) __builtin_amdgcn_mfma_f32_32x32x16_bf16(a, b, c, 0, 0, 0)

__device__ __forceinline__ unsigned f2bf(float f) { unsigned u = __builtin_bit_cast(unsigned, f); return (u + 0x7fffu + ((u >> 16) & 1u)) >> 16; }
__device__ __forceinline__ unsigned pk2(float lo, float hi) { typedef float f2_ __attribute__((ext_vector_type(2))); typedef __bf16 b2_ __attribute__((ext_vector_type(2))); f2_ v = {lo, hi}; b2_ b = __builtin_convertvector(v, b2_); return __builtin_bit_cast(unsigned, b); }
__device__ __forceinline__ float bf2f(unsigned short b) { return __builtin_bit_cast(float, (unsigned)b << 16); }
__device__ __forceinline__ int crow(int r, int hi) { return (r & 3) + 8 * (r >> 2) + 4 * hi; }
template <int K> __device__ __forceinline__ float shx(float v) { static_assert(K < 32, "xor 32: use xsum32 / xmax32 / xpair32"); return __uint_as_float((unsigned)__builtin_amdgcn_ds_swizzle((int)__float_as_uint(v), (K << 10) | 0x1f)); }
__device__ __forceinline__ float xsum32(float v) { auto rr = __builtin_amdgcn_permlane32_swap(__float_as_uint(v), __float_as_uint(v), false, false); return __uint_as_float(rr[0]) + __uint_as_float(rr[1]); }
__device__ __forceinline__ float xmax32(float v) { auto rr = __builtin_amdgcn_permlane32_swap(__float_as_uint(v), __float_as_uint(v), false, false); return fmaxf(__uint_as_float(rr[0]), __uint_as_float(rr[1])); }
__device__ __forceinline__ float xpair32(float lo, float hi) { auto rr = __builtin_amdgcn_permlane32_swap(__float_as_uint(lo), __float_as_uint(hi), false, false); return __uint_as_float(rr[0]) + __uint_as_float(rr[1]); }
__device__ __forceinline__ float wave_sum(float v) {
    v += shx<1>(v); v += shx<2>(v); v += shx<4>(v); v += shx<8>(v); v += shx<16>(v);
    return xsum32(v);
}
__device__ __forceinline__ float fast_exp2(float x) { return __builtin_amdgcn_exp2f(x); }

constexpr int NTOK = 65536, DM = 1024, DEPTH = 4;
constexpr int NTOK_P = 32768;
constexpr int HP = 2560;
constexpr int HC_AQ = 0, HC_AK = 256, HC_AV = 512, HC_CQ_LAT = 768, HC_CKV = 1024, HC_KROPE = 1152, HC_CQ = 1280, HC_CK = 1664, HC_CV = 2048;
constexpr int QBP = 768, KVP = 768;
constexpr int MIX_A = 0, MIX_B = 256, MIX_C = 640;
constexpr int NEXP = 32, DEXP = 512;
constexpr float LOG2E = 1.4426950408889634f;
constexpr float SC_A = 0.17677669529663687f * LOG2E;
constexpr float SC_B = 0.10206207261596575f * LOG2E;
constexpr float SC_C = 0.125f * LOG2E;
constexpr float DN_ALPHA = 1.681792830507429f;
constexpr float LN_EPS = 1e-5f, RMS_EPS = 1e-6f;

constexpr size_t MiB = 1u << 20;
constexpr size_t WS_CTL = 0, CTL_ZERO_BYTES = 64 * 1024;
constexpr size_t WS_ROPE32 = 4 * MiB;
constexpr size_t WS_ROPE64 = 5 * MiB;
constexpr size_t WS_WIN = 8 * MiB;
constexpr size_t WS_WOUT = 28 * MiB;
constexpr size_t WS_WUQ = 36 * MiB;
constexpr size_t WS_WUKV = 38 * MiB;
constexpr size_t WS_W13 = 40 * MiB;
constexpr size_t WS_W2 = 104 * MiB;
constexpr size_t WS_XB = 136 * MiB;
constexpr size_t WS_H = 264 * MiB;
constexpr size_t WS_QB = 584 * MiB;
constexpr size_t WS_KVB = 680 * MiB;
constexpr size_t WS_MIX = 776 * MiB;
constexpr size_t WS_RSTD = 904 * MiB;
constexpr size_t WS_LSEC = 905 * MiB;
constexpr size_t WS_TW = 907 * MiB;
constexpr size_t WS_LIST = 908 * MiB;
constexpr size_t WS_END = 924 * MiB;
constexpr size_t WS_HID = WS_H;
constexpr size_t WS_YB = WS_H + 136 * MiB;
static_assert(WS_YB + 256 * MiB <= WS_KVB + 96 * MiB, "YB overlay");
constexpr int LIST_CAP = 131072;
constexpr int CW_TMO = 0;
constexpr int CW_CNT = 64;
constexpr int CW_BAR = 4096;

constexpr int RING_BYTES = 131072;
constexpr int MISC_OFF = RING_BYTES + 320;
constexpr int LDS_BYTES = 147456;
constexpr int NWAVES = 8, NTHREADS = 512;

#define XB_TMO      128
#define XB_XCNT(j)  (256  + 64 * (j))
#define XB_XSUB(j)  (1280 + 64 * (j))
#define XB_XGEN(j)  (2304 + 64 * (j))
#define XB_TOP      3328
#define XB_TOPGEN   3392
#define XCD_BAR_WORDS 3456
#define XB_SPIN_CAP (1u << 22)
__device__ __forceinline__ unsigned xb_ld(unsigned* p)              { return __hip_atomic_load(p, __ATOMIC_RELAXED, __HIP_MEMORY_SCOPE_AGENT); }
__device__ __forceinline__ unsigned xb_add(unsigned* p, unsigned v) { return __hip_atomic_fetch_add(p, v, __ATOMIC_RELAXED, __HIP_MEMORY_SCOPE_AGENT); }
__device__ __forceinline__ unsigned xb_xcc_id() { return (unsigned)__builtin_amdgcn_s_getreg((3 << 11) | 20) & 0xFu; }
#define XB_SPIN(cond, bar) do { unsigned _sp = 0; while (cond) { __builtin_amdgcn_s_sleep(1); \
    if ((++_sp & 255u) == 0u) { if (xb_ld(&(bar)[XB_TMO])) break; if (_sp > XB_SPIN_CAP) { atomicAdd(&(bar)[XB_TMO], 1u); break; } } } } while (0)
struct XcdBarrier { unsigned* bar; unsigned x; volatile LAS unsigned* st; };
__device__ __forceinline__ XcdBarrier xcd_barrier_post(unsigned* bar, volatile LAS unsigned* st) {
    XcdBarrier b; b.bar = bar; b.x = xb_xcc_id(); b.st = st;
    if (threadIdx.x == 0) (void)xb_add(&bar[XB_XCNT(b.x)], 1u);
    return b;
}
__device__ __forceinline__ void xcd_barrier_complete(unsigned* bar, unsigned x, unsigned& nloc, unsigned& nx) {
    const unsigned G = gridDim.x * gridDim.y * gridDim.z;
    unsigned sum, cnt, mine, sp = 0u;
    for (;;) {
        sum = 0u; cnt = 0u; mine = 0u;
#pragma unroll
        for (unsigned j = 0; j < 16; ++j) { const unsigned c = xb_ld(&bar[XB_XCNT(j)]); sum += c; cnt += (c > 0u) ? 1u : 0u; mine = (j == x) ? c : mine; }
        if (sum == G) break;
        __builtin_amdgcn_s_sleep(1);
        if ((++sp & 255u) == 0u) { if (xb_ld(&bar[XB_TMO])) break; if (sp > XB_SPIN_CAP) { atomicAdd(&bar[XB_TMO], 1u); break; } }
    }
    nloc = mine > 0u ? mine : 1u; nx = cnt > 0u ? cnt : 1u;
}
__device__ __forceinline__ void xcd_barrier(const XcdBarrier& b) {
    asm volatile("s_waitcnt vmcnt(0)" ::: "memory");
    __syncthreads();
    if (threadIdx.x == 0) {
        unsigned* bar = b.bar;
        __builtin_amdgcn_s_waitcnt(0);
        unsigned nloc = b.st[0], nx = b.st[1];
        if (nloc == 0u) { xcd_barrier_complete(bar, b.x, nloc, nx); b.st[0] = nloc; b.st[1] = nx; }
        const unsigned old = xb_add(&bar[XB_XSUB(b.x)], 1u);
        const unsigned gen = old / nloc;
        if (old + 1u == (gen + 1u) * nloc) {
            __builtin_amdgcn_fence(__ATOMIC_RELEASE, "agent");
            asm volatile("s_waitcnt vmcnt(0)" ::: "memory");
            const unsigned og = xb_add(&bar[XB_TOP], 1u);
            const unsigned tg = og / nx;
            if (og + 1u == (tg + 1u) * nx) xb_add(&bar[XB_TOPGEN], 1u);
            else XB_SPIN(xb_ld(&bar[XB_TOPGEN]) == tg, bar);
            __builtin_amdgcn_fence(__ATOMIC_ACQUIRE, "agent");
            xb_add(&bar[XB_XGEN(b.x)], 1u);
            asm volatile("s_waitcnt vmcnt(0)" ::: "memory");
        } else {
            XB_SPIN(xb_ld(&bar[XB_XGEN(b.x)]) == gen, bar);
            __builtin_amdgcn_fence(__ATOMIC_ACQUIRE, "agent");
            asm volatile("s_waitcnt vmcnt(0)" ::: "memory");
        }
    }
    __syncthreads();
}

struct Args {
    const float* x_prompt; const float* x_sample; const float* w_in; const float* diff_lambda; const float* diff_subln; const float* mla_q_norm; const float* mla_w_uq;
    const float* mla_kv_norm; const float* mla_w_ukv; const float* w_out; const float* ln1_g; const float* ln1_b; const float* moe_w_coarse; const float* moe_w_fine;
    const float* moe_w1; const float* moe_w3; const float* moe_w2; const float* ln2_g; const float* ln2_b;
    float* out; unsigned char* ws; int ph_lo, ph_hi, use_bar, pad;
};
struct Frame {
    LAS unsigned char* lds; unsigned char* ldsg;
    int tid, lane, wave, G, gw, NGW, bid;
    gu32* ctl; unsigned char* ws;
};
__device__ __forceinline__ void launder(Frame& F) {
    int wv = F.wave; asm volatile("" : "+s"(wv)); F.wave = wv;
    int t; asm volatile("v_mbcnt_lo_u32_b32 %0, -1, 0\n\tv_mbcnt_hi_u32_b32 %0, -1, %0" : "=v"(t)); F.lane = t; F.tid = wv * 64 + t;
    int b = (int)blockIdx.x; asm volatile("" : "+s"(b)); F.bid = b; F.gw = b * NWAVES + F.wave;
    unsigned char* w = F.ws; asm volatile("" : "+s"(w)); F.ws = w; F.ctl = (gu32*)(w + WS_CTL);
}
struct SeqInfo { int base, len, pos; };
__device__ __forceinline__ SeqInfo seqinfo(int m) { SeqInfo s; if (m < NTOK_P) { s.base = m & ~2047; s.len = 2048; } else { s.base = m & ~4095; s.len = 4096; } s.pos = m - s.base; return s; }

template <class ColMap>
__device__ __forceinline__ void transpose_item(const float* W, int N, bf16_t* WT, int ldd, LAS float* scr, int k0, int n0, const ColMap& cm, const float* kscale, int lane) {
    const int sc = cm(n0 + (lane & 31));
#pragma unroll 8
    for (int i = 0; i < 32; ++i) { const int kk = 2 * i + (lane >> 5); float v = 0.f; if (sc >= 0) { v = W[(size_t)(k0 + kk) * N + sc]; if (kscale) v *= kscale[k0 + kk]; } scr[kk * 33 + (lane & 31)] = v; }
    LDS_WAIT(); asm volatile("" ::: "memory");
    const int c = lane & 7;
#pragma unroll
    for (int j = 0; j < 4; ++j) { const int n = (lane >> 3) + 8 * j; const LAS float* s = scr + (8 * c) * 33 + n;
        u32x4 o; o.x = pk2(s[0 * 33], s[1 * 33]); o.y = pk2(s[2 * 33], s[3 * 33]); o.z = pk2(s[4 * 33], s[5 * 33]); o.w = pk2(s[6 * 33], s[7 * 33]);
        *(u32x4*)(WT + (size_t)(n0 + n) * ldd + k0 + 8 * c) = o; }
    LDS_WAIT(); asm volatile("" ::: "memory");
}
__device__ __forceinline__ void transpose_item_v4(const float* Wsrc, int N, bf16_t* WTdst, int ldd, LAS float* scr, int lane) {
    const int c4 = (lane & 7) * 4, kr = lane >> 3;
    f32x4 t[8];
#pragma unroll
    for (int i = 0; i < 8; ++i) t[i] = *(const f32x4*)(Wsrc + (size_t)(i * 8 + kr) * N + c4);
#pragma unroll
    for (int i = 0; i < 8; ++i) { const int kk = i * 8 + kr; scr[(c4 + 0) * 65 + kk] = t[i].x; scr[(c4 + 1) * 65 + kk] = t[i].y; scr[(c4 + 2) * 65 + kk] = t[i].z; scr[(c4 + 3) * 65 + kk] = t[i].w; }
    LDS_WAIT(); asm volatile("" ::: "memory");
    const int c = lane & 7;
#pragma unroll
    for (int j = 0; j < 4; ++j) { const int n = (lane >> 3) + 8 * j; const LAS float* p = scr + n * 65 + 8 * c;
        u32x4 o; o.x = pk2(p[0], p[1]); o.y = pk2(p[2], p[3]); o.z = pk2(p[4], p[5]); o.w = pk2(p[6], p[7]);
        *(u32x4*)(WTdst + (size_t)n * ldd + 8 * c) = o; }
    LDS_WAIT(); asm volatile("" ::: "memory");
}
struct WinMap {
    __device__ __forceinline__ int operator()(int n) const {
        if (n < 512) { const int t = n & 31; return (n & ~31) + (t >> 1) + 16 * (t & 1); }
        if (n < 1152) return n;
        if (n < 1184) { const int t = n - 1152; return 1152 + (t >> 1) + 16 * (t & 1); }
        if (n < 1280) return -1;
        if (n < 2048) { const int u = n - 1280, t = u & 63; return 1184 + (u & ~63) + (t >> 1) + 32 * (t & 1); }
        if (n < 2432) return 1952 + (n - 2048);
        return -1;
    }
};
struct UqMap { __device__ __forceinline__ int operator()(int n) const { if (n >= 576) return -1; const int h = n / 96, t = n - 96 * h; if (t < 64) return n; const int u = t - 64; return 96 * h + 64 + (u >> 1) + 16 * (u & 1); } };
struct IdMap { __device__ __forceinline__ int operator()(int n) const { return n; } };
struct W13Map { __device__ __forceinline__ int operator()(int n) const { return (n >> 8) * 128 + (n & 127); } };

__device__ __forceinline__ void p0_prologue(Frame& F, const Args& a) {
    LAS float* scr = (LAS float*)(F.lds + F.wave * 16384);
    { float2* r32 = (float2*)(F.ws + WS_ROPE32); float2* r64 = (float2*)(F.ws + WS_ROPE64);
      for (int i = F.gw * 64 + F.lane; i < 4096 * 16; i += F.NGW * 64) { const int pos = i >> 4, j = i & 15; const float inv = 1.0f / powf(10000.0f, (float)(2 * j) / 32.0f); const float ang = (float)pos * inv; r32[i] = make_float2(cosf(ang), sinf(ang)); }
      for (int i = F.gw * 64 + F.lane; i < 4096 * 32; i += F.NGW * 64) { const int pos = i >> 5, j = i & 31; const float inv = 1.0f / powf(10000.0f, (float)(2 * j) / 64.0f); const float ang = (float)pos * inv; r64[i] = make_float2(cosf(ang), sinf(ang)); } }
    constexpr int I_WIN = (1024 / 64) * (2560 / 32), I_WOUT = (1024 / 64) * (1024 / 32), I_UQ = (256 / 64) * (768 / 32), I_UKV = (256 / 64) * (768 / 32);
    constexpr int PER_L = I_WIN + I_WOUT + I_UQ + I_UKV;
    for (int it = F.gw; it < DEPTH * PER_L; it += F.NGW) {
        const int l = it / PER_L; int r = it - l * PER_L;
        if (r < I_WIN) { const int kb = r / 80, nb = r % 80; transpose_item(a.w_in + (size_t)l * 1024 * 2336, 2336, (bf16_t*)(F.ws + WS_WIN) + (size_t)l * 2560 * 1024, 1024, scr, kb * 64, nb * 32, WinMap(), nullptr, F.lane); continue; } r -= I_WIN;
        if (r < I_WOUT) { const int kb = r / 32, nb = r % 32; transpose_item(a.w_out + (size_t)l * 1024 * 1024, 1024, (bf16_t*)(F.ws + WS_WOUT) + (size_t)l * 1024 * 1024, 1024, scr, kb * 64, nb * 32, IdMap(), nullptr, F.lane); continue; } r -= I_WOUT;
        if (r < I_UQ) { const int kb = r / 24, nb = r % 24; transpose_item(a.mla_w_uq + (size_t)l * 256 * 576, 576, (bf16_t*)(F.ws + WS_WUQ) + (size_t)l * 768 * 256, 256, scr, kb * 64, nb * 32, UqMap(), a.mla_q_norm + l * 256, F.lane); continue; } r -= I_UQ;
        { const int kb = r / 24, nb = r % 24; bf16_t* dst = (bf16_t*)(F.ws + WS_WUKV) + (size_t)l * 768 * 256;
          if (kb < 2) transpose_item(a.mla_w_ukv + (size_t)l * 128 * 768, 768, dst, 256, scr, kb * 64, nb * 32, IdMap(), a.mla_kv_norm + l * 128, F.lane);
          else { const int c = F.lane & 7;
#pragma unroll
              for (int j = 0; j < 4; ++j) { const int n = (F.lane >> 3) + 8 * j; *(u32x4*)(dst + (size_t)(nb * 32 + n) * 256 + kb * 64 + 8 * c) = (u32x4){0u, 0u, 0u, 0u}; } } }
    }
    bf16_t* XB = (bf16_t*)(F.ws + WS_XB);
    for (int m = F.gw; m < NTOK; m += F.NGW) {
        const float* src = (m < NTOK_P) ? a.x_prompt + (size_t)m * DM : a.x_sample + (size_t)(m - NTOK_P) * DM;
#pragma unroll
        for (int j = 0; j < 4; ++j) { const f32x4 v = *((const f32x4*)src + F.lane + 64 * j);
            u32x2 w; w.x = pk2(v.x, v.y); w.y = pk2(v.z, v.w); *((u32x2*)(XB + (size_t)m * DM) + F.lane + 64 * j) = w; }
    }
}

template <class Epi, class RowMap>
__device__ __forceinline__ void sg_tile(const bf16_t* A, int lda, const bf16_t* B0, const bf16_t* B1, int ldb, int K, int m0, int c0, const Epi& E, const RowMap& RM, int lane) {
    const int r32 = lane & 31, hi = lane >> 5;
    const bf16_t* ap = A + (size_t)RM.src(m0 + r32) * lda + 8 * hi;
    const bf16_t* b0p = B0 + (size_t)r32 * ldb + 8 * hi;
    const bf16_t* b1p = B1 + (size_t)r32 * ldb + 8 * hi;
    f32x16 acc0 = {}, acc1 = {};
#pragma unroll 4
    for (int k = 0; k < K; k += 16) {
        const bf16x8 af = *(const bf16x8*)(ap + k), bf0 = *(const bf16x8*)(b0p + k), bf1 = *(const bf16x8*)(b1p + k);
        acc0 = MFMA32(bf0, af, acc0); acc1 = MFMA32(bf1, af, acc1);
    }
#pragma unroll
    for (int g = 0; g < 4; ++g) { const f32x4 v0 = {acc0[4 * g], acc0[4 * g + 1], acc0[4 * g + 2], acc0[4 * g + 3]}, v1 = {acc1[4 * g], acc1[4 * g + 1], acc1[4 * g + 2], acc1[4 * g + 3]};
        E.put(m0 + r32, c0, 8 * g + 4 * hi, v0, v1); }
}
struct IdRows { __device__ __forceinline__ int src(int m) const { return m; } };

__device__ __forceinline__ void store_bf8(bf16_t* p, f32x4 a, f32x4 b) { u32x4 w; w.x = pk2(a.x, a.y); w.y = pk2(a.z, a.w); w.z = pk2(b.x, b.y); w.w = pk2(b.z, b.w); *(u32x4*)p = w; }
__device__ __forceinline__ void store_bf4(bf16_t* p, f32x4 v) { u32x2 w; w.x = pk2(v.x, v.y); w.y = pk2(v.z, v.w); *(u32x2*)p = w; }
struct EpiH {
    static constexpr bool INPLACE = false;
    static constexpr bool PERM = true;
    bf16_t* H; const float2* rope32; const float2* rope64;
    __device__ __forceinline__ f32x4 xf(int pos, int col, f32x4 v) const {
        if (col < 512 || (col >= HC_KROPE && col < HC_KROPE + 32)) {
            const int j0 = (col & 31) >> 1; const f32x4 cs = *(const f32x4*)(rope32 + pos * 16 + j0);
            f32x4 o; o.x = v.x * cs.x - v.y * cs.y; o.y = v.x * cs.y + v.y * cs.x; o.z = v.z * cs.z - v.w * cs.w; o.w = v.z * cs.w + v.w * cs.z;
            if (col < 256) o = o * SC_A; v = o;
        } else if (col >= HC_CQ && col < HC_CV) {
            const int j0 = ((col - HC_CQ) & 63) >> 1; const f32x4 cs = *(const f32x4*)(rope64 + pos * 32 + j0);
            f32x4 o; o.x = v.x * cs.x - v.y * cs.y; o.y = v.x * cs.y + v.y * cs.x; o.z = v.z * cs.z - v.w * cs.w; o.w = v.z * cs.w + v.w * cs.z;
            if (col < HC_CK) o = o * SC_C; v = o;
        }
        return v;
    }
    __device__ __forceinline__ void put4(int row, int col, f32x4 v) const { store_bf4(H + (size_t)row * HP + col, xf(seqinfo(row).pos, col, v)); }
    __device__ __forceinline__ void put(int row, int c0, int cc, f32x4 v0, f32x4 v1) const { put4(row, c0 + cc, v0); put4(row, c0 + 32 + cc, v1); }
    template <class U> __device__ __forceinline__ void put8(const U&, int row, int col, f32x4 v0, f32x4 v1) const { const int pos = seqinfo(row).pos; store_bf8(H + (size_t)row * HP + col, xf(pos, col, v0), xf(pos, col + 4, v1)); }
    struct Pre { f32x4 c0, c1; };
    __device__ __forceinline__ static f32x4 rot(f32x4 v, f32x4 cs) { f32x4 o; o.x = v.x * cs.x - v.y * cs.y; o.y = v.x * cs.y + v.y * cs.x; o.z = v.z * cs.z - v.w * cs.w; o.w = v.z * cs.w + v.w * cs.z; return o; }
    template <class U> __device__ __forceinline__ Pre pre(const U&, int row, int col) const { Pre p; p.c0 = (f32x4){0.f, 0.f, 0.f, 0.f}; p.c1 = p.c0; const int pos = seqinfo(row).pos;
        if (col < 512 || (col >= HC_KROPE && col < HC_KROPE + 32)) { const f32x4* t = (const f32x4*)(rope32 + pos * 16 + ((col & 31) >> 1)); p.c0 = t[0]; p.c1 = t[1]; }
        else if (col >= HC_CQ && col < HC_CV) { const f32x4* t = (const f32x4*)(rope64 + pos * 32 + (((col - HC_CQ) & 63) >> 1)); p.c0 = t[0]; p.c1 = t[1]; }
        return p; }
    template <class U> __device__ __forceinline__ void fin8(const U&, int row, int col, f32x4 v0, f32x4 v1, const Pre& p) const {
        if (col < 512 || (col >= HC_KROPE && col < HC_KROPE + 32)) { v0 = rot(v0, p.c0); v1 = rot(v1, p.c1); if (col < 256) { v0 = v0 * SC_A; v1 = v1 * SC_A; } }
        else if (col >= HC_CQ && col < HC_CV) { v0 = rot(v0, p.c0); v1 = rot(v1, p.c1); if (col < HC_CK) { v0 = v0 * SC_C; v1 = v1 * SC_C; } }
        store_bf8(H + (size_t)row * HP + col, v0, v1); }
};
struct EpiUQ {
    static constexpr bool INPLACE = false;
    static constexpr bool PERM = true;
    bf16_t* Q; const float* rstd; const float2* rope32;
    __device__ __forceinline__ f32x4 xf(int row, int col, f32x4 v, float rs) const {
        v = v * rs;
        const int t = col % 96;
        if (t >= 64) { const int pos = seqinfo(row).pos; const int j0 = (t - 64) >> 1; const f32x4 cs = *(const f32x4*)(rope32 + pos * 16 + j0);
            f32x4 o; o.x = v.x * cs.x - v.y * cs.y; o.y = v.x * cs.y + v.y * cs.x; o.z = v.z * cs.z - v.w * cs.w; o.w = v.z * cs.w + v.w * cs.z; v = o; }
        return v * SC_B;
    }
    __device__ __forceinline__ void put4(int row, int col, f32x4 v) const { if (col >= 576) return; store_bf4(Q + (size_t)row * QBP + col, xf(row, col, v, rstd[2 * row])); }
    template <class U> __device__ __forceinline__ void put8(const U&, int row, int col, f32x4 v0, f32x4 v1) const { if (col >= 576) return; const float rs = rstd[2 * row]; store_bf8(Q + (size_t)row * QBP + col, xf(row, col, v0, rs), xf(row, col + 4, v1, rs)); }
    __device__ __forceinline__ void put(int row, int c0, int cc, f32x4 v0, f32x4 v1) const { put4(row, c0 + cc, v0); put4(row, c0 + 32 + cc, v1); }
    struct Pre { float rs; f32x4 c0, c1; };
    template <class U> __device__ __forceinline__ Pre pre(const U&, int row, int col) const { Pre p; p.rs = rstd[2 * row]; p.c0 = (f32x4){0.f, 0.f, 0.f, 0.f}; p.c1 = p.c0;
        if (col < 576 && (col % 96) >= 64) { const f32x4* t = (const f32x4*)(rope32 + seqinfo(row).pos * 16 + (((col % 96) - 64) >> 1)); p.c0 = t[0]; p.c1 = t[1]; }
        return p; }
    template <class U> __device__ __forceinline__ void fin8(const U&, int row, int col, f32x4 v0, f32x4 v1, const Pre& p) const { if (col >= 576) return;
        v0 = v0 * p.rs; v1 = v1 * p.rs; if ((col % 96) >= 64) { v0 = EpiH::rot(v0, p.c0); v1 = EpiH::rot(v1, p.c1); }
        store_bf8(Q + (size_t)row * QBP + col, v0 * SC_B, v1 * SC_B); }
};
struct EpiUKV {
    static constexpr bool INPLACE = false;
    static constexpr bool PERM = true;
    bf16_t* KV; const float* rstd;
    template <class U> __device__ __forceinline__ void put8(const U&, int row, int col, f32x4 v0, f32x4 v1) const { const float rs = rstd[2 * row + 1]; store_bf8(KV + (size_t)row * KVP + col, v0 * rs, v1 * rs); }
    __device__ __forceinline__ void put4(int row, int col, f32x4 v) const { store_bf4(KV + (size_t)row * KVP + col, v * rstd[2 * row + 1]); }
    __device__ __forceinline__ void put(int row, int c0, int cc, f32x4 v0, f32x4 v1) const { put4(row, c0 + cc, v0); put4(row, c0 + 32 + cc, v1); }
    struct Pre { float rs; };
    template <class U> __device__ __forceinline__ Pre pre(const U&, int row, int) const { Pre p; p.rs = rstd[2 * row + 1]; return p; }
    template <class U> __device__ __forceinline__ void fin8(const U&, int row, int col, f32x4 v0, f32x4 v1, const Pre& p) const { store_bf8(KV + (size_t)row * KVP + col, v0 * p.rs, v1 * p.rs); }
};
struct EpiRes {
    static constexpr bool INPLACE = true;
    static constexpr bool PERM = false;
    float* X; const float* xp; const float* xs; float* D;
    template <class U> __device__ __forceinline__ void put4(const U&, int row, int col, f32x4 v) const { put4(row, col, v); }
    __device__ __forceinline__ void put4(int row, int col, f32x4 v) const {
        const f32x4* p = (const f32x4*)(X + (size_t)row * DM + col);
        const f32x4 r = xp ? *(const f32x4*)(((row < NTOK_P) ? xp + (size_t)row * DM : xs + (size_t)(row - NTOK_P) * DM) + col) : *p;
        *(f32x4*)(D + (size_t)row * DM + col) = r * DN_ALPHA + v; }
    __device__ __forceinline__ void put(int row, int c0, int cc, f32x4 v0, f32x4 v1) const { put4(row, c0 + cc, v0); put4(row, c0 + 32 + cc, v1); }
    struct Pre { f32x4 a, b; };
    template <class U> __device__ __forceinline__ Pre pre(const U&, int row, int col) const { Pre p;
        const float* src = xp ? ((row < NTOK_P) ? xp + (size_t)row * DM : xs + (size_t)(row - NTOK_P) * DM) : X + (size_t)row * DM;
        p.a = *(const f32x4*)(src + col); p.b = *(const f32x4*)(src + col + 16); return p; }
    template <class U> __device__ __forceinline__ void fin4x2(const U&, int row, int col, f32x4 v0, f32x4 v1, const Pre& p) const {
        *(f32x4*)(D + (size_t)row * DM + col) = p.a * DN_ALPHA + v0; *(f32x4*)(D + (size_t)row * DM + col + 16) = p.b * DN_ALPHA + v1; }
};
__device__ __forceinline__ float silu_f(float x) { return x / (1.0f + __expf(-x)); }
struct EpiHid {
    static constexpr bool INPLACE = false;
    static constexpr bool PERM = true;
    bf16_t* HID;
    __device__ __forceinline__ f32x4 act(f32x4 g, f32x4 u) const { f32x4 o; o.x = silu_f(g.x) * u.x; o.y = silu_f(g.y) * u.y; o.z = silu_f(g.z) * u.z; o.w = silu_f(g.w) * u.w; return o; }
    template <class U> __device__ __forceinline__ void putp8(const U&, int row, int col, f32x4 g0, f32x4 g1, f32x4 u0, f32x4 u1) const { store_bf8(HID + (size_t)row * DEXP + col, act(g0, u0), act(g1, u1)); }
    __device__ __forceinline__ void putp(int row, int col, f32x4 g, f32x4 u) const { f32x4 o; o.x = silu_f(g.x) * u.x; o.y = silu_f(g.y) * u.y; o.z = silu_f(g.z) * u.z; o.w = silu_f(g.w) * u.w; store_bf4(HID + (size_t)row * DEXP + col, o); }
    __device__ __forceinline__ void put(int row, int c0, int cc, f32x4 v0, f32x4 v1) const { putp(row, c0 + cc, v0, v1); }
};
struct EpiY {
    static constexpr bool INPLACE = false;
    bf16_t* YB; const float* tw; const int* list; int seg0, cnt;
    __device__ __forceinline__ void put4(int row, int col, f32x4 v) const { const int r = row - seg0; if (r >= cnt) return; const int a = list[r]; store_bf4(YB + (size_t)a * DM + col, v * tw[a]); }
    __device__ __forceinline__ void put(int row, int c0, int cc, f32x4 v0, f32x4 v1) const { put4(row, c0 + cc, v0); put4(row, c0 + 32 + cc, v1); }
};

struct EpiYO {
    static constexpr bool INPLACE = false;
    static constexpr bool PERM = true;
    bf16_t* YB; const float* tw; const int* list; const LAS int* seg;
    template <class U> __device__ __forceinline__ void put8(const U& u, int row, int col, f32x4 v0, f32x4 v1) const {
        const int r = row - __builtin_amdgcn_readfirstlane(seg[u.e]); if (r >= __builtin_amdgcn_readfirstlane(seg[33 + u.e])) return; const int a = list[(size_t)u.e * LIST_CAP + r]; const float w = tw[a]; store_bf8(YB + (size_t)a * DM + col, v0 * w, v1 * w); }
    struct Pre { int a; float w; };
    template <class U> __device__ __forceinline__ Pre pre(const U& u, int row, int) const { Pre p; p.a = -1; p.w = 0.f;
        const int r = row - __builtin_amdgcn_readfirstlane(seg[u.e]); if (r < __builtin_amdgcn_readfirstlane(seg[33 + u.e])) { p.a = list[(size_t)u.e * LIST_CAP + r]; p.w = tw[p.a]; } return p; }
    template <class U> __device__ __forceinline__ void fin8(const U&, int, int col, f32x4 v0, f32x4 v1, const Pre& p) const { if (p.a >= 0) store_bf8(YB + (size_t)p.a * DM + col, v0 * p.w, v1 * p.w); }
};
template <class Epi>
__device__ __forceinline__ void sg_phase(Frame& F, const bf16_t* A, int lda, const bf16_t* Bt, int ldb, int M, int N, int K, const Epi& E) {
    const int nN = N / 64, items = (M / 32) * nN;
    for (int it = F.gw; it < items; it += F.NGW) { const int mt = it / nN, nt = it - mt * nN;
        sg_tile(A, lda, Bt + (size_t)(nt * 64) * ldb, Bt + (size_t)(nt * 64 + 32) * ldb, ldb, K, mt * 32, nt * 64, E, IdRows(), F.lane); }
}


namespace pg8 {
constexpr int BM = 256, BK = 64, HALF = 128, HTB = HALF * BK * 2, NXCD = 8, WGM = 8;
__host__ __device__ __forceinline__ int lds_byte(int r, int c) { const int st = (r >> 4) * 2 + (c >> 5), rr = r & 15, cc = c & 31, ob = rr * 64 + cc * 2; return st * 1024 + (ob ^ (((ob >> 9) & 1) << 5)); }
__host__ __device__ __forceinline__ void stage_rc(int b, int& R, int& C) { const int st = b / 1024, sb = b % 1024, swz = sb ^ (((sb >> 9) & 1) << 5); R = (st >> 1) * 16 + swz / 64; C = (st & 1) * 32 + (swz % 64) / 2; }
__host__ __device__ __forceinline__ int perm32(int rho) { const int n = rho >> 4, i = rho & 15; return 8 * (i >> 2) + 4 * n + (i & 3); }
struct Unit { int pm, pn, e; const char* a; const char* b; };
__device__ __forceinline__ bool order_next(int i, int G, int c, int nM, int nN, int& pm, int& pn) {
    const int nwg = nM * nN; const long L = (long)i * G + c; if (L >= nwg) return false;
    int wgid = (int)L; { const int q = nwg / NXCD, r = nwg % NXCD, xcd = wgid % NXCD, off = wgid / NXCD; wgid = (xcd < r ? xcd * (q + 1) : r * (q + 1) + (xcd - r) * q) + off; }
    const int nig = WGM * nN, gid = wgid / nig, fm = gid * WGM, gsz = (nM - fm) < WGM ? (nM - fm) : WGM;
    pm = fm + ((wgid % nig) % gsz); pn = (wgid % nig) / gsz; return true;
}
struct DenseSched {
    const char* A; const char* Bt; int nM, nN, G, c; size_t tstepA, tstepB;
    __device__ __forceinline__ void init(const bf16_t* A_, int lda, const bf16_t* Bt_, int M, int N, int K, int G_, int c_) { A = (const char*)A_; Bt = (const char*)Bt_; nM = M / BM; nN = N / BM; G = G_; c = c_; tstepA = (size_t)BM * lda * 2; tstepB = (size_t)BM * K * 2; }
    __device__ __forceinline__ bool next(int i, Unit& u) const { if (!order_next(i, G, c, nM, nN, u.pm, u.pn)) return false; u.e = 0; u.a = A + (size_t)u.pm * tstepA; u.b = Bt + (size_t)u.pn * tstepB; return true; }
    __device__ __forceinline__ unsigned arow(const Unit&, int) const { return 0u; }
};
struct PanelSched {
    const char* A; const char* Bt; int pm, nN; size_t tstepB;
    __device__ __forceinline__ void init(const bf16_t* A_, int lda, const bf16_t* Bt_, int pm_, int N, int K) { pm = pm_; nN = N / BM; A = (const char*)A_ + (size_t)pm_ * BM * lda * 2; Bt = (const char*)Bt_; tstepB = (size_t)BM * K * 2; }
    __device__ __forceinline__ bool next(int i, Unit& u) const { if (i >= nN) return false; u.pm = pm; int pn = i + (pm % nN); if (pn >= nN) pn -= nN; u.pn = pn; u.e = 0; u.a = A; u.b = Bt + (size_t)pn * tstepB; return true; }
    __device__ __forceinline__ unsigned arow(const Unit&, int) const { return 0u; }
};
template <class Epi, bool PAIR> struct EpiApply;
template <class Epi, class Sched, bool GATHER, bool PAIR>
__device__ __forceinline__ void gemm_phase(LAS unsigned char* lds, int tid, int K, int lda, const Sched& S, const Epi& E) {
    const int wid = __builtin_amdgcn_readfirstlane(tid >> 6), lane = tid & 63, wr = wid >> 2, wc = wid & 3, fr = lane & 15, fq = lane >> 4;
    const int nt = K / BK;
    unsigned voffA[2], voffB[2]; int RA[2], CA[2];
#pragma unroll
    for (int i = 0; i < 2; ++i) { int R, C; stage_rc(tid * 16 + i * 8192, R, C); const int Rb = Epi::PERM ? ((R & ~31) + perm32(R & 31)) : R; RA[i] = R; CA[i] = C;
        voffA[i] = (unsigned)(R * lda + C) * 2u; voffB[i] = (unsigned)(Rb * K + C) * 2u; }
    const size_t kstep = (size_t)(BK * 2);
    const size_t hstepA = (size_t)HALF * lda * 2, hstepB = (size_t)HALF * K * 2;
    const unsigned ldsw = (unsigned)wid * 1024u;
    const int aoff = lds_byte(wr * 64 + fr, fq * 8), boff = lds_byte(wc * 32 + fr, fq * 8);
#define PG8_SA(b, h) (((b) * 2 + (h)) * HTB)
#define PG8_SB(b, h) ((4 + (b) * 2 + (h)) * HTB)
#define PG8_STAGE(bufoff, gbase, voff) do { _Pragma("unroll") for (int _i = 0; _i < 2; ++_i) \
        __builtin_amdgcn_global_load_lds((const unsigned*)((const char*)(gbase) + (voff)[_i]), (LAS unsigned*)(lds + (bufoff) + ldsw + _i * 8192), 16, 0, 0); } while (0)
#define PG8_STAGE_A(bufoff, ab, vg, h, koff) do { if (GATHER) { PG8_STAGE(bufoff, (ab) + (koff), (vg)[h]); } else { PG8_STAGE(bufoff, (ab) + (h) * hstepA + (koff), voffA); } } while (0)
#define PG8_LDA(dst, b, h) do { _Pragma("unroll") for (int m = 0; m < 4; ++m) _Pragma("unroll") for (int k = 0; k < 2; ++k) dst[m][k] = *(const LAS bf16x8*)(lds + PG8_SA(b, h) + aoff + m * 2048 + k * 1024); } while (0)
#define PG8_LDB(dst, b, h) do { _Pragma("unroll") for (int n = 0; n < 2; ++n) _Pragma("unroll") for (int k = 0; k < 2; ++k) dst[n][k] = *(const LAS bf16x8*)(lds + PG8_SB(b, h) + boff + n * 2048 + k * 1024); } while (0)
#define PG8_MMA(ai, bj, At, Bt) do { __builtin_amdgcn_s_setprio(1); _Pragma("unroll") for (int m = 0; m < 4; ++m) _Pragma("unroll") for (int n = 0; n < 2; ++n) _Pragma("unroll") for (int k = 0; k < 2; ++k) \
        acc[ai][bj][m][n] = __builtin_amdgcn_mfma_f32_16x16x32_bf16(Bt[n][k], At[m][k], acc[ai][bj][m][n], 0, 0, 0); __builtin_amdgcn_s_setprio(0); } while (0)
#define PG8_WAIT_V(n) asm volatile("s_waitcnt vmcnt(" #n ")" ::: "memory")
#define PG8_WAIT_L(n) asm volatile("s_waitcnt lgkmcnt(" #n ")" ::: "memory")
#define PG8_BAR __builtin_amdgcn_s_barrier()
#define PG8_SCHED __builtin_amdgcn_sched_barrier(0)
    Unit cur, nxt; int ui = 0;
    if (!S.next(0, cur)) return;
    f32x4 acc[2][2][4][2];
#pragma unroll
    for (int a = 0; a < 2; ++a)
#pragma unroll
        for (int b = 0; b < 2; ++b)
#pragma unroll
            for (int m = 0; m < 4; ++m)
#pragma unroll
                for (int n = 0; n < 2; ++n) acc[a][b][m][n] = (f32x4){0.f, 0.f, 0.f, 0.f};
    bf16x8 At[4][2], B0[2][2], B1[2][2];
    unsigned vgc[2][2] = {{0u, 0u}, {0u, 0u}}, vgn[2][2] = {{0u, 0u}, {0u, 0u}};
    if (GATHER) {
#pragma unroll
        for (int h = 0; h < 2; ++h)
#pragma unroll
            for (int i = 0; i < 2; ++i) vgc[h][i] = S.arow(cur, h * HALF + RA[i]) * (unsigned)(lda * 2) + (unsigned)CA[i] * 2u;
    }
    const char* cA = cur.a; const char* cB = cur.b;
    PG8_STAGE(PG8_SB(0, 0), cB, voffB); PG8_STAGE(PG8_SB(0, 1), cB + hstepB, voffB); PG8_STAGE_A(PG8_SA(0, 0), cA, vgc, 0, 0); PG8_STAGE_A(PG8_SA(0, 1), cA, vgc, 1, 0);
    if (wr == 1) PG8_BAR;
    PG8_WAIT_V(2); PG8_BAR;
    PG8_STAGE(PG8_SB(1, 0), cB + kstep, voffB); PG8_STAGE_A(PG8_SA(1, 0), cA, vgc, 0, kstep); PG8_STAGE(PG8_SB(1, 1), cB + hstepB + kstep, voffB);
    PG8_WAIT_V(6); PG8_BAR;
    for (;;) {
        const bool has_next = S.next(ui + 1, nxt);
        const char* nA = has_next ? nxt.a : cA; const char* nB = has_next ? nxt.b : cB;
        if (GATHER) {
#pragma unroll
            for (int h = 0; h < 2; ++h)
#pragma unroll
                for (int i = 0; i < 2; ++i) vgn[h][i] = has_next ? (S.arow(nxt, h * HALF + RA[i]) * (unsigned)(lda * 2) + (unsigned)CA[i] * 2u) : vgc[h][i];
        }
#pragma clang loop unroll(disable)
        for (int t = 0; t < nt; t += 2) {
            const bool last = (t == nt - 2);
            const size_t k1 = (size_t)(t + 1) * kstep;
            const char* a2 = last ? nA : cA; const char* b2 = last ? nB : cB + (size_t)(t + 2) * kstep; const size_t ka2 = last ? 0 : (size_t)(t + 2) * kstep;
            const char* b3 = b2 + kstep; const size_t ka3 = ka2 + kstep;
            unsigned v2[2][2];
#pragma unroll
            for (int h = 0; h < 2; ++h)
#pragma unroll
                for (int i = 0; i < 2; ++i) v2[h][i] = last ? vgn[h][i] : vgc[h][i];
            PG8_LDB(B0, 0, 0); PG8_LDB(B1, 0, 1); PG8_SCHED; PG8_LDA(At, 0, 0); PG8_STAGE_A(PG8_SA(1, 1), cA, vgc, 1, k1);
            PG8_WAIT_V(8); PG8_WAIT_L(0); PG8_BAR; PG8_MMA(0, 0, At, B0); PG8_MMA(0, 1, At, B1); PG8_BAR; PG8_SCHED;
            PG8_LDA(At, 0, 1); PG8_STAGE(PG8_SB(0, 0), b2, voffB); PG8_STAGE(PG8_SB(0, 1), b2 + hstepB, voffB); PG8_STAGE_A(PG8_SA(0, 0), a2, v2, 0, ka2);
            PG8_WAIT_V(8); PG8_WAIT_L(0); PG8_BAR; PG8_MMA(1, 0, At, B0); PG8_MMA(1, 1, At, B1); PG8_BAR; PG8_SCHED;
            PG8_LDB(B0, 1, 0); PG8_LDB(B1, 1, 1); PG8_SCHED; PG8_LDA(At, 1, 0); PG8_STAGE_A(PG8_SA(0, 1), a2, v2, 1, ka2);
            PG8_WAIT_V(8); PG8_WAIT_L(0); PG8_BAR; PG8_MMA(0, 0, At, B0); PG8_MMA(0, 1, At, B1); PG8_BAR; PG8_SCHED;
            PG8_LDA(At, 1, 1); PG8_STAGE(PG8_SB(1, 0), b3, voffB); PG8_STAGE(PG8_SB(1, 1), b3 + hstepB, voffB); PG8_STAGE_A(PG8_SA(1, 0), a2, v2, 0, ka3);
            PG8_WAIT_V(8); PG8_WAIT_L(0); PG8_BAR; PG8_MMA(1, 0, At, B0); PG8_MMA(1, 1, At, B1); PG8_BAR; PG8_SCHED;
        }
        if (wr == 0) PG8_BAR;
        { int fr_ = fr, fq_ = fq; asm volatile("" : "+v"(fr_), "+v"(fq_));
          EpiApply<Epi, PAIR>::run(E, acc, cur, wr, wc, fr_, fq_);
#ifdef PROBE_DUP_EPI
          if (!Epi::INPLACE) { asm volatile("" : "+v"(fr_), "+v"(fq_)); EpiApply<Epi, PAIR>::run(E, acc, cur, wr, wc, fr_, fq_); }
#endif
          }
        if (!has_next) break;
#pragma unroll
        for (int a = 0; a < 2; ++a)
#pragma unroll
            for (int b = 0; b < 2; ++b)
#pragma unroll
                for (int m = 0; m < 4; ++m)
#pragma unroll
                    for (int n = 0; n < 2; ++n) acc[a][b][m][n] = (f32x4){0.f, 0.f, 0.f, 0.f};
        cur = nxt; cA = nA; cB = nB; ++ui;
        if (GATHER) {
#pragma unroll
            for (int h = 0; h < 2; ++h)
#pragma unroll
                for (int i = 0; i < 2; ++i) vgc[h][i] = vgn[h][i];
        }
        if (wr == 1) PG8_BAR;
    }
    PG8_WAIT_V(0);
    PG8_BAR;
#undef PG8_SA
#undef PG8_SB
#undef PG8_STAGE
#undef PG8_STAGE_A
#undef PG8_LDA
#undef PG8_LDB
#undef PG8_MMA
#undef PG8_WAIT_V
#undef PG8_WAIT_L
#undef PG8_BAR
#undef PG8_SCHED
}
template <class Epi> struct EpiApply<Epi, false> {
    static __device__ __forceinline__ void run(const Epi& E, const f32x4 (&acc)[2][2][4][2], const Unit& u, int wr, int wc, int fr, int fq) {
#pragma unroll
        for (int ai = 0; ai < 2; ++ai) {
            typename Epi::Pre pre[4][2];
#pragma unroll
            for (int m = 0; m < 4; ++m) { const int row = u.pm * BM + ai * HALF + wr * 64 + m * 16 + fr;
#pragma unroll
                for (int bj = 0; bj < 2; ++bj) pre[m][bj] = E.pre(u, row, u.pn * BM + bj * HALF + wc * 32 + (Epi::PERM ? 8 : 4) * fq); }
#pragma unroll
            for (int m = 0; m < 4; ++m) { const int row = u.pm * BM + ai * HALF + wr * 64 + m * 16 + fr;
#pragma unroll
                for (int bj = 0; bj < 2; ++bj) {
                    if constexpr (Epi::PERM) E.fin8(u, row, u.pn * BM + bj * HALF + wc * 32 + 8 * fq, acc[ai][bj][m][0], acc[ai][bj][m][1], pre[m][bj]);
                    else E.fin4x2(u, row, u.pn * BM + bj * HALF + wc * 32 + 4 * fq, acc[ai][bj][m][0], acc[ai][bj][m][1], pre[m][bj]); } }
        }
    }
};
template <class Epi> struct EpiApply<Epi, true> {
    static __device__ __forceinline__ void run(const Epi& E, const f32x4 (&acc)[2][2][4][2], const Unit& u, int wr, int wc, int fr, int fq) {
#pragma unroll
        for (int ai = 0; ai < 2; ++ai)
#pragma unroll
            for (int m = 0; m < 4; ++m) { const int row = u.pm * BM + ai * HALF + wr * 64 + m * 16 + fr;
                E.putp8(u, row, u.pn * HALF + wc * 32 + 8 * fq, acc[ai][0][m][0], acc[ai][0][m][1], acc[ai][1][m][0], acc[ai][1][m][1]); }
    }
};
}

__device__ __forceinline__ void rowstat_pass(Frame& F, int r_first, int r_stride, int r_end) {
    const bf16_t* H = (const bf16_t*)(F.ws + WS_H); float* rstd = (float*)(F.ws + WS_RSTD);
    for (int m = r_first; m < r_end; m += r_stride) {
        const bf16_t* hr = H + (size_t)m * HP;
        const u32x2 q = *((const u32x2*)(hr + HC_CQ_LAT) + F.lane);
        const unsigned kv = *((const unsigned*)(hr + HC_CKV) + F.lane);
        float a0 = bf2f(q.x & 0xffff), a1 = bf2f(q.x >> 16), a2 = bf2f(q.y & 0xffff), a3 = bf2f(q.y >> 16), b0 = bf2f(kv & 0xffff), b1 = bf2f(kv >> 16);
        const float sq = wave_sum(a0 * a0 + a1 * a1 + a2 * a2 + a3 * a3), sk = wave_sum(b0 * b0 + b1 * b1);
        if (F.lane == 0) { rstd[2 * m] = 1.0f / sqrtf(sq * (1.0f / 256.0f) + RMS_EPS); rstd[2 * m + 1] = 1.0f / sqrtf(sk * (1.0f / 128.0f) + RMS_EPS); }
    }
}
__device__ __forceinline__ void red8(float (&v)[8], int lane) {
    float a[4], b[2], c;
#pragma unroll
    for (int i = 0; i < 4; ++i) a[i] = xpair32(v[i], v[i + 4]);
    { const bool up = (lane & 16) != 0;
#pragma unroll
      for (int i = 0; i < 2; ++i) { const float send = up ? a[i] : a[i + 2], keep = up ? a[i + 2] : a[i]; b[i] = keep + shx<16>(send); } }
    { const bool up = (lane & 8) != 0; const float send = up ? b[0] : b[1], keep = up ? b[1] : b[0]; c = keep + shx<8>(send); }
    c += shx<4>(c); c += shx<2>(c); c += shx<1>(c);
#pragma unroll
    for (int i = 0; i < 8; ++i) v[i] = __uint_as_float(__builtin_amdgcn_readlane(__float_as_uint(c), ((i >> 2) & 1) * 32 + ((i >> 1) & 1) * 16 + (i & 1) * 8));
}
__device__ __forceinline__ void red4(float (&v)[4], int lane) {
    float a[2], c;
#pragma unroll
    for (int i = 0; i < 2; ++i) a[i] = xpair32(v[i], v[i + 2]);
    { const bool up = (lane & 16) != 0; const float send = up ? a[0] : a[1], keep = up ? a[1] : a[0]; c = keep + shx<16>(send); }
    c += shx<8>(c); c += shx<4>(c); c += shx<2>(c); c += shx<1>(c);
#pragma unroll
    for (int i = 0; i < 4; ++i) v[i] = __uint_as_float(__builtin_amdgcn_readlane(__float_as_uint(c), ((i >> 1) & 1) * 32 + (i & 1) * 16));
}
__device__ __forceinline__ void ln1_route_pass(Frame& F, const Args& a, int layer, int r_first, int r_stride, int r_end) {
    bf16_t* XB = (bf16_t*)(F.ws + WS_XB); float* tw = (float*)(F.ws + WS_TW); int* list = (int*)(F.ws + WS_LIST);
    const float* g = a.ln1_g + layer * DM; const float* bb = a.ln1_b + layer * DM;
    const float* wc = a.moe_w_coarse + (size_t)layer * DM * 4; const float* wf = a.moe_w_fine + (size_t)layer * 4 * DM * 8;
    for (int q = F.tid; q < 4 * 1024 * 2; q += NTHREADS) { const int hf = q & 1, k = (q >> 1) & 1023, gg = q >> 11; const int l = (k & 255) >> 2, e = k & 3, j = k >> 8;
        *(LAS f32x4*)(F.lds + (size_t)(gg * 2048 + ((j * 4 + e) * 2 + hf) * 64 + l) * 16) = *((const f32x4*)wf + q); }
    f32x4 wcr[4][4];
#pragma unroll
    for (int j = 0; j < 4; ++j)
#pragma unroll
        for (int e = 0; e < 4; ++e) wcr[j][e] = *(const f32x4*)(wc + (size_t)(4 * F.lane + 256 * j + e) * 4);
    __syncthreads();
    f32x4 vn[2][4];
#pragma unroll
    for (int rr = 0; rr < 2; ++rr) { const int mm = r_first + rr * r_stride; if (mm < r_end) {
#pragma unroll
        for (int j = 0; j < 4; ++j) vn[rr][j] = *((const f32x4*)(a.out + (size_t)mm * DM) + F.lane + 64 * j); } }
    for (int m0 = r_first; m0 < r_end; m0 += 2 * r_stride) {
        f32x4 vc[2][4];
#pragma unroll
        for (int rr = 0; rr < 2; ++rr)
#pragma unroll
            for (int j = 0; j < 4; ++j) vc[rr][j] = vn[rr][j];
#pragma unroll
        for (int rr = 0; rr < 2; ++rr) { const int mm = m0 + (2 + rr) * r_stride; if (mm < r_end) {
#pragma unroll
            for (int j = 0; j < 4; ++j) vn[rr][j] = *((const f32x4*)(a.out + (size_t)mm * DM) + F.lane + 64 * j); } }
#pragma unroll
      for (int rr = 0; rr < 2; ++rr) { const int m = m0 + rr * r_stride; if (m < r_end) {
        f32x4 v[4]; float s = 0.f;
#pragma unroll
        for (int j = 0; j < 4; ++j) { v[j] = vc[rr][j]; s += (v[j].x + v[j].y) + (v[j].z + v[j].w); }
        const float mean = wave_sum(s) * (1.f / DM); float s2 = 0.f;
#pragma unroll
        for (int j = 0; j < 4; ++j) { v[j] = v[j] - mean; s2 += (v[j].x * v[j].x + v[j].y * v[j].y) + (v[j].z * v[j].z + v[j].w * v[j].w); }
        const float rs = 1.f / sqrtf(wave_sum(s2) * (1.f / DM) + LN_EPS);
        float cl[4] = {0.f, 0.f, 0.f, 0.f};
#pragma unroll
        for (int j = 0; j < 4; ++j) { const int c = 4 * F.lane + 256 * j; const f32x4 gg = *(const f32x4*)(g + c), bv = *(const f32x4*)(bb + c); v[j] = v[j] * rs * gg + bv;
            u32x2 w; w.x = pk2(v[j].x, v[j].y); w.y = pk2(v[j].z, v[j].w); *((u32x2*)(XB + (size_t)m * DM) + F.lane + 64 * j) = w;
#pragma unroll
            for (int e = 0; e < 4; ++e) { const f32x4 w4 = wcr[j][e]; const float xe = v[j][e]; cl[0] += xe * w4.x; cl[1] += xe * w4.y; cl[2] += xe * w4.z; cl[3] += xe * w4.w; } }
        red4(cl, F.lane);
        int grp = 0; float cm = cl[0];
#pragma unroll
        for (int e = 1; e < 4; ++e) if (cl[e] > cm) { cm = cl[e]; grp = e; }
        float den = 0.f;
#pragma unroll
        for (int e = 0; e < 4; ++e) den += __expf(cl[e] - cm);
        const float pg = 1.0f / den;
        grp = __builtin_amdgcn_readfirstlane(grp);
        const LAS f32x4* wl = (const LAS f32x4*)(F.lds) + grp * 2048 + F.lane;
        float fl[8] = {0.f, 0.f, 0.f, 0.f, 0.f, 0.f, 0.f, 0.f};
#pragma unroll
        for (int j = 0; j < 4; ++j)
#pragma unroll
            for (int e = 0; e < 4; ++e) { const f32x4 wa = wl[((j * 4 + e) * 2) * 64], wb = wl[((j * 4 + e) * 2 + 1) * 64]; const float xe = v[j][e];
                fl[0] += xe * wa.x; fl[1] += xe * wa.y; fl[2] += xe * wa.z; fl[3] += xe * wa.w; fl[4] += xe * wb.x; fl[5] += xe * wb.y; fl[6] += xe * wb.z; fl[7] += xe * wb.w; }
        red8(fl, F.lane);
        int i0 = 0; float v0 = fl[0];
#pragma unroll
        for (int e = 1; e < 8; ++e) if (fl[e] > v0) { v0 = fl[e]; i0 = e; }
        int i1 = -1; float v1 = -3.0e38f;
#pragma unroll
        for (int e = 0; e < 8; ++e) if (e != i0 && fl[e] > v1) { v1 = fl[e]; i1 = e; }
        const float e1 = __expf(v1 - v0), w0 = pg / (1.0f + e1), w1 = pg * e1 / (1.0f + e1);
        if (F.lane < 2) { const int e = grp * 8 + (F.lane == 0 ? i0 : i1); const int a_id = 2 * m + F.lane;
            const unsigned pos = __hip_atomic_fetch_add(F.ctl + CW_CNT + layer * 64 + e, 1u, RLX_AGENT);
            list[(size_t)e * LIST_CAP + pos] = a_id; tw[a_id] = (F.lane == 0) ? w0 : w1; }
          } }
    }
    __syncthreads();
}
__device__ __forceinline__ void ln2_pass(Frame& F, const Args& a, int layer, int r_first, int r_stride, int r_end) {
    bf16_t* XB = (bf16_t*)(F.ws + WS_XB); const bf16_t* YB = (const bf16_t*)(F.ws + WS_YB);
    const float* g = a.ln2_g + layer * DM; const float* bb = a.ln2_b + layer * DM; const float* g1 = a.ln1_g + layer * DM; const float* b1 = a.ln1_b + layer * DM;
    f32x4 xn[2][4]; u32x2 pn[2][4], qn[2][4];
#define LN2_LOAD(rr, mm) do { const bf16_t* y0_ = YB + (size_t)(2 * (mm)) * DM; _Pragma("unroll") for (int j = 0; j < 4; ++j) { xn[rr][j] = *((const f32x4*)(a.out + (size_t)(mm) * DM) + F.lane + 64 * j); \
        pn[rr][j] = *((const u32x2*)y0_ + F.lane + 64 * j); qn[rr][j] = *((const u32x2*)(y0_ + DM) + F.lane + 64 * j); } } while (0)
#pragma unroll
    for (int rr = 0; rr < 2; ++rr) { const int mm = r_first + rr * r_stride; if (mm < r_end) LN2_LOAD(rr, mm); }
    for (int m0 = r_first; m0 < r_end; m0 += 2 * r_stride) {
        f32x4 xc[2][4]; u32x2 pc[2][4], qc[2][4];
#pragma unroll
        for (int rr = 0; rr < 2; ++rr)
#pragma unroll
            for (int j = 0; j < 4; ++j) { xc[rr][j] = xn[rr][j]; pc[rr][j] = pn[rr][j]; qc[rr][j] = qn[rr][j]; }
#pragma unroll
        for (int rr = 0; rr < 2; ++rr) { const int mm = m0 + (2 + rr) * r_stride; if (mm < r_end) LN2_LOAD(rr, mm); }
#pragma unroll
        for (int rr = 0; rr < 2; ++rr) { const int m = m0 + rr * r_stride; if (m < r_end) {
            float* xr = a.out + (size_t)m * DM;
            f32x4 v[4]; float s = 0.f;
            { float s1 = 0.f;
#pragma unroll
              for (int j = 0; j < 4; ++j) { v[j] = xc[rr][j]; s1 += (v[j].x + v[j].y) + (v[j].z + v[j].w); }
              const float mean1 = wave_sum(s1) * (1.f / DM); float q1 = 0.f;
#pragma unroll
              for (int j = 0; j < 4; ++j) { v[j] = v[j] - mean1; q1 += (v[j].x * v[j].x + v[j].y * v[j].y) + (v[j].z * v[j].z + v[j].w * v[j].w); }
              const float rs1 = 1.f / sqrtf(wave_sum(q1) * (1.f / DM) + LN_EPS);
#pragma unroll
              for (int j = 0; j < 4; ++j) { const int c = 4 * F.lane + 256 * j; xc[rr][j] = v[j] * rs1 * *(const f32x4*)(g1 + c) + *(const f32x4*)(b1 + c); } }
#pragma unroll
            for (int j = 0; j < 4; ++j) { v[j] = xc[rr][j] * DN_ALPHA; const u32x2 p = pc[rr][j], q = qc[rr][j];
                v[j].x += bf2f(p.x & 0xffff) + bf2f(q.x & 0xffff); v[j].y += bf2f(p.x >> 16) + bf2f(q.x >> 16); v[j].z += bf2f(p.y & 0xffff) + bf2f(q.y & 0xffff); v[j].w += bf2f(p.y >> 16) + bf2f(q.y >> 16);
                s += (v[j].x + v[j].y) + (v[j].z + v[j].w); }
            const float mean = wave_sum(s) * (1.f / DM); float s2 = 0.f;
#pragma unroll
            for (int j = 0; j < 4; ++j) { v[j] = v[j] - mean; s2 += (v[j].x * v[j].x + v[j].y * v[j].y) + (v[j].z * v[j].z + v[j].w * v[j].w); }
            const float rs = 1.f / sqrtf(wave_sum(s2) * (1.f / DM) + LN_EPS);
#pragma unroll
            for (int j = 0; j < 4; ++j) { const int c = 4 * F.lane + 256 * j; const f32x4 gg = *(const f32x4*)(g + c), bv = *(const f32x4*)(bb + c); v[j] = v[j] * rs * gg + bv;
                *((f32x4*)xr + F.lane + 64 * j) = v[j];
                if (layer + 1 < DEPTH) { u32x2 w; w.x = pk2(v[j].x, v[j].y); w.y = pk2(v[j].z, v[j].w); *((u32x2*)(XB + (size_t)m * DM) + F.lane + 64 * j) = w; } }
        } }
    }
#undef LN2_LOAD
}
__device__ __forceinline__ void moe_convert(Frame& F, const Args& a, int layer) {
    LAS float* scr = (LAS float*)(F.lds + F.wave * 16384);
    constexpr int I_13 = (1024 / 64) * (1024 / 32), I_2 = (512 / 64) * (1024 / 32), PER_E = I_13 + I_2;
    for (int it = F.gw; it < NEXP * PER_E; it += F.NGW) {
        const int e = it / PER_E; int r = it - e * PER_E; const size_t le = (size_t)layer * NEXP + e;
        if (r < I_13) { const int kb = r / 32, nb = r % 32; const float* src = ((nb >> 2) & 1) ? a.moe_w3 : a.moe_w1;
            const int sc0 = ((32 * nb) >> 8) * 128 + ((32 * nb) & 127);
            transpose_item_v4(src + le * 1024 * 512 + (size_t)(kb * 64) * 512 + sc0, 512, (bf16_t*)(F.ws + WS_W13) + (size_t)e * 1024 * 1024 + (size_t)(nb * 32) * 1024 + kb * 64, 1024, scr, F.lane); }
        else { r -= I_13; const int kb = r / 32, nb = r % 32;
            transpose_item_v4(a.moe_w2 + le * 512 * 1024 + (size_t)(kb * 64) * 1024 + nb * 32, 1024, (bf16_t*)(F.ws + WS_W2) + (size_t)e * 1024 * 512 + (size_t)(nb * 32) * 512 + kb * 64, 512, scr, F.lane); }
    }
}

typedef short at_s16x4 __attribute__((ext_vector_type(4)));
typedef LAS const unsigned char* at_lds_cptr;
__device__ __forceinline__ at_s16x4 at_vtr(at_lds_cptr p) { return __builtin_bit_cast(at_s16x4, __builtin_amdgcn_ds_read_tr16_b64_v4i16((LAS at_s16x4*)p)); }
struct RowSrc { const bf16_t* p; long pitch; };
constexpr int SA_P = 0, SA_V = 4096, SA_AL = 12288, SA_RL = 12544;
template <int NC0, int NC1, int MODE>
__device__ __forceinline__ void sattn_core(const bf16x8* qf, RowSrc k0, RowSrc k1, RowSrc vs, int kb_lo, int kb_hi, int qidx0, float lse_ref, LAS unsigned char* scr, int lane, f32x16* o, float& lse_out) {
    const int r32 = lane & 31, hi = lane >> 5;
    LAS bf16_t* Pb = (LAS bf16_t*)(scr + SA_P); LAS bf16_t* Vb = (LAS bf16_t*)(scr + SA_V); LAS float* Al = (LAS float*)(scr + SA_AL);
    float m = -1.0e30f, l = 0.f;
    if (MODE != 1) { o[0] = f32x16{}; o[1] = f32x16{}; }
    bf16x8 kn[NC0 + NC1]; u32x4 vn[4];
#define SA_LOAD(kb_) do { const long key_ = (long)(kb_) * 32 + r32; \
        _Pragma("unroll") for (int c = 0; c < NC0; ++c) kn[c] = *(const bf16x8*)(k0.p + key_ * k0.pitch + 16 * c + 8 * hi); \
        _Pragma("unroll") for (int c = 0; c < NC1; ++c) kn[NC0 + c] = *(const bf16x8*)(k1.p + key_ * k1.pitch + 16 * c + 8 * hi); \
        if (MODE != 1) { _Pragma("unroll") for (int i = 0; i < 4; ++i) { const int idx = i * 64 + lane, kr = idx >> 3, pc = idx & 7; vn[i] = *(const u32x4*)(vs.p + ((long)(kb_) * 32 + kr) * vs.pitch + pc * 8); } } } while (0)
    if (kb_lo < kb_hi) SA_LOAD(kb_lo);
    const at_lds_cptr vtb = (at_lds_cptr)(scr + SA_V) + ((8 * hi + ((lane & 15) >> 2)) * 72 + 16 * ((lane >> 4) & 1) + 4 * (lane & 3)) * 2;
    for (int kb = kb_lo; kb < kb_hi; ++kb) {
        bf16x8 kc[NC0 + NC1]; u32x4 vc[4];
#pragma unroll
        for (int c = 0; c < NC0 + NC1; ++c) kc[c] = kn[c];
#pragma unroll
        for (int i = 0; i < 4; ++i) vc[i] = vn[i];
        if (kb + 1 < kb_hi) SA_LOAD(kb + 1);
        f32x16 s = {};
#pragma unroll
        for (int c = 0; c < NC0 + NC1; ++c) s = MFMA32(kc[c], qf[c], s);
        bool valid[16];
#pragma unroll
        for (int r = 0; r < 16; ++r) { if (MODE == 0) valid[r] = true; else { const int d = kb * 32 + crow(r, hi) - (qidx0 + r32); valid[r] = (d <= 64 && d >= -64); } }
        float p[16];
        if (MODE == 2) {
#pragma unroll
            for (int r = 0; r < 16; ++r) p[r] = valid[r] ? fast_exp2(s[r] - lse_ref) : 0.f;
        } else {
            float mx = -1.0e30f;
#pragma unroll
            for (int r = 0; r < 16; ++r) if (valid[r]) mx = fmaxf(mx, s[r]);
            mx = xmax32(mx);
            const float mn = fmaxf(m, mx), alpha = fast_exp2(m - mn); m = mn;
            float ps = 0.f;
#pragma unroll
            for (int r = 0; r < 16; ++r) { p[r] = valid[r] ? fast_exp2(s[r] - mn) : 0.f; ps += p[r]; }
            l = l * alpha + ps;
            if (MODE == 0) { if (hi == 0) Al[r32] = alpha; }
        }
        if (MODE != 1) {
#pragma unroll
            for (int g = 0; g < 4; ++g) { u32x2 w; w.x = pk2(p[4 * g], p[4 * g + 1]); w.y = pk2(p[4 * g + 2], p[4 * g + 3]); *(LAS u32x2*)(Pb + r32 * 40 + 8 * g + 4 * hi) = w; }
#pragma unroll
            for (int i = 0; i < 4; ++i) { const int idx = i * 64 + lane, kr = idx >> 3, pc = idx & 7; *(LAS u32x4*)(Vb + kr * 72 + pc * 8) = vc[i]; }
            LDS_WAIT();
            if (MODE == 0) {
#pragma unroll
                for (int r = 0; r < 16; ++r) { const float al = Al[crow(r, hi)]; o[0][r] *= al; o[1][r] *= al; }
            }
#pragma unroll
            for (int st = 0; st < 2; ++st) {
                const bf16x8 pf = *(const LAS bf16x8*)(Pb + r32 * 40 + 16 * st + 8 * hi);
#pragma unroll
                for (int db = 0; db < 2; ++db) {
                    const at_s16x4 lo_ = at_vtr(vtb + (16 * st * 72 + 32 * db) * 2), hi_ = at_vtr(vtb + ((16 * st + 4) * 72 + 32 * db) * 2);
                    const bf16x8 vf = {lo_[0], lo_[1], lo_[2], lo_[3], hi_[0], hi_[1], hi_[2], hi_[3]};
                    o[db] = MFMA32(pf, vf, o[db]); }
            }
            LDS_WAIT();
        }
    }
#undef SA_LOAD
    if (MODE != 2) { l = xsum32(l); lse_out = m + __log2f(l); }
    if (MODE == 0) {
        LAS float* Rl = (LAS float*)(scr + SA_RL);
        if (hi == 0) Rl[r32] = 1.0f / l;
        LDS_WAIT();
#pragma unroll
        for (int r = 0; r < 16; ++r) { const float rl = Rl[crow(r, hi)]; o[0][r] *= rl; o[1][r] *= rl; }
        LDS_WAIT();
    }
}

__device__ __forceinline__ void sattn_phase(Frame& F, const Args& a, int layer, int kind_lo) {
    const bf16_t* H = (const bf16_t*)(F.ws + WS_H); const bf16_t* QB = (const bf16_t*)(F.ws + WS_QB); const bf16_t* KVB = (const bf16_t*)(F.ws + WS_KVB);
    bf16_t* MIX = (bf16_t*)(F.ws + WS_MIX); const float* lsec = (const float*)(F.ws + WS_LSEC);
    LAS unsigned char* scr = F.lds + F.wave * 16384;
    const int lane = F.lane, r32 = lane & 31, hi = lane >> 5;
    float lam, lam_init;
    { const float* lv = a.diff_lambda + layer * 128; float d1 = 0.f, d2 = 0.f;
      for (int i = 0; i < 32; ++i) { d1 += lv[i] * lv[32 + i]; d2 += lv[64 + i] * lv[96 + i]; }
      lam_init = 0.8f - 0.6f * expf(-0.3f * (float)layer); lam = expf(d1) - expf(d2) + lam_init; }
    constexpr int NRB = NTOK / 32;
    const int items = NRB * (4 + 6 + 6);
    for (int it = kind_lo * NRB + F.gw; it < items; it += F.NGW) {
        const int kind = it / NRB, rb = it - kind * NRB; const int m0 = rb * 32; const SeqInfo si = seqinfo(m0);
#if !OPT_ATTN
        if (kind < 4) {
            const int h = kind; f32x16 o0[2], o1[2]; float dummy;
            for (int c = 0; c < 2; ++c) {
                bf16x8 qf[2];
#pragma unroll
                for (int d0 = 0; d0 < 2; ++d0) qf[d0] = *(const bf16x8*)(H + (size_t)(m0 + r32) * HP + HC_AQ + h * 64 + c * 32 + 16 * d0 + 8 * hi);
                const RowSrc ks{H + (size_t)si.base * HP + HC_AK + h * 64 + c * 32, HP}, vs{H + (size_t)si.base * HP + HC_AV + h * 64, HP};
                sattn_core<2, 0, 0>(qf, ks, ks, vs, 0, si.len / 32, 0, 0.f, scr, lane, c == 0 ? o0 : o1, dummy);
            }
            const float* sg = a.diff_subln + layer * 64; const float g0 = sg[r32], g1 = sg[32 + r32];
#pragma unroll
            for (int r = 0; r < 16; ++r) { const float x0 = o0[0][r] - lam * o1[0][r], x1 = o0[1][r] - lam * o1[1][r]; float ss = x0 * x0 + x1 * x1;
                ss += shx<1>(ss); ss += shx<2>(ss); ss += shx<4>(ss); ss += shx<8>(ss); ss += shx<16>(ss);
                const float rs = (1.0f - lam_init) / sqrtf(ss * (1.0f / 64.0f) + RMS_EPS);
                bf16_t* op = MIX + (size_t)(m0 + crow(r, hi)) * DM + MIX_A + h * 64 + r32;
                op[0] = (bf16_t)f2bf(x0 * rs * g0); op[32] = (bf16_t)f2bf(x1 * rs * g1); }
        } else if (kind < 10) {
            const int h = kind - 4; f32x16 o[2]; float dummy; bf16x8 qf[6];
#pragma unroll
            for (int d0 = 0; d0 < 6; ++d0) qf[d0] = *(const bf16x8*)(QB + (size_t)(m0 + r32) * QBP + h * 96 + 16 * d0 + 8 * hi);
            const RowSrc k0{KVB + (size_t)si.base * KVP + h * 128, KVP}, k1{H + (size_t)si.base * HP + HC_KROPE, HP}, vs{KVB + (size_t)si.base * KVP + h * 128 + 64, KVP};
            sattn_core<4, 2, 0>(qf, k0, k1, vs, 0, si.len / 32, 0, 0.f, scr, lane, o, dummy);
#pragma unroll
            for (int r = 0; r < 16; ++r) { bf16_t* op = MIX + (size_t)(m0 + crow(r, hi)) * DM + MIX_B + h * 64 + r32; op[0] = (bf16_t)f2bf(o[0][r]); op[32] = (bf16_t)f2bf(o[1][r]); }
        } else
#endif
        {
            const int gj = kind - 10, g = gj >> 1, hh = gj;
            const int dil = (g == 0) ? 1 : (g == 1 ? 4 : 16); const int L = si.len / dil, bpr = L / 32;
            const int w = (m0 - si.base) / 32, rho = w / bpr, ib = w - rho * bpr, i0 = ib * 32;
            const size_t qrow = (size_t)si.base + (size_t)(i0 + r32) * dil + rho;
            bf16x8 qf[4];
#pragma unroll
            for (int d0 = 0; d0 < 4; ++d0) qf[d0] = *(const bf16x8*)(H + qrow * HP + HC_CQ + hh * 64 + 16 * d0 + 8 * hi);
            const int j = gj & 1; const float l0 = lsec[(0 * (size_t)NTOK + qrow) * 2 + j], l1 = lsec[(1 * (size_t)NTOK + qrow) * 2 + j], l2 = lsec[(2 * (size_t)NTOK + qrow) * 2 + j];
            const float lm = fmaxf(l0, fmaxf(l1, l2)); const float lref = lm + __log2f(fast_exp2(l0 - lm) + fast_exp2(l1 - lm) + fast_exp2(l2 - lm));
            const RowSrc ks{H + ((size_t)si.base + rho) * HP + HC_CK + hh * 64, (long)HP * dil}, vs{H + ((size_t)si.base + rho) * HP + HC_CV + hh * 64, (long)HP * dil};
            int kb_lo = ib - 2, kb_hi = ib + 3; if (kb_lo < 0) kb_lo = 0; if (kb_hi > bpr) kb_hi = bpr;
            f32x16 o[2]; float dummy;
            sattn_core<4, 0, 2>(qf, ks, ks, vs, kb_lo, kb_hi, i0, lref, scr, lane, o, dummy);
#pragma unroll
            for (int r = 0; r < 16; ++r) { const size_t orow = (size_t)si.base + (size_t)(i0 + crow(r, hi)) * dil + rho; bf16_t* op = MIX + orow * DM + MIX_C + hh * 64 + r32; op[0] = (bf16_t)f2bf(o[0][r]); op[32] = (bf16_t)f2bf(o[1][r]); }
        }
    }
}
__device__ __forceinline__ void cstat_phase(Frame& F) {
    const bf16_t* H = (const bf16_t*)(F.ws + WS_H); float* lsec = (float*)(F.ws + WS_LSEC);
    LAS unsigned char* scr = F.lds + F.wave * 16384;
    const int lane = F.lane, r32 = lane & 31, hi = lane >> 5;
    constexpr int NRB = NTOK / 32;
    for (int it = F.gw; it < NRB * 6; it += F.NGW) {
        const int gj = it / NRB, rb = it - gj * NRB, g = gj >> 1, j = gj & 1; const int m0 = rb * 32; const SeqInfo si = seqinfo(m0);
        const int dil = (g == 0) ? 1 : (g == 1 ? 4 : 16); const int L = si.len / dil, bpr = L / 32;
        const int w = (m0 - si.base) / 32, rho = w / bpr, ib = w - rho * bpr, i0 = ib * 32;
        const size_t qrow = (size_t)si.base + (size_t)(i0 + r32) * dil + rho;
        bf16x8 qf[4];
#pragma unroll
        for (int d0 = 0; d0 < 4; ++d0) qf[d0] = *(const bf16x8*)(H + qrow * HP + HC_CQ + gj * 64 + 16 * d0 + 8 * hi);
        const RowSrc ks{H + ((size_t)si.base + rho) * HP + HC_CK + gj * 64, (long)HP * dil};
        int kb_lo = ib - 2, kb_hi = ib + 3; if (kb_lo < 0) kb_lo = 0; if (kb_hi > bpr) kb_hi = bpr;
        float lse; sattn_core<4, 0, 1>(qf, ks, ks, ks, kb_lo, kb_hi, i0, 0.f, scr, lane, nullptr, lse);
        if (hi == 0) lsec[((size_t)g * NTOK + qrow) * 2 + j] = lse;
    }
}


namespace at {
typedef short s16x4 __attribute__((ext_vector_type(4)));
typedef short v4i16_t __attribute__((ext_vector_type(4)));
typedef LAS const unsigned char* lds_cptr;
constexpr int LDS_K = 0, KSLOT_MAX = 12288, LDS_V = 3 * KSLOT_MAX, VSLOT = 8192, LDS_WS = LDS_V + 3 * VSLOT, LDS_OST = LDS_WS + 8 * 256, LDS_TOTAL = LDS_OST + 8 * 8192;
static_assert(LDS_TOTAL <= RING_BYTES, "attention LDS");
constexpr float THR = 8.0f;
__device__ __forceinline__ void glds16(const void* g, unsigned lds_dst) {
    unsigned keep; asm volatile("s_mov_b32 %0, m0\n\ts_mov_b32 m0, %2\n\ts_nop 0\n\tglobal_load_lds_dwordx4 %1, off\n\ts_mov_b32 m0, %0" : "=&s"(keep) : "v"(g), "s"(lds_dst) : "memory"); }
__device__ __forceinline__ s16x4 vtr(lds_cptr p) { return __builtin_bit_cast(s16x4, __builtin_amdgcn_ds_read_tr16_b64_v4i16((LAS v4i16_t*)p)); }
__device__ __forceinline__ unsigned cvtpk(float lo, float hi) { typedef float f2 __attribute__((ext_vector_type(2))); typedef __bf16 b2 __attribute__((ext_vector_type(2))); f2 v = {lo, hi}; b2 b = __builtin_convertvector(v, b2); return __builtin_bit_cast(unsigned, b); }
#define AT_MX3(a, b, c) __builtin_fmaxf(__builtin_fmaxf((a), (b)), (c))
__device__ __forceinline__ float rowmax(const f32x16& p0, const f32x16& p1) {
    float a = AT_MX3(p0[0], p0[1], p1[0]), b = AT_MX3(p0[2], p0[3], p1[1]); a = AT_MX3(a, p1[2], p1[3]);
#pragma unroll
    for (int r = 4; r < 16; r += 4) { a = AT_MX3(a, p0[r], p0[r + 1]); b = AT_MX3(b, p0[r + 2], p0[r + 3]); a = AT_MX3(a, p1[r], p1[r + 1]); b = AT_MX3(b, p1[r + 2], p1[r + 3]); }
    float m = __builtin_fmaxf(a, b); auto rr = __builtin_amdgcn_permlane32_swap(__float_as_uint(m), __float_as_uint(m), false, false);
    return __builtin_fmaxf(__uint_as_float(rr[0]), __uint_as_float(rr[1])); }
#define AT_WAIT_BAR(N) asm volatile("s_waitcnt vmcnt(" #N ") lgkmcnt(0)\n\ts_barrier" ::: "memory")

struct Src { const bf16_t* p; long pitch; };
template <int NC, int NK0, int NK1>
__device__ __forceinline__ void stream(LAS unsigned char* lds, int tid, const bf16_t* qrow, Src k0, Src k1, Src vs, int NT, f32x16& o0, f32x16& o1, float& lsum) {
    asm volatile("" : "+v"(tid));
    constexpr int SLOTK = 2 * NC * 1024;
    const int lane = tid & 63, r32 = lane & 31, hi = lane >> 5; const int wid = __builtin_amdgcn_readfirstlane(tid >> 6);
    const unsigned lds0 = (unsigned)(uintptr_t)lds;
    LAS float* wsf = (LAS float*)(lds + LDS_WS) + wid * 64;
    constexpr int P0 = NK0 * 16;
    const bool hasA = (NK0 == 8) || (wid < 4), hasB = (NK1 > 0) && (wid < 4);
    const int pA = (NK0 == 8) ? wid : (wid & 3);
    const int rowA = (NK0 == 8) ? pA * 8 + (lane >> 3) : pA * 16 + (lane >> 2);
    const int chA = (NK0 == 8) ? ((lane & 7) ^ ((4 * pA + (lane >> 4)) & 7)) : ((lane & 3) ^ ((lane >> 4) & 3));
    const bf16_t* ksA = k0.p + (long)rowA * k0.pitch + chA * 8;
    const int rowB = (wid & 3) * 16 + (lane >> 2), chB = (lane & 3) ^ ((lane >> 4) & 3);
    const bf16_t* ksB = (NK1 > 0) ? k1.p + (long)rowB * k1.pitch + chB * 8 : k0.p;
    const bf16_t* vsp = vs.p + (long)(16 * (wid & 3) + (lane >> 2)) * vs.pitch + (wid >> 2) * 32 + (lane & 3) * 8;
    const unsigned kdA = lds0 + LDS_K + pA * 1024, kdB = lds0 + LDS_K + (NK0 + (wid & 3)) * 1024, vd = lds0 + LDS_V + wid * 1024;
    const long ktA = 64 * k0.pitch, ktB = 64 * k1.pitch, vt = 64 * vs.pitch;
    const int nd = (hasA ? 1 : 0) + (hasB ? 1 : 0) + 1;
#define AT_DMA_K(t, slot) do { if (hasA) glds16(ksA + (long)(t) * ktA, (unsigned)__builtin_amdgcn_readfirstlane(kdA + (slot) * SLOTK)); if (hasB) glds16(ksB + (long)(t) * ktB, (unsigned)__builtin_amdgcn_readfirstlane(kdB + (slot) * SLOTK)); } while (0)
#define AT_DMA_V(t, slot) glds16(vsp + (long)(t) * vt, (unsigned)__builtin_amdgcn_readfirstlane(vd + (slot) * VSLOT))
    lds_cptr kb[NC];
#pragma unroll
    for (int d0 = 0; d0 < NC; ++d0) { const int c = 2 * d0 + hi;
        if (2 * d0 < NK0) kb[d0] = (lds_cptr)lds + LDS_K + r32 * P0 + ((NK0 == 8) ? (c ^ ((r32 >> 1) & 7)) : (c ^ ((r32 >> 2) & 3))) * 16;
        else kb[d0] = (lds_cptr)lds + LDS_K + NK0 * 1024 + r32 * 64 + ((c - NK0) ^ ((r32 >> 2) & 3)) * 16; }
    const lds_cptr vp0 = (lds_cptr)lds + LDS_V + ((lane >> 4) & 1) * 32 + (lane & 3) * 8 + (4 * hi + ((lane & 15) >> 2)) * 64;
    AT_DMA_K(0, 0); AT_DMA_V(0, 0); if (NT > 1) AT_DMA_K(1, 1);
    bf16x8 qr[NC];
#pragma unroll
    for (int d0 = 0; d0 < NC; ++d0) qr[d0] = *(const bf16x8*)(qrow + 16 * d0 + 8 * hi);
    float mhat = 0.f, l = 0.f; f32x16 oa = {}, ob = {}, negm = {}, S0, S1; u32x4 pw0, pw1, pw2, pw3;
    asm volatile("" : "+v"(negm));
    AT_WAIT_BAR(0);
    __builtin_amdgcn_s_waitcnt(0);
#pragma unroll
    for (int d0 = 0; d0 < NC; ++d0) asm volatile("" : "+v"(qr[d0]));
    constexpr bool QLDS = (NC > 2);
    const lds_cptr qb = (lds_cptr)lds + LDS_OST + wid * 8192 + lane * 16;
    if (QLDS) {
#pragma unroll
        for (int d0 = 0; d0 < NC; ++d0) *(LAS bf16x8*)(lds + LDS_OST + wid * 8192 + lane * 16 + d0 * 1024) = qr[d0];
        LDS_WAIT();
    }
    int kc = 0, kn1 = 1, kn2 = 2, vpv = 2, vcu = 0, vnx = 1;
    bf16x8 kf[2 * NC], vf[8];
#define AT_SB() __builtin_amdgcn_sched_barrier(0)
#define AT_KRD(so_, d0) do { kf[2 * (d0)] = *(const LAS bf16x8*)(kb[d0] + (so_)); kf[2 * (d0) + 1] = *(const LAS bf16x8*)(kb[d0] + (so_) + 32 * ((2 * (d0) < NK0) ? P0 : 64)); if (QLDS) qr[d0] = *(const LAS bf16x8*)(qb + (d0) * 1024); } while (0)
#define AT_KHEAD(slot) do { const int kp_ = (slot) * SLOTK; AT_KRD(kp_, 0); } while (0)
#define AT_VF(i) ({ const s16x4 lo_ = vtr(vp_ + (((i) >> 2) * 4096 + ((i) & 3) * 1024)), hi_ = vtr(vp_ + (((i) >> 2) * 4096 + ((i) & 3) * 1024 + 512)); (bf16x8){lo_[0], lo_[1], lo_[2], lo_[3], hi_[0], hi_[1], hi_[2], hi_[3]}; })
#define AT_VHEAD(slot) do { const lds_cptr vp_ = vp0 + (slot) * VSLOT; vf[0] = AT_VF(0); vf[4] = AT_VF(4); } while (0)
#define AT_QKM(slot) do { const int kp_ = (slot) * SLOTK; \
        _Pragma("unroll") for (int d0 = 0; d0 < NC; ++d0) { if (d0 + 1 < NC) AT_KRD(kp_, d0 + 1); \
            if (d0 == 0) { S0 = MFMA32(kf[0], qr[0], negm); S1 = MFMA32(kf[1], qr[0], negm); } else { S0 = MFMA32(kf[2 * d0], qr[d0], S0); S1 = MFMA32(kf[2 * d0 + 1], qr[d0], S1); } AT_SB(); } } while (0)
#define AT_PVM(slot) do { const lds_cptr vp_ = vp0 + (slot) * VSLOT; \
        vf[1] = AT_VF(1); vf[5] = AT_VF(5); oa = MFMA32(__builtin_bit_cast(bf16x8, pw0), vf[0], oa); ob = MFMA32(__builtin_bit_cast(bf16x8, pw0), vf[4], ob); AT_SB(); \
        vf[2] = AT_VF(2); vf[6] = AT_VF(6); oa = MFMA32(__builtin_bit_cast(bf16x8, pw1), vf[1], oa); ob = MFMA32(__builtin_bit_cast(bf16x8, pw1), vf[5], ob); AT_SB(); \
        vf[3] = AT_VF(3); vf[7] = AT_VF(7); oa = MFMA32(__builtin_bit_cast(bf16x8, pw2), vf[2], oa); ob = MFMA32(__builtin_bit_cast(bf16x8, pw2), vf[6], ob); AT_SB(); \
        oa = MFMA32(__builtin_bit_cast(bf16x8, pw3), vf[3], oa); ob = MFMA32(__builtin_bit_cast(bf16x8, pw3), vf[7], ob); AT_SB(); } while (0)
    bool resc = false; u32x4 qw0, qw1, qw2, qw3; float sacc = 0.f;
#define AT_PIN(x) asm volatile("" : "+v"(x))
#define AT_DECIDE(first) do { const float rm_ = rowmax(S0, S1); resc = false; \
        if ((first) || __any(rm_ > THR)) { const float dl_ = (first) ? rm_ : __builtin_fmaxf(rm_, 0.f); mhat += dl_; \
            _Pragma("unroll") for (int r = 0; r < 16; ++r) { S0[r] -= dl_; S1[r] -= dl_; negm[r] = -mhat; } asm volatile("" : "+v"(negm)); \
            if (!(first)) { const float f_ = fast_exp2(-dl_); l *= f_; if (hi == 0) wsf[r32] = f_; resc = true; } } } while (0)
#define AT_RESC() do { if (resc) { LDS_WAIT(); \
        _Pragma("unroll") for (int r = 0; r < 16; ++r) { const float g_ = wsf[crow(r, hi)]; oa[r] *= g_; ob[r] *= g_; } LDS_WAIT(); } } while (0)
#define AT_EXP8(S, b, Q) do { \
        _Pragma("unroll") for (int r = 0; r < 8; ++r) S[(b) + r] = fast_exp2(S[(b) + r]); \
        sacc += (S[(b)] + S[(b) + 1]) + (S[(b) + 2] + S[(b) + 3]); sacc += (S[(b) + 4] + S[(b) + 5]) + (S[(b) + 6] + S[(b) + 7]); \
        Q = (u32x4){cvtpk(S[(b)], S[(b) + 1]), cvtpk(S[(b) + 2], S[(b) + 3]), cvtpk(S[(b) + 4], S[(b) + 5]), cvtpk(S[(b) + 6], S[(b) + 7])}; AT_PIN(Q); AT_PIN(sacc); } while (0)
#define AT_EXPALL() do { sacc = 0.f; AT_EXP8(S0, 0, qw0); AT_EXP8(S0, 8, qw1); AT_EXP8(S1, 0, qw2); AT_EXP8(S1, 8, qw3); l += sacc; pw0 = qw0; pw1 = qw1; pw2 = qw2; pw3 = qw3; } while (0)
#define AT_PV_EXP(slot, C0, C1, C2, C3, N0, N1, N2, N3) do { const lds_cptr vp_ = vp0 + (slot) * VSLOT; sacc = 0.f; \
        vf[1] = AT_VF(1); vf[5] = AT_VF(5); oa = MFMA32(__builtin_bit_cast(bf16x8, C0), vf[0], oa); ob = MFMA32(__builtin_bit_cast(bf16x8, C0), vf[4], ob); AT_EXP8(S0, 0, N0); AT_SB(); \
        vf[2] = AT_VF(2); vf[6] = AT_VF(6); oa = MFMA32(__builtin_bit_cast(bf16x8, C1), vf[1], oa); ob = MFMA32(__builtin_bit_cast(bf16x8, C1), vf[5], ob); AT_EXP8(S0, 8, N1); AT_SB(); \
        vf[3] = AT_VF(3); vf[7] = AT_VF(7); oa = MFMA32(__builtin_bit_cast(bf16x8, C2), vf[2], oa); ob = MFMA32(__builtin_bit_cast(bf16x8, C2), vf[6], ob); AT_EXP8(S1, 0, N2); AT_SB(); \
        oa = MFMA32(__builtin_bit_cast(bf16x8, C3), vf[3], oa); ob = MFMA32(__builtin_bit_cast(bf16x8, C3), vf[7], ob); AT_EXP8(S1, 8, N3); AT_SB(); \
        l += sacc; } while (0)
#define AT_STEP_WAIT(t) do { if ((t) + 2 < NT) { if (nd == 3) AT_WAIT_BAR(3); else if (nd == 2) AT_WAIT_BAR(2); else AT_WAIT_BAR(1); } else AT_WAIT_BAR(0); } while (0)
#define AT_ROT() do { const int a_ = kc; kc = kn1; kn1 = kn2; kn2 = a_; const int b_ = vpv; vpv = vcu; vcu = vnx; vnx = b_; } while (0)
    AT_DMA_K(2, kn2); AT_DMA_V(1, vnx);
    AT_KHEAD(kc); AT_SB();
    AT_QKM(kc); AT_DECIDE(true); AT_EXPALL();
    AT_STEP_WAIT(0); AT_ROT();
#define AT_STEP(t, C0, C1, C2, C3, N0, N1, N2, N3) do { \
        if ((t) + 2 < NT) AT_DMA_K((t) + 2, kn2); \
        if ((t) + 1 < NT) AT_DMA_V((t) + 1, vnx); \
        AT_KHEAD(kc); AT_VHEAD(vpv); AT_SB(); \
        AT_QKM(kc); \
        AT_DECIDE(false); AT_SB(); \
        AT_PV_EXP(vpv, C0, C1, C2, C3, N0, N1, N2, N3); \
        AT_RESC(); \
        AT_STEP_WAIT(t); AT_ROT(); } while (0)
    int t = 1;
    for (; t + 1 < NT; t += 2) { AT_STEP(t, pw0, pw1, pw2, pw3, qw0, qw1, qw2, qw3); AT_STEP(t + 1, qw0, qw1, qw2, qw3, pw0, pw1, pw2, pw3); }
    if (t < NT) { AT_STEP(t, pw0, pw1, pw2, pw3, qw0, qw1, qw2, qw3); pw0 = qw0; pw1 = qw1; pw2 = qw2; pw3 = qw3; }
#undef AT_STEP
    AT_VHEAD(vpv); AT_SB(); AT_PVM(vpv);
    { auto rr = __builtin_amdgcn_permlane32_swap(__float_as_uint(l), __float_as_uint(l), false, false); l = __uint_as_float(rr[0]) + __uint_as_float(rr[1]); }
    o0 = oa; o1 = ob; lsum = l;
#undef AT_DMA_K
#undef AT_DMA_V
#undef AT_SB
#undef AT_KRD
#undef AT_KHEAD
#undef AT_VF
#undef AT_VHEAD
#undef AT_QKM
#undef AT_PVM
#undef AT_PIN
#undef AT_DECIDE
#undef AT_RESC
#undef AT_EXP8
#undef AT_EXPALL
#undef AT_PV_EXP
#undef AT_STEP_WAIT
#undef AT_ROT
}
__device__ __forceinline__ void normalise(LAS unsigned char* lds, int tid, f32x16& o0, f32x16& o1, float lsum) {
    const int lane = tid & 63, r32 = lane & 31, hi = lane >> 5; const int wid = __builtin_amdgcn_readfirstlane(tid >> 6);
    LAS float* wsf = (LAS float*)(lds + LDS_WS) + wid * 64;
    if (hi == 0) wsf[32 + r32] = 1.0f / lsum; LDS_WAIT();
#pragma unroll
    for (int r = 0; r < 16; ++r) { const float g = wsf[32 + crow(r, hi)]; o0[r] *= g; o1[r] *= g; }
    LDS_WAIT();
}
}

struct AttnUnitId { int kind, seq, head, qb; };
__device__ __forceinline__ bool attn_unit_at(int i, int G, int bid, AttnUnitId& u) {
    const long L = (long)i * G + bid; if (L >= 2560) return false; int o = (int)L;
    int kind, longs, nh;
    if (o < 512) { kind = 0; longs = 1; nh = 4; } else if (o < 1024) { kind = 0; longs = 0; nh = 4; o -= 512; } else if (o < 1792) { kind = 1; longs = 1; nh = 6; o -= 1024; } else { kind = 1; longs = 0; nh = 6; o -= 1792; }
    const int nqb = longs ? 16 : 8;
    int pair, qb;
    if (G == 256) { const int rnd = o >> 8, b = o & 255, x = b & 7, c = b >> 3;
        const int ppr = 32 / nqb; pair = x + 8 * (rnd * ppr + c / nqb); qb = c % nqb; }
    else { pair = o / nqb; qb = o % nqb; }
    u.kind = kind; u.head = pair % nh; const int sq = pair / nh; u.seq = longs ? 16 + sq : sq; u.qb = qb; return true;
}
__device__ __forceinline__ void attn_ab_phase(Frame& F, const Args& a, int layer, int kmask = 3) {
    const bf16_t* H = (const bf16_t*)(F.ws + WS_H); const bf16_t* QB = (const bf16_t*)(F.ws + WS_QB); const bf16_t* KVB = (const bf16_t*)(F.ws + WS_KVB);
    bf16_t* MIX = (bf16_t*)(F.ws + WS_MIX);
    const int wid = F.wave;
    float lam, lam_init;
    { const float* lv = a.diff_lambda + layer * 128; float d1 = 0.f, d2 = 0.f;
      for (int i = 0; i < 32; ++i) { d1 += lv[i] * lv[32 + i]; d2 += lv[64 + i] * lv[96 + i]; }
      lam_init = 0.8f - 0.6f * expf(-0.3f * (float)layer); lam = expf(d1) - expf(d2) + lam_init;
      lam = __uint_as_float(__builtin_amdgcn_readfirstlane(__float_as_uint(lam))); lam_init = __uint_as_float(__builtin_amdgcn_readfirstlane(__float_as_uint(lam_init))); }
    AttnUnitId u;
    for (int i = 0; attn_unit_at(i, F.G, F.bid, u); ++i) {
        if (!((kmask >> u.kind) & 1)) continue;
        int tid = F.tid; asm volatile("" : "+v"(tid)); const int lane = tid & 63, r32 = lane & 31, hi = lane >> 5;
        const int len = (u.seq < 16) ? 2048 : 4096, base = (u.seq < 16) ? u.seq * 2048 : NTOK_P + (u.seq - 16) * 4096, NT = len / 64;
        const int m0 = base + u.qb * 256 + wid * 32;
        LAS bf16_t* sb = (LAS bf16_t*)(F.lds + at::LDS_OST + wid * 8192);
        LAS float* sf = (LAS float*)sb;
        if (u.kind == 0) {
            f32x16 q0, q1; float ls;
            { f32x16 p0, p1; const at::Src ks{H + (size_t)base * HP + HC_AK + u.head * 64, HP}, vs{H + (size_t)base * HP + HC_AV + u.head * 64, HP};
              at::stream<2, 4, 0>(F.lds, tid, H + (size_t)(m0 + r32) * HP + HC_AQ + u.head * 64, ks, ks, vs, NT, p0, p1, ls); at::normalise(F.lds, tid, p0, p1, ls);
#pragma unroll
              for (int r = 0; r < 16; ++r) { const int row = crow(r, hi); sf[row * 64 + r32] = p0[r]; sf[row * 64 + 32 + r32] = p1[r]; }
              AT_WAIT_BAR(0); }
            { const at::Src ks{H + (size_t)base * HP + HC_AK + u.head * 64 + 32, HP}, vs{H + (size_t)base * HP + HC_AV + u.head * 64, HP};
              at::stream<2, 4, 0>(F.lds, tid, H + (size_t)(m0 + r32) * HP + HC_AQ + u.head * 64 + 32, ks, ks, vs, NT, q0, q1, ls); at::normalise(F.lds, tid, q0, q1, ls); }
            float xa[16], xb[16];
#pragma unroll
            for (int r = 0; r < 16; ++r) { const int row = crow(r, hi); xa[r] = sf[row * 64 + r32] - lam * q0[r]; xb[r] = sf[row * 64 + 32 + r32] - lam * q1[r]; }
            LDS_WAIT();
            const float* sg = a.diff_subln + layer * 64; const float g0 = sg[r32] * (1.0f - lam_init), g1 = sg[32 + r32] * (1.0f - lam_init);
#pragma unroll
            for (int r = 0; r < 16; ++r) { const float x0 = xa[r], x1 = xb[r]; float ss = x0 * x0 + x1 * x1;
                ss += shx<1>(ss); ss += shx<2>(ss); ss += shx<4>(ss); ss += shx<8>(ss); ss += shx<16>(ss);
                const float rs = 1.0f / sqrtf(ss * (1.0f / 64.0f) + RMS_EPS); const int row = crow(r, hi);
                sb[row * 64 + r32] = (bf16_t)f2bf(x0 * rs * g0); sb[row * 64 + 32 + r32] = (bf16_t)f2bf(x1 * rs * g1); }
            LDS_WAIT();
#pragma unroll
            for (int it = 0; it < 4; ++it) { const int row = it * 8 + (lane >> 3), ch = lane & 7; *(u32x4*)(MIX + (size_t)(m0 + row) * DM + MIX_A + u.head * 64 + ch * 8) = *(const LAS u32x4*)(sb + row * 64 + ch * 8); }
        } else {
            f32x16 p0, p1; float ls;
            const at::Src k0{KVB + (size_t)base * KVP + u.head * 128, KVP}, k1{H + (size_t)base * HP + HC_KROPE, HP}, vs{KVB + (size_t)base * KVP + u.head * 128 + 64, KVP};
            at::stream<6, 8, 4>(F.lds, tid, QB + (size_t)(m0 + r32) * QBP + u.head * 96, k0, k1, vs, NT, p0, p1, ls); at::normalise(F.lds, tid, p0, p1, ls);
#pragma unroll
            for (int r = 0; r < 16; ++r) { const int row = crow(r, hi); sb[row * 64 + r32] = (bf16_t)f2bf(p0[r]); sb[row * 64 + 32 + r32] = (bf16_t)f2bf(p1[r]); }
            LDS_WAIT();
#pragma unroll
            for (int it = 0; it < 4; ++it) { const int row = it * 8 + (lane >> 3), ch = lane & 7; *(u32x4*)(MIX + (size_t)(m0 + row) * DM + MIX_B + u.head * 64 + ch * 8) = *(const LAS u32x4*)(sb + row * 64 + ch * 8); }
        }
        AT_WAIT_BAR(0);
    }
}

struct ListRows { const int* list; int seg0, cnt; __device__ __forceinline__ int src(int m) const { const int r = m - seg0; return (r < cnt) ? (list[r] >> 1) : 0; } };
__device__ __forceinline__ void moe_segments(Frame& F, int layer, LAS int* seg) {
    if (F.tid == 0) { int acc = 0; for (int e = 0; e < NEXP; ++e) { const int c = (int)__hip_atomic_load(F.ctl + CW_CNT + layer * 64 + e, RLX_AGENT); seg[e] = acc; seg[33 + e] = c; acc += (c + 255) & ~255; } seg[32] = acc; }
    __syncthreads();
}
__device__ __forceinline__ int seg_find(const LAS int* seg, int row) { int e = 0;
#pragma unroll
    for (int s = 16; s > 0; s >>= 1) if (seg[e + s] <= row) e += s;
    return e; }
__device__ __forceinline__ void moe_up_simple(Frame& F, int layer) {
    LAS int* seg = (LAS int*)(F.lds + RING_BYTES); moe_segments(F, layer, seg);
    const bf16_t* XB = (const bf16_t*)(F.ws + WS_XB); const bf16_t* W13 = (const bf16_t*)(F.ws + WS_W13); const int* list = (const int*)(F.ws + WS_LIST);
    const EpiHid E{(bf16_t*)(F.ws + WS_HID)};
    const int items = (seg[32] / 32) * 16;
    for (int it = F.gw; it < items; it += F.NGW) { const int mt = it >> 4, ct = it & 15, m0 = mt * 32, e = seg_find(seg, m0), c0 = ct * 32;
        const ListRows RM{list + (size_t)e * LIST_CAP, seg[e], seg[33 + e]};
        const bf16_t* Bg = W13 + (size_t)e * 1024 * 1024 + (size_t)((c0 >> 7) * 256 + (c0 & 127)) * 1024;
        sg_tile(XB, DM, Bg, Bg + (size_t)128 * 1024, 1024, 1024, m0, c0, E, RM, F.lane); }
    __syncthreads();
}
__device__ __forceinline__ void moe_down_simple(Frame& F, int layer) {
    LAS int* seg = (LAS int*)(F.lds + RING_BYTES); moe_segments(F, layer, seg);
    const bf16_t* HID = (const bf16_t*)(F.ws + WS_HID); const bf16_t* W2 = (const bf16_t*)(F.ws + WS_W2); const int* list = (const int*)(F.ws + WS_LIST);
    const int items = (seg[32] / 32) * 16;
    for (int it = F.gw; it < items; it += F.NGW) { const int mt = it >> 4, ct = it & 15, m0 = mt * 32, e = seg_find(seg, m0), c0 = ct * 64;
        const EpiY E{(bf16_t*)(F.ws + WS_YB), (const float*)(F.ws + WS_TW), list + (size_t)e * LIST_CAP, seg[e], seg[33 + e]};
        const bf16_t* B0 = W2 + (size_t)e * 1024 * 512 + (size_t)c0 * 512;
        sg_tile(HID, DEXP, B0, B0 + (size_t)32 * 512, 512, 512, m0, c0, E, IdRows(), F.lane); }
    __syncthreads();
}


struct MoeUpSched {
    const char* XB; const char* W13; const LAS int* seg; const int* list; int nM, G, c;
    __device__ __forceinline__ bool next(int i, pg8::Unit& u) const { if (!pg8::order_next(i, G, c, nM, 4, u.pm, u.pn)) return false; u.e = __builtin_amdgcn_readfirstlane(seg_find(seg, u.pm * 256)); u.a = XB; u.b = W13 + ((size_t)u.e * 1024 + (size_t)u.pn * 256) * 2048; return true; }
    __device__ __forceinline__ unsigned arow(const pg8::Unit& u, int r) const { const int rr = u.pm * 256 + r - __builtin_amdgcn_readfirstlane(seg[u.e]); return (rr < __builtin_amdgcn_readfirstlane(seg[33 + u.e])) ? (unsigned)(list[(size_t)u.e * LIST_CAP + rr] >> 1) : 0u; }
};
struct MoeDownSched {
    const char* HID; const char* W2; const LAS int* seg; int nM, G, c;
    __device__ __forceinline__ bool next(int i, pg8::Unit& u) const { if (!pg8::order_next(i, G, c, nM, 4, u.pm, u.pn)) return false; u.e = __builtin_amdgcn_readfirstlane(seg_find(seg, u.pm * 256)); u.a = HID + (size_t)u.pm * 256 * DEXP * 2; u.b = W2 + ((size_t)u.e * 1024 + (size_t)u.pn * 256) * 1024; return true; }
    __device__ __forceinline__ unsigned arow(const pg8::Unit&, int) const { return 0u; }
};
__device__ __forceinline__ void moe_up_opt(Frame& F, int layer) {
    LAS int* seg = (LAS int*)(F.lds + RING_BYTES); moe_segments(F, layer, seg);
    const MoeUpSched S{(const char*)(F.ws + WS_XB), (const char*)(F.ws + WS_W13), seg, (const int*)(F.ws + WS_LIST), __builtin_amdgcn_readfirstlane(seg[32]) / 256, F.G, F.bid};
    const EpiHid E{(bf16_t*)(F.ws + WS_HID)};
    pg8::gemm_phase<EpiHid, MoeUpSched, true, true>(F.lds, F.tid, 1024, DM, S, E);
    __syncthreads();
}
__device__ __forceinline__ void moe_down_opt(Frame& F, int layer) {
    LAS int* seg = (LAS int*)(F.lds + RING_BYTES); moe_segments(F, layer, seg);
    const MoeDownSched S{(const char*)(F.ws + WS_HID), (const char*)(F.ws + WS_W2), seg, __builtin_amdgcn_readfirstlane(seg[32]) / 256, F.G, F.bid};
    const EpiYO E{(bf16_t*)(F.ws + WS_YB), (const float*)(F.ws + WS_TW), (const int*)(F.ws + WS_LIST), seg};
    pg8::gemm_phase<EpiYO, MoeDownSched, false, false>(F.lds, F.tid, DEXP, DEXP, S, E);
    __syncthreads();
}
template <class Epi>
__device__ __forceinline__ void pg_phase(Frame& F, const bf16_t* A, int lda, const bf16_t* Bt, int panel, int N, int K, const Epi& E) {
    pg8::PanelSched S; S.init(A, lda, Bt, panel, N, K);
    pg8::gemm_phase<Epi, pg8::PanelSched, false, false>(F.lds, F.tid, K, lda, S, E);
}
__device__ __forceinline__ void local_sync(Frame& F) {
    asm volatile("s_waitcnt vmcnt(0) lgkmcnt(0)" ::: "memory");
    __syncthreads();
    if (F.tid == 0) { __builtin_amdgcn_fence(__ATOMIC_ACQUIRE, "agent"); asm volatile("s_waitcnt vmcnt(0)" ::: "memory"); }
    __syncthreads();
}
template <class Epi>
__device__ __forceinline__ void og_phase(Frame& F, const bf16_t* A, int lda, const bf16_t* Bt, int M, int N, int K, const Epi& E) {
    pg8::DenseSched S; S.init(A, lda, Bt, M, N, K, F.G, F.bid);
    pg8::gemm_phase<Epi, pg8::DenseSched, false, false>(F.lds, F.tid, K, lda, S, E);
}

#ifndef PANEL_PROG
#define PANEL_PROG 1
#endif
#if PANEL_PROG
constexpr int PH_PER_LAYER = 6, N_PHASES = 2 + DEPTH * PH_PER_LAYER;
#else
constexpr int PH_PER_LAYER = 9, N_PHASES = 1 + DEPTH * PH_PER_LAYER;
#endif
__global__ void __launch_bounds__(NTHREADS, 2) fwd(Args args) {
    extern __shared__ __attribute__((aligned(16))) unsigned char lds[];
    Frame F;
    F.lds = (LAS unsigned char*)lds; F.ldsg = lds;
    F.tid = threadIdx.x; F.lane = F.tid & 63; F.wave = __builtin_amdgcn_readfirstlane(F.tid >> 6);
    F.G = gridDim.x; F.bid = blockIdx.x; F.gw = blockIdx.x * NWAVES + F.wave; F.NGW = F.G * NWAVES;
    F.ws = args.ws; F.ctl = (gu32*)(args.ws + WS_CTL);
    volatile LAS unsigned* MISC = (volatile LAS unsigned*)(F.lds + MISC_OFF);
    for (int u = F.tid; u < (LDS_BYTES - RING_BYTES) / 4; u += NTHREADS) ((LAS unsigned*)(F.lds + RING_BYTES))[u] = 0u;
    __syncthreads();
    XcdBarrier bar; bar.bar = (unsigned*)(F.ctl + CW_BAR); bar.x = 0; bar.st = nullptr;
    if (args.use_bar) bar = xcd_barrier_post((unsigned*)(F.ctl + CW_BAR), MISC + 8);
    const int lo = args.ph_lo, hi = args.ph_hi;
#ifndef PH_MASK
#define PH_MASK 0x3ff
#endif
#define IN(k) (lo <= (k) && (k) < hi && (launder(F), true))
#define SEAM(k) do { if (lo <= (k) && (k) + 1 < hi) xcd_barrier(bar); } while (0)
    if ((PH_MASK & 1) && IN(0)) { p0_prologue(F, args);
#ifdef PROBE_DUP_P0
        launder(F); p0_prologue(F, args);
#endif
    }
    SEAM(0);
#if PANEL_PROG
    for (int layer = 0; layer < DEPTH; ++layer) {
        const int pb = 1 + layer * PH_PER_LAYER;
        if (IN(pb + 0)) {
            for (int panel = F.bid; panel < NTOK / 256; panel += F.G) {
                const int r0 = panel * 256;
                if (layer > 0) { ln2_pass(F, args, layer - 1, r0 + F.wave, NWAVES, r0 + 256); local_sync(F); launder(F); }
                { bf16_t* H = (bf16_t*)(F.ws + WS_H); const EpiH E{H, (const float2*)(F.ws + WS_ROPE32), (const float2*)(F.ws + WS_ROPE64)};
                  pg_phase(F, (const bf16_t*)(F.ws + WS_XB), DM, (const bf16_t*)(F.ws + WS_WIN) + (size_t)layer * 2560 * 1024, panel, 2560, 1024, E); }
                local_sync(F); launder(F);
                rowstat_pass(F, r0 + F.wave, NWAVES, r0 + 256);
                local_sync(F); launder(F);
                { bf16_t* H = (bf16_t*)(F.ws + WS_H); const EpiUQ Eq{(bf16_t*)(F.ws + WS_QB), (const float*)(F.ws + WS_RSTD), (const float2*)(F.ws + WS_ROPE32)};
                  pg_phase(F, H + HC_CQ_LAT, HP, (const bf16_t*)(F.ws + WS_WUQ) + (size_t)layer * 768 * 256, panel, 768, 256, Eq); }
                launder(F);
                { bf16_t* H = (bf16_t*)(F.ws + WS_H); const EpiUKV Ek{(bf16_t*)(F.ws + WS_KVB), (const float*)(F.ws + WS_RSTD)};
                  pg_phase(F, H + HC_CKV, HP, (const bf16_t*)(F.ws + WS_WUKV) + (size_t)layer * 768 * 256, panel, 768, 256, Ek); }
                launder(F);
            }
        }
        SEAM(pb + 0);
        if (IN(pb + 1)) { cstat_phase(F); }
        SEAM(pb + 1);
        if (IN(pb + 2)) { attn_ab_phase(F, args, layer); launder(F); sattn_phase(F, args, layer, 10); }
        SEAM(pb + 2);
        if (IN(pb + 3)) {
            for (int panel = F.bid; panel < NTOK / 256; panel += F.G) {
                const int r0 = panel * 256;
                { const EpiRes E{args.out, layer == 0 ? args.x_prompt : nullptr, args.x_sample, args.out};
                  pg_phase(F, (const bf16_t*)(F.ws + WS_MIX), DM, (const bf16_t*)(F.ws + WS_WOUT) + (size_t)layer * 1024 * 1024, panel, 1024, 1024, E); }
                local_sync(F); launder(F);
                ln1_route_pass(F, args, layer, r0 + F.wave, NWAVES, r0 + 256);
                launder(F);
            }
            moe_convert(F, args, layer);
        }
        SEAM(pb + 3);
        if (IN(pb + 4)) { moe_up_opt(F, layer);
#ifdef PROBE_DUP_MOE
            launder(F); moe_up_opt(F, layer);
#endif
        }
        SEAM(pb + 4);
        if (IN(pb + 5)) { moe_down_opt(F, layer);
#ifdef PROBE_DUP_MOE
            launder(F); moe_down_opt(F, layer);
#endif
        }
        SEAM(pb + 5);
    }
    if (IN(1 + DEPTH * PH_PER_LAYER)) { ln2_pass(F, args, DEPTH - 1, F.gw, F.NGW, NTOK); }
#else
    for (int layer = 0; layer < DEPTH; ++layer) {
        const int pb = 1 + layer * PH_PER_LAYER;
        if ((PH_MASK & (2 << 0)) && IN(pb + 0)) {   bf16_t* H = (bf16_t*)(F.ws + WS_H);
            const EpiH E{H, (const float2*)(F.ws + WS_ROPE32), (const float2*)(F.ws + WS_ROPE64)};
#if OPT_GEMM
            og_phase(F, (const bf16_t*)(F.ws + WS_XB), DM, (const bf16_t*)(F.ws + WS_WIN) + (size_t)layer * 2560 * 1024, NTOK, 2560, 1024, E);
#ifdef PROBE_DUP_GEMM
            launder(F); og_phase(F, (const bf16_t*)(F.ws + WS_XB), DM, (const bf16_t*)(F.ws + WS_WIN) + (size_t)layer * 2560 * 1024, NTOK, 2560, 1024, E);
#endif
#else
            sg_phase(F, (const bf16_t*)(F.ws + WS_XB), DM, (const bf16_t*)(F.ws + WS_WIN) + (size_t)layer * 2560 * 1024, 1024, NTOK, 2560, 1024, E);
#endif
        }
        SEAM(pb + 0);
        if ((PH_MASK & (2 << 1)) && IN(pb + 1)) { rowstat_pass(F, F.gw, F.NGW, NTOK); cstat_phase(F);
#ifdef PROBE_DUP_CSTAT
            launder(F); rowstat_pass(F, F.gw, F.NGW, NTOK); cstat_phase(F);
#endif
        }
        SEAM(pb + 1);
        if ((PH_MASK & (2 << 2)) && IN(pb + 2)) {
            bf16_t* H = (bf16_t*)(F.ws + WS_H);
            const EpiUQ Eq{(bf16_t*)(F.ws + WS_QB), (const float*)(F.ws + WS_RSTD), (const float2*)(F.ws + WS_ROPE32)};
#if OPT_GEMM
            og_phase(F, H + HC_CQ_LAT, HP, (const bf16_t*)(F.ws + WS_WUQ) + (size_t)layer * 768 * 256, NTOK, 768, 256, Eq);
            launder(F);
#else
            sg_phase(F, H + HC_CQ_LAT, HP, (const bf16_t*)(F.ws + WS_WUQ) + (size_t)layer * 768 * 256, 256, NTOK, 768, 256, Eq);
#endif
            const EpiUKV Ek{(bf16_t*)(F.ws + WS_KVB), (const float*)(F.ws + WS_RSTD)};
#if OPT_GEMM
            og_phase(F, H + HC_CKV, HP, (const bf16_t*)(F.ws + WS_WUKV) + (size_t)layer * 768 * 256, NTOK, 768, 256, Ek);
#ifdef PROBE_DUP_UP
            launder(F); og_phase(F, H + HC_CQ_LAT, HP, (const bf16_t*)(F.ws + WS_WUQ) + (size_t)layer * 768 * 256, NTOK, 768, 256, Eq);
            launder(F); og_phase(F, H + HC_CKV, HP, (const bf16_t*)(F.ws + WS_WUKV) + (size_t)layer * 768 * 256, NTOK, 768, 256, Ek);
#endif
#else
            sg_phase(F, H + HC_CKV, HP, (const bf16_t*)(F.ws + WS_WUKV) + (size_t)layer * 768 * 256, 256, NTOK, 768, 256, Ek);
#endif
        }
        SEAM(pb + 2);
        if ((PH_MASK & (2 << 3)) && IN(pb + 3)) {
#if OPT_ATTN
            attn_ab_phase(F, args, layer); launder(F);
#ifdef PROBE_DUP_ATTN
            attn_ab_phase(F, args, layer, PROBE_DUP_ATTN); launder(F);
#endif
            sattn_phase(F, args, layer, 10);
#ifdef PROBE_DUP_CFIN
            launder(F); sattn_phase(F, args, layer, 10);
#endif
#else
            sattn_phase(F, args, layer, 0);
#endif
        }
        SEAM(pb + 3);
        if ((PH_MASK & (2 << 4)) && IN(pb + 4)) {
#ifdef PROBE_DUP_WOUT
            { const EpiRes E0{args.out, layer == 0 ? args.x_prompt : nullptr, args.x_sample, (float*)(F.ws + WS_H)};
              og_phase(F, (const bf16_t*)(F.ws + WS_MIX), DM, (const bf16_t*)(F.ws + WS_WOUT) + (size_t)layer * 1024 * 1024, NTOK, 1024, 1024, E0); launder(F); }
#endif
            const EpiRes E{args.out, layer == 0 ? args.x_prompt : nullptr, args.x_sample, args.out};
#if OPT_GEMM
            og_phase(F, (const bf16_t*)(F.ws + WS_MIX), DM, (const bf16_t*)(F.ws + WS_WOUT) + (size_t)layer * 1024 * 1024, NTOK, 1024, 1024, E);
#else
            sg_phase(F, (const bf16_t*)(F.ws + WS_MIX), DM, (const bf16_t*)(F.ws + WS_WOUT) + (size_t)layer * 1024 * 1024, 1024, NTOK, 1024, 1024, E);
#endif
        }
        SEAM(pb + 4);
        if ((PH_MASK & (2 << 5)) && IN(pb + 5)) {
#ifdef PROBE_DUP_LN1
#endif
            ln1_route_pass(F, args, layer, F.gw, F.NGW, NTOK); moe_convert(F, args, layer);
#ifdef PROBE_DUP_CONV
            launder(F); moe_convert(F, args, layer);
#endif
        }
        SEAM(pb + 5);
#if OPT_GEMM
        if ((PH_MASK & (2 << 6)) && IN(pb + 6)) { moe_up_opt(F, layer);
#ifdef PROBE_DUP_MOE
            launder(F); moe_up_opt(F, layer);
#endif
        }
#else
        if ((PH_MASK & (2 << 6)) && IN(pb + 6)) { moe_up_simple(F, layer); }
#endif
        SEAM(pb + 6);
#if OPT_GEMM
        if ((PH_MASK & (2 << 7)) && IN(pb + 7)) { moe_down_opt(F, layer);
#ifdef PROBE_DUP_MOE
            launder(F); moe_down_opt(F, layer);
#endif
        }
#else
        if ((PH_MASK & (2 << 7)) && IN(pb + 7)) { moe_down_simple(F, layer); }
#endif
        SEAM(pb + 7);
        if ((PH_MASK & (2 << 8)) && IN(pb + 8)) { ln2_pass(F, args, layer, F.gw, F.NGW, NTOK); }
        SEAM(pb + 8);
    }
#endif
#undef IN
#undef SEAM
}

extern "C" void kernel_launch(void* const* d_in, const int* in_sizes, int n_in, void* d_out, int out_size, void* d_ws, size_t ws_size, hipStream_t stream) {
    static int grid = 0;
    if (grid == 0) {
        if (n_in != 19 || out_size != NTOK * DM || ws_size < WS_END) { fprintf(stderr, "kernel_launch: unexpected shapes (n_in %d out %d ws %zu)\n", n_in, out_size, ws_size); grid = -1; return; }
        int dev = 0, cus = 0, per_cu = 0;
        if (hipGetDevice(&dev) != hipSuccess || hipDeviceGetAttribute(&cus, hipDeviceAttributeMultiprocessorCount, dev) != hipSuccess) { grid = -1; return; }
        if (hipFuncSetAttribute((const void*)fwd, hipFuncAttributeMaxDynamicSharedMemorySize, LDS_BYTES) != hipSuccess) { grid = -1; return; }
        if (hipOccupancyMaxActiveBlocksPerMultiprocessor(&per_cu, (const void*)fwd, NTHREADS, LDS_BYTES) != hipSuccess || per_cu < 1) { fprintf(stderr, "kernel_launch: occupancy query says %d\n", per_cu); }
        (void)hipGetLastError();
        grid = cus;
    }
    if (grid < 0) return;
    if (hipMemsetAsync((char*)d_ws + WS_CTL, 0, CTL_ZERO_BYTES, stream) != hipSuccess) return;
    Args a{};
    a.x_prompt = (const float*)d_in[0]; a.x_sample = (const float*)d_in[1]; a.w_in = (const float*)d_in[2]; a.diff_lambda = (const float*)d_in[3]; a.diff_subln = (const float*)d_in[4];
    a.mla_q_norm = (const float*)d_in[5]; a.mla_w_uq = (const float*)d_in[6]; a.mla_kv_norm = (const float*)d_in[7]; a.mla_w_ukv = (const float*)d_in[8]; a.w_out = (const float*)d_in[9];
    a.ln1_g = (const float*)d_in[10]; a.ln1_b = (const float*)d_in[11]; a.moe_w_coarse = (const float*)d_in[12]; a.moe_w_fine = (const float*)d_in[13];
    a.moe_w1 = (const float*)d_in[14]; a.moe_w3 = (const float*)d_in[15]; a.moe_w2 = (const float*)d_in[16]; a.ln2_g = (const float*)d_in[17]; a.ln2_b = (const float*)d_in[18];
    a.out = (float*)d_out; a.ws = (unsigned char*)d_ws; a.pad = 0;
#if MK_ONE_LAUNCH
    a.ph_lo = 0; a.ph_hi = N_PHASES; a.use_bar = 1;
    hipLaunchKernelGGL(fwd, dim3(grid), dim3(NTHREADS), LDS_BYTES, stream, a);
#else
    for (int p = 0; p < N_PHASES; ++p) { a.ph_lo = p; a.ph_hi = p + 1; a.use_bar = 0; hipLaunchKernelGGL(fwd, dim3(grid), dim3(NTHREADS), LDS_BYTES, stream, a); }
#endif
}
```

```cpp
#include <hip/hip_runtime.h>
#include <cstdio>
#include <cstdint>

#ifndef OPT_ATTN
#define OPT_ATTN 1
#endif
#ifndef OPT_GEMM
#define OPT_GEMM 1
#endif
#ifndef MK_ONE_LAUNCH
#define MK_ONE_LAUNCH 1
#endif

#define GAS __attribute__((address_space(1)))
#define LAS __attribute__((address_space(3)))
typedef unsigned short bf16_t;
typedef short bf16x8 __attribute__((ext_vector_type(8)));
typedef float f32x4 __attribute__((ext_vector_type(4)));
typedef float f32x2 __attribute__((ext_vector_type(2)));
typedef float f32x16 __attribute__((ext_vector_type(16)));
typedef unsigned u32x4 __attribute__((ext_vector_type(4)));
typedef unsigned u32x2 __attribute__((ext_vector_type(2)));
typedef GAS unsigned gu32;
#define RLX_AGENT __ATOMIC_RELAXED, __HIP_MEMORY_SCOPE_AGENT
#define LDS_WAIT() asm volatile("s_waitcnt lgkmcnt(0)" ::: "memory")
#define VM_WAIT() asm volatile("s_waitcnt vmcnt(0)" ::: "memory")
#define MFMA32(a, b, c) __builtin_amdgcn_mfma_f32_32x32x16_bf16(a, b, c, 0, 0, 0)

__device__ __forceinline__ unsigned f2bf(float f) { unsigned u = __builtin_bit_cast(unsigned, f); return (u + 0x7fffu + ((u >> 16) & 1u)) >> 16; }
__device__ __forceinline__ unsigned pk2(float lo, float hi) { typedef float f2_ __attribute__((ext_vector_type(2))); typedef __bf16 b2_ __attribute__((ext_vector_type(2))); f2_ v = {lo, hi}; b2_ b = __builtin_convertvector(v, b2_); return __builtin_bit_cast(unsigned, b); }
__device__ __forceinline__ float bf2f(unsigned short b) { return __builtin_bit_cast(float, (unsigned)b << 16); }
__device__ __forceinline__ int crow(int r, int hi) { return (r & 3) + 8 * (r >> 2) + 4 * hi; }
template <int K> __device__ __forceinline__ float shx(float v) { static_assert(K < 32, "xor 32: use xsum32 / xmax32 / xpair32"); return __uint_as_float((unsigned)__builtin_amdgcn_ds_swizzle((int)__float_as_uint(v), (K << 10) | 0x1f)); }
__device__ __forceinline__ float xsum32(float v) { auto rr = __builtin_amdgcn_permlane32_swap(__float_as_uint(v), __float_as_uint(v), false, false); return __uint_as_float(rr[0]) + __uint_as_float(rr[1]); }
__device__ __forceinline__ float xmax32(float v) { auto rr = __builtin_amdgcn_permlane32_swap(__float_as_uint(v), __float_as_uint(v), false, false); return fmaxf(__uint_as_float(rr[0]), __uint_as_float(rr[1])); }
__device__ __forceinline__ float xpair32(float lo, float hi) { auto rr = __builtin_amdgcn_permlane32_swap(__float_as_uint(lo), __float_as_uint(hi), false, false); return __uint_as_float(rr[0]) + __uint_as_float(rr[1]); }
__device__ __forceinline__ float wave_sum(float v) {
    v += shx<1>(v); v += shx<2>(v); v += shx<4>(v); v += shx<8>(v); v += shx<16>(v);
    return xsum32(v);
}
__device__ __forceinline__ float fast_exp2(float x) { return __builtin_amdgcn_exp2f(x); }

constexpr int NTOK = 65536, DM = 1024, DEPTH = 4;
constexpr int NTOK_P = 32768;
constexpr int HP = 2560;
constexpr int HC_AQ = 0, HC_AK = 256, HC_AV = 512, HC_CQ_LAT = 768, HC_CKV = 1024, HC_KROPE = 1152, HC_CQ = 1280, HC_CK = 1664, HC_CV = 2048;
constexpr int QBP = 768, KVP = 768;
constexpr int MIX_A = 0, MIX_B = 256, MIX_C = 640;
constexpr int NEXP = 32, DEXP = 512;
constexpr float LOG2E = 1.4426950408889634f;
constexpr float SC_A = 0.17677669529663687f * LOG2E;
constexpr float SC_B = 0.10206207261596575f * LOG2E;
constexpr float SC_C = 0.125f * LOG2E;
constexpr float DN_ALPHA = 1.681792830507429f;
constexpr float LN_EPS = 1e-5f, RMS_EPS = 1e-6f;

constexpr size_t MiB = 1u << 20;
constexpr size_t WS_CTL = 0, CTL_ZERO_BYTES = 64 * 1024;
constexpr size_t WS_ROPE32 = 4 * MiB;
constexpr size_t WS_ROPE64 = 5 * MiB;
constexpr size_t WS_WIN = 8 * MiB;
constexpr size_t WS_WOUT = 28 * MiB;
constexpr size_t WS_WUQ = 36 * MiB;
constexpr size_t WS_WUKV = 38 * MiB;
constexpr size_t WS_W13 = 40 * MiB;
constexpr size_t WS_W2 = 104 * MiB;
constexpr size_t WS_XB = 136 * MiB;
constexpr size_t WS_H = 264 * MiB;
constexpr size_t WS_QB = 584 * MiB;
constexpr size_t WS_KVB = 680 * MiB;
constexpr size_t WS_MIX = 776 * MiB;
constexpr size_t WS_RSTD = 904 * MiB;
constexpr size_t WS_LSEC = 905 * MiB;
constexpr size_t WS_TW = 907 * MiB;
constexpr size_t WS_LIST = 908 * MiB;
constexpr size_t WS_END = 924 * MiB;
constexpr size_t WS_HID = WS_H;
constexpr size_t WS_YB = WS_H + 136 * MiB;
static_assert(WS_YB + 256 * MiB <= WS_KVB + 96 * MiB, "YB overlay");
constexpr int LIST_CAP = 131072;
constexpr int CW_TMO = 0;
constexpr int CW_CNT = 64;
constexpr int CW_BAR = 4096;

constexpr int RING_BYTES = 131072;
constexpr int MISC_OFF = RING_BYTES + 320;
constexpr int LDS_BYTES = 147456;
constexpr int NWAVES = 8, NTHREADS = 512;

#define XB_TMO      128
#define XB_XCNT(j)  (256  + 64 * (j))
#define XB_XSUB(j)  (1280 + 64 * (j))
#define XB_XGEN(j)  (2304 + 64 * (j))
#define XB_TOP      3328
#define XB_TOPGEN   3392
#define XCD_BAR_WORDS 3456
#define XB_SPIN_CAP (1u << 22)
__device__ __forceinline__ unsigned xb_ld(unsigned* p)              { return __hip_atomic_load(p, __ATOMIC_RELAXED, __HIP_MEMORY_SCOPE_AGENT); }
__device__ __forceinline__ unsigned xb_add(unsigned* p, unsigned v) { return __hip_atomic_fetch_add(p, v, __ATOMIC_RELAXED, __HIP_MEMORY_SCOPE_AGENT); }
__device__ __forceinline__ unsigned xb_xcc_id() { return (unsigned)__builtin_amdgcn_s_getreg((3 << 11) | 20) & 0xFu; }
#define XB_SPIN(cond, bar) do { unsigned _sp = 0; while (cond) { __builtin_amdgcn_s_sleep(1); \
    if ((++_sp & 255u) == 0u) { if (xb_ld(&(bar)[XB_TMO])) break; if (_sp > XB_SPIN_CAP) { atomicAdd(&(bar)[XB_TMO], 1u); break; } } } } while (0)
struct XcdBarrier { unsigned* bar; unsigned x; volatile LAS unsigned* st; };
__device__ __forceinline__ XcdBarrier xcd_barrier_post(unsigned* bar, volatile LAS unsigned* st) {
    XcdBarrier b; b.bar = bar; b.x = xb_xcc_id(); b.st = st;
    if (threadIdx.x == 0) (void)xb_add(&bar[XB_XCNT(b.x)], 1u);
    return b;
}
__device__ __forceinline__ void xcd_barrier_complete(unsigned* bar, unsigned x, unsigned& nloc, unsigned& nx) {
    const unsigned G = gridDim.x * gridDim.y * gridDim.z;
    unsigned sum, cnt, mine, sp = 0u;
    for (;;) {
        sum = 0u; cnt = 0u; mine = 0u;
#pragma unroll
        for (unsigned j = 0; j < 16; ++j) { const unsigned c = xb_ld(&bar[XB_XCNT(j)]); sum += c; cnt += (c > 0u) ? 1u : 0u; mine = (j == x) ? c : mine; }
        if (sum == G) break;
        __builtin_amdgcn_s_sleep(1);
        if ((++sp & 255u) == 0u) { if (xb_ld(&bar[XB_TMO])) break; if (sp > XB_SPIN_CAP) { atomicAdd(&bar[XB_TMO], 1u); break; } }
    }
    nloc = mine > 0u ? mine : 1u; nx = cnt > 0u ? cnt : 1u;
}
__device__ __forceinline__ void xcd_barrier(const XcdBarrier& b) {
    asm volatile("s_waitcnt vmcnt(0)" ::: "memory");
    __syncthreads();
    if (threadIdx.x == 0) {
        unsigned* bar = b.bar;
        __builtin_amdgcn_s_waitcnt(0);
        unsigned nloc = b.st[0], nx = b.st[1];
        if (nloc == 0u) { xcd_barrier_complete(bar, b.x, nloc, nx); b.st[0] = nloc; b.st[1] = nx; }
        const unsigned old = xb_add(&bar[XB_XSUB(b.x)], 1u);
        const unsigned gen = old / nloc;
        if (old + 1u == (gen + 1u) * nloc) {
            __builtin_amdgcn_fence(__ATOMIC_RELEASE, "agent");
            asm volatile("s_waitcnt vmcnt(0)" ::: "memory");
            const unsigned og = xb_add(&bar[XB_TOP], 1u);
            const unsigned tg = og / nx;
            if (og + 1u == (tg + 1u) * nx) xb_add(&bar[XB_TOPGEN], 1u);
            else XB_SPIN(xb_ld(&bar[XB_TOPGEN]) == tg, bar);
            __builtin_amdgcn_fence(__ATOMIC_ACQUIRE, "agent");
            xb_add(&bar[XB_XGEN(b.x)], 1u);
            asm volatile("s_waitcnt vmcnt(0)" ::: "memory");
        } else {
            XB_SPIN(xb_ld(&bar[XB_XGEN(b.x)]) == gen, bar);
            __builtin_amdgcn_fence(__ATOMIC_ACQUIRE, "agent");
            asm volatile("s_waitcnt vmcnt(0)" ::: "memory");
        }
    }
    __syncthreads();
}

struct Args {
    const float* x_prompt; const float* x_sample; const float* w_in; const float* diff_lambda; const float* diff_subln; const float* mla_q_norm; const float* mla_w_uq;
    const float* mla_kv_norm; const float* mla_w_ukv; const float* w_out; const float* ln1_g; const float* ln1_b; const float* moe_w_coarse; const float* moe_w_fine;
    const float* moe_w1; const float* moe_w3; const float* moe_w2; const float* ln2_g; const float* ln2_b;
    float* out; unsigned char* ws; int ph_lo, ph_hi, use_bar, pad;
};
struct Frame {
    LAS unsigned char* lds; unsigned char* ldsg;
    int tid, lane, wave, G, gw, NGW, bid;
    gu32* ctl; unsigned char* ws;
};
__device__ __forceinline__ void launder(Frame& F) {
    int wv = F.wave; asm volatile("" : "+s"(wv)); F.wave = wv;
    int t; asm volatile("v_mbcnt_lo_u32_b32 %0, -1, 0\n\tv_mbcnt_hi_u32_b32 %0, -1, %0" : "=v"(t)); F.lane = t; F.tid = wv * 64 + t;
    int b = (int)blockIdx.x; asm volatile("" : "+s"(b)); F.bid = b; F.gw = b * NWAVES + F.wave;
    unsigned char* w = F.ws; asm volatile("" : "+s"(w)); F.ws = w; F.ctl = (gu32*)(w + WS_CTL);
}
struct SeqInfo { int base, len, pos; };
__device__ __forceinline__ SeqInfo seqinfo(int m) { SeqInfo s; if (m < NTOK_P) { s.base = m & ~2047; s.len = 2048; } else { s.base = m & ~4095; s.len = 4096; } s.pos = m - s.base; return s; }

template <class ColMap>
__device__ __forceinline__ void transpose_item(const float* W, int N, bf16_t* WT, int ldd, LAS float* scr, int k0, int n0, const ColMap& cm, const float* kscale, int lane) {
    const int sc = cm(n0 + (lane & 31));
#pragma unroll 8
    for (int i = 0; i < 32; ++i) { const int kk = 2 * i + (lane >> 5); float v = 0.f; if (sc >= 0) { v = W[(size_t)(k0 + kk) * N + sc]; if (kscale) v *= kscale[k0 + kk]; } scr[kk * 33 + (lane & 31)] = v; }
    LDS_WAIT(); asm volatile("" ::: "memory");
    const int c = lane & 7;
#pragma unroll
    for (int j = 0; j < 4; ++j) { const int n = (lane >> 3) + 8 * j; const LAS float* s = scr + (8 * c) * 33 + n;
        u32x4 o; o.x = pk2(s[0 * 33], s[1 * 33]); o.y = pk2(s[2 * 33], s[3 * 33]); o.z = pk2(s[4 * 33], s[5 * 33]); o.w = pk2(s[6 * 33], s[7 * 33]);
        *(u32x4*)(WT + (size_t)(n0 + n) * ldd + k0 + 8 * c) = o; }
    LDS_WAIT(); asm volatile("" ::: "memory");
}
__device__ __forceinline__ void transpose_item_v4(const float* Wsrc, int N, bf16_t* WTdst, int ldd, LAS float* scr, int lane) {
    const int c4 = (lane & 7) * 4, kr = lane >> 3;
    f32x4 t[8];
#pragma unroll
    for (int i = 0; i < 8; ++i) t[i] = *(const f32x4*)(Wsrc + (size_t)(i * 8 + kr) * N + c4);
#pragma unroll
    for (int i = 0; i < 8; ++i) { const int kk = i * 8 + kr; scr[(c4 + 0) * 65 + kk] = t[i].x; scr[(c4 + 1) * 65 + kk] = t[i].y; scr[(c4 + 2) * 65 + kk] = t[i].z; scr[(c4 + 3) * 65 + kk] = t[i].w; }
    LDS_WAIT(); asm volatile("" ::: "memory");
    const int c = lane & 7;
#pragma unroll
    for (int j = 0; j < 4; ++j) { const int n = (lane >> 3) + 8 * j; const LAS float* p = scr + n * 65 + 8 * c;
        u32x4 o; o.x = pk2(p[0], p[1]); o.y = pk2(p[2], p[3]); o.z = pk2(p[4], p[5]); o.w = pk2(p[6], p[7]);
        *(u32x4*)(WTdst + (size_t)n * ldd + 8 * c) = o; }
    LDS_WAIT(); asm volatile("" ::: "memory");
}
struct WinMap {
    __device__ __forceinline__ int operator()(int n) const {
        if (n < 512) { const int t = n & 31; return (n & ~31) + (t >> 1) + 16 * (t & 1); }
        if (n < 1152) return n;
        if (n < 1184) { const int t = n - 1152; return 1152 + (t >> 1) + 16 * (t & 1); }
        if (n < 1280) return -1;
        if (n < 2048) { const int u = n - 1280, t = u & 63; return 1184 + (u & ~63) + (t >> 1) + 32 * (t & 1); }
        if (n < 2432) return 1952 + (n - 2048);
        return -1;
    }
};
struct UqMap { __device__ __forceinline__ int operator()(int n) const { if (n >= 576) return -1; const int h = n / 96, t = n - 96 * h; if (t < 64) return n; const int u = t - 64; return 96 * h + 64 + (u >> 1) + 16 * (u & 1); } };
struct IdMap { __device__ __forceinline__ int operator()(int n) const { return n; } };
struct W13Map { __device__ __forceinline__ int operator()(int n) const { return (n >> 8) * 128 + (n & 127); } };

__device__ __forceinline__ void p0_prologue(Frame& F, const Args& a) {
    LAS float* scr = (LAS float*)(F.lds + F.wave * 16384);
    { float2* r32 = (float2*)(F.ws + WS_ROPE32); float2* r64 = (float2*)(F.ws + WS_ROPE64);
      for (int i = F.gw * 64 + F.lane; i < 4096 * 16; i += F.NGW * 64) { const int pos = i >> 4, j = i & 15; const float inv = 1.0f / powf(10000.0f, (float)(2 * j) / 32.0f); const float ang = (float)pos * inv; r32[i] = make_float2(cosf(ang), sinf(ang)); }
      for (int i = F.gw * 64 + F.lane; i < 4096 * 32; i += F.NGW * 64) { const int pos = i >> 5, j = i & 31; const float inv = 1.0f / powf(10000.0f, (float)(2 * j) / 64.0f); const float ang = (float)pos * inv; r64[i] = make_float2(cosf(ang), sinf(ang)); } }
    constexpr int I_WIN = (1024 / 64) * (2560 / 32), I_WOUT = (1024 / 64) * (1024 / 32), I_UQ = (256 / 64) * (768 / 32), I_UKV = (256 / 64) * (768 / 32);
    constexpr int PER_L = I_WIN + I_WOUT + I_UQ + I_UKV;
    for (int it = F.gw; it < DEPTH * PER_L; it += F.NGW) {
        const int l = it / PER_L; int r = it - l * PER_L;
        if (r < I_WIN) { const int kb = r / 80, nb = r % 80; transpose_item(a.w_in + (size_t)l * 1024 * 2336, 2336, (bf16_t*)(F.ws + WS_WIN) + (size_t)l * 2560 * 1024, 1024, scr, kb * 64, nb * 32, WinMap(), nullptr, F.lane); continue; } r -= I_WIN;
        if (r < I_WOUT) { const int kb = r / 32, nb = r % 32; transpose_item(a.w_out + (size_t)l * 1024 * 1024, 1024, (bf16_t*)(F.ws + WS_WOUT) + (size_t)l * 1024 * 1024, 1024, scr, kb * 64, nb * 32, IdMap(), nullptr, F.lane); continue; } r -= I_WOUT;
        if (r < I_UQ) { const int kb = r / 24, nb = r % 24; transpose_item(a.mla_w_uq + (size_t)l * 256 * 576, 576, (bf16_t*)(F.ws + WS_WUQ) + (size_t)l * 768 * 256, 256, scr, kb * 64, nb * 32, UqMap(), a.mla_q_norm + l * 256, F.lane); continue; } r -= I_UQ;
        { const int kb = r / 24, nb = r % 24; bf16_t* dst = (bf16_t*)(F.ws + WS_WUKV) + (size_t)l * 768 * 256;
          if (kb < 2) transpose_item(a.mla_w_ukv + (size_t)l * 128 * 768, 768, dst, 256, scr, kb * 64, nb * 32, IdMap(), a.mla_kv_norm + l * 128, F.lane);
          else { const int c = F.lane & 7;
#pragma unroll
              for (int j = 0; j < 4; ++j) { const int n = (F.lane >> 3) + 8 * j; *(u32x4*)(dst + (size_t)(nb * 32 + n) * 256 + kb * 64 + 8 * c) = (u32x4){0u, 0u, 0u, 0u}; } } }
    }
    bf16_t* XB = (bf16_t*)(F.ws + WS_XB);
    for (int m = F.gw; m < NTOK; m += F.NGW) {
        const float* src = (m < NTOK_P) ? a.x_prompt + (size_t)m * DM : a.x_sample + (size_t)(m - NTOK_P) * DM;
#pragma unroll
        for (int j = 0; j < 4; ++j) { const f32x4 v = *((const f32x4*)src + F.lane + 64 * j);
            u32x2 w; w.x = pk2(v.x, v.y); w.y = pk2(v.z, v.w); *((u32x2*)(XB + (size_t)m * DM) + F.lane + 64 * j) = w; }
    }
}

template <class Epi, class RowMap>
__device__ __forceinline__ void sg_tile(const bf16_t* A, int lda, const bf16_t* B0, const bf16_t* B1, int ldb, int K, int m0, int c0, const Epi& E, const RowMap& RM, int lane) {
    const int r32 = lane & 31, hi = lane >> 5;
    const bf16_t* ap = A + (size_t)RM.src(m0 + r32) * lda + 8 * hi;
    const bf16_t* b0p = B0 + (size_t)r32 * ldb + 8 * hi;
    const bf16_t* b1p = B1 + (size_t)r32 * ldb + 8 * hi;
    f32x16 acc0 = {}, acc1 = {};
#pragma unroll 4
    for (int k = 0; k < K; k += 16) {
        const bf16x8 af = *(const bf16x8*)(ap + k), bf0 = *(const bf16x8*)(b0p + k), bf1 = *(const bf16x8*)(b1p + k);
        acc0 = MFMA32(bf0, af, acc0); acc1 = MFMA32(bf1, af, acc1);
    }
#pragma unroll
    for (int g = 0; g < 4; ++g) { const f32x4 v0 = {acc0[4 * g], acc0[4 * g + 1], acc0[4 * g + 2], acc0[4 * g + 3]}, v1 = {acc1[4 * g], acc1[4 * g + 1], acc1[4 * g + 2], acc1[4 * g + 3]};
        E.put(m0 + r32, c0, 8 * g + 4 * hi, v0, v1); }
}
struct IdRows { __device__ __forceinline__ int src(int m) const { return m; } };

__device__ __forceinline__ void store_bf8(bf16_t* p, f32x4 a, f32x4 b) { u32x4 w; w.x = pk2(a.x, a.y); w.y = pk2(a.z, a.w); w.z = pk2(b.x, b.y); w.w = pk2(b.z, b.w); *(u32x4*)p = w; }
__device__ __forceinline__ void store_bf4(bf16_t* p, f32x4 v) { u32x2 w; w.x = pk2(v.x, v.y); w.y = pk2(v.z, v.w); *(u32x2*)p = w; }
struct EpiH {
    static constexpr bool INPLACE = false;
    static constexpr bool PERM = true;
    bf16_t* H; const float2* rope32; const float2* rope64;
    __device__ __forceinline__ f32x4 xf(int pos, int col, f32x4 v) const {
        if (col < 512 || (col >= HC_KROPE && col < HC_KROPE + 32)) {
            const int j0 = (col & 31) >> 1; const f32x4 cs = *(const f32x4*)(rope32 + pos * 16 + j0);
            f32x4 o; o.x = v.x * cs.x - v.y * cs.y; o.y = v.x * cs.y + v.y * cs.x; o.z = v.z * cs.z - v.w * cs.w; o.w = v.z * cs.w + v.w * cs.z;
            if (col < 256) o = o * SC_A; v = o;
        } else if (col >= HC_CQ && col < HC_CV) {
            const int j0 = ((col - HC_CQ) & 63) >> 1; const f32x4 cs = *(const f32x4*)(rope64 + pos * 32 + j0);
            f32x4 o; o.x = v.x * cs.x - v.y * cs.y; o.y = v.x * cs.y + v.y * cs.x; o.z = v.z * cs.z - v.w * cs.w; o.w = v.z * cs.w + v.w * cs.z;
            if (col < HC_CK) o = o * SC_C; v = o;
        }
        return v;
    }
    __device__ __forceinline__ void put4(int row, int col, f32x4 v) const { store_bf4(H + (size_t)row * HP + col, xf(seqinfo(row).pos, col, v)); }
    __device__ __forceinline__ void put(int row, int c0, int cc, f32x4 v0, f32x4 v1) const { put4(row, c0 + cc, v0); put4(row, c0 + 32 + cc, v1); }
    template <class U> __device__ __forceinline__ void put8(const U&, int row, int col, f32x4 v0, f32x4 v1) const { const int pos = seqinfo(row).pos; store_bf8(H + (size_t)row * HP + col, xf(pos, col, v0), xf(pos, col + 4, v1)); }
    struct Pre { f32x4 c0, c1; };
    __device__ __forceinline__ static f32x4 rot(f32x4 v, f32x4 cs) { f32x4 o; o.x = v.x * cs.x - v.y * cs.y; o.y = v.x * cs.y + v.y * cs.x; o.z = v.z * cs.z - v.w * cs.w; o.w = v.z * cs.w + v.w * cs.z; return o; }
    template <class U> __device__ __forceinline__ Pre pre(const U&, int row, int col) const { Pre p; p.c0 = (f32x4){0.f, 0.f, 0.f, 0.f}; p.c1 = p.c0; const int pos = seqinfo(row).pos;
        if (col < 512 || (col >= HC_KROPE && col < HC_KROPE + 32)) { const f32x4* t = (const f32x4*)(rope32 + pos * 16 + ((col & 31) >> 1)); p.c0 = t[0]; p.c1 = t[1]; }
        else if (col >= HC_CQ && col < HC_CV) { const f32x4* t = (const f32x4*)(rope64 + pos * 32 + (((col - HC_CQ) & 63) >> 1)); p.c0 = t[0]; p.c1 = t[1]; }
        return p; }
    template <class U> __device__ __forceinline__ void fin8(const U&, int row, int col, f32x4 v0, f32x4 v1, const Pre& p) const {
        if (col < 512 || (col >= HC_KROPE && col < HC_KROPE + 32)) { v0 = rot(v0, p.c0); v1 = rot(v1, p.c1); if (col < 256) { v0 = v0 * SC_A; v1 = v1 * SC_A; } }
        else if (col >= HC_CQ && col < HC_CV) { v0 = rot(v0, p.c0); v1 = rot(v1, p.c1); if (col < HC_CK) { v0 = v0 * SC_C; v1 = v1 * SC_C; } }
        store_bf8(H + (size_t)row * HP + col, v0, v1); }
};
struct EpiUQ {
    static constexpr bool INPLACE = false;
    static constexpr bool PERM = true;
    bf16_t* Q; const float* rstd; const float2* rope32;
    __device__ __forceinline__ f32x4 xf(int row, int col, f32x4 v, float rs) const {
        v = v * rs;
        const int t = col % 96;
        if (t >= 64) { const int pos = seqinfo(row).pos; const int j0 = (t - 64) >> 1; const f32x4 cs = *(const f32x4*)(rope32 + pos * 16 + j0);
            f32x4 o; o.x = v.x * cs.x - v.y * cs.y; o.y = v.x * cs.y + v.y * cs.x; o.z = v.z * cs.z - v.w * cs.w; o.w = v.z * cs.w + v.w * cs.z; v = o; }
        return v * SC_B;
    }
    __device__ __forceinline__ void put4(int row, int col, f32x4 v) const { if (col >= 576) return; store_bf4(Q + (size_t)row * QBP + col, xf(row, col, v, rstd[2 * row])); }
    template <class U> __device__ __forceinline__ void put8(const U&, int row, int col, f32x4 v0, f32x4 v1) const { if (col >= 576) return; const float rs = rstd[2 * row]; store_bf8(Q + (size_t)row * QBP + col, xf(row, col, v0, rs), xf(row, col + 4, v1, rs)); }
    __device__ __forceinline__ void put(int row, int c0, int cc, f32x4 v0, f32x4 v1) const { put4(row, c0 + cc, v0); put4(row, c0 + 32 + cc, v1); }
    struct Pre { float rs; f32x4 c0, c1; };
    template <class U> __device__ __forceinline__ Pre pre(const U&, int row, int col) const { Pre p; p.rs = rstd[2 * row]; p.c0 = (f32x4){0.f, 0.f, 0.f, 0.f}; p.c1 = p.c0;
        if (col < 576 && (col % 96) >= 64) { const f32x4* t = (const f32x4*)(rope32 + seqinfo(row).pos * 16 + (((col % 96) - 64) >> 1)); p.c0 = t[0]; p.c1 = t[1]; }
        return p; }
    template <class U> __device__ __forceinline__ void fin8(const U&, int row, int col, f32x4 v0, f32x4 v1, const Pre& p) const { if (col >= 576) return;
        v0 = v0 * p.rs; v1 = v1 * p.rs; if ((col % 96) >= 64) { v0 = EpiH::rot(v0, p.c0); v1 = EpiH::rot(v1, p.c1); }
        store_bf8(Q + (size_t)row * QBP + col, v0 * SC_B, v1 * SC_B); }
};
struct EpiUKV {
    static constexpr bool INPLACE = false;
    static constexpr bool PERM = true;
    bf16_t* KV; const float* rstd;
    template <class U> __device__ __forceinline__ void put8(const U&, int row, int col, f32x4 v0, f32x4 v1) const { const float rs = rstd[2 * row + 1]; store_bf8(KV + (size_t)row * KVP + col, v0 * rs, v1 * rs); }
    __device__ __forceinline__ void put4(int row, int col, f32x4 v) const { store_bf4(KV + (size_t)row * KVP + col, v * rstd[2 * row + 1]); }
    __device__ __forceinline__ void put(int row, int c0, int cc, f32x4 v0, f32x4 v1) const { put4(row, c0 + cc, v0); put4(row, c0 + 32 + cc, v1); }
    struct Pre { float rs; };
    template <class U> __device__ __forceinline__ Pre pre(const U&, int row, int) const { Pre p; p.rs = rstd[2 * row + 1]; return p; }
    template <class U> __device__ __forceinline__ void fin8(const U&, int row, int col, f32x4 v0, f32x4 v1, const Pre& p) const { store_bf8(KV + (size_t)row * KVP + col, v0 * p.rs, v1 * p.rs); }
};
struct EpiRes {
    static constexpr bool INPLACE = true;
    static constexpr bool PERM = false;
    float* X; const float* xp; const float* xs; float* D;
    template <class U> __device__ __forceinline__ void put4(const U&, int row, int col, f32x4 v) const { put4(row, col, v); }
    __device__ __forceinline__ void put4(int row, int col, f32x4 v) const {
        const f32x4* p = (const f32x4*)(X + (size_t)row * DM + col);
        const f32x4 r = xp ? *(const f32x4*)(((row < NTOK_P) ? xp + (size_t)row * DM : xs + (size_t)(row - NTOK_P) * DM) + col) : *p;
        *(f32x4*)(D + (size_t)row * DM + col) = r * DN_ALPHA + v; }
    __device__ __forceinline__ void put(int row, int c0, int cc, f32x4 v0, f32x4 v1) const { put4(row, c0 + cc, v0); put4(row, c0 + 32 + cc, v1); }
    struct Pre { f32x4 a, b; };
    template <class U> __device__ __forceinline__ Pre pre(const U&, int row, int col) const { Pre p;
        const float* src = xp ? ((row < NTOK_P) ? xp + (size_t)row * DM : xs + (size_t)(row - NTOK_P) * DM) : X + (size_t)row * DM;
        p.a = *(const f32x4*)(src + col); p.b = *(const f32x4*)(src + col + 16); return p; }
    template <class U> __device__ __forceinline__ void fin4x2(const U&, int row, int col, f32x4 v0, f32x4 v1, const Pre& p) const {
        *(f32x4*)(D + (size_t)row * DM + col) = p.a * DN_ALPHA + v0; *(f32x4*)(D + (size_t)row * DM + col + 16) = p.b * DN_ALPHA + v1; }
};
__device__ __forceinline__ float silu_f(float x) { return x / (1.0f + __expf(-x)); }
struct EpiHid {
    static constexpr bool INPLACE = false;
    static constexpr bool PERM = true;
    bf16_t* HID;
    __device__ __forceinline__ f32x4 act(f32x4 g, f32x4 u) const { f32x4 o; o.x = silu_f(g.x) * u.x; o.y = silu_f(g.y) * u.y; o.z = silu_f(g.z) * u.z; o.w = silu_f(g.w) * u.w; return o; }
    template <class U> __device__ __forceinline__ void putp8(const U&, int row, int col, f32x4 g0, f32x4 g1, f32x4 u0, f32x4 u1) const { store_bf8(HID + (size_t)row * DEXP + col, act(g0, u0), act(g1, u1)); }
    __device__ __forceinline__ void putp(int row, int col, f32x4 g, f32x4 u) const { f32x4 o; o.x = silu_f(g.x) * u.x; o.y = silu_f(g.y) * u.y; o.z = silu_f(g.z) * u.z; o.w = silu_f(g.w) * u.w; store_bf4(HID + (size_t)row * DEXP + col, o); }
    __device__ __forceinline__ void put(int row, int c0, int cc, f32x4 v0, f32x4 v1) const { putp(row, c0 + cc, v0, v1); }
};
struct EpiY {
    static constexpr bool INPLACE = false;
    bf16_t* YB; const float* tw; const int* list; int seg0, cnt;
    __device__ __forceinline__ void put4(int row, int col, f32x4 v) const { const int r = row - seg0; if (r >= cnt) return; const int a = list[r]; store_bf4(YB + (size_t)a * DM + col, v * tw[a]); }
    __device__ __forceinline__ void put(int row, int c0, int cc, f32x4 v0, f32x4 v1) const { put4(row, c0 + cc, v0); put4(row, c0 + 32 + cc, v1); }
};

struct EpiYO {
    static constexpr bool INPLACE = false;
    static constexpr bool PERM = true;
    bf16_t* YB; const float* tw; const int* list; const LAS int* seg;
    template <class U> __device__ __forceinline__ void put8(const U& u, int row, int col, f32x4 v0, f32x4 v1) const {
        const int r = row - __builtin_amdgcn_readfirstlane(seg[u.e]); if (r >= __builtin_amdgcn_readfirstlane(seg[33 + u.e])) return; const int a = list[(size_t)u.e * LIST_CAP + r]; const float w = tw[a]; store_bf8(YB + (size_t)a * DM + col, v0 * w, v1 * w); }
    struct Pre { int a; float w; };
    template <class U> __device__ __forceinline__ Pre pre(const U& u, int row, int) const { Pre p; p.a = -1; p.w = 0.f;
        const int r = row - __builtin_amdgcn_readfirstlane(seg[u.e]); if (r < __builtin_amdgcn_readfirstlane(seg[33 + u.e])) { p.a = list[(size_t)u.e * LIST_CAP + r]; p.w = tw[p.a]; } return p; }
    template <class U> __device__ __forceinline__ void fin8(const U&, int, int col, f32x4 v0, f32x4 v1, const Pre& p) const { if (p.a >= 0) store_bf8(YB + (size_t)p.a * DM + col, v0 * p.w, v1 * p.w); }
};
template <class Epi>
__device__ __forceinline__ void sg_phase(Frame& F, const bf16_t* A, int lda, const bf16_t* Bt, int ldb, int M, int N, int K, const Epi& E) {
    const int nN = N / 64, items = (M / 32) * nN;
    for (int it = F.gw; it < items; it += F.NGW) { const int mt = it / nN, nt = it - mt * nN;
        sg_tile(A, lda, Bt + (size_t)(nt * 64) * ldb, Bt + (size_t)(nt * 64 + 32) * ldb, ldb, K, mt * 32, nt * 64, E, IdRows(), F.lane); }
}


namespace pg8 {
constexpr int BM = 256, BK = 64, HALF = 128, HTB = HALF * BK * 2, NXCD = 8, WGM = 8;
__host__ __device__ __forceinline__ int lds_byte(int r, int c) { const int st = (r >> 4) * 2 + (c >> 5), rr = r & 15, cc = c & 31, ob = rr * 64 + cc * 2; return st * 1024 + (ob ^ (((ob >> 9) & 1) << 5)); }
__host__ __device__ __forceinline__ void stage_rc(int b, int& R, int& C) { const int st = b / 1024, sb = b % 1024, swz = sb ^ (((sb >> 9) & 1) << 5); R = (st >> 1) * 16 + swz / 64; C = (st & 1) * 32 + (swz % 64) / 2; }
__host__ __device__ __forceinline__ int perm32(int rho) { const int n = rho >> 4, i = rho & 15; return 8 * (i >> 2) + 4 * n + (i & 3); }
struct Unit { int pm, pn, e; const char* a; const char* b; };
__device__ __forceinline__ bool order_next(int i, int G, int c, int nM, int nN, int& pm, int& pn) {
    const int nwg = nM * nN; const long L = (long)i * G + c; if (L >= nwg) return false;
    int wgid = (int)L; { const int q = nwg / NXCD, r = nwg % NXCD, xcd = wgid % NXCD, off = wgid / NXCD; wgid = (xcd < r ? xcd * (q + 1) : r * (q + 1) + (xcd - r) * q) + off; }
    const int nig = WGM * nN, gid = wgid / nig, fm = gid * WGM, gsz = (nM - fm) < WGM ? (nM - fm) : WGM;
    pm = fm + ((wgid % nig) % gsz); pn = (wgid % nig) / gsz; return true;
}
struct DenseSched {
    const char* A; const char* Bt; int nM, nN, G, c; size_t tstepA, tstepB;
    __device__ __forceinline__ void init(const bf16_t* A_, int lda, const bf16_t* Bt_, int M, int N, int K, int G_, int c_) { A = (const char*)A_; Bt = (const char*)Bt_; nM = M / BM; nN = N / BM; G = G_; c = c_; tstepA = (size_t)BM * lda * 2; tstepB = (size_t)BM * K * 2; }
    __device__ __forceinline__ bool next(int i, Unit& u) const { if (!order_next(i, G, c, nM, nN, u.pm, u.pn)) return false; u.e = 0; u.a = A + (size_t)u.pm * tstepA; u.b = Bt + (size_t)u.pn * tstepB; return true; }
    __device__ __forceinline__ unsigned arow(const Unit&, int) const { return 0u; }
};
struct PanelSched {
    const char* A; const char* Bt; int pm, nN; size_t tstepB;
    __device__ __forceinline__ void init(const bf16_t* A_, int lda, const bf16_t* Bt_, int pm_, int N, int K) { pm = pm_; nN = N / BM; A = (const char*)A_ + (size_t)pm_ * BM * lda * 2; Bt = (const char*)Bt_; tstepB = (size_t)BM * K * 2; }
    __device__ __forceinline__ bool next(int i, Unit& u) const { if (i >= nN) return false; u.pm = pm; int pn = i + (pm % nN); if (pn >= nN) pn -= nN; u.pn = pn; u.e = 0; u.a = A; u.b = Bt + (size_t)pn * tstepB; return true; }
    __device__ __forceinline__ unsigned arow(const Unit&, int) const { return 0u; }
};
template <class Epi, bool PAIR> struct EpiApply;
template <class Epi, class Sched, bool GATHER, bool PAIR>
__device__ __forceinline__ void gemm_phase(LAS unsigned char* lds, int tid, int K, int lda, const Sched& S, const Epi& E) {
    const int wid = __builtin_amdgcn_readfirstlane(tid >> 6), lane = tid & 63, wr = wid >> 2, wc = wid & 3, fr = lane & 15, fq = lane >> 4;
    const int nt = K / BK;
    unsigned voffA[2], voffB[2]; int RA[2], CA[2];
#pragma unroll
    for (int i = 0; i < 2; ++i) { int R, C; stage_rc(tid * 16 + i * 8192, R, C); const int Rb = Epi::PERM ? ((R & ~31) + perm32(R & 31)) : R; RA[i] = R; CA[i] = C;
        voffA[i] = (unsigned)(R * lda + C) * 2u; voffB[i] = (unsigned)(Rb * K + C) * 2u; }
    const size_t kstep = (size_t)(BK * 2);
    const size_t hstepA = (size_t)HALF * lda * 2, hstepB = (size_t)HALF * K * 2;
    const unsigned ldsw = (unsigned)wid * 1024u;
    const int aoff = lds_byte(wr * 64 + fr, fq * 8), boff = lds_byte(wc * 32 + fr, fq * 8);
#define PG8_SA(b, h) (((b) * 2 + (h)) * HTB)
#define PG8_SB(b, h) ((4 + (b) * 2 + (h)) * HTB)
#define PG8_STAGE(bufoff, gbase, voff) do { _Pragma("unroll") for (int _i = 0; _i < 2; ++_i) \
        __builtin_amdgcn_global_load_lds((const unsigned*)((const char*)(gbase) + (voff)[_i]), (LAS unsigned*)(lds + (bufoff) + ldsw + _i * 8192), 16, 0, 0); } while (0)
#define PG8_STAGE_A(bufoff, ab, vg, h, koff) do { if (GATHER) { PG8_STAGE(bufoff, (ab) + (koff), (vg)[h]); } else { PG8_STAGE(bufoff, (ab) + (h) * hstepA + (koff), voffA); } } while (0)
#define PG8_LDA(dst, b, h) do { _Pragma("unroll") for (int m = 0; m < 4; ++m) _Pragma("unroll") for (int k = 0; k < 2; ++k) dst[m][k] = *(const LAS bf16x8*)(lds + PG8_SA(b, h) + aoff + m * 2048 + k * 1024); } while (0)
#define PG8_LDB(dst, b, h) do { _Pragma("unroll") for (int n = 0; n < 2; ++n) _Pragma("unroll") for (int k = 0; k < 2; ++k) dst[n][k] = *(const LAS bf16x8*)(lds + PG8_SB(b, h) + boff + n * 2048 + k * 1024); } while (0)
#define PG8_MMA(ai, bj, At, Bt) do { __builtin_amdgcn_s_setprio(1); _Pragma("unroll") for (int m = 0; m < 4; ++m) _Pragma("unroll") for (int n = 0; n < 2; ++n) _Pragma("unroll") for (int k = 0; k < 2; ++k) \
        acc[ai][bj][m][n] = __builtin_amdgcn_mfma_f32_16x16x32_bf16(Bt[n][k], At[m][k], acc[ai][bj][m][n], 0, 0, 0); __builtin_amdgcn_s_setprio(0); } while (0)
#define PG8_WAIT_V(n) asm volatile("s_waitcnt vmcnt(" #n ")" ::: "memory")
#define PG8_WAIT_L(n) asm volatile("s_waitcnt lgkmcnt(" #n ")" ::: "memory")
#define PG8_BAR __builtin_amdgcn_s_barrier()
#define PG8_SCHED __builtin_amdgcn_sched_barrier(0)
    Unit cur, nxt; int ui = 0;
    if (!S.next(0, cur)) return;
    f32x4 acc[2][2][4][2];
#pragma unroll
    for (int a = 0; a < 2; ++a)
#pragma unroll
        for (int b = 0; b < 2; ++b)
#pragma unroll
            for (int m = 0; m < 4; ++m)
#pragma unroll
                for (int n = 0; n < 2; ++n) acc[a][b][m][n] = (f32x4){0.f, 0.f, 0.f, 0.f};
    bf16x8 At[4][2], B0[2][2], B1[2][2];
    unsigned vgc[2][2] = {{0u, 0u}, {0u, 0u}}, vgn[2][2] = {{0u, 0u}, {0u, 0u}};
    if (GATHER) {
#pragma unroll
        for (int h = 0; h < 2; ++h)
#pragma unroll
            for (int i = 0; i < 2; ++i) vgc[h][i] = S.arow(cur, h * HALF + RA[i]) * (unsigned)(lda * 2) + (unsigned)CA[i] * 2u;
    }
    const char* cA = cur.a; const char* cB = cur.b;
    PG8_STAGE(PG8_SB(0, 0), cB, voffB); PG8_STAGE(PG8_SB(0, 1), cB + hstepB, voffB); PG8_STAGE_A(PG8_SA(0, 0), cA, vgc, 0, 0); PG8_STAGE_A(PG8_SA(0, 1), cA, vgc, 1, 0);
    if (wr == 1) PG8_BAR;
    PG8_WAIT_V(2); PG8_BAR;
    PG8_STAGE(PG8_SB(1, 0), cB + kstep, voffB); PG8_STAGE_A(PG8_SA(1, 0), cA, vgc, 0, kstep); PG8_STAGE(PG8_SB(1, 1), cB + hstepB + kstep, voffB);
    PG8_WAIT_V(6); PG8_BAR;
    for (;;) {
        const bool has_next = S.next(ui + 1, nxt);
        const char* nA = has_next ? nxt.a : cA; const char* nB = has_next ? nxt.b : cB;
        if (GATHER) {
#pragma unroll
            for (int h = 0; h < 2; ++h)
#pragma unroll
                for (int i = 0; i < 2; ++i) vgn[h][i] = has_next ? (S.arow(nxt, h * HALF + RA[i]) * (unsigned)(lda * 2) + (unsigned)CA[i] * 2u) : vgc[h][i];
        }
#pragma clang loop unroll(disable)
        for (int t = 0; t < nt; t += 2) {
            const bool last = (t == nt - 2);
            const size_t k1 = (size_t)(t + 1) * kstep;
            const char* a2 = last ? nA : cA; const char* b2 = last ? nB : cB + (size_t)(t + 2) * kstep; const size_t ka2 = last ? 0 : (size_t)(t + 2) * kstep;
            const char* b3 = b2 + kstep; const size_t ka3 = ka2 + kstep;
            unsigned v2[2][2];
#pragma unroll
            for (int h = 0; h < 2; ++h)
#pragma unroll
                for (int i = 0; i < 2; ++i) v2[h][i] = last ? vgn[h][i] : vgc[h][i];
            PG8_LDB(B0, 0, 0); PG8_LDB(B1, 0, 1); PG8_SCHED; PG8_LDA(At, 0, 0); PG8_STAGE_A(PG8_SA(1, 1), cA, vgc, 1, k1);
            PG8_WAIT_V(8); PG8_WAIT_L(0); PG8_BAR; PG8_MMA(0, 0, At, B0); PG8_MMA(0, 1, At, B1); PG8_BAR; PG8_SCHED;
            PG8_LDA(At, 0, 1); PG8_STAGE(PG8_SB(0, 0), b2, voffB); PG8_STAGE(PG8_SB(0, 1), b2 + hstepB, voffB); PG8_STAGE_A(PG8_SA(0, 0), a2, v2, 0, ka2);
            PG8_WAIT_V(8); PG8_WAIT_L(0); PG8_BAR; PG8_MMA(1, 0, At, B0); PG8_MMA(1, 1, At, B1); PG8_BAR; PG8_SCHED;
            PG8_LDB(B0, 1, 0); PG8_LDB(B1, 1, 1); PG8_SCHED; PG8_LDA(At, 1, 0); PG8_STAGE_A(PG8_SA(0, 1), a2, v2, 1, ka2);
            PG8_WAIT_V(8); PG8_WAIT_L(0); PG8_BAR; PG8_MMA(0, 0, At, B0); PG8_MMA(0, 1, At, B1); PG8_BAR; PG8_SCHED;
            PG8_LDA(At, 1, 1); PG8_STAGE(PG8_SB(1, 0), b3, voffB); PG8_STAGE(PG8_SB(1, 1), b3 + hstepB, voffB); PG8_STAGE_A(PG8_SA(1, 0), a2, v2, 0, ka3);
            PG8_WAIT_V(8); PG8_WAIT_L(0); PG8_BAR; PG8_MMA(1, 0, At, B0); PG8_MMA(1, 1, At, B1); PG8_BAR; PG8_SCHED;
        }
        if (wr == 0) PG8_BAR;
        { int fr_ = fr, fq_ = fq; asm volatile("" : "+v"(fr_), "+v"(fq_));
          EpiApply<Epi, PAIR>::run(E, acc, cur, wr, wc, fr_, fq_);
#ifdef PROBE_DUP_EPI
          if (!Epi::INPLACE) { asm volatile("" : "+v"(fr_), "+v"(fq_)); EpiApply<Epi, PAIR>::run(E, acc, cur, wr, wc, fr_, fq_); }
#endif
          }
        if (!has_next) break;
#pragma unroll
        for (int a = 0; a < 2; ++a)
#pragma unroll
            for (int b = 0; b < 2; ++b)
#pragma unroll
                for (int m = 0; m < 4; ++m)
#pragma unroll
                    for (int n = 0; n < 2; ++n) acc[a][b][m][n] = (f32x4){0.f, 0.f, 0.f, 0.f};
        cur = nxt; cA = nA; cB = nB; ++ui;
        if (GATHER) {
#pragma unroll
            for (int h = 0; h < 2; ++h)
#pragma unroll
                for (int i = 0; i < 2; ++i) vgc[h][i] = vgn[h][i];
        }
        if (wr == 1) PG8_BAR;
    }
    PG8_WAIT_V(0);
    PG8_BAR;
#undef PG8_SA
#undef PG8_SB
#undef PG8_STAGE
#undef PG8_STAGE_A
#undef PG8_LDA
#undef PG8_LDB
#undef PG8_MMA
#undef PG8_WAIT_V
#undef PG8_WAIT_L
#undef PG8_BAR
#undef PG8_SCHED
}
template <class Epi> struct EpiApply<Epi, false> {
    static __device__ __forceinline__ void run(const Epi& E, const f32x4 (&acc)[2][2][4][2], const Unit& u, int wr, int wc, int fr, int fq) {
#pragma unroll
        for (int ai = 0; ai < 2; ++ai) {
            typename Epi::Pre pre[4][2];
#pragma unroll
            for (int m = 0; m < 4; ++m) { const int row = u.pm * BM + ai * HALF + wr * 64 + m * 16 + fr;
#pragma unroll
                for (int bj = 0; bj < 2; ++bj) pre[m][bj] = E.pre(u, row, u.pn * BM + bj * HALF + wc * 32 + (Epi::PERM ? 8 : 4) * fq); }
#pragma unroll
            for (int m = 0; m < 4; ++m) { const int row = u.pm * BM + ai * HALF + wr * 64 + m * 16 + fr;
#pragma unroll
                for (int bj = 0; bj < 2; ++bj) {
                    if constexpr (Epi::PERM) E.fin8(u, row, u.pn * BM + bj * HALF + wc * 32 + 8 * fq, acc[ai][bj][m][0], acc[ai][bj][m][1], pre[m][bj]);
                    else E.fin4x2(u, row, u.pn * BM + bj * HALF + wc * 32 + 4 * fq, acc[ai][bj][m][0], acc[ai][bj][m][1], pre[m][bj]); } }
        }
    }
};
template <class Epi> struct EpiApply<Epi, true> {
    static __device__ __forceinline__ void run(const Epi& E, const f32x4 (&acc)[2][2][4][2], const Unit& u, int wr, int wc, int fr, int fq) {
#pragma unroll
        for (int ai = 0; ai < 2; ++ai)
#pragma unroll
            for (int m = 0; m < 4; ++m) { const int row = u.pm * BM + ai * HALF + wr * 64 + m * 16 + fr;
                E.putp8(u, row, u.pn * HALF + wc * 32 + 8 * fq, acc[ai][0][m][0], acc[ai][0][m][1], acc[ai][1][m][0], acc[ai][1][m][1]); }
    }
};
}

__device__ __forceinline__ void rowstat_pass(Frame& F, int r_first, int r_stride, int r_end) {
    const bf16_t* H = (const bf16_t*)(F.ws + WS_H); float* rstd = (float*)(F.ws + WS_RSTD);
    for (int m = r_first; m < r_end; m += r_stride) {
        const bf16_t* hr = H + (size_t)m * HP;
        const u32x2 q = *((const u32x2*)(hr + HC_CQ_LAT) + F.lane);
        const unsigned kv = *((const unsigned*)(hr + HC_CKV) + F.lane);
        float a0 = bf2f(q.x & 0xffff), a1 = bf2f(q.x >> 16), a2 = bf2f(q.y & 0xffff), a3 = bf2f(q.y >> 16), b0 = bf2f(kv & 0xffff), b1 = bf2f(kv >> 16);
        const float sq = wave_sum(a0 * a0 + a1 * a1 + a2 * a2 + a3 * a3), sk = wave_sum(b0 * b0 + b1 * b1);
        if (F.lane == 0) { rstd[2 * m] = 1.0f / sqrtf(sq * (1.0f / 256.0f) + RMS_EPS); rstd[2 * m + 1] = 1.0f / sqrtf(sk * (1.0f / 128.0f) + RMS_EPS); }
    }
}
__device__ __forceinline__ void red8(float (&v)[8], int lane) {
    float a[4], b[2], c;
#pragma unroll
    for (int i = 0; i < 4; ++i) a[i] = xpair32(v[i], v[i + 4]);
    { const bool up = (lane & 16) != 0;
#pragma unroll
      for (int i = 0; i < 2; ++i) { const float send = up ? a[i] : a[i + 2], keep = up ? a[i + 2] : a[i]; b[i] = keep + shx<16>(send); } }
    { const bool up = (lane & 8) != 0; const float send = up ? b[0] : b[1], keep = up ? b[1] : b[0]; c = keep + shx<8>(send); }
    c += shx<4>(c); c += shx<2>(c); c += shx<1>(c);
#pragma unroll
    for (int i = 0; i < 8; ++i) v[i] = __uint_as_float(__builtin_amdgcn_readlane(__float_as_uint(c), ((i >> 2) & 1) * 32 + ((i >> 1) & 1) * 16 + (i & 1) * 8));
}
__device__ __forceinline__ void red4(float (&v)[4], int lane) {
    float a[2], c;
#pragma unroll
    for (int i = 0; i < 2; ++i) a[i] = xpair32(v[i], v[i + 2]);
    { const bool up = (lane & 16) != 0; const float send = up ? a[0] : a[1], keep = up ? a[1] : a[0]; c = keep + shx<16>(send); }
    c += shx<8>(c); c += shx<4>(c); c += shx<2>(c); c += shx<1>(c);
#pragma unroll
    for (int i = 0; i < 4; ++i) v[i] = __uint_as_float(__builtin_amdgcn_readlane(__float_as_uint(c), ((i >> 1) & 1) * 32 + (i & 1) * 16));
}
__device__ __forceinline__ void ln1_route_pass(Frame& F, const Args& a, int layer, int r_first, int r_stride, int r_end) {
    bf16_t* XB = (bf16_t*)(F.ws + WS_XB); float* tw = (float*)(F.ws + WS_TW); int* list = (int*)(F.ws + WS_LIST);
    const float* g = a.ln1_g + layer * DM; const float* bb = a.ln1_b + layer * DM;
    const float* wc = a.moe_w_coarse + (size_t)layer * DM * 4; const float* wf = a.moe_w_fine + (size_t)layer * 4 * DM * 8;
    for (int q = F.tid; q < 4 * 1024 * 2; q += NTHREADS) { const int hf = q & 1, k = (q >> 1) & 1023, gg = q >> 11; const int l = (k & 255) >> 2, e = k & 3, j = k >> 8;
        *(LAS f32x4*)(F.lds + (size_t)(gg * 2048 + ((j * 4 + e) * 2 + hf) * 64 + l) * 16) = *((const f32x4*)wf + q); }
    f32x4 wcr[4][4];
#pragma unroll
    for (int j = 0; j < 4; ++j)
#pragma unroll
        for (int e = 0; e < 4; ++e) wcr[j][e] = *(const f32x4*)(wc + (size_t)(4 * F.lane + 256 * j + e) * 4);
    __syncthreads();
    f32x4 vn[2][4];
#pragma unroll
    for (int rr = 0; rr < 2; ++rr) { const int mm = r_first + rr * r_stride; if (mm < r_end) {
#pragma unroll
        for (int j = 0; j < 4; ++j) vn[rr][j] = *((const f32x4*)(a.out + (size_t)mm * DM) + F.lane + 64 * j); } }
    for (int m0 = r_first; m0 < r_end; m0 += 2 * r_stride) {
        f32x4 vc[2][4];
#pragma unroll
        for (int rr = 0; rr < 2; ++rr)
#pragma unroll
            for (int j = 0; j < 4; ++j) vc[rr][j] = vn[rr][j];
#pragma unroll
        for (int rr = 0; rr < 2; ++rr) { const int mm = m0 + (2 + rr) * r_stride; if (mm < r_end) {
#pragma unroll
            for (int j = 0; j < 4; ++j) vn[rr][j] = *((const f32x4*)(a.out + (size_t)mm * DM) + F.lane + 64 * j); } }
#pragma unroll
      for (int rr = 0; rr < 2; ++rr) { const int m = m0 + rr * r_stride; if (m < r_end) {
        f32x4 v[4]; float s = 0.f;
#pragma unroll
        for (int j = 0; j < 4; ++j) { v[j] = vc[rr][j]; s += (v[j].x + v[j].y) + (v[j].z + v[j].w); }
        const float mean = wave_sum(s) * (1.f / DM); float s2 = 0.f;
#pragma unroll
        for (int j = 0; j < 4; ++j) { v[j] = v[j] - mean; s2 += (v[j].x * v[j].x + v[j].y * v[j].y) + (v[j].z * v[j].z + v[j].w * v[j].w); }
        const float rs = 1.f / sqrtf(wave_sum(s2) * (1.f / DM) + LN_EPS);
        float cl[4] = {0.f, 0.f, 0.f, 0.f};
#pragma unroll
        for (int j = 0; j < 4; ++j) { const int c = 4 * F.lane + 256 * j; const f32x4 gg = *(const f32x4*)(g + c), bv = *(const f32x4*)(bb + c); v[j] = v[j] * rs * gg + bv;
            u32x2 w; w.x = pk2(v[j].x, v[j].y); w.y = pk2(v[j].z, v[j].w); *((u32x2*)(XB + (size_t)m * DM) + F.lane + 64 * j) = w;
#pragma unroll
            for (int e = 0; e < 4; ++e) { const f32x4 w4 = wcr[j][e]; const float xe = v[j][e]; cl[0] += xe * w4.x; cl[1] += xe * w4.y; cl[2] += xe * w4.z; cl[3] += xe * w4.w; } }
        red4(cl, F.lane);
        int grp = 0; float cm = cl[0];
#pragma unroll
        for (int e = 1; e < 4; ++e) if (cl[e] > cm) { cm = cl[e]; grp = e; }
        float den = 0.f;
#pragma unroll
        for (int e = 0; e < 4; ++e) den += __expf(cl[e] - cm);
        const float pg = 1.0f / den;
        grp = __builtin_amdgcn_readfirstlane(grp);
        const LAS f32x4* wl = (const LAS f32x4*)(F.lds) + grp * 2048 + F.lane;
        float fl[8] = {0.f, 0.f, 0.f, 0.f, 0.f, 0.f, 0.f, 0.f};
#pragma unroll
        for (int j = 0; j < 4; ++j)
#pragma unroll
            for (int e = 0; e < 4; ++e) { const f32x4 wa = wl[((j * 4 + e) * 2) * 64], wb = wl[((j * 4 + e) * 2 + 1) * 64]; const float xe = v[j][e];
                fl[0] += xe * wa.x; fl[1] += xe * wa.y; fl[2] += xe * wa.z; fl[3] += xe * wa.w; fl[4] += xe * wb.x; fl[5] += xe * wb.y; fl[6] += xe * wb.z; fl[7] += xe * wb.w; }
        red8(fl, F.lane);
        int i0 = 0; float v0 = fl[0];
#pragma unroll
        for (int e = 1; e < 8; ++e) if (fl[e] > v0) { v0 = fl[e]; i0 = e; }
        int i1 = -1; float v1 = -3.0e38f;
#pragma unroll
        for (int e = 0; e < 8; ++e) if (e != i0 && fl[e] > v1) { v1 = fl[e]; i1 = e; }
        const float e1 = __expf(v1 - v0), w0 = pg / (1.0f + e1), w1 = pg * e1 / (1.0f + e1);
        if (F.lane < 2) { const int e = grp * 8 + (F.lane == 0 ? i0 : i1); const int a_id = 2 * m + F.lane;
            const unsigned pos = __hip_atomic_fetch_add(F.ctl + CW_CNT + layer * 64 + e, 1u, RLX_AGENT);
            list[(size_t)e * LIST_CAP + pos] = a_id; tw[a_id] = (F.lane == 0) ? w0 : w1; }
          } }
    }
    __syncthreads();
}
__device__ __forceinline__ void ln2_pass(Frame& F, const Args& a, int layer, int r_first, int r_stride, int r_end) {
    bf16_t* XB = (bf16_t*)(F.ws + WS_XB); const bf16_t* YB = (const bf16_t*)(F.ws + WS_YB);
    const float* g = a.ln2_g + layer * DM; const float* bb = a.ln2_b + layer * DM; const float* g1 = a.ln1_g + layer * DM; const float* b1 = a.ln1_b + layer * DM;
    f32x4 xn[2][4]; u32x2 pn[2][4], qn[2][4];
#define LN2_LOAD(rr, mm) do { const bf16_t* y0_ = YB + (size_t)(2 * (mm)) * DM; _Pragma("unroll") for (int j = 0; j < 4; ++j) { xn[rr][j] = *((const f32x4*)(a.out + (size_t)(mm) * DM) + F.lane + 64 * j); \
        pn[rr][j] = *((const u32x2*)y0_ + F.lane + 64 * j); qn[rr][j] = *((const u32x2*)(y0_ + DM) + F.lane + 64 * j); } } while (0)
#pragma unroll
    for (int rr = 0; rr < 2; ++rr) { const int mm = r_first + rr * r_stride; if (mm < r_end) LN2_LOAD(rr, mm); }
    for (int m0 = r_first; m0 < r_end; m0 += 2 * r_stride) {
        f32x4 xc[2][4]; u32x2 pc[2][4], qc[2][4];
#pragma unroll
        for (int rr = 0; rr < 2; ++rr)
#pragma unroll
            for (int j = 0; j < 4; ++j) { xc[rr][j] = xn[rr][j]; pc[rr][j] = pn[rr][j]; qc[rr][j] = qn[rr][j]; }
#pragma unroll
        for (int rr = 0; rr < 2; ++rr) { const int mm = m0 + (2 + rr) * r_stride; if (mm < r_end) LN2_LOAD(rr, mm); }
#pragma unroll
        for (int rr = 0; rr < 2; ++rr) { const int m = m0 + rr * r_stride; if (m < r_end) {
            float* xr = a.out + (size_t)m * DM;
            f32x4 v[4]; float s = 0.f;
            { float s1 = 0.f;
#pragma unroll
              for (int j = 0; j < 4; ++j) { v[j] = xc[rr][j]; s1 += (v[j].x + v[j].y) + (v[j].z + v[j].w); }
              const float mean1 = wave_sum(s1) * (1.f / DM); float q1 = 0.f;
#pragma unroll
              for (int j = 0; j < 4; ++j) { v[j] = v[j] - mean1; q1 += (v[j].x * v[j].x + v[j].y * v[j].y) + (v[j].z * v[j].z + v[j].w * v[j].w); }
              const float rs1 = 1.f / sqrtf(wave_sum(q1) * (1.f / DM) + LN_EPS);
#pragma unroll
              for (int j = 0; j < 4; ++j) { const int c = 4 * F.lane + 256 * j; xc[rr][j] = v[j] * rs1 * *(const f32x4*)(g1 + c) + *(const f32x4*)(b1 + c); } }
#pragma unroll
            for (int j = 0; j < 4; ++j) { v[j] = xc[rr][j] * DN_ALPHA; const u32x2 p = pc[rr][j], q = qc[rr][j];
                v[j].x += bf2f(p.x & 0xffff) + bf2f(q.x & 0xffff); v[j].y += bf2f(p.x >> 16) + bf2f(q.x >> 16); v[j].z += bf2f(p.y & 0xffff) + bf2f(q.y & 0xffff); v[j].w += bf2f(p.y >> 16) + bf2f(q.y >> 16);
                s += (v[j].x + v[j].y) + (v[j].z + v[j].w); }
            const float mean = wave_sum(s) * (1.f / DM); float s2 = 0.f;
#pragma unroll
            for (int j = 0; j < 4; ++j) { v[j] = v[j] - mean; s2 += (v[j].x * v[j].x + v[j].y * v[j].y) + (v[j].z * v[j].z + v[j].w * v[j].w); }
            const float rs = 1.f / sqrtf(wave_sum(s2) * (1.f / DM) + LN_EPS);
#pragma unroll
            for (int j = 0; j < 4; ++j) { const int c = 4 * F.lane + 256 * j; const f32x4 gg = *(const f32x4*)(g + c), bv = *(const f32x4*)(bb + c); v[j] = v[j] * rs * gg + bv;
                *((f32x4*)xr + F.lane + 64 * j) = v[j];
                if (layer + 1 < DEPTH) { u32x2 w; w.x = pk2(v[j].x, v[j].y); w.y = pk2(v[j].z, v[j].w); *((u32x2*)(XB + (size_t)m * DM) + F.lane + 64 * j) = w; } }
        } }
    }
#undef LN2_LOAD
}
__device__ __forceinline__ void moe_convert(Frame& F, const Args& a, int layer) {
    LAS float* scr = (LAS float*)(F.lds + F.wave * 16384);
    constexpr int I_13 = (1024 / 64) * (1024 / 32), I_2 = (512 / 64) * (1024 / 32), PER_E = I_13 + I_2;
    for (int it = F.gw; it < NEXP * PER_E; it += F.NGW) {
        const int e = it / PER_E; int r = it - e * PER_E; const size_t le = (size_t)layer * NEXP + e;
        if (r < I_13) { const int kb = r / 32, nb = r % 32; const float* src = ((nb >> 2) & 1) ? a.moe_w3 : a.moe_w1;
            const int sc0 = ((32 * nb) >> 8) * 128 + ((32 * nb) & 127);
            transpose_item_v4(src + le * 1024 * 512 + (size_t)(kb * 64) * 512 + sc0, 512, (bf16_t*)(F.ws + WS_W13) + (size_t)e * 1024 * 1024 + (size_t)(nb * 32) * 1024 + kb * 64, 1024, scr, F.lane); }
        else { r -= I_13; const int kb = r / 32, nb = r % 32;
            transpose_item_v4(a.moe_w2 + le * 512 * 1024 + (size_t)(kb * 64) * 1024 + nb * 32, 1024, (bf16_t*)(F.ws + WS_W2) + (size_t)e * 1024 * 512 + (size_t)(nb * 32) * 512 + kb * 64, 512, scr, F.lane); }
    }
}

typedef short at_s16x4 __attribute__((ext_vector_type(4)));
typedef LAS const unsigned char* at_lds_cptr;
__device__ __forceinline__ at_s16x4 at_vtr(at_lds_cptr p) { return __builtin_bit_cast(at_s16x4, __builtin_amdgcn_ds_read_tr16_b64_v4i16((LAS at_s16x4*)p)); }
struct RowSrc { const bf16_t* p; long pitch; };
constexpr int SA_P = 0, SA_V = 4096, SA_AL = 12288, SA_RL = 12544;
template <int NC0, int NC1, int MODE>
__device__ __forceinline__ void sattn_core(const bf16x8* qf, RowSrc k0, RowSrc k1, RowSrc vs, int kb_lo, int kb_hi, int qidx0, float lse_ref, LAS unsigned char* scr, int lane, f32x16* o, float& lse_out) {
    const int r32 = lane & 31, hi = lane >> 5;
    LAS bf16_t* Pb = (LAS bf16_t*)(scr + SA_P); LAS bf16_t* Vb = (LAS bf16_t*)(scr + SA_V); LAS float* Al = (LAS float*)(scr + SA_AL);
    float m = -1.0e30f, l = 0.f;
    if (MODE != 1) { o[0] = f32x16{}; o[1] = f32x16{}; }
    bf16x8 kn[NC0 + NC1]; u32x4 vn[4];
#define SA_LOAD(kb_) do { const long key_ = (long)(kb_) * 32 + r32; \
        _Pragma("unroll") for (int c = 0; c < NC0; ++c) kn[c] = *(const bf16x8*)(k0.p + key_ * k0.pitch + 16 * c + 8 * hi); \
        _Pragma("unroll") for (int c = 0; c < NC1; ++c) kn[NC0 + c] = *(const bf16x8*)(k1.p + key_ * k1.pitch + 16 * c + 8 * hi); \
        if (MODE != 1) { _Pragma("unroll") for (int i = 0; i < 4; ++i) { const int idx = i * 64 + lane, kr = idx >> 3, pc = idx & 7; vn[i] = *(const u32x4*)(vs.p + ((long)(kb_) * 32 + kr) * vs.pitch + pc * 8); } } } while (0)
    if (kb_lo < kb_hi) SA_LOAD(kb_lo);
    const at_lds_cptr vtb = (at_lds_cptr)(scr + SA_V) + ((8 * hi + ((lane & 15) >> 2)) * 72 + 16 * ((lane >> 4) & 1) + 4 * (lane & 3)) * 2;
    for (int kb = kb_lo; kb < kb_hi; ++kb) {
        bf16x8 kc[NC0 + NC1]; u32x4 vc[4];
#pragma unroll
        for (int c = 0; c < NC0 + NC1; ++c) kc[c] = kn[c];
#pragma unroll
        for (int i = 0; i < 4; ++i) vc[i] = vn[i];
        if (kb + 1 < kb_hi) SA_LOAD(kb + 1);
        f32x16 s = {};
#pragma unroll
        for (int c = 0; c < NC0 + NC1; ++c) s = MFMA32(kc[c], qf[c], s);
        bool valid[16];
#pragma unroll
        for (int r = 0; r < 16; ++r) { if (MODE == 0) valid[r] = true; else { const int d = kb * 32 + crow(r, hi) - (qidx0 + r32); valid[r] = (d <= 64 && d >= -64); } }
        float p[16];
        if (MODE == 2) {
#pragma unroll
            for (int r = 0; r < 16; ++r) p[r] = valid[r] ? fast_exp2(s[r] - lse_ref) : 0.f;
        } else {
            float mx = -1.0e30f;
#pragma unroll
            for (int r = 0; r < 16; ++r) if (valid[r]) mx = fmaxf(mx, s[r]);
            mx = xmax32(mx);
            const float mn = fmaxf(m, mx), alpha = fast_exp2(m - mn); m = mn;
            float ps = 0.f;
#pragma unroll
            for (int r = 0; r < 16; ++r) { p[r] = valid[r] ? fast_exp2(s[r] - mn) : 0.f; ps += p[r]; }
            l = l * alpha + ps;
            if (MODE == 0) { if (hi == 0) Al[r32] = alpha; }
        }
        if (MODE != 1) {
#pragma unroll
            for (int g = 0; g < 4; ++g) { u32x2 w; w.x = pk2(p[4 * g], p[4 * g + 1]); w.y = pk2(p[4 * g + 2], p[4 * g + 3]); *(LAS u32x2*)(Pb + r32 * 40 + 8 * g + 4 * hi) = w; }
#pragma unroll
            for (int i = 0; i < 4; ++i) { const int idx = i * 64 + lane, kr = idx >> 3, pc = idx & 7; *(LAS u32x4*)(Vb + kr * 72 + pc * 8) = vc[i]; }
            LDS_WAIT();
            if (MODE == 0) {
#pragma unroll
                for (int r = 0; r < 16; ++r) { const float al = Al[crow(r, hi)]; o[0][r] *= al; o[1][r] *= al; }
            }
#pragma unroll
            for (int st = 0; st < 2; ++st) {
                const bf16x8 pf = *(const LAS bf16x8*)(Pb + r32 * 40 + 16 * st + 8 * hi);
#pragma unroll
                for (int db = 0; db < 2; ++db) {
                    const at_s16x4 lo_ = at_vtr(vtb + (16 * st * 72 + 32 * db) * 2), hi_ = at_vtr(vtb + ((16 * st + 4) * 72 + 32 * db) * 2);
                    const bf16x8 vf = {lo_[0], lo_[1], lo_[2], lo_[3], hi_[0], hi_[1], hi_[2], hi_[3]};
                    o[db] = MFMA32(pf, vf, o[db]); }
            }
            LDS_WAIT();
        }
    }
#undef SA_LOAD
    if (MODE != 2) { l = xsum32(l); lse_out = m + __log2f(l); }
    if (MODE == 0) {
        LAS float* Rl = (LAS float*)(scr + SA_RL);
        if (hi == 0) Rl[r32] = 1.0f / l;
        LDS_WAIT();
#pragma unroll
        for (int r = 0; r < 16; ++r) { const float rl = Rl[crow(r, hi)]; o[0][r] *= rl; o[1][r] *= rl; }
        LDS_WAIT();
    }
}

__device__ __forceinline__ void sattn_phase(Frame& F, const Args& a, int layer, int kind_lo) {
    const bf16_t* H = (const bf16_t*)(F.ws + WS_H); const bf16_t* QB = (const bf16_t*)(F.ws + WS_QB); const bf16_t* KVB = (const bf16_t*)(F.ws + WS_KVB);
    bf16_t* MIX = (bf16_t*)(F.ws + WS_MIX); const float* lsec = (const float*)(F.ws + WS_LSEC);
    LAS unsigned char* scr = F.lds + F.wave * 16384;
    const int lane = F.lane, r32 = lane & 31, hi = lane >> 5;
    float lam, lam_init;
    { const float* lv = a.diff_lambda + layer * 128; float d1 = 0.f, d2 = 0.f;
      for (int i = 0; i < 32; ++i) { d1 += lv[i] * lv[32 + i]; d2 += lv[64 + i] * lv[96 + i]; }
      lam_init = 0.8f - 0.6f * expf(-0.3f * (float)layer); lam = expf(d1) - expf(d2) + lam_init; }
    constexpr int NRB = NTOK / 32;
    const int items = NRB * (4 + 6 + 6);
    for (int it = kind_lo * NRB + F.gw; it < items; it += F.NGW) {
        const int kind = it / NRB, rb = it - kind * NRB; const int m0 = rb * 32; const SeqInfo si = seqinfo(m0);
#if !OPT_ATTN
        if (kind < 4) {
            const int h = kind; f32x16 o0[2], o1[2]; float dummy;
            for (int c = 0; c < 2; ++c) {
                bf16x8 qf[2];
#pragma unroll
                for (int d0 = 0; d0 < 2; ++d0) qf[d0] = *(const bf16x8*)(H + (size_t)(m0 + r32) * HP + HC_AQ + h * 64 + c * 32 + 16 * d0 + 8 * hi);
                const RowSrc ks{H + (size_t)si.base * HP + HC_AK + h * 64 + c * 32, HP}, vs{H + (size_t)si.base * HP + HC_AV + h * 64, HP};
                sattn_core<2, 0, 0>(qf, ks, ks, vs, 0, si.len / 32, 0, 0.f, scr, lane, c == 0 ? o0 : o1, dummy);
            }
            const float* sg = a.diff_subln + layer * 64; const float g0 = sg[r32], g1 = sg[32 + r32];
#pragma unroll
            for (int r = 0; r < 16; ++r) { const float x0 = o0[0][r] - lam * o1[0][r], x1 = o0[1][r] - lam * o1[1][r]; float ss = x0 * x0 + x1 * x1;
                ss += shx<1>(ss); ss += shx<2>(ss); ss += shx<4>(ss); ss += shx<8>(ss); ss += shx<16>(ss);
                const float rs = (1.0f - lam_init) / sqrtf(ss * (1.0f / 64.0f) + RMS_EPS);
                bf16_t* op = MIX + (size_t)(m0 + crow(r, hi)) * DM + MIX_A + h * 64 + r32;
                op[0] = (bf16_t)f2bf(x0 * rs * g0); op[32] = (bf16_t)f2bf(x1 * rs * g1); }
        } else if (kind < 10) {
            const int h = kind - 4; f32x16 o[2]; float dummy; bf16x8 qf[6];
#pragma unroll
            for (int d0 = 0; d0 < 6; ++d0) qf[d0] = *(const bf16x8*)(QB + (size_t)(m0 + r32) * QBP + h * 96 + 16 * d0 + 8 * hi);
            const RowSrc k0{KVB + (size_t)si.base * KVP + h * 128, KVP}, k1{H + (size_t)si.base * HP + HC_KROPE, HP}, vs{KVB + (size_t)si.base * KVP + h * 128 + 64, KVP};
            sattn_core<4, 2, 0>(qf, k0, k1, vs, 0, si.len / 32, 0, 0.f, scr, lane, o, dummy);
#pragma unroll
            for (int r = 0; r < 16; ++r) { bf16_t* op = MIX + (size_t)(m0 + crow(r, hi)) * DM + MIX_B + h * 64 + r32; op[0] = (bf16_t)f2bf(o[0][r]); op[32] = (bf16_t)f2bf(o[1][r]); }
        } else
#endif
        {
            const int gj = kind - 10, g = gj >> 1, hh = gj;
            const int dil = (g == 0) ? 1 : (g == 1 ? 4 : 16); const int L = si.len / dil, bpr = L / 32;
            const int w = (m0 - si.base) / 32, rho = w / bpr, ib = w - rho * bpr, i0 = ib * 32;
            const size_t qrow = (size_t)si.base + (size_t)(i0 + r32) * dil + rho;
            bf16x8 qf[4];
#pragma unroll
            for (int d0 = 0; d0 < 4; ++d0) qf[d0] = *(const bf16x8*)(H + qrow * HP + HC_CQ + hh * 64 + 16 * d0 + 8 * hi);
            const int j = gj & 1; const float l0 = lsec[(0 * (size_t)NTOK + qrow) * 2 + j], l1 = lsec[(1 * (size_t)NTOK + qrow) * 2 + j], l2 = lsec[(2 * (size_t)NTOK + qrow) * 2 + j];
            const float lm = fmaxf(l0, fmaxf(l1, l2)); const float lref = lm + __log2f(fast_exp2(l0 - lm) + fast_exp2(l1 - lm) + fast_exp2(l2 - lm));
            const RowSrc ks{H + ((size_t)si.base + rho) * HP + HC_CK + hh * 64, (long)HP * dil}, vs{H + ((size_t)si.base + rho) * HP + HC_CV + hh * 64, (long)HP * dil};
            int kb_lo = ib - 2, kb_hi = ib + 3; if (kb_lo < 0) kb_lo = 0; if (kb_hi > bpr) kb_hi = bpr;
            f32x16 o[2]; float dummy;
            sattn_core<4, 0, 2>(qf, ks, ks, vs, kb_lo, kb_hi, i0, lref, scr, lane, o, dummy);
#pragma unroll
            for (int r = 0; r < 16; ++r) { const size_t orow = (size_t)si.base + (size_t)(i0 + crow(r, hi)) * dil + rho; bf16_t* op = MIX + orow * DM + MIX_C + hh * 64 + r32; op[0] = (bf16_t)f2bf(o[0][r]); op[32] = (bf16_t)f2bf(o[1][r]); }
        }
    }
}
__device__ __forceinline__ void cstat_phase(Frame& F) {
    const bf16_t* H = (const bf16_t*)(F.ws + WS_H); float* lsec = (float*)(F.ws + WS_LSEC);
    LAS unsigned char* scr = F.lds + F.wave * 16384;
    const int lane = F.lane, r32 = lane & 31, hi = lane >> 5;
    constexpr int NRB = NTOK / 32;
    for (int it = F.gw; it < NRB * 6; it += F.NGW) {
        const int gj = it / NRB, rb = it - gj * NRB, g = gj >> 1, j = gj & 1; const int m0 = rb * 32; const SeqInfo si = seqinfo(m0);
        const int dil = (g == 0) ? 1 : (g == 1 ? 4 : 16); const int L = si.len / dil, bpr = L / 32;
        const int w = (m0 - si.base) / 32, rho = w / bpr, ib = w - rho * bpr, i0 = ib * 32;
        const size_t qrow = (size_t)si.base + (size_t)(i0 + r32) * dil + rho;
        bf16x8 qf[4];
#pragma unroll
        for (int d0 = 0; d0 < 4; ++d0) qf[d0] = *(const bf16x8*)(H + qrow * HP + HC_CQ + gj * 64 + 16 * d0 + 8 * hi);
        const RowSrc ks{H + ((size_t)si.base + rho) * HP + HC_CK + gj * 64, (long)HP * dil};
        int kb_lo = ib - 2, kb_hi = ib + 3; if (kb_lo < 0) kb_lo = 0; if (kb_hi > bpr) kb_hi = bpr;
        float lse; sattn_core<4, 0, 1>(qf, ks, ks, ks, kb_lo, kb_hi, i0, 0.f, scr, lane, nullptr, lse);
        if (hi == 0) lsec[((size_t)g * NTOK + qrow) * 2 + j] = lse;
    }
}


namespace at {
typedef short s16x4 __attribute__((ext_vector_type(4)));
typedef short v4i16_t __attribute__((ext_vector_type(4)));
typedef LAS const unsigned char* lds_cptr;
constexpr int LDS_K = 0, KSLOT_MAX = 12288, LDS_V = 3 * KSLOT_MAX, VSLOT = 8192, LDS_WS = LDS_V + 3 * VSLOT, LDS_OST = LDS_WS + 8 * 256, LDS_TOTAL = LDS_OST + 8 * 8192;
static_assert(LDS_TOTAL <= RING_BYTES, "attention LDS");
constexpr float THR = 8.0f;
__device__ __forceinline__ void glds16(const void* g, unsigned lds_dst) {
    unsigned keep; asm volatile("s_mov_b32 %0, m0\n\ts_mov_b32 m0, %2\n\ts_nop 0\n\tglobal_load_lds_dwordx4 %1, off\n\ts_mov_b32 m0, %0" : "=&s"(keep) : "v"(g), "s"(lds_dst) : "memory"); }
__device__ __forceinline__ s16x4 vtr(lds_cptr p) { return __builtin_bit_cast(s16x4, __builtin_amdgcn_ds_read_tr16_b64_v4i16((LAS v4i16_t*)p)); }
__device__ __forceinline__ unsigned cvtpk(float lo, float hi) { typedef float f2 __attribute__((ext_vector_type(2))); typedef __bf16 b2 __attribute__((ext_vector_type(2))); f2 v = {lo, hi}; b2 b = __builtin_convertvector(v, b2); return __builtin_bit_cast(unsigned, b); }
#define AT_MX3(a, b, c) __builtin_fmaxf(__builtin_fmaxf((a), (b)), (c))
__device__ __forceinline__ float rowmax(const f32x16& p0, const f32x16& p1) {
    float a = AT_MX3(p0[0], p0[1], p1[0]), b = AT_MX3(p0[2], p0[3], p1[1]); a = AT_MX3(a, p1[2], p1[3]);
#pragma unroll
    for (int r = 4; r < 16; r += 4) { a = AT_MX3(a, p0[r], p0[r + 1]); b = AT_MX3(b, p0[r + 2], p0[r + 3]); a = AT_MX3(a, p1[r], p1[r + 1]); b = AT_MX3(b, p1[r + 2], p1[r + 3]); }
    float m = __builtin_fmaxf(a, b); auto rr = __builtin_amdgcn_permlane32_swap(__float_as_uint(m), __float_as_uint(m), false, false);
    return __builtin_fmaxf(__uint_as_float(rr[0]), __uint_as_float(rr[1])); }
#define AT_WAIT_BAR(N) asm volatile("s_waitcnt vmcnt(" #N ") lgkmcnt(0)\n\ts_barrier" ::: "memory")

struct Src { const bf16_t* p; long pitch; };
template <int NC, int NK0, int NK1>
__device__ __forceinline__ void stream(LAS unsigned char* lds, int tid, const bf16_t* qrow, Src k0, Src k1, Src vs, int NT, f32x16& o0, f32x16& o1, float& lsum) {
    asm volatile("" : "+v"(tid));
    constexpr int SLOTK = 2 * NC * 1024;
    const int lane = tid & 63, r32 = lane & 31, hi = lane >> 5; const int wid = __builtin_amdgcn_readfirstlane(tid >> 6);
    const unsigned lds0 = (unsigned)(uintptr_t)lds;
    LAS float* wsf = (LAS float*)(lds + LDS_WS) + wid * 64;
    constexpr int P0 = NK0 * 16;
    const bool hasA = (NK0 == 8) || (wid < 4), hasB = (NK1 > 0) && (wid < 4);
    const int pA = (NK0 == 8) ? wid : (wid & 3);
    const int rowA = (NK0 == 8) ? pA * 8 + (lane >> 3) : pA * 16 + (lane >> 2);
    const int chA = (NK0 == 8) ? ((lane & 7) ^ ((4 * pA + (lane >> 4)) & 7)) : ((lane & 3) ^ ((lane >> 4) & 3));
    const bf16_t* ksA = k0.p + (long)rowA * k0.pitch + chA * 8;
    const int rowB = (wid & 3) * 16 + (lane >> 2), chB = (lane & 3) ^ ((lane >> 4) & 3);
    const bf16_t* ksB = (NK1 > 0) ? k1.p + (long)rowB * k1.pitch + chB * 8 : k0.p;
    const bf16_t* vsp = vs.p + (long)(16 * (wid & 3) + (lane >> 2)) * vs.pitch + (wid >> 2) * 32 + (lane & 3) * 8;
    const unsigned kdA = lds0 + LDS_K + pA * 1024, kdB = lds0 + LDS_K + (NK0 + (wid & 3)) * 1024, vd = lds0 + LDS_V + wid * 1024;
    const long ktA = 64 * k0.pitch, ktB = 64 * k1.pitch, vt = 64 * vs.pitch;
    const int nd = (hasA ? 1 : 0) + (hasB ? 1 : 0) + 1;
#define AT_DMA_K(t, slot) do { if (hasA) glds16(ksA + (long)(t) * ktA, (unsigned)__builtin_amdgcn_readfirstlane(kdA + (slot) * SLOTK)); if (hasB) glds16(ksB + (long)(t) * ktB, (unsigned)__builtin_amdgcn_readfirstlane(kdB + (slot) * SLOTK)); } while (0)
#define AT_DMA_V(t, slot) glds16(vsp + (long)(t) * vt, (unsigned)__builtin_amdgcn_readfirstlane(vd + (slot) * VSLOT))
    lds_cptr kb[NC];
#pragma unroll
    for (int d0 = 0; d0 < NC; ++d0) { const int c = 2 * d0 + hi;
        if (2 * d0 < NK0) kb[d0] = (lds_cptr)lds + LDS_K + r32 * P0 + ((NK0 == 8) ? (c ^ ((r32 >> 1) & 7)) : (c ^ ((r32 >> 2) & 3))) * 16;
        else kb[d0] = (lds_cptr)lds + LDS_K + NK0 * 1024 + r32 * 64 + ((c - NK0) ^ ((r32 >> 2) & 3)) * 16; }
    const lds_cptr vp0 = (lds_cptr)lds + LDS_V + ((lane >> 4) & 1) * 32 + (lane & 3) * 8 + (4 * hi + ((lane & 15) >> 2)) * 64;
    AT_DMA_K(0, 0); AT_DMA_V(0, 0); if (NT > 1) AT_DMA_K(1, 1);
    bf16x8 qr[NC];
#pragma unroll
    for (int d0 = 0; d0 < NC; ++d0) qr[d0] = *(const bf16x8*)(qrow + 16 * d0 + 8 * hi);
    float mhat = 0.f, l = 0.f; f32x16 oa = {}, ob = {}, negm = {}, S0, S1; u32x4 pw0, pw1, pw2, pw3;
    asm volatile("" : "+v"(negm));
    AT_WAIT_BAR(0);
    __builtin_amdgcn_s_waitcnt(0);
#pragma unroll
    for (int d0 = 0; d0 < NC; ++d0) asm volatile("" : "+v"(qr[d0]));
    constexpr int QREG = NC;
    constexpr bool QLDS = (NC > 2);
    const lds_cptr qb = (lds_cptr)lds + LDS_OST + wid * 8192 + lane * 16;
    if (QLDS) {
#pragma unroll
        for (int d0 = 0; d0 < NC; ++d0) *(LAS bf16x8*)(lds + LDS_OST + wid * 8192 + lane * 16 + d0 * 1024) = qr[d0];
        LDS_WAIT();
    }
    int kc = 0, kn1 = 1, kn2 = 2, vpv = 2, vcu = 0, vnx = 1;
    bf16x8 kf[2 * NC], vf[8];
#define AT_SB() __builtin_amdgcn_sched_barrier(0)
#define AT_KRD(so_, d0) do { kf[2 * (d0)] = *(const LAS bf16x8*)(kb[d0] + (so_)); kf[2 * (d0) + 1] = *(const LAS bf16x8*)(kb[d0] + (so_) + 32 * ((2 * (d0) < NK0) ? P0 : 64)); if (QLDS && (d0) >= QREG) qr[d0] = *(const LAS bf16x8*)(qb + (d0) * 1024); } while (0)
#define AT_KHEAD(slot) do { const int kp_ = (slot) * SLOTK; AT_KRD(kp_, 0); if (NC > 1) AT_KRD(kp_, 1); } while (0)
#define AT_VF(i) ({ const s16x4 lo_ = vtr(vp_ + (((i) >> 2) * 4096 + ((i) & 3) * 1024)), hi_ = vtr(vp_ + (((i) >> 2) * 4096 + ((i) & 3) * 1024 + 512)); (bf16x8){lo_[0], lo_[1], lo_[2], lo_[3], hi_[0], hi_[1], hi_[2], hi_[3]}; })
#define AT_VHEAD(slot) do { const lds_cptr vp_ = vp0 + (slot) * VSLOT; vf[0] = AT_VF(0); vf[4] = AT_VF(4); } while (0)
#define AT_QKM(slot) do { const int kp_ = (slot) * SLOTK; \
        _Pragma("unroll") for (int d0 = 0; d0 < NC; ++d0) { if (d0 + 2 < NC) AT_KRD(kp_, d0 + 2); \
            if (d0 == 0) { S0 = MFMA32(kf[0], qr[0], negm); S1 = MFMA32(kf[1], qr[0], negm); } else { S0 = MFMA32(kf[2 * d0], qr[d0], S0); S1 = MFMA32(kf[2 * d0 + 1], qr[d0], S1); } AT_SB(); } } while (0)
#define AT_PVM(slot) do { const lds_cptr vp_ = vp0 + (slot) * VSLOT; \
        vf[1] = AT_VF(1); vf[5] = AT_VF(5); oa = MFMA32(__builtin_bit_cast(bf16x8, pw0), vf[0], oa); ob = MFMA32(__builtin_bit_cast(bf16x8, pw0), vf[4], ob); AT_SB(); \
        vf[2] = AT_VF(2); vf[6] = AT_VF(6); oa = MFMA32(__builtin_bit_cast(bf16x8, pw1), vf[1], oa); ob = MFMA32(__builtin_bit_cast(bf16x8, pw1), vf[5], ob); AT_SB(); \
        vf[3] = AT_VF(3); vf[7] = AT_VF(7); oa = MFMA32(__builtin_bit_cast(bf16x8, pw2), vf[2], oa); ob = MFMA32(__builtin_bit_cast(bf16x8, pw2), vf[6], ob); AT_SB(); \
        oa = MFMA32(__builtin_bit_cast(bf16x8, pw3), vf[3], oa); ob = MFMA32(__builtin_bit_cast(bf16x8, pw3), vf[7], ob); AT_SB(); } while (0)
    bool resc = false; u32x4 qw0, qw1, qw2, qw3; float sacc = 0.f;
#define AT_PIN(x) asm volatile("" : "+v"(x))
#define AT_DECIDE(first) do { const float rm_ = rowmax(S0, S1); resc = false; \
        if ((first) || __any(rm_ > THR)) { const float dl_ = (first) ? rm_ : __builtin_fmaxf(rm_, 0.f); mhat += dl_; \
            _Pragma("unroll") for (int r = 0; r < 16; ++r) { S0[r] -= dl_; S1[r] -= dl_; negm[r] = -mhat; } asm volatile("" : "+v"(negm)); \
            if (!(first)) { const float f_ = fast_exp2(-dl_); l *= f_; if (hi == 0) wsf[r32] = f_; resc = true; } } } while (0)
#define AT_RESC() do { if (resc) { LDS_WAIT(); \
        _Pragma("unroll") for (int r = 0; r < 16; ++r) { const float g_ = wsf[crow(r, hi)]; oa[r] *= g_; ob[r] *= g_; } LDS_WAIT(); } } while (0)
#define AT_EXP8(S, b, Q) do { \
        _Pragma("unroll") for (int r = 0; r < 8; ++r) S[(b) + r] = fast_exp2(S[(b) + r]); \
        sacc += (S[(b)] + S[(b) + 1]) + (S[(b) + 2] + S[(b) + 3]); sacc += (S[(b) + 4] + S[(b) + 5]) + (S[(b) + 6] + S[(b) + 7]); \
        Q = (u32x4){cvtpk(S[(b)], S[(b) + 1]), cvtpk(S[(b) + 2], S[(b) + 3]), cvtpk(S[(b) + 4], S[(b) + 5]), cvtpk(S[(b) + 6], S[(b) + 7])}; AT_PIN(Q); AT_PIN(sacc); } while (0)
#define AT_EXPALL() do { sacc = 0.f; AT_EXP8(S0, 0, qw0); AT_EXP8(S0, 8, qw1); AT_EXP8(S1, 0, qw2); AT_EXP8(S1, 8, qw3); l += sacc; pw0 = qw0; pw1 = qw1; pw2 = qw2; pw3 = qw3; } while (0)
#define AT_PV_EXP(slot, C0, C1, C2, C3, N0, N1, N2, N3) do { const lds_cptr vp_ = vp0 + (slot) * VSLOT; sacc = 0.f; \
        vf[1] = AT_VF(1); vf[5] = AT_VF(5); oa = MFMA32(__builtin_bit_cast(bf16x8, C0), vf[0], oa); ob = MFMA32(__builtin_bit_cast(bf16x8, C0), vf[4], ob); AT_EXP8(S0, 0, N0); AT_SB(); \
        vf[2] = AT_VF(2); vf[6] = AT_VF(6); oa = MFMA32(__builtin_bit_cast(bf16x8, C1), vf[1], oa); ob = MFMA32(__builtin_bit_cast(bf16x8, C1), vf[5], ob); AT_EXP8(S0, 8, N1); AT_SB(); \
        vf[3] = AT_VF(3); vf[7] = AT_VF(7); oa = MFMA32(__builtin_bit_cast(bf16x8, C2), vf[2], oa); ob = MFMA32(__builtin_bit_cast(bf16x8, C2), vf[6], ob); AT_EXP8(S1, 0, N2); AT_SB(); \
        oa = MFMA32(__builtin_bit_cast(bf16x8, C3), vf[3], oa); ob = MFMA32(__builtin_bit_cast(bf16x8, C3), vf[7], ob); AT_EXP8(S1, 8, N3); AT_SB(); \
        l += sacc; } while (0)
#define AT_STEP_WAIT(t) do { if ((t) + 2 < NT) { if (nd == 3) AT_WAIT_BAR(3); else if (nd == 2) AT_WAIT_BAR(2); else AT_WAIT_BAR(1); } else AT_WAIT_BAR(0); } while (0)
#define AT_ROT() do { const int a_ = kc; kc = kn1; kn1 = kn2; kn2 = a_; const int b_ = vpv; vpv = vcu; vcu = vnx; vnx = b_; } while (0)
    AT_DMA_K(2, kn2); AT_DMA_V(1, vnx);
    AT_KHEAD(kc); AT_SB();
    AT_QKM(kc); AT_DECIDE(true); AT_EXPALL();
    AT_STEP_WAIT(0); AT_ROT();
#define AT_STEP(t, C0, C1, C2, C3, N0, N1, N2, N3) do { \
        if ((t) + 2 < NT) AT_DMA_K((t) + 2, kn2); \
        if ((t) + 1 < NT) AT_DMA_V((t) + 1, vnx); \
        AT_KHEAD(kc); AT_VHEAD(vpv); AT_SB(); \
        AT_QKM(kc); \
        AT_DECIDE(false); AT_SB(); \
        AT_PV_EXP(vpv, C0, C1, C2, C3, N0, N1, N2, N3); \
        AT_RESC(); \
        AT_STEP_WAIT(t); AT_ROT(); } while (0)
    int t = 1;
    for (; t + 1 < NT; t += 2) { AT_STEP(t, pw0, pw1, pw2, pw3, qw0, qw1, qw2, qw3); AT_STEP(t + 1, qw0, qw1, qw2, qw3, pw0, pw1, pw2, pw3); }
    if (t < NT) { AT_STEP(t, pw0, pw1, pw2, pw3, qw0, qw1, qw2, qw3); pw0 = qw0; pw1 = qw1; pw2 = qw2; pw3 = qw3; }
#undef AT_STEP
    AT_VHEAD(vpv); AT_SB(); AT_PVM(vpv);
    { auto rr = __builtin_amdgcn_permlane32_swap(__float_as_uint(l), __float_as_uint(l), false, false); l = __uint_as_float(rr[0]) + __uint_as_float(rr[1]); }
    o0 = oa; o1 = ob; lsum = l;
#undef AT_DMA_K
#undef AT_DMA_V
#undef AT_SB
#undef AT_KRD
#undef AT_KHEAD
#undef AT_VF
#undef AT_VHEAD
#undef AT_QKM
#undef AT_PVM
#undef AT_PIN
#undef AT_DECIDE
#undef AT_RESC
#undef AT_EXP8
#undef AT_EXPALL
#undef AT_PV_EXP
#undef AT_STEP_WAIT
#undef AT_ROT
}
__device__ __forceinline__ void normalise(LAS unsigned char* lds, int tid, f32x16& o0, f32x16& o1, float lsum) {
    const int lane = tid & 63, r32 = lane & 31, hi = lane >> 5; const int wid = __builtin_amdgcn_readfirstlane(tid >> 6);
    LAS float* wsf = (LAS float*)(lds + LDS_WS) + wid * 64;
    if (hi == 0) wsf[32 + r32] = 1.0f / lsum; LDS_WAIT();
#pragma unroll
    for (int r = 0; r < 16; ++r) { const float g = wsf[32 + crow(r, hi)]; o0[r] *= g; o1[r] *= g; }
    LDS_WAIT();
}
}

struct AttnUnitId { int kind, seq, head, qb; };
__device__ __forceinline__ bool attn_unit_at(int i, int G, int bid, AttnUnitId& u) {
    const long L = (long)i * G + bid; if (L >= 2560) return false; int o = (int)L;
    int kind, longs, nh;
    if (o < 512) { kind = 0; longs = 1; nh = 4; } else if (o < 1024) { kind = 0; longs = 0; nh = 4; o -= 512; } else if (o < 1792) { kind = 1; longs = 1; nh = 6; o -= 1024; } else { kind = 1; longs = 0; nh = 6; o -= 1792; }
    const int nqb = longs ? 16 : 8;
    int pair, qb;
    if (G == 256) { const int rnd = o >> 8, b = o & 255, x = b & 7, c = b >> 3;
        const int ppr = 32 / nqb; pair = x + 8 * (rnd * ppr + c / nqb); qb = c % nqb; }
    else { pair = o / nqb; qb = o % nqb; }
    u.kind = kind; u.head = pair % nh; const int sq = pair / nh; u.seq = longs ? 16 + sq : sq; u.qb = qb; return true;
}
__device__ __forceinline__ void attn_ab_phase(Frame& F, const Args& a, int layer, int kmask = 3) {
    const bf16_t* H = (const bf16_t*)(F.ws + WS_H); const bf16_t* QB = (const bf16_t*)(F.ws + WS_QB); const bf16_t* KVB = (const bf16_t*)(F.ws + WS_KVB);
    bf16_t* MIX = (bf16_t*)(F.ws + WS_MIX);
    const int wid = F.wave;
    float lam, lam_init;
    { const float* lv = a.diff_lambda + layer * 128; float d1 = 0.f, d2 = 0.f;
      for (int i = 0; i < 32; ++i) { d1 += lv[i] * lv[32 + i]; d2 += lv[64 + i] * lv[96 + i]; }
      lam_init = 0.8f - 0.6f * expf(-0.3f * (float)layer); lam = expf(d1) - expf(d2) + lam_init;
      lam = __uint_as_float(__builtin_amdgcn_readfirstlane(__float_as_uint(lam))); lam_init = __uint_as_float(__builtin_amdgcn_readfirstlane(__float_as_uint(lam_init))); }
    AttnUnitId u;
    for (int i = 0; attn_unit_at(i, F.G, F.bid, u); ++i) {
        if (!((kmask >> u.kind) & 1)) continue;
        int tid = F.tid; asm volatile("" : "+v"(tid)); const int lane = tid & 63, r32 = lane & 31, hi = lane >> 5;
        const int len = (u.seq < 16) ? 2048 : 4096, base = (u.seq < 16) ? u.seq * 2048 : NTOK_P + (u.seq - 16) * 4096, NT = len / 64;
        const int m0 = base + u.qb * 256 + wid * 32;
        LAS bf16_t* sb = (LAS bf16_t*)(F.lds + at::LDS_OST + wid * 8192);
        LAS float* sf = (LAS float*)sb;
        if (u.kind == 0) {
            f32x16 q0, q1; float ls;
            { f32x16 p0, p1; const at::Src ks{H + (size_t)base * HP + HC_AK + u.head * 64, HP}, vs{H + (size_t)base * HP + HC_AV + u.head * 64, HP};
              at::stream<2, 4, 0>(F.lds, tid, H + (size_t)(m0 + r32) * HP + HC_AQ + u.head * 64, ks, ks, vs, NT, p0, p1, ls); at::normalise(F.lds, tid, p0, p1, ls);
#pragma unroll
              for (int r = 0; r < 16; ++r) { const int row = crow(r, hi); sf[row * 64 + r32] = p0[r]; sf[row * 64 + 32 + r32] = p1[r]; }
              AT_WAIT_BAR(0); }
            { const at::Src ks{H + (size_t)base * HP + HC_AK + u.head * 64 + 32, HP}, vs{H + (size_t)base * HP + HC_AV + u.head * 64, HP};
              at::stream<2, 4, 0>(F.lds, tid, H + (size_t)(m0 + r32) * HP + HC_AQ + u.head * 64 + 32, ks, ks, vs, NT, q0, q1, ls); at::normalise(F.lds, tid, q0, q1, ls); }
            float xa[16], xb[16];
#pragma unroll
            for (int r = 0; r < 16; ++r) { const int row = crow(r, hi); xa[r] = sf[row * 64 + r32] - lam * q0[r]; xb[r] = sf[row * 64 + 32 + r32] - lam * q1[r]; }
            LDS_WAIT();
            const float* sg = a.diff_subln + layer * 64; const float g0 = sg[r32] * (1.0f - lam_init), g1 = sg[32 + r32] * (1.0f - lam_init);
#pragma unroll
            for (int r = 0; r < 16; ++r) { const float x0 = xa[r], x1 = xb[r]; float ss = x0 * x0 + x1 * x1;
                ss += shx<1>(ss); ss += shx<2>(ss); ss += shx<4>(ss); ss += shx<8>(ss); ss += shx<16>(ss);
                const float rs = 1.0f / sqrtf(ss * (1.0f / 64.0f) + RMS_EPS); const int row = crow(r, hi);
                sb[row * 64 + r32] = (bf16_t)f2bf(x0 * rs * g0); sb[row * 64 + 32 + r32] = (bf16_t)f2bf(x1 * rs * g1); }
            LDS_WAIT();
#pragma unroll
            for (int it = 0; it < 4; ++it) { const int row = it * 8 + (lane >> 3), ch = lane & 7; *(u32x4*)(MIX + (size_t)(m0 + row) * DM + MIX_A + u.head * 64 + ch * 8) = *(const LAS u32x4*)(sb + row * 64 + ch * 8); }
        } else {
            f32x16 p0, p1; float ls;
            const at::Src k0{KVB + (size_t)base * KVP + u.head * 128, KVP}, k1{H + (size_t)base * HP + HC_KROPE, HP}, vs{KVB + (size_t)base * KVP + u.head * 128 + 64, KVP};
            at::stream<6, 8, 4>(F.lds, tid, QB + (size_t)(m0 + r32) * QBP + u.head * 96, k0, k1, vs, NT, p0, p1, ls); at::normalise(F.lds, tid, p0, p1, ls);
#pragma unroll
            for (int r = 0; r < 16; ++r) { const int row = crow(r, hi); sb[row * 64 + r32] = (bf16_t)f2bf(p0[r]); sb[row * 64 + 32 + r32] = (bf16_t)f2bf(p1[r]); }
            LDS_WAIT();
#pragma unroll
            for (int it = 0; it < 4; ++it) { const int row = it * 8 + (lane >> 3), ch = lane & 7; *(u32x4*)(MIX + (size_t)(m0 + row) * DM + MIX_B + u.head * 64 + ch * 8) = *(const LAS u32x4*)(sb + row * 64 + ch * 8); }
        }
        AT_WAIT_BAR(0);
    }
}

struct ListRows { const int* list; int seg0, cnt; __device__ __forceinline__ int src(int m) const { const int r = m - seg0; return (r < cnt) ? (list[r] >> 1) : 0; } };
__device__ __forceinline__ void moe_segments(Frame& F, int layer, LAS int* seg) {
    if (F.tid == 0) { int acc = 0; for (int e = 0; e < NEXP; ++e) { const int c = (int)__hip_atomic_load(F.ctl + CW_CNT + layer * 64 + e, RLX_AGENT); seg[e] = acc; seg[33 + e] = c; acc += (c + 255) & ~255; } seg[32] = acc; }
    __syncthreads();
}
__device__ __forceinline__ int seg_find(const LAS int* seg, int row) { int e = 0;
#pragma unroll
    for (int s = 16; s > 0; s >>= 1) if (seg[e + s] <= row) e += s;
    return e; }
__device__ __forceinline__ void moe_up_simple(Frame& F, int layer) {
    LAS int* seg = (LAS int*)(F.lds + RING_BYTES); moe_segments(F, layer, seg);
    const bf16_t* XB = (const bf16_t*)(F.ws + WS_XB); const bf16_t* W13 = (const bf16_t*)(F.ws + WS_W13); const int* list = (const int*)(F.ws + WS_LIST);
    const EpiHid E{(bf16_t*)(F.ws + WS_HID)};
    const int items = (seg[32] / 32) * 16;
    for (int it = F.gw; it < items; it += F.NGW) { const int mt = it >> 4, ct = it & 15, m0 = mt * 32, e = seg_find(seg, m0), c0 = ct * 32;
        const ListRows RM{list + (size_t)e * LIST_CAP, seg[e], seg[33 + e]};
        const bf16_t* Bg = W13 + (size_t)e * 1024 * 1024 + (size_t)((c0 >> 7) * 256 + (c0 & 127)) * 1024;
        sg_tile(XB, DM, Bg, Bg + (size_t)128 * 1024, 1024, 1024, m0, c0, E, RM, F.lane); }
    __syncthreads();
}
__device__ __forceinline__ void moe_down_simple(Frame& F, int layer) {
    LAS int* seg = (LAS int*)(F.lds + RING_BYTES); moe_segments(F, layer, seg);
    const bf16_t* HID = (const bf16_t*)(F.ws + WS_HID); const bf16_t* W2 = (const bf16_t*)(F.ws + WS_W2); const int* list = (const int*)(F.ws + WS_LIST);
    const int items = (seg[32] / 32) * 16;
    for (int it = F.gw; it < items; it += F.NGW) { const int mt = it >> 4, ct = it & 15, m0 = mt * 32, e = seg_find(seg, m0), c0 = ct * 64;
        const EpiY E{(bf16_t*)(F.ws + WS_YB), (const float*)(F.ws + WS_TW), list + (size_t)e * LIST_CAP, seg[e], seg[33 + e]};
        const bf16_t* B0 = W2 + (size_t)e * 1024 * 512 + (size_t)c0 * 512;
        sg_tile(HID, DEXP, B0, B0 + (size_t)32 * 512, 512, 512, m0, c0, E, IdRows(), F.lane); }
    __syncthreads();
}


struct MoeUpSched {
    const char* XB; const char* W13; const LAS int* seg; const int* list; int nM, G, c;
    __device__ __forceinline__ bool next(int i, pg8::Unit& u) const { if (!pg8::order_next(i, G, c, nM, 4, u.pm, u.pn)) return false; u.e = __builtin_amdgcn_readfirstlane(seg_find(seg, u.pm * 256)); u.a = XB; u.b = W13 + ((size_t)u.e * 1024 + (size_t)u.pn * 256) * 2048; return true; }
    __device__ __forceinline__ unsigned arow(const pg8::Unit& u, int r) const { const int rr = u.pm * 256 + r - __builtin_amdgcn_readfirstlane(seg[u.e]); return (rr < __builtin_amdgcn_readfirstlane(seg[33 + u.e])) ? (unsigned)(list[(size_t)u.e * LIST_CAP + rr] >> 1) : 0u; }
};
struct MoeDownSched {
    const char* HID; const char* W2; const LAS int* seg; int nM, G, c;
    __device__ __forceinline__ bool next(int i, pg8::Unit& u) const { if (!pg8::order_next(i, G, c, nM, 4, u.pm, u.pn)) return false; u.e = __builtin_amdgcn_readfirstlane(seg_find(seg, u.pm * 256)); u.a = HID + (size_t)u.pm * 256 * DEXP * 2; u.b = W2 + ((size_t)u.e * 1024 + (size_t)u.pn * 256) * 1024; return true; }
    __device__ __forceinline__ unsigned arow(const pg8::Unit&, int) const { return 0u; }
};
__device__ __forceinline__ void moe_up_opt(Frame& F, int layer) {
    LAS int* seg = (LAS int*)(F.lds + RING_BYTES); moe_segments(F, layer, seg);
    const MoeUpSched S{(const char*)(F.ws + WS_XB), (const char*)(F.ws + WS_W13), seg, (const int*)(F.ws + WS_LIST), __builtin_amdgcn_readfirstlane(seg[32]) / 256, F.G, F.bid};
    const EpiHid E{(bf16_t*)(F.ws + WS_HID)};
    pg8::gemm_phase<EpiHid, MoeUpSched, true, true>(F.lds, F.tid, 1024, DM, S, E);
    __syncthreads();
}
__device__ __forceinline__ void moe_down_opt(Frame& F, int layer) {
    LAS int* seg = (LAS int*)(F.lds + RING_BYTES); moe_segments(F, layer, seg);
    const MoeDownSched S{(const char*)(F.ws + WS_HID), (const char*)(F.ws + WS_W2), seg, __builtin_amdgcn_readfirstlane(seg[32]) / 256, F.G, F.bid};
    const EpiYO E{(bf16_t*)(F.ws + WS_YB), (const float*)(F.ws + WS_TW), (const int*)(F.ws + WS_LIST), seg};
    pg8::gemm_phase<EpiYO, MoeDownSched, false, false>(F.lds, F.tid, DEXP, DEXP, S, E);
    __syncthreads();
}
template <class Epi>
__device__ __forceinline__ void pg_phase(Frame& F, const bf16_t* A, int lda, const bf16_t* Bt, int panel, int N, int K, const Epi& E) {
    pg8::PanelSched S; S.init(A, lda, Bt, panel, N, K);
    pg8::gemm_phase<Epi, pg8::PanelSched, false, false>(F.lds, F.tid, K, lda, S, E);
}
__device__ __forceinline__ void local_sync(Frame& F) {
    asm volatile("s_waitcnt vmcnt(0) lgkmcnt(0)" ::: "memory");
    __syncthreads();
    if (F.tid == 0) { __builtin_amdgcn_fence(__ATOMIC_ACQUIRE, "agent"); asm volatile("s_waitcnt vmcnt(0)" ::: "memory"); }
    __syncthreads();
}
template <class Epi>
__device__ __forceinline__ void og_phase(Frame& F, const bf16_t* A, int lda, const bf16_t* Bt, int M, int N, int K, const Epi& E) {
    pg8::DenseSched S; S.init(A, lda, Bt, M, N, K, F.G, F.bid);
    pg8::gemm_phase<Epi, pg8::DenseSched, false, false>(F.lds, F.tid, K, lda, S, E);
}

#ifndef PANEL_PROG
#define PANEL_PROG 1
#endif
#if PANEL_PROG
constexpr int PH_PER_LAYER = 6, N_PHASES = 2 + DEPTH * PH_PER_LAYER;
#else
constexpr int PH_PER_LAYER = 9, N_PHASES = 1 + DEPTH * PH_PER_LAYER;
#endif
__global__ void __launch_bounds__(NTHREADS, 2) fwd(Args args) {
    extern __shared__ __attribute__((aligned(16))) unsigned char lds[];
    Frame F;
    F.lds = (LAS unsigned char*)lds; F.ldsg = lds;
    F.tid = threadIdx.x; F.lane = F.tid & 63; F.wave = __builtin_amdgcn_readfirstlane(F.tid >> 6);
    F.G = gridDim.x; F.bid = blockIdx.x; F.gw = blockIdx.x * NWAVES + F.wave; F.NGW = F.G * NWAVES;
    F.ws = args.ws; F.ctl = (gu32*)(args.ws + WS_CTL);
    volatile LAS unsigned* MISC = (volatile LAS unsigned*)(F.lds + MISC_OFF);
    for (int u = F.tid; u < (LDS_BYTES - RING_BYTES) / 4; u += NTHREADS) ((LAS unsigned*)(F.lds + RING_BYTES))[u] = 0u;
    __syncthreads();
    XcdBarrier bar; bar.bar = (unsigned*)(F.ctl + CW_BAR); bar.x = 0; bar.st = nullptr;
    if (args.use_bar) bar = xcd_barrier_post((unsigned*)(F.ctl + CW_BAR), MISC + 8);
    const int lo = args.ph_lo, hi = args.ph_hi;
#ifndef PH_MASK
#define PH_MASK 0x3ff
#endif
#define IN(k) (lo <= (k) && (k) < hi && (launder(F), true))
#define SEAM(k) do { if (lo <= (k) && (k) + 1 < hi) xcd_barrier(bar); } while (0)
    if ((PH_MASK & 1) && IN(0)) { p0_prologue(F, args);
#ifdef PROBE_DUP_P0
        launder(F); p0_prologue(F, args);
#endif
    }
    SEAM(0);
#if PANEL_PROG
    for (int layer = 0; layer < DEPTH; ++layer) {
        const int pb = 1 + layer * PH_PER_LAYER;
        if (IN(pb + 0)) {
            for (int panel = F.bid; panel < NTOK / 256; panel += F.G) {
                const int r0 = panel * 256;
                if (layer > 0) { ln2_pass(F, args, layer - 1, r0 + F.wave, NWAVES, r0 + 256); local_sync(F); launder(F); }
                { bf16_t* H = (bf16_t*)(F.ws + WS_H); const EpiH E{H, (const float2*)(F.ws + WS_ROPE32), (const float2*)(F.ws + WS_ROPE64)};
                  pg_phase(F, (const bf16_t*)(F.ws + WS_XB), DM, (const bf16_t*)(F.ws + WS_WIN) + (size_t)layer * 2560 * 1024, panel, 2560, 1024, E); }
                local_sync(F); launder(F);
                rowstat_pass(F, r0 + F.wave, NWAVES, r0 + 256);
                local_sync(F); launder(F);
                { bf16_t* H = (bf16_t*)(F.ws + WS_H); const EpiUQ Eq{(bf16_t*)(F.ws + WS_QB), (const float*)(F.ws + WS_RSTD), (const float2*)(F.ws + WS_ROPE32)};
                  pg_phase(F, H + HC_CQ_LAT, HP, (const bf16_t*)(F.ws + WS_WUQ) + (size_t)layer * 768 * 256, panel, 768, 256, Eq); }
                launder(F);
                { bf16_t* H = (bf16_t*)(F.ws + WS_H); const EpiUKV Ek{(bf16_t*)(F.ws + WS_KVB), (const float*)(F.ws + WS_RSTD)};
                  pg_phase(F, H + HC_CKV, HP, (const bf16_t*)(F.ws + WS_WUKV) + (size_t)layer * 768 * 256, panel, 768, 256, Ek); }
                launder(F);
            }
        }
        SEAM(pb + 0);
        if (IN(pb + 1)) { cstat_phase(F); }
        SEAM(pb + 1);
        if (IN(pb + 2)) { attn_ab_phase(F, args, layer); launder(F); sattn_phase(F, args, layer, 10); }
        SEAM(pb + 2);
        if (IN(pb + 3)) {
            for (int panel = F.bid; panel < NTOK / 256; panel += F.G) {
                const int r0 = panel * 256;
                { const EpiRes E{args.out, layer == 0 ? args.x_prompt : nullptr, args.x_sample, args.out};
                  pg_phase(F, (const bf16_t*)(F.ws + WS_MIX), DM, (const bf16_t*)(F.ws + WS_WOUT) + (size_t)layer * 1024 * 1024, panel, 1024, 1024, E); }
                local_sync(F); launder(F);
                ln1_route_pass(F, args, layer, r0 + F.wave, NWAVES, r0 + 256);
                launder(F);
            }
            moe_convert(F, args, layer);
        }
        SEAM(pb + 3);
        if (IN(pb + 4)) { moe_up_opt(F, layer);
#ifdef PROBE_DUP_MOE
            launder(F); moe_up_opt(F, layer);
#endif
        }
        SEAM(pb + 4);
        if (IN(pb + 5)) { moe_down_opt(F, layer);
#ifdef PROBE_DUP_MOE
            launder(F); moe_down_opt(F, layer);
#endif
        }
        SEAM(pb + 5);
    }
    if (IN(1 + DEPTH * PH_PER_LAYER)) { ln2_pass(F, args, DEPTH - 1, F.gw, F.NGW, NTOK); }
#else
    for (int layer = 0; layer < DEPTH; ++layer) {
        const int pb = 1 + layer * PH_PER_LAYER;
        if ((PH_MASK & (2 << 0)) && IN(pb + 0)) {   bf16_t* H = (bf16_t*)(F.ws + WS_H);
            const EpiH E{H, (const float2*)(F.ws + WS_ROPE32), (const float2*)(F.ws + WS_ROPE64)};
#if OPT_GEMM
            og_phase(F, (const bf16_t*)(F.ws + WS_XB), DM, (const bf16_t*)(F.ws + WS_WIN) + (size_t)layer * 2560 * 1024, NTOK, 2560, 1024, E);
#ifdef PROBE_DUP_GEMM
            launder(F); og_phase(F, (const bf16_t*)(F.ws + WS_XB), DM, (const bf16_t*)(F.ws + WS_WIN) + (size_t)layer * 2560 * 1024, NTOK, 2560, 1024, E);
#endif
#else
            sg_phase(F, (const bf16_t*)(F.ws + WS_XB), DM, (const bf16_t*)(F.ws + WS_WIN) + (size_t)layer * 2560 * 1024, 1024, NTOK, 2560, 1024, E);
#endif
        }
        SEAM(pb + 0);
        if ((PH_MASK & (2 << 1)) && IN(pb + 1)) { rowstat_pass(F, F.gw, F.NGW, NTOK); cstat_phase(F);
#ifdef PROBE_DUP_CSTAT
            launder(F); rowstat_pass(F, F.gw, F.NGW, NTOK); cstat_phase(F);
#endif
        }
        SEAM(pb + 1);
        if ((PH_MASK & (2 << 2)) && IN(pb + 2)) {
            bf16_t* H = (bf16_t*)(F.ws + WS_H);
            const EpiUQ Eq{(bf16_t*)(F.ws + WS_QB), (const float*)(F.ws + WS_RSTD), (const float2*)(F.ws + WS_ROPE32)};
#if OPT_GEMM
            og_phase(F, H + HC_CQ_LAT, HP, (const bf16_t*)(F.ws + WS_WUQ) + (size_t)layer * 768 * 256, NTOK, 768, 256, Eq);
            launder(F);
#else
            sg_phase(F, H + HC_CQ_LAT, HP, (const bf16_t*)(F.ws + WS_WUQ) + (size_t)layer * 768 * 256, 256, NTOK, 768, 256, Eq);
#endif
            const EpiUKV Ek{(bf16_t*)(F.ws + WS_KVB), (const float*)(F.ws + WS_RSTD)};
#if OPT_GEMM
            og_phase(F, H + HC_CKV, HP, (const bf16_t*)(F.ws + WS_WUKV) + (size_t)layer * 768 * 256, NTOK, 768, 256, Ek);
#ifdef PROBE_DUP_UP
            launder(F); og_phase(F, H + HC_CQ_LAT, HP, (const bf16_t*)(F.ws + WS_WUQ) + (size_t)layer * 768 * 256, NTOK, 768, 256, Eq);
            launder(F); og_phase(F, H + HC_CKV, HP, (const bf16_t*)(F.ws + WS_WUKV) + (size_t)layer * 768 * 256, NTOK, 768, 256, Ek);
#endif
#else
            sg_phase(F, H + HC_CKV, HP, (const bf16_t*)(F.ws + WS_WUKV) + (size_t)layer * 768 * 256, 256, NTOK, 768, 256, Ek);
#endif
        }
        SEAM(pb + 2);
        if ((PH_MASK & (2 << 3)) && IN(pb + 3)) {
#if OPT_ATTN
            attn_ab_phase(F, args, layer); launder(F);
#ifdef PROBE_DUP_ATTN
            attn_ab_phase(F, args, layer, PROBE_DUP_ATTN); launder(F);
#endif
            sattn_phase(F, args, layer, 10);
#ifdef PROBE_DUP_CFIN
            launder(F); sattn_phase(F, args, layer, 10);
#endif
#else
            sattn_phase(F, args, layer, 0);
#endif
        }
        SEAM(pb + 3);
        if ((PH_MASK & (2 << 4)) && IN(pb + 4)) {
#ifdef PROBE_DUP_WOUT
            { const EpiRes E0{args.out, layer == 0 ? args.x_prompt : nullptr, args.x_sample, (float*)(F.ws + WS_H)};
              og_phase(F, (const bf16_t*)(F.ws + WS_MIX), DM, (const bf16_t*)(F.ws + WS_WOUT) + (size_t)layer * 1024 * 1024, NTOK, 1024, 1024, E0); launder(F); }
#endif
            const EpiRes E{args.out, layer == 0 ? args.x_prompt : nullptr, args.x_sample, args.out};
#if OPT_GEMM
            og_phase(F, (const bf16_t*)(F.ws + WS_MIX), DM, (const bf16_t*)(F.ws + WS_WOUT) + (size_t)layer * 1024 * 1024, NTOK, 1024, 1024, E);
#else
            sg_phase(F, (const bf16_t*)(F.ws + WS_MIX), DM, (const bf16_t*)(F.ws + WS_WOUT) + (size_t)layer * 1024 * 1024, 1024, NTOK, 1024, 1024, E);
#endif
        }
        SEAM(pb + 4);
        if ((PH_MASK & (2 << 5)) && IN(pb + 5)) {
#ifdef PROBE_DUP_LN1
#endif
            ln1_route_pass(F, args, layer, F.gw, F.NGW, NTOK); moe_convert(F, args, layer);
#ifdef PROBE_DUP_CONV
            launder(F); moe_convert(F, args, layer);
#endif
        }
        SEAM(pb + 5);
#if OPT_GEMM
        if ((PH_MASK & (2 << 6)) && IN(pb + 6)) { moe_up_opt(F, layer);
#ifdef PROBE_DUP_MOE
            launder(F); moe_up_opt(F, layer);
#endif
        }
#else
        if ((PH_MASK & (2 << 6)) && IN(pb + 6)) { moe_up_simple(F, layer); }
#endif
        SEAM(pb + 6);
#if OPT_GEMM
        if ((PH_MASK & (2 << 7)) && IN(pb + 7)) { moe_down_opt(F, layer);
#ifdef PROBE_DUP_MOE
            launder(F); moe_down_opt(F, layer);
#endif
        }
#else
        if ((PH_MASK & (2 << 7)) && IN(pb + 7)) { moe_down_simple(F, layer); }
#endif
        SEAM(pb + 7);
        if ((PH_MASK & (2 << 8)) && IN(pb + 8)) { ln2_pass(F, args, layer, F.gw, F.NGW, NTOK); }
        SEAM(pb + 8);
    }
#endif
#undef IN
#undef SEAM
}

extern "C" void kernel_launch(void* const* d_in, const int* in_sizes, int n_in, void* d_out, int out_size, void* d_ws, size_t ws_size, hipStream_t stream) {
    static int grid = 0;
    if (grid == 0) {
        if (n_in != 19 || out_size != NTOK * DM || ws_size < WS_END) { fprintf(stderr, "kernel_launch: unexpected shapes (n_in %d out %d ws %zu)\n", n_in, out_size, ws_size); grid = -1; return; }
        int dev = 0, cus = 0, per_cu = 0;
        if (hipGetDevice(&dev) != hipSuccess || hipDeviceGetAttribute(&cus, hipDeviceAttributeMultiprocessorCount, dev) != hipSuccess) { grid = -1; return; }
        if (hipFuncSetAttribute((const void*)fwd, hipFuncAttributeMaxDynamicSharedMemorySize, LDS_BYTES) != hipSuccess) { grid = -1; return; }
        if (hipOccupancyMaxActiveBlocksPerMultiprocessor(&per_cu, (const void*)fwd, NTHREADS, LDS_BYTES) != hipSuccess || per_cu < 1) { fprintf(stderr, "kernel_launch: occupancy query says %d\n", per_cu); }
        (void)hipGetLastError();
        grid = cus;
    }
    if (grid < 0) return;
    if (hipMemsetAsync((char*)d_ws + WS_CTL, 0, CTL_ZERO_BYTES, stream) != hipSuccess) return;
    Args a{};
    a.x_prompt = (const float*)d_in[0]; a.x_sample = (const float*)d_in[1]; a.w_in = (const float*)d_in[2]; a.diff_lambda = (const float*)d_in[3]; a.diff_subln = (const float*)d_in[4];
    a.mla_q_norm = (const float*)d_in[5]; a.mla_w_uq = (const float*)d_in[6]; a.mla_kv_norm = (const float*)d_in[7]; a.mla_w_ukv = (const float*)d_in[8]; a.w_out = (const float*)d_in[9];
    a.ln1_g = (const float*)d_in[10]; a.ln1_b = (const float*)d_in[11]; a.moe_w_coarse = (const float*)d_in[12]; a.moe_w_fine = (const float*)d_in[13];
    a.moe_w1 = (const float*)d_in[14]; a.moe_w3 = (const float*)d_in[15]; a.moe_w2 = (const float*)d_in[16]; a.ln2_g = (const float*)d_in[17]; a.ln2_b = (const float*)d_in[18];
    a.out = (float*)d_out; a.ws = (unsigned char*)d_ws; a.pad = 0;
#if MK_ONE_LAUNCH
    a.ph_lo = 0; a.ph_hi = N_PHASES; a.use_bar = 1;
    hipLaunchKernelGGL(fwd, dim3(grid), dim3(NTHREADS), LDS_BYTES, stream, a);
#else
    for (int p = 0; p < N_PHASES; ++p) { a.ph_lo = p; a.ph_hi = p + 1; a.use_bar = 0; hipLaunchKernelGGL(fwd, dim3(grid), dim3(NTHREADS), LDS_BYTES, stream, a); }
#endif
}
```

```cpp
#include <hip/hip_runtime.h>
#include <cstdio>
#include <cstdint>

#ifndef OPT_ATTN
#define OPT_ATTN 1
#endif
#ifndef OPT_GEMM
#define OPT_GEMM 1
#endif
#ifndef MK_ONE_LAUNCH
#define MK_ONE_LAUNCH 1
#endif

#define GAS __attribute__((address_space(1)))
#define LAS __attribute__((address_space(3)))
typedef unsigned short bf16_t;
typedef short bf16x8 __attribute__((ext_vector_type(8)));
typedef float f32x4 __attribute__((ext_vector_type(4)));
typedef float f32x2 __attribute__((ext_vector_type(2)));
typedef float f32x16 __attribute__((ext_vector_type(16)));
typedef unsigned u32x4 __attribute__((ext_vector_type(4)));
typedef unsigned u32x2 __attribute__((ext_vector_type(2)));
typedef GAS unsigned gu32;
#define RLX_AGENT __ATOMIC_RELAXED, __HIP_MEMORY_SCOPE_AGENT
#define LDS_WAIT() asm volatile("s_waitcnt lgkmcnt(0)" ::: "memory")
#define VM_WAIT() asm volatile("s_waitcnt vmcnt(0)" ::: "memory")
#define MFMA32(a, b, c) __builtin_amdgcn_mfma_f32_32x32x16_bf16(a, b, c, 0, 0, 0)

__device__ __forceinline__ unsigned f2bf(float f) { unsigned u = __builtin_bit_cast(unsigned, f); return (u + 0x7fffu + ((u >> 16) & 1u)) >> 16; }
__device__ __forceinline__ unsigned pk2(float lo, float hi) { typedef float f2_ __attribute__((ext_vector_type(2))); typedef __bf16 b2_ __attribute__((ext_vector_type(2))); f2_ v = {lo, hi}; b2_ b = __builtin_convertvector(v, b2_); return __builtin_bit_cast(unsigned, b); }
__device__ __forceinline__ float bf2f(unsigned short b) { return __builtin_bit_cast(float, (unsigned)b << 16); }
__device__ __forceinline__ int crow(int r, int hi) { return (r & 3) + 8 * (r >> 2) + 4 * hi; }
template <int K> __device__ __forceinline__ float shx(float v) { static_assert(K < 32, "xor 32: use xsum32 / xmax32 / xpair32"); return __uint_as_float((unsigned)__builtin_amdgcn_ds_swizzle((int)__float_as_uint(v), (K << 10) | 0x1f)); }
__device__ __forceinline__ float xsum32(float v) { auto rr = __builtin_amdgcn_permlane32_swap(__float_as_uint(v), __float_as_uint(v), false, false); return __uint_as_float(rr[0]) + __uint_as_float(rr[1]); }
__device__ __forceinline__ float xmax32(float v) { auto rr = __builtin_amdgcn_permlane32_swap(__float_as_uint(v), __float_as_uint(v), false, false); return fmaxf(__uint_as_float(rr[0]), __uint_as_float(rr[1])); }
__device__ __forceinline__ float xpair32(float lo, float hi) { auto rr = __builtin_amdgcn_permlane32_swap(__float_as_uint(lo), __float_as_uint(hi), false, false); return __uint_as_float(rr[0]) + __uint_as_float(rr[1]); }
__device__ __forceinline__ float wave_sum(float v) {
    v += shx<1>(v); v += shx<2>(v); v += shx<4>(v); v += shx<8>(v); v += shx<16>(v);
    return xsum32(v);
}
__device__ __forceinline__ float fast_exp2(float x) { return __builtin_amdgcn_exp2f(x); }

constexpr int NTOK = 65536, DM = 1024, DEPTH = 4;
constexpr int NTOK_P = 32768;
constexpr int HP = 2560;
constexpr int HC_AQ = 0, HC_AK = 256, HC_AV = 512, HC_CQ_LAT = 768, HC_CKV = 1024, HC_KROPE = 1152, HC_CQ = 1280, HC_CK = 1664, HC_CV = 2048;
constexpr int QBP = 768, KVP = 768;
constexpr int MIX_A = 0, MIX_B = 256, MIX_C = 640;
constexpr int NEXP = 32, DEXP = 512;
constexpr float LOG2E = 1.4426950408889634f;
constexpr float SC_A = 0.17677669529663687f * LOG2E;
constexpr float SC_B = 0.10206207261596575f * LOG2E;
constexpr float SC_C = 0.125f * LOG2E;
constexpr float DN_ALPHA = 1.681792830507429f;
constexpr float LN_EPS = 1e-5f, RMS_EPS = 1e-6f;

constexpr size_t MiB = 1u << 20;
constexpr size_t WS_CTL = 0, CTL_ZERO_BYTES = 64 * 1024;
constexpr size_t WS_ROPE32 = 4 * MiB;
constexpr size_t WS_ROPE64 = 5 * MiB;
constexpr size_t WS_WIN = 8 * MiB;
constexpr size_t WS_WOUT = 28 * MiB;
constexpr size_t WS_WUQ = 36 * MiB;
constexpr size_t WS_WUKV = 38 * MiB;
constexpr size_t WS_W13 = 40 * MiB;
constexpr size_t WS_W2 = 104 * MiB;
constexpr size_t WS_XB = 136 * MiB;
constexpr size_t WS_H = 264 * MiB;
constexpr size_t WS_QB = 584 * MiB;
constexpr size_t WS_KVB = 680 * MiB;
constexpr size_t WS_MIX = 776 * MiB;
constexpr size_t WS_RSTD = 904 * MiB;
constexpr size_t WS_LSEC = 905 * MiB;
constexpr size_t WS_TW = 907 * MiB;
constexpr size_t WS_LIST = 908 * MiB;
constexpr size_t WS_END = 924 * MiB;
constexpr size_t WS_HID = WS_H;
constexpr size_t WS_YB = WS_H + 136 * MiB;
static_assert(WS_YB + 256 * MiB <= WS_KVB + 96 * MiB, "YB overlay");
constexpr int LIST_CAP = 131072;
constexpr int CW_TMO = 0;
constexpr int CW_CNT = 64;
constexpr int CW_BAR = 4096;

constexpr int RING_BYTES = 131072;
constexpr int MISC_OFF = RING_BYTES + 320;
constexpr int LDS_BYTES = 147456;
constexpr int NWAVES = 8, NTHREADS = 512;

#define XB_TMO      128
#define XB_XCNT(j)  (256  + 64 * (j))
#define XB_XSUB(j)  (1280 + 64 * (j))
#define XB_XGEN(j)  (2304 + 64 * (j))
#define XB_TOP      3328
#define XB_TOPGEN   3392
#define XCD_BAR_WORDS 3456
#define XB_SPIN_CAP (1u << 22)
__device__ __forceinline__ unsigned xb_ld(unsigned* p)              { return __hip_atomic_load(p, __ATOMIC_RELAXED, __HIP_MEMORY_SCOPE_AGENT); }
__device__ __forceinline__ unsigned xb_add(unsigned* p, unsigned v) { return __hip_atomic_fetch_add(p, v, __ATOMIC_RELAXED, __HIP_MEMORY_SCOPE_AGENT); }
__device__ __forceinline__ unsigned xb_xcc_id() { return (unsigned)__builtin_amdgcn_s_getreg((3 << 11) | 20) & 0xFu; }
#define XB_SPIN(cond, bar) do { unsigned _sp = 0; while (cond) { __builtin_amdgcn_s_sleep(1); \
    if ((++_sp & 255u) == 0u) { if (xb_ld(&(bar)[XB_TMO])) break; if (_sp > XB_SPIN_CAP) { atomicAdd(&(bar)[XB_TMO], 1u); break; } } } } while (0)
struct XcdBarrier { unsigned* bar; unsigned x; volatile LAS unsigned* st; };
__device__ __forceinline__ XcdBarrier xcd_barrier_post(unsigned* bar, volatile LAS unsigned* st) {
    XcdBarrier b; b.bar = bar; b.x = xb_xcc_id(); b.st = st;
    if (threadIdx.x == 0) (void)xb_add(&bar[XB_XCNT(b.x)], 1u);
    return b;
}
__device__ __forceinline__ void xcd_barrier_complete(unsigned* bar, unsigned x, unsigned& nloc, unsigned& nx) {
    const unsigned G = gridDim.x * gridDim.y * gridDim.z;
    unsigned sum, cnt, mine, sp = 0u;
    for (;;) {
        sum = 0u; cnt = 0u; mine = 0u;
#pragma unroll
        for (unsigned j = 0; j < 16; ++j) { const unsigned c = xb_ld(&bar[XB_XCNT(j)]); sum += c; cnt += (c > 0u) ? 1u : 0u; mine = (j == x) ? c : mine; }
        if (sum == G) break;
        __builtin_amdgcn_s_sleep(1);
        if ((++sp & 255u) == 0u) { if (xb_ld(&bar[XB_TMO])) break; if (sp > XB_SPIN_CAP) { atomicAdd(&bar[XB_TMO], 1u); break; } }
    }
    nloc = mine > 0u ? mine : 1u; nx = cnt > 0u ? cnt : 1u;
}
__device__ __forceinline__ void xcd_barrier(const XcdBarrier& b) {
    asm volatile("s_waitcnt vmcnt(0)" ::: "memory");
    __syncthreads();
    if (threadIdx.x == 0) {
        unsigned* bar = b.bar;
        __builtin_amdgcn_s_waitcnt(0);
        unsigned nloc = b.st[0], nx = b.st[1];
        if (nloc == 0u) { xcd_barrier_complete(bar, b.x, nloc, nx); b.st[0] = nloc; b.st[1] = nx; }
        const unsigned old = xb_add(&bar[XB_XSUB(b.x)], 1u);
        const unsigned gen = old / nloc;
        if (old + 1u == (gen + 1u) * nloc) {
            __builtin_amdgcn_fence(__ATOMIC_RELEASE, "agent");
            asm volatile("s_waitcnt vmcnt(0)" ::: "memory");
            const unsigned og = xb_add(&bar[XB_TOP], 1u);
            const unsigned tg = og / nx;
            if (og + 1u == (tg + 1u) * nx) xb_add(&bar[XB_TOPGEN], 1u);
            else XB_SPIN(xb_ld(&bar[XB_TOPGEN]) == tg, bar);
            __builtin_amdgcn_fence(__ATOMIC_ACQUIRE, "agent");
            xb_add(&bar[XB_XGEN(b.x)], 1u);
            asm volatile("s_waitcnt vmcnt(0)" ::: "memory");
        } else {
            XB_SPIN(xb_ld(&bar[XB_XGEN(b.x)]) == gen, bar);
            __builtin_amdgcn_fence(__ATOMIC_ACQUIRE, "agent");
            asm volatile("s_waitcnt vmcnt(0)" ::: "memory");
        }
    }
    __syncthreads();
}

struct Args {
    const float* x_prompt; const float* x_sample; const float* w_in; const float* diff_lambda; const float* diff_subln; const float* mla_q_norm; const float* mla_w_uq;
    const float* mla_kv_norm; const float* mla_w_ukv; const float* w_out; const float* ln1_g; const float* ln1_b; const float* moe_w_coarse; const float* moe_w_fine;
    const float* moe_w1; const float* moe_w3; const float* moe_w2; const float* ln2_g; const float* ln2_b;
    float* out; unsigned char* ws; int ph_lo, ph_hi, use_bar, pad;
};
struct Frame {
    LAS unsigned char* lds; unsigned char* ldsg;
    int tid, lane, wave, G, gw, NGW, bid;
    gu32* ctl; unsigned char* ws;
};
__device__ __forceinline__ void launder(Frame& F) {
    int wv = F.wave; asm volatile("" : "+s"(wv)); F.wave = wv;
    int t; asm volatile("v_mbcnt_lo_u32_b32 %0, -1, 0\n\tv_mbcnt_hi_u32_b32 %0, -1, %0" : "=v"(t)); F.lane = t; F.tid = wv * 64 + t;
    int b = (int)blockIdx.x; asm volatile("" : "+s"(b)); F.bid = b; F.gw = b * NWAVES + F.wave;
    unsigned char* w = F.ws; asm volatile("" : "+s"(w)); F.ws = w; F.ctl = (gu32*)(w + WS_CTL);
}
struct SeqInfo { int base, len, pos; };
__device__ __forceinline__ SeqInfo seqinfo(int m) { SeqInfo s; if (m < NTOK_P) { s.base = m & ~2047; s.len = 2048; } else { s.base = m & ~4095; s.len = 4096; } s.pos = m - s.base; return s; }

template <class ColMap>
__device__ __forceinline__ void transpose_item(const float* W, int N, bf16_t* WT, int ldd, LAS float* scr, int k0, int n0, const ColMap& cm, const float* kscale, int lane) {
    const int sc = cm(n0 + (lane & 31));
#pragma unroll 8
    for (int i = 0; i < 32; ++i) { const int kk = 2 * i + (lane >> 5); float v = 0.f; if (sc >= 0) { v = W[(size_t)(k0 + kk) * N + sc]; if (kscale) v *= kscale[k0 + kk]; } scr[kk * 33 + (lane & 31)] = v; }
    LDS_WAIT(); asm volatile("" ::: "memory");
    const int c = lane & 7;
#pragma unroll
    for (int j = 0; j < 4; ++j) { const int n = (lane >> 3) + 8 * j; const LAS float* s = scr + (8 * c) * 33 + n;
        u32x4 o; o.x = pk2(s[0 * 33], s[1 * 33]); o.y = pk2(s[2 * 33], s[3 * 33]); o.z = pk2(s[4 * 33], s[5 * 33]); o.w = pk2(s[6 * 33], s[7 * 33]);
        *(u32x4*)(WT + (size_t)(n0 + n) * ldd + k0 + 8 * c) = o; }
    LDS_WAIT(); asm volatile("" ::: "memory");
}
__device__ __forceinline__ void transpose_item_v4(const float* Wsrc, int N, bf16_t* WTdst, int ldd, LAS float* scr, int lane) {
    const int c4 = (lane & 7) * 4, kr = lane >> 3;
    f32x4 t[8];
#pragma unroll
    for (int i = 0; i < 8; ++i) t[i] = *(const f32x4*)(Wsrc + (size_t)(i * 8 + kr) * N + c4);
#pragma unroll
    for (int i = 0; i < 8; ++i) { const int kk = i * 8 + kr; scr[(c4 + 0) * 65 + kk] = t[i].x; scr[(c4 + 1) * 65 + kk] = t[i].y; scr[(c4 + 2) * 65 + kk] = t[i].z; scr[(c4 + 3) * 65 + kk] = t[i].w; }
    LDS_WAIT(); asm volatile("" ::: "memory");
    const int c = lane & 7;
#pragma unroll
    for (int j = 0; j < 4; ++j) { const int n = (lane >> 3) + 8 * j; const LAS float* p = scr + n * 65 + 8 * c;
        u32x4 o; o.x = pk2(p[0], p[1]); o.y = pk2(p[2], p[3]); o.z = pk2(p[4], p[5]); o.w = pk2(p[6], p[7]);
        *(u32x4*)(WTdst + (size_t)n * ldd + 8 * c) = o; }
    LDS_WAIT(); asm volatile("" ::: "memory");
}
struct WinMap {
    __device__ __forceinline__ int operator()(int n) const {
        if (n < 512) { const int t = n & 31; return (n & ~31) + (t >> 1) + 16 * (t & 1); }
        if (n < 1152) return n;
        if (n < 1184) { const int t = n - 1152; return 1152 + (t >> 1) + 16 * (t & 1); }
        if (n < 1280) return -1;
        if (n < 2048) { const int u = n - 1280, t = u & 63; return 1184 + (u & ~63) + (t >> 1) + 32 * (t & 1); }
        if (n < 2432) return 1952 + (n - 2048);
        return -1;
    }
};
struct UqMap { __device__ __forceinline__ int operator()(int n) const { if (n >= 576) return -1; const int h = n / 96, t = n - 96 * h; if (t < 64) return n; const int u = t - 64; return 96 * h + 64 + (u >> 1) + 16 * (u & 1); } };
struct IdMap { __device__ __forceinline__ int operator()(int n) const { return n; } };
struct W13Map { __device__ __forceinline__ int operator()(int n) const { return (n >> 8) * 128 + (n & 127); } };

__device__ __forceinline__ void p0_prologue(Frame& F, const Args& a) {
    LAS float* scr = (LAS float*)(F.lds + F.wave * 16384);
    { float2* r32 = (float2*)(F.ws + WS_ROPE32); float2* r64 = (float2*)(F.ws + WS_ROPE64);
      for (int i = F.gw * 64 + F.lane; i < 4096 * 16; i += F.NGW * 64) { const int pos = i >> 4, j = i & 15; const float inv = 1.0f / powf(10000.0f, (float)(2 * j) / 32.0f); const float ang = (float)pos * inv; r32[i] = make_float2(cosf(ang), sinf(ang)); }
      for (int i = F.gw * 64 + F.lane; i < 4096 * 32; i += F.NGW * 64) { const int pos = i >> 5, j = i & 31; const float inv = 1.0f / powf(10000.0f, (float)(2 * j) / 64.0f); const float ang = (float)pos * inv; r64[i] = make_float2(cosf(ang), sinf(ang)); } }
    constexpr int I_WIN = (1024 / 64) * (2560 / 32), I_WOUT = (1024 / 64) * (1024 / 32), I_UQ = (256 / 64) * (768 / 32), I_UKV = (256 / 64) * (768 / 32);
    constexpr int PER_L = I_WIN + I_WOUT + I_UQ + I_UKV;
    for (int it = F.gw; it < DEPTH * PER_L; it += F.NGW) {
        const int l = it / PER_L; int r = it - l * PER_L;
        if (r < I_WIN) { const int kb = r / 80, nb = r % 80; transpose_item(a.w_in + (size_t)l * 1024 * 2336, 2336, (bf16_t*)(F.ws + WS_WIN) + (size_t)l * 2560 * 1024, 1024, scr, kb * 64, nb * 32, WinMap(), nullptr, F.lane); continue; } r -= I_WIN;
        if (r < I_WOUT) { const int kb = r / 32, nb = r % 32; transpose_item(a.w_out + (size_t)l * 1024 * 1024, 1024, (bf16_t*)(F.ws + WS_WOUT) + (size_t)l * 1024 * 1024, 1024, scr, kb * 64, nb * 32, IdMap(), nullptr, F.lane); continue; } r -= I_WOUT;
        if (r < I_UQ) { const int kb = r / 24, nb = r % 24; transpose_item(a.mla_w_uq + (size_t)l * 256 * 576, 576, (bf16_t*)(F.ws + WS_WUQ) + (size_t)l * 768 * 256, 256, scr, kb * 64, nb * 32, UqMap(), a.mla_q_norm + l * 256, F.lane); continue; } r -= I_UQ;
        { const int kb = r / 24, nb = r % 24; bf16_t* dst = (bf16_t*)(F.ws + WS_WUKV) + (size_t)l * 768 * 256;
          if (kb < 2) transpose_item(a.mla_w_ukv + (size_t)l * 128 * 768, 768, dst, 256, scr, kb * 64, nb * 32, IdMap(), a.mla_kv_norm + l * 128, F.lane);
          else { const int c = F.lane & 7;
#pragma unroll
              for (int j = 0; j < 4; ++j) { const int n = (F.lane >> 3) + 8 * j; *(u32x4*)(dst + (size_t)(nb * 32 + n) * 256 + kb * 64 + 8 * c) = (u32x4){0u, 0u, 0u, 0u}; } } }
    }
    bf16_t* XB = (bf16_t*)(F.ws + WS_XB);
    for (int m = F.gw; m < NTOK; m += F.NGW) {
        const float* src = (m < NTOK_P) ? a.x_prompt + (size_t)m * DM : a.x_sample + (size_t)(m - NTOK_P) * DM;
#pragma unroll
        for (int j = 0; j < 4; ++j) { const f32x4 v = *((const f32x4*)src + F.lane + 64 * j);
            u32x2 w; w.x = pk2(v.x, v.y); w.y = pk2(v.z, v.w); *((u32x2*)(XB + (size_t)m * DM) + F.lane + 64 * j) = w; }
    }
}

template <class Epi, class RowMap>
__device__ __forceinline__ void sg_tile(const bf16_t* A, int lda, const bf16_t* B0, const bf16_t* B1, int ldb, int K, int m0, int c0, const Epi& E, const RowMap& RM, int lane) {
    const int r32 = lane & 31, hi = lane >> 5;
    const bf16_t* ap = A + (size_t)RM.src(m0 + r32) * lda + 8 * hi;
    const bf16_t* b0p = B0 + (size_t)r32 * ldb + 8 * hi;
    const bf16_t* b1p = B1 + (size_t)r32 * ldb + 8 * hi;
    f32x16 acc0 = {}, acc1 = {};
#pragma unroll 4
    for (int k = 0; k < K; k += 16) {
        const bf16x8 af = *(const bf16x8*)(ap + k), bf0 = *(const bf16x8*)(b0p + k), bf1 = *(const bf16x8*)(b1p + k);
        acc0 = MFMA32(bf0, af, acc0); acc1 = MFMA32(bf1, af, acc1);
    }
#pragma unroll
    for (int g = 0; g < 4; ++g) { const f32x4 v0 = {acc0[4 * g], acc0[4 * g + 1], acc0[4 * g + 2], acc0[4 * g + 3]}, v1 = {acc1[4 * g], acc1[4 * g + 1], acc1[4 * g + 2], acc1[4 * g + 3]};
        E.put(m0 + r32, c0, 8 * g + 4 * hi, v0, v1); }
}
struct IdRows { __device__ __forceinline__ int src(int m) const { return m; } };

__device__ __forceinline__ void store_bf8(bf16_t* p, f32x4 a, f32x4 b) { u32x4 w; w.x = pk2(a.x, a.y); w.y = pk2(a.z, a.w); w.z = pk2(b.x, b.y); w.w = pk2(b.z, b.w); *(u32x4*)p = w; }
__device__ __forceinline__ void store_bf4(bf16_t* p, f32x4 v) { u32x2 w; w.x = pk2(v.x, v.y); w.y = pk2(v.z, v.w); *(u32x2*)p = w; }
struct EpiH {
    static constexpr bool INPLACE = false;
    static constexpr bool PERM = true;
    bf16_t* H; const float2* rope32; const float2* rope64;
    __device__ __forceinline__ f32x4 xf(int pos, int col, f32x4 v) const {
        if (col < 512 || (col >= HC_KROPE && col < HC_KROPE + 32)) {
            const int j0 = (col & 31) >> 1; const f32x4 cs = *(const f32x4*)(rope32 + pos * 16 + j0);
            f32x4 o; o.x = v.x * cs.x - v.y * cs.y; o.y = v.x * cs.y + v.y * cs.x; o.z = v.z * cs.z - v.w * cs.w; o.w = v.z * cs.w + v.w * cs.z;
            if (col < 256) o = o * SC_A; v = o;
        } else if (col >= HC_CQ && col < HC_CV) {
            const int j0 = ((col - HC_CQ) & 63) >> 1; const f32x4 cs = *(const f32x4*)(rope64 + pos * 32 + j0);
            f32x4 o; o.x = v.x * cs.x - v.y * cs.y; o.y = v.x * cs.y + v.y * cs.x; o.z = v.z * cs.z - v.w * cs.w; o.w = v.z * cs.w + v.w * cs.z;
            if (col < HC_CK) o = o * SC_C; v = o;
        }
        return v;
    }
    __device__ __forceinline__ void put4(int row, int col, f32x4 v) const { store_bf4(H + (size_t)row * HP + col, xf(seqinfo(row).pos, col, v)); }
    __device__ __forceinline__ void put(int row, int c0, int cc, f32x4 v0, f32x4 v1) const { put4(row, c0 + cc, v0); put4(row, c0 + 32 + cc, v1); }
    template <class U> __device__ __forceinline__ void put8(const U&, int row, int col, f32x4 v0, f32x4 v1) const { const int pos = seqinfo(row).pos; store_bf8(H + (size_t)row * HP + col, xf(pos, col, v0), xf(pos, col + 4, v1)); }
    struct Pre { f32x4 c0, c1; };
    __device__ __forceinline__ static f32x4 rot(f32x4 v, f32x4 cs) { f32x4 o; o.x = v.x * cs.x - v.y * cs.y; o.y = v.x * cs.y + v.y * cs.x; o.z = v.z * cs.z - v.w * cs.w; o.w = v.z * cs.w + v.w * cs.z; return o; }
    template <class U> __device__ __forceinline__ Pre pre(const U&, int row, int col) const { Pre p; p.c0 = (f32x4){0.f, 0.f, 0.f, 0.f}; p.c1 = p.c0; const int pos = seqinfo(row).pos;
        if (col < 512 || (col >= HC_KROPE && col < HC_KROPE + 32)) { const f32x4* t = (const f32x4*)(rope32 + pos * 16 + ((col & 31) >> 1)); p.c0 = t[0]; p.c1 = t[1]; }
        else if (col >= HC_CQ && col < HC_CV) { const f32x4* t = (const f32x4*)(rope64 + pos * 32 + (((col - HC_CQ) & 63) >> 1)); p.c0 = t[0]; p.c1 = t[1]; }
        return p; }
    template <class U> __device__ __forceinline__ void fin8(const U&, int row, int col, f32x4 v0, f32x4 v1, const Pre& p) const {
        if (col < 512 || (col >= HC_KROPE && col < HC_KROPE + 32)) { v0 = rot(v0, p.c0); v1 = rot(v1, p.c1); if (col < 256) { v0 = v0 * SC_A; v1 = v1 * SC_A; } }
        else if (col >= HC_CQ && col < HC_CV) { v0 = rot(v0, p.c0); v1 = rot(v1, p.c1); if (col < HC_CK) { v0 = v0 * SC_C; v1 = v1 * SC_C; } }
        store_bf8(H + (size_t)row * HP + col, v0, v1); }
};
struct EpiUQ {
    static constexpr bool INPLACE = false;
    static constexpr bool PERM = true;
    bf16_t* Q; const float* rstd; const float2* rope32;
    __device__ __forceinline__ f32x4 xf(int row, int col, f32x4 v, float rs) const {
        v = v * rs;
        const int t = col % 96;
        if (t >= 64) { const int pos = seqinfo(row).pos; const int j0 = (t - 64) >> 1; const f32x4 cs = *(const f32x4*)(rope32 + pos * 16 + j0);
            f32x4 o; o.x = v.x * cs.x - v.y * cs.y; o.y = v.x * cs.y + v.y * cs.x; o.z = v.z * cs.z - v.w * cs.w; o.w = v.z * cs.w + v.w * cs.z; v = o; }
        return v * SC_B;
    }
    __device__ __forceinline__ void put4(int row, int col, f32x4 v) const { if (col >= 576) return; store_bf4(Q + (size_t)row * QBP + col, xf(row, col, v, rstd[2 * row])); }
    template <class U> __device__ __forceinline__ void put8(const U&, int row, int col, f32x4 v0, f32x4 v1) const { if (col >= 576) return; const float rs = rstd[2 * row]; store_bf8(Q + (size_t)row * QBP + col, xf(row, col, v0, rs), xf(row, col + 4, v1, rs)); }
    __device__ __forceinline__ void put(int row, int c0, int cc, f32x4 v0, f32x4 v1) const { put4(row, c0 + cc, v0); put4(row, c0 + 32 + cc, v1); }
    struct Pre { float rs; f32x4 c0, c1; };
    template <class U> __device__ __forceinline__ Pre pre(const U&, int row, int col) const { Pre p; p.rs = rstd[2 * row]; p.c0 = (f32x4){0.f, 0.f, 0.f, 0.f}; p.c1 = p.c0;
        if (col < 576 && (col % 96) >= 64) { const f32x4* t = (const f32x4*)(rope32 + seqinfo(row).pos * 16 + (((col % 96) - 64) >> 1)); p.c0 = t[0]; p.c1 = t[1]; }
        return p; }
    template <class U> __device__ __forceinline__ void fin8(const U&, int row, int col, f32x4 v0, f32x4 v1, const Pre& p) const { if (col >= 576) return;
        v0 = v0 * p.rs; v1 = v1 * p.rs; if ((col % 96) >= 64) { v0 = EpiH::rot(v0, p.c0); v1 = EpiH::rot(v1, p.c1); }
        store_bf8(Q + (size_t)row * QBP + col, v0 * SC_B, v1 * SC_B); }
};
struct EpiUKV {
    static constexpr bool INPLACE = false;
    static constexpr bool PERM = true;
    bf16_t* KV; const float* rstd;
    template <class U> __device__ __forceinline__ void put8(const U&, int row, int col, f32x4 v0, f32x4 v1) const { const float rs = rstd[2 * row + 1]; store_bf8(KV + (size_t)row * KVP + col, v0 * rs, v1 * rs); }
    __device__ __forceinline__ void put4(int row, int col, f32x4 v) const { store_bf4(KV + (size_t)row * KVP + col, v * rstd[2 * row + 1]); }
    __device__ __forceinline__ void put(int row, int c0, int cc, f32x4 v0, f32x4 v1) const { put4(row, c0 + cc, v0); put4(row, c0 + 32 + cc, v1); }
    struct Pre { float rs; };
    template <class U> __device__ __forceinline__ Pre pre(const U&, int row, int) const { Pre p; p.rs = rstd[2 * row + 1]; return p; }
    template <class U> __device__ __forceinline__ void fin8(const U&, int row, int col, f32x4 v0, f32x4 v1, const Pre& p) const { store_bf8(KV + (size_t)row * KVP + col, v0 * p.rs, v1 * p.rs); }
};
struct EpiRes {
    static constexpr bool INPLACE = true;
    static constexpr bool PERM = false;
    float* X; const float* xp; const float* xs; float* D;
    template <class U> __device__ __forceinline__ void put4(const U&, int row, int col, f32x4 v) const { put4(row, col, v); }
    __device__ __forceinline__ void put4(int row, int col, f32x4 v) const {
        const f32x4* p = (const f32x4*)(X + (size_t)row * DM + col);
        const f32x4 r = xp ? *(const f32x4*)(((row < NTOK_P) ? xp + (size_t)row * DM : xs + (size_t)(row - NTOK_P) * DM) + col) : *p;
        *(f32x4*)(D + (size_t)row * DM + col) = r * DN_ALPHA + v; }
    __device__ __forceinline__ void put(int row, int c0, int cc, f32x4 v0, f32x4 v1) const { put4(row, c0 + cc, v0); put4(row, c0 + 32 + cc, v1); }
    struct Pre { f32x4 a, b; };
    template <class U> __device__ __forceinline__ Pre pre(const U&, int row, int col) const { Pre p;
        const float* src = xp ? ((row < NTOK_P) ? xp + (size_t)row * DM : xs + (size_t)(row - NTOK_P) * DM) : X + (size_t)row * DM;
        p.a = *(const f32x4*)(src + col); p.b = *(const f32x4*)(src + col + 16); return p; }
    template <class U> __device__ __forceinline__ void fin4x2(const U&, int row, int col, f32x4 v0, f32x4 v1, const Pre& p) const {
        *(f32x4*)(D + (size_t)row * DM + col) = p.a * DN_ALPHA + v0; *(f32x4*)(D + (size_t)row * DM + col + 16) = p.b * DN_ALPHA + v1; }
};
__device__ __forceinline__ float silu_f(float x) { return x / (1.0f + __expf(-x)); }
struct EpiHid {
    static constexpr bool INPLACE = false;
    static constexpr bool PERM = true;
    bf16_t* HID;
    __device__ __forceinline__ f32x4 act(f32x4 g, f32x4 u) const { f32x4 o; o.x = silu_f(g.x) * u.x; o.y = silu_f(g.y) * u.y; o.z = silu_f(g.z) * u.z; o.w = silu_f(g.w) * u.w; return o; }
    template <class U> __device__ __forceinline__ void putp8(const U&, int row, int col, f32x4 g0, f32x4 g1, f32x4 u0, f32x4 u1) const { store_bf8(HID + (size_t)row * DEXP + col, act(g0, u0), act(g1, u1)); }
    __device__ __forceinline__ void putp(int row, int col, f32x4 g, f32x4 u) const { f32x4 o; o.x = silu_f(g.x) * u.x; o.y = silu_f(g.y) * u.y; o.z = silu_f(g.z) * u.z; o.w = silu_f(g.w) * u.w; store_bf4(HID + (size_t)row * DEXP + col, o); }
    __device__ __forceinline__ void put(int row, int c0, int cc, f32x4 v0, f32x4 v1) const { putp(row, c0 + cc, v0, v1); }
};
struct EpiY {
    static constexpr bool INPLACE = false;
    bf16_t* YB; const float* tw; const int* list; int seg0, cnt;
    __device__ __forceinline__ void put4(int row, int col, f32x4 v) const { const int r = row - seg0; if (r >= cnt) return; const int a = list[r]; store_bf4(YB + (size_t)a * DM + col, v * tw[a]); }
    __device__ __forceinline__ void put(int row, int c0, int cc, f32x4 v0, f32x4 v1) const { put4(row, c0 + cc, v0); put4(row, c0 + 32 + cc, v1); }
};

struct EpiYO {
    static constexpr bool INPLACE = false;
    static constexpr bool PERM = true;
    bf16_t* YB; const float* tw; const int* list; const LAS int* seg;
    template <class U> __device__ __forceinline__ void put8(const U& u, int row, int col, f32x4 v0, f32x4 v1) const {
        const int r = row - __builtin_amdgcn_readfirstlane(seg[u.e]); if (r >= __builtin_amdgcn_readfirstlane(seg[33 + u.e])) return; const int a = list[(size_t)u.e * LIST_CAP + r]; const float w = tw[a]; store_bf8(YB + (size_t)a * DM + col, v0 * w, v1 * w); }
    struct Pre { int a; float w; };
    template <class U> __device__ __forceinline__ Pre pre(const U& u, int row, int) const { Pre p; p.a = -1; p.w = 0.f;
        const int r = row - __builtin_amdgcn_readfirstlane(seg[u.e]); if (r < __builtin_amdgcn_readfirstlane(seg[33 + u.e])) { p.a = list[(size_t)u.e * LIST_CAP + r]; p.w = tw[p.a]; } return p; }
    template <class U> __device__ __forceinline__ void fin8(const U&, int, int col, f32x4 v0, f32x4 v1, const Pre& p) const { if (p.a >= 0) store_bf8(YB + (size_t)p.a * DM + col, v0 * p.w, v1 * p.w); }
};
template <class Epi>
__device__ __forceinline__ void sg_phase(Frame& F, const bf16_t* A, int lda, const bf16_t* Bt, int ldb, int M, int N, int K, const Epi& E) {
    const int nN = N / 64, items = (M / 32) * nN;
    for (int it = F.gw; it < items; it += F.NGW) { const int mt = it / nN, nt = it - mt * nN;
        sg_tile(A, lda, Bt + (size_t)(nt * 64) * ldb, Bt + (size_t)(nt * 64 + 32) * ldb, ldb, K, mt * 32, nt * 64, E, IdRows(), F.lane); }
}


namespace pg8 {
constexpr int BM = 256, BK = 64, HALF = 128, HTB = HALF * BK * 2, NXCD = 8, WGM = 8;
__host__ __device__ __forceinline__ int lds_byte(int r, int c) { const int st = (r >> 4) * 2 + (c >> 5), rr = r & 15, cc = c & 31, ob = rr * 64 + cc * 2; return st * 1024 + (ob ^ (((ob >> 9) & 1) << 5)); }
__host__ __device__ __forceinline__ void stage_rc(int b, int& R, int& C) { const int st = b / 1024, sb = b % 1024, swz = sb ^ (((sb >> 9) & 1) << 5); R = (st >> 1) * 16 + swz / 64; C = (st & 1) * 32 + (swz % 64) / 2; }
__host__ __device__ __forceinline__ int perm32(int rho) { const int n = rho >> 4, i = rho & 15; return 8 * (i >> 2) + 4 * n + (i & 3); }
struct Unit { int pm, pn, e; const char* a; const char* b; };
__device__ __forceinline__ bool order_next(int i, int G, int c, int nM, int nN, int& pm, int& pn) {
    const int nwg = nM * nN; const long L = (long)i * G + c; if (L >= nwg) return false;
    int wgid = (int)L; { const int q = nwg / NXCD, r = nwg % NXCD, xcd = wgid % NXCD, off = wgid / NXCD; wgid = (xcd < r ? xcd * (q + 1) : r * (q + 1) + (xcd - r) * q) + off; }
    const int nig = WGM * nN, gid = wgid / nig, fm = gid * WGM, gsz = (nM - fm) < WGM ? (nM - fm) : WGM;
    pm = fm + ((wgid % nig) % gsz); pn = (wgid % nig) / gsz; return true;
}
struct DenseSched {
    const char* A; const char* Bt; int nM, nN, G, c; size_t tstepA, tstepB;
    __device__ __forceinline__ void init(const bf16_t* A_, int lda, const bf16_t* Bt_, int M, int N, int K, int G_, int c_) { A = (const char*)A_; Bt = (const char*)Bt_; nM = M / BM; nN = N / BM; G = G_; c = c_; tstepA = (size_t)BM * lda * 2; tstepB = (size_t)BM * K * 2; }
    __device__ __forceinline__ bool next(int i, Unit& u) const { if (!order_next(i, G, c, nM, nN, u.pm, u.pn)) return false; u.e = 0; u.a = A + (size_t)u.pm * tstepA; u.b = Bt + (size_t)u.pn * tstepB; return true; }
    __device__ __forceinline__ unsigned arow(const Unit&, int) const { return 0u; }
};
struct PanelSched {
    const char* A; const char* Bt; int pm, nN; size_t tstepB;
    __device__ __forceinline__ void init(const bf16_t* A_, int lda, const bf16_t* Bt_, int pm_, int N, int K) { pm = pm_; nN = N / BM; A = (const char*)A_ + (size_t)pm_ * BM * lda * 2; Bt = (const char*)Bt_; tstepB = (size_t)BM * K * 2; }
    __device__ __forceinline__ bool next(int i, Unit& u) const { if (i >= nN) return false; u.pm = pm; int pn = i + (pm % nN); if (pn >= nN) pn -= nN; u.pn = pn; u.e = 0; u.a = A; u.b = Bt + (size_t)pn * tstepB; return true; }
    __device__ __forceinline__ unsigned arow(const Unit&, int) const { return 0u; }
};
template <class Epi, bool PAIR> struct EpiApply;
template <class Epi, class Sched, bool GATHER, bool PAIR>
__device__ __forceinline__ void gemm_phase(LAS unsigned char* lds, int tid, int K, int lda, const Sched& S, const Epi& E) {
    const int wid = __builtin_amdgcn_readfirstlane(tid >> 6), lane = tid & 63, wr = wid >> 2, wc = wid & 3, fr = lane & 15, fq = lane >> 4;
    const int nt = K / BK;
    unsigned voffA[2], voffB[2]; int RA[2], CA[2];
#pragma unroll
    for (int i = 0; i < 2; ++i) { int R, C; stage_rc(tid * 16 + i * 8192, R, C); const int Rb = Epi::PERM ? ((R & ~31) + perm32(R & 31)) : R; RA[i] = R; CA[i] = C;
        voffA[i] = (unsigned)(R * lda + C) * 2u; voffB[i] = (unsigned)(Rb * K + C) * 2u; }
    const size_t kstep = (size_t)(BK * 2);
    const size_t hstepA = (size_t)HALF * lda * 2, hstepB = (size_t)HALF * K * 2;
    const unsigned ldsw = (unsigned)wid * 1024u;
    const int aoff = lds_byte(wr * 64 + fr, fq * 8), boff = lds_byte(wc * 32 + fr, fq * 8);
#define PG8_SA(b, h) (((b) * 2 + (h)) * HTB)
#define PG8_SB(b, h) ((4 + (b) * 2 + (h)) * HTB)
#define PG8_STAGE(bufoff, gbase, voff) do { _Pragma("unroll") for (int _i = 0; _i < 2; ++_i) \
        __builtin_amdgcn_global_load_lds((const unsigned*)((const char*)(gbase) + (voff)[_i]), (LAS unsigned*)(lds + (bufoff) + ldsw + _i * 8192), 16, 0, 0); } while (0)
#define PG8_STAGE_A(bufoff, ab, vg, h, koff) do { if (GATHER) { PG8_STAGE(bufoff, (ab) + (koff), (vg)[h]); } else { PG8_STAGE(bufoff, (ab) + (h) * hstepA + (koff), voffA); } } while (0)
#define PG8_LDA(dst, b, h) do { _Pragma("unroll") for (int m = 0; m < 4; ++m) _Pragma("unroll") for (int k = 0; k < 2; ++k) dst[m][k] = *(const LAS bf16x8*)(lds + PG8_SA(b, h) + aoff + m * 2048 + k * 1024); } while (0)
#define PG8_LDB(dst, b, h) do { _Pragma("unroll") for (int n = 0; n < 2; ++n) _Pragma("unroll") for (int k = 0; k < 2; ++k) dst[n][k] = *(const LAS bf16x8*)(lds + PG8_SB(b, h) + boff + n * 2048 + k * 1024); } while (0)
#define PG8_MMA(ai, bj, At, Bt) do { __builtin_amdgcn_s_setprio(1); _Pragma("unroll") for (int m = 0; m < 4; ++m) _Pragma("unroll") for (int n = 0; n < 2; ++n) _Pragma("unroll") for (int k = 0; k < 2; ++k) \
        acc[ai][bj][m][n] = __builtin_amdgcn_mfma_f32_16x16x32_bf16(Bt[n][k], At[m][k], acc[ai][bj][m][n], 0, 0, 0); __builtin_amdgcn_s_setprio(0); } while (0)
#define PG8_WAIT_V(n) asm volatile("s_waitcnt vmcnt(" #n ")" ::: "memory")
#define PG8_WAIT_L(n) asm volatile("s_waitcnt lgkmcnt(" #n ")" ::: "memory")
#define PG8_BAR __builtin_amdgcn_s_barrier()
#define PG8_SCHED __builtin_amdgcn_sched_barrier(0)
    Unit cur, nxt; int ui = 0;
    if (!S.next(0, cur)) return;
    f32x4 acc[2][2][4][2];
#pragma unroll
    for (int a = 0; a < 2; ++a)
#pragma unroll
        for (int b = 0; b < 2; ++b)
#pragma unroll
            for (int m = 0; m < 4; ++m)
#pragma unroll
                for (int n = 0; n < 2; ++n) acc[a][b][m][n] = (f32x4){0.f, 0.f, 0.f, 0.f};
    bf16x8 At[4][2], B0[2][2], B1[2][2];
    unsigned vgc[2][2] = {{0u, 0u}, {0u, 0u}}, vgn[2][2] = {{0u, 0u}, {0u, 0u}};
    if (GATHER) {
#pragma unroll
        for (int h = 0; h < 2; ++h)
#pragma unroll
            for (int i = 0; i < 2; ++i) vgc[h][i] = S.arow(cur, h * HALF + RA[i]) * (unsigned)(lda * 2) + (unsigned)CA[i] * 2u;
    }
    const char* cA = cur.a; const char* cB = cur.b;
    PG8_STAGE(PG8_SB(0, 0), cB, voffB); PG8_STAGE(PG8_SB(0, 1), cB + hstepB, voffB); PG8_STAGE_A(PG8_SA(0, 0), cA, vgc, 0, 0); PG8_STAGE_A(PG8_SA(0, 1), cA, vgc, 1, 0);
    if (wr == 1) PG8_BAR;
    PG8_WAIT_V(2); PG8_BAR;
    PG8_STAGE(PG8_SB(1, 0), cB + kstep, voffB); PG8_STAGE_A(PG8_SA(1, 0), cA, vgc, 0, kstep); PG8_STAGE(PG8_SB(1, 1), cB + hstepB + kstep, voffB);
    PG8_WAIT_V(6); PG8_BAR;
    for (;;) {
        const bool has_next = S.next(ui + 1, nxt);
        const char* nA = has_next ? nxt.a : cA; const char* nB = has_next ? nxt.b : cB;
        if (GATHER) {
#pragma unroll
            for (int h = 0; h < 2; ++h)
#pragma unroll
                for (int i = 0; i < 2; ++i) vgn[h][i] = has_next ? (S.arow(nxt, h * HALF + RA[i]) * (unsigned)(lda * 2) + (unsigned)CA[i] * 2u) : vgc[h][i];
        }
#pragma clang loop unroll(disable)
        for (int t = 0; t < nt; t += 2) {
            const bool last = (t == nt - 2);
            const size_t k1 = (size_t)(t + 1) * kstep;
            const char* a2 = last ? nA : cA; const char* b2 = last ? nB : cB + (size_t)(t + 2) * kstep; const size_t ka2 = last ? 0 : (size_t)(t + 2) * kstep;
            const char* b3 = b2 + kstep; const size_t ka3 = ka2 + kstep;
            unsigned v2[2][2];
#pragma unroll
            for (int h = 0; h < 2; ++h)
#pragma unroll
                for (int i = 0; i < 2; ++i) v2[h][i] = last ? vgn[h][i] : vgc[h][i];
            PG8_LDB(B0, 0, 0); PG8_LDB(B1, 0, 1); PG8_SCHED; PG8_LDA(At, 0, 0); PG8_STAGE_A(PG8_SA(1, 1), cA, vgc, 1, k1);
            PG8_WAIT_V(8); PG8_WAIT_L(0); PG8_BAR; PG8_MMA(0, 0, At, B0); PG8_MMA(0, 1, At, B1); PG8_BAR; PG8_SCHED;
            PG8_LDA(At, 0, 1); PG8_STAGE(PG8_SB(0, 0), b2, voffB); PG8_STAGE(PG8_SB(0, 1), b2 + hstepB, voffB); PG8_STAGE_A(PG8_SA(0, 0), a2, v2, 0, ka2);
            PG8_WAIT_V(8); PG8_WAIT_L(0); PG8_BAR; PG8_MMA(1, 0, At, B0); PG8_MMA(1, 1, At, B1); PG8_BAR; PG8_SCHED;
            PG8_LDB(B0, 1, 0); PG8_LDB(B1, 1, 1); PG8_SCHED; PG8_LDA(At, 1, 0); PG8_STAGE_A(PG8_SA(0, 1), a2, v2, 1, ka2);
            PG8_WAIT_V(8); PG8_WAIT_L(0); PG8_BAR; PG8_MMA(0, 0, At, B0); PG8_MMA(0, 1, At, B1); PG8_BAR; PG8_SCHED;
            PG8_LDA(At, 1, 1); PG8_STAGE(PG8_SB(1, 0), b3, voffB); PG8_STAGE(PG8_SB(1, 1), b3 + hstepB, voffB); PG8_STAGE_A(PG8_SA(1, 0), a2, v2, 0, ka3);
            PG8_WAIT_V(8); PG8_WAIT_L(0); PG8_BAR; PG8_MMA(1, 0, At, B0); PG8_MMA(1, 1, At, B1); PG8_BAR; PG8_SCHED;
        }
        if (wr == 0) PG8_BAR;
        { int fr_ = fr, fq_ = fq; asm volatile("" : "+v"(fr_), "+v"(fq_));
          EpiApply<Epi, PAIR>::run(E, acc, cur, wr, wc, fr_, fq_);
#ifdef PROBE_DUP_EPI
          if (!Epi::INPLACE) { asm volatile("" : "+v"(fr_), "+v"(fq_)); EpiApply<Epi, PAIR>::run(E, acc, cur, wr, wc, fr_, fq_); }
#endif
          }
        if (!has_next) break;
#pragma unroll
        for (int a = 0; a < 2; ++a)
#pragma unroll
            for (int b = 0; b < 2; ++b)
#pragma unroll
                for (int m = 0; m < 4; ++m)
#pragma unroll
                    for (int n = 0; n < 2; ++n) acc[a][b][m][n] = (f32x4){0.f, 0.f, 0.f, 0.f};
        cur = nxt; cA = nA; cB = nB; ++ui;
        if (GATHER) {
#pragma unroll
            for (int h = 0; h < 2; ++h)
#pragma unroll
                for (int i = 0; i < 2; ++i) vgc[h][i] = vgn[h][i];
        }
        if (wr == 1) PG8_BAR;
    }
    PG8_WAIT_V(0);
    PG8_BAR;
#undef PG8_SA
#undef PG8_SB
#undef PG8_STAGE
#undef PG8_STAGE_A
#undef PG8_LDA
#undef PG8_LDB
#undef PG8_MMA
#undef PG8_WAIT_V
#undef PG8_WAIT_L
#undef PG8_BAR
#undef PG8_SCHED
}
template <class Epi> struct EpiApply<Epi, false> {
    static __device__ __forceinline__ void run(const Epi& E, const f32x4 (&acc)[2][2][4][2], const Unit& u, int wr, int wc, int fr, int fq) {
#pragma unroll
        for (int ai = 0; ai < 2; ++ai) {
            typename Epi::Pre pre[4][2];
#pragma unroll
            for (int m = 0; m < 4; ++m) { const int row = u.pm * BM + ai * HALF + wr * 64 + m * 16 + fr;
#pragma unroll
                for (int bj = 0; bj < 2; ++bj) pre[m][bj] = E.pre(u, row, u.pn * BM + bj * HALF + wc * 32 + (Epi::PERM ? 8 : 4) * fq); }
#pragma unroll
            for (int m = 0; m < 4; ++m) { const int row = u.pm * BM + ai * HALF + wr * 64 + m * 16 + fr;
#pragma unroll
                for (int bj = 0; bj < 2; ++bj) {
                    if constexpr (Epi::PERM) E.fin8(u, row, u.pn * BM + bj * HALF + wc * 32 + 8 * fq, acc[ai][bj][m][0], acc[ai][bj][m][1], pre[m][bj]);
                    else E.fin4x2(u, row, u.pn * BM + bj * HALF + wc * 32 + 4 * fq, acc[ai][bj][m][0], acc[ai][bj][m][1], pre[m][bj]); } }
        }
    }
};
template <class Epi> struct EpiApply<Epi, true> {
    static __device__ __forceinline__ void run(const Epi& E, const f32x4 (&acc)[2][2][4][2], const Unit& u, int wr, int wc, int fr, int fq) {
#pragma unroll
        for (int ai = 0; ai < 2; ++ai)
#pragma unroll
            for (int m = 0; m < 4; ++m) { const int row = u.pm * BM + ai * HALF + wr * 64 + m * 16 + fr;
                E.putp8(u, row, u.pn * HALF + wc * 32 + 8 * fq, acc[ai][0][m][0], acc[ai][0][m][1], acc[ai][1][m][0], acc[ai][1][m][1]); }
    }
};
}

__device__ __forceinline__ void rowstat_pass(Frame& F, int r_first, int r_stride, int r_end) {
    const bf16_t* H = (const bf16_t*)(F.ws + WS_H); float* rstd = (float*)(F.ws + WS_RSTD);
    for (int m = r_first; m < r_end; m += r_stride) {
        const bf16_t* hr = H + (size_t)m * HP;
        const u32x2 q = *((const u32x2*)(hr + HC_CQ_LAT) + F.lane);
        const unsigned kv = *((const unsigned*)(hr + HC_CKV) + F.lane);
        float a0 = bf2f(q.x & 0xffff), a1 = bf2f(q.x >> 16), a2 = bf2f(q.y & 0xffff), a3 = bf2f(q.y >> 16), b0 = bf2f(kv & 0xffff), b1 = bf2f(kv >> 16);
        const float sq = wave_sum(a0 * a0 + a1 * a1 + a2 * a2 + a3 * a3), sk = wave_sum(b0 * b0 + b1 * b1);
        if (F.lane == 0) { rstd[2 * m] = 1.0f / sqrtf(sq * (1.0f / 256.0f) + RMS_EPS); rstd[2 * m + 1] = 1.0f / sqrtf(sk * (1.0f / 128.0f) + RMS_EPS); }
    }
}
__device__ __forceinline__ void red8(float (&v)[8], int lane) {
    float a[4], b[2], c;
#pragma unroll
    for (int i = 0; i < 4; ++i) a[i] = xpair32(v[i], v[i + 4]);
    { const bool up = (lane & 16) != 0;
#pragma unroll
      for (int i = 0; i < 2; ++i) { const float send = up ? a[i] : a[i + 2], keep = up ? a[i + 2] : a[i]; b[i] = keep + shx<16>(send); } }
    { const bool up = (lane & 8) != 0; const float send = up ? b[0] : b[1], keep = up ? b[1] : b[0]; c = keep + shx<8>(send); }
    c += shx<4>(c); c += shx<2>(c); c += shx<1>(c);
#pragma unroll
    for (int i = 0; i < 8; ++i) v[i] = __uint_as_float(__builtin_amdgcn_readlane(__float_as_uint(c), ((i >> 2) & 1) * 32 + ((i >> 1) & 1) * 16 + (i & 1) * 8));
}
__device__ __forceinline__ void red4(float (&v)[4], int lane) {
    float a[2], c;
#pragma unroll
    for (int i = 0; i < 2; ++i) a[i] = xpair32(v[i], v[i + 2]);
    { const bool up = (lane & 16) != 0; const float send = up ? a[0] : a[1], keep = up ? a[1] : a[0]; c = keep + shx<16>(send); }
    c += shx<8>(c); c += shx<4>(c); c += shx<2>(c); c += shx<1>(c);
#pragma unroll
    for (int i = 0; i < 4; ++i) v[i] = __uint_as_float(__builtin_amdgcn_readlane(__float_as_uint(c), ((i >> 1) & 1) * 32 + (i & 1) * 16));
}
__device__ __forceinline__ void ln1_route_pass(Frame& F, const Args& a, int layer, int r_first, int r_stride, int r_end) {
    bf16_t* XB = (bf16_t*)(F.ws + WS_XB); float* tw = (float*)(F.ws + WS_TW); int* list = (int*)(F.ws + WS_LIST);
    const float* g = a.ln1_g + layer * DM; const float* bb = a.ln1_b + layer * DM;
    const float* wc = a.moe_w_coarse + (size_t)layer * DM * 4; const float* wf = a.moe_w_fine + (size_t)layer * 4 * DM * 8;
    for (int q = F.tid; q < 4 * 1024 * 2; q += NTHREADS) { const int hf = q & 1, k = (q >> 1) & 1023, gg = q >> 11; const int l = (k & 255) >> 2, e = k & 3, j = k >> 8;
        *(LAS f32x4*)(F.lds + (size_t)(gg * 2048 + ((j * 4 + e) * 2 + hf) * 64 + l) * 16) = *((const f32x4*)wf + q); }
    f32x4 wcr[4][4];
#pragma unroll
    for (int j = 0; j < 4; ++j)
#pragma unroll
        for (int e = 0; e < 4; ++e) wcr[j][e] = *(const f32x4*)(wc + (size_t)(4 * F.lane + 256 * j + e) * 4);
    __syncthreads();
    LAS int* lcnt = (LAS int*)(F.lds + RING_BYTES + 1024); LAS int* lbase = lcnt + 32; LAS int* rec_er = lcnt + 64; LAS int* rec_a = rec_er + 512;
  for (int c_first = r_first; c_first < r_end; c_first += 32 * r_stride) {
    const int c_end = (c_first + 32 * r_stride < r_end) ? c_first + 32 * r_stride : r_end;
    if (F.tid < 32) lcnt[F.tid] = 0;
    for (int q = F.tid; q < 512; q += NTHREADS) rec_a[q] = -1;
    __syncthreads();
    f32x4 vn[2][4];
#pragma unroll
    for (int rr = 0; rr < 2; ++rr) { const int mm = c_first + rr * r_stride; if (mm < c_end) {
#pragma unroll
        for (int j = 0; j < 4; ++j) vn[rr][j] = *((const f32x4*)(a.out + (size_t)mm * DM) + F.lane + 64 * j); } }
    for (int m0 = c_first; m0 < c_end; m0 += 2 * r_stride) {
        f32x4 vc[2][4];
#pragma unroll
        for (int rr = 0; rr < 2; ++rr)
#pragma unroll
            for (int j = 0; j < 4; ++j) vc[rr][j] = vn[rr][j];
#pragma unroll
        for (int rr = 0; rr < 2; ++rr) { const int mm = m0 + (2 + rr) * r_stride; if (mm < c_end) {
#pragma unroll
            for (int j = 0; j < 4; ++j) vn[rr][j] = *((const f32x4*)(a.out + (size_t)mm * DM) + F.lane + 64 * j); } }
#pragma unroll
      for (int rr = 0; rr < 2; ++rr) { const int m = m0 + rr * r_stride; if (m < c_end) {
        f32x4 v[4]; float s = 0.f;
#pragma unroll
        for (int j = 0; j < 4; ++j) { v[j] = vc[rr][j]; s += (v[j].x + v[j].y) + (v[j].z + v[j].w); }
        const float mean = wave_sum(s) * (1.f / DM); float s2 = 0.f;
#pragma unroll
        for (int j = 0; j < 4; ++j) { v[j] = v[j] - mean; s2 += (v[j].x * v[j].x + v[j].y * v[j].y) + (v[j].z * v[j].z + v[j].w * v[j].w); }
        const float rs = 1.f / sqrtf(wave_sum(s2) * (1.f / DM) + LN_EPS);
        float cl[4] = {0.f, 0.f, 0.f, 0.f};
#pragma unroll
        for (int j = 0; j < 4; ++j) { const int c = 4 * F.lane + 256 * j; const f32x4 gg = *(const f32x4*)(g + c), bv = *(const f32x4*)(bb + c); v[j] = v[j] * rs * gg + bv;
            u32x2 w; w.x = pk2(v[j].x, v[j].y); w.y = pk2(v[j].z, v[j].w); *((u32x2*)(XB + (size_t)m * DM) + F.lane + 64 * j) = w;
#pragma unroll
            for (int e = 0; e < 4; ++e) { const f32x4 w4 = wcr[j][e]; const float xe = v[j][e]; cl[0] += xe * w4.x; cl[1] += xe * w4.y; cl[2] += xe * w4.z; cl[3] += xe * w4.w; } }
        red4(cl, F.lane);
        int grp = 0; float cm = cl[0];
#pragma unroll
        for (int e = 1; e < 4; ++e) if (cl[e] > cm) { cm = cl[e]; grp = e; }
        float den = 0.f;
#pragma unroll
        for (int e = 0; e < 4; ++e) den += __expf(cl[e] - cm);
        const float pg = 1.0f / den;
        grp = __builtin_amdgcn_readfirstlane(grp);
        const LAS f32x4* wl = (const LAS f32x4*)(F.lds) + grp * 2048 + F.lane;
        float fl[8] = {0.f, 0.f, 0.f, 0.f, 0.f, 0.f, 0.f, 0.f};
#pragma unroll
        for (int j = 0; j < 4; ++j)
#pragma unroll
            for (int e = 0; e < 4; ++e) { const f32x4 wa = wl[((j * 4 + e) * 2) * 64], wb = wl[((j * 4 + e) * 2 + 1) * 64]; const float xe = v[j][e];
                fl[0] += xe * wa.x; fl[1] += xe * wa.y; fl[2] += xe * wa.z; fl[3] += xe * wa.w; fl[4] += xe * wb.x; fl[5] += xe * wb.y; fl[6] += xe * wb.z; fl[7] += xe * wb.w; }
        red8(fl, F.lane);
        int i0 = 0; float v0 = fl[0];
#pragma unroll
        for (int e = 1; e < 8; ++e) if (fl[e] > v0) { v0 = fl[e]; i0 = e; }
        int i1 = -1; float v1 = -3.0e38f;
#pragma unroll
        for (int e = 0; e < 8; ++e) if (e != i0 && fl[e] > v1) { v1 = fl[e]; i1 = e; }
        const float e1 = __expf(v1 - v0), w0 = pg / (1.0f + e1), w1 = pg * e1 / (1.0f + e1);
        if (F.lane < 2) { const int e = grp * 8 + (F.lane == 0 ? i0 : i1); const int a_id = 2 * m + F.lane;
            const int lr = __hip_atomic_fetch_add(lcnt + e, 1, __ATOMIC_RELAXED, __HIP_MEMORY_SCOPE_WORKGROUP);
            const int ri = (((m - c_first) / r_stride) * NWAVES + F.wave) * 2 + F.lane;
            rec_er[ri] = (e << 16) | lr; rec_a[ri] = a_id; tw[a_id] = (F.lane == 0) ? w0 : w1; }
          } }
    }
    __syncthreads();
    if (F.tid < 32) { const int n = lcnt[F.tid]; lbase[F.tid] = n ? (int)__hip_atomic_fetch_add(F.ctl + CW_CNT + layer * 64 + F.tid, (unsigned)n, RLX_AGENT) : 0; }
    __syncthreads();
    for (int q = F.tid; q < 512; q += NTHREADS) { const int aid = rec_a[q]; if (aid >= 0) { const int er = rec_er[q], e = er >> 16; list[(size_t)e * LIST_CAP + lbase[e] + (er & 0xffff)] = aid; } }
    __syncthreads();
  }
    __syncthreads();
}
__device__ __forceinline__ void ln2_pass(Frame& F, const Args& a, int layer, int r_first, int r_stride, int r_end) {
    bf16_t* XB = (bf16_t*)(F.ws + WS_XB); const bf16_t* YB = (const bf16_t*)(F.ws + WS_YB);
    const float* g = a.ln2_g + layer * DM; const float* bb = a.ln2_b + layer * DM; const float* g1 = a.ln1_g + layer * DM; const float* b1 = a.ln1_b + layer * DM;
    f32x4 xn[2][4]; u32x2 pn[2][4], qn[2][4];
#define LN2_LOAD(rr, mm) do { const bf16_t* y0_ = YB + (size_t)(2 * (mm)) * DM; _Pragma("unroll") for (int j = 0; j < 4; ++j) { xn[rr][j] = *((const f32x4*)(a.out + (size_t)(mm) * DM) + F.lane + 64 * j); \
        pn[rr][j] = *((const u32x2*)y0_ + F.lane + 64 * j); qn[rr][j] = *((const u32x2*)(y0_ + DM) + F.lane + 64 * j); } } while (0)
#pragma unroll
    for (int rr = 0; rr < 2; ++rr) { const int mm = r_first + rr * r_stride; if (mm < r_end) LN2_LOAD(rr, mm); }
    for (int m0 = r_first; m0 < r_end; m0 += 2 * r_stride) {
        f32x4 xc[2][4]; u32x2 pc[2][4], qc[2][4];
#pragma unroll
        for (int rr = 0; rr < 2; ++rr)
#pragma unroll
            for (int j = 0; j < 4; ++j) { xc[rr][j] = xn[rr][j]; pc[rr][j] = pn[rr][j]; qc[rr][j] = qn[rr][j]; }
#pragma unroll
        for (int rr = 0; rr < 2; ++rr) { const int mm = m0 + (2 + rr) * r_stride; if (mm < r_end) LN2_LOAD(rr, mm); }
#pragma unroll
        for (int rr = 0; rr < 2; ++rr) { const int m = m0 + rr * r_stride; if (m < r_end) {
            float* xr = a.out + (size_t)m * DM;
            f32x4 v[4]; float s = 0.f;
            { float s1 = 0.f;
#pragma unroll
              for (int j = 0; j < 4; ++j) { v[j] = xc[rr][j]; s1 += (v[j].x + v[j].y) + (v[j].z + v[j].w); }
              const float mean1 = wave_sum(s1) * (1.f / DM); float q1 = 0.f;
#pragma unroll
              for (int j = 0; j < 4; ++j) { v[j] = v[j] - mean1; q1 += (v[j].x * v[j].x + v[j].y * v[j].y) + (v[j].z * v[j].z + v[j].w * v[j].w); }
              const float rs1 = 1.f / sqrtf(wave_sum(q1) * (1.f / DM) + LN_EPS);
#pragma unroll
              for (int j = 0; j < 4; ++j) { const int c = 4 * F.lane + 256 * j; xc[rr][j] = v[j] * rs1 * *(const f32x4*)(g1 + c) + *(const f32x4*)(b1 + c); } }
#pragma unroll
            for (int j = 0; j < 4; ++j) { v[j] = xc[rr][j] * DN_ALPHA; const u32x2 p = pc[rr][j], q = qc[rr][j];
                v[j].x += bf2f(p.x & 0xffff) + bf2f(q.x & 0xffff); v[j].y += bf2f(p.x >> 16) + bf2f(q.x >> 16); v[j].z += bf2f(p.y & 0xffff) + bf2f(q.y & 0xffff); v[j].w += bf2f(p.y >> 16) + bf2f(q.y >> 16);
                s += (v[j].x + v[j].y) + (v[j].z + v[j].w); }
            const float mean = wave_sum(s) * (1.f / DM); float s2 = 0.f;
#pragma unroll
            for (int j = 0; j < 4; ++j) { v[j] = v[j] - mean; s2 += (v[j].x * v[j].x + v[j].y * v[j].y) + (v[j].z * v[j].z + v[j].w * v[j].w); }
            const float rs = 1.f / sqrtf(wave_sum(s2) * (1.f / DM) + LN_EPS);
#pragma unroll
            for (int j = 0; j < 4; ++j) { const int c = 4 * F.lane + 256 * j; const f32x4 gg = *(const f32x4*)(g + c), bv = *(const f32x4*)(bb + c); v[j] = v[j] * rs * gg + bv;
                *((f32x4*)xr + F.lane + 64 * j) = v[j];
                if (layer + 1 < DEPTH) { u32x2 w; w.x = pk2(v[j].x, v[j].y); w.y = pk2(v[j].z, v[j].w); *((u32x2*)(XB + (size_t)m * DM) + F.lane + 64 * j) = w; } }
        } }
    }
#undef LN2_LOAD
}
__device__ __forceinline__ void moe_convert(Frame& F, const Args& a, int layer) {
    LAS float* scr = (LAS float*)(F.lds + F.wave * 16384);
    constexpr int I_13 = (1024 / 64) * (1024 / 32), I_2 = (512 / 64) * (1024 / 32), PER_E = I_13 + I_2;
    for (int it = F.gw; it < NEXP * PER_E; it += F.NGW) {
        const int e = it / PER_E; int r = it - e * PER_E; const size_t le = (size_t)layer * NEXP + e;
        if (r < I_13) { const int kb = r / 32, nb = r % 32; const float* src = ((nb >> 2) & 1) ? a.moe_w3 : a.moe_w1;
            const int sc0 = ((32 * nb) >> 8) * 128 + ((32 * nb) & 127);
            transpose_item_v4(src + le * 1024 * 512 + (size_t)(kb * 64) * 512 + sc0, 512, (bf16_t*)(F.ws + WS_W13) + (size_t)e * 1024 * 1024 + (size_t)(nb * 32) * 1024 + kb * 64, 1024, scr, F.lane); }
        else { r -= I_13; const int kb = r / 32, nb = r % 32;
            transpose_item_v4(a.moe_w2 + le * 512 * 1024 + (size_t)(kb * 64) * 1024 + nb * 32, 1024, (bf16_t*)(F.ws + WS_W2) + (size_t)e * 1024 * 512 + (size_t)(nb * 32) * 512 + kb * 64, 512, scr, F.lane); }
    }
}

typedef short at_s16x4 __attribute__((ext_vector_type(4)));
typedef LAS const unsigned char* at_lds_cptr;
__device__ __forceinline__ at_s16x4 at_vtr(at_lds_cptr p) { return __builtin_bit_cast(at_s16x4, __builtin_amdgcn_ds_read_tr16_b64_v4i16((LAS at_s16x4*)p)); }
struct RowSrc { const bf16_t* p; long pitch; };
constexpr int SA_P = 0, SA_V = 4096, SA_AL = 12288, SA_RL = 12544;
template <int NC0, int NC1, int MODE>
__device__ __forceinline__ void sattn_core(const bf16x8* qf, RowSrc k0, RowSrc k1, RowSrc vs, int kb_lo, int kb_hi, int qidx0, float lse_ref, LAS unsigned char* scr, int lane, f32x16* o, float& lse_out) {
    const int r32 = lane & 31, hi = lane >> 5;
    LAS bf16_t* Pb = (LAS bf16_t*)(scr + SA_P); LAS bf16_t* Vb = (LAS bf16_t*)(scr + SA_V); LAS float* Al = (LAS float*)(scr + SA_AL);
    float m = -1.0e30f, l = 0.f;
    if (MODE != 1) { o[0] = f32x16{}; o[1] = f32x16{}; }
    bf16x8 kn[NC0 + NC1]; u32x4 vn[4];
#define SA_LOAD(kb_) do { const long key_ = (long)(kb_) * 32 + r32; \
        _Pragma("unroll") for (int c = 0; c < NC0; ++c) kn[c] = *(const bf16x8*)(k0.p + key_ * k0.pitch + 16 * c + 8 * hi); \
        _Pragma("unroll") for (int c = 0; c < NC1; ++c) kn[NC0 + c] = *(const bf16x8*)(k1.p + key_ * k1.pitch + 16 * c + 8 * hi); \
        if (MODE != 1) { _Pragma("unroll") for (int i = 0; i < 4; ++i) { const int idx = i * 64 + lane, kr = idx >> 3, pc = idx & 7; vn[i] = *(const u32x4*)(vs.p + ((long)(kb_) * 32 + kr) * vs.pitch + pc * 8); } } } while (0)
    if (kb_lo < kb_hi) SA_LOAD(kb_lo);
    const at_lds_cptr vtb = (at_lds_cptr)(scr + SA_V) + ((8 * hi + ((lane & 15) >> 2)) * 72 + 16 * ((lane >> 4) & 1) + 4 * (lane & 3)) * 2;
    for (int kb = kb_lo; kb < kb_hi; ++kb) {
        bf16x8 kc[NC0 + NC1]; u32x4 vc[4];
#pragma unroll
        for (int c = 0; c < NC0 + NC1; ++c) kc[c] = kn[c];
#pragma unroll
        for (int i = 0; i < 4; ++i) vc[i] = vn[i];
        if (kb + 1 < kb_hi) SA_LOAD(kb + 1);
        f32x16 s = {};
#pragma unroll
        for (int c = 0; c < NC0 + NC1; ++c) s = MFMA32(kc[c], qf[c], s);
        bool valid[16];
#pragma unroll
        for (int r = 0; r < 16; ++r) { if (MODE == 0) valid[r] = true; else { const int d = kb * 32 + crow(r, hi) - (qidx0 + r32); valid[r] = (d <= 64 && d >= -64); } }
        float p[16];
        if (MODE == 2) {
#pragma unroll
            for (int r = 0; r < 16; ++r) p[r] = valid[r] ? fast_exp2(s[r] - lse_ref) : 0.f;
        } else {
            float mx = -1.0e30f;
#pragma unroll
            for (int r = 0; r < 16; ++r) if (valid[r]) mx = fmaxf(mx, s[r]);
            mx = xmax32(mx);
            const float mn = fmaxf(m, mx), alpha = fast_exp2(m - mn); m = mn;
            float ps = 0.f;
#pragma unroll
            for (int r = 0; r < 16; ++r) { p[r] = valid[r] ? fast_exp2(s[r] - mn) : 0.f; ps += p[r]; }
            l = l * alpha + ps;
            if (MODE == 0) { if (hi == 0) Al[r32] = alpha; }
        }
        if (MODE != 1) {
#pragma unroll
            for (int g = 0; g < 4; ++g) { u32x2 w; w.x = pk2(p[4 * g], p[4 * g + 1]); w.y = pk2(p[4 * g + 2], p[4 * g + 3]); *(LAS u32x2*)(Pb + r32 * 40 + 8 * g + 4 * hi) = w; }
#pragma unroll
            for (int i = 0; i < 4; ++i) { const int idx = i * 64 + lane, kr = idx >> 3, pc = idx & 7; *(LAS u32x4*)(Vb + kr * 72 + pc * 8) = vc[i]; }
            LDS_WAIT();
            if (MODE == 0) {
#pragma unroll
                for (int r = 0; r < 16; ++r) { const float al = Al[crow(r, hi)]; o[0][r] *= al; o[1][r] *= al; }
            }
#pragma unroll
            for (int st = 0; st < 2; ++st) {
                const bf16x8 pf = *(const LAS bf16x8*)(Pb + r32 * 40 + 16 * st + 8 * hi);
#pragma unroll
                for (int db = 0; db < 2; ++db) {
                    const at_s16x4 lo_ = at_vtr(vtb + (16 * st * 72 + 32 * db) * 2), hi_ = at_vtr(vtb + ((16 * st + 4) * 72 + 32 * db) * 2);
                    const bf16x8 vf = {lo_[0], lo_[1], lo_[2], lo_[3], hi_[0], hi_[1], hi_[2], hi_[3]};
                    o[db] = MFMA32(pf, vf, o[db]); }
            }
            LDS_WAIT();
        }
    }
#undef SA_LOAD
    if (MODE != 2) { l = xsum32(l); lse_out = m + __log2f(l); }
    if (MODE == 0) {
        LAS float* Rl = (LAS float*)(scr + SA_RL);
        if (hi == 0) Rl[r32] = 1.0f / l;
        LDS_WAIT();
#pragma unroll
        for (int r = 0; r < 16; ++r) { const float rl = Rl[crow(r, hi)]; o[0][r] *= rl; o[1][r] *= rl; }
        LDS_WAIT();
    }
}

__device__ __forceinline__ void sattn_phase(Frame& F, const Args& a, int layer, int kind_lo) {
    const bf16_t* H = (const bf16_t*)(F.ws + WS_H); const bf16_t* QB = (const bf16_t*)(F.ws + WS_QB); const bf16_t* KVB = (const bf16_t*)(F.ws + WS_KVB);
    bf16_t* MIX = (bf16_t*)(F.ws + WS_MIX); const float* lsec = (const float*)(F.ws + WS_LSEC);
    LAS unsigned char* scr = F.lds + F.wave * 16384;
    const int lane = F.lane, r32 = lane & 31, hi = lane >> 5;
    float lam, lam_init;
    { const float* lv = a.diff_lambda + layer * 128; float d1 = 0.f, d2 = 0.f;
      for (int i = 0; i < 32; ++i) { d1 += lv[i] * lv[32 + i]; d2 += lv[64 + i] * lv[96 + i]; }
      lam_init = 0.8f - 0.6f * expf(-0.3f * (float)layer); lam = expf(d1) - expf(d2) + lam_init; }
    constexpr int NRB = NTOK / 32;
    const int items = NRB * (4 + 6 + 6);
    for (int it = kind_lo * NRB + F.gw; it < items; it += F.NGW) {
        const int kind = it / NRB, rb = it - kind * NRB; const int m0 = rb * 32; const SeqInfo si = seqinfo(m0);
#if !OPT_ATTN
        if (kind < 4) {
            const int h = kind; f32x16 o0[2], o1[2]; float dummy;
            for (int c = 0; c < 2; ++c) {
                bf16x8 qf[2];
#pragma unroll
                for (int d0 = 0; d0 < 2; ++d0) qf[d0] = *(const bf16x8*)(H + (size_t)(m0 + r32) * HP + HC_AQ + h * 64 + c * 32 + 16 * d0 + 8 * hi);
                const RowSrc ks{H + (size_t)si.base * HP + HC_AK + h * 64 + c * 32, HP}, vs{H + (size_t)si.base * HP + HC_AV + h * 64, HP};
                sattn_core<2, 0, 0>(qf, ks, ks, vs, 0, si.len / 32, 0, 0.f, scr, lane, c == 0 ? o0 : o1, dummy);
            }
            const float* sg = a.diff_subln + layer * 64; const float g0 = sg[r32], g1 = sg[32 + r32];
#pragma unroll
            for (int r = 0; r < 16; ++r) { const float x0 = o0[0][r] - lam * o1[0][r], x1 = o0[1][r] - lam * o1[1][r]; float ss = x0 * x0 + x1 * x1;
                ss += shx<1>(ss); ss += shx<2>(ss); ss += shx<4>(ss); ss += shx<8>(ss); ss += shx<16>(ss);
                const float rs = (1.0f - lam_init) / sqrtf(ss * (1.0f / 64.0f) + RMS_EPS);
                bf16_t* op = MIX + (size_t)(m0 + crow(r, hi)) * DM + MIX_A + h * 64 + r32;
                op[0] = (bf16_t)f2bf(x0 * rs * g0); op[32] = (bf16_t)f2bf(x1 * rs * g1); }
        } else if (kind < 10) {
            const int h = kind - 4; f32x16 o[2]; float dummy; bf16x8 qf[6];
#pragma unroll
            for (int d0 = 0; d0 < 6; ++d0) qf[d0] = *(const bf16x8*)(QB + (size_t)(m0 + r32) * QBP + h * 96 + 16 * d0 + 8 * hi);
            const RowSrc k0{KVB + (size_t)si.base * KVP + h * 128, KVP}, k1{H + (size_t)si.base * HP + HC_KROPE, HP}, vs{KVB + (size_t)si.base * KVP + h * 128 + 64, KVP};
            sattn_core<4, 2, 0>(qf, k0, k1, vs, 0, si.len / 32, 0, 0.f, scr, lane, o, dummy);
#pragma unroll
            for (int r = 0; r < 16; ++r) { bf16_t* op = MIX + (size_t)(m0 + crow(r, hi)) * DM + MIX_B + h * 64 + r32; op[0] = (bf16_t)f2bf(o[0][r]); op[32] = (bf16_t)f2bf(o[1][r]); }
        } else
#endif
        {
            const int gj = kind - 10, g = gj >> 1, hh = gj;
            const int dil = (g == 0) ? 1 : (g == 1 ? 4 : 16); const int L = si.len / dil, bpr = L / 32;
            const int w = (m0 - si.base) / 32, rho = w / bpr, ib = w - rho * bpr, i0 = ib * 32;
            const size_t qrow = (size_t)si.base + (size_t)(i0 + r32) * dil + rho;
            bf16x8 qf[4];
#pragma unroll
            for (int d0 = 0; d0 < 4; ++d0) qf[d0] = *(const bf16x8*)(H + qrow * HP + HC_CQ + hh * 64 + 16 * d0 + 8 * hi);
            const int j = gj & 1; const float l0 = lsec[(0 * (size_t)NTOK + qrow) * 2 + j], l1 = lsec[(1 * (size_t)NTOK + qrow) * 2 + j], l2 = lsec[(2 * (size_t)NTOK + qrow) * 2 + j];
            const float lm = fmaxf(l0, fmaxf(l1, l2)); const float lref = lm + __log2f(fast_exp2(l0 - lm) + fast_exp2(l1 - lm) + fast_exp2(l2 - lm));
            const RowSrc ks{H + ((size_t)si.base + rho) * HP + HC_CK + hh * 64, (long)HP * dil}, vs{H + ((size_t)si.base + rho) * HP + HC_CV + hh * 64, (long)HP * dil};
            int kb_lo = ib - 2, kb_hi = ib + 3; if (kb_lo < 0) kb_lo = 0; if (kb_hi > bpr) kb_hi = bpr;
            f32x16 o[2]; float dummy;
            sattn_core<4, 0, 2>(qf, ks, ks, vs, kb_lo, kb_hi, i0, lref, scr, lane, o, dummy);
#pragma unroll
            for (int r = 0; r < 16; ++r) { const size_t orow = (size_t)si.base + (size_t)(i0 + crow(r, hi)) * dil + rho; bf16_t* op = MIX + orow * DM + MIX_C + hh * 64 + r32; op[0] = (bf16_t)f2bf(o[0][r]); op[32] = (bf16_t)f2bf(o[1][r]); }
        }
    }
}
__device__ __forceinline__ void cstat_phase(Frame& F) {
    const bf16_t* H = (const bf16_t*)(F.ws + WS_H); float* lsec = (float*)(F.ws + WS_LSEC);
    LAS unsigned char* scr = F.lds + F.wave * 16384;
    const int lane = F.lane, r32 = lane & 31, hi = lane >> 5;
    constexpr int NRB = NTOK / 32;
    for (int it = F.gw; it < NRB * 6; it += F.NGW) {
        const int gj = it / NRB, rb = it - gj * NRB, g = gj >> 1, j = gj & 1; const int m0 = rb * 32; const SeqInfo si = seqinfo(m0);
        const int dil = (g == 0) ? 1 : (g == 1 ? 4 : 16); const int L = si.len / dil, bpr = L / 32;
        const int w = (m0 - si.base) / 32, rho = w / bpr, ib = w - rho * bpr, i0 = ib * 32;
        const size_t qrow = (size_t)si.base + (size_t)(i0 + r32) * dil + rho;
        bf16x8 qf[4];
#pragma unroll
        for (int d0 = 0; d0 < 4; ++d0) qf[d0] = *(const bf16x8*)(H + qrow * HP + HC_CQ + gj * 64 + 16 * d0 + 8 * hi);
        const RowSrc ks{H + ((size_t)si.base + rho) * HP + HC_CK + gj * 64, (long)HP * dil};
        int kb_lo = ib - 2, kb_hi = ib + 3; if (kb_lo < 0) kb_lo = 0; if (kb_hi > bpr) kb_hi = bpr;
        float lse; sattn_core<4, 0, 1>(qf, ks, ks, ks, kb_lo, kb_hi, i0, 0.f, scr, lane, nullptr, lse);
        if (hi == 0) lsec[((size_t)g * NTOK + qrow) * 2 + j] = lse;
    }
}


namespace at {
typedef short s16x4 __attribute__((ext_vector_type(4)));
typedef short v4i16_t __attribute__((ext_vector_type(4)));
typedef LAS const unsigned char* lds_cptr;
constexpr int LDS_K = 0, KSLOT_MAX = 12288, LDS_V = 3 * KSLOT_MAX, VSLOT = 8192, LDS_WS = LDS_V + 3 * VSLOT, LDS_OST = LDS_WS + 8 * 256, LDS_TOTAL = LDS_OST + 8 * 8192;
static_assert(LDS_TOTAL <= RING_BYTES, "attention LDS");
constexpr float THR = 8.0f;
__device__ __forceinline__ void glds16(const void* g, unsigned lds_dst) {
    unsigned keep; asm volatile("s_mov_b32 %0, m0\n\ts_mov_b32 m0, %2\n\ts_nop 0\n\tglobal_load_lds_dwordx4 %1, off\n\ts_mov_b32 m0, %0" : "=&s"(keep) : "v"(g), "s"(lds_dst) : "memory"); }
__device__ __forceinline__ s16x4 vtr(lds_cptr p) { return __builtin_bit_cast(s16x4, __builtin_amdgcn_ds_read_tr16_b64_v4i16((LAS v4i16_t*)p)); }
__device__ __forceinline__ unsigned cvtpk(float lo, float hi) { typedef float f2 __attribute__((ext_vector_type(2))); typedef __bf16 b2 __attribute__((ext_vector_type(2))); f2 v = {lo, hi}; b2 b = __builtin_convertvector(v, b2); return __builtin_bit_cast(unsigned, b); }
#define AT_MX3(a, b, c) __builtin_fmaxf(__builtin_fmaxf((a), (b)), (c))
__device__ __forceinline__ float rowmax(const f32x16& p0, const f32x16& p1) {
    float a = AT_MX3(p0[0], p0[1], p1[0]), b = AT_MX3(p0[2], p0[3], p1[1]); a = AT_MX3(a, p1[2], p1[3]);
#pragma unroll
    for (int r = 4; r < 16; r += 4) { a = AT_MX3(a, p0[r], p0[r + 1]); b = AT_MX3(b, p0[r + 2], p0[r + 3]); a = AT_MX3(a, p1[r], p1[r + 1]); b = AT_MX3(b, p1[r + 2], p1[r + 3]); }
    float m = __builtin_fmaxf(a, b); auto rr = __builtin_amdgcn_permlane32_swap(__float_as_uint(m), __float_as_uint(m), false, false);
    return __builtin_fmaxf(__uint_as_float(rr[0]), __uint_as_float(rr[1])); }
#define AT_WAIT_BAR(N) asm volatile("s_waitcnt vmcnt(" #N ") lgkmcnt(0)\n\ts_barrier" ::: "memory")

struct Src { const bf16_t* p; long pitch; };
template <int NC, int NK0, int NK1>
__device__ __forceinline__ void stream(LAS unsigned char* lds, int tid, const bf16_t* qrow, Src k0, Src k1, Src vs, int NT, f32x16& o0, f32x16& o1, float& lsum) {
    asm volatile("" : "+v"(tid));
    constexpr int SLOTK = 2 * NC * 1024;
    const int lane = tid & 63, r32 = lane & 31, hi = lane >> 5; const int wid = __builtin_amdgcn_readfirstlane(tid >> 6);
    const unsigned lds0 = (unsigned)(uintptr_t)lds;
    LAS float* wsf = (LAS float*)(lds + LDS_WS) + wid * 64;
    constexpr int P0 = NK0 * 16;
    const bool hasA = (NK0 == 8) || (wid < 4), hasB = (NK1 > 0) && (wid < 4);
    const int pA = (NK0 == 8) ? wid : (wid & 3);
    const int rowA = (NK0 == 8) ? pA * 8 + (lane >> 3) : pA * 16 + (lane >> 2);
    const int chA = (NK0 == 8) ? ((lane & 7) ^ ((4 * pA + (lane >> 4)) & 7)) : ((lane & 3) ^ ((lane >> 4) & 3));
    const bf16_t* ksA = k0.p + (long)rowA * k0.pitch + chA * 8;
    const int rowB = (wid & 3) * 16 + (lane >> 2), chB = (lane & 3) ^ ((lane >> 4) & 3);
    const bf16_t* ksB = (NK1 > 0) ? k1.p + (long)rowB * k1.pitch + chB * 8 : k0.p;
    const bf16_t* vsp = vs.p + (long)(16 * (wid & 3) + (lane >> 2)) * vs.pitch + (wid >> 2) * 32 + (lane & 3) * 8;
    const unsigned kdA = lds0 + LDS_K + pA * 1024, kdB = lds0 + LDS_K + (NK0 + (wid & 3)) * 1024, vd = lds0 + LDS_V + wid * 1024;
    const long ktA = 64 * k0.pitch, ktB = 64 * k1.pitch, vt = 64 * vs.pitch;
    const int nd = (hasA ? 1 : 0) + (hasB ? 1 : 0) + 1;
#define AT_DMA_K(t, slot) do { if (hasA) glds16(ksA + (long)(t) * ktA, (unsigned)__builtin_amdgcn_readfirstlane(kdA + (slot) * SLOTK)); if (hasB) glds16(ksB + (long)(t) * ktB, (unsigned)__builtin_amdgcn_readfirstlane(kdB + (slot) * SLOTK)); } while (0)
#define AT_DMA_V(t, slot) glds16(vsp + (long)(t) * vt, (unsigned)__builtin_amdgcn_readfirstlane(vd + (slot) * VSLOT))
    lds_cptr kb[NC];
#pragma unroll
    for (int d0 = 0; d0 < NC; ++d0) { const int c = 2 * d0 + hi;
        if (2 * d0 < NK0) kb[d0] = (lds_cptr)lds + LDS_K + r32 * P0 + ((NK0 == 8) ? (c ^ ((r32 >> 1) & 7)) : (c ^ ((r32 >> 2) & 3))) * 16;
        else kb[d0] = (lds_cptr)lds + LDS_K + NK0 * 1024 + r32 * 64 + ((c - NK0) ^ ((r32 >> 2) & 3)) * 16; }
    const lds_cptr vp0 = (lds_cptr)lds + LDS_V + ((lane >> 4) & 1) * 32 + (lane & 3) * 8 + (4 * hi + ((lane & 15) >> 2)) * 64;
    AT_DMA_K(0, 0); AT_DMA_V(0, 0); if (NT > 1) AT_DMA_K(1, 1);
    bf16x8 qr[NC];
#pragma unroll
    for (int d0 = 0; d0 < NC; ++d0) qr[d0] = *(const bf16x8*)(qrow + 16 * d0 + 8 * hi);
    float mhat = 0.f, l = 0.f; f32x16 oa = {}, ob = {}, negm = {}, S0, S1; u32x4 pw0, pw1, pw2, pw3;
    asm volatile("" : "+v"(negm));
    AT_WAIT_BAR(0);
    __builtin_amdgcn_s_waitcnt(0);
#pragma unroll
    for (int d0 = 0; d0 < NC; ++d0) asm volatile("" : "+v"(qr[d0]));
    constexpr int QREG = NC;
    constexpr bool QLDS = (NC > 2);
    const lds_cptr qb = (lds_cptr)lds + LDS_OST + wid * 8192 + lane * 16;
    if (QLDS) {
#pragma unroll
        for (int d0 = 0; d0 < NC; ++d0) *(LAS bf16x8*)(lds + LDS_OST + wid * 8192 + lane * 16 + d0 * 1024) = qr[d0];
        LDS_WAIT();
    }
    int kc = 0, kn1 = 1, kn2 = 2, vpv = 2, vcu = 0, vnx = 1;
    bf16x8 kf[2 * NC], vf[8];
#define AT_SB() __builtin_amdgcn_sched_barrier(0)
#define AT_KRD(so_, d0) do { kf[2 * (d0)] = *(const LAS bf16x8*)(kb[d0] + (so_)); kf[2 * (d0) + 1] = *(const LAS bf16x8*)(kb[d0] + (so_) + 32 * ((2 * (d0) < NK0) ? P0 : 64)); if (QLDS && (d0) >= QREG) qr[d0] = *(const LAS bf16x8*)(qb + (d0) * 1024); } while (0)
#define AT_KHEAD(slot) do { const int kp_ = (slot) * SLOTK; AT_KRD(kp_, 0); if (NC > 1) AT_KRD(kp_, 1); } while (0)
#define AT_VF(i) ({ const s16x4 lo_ = vtr(vp_ + (((i) >> 2) * 4096 + ((i) & 3) * 1024)), hi_ = vtr(vp_ + (((i) >> 2) * 4096 + ((i) & 3) * 1024 + 512)); (bf16x8){lo_[0], lo_[1], lo_[2], lo_[3], hi_[0], hi_[1], hi_[2], hi_[3]}; })
#define AT_VHEAD(slot) do { const lds_cptr vp_ = vp0 + (slot) * VSLOT; vf[0] = AT_VF(0); vf[4] = AT_VF(4); } while (0)
#define AT_QKM(slot) do { const int kp_ = (slot) * SLOTK; \
        _Pragma("unroll") for (int d0 = 0; d0 < NC; ++d0) { if (d0 + 2 < NC) AT_KRD(kp_, d0 + 2); \
            if (d0 == 0) { S0 = MFMA32(kf[0], qr[0], negm); S1 = MFMA32(kf[1], qr[0], negm); } else { S0 = MFMA32(kf[2 * d0], qr[d0], S0); S1 = MFMA32(kf[2 * d0 + 1], qr[d0], S1); } AT_SB(); } } while (0)
#define AT_PVM(slot) do { const lds_cptr vp_ = vp0 + (slot) * VSLOT; \
        vf[1] = AT_VF(1); vf[5] = AT_VF(5); oa = MFMA32(__builtin_bit_cast(bf16x8, pw0), vf[0], oa); ob = MFMA32(__builtin_bit_cast(bf16x8, pw0), vf[4], ob); AT_SB(); \
        vf[2] = AT_VF(2); vf[6] = AT_VF(6); oa = MFMA32(__builtin_bit_cast(bf16x8, pw1), vf[1], oa); ob = MFMA32(__builtin_bit_cast(bf16x8, pw1), vf[5], ob); AT_SB(); \
        vf[3] = AT_VF(3); vf[7] = AT_VF(7); oa = MFMA32(__builtin_bit_cast(bf16x8, pw2), vf[2], oa); ob = MFMA32(__builtin_bit_cast(bf16x8, pw2), vf[6], ob); AT_SB(); \
        oa = MFMA32(__builtin_bit_cast(bf16x8, pw3), vf[3], oa); ob = MFMA32(__builtin_bit_cast(bf16x8, pw3), vf[7], ob); AT_SB(); } while (0)
    bool resc = false; u32x4 qw0, qw1, qw2, qw3; float sacc = 0.f;
#define AT_PIN(x) asm volatile("" : "+v"(x))
#define AT_DECIDE(first) do { const float rm_ = rowmax(S0, S1); resc = false; \
        if ((first) || __any(rm_ > THR)) { const float dl_ = (first) ? rm_ : __builtin_fmaxf(rm_, 0.f); mhat += dl_; \
            _Pragma("unroll") for (int r = 0; r < 16; ++r) { S0[r] -= dl_; S1[r] -= dl_; negm[r] = -mhat; } asm volatile("" : "+v"(negm)); \
            if (!(first)) { const float f_ = fast_exp2(-dl_); l *= f_; if (hi == 0) wsf[r32] = f_; resc = true; } } } while (0)
#define AT_RESC() do { if (resc) { LDS_WAIT(); \
        _Pragma("unroll") for (int r = 0; r < 16; ++r) { const float g_ = wsf[crow(r, hi)]; oa[r] *= g_; ob[r] *= g_; } LDS_WAIT(); } } while (0)
#define AT_EXP8(S, b, Q) do { \
        _Pragma("unroll") for (int r = 0; r < 8; ++r) S[(b) + r] = fast_exp2(S[(b) + r]); \
        sacc += (S[(b)] + S[(b) + 1]) + (S[(b) + 2] + S[(b) + 3]); sacc += (S[(b) + 4] + S[(b) + 5]) + (S[(b) + 6] + S[(b) + 7]); \
        Q = (u32x4){cvtpk(S[(b)], S[(b) + 1]), cvtpk(S[(b) + 2], S[(b) + 3]), cvtpk(S[(b) + 4], S[(b) + 5]), cvtpk(S[(b) + 6], S[(b) + 7])}; AT_PIN(Q); AT_PIN(sacc); } while (0)
#define AT_EXPALL() do { sacc = 0.f; AT_EXP8(S0, 0, qw0); AT_EXP8(S0, 8, qw1); AT_EXP8(S1, 0, qw2); AT_EXP8(S1, 8, qw3); l += sacc; pw0 = qw0; pw1 = qw1; pw2 = qw2; pw3 = qw3; } while (0)
#define AT_PV_EXP(slot, C0, C1, C2, C3, N0, N1, N2, N3) do { const lds_cptr vp_ = vp0 + (slot) * VSLOT; sacc = 0.f; \
        vf[1] = AT_VF(1); vf[5] = AT_VF(5); oa = MFMA32(__builtin_bit_cast(bf16x8, C0), vf[0], oa); ob = MFMA32(__builtin_bit_cast(bf16x8, C0), vf[4], ob); AT_EXP8(S0, 0, N0); AT_SB(); \
        vf[2] = AT_VF(2); vf[6] = AT_VF(6); oa = MFMA32(__builtin_bit_cast(bf16x8, C1), vf[1], oa); ob = MFMA32(__builtin_bit_cast(bf16x8, C1), vf[5], ob); AT_EXP8(S0, 8, N1); AT_SB(); \
        vf[3] = AT_VF(3); vf[7] = AT_VF(7); oa = MFMA32(__builtin_bit_cast(bf16x8, C2), vf[2], oa); ob = MFMA32(__builtin_bit_cast(bf16x8, C2), vf[6], ob); AT_EXP8(S1, 0, N2); AT_SB(); \
        oa = MFMA32(__builtin_bit_cast(bf16x8, C3), vf[3], oa); ob = MFMA32(__builtin_bit_cast(bf16x8, C3), vf[7], ob); AT_EXP8(S1, 8, N3); AT_SB(); \
        l += sacc; } while (0)
#define AT_STEP_WAIT(t) do { if ((t) + 2 < NT) { if (nd == 3) AT_WAIT_BAR(3); else if (nd == 2) AT_WAIT_BAR(2); else AT_WAIT_BAR(1); } else AT_WAIT_BAR(0); } while (0)
#define AT_ROT() do { const int a_ = kc; kc = kn1; kn1 = kn2; kn2 = a_; const int b_ = vpv; vpv = vcu; vcu = vnx; vnx = b_; } while (0)
    AT_DMA_K(2, kn2); AT_DMA_V(1, vnx);
    AT_KHEAD(kc); AT_SB();
    AT_QKM(kc); AT_DECIDE(true); AT_EXPALL();
    AT_STEP_WAIT(0); AT_ROT();
#define AT_STEP(t, C0, C1, C2, C3, N0, N1, N2, N3) do { \
        if ((t) + 2 < NT) AT_DMA_K((t) + 2, kn2); \
        if ((t) + 1 < NT) AT_DMA_V((t) + 1, vnx); \
        AT_KHEAD(kc); AT_VHEAD(vpv); AT_SB(); \
        AT_QKM(kc); \
        AT_DECIDE(false); AT_SB(); \
        AT_PV_EXP(vpv, C0, C1, C2, C3, N0, N1, N2, N3); \
        AT_RESC(); \
        AT_STEP_WAIT(t); AT_ROT(); } while (0)
    int t = 1;
    for (; t + 1 < NT; t += 2) { AT_STEP(t, pw0, pw1, pw2, pw3, qw0, qw1, qw2, qw3); AT_STEP(t + 1, qw0, qw1, qw2, qw3, pw0, pw1, pw2, pw3); }
    if (t < NT) { AT_STEP(t, pw0, pw1, pw2, pw3, qw0, qw1, qw2, qw3); pw0 = qw0; pw1 = qw1; pw2 = qw2; pw3 = qw3; }
#undef AT_STEP
    AT_VHEAD(vpv); AT_SB(); AT_PVM(vpv);
    { auto rr = __builtin_amdgcn_permlane32_swap(__float_as_uint(l), __float_as_uint(l), false, false); l = __uint_as_float(rr[0]) + __uint_as_float(rr[1]); }
    o0 = oa; o1 = ob; lsum = l;
#undef AT_DMA_K
#undef AT_DMA_V
#undef AT_SB
#undef AT_KRD
#undef AT_KHEAD
#undef AT_VF
#undef AT_VHEAD
#undef AT_QKM
#undef AT_PVM
#undef AT_PIN
#undef AT_DECIDE
#undef AT_RESC
#undef AT_EXP8
#undef AT_EXPALL
#undef AT_PV_EXP
#undef AT_STEP_WAIT
#undef AT_ROT
}
__device__ __forceinline__ void normalise(LAS unsigned char* lds, int tid, f32x16& o0, f32x16& o1, float lsum) {
    const int lane = tid & 63, r32 = lane & 31, hi = lane >> 5; const int wid = __builtin_amdgcn_readfirstlane(tid >> 6);
    LAS float* wsf = (LAS float*)(lds + LDS_WS) + wid * 64;
    if (hi == 0) wsf[32 + r32] = 1.0f / lsum; LDS_WAIT();
#pragma unroll
    for (int r = 0; r < 16; ++r) { const float g = wsf[32 + crow(r, hi)]; o0[r] *= g; o1[r] *= g; }
    LDS_WAIT();
}
}

struct AttnUnitId { int kind, seq, head, qb; };
__device__ __forceinline__ bool attn_unit_at(int i, int G, int bid, AttnUnitId& u) {
    const long L = (long)i * G + bid; if (L >= 2560) return false; int o = (int)L;
    int kind, longs, nh;
    if (o < 512) { kind = 0; longs = 1; nh = 4; } else if (o < 1024) { kind = 0; longs = 0; nh = 4; o -= 512; } else if (o < 1792) { kind = 1; longs = 1; nh = 6; o -= 1024; } else { kind = 1; longs = 0; nh = 6; o -= 1792; }
    const int nqb = longs ? 16 : 8;
    int pair, qb;
    if (G == 256) { const int rnd = o >> 8, b = o & 255, x = b & 7, c = b >> 3;
        const int ppr = 32 / nqb; pair = x + 8 * (rnd * ppr + c / nqb); qb = c % nqb; }
    else { pair = o / nqb; qb = o % nqb; }
    u.kind = kind; u.head = pair % nh; const int sq = pair / nh; u.seq = longs ? 16 + sq : sq; u.qb = qb; return true;
}
__device__ __forceinline__ void attn_ab_phase(Frame& F, const Args& a, int layer, int kmask = 3) {
    const bf16_t* H = (const bf16_t*)(F.ws + WS_H); const bf16_t* QB = (const bf16_t*)(F.ws + WS_QB); const bf16_t* KVB = (const bf16_t*)(F.ws + WS_KVB);
    bf16_t* MIX = (bf16_t*)(F.ws + WS_MIX);
    const int wid = F.wave;
    float lam, lam_init;
    { const float* lv = a.diff_lambda + layer * 128; float d1 = 0.f, d2 = 0.f;
      for (int i = 0; i < 32; ++i) { d1 += lv[i] * lv[32 + i]; d2 += lv[64 + i] * lv[96 + i]; }
      lam_init = 0.8f - 0.6f * expf(-0.3f * (float)layer); lam = expf(d1) - expf(d2) + lam_init;
      lam = __uint_as_float(__builtin_amdgcn_readfirstlane(__float_as_uint(lam))); lam_init = __uint_as_float(__builtin_amdgcn_readfirstlane(__float_as_uint(lam_init))); }
    AttnUnitId u;
    for (int i = 0; attn_unit_at(i, F.G, F.bid, u); ++i) {
        if (!((kmask >> u.kind) & 1)) continue;
        int tid = F.tid; asm volatile("" : "+v"(tid)); const int lane = tid & 63, r32 = lane & 31, hi = lane >> 5;
        const int len = (u.seq < 16) ? 2048 : 4096, base = (u.seq < 16) ? u.seq * 2048 : NTOK_P + (u.seq - 16) * 4096, NT = len / 64;
        const int m0 = base + u.qb * 256 + wid * 32;
        LAS bf16_t* sb = (LAS bf16_t*)(F.lds + at::LDS_OST + wid * 8192);
        LAS float* sf = (LAS float*)sb;
        if (u.kind == 0) {
            f32x16 q0, q1; float ls;
            { f32x16 p0, p1; const at::Src ks{H + (size_t)base * HP + HC_AK + u.head * 64, HP}, vs{H + (size_t)base * HP + HC_AV + u.head * 64, HP};
              at::stream<2, 4, 0>(F.lds, tid, H + (size_t)(m0 + r32) * HP + HC_AQ + u.head * 64, ks, ks, vs, NT, p0, p1, ls); at::normalise(F.lds, tid, p0, p1, ls);
#pragma unroll
              for (int r = 0; r < 16; ++r) { const int row = crow(r, hi); sf[row * 64 + r32] = p0[r]; sf[row * 64 + 32 + r32] = p1[r]; }
              AT_WAIT_BAR(0); }
            { const at::Src ks{H + (size_t)base * HP + HC_AK + u.head * 64 + 32, HP}, vs{H + (size_t)base * HP + HC_AV + u.head * 64, HP};
              at::stream<2, 4, 0>(F.lds, tid, H + (size_t)(m0 + r32) * HP + HC_AQ + u.head * 64 + 32, ks, ks, vs, NT, q0, q1, ls); at::normalise(F.lds, tid, q0, q1, ls); }
            float xa[16], xb[16];
#pragma unroll
            for (int r = 0; r < 16; ++r) { const int row = crow(r, hi); xa[r] = sf[row * 64 + r32] - lam * q0[r]; xb[r] = sf[row * 64 + 32 + r32] - lam * q1[r]; }
            LDS_WAIT();
            const float* sg = a.diff_subln + layer * 64; const float g0 = sg[r32] * (1.0f - lam_init), g1 = sg[32 + r32] * (1.0f - lam_init);
#pragma unroll
            for (int r = 0; r < 16; ++r) { const float x0 = xa[r], x1 = xb[r]; float ss = x0 * x0 + x1 * x1;
                ss += shx<1>(ss); ss += shx<2>(ss); ss += shx<4>(ss); ss += shx<8>(ss); ss += shx<16>(ss);
                const float rs = 1.0f / sqrtf(ss * (1.0f / 64.0f) + RMS_EPS); const int row = crow(r, hi);
                sb[row * 64 + r32] = (bf16_t)f2bf(x0 * rs * g0); sb[row * 64 + 32 + r32] = (bf16_t)f2bf(x1 * rs * g1); }
            LDS_WAIT();
#pragma unroll
            for (int it = 0; it < 4; ++it) { const int row = it * 8 + (lane >> 3), ch = lane & 7; *(u32x4*)(MIX + (size_t)(m0 + row) * DM + MIX_A + u.head * 64 + ch * 8) = *(const LAS u32x4*)(sb + row * 64 + ch * 8); }
        } else {
            f32x16 p0, p1; float ls;
            const at::Src k0{KVB + (size_t)base * KVP + u.head * 128, KVP}, k1{H + (size_t)base * HP + HC_KROPE, HP}, vs{KVB + (size_t)base * KVP + u.head * 128 + 64, KVP};
            at::stream<6, 8, 4>(F.lds, tid, QB + (size_t)(m0 + r32) * QBP + u.head * 96, k0, k1, vs, NT, p0, p1, ls); at::normalise(F.lds, tid, p0, p1, ls);
#pragma unroll
            for (int r = 0; r < 16; ++r) { const int row = crow(r, hi); sb[row * 64 + r32] = (bf16_t)f2bf(p0[r]); sb[row * 64 + 32 + r32] = (bf16_t)f2bf(p1[r]); }
            LDS_WAIT();
#pragma unroll
            for (int it = 0; it < 4; ++it) { const int row = it * 8 + (lane >> 3), ch = lane & 7; *(u32x4*)(MIX + (size_t)(m0 + row) * DM + MIX_B + u.head * 64 + ch * 8) = *(const LAS u32x4*)(sb + row * 64 + ch * 8); }
        }
        AT_WAIT_BAR(0);
    }
}

struct ListRows { const int* list; int seg0, cnt; __device__ __forceinline__ int src(int m) const { const int r = m - seg0; return (r < cnt) ? (list[r] >> 1) : 0; } };
__device__ __forceinline__ void moe_segments(Frame& F, int layer, LAS int* seg) {
    if (F.tid == 0) { int acc = 0; for (int e = 0; e < NEXP; ++e) { const int c = (int)__hip_atomic_load(F.ctl + CW_CNT + layer * 64 + e, RLX_AGENT); seg[e] = acc; seg[33 + e] = c; acc += (c + 255) & ~255; } seg[32] = acc; }
    __syncthreads();
}
__device__ __forceinline__ int seg_find(const LAS int* seg, int row) { int e = 0;
#pragma unroll
    for (int s = 16; s > 0; s >>= 1) if (seg[e + s] <= row) e += s;
    return e; }
__device__ __forceinline__ void moe_up_simple(Frame& F, int layer) {
    LAS int* seg = (LAS int*)(F.lds + RING_BYTES); moe_segments(F, layer, seg);
    const bf16_t* XB = (const bf16_t*)(F.ws + WS_XB); const bf16_t* W13 = (const bf16_t*)(F.ws + WS_W13); const int* list = (const int*)(F.ws + WS_LIST);
    const EpiHid E{(bf16_t*)(F.ws + WS_HID)};
    const int items = (seg[32] / 32) * 16;
    for (int it = F.gw; it < items; it += F.NGW) { const int mt = it >> 4, ct = it & 15, m0 = mt * 32, e = seg_find(seg, m0), c0 = ct * 32;
        const ListRows RM{list + (size_t)e * LIST_CAP, seg[e], seg[33 + e]};
        const bf16_t* Bg = W13 + (size_t)e * 1024 * 1024 + (size_t)((c0 >> 7) * 256 + (c0 & 127)) * 1024;
        sg_tile(XB, DM, Bg, Bg + (size_t)128 * 1024, 1024, 1024, m0, c0, E, RM, F.lane); }
    __syncthreads();
}
__device__ __forceinline__ void moe_down_simple(Frame& F, int layer) {
    LAS int* seg = (LAS int*)(F.lds + RING_BYTES); moe_segments(F, layer, seg);
    const bf16_t* HID = (const bf16_t*)(F.ws + WS_HID); const bf16_t* W2 = (const bf16_t*)(F.ws + WS_W2); const int* list = (const int*)(F.ws + WS_LIST);
    const int items = (seg[32] / 32) * 16;
    for (int it = F.gw; it < items; it += F.NGW) { const int mt = it >> 4, ct = it & 15, m0 = mt * 32, e = seg_find(seg, m0), c0 = ct * 64;
        const EpiY E{(bf16_t*)(F.ws + WS_YB), (const float*)(F.ws + WS_TW), list + (size_t)e * LIST_CAP, seg[e], seg[33 + e]};
        const bf16_t* B0 = W2 + (size_t)e * 1024 * 512 + (size_t)c0 * 512;
        sg_tile(HID, DEXP, B0, B0 + (size_t)32 * 512, 512, 512, m0, c0, E, IdRows(), F.lane); }
    __syncthreads();
}


struct MoeUpSched {
    const char* XB; const char* W13; const LAS int* seg; const int* list; int nM, G, c;
    __device__ __forceinline__ bool next(int i, pg8::Unit& u) const { if (!pg8::order_next(i, G, c, nM, 4, u.pm, u.pn)) return false; u.e = __builtin_amdgcn_readfirstlane(seg_find(seg, u.pm * 256)); u.a = XB; u.b = W13 + ((size_t)u.e * 1024 + (size_t)u.pn * 256) * 2048; return true; }
    __device__ __forceinline__ unsigned arow(const pg8::Unit& u, int r) const { const int rr = u.pm * 256 + r - __builtin_amdgcn_readfirstlane(seg[u.e]); return (rr < __builtin_amdgcn_readfirstlane(seg[33 + u.e])) ? (unsigned)(list[(size_t)u.e * LIST_CAP + rr] >> 1) : 0u; }
};
struct MoeDownSched {
    const char* HID; const char* W2; const LAS int* seg; int nM, G, c;
    __device__ __forceinline__ bool next(int i, pg8::Unit& u) const { if (!pg8::order_next(i, G, c, nM, 4, u.pm, u.pn)) return false; u.e = __builtin_amdgcn_readfirstlane(seg_find(seg, u.pm * 256)); u.a = HID + (size_t)u.pm * 256 * DEXP * 2; u.b = W2 + ((size_t)u.e * 1024 + (size_t)u.pn * 256) * 1024; return true; }
    __device__ __forceinline__ unsigned arow(const pg8::Unit&, int) const { return 0u; }
};
__device__ __forceinline__ void moe_up_opt(Frame& F, int layer) {
    LAS int* seg = (LAS int*)(F.lds + RING_BYTES); moe_segments(F, layer, seg);
    const MoeUpSched S{(const char*)(F.ws + WS_XB), (const char*)(F.ws + WS_W13), seg, (const int*)(F.ws + WS_LIST), __builtin_amdgcn_readfirstlane(seg[32]) / 256, F.G, F.bid};
    const EpiHid E{(bf16_t*)(F.ws + WS_HID)};
    pg8::gemm_phase<EpiHid, MoeUpSched, true, true>(F.lds, F.tid, 1024, DM, S, E);
    __syncthreads();
}
__device__ __forceinline__ void moe_down_opt(Frame& F, int layer) {
    LAS int* seg = (LAS int*)(F.lds + RING_BYTES); moe_segments(F, layer, seg);
    const MoeDownSched S{(const char*)(F.ws + WS_HID), (const char*)(F.ws + WS_W2), seg, __builtin_amdgcn_readfirstlane(seg[32]) / 256, F.G, F.bid};
    const EpiYO E{(bf16_t*)(F.ws + WS_YB), (const float*)(F.ws + WS_TW), (const int*)(F.ws + WS_LIST), seg};
    pg8::gemm_phase<EpiYO, MoeDownSched, false, false>(F.lds, F.tid, DEXP, DEXP, S, E);
    __syncthreads();
}
template <class Epi>
__device__ __forceinline__ void pg_phase(Frame& F, const bf16_t* A, int lda, const bf16_t* Bt, int panel, int N, int K, const Epi& E) {
    pg8::PanelSched S; S.init(A, lda, Bt, panel, N, K);
    pg8::gemm_phase<Epi, pg8::PanelSched, false, false>(F.lds, F.tid, K, lda, S, E);
}
__device__ __forceinline__ void local_sync(Frame& F) {
    asm volatile("s_waitcnt vmcnt(0) lgkmcnt(0)" ::: "memory");
    __syncthreads();
    if (F.tid == 0) { __builtin_amdgcn_fence(__ATOMIC_ACQUIRE, "agent"); asm volatile("s_waitcnt vmcnt(0)" ::: "memory"); }
    __syncthreads();
}
template <class Epi>
__device__ __forceinline__ void og_phase(Frame& F, const bf16_t* A, int lda, const bf16_t* Bt, int M, int N, int K, const Epi& E) {
    pg8::DenseSched S; S.init(A, lda, Bt, M, N, K, F.G, F.bid);
    pg8::gemm_phase<Epi, pg8::DenseSched, false, false>(F.lds, F.tid, K, lda, S, E);
}

#ifndef PANEL_PROG
#define PANEL_PROG 1
#endif
#if PANEL_PROG
constexpr int PH_PER_LAYER = 6, N_PHASES = 2 + DEPTH * PH_PER_LAYER;
#else
constexpr int PH_PER_LAYER = 9, N_PHASES = 1 + DEPTH * PH_PER_LAYER;
#endif
__global__ void __launch_bounds__(NTHREADS, 2) fwd(Args args) {
    extern __shared__ __attribute__((aligned(16))) unsigned char lds[];
    Frame F;
    F.lds = (LAS unsigned char*)lds; F.ldsg = lds;
    F.tid = threadIdx.x; F.lane = F.tid & 63; F.wave = __builtin_amdgcn_readfirstlane(F.tid >> 6);
    F.G = gridDim.x; F.bid = blockIdx.x; F.gw = blockIdx.x * NWAVES + F.wave; F.NGW = F.G * NWAVES;
    F.ws = args.ws; F.ctl = (gu32*)(args.ws + WS_CTL);
    volatile LAS unsigned* MISC = (volatile LAS unsigned*)(F.lds + MISC_OFF);
    for (int u = F.tid; u < (LDS_BYTES - RING_BYTES) / 4; u += NTHREADS) ((LAS unsigned*)(F.lds + RING_BYTES))[u] = 0u;
    __syncthreads();
    XcdBarrier bar; bar.bar = (unsigned*)(F.ctl + CW_BAR); bar.x = 0; bar.st = nullptr;
    if (args.use_bar) bar = xcd_barrier_post((unsigned*)(F.ctl + CW_BAR), MISC + 8);
    const int lo = args.ph_lo, hi = args.ph_hi;
#ifndef PH_MASK
#define PH_MASK 0x3ff
#endif
#define IN(k) (lo <= (k) && (k) < hi && (launder(F), true))
#define SEAM(k) do { if (lo <= (k) && (k) + 1 < hi) xcd_barrier(bar); } while (0)
    if ((PH_MASK & 1) && IN(0)) { p0_prologue(F, args);
#ifdef PROBE_DUP_P0
        launder(F); p0_prologue(F, args);
#endif
    }
    SEAM(0);
#if PANEL_PROG
    for (int layer = 0; layer < DEPTH; ++layer) {
        const int pb = 1 + layer * PH_PER_LAYER;
        if (IN(pb + 0)) {
            for (int panel = F.bid; panel < NTOK / 256; panel += F.G) {
                const int r0 = panel * 256;
                if (layer > 0) { ln2_pass(F, args, layer - 1, r0 + F.wave, NWAVES, r0 + 256); local_sync(F); launder(F); }
                { bf16_t* H = (bf16_t*)(F.ws + WS_H); const EpiH E{H, (const float2*)(F.ws + WS_ROPE32), (const float2*)(F.ws + WS_ROPE64)};
                  pg_phase(F, (const bf16_t*)(F.ws + WS_XB), DM, (const bf16_t*)(F.ws + WS_WIN) + (size_t)layer * 2560 * 1024, panel, 2560, 1024, E); }
                local_sync(F); launder(F);
                rowstat_pass(F, r0 + F.wave, NWAVES, r0 + 256);
                local_sync(F); launder(F);
                { bf16_t* H = (bf16_t*)(F.ws + WS_H); const EpiUQ Eq{(bf16_t*)(F.ws + WS_QB), (const float*)(F.ws + WS_RSTD), (const float2*)(F.ws + WS_ROPE32)};
                  pg_phase(F, H + HC_CQ_LAT, HP, (const bf16_t*)(F.ws + WS_WUQ) + (size_t)layer * 768 * 256, panel, 768, 256, Eq); }
                launder(F);
                { bf16_t* H = (bf16_t*)(F.ws + WS_H); const EpiUKV Ek{(bf16_t*)(F.ws + WS_KVB), (const float*)(F.ws + WS_RSTD)};
                  pg_phase(F, H + HC_CKV, HP, (const bf16_t*)(F.ws + WS_WUKV) + (size_t)layer * 768 * 256, panel, 768, 256, Ek); }
                launder(F);
            }
        }
        SEAM(pb + 0);
        if (IN(pb + 1)) { cstat_phase(F); }
        SEAM(pb + 1);
        if (IN(pb + 2)) { attn_ab_phase(F, args, layer); launder(F); sattn_phase(F, args, layer, 10); }
        SEAM(pb + 2);
        if (IN(pb + 3)) {
            for (int panel = F.bid; panel < NTOK / 256; panel += F.G) {
                const int r0 = panel * 256;
                { const EpiRes E{args.out, layer == 0 ? args.x_prompt : nullptr, args.x_sample, args.out};
                  pg_phase(F, (const bf16_t*)(F.ws + WS_MIX), DM, (const bf16_t*)(F.ws + WS_WOUT) + (size_t)layer * 1024 * 1024, panel, 1024, 1024, E); }
                local_sync(F); launder(F);
                ln1_route_pass(F, args, layer, r0 + F.wave, NWAVES, r0 + 256);
                launder(F);
            }
            moe_convert(F, args, layer);
        }
        SEAM(pb + 3);
        if (IN(pb + 4)) { moe_up_opt(F, layer);
#ifdef PROBE_DUP_MOE
            launder(F); moe_up_opt(F, layer);
#endif
        }
        SEAM(pb + 4);
        if (IN(pb + 5)) { moe_down_opt(F, layer);
#ifdef PROBE_DUP_MOE
            launder(F); moe_down_opt(F, layer);
#endif
        }
        SEAM(pb + 5);
    }
    if (IN(1 + DEPTH * PH_PER_LAYER)) { ln2_pass(F, args, DEPTH - 1, F.gw, F.NGW, NTOK); }
#else
    for (int layer = 0; layer < DEPTH; ++layer) {
        const int pb = 1 + layer * PH_PER_LAYER;
        if ((PH_MASK & (2 << 0)) && IN(pb + 0)) {   bf16_t* H = (bf16_t*)(F.ws + WS_H);
            const EpiH E{H, (const float2*)(F.ws + WS_ROPE32), (const float2*)(F.ws + WS_ROPE64)};
#if OPT_GEMM
            og_phase(F, (const bf16_t*)(F.ws + WS_XB), DM, (const bf16_t*)(F.ws + WS_WIN) + (size_t)layer * 2560 * 1024, NTOK, 2560, 1024, E);
#ifdef PROBE_DUP_GEMM
            launder(F); og_phase(F, (const bf16_t*)(F.ws + WS_XB), DM, (const bf16_t*)(F.ws + WS_WIN) + (size_t)layer * 2560 * 1024, NTOK, 2560, 1024, E);
#endif
#else
            sg_phase(F, (const bf16_t*)(F.ws + WS_XB), DM, (const bf16_t*)(F.ws + WS_WIN) + (size_t)layer * 2560 * 1024, 1024, NTOK, 2560, 1024, E);
#endif
        }
        SEAM(pb + 0);
        if ((PH_MASK & (2 << 1)) && IN(pb + 1)) { rowstat_pass(F, F.gw, F.NGW, NTOK); cstat_phase(F);
#ifdef PROBE_DUP_CSTAT
            launder(F); rowstat_pass(F, F.gw, F.NGW, NTOK); cstat_phase(F);
#endif
        }
        SEAM(pb + 1);
        if ((PH_MASK & (2 << 2)) && IN(pb + 2)) {
            bf16_t* H = (bf16_t*)(F.ws + WS_H);
            const EpiUQ Eq{(bf16_t*)(F.ws + WS_QB), (const float*)(F.ws + WS_RSTD), (const float2*)(F.ws + WS_ROPE32)};
#if OPT_GEMM
            og_phase(F, H + HC_CQ_LAT, HP, (const bf16_t*)(F.ws + WS_WUQ) + (size_t)layer * 768 * 256, NTOK, 768, 256, Eq);
            launder(F);
#else
            sg_phase(F, H + HC_CQ_LAT, HP, (const bf16_t*)(F.ws + WS_WUQ) + (size_t)layer * 768 * 256, 256, NTOK, 768, 256, Eq);
#endif
            const EpiUKV Ek{(bf16_t*)(F.ws + WS_KVB), (const float*)(F.ws + WS_RSTD)};
#if OPT_GEMM
            og_phase(F, H + HC_CKV, HP, (const bf16_t*)(F.ws + WS_WUKV) + (size_t)layer * 768 * 256, NTOK, 768, 256, Ek);
#ifdef PROBE_DUP_UP
            launder(F); og_phase(F, H + HC_CQ_LAT, HP, (const bf16_t*)(F.ws + WS_WUQ) + (size_t)layer * 768 * 256, NTOK, 768, 256, Eq);
            launder(F); og_phase(F, H + HC_CKV, HP, (const bf16_t*)(F.ws + WS_WUKV) + (size_t)layer * 768 * 256, NTOK, 768, 256, Ek);
#endif
#else
            sg_phase(F, H + HC_CKV, HP, (const bf16_t*)(F.ws + WS_WUKV) + (size_t)layer * 768 * 256, 256, NTOK, 768, 256, Ek);
#endif
        }
        SEAM(pb + 2);
        if ((PH_MASK & (2 << 3)) && IN(pb + 3)) {
#if OPT_ATTN
            attn_ab_phase(F, args, layer); launder(F);
#ifdef PROBE_DUP_ATTN
            attn_ab_phase(F, args, layer, PROBE_DUP_ATTN); launder(F);
#endif
            sattn_phase(F, args, layer, 10);
#ifdef PROBE_DUP_CFIN
            launder(F); sattn_phase(F, args, layer, 10);
#endif
#else
            sattn_phase(F, args, layer, 0);
#endif
        }
        SEAM(pb + 3);
        if ((PH_MASK & (2 << 4)) && IN(pb + 4)) {
#ifdef PROBE_DUP_WOUT
            { const EpiRes E0{args.out, layer == 0 ? args.x_prompt : nullptr, args.x_sample, (float*)(F.ws + WS_H)};
              og_phase(F, (const bf16_t*)(F.ws + WS_MIX), DM, (const bf16_t*)(F.ws + WS_WOUT) + (size_t)layer * 1024 * 1024, NTOK, 1024, 1024, E0); launder(F); }
#endif
            const EpiRes E{args.out, layer == 0 ? args.x_prompt : nullptr, args.x_sample, args.out};
#if OPT_GEMM
            og_phase(F, (const bf16_t*)(F.ws + WS_MIX), DM, (const bf16_t*)(F.ws + WS_WOUT) + (size_t)layer * 1024 * 1024, NTOK, 1024, 1024, E);
#else
            sg_phase(F, (const bf16_t*)(F.ws + WS_MIX), DM, (const bf16_t*)(F.ws + WS_WOUT) + (size_t)layer * 1024 * 1024, 1024, NTOK, 1024, 1024, E);
#endif
        }
        SEAM(pb + 4);
        if ((PH_MASK & (2 << 5)) && IN(pb + 5)) {
#ifdef PROBE_DUP_LN1
#endif
            ln1_route_pass(F, args, layer, F.gw, F.NGW, NTOK); moe_convert(F, args, layer);
#ifdef PROBE_DUP_CONV
            launder(F); moe_convert(F, args, layer);
#endif
        }
        SEAM(pb + 5);
#if OPT_GEMM
        if ((PH_MASK & (2 << 6)) && IN(pb + 6)) { moe_up_opt(F, layer);
#ifdef PROBE_DUP_MOE
            launder(F); moe_up_opt(F, layer);
#endif
        }
#else
        if ((PH_MASK & (2 << 6)) && IN(pb + 6)) { moe_up_simple(F, layer); }
#endif
        SEAM(pb + 6);
#if OPT_GEMM
        if ((PH_MASK & (2 << 7)) && IN(pb + 7)) { moe_down_opt(F, layer);
#ifdef PROBE_DUP_MOE
            launder(F); moe_down_opt(F, layer);
#endif
        }
#else
        if ((PH_MASK & (2 << 7)) && IN(pb + 7)) { moe_down_simple(F, layer); }
#endif
        SEAM(pb + 7);
        if ((PH_MASK & (2 << 8)) && IN(pb + 8)) { ln2_pass(F, args, layer, F.gw, F.NGW, NTOK); }
        SEAM(pb + 8);
    }
#endif
#undef IN
#undef SEAM
}

extern "C" void kernel_launch(void* const* d_in, const int* in_sizes, int n_in, void* d_out, int out_size, void* d_ws, size_t ws_size, hipStream_t stream) {
    static int grid = 0;
    if (grid == 0) {
        if (n_in != 19 || out_size != NTOK * DM || ws_size < WS_END) { fprintf(stderr, "kernel_launch: unexpected shapes (n_in %d out %d ws %zu)\n", n_in, out_size, ws_size); grid = -1; return; }
        int dev = 0, cus = 0, per_cu = 0;
        if (hipGetDevice(&dev) != hipSuccess || hipDeviceGetAttribute(&cus, hipDeviceAttributeMultiprocessorCount, dev) != hipSuccess) { grid = -1; return; }
        if (hipFuncSetAttribute((const void*)fwd, hipFuncAttributeMaxDynamicSharedMemorySize, LDS_BYTES) != hipSuccess) { grid = -1; return; }
        if (hipOccupancyMaxActiveBlocksPerMultiprocessor(&per_cu, (const void*)fwd, NTHREADS, LDS_BYTES) != hipSuccess || per_cu < 1) { fprintf(stderr, "kernel_launch: occupancy query says %d\n", per_cu); }
        (void)hipGetLastError();
        grid = cus;
    }
    if (grid < 0) return;
    if (hipMemsetAsync((char*)d_ws + WS_CTL, 0, CTL_ZERO_BYTES, stream) != hipSuccess) return;
    Args a{};
    a.x_prompt = (const float*)d_in[0]; a.x_sample = (const float*)d_in[1]; a.w_in = (const float*)d_in[2]; a.diff_lambda = (const float*)d_in[3]; a.diff_subln = (const float*)d_in[4];
    a.mla_q_norm = (const float*)d_in[5]; a.mla_w_uq = (const float*)d_in[6]; a.mla_kv_norm = (const float*)d_in[7]; a.mla_w_ukv = (const float*)d_in[8]; a.w_out = (const float*)d_in[9];
    a.ln1_g = (const float*)d_in[10]; a.ln1_b = (const float*)d_in[11]; a.moe_w_coarse = (const float*)d_in[12]; a.moe_w_fine = (const float*)d_in[13];
    a.moe_w1 = (const float*)d_in[14]; a.moe_w3 = (const float*)d_in[15]; a.moe_w2 = (const float*)d_in[16]; a.ln2_g = (const float*)d_in[17]; a.ln2_b = (const float*)d_in[18];
    a.out = (float*)d_out; a.ws = (unsigned char*)d_ws; a.pad = 0;
#if MK_ONE_LAUNCH
    a.ph_lo = 0; a.ph_hi = N_PHASES; a.use_bar = 1;
    hipLaunchKernelGGL(fwd, dim3(grid), dim3(NTHREADS), LDS_BYTES, stream, a);
#else
    for (int p = 0; p < N_PHASES; ++p) { a.ph_lo = p; a.ph_hi = p + 1; a.use_bar = 0; hipLaunchKernelGGL(fwd, dim3(grid), dim3(NTHREADS), LDS_BYTES, stream, a); }
#endif
}
```

```cpp
#include <hip/hip_runtime.h>
#include <cstdio>
#include <cstdint>

#ifndef OPT_ATTN
#define OPT_ATTN 1
#endif
#ifndef OPT_GEMM
#define OPT_GEMM 1
#endif
#ifndef MK_ONE_LAUNCH
#define MK_ONE_LAUNCH 1
#endif

#define GAS __attribute__((address_space(1)))
#define LAS __attribute__((address_space(3)))
typedef unsigned short bf16_t;
typedef short bf16x8 __attribute__((ext_vector_type(8)));
typedef float f32x4 __attribute__((ext_vector_type(4)));
typedef float f32x2 __attribute__((ext_vector_type(2)));
typedef float f32x16 __attribute__((ext_vector_type(16)));
typedef unsigned u32x4 __attribute__((ext_vector_type(4)));
typedef unsigned u32x2 __attribute__((ext_vector_type(2)));
typedef GAS unsigned gu32;
#define RLX_AGENT __ATOMIC_RELAXED, __HIP_MEMORY_SCOPE_AGENT
#define LDS_WAIT() asm volatile("s_waitcnt lgkmcnt(0)" ::: "memory")
#define VM_WAIT() asm volatile("s_waitcnt vmcnt(0)" ::: "memory")
#define MFMA32(a, b, c) __builtin_amdgcn_mfma_f32_32x32x16_bf16(a, b, c, 0, 0, 0)

__device__ __forceinline__ unsigned f2bf(float f) { unsigned u = __builtin_bit_cast(unsigned, f); return (u + 0x7fffu + ((u >> 16) & 1u)) >> 16; }
__device__ __forceinline__ unsigned pk2(float lo, float hi) { typedef float f2_ __attribute__((ext_vector_type(2))); typedef __bf16 b2_ __attribute__((ext_vector_type(2))); f2_ v = {lo, hi}; b2_ b = __builtin_convertvector(v, b2_); return __builtin_bit_cast(unsigned, b); }
__device__ __forceinline__ float bf2f(unsigned short b) { return __builtin_bit_cast(float, (unsigned)b << 16); }
__device__ __forceinline__ int crow(int r, int hi) { return (r & 3) + 8 * (r >> 2) + 4 * hi; }
template <int K> __device__ __forceinline__ float shx(float v) { static_assert(K < 32, "xor 32: use xsum32 / xmax32 / xpair32"); return __uint_as_float((unsigned)__builtin_amdgcn_ds_swizzle((int)__float_as_uint(v), (K << 10) | 0x1f)); }
__device__ __forceinline__ float xsum32(float v) { auto rr = __builtin_amdgcn_permlane32_swap(__float_as_uint(v), __float_as_uint(v), false, false); return __uint_as_float(rr[0]) + __uint_as_float(rr[1]); }
__device__ __forceinline__ float xmax32(float v) { auto rr = __builtin_amdgcn_permlane32_swap(__float_as_uint(v), __float_as_uint(v), false, false); return fmaxf(__uint_as_float(rr[0]), __uint_as_float(rr[1])); }
__device__ __forceinline__ float xpair32(float lo, float hi) { auto rr = __builtin_amdgcn_permlane32_swap(__float_as_uint(lo), __float_as_uint(hi), false, false); return __uint_as_float(rr[0]) + __uint_as_float(rr[1]); }
__device__ __forceinline__ float wave_sum(float v) {
    v += shx<1>(v); v += shx<2>(v); v += shx<4>(v); v += shx<8>(v); v += shx<16>(v);
    return xsum32(v);
}
__device__ __forceinline__ float fast_exp2(float x) { return __builtin_amdgcn_exp2f(x); }

constexpr int NTOK = 65536, DM = 1024, DEPTH = 4;
constexpr int NTOK_P = 32768;
constexpr int HP = 2560;
constexpr int HC_AQ = 0, HC_AK = 256, HC_AV = 512, HC_CQ_LAT = 768, HC_CKV = 1024, HC_KROPE = 1152, HC_CQ = 1280, HC_CK = 1664, HC_CV = 2048;
constexpr int QBP = 768, KVP = 768;
constexpr int MIX_A = 0, MIX_B = 256, MIX_C = 640;
constexpr int NEXP = 32, DEXP = 512;
constexpr float LOG2E = 1.4426950408889634f;
constexpr float SC_A = 0.17677669529663687f * LOG2E;
constexpr float SC_B = 0.10206207261596575f * LOG2E;
constexpr float SC_C = 0.125f * LOG2E;
constexpr float DN_ALPHA = 1.681792830507429f;
constexpr float LN_EPS = 1e-5f, RMS_EPS = 1e-6f;

constexpr size_t MiB = 1u << 20;
constexpr size_t WS_CTL = 0, CTL_ZERO_BYTES = 64 * 1024;
constexpr size_t WS_ROPE32 = 4 * MiB;
constexpr size_t WS_ROPE64 = 5 * MiB;
constexpr size_t WS_WIN = 8 * MiB;
constexpr size_t WS_WOUT = 28 * MiB;
constexpr size_t WS_WUQ = 36 * MiB;
constexpr size_t WS_WUKV = 38 * MiB;
constexpr size_t WS_W13 = 40 * MiB;
constexpr size_t WS_W2 = 104 * MiB;
constexpr size_t WS_XB = 136 * MiB;
constexpr size_t WS_H = 264 * MiB;
constexpr size_t WS_QB = 584 * MiB;
constexpr size_t WS_KVB = 680 * MiB;
constexpr size_t WS_MIX = 776 * MiB;
constexpr size_t WS_RSTD = 904 * MiB;
constexpr size_t WS_LSEC = 905 * MiB;
constexpr size_t WS_TW = 907 * MiB;
constexpr size_t WS_LIST = 908 * MiB;
constexpr size_t WS_LW = 924 * MiB;
constexpr size_t WS_END = 940 * MiB;
constexpr size_t WS_HID = WS_H;
constexpr size_t WS_YB = WS_H + 136 * MiB;
static_assert(WS_YB + 256 * MiB <= WS_KVB + 96 * MiB, "YB overlay");
constexpr int LIST_CAP = 131072;
constexpr int CW_TMO = 0;
constexpr int CW_CNT = 64;
constexpr int CW_BAR = 4096;

constexpr int RING_BYTES = 131072;
constexpr int MISC_OFF = RING_BYTES + 320;
constexpr int LDS_BYTES = 147456;
constexpr int NWAVES = 8, NTHREADS = 512;

#define XB_TMO      128
#define XB_XCNT(j)  (256  + 64 * (j))
#define XB_XSUB(j)  (1280 + 64 * (j))
#define XB_XGEN(j)  (2304 + 64 * (j))
#define XB_TOP      3328
#define XB_TOPGEN   3392
#define XCD_BAR_WORDS 3456
#define XB_SPIN_CAP (1u << 22)
__device__ __forceinline__ unsigned xb_ld(unsigned* p)              { return __hip_atomic_load(p, __ATOMIC_RELAXED, __HIP_MEMORY_SCOPE_AGENT); }
__device__ __forceinline__ unsigned xb_add(unsigned* p, unsigned v) { return __hip_atomic_fetch_add(p, v, __ATOMIC_RELAXED, __HIP_MEMORY_SCOPE_AGENT); }
__device__ __forceinline__ unsigned xb_xcc_id() { return (unsigned)__builtin_amdgcn_s_getreg((3 << 11) | 20) & 0xFu; }
#define XB_SPIN(cond, bar) do { unsigned _sp = 0; while (cond) { __builtin_amdgcn_s_sleep(1); \
    if ((++_sp & 255u) == 0u) { if (xb_ld(&(bar)[XB_TMO])) break; if (_sp > XB_SPIN_CAP) { atomicAdd(&(bar)[XB_TMO], 1u); break; } } } } while (0)
struct XcdBarrier { unsigned* bar; unsigned x; volatile LAS unsigned* st; };
__device__ __forceinline__ XcdBarrier xcd_barrier_post(unsigned* bar, volatile LAS unsigned* st) {
    XcdBarrier b; b.bar = bar; b.x = xb_xcc_id(); b.st = st;
    if (threadIdx.x == 0) (void)xb_add(&bar[XB_XCNT(b.x)], 1u);
    return b;
}
__device__ __forceinline__ void xcd_barrier_complete(unsigned* bar, unsigned x, unsigned& nloc, unsigned& nx) {
    const unsigned G = gridDim.x * gridDim.y * gridDim.z;
    unsigned sum, cnt, mine, sp = 0u;
    for (;;) {
        sum = 0u; cnt = 0u; mine = 0u;
#pragma unroll
        for (unsigned j = 0; j < 16; ++j) { const unsigned c = xb_ld(&bar[XB_XCNT(j)]); sum += c; cnt += (c > 0u) ? 1u : 0u; mine = (j == x) ? c : mine; }
        if (sum == G) break;
        __builtin_amdgcn_s_sleep(1);
        if ((++sp & 255u) == 0u) { if (xb_ld(&bar[XB_TMO])) break; if (sp > XB_SPIN_CAP) { atomicAdd(&bar[XB_TMO], 1u); break; } }
    }
    nloc = mine > 0u ? mine : 1u; nx = cnt > 0u ? cnt : 1u;
}
__device__ __forceinline__ void xcd_barrier(const XcdBarrier& b) {
    asm volatile("s_waitcnt vmcnt(0)" ::: "memory");
    __syncthreads();
    if (threadIdx.x == 0) {
        unsigned* bar = b.bar;
        __builtin_amdgcn_s_waitcnt(0);
        unsigned nloc = b.st[0], nx = b.st[1];
        if (nloc == 0u) { xcd_barrier_complete(bar, b.x, nloc, nx); b.st[0] = nloc; b.st[1] = nx; }
        const unsigned old = xb_add(&bar[XB_XSUB(b.x)], 1u);
        const unsigned gen = old / nloc;
        if (old + 1u == (gen + 1u) * nloc) {
            __builtin_amdgcn_fence(__ATOMIC_RELEASE, "agent");
            asm volatile("s_waitcnt vmcnt(0)" ::: "memory");
            const unsigned og = xb_add(&bar[XB_TOP], 1u);
            const unsigned tg = og / nx;
            if (og + 1u == (tg + 1u) * nx) xb_add(&bar[XB_TOPGEN], 1u);
            else XB_SPIN(xb_ld(&bar[XB_TOPGEN]) == tg, bar);
            __builtin_amdgcn_fence(__ATOMIC_ACQUIRE, "agent");
            xb_add(&bar[XB_XGEN(b.x)], 1u);
            asm volatile("s_waitcnt vmcnt(0)" ::: "memory");
        } else {
            XB_SPIN(xb_ld(&bar[XB_XGEN(b.x)]) == gen, bar);
            __builtin_amdgcn_fence(__ATOMIC_ACQUIRE, "agent");
            asm volatile("s_waitcnt vmcnt(0)" ::: "memory");
        }
    }
    __syncthreads();
}

struct Args {
    const float* x_prompt; const float* x_sample; const float* w_in; const float* diff_lambda; const float* diff_subln; const float* mla_q_norm; const float* mla_w_uq;
    const float* mla_kv_norm; const float* mla_w_ukv; const float* w_out; const float* ln1_g; const float* ln1_b; const float* moe_w_coarse; const float* moe_w_fine;
    const float* moe_w1; const float* moe_w3; const float* moe_w2; const float* ln2_g; const float* ln2_b;
    float* out; unsigned char* ws; int ph_lo, ph_hi, use_bar, pad;
};
struct Frame {
    LAS unsigned char* lds; unsigned char* ldsg;
    int tid, lane, wave, G, gw, NGW, bid;
    gu32* ctl; unsigned char* ws;
};
__device__ __forceinline__ void launder(Frame& F) {
    int wv = F.wave; asm volatile("" : "+s"(wv)); F.wave = wv;
    int t; asm volatile("v_mbcnt_lo_u32_b32 %0, -1, 0\n\tv_mbcnt_hi_u32_b32 %0, -1, %0" : "=v"(t)); F.lane = t; F.tid = wv * 64 + t;
    int b = (int)blockIdx.x; asm volatile("" : "+s"(b)); F.bid = b; F.gw = b * NWAVES + F.wave;
    unsigned char* w = F.ws; asm volatile("" : "+s"(w)); F.ws = w; F.ctl = (gu32*)(w + WS_CTL);
}
struct SeqInfo { int base, len, pos; };
__device__ __forceinline__ SeqInfo seqinfo(int m) { SeqInfo s; if (m < NTOK_P) { s.base = m & ~2047; s.len = 2048; } else { s.base = m & ~4095; s.len = 4096; } s.pos = m - s.base; return s; }

template <class ColMap>
__device__ __forceinline__ void transpose_item(const float* W, int N, bf16_t* WT, int ldd, LAS float* scr, int k0, int n0, const ColMap& cm, const float* kscale, int lane) {
    const int sc = cm(n0 + (lane & 31));
#pragma unroll 8
    for (int i = 0; i < 32; ++i) { const int kk = 2 * i + (lane >> 5); float v = 0.f; if (sc >= 0) { v = W[(size_t)(k0 + kk) * N + sc]; if (kscale) v *= kscale[k0 + kk]; } scr[kk * 33 + (lane & 31)] = v; }
    LDS_WAIT(); asm volatile("" ::: "memory");
    const int c = lane & 7;
#pragma unroll
    for (int j = 0; j < 4; ++j) { const int n = (lane >> 3) + 8 * j; const LAS float* s = scr + (8 * c) * 33 + n;
        u32x4 o; o.x = pk2(s[0 * 33], s[1 * 33]); o.y = pk2(s[2 * 33], s[3 * 33]); o.z = pk2(s[4 * 33], s[5 * 33]); o.w = pk2(s[6 * 33], s[7 * 33]);
        *(u32x4*)(WT + (size_t)(n0 + n) * ldd + k0 + 8 * c) = o; }
    LDS_WAIT(); asm volatile("" ::: "memory");
}
__device__ __forceinline__ void transpose_item_v4(const float* Wsrc, int N, bf16_t* WTdst, int ldd, LAS float* scr, int lane) {
    const int c4 = (lane & 7) * 4, kr = lane >> 3;
    f32x4 t[8];
#pragma unroll
    for (int i = 0; i < 8; ++i) t[i] = *(const f32x4*)(Wsrc + (size_t)(i * 8 + kr) * N + c4);
#pragma unroll
    for (int i = 0; i < 8; ++i) { const int kk = i * 8 + kr; scr[(c4 + 0) * 65 + kk] = t[i].x; scr[(c4 + 1) * 65 + kk] = t[i].y; scr[(c4 + 2) * 65 + kk] = t[i].z; scr[(c4 + 3) * 65 + kk] = t[i].w; }
    LDS_WAIT(); asm volatile("" ::: "memory");
    const int c = lane & 7;
#pragma unroll
    for (int j = 0; j < 4; ++j) { const int n = (lane >> 3) + 8 * j; const LAS float* p = scr + n * 65 + 8 * c;
        u32x4 o; o.x = pk2(p[0], p[1]); o.y = pk2(p[2], p[3]); o.z = pk2(p[4], p[5]); o.w = pk2(p[6], p[7]);
        *(u32x4*)(WTdst + (size_t)n * ldd + 8 * c) = o; }
    LDS_WAIT(); asm volatile("" ::: "memory");
}
struct WinMap {
    __device__ __forceinline__ int operator()(int n) const {
        if (n < 512) { const int t = n & 31; return (n & ~31) + (t >> 1) + 16 * (t & 1); }
        if (n < 1152) return n;
        if (n < 1184) { const int t = n - 1152; return 1152 + (t >> 1) + 16 * (t & 1); }
        if (n < 1280) return -1;
        if (n < 2048) { const int u = n - 1280, t = u & 63; return 1184 + (u & ~63) + (t >> 1) + 32 * (t & 1); }
        if (n < 2432) return 1952 + (n - 2048);
        return -1;
    }
};
struct UqMap { __device__ __forceinline__ int operator()(int n) const { if (n >= 576) return -1; const int h = n / 96, t = n - 96 * h; if (t < 64) return n; const int u = t - 64; return 96 * h + 64 + (u >> 1) + 16 * (u & 1); } };
struct IdMap { __device__ __forceinline__ int operator()(int n) const { return n; } };
struct W13Map { __device__ __forceinline__ int operator()(int n) const { return (n >> 8) * 128 + (n & 127); } };

__device__ __forceinline__ void p0_prologue(Frame& F, const Args& a) {
    LAS float* scr = (LAS float*)(F.lds + F.wave * 16384);
    { float2* r32 = (float2*)(F.ws + WS_ROPE32); float2* r64 = (float2*)(F.ws + WS_ROPE64);
      for (int i = F.gw * 64 + F.lane; i < 4096 * 16; i += F.NGW * 64) { const int pos = i >> 4, j = i & 15; const float inv = 1.0f / powf(10000.0f, (float)(2 * j) / 32.0f); const float ang = (float)pos * inv; r32[i] = make_float2(cosf(ang), sinf(ang)); }
      for (int i = F.gw * 64 + F.lane; i < 4096 * 32; i += F.NGW * 64) { const int pos = i >> 5, j = i & 31; const float inv = 1.0f / powf(10000.0f, (float)(2 * j) / 64.0f); const float ang = (float)pos * inv; r64[i] = make_float2(cosf(ang), sinf(ang)); } }
    constexpr int I_WIN = (1024 / 64) * (2560 / 32), I_WOUT = (1024 / 64) * (1024 / 32), I_UQ = (256 / 64) * (768 / 32), I_UKV = (256 / 64) * (768 / 32);
    constexpr int PER_L = I_WIN + I_WOUT + I_UQ + I_UKV;
    for (int it = F.gw; it < DEPTH * PER_L; it += F.NGW) {
        const int l = it / PER_L; int r = it - l * PER_L;
        if (r < I_WIN) { const int kb = r / 80, nb = r % 80; transpose_item(a.w_in + (size_t)l * 1024 * 2336, 2336, (bf16_t*)(F.ws + WS_WIN) + (size_t)l * 2560 * 1024, 1024, scr, kb * 64, nb * 32, WinMap(), nullptr, F.lane); continue; } r -= I_WIN;
        if (r < I_WOUT) { const int kb = r / 32, nb = r % 32; transpose_item(a.w_out + (size_t)l * 1024 * 1024, 1024, (bf16_t*)(F.ws + WS_WOUT) + (size_t)l * 1024 * 1024, 1024, scr, kb * 64, nb * 32, IdMap(), nullptr, F.lane); continue; } r -= I_WOUT;
        if (r < I_UQ) { const int kb = r / 24, nb = r % 24; transpose_item(a.mla_w_uq + (size_t)l * 256 * 576, 576, (bf16_t*)(F.ws + WS_WUQ) + (size_t)l * 768 * 256, 256, scr, kb * 64, nb * 32, UqMap(), a.mla_q_norm + l * 256, F.lane); continue; } r -= I_UQ;
        { const int kb = r / 24, nb = r % 24; bf16_t* dst = (bf16_t*)(F.ws + WS_WUKV) + (size_t)l * 768 * 256;
          if (kb < 2) transpose_item(a.mla_w_ukv + (size_t)l * 128 * 768, 768, dst, 256, scr, kb * 64, nb * 32, IdMap(), a.mla_kv_norm + l * 128, F.lane);
          else { const int c = F.lane & 7;
#pragma unroll
              for (int j = 0; j < 4; ++j) { const int n = (F.lane >> 3) + 8 * j; *(u32x4*)(dst + (size_t)(nb * 32 + n) * 256 + kb * 64 + 8 * c) = (u32x4){0u, 0u, 0u, 0u}; } } }
    }
    bf16_t* XB = (bf16_t*)(F.ws + WS_XB);
    for (int m = F.gw; m < NTOK; m += F.NGW) {
        const float* src = (m < NTOK_P) ? a.x_prompt + (size_t)m * DM : a.x_sample + (size_t)(m - NTOK_P) * DM;
#pragma unroll
        for (int j = 0; j < 4; ++j) { const f32x4 v = *((const f32x4*)src + F.lane + 64 * j);
            u32x2 w; w.x = pk2(v.x, v.y); w.y = pk2(v.z, v.w); *((u32x2*)(XB + (size_t)m * DM) + F.lane + 64 * j) = w; }
    }
}

template <class Epi, class RowMap>
__device__ __forceinline__ void sg_tile(const bf16_t* A, int lda, const bf16_t* B0, const bf16_t* B1, int ldb, int K, int m0, int c0, const Epi& E, const RowMap& RM, int lane) {
    const int r32 = lane & 31, hi = lane >> 5;
    const bf16_t* ap = A + (size_t)RM.src(m0 + r32) * lda + 8 * hi;
    const bf16_t* b0p = B0 + (size_t)r32 * ldb + 8 * hi;
    const bf16_t* b1p = B1 + (size_t)r32 * ldb + 8 * hi;
    f32x16 acc0 = {}, acc1 = {};
#pragma unroll 4
    for (int k = 0; k < K; k += 16) {
        const bf16x8 af = *(const bf16x8*)(ap + k), bf0 = *(const bf16x8*)(b0p + k), bf1 = *(const bf16x8*)(b1p + k);
        acc0 = MFMA32(bf0, af, acc0); acc1 = MFMA32(bf1, af, acc1);
    }
#pragma unroll
    for (int g = 0; g < 4; ++g) { const f32x4 v0 = {acc0[4 * g], acc0[4 * g + 1], acc0[4 * g + 2], acc0[4 * g + 3]}, v1 = {acc1[4 * g], acc1[4 * g + 1], acc1[4 * g + 2], acc1[4 * g + 3]};
        E.put(m0 + r32, c0, 8 * g + 4 * hi, v0, v1); }
}
struct IdRows { __device__ __forceinline__ int src(int m) const { return m; } };

__device__ __forceinline__ void store_bf8(bf16_t* p, f32x4 a, f32x4 b) { u32x4 w; w.x = pk2(a.x, a.y); w.y = pk2(a.z, a.w); w.z = pk2(b.x, b.y); w.w = pk2(b.z, b.w); *(u32x4*)p = w; }
__device__ __forceinline__ void store_bf4(bf16_t* p, f32x4 v) { u32x2 w; w.x = pk2(v.x, v.y); w.y = pk2(v.z, v.w); *(u32x2*)p = w; }
struct EpiH {
    static constexpr bool INPLACE = false;
    static constexpr bool PERM = true;
    bf16_t* H; const float2* rope32; const float2* rope64;
    __device__ __forceinline__ f32x4 xf(int pos, int col, f32x4 v) const {
        if (col < 512 || (col >= HC_KROPE && col < HC_KROPE + 32)) {
            const int j0 = (col & 31) >> 1; const f32x4 cs = *(const f32x4*)(rope32 + pos * 16 + j0);
            f32x4 o; o.x = v.x * cs.x - v.y * cs.y; o.y = v.x * cs.y + v.y * cs.x; o.z = v.z * cs.z - v.w * cs.w; o.w = v.z * cs.w + v.w * cs.z;
            if (col < 256) o = o * SC_A; v = o;
        } else if (col >= HC_CQ && col < HC_CV) {
            const int j0 = ((col - HC_CQ) & 63) >> 1; const f32x4 cs = *(const f32x4*)(rope64 + pos * 32 + j0);
            f32x4 o; o.x = v.x * cs.x - v.y * cs.y; o.y = v.x * cs.y + v.y * cs.x; o.z = v.z * cs.z - v.w * cs.w; o.w = v.z * cs.w + v.w * cs.z;
            if (col < HC_CK) o = o * SC_C; v = o;
        }
        return v;
    }
    __device__ __forceinline__ void put4(int row, int col, f32x4 v) const { store_bf4(H + (size_t)row * HP + col, xf(seqinfo(row).pos, col, v)); }
    __device__ __forceinline__ void put(int row, int c0, int cc, f32x4 v0, f32x4 v1) const { put4(row, c0 + cc, v0); put4(row, c0 + 32 + cc, v1); }
    template <class U> __device__ __forceinline__ void put8(const U&, int row, int col, f32x4 v0, f32x4 v1) const { const int pos = seqinfo(row).pos; store_bf8(H + (size_t)row * HP + col, xf(pos, col, v0), xf(pos, col + 4, v1)); }
    struct Pre { f32x4 c0, c1; };
    __device__ __forceinline__ static f32x4 rot(f32x4 v, f32x4 cs) { f32x4 o; o.x = v.x * cs.x - v.y * cs.y; o.y = v.x * cs.y + v.y * cs.x; o.z = v.z * cs.z - v.w * cs.w; o.w = v.z * cs.w + v.w * cs.z; return o; }
    template <class U> __device__ __forceinline__ Pre pre(const U&, int row, int col) const { Pre p; p.c0 = (f32x4){0.f, 0.f, 0.f, 0.f}; p.c1 = p.c0; const int pos = seqinfo(row).pos;
        if (col < 512 || (col >= HC_KROPE && col < HC_KROPE + 32)) { const f32x4* t = (const f32x4*)(rope32 + pos * 16 + ((col & 31) >> 1)); p.c0 = t[0]; p.c1 = t[1]; }
        else if (col >= HC_CQ && col < HC_CV) { const f32x4* t = (const f32x4*)(rope64 + pos * 32 + (((col - HC_CQ) & 63) >> 1)); p.c0 = t[0]; p.c1 = t[1]; }
        return p; }
    template <class U> __device__ __forceinline__ void fin8(const U&, int row, int col, f32x4 v0, f32x4 v1, const Pre& p) const {
        if (col < 512 || (col >= HC_KROPE && col < HC_KROPE + 32)) { v0 = rot(v0, p.c0); v1 = rot(v1, p.c1); if (col < 256) { v0 = v0 * SC_A; v1 = v1 * SC_A; } }
        else if (col >= HC_CQ && col < HC_CV) { v0 = rot(v0, p.c0); v1 = rot(v1, p.c1); if (col < HC_CK) { v0 = v0 * SC_C; v1 = v1 * SC_C; } }
        store_bf8(H + (size_t)row * HP + col, v0, v1); }
};
struct EpiUQ {
    static constexpr bool INPLACE = false;
    static constexpr bool PERM = true;
    bf16_t* Q; const float* rstd; const float2* rope32;
    __device__ __forceinline__ f32x4 xf(int row, int col, f32x4 v, float rs) const {
        v = v * rs;
        const int t = col % 96;
        if (t >= 64) { const int pos = seqinfo(row).pos; const int j0 = (t - 64) >> 1; const f32x4 cs = *(const f32x4*)(rope32 + pos * 16 + j0);
            f32x4 o; o.x = v.x * cs.x - v.y * cs.y; o.y = v.x * cs.y + v.y * cs.x; o.z = v.z * cs.z - v.w * cs.w; o.w = v.z * cs.w + v.w * cs.z; v = o; }
        return v * SC_B;
    }
    __device__ __forceinline__ void put4(int row, int col, f32x4 v) const { if (col >= 576) return; store_bf4(Q + (size_t)row * QBP + col, xf(row, col, v, rstd[2 * row])); }
    template <class U> __device__ __forceinline__ void put8(const U&, int row, int col, f32x4 v0, f32x4 v1) const { if (col >= 576) return; const float rs = rstd[2 * row]; store_bf8(Q + (size_t)row * QBP + col, xf(row, col, v0, rs), xf(row, col + 4, v1, rs)); }
    __device__ __forceinline__ void put(int row, int c0, int cc, f32x4 v0, f32x4 v1) const { put4(row, c0 + cc, v0); put4(row, c0 + 32 + cc, v1); }
    struct Pre { float rs; f32x4 c0, c1; };
    template <class U> __device__ __forceinline__ Pre pre(const U&, int row, int col) const { Pre p; p.rs = rstd[2 * row]; p.c0 = (f32x4){0.f, 0.f, 0.f, 0.f}; p.c1 = p.c0;
        if (col < 576 && (col % 96) >= 64) { const f32x4* t = (const f32x4*)(rope32 + seqinfo(row).pos * 16 + (((col % 96) - 64) >> 1)); p.c0 = t[0]; p.c1 = t[1]; }
        return p; }
    template <class U> __device__ __forceinline__ void fin8(const U&, int row, int col, f32x4 v0, f32x4 v1, const Pre& p) const { if (col >= 576) return;
        v0 = v0 * p.rs; v1 = v1 * p.rs; if ((col % 96) >= 64) { v0 = EpiH::rot(v0, p.c0); v1 = EpiH::rot(v1, p.c1); }
        store_bf8(Q + (size_t)row * QBP + col, v0 * SC_B, v1 * SC_B); }
};
struct EpiUKV {
    static constexpr bool INPLACE = false;
    static constexpr bool PERM = true;
    bf16_t* KV; const float* rstd;
    template <class U> __device__ __forceinline__ void put8(const U&, int row, int col, f32x4 v0, f32x4 v1) const { const float rs = rstd[2 * row + 1]; store_bf8(KV + (size_t)row * KVP + col, v0 * rs, v1 * rs); }
    __device__ __forceinline__ void put4(int row, int col, f32x4 v) const { store_bf4(KV + (size_t)row * KVP + col, v * rstd[2 * row + 1]); }
    __device__ __forceinline__ void put(int row, int c0, int cc, f32x4 v0, f32x4 v1) const { put4(row, c0 + cc, v0); put4(row, c0 + 32 + cc, v1); }
    struct Pre { float rs; };
    template <class U> __device__ __forceinline__ Pre pre(const U&, int row, int) const { Pre p; p.rs = rstd[2 * row + 1]; return p; }
    template <class U> __device__ __forceinline__ void fin8(const U&, int row, int col, f32x4 v0, f32x4 v1, const Pre& p) const { store_bf8(KV + (size_t)row * KVP + col, v0 * p.rs, v1 * p.rs); }
};
struct EpiRes {
    static constexpr bool INPLACE = true;
    static constexpr bool PERM = false;
    float* X; const float* xp; const float* xs; float* D;
    template <class U> __device__ __forceinline__ void put4(const U&, int row, int col, f32x4 v) const { put4(row, col, v); }
    __device__ __forceinline__ void put4(int row, int col, f32x4 v) const {
        const f32x4* p = (const f32x4*)(X + (size_t)row * DM + col);
        const f32x4 r = xp ? *(const f32x4*)(((row < NTOK_P) ? xp + (size_t)row * DM : xs + (size_t)(row - NTOK_P) * DM) + col) : *p;
        *(f32x4*)(D + (size_t)row * DM + col) = r * DN_ALPHA + v; }
    __device__ __forceinline__ void put(int row, int c0, int cc, f32x4 v0, f32x4 v1) const { put4(row, c0 + cc, v0); put4(row, c0 + 32 + cc, v1); }
    struct Pre { f32x4 a, b; };
    template <class U> __device__ __forceinline__ Pre pre(const U&, int row, int col) const { Pre p;
        const float* src = xp ? ((row < NTOK_P) ? xp + (size_t)row * DM : xs + (size_t)(row - NTOK_P) * DM) : X + (size_t)row * DM;
        p.a = *(const f32x4*)(src + col); p.b = *(const f32x4*)(src + col + 16); return p; }
    template <class U> __device__ __forceinline__ void fin4x2(const U&, int row, int col, f32x4 v0, f32x4 v1, const Pre& p) const {
        *(f32x4*)(D + (size_t)row * DM + col) = p.a * DN_ALPHA + v0; *(f32x4*)(D + (size_t)row * DM + col + 16) = p.b * DN_ALPHA + v1; }
};
__device__ __forceinline__ float silu_f(float x) { return x / (1.0f + __expf(-x)); }
struct EpiHid {
    static constexpr bool INPLACE = false;
    static constexpr bool PERM = true;
    bf16_t* HID;
    __device__ __forceinline__ f32x4 act(f32x4 g, f32x4 u) const { f32x4 o; o.x = silu_f(g.x) * u.x; o.y = silu_f(g.y) * u.y; o.z = silu_f(g.z) * u.z; o.w = silu_f(g.w) * u.w; return o; }
    template <class U> __device__ __forceinline__ void putp8(const U&, int row, int col, f32x4 g0, f32x4 g1, f32x4 u0, f32x4 u1) const { store_bf8(HID + (size_t)row * DEXP + col, act(g0, u0), act(g1, u1)); }
    __device__ __forceinline__ void putp(int row, int col, f32x4 g, f32x4 u) const { f32x4 o; o.x = silu_f(g.x) * u.x; o.y = silu_f(g.y) * u.y; o.z = silu_f(g.z) * u.z; o.w = silu_f(g.w) * u.w; store_bf4(HID + (size_t)row * DEXP + col, o); }
    __device__ __forceinline__ void put(int row, int c0, int cc, f32x4 v0, f32x4 v1) const { putp(row, c0 + cc, v0, v1); }
};
struct EpiY {
    static constexpr bool INPLACE = false;
    bf16_t* YB; const float* tw; const int* list; int seg0, cnt;
    __device__ __forceinline__ void put4(int row, int col, f32x4 v) const { const int r = row - seg0; if (r >= cnt) return; const int a = list[r]; store_bf4(YB + (size_t)a * DM + col, v * tw[a]); }
    __device__ __forceinline__ void put(int row, int c0, int cc, f32x4 v0, f32x4 v1) const { put4(row, c0 + cc, v0); put4(row, c0 + 32 + cc, v1); }
};

struct EpiYO {
    static constexpr bool INPLACE = false;
    static constexpr bool PERM = true;
    bf16_t* YB; const float* tw; const int* list; const LAS int* seg; const float* lw;
    template <class U> __device__ __forceinline__ void put8(const U& u, int row, int col, f32x4 v0, f32x4 v1) const {
        const int r = row - __builtin_amdgcn_readfirstlane(seg[u.e]); if (r >= __builtin_amdgcn_readfirstlane(seg[33 + u.e])) return; const int a = list[(size_t)u.e * LIST_CAP + r]; const float w = tw[a]; store_bf8(YB + (size_t)a * DM + col, v0 * w, v1 * w); }
    struct Pre { int a; float w; };
    template <class U> __device__ __forceinline__ Pre pre(const U& u, int row, int) const { Pre p; p.a = -1; p.w = 0.f;
        const int r = row - __builtin_amdgcn_readfirstlane(seg[u.e]); if (r < __builtin_amdgcn_readfirstlane(seg[33 + u.e])) { p.a = list[(size_t)u.e * LIST_CAP + r]; p.w = lw[(size_t)u.e * LIST_CAP + r]; } return p; }
    template <class U> __device__ __forceinline__ void fin8(const U&, int, int col, f32x4 v0, f32x4 v1, const Pre& p) const { if (p.a >= 0) store_bf8(YB + (size_t)p.a * DM + col, v0 * p.w, v1 * p.w); }
};
template <class Epi>
__device__ __forceinline__ void sg_phase(Frame& F, const bf16_t* A, int lda, const bf16_t* Bt, int ldb, int M, int N, int K, const Epi& E) {
    const int nN = N / 64, items = (M / 32) * nN;
    for (int it = F.gw; it < items; it += F.NGW) { const int mt = it / nN, nt = it - mt * nN;
        sg_tile(A, lda, Bt + (size_t)(nt * 64) * ldb, Bt + (size_t)(nt * 64 + 32) * ldb, ldb, K, mt * 32, nt * 64, E, IdRows(), F.lane); }
}


namespace pg8 {
constexpr int BM = 256, BK = 64, HALF = 128, HTB = HALF * BK * 2, NXCD = 8, WGM = 8;
__host__ __device__ __forceinline__ int lds_byte(int r, int c) { const int st = (r >> 4) * 2 + (c >> 5), rr = r & 15, cc = c & 31, ob = rr * 64 + cc * 2; return st * 1024 + (ob ^ (((ob >> 9) & 1) << 5)); }
__host__ __device__ __forceinline__ void stage_rc(int b, int& R, int& C) { const int st = b / 1024, sb = b % 1024, swz = sb ^ (((sb >> 9) & 1) << 5); R = (st >> 1) * 16 + swz / 64; C = (st & 1) * 32 + (swz % 64) / 2; }
__host__ __device__ __forceinline__ int perm32(int rho) { const int n = rho >> 4, i = rho & 15; return 8 * (i >> 2) + 4 * n + (i & 3); }
struct Unit { int pm, pn, e; const char* a; const char* b; };
__device__ __forceinline__ bool order_next(int i, int G, int c, int nM, int nN, int& pm, int& pn) {
    const int nwg = nM * nN; const long L = (long)i * G + c; if (L >= nwg) return false;
    int wgid = (int)L; { const int q = nwg / NXCD, r = nwg % NXCD, xcd = wgid % NXCD, off = wgid / NXCD; wgid = (xcd < r ? xcd * (q + 1) : r * (q + 1) + (xcd - r) * q) + off; }
    const int nig = WGM * nN, gid = wgid / nig, fm = gid * WGM, gsz = (nM - fm) < WGM ? (nM - fm) : WGM;
    pm = fm + ((wgid % nig) % gsz); pn = (wgid % nig) / gsz; return true;
}
struct DenseSched {
    const char* A; const char* Bt; int nM, nN, G, c; size_t tstepA, tstepB;
    __device__ __forceinline__ void init(const bf16_t* A_, int lda, const bf16_t* Bt_, int M, int N, int K, int G_, int c_) { A = (const char*)A_; Bt = (const char*)Bt_; nM = M / BM; nN = N / BM; G = G_; c = c_; tstepA = (size_t)BM * lda * 2; tstepB = (size_t)BM * K * 2; }
    __device__ __forceinline__ bool next(int i, Unit& u) const { if (!order_next(i, G, c, nM, nN, u.pm, u.pn)) return false; u.e = 0; u.a = A + (size_t)u.pm * tstepA; u.b = Bt + (size_t)u.pn * tstepB; return true; }
    __device__ __forceinline__ unsigned arow(const Unit&, int) const { return 0u; }
};
struct PanelSched {
    const char* A; const char* Bt; int pm, nN; size_t tstepB;
    __device__ __forceinline__ void init(const bf16_t* A_, int lda, const bf16_t* Bt_, int pm_, int N, int K) { pm = pm_; nN = N / BM; A = (const char*)A_ + (size_t)pm_ * BM * lda * 2; Bt = (const char*)Bt_; tstepB = (size_t)BM * K * 2; }
    __device__ __forceinline__ bool next(int i, Unit& u) const { if (i >= nN) return false; u.pm = pm; int pn = i + (pm % nN); if (pn >= nN) pn -= nN; u.pn = pn; u.e = 0; u.a = A; u.b = Bt + (size_t)pn * tstepB; return true; }
    __device__ __forceinline__ unsigned arow(const Unit&, int) const { return 0u; }
};
template <class Epi, bool PAIR> struct EpiApply;
template <class Epi, class Sched, bool GATHER, bool PAIR>
__device__ __forceinline__ void gemm_phase(LAS unsigned char* lds, int tid, int K, int lda, const Sched& S, const Epi& E) {
    const int wid = __builtin_amdgcn_readfirstlane(tid >> 6), lane = tid & 63, wr = wid >> 2, wc = wid & 3, fr = lane & 15, fq = lane >> 4;
    const int nt = K / BK;
    unsigned voffA[2], voffB[2]; int RA[2], CA[2];
#pragma unroll
    for (int i = 0; i < 2; ++i) { int R, C; stage_rc(tid * 16 + i * 8192, R, C); const int Rb = Epi::PERM ? ((R & ~31) + perm32(R & 31)) : R; RA[i] = R; CA[i] = C;
        voffA[i] = (unsigned)(R * lda + C) * 2u; voffB[i] = (unsigned)(Rb * K + C) * 2u; }
    const size_t kstep = (size_t)(BK * 2);
    const size_t hstepA = (size_t)HALF * lda * 2, hstepB = (size_t)HALF * K * 2;
    const unsigned ldsw = (unsigned)wid * 1024u;
    const int aoff = lds_byte(wr * 64 + fr, fq * 8), boff = lds_byte(wc * 32 + fr, fq * 8);
#define PG8_SA(b, h) (((b) * 2 + (h)) * HTB)
#define PG8_SB(b, h) ((4 + (b) * 2 + (h)) * HTB)
#define PG8_STAGE(bufoff, gbase, voff) do { _Pragma("unroll") for (int _i = 0; _i < 2; ++_i) \
        __builtin_amdgcn_global_load_lds((const unsigned*)((const char*)(gbase) + (voff)[_i]), (LAS unsigned*)(lds + (bufoff) + ldsw + _i * 8192), 16, 0, 0); } while (0)
#define PG8_STAGE_A(bufoff, ab, vg, h, koff) do { if (GATHER) { PG8_STAGE(bufoff, (ab) + (koff), (vg)[h]); } else { PG8_STAGE(bufoff, (ab) + (h) * hstepA + (koff), voffA); } } while (0)
#define PG8_LDA(dst, b, h) do { _Pragma("unroll") for (int m = 0; m < 4; ++m) _Pragma("unroll") for (int k = 0; k < 2; ++k) dst[m][k] = *(const LAS bf16x8*)(lds + PG8_SA(b, h) + aoff + m * 2048 + k * 1024); } while (0)
#define PG8_LDB(dst, b, h) do { _Pragma("unroll") for (int n = 0; n < 2; ++n) _Pragma("unroll") for (int k = 0; k < 2; ++k) dst[n][k] = *(const LAS bf16x8*)(lds + PG8_SB(b, h) + boff + n * 2048 + k * 1024); } while (0)
#define PG8_MMA(ai, bj, At, Bt) do { __builtin_amdgcn_s_setprio(1); _Pragma("unroll") for (int m = 0; m < 4; ++m) _Pragma("unroll") for (int n = 0; n < 2; ++n) _Pragma("unroll") for (int k = 0; k < 2; ++k) \
        acc[ai][bj][m][n] = __builtin_amdgcn_mfma_f32_16x16x32_bf16(Bt[n][k], At[m][k], acc[ai][bj][m][n], 0, 0, 0); __builtin_amdgcn_s_setprio(0); } while (0)
#define PG8_WAIT_V(n) asm volatile("s_waitcnt vmcnt(" #n ")" ::: "memory")
#define PG8_WAIT_L(n) asm volatile("s_waitcnt lgkmcnt(" #n ")" ::: "memory")
#define PG8_BAR __builtin_amdgcn_s_barrier()
#define PG8_SCHED __builtin_amdgcn_sched_barrier(0)
    Unit cur, nxt; int ui = 0;
    if (!S.next(0, cur)) return;
    f32x4 acc[2][2][4][2];
#pragma unroll
    for (int a = 0; a < 2; ++a)
#pragma unroll
        for (int b = 0; b < 2; ++b)
#pragma unroll
            for (int m = 0; m < 4; ++m)
#pragma unroll
                for (int n = 0; n < 2; ++n) acc[a][b][m][n] = (f32x4){0.f, 0.f, 0.f, 0.f};
    bf16x8 At[4][2], B0[2][2], B1[2][2];
    unsigned vgc[2][2] = {{0u, 0u}, {0u, 0u}}, vgn[2][2] = {{0u, 0u}, {0u, 0u}};
    if (GATHER) {
#pragma unroll
        for (int h = 0; h < 2; ++h)
#pragma unroll
            for (int i = 0; i < 2; ++i) vgc[h][i] = S.arow(cur, h * HALF + RA[i]) * (unsigned)(lda * 2) + (unsigned)CA[i] * 2u;
    }
    const char* cA = cur.a; const char* cB = cur.b;
    PG8_STAGE(PG8_SB(0, 0), cB, voffB); PG8_STAGE(PG8_SB(0, 1), cB + hstepB, voffB); PG8_STAGE_A(PG8_SA(0, 0), cA, vgc, 0, 0); PG8_STAGE_A(PG8_SA(0, 1), cA, vgc, 1, 0);
    if (wr == 1) PG8_BAR;
    PG8_WAIT_V(2); PG8_BAR;
    PG8_STAGE(PG8_SB(1, 0), cB + kstep, voffB); PG8_STAGE_A(PG8_SA(1, 0), cA, vgc, 0, kstep); PG8_STAGE(PG8_SB(1, 1), cB + hstepB + kstep, voffB);
    PG8_WAIT_V(6); PG8_BAR;
    for (;;) {
        const bool has_next = S.next(ui + 1, nxt);
        const char* nA = has_next ? nxt.a : cA; const char* nB = has_next ? nxt.b : cB;
        if (GATHER) {
#pragma unroll
            for (int h = 0; h < 2; ++h)
#pragma unroll
                for (int i = 0; i < 2; ++i) vgn[h][i] = has_next ? (S.arow(nxt, h * HALF + RA[i]) * (unsigned)(lda * 2) + (unsigned)CA[i] * 2u) : vgc[h][i];
        }
#pragma clang loop unroll(disable)
        for (int t = 0; t < nt; t += 2) {
            const bool last = (t == nt - 2);
            const size_t k1 = (size_t)(t + 1) * kstep;
            const char* a2 = last ? nA : cA; const char* b2 = last ? nB : cB + (size_t)(t + 2) * kstep; const size_t ka2 = last ? 0 : (size_t)(t + 2) * kstep;
            const char* b3 = b2 + kstep; const size_t ka3 = ka2 + kstep;
            unsigned v2[2][2];
#pragma unroll
            for (int h = 0; h < 2; ++h)
#pragma unroll
                for (int i = 0; i < 2; ++i) v2[h][i] = last ? vgn[h][i] : vgc[h][i];
            PG8_LDB(B0, 0, 0); PG8_LDB(B1, 0, 1); PG8_SCHED; PG8_LDA(At, 0, 0); PG8_STAGE_A(PG8_SA(1, 1), cA, vgc, 1, k1);
            PG8_WAIT_V(8); PG8_WAIT_L(0); PG8_BAR; PG8_MMA(0, 0, At, B0); PG8_MMA(0, 1, At, B1); PG8_BAR; PG8_SCHED;
            PG8_LDA(At, 0, 1); PG8_STAGE(PG8_SB(0, 0), b2, voffB); PG8_STAGE(PG8_SB(0, 1), b2 + hstepB, voffB); PG8_STAGE_A(PG8_SA(0, 0), a2, v2, 0, ka2);
            PG8_WAIT_V(8); PG8_WAIT_L(0); PG8_BAR; PG8_MMA(1, 0, At, B0); PG8_MMA(1, 1, At, B1); PG8_BAR; PG8_SCHED;
            PG8_LDB(B0, 1, 0); PG8_LDB(B1, 1, 1); PG8_SCHED; PG8_LDA(At, 1, 0); PG8_STAGE_A(PG8_SA(0, 1), a2, v2, 1, ka2);
            PG8_WAIT_V(8); PG8_WAIT_L(0); PG8_BAR; PG8_MMA(0, 0, At, B0); PG8_MMA(0, 1, At, B1); PG8_BAR; PG8_SCHED;
            PG8_LDA(At, 1, 1); PG8_STAGE(PG8_SB(1, 0), b3, voffB); PG8_STAGE(PG8_SB(1, 1), b3 + hstepB, voffB); PG8_STAGE_A(PG8_SA(1, 0), a2, v2, 0, ka3);
            PG8_WAIT_V(8); PG8_WAIT_L(0); PG8_BAR; PG8_MMA(1, 0, At, B0); PG8_MMA(1, 1, At, B1); PG8_BAR; PG8_SCHED;
        }
        if (wr == 0) PG8_BAR;
        { int fr_ = fr, fq_ = fq; asm volatile("" : "+v"(fr_), "+v"(fq_));
          EpiApply<Epi, PAIR>::run(E, acc, cur, wr, wc, fr_, fq_);
#ifdef PROBE_DUP_EPI
          if (!Epi::INPLACE) { asm volatile("" : "+v"(fr_), "+v"(fq_)); EpiApply<Epi, PAIR>::run(E, acc, cur, wr, wc, fr_, fq_); }
#endif
          }
        if (!has_next) break;
#pragma unroll
        for (int a = 0; a < 2; ++a)
#pragma unroll
            for (int b = 0; b < 2; ++b)
#pragma unroll
                for (int m = 0; m < 4; ++m)
#pragma unroll
                    for (int n = 0; n < 2; ++n) acc[a][b][m][n] = (f32x4){0.f, 0.f, 0.f, 0.f};
        cur = nxt; cA = nA; cB = nB; ++ui;
        if (GATHER) {
#pragma unroll
            for (int h = 0; h < 2; ++h)
#pragma unroll
                for (int i = 0; i < 2; ++i) vgc[h][i] = vgn[h][i];
        }
        if (wr == 1) PG8_BAR;
    }
    PG8_WAIT_V(0);
    PG8_BAR;
#undef PG8_SA
#undef PG8_SB
#undef PG8_STAGE
#undef PG8_STAGE_A
#undef PG8_LDA
#undef PG8_LDB
#undef PG8_MMA
#undef PG8_WAIT_V
#undef PG8_WAIT_L
#undef PG8_BAR
#undef PG8_SCHED
}
template <class Epi> struct EpiApply<Epi, false> {
    static __device__ __forceinline__ void run(const Epi& E, const f32x4 (&acc)[2][2][4][2], const Unit& u, int wr, int wc, int fr, int fq) {
#pragma unroll
        for (int ai = 0; ai < 2; ++ai) {
            typename Epi::Pre pre[4][2];
#pragma unroll
            for (int m = 0; m < 4; ++m) { const int row = u.pm * BM + ai * HALF + wr * 64 + m * 16 + fr;
#pragma unroll
                for (int bj = 0; bj < 2; ++bj) pre[m][bj] = E.pre(u, row, u.pn * BM + bj * HALF + wc * 32 + (Epi::PERM ? 8 : 4) * fq); }
#pragma unroll
            for (int m = 0; m < 4; ++m) { const int row = u.pm * BM + ai * HALF + wr * 64 + m * 16 + fr;
#pragma unroll
                for (int bj = 0; bj < 2; ++bj) {
                    if constexpr (Epi::PERM) E.fin8(u, row, u.pn * BM + bj * HALF + wc * 32 + 8 * fq, acc[ai][bj][m][0], acc[ai][bj][m][1], pre[m][bj]);
                    else E.fin4x2(u, row, u.pn * BM + bj * HALF + wc * 32 + 4 * fq, acc[ai][bj][m][0], acc[ai][bj][m][1], pre[m][bj]); } }
        }
    }
};
template <class Epi> struct EpiApply<Epi, true> {
    static __device__ __forceinline__ void run(const Epi& E, const f32x4 (&acc)[2][2][4][2], const Unit& u, int wr, int wc, int fr, int fq) {
#pragma unroll
        for (int ai = 0; ai < 2; ++ai)
#pragma unroll
            for (int m = 0; m < 4; ++m) { const int row = u.pm * BM + ai * HALF + wr * 64 + m * 16 + fr;
                E.putp8(u, row, u.pn * HALF + wc * 32 + 8 * fq, acc[ai][0][m][0], acc[ai][0][m][1], acc[ai][1][m][0], acc[ai][1][m][1]); }
    }
};
}

__device__ __forceinline__ void rowstat_pass(Frame& F, int r_first, int r_stride, int r_end) {
    const bf16_t* H = (const bf16_t*)(F.ws + WS_H); float* rstd = (float*)(F.ws + WS_RSTD);
    for (int m = r_first; m < r_end; m += r_stride) {
        const bf16_t* hr = H + (size_t)m * HP;
        const u32x2 q = *((const u32x2*)(hr + HC_CQ_LAT) + F.lane);
        const unsigned kv = *((const unsigned*)(hr + HC_CKV) + F.lane);
        float a0 = bf2f(q.x & 0xffff), a1 = bf2f(q.x >> 16), a2 = bf2f(q.y & 0xffff), a3 = bf2f(q.y >> 16), b0 = bf2f(kv & 0xffff), b1 = bf2f(kv >> 16);
        const float sq = wave_sum(a0 * a0 + a1 * a1 + a2 * a2 + a3 * a3), sk = wave_sum(b0 * b0 + b1 * b1);
        if (F.lane == 0) { rstd[2 * m] = 1.0f / sqrtf(sq * (1.0f / 256.0f) + RMS_EPS); rstd[2 * m + 1] = 1.0f / sqrtf(sk * (1.0f / 128.0f) + RMS_EPS); }
    }
}
__device__ __forceinline__ void red8(float (&v)[8], int lane) {
    float a[4], b[2], c;
#pragma unroll
    for (int i = 0; i < 4; ++i) a[i] = xpair32(v[i], v[i + 4]);
    { const bool up = (lane & 16) != 0;
#pragma unroll
      for (int i = 0; i < 2; ++i) { const float send = up ? a[i] : a[i + 2], keep = up ? a[i + 2] : a[i]; b[i] = keep + shx<16>(send); } }
    { const bool up = (lane & 8) != 0; const float send = up ? b[0] : b[1], keep = up ? b[1] : b[0]; c = keep + shx<8>(send); }
    c += shx<4>(c); c += shx<2>(c); c += shx<1>(c);
#pragma unroll
    for (int i = 0; i < 8; ++i) v[i] = __uint_as_float(__builtin_amdgcn_readlane(__float_as_uint(c), ((i >> 2) & 1) * 32 + ((i >> 1) & 1) * 16 + (i & 1) * 8));
}
__device__ __forceinline__ void red4(float (&v)[4], int lane) {
    float a[2], c;
#pragma unroll
    for (int i = 0; i < 2; ++i) a[i] = xpair32(v[i], v[i + 2]);
    { const bool up = (lane & 16) != 0; const float send = up ? a[0] : a[1], keep = up ? a[1] : a[0]; c = keep + shx<16>(send); }
    c += shx<8>(c); c += shx<4>(c); c += shx<2>(c); c += shx<1>(c);
#pragma unroll
    for (int i = 0; i < 4; ++i) v[i] = __uint_as_float(__builtin_amdgcn_readlane(__float_as_uint(c), ((i >> 1) & 1) * 32 + (i & 1) * 16));
}
__device__ __forceinline__ void ln1_route_pass(Frame& F, const Args& a, int layer, int r_first, int r_stride, int r_end) {
    bf16_t* XB = (bf16_t*)(F.ws + WS_XB); float* tw = (float*)(F.ws + WS_TW); int* list = (int*)(F.ws + WS_LIST);
    const float* g = a.ln1_g + layer * DM; const float* bb = a.ln1_b + layer * DM;
    const float* wc = a.moe_w_coarse + (size_t)layer * DM * 4; const float* wf = a.moe_w_fine + (size_t)layer * 4 * DM * 8;
    for (int q = F.tid; q < 4 * 1024 * 2; q += NTHREADS) { const int hf = q & 1, k = (q >> 1) & 1023, gg = q >> 11; const int l = (k & 255) >> 2, e = k & 3, j = k >> 8;
        *(LAS f32x4*)(F.lds + (size_t)(gg * 2048 + ((j * 4 + e) * 2 + hf) * 64 + l) * 16) = *((const f32x4*)wf + q); }
    f32x4 wcr[4][4];
#pragma unroll
    for (int j = 0; j < 4; ++j)
#pragma unroll
        for (int e = 0; e < 4; ++e) wcr[j][e] = *(const f32x4*)(wc + (size_t)(4 * F.lane + 256 * j + e) * 4);
    __syncthreads();
    LAS int* lcnt = (LAS int*)(F.lds + RING_BYTES + 1024); LAS int* lbase = lcnt + 32; LAS int* rec_er = lcnt + 64; LAS int* rec_a = rec_er + 512; LAS float* rec_w = (LAS float*)(rec_a + 512); float* lw = (float*)(F.ws + WS_LW);
  for (int c_first = r_first; c_first < r_end; c_first += 32 * r_stride) {
    const int c_end = (c_first + 32 * r_stride < r_end) ? c_first + 32 * r_stride : r_end;
    if (F.tid < 32) lcnt[F.tid] = 0;
    for (int q = F.tid; q < 512; q += NTHREADS) rec_a[q] = -1;
    __syncthreads();
    f32x4 vn[2][4];
#pragma unroll
    for (int rr = 0; rr < 2; ++rr) { const int mm = c_first + rr * r_stride; if (mm < c_end) {
#pragma unroll
        for (int j = 0; j < 4; ++j) vn[rr][j] = *((const f32x4*)(a.out + (size_t)mm * DM) + F.lane + 64 * j); } }
    for (int m0 = c_first; m0 < c_end; m0 += 2 * r_stride) {
        f32x4 vc[2][4];
#pragma unroll
        for (int rr = 0; rr < 2; ++rr)
#pragma unroll
            for (int j = 0; j < 4; ++j) vc[rr][j] = vn[rr][j];
#pragma unroll
        for (int rr = 0; rr < 2; ++rr) { const int mm = m0 + (2 + rr) * r_stride; if (mm < c_end) {
#pragma unroll
            for (int j = 0; j < 4; ++j) vn[rr][j] = *((const f32x4*)(a.out + (size_t)mm * DM) + F.lane + 64 * j); } }
#pragma unroll
      for (int rr = 0; rr < 2; ++rr) { const int m = m0 + rr * r_stride; if (m < c_end) {
        f32x4 v[4]; float s = 0.f;
#pragma unroll
        for (int j = 0; j < 4; ++j) { v[j] = vc[rr][j]; s += (v[j].x + v[j].y) + (v[j].z + v[j].w); }
        const float mean = wave_sum(s) * (1.f / DM); float s2 = 0.f;
#pragma unroll
        for (int j = 0; j < 4; ++j) { v[j] = v[j] - mean; s2 += (v[j].x * v[j].x + v[j].y * v[j].y) + (v[j].z * v[j].z + v[j].w * v[j].w); }
        const float rs = 1.f / sqrtf(wave_sum(s2) * (1.f / DM) + LN_EPS);
        float cl[4] = {0.f, 0.f, 0.f, 0.f};
#pragma unroll
        for (int j = 0; j < 4; ++j) { const int c = 4 * F.lane + 256 * j; const f32x4 gg = *(const f32x4*)(g + c), bv = *(const f32x4*)(bb + c); v[j] = v[j] * rs * gg + bv;
            u32x2 w; w.x = pk2(v[j].x, v[j].y); w.y = pk2(v[j].z, v[j].w); *((u32x2*)(XB + (size_t)m * DM) + F.lane + 64 * j) = w;
#pragma unroll
            for (int e = 0; e < 4; ++e) { const f32x4 w4 = wcr[j][e]; const float xe = v[j][e]; cl[0] += xe * w4.x; cl[1] += xe * w4.y; cl[2] += xe * w4.z; cl[3] += xe * w4.w; } }
        red4(cl, F.lane);
        int grp = 0; float cm = cl[0];
#pragma unroll
        for (int e = 1; e < 4; ++e) if (cl[e] > cm) { cm = cl[e]; grp = e; }
        float den = 0.f;
#pragma unroll
        for (int e = 0; e < 4; ++e) den += __expf(cl[e] - cm);
        const float pg = 1.0f / den;
        grp = __builtin_amdgcn_readfirstlane(grp);
        const LAS f32x4* wl = (const LAS f32x4*)(F.lds) + grp * 2048 + F.lane;
        float fl[8] = {0.f, 0.f, 0.f, 0.f, 0.f, 0.f, 0.f, 0.f};
#pragma unroll
        for (int j = 0; j < 4; ++j)
#pragma unroll
            for (int e = 0; e < 4; ++e) { const f32x4 wa = wl[((j * 4 + e) * 2) * 64], wb = wl[((j * 4 + e) * 2 + 1) * 64]; const float xe = v[j][e];
                fl[0] += xe * wa.x; fl[1] += xe * wa.y; fl[2] += xe * wa.z; fl[3] += xe * wa.w; fl[4] += xe * wb.x; fl[5] += xe * wb.y; fl[6] += xe * wb.z; fl[7] += xe * wb.w; }
        red8(fl, F.lane);
        int i0 = 0; float v0 = fl[0];
#pragma unroll
        for (int e = 1; e < 8; ++e) if (fl[e] > v0) { v0 = fl[e]; i0 = e; }
        int i1 = -1; float v1 = -3.0e38f;
#pragma unroll
        for (int e = 0; e < 8; ++e) if (e != i0 && fl[e] > v1) { v1 = fl[e]; i1 = e; }
        const float e1 = __expf(v1 - v0), w0 = pg / (1.0f + e1), w1 = pg * e1 / (1.0f + e1);
        if (F.lane < 2) { const int e = grp * 8 + (F.lane == 0 ? i0 : i1); const int a_id = 2 * m + F.lane;
            const int lr = __hip_atomic_fetch_add(lcnt + e, 1, __ATOMIC_RELAXED, __HIP_MEMORY_SCOPE_WORKGROUP);
            const int ri = (((m - c_first) / r_stride) * NWAVES + F.wave) * 2 + F.lane;
            rec_er[ri] = (e << 16) | lr; rec_a[ri] = a_id; rec_w[ri] = (F.lane == 0) ? w0 : w1; tw[a_id] = (F.lane == 0) ? w0 : w1; }
          } }
    }
    __syncthreads();
    if (F.tid < 32) { const int n = lcnt[F.tid]; lbase[F.tid] = n ? (int)__hip_atomic_fetch_add(F.ctl + CW_CNT + layer * 64 + F.tid, (unsigned)n, RLX_AGENT) : 0; }
    __syncthreads();
    for (int q = F.tid; q < 512; q += NTHREADS) { const int aid = rec_a[q]; if (aid >= 0) { const int er = rec_er[q], e = er >> 16; const size_t li = (size_t)e * LIST_CAP + lbase[e] + (er & 0xffff); list[li] = aid; lw[li] = rec_w[q]; } }
    __syncthreads();
  }
    __syncthreads();
}
__device__ __forceinline__ void ln2_pass(Frame& F, const Args& a, int layer, int r_first, int r_stride, int r_end) {
    bf16_t* XB = (bf16_t*)(F.ws + WS_XB); const bf16_t* YB = (const bf16_t*)(F.ws + WS_YB);
    const float* g = a.ln2_g + layer * DM; const float* bb = a.ln2_b + layer * DM; const float* g1 = a.ln1_g + layer * DM; const float* b1 = a.ln1_b + layer * DM;
    f32x4 xn[2][4]; u32x2 pn[2][4], qn[2][4];
#define LN2_LOAD(rr, mm) do { const bf16_t* y0_ = YB + (size_t)(2 * (mm)) * DM; _Pragma("unroll") for (int j = 0; j < 4; ++j) { xn[rr][j] = *((const f32x4*)(a.out + (size_t)(mm) * DM) + F.lane + 64 * j); \
        pn[rr][j] = *((const u32x2*)y0_ + F.lane + 64 * j); qn[rr][j] = *((const u32x2*)(y0_ + DM) + F.lane + 64 * j); } } while (0)
#pragma unroll
    for (int rr = 0; rr < 2; ++rr) { const int mm = r_first + rr * r_stride; if (mm < r_end) LN2_LOAD(rr, mm); }
    for (int m0 = r_first; m0 < r_end; m0 += 2 * r_stride) {
        f32x4 xc[2][4]; u32x2 pc[2][4], qc[2][4];
#pragma unroll
        for (int rr = 0; rr < 2; ++rr)
#pragma unroll
            for (int j = 0; j < 4; ++j) { xc[rr][j] = xn[rr][j]; pc[rr][j] = pn[rr][j]; qc[rr][j] = qn[rr][j]; }
#pragma unroll
        for (int rr = 0; rr < 2; ++rr) { const int mm = m0 + (2 + rr) * r_stride; if (mm < r_end) LN2_LOAD(rr, mm); }
#pragma unroll
        for (int rr = 0; rr < 2; ++rr) { const int m = m0 + rr * r_stride; if (m < r_end) {
            float* xr = a.out + (size_t)m * DM;
            f32x4 v[4]; float s = 0.f;
            { float s1 = 0.f;
#pragma unroll
              for (int j = 0; j < 4; ++j) { v[j] = xc[rr][j]; s1 += (v[j].x + v[j].y) + (v[j].z + v[j].w); }
              const float mean1 = wave_sum(s1) * (1.f / DM); float q1 = 0.f;
#pragma unroll
              for (int j = 0; j < 4; ++j) { v[j] = v[j] - mean1; q1 += (v[j].x * v[j].x + v[j].y * v[j].y) + (v[j].z * v[j].z + v[j].w * v[j].w); }
              const float rs1 = 1.f / sqrtf(wave_sum(q1) * (1.f / DM) + LN_EPS);
#pragma unroll
              for (int j = 0; j < 4; ++j) { const int c = 4 * F.lane + 256 * j; xc[rr][j] = v[j] * rs1 * *(const f32x4*)(g1 + c) + *(const f32x4*)(b1 + c); } }
#pragma unroll
            for (int j = 0; j < 4; ++j) { v[j] = xc[rr][j] * DN_ALPHA; const u32x2 p = pc[rr][j], q = qc[rr][j];
                v[j].x += bf2f(p.x & 0xffff) + bf2f(q.x & 0xffff); v[j].y += bf2f(p.x >> 16) + bf2f(q.x >> 16); v[j].z += bf2f(p.y & 0xffff) + bf2f(q.y & 0xffff); v[j].w += bf2f(p.y >> 16) + bf2f(q.y >> 16);
                s += (v[j].x + v[j].y) + (v[j].z + v[j].w); }
            const float mean = wave_sum(s) * (1.f / DM); float s2 = 0.f;
#pragma unroll
            for (int j = 0; j < 4; ++j) { v[j] = v[j] - mean; s2 += (v[j].x * v[j].x + v[j].y * v[j].y) + (v[j].z * v[j].z + v[j].w * v[j].w); }
            const float rs = 1.f / sqrtf(wave_sum(s2) * (1.f / DM) + LN_EPS);
#pragma unroll
            for (int j = 0; j < 4; ++j) { const int c = 4 * F.lane + 256 * j; const f32x4 gg = *(const f32x4*)(g + c), bv = *(const f32x4*)(bb + c); v[j] = v[j] * rs * gg + bv;
                *((f32x4*)xr + F.lane + 64 * j) = v[j];
                if (layer + 1 < DEPTH) { u32x2 w; w.x = pk2(v[j].x, v[j].y); w.y = pk2(v[j].z, v[j].w); *((u32x2*)(XB + (size_t)m * DM) + F.lane + 64 * j) = w; } }
        } }
    }
#undef LN2_LOAD
}
__device__ __forceinline__ void moe_convert(Frame& F, const Args& a, int layer) {
    LAS float* scr = (LAS float*)(F.lds + F.wave * 16384);
    constexpr int I_13 = (1024 / 64) * (1024 / 32), I_2 = (512 / 64) * (1024 / 32), PER_E = I_13 + I_2;
    for (int it = F.gw; it < NEXP * PER_E; it += F.NGW) {
        const int e = it / PER_E; int r = it - e * PER_E; const size_t le = (size_t)layer * NEXP + e;
        if (r < I_13) { const int kb = r / 32, nb = r % 32; const float* src = ((nb >> 2) & 1) ? a.moe_w3 : a.moe_w1;
            const int sc0 = ((32 * nb) >> 8) * 128 + ((32 * nb) & 127);
            transpose_item_v4(src + le * 1024 * 512 + (size_t)(kb * 64) * 512 + sc0, 512, (bf16_t*)(F.ws + WS_W13) + (size_t)e * 1024 * 1024 + (size_t)(nb * 32) * 1024 + kb * 64, 1024, scr, F.lane); }
        else { r -= I_13; const int kb = r / 32, nb = r % 32;
            transpose_item_v4(a.moe_w2 + le * 512 * 1024 + (size_t)(kb * 64) * 1024 + nb * 32, 1024, (bf16_t*)(F.ws + WS_W2) + (size_t)e * 1024 * 512 + (size_t)(nb * 32) * 512 + kb * 64, 512, scr, F.lane); }
    }
}

typedef short at_s16x4 __attribute__((ext_vector_type(4)));
typedef LAS const unsigned char* at_lds_cptr;
__device__ __forceinline__ at_s16x4 at_vtr(at_lds_cptr p) { return __builtin_bit_cast(at_s16x4, __builtin_amdgcn_ds_read_tr16_b64_v4i16((LAS at_s16x4*)p)); }
struct RowSrc { const bf16_t* p; long pitch; };
constexpr int SA_P = 0, SA_V = 4096, SA_AL = 12288, SA_RL = 12544;
template <int NC0, int NC1, int MODE>
__device__ __forceinline__ void sattn_core(const bf16x8* qf, RowSrc k0, RowSrc k1, RowSrc vs, int kb_lo, int kb_hi, int qidx0, float lse_ref, LAS unsigned char* scr, int lane, f32x16* o, float& lse_out) {
    const int r32 = lane & 31, hi = lane >> 5;
    LAS bf16_t* Pb = (LAS bf16_t*)(scr + SA_P); LAS bf16_t* Vb = (LAS bf16_t*)(scr + SA_V); LAS float* Al = (LAS float*)(scr + SA_AL);
    float m = -1.0e30f, l = 0.f;
    if (MODE != 1) { o[0] = f32x16{}; o[1] = f32x16{}; }
    bf16x8 kn[NC0 + NC1]; u32x4 vn[4];
#define SA_LOAD(kb_) do { const long key_ = (long)(kb_) * 32 + r32; \
        _Pragma("unroll") for (int c = 0; c < NC0; ++c) kn[c] = *(const bf16x8*)(k0.p + key_ * k0.pitch + 16 * c + 8 * hi); \
        _Pragma("unroll") for (int c = 0; c < NC1; ++c) kn[NC0 + c] = *(const bf16x8*)(k1.p + key_ * k1.pitch + 16 * c + 8 * hi); \
        if (MODE != 1) { _Pragma("unroll") for (int i = 0; i < 4; ++i) { const int idx = i * 64 + lane, kr = idx >> 3, pc = idx & 7; vn[i] = *(const u32x4*)(vs.p + ((long)(kb_) * 32 + kr) * vs.pitch + pc * 8); } } } while (0)
    if (kb_lo < kb_hi) SA_LOAD(kb_lo);
    const at_lds_cptr vtb = (at_lds_cptr)(scr + SA_V) + ((8 * hi + ((lane & 15) >> 2)) * 72 + 16 * ((lane >> 4) & 1) + 4 * (lane & 3)) * 2;
    for (int kb = kb_lo; kb < kb_hi; ++kb) {
        bf16x8 kc[NC0 + NC1]; u32x4 vc[4];
#pragma unroll
        for (int c = 0; c < NC0 + NC1; ++c) kc[c] = kn[c];
#pragma unroll
        for (int i = 0; i < 4; ++i) vc[i] = vn[i];
        if (kb + 1 < kb_hi) SA_LOAD(kb + 1);
        f32x16 s = {};
#pragma unroll
        for (int c = 0; c < NC0 + NC1; ++c) s = MFMA32(kc[c], qf[c], s);
        bool valid[16];
#pragma unroll
        for (int r = 0; r < 16; ++r) { if (MODE == 0) valid[r] = true; else { const int d = kb * 32 + crow(r, hi) - (qidx0 + r32); valid[r] = (d <= 64 && d >= -64); } }
        float p[16];
        if (MODE == 2) {
#pragma unroll
            for (int r = 0; r < 16; ++r) p[r] = valid[r] ? fast_exp2(s[r] - lse_ref) : 0.f;
        } else {
            float mx = -1.0e30f;
#pragma unroll
            for (int r = 0; r < 16; ++r) if (valid[r]) mx = fmaxf(mx, s[r]);
            mx = xmax32(mx);
            const float mn = fmaxf(m, mx), alpha = fast_exp2(m - mn); m = mn;
            float ps = 0.f;
#pragma unroll
            for (int r = 0; r < 16; ++r) { p[r] = valid[r] ? fast_exp2(s[r] - mn) : 0.f; ps += p[r]; }
            l = l * alpha + ps;
            if (MODE == 0) { if (hi == 0) Al[r32] = alpha; }
        }
        if (MODE != 1) {
#pragma unroll
            for (int g = 0; g < 4; ++g) { u32x2 w; w.x = pk2(p[4 * g], p[4 * g + 1]); w.y = pk2(p[4 * g + 2], p[4 * g + 3]); *(LAS u32x2*)(Pb + r32 * 40 + 8 * g + 4 * hi) = w; }
#pragma unroll
            for (int i = 0; i < 4; ++i) { const int idx = i * 64 + lane, kr = idx >> 3, pc = idx & 7; *(LAS u32x4*)(Vb + kr * 72 + pc * 8) = vc[i]; }
            LDS_WAIT();
            if (MODE == 0) {
#pragma unroll
                for (int r = 0; r < 16; ++r) { const float al = Al[crow(r, hi)]; o[0][r] *= al; o[1][r] *= al; }
            }
#pragma unroll
            for (int st = 0; st < 2; ++st) {
                const bf16x8 pf = *(const LAS bf16x8*)(Pb + r32 * 40 + 16 * st + 8 * hi);
#pragma unroll
                for (int db = 0; db < 2; ++db) {
                    const at_s16x4 lo_ = at_vtr(vtb + (16 * st * 72 + 32 * db) * 2), hi_ = at_vtr(vtb + ((16 * st + 4) * 72 + 32 * db) * 2);
                    const bf16x8 vf = {lo_[0], lo_[1], lo_[2], lo_[3], hi_[0], hi_[1], hi_[2], hi_[3]};
                    o[db] = MFMA32(pf, vf, o[db]); }
            }
            LDS_WAIT();
        }
    }
#undef SA_LOAD
    if (MODE != 2) { l = xsum32(l); lse_out = m + __log2f(l); }
    if (MODE == 0) {
        LAS float* Rl = (LAS float*)(scr + SA_RL);
        if (hi == 0) Rl[r32] = 1.0f / l;
        LDS_WAIT();
#pragma unroll
        for (int r = 0; r < 16; ++r) { const float rl = Rl[crow(r, hi)]; o[0][r] *= rl; o[1][r] *= rl; }
        LDS_WAIT();
    }
}

__device__ __forceinline__ void sattn_phase(Frame& F, const Args& a, int layer, int kind_lo) {
    const bf16_t* H = (const bf16_t*)(F.ws + WS_H); const bf16_t* QB = (const bf16_t*)(F.ws + WS_QB); const bf16_t* KVB = (const bf16_t*)(F.ws + WS_KVB);
    bf16_t* MIX = (bf16_t*)(F.ws + WS_MIX); const float* lsec = (const float*)(F.ws + WS_LSEC);
    LAS unsigned char* scr = F.lds + F.wave * 16384;
    const int lane = F.lane, r32 = lane & 31, hi = lane >> 5;
    float lam, lam_init;
    { const float* lv = a.diff_lambda + layer * 128; float d1 = 0.f, d2 = 0.f;
      for (int i = 0; i < 32; ++i) { d1 += lv[i] * lv[32 + i]; d2 += lv[64 + i] * lv[96 + i]; }
      lam_init = 0.8f - 0.6f * expf(-0.3f * (float)layer); lam = expf(d1) - expf(d2) + lam_init; }
    constexpr int NRB = NTOK / 32;
    const int items = NRB * (4 + 6 + 6);
    for (int it = kind_lo * NRB + F.gw; it < items; it += F.NGW) {
        const int kind = it / NRB, rb = it - kind * NRB; const int m0 = rb * 32; const SeqInfo si = seqinfo(m0);
#if !OPT_ATTN
        if (kind < 4) {
            const int h = kind; f32x16 o0[2], o1[2]; float dummy;
            for (int c = 0; c < 2; ++c) {
                bf16x8 qf[2];
#pragma unroll
                for (int d0 = 0; d0 < 2; ++d0) qf[d0] = *(const bf16x8*)(H + (size_t)(m0 + r32) * HP + HC_AQ + h * 64 + c * 32 + 16 * d0 + 8 * hi);
                const RowSrc ks{H + (size_t)si.base * HP + HC_AK + h * 64 + c * 32, HP}, vs{H + (size_t)si.base * HP + HC_AV + h * 64, HP};
                sattn_core<2, 0, 0>(qf, ks, ks, vs, 0, si.len / 32, 0, 0.f, scr, lane, c == 0 ? o0 : o1, dummy);
            }
            const float* sg = a.diff_subln + layer * 64; const float g0 = sg[r32], g1 = sg[32 + r32];
#pragma unroll
            for (int r = 0; r < 16; ++r) { const float x0 = o0[0][r] - lam * o1[0][r], x1 = o0[1][r] - lam * o1[1][r]; float ss = x0 * x0 + x1 * x1;
                ss += shx<1>(ss); ss += shx<2>(ss); ss += shx<4>(ss); ss += shx<8>(ss); ss += shx<16>(ss);
                const float rs = (1.0f - lam_init) / sqrtf(ss * (1.0f / 64.0f) + RMS_EPS);
                bf16_t* op = MIX + (size_t)(m0 + crow(r, hi)) * DM + MIX_A + h * 64 + r32;
                op[0] = (bf16_t)f2bf(x0 * rs * g0); op[32] = (bf16_t)f2bf(x1 * rs * g1); }
        } else if (kind < 10) {
            const int h = kind - 4; f32x16 o[2]; float dummy; bf16x8 qf[6];
#pragma unroll
            for (int d0 = 0; d0 < 6; ++d0) qf[d0] = *(const bf16x8*)(QB + (size_t)(m0 + r32) * QBP + h * 96 + 16 * d0 + 8 * hi);
            const RowSrc k0{KVB + (size_t)si.base * KVP + h * 128, KVP}, k1{H + (size_t)si.base * HP + HC_KROPE, HP}, vs{KVB + (size_t)si.base * KVP + h * 128 + 64, KVP};
            sattn_core<4, 2, 0>(qf, k0, k1, vs, 0, si.len / 32, 0, 0.f, scr, lane, o, dummy);
#pragma unroll
            for (int r = 0; r < 16; ++r) { bf16_t* op = MIX + (size_t)(m0 + crow(r, hi)) * DM + MIX_B + h * 64 + r32; op[0] = (bf16_t)f2bf(o[0][r]); op[32] = (bf16_t)f2bf(o[1][r]); }
        } else
#endif
        {
            const int gj = kind - 10, g = gj >> 1, hh = gj;
            const int dil = (g == 0) ? 1 : (g == 1 ? 4 : 16); const int L = si.len / dil, bpr = L / 32;
            const int w = (m0 - si.base) / 32, rho = w / bpr, ib = w - rho * bpr, i0 = ib * 32;
            const size_t qrow = (size_t)si.base + (size_t)(i0 + r32) * dil + rho;
            bf16x8 qf[4];
#pragma unroll
            for (int d0 = 0; d0 < 4; ++d0) qf[d0] = *(const bf16x8*)(H + qrow * HP + HC_CQ + hh * 64 + 16 * d0 + 8 * hi);
            const int j = gj & 1; const float l0 = lsec[(0 * (size_t)NTOK + qrow) * 2 + j], l1 = lsec[(1 * (size_t)NTOK + qrow) * 2 + j], l2 = lsec[(2 * (size_t)NTOK + qrow) * 2 + j];
            const float lm = fmaxf(l0, fmaxf(l1, l2)); const float lref = lm + __log2f(fast_exp2(l0 - lm) + fast_exp2(l1 - lm) + fast_exp2(l2 - lm));
            const RowSrc ks{H + ((size_t)si.base + rho) * HP + HC_CK + hh * 64, (long)HP * dil}, vs{H + ((size_t)si.base + rho) * HP + HC_CV + hh * 64, (long)HP * dil};
            int kb_lo = ib - 2, kb_hi = ib + 3; if (kb_lo < 0) kb_lo = 0; if (kb_hi > bpr) kb_hi = bpr;
            f32x16 o[2]; float dummy;
            sattn_core<4, 0, 2>(qf, ks, ks, vs, kb_lo, kb_hi, i0, lref, scr, lane, o, dummy);
#pragma unroll
            for (int r = 0; r < 16; ++r) { const size_t orow = (size_t)si.base + (size_t)(i0 + crow(r, hi)) * dil + rho; bf16_t* op = MIX + orow * DM + MIX_C + hh * 64 + r32; op[0] = (bf16_t)f2bf(o[0][r]); op[32] = (bf16_t)f2bf(o[1][r]); }
        }
    }
}
__device__ __forceinline__ void cstat_phase(Frame& F) {
    const bf16_t* H = (const bf16_t*)(F.ws + WS_H); float* lsec = (float*)(F.ws + WS_LSEC);
    LAS unsigned char* scr = F.lds + F.wave * 16384;
    const int lane = F.lane, r32 = lane & 31, hi = lane >> 5;
    constexpr int NRB = NTOK / 32;
    for (int it = F.gw; it < NRB * 6; it += F.NGW) {
        const int gj = it / NRB, rb = it - gj * NRB, g = gj >> 1, j = gj & 1; const int m0 = rb * 32; const SeqInfo si = seqinfo(m0);
        const int dil = (g == 0) ? 1 : (g == 1 ? 4 : 16); const int L = si.len / dil, bpr = L / 32;
        const int w = (m0 - si.base) / 32, rho = w / bpr, ib = w - rho * bpr, i0 = ib * 32;
        const size_t qrow = (size_t)si.base + (size_t)(i0 + r32) * dil + rho;
        bf16x8 qf[4];
#pragma unroll
        for (int d0 = 0; d0 < 4; ++d0) qf[d0] = *(const bf16x8*)(H + qrow * HP + HC_CQ + gj * 64 + 16 * d0 + 8 * hi);
        const RowSrc ks{H + ((size_t)si.base + rho) * HP + HC_CK + gj * 64, (long)HP * dil};
        int kb_lo = ib - 2, kb_hi = ib + 3; if (kb_lo < 0) kb_lo = 0; if (kb_hi > bpr) kb_hi = bpr;
        float lse; sattn_core<4, 0, 1>(qf, ks, ks, ks, kb_lo, kb_hi, i0, 0.f, scr, lane, nullptr, lse);
        if (hi == 0) lsec[((size_t)g * NTOK + qrow) * 2 + j] = lse;
    }
}


namespace at {
typedef short s16x4 __attribute__((ext_vector_type(4)));
typedef short v4i16_t __attribute__((ext_vector_type(4)));
typedef LAS const unsigned char* lds_cptr;
constexpr int LDS_K = 0, KSLOT_MAX = 12288, LDS_V = 3 * KSLOT_MAX, VSLOT = 8192, LDS_WS = LDS_V + 3 * VSLOT, LDS_OST = LDS_WS + 8 * 256, LDS_TOTAL = LDS_OST + 8 * 8192;
static_assert(LDS_TOTAL <= RING_BYTES, "attention LDS");
constexpr float THR = 8.0f;
__device__ __forceinline__ void glds16(const void* g, unsigned lds_dst) {
    unsigned keep; asm volatile("s_mov_b32 %0, m0\n\ts_mov_b32 m0, %2\n\ts_nop 0\n\tglobal_load_lds_dwordx4 %1, off\n\ts_mov_b32 m0, %0" : "=&s"(keep) : "v"(g), "s"(lds_dst) : "memory"); }
__device__ __forceinline__ s16x4 vtr(lds_cptr p) { return __builtin_bit_cast(s16x4, __builtin_amdgcn_ds_read_tr16_b64_v4i16((LAS v4i16_t*)p)); }
__device__ __forceinline__ unsigned cvtpk(float lo, float hi) { typedef float f2 __attribute__((ext_vector_type(2))); typedef __bf16 b2 __attribute__((ext_vector_type(2))); f2 v = {lo, hi}; b2 b = __builtin_convertvector(v, b2); return __builtin_bit_cast(unsigned, b); }
#define AT_MX3(a, b, c) __builtin_fmaxf(__builtin_fmaxf((a), (b)), (c))
__device__ __forceinline__ float rowmax(const f32x16& p0, const f32x16& p1) {
    float a = AT_MX3(p0[0], p0[1], p1[0]), b = AT_MX3(p0[2], p0[3], p1[1]); a = AT_MX3(a, p1[2], p1[3]);
#pragma unroll
    for (int r = 4; r < 16; r += 4) { a = AT_MX3(a, p0[r], p0[r + 1]); b = AT_MX3(b, p0[r + 2], p0[r + 3]); a = AT_MX3(a, p1[r], p1[r + 1]); b = AT_MX3(b, p1[r + 2], p1[r + 3]); }
    float m = __builtin_fmaxf(a, b); auto rr = __builtin_amdgcn_permlane32_swap(__float_as_uint(m), __float_as_uint(m), false, false);
    return __builtin_fmaxf(__uint_as_float(rr[0]), __uint_as_float(rr[1])); }
#define AT_WAIT_BAR(N) asm volatile("s_waitcnt vmcnt(" #N ") lgkmcnt(0)\n\ts_barrier" ::: "memory")

struct Src { const bf16_t* p; long pitch; };
template <int NC, int NK0, int NK1>
__device__ __forceinline__ void stream(LAS unsigned char* lds, int tid, const bf16_t* qrow, Src k0, Src k1, Src vs, int NT, f32x16& o0, f32x16& o1, float& lsum) {
    asm volatile("" : "+v"(tid));
    constexpr int SLOTK = 2 * NC * 1024;
    const int lane = tid & 63, r32 = lane & 31, hi = lane >> 5; const int wid = __builtin_amdgcn_readfirstlane(tid >> 6);
    const unsigned lds0 = (unsigned)(uintptr_t)lds;
    LAS float* wsf = (LAS float*)(lds + LDS_WS) + wid * 64;
    constexpr int P0 = NK0 * 16;
    const bool hasA = (NK0 == 8) || (wid < 4), hasB = (NK1 > 0) && (wid < 4);
    const int pA = (NK0 == 8) ? wid : (wid & 3);
    const int rowA = (NK0 == 8) ? pA * 8 + (lane >> 3) : pA * 16 + (lane >> 2);
    const int chA = (NK0 == 8) ? ((lane & 7) ^ ((4 * pA + (lane >> 4)) & 7)) : ((lane & 3) ^ ((lane >> 4) & 3));
    const bf16_t* ksA = k0.p + (long)rowA * k0.pitch + chA * 8;
    const int rowB = (wid & 3) * 16 + (lane >> 2), chB = (lane & 3) ^ ((lane >> 4) & 3);
    const bf16_t* ksB = (NK1 > 0) ? k1.p + (long)rowB * k1.pitch + chB * 8 : k0.p;
    const bf16_t* vsp = vs.p + (long)(16 * (wid & 3) + (lane >> 2)) * vs.pitch + (wid >> 2) * 32 + (lane & 3) * 8;
    const unsigned kdA = lds0 + LDS_K + pA * 1024, kdB = lds0 + LDS_K + (NK0 + (wid & 3)) * 1024, vd = lds0 + LDS_V + wid * 1024;
    const long ktA = 64 * k0.pitch, ktB = 64 * k1.pitch, vt = 64 * vs.pitch;
    const int nd = (hasA ? 1 : 0) + (hasB ? 1 : 0) + 1;
#define AT_DMA_K(t, slot) do { if (hasA) glds16(ksA + (long)(t) * ktA, (unsigned)__builtin_amdgcn_readfirstlane(kdA + (slot) * SLOTK)); if (hasB) glds16(ksB + (long)(t) * ktB, (unsigned)__builtin_amdgcn_readfirstlane(kdB + (slot) * SLOTK)); } while (0)
#define AT_DMA_V(t, slot) glds16(vsp + (long)(t) * vt, (unsigned)__builtin_amdgcn_readfirstlane(vd + (slot) * VSLOT))
    lds_cptr kb[NC];
#pragma unroll
    for (int d0 = 0; d0 < NC; ++d0) { const int c = 2 * d0 + hi;
        if (2 * d0 < NK0) kb[d0] = (lds_cptr)lds + LDS_K + r32 * P0 + ((NK0 == 8) ? (c ^ ((r32 >> 1) & 7)) : (c ^ ((r32 >> 2) & 3))) * 16;
        else kb[d0] = (lds_cptr)lds + LDS_K + NK0 * 1024 + r32 * 64 + ((c - NK0) ^ ((r32 >> 2) & 3)) * 16; }
    const lds_cptr vp0 = (lds_cptr)lds + LDS_V + ((lane >> 4) & 1) * 32 + (lane & 3) * 8 + (4 * hi + ((lane & 15) >> 2)) * 64;
    AT_DMA_K(0, 0); AT_DMA_V(0, 0); if (NT > 1) AT_DMA_K(1, 1);
    bf16x8 qr[NC];
#pragma unroll
    for (int d0 = 0; d0 < NC; ++d0) qr[d0] = *(const bf16x8*)(qrow + 16 * d0 + 8 * hi);
    float mhat = 0.f, l = 0.f; f32x16 oa = {}, ob = {}, negm = {}, S0, S1; u32x4 pw0, pw1, pw2, pw3;
    asm volatile("" : "+v"(negm));
    AT_WAIT_BAR(0);
    __builtin_amdgcn_s_waitcnt(0);
#pragma unroll
    for (int d0 = 0; d0 < NC; ++d0) asm volatile("" : "+v"(qr[d0]));
    constexpr int QREG = NC;
    constexpr bool QLDS = (NC > 2);
    const lds_cptr qb = (lds_cptr)lds + LDS_OST + wid * 8192 + lane * 16;
    if (QLDS) {
#pragma unroll
        for (int d0 = 0; d0 < NC; ++d0) *(LAS bf16x8*)(lds + LDS_OST + wid * 8192 + lane * 16 + d0 * 1024) = qr[d0];
        LDS_WAIT();
    }
    int kc = 0, kn1 = 1, kn2 = 2, vpv = 2, vcu = 0, vnx = 1;
    bf16x8 kf[2 * NC], vf[8];
#define AT_SB() __builtin_amdgcn_sched_barrier(0)
#define AT_KRD(so_, d0) do { kf[2 * (d0)] = *(const LAS bf16x8*)(kb[d0] + (so_)); kf[2 * (d0) + 1] = *(const LAS bf16x8*)(kb[d0] + (so_) + 32 * ((2 * (d0) < NK0) ? P0 : 64)); if (QLDS && (d0) >= QREG) qr[d0] = *(const LAS bf16x8*)(qb + (d0) * 1024); } while (0)
#define AT_KHEAD(slot) do { const int kp_ = (slot) * SLOTK; AT_KRD(kp_, 0); if (NC > 1) AT_KRD(kp_, 1); } while (0)
#define AT_VF(i) ({ const s16x4 lo_ = vtr(vp_ + (((i) >> 2) * 4096 + ((i) & 3) * 1024)), hi_ = vtr(vp_ + (((i) >> 2) * 4096 + ((i) & 3) * 1024 + 512)); (bf16x8){lo_[0], lo_[1], lo_[2], lo_[3], hi_[0], hi_[1], hi_[2], hi_[3]}; })
#define AT_VHEAD(slot) do { const lds_cptr vp_ = vp0 + (slot) * VSLOT; vf[0] = AT_VF(0); vf[4] = AT_VF(4); } while (0)
#define AT_QKM(slot) do { const int kp_ = (slot) * SLOTK; \
        _Pragma("unroll") for (int d0 = 0; d0 < NC; ++d0) { if (d0 + 2 < NC) AT_KRD(kp_, d0 + 2); \
            if (d0 == 0) { S0 = MFMA32(kf[0], qr[0], negm); S1 = MFMA32(kf[1], qr[0], negm); } else { S0 = MFMA32(kf[2 * d0], qr[d0], S0); S1 = MFMA32(kf[2 * d0 + 1], qr[d0], S1); } AT_SB(); } } while (0)
#define AT_PVM(slot) do { const lds_cptr vp_ = vp0 + (slot) * VSLOT; \
        vf[1] = AT_VF(1); vf[5] = AT_VF(5); oa = MFMA32(__builtin_bit_cast(bf16x8, pw0), vf[0], oa); ob = MFMA32(__builtin_bit_cast(bf16x8, pw0), vf[4], ob); AT_SB(); \
        vf[2] = AT_VF(2); vf[6] = AT_VF(6); oa = MFMA32(__builtin_bit_cast(bf16x8, pw1), vf[1], oa); ob = MFMA32(__builtin_bit_cast(bf16x8, pw1), vf[5], ob); AT_SB(); \
        vf[3] = AT_VF(3); vf[7] = AT_VF(7); oa = MFMA32(__builtin_bit_cast(bf16x8, pw2), vf[2], oa); ob = MFMA32(__builtin_bit_cast(bf16x8, pw2), vf[6], ob); AT_SB(); \
        oa = MFMA32(__builtin_bit_cast(bf16x8, pw3), vf[3], oa); ob = MFMA32(__builtin_bit_cast(bf16x8, pw3), vf[7], ob); AT_SB(); } while (0)
    bool resc = false; u32x4 qw0, qw1, qw2, qw3; float sacc = 0.f;
#define AT_PIN(x) asm volatile("" : "+v"(x))
#define AT_DECIDE(first) do { const float rm_ = rowmax(S0, S1); resc = false; \
        if ((first) || __any(rm_ > THR)) { const float dl_ = (first) ? rm_ : __builtin_fmaxf(rm_, 0.f); mhat += dl_; \
            _Pragma("unroll") for (int r = 0; r < 16; ++r) { S0[r] -= dl_; S1[r] -= dl_; negm[r] = -mhat; } asm volatile("" : "+v"(negm)); \
            if (!(first)) { const float f_ = fast_exp2(-dl_); l *= f_; if (hi == 0) wsf[r32] = f_; resc = true; } } } while (0)
#define AT_RESC() do { if (resc) { LDS_WAIT(); \
        _Pragma("unroll") for (int r = 0; r < 16; ++r) { const float g_ = wsf[crow(r, hi)]; oa[r] *= g_; ob[r] *= g_; } LDS_WAIT(); } } while (0)
#define AT_EXP8(S, b, Q) do { \
        _Pragma("unroll") for (int r = 0; r < 8; ++r) S[(b) + r] = fast_exp2(S[(b) + r]); \
        sacc += (S[(b)] + S[(b) + 1]) + (S[(b) + 2] + S[(b) + 3]); sacc += (S[(b) + 4] + S[(b) + 5]) + (S[(b) + 6] + S[(b) + 7]); \
        Q = (u32x4){cvtpk(S[(b)], S[(b) + 1]), cvtpk(S[(b) + 2], S[(b) + 3]), cvtpk(S[(b) + 4], S[(b) + 5]), cvtpk(S[(b) + 6], S[(b) + 7])}; AT_PIN(Q); AT_PIN(sacc); } while (0)
#define AT_EXPALL() do { sacc = 0.f; AT_EXP8(S0, 0, qw0); AT_EXP8(S0, 8, qw1); AT_EXP8(S1, 0, qw2); AT_EXP8(S1, 8, qw3); l += sacc; pw0 = qw0; pw1 = qw1; pw2 = qw2; pw3 = qw3; } while (0)
#define AT_PV_EXP(slot, C0, C1, C2, C3, N0, N1, N2, N3) do { const lds_cptr vp_ = vp0 + (slot) * VSLOT; sacc = 0.f; \
        vf[1] = AT_VF(1); vf[5] = AT_VF(5); oa = MFMA32(__builtin_bit_cast(bf16x8, C0), vf[0], oa); ob = MFMA32(__builtin_bit_cast(bf16x8, C0), vf[4], ob); AT_EXP8(S0, 0, N0); AT_SB(); \
        vf[2] = AT_VF(2); vf[6] = AT_VF(6); oa = MFMA32(__builtin_bit_cast(bf16x8, C1), vf[1], oa); ob = MFMA32(__builtin_bit_cast(bf16x8, C1), vf[5], ob); AT_EXP8(S0, 8, N1); AT_SB(); \
        vf[3] = AT_VF(3); vf[7] = AT_VF(7); oa = MFMA32(__builtin_bit_cast(bf16x8, C2), vf[2], oa); ob = MFMA32(__builtin_bit_cast(bf16x8, C2), vf[6], ob); AT_EXP8(S1, 0, N2); AT_SB(); \
        oa = MFMA32(__builtin_bit_cast(bf16x8, C3), vf[3], oa); ob = MFMA32(__builtin_bit_cast(bf16x8, C3), vf[7], ob); AT_EXP8(S1, 8, N3); AT_SB(); \
        l += sacc; } while (0)
#define AT_STEP_WAIT(t) do { if ((t) + 2 < NT) { if (nd == 3) AT_WAIT_BAR(3); else if (nd == 2) AT_WAIT_BAR(2); else AT_WAIT_BAR(1); } else AT_WAIT_BAR(0); } while (0)
#define AT_ROT() do { const int a_ = kc; kc = kn1; kn1 = kn2; kn2 = a_; const int b_ = vpv; vpv = vcu; vcu = vnx; vnx = b_; } while (0)
    AT_DMA_K(2, kn2); AT_DMA_V(1, vnx);
    AT_KHEAD(kc); AT_SB();
    AT_QKM(kc); AT_DECIDE(true); AT_EXPALL();
    AT_STEP_WAIT(0); AT_ROT();
#define AT_STEP(t, C0, C1, C2, C3, N0, N1, N2, N3) do { \
        if ((t) + 2 < NT) AT_DMA_K((t) + 2, kn2); \
        if ((t) + 1 < NT) AT_DMA_V((t) + 1, vnx); \
        AT_KHEAD(kc); AT_VHEAD(vpv); AT_SB(); \
        AT_QKM(kc); \
        AT_DECIDE(false); AT_SB(); \
        AT_PV_EXP(vpv, C0, C1, C2, C3, N0, N1, N2, N3); \
        AT_RESC(); \
        AT_STEP_WAIT(t); AT_ROT(); } while (0)
    int t = 1;
    for (; t + 1 < NT; t += 2) { AT_STEP(t, pw0, pw1, pw2, pw3, qw0, qw1, qw2, qw3); AT_STEP(t + 1, qw0, qw1, qw2, qw3, pw0, pw1, pw2, pw3); }
    if (t < NT) { AT_STEP(t, pw0, pw1, pw2, pw3, qw0, qw1, qw2, qw3); pw0 = qw0; pw1 = qw1; pw2 = qw2; pw3 = qw3; }
#undef AT_STEP
    AT_VHEAD(vpv); AT_SB(); AT_PVM(vpv);
    { auto rr = __builtin_amdgcn_permlane32_swap(__float_as_uint(l), __float_as_uint(l), false, false); l = __uint_as_float(rr[0]) + __uint_as_float(rr[1]); }
    o0 = oa; o1 = ob; lsum = l;
#undef AT_DMA_K
#undef AT_DMA_V
#undef AT_SB
#undef AT_KRD
#undef AT_KHEAD
#undef AT_VF
#undef AT_VHEAD
#undef AT_QKM
#undef AT_PVM
#undef AT_PIN
#undef AT_DECIDE
#undef AT_RESC
#undef AT_EXP8
#undef AT_EXPALL
#undef AT_PV_EXP
#undef AT_STEP_WAIT
#undef AT_ROT
}
__device__ __forceinline__ void normalise(LAS unsigned char* lds, int tid, f32x16& o0, f32x16& o1, float lsum) {
    const int lane = tid & 63, r32 = lane & 31, hi = lane >> 5; const int wid = __builtin_amdgcn_readfirstlane(tid >> 6);
    LAS float* wsf = (LAS float*)(lds + LDS_WS) + wid * 64;
    if (hi == 0) wsf[32 + r32] = 1.0f / lsum; LDS_WAIT();
#pragma unroll
    for (int r = 0; r < 16; ++r) { const float g = wsf[32 + crow(r, hi)]; o0[r] *= g; o1[r] *= g; }
    LDS_WAIT();
}
}

struct AttnUnitId { int kind, seq, head, qb; };
__device__ __forceinline__ bool attn_unit_at(int i, int G, int bid, AttnUnitId& u) {
    const long L = (long)i * G + bid; if (L >= 2560) return false; int o = (int)L;
    int kind, longs, nh;
    if (o < 512) { kind = 0; longs = 1; nh = 4; } else if (o < 1024) { kind = 0; longs = 0; nh = 4; o -= 512; } else if (o < 1792) { kind = 1; longs = 1; nh = 6; o -= 1024; } else { kind = 1; longs = 0; nh = 6; o -= 1792; }
    const int nqb = longs ? 16 : 8;
    int pair, qb;
    if (G == 256) { const int rnd = o >> 8, b = o & 255, x = b & 7, c = b >> 3;
        const int ppr = 32 / nqb; pair = x + 8 * (rnd * ppr + c / nqb); qb = c % nqb; }
    else { pair = o / nqb; qb = o % nqb; }
    u.kind = kind; u.head = pair % nh; const int sq = pair / nh; u.seq = longs ? 16 + sq : sq; u.qb = qb; return true;
}
__device__ __forceinline__ void attn_ab_phase(Frame& F, const Args& a, int layer, int kmask = 3) {
    const bf16_t* H = (const bf16_t*)(F.ws + WS_H); const bf16_t* QB = (const bf16_t*)(F.ws + WS_QB); const bf16_t* KVB = (const bf16_t*)(F.ws + WS_KVB);
    bf16_t* MIX = (bf16_t*)(F.ws + WS_MIX);
    const int wid = F.wave;
    float lam, lam_init;
    { const float* lv = a.diff_lambda + layer * 128; float d1 = 0.f, d2 = 0.f;
      for (int i = 0; i < 32; ++i) { d1 += lv[i] * lv[32 + i]; d2 += lv[64 + i] * lv[96 + i]; }
      lam_init = 0.8f - 0.6f * expf(-0.3f * (float)layer); lam = expf(d1) - expf(d2) + lam_init;
      lam = __uint_as_float(__builtin_amdgcn_readfirstlane(__float_as_uint(lam))); lam_init = __uint_as_float(__builtin_amdgcn_readfirstlane(__float_as_uint(lam_init))); }
    AttnUnitId u;
    for (int i = 0; attn_unit_at(i, F.G, F.bid, u); ++i) {
        if (!((kmask >> u.kind) & 1)) continue;
        int tid = F.tid; asm volatile("" : "+v"(tid)); const int lane = tid & 63, r32 = lane & 31, hi = lane >> 5;
        const int len = (u.seq < 16) ? 2048 : 4096, base = (u.seq < 16) ? u.seq * 2048 : NTOK_P + (u.seq - 16) * 4096, NT = len / 64;
        const int m0 = base + u.qb * 256 + wid * 32;
        LAS bf16_t* sb = (LAS bf16_t*)(F.lds + at::LDS_OST + wid * 8192);
        LAS float* sf = (LAS float*)sb;
        if (u.kind == 0) {
            f32x16 q0, q1; float ls;
            { f32x16 p0, p1; const at::Src ks{H + (size_t)base * HP + HC_AK + u.head * 64, HP}, vs{H + (size_t)base * HP + HC_AV + u.head * 64, HP};
              at::stream<2, 4, 0>(F.lds, tid, H + (size_t)(m0 + r32) * HP + HC_AQ + u.head * 64, ks, ks, vs, NT, p0, p1, ls); at::normalise(F.lds, tid, p0, p1, ls);
#pragma unroll
              for (int r = 0; r < 16; ++r) { const int row = crow(r, hi); sf[row * 64 + r32] = p0[r]; sf[row * 64 + 32 + r32] = p1[r]; }
              AT_WAIT_BAR(0); }
            { const at::Src ks{H + (size_t)base * HP + HC_AK + u.head * 64 + 32, HP}, vs{H + (size_t)base * HP + HC_AV + u.head * 64, HP};
              at::stream<2, 4, 0>(F.lds, tid, H + (size_t)(m0 + r32) * HP + HC_AQ + u.head * 64 + 32, ks, ks, vs, NT, q0, q1, ls); at::normalise(F.lds, tid, q0, q1, ls); }
            float xa[16], xb[16];
#pragma unroll
            for (int r = 0; r < 16; ++r) { const int row = crow(r, hi); xa[r] = sf[row * 64 + r32] - lam * q0[r]; xb[r] = sf[row * 64 + 32 + r32] - lam * q1[r]; }
            LDS_WAIT();
            const float* sg = a.diff_subln + layer * 64; const float g0 = sg[r32] * (1.0f - lam_init), g1 = sg[32 + r32] * (1.0f - lam_init);
#pragma unroll
            for (int r = 0; r < 16; ++r) { const float x0 = xa[r], x1 = xb[r]; float ss = x0 * x0 + x1 * x1;
                ss += shx<1>(ss); ss += shx<2>(ss); ss += shx<4>(ss); ss += shx<8>(ss); ss += shx<16>(ss);
                const float rs = 1.0f / sqrtf(ss * (1.0f / 64.0f) + RMS_EPS); const int row = crow(r, hi);
                sb[row * 64 + r32] = (bf16_t)f2bf(x0 * rs * g0); sb[row * 64 + 32 + r32] = (bf16_t)f2bf(x1 * rs * g1); }
            LDS_WAIT();
#pragma unroll
            for (int it = 0; it < 4; ++it) { const int row = it * 8 + (lane >> 3), ch = lane & 7; *(u32x4*)(MIX + (size_t)(m0 + row) * DM + MIX_A + u.head * 64 + ch * 8) = *(const LAS u32x4*)(sb + row * 64 + ch * 8); }
        } else {
            f32x16 p0, p1; float ls;
            const at::Src k0{KVB + (size_t)base * KVP + u.head * 128, KVP}, k1{H + (size_t)base * HP + HC_KROPE, HP}, vs{KVB + (size_t)base * KVP + u.head * 128 + 64, KVP};
            at::stream<6, 8, 4>(F.lds, tid, QB + (size_t)(m0 + r32) * QBP + u.head * 96, k0, k1, vs, NT, p0, p1, ls); at::normalise(F.lds, tid, p0, p1, ls);
#pragma unroll
            for (int r = 0; r < 16; ++r) { const int row = crow(r, hi); sb[row * 64 + r32] = (bf16_t)f2bf(p0[r]); sb[row * 64 + 32 + r32] = (bf16_t)f2bf(p1[r]); }
            LDS_WAIT();
#pragma unroll
            for (int it = 0; it < 4; ++it) { const int row = it * 8 + (lane >> 3), ch = lane & 7; *(u32x4*)(MIX + (size_t)(m0 + row) * DM + MIX_B + u.head * 64 + ch * 8) = *(const LAS u32x4*)(sb + row * 64 + ch * 8); }
        }
        AT_WAIT_BAR(0);
    }
}

struct ListRows { const int* list; int seg0, cnt; __device__ __forceinline__ int src(int m) const { const int r = m - seg0; return (r < cnt) ? (list[r] >> 1) : 0; } };
__device__ __forceinline__ void moe_segments(Frame& F, int layer, LAS int* seg) {
    if (F.tid < 32) seg[33 + F.tid] = (int)__hip_atomic_load(F.ctl + CW_CNT + layer * 64 + F.tid, RLX_AGENT);
    __syncthreads();
    if (F.tid == 0) { int acc = 0; for (int e = 0; e < NEXP; ++e) { seg[e] = acc; acc += (seg[33 + e] + 255) & ~255; } seg[32] = acc; }
    __syncthreads();
}
__device__ __forceinline__ int seg_find(const LAS int* seg, int row) { int e = 0;
#pragma unroll
    for (int s = 16; s > 0; s >>= 1) if (seg[e + s] <= row) e += s;
    return e; }
__device__ __forceinline__ void moe_up_simple(Frame& F, int layer) {
    LAS int* seg = (LAS int*)(F.lds + RING_BYTES); moe_segments(F, layer, seg);
    const bf16_t* XB = (const bf16_t*)(F.ws + WS_XB); const bf16_t* W13 = (const bf16_t*)(F.ws + WS_W13); const int* list = (const int*)(F.ws + WS_LIST);
    const EpiHid E{(bf16_t*)(F.ws + WS_HID)};
    const int items = (seg[32] / 32) * 16;
    for (int it = F.gw; it < items; it += F.NGW) { const int mt = it >> 4, ct = it & 15, m0 = mt * 32, e = seg_find(seg, m0), c0 = ct * 32;
        const ListRows RM{list + (size_t)e * LIST_CAP, seg[e], seg[33 + e]};
        const bf16_t* Bg = W13 + (size_t)e * 1024 * 1024 + (size_t)((c0 >> 7) * 256 + (c0 & 127)) * 1024;
        sg_tile(XB, DM, Bg, Bg + (size_t)128 * 1024, 1024, 1024, m0, c0, E, RM, F.lane); }
    __syncthreads();
}
__device__ __forceinline__ void moe_down_simple(Frame& F, int layer) {
    LAS int* seg = (LAS int*)(F.lds + RING_BYTES); moe_segments(F, layer, seg);
    const bf16_t* HID = (const bf16_t*)(F.ws + WS_HID); const bf16_t* W2 = (const bf16_t*)(F.ws + WS_W2); const int* list = (const int*)(F.ws + WS_LIST);
    const int items = (seg[32] / 32) * 16;
    for (int it = F.gw; it < items; it += F.NGW) { const int mt = it >> 4, ct = it & 15, m0 = mt * 32, e = seg_find(seg, m0), c0 = ct * 64;
        const EpiY E{(bf16_t*)(F.ws + WS_YB), (const float*)(F.ws + WS_TW), list + (size_t)e * LIST_CAP, seg[e], seg[33 + e]};
        const bf16_t* B0 = W2 + (size_t)e * 1024 * 512 + (size_t)c0 * 512;
        sg_tile(HID, DEXP, B0, B0 + (size_t)32 * 512, 512, 512, m0, c0, E, IdRows(), F.lane); }
    __syncthreads();
}


struct MoeUpSched {
    const char* XB; const char* W13; const LAS int* seg; const int* list; int nM, G, c;
    __device__ __forceinline__ bool next(int i, pg8::Unit& u) const { if (!pg8::order_next(i, G, c, nM, 4, u.pm, u.pn)) return false; u.e = __builtin_amdgcn_readfirstlane(seg_find(seg, u.pm * 256)); u.a = XB; u.b = W13 + ((size_t)u.e * 1024 + (size_t)u.pn * 256) * 2048; return true; }
    __device__ __forceinline__ unsigned arow(const pg8::Unit& u, int r) const { const int rr = u.pm * 256 + r - __builtin_amdgcn_readfirstlane(seg[u.e]); return (rr < __builtin_amdgcn_readfirstlane(seg[33 + u.e])) ? (unsigned)(list[(size_t)u.e * LIST_CAP + rr] >> 1) : 0u; }
};
struct MoeDownSched {
    const char* HID; const char* W2; const LAS int* seg; int nM, G, c;
    __device__ __forceinline__ bool next(int i, pg8::Unit& u) const { if (!pg8::order_next(i, G, c, nM, 4, u.pm, u.pn)) return false; u.e = __builtin_amdgcn_readfirstlane(seg_find(seg, u.pm * 256)); u.a = HID + (size_t)u.pm * 256 * DEXP * 2; u.b = W2 + ((size_t)u.e * 1024 + (size_t)u.pn * 256) * 1024; return true; }
    __device__ __forceinline__ unsigned arow(const pg8::Unit&, int) const { return 0u; }
};
__device__ __forceinline__ void moe_up_opt(Frame& F, int layer) {
    LAS int* seg = (LAS int*)(F.lds + RING_BYTES); moe_segments(F, layer, seg);
    const MoeUpSched S{(const char*)(F.ws + WS_XB), (const char*)(F.ws + WS_W13), seg, (const int*)(F.ws + WS_LIST), __builtin_amdgcn_readfirstlane(seg[32]) / 256, F.G, F.bid};
    const EpiHid E{(bf16_t*)(F.ws + WS_HID)};
    pg8::gemm_phase<EpiHid, MoeUpSched, true, true>(F.lds, F.tid, 1024, DM, S, E);
    __syncthreads();
}
__device__ __forceinline__ void moe_down_opt(Frame& F, int layer) {
    LAS int* seg = (LAS int*)(F.lds + RING_BYTES); moe_segments(F, layer, seg);
    const MoeDownSched S{(const char*)(F.ws + WS_HID), (const char*)(F.ws + WS_W2), seg, __builtin_amdgcn_readfirstlane(seg[32]) / 256, F.G, F.bid};
    const EpiYO E{(bf16_t*)(F.ws + WS_YB), (const float*)(F.ws + WS_TW), (const int*)(F.ws + WS_LIST), seg, (const float*)(F.ws + WS_LW)};
    pg8::gemm_phase<EpiYO, MoeDownSched, false, false>(F.lds, F.tid, DEXP, DEXP, S, E);
    __syncthreads();
}
template <class Epi>
__device__ __forceinline__ void pg_phase(Frame& F, const bf16_t* A, int lda, const bf16_t* Bt, int panel, int N, int K, const Epi& E) {
    pg8::PanelSched S; S.init(A, lda, Bt, panel, N, K);
    pg8::gemm_phase<Epi, pg8::PanelSched, false, false>(F.lds, F.tid, K, lda, S, E);
}
__device__ __forceinline__ void local_sync(Frame& F) {
    asm volatile("s_waitcnt vmcnt(0) lgkmcnt(0)" ::: "memory");
    __syncthreads();
    if (F.tid == 0) { __builtin_amdgcn_fence(__ATOMIC_ACQUIRE, "agent"); asm volatile("s_waitcnt vmcnt(0)" ::: "memory"); }
    __syncthreads();
}
template <class Epi>
__device__ __forceinline__ void og_phase(Frame& F, const bf16_t* A, int lda, const bf16_t* Bt, int M, int N, int K, const Epi& E) {
    pg8::DenseSched S; S.init(A, lda, Bt, M, N, K, F.G, F.bid);
    pg8::gemm_phase<Epi, pg8::DenseSched, false, false>(F.lds, F.tid, K, lda, S, E);
}

#ifndef PANEL_PROG
#define PANEL_PROG 1
#endif
#if PANEL_PROG
constexpr int PH_PER_LAYER = 6, N_PHASES = 2 + DEPTH * PH_PER_LAYER;
#else
constexpr int PH_PER_LAYER = 9, N_PHASES = 1 + DEPTH * PH_PER_LAYER;
#endif
__global__ void __launch_bounds__(NTHREADS, 2) fwd(Args args) {
    extern __shared__ __attribute__((aligned(16))) unsigned char lds[];
    Frame F;
    F.lds = (LAS unsigned char*)lds; F.ldsg = lds;
    F.tid = threadIdx.x; F.lane = F.tid & 63; F.wave = __builtin_amdgcn_readfirstlane(F.tid >> 6);
    F.G = gridDim.x; F.bid = blockIdx.x; F.gw = blockIdx.x * NWAVES + F.wave; F.NGW = F.G * NWAVES;
    F.ws = args.ws; F.ctl = (gu32*)(args.ws + WS_CTL);
    volatile LAS unsigned* MISC = (volatile LAS unsigned*)(F.lds + MISC_OFF);
    for (int u = F.tid; u < (LDS_BYTES - RING_BYTES) / 4; u += NTHREADS) ((LAS unsigned*)(F.lds + RING_BYTES))[u] = 0u;
    __syncthreads();
    XcdBarrier bar; bar.bar = (unsigned*)(F.ctl + CW_BAR); bar.x = 0; bar.st = nullptr;
    if (args.use_bar) bar = xcd_barrier_post((unsigned*)(F.ctl + CW_BAR), MISC + 8);
    const int lo = args.ph_lo, hi = args.ph_hi;
#ifndef PH_MASK
#define PH_MASK 0x3ff
#endif
#define IN(k) (lo <= (k) && (k) < hi && (launder(F), true))
#define SEAM(k) do { if (lo <= (k) && (k) + 1 < hi) xcd_barrier(bar); } while (0)
    if ((PH_MASK & 1) && IN(0)) { p0_prologue(F, args);
#ifdef PROBE_DUP_P0
        launder(F); p0_prologue(F, args);
#endif
    }
    SEAM(0);
#if PANEL_PROG
    for (int layer = 0; layer < DEPTH; ++layer) {
        const int pb = 1 + layer * PH_PER_LAYER;
        if (IN(pb + 0)) {
            for (int panel = F.bid; panel < NTOK / 256; panel += F.G) {
                const int r0 = panel * 256;
                if (layer > 0) { ln2_pass(F, args, layer - 1, r0 + F.wave, NWAVES, r0 + 256); local_sync(F); launder(F); }
                { bf16_t* H = (bf16_t*)(F.ws + WS_H); const EpiH E{H, (const float2*)(F.ws + WS_ROPE32), (const float2*)(F.ws + WS_ROPE64)};
                  pg_phase(F, (const bf16_t*)(F.ws + WS_XB), DM, (const bf16_t*)(F.ws + WS_WIN) + (size_t)layer * 2560 * 1024, panel, 2560, 1024, E); }
                local_sync(F); launder(F);
                rowstat_pass(F, r0 + F.wave, NWAVES, r0 + 256);
                local_sync(F); launder(F);
                { bf16_t* H = (bf16_t*)(F.ws + WS_H); const EpiUQ Eq{(bf16_t*)(F.ws + WS_QB), (const float*)(F.ws + WS_RSTD), (const float2*)(F.ws + WS_ROPE32)};
                  pg_phase(F, H + HC_CQ_LAT, HP, (const bf16_t*)(F.ws + WS_WUQ) + (size_t)layer * 768 * 256, panel, 768, 256, Eq); }
                launder(F);
                { bf16_t* H = (bf16_t*)(F.ws + WS_H); const EpiUKV Ek{(bf16_t*)(F.ws + WS_KVB), (const float*)(F.ws + WS_RSTD)};
                  pg_phase(F, H + HC_CKV, HP, (const bf16_t*)(F.ws + WS_WUKV) + (size_t)layer * 768 * 256, panel, 768, 256, Ek); }
                launder(F);
            }
        }
        SEAM(pb + 0);
        if (IN(pb + 1)) { cstat_phase(F); }
        SEAM(pb + 1);
        if (IN(pb + 2)) { attn_ab_phase(F, args, layer); launder(F); sattn_phase(F, args, layer, 10); }
        SEAM(pb + 2);
        if (IN(pb + 3)) {
            for (int panel = F.bid; panel < NTOK / 256; panel += F.G) {
                const int r0 = panel * 256;
                { const EpiRes E{args.out, layer == 0 ? args.x_prompt : nullptr, args.x_sample, args.out};
                  pg_phase(F, (const bf16_t*)(F.ws + WS_MIX), DM, (const bf16_t*)(F.ws + WS_WOUT) + (size_t)layer * 1024 * 1024, panel, 1024, 1024, E); }
                local_sync(F); launder(F);
                ln1_route_pass(F, args, layer, r0 + F.wave, NWAVES, r0 + 256);
                launder(F);
            }
            moe_convert(F, args, layer);
        }
        SEAM(pb + 3);
        if (IN(pb + 4)) { moe_up_opt(F, layer);
#ifdef PROBE_DUP_MOE
            launder(F); moe_up_opt(F, layer);
#endif
        }
        SEAM(pb + 4);
        if (IN(pb + 5)) { moe_down_opt(F, layer);
#ifdef PROBE_DUP_MOE
            launder(F); moe_down_opt(F, layer);
#endif
        }
        SEAM(pb + 5);
    }
    if (IN(1 + DEPTH * PH_PER_LAYER)) { ln2_pass(F, args, DEPTH - 1, F.gw, F.NGW, NTOK); }
#else
    for (int layer = 0; layer < DEPTH; ++layer) {
        const int pb = 1 + layer * PH_PER_LAYER;
        if ((PH_MASK & (2 << 0)) && IN(pb + 0)) {   bf16_t* H = (bf16_t*)(F.ws + WS_H);
            const EpiH E{H, (const float2*)(F.ws + WS_ROPE32), (const float2*)(F.ws + WS_ROPE64)};
#if OPT_GEMM
            og_phase(F, (const bf16_t*)(F.ws + WS_XB), DM, (const bf16_t*)(F.ws + WS_WIN) + (size_t)layer * 2560 * 1024, NTOK, 2560, 1024, E);
#ifdef PROBE_DUP_GEMM
            launder(F); og_phase(F, (const bf16_t*)(F.ws + WS_XB), DM, (const bf16_t*)(F.ws + WS_WIN) + (size_t)layer * 2560 * 1024, NTOK, 2560, 1024, E);
#endif
#else
            sg_phase(F, (const bf16_t*)(F.ws + WS_XB), DM, (const bf16_t*)(F.ws + WS_WIN) + (size_t)layer * 2560 * 1024, 1024, NTOK, 2560, 1024, E);
#endif
        }
        SEAM(pb + 0);
        if ((PH_MASK & (2 << 1)) && IN(pb + 1)) { rowstat_pass(F, F.gw, F.NGW, NTOK); cstat_phase(F);
#ifdef PROBE_DUP_CSTAT
            launder(F); rowstat_pass(F, F.gw, F.NGW, NTOK); cstat_phase(F);
#endif
        }
        SEAM(pb + 1);
        if ((PH_MASK & (2 << 2)) && IN(pb + 2)) {
            bf16_t* H = (bf16_t*)(F.ws + WS_H);
            const EpiUQ Eq{(bf16_t*)(F.ws + WS_QB), (const float*)(F.ws + WS_RSTD), (const float2*)(F.ws + WS_ROPE32)};
#if OPT_GEMM
            og_phase(F, H + HC_CQ_LAT, HP, (const bf16_t*)(F.ws + WS_WUQ) + (size_t)layer * 768 * 256, NTOK, 768, 256, Eq);
            launder(F);
#else
            sg_phase(F, H + HC_CQ_LAT, HP, (const bf16_t*)(F.ws + WS_WUQ) + (size_t)layer * 768 * 256, 256, NTOK, 768, 256, Eq);
#endif
            const EpiUKV Ek{(bf16_t*)(F.ws + WS_KVB), (const float*)(F.ws + WS_RSTD)};
#if OPT_GEMM
            og_phase(F, H + HC_CKV, HP, (const bf16_t*)(F.ws + WS_WUKV) + (size_t)layer * 768 * 256, NTOK, 768, 256, Ek);
#ifdef PROBE_DUP_UP
            launder(F); og_phase(F, H + HC_CQ_LAT, HP, (const bf16_t*)(F.ws + WS_WUQ) + (size_t)layer * 768 * 256, NTOK, 768, 256, Eq);
            launder(F); og_phase(F, H + HC_CKV, HP, (const bf16_t*)(F.ws + WS_WUKV) + (size_t)layer * 768 * 256, NTOK, 768, 256, Ek);
#endif
#else
            sg_phase(F, H + HC_CKV, HP, (const bf16_t*)(F.ws + WS_WUKV) + (size_t)layer * 768 * 256, 256, NTOK, 768, 256, Ek);
#endif
        }
        SEAM(pb + 2);
        if ((PH_MASK & (2 << 3)) && IN(pb + 3)) {
#if OPT_ATTN
            attn_ab_phase(F, args, layer); launder(F);
#ifdef PROBE_DUP_ATTN
            attn_ab_phase(F, args, layer, PROBE_DUP_ATTN); launder(F);
#endif
            sattn_phase(F, args, layer, 10);
#ifdef PROBE_DUP_CFIN
            launder(F); sattn_phase(F, args, layer, 10);
#endif
#else
            sattn_phase(F, args, layer, 0);
#endif
        }
        SEAM(pb + 3);
        if ((PH_MASK & (2 << 4)) && IN(pb + 4)) {
#ifdef PROBE_DUP_WOUT
            { const EpiRes E0{args.out, layer == 0 ? args.x_prompt : nullptr, args.x_sample, (float*)(F.ws + WS_H)};
              og_phase(F, (const bf16_t*)(F.ws + WS_MIX), DM, (const bf16_t*)(F.ws + WS_WOUT) + (size_t)layer * 1024 * 1024, NTOK, 1024, 1024, E0); launder(F); }
#endif
            const EpiRes E{args.out, layer == 0 ? args.x_prompt : nullptr, args.x_sample, args.out};
#if OPT_GEMM
            og_phase(F, (const bf16_t*)(F.ws + WS_MIX), DM, (const bf16_t*)(F.ws + WS_WOUT) + (size_t)layer * 1024 * 1024, NTOK, 1024, 1024, E);
#else
            sg_phase(F, (const bf16_t*)(F.ws + WS_MIX), DM, (const bf16_t*)(F.ws + WS_WOUT) + (size_t)layer * 1024 * 1024, 1024, NTOK, 1024, 1024, E);
#endif
        }
        SEAM(pb + 4);
        if ((PH_MASK & (2 << 5)) && IN(pb + 5)) {
#ifdef PROBE_DUP_LN1
#endif
            ln1_route_pass(F, args, layer, F.gw, F.NGW, NTOK); moe_convert(F, args, layer);
#ifdef PROBE_DUP_CONV
            launder(F); moe_convert(F, args, layer);
#endif
        }
        SEAM(pb + 5);
#if OPT_GEMM
        if ((PH_MASK & (2 << 6)) && IN(pb + 6)) { moe_up_opt(F, layer);
#ifdef PROBE_DUP_MOE
            launder(F); moe_up_opt(F, layer);
#endif
        }
#else
        if ((PH_MASK & (2 << 6)) && IN(pb + 6)) { moe_up_simple(F, layer); }
#endif
        SEAM(pb + 6);
#if OPT_GEMM
        if ((PH_MASK & (2 << 7)) && IN(pb + 7)) { moe_down_opt(F, layer);
#ifdef PROBE_DUP_MOE
            launder(F); moe_down_opt(F, layer);
#endif
        }
#else
        if ((PH_MASK & (2 << 7)) && IN(pb + 7)) { moe_down_simple(F, layer); }
#endif
        SEAM(pb + 7);
        if ((PH_MASK & (2 << 8)) && IN(pb + 8)) { ln2_pass(F, args, layer, F.gw, F.NGW, NTOK); }
        SEAM(pb + 8);
    }
#endif
#undef IN
#undef SEAM
}

extern "C" void kernel_launch(void* const* d_in, const int* in_sizes, int n_in, void* d_out, int out_size, void* d_ws, size_t ws_size, hipStream_t stream) {
    static int grid = 0;
    if (grid == 0) {
        if (n_in != 19 || out_size != NTOK * DM || ws_size < WS_END) { fprintf(stderr, "kernel_launch: unexpected shapes (n_in %d out %d ws %zu)\n", n_in, out_size, ws_size); grid = -1; return; }
        int dev = 0, cus = 0, per_cu = 0;
        if (hipGetDevice(&dev) != hipSuccess || hipDeviceGetAttribute(&cus, hipDeviceAttributeMultiprocessorCount, dev) != hipSuccess) { grid = -1; return; }
        if (hipFuncSetAttribute((const void*)fwd, hipFuncAttributeMaxDynamicSharedMemorySize, LDS_BYTES) != hipSuccess) { grid = -1; return; }
        if (hipOccupancyMaxActiveBlocksPerMultiprocessor(&per_cu, (const void*)fwd, NTHREADS, LDS_BYTES) != hipSuccess || per_cu < 1) { fprintf(stderr, "kernel_launch: occupancy query says %d\n", per_cu); }
        (void)hipGetLastError();
        grid = cus;
    }
    if (grid < 0) return;
    if (hipMemsetAsync((char*)d_ws + WS_CTL, 0, CTL_ZERO_BYTES, stream) != hipSuccess) return;
    Args a{};
    a.x_prompt = (const float*)d_in[0]; a.x_sample = (const float*)d_in[1]; a.w_in = (const float*)d_in[2]; a.diff_lambda = (const float*)d_in[3]; a.diff_subln = (const float*)d_in[4];
    a.mla_q_norm = (const float*)d_in[5]; a.mla_w_uq = (const float*)d_in[6]; a.mla_kv_norm = (const float*)d_in[7]; a.mla_w_ukv = (const float*)d_in[8]; a.w_out = (const float*)d_in[9];
    a.ln1_g = (const float*)d_in[10]; a.ln1_b = (const float*)d_in[11]; a.moe_w_coarse = (const float*)d_in[12]; a.moe_w_fine = (const float*)d_in[13];
    a.moe_w1 = (const float*)d_in[14]; a.moe_w3 = (const float*)d_in[15]; a.moe_w2 = (const float*)d_in[16]; a.ln2_g = (const float*)d_in[17]; a.ln2_b = (const float*)d_in[18];
    a.out = (float*)d_out; a.ws = (unsigned char*)d_ws; a.pad = 0;
#if MK_ONE_LAUNCH
    a.ph_lo = 0; a.ph_hi = N_PHASES; a.use_bar = 1;
    hipLaunchKernelGGL(fwd, dim3(grid), dim3(NTHREADS), LDS_BYTES, stream, a);
#else
    for (int p = 0; p < N_PHASES; ++p) { a.ph_lo = p; a.ph_hi = p + 1; a.use_bar = 0; hipLaunchKernelGGL(fwd, dim3(grid), dim3(NTHREADS), LDS_BYTES, stream, a); }
#endif
}
```

```cpp
#include <hip/hip_runtime.h>
#include <cstdio>
#include <cstdint>

#ifndef OPT_ATTN
#define OPT_ATTN 1
#endif
#ifndef OPT_GEMM
#define OPT_GEMM 1
#endif
#ifndef MK_ONE_LAUNCH
#define MK_ONE_LAUNCH 1
#endif

#define GAS __attribute__((address_space(1)))
#define LAS __attribute__((address_space(3)))
typedef unsigned short bf16_t;
typedef short bf16x8 __attribute__((ext_vector_type(8)));
typedef float f32x4 __attribute__((ext_vector_type(4)));
typedef float f32x2 __attribute__((ext_vector_type(2)));
typedef float f32x16 __attribute__((ext_vector_type(16)));
typedef unsigned u32x4 __attribute__((ext_vector_type(4)));
typedef unsigned u32x2 __attribute__((ext_vector_type(2)));
typedef GAS unsigned gu32;
#define RLX_AGENT __ATOMIC_RELAXED, __HIP_MEMORY_SCOPE_AGENT
#define LDS_WAIT() asm volatile("s_waitcnt lgkmcnt(0)" ::: "memory")
#define VM_WAIT() asm volatile("s_waitcnt vmcnt(0)" ::: "memory")
#define MFMA32(a, b, c) __builtin_amdgcn_mfma_f32_32x32x16_bf16(a, b, c, 0, 0, 0)
#define MFMA16(a, b, c) __builtin_amdgcn_mfma_f32_16x16x32_bf16(a, b, c, 0, 0, 0)

__device__ __forceinline__ unsigned f2bf(float f) { unsigned u = __builtin_bit_cast(unsigned, f); return (u + 0x7fffu + ((u >> 16) & 1u)) >> 16; }
__device__ __forceinline__ unsigned pk2(float lo, float hi) { typedef float f2_ __attribute__((ext_vector_type(2))); typedef __bf16 b2_ __attribute__((ext_vector_type(2))); f2_ v = {lo, hi}; b2_ b = __builtin_convertvector(v, b2_); return __builtin_bit_cast(unsigned, b); }
__device__ __forceinline__ float bf2f(unsigned short b) { return __builtin_bit_cast(float, (unsigned)b << 16); }
__device__ __forceinline__ int crow(int r, int hi) { return (r & 3) + 8 * (r >> 2) + 4 * hi; }
template <int K> __device__ __forceinline__ float shx(float v) { static_assert(K < 32, "xor 32: use xsum32 / xmax32 / xpair32"); return __uint_as_float((unsigned)__builtin_amdgcn_ds_swizzle((int)__float_as_uint(v), (K << 10) | 0x1f)); }
__device__ __forceinline__ float xsum32(float v) { auto rr = __builtin_amdgcn_permlane32_swap(__float_as_uint(v), __float_as_uint(v), false, false); return __uint_as_float(rr[0]) + __uint_as_float(rr[1]); }
__device__ __forceinline__ float xmax32(float v) { auto rr = __builtin_amdgcn_permlane32_swap(__float_as_uint(v), __float_as_uint(v), false, false); return fmaxf(__uint_as_float(rr[0]), __uint_as_float(rr[1])); }
__device__ __forceinline__ float xpair32(float lo, float hi) { auto rr = __builtin_amdgcn_permlane32_swap(__float_as_uint(lo), __float_as_uint(hi), false, false); return __uint_as_float(rr[0]) + __uint_as_float(rr[1]); }
__device__ __forceinline__ float wave_sum(float v) {
    v += shx<1>(v); v += shx<2>(v); v += shx<4>(v); v += shx<8>(v); v += shx<16>(v);
    return xsum32(v);
}
__device__ __forceinline__ float fast_exp2(float x) { return __builtin_amdgcn_exp2f(x); }

constexpr int NTOK = 65536, DM = 1024, DEPTH = 4;
constexpr int NTOK_P = 32768;
constexpr int HP = 2560;
constexpr int HC_AQ = 0, HC_AK = 256, HC_AV = 512, HC_CQ_LAT = 768, HC_CKV = 1024, HC_KROPE = 1152, HC_CQ = 1280, HC_CK = 1664, HC_CV = 2048;
constexpr int QBP = 768, KVP = 768;
constexpr int MIX_A = 0, MIX_B = 256, MIX_C = 640;
constexpr int NEXP = 32, DEXP = 512;
constexpr float LOG2E = 1.4426950408889634f;
constexpr float SC_A = 0.17677669529663687f * LOG2E;
constexpr float SC_B = 0.10206207261596575f * LOG2E;
constexpr float SC_C = 0.125f * LOG2E;
constexpr float DN_ALPHA = 1.681792830507429f;
constexpr float LN_EPS = 1e-5f, RMS_EPS = 1e-6f;

constexpr size_t MiB = 1u << 20;
constexpr size_t WS_CTL = 0, CTL_ZERO_BYTES = 64 * 1024;
constexpr size_t WS_ROPE32 = 4 * MiB;
constexpr size_t WS_ROPE64 = 5 * MiB;
constexpr size_t WS_WIN = 8 * MiB;
constexpr size_t WS_WOUT = 28 * MiB;
constexpr size_t WS_WUQ = 36 * MiB;
constexpr size_t WS_WUKV = 38 * MiB;
constexpr size_t WS_W13 = 40 * MiB;
constexpr size_t WS_W2 = 104 * MiB;
constexpr size_t WS_XB = 136 * MiB;
constexpr size_t WS_H = 264 * MiB;
constexpr size_t WS_QB = 584 * MiB;
constexpr size_t WS_KVB = 680 * MiB;
constexpr size_t WS_MIX = 776 * MiB;
constexpr size_t WS_RSTD = 904 * MiB;
constexpr size_t WS_LSEC = 905 * MiB;
constexpr size_t WS_TW = 907 * MiB;
constexpr size_t WS_LIST = 908 * MiB;
constexpr size_t WS_LW = 924 * MiB;
constexpr size_t WS_END = 940 * MiB;
constexpr size_t WS_HID = WS_H;
constexpr size_t WS_YB = WS_H + 136 * MiB;
static_assert(WS_YB + 256 * MiB <= WS_KVB + 96 * MiB, "YB overlay");
constexpr int LIST_CAP = 131072;
constexpr int CW_TMO = 0;
constexpr int CW_CNT = 64;
constexpr int CW_BAR = 4096;

constexpr int RING_BYTES = 131072;
constexpr int MISC_OFF = RING_BYTES + 320;
constexpr int LDS_BYTES = 147456;
constexpr int NWAVES = 8, NTHREADS = 512;

#define XB_TMO      128
#define XB_XCNT(j)  (256  + 64 * (j))
#define XB_XSUB(j)  (1280 + 64 * (j))
#define XB_XGEN(j)  (2304 + 64 * (j))
#define XB_TOP      3328
#define XB_TOPGEN   3392
#define XCD_BAR_WORDS 3456
#define XB_SPIN_CAP (1u << 22)
__device__ __forceinline__ unsigned xb_ld(unsigned* p)              { return __hip_atomic_load(p, __ATOMIC_RELAXED, __HIP_MEMORY_SCOPE_AGENT); }
__device__ __forceinline__ unsigned xb_add(unsigned* p, unsigned v) { return __hip_atomic_fetch_add(p, v, __ATOMIC_RELAXED, __HIP_MEMORY_SCOPE_AGENT); }
__device__ __forceinline__ unsigned xb_xcc_id() { return (unsigned)__builtin_amdgcn_s_getreg((3 << 11) | 20) & 0xFu; }
#define XB_SPIN(cond, bar) do { unsigned _sp = 0; while (cond) { __builtin_amdgcn_s_sleep(1); \
    if ((++_sp & 255u) == 0u) { if (xb_ld(&(bar)[XB_TMO])) break; if (_sp > XB_SPIN_CAP) { atomicAdd(&(bar)[XB_TMO], 1u); break; } } } } while (0)
struct XcdBarrier { unsigned* bar; unsigned x; volatile LAS unsigned* st; };
__device__ __forceinline__ XcdBarrier xcd_barrier_post(unsigned* bar, volatile LAS unsigned* st) {
    XcdBarrier b; b.bar = bar; b.x = xb_xcc_id(); b.st = st;
    if (threadIdx.x == 0) (void)xb_add(&bar[XB_XCNT(b.x)], 1u);
    return b;
}
__device__ __forceinline__ void xcd_barrier_complete(unsigned* bar, unsigned x, unsigned& nloc, unsigned& nx) {
    const unsigned G = gridDim.x * gridDim.y * gridDim.z;
    unsigned sum, cnt, mine, sp = 0u;
    for (;;) {
        sum = 0u; cnt = 0u; mine = 0u;
#pragma unroll
        for (unsigned j = 0; j < 16; ++j) { const unsigned c = xb_ld(&bar[XB_XCNT(j)]); sum += c; cnt += (c > 0u) ? 1u : 0u; mine = (j == x) ? c : mine; }
        if (sum == G) break;
        __builtin_amdgcn_s_sleep(1);
        if ((++sp & 255u) == 0u) { if (xb_ld(&bar[XB_TMO])) break; if (sp > XB_SPIN_CAP) { atomicAdd(&bar[XB_TMO], 1u); break; } }
    }
    nloc = mine > 0u ? mine : 1u; nx = cnt > 0u ? cnt : 1u;
}
__device__ __forceinline__ void xcd_barrier(const XcdBarrier& b) {
    asm volatile("s_waitcnt vmcnt(0)" ::: "memory");
    __syncthreads();
    if (threadIdx.x == 0) {
        unsigned* bar = b.bar;
        __builtin_amdgcn_s_waitcnt(0);
        unsigned nloc = b.st[0], nx = b.st[1];
        if (nloc == 0u) { xcd_barrier_complete(bar, b.x, nloc, nx); b.st[0] = nloc; b.st[1] = nx; }
        const unsigned old = xb_add(&bar[XB_XSUB(b.x)], 1u);
        const unsigned gen = old / nloc;
        if (old + 1u == (gen + 1u) * nloc) {
            __builtin_amdgcn_fence(__ATOMIC_RELEASE, "agent");
            asm volatile("s_waitcnt vmcnt(0)" ::: "memory");
            const unsigned og = xb_add(&bar[XB_TOP], 1u);
            const unsigned tg = og / nx;
            if (og + 1u == (tg + 1u) * nx) xb_add(&bar[XB_TOPGEN], 1u);
            else XB_SPIN(xb_ld(&bar[XB_TOPGEN]) == tg, bar);
            __builtin_amdgcn_fence(__ATOMIC_ACQUIRE, "agent");
            xb_add(&bar[XB_XGEN(b.x)], 1u);
            asm volatile("s_waitcnt vmcnt(0)" ::: "memory");
        } else {
            XB_SPIN(xb_ld(&bar[XB_XGEN(b.x)]) == gen, bar);
            __builtin_amdgcn_fence(__ATOMIC_ACQUIRE, "agent");
            asm volatile("s_waitcnt vmcnt(0)" ::: "memory");
        }
    }
    __syncthreads();
}

struct Args {
    const float* x_prompt; const float* x_sample; const float* w_in; const float* diff_lambda; const float* diff_subln; const float* mla_q_norm; const float* mla_w_uq;
    const float* mla_kv_norm; const float* mla_w_ukv; const float* w_out; const float* ln1_g; const float* ln1_b; const float* moe_w_coarse; const float* moe_w_fine;
    const float* moe_w1; const float* moe_w3; const float* moe_w2; const float* ln2_g; const float* ln2_b;
    float* out; unsigned char* ws; int ph_lo, ph_hi, use_bar, pad;
};
struct Frame {
    LAS unsigned char* lds; unsigned char* ldsg;
    int tid, lane, wave, G, gw, NGW, bid;
    gu32* ctl; unsigned char* ws;
};
__device__ __forceinline__ void launder(Frame& F) {
    int wv = F.wave; asm volatile("" : "+s"(wv)); F.wave = wv;
    int t; asm volatile("v_mbcnt_lo_u32_b32 %0, -1, 0\n\tv_mbcnt_hi_u32_b32 %0, -1, %0" : "=v"(t)); F.lane = t; F.tid = wv * 64 + t;
    int b = (int)blockIdx.x; asm volatile("" : "+s"(b)); F.bid = b; F.gw = b * NWAVES + F.wave;
    unsigned char* w = F.ws; asm volatile("" : "+s"(w)); F.ws = w; F.ctl = (gu32*)(w + WS_CTL);
}
struct SeqInfo { int base, len, pos; };
__device__ __forceinline__ SeqInfo seqinfo(int m) { SeqInfo s; if (m < NTOK_P) { s.base = m & ~2047; s.len = 2048; } else { s.base = m & ~4095; s.len = 4096; } s.pos = m - s.base; return s; }

template <class ColMap>
__device__ __forceinline__ void transpose_item(const float* W, int N, bf16_t* WT, int ldd, LAS float* scr, int k0, int n0, const ColMap& cm, const float* kscale, int lane) {
    const int sc = cm(n0 + (lane & 31));
#pragma unroll 8
    for (int i = 0; i < 32; ++i) { const int kk = 2 * i + (lane >> 5); float v = 0.f; if (sc >= 0) { v = W[(size_t)(k0 + kk) * N + sc]; if (kscale) v *= kscale[k0 + kk]; } scr[kk * 33 + (lane & 31)] = v; }
    LDS_WAIT(); asm volatile("" ::: "memory");
    const int c = lane & 7;
#pragma unroll
    for (int j = 0; j < 4; ++j) { const int n = (lane >> 3) + 8 * j; const LAS float* s = scr + (8 * c) * 33 + n;
        u32x4 o; o.x = pk2(s[0 * 33], s[1 * 33]); o.y = pk2(s[2 * 33], s[3 * 33]); o.z = pk2(s[4 * 33], s[5 * 33]); o.w = pk2(s[6 * 33], s[7 * 33]);
        *(u32x4*)(WT + (size_t)(n0 + n) * ldd + k0 + 8 * c) = o; }
    LDS_WAIT(); asm volatile("" ::: "memory");
}
__device__ __forceinline__ void transpose_item_v4(const float* Wsrc, int N, bf16_t* WTdst, int ldd, LAS float* scr, int lane) {
    const int c4 = (lane & 7) * 4, kr = lane >> 3;
    f32x4 t[8];
#pragma unroll
    for (int i = 0; i < 8; ++i) t[i] = *(const f32x4*)(Wsrc + (size_t)(i * 8 + kr) * N + c4);
#pragma unroll
    for (int i = 0; i < 8; ++i) { const int kk = i * 8 + kr; scr[(c4 + 0) * 65 + kk] = t[i].x; scr[(c4 + 1) * 65 + kk] = t[i].y; scr[(c4 + 2) * 65 + kk] = t[i].z; scr[(c4 + 3) * 65 + kk] = t[i].w; }
    LDS_WAIT(); asm volatile("" ::: "memory");
    const int c = lane & 7;
#pragma unroll
    for (int j = 0; j < 4; ++j) { const int n = (lane >> 3) + 8 * j; const LAS float* p = scr + n * 65 + 8 * c;
        u32x4 o; o.x = pk2(p[0], p[1]); o.y = pk2(p[2], p[3]); o.z = pk2(p[4], p[5]); o.w = pk2(p[6], p[7]);
        *(u32x4*)(WTdst + (size_t)n * ldd + 8 * c) = o; }
    LDS_WAIT(); asm volatile("" ::: "memory");
}
struct WinMap {
    __device__ __forceinline__ int operator()(int n) const {
        if (n < 512) { const int t = n & 31; return (n & ~31) + (t >> 1) + 16 * (t & 1); }
        if (n < 1152) return n;
        if (n < 1184) { const int t = n - 1152; return 1152 + (t >> 1) + 16 * (t & 1); }
        if (n < 1280) return -1;
        if (n < 2048) { const int u = n - 1280, t = u & 63; return 1184 + (u & ~63) + (t >> 1) + 32 * (t & 1); }
        if (n < 2432) return 1952 + (n - 2048);
        return -1;
    }
};
struct UqMap { __device__ __forceinline__ int operator()(int n) const { if (n >= 576) return -1; const int h = n / 96, t = n - 96 * h; if (t < 64) return n; const int u = t - 64; return 96 * h + 64 + (u >> 1) + 16 * (u & 1); } };
struct IdMap { __device__ __forceinline__ int operator()(int n) const { return n; } };
struct W13Map { __device__ __forceinline__ int operator()(int n) const { return (n >> 8) * 128 + (n & 127); } };

__device__ __forceinline__ void p0_prologue(Frame& F, const Args& a) {
    LAS float* scr = (LAS float*)(F.lds + F.wave * 16384);
    { float2* r32 = (float2*)(F.ws + WS_ROPE32); float2* r64 = (float2*)(F.ws + WS_ROPE64);
      for (int i = F.gw * 64 + F.lane; i < 4096 * 16; i += F.NGW * 64) { const int pos = i >> 4, j = i & 15; const float inv = 1.0f / powf(10000.0f, (float)(2 * j) / 32.0f); const float ang = (float)pos * inv; r32[i] = make_float2(cosf(ang), sinf(ang)); }
      for (int i = F.gw * 64 + F.lane; i < 4096 * 32; i += F.NGW * 64) { const int pos = i >> 5, j = i & 31; const float inv = 1.0f / powf(10000.0f, (float)(2 * j) / 64.0f); const float ang = (float)pos * inv; r64[i] = make_float2(cosf(ang), sinf(ang)); } }
    constexpr int I_WIN = (1024 / 64) * (2560 / 32), I_WOUT = (1024 / 64) * (1024 / 32), I_UQ = (256 / 64) * (768 / 32), I_UKV = (256 / 64) * (768 / 32);
    constexpr int PER_L = I_WIN + I_WOUT + I_UQ + I_UKV;
    for (int it = F.gw; it < DEPTH * PER_L; it += F.NGW) {
        const int l = it / PER_L; int r = it - l * PER_L;
        if (r < I_WIN) { const int kb = r / 80, nb = r % 80; transpose_item(a.w_in + (size_t)l * 1024 * 2336, 2336, (bf16_t*)(F.ws + WS_WIN) + (size_t)l * 2560 * 1024, 1024, scr, kb * 64, nb * 32, WinMap(), nullptr, F.lane); continue; } r -= I_WIN;
        if (r < I_WOUT) { const int kb = r / 32, nb = r % 32; transpose_item(a.w_out + (size_t)l * 1024 * 1024, 1024, (bf16_t*)(F.ws + WS_WOUT) + (size_t)l * 1024 * 1024, 1024, scr, kb * 64, nb * 32, IdMap(), nullptr, F.lane); continue; } r -= I_WOUT;
        if (r < I_UQ) { const int kb = r / 24, nb = r % 24; transpose_item(a.mla_w_uq + (size_t)l * 256 * 576, 576, (bf16_t*)(F.ws + WS_WUQ) + (size_t)l * 768 * 256, 256, scr, kb * 64, nb * 32, UqMap(), a.mla_q_norm + l * 256, F.lane); continue; } r -= I_UQ;
        { const int kb = r / 24, nb = r % 24; bf16_t* dst = (bf16_t*)(F.ws + WS_WUKV) + (size_t)l * 768 * 256;
          if (kb < 2) transpose_item(a.mla_w_ukv + (size_t)l * 128 * 768, 768, dst, 256, scr, kb * 64, nb * 32, IdMap(), a.mla_kv_norm + l * 128, F.lane);
          else { const int c = F.lane & 7;
#pragma unroll
              for (int j = 0; j < 4; ++j) { const int n = (F.lane >> 3) + 8 * j; *(u32x4*)(dst + (size_t)(nb * 32 + n) * 256 + kb * 64 + 8 * c) = (u32x4){0u, 0u, 0u, 0u}; } } }
    }
    bf16_t* XB = (bf16_t*)(F.ws + WS_XB);
    for (int m = F.gw; m < NTOK; m += F.NGW) {
        const float* src = (m < NTOK_P) ? a.x_prompt + (size_t)m * DM : a.x_sample + (size_t)(m - NTOK_P) * DM;
#pragma unroll
        for (int j = 0; j < 4; ++j) { const f32x4 v = *((const f32x4*)src + F.lane + 64 * j);
            u32x2 w; w.x = pk2(v.x, v.y); w.y = pk2(v.z, v.w); *((u32x2*)(XB + (size_t)m * DM) + F.lane + 64 * j) = w; }
    }
}

template <class Epi, class RowMap>
__device__ __forceinline__ void sg_tile(const bf16_t* A, int lda, const bf16_t* B0, const bf16_t* B1, int ldb, int K, int m0, int c0, const Epi& E, const RowMap& RM, int lane) {
    const int r32 = lane & 31, hi = lane >> 5;
    const bf16_t* ap = A + (size_t)RM.src(m0 + r32) * lda + 8 * hi;
    const bf16_t* b0p = B0 + (size_t)r32 * ldb + 8 * hi;
    const bf16_t* b1p = B1 + (size_t)r32 * ldb + 8 * hi;
    f32x16 acc0 = {}, acc1 = {};
#pragma unroll 4
    for (int k = 0; k < K; k += 16) {
        const bf16x8 af = *(const bf16x8*)(ap + k), bf0 = *(const bf16x8*)(b0p + k), bf1 = *(const bf16x8*)(b1p + k);
        acc0 = MFMA32(bf0, af, acc0); acc1 = MFMA32(bf1, af, acc1);
    }
#pragma unroll
    for (int g = 0; g < 4; ++g) { const f32x4 v0 = {acc0[4 * g], acc0[4 * g + 1], acc0[4 * g + 2], acc0[4 * g + 3]}, v1 = {acc1[4 * g], acc1[4 * g + 1], acc1[4 * g + 2], acc1[4 * g + 3]};
        E.put(m0 + r32, c0, 8 * g + 4 * hi, v0, v1); }
}
struct IdRows { __device__ __forceinline__ int src(int m) const { return m; } };

__device__ __forceinline__ void store_bf8(bf16_t* p, f32x4 a, f32x4 b) { u32x4 w; w.x = pk2(a.x, a.y); w.y = pk2(a.z, a.w); w.z = pk2(b.x, b.y); w.w = pk2(b.z, b.w); *(u32x4*)p = w; }
__device__ __forceinline__ void store_bf4(bf16_t* p, f32x4 v) { u32x2 w; w.x = pk2(v.x, v.y); w.y = pk2(v.z, v.w); *(u32x2*)p = w; }
struct EpiH {
    static constexpr bool INPLACE = false;
    static constexpr bool PERM = true;
    bf16_t* H; const float2* rope32; const float2* rope64;
    __device__ __forceinline__ f32x4 xf(int pos, int col, f32x4 v) const {
        if (col < 512 || (col >= HC_KROPE && col < HC_KROPE + 32)) {
            const int j0 = (col & 31) >> 1; const f32x4 cs = *(const f32x4*)(rope32 + pos * 16 + j0);
            f32x4 o; o.x = v.x * cs.x - v.y * cs.y; o.y = v.x * cs.y + v.y * cs.x; o.z = v.z * cs.z - v.w * cs.w; o.w = v.z * cs.w + v.w * cs.z;
            if (col < 256) o = o * SC_A; v = o;
        } else if (col >= HC_CQ && col < HC_CV) {
            const int j0 = ((col - HC_CQ) & 63) >> 1; const f32x4 cs = *(const f32x4*)(rope64 + pos * 32 + j0);
            f32x4 o; o.x = v.x * cs.x - v.y * cs.y; o.y = v.x * cs.y + v.y * cs.x; o.z = v.z * cs.z - v.w * cs.w; o.w = v.z * cs.w + v.w * cs.z;
            if (col < HC_CK) o = o * SC_C; v = o;
        }
        return v;
    }
    __device__ __forceinline__ void put4(int row, int col, f32x4 v) const { store_bf4(H + (size_t)row * HP + col, xf(seqinfo(row).pos, col, v)); }
    __device__ __forceinline__ void put(int row, int c0, int cc, f32x4 v0, f32x4 v1) const { put4(row, c0 + cc, v0); put4(row, c0 + 32 + cc, v1); }
    template <class U> __device__ __forceinline__ void put8(const U&, int row, int col, f32x4 v0, f32x4 v1) const { const int pos = seqinfo(row).pos; store_bf8(H + (size_t)row * HP + col, xf(pos, col, v0), xf(pos, col + 4, v1)); }
    struct Pre { f32x4 c0, c1; };
    __device__ __forceinline__ static f32x4 rot(f32x4 v, f32x4 cs) { f32x4 o; o.x = v.x * cs.x - v.y * cs.y; o.y = v.x * cs.y + v.y * cs.x; o.z = v.z * cs.z - v.w * cs.w; o.w = v.z * cs.w + v.w * cs.z; return o; }
    template <class U> __device__ __forceinline__ Pre pre(const U&, int row, int col) const { Pre p; p.c0 = (f32x4){0.f, 0.f, 0.f, 0.f}; p.c1 = p.c0; const int pos = seqinfo(row).pos;
        if (col < 512 || (col >= HC_KROPE && col < HC_KROPE + 32)) { const f32x4* t = (const f32x4*)(rope32 + pos * 16 + ((col & 31) >> 1)); p.c0 = t[0]; p.c1 = t[1]; }
        else if (col >= HC_CQ && col < HC_CV) { const f32x4* t = (const f32x4*)(rope64 + pos * 32 + (((col - HC_CQ) & 63) >> 1)); p.c0 = t[0]; p.c1 = t[1]; }
        return p; }
    template <class U> __device__ __forceinline__ void fin8(const U&, int row, int col, f32x4 v0, f32x4 v1, const Pre& p) const {
        if (col < 512 || (col >= HC_KROPE && col < HC_KROPE + 32)) { v0 = rot(v0, p.c0); v1 = rot(v1, p.c1); if (col < 256) { v0 = v0 * SC_A; v1 = v1 * SC_A; } }
        else if (col >= HC_CQ && col < HC_CV) { v0 = rot(v0, p.c0); v1 = rot(v1, p.c1); if (col < HC_CK) { v0 = v0 * SC_C; v1 = v1 * SC_C; } }
        store_bf8(H + (size_t)row * HP + col, v0, v1); }
};
struct EpiUQ {
    static constexpr bool INPLACE = false;
    static constexpr bool PERM = true;
    bf16_t* Q; const float* rstd; const float2* rope32;
    __device__ __forceinline__ f32x4 xf(int row, int col, f32x4 v, float rs) const {
        v = v * rs;
        const int t = col % 96;
        if (t >= 64) { const int pos = seqinfo(row).pos; const int j0 = (t - 64) >> 1; const f32x4 cs = *(const f32x4*)(rope32 + pos * 16 + j0);
            f32x4 o; o.x = v.x * cs.x - v.y * cs.y; o.y = v.x * cs.y + v.y * cs.x; o.z = v.z * cs.z - v.w * cs.w; o.w = v.z * cs.w + v.w * cs.z; v = o; }
        return v * SC_B;
    }
    __device__ __forceinline__ void put4(int row, int col, f32x4 v) const { if (col >= 576) return; store_bf4(Q + (size_t)row * QBP + col, xf(row, col, v, rstd[2 * row])); }
    template <class U> __device__ __forceinline__ void put8(const U&, int row, int col, f32x4 v0, f32x4 v1) const { if (col >= 576) return; const float rs = rstd[2 * row]; store_bf8(Q + (size_t)row * QBP + col, xf(row, col, v0, rs), xf(row, col + 4, v1, rs)); }
    __device__ __forceinline__ void put(int row, int c0, int cc, f32x4 v0, f32x4 v1) const { put4(row, c0 + cc, v0); put4(row, c0 + 32 + cc, v1); }
    struct Pre { float rs; f32x4 c0, c1; };
    template <class U> __device__ __forceinline__ Pre pre(const U&, int row, int col) const { Pre p; p.rs = rstd[2 * row]; p.c0 = (f32x4){0.f, 0.f, 0.f, 0.f}; p.c1 = p.c0;
        if (col < 576 && (col % 96) >= 64) { const f32x4* t = (const f32x4*)(rope32 + seqinfo(row).pos * 16 + (((col % 96) - 64) >> 1)); p.c0 = t[0]; p.c1 = t[1]; }
        return p; }
    template <class U> __device__ __forceinline__ void fin8(const U&, int row, int col, f32x4 v0, f32x4 v1, const Pre& p) const { if (col >= 576) return;
        v0 = v0 * p.rs; v1 = v1 * p.rs; if ((col % 96) >= 64) { v0 = EpiH::rot(v0, p.c0); v1 = EpiH::rot(v1, p.c1); }
        store_bf8(Q + (size_t)row * QBP + col, v0 * SC_B, v1 * SC_B); }
};
struct EpiUKV {
    static constexpr bool INPLACE = false;
    static constexpr bool PERM = true;
    bf16_t* KV; const float* rstd;
    template <class U> __device__ __forceinline__ void put8(const U&, int row, int col, f32x4 v0, f32x4 v1) const { const float rs = rstd[2 * row + 1]; store_bf8(KV + (size_t)row * KVP + col, v0 * rs, v1 * rs); }
    __device__ __forceinline__ void put4(int row, int col, f32x4 v) const { store_bf4(KV + (size_t)row * KVP + col, v * rstd[2 * row + 1]); }
    __device__ __forceinline__ void put(int row, int c0, int cc, f32x4 v0, f32x4 v1) const { put4(row, c0 + cc, v0); put4(row, c0 + 32 + cc, v1); }
    struct Pre { float rs; };
    template <class U> __device__ __forceinline__ Pre pre(const U&, int row, int) const { Pre p; p.rs = rstd[2 * row + 1]; return p; }
    template <class U> __device__ __forceinline__ void fin8(const U&, int row, int col, f32x4 v0, f32x4 v1, const Pre& p) const { store_bf8(KV + (size_t)row * KVP + col, v0 * p.rs, v1 * p.rs); }
};
struct EpiRes {
    static constexpr bool INPLACE = true;
    static constexpr bool PERM = false;
    float* X; const float* xp; const float* xs; float* D;
    template <class U> __device__ __forceinline__ void put4(const U&, int row, int col, f32x4 v) const { put4(row, col, v); }
    __device__ __forceinline__ void put4(int row, int col, f32x4 v) const {
        const f32x4* p = (const f32x4*)(X + (size_t)row * DM + col);
        const f32x4 r = xp ? *(const f32x4*)(((row < NTOK_P) ? xp + (size_t)row * DM : xs + (size_t)(row - NTOK_P) * DM) + col) : *p;
        *(f32x4*)(D + (size_t)row * DM + col) = r * DN_ALPHA + v; }
    __device__ __forceinline__ void put(int row, int c0, int cc, f32x4 v0, f32x4 v1) const { put4(row, c0 + cc, v0); put4(row, c0 + 32 + cc, v1); }
    struct Pre { f32x4 a, b; };
    template <class U> __device__ __forceinline__ Pre pre(const U&, int row, int col) const { Pre p;
        const float* src = xp ? ((row < NTOK_P) ? xp + (size_t)row * DM : xs + (size_t)(row - NTOK_P) * DM) : X + (size_t)row * DM;
        p.a = *(const f32x4*)(src + col); p.b = *(const f32x4*)(src + col + 16); return p; }
    template <class U> __device__ __forceinline__ void fin4x2(const U&, int row, int col, f32x4 v0, f32x4 v1, const Pre& p) const {
        *(f32x4*)(D + (size_t)row * DM + col) = p.a * DN_ALPHA + v0; *(f32x4*)(D + (size_t)row * DM + col + 16) = p.b * DN_ALPHA + v1; }
};
__device__ __forceinline__ float silu_f(float x) { return x / (1.0f + __expf(-x)); }
struct EpiHid {
    static constexpr bool INPLACE = false;
    static constexpr bool PERM = true;
    bf16_t* HID;
    __device__ __forceinline__ f32x4 act(f32x4 g, f32x4 u) const { f32x4 o; o.x = silu_f(g.x) * u.x; o.y = silu_f(g.y) * u.y; o.z = silu_f(g.z) * u.z; o.w = silu_f(g.w) * u.w; return o; }
    template <class U> __device__ __forceinline__ void putp8(const U&, int row, int col, f32x4 g0, f32x4 g1, f32x4 u0, f32x4 u1) const { store_bf8(HID + (size_t)row * DEXP + col, act(g0, u0), act(g1, u1)); }
    __device__ __forceinline__ void putp(int row, int col, f32x4 g, f32x4 u) const { f32x4 o; o.x = silu_f(g.x) * u.x; o.y = silu_f(g.y) * u.y; o.z = silu_f(g.z) * u.z; o.w = silu_f(g.w) * u.w; store_bf4(HID + (size_t)row * DEXP + col, o); }
    __device__ __forceinline__ void put(int row, int c0, int cc, f32x4 v0, f32x4 v1) const { putp(row, c0 + cc, v0, v1); }
};
struct EpiY {
    static constexpr bool INPLACE = false;
    bf16_t* YB; const float* tw; const int* list; int seg0, cnt;
    __device__ __forceinline__ void put4(int row, int col, f32x4 v) const { const int r = row - seg0; if (r >= cnt) return; const int a = list[r]; store_bf4(YB + (size_t)a * DM + col, v * tw[a]); }
    __device__ __forceinline__ void put(int row, int c0, int cc, f32x4 v0, f32x4 v1) const { put4(row, c0 + cc, v0); put4(row, c0 + 32 + cc, v1); }
};

struct EpiYO {
    static constexpr bool INPLACE = false;
    static constexpr bool PERM = true;
    bf16_t* YB; const float* tw; const int* list; const LAS int* seg; const float* lw;
    template <class U> __device__ __forceinline__ void put8(const U& u, int row, int col, f32x4 v0, f32x4 v1) const {
        const int r = row - __builtin_amdgcn_readfirstlane(seg[u.e]); if (r >= __builtin_amdgcn_readfirstlane(seg[33 + u.e])) return; const int a = list[(size_t)u.e * LIST_CAP + r]; const float w = tw[a]; store_bf8(YB + (size_t)a * DM + col, v0 * w, v1 * w); }
    struct Pre { int a; float w; };
    template <class U> __device__ __forceinline__ Pre pre(const U& u, int row, int) const { Pre p; p.a = -1; p.w = 0.f;
        const int r = row - __builtin_amdgcn_readfirstlane(seg[u.e]); if (r < __builtin_amdgcn_readfirstlane(seg[33 + u.e])) { p.a = list[(size_t)u.e * LIST_CAP + r]; p.w = lw[(size_t)u.e * LIST_CAP + r]; } return p; }
    template <class U> __device__ __forceinline__ void fin8(const U&, int, int col, f32x4 v0, f32x4 v1, const Pre& p) const { if (p.a >= 0) store_bf8(YB + (size_t)p.a * DM + col, v0 * p.w, v1 * p.w); }
};
template <class Epi>
__device__ __forceinline__ void sg_phase(Frame& F, const bf16_t* A, int lda, const bf16_t* Bt, int ldb, int M, int N, int K, const Epi& E) {
    const int nN = N / 64, items = (M / 32) * nN;
    for (int it = F.gw; it < items; it += F.NGW) { const int mt = it / nN, nt = it - mt * nN;
        sg_tile(A, lda, Bt + (size_t)(nt * 64) * ldb, Bt + (size_t)(nt * 64 + 32) * ldb, ldb, K, mt * 32, nt * 64, E, IdRows(), F.lane); }
}


namespace pg8 {
constexpr int BM = 256, BK = 64, HALF = 128, HTB = HALF * BK * 2, NXCD = 8, WGM = 8;
__host__ __device__ __forceinline__ int lds_byte(int r, int c) { const int st = (r >> 4) * 2 + (c >> 5), rr = r & 15, cc = c & 31, ob = rr * 64 + cc * 2; return st * 1024 + (ob ^ (((ob >> 9) & 1) << 5)); }
__host__ __device__ __forceinline__ void stage_rc(int b, int& R, int& C) { const int st = b / 1024, sb = b % 1024, swz = sb ^ (((sb >> 9) & 1) << 5); R = (st >> 1) * 16 + swz / 64; C = (st & 1) * 32 + (swz % 64) / 2; }
__host__ __device__ __forceinline__ int perm32(int rho) { const int n = rho >> 4, i = rho & 15; return 8 * (i >> 2) + 4 * n + (i & 3); }
struct Unit { int pm, pn, e; const char* a; const char* b; };
__device__ __forceinline__ bool order_next(int i, int G, int c, int nM, int nN, int& pm, int& pn) {
    const int nwg = nM * nN; const long L = (long)i * G + c; if (L >= nwg) return false;
    int wgid = (int)L; { const int q = nwg / NXCD, r = nwg % NXCD, xcd = wgid % NXCD, off = wgid / NXCD; wgid = (xcd < r ? xcd * (q + 1) : r * (q + 1) + (xcd - r) * q) + off; }
    const int nig = WGM * nN, gid = wgid / nig, fm = gid * WGM, gsz = (nM - fm) < WGM ? (nM - fm) : WGM;
    pm = fm + ((wgid % nig) % gsz); pn = (wgid % nig) / gsz; return true;
}
struct DenseSched {
    const char* A; const char* Bt; int nM, nN, G, c; size_t tstepA, tstepB;
    __device__ __forceinline__ void init(const bf16_t* A_, int lda, const bf16_t* Bt_, int M, int N, int K, int G_, int c_) { A = (const char*)A_; Bt = (const char*)Bt_; nM = M / BM; nN = N / BM; G = G_; c = c_; tstepA = (size_t)BM * lda * 2; tstepB = (size_t)BM * K * 2; }
    __device__ __forceinline__ bool next(int i, Unit& u) const { if (!order_next(i, G, c, nM, nN, u.pm, u.pn)) return false; u.e = 0; u.a = A + (size_t)u.pm * tstepA; u.b = Bt + (size_t)u.pn * tstepB; return true; }
    __device__ __forceinline__ unsigned arow(const Unit&, int) const { return 0u; }
};
struct PanelSched {
    const char* A; const char* Bt; int pm, nN; size_t tstepB;
    __device__ __forceinline__ void init(const bf16_t* A_, int lda, const bf16_t* Bt_, int pm_, int N, int K) { pm = pm_; nN = N / BM; A = (const char*)A_ + (size_t)pm_ * BM * lda * 2; Bt = (const char*)Bt_; tstepB = (size_t)BM * K * 2; }
    __device__ __forceinline__ bool next(int i, Unit& u) const { if (i >= nN) return false; u.pm = pm; int pn = i + (pm % nN); if (pn >= nN) pn -= nN; u.pn = pn; u.e = 0; u.a = A; u.b = Bt + (size_t)pn * tstepB; return true; }
    __device__ __forceinline__ unsigned arow(const Unit&, int) const { return 0u; }
};
template <class Epi, bool PAIR> struct EpiApply;
template <class Epi, class Sched, bool GATHER, bool PAIR>
__device__ __forceinline__ void gemm_phase(LAS unsigned char* lds, int tid, int K, int lda, const Sched& S, const Epi& E) {
    const int wid = __builtin_amdgcn_readfirstlane(tid >> 6), lane = tid & 63, wr = wid >> 2, wc = wid & 3, fr = lane & 15, fq = lane >> 4;
    const int nt = K / BK;
    unsigned voffA[2], voffB[2]; int RA[2], CA[2];
#pragma unroll
    for (int i = 0; i < 2; ++i) { int R, C; stage_rc(tid * 16 + i * 8192, R, C); const int Rb = Epi::PERM ? ((R & ~31) + perm32(R & 31)) : R; RA[i] = R; CA[i] = C;
        voffA[i] = (unsigned)(R * lda + C) * 2u; voffB[i] = (unsigned)(Rb * K + C) * 2u; }
    const size_t kstep = (size_t)(BK * 2);
    const size_t hstepA = (size_t)HALF * lda * 2, hstepB = (size_t)HALF * K * 2;
    const unsigned ldsw = (unsigned)wid * 1024u;
    const int aoff = lds_byte(wr * 64 + fr, fq * 8), boff = lds_byte(wc * 32 + fr, fq * 8);
#define PG8_SA(b, h) (((b) * 2 + (h)) * HTB)
#define PG8_SB(b, h) ((4 + (b) * 2 + (h)) * HTB)
#define PG8_STAGE(bufoff, gbase, voff) do { _Pragma("unroll") for (int _i = 0; _i < 2; ++_i) \
        __builtin_amdgcn_global_load_lds((const unsigned*)((const char*)(gbase) + (voff)[_i]), (LAS unsigned*)(lds + (bufoff) + ldsw + _i * 8192), 16, 0, 0); } while (0)
#define PG8_STAGE_A(bufoff, ab, vg, h, koff) do { if (GATHER) { PG8_STAGE(bufoff, (ab) + (koff), (vg)[h]); } else { PG8_STAGE(bufoff, (ab) + (h) * hstepA + (koff), voffA); } } while (0)
#define PG8_LDA(dst, b, h) do { _Pragma("unroll") for (int m = 0; m < 4; ++m) _Pragma("unroll") for (int k = 0; k < 2; ++k) dst[m][k] = *(const LAS bf16x8*)(lds + PG8_SA(b, h) + aoff + m * 2048 + k * 1024); } while (0)
#define PG8_LDB(dst, b, h) do { _Pragma("unroll") for (int n = 0; n < 2; ++n) _Pragma("unroll") for (int k = 0; k < 2; ++k) dst[n][k] = *(const LAS bf16x8*)(lds + PG8_SB(b, h) + boff + n * 2048 + k * 1024); } while (0)
#define PG8_MMA(ai, bj, At, Bt) do { __builtin_amdgcn_s_setprio(1); _Pragma("unroll") for (int m = 0; m < 4; ++m) _Pragma("unroll") for (int n = 0; n < 2; ++n) _Pragma("unroll") for (int k = 0; k < 2; ++k) \
        acc[ai][bj][m][n] = __builtin_amdgcn_mfma_f32_16x16x32_bf16(Bt[n][k], At[m][k], acc[ai][bj][m][n], 0, 0, 0); __builtin_amdgcn_s_setprio(0); } while (0)
#define PG8_WAIT_V(n) asm volatile("s_waitcnt vmcnt(" #n ")" ::: "memory")
#define PG8_WAIT_L(n) asm volatile("s_waitcnt lgkmcnt(" #n ")" ::: "memory")
#define PG8_BAR __builtin_amdgcn_s_barrier()
#define PG8_SCHED __builtin_amdgcn_sched_barrier(0)
    Unit cur, nxt; int ui = 0;
    if (!S.next(0, cur)) return;
    f32x4 acc[2][2][4][2];
#pragma unroll
    for (int a = 0; a < 2; ++a)
#pragma unroll
        for (int b = 0; b < 2; ++b)
#pragma unroll
            for (int m = 0; m < 4; ++m)
#pragma unroll
                for (int n = 0; n < 2; ++n) acc[a][b][m][n] = (f32x4){0.f, 0.f, 0.f, 0.f};
    bf16x8 At[4][2], B0[2][2], B1[2][2];
    unsigned vgc[2][2] = {{0u, 0u}, {0u, 0u}}, vgn[2][2] = {{0u, 0u}, {0u, 0u}};
    if (GATHER) {
#pragma unroll
        for (int h = 0; h < 2; ++h)
#pragma unroll
            for (int i = 0; i < 2; ++i) vgc[h][i] = S.arow(cur, h * HALF + RA[i]) * (unsigned)(lda * 2) + (unsigned)CA[i] * 2u;
    }
    const char* cA = cur.a; const char* cB = cur.b;
    PG8_STAGE(PG8_SB(0, 0), cB, voffB); PG8_STAGE(PG8_SB(0, 1), cB + hstepB, voffB); PG8_STAGE_A(PG8_SA(0, 0), cA, vgc, 0, 0); PG8_STAGE_A(PG8_SA(0, 1), cA, vgc, 1, 0);
    if (wr == 1) PG8_BAR;
    PG8_WAIT_V(2); PG8_BAR;
    PG8_STAGE(PG8_SB(1, 0), cB + kstep, voffB); PG8_STAGE_A(PG8_SA(1, 0), cA, vgc, 0, kstep); PG8_STAGE(PG8_SB(1, 1), cB + hstepB + kstep, voffB);
    PG8_WAIT_V(6); PG8_BAR;
    for (;;) {
        const bool has_next = S.next(ui + 1, nxt);
        const char* nA = has_next ? nxt.a : cA; const char* nB = has_next ? nxt.b : cB;
        if (GATHER) {
#pragma unroll
            for (int h = 0; h < 2; ++h)
#pragma unroll
                for (int i = 0; i < 2; ++i) vgn[h][i] = has_next ? (S.arow(nxt, h * HALF + RA[i]) * (unsigned)(lda * 2) + (unsigned)CA[i] * 2u) : vgc[h][i];
        }
#pragma clang loop unroll(disable)
        for (int t = 0; t < nt; t += 2) {
            const bool last = (t == nt - 2);
            const size_t k1 = (size_t)(t + 1) * kstep;
            const char* a2 = last ? nA : cA; const char* b2 = last ? nB : cB + (size_t)(t + 2) * kstep; const size_t ka2 = last ? 0 : (size_t)(t + 2) * kstep;
            const char* b3 = b2 + kstep; const size_t ka3 = ka2 + kstep;
            unsigned v2[2][2];
#pragma unroll
            for (int h = 0; h < 2; ++h)
#pragma unroll
                for (int i = 0; i < 2; ++i) v2[h][i] = last ? vgn[h][i] : vgc[h][i];
            PG8_LDB(B0, 0, 0); PG8_LDB(B1, 0, 1); PG8_SCHED; PG8_LDA(At, 0, 0); PG8_STAGE_A(PG8_SA(1, 1), cA, vgc, 1, k1);
            PG8_WAIT_V(8); PG8_WAIT_L(0); PG8_BAR; PG8_MMA(0, 0, At, B0); PG8_MMA(0, 1, At, B1); PG8_BAR; PG8_SCHED;
            PG8_LDA(At, 0, 1); PG8_STAGE(PG8_SB(0, 0), b2, voffB); PG8_STAGE(PG8_SB(0, 1), b2 + hstepB, voffB); PG8_STAGE_A(PG8_SA(0, 0), a2, v2, 0, ka2);
            PG8_WAIT_V(8); PG8_WAIT_L(0); PG8_BAR; PG8_MMA(1, 0, At, B0); PG8_MMA(1, 1, At, B1); PG8_BAR; PG8_SCHED;
            PG8_LDB(B0, 1, 0); PG8_LDB(B1, 1, 1); PG8_SCHED; PG8_LDA(At, 1, 0); PG8_STAGE_A(PG8_SA(0, 1), a2, v2, 1, ka2);
            PG8_WAIT_V(8); PG8_WAIT_L(0); PG8_BAR; PG8_MMA(0, 0, At, B0); PG8_MMA(0, 1, At, B1); PG8_BAR; PG8_SCHED;
            PG8_LDA(At, 1, 1); PG8_STAGE(PG8_SB(1, 0), b3, voffB); PG8_STAGE(PG8_SB(1, 1), b3 + hstepB, voffB); PG8_STAGE_A(PG8_SA(1, 0), a2, v2, 0, ka3);
            PG8_WAIT_V(8); PG8_WAIT_L(0); PG8_BAR; PG8_MMA(1, 0, At, B0); PG8_MMA(1, 1, At, B1); PG8_BAR; PG8_SCHED;
        }
        if (wr == 0) PG8_BAR;
        { int fr_ = fr, fq_ = fq; asm volatile("" : "+v"(fr_), "+v"(fq_));
          EpiApply<Epi, PAIR>::run(E, acc, cur, wr, wc, fr_, fq_);
#ifdef PROBE_DUP_EPI
          if (!Epi::INPLACE) { asm volatile("" : "+v"(fr_), "+v"(fq_)); EpiApply<Epi, PAIR>::run(E, acc, cur, wr, wc, fr_, fq_); }
#endif
          }
        if (!has_next) break;
#pragma unroll
        for (int a = 0; a < 2; ++a)
#pragma unroll
            for (int b = 0; b < 2; ++b)
#pragma unroll
                for (int m = 0; m < 4; ++m)
#pragma unroll
                    for (int n = 0; n < 2; ++n) acc[a][b][m][n] = (f32x4){0.f, 0.f, 0.f, 0.f};
        cur = nxt; cA = nA; cB = nB; ++ui;
        if (GATHER) {
#pragma unroll
            for (int h = 0; h < 2; ++h)
#pragma unroll
                for (int i = 0; i < 2; ++i) vgc[h][i] = vgn[h][i];
        }
        if (wr == 1) PG8_BAR;
    }
    PG8_WAIT_V(0);
    PG8_BAR;
#undef PG8_SA
#undef PG8_SB
#undef PG8_STAGE
#undef PG8_STAGE_A
#undef PG8_LDA
#undef PG8_LDB
#undef PG8_MMA
#undef PG8_WAIT_V
#undef PG8_WAIT_L
#undef PG8_BAR
#undef PG8_SCHED
}
template <class Epi> struct EpiApply<Epi, false> {
    static __device__ __forceinline__ void run(const Epi& E, const f32x4 (&acc)[2][2][4][2], const Unit& u, int wr, int wc, int fr, int fq) {
#pragma unroll
        for (int ai = 0; ai < 2; ++ai) {
            typename Epi::Pre pre[4][2];
#pragma unroll
            for (int m = 0; m < 4; ++m) { const int row = u.pm * BM + ai * HALF + wr * 64 + m * 16 + fr;
#pragma unroll
                for (int bj = 0; bj < 2; ++bj) pre[m][bj] = E.pre(u, row, u.pn * BM + bj * HALF + wc * 32 + (Epi::PERM ? 8 : 4) * fq); }
#pragma unroll
            for (int m = 0; m < 4; ++m) { const int row = u.pm * BM + ai * HALF + wr * 64 + m * 16 + fr;
#pragma unroll
                for (int bj = 0; bj < 2; ++bj) {
                    if constexpr (Epi::PERM) E.fin8(u, row, u.pn * BM + bj * HALF + wc * 32 + 8 * fq, acc[ai][bj][m][0], acc[ai][bj][m][1], pre[m][bj]);
                    else E.fin4x2(u, row, u.pn * BM + bj * HALF + wc * 32 + 4 * fq, acc[ai][bj][m][0], acc[ai][bj][m][1], pre[m][bj]); } }
        }
    }
};
template <class Epi> struct EpiApply<Epi, true> {
    static __device__ __forceinline__ void run(const Epi& E, const f32x4 (&acc)[2][2][4][2], const Unit& u, int wr, int wc, int fr, int fq) {
#pragma unroll
        for (int ai = 0; ai < 2; ++ai)
#pragma unroll
            for (int m = 0; m < 4; ++m) { const int row = u.pm * BM + ai * HALF + wr * 64 + m * 16 + fr;
                E.putp8(u, row, u.pn * HALF + wc * 32 + 8 * fq, acc[ai][0][m][0], acc[ai][0][m][1], acc[ai][1][m][0], acc[ai][1][m][1]); }
    }
};
}

__device__ __forceinline__ void rowstat_pass(Frame& F, int r_first, int r_stride, int r_end) {
    const bf16_t* H = (const bf16_t*)(F.ws + WS_H); float* rstd = (float*)(F.ws + WS_RSTD);
    for (int m = r_first; m < r_end; m += r_stride) {
        const bf16_t* hr = H + (size_t)m * HP;
        const u32x2 q = *((const u32x2*)(hr + HC_CQ_LAT) + F.lane);
        const unsigned kv = *((const unsigned*)(hr + HC_CKV) + F.lane);
        float a0 = bf2f(q.x & 0xffff), a1 = bf2f(q.x >> 16), a2 = bf2f(q.y & 0xffff), a3 = bf2f(q.y >> 16), b0 = bf2f(kv & 0xffff), b1 = bf2f(kv >> 16);
        const float sq = wave_sum(a0 * a0 + a1 * a1 + a2 * a2 + a3 * a3), sk = wave_sum(b0 * b0 + b1 * b1);
        if (F.lane == 0) { rstd[2 * m] = 1.0f / sqrtf(sq * (1.0f / 256.0f) + RMS_EPS); rstd[2 * m + 1] = 1.0f / sqrtf(sk * (1.0f / 128.0f) + RMS_EPS); }
    }
}
__device__ __forceinline__ void red8(float (&v)[8], int lane) {
    float a[4], b[2], c;
#pragma unroll
    for (int i = 0; i < 4; ++i) a[i] = xpair32(v[i], v[i + 4]);
    { const bool up = (lane & 16) != 0;
#pragma unroll
      for (int i = 0; i < 2; ++i) { const float send = up ? a[i] : a[i + 2], keep = up ? a[i + 2] : a[i]; b[i] = keep + shx<16>(send); } }
    { const bool up = (lane & 8) != 0; const float send = up ? b[0] : b[1], keep = up ? b[1] : b[0]; c = keep + shx<8>(send); }
    c += shx<4>(c); c += shx<2>(c); c += shx<1>(c);
#pragma unroll
    for (int i = 0; i < 8; ++i) v[i] = __uint_as_float(__builtin_amdgcn_readlane(__float_as_uint(c), ((i >> 2) & 1) * 32 + ((i >> 1) & 1) * 16 + (i & 1) * 8));
}
__device__ __forceinline__ void red4(float (&v)[4], int lane) {
    float a[2], c;
#pragma unroll
    for (int i = 0; i < 2; ++i) a[i] = xpair32(v[i], v[i + 2]);
    { const bool up = (lane & 16) != 0; const float send = up ? a[0] : a[1], keep = up ? a[1] : a[0]; c = keep + shx<16>(send); }
    c += shx<8>(c); c += shx<4>(c); c += shx<2>(c); c += shx<1>(c);
#pragma unroll
    for (int i = 0; i < 4; ++i) v[i] = __uint_as_float(__builtin_amdgcn_readlane(__float_as_uint(c), ((i >> 1) & 1) * 32 + (i & 1) * 16));
}
__device__ __forceinline__ void ln1_route_pass(Frame& F, const Args& a, int layer, int r_first, int r_stride, int r_end) {
    bf16_t* XB = (bf16_t*)(F.ws + WS_XB); float* tw = (float*)(F.ws + WS_TW); int* list = (int*)(F.ws + WS_LIST);
    const float* g = a.ln1_g + layer * DM; const float* bb = a.ln1_b + layer * DM;
    const float* wc = a.moe_w_coarse + (size_t)layer * DM * 4; const float* wf = a.moe_w_fine + (size_t)layer * 4 * DM * 8;
    for (int q = F.tid; q < 4 * 1024 * 2; q += NTHREADS) { const int hf = q & 1, k = (q >> 1) & 1023, gg = q >> 11; const int l = (k & 255) >> 2, e = k & 3, j = k >> 8;
        *(LAS f32x4*)(F.lds + (size_t)(gg * 2048 + ((j * 4 + e) * 2 + hf) * 64 + l) * 16) = *((const f32x4*)wf + q); }
    f32x4 wcr[4][4];
#pragma unroll
    for (int j = 0; j < 4; ++j)
#pragma unroll
        for (int e = 0; e < 4; ++e) wcr[j][e] = *(const f32x4*)(wc + (size_t)(4 * F.lane + 256 * j + e) * 4);
    __syncthreads();
    LAS int* lcnt = (LAS int*)(F.lds + RING_BYTES + 1024); LAS int* lbase = lcnt + 32; LAS int* rec_er = lcnt + 64; LAS int* rec_a = rec_er + 512; LAS float* rec_w = (LAS float*)(rec_a + 512); float* lw = (float*)(F.ws + WS_LW);
  for (int c_first = r_first; c_first < r_end; c_first += 32 * r_stride) {
    const int c_end = (c_first + 32 * r_stride < r_end) ? c_first + 32 * r_stride : r_end;
    if (F.tid < 32) lcnt[F.tid] = 0;
    for (int q = F.tid; q < 512; q += NTHREADS) rec_a[q] = -1;
    __syncthreads();
    f32x4 vn[2][4];
#pragma unroll
    for (int rr = 0; rr < 2; ++rr) { const int mm = c_first + rr * r_stride; if (mm < c_end) {
#pragma unroll
        for (int j = 0; j < 4; ++j) vn[rr][j] = *((const f32x4*)(a.out + (size_t)mm * DM) + F.lane + 64 * j); } }
    for (int m0 = c_first; m0 < c_end; m0 += 2 * r_stride) {
        f32x4 vc[2][4];
#pragma unroll
        for (int rr = 0; rr < 2; ++rr)
#pragma unroll
            for (int j = 0; j < 4; ++j) vc[rr][j] = vn[rr][j];
#pragma unroll
        for (int rr = 0; rr < 2; ++rr) { const int mm = m0 + (2 + rr) * r_stride; if (mm < c_end) {
#pragma unroll
            for (int j = 0; j < 4; ++j) vn[rr][j] = *((const f32x4*)(a.out + (size_t)mm * DM) + F.lane + 64 * j); } }
#pragma unroll
      for (int rr = 0; rr < 2; ++rr) { const int m = m0 + rr * r_stride; if (m < c_end) {
        f32x4 v[4]; float s = 0.f;
#pragma unroll
        for (int j = 0; j < 4; ++j) { v[j] = vc[rr][j]; s += (v[j].x + v[j].y) + (v[j].z + v[j].w); }
        const float mean = wave_sum(s) * (1.f / DM); float s2 = 0.f;
#pragma unroll
        for (int j = 0; j < 4; ++j) { v[j] = v[j] - mean; s2 += (v[j].x * v[j].x + v[j].y * v[j].y) + (v[j].z * v[j].z + v[j].w * v[j].w); }
        const float rs = 1.f / sqrtf(wave_sum(s2) * (1.f / DM) + LN_EPS);
        float cl[4] = {0.f, 0.f, 0.f, 0.f};
#pragma unroll
        for (int j = 0; j < 4; ++j) { const int c = 4 * F.lane + 256 * j; const f32x4 gg = *(const f32x4*)(g + c), bv = *(const f32x4*)(bb + c); v[j] = v[j] * rs * gg + bv;
            u32x2 w; w.x = pk2(v[j].x, v[j].y); w.y = pk2(v[j].z, v[j].w); *((u32x2*)(XB + (size_t)m * DM) + F.lane + 64 * j) = w;
#pragma unroll
            for (int e = 0; e < 4; ++e) { const f32x4 w4 = wcr[j][e]; const float xe = v[j][e]; cl[0] += xe * w4.x; cl[1] += xe * w4.y; cl[2] += xe * w4.z; cl[3] += xe * w4.w; } }
        red4(cl, F.lane);
        int grp = 0; float cm = cl[0];
#pragma unroll
        for (int e = 1; e < 4; ++e) if (cl[e] > cm) { cm = cl[e]; grp = e; }
        float den = 0.f;
#pragma unroll
        for (int e = 0; e < 4; ++e) den += __expf(cl[e] - cm);
        const float pg = 1.0f / den;
        grp = __builtin_amdgcn_readfirstlane(grp);
        const LAS f32x4* wl = (const LAS f32x4*)(F.lds) + grp * 2048 + F.lane;
        float fl[8] = {0.f, 0.f, 0.f, 0.f, 0.f, 0.f, 0.f, 0.f};
#pragma unroll
        for (int j = 0; j < 4; ++j)
#pragma unroll
            for (int e = 0; e < 4; ++e) { const f32x4 wa = wl[((j * 4 + e) * 2) * 64], wb = wl[((j * 4 + e) * 2 + 1) * 64]; const float xe = v[j][e];
                fl[0] += xe * wa.x; fl[1] += xe * wa.y; fl[2] += xe * wa.z; fl[3] += xe * wa.w; fl[4] += xe * wb.x; fl[5] += xe * wb.y; fl[6] += xe * wb.z; fl[7] += xe * wb.w; }
        red8(fl, F.lane);
        int i0 = 0; float v0 = fl[0];
#pragma unroll
        for (int e = 1; e < 8; ++e) if (fl[e] > v0) { v0 = fl[e]; i0 = e; }
        int i1 = -1; float v1 = -3.0e38f;
#pragma unroll
        for (int e = 0; e < 8; ++e) if (e != i0 && fl[e] > v1) { v1 = fl[e]; i1 = e; }
        const float e1 = __expf(v1 - v0), w0 = pg / (1.0f + e1), w1 = pg * e1 / (1.0f + e1);
        if (F.lane < 2) { const int e = grp * 8 + (F.lane == 0 ? i0 : i1); const int a_id = 2 * m + F.lane;
            const int lr = __hip_atomic_fetch_add(lcnt + e, 1, __ATOMIC_RELAXED, __HIP_MEMORY_SCOPE_WORKGROUP);
            const int ri = (((m - c_first) / r_stride) * NWAVES + F.wave) * 2 + F.lane;
            rec_er[ri] = (e << 16) | lr; rec_a[ri] = a_id; rec_w[ri] = (F.lane == 0) ? w0 : w1; tw[a_id] = (F.lane == 0) ? w0 : w1; }
          } }
    }
    __syncthreads();
    if (F.tid < 32) { const int n = lcnt[F.tid]; lbase[F.tid] = n ? (int)__hip_atomic_fetch_add(F.ctl + CW_CNT + layer * 64 + F.tid, (unsigned)n, RLX_AGENT) : 0; }
    __syncthreads();
    for (int q = F.tid; q < 512; q += NTHREADS) { const int aid = rec_a[q]; if (aid >= 0) { const int er = rec_er[q], e = er >> 16; const size_t li = (size_t)e * LIST_CAP + lbase[e] + (er & 0xffff); list[li] = aid; lw[li] = rec_w[q]; } }
    __syncthreads();
  }
    __syncthreads();
}
__device__ __forceinline__ void ln2_pass(Frame& F, const Args& a, int layer, int r_first, int r_stride, int r_end) {
    bf16_t* XB = (bf16_t*)(F.ws + WS_XB); const bf16_t* YB = (const bf16_t*)(F.ws + WS_YB);
    const float* g = a.ln2_g + layer * DM; const float* bb = a.ln2_b + layer * DM; const float* g1 = a.ln1_g + layer * DM; const float* b1 = a.ln1_b + layer * DM;
    f32x4 xn[2][4]; u32x2 pn[2][4], qn[2][4];
#define LN2_LOAD(rr, mm) do { const bf16_t* y0_ = YB + (size_t)(2 * (mm)) * DM; _Pragma("unroll") for (int j = 0; j < 4; ++j) { xn[rr][j] = *((const f32x4*)(a.out + (size_t)(mm) * DM) + F.lane + 64 * j); \
        pn[rr][j] = *((const u32x2*)y0_ + F.lane + 64 * j); qn[rr][j] = *((const u32x2*)(y0_ + DM) + F.lane + 64 * j); } } while (0)
#pragma unroll
    for (int rr = 0; rr < 2; ++rr) { const int mm = r_first + rr * r_stride; if (mm < r_end) LN2_LOAD(rr, mm); }
    for (int m0 = r_first; m0 < r_end; m0 += 2 * r_stride) {
        f32x4 xc[2][4]; u32x2 pc[2][4], qc[2][4];
#pragma unroll
        for (int rr = 0; rr < 2; ++rr)
#pragma unroll
            for (int j = 0; j < 4; ++j) { xc[rr][j] = xn[rr][j]; pc[rr][j] = pn[rr][j]; qc[rr][j] = qn[rr][j]; }
#pragma unroll
        for (int rr = 0; rr < 2; ++rr) { const int mm = m0 + (2 + rr) * r_stride; if (mm < r_end) LN2_LOAD(rr, mm); }
#pragma unroll
        for (int rr = 0; rr < 2; ++rr) { const int m = m0 + rr * r_stride; if (m < r_end) {
            float* xr = a.out + (size_t)m * DM;
            f32x4 v[4]; float s = 0.f;
            { float s1 = 0.f;
#pragma unroll
              for (int j = 0; j < 4; ++j) { v[j] = xc[rr][j]; s1 += (v[j].x + v[j].y) + (v[j].z + v[j].w); }
              const float mean1 = wave_sum(s1) * (1.f / DM); float q1 = 0.f;
#pragma unroll
              for (int j = 0; j < 4; ++j) { v[j] = v[j] - mean1; q1 += (v[j].x * v[j].x + v[j].y * v[j].y) + (v[j].z * v[j].z + v[j].w * v[j].w); }
              const float rs1 = 1.f / sqrtf(wave_sum(q1) * (1.f / DM) + LN_EPS);
#pragma unroll
              for (int j = 0; j < 4; ++j) { const int c = 4 * F.lane + 256 * j; xc[rr][j] = v[j] * rs1 * *(const f32x4*)(g1 + c) + *(const f32x4*)(b1 + c); } }
#pragma unroll
            for (int j = 0; j < 4; ++j) { v[j] = xc[rr][j] * DN_ALPHA; const u32x2 p = pc[rr][j], q = qc[rr][j];
                v[j].x += bf2f(p.x & 0xffff) + bf2f(q.x & 0xffff); v[j].y += bf2f(p.x >> 16) + bf2f(q.x >> 16); v[j].z += bf2f(p.y & 0xffff) + bf2f(q.y & 0xffff); v[j].w += bf2f(p.y >> 16) + bf2f(q.y >> 16);
                s += (v[j].x + v[j].y) + (v[j].z + v[j].w); }
            const float mean = wave_sum(s) * (1.f / DM); float s2 = 0.f;
#pragma unroll
            for (int j = 0; j < 4; ++j) { v[j] = v[j] - mean; s2 += (v[j].x * v[j].x + v[j].y * v[j].y) + (v[j].z * v[j].z + v[j].w * v[j].w); }
            const float rs = 1.f / sqrtf(wave_sum(s2) * (1.f / DM) + LN_EPS);
#pragma unroll
            for (int j = 0; j < 4; ++j) { const int c = 4 * F.lane + 256 * j; const f32x4 gg = *(const f32x4*)(g + c), bv = *(const f32x4*)(bb + c); v[j] = v[j] * rs * gg + bv;
                *((f32x4*)xr + F.lane + 64 * j) = v[j];
                if (layer + 1 < DEPTH) { u32x2 w; w.x = pk2(v[j].x, v[j].y); w.y = pk2(v[j].z, v[j].w); *((u32x2*)(XB + (size_t)m * DM) + F.lane + 64 * j) = w; } }
        } }
    }
#undef LN2_LOAD
}
__device__ __forceinline__ void moe_convert(Frame& F, const Args& a, int layer) {
    LAS float* scr = (LAS float*)(F.lds + F.wave * 16384);
    constexpr int I_13 = (1024 / 64) * (1024 / 32), I_2 = (512 / 64) * (1024 / 32), PER_E = I_13 + I_2;
    for (int it = F.gw; it < NEXP * PER_E; it += F.NGW) {
        const int e = it / PER_E; int r = it - e * PER_E; const size_t le = (size_t)layer * NEXP + e;
        if (r < I_13) { const int kb = r / 32, nb = r % 32; const float* src = ((nb >> 2) & 1) ? a.moe_w3 : a.moe_w1;
            const int sc0 = ((32 * nb) >> 8) * 128 + ((32 * nb) & 127);
            transpose_item_v4(src + le * 1024 * 512 + (size_t)(kb * 64) * 512 + sc0, 512, (bf16_t*)(F.ws + WS_W13) + (size_t)e * 1024 * 1024 + (size_t)(nb * 32) * 1024 + kb * 64, 1024, scr, F.lane); }
        else { r -= I_13; const int kb = r / 32, nb = r % 32;
            transpose_item_v4(a.moe_w2 + le * 512 * 1024 + (size_t)(kb * 64) * 1024 + nb * 32, 1024, (bf16_t*)(F.ws + WS_W2) + (size_t)e * 1024 * 512 + (size_t)(nb * 32) * 512 + kb * 64, 512, scr, F.lane); }
    }
}

typedef short at_s16x4 __attribute__((ext_vector_type(4)));
typedef LAS const unsigned char* at_lds_cptr;
__device__ __forceinline__ at_s16x4 at_vtr(at_lds_cptr p) { return __builtin_bit_cast(at_s16x4, __builtin_amdgcn_ds_read_tr16_b64_v4i16((LAS at_s16x4*)p)); }
struct RowSrc { const bf16_t* p; long pitch; };
constexpr int SA_P = 0, SA_V = 4096, SA_AL = 12288, SA_RL = 12544;
template <int NC0, int NC1, int MODE>
__device__ __forceinline__ void sattn_core(const bf16x8* qf, RowSrc k0, RowSrc k1, RowSrc vs, int kb_lo, int kb_hi, int qidx0, float lse_ref, LAS unsigned char* scr, int lane, f32x16* o, float& lse_out) {
    const int r32 = lane & 31, hi = lane >> 5;
    LAS bf16_t* Pb = (LAS bf16_t*)(scr + SA_P); LAS bf16_t* Vb = (LAS bf16_t*)(scr + SA_V); LAS float* Al = (LAS float*)(scr + SA_AL);
    float m = -1.0e30f, l = 0.f;
    if (MODE != 1) { o[0] = f32x16{}; o[1] = f32x16{}; }
    bf16x8 kn[NC0 + NC1]; u32x4 vn[4];
#define SA_LOAD(kb_) do { const long key_ = (long)(kb_) * 32 + r32; \
        _Pragma("unroll") for (int c = 0; c < NC0; ++c) kn[c] = *(const bf16x8*)(k0.p + key_ * k0.pitch + 16 * c + 8 * hi); \
        _Pragma("unroll") for (int c = 0; c < NC1; ++c) kn[NC0 + c] = *(const bf16x8*)(k1.p + key_ * k1.pitch + 16 * c + 8 * hi); \
        if (MODE != 1) { _Pragma("unroll") for (int i = 0; i < 4; ++i) { const int idx = i * 64 + lane, kr = idx >> 3, pc = idx & 7; vn[i] = *(const u32x4*)(vs.p + ((long)(kb_) * 32 + kr) * vs.pitch + pc * 8); } } } while (0)
    if (kb_lo < kb_hi) SA_LOAD(kb_lo);
    const at_lds_cptr vtb = (at_lds_cptr)(scr + SA_V) + ((8 * hi + ((lane & 15) >> 2)) * 72 + 16 * ((lane >> 4) & 1) + 4 * (lane & 3)) * 2;
    for (int kb = kb_lo; kb < kb_hi; ++kb) {
        bf16x8 kc[NC0 + NC1]; u32x4 vc[4];
#pragma unroll
        for (int c = 0; c < NC0 + NC1; ++c) kc[c] = kn[c];
#pragma unroll
        for (int i = 0; i < 4; ++i) vc[i] = vn[i];
        if (kb + 1 < kb_hi) SA_LOAD(kb + 1);
        f32x16 s = {};
#pragma unroll
        for (int c = 0; c < NC0 + NC1; ++c) s = MFMA32(kc[c], qf[c], s);
        bool valid[16];
#pragma unroll
        for (int r = 0; r < 16; ++r) { if (MODE == 0) valid[r] = true; else { const int d = kb * 32 + crow(r, hi) - (qidx0 + r32); valid[r] = (d <= 64 && d >= -64); } }
        float p[16];
        if (MODE == 2) {
#pragma unroll
            for (int r = 0; r < 16; ++r) p[r] = valid[r] ? fast_exp2(s[r] - lse_ref) : 0.f;
        } else {
            float mx = -1.0e30f;
#pragma unroll
            for (int r = 0; r < 16; ++r) if (valid[r]) mx = fmaxf(mx, s[r]);
            mx = xmax32(mx);
            const float mn = fmaxf(m, mx), alpha = fast_exp2(m - mn); m = mn;
            float ps = 0.f;
#pragma unroll
            for (int r = 0; r < 16; ++r) { p[r] = valid[r] ? fast_exp2(s[r] - mn) : 0.f; ps += p[r]; }
            l = l * alpha + ps;
            if (MODE == 0) { if (hi == 0) Al[r32] = alpha; }
        }
        if (MODE != 1) {
#pragma unroll
            for (int g = 0; g < 4; ++g) { u32x2 w; w.x = pk2(p[4 * g], p[4 * g + 1]); w.y = pk2(p[4 * g + 2], p[4 * g + 3]); *(LAS u32x2*)(Pb + r32 * 40 + 8 * g + 4 * hi) = w; }
#pragma unroll
            for (int i = 0; i < 4; ++i) { const int idx = i * 64 + lane, kr = idx >> 3, pc = idx & 7; *(LAS u32x4*)(Vb + kr * 72 + pc * 8) = vc[i]; }
            LDS_WAIT();
            if (MODE == 0) {
#pragma unroll
                for (int r = 0; r < 16; ++r) { const float al = Al[crow(r, hi)]; o[0][r] *= al; o[1][r] *= al; }
            }
#pragma unroll
            for (int st = 0; st < 2; ++st) {
                const bf16x8 pf = *(const LAS bf16x8*)(Pb + r32 * 40 + 16 * st + 8 * hi);
#pragma unroll
                for (int db = 0; db < 2; ++db) {
                    const at_s16x4 lo_ = at_vtr(vtb + (16 * st * 72 + 32 * db) * 2), hi_ = at_vtr(vtb + ((16 * st + 4) * 72 + 32 * db) * 2);
                    const bf16x8 vf = {lo_[0], lo_[1], lo_[2], lo_[3], hi_[0], hi_[1], hi_[2], hi_[3]};
                    o[db] = MFMA32(pf, vf, o[db]); }
            }
            LDS_WAIT();
        }
    }
#undef SA_LOAD
    if (MODE != 2) { l = xsum32(l); lse_out = m + __log2f(l); }
    if (MODE == 0) {
        LAS float* Rl = (LAS float*)(scr + SA_RL);
        if (hi == 0) Rl[r32] = 1.0f / l;
        LDS_WAIT();
#pragma unroll
        for (int r = 0; r < 16; ++r) { const float rl = Rl[crow(r, hi)]; o[0][r] *= rl; o[1][r] *= rl; }
        LDS_WAIT();
    }
}

__device__ __forceinline__ void sattn_phase(Frame& F, const Args& a, int layer, int kind_lo) {
    const bf16_t* H = (const bf16_t*)(F.ws + WS_H); const bf16_t* QB = (const bf16_t*)(F.ws + WS_QB); const bf16_t* KVB = (const bf16_t*)(F.ws + WS_KVB);
    bf16_t* MIX = (bf16_t*)(F.ws + WS_MIX); const float* lsec = (const float*)(F.ws + WS_LSEC);
    LAS unsigned char* scr = F.lds + F.wave * 16384;
    const int lane = F.lane, r32 = lane & 31, hi = lane >> 5;
    float lam, lam_init;
    { const float* lv = a.diff_lambda + layer * 128; float d1 = 0.f, d2 = 0.f;
      for (int i = 0; i < 32; ++i) { d1 += lv[i] * lv[32 + i]; d2 += lv[64 + i] * lv[96 + i]; }
      lam_init = 0.8f - 0.6f * expf(-0.3f * (float)layer); lam = expf(d1) - expf(d2) + lam_init; }
    constexpr int NRB = NTOK / 32;
    const int items = NRB * (4 + 6 + 6);
    for (int it = kind_lo * NRB + F.gw; it < items; it += F.NGW) {
        const int kind = it / NRB, rb = it - kind * NRB; const int m0 = rb * 32; const SeqInfo si = seqinfo(m0);
#if !OPT_ATTN
        if (kind < 4) {
            const int h = kind; f32x16 o0[2], o1[2]; float dummy;
            for (int c = 0; c < 2; ++c) {
                bf16x8 qf[2];
#pragma unroll
                for (int d0 = 0; d0 < 2; ++d0) qf[d0] = *(const bf16x8*)(H + (size_t)(m0 + r32) * HP + HC_AQ + h * 64 + c * 32 + 16 * d0 + 8 * hi);
                const RowSrc ks{H + (size_t)si.base * HP + HC_AK + h * 64 + c * 32, HP}, vs{H + (size_t)si.base * HP + HC_AV + h * 64, HP};
                sattn_core<2, 0, 0>(qf, ks, ks, vs, 0, si.len / 32, 0, 0.f, scr, lane, c == 0 ? o0 : o1, dummy);
            }
            const float* sg = a.diff_subln + layer * 64; const float g0 = sg[r32], g1 = sg[32 + r32];
#pragma unroll
            for (int r = 0; r < 16; ++r) { const float x0 = o0[0][r] - lam * o1[0][r], x1 = o0[1][r] - lam * o1[1][r]; float ss = x0 * x0 + x1 * x1;
                ss += shx<1>(ss); ss += shx<2>(ss); ss += shx<4>(ss); ss += shx<8>(ss); ss += shx<16>(ss);
                const float rs = (1.0f - lam_init) / sqrtf(ss * (1.0f / 64.0f) + RMS_EPS);
                bf16_t* op = MIX + (size_t)(m0 + crow(r, hi)) * DM + MIX_A + h * 64 + r32;
                op[0] = (bf16_t)f2bf(x0 * rs * g0); op[32] = (bf16_t)f2bf(x1 * rs * g1); }
        } else if (kind < 10) {
            const int h = kind - 4; f32x16 o[2]; float dummy; bf16x8 qf[6];
#pragma unroll
            for (int d0 = 0; d0 < 6; ++d0) qf[d0] = *(const bf16x8*)(QB + (size_t)(m0 + r32) * QBP + h * 96 + 16 * d0 + 8 * hi);
            const RowSrc k0{KVB + (size_t)si.base * KVP + h * 128, KVP}, k1{H + (size_t)si.base * HP + HC_KROPE, HP}, vs{KVB + (size_t)si.base * KVP + h * 128 + 64, KVP};
            sattn_core<4, 2, 0>(qf, k0, k1, vs, 0, si.len / 32, 0, 0.f, scr, lane, o, dummy);
#pragma unroll
            for (int r = 0; r < 16; ++r) { bf16_t* op = MIX + (size_t)(m0 + crow(r, hi)) * DM + MIX_B + h * 64 + r32; op[0] = (bf16_t)f2bf(o[0][r]); op[32] = (bf16_t)f2bf(o[1][r]); }
        } else
#endif
        {
            const int gj = kind - 10, g = gj >> 1, hh = gj;
            const int dil = (g == 0) ? 1 : (g == 1 ? 4 : 16); const int L = si.len / dil, bpr = L / 32;
            const int w = (m0 - si.base) / 32, rho = w / bpr, ib = w - rho * bpr, i0 = ib * 32;
            const size_t qrow = (size_t)si.base + (size_t)(i0 + r32) * dil + rho;
            bf16x8 qf[4];
#pragma unroll
            for (int d0 = 0; d0 < 4; ++d0) qf[d0] = *(const bf16x8*)(H + qrow * HP + HC_CQ + hh * 64 + 16 * d0 + 8 * hi);
            const int j = gj & 1; const float l0 = lsec[(0 * (size_t)NTOK + qrow) * 2 + j], l1 = lsec[(1 * (size_t)NTOK + qrow) * 2 + j], l2 = lsec[(2 * (size_t)NTOK + qrow) * 2 + j];
            const float lm = fmaxf(l0, fmaxf(l1, l2)); const float lref = lm + __log2f(fast_exp2(l0 - lm) + fast_exp2(l1 - lm) + fast_exp2(l2 - lm));
            const RowSrc ks{H + ((size_t)si.base + rho) * HP + HC_CK + hh * 64, (long)HP * dil}, vs{H + ((size_t)si.base + rho) * HP + HC_CV + hh * 64, (long)HP * dil};
            int kb_lo = ib - 2, kb_hi = ib + 3; if (kb_lo < 0) kb_lo = 0; if (kb_hi > bpr) kb_hi = bpr;
            f32x16 o[2]; float dummy;
            sattn_core<4, 0, 2>(qf, ks, ks, vs, kb_lo, kb_hi, i0, lref, scr, lane, o, dummy);
#pragma unroll
            for (int r = 0; r < 16; ++r) { const size_t orow = (size_t)si.base + (size_t)(i0 + crow(r, hi)) * dil + rho; bf16_t* op = MIX + orow * DM + MIX_C + hh * 64 + r32; op[0] = (bf16_t)f2bf(o[0][r]); op[32] = (bf16_t)f2bf(o[1][r]); }
        }
    }
}
__device__ __forceinline__ void cstat_phase(Frame& F) {
    const bf16_t* H = (const bf16_t*)(F.ws + WS_H); float* lsec = (float*)(F.ws + WS_LSEC);
    LAS unsigned char* scr = F.lds + F.wave * 16384;
    const int lane = F.lane, r32 = lane & 31, hi = lane >> 5;
    constexpr int NRB = NTOK / 32;
    for (int it = F.gw; it < NRB * 6; it += F.NGW) {
        const int gj = it / NRB, rb = it - gj * NRB, g = gj >> 1, j = gj & 1; const int m0 = rb * 32; const SeqInfo si = seqinfo(m0);
        const int dil = (g == 0) ? 1 : (g == 1 ? 4 : 16); const int L = si.len / dil, bpr = L / 32;
        const int w = (m0 - si.base) / 32, rho = w / bpr, ib = w - rho * bpr, i0 = ib * 32;
        const size_t qrow = (size_t)si.base + (size_t)(i0 + r32) * dil + rho;
        bf16x8 qf[4];
#pragma unroll
        for (int d0 = 0; d0 < 4; ++d0) qf[d0] = *(const bf16x8*)(H + qrow * HP + HC_CQ + gj * 64 + 16 * d0 + 8 * hi);
        const RowSrc ks{H + ((size_t)si.base + rho) * HP + HC_CK + gj * 64, (long)HP * dil};
        int kb_lo = ib - 2, kb_hi = ib + 3; if (kb_lo < 0) kb_lo = 0; if (kb_hi > bpr) kb_hi = bpr;
        float lse; sattn_core<4, 0, 1>(qf, ks, ks, ks, kb_lo, kb_hi, i0, 0.f, scr, lane, nullptr, lse);
        if (hi == 0) lsec[((size_t)g * NTOK + qrow) * 2 + j] = lse;
    }
}


namespace at {
typedef short s16x4 __attribute__((ext_vector_type(4)));
typedef short v4i16_t __attribute__((ext_vector_type(4)));
typedef LAS const unsigned char* lds_cptr;
constexpr int LDS_K = 0, NSLOT = 4, VSLOT = 8192;
template <int NC> struct Lay { static constexpr int SLOTK = 2 * NC * 1024, V = NSLOT * SLOTK, WS = V + NSLOT * VSLOT, OST = WS + 8 * 256, STG = (NC > 2) ? 4096 : 8192, TOTAL = OST + 8 * STG; };
static_assert(Lay<2>::TOTAL <= RING_BYTES && Lay<6>::TOTAL <= RING_BYTES, "attention LDS");
constexpr float THR = 8.0f;
__device__ __forceinline__ void glds16(const void* g, unsigned lds_dst) {
    unsigned keep; asm volatile("s_mov_b32 %0, m0\n\ts_mov_b32 m0, %2\n\ts_nop 0\n\tglobal_load_lds_dwordx4 %1, off\n\ts_mov_b32 m0, %0" : "=&s"(keep) : "v"(g), "s"(lds_dst) : "memory"); }
__device__ __forceinline__ s16x4 vtr(lds_cptr p) { return __builtin_bit_cast(s16x4, __builtin_amdgcn_ds_read_tr16_b64_v4i16((LAS v4i16_t*)p)); }
__device__ __forceinline__ unsigned cvtpk(float lo, float hi) { typedef float f2 __attribute__((ext_vector_type(2))); typedef __bf16 b2 __attribute__((ext_vector_type(2))); f2 v = {lo, hi}; b2 b = __builtin_convertvector(v, b2); return __builtin_bit_cast(unsigned, b); }
#define AT_MX3(a, b, c) __builtin_fmaxf(__builtin_fmaxf((a), (b)), (c))
__device__ __forceinline__ float rowmax(const f32x16& p0, const f32x16& p1) {
    float a = AT_MX3(p0[0], p0[1], p1[0]), b = AT_MX3(p0[2], p0[3], p1[1]); a = AT_MX3(a, p1[2], p1[3]);
#pragma unroll
    for (int r = 4; r < 16; r += 4) { a = AT_MX3(a, p0[r], p0[r + 1]); b = AT_MX3(b, p0[r + 2], p0[r + 3]); a = AT_MX3(a, p1[r], p1[r + 1]); b = AT_MX3(b, p1[r + 2], p1[r + 3]); }
    float m = __builtin_fmaxf(a, b); auto rr = __builtin_amdgcn_permlane32_swap(__float_as_uint(m), __float_as_uint(m), false, false);
    return __builtin_fmaxf(__uint_as_float(rr[0]), __uint_as_float(rr[1])); }
#define AT_WAIT_BAR(N) asm volatile("s_waitcnt vmcnt(" #N ") lgkmcnt(0)\n\ts_barrier" ::: "memory")

struct Src { const bf16_t* p; long pitch; };
template <int NC, int NK0, int NK1>
__device__ __forceinline__ void stream(LAS unsigned char* lds, int tid, const bf16_t* qrow, Src k0, Src k1, Src vs, int NT, f32x16& o0, f32x16& o1, f32x4& lsum) {
    asm volatile("" : "+v"(tid));
    constexpr int SLOTK = Lay<NC>::SLOTK, LDS_V = Lay<NC>::V, LDS_WS = Lay<NC>::WS;
    const int lane = tid & 63, r32 = lane & 31, hi = lane >> 5; const int wid = __builtin_amdgcn_readfirstlane(tid >> 6);
    const unsigned lds0 = (unsigned)(uintptr_t)lds;
    LAS float* wsf = (LAS float*)(lds + LDS_WS) + wid * 64;
    constexpr int P0 = NK0 * 16;
    const bool hasA = (NK0 == 8) || (wid < 4), hasB = (NK1 > 0) && (wid < 4);
    const int pA = (NK0 == 8) ? wid : (wid & 3);
    const int rowA = (NK0 == 8) ? pA * 8 + (lane >> 3) : pA * 16 + (lane >> 2);
    const int chA = (NK0 == 8) ? ((lane & 7) ^ ((4 * pA + (lane >> 4)) & 7)) : ((lane & 3) ^ ((lane >> 4) & 3));
    const bf16_t* ksA = k0.p + (long)rowA * k0.pitch + chA * 8;
    const int rowB = (wid & 3) * 16 + (lane >> 2), chB = (lane & 3) ^ ((lane >> 4) & 3);
    const bf16_t* ksB = (NK1 > 0) ? k1.p + (long)rowB * k1.pitch + chB * 8 : k0.p;
    const bf16_t* vsp = vs.p + (long)(16 * (wid & 3) + (lane >> 2)) * vs.pitch + (wid >> 2) * 32 + (lane & 3) * 8;
    const unsigned kdA = lds0 + LDS_K + pA * 1024, kdB = lds0 + LDS_K + (NK0 + (wid & 3)) * 1024, vd = lds0 + LDS_V + wid * 1024;
    const long ktA = 64 * k0.pitch, ktB = 64 * k1.pitch, vt = 64 * vs.pitch;
    const int nd = (hasA ? 1 : 0) + (hasB ? 1 : 0) + 1;
#define AT_DMA_K(t, slot) do { if (hasA) glds16(ksA + (long)(t) * ktA, (unsigned)__builtin_amdgcn_readfirstlane(kdA + (slot) * SLOTK)); if (hasB) glds16(ksB + (long)(t) * ktB, (unsigned)__builtin_amdgcn_readfirstlane(kdB + (slot) * SLOTK)); } while (0)
#define AT_DMA_V(t, slot) glds16(vsp + (long)(t) * vt, (unsigned)__builtin_amdgcn_readfirstlane(vd + (slot) * VSLOT))
    lds_cptr kb[NC];
#pragma unroll
    for (int d0 = 0; d0 < NC; ++d0) { const int c = 2 * d0 + hi;
        if (2 * d0 < NK0) kb[d0] = (lds_cptr)lds + LDS_K + r32 * P0 + ((NK0 == 8) ? (c ^ ((r32 >> 1) & 7)) : (c ^ ((r32 >> 2) & 3))) * 16;
        else kb[d0] = (lds_cptr)lds + LDS_K + NK0 * 1024 + r32 * 64 + ((c - NK0) ^ ((r32 >> 2) & 3)) * 16; }
    const lds_cptr vp0 = (lds_cptr)lds + LDS_V + ((lane >> 4) & 1) * 32 + (lane & 3) * 8 + (4 * hi + ((lane & 15) >> 2)) * 64;
#ifdef PROBE_SEL
    { unsigned long long pc0_, pr0_; asm volatile("s_memtime %0\n\ts_memrealtime %1\n\ts_waitcnt lgkmcnt(0)" : "=s"(pc0_), "=s"(pr0_) :: "memory");
      LAS unsigned long long* ps_ = (LAS unsigned long long*)(lds + RING_BYTES + 8192 + 128) + wid * 2; ps_[0] = pc0_; ps_[1] = pr0_; }
#endif
    AT_DMA_K(0, 0); AT_DMA_V(0, 0); AT_DMA_K(1, 1); AT_DMA_K(2, 2); AT_DMA_V(1, 1);
    bf16x8 qr[NC];
#pragma unroll
    for (int d0 = 0; d0 < NC; ++d0) qr[d0] = *(const bf16x8*)(qrow + 16 * d0 + 8 * hi);
    float mhat = 0.f; f32x16 oa = {}, ob = {}, negm = {}, S0, S1; f32x4 la = {}; u32x4 pw0, pw1, pw2, pw3;
    bf16x8 ones; { const unsigned o_ = (((lane >> 4) & 1) == ((lane >> 3) & 1)) ? 0x3F803F80u : 0u; u32x4 o1_ = {o_, o_, o_, o_}; asm volatile("" : "+v"(o1_)); ones = __builtin_bit_cast(bf16x8, o1_); }
    asm volatile("" : "+v"(negm));
    AT_WAIT_BAR(0);
    __builtin_amdgcn_s_waitcnt(0);
#pragma unroll
    for (int d0 = 0; d0 < NC; ++d0) asm volatile("" : "+v"(qr[d0]));
    bf16x8 kf[2 * NC], vf[8];
#define AT_SB() __builtin_amdgcn_sched_barrier(0)
#define AT_KRD(so_, d0) do { kf[2 * (d0)] = *(const LAS bf16x8*)(kb[d0] + (so_)); kf[2 * (d0) + 1] = *(const LAS bf16x8*)(kb[d0] + (so_) + 32 * ((2 * (d0) < NK0) ? P0 : 64)); } while (0)
#define AT_KHEAD(slot) do { const int kp_ = (slot) * SLOTK; AT_KRD(kp_, 0); if (NC > 1) AT_KRD(kp_, 1); } while (0)
#define AT_VF(i) ({ const s16x4 lo_ = vtr(vp_ + (((i) >> 2) * 4096 + ((i) & 3) * 1024)), hi_ = vtr(vp_ + (((i) >> 2) * 4096 + ((i) & 3) * 1024 + 512)); (bf16x8){lo_[0], lo_[1], lo_[2], lo_[3], hi_[0], hi_[1], hi_[2], hi_[3]}; })
#define AT_VHEAD(slot) do { const lds_cptr vp_ = vp0 + (slot) * VSLOT; vf[0] = AT_VF(0); vf[4] = AT_VF(4); } while (0)
#define AT_QKM(slot) do { const int kp_ = (slot) * SLOTK; \
        _Pragma("unroll") for (int d0 = 0; d0 < NC; ++d0) { if (d0 + 2 < NC) AT_KRD(kp_, d0 + 2); \
            if (d0 == 0) { S0 = MFMA32(kf[0], qr[0], negm); S1 = MFMA32(kf[1], qr[0], negm); } else { S0 = MFMA32(kf[2 * d0], qr[d0], S0); S1 = MFMA32(kf[2 * d0 + 1], qr[d0], S1); } AT_SB(); } } while (0)
#define AT_PVM(slot) do { const lds_cptr vp_ = vp0 + (slot) * VSLOT; \
        vf[1] = AT_VF(1); vf[5] = AT_VF(5); oa = MFMA32(__builtin_bit_cast(bf16x8, pw0), vf[0], oa); ob = MFMA32(__builtin_bit_cast(bf16x8, pw0), vf[4], ob); la = MFMA16(__builtin_bit_cast(bf16x8, pw0), ones, la); AT_SB(); \
        vf[2] = AT_VF(2); vf[6] = AT_VF(6); oa = MFMA32(__builtin_bit_cast(bf16x8, pw1), vf[1], oa); ob = MFMA32(__builtin_bit_cast(bf16x8, pw1), vf[5], ob); la = MFMA16(__builtin_bit_cast(bf16x8, pw1), ones, la); AT_SB(); \
        vf[3] = AT_VF(3); vf[7] = AT_VF(7); oa = MFMA32(__builtin_bit_cast(bf16x8, pw2), vf[2], oa); ob = MFMA32(__builtin_bit_cast(bf16x8, pw2), vf[6], ob); la = MFMA16(__builtin_bit_cast(bf16x8, pw2), ones, la); AT_SB(); \
        oa = MFMA32(__builtin_bit_cast(bf16x8, pw3), vf[3], oa); ob = MFMA32(__builtin_bit_cast(bf16x8, pw3), vf[7], ob); la = MFMA16(__builtin_bit_cast(bf16x8, pw3), ones, la); AT_SB(); } while (0)
    bool resc = false; u32x4 qw0, qw1, qw2, qw3;
#define AT_PIN(x) asm volatile("" : "+v"(x))
#define AT_DECIDE(first) do { const float rm_ = rowmax(S0, S1); resc = false; \
        if ((first) || __any(rm_ > THR)) { const float dl_ = (first) ? rm_ : __builtin_fmaxf(rm_, 0.f); mhat += dl_; \
            _Pragma("unroll") for (int r = 0; r < 16; ++r) { S0[r] -= dl_; S1[r] -= dl_; negm[r] = -mhat; } asm volatile("" : "+v"(negm)); \
            if (!(first)) { const float f_ = fast_exp2(-dl_); if (hi == 0) wsf[r32] = f_; resc = true; } } } while (0)
#define AT_RESC() do { if (resc) { LDS_WAIT(); \
        _Pragma("unroll") for (int r = 0; r < 16; ++r) { const float g_ = wsf[crow(r, hi)]; oa[r] *= g_; ob[r] *= g_; } \
        _Pragma("unroll") for (int v = 0; v < 4; ++v) la[v] *= wsf[4 * (lane >> 4) + 16 * ((lane >> 3) & 1) + v]; LDS_WAIT(); } } while (0)
#define AT_EXP8(S, b, Q) do { \
        _Pragma("unroll") for (int r = 0; r < 8; ++r) S[(b) + r] = fast_exp2(S[(b) + r]); \
        Q = (u32x4){cvtpk(S[(b)], S[(b) + 1]), cvtpk(S[(b) + 2], S[(b) + 3]), cvtpk(S[(b) + 4], S[(b) + 5]), cvtpk(S[(b) + 6], S[(b) + 7])}; AT_PIN(Q); } while (0)
#define AT_EXPALL() do { AT_EXP8(S0, 0, qw0); AT_EXP8(S0, 8, qw1); AT_EXP8(S1, 0, qw2); AT_EXP8(S1, 8, qw3); pw0 = qw0; pw1 = qw1; pw2 = qw2; pw3 = qw3; } while (0)
#define AT_PV_EXP(slot, C0, C1, C2, C3, N0, N1, N2, N3) do { const lds_cptr vp_ = vp0 + (slot) * VSLOT; \
        vf[1] = AT_VF(1); vf[5] = AT_VF(5); oa = MFMA32(__builtin_bit_cast(bf16x8, C0), vf[0], oa); ob = MFMA32(__builtin_bit_cast(bf16x8, C0), vf[4], ob); la = MFMA16(__builtin_bit_cast(bf16x8, C0), ones, la); AT_EXP8(S0, 0, N0); AT_SB(); \
        vf[2] = AT_VF(2); vf[6] = AT_VF(6); oa = MFMA32(__builtin_bit_cast(bf16x8, C1), vf[1], oa); ob = MFMA32(__builtin_bit_cast(bf16x8, C1), vf[5], ob); la = MFMA16(__builtin_bit_cast(bf16x8, C1), ones, la); AT_EXP8(S0, 8, N1); AT_SB(); \
        vf[3] = AT_VF(3); vf[7] = AT_VF(7); oa = MFMA32(__builtin_bit_cast(bf16x8, C2), vf[2], oa); ob = MFMA32(__builtin_bit_cast(bf16x8, C2), vf[6], ob); la = MFMA16(__builtin_bit_cast(bf16x8, C2), ones, la); AT_EXP8(S1, 0, N2); AT_SB(); \
        oa = MFMA32(__builtin_bit_cast(bf16x8, C3), vf[3], oa); ob = MFMA32(__builtin_bit_cast(bf16x8, C3), vf[7], ob); la = MFMA16(__builtin_bit_cast(bf16x8, C3), ones, la); AT_EXP8(S1, 8, N3); AT_SB(); } while (0)
#define AT_STEP_WAIT(t) do { if ((t) + 3 < NT) { if (nd == 3) AT_WAIT_BAR(6); else if (nd == 2) AT_WAIT_BAR(4); else AT_WAIT_BAR(2); } else AT_WAIT_BAR(0); } while (0)
    AT_DMA_K(3, 3); AT_DMA_V(2, 2);
    AT_KHEAD(0); AT_SB();
    AT_QKM(0); AT_DECIDE(true); AT_EXPALL();
    AT_STEP_WAIT(0);
#define AT_STEP(t, C0, C1, C2, C3, N0, N1, N2, N3) do { const int kc_ = (t) & 3, vp1_ = ((t) - 1) & 3; \
        if ((t) + 3 < NT) AT_DMA_K((t) + 3, ((t) + 3) & 3); \
        if ((t) + 2 < NT) AT_DMA_V((t) + 2, ((t) + 2) & 3); \
        AT_KHEAD(kc_); AT_VHEAD(vp1_); AT_SB(); \
        AT_QKM(kc_); \
        AT_DECIDE(false); AT_SB(); \
        AT_PV_EXP(vp1_, C0, C1, C2, C3, N0, N1, N2, N3); \
        AT_RESC(); \
        AT_STEP_WAIT(t); } while (0)
    int t = 1;
    for (; t + 1 < NT; t += 2) { AT_STEP(t, pw0, pw1, pw2, pw3, qw0, qw1, qw2, qw3); AT_STEP(t + 1, qw0, qw1, qw2, qw3, pw0, pw1, pw2, pw3); }
    if (t < NT) { AT_STEP(t, pw0, pw1, pw2, pw3, qw0, qw1, qw2, qw3); pw0 = qw0; pw1 = qw1; pw2 = qw2; pw3 = qw3; }
#undef AT_STEP
    AT_VHEAD((NT - 1) & 3); AT_SB(); AT_PVM((NT - 1) & 3);
    o0 = oa; o1 = ob; lsum = la;
#ifdef PROBE_SEL
    { unsigned long long pc1_, pr1_; asm volatile("s_memtime %0\n\ts_memrealtime %1\n\ts_waitcnt lgkmcnt(0)" : "=s"(pc1_), "=s"(pr1_) :: "memory");
      const LAS unsigned long long* ps_ = (const LAS unsigned long long*)(lds + RING_BYTES + 8192 + 128) + wid * 2; const unsigned long long pc0_ = ps_[0], pr0_ = ps_[1];
      if (wid == 0) { LAS unsigned long long* pb_ = (LAS unsigned long long*)(lds + RING_BYTES + 8192) + (NC > 2 ? 4 : 0); pb_[0] += pc1_ - pc0_; pb_[1] += pr1_ - pr0_; pb_[2] += (unsigned long long)NT; } }
#endif
#undef AT_DMA_K
#undef AT_DMA_V
#undef AT_SB
#undef AT_KRD
#undef AT_KHEAD
#undef AT_VF
#undef AT_VHEAD
#undef AT_QKM
#undef AT_PVM
#undef AT_PIN
#undef AT_DECIDE
#undef AT_RESC
#undef AT_EXP8
#undef AT_EXPALL
#undef AT_PV_EXP
#undef AT_STEP_WAIT
}
template <int NC>
__device__ __forceinline__ void normalise(LAS unsigned char* lds, int tid, f32x16& o0, f32x16& o1, const f32x4& lsum) {
    const int lane = tid & 63, hi = lane >> 5; const int wid = __builtin_amdgcn_readfirstlane(tid >> 6);
    LAS float* wsf = (LAS float*)(lds + Lay<NC>::WS) + wid * 64;
#pragma unroll
    for (int v = 0; v < 4; ++v) wsf[32 + 4 * (lane >> 4) + 16 * ((lane >> 3) & 1) + v] = 1.0f / lsum[v];
    LDS_WAIT();
#pragma unroll
    for (int r = 0; r < 16; ++r) { const float g = wsf[32 + crow(r, hi)]; o0[r] *= g; o1[r] *= g; }
    LDS_WAIT();
}
}

struct AttnUnitId { int kind, seq, head, qb; };
__device__ __forceinline__ bool attn_unit_at(int i, int G, int bid, AttnUnitId& u) {
    const long L = (long)i * G + bid; if (L >= 2560) return false; int o = (int)L;
    int kind, longs, nh;
    if (o < 512) { kind = 0; longs = 1; nh = 4; } else if (o < 1024) { kind = 0; longs = 0; nh = 4; o -= 512; } else if (o < 1792) { kind = 1; longs = 1; nh = 6; o -= 1024; } else { kind = 1; longs = 0; nh = 6; o -= 1792; }
    const int nqb = longs ? 16 : 8;
    int pair, qb;
    if (G == 256) { const int rnd = o >> 8, b = o & 255, x = b & 7, c = b >> 3;
        const int ppr = 32 / nqb; pair = x + 8 * (rnd * ppr + c / nqb); qb = c % nqb; }
    else { pair = o / nqb; qb = o % nqb; }
    u.kind = kind; u.head = pair % nh; const int sq = pair / nh; u.seq = longs ? 16 + sq : sq; u.qb = qb; return true;
}
__device__ __forceinline__ void attn_ab_phase(Frame& F, const Args& a, int layer, int kmask = 3) {
    const bf16_t* H = (const bf16_t*)(F.ws + WS_H); const bf16_t* QB = (const bf16_t*)(F.ws + WS_QB); const bf16_t* KVB = (const bf16_t*)(F.ws + WS_KVB);
    bf16_t* MIX = (bf16_t*)(F.ws + WS_MIX);
    const int wid = F.wave;
    float lam, lam_init;
    { const float* lv = a.diff_lambda + layer * 128; float d1 = 0.f, d2 = 0.f;
      for (int i = 0; i < 32; ++i) { d1 += lv[i] * lv[32 + i]; d2 += lv[64 + i] * lv[96 + i]; }
      lam_init = 0.8f - 0.6f * expf(-0.3f * (float)layer); lam = expf(d1) - expf(d2) + lam_init;
      lam = __uint_as_float(__builtin_amdgcn_readfirstlane(__float_as_uint(lam))); lam_init = __uint_as_float(__builtin_amdgcn_readfirstlane(__float_as_uint(lam_init))); }
    AttnUnitId u;
    for (int i = 0; attn_unit_at(i, F.G, F.bid, u); ++i) {
        if (!((kmask >> u.kind) & 1)) continue;
        int tid = F.tid; asm volatile("" : "+v"(tid)); const int lane = tid & 63, r32 = lane & 31, hi = lane >> 5;
        const int len = (u.seq < 16) ? 2048 : 4096, base = (u.seq < 16) ? u.seq * 2048 : NTOK_P + (u.seq - 16) * 4096, NT = len / 64;
        const int m0 = base + u.qb * 256 + wid * 32;
        LAS bf16_t* sb = (LAS bf16_t*)(F.lds + ((u.kind == 0) ? at::Lay<2>::OST + wid * at::Lay<2>::STG : at::Lay<6>::OST + wid * at::Lay<6>::STG));
        LAS float* sf = (LAS float*)sb;
        if (u.kind == 0) {
            f32x16 q0, q1; f32x4 ls;
            { f32x16 p0, p1; const at::Src ks{H + (size_t)base * HP + HC_AK + u.head * 64, HP}, vs{H + (size_t)base * HP + HC_AV + u.head * 64, HP};
              at::stream<2, 4, 0>(F.lds, tid, H + (size_t)(m0 + r32) * HP + HC_AQ + u.head * 64, ks, ks, vs, NT, p0, p1, ls); at::normalise<2>(F.lds, tid, p0, p1, ls);
#pragma unroll
              for (int r = 0; r < 16; ++r) { const int row = crow(r, hi); sf[row * 64 + r32] = p0[r]; sf[row * 64 + 32 + r32] = p1[r]; }
              AT_WAIT_BAR(0); }
            { const at::Src ks{H + (size_t)base * HP + HC_AK + u.head * 64 + 32, HP}, vs{H + (size_t)base * HP + HC_AV + u.head * 64, HP};
              at::stream<2, 4, 0>(F.lds, tid, H + (size_t)(m0 + r32) * HP + HC_AQ + u.head * 64 + 32, ks, ks, vs, NT, q0, q1, ls); at::normalise<2>(F.lds, tid, q0, q1, ls); }
            float xa[16], xb[16];
#pragma unroll
            for (int r = 0; r < 16; ++r) { const int row = crow(r, hi); xa[r] = sf[row * 64 + r32] - lam * q0[r]; xb[r] = sf[row * 64 + 32 + r32] - lam * q1[r]; }
            LDS_WAIT();
            const float* sg = a.diff_subln + layer * 64; const float g0 = sg[r32] * (1.0f - lam_init), g1 = sg[32 + r32] * (1.0f - lam_init);
#pragma unroll
            for (int r = 0; r < 16; ++r) { const float x0 = xa[r], x1 = xb[r]; float ss = x0 * x0 + x1 * x1;
                ss += shx<1>(ss); ss += shx<2>(ss); ss += shx<4>(ss); ss += shx<8>(ss); ss += shx<16>(ss);
                const float rs = 1.0f / sqrtf(ss * (1.0f / 64.0f) + RMS_EPS); const int row = crow(r, hi);
                sb[row * 64 + r32] = (bf16_t)f2bf(x0 * rs * g0); sb[row * 64 + 32 + r32] = (bf16_t)f2bf(x1 * rs * g1); }
            LDS_WAIT();
#pragma unroll
            for (int it = 0; it < 4; ++it) { const int row = it * 8 + (lane >> 3), ch = lane & 7; *(u32x4*)(MIX + (size_t)(m0 + row) * DM + MIX_A + u.head * 64 + ch * 8) = *(const LAS u32x4*)(sb + row * 64 + ch * 8); }
        } else {
            f32x16 p0, p1; f32x4 ls;
            const at::Src k0{KVB + (size_t)base * KVP + u.head * 128, KVP}, k1{H + (size_t)base * HP + HC_KROPE, HP}, vs{KVB + (size_t)base * KVP + u.head * 128 + 64, KVP};
            at::stream<6, 8, 4>(F.lds, tid, QB + (size_t)(m0 + r32) * QBP + u.head * 96, k0, k1, vs, NT, p0, p1, ls); at::normalise<6>(F.lds, tid, p0, p1, ls);
#pragma unroll
            for (int r = 0; r < 16; ++r) { const int row = crow(r, hi); sb[row * 64 + r32] = (bf16_t)f2bf(p0[r]); sb[row * 64 + 32 + r32] = (bf16_t)f2bf(p1[r]); }
            LDS_WAIT();
#pragma unroll
            for (int it = 0; it < 4; ++it) { const int row = it * 8 + (lane >> 3), ch = lane & 7; *(u32x4*)(MIX + (size_t)(m0 + row) * DM + MIX_B + u.head * 64 + ch * 8) = *(const LAS u32x4*)(sb + row * 64 + ch * 8); }
        }
        AT_WAIT_BAR(0);
    }
}

struct ListRows { const int* list; int seg0, cnt; __device__ __forceinline__ int src(int m) const { const int r = m - seg0; return (r < cnt) ? (list[r] >> 1) : 0; } };
__device__ __forceinline__ void moe_segments(Frame& F, int layer, LAS int* seg) {
    if (F.tid < 32) seg[33 + F.tid] = (int)__hip_atomic_load(F.ctl + CW_CNT + layer * 64 + F.tid, RLX_AGENT);
    __syncthreads();
    if (F.tid == 0) { int acc = 0; for (int e = 0; e < NEXP; ++e) { seg[e] = acc; acc += (seg[33 + e] + 255) & ~255; } seg[32] = acc; }
    __syncthreads();
}
__device__ __forceinline__ int seg_find(const LAS int* seg, int row) { int e = 0;
#pragma unroll
    for (int s = 16; s > 0; s >>= 1) if (seg[e + s] <= row) e += s;
    return e; }
__device__ __forceinline__ void moe_up_simple(Frame& F, int layer) {
    LAS int* seg = (LAS int*)(F.lds + RING_BYTES); moe_segments(F, layer, seg);
    const bf16_t* XB = (const bf16_t*)(F.ws + WS_XB); const bf16_t* W13 = (const bf16_t*)(F.ws + WS_W13); const int* list = (const int*)(F.ws + WS_LIST);
    const EpiHid E{(bf16_t*)(F.ws + WS_HID)};
    const int items = (seg[32] / 32) * 16;
    for (int it = F.gw; it < items; it += F.NGW) { const int mt = it >> 4, ct = it & 15, m0 = mt * 32, e = seg_find(seg, m0), c0 = ct * 32;
        const ListRows RM{list + (size_t)e * LIST_CAP, seg[e], seg[33 + e]};
        const bf16_t* Bg = W13 + (size_t)e * 1024 * 1024 + (size_t)((c0 >> 7) * 256 + (c0 & 127)) * 1024;
        sg_tile(XB, DM, Bg, Bg + (size_t)128 * 1024, 1024, 1024, m0, c0, E, RM, F.lane); }
    __syncthreads();
}
__device__ __forceinline__ void moe_down_simple(Frame& F, int layer) {
    LAS int* seg = (LAS int*)(F.lds + RING_BYTES); moe_segments(F, layer, seg);
    const bf16_t* HID = (const bf16_t*)(F.ws + WS_HID); const bf16_t* W2 = (const bf16_t*)(F.ws + WS_W2); const int* list = (const int*)(F.ws + WS_LIST);
    const int items = (seg[32] / 32) * 16;
    for (int it = F.gw; it < items; it += F.NGW) { const int mt = it >> 4, ct = it & 15, m0 = mt * 32, e = seg_find(seg, m0), c0 = ct * 64;
        const EpiY E{(bf16_t*)(F.ws + WS_YB), (const float*)(F.ws + WS_TW), list + (size_t)e * LIST_CAP, seg[e], seg[33 + e]};
        const bf16_t* B0 = W2 + (size_t)e * 1024 * 512 + (size_t)c0 * 512;
        sg_tile(HID, DEXP, B0, B0 + (size_t)32 * 512, 512, 512, m0, c0, E, IdRows(), F.lane); }
    __syncthreads();
}


struct MoeUpSched {
    const char* XB; const char* W13; const LAS int* seg; const int* list; int nM, G, c;
    __device__ __forceinline__ bool next(int i, pg8::Unit& u) const { if (!pg8::order_next(i, G, c, nM, 4, u.pm, u.pn)) return false; u.e = __builtin_amdgcn_readfirstlane(seg_find(seg, u.pm * 256)); u.a = XB; u.b = W13 + ((size_t)u.e * 1024 + (size_t)u.pn * 256) * 2048; return true; }
    __device__ __forceinline__ unsigned arow(const pg8::Unit& u, int r) const { const int rr = u.pm * 256 + r - __builtin_amdgcn_readfirstlane(seg[u.e]); return (rr < __builtin_amdgcn_readfirstlane(seg[33 + u.e])) ? (unsigned)(list[(size_t)u.e * LIST_CAP + rr] >> 1) : 0u; }
};
struct MoeDownSched {
    const char* HID; const char* W2; const LAS int* seg; int nM, G, c;
    __device__ __forceinline__ bool next(int i, pg8::Unit& u) const { if (!pg8::order_next(i, G, c, nM, 4, u.pm, u.pn)) return false; u.e = __builtin_amdgcn_readfirstlane(seg_find(seg, u.pm * 256)); u.a = HID + (size_t)u.pm * 256 * DEXP * 2; u.b = W2 + ((size_t)u.e * 1024 + (size_t)u.pn * 256) * 1024; return true; }
    __device__ __forceinline__ unsigned arow(const pg8::Unit&, int) const { return 0u; }
};
__device__ __forceinline__ void moe_up_opt(Frame& F, int layer) {
    LAS int* seg = (LAS int*)(F.lds + RING_BYTES); moe_segments(F, layer, seg);
    const MoeUpSched S{(const char*)(F.ws + WS_XB), (const char*)(F.ws + WS_W13), seg, (const int*)(F.ws + WS_LIST), __builtin_amdgcn_readfirstlane(seg[32]) / 256, F.G, F.bid};
    const EpiHid E{(bf16_t*)(F.ws + WS_HID)};
    pg8::gemm_phase<EpiHid, MoeUpSched, true, true>(F.lds, F.tid, 1024, DM, S, E);
    __syncthreads();
}
__device__ __forceinline__ void moe_down_opt(Frame& F, int layer) {
    LAS int* seg = (LAS int*)(F.lds + RING_BYTES); moe_segments(F, layer, seg);
    const MoeDownSched S{(const char*)(F.ws + WS_HID), (const char*)(F.ws + WS_W2), seg, __builtin_amdgcn_readfirstlane(seg[32]) / 256, F.G, F.bid};
    const EpiYO E{(bf16_t*)(F.ws + WS_YB), (const float*)(F.ws + WS_TW), (const int*)(F.ws + WS_LIST), seg, (const float*)(F.ws + WS_LW)};
    pg8::gemm_phase<EpiYO, MoeDownSched, false, false>(F.lds, F.tid, DEXP, DEXP, S, E);
    __syncthreads();
}
template <class Epi>
__device__ __forceinline__ void pg_phase(Frame& F, const bf16_t* A, int lda, const bf16_t* Bt, int panel, int N, int K, const Epi& E) {
    pg8::PanelSched S; S.init(A, lda, Bt, panel, N, K);
    pg8::gemm_phase<Epi, pg8::PanelSched, false, false>(F.lds, F.tid, K, lda, S, E);
}
__device__ __forceinline__ void local_sync(Frame& F) {
    asm volatile("s_waitcnt vmcnt(0) lgkmcnt(0)" ::: "memory");
    __syncthreads();
    if (F.tid == 0) { __builtin_amdgcn_fence(__ATOMIC_ACQUIRE, "agent"); asm volatile("s_waitcnt vmcnt(0)" ::: "memory"); }
    __syncthreads();
}
template <class Epi>
__device__ __forceinline__ void og_phase(Frame& F, const bf16_t* A, int lda, const bf16_t* Bt, int M, int N, int K, const Epi& E) {
    pg8::DenseSched S; S.init(A, lda, Bt, M, N, K, F.G, F.bid);
    pg8::gemm_phase<Epi, pg8::DenseSched, false, false>(F.lds, F.tid, K, lda, S, E);
}

#ifndef PANEL_PROG
#define PANEL_PROG 1
#endif
#if PANEL_PROG
constexpr int PH_PER_LAYER = 6, N_PHASES = 2 + DEPTH * PH_PER_LAYER;
#else
constexpr int PH_PER_LAYER = 9, N_PHASES = 1 + DEPTH * PH_PER_LAYER;
#endif
__global__ void __launch_bounds__(NTHREADS, 2) fwd(Args args) {
    extern __shared__ __attribute__((aligned(16))) unsigned char lds[];
    Frame F;
    F.lds = (LAS unsigned char*)lds; F.ldsg = lds;
    F.tid = threadIdx.x; F.lane = F.tid & 63; F.wave = __builtin_amdgcn_readfirstlane(F.tid >> 6);
    F.G = gridDim.x; F.bid = blockIdx.x; F.gw = blockIdx.x * NWAVES + F.wave; F.NGW = F.G * NWAVES;
    F.ws = args.ws; F.ctl = (gu32*)(args.ws + WS_CTL);
    volatile LAS unsigned* MISC = (volatile LAS unsigned*)(F.lds + MISC_OFF);
    for (int u = F.tid; u < (LDS_BYTES - RING_BYTES) / 4; u += NTHREADS) ((LAS unsigned*)(F.lds + RING_BYTES))[u] = 0u;
    __syncthreads();
    XcdBarrier bar; bar.bar = (unsigned*)(F.ctl + CW_BAR); bar.x = 0; bar.st = nullptr;
    if (args.use_bar) bar = xcd_barrier_post((unsigned*)(F.ctl + CW_BAR), MISC + 8);
    const int lo = args.ph_lo, hi = args.ph_hi;
#ifndef PH_MASK
#define PH_MASK 0x3ff
#endif
#define IN(k) (lo <= (k) && (k) < hi && (launder(F), true))
#define SEAM(k) do { if (lo <= (k) && (k) + 1 < hi) xcd_barrier(bar); } while (0)
    if ((PH_MASK & 1) && IN(0)) { p0_prologue(F, args);
#ifdef PROBE_DUP_P0
        launder(F); p0_prologue(F, args);
#endif
    }
    SEAM(0);
#if PANEL_PROG
    for (int layer = 0; layer < DEPTH; ++layer) {
        const int pb = 1 + layer * PH_PER_LAYER;
        if (IN(pb + 0)) {
            for (int panel = F.bid; panel < NTOK / 256; panel += F.G) {
                const int r0 = panel * 256;
                if (layer > 0) { ln2_pass(F, args, layer - 1, r0 + F.wave, NWAVES, r0 + 256); local_sync(F); launder(F); }
                { bf16_t* H = (bf16_t*)(F.ws + WS_H); const EpiH E{H, (const float2*)(F.ws + WS_ROPE32), (const float2*)(F.ws + WS_ROPE64)};
                  pg_phase(F, (const bf16_t*)(F.ws + WS_XB), DM, (const bf16_t*)(F.ws + WS_WIN) + (size_t)layer * 2560 * 1024, panel, 2560, 1024, E); }
                local_sync(F); launder(F);
                rowstat_pass(F, r0 + F.wave, NWAVES, r0 + 256);
                local_sync(F); launder(F);
                { bf16_t* H = (bf16_t*)(F.ws + WS_H); const EpiUQ Eq{(bf16_t*)(F.ws + WS_QB), (const float*)(F.ws + WS_RSTD), (const float2*)(F.ws + WS_ROPE32)};
                  pg_phase(F, H + HC_CQ_LAT, HP, (const bf16_t*)(F.ws + WS_WUQ) + (size_t)layer * 768 * 256, panel, 768, 256, Eq); }
                launder(F);
                { bf16_t* H = (bf16_t*)(F.ws + WS_H); const EpiUKV Ek{(bf16_t*)(F.ws + WS_KVB), (const float*)(F.ws + WS_RSTD)};
                  pg_phase(F, H + HC_CKV, HP, (const bf16_t*)(F.ws + WS_WUKV) + (size_t)layer * 768 * 256, panel, 768, 256, Ek); }
                launder(F);
            }
        }
        SEAM(pb + 0);
        if (IN(pb + 1)) { cstat_phase(F); }
        SEAM(pb + 1);
        if (IN(pb + 2)) { attn_ab_phase(F, args, layer); launder(F); sattn_phase(F, args, layer, 10); }
        SEAM(pb + 2);
        if (IN(pb + 3)) {
            for (int panel = F.bid; panel < NTOK / 256; panel += F.G) {
                const int r0 = panel * 256;
                { const EpiRes E{args.out, layer == 0 ? args.x_prompt : nullptr, args.x_sample, args.out};
                  pg_phase(F, (const bf16_t*)(F.ws + WS_MIX), DM, (const bf16_t*)(F.ws + WS_WOUT) + (size_t)layer * 1024 * 1024, panel, 1024, 1024, E); }
                local_sync(F); launder(F);
                ln1_route_pass(F, args, layer, r0 + F.wave, NWAVES, r0 + 256);
                launder(F);
            }
            moe_convert(F, args, layer);
        }
        SEAM(pb + 3);
        if (IN(pb + 4)) { moe_up_opt(F, layer);
#ifdef PROBE_DUP_MOE
            launder(F); moe_up_opt(F, layer);
#endif
        }
        SEAM(pb + 4);
        if (IN(pb + 5)) { moe_down_opt(F, layer);
#ifdef PROBE_DUP_MOE
            launder(F); moe_down_opt(F, layer);
#endif
        }
        SEAM(pb + 5);
    }
    if (IN(1 + DEPTH * PH_PER_LAYER)) { ln2_pass(F, args, DEPTH - 1, F.gw, F.NGW, NTOK); }
#ifdef PROBE_SEL
    __syncthreads(); launder(F);
    if (F.bid == 0 && F.tid == 0) { const LAS unsigned long long* pb_ = (const LAS unsigned long long*)(F.lds + RING_BYTES + 8192);
        const unsigned long long num_ = (PROBE_SEL == 1) ? 10000ull * pb_[4] : (PROBE_SEL == 2) ? 100ull * pb_[4] : (PROBE_SEL == 3) ? 100ull * pb_[0] : 10000ull * pb_[0];
        const unsigned long long den_ = (PROBE_SEL == 1) ? pb_[5] : (PROBE_SEL == 2) ? pb_[6] : (PROBE_SEL == 3) ? pb_[2] : pb_[1];
        const unsigned long long t0_ = __builtin_amdgcn_s_memrealtime();
        while ((__builtin_amdgcn_s_memrealtime() - t0_) * den_ < num_) __builtin_amdgcn_s_sleep(8); }
#endif
#else
    for (int layer = 0; layer < DEPTH; ++layer) {
        const int pb = 1 + layer * PH_PER_LAYER;
        if ((PH_MASK & (2 << 0)) && IN(pb + 0)) {   bf16_t* H = (bf16_t*)(F.ws + WS_H);
            const EpiH E{H, (const float2*)(F.ws + WS_ROPE32), (const float2*)(F.ws + WS_ROPE64)};
#if OPT_GEMM
            og_phase(F, (const bf16_t*)(F.ws + WS_XB), DM, (const bf16_t*)(F.ws + WS_WIN) + (size_t)layer * 2560 * 1024, NTOK, 2560, 1024, E);
#ifdef PROBE_DUP_GEMM
            launder(F); og_phase(F, (const bf16_t*)(F.ws + WS_XB), DM, (const bf16_t*)(F.ws + WS_WIN) + (size_t)layer * 2560 * 1024, NTOK, 2560, 1024, E);
#endif
#else
            sg_phase(F, (const bf16_t*)(F.ws + WS_XB), DM, (const bf16_t*)(F.ws + WS_WIN) + (size_t)layer * 2560 * 1024, 1024, NTOK, 2560, 1024, E);
#endif
        }
        SEAM(pb + 0);
        if ((PH_MASK & (2 << 1)) && IN(pb + 1)) { rowstat_pass(F, F.gw, F.NGW, NTOK); cstat_phase(F);
#ifdef PROBE_DUP_CSTAT
            launder(F); rowstat_pass(F, F.gw, F.NGW, NTOK); cstat_phase(F);
#endif
        }
        SEAM(pb + 1);
        if ((PH_MASK & (2 << 2)) && IN(pb + 2)) {
            bf16_t* H = (bf16_t*)(F.ws + WS_H);
            const EpiUQ Eq{(bf16_t*)(F.ws + WS_QB), (const float*)(F.ws + WS_RSTD), (const float2*)(F.ws + WS_ROPE32)};
#if OPT_GEMM
            og_phase(F, H + HC_CQ_LAT, HP, (const bf16_t*)(F.ws + WS_WUQ) + (size_t)layer * 768 * 256, NTOK, 768, 256, Eq);
            launder(F);
#else
            sg_phase(F, H + HC_CQ_LAT, HP, (const bf16_t*)(F.ws + WS_WUQ) + (size_t)layer * 768 * 256, 256, NTOK, 768, 256, Eq);
#endif
            const EpiUKV Ek{(bf16_t*)(F.ws + WS_KVB), (const float*)(F.ws + WS_RSTD)};
#if OPT_GEMM
            og_phase(F, H + HC_CKV, HP, (const bf16_t*)(F.ws + WS_WUKV) + (size_t)layer * 768 * 256, NTOK, 768, 256, Ek);
#ifdef PROBE_DUP_UP
            launder(F); og_phase(F, H + HC_CQ_LAT, HP, (const bf16_t*)(F.ws + WS_WUQ) + (size_t)layer * 768 * 256, NTOK, 768, 256, Eq);
            launder(F); og_phase(F, H + HC_CKV, HP, (const bf16_t*)(F.ws + WS_WUKV) + (size_t)layer * 768 * 256, NTOK, 768, 256, Ek);
#endif
#else
            sg_phase(F, H + HC_CKV, HP, (const bf16_t*)(F.ws + WS_WUKV) + (size_t)layer * 768 * 256, 256, NTOK, 768, 256, Ek);
#endif
        }
        SEAM(pb + 2);
        if ((PH_MASK & (2 << 3)) && IN(pb + 3)) {
#if OPT_ATTN
            attn_ab_phase(F, args, layer); launder(F);
#ifdef PROBE_DUP_ATTN
            attn_ab_phase(F, args, layer, PROBE_DUP_ATTN); launder(F);
#endif
            sattn_phase(F, args, layer, 10);
#ifdef PROBE_DUP_CFIN
            launder(F); sattn_phase(F, args, layer, 10);
#endif
#else
            sattn_phase(F, args, layer, 0);
#endif
        }
        SEAM(pb + 3);
        if ((PH_MASK & (2 << 4)) && IN(pb + 4)) {
#ifdef PROBE_DUP_WOUT
            { const EpiRes E0{args.out, layer == 0 ? args.x_prompt : nullptr, args.x_sample, (float*)(F.ws + WS_H)};
              og_phase(F, (const bf16_t*)(F.ws + WS_MIX), DM, (const bf16_t*)(F.ws + WS_WOUT) + (size_t)layer * 1024 * 1024, NTOK, 1024, 1024, E0); launder(F); }
#endif
            const EpiRes E{args.out, layer == 0 ? args.x_prompt : nullptr, args.x_sample, args.out};
#if OPT_GEMM
            og_phase(F, (const bf16_t*)(F.ws + WS_MIX), DM, (const bf16_t*)(F.ws + WS_WOUT) + (size_t)layer * 1024 * 1024, NTOK, 1024, 1024, E);
#else
            sg_phase(F, (const bf16_t*)(F.ws + WS_MIX), DM, (const bf16_t*)(F.ws + WS_WOUT) + (size_t)layer * 1024 * 1024, 1024, NTOK, 1024, 1024, E);
#endif
        }
        SEAM(pb + 4);
        if ((PH_MASK & (2 << 5)) && IN(pb + 5)) {
#ifdef PROBE_DUP_LN1
#endif
            ln1_route_pass(F, args, layer, F.gw, F.NGW, NTOK); moe_convert(F, args, layer);
#ifdef PROBE_DUP_CONV
            launder(F); moe_convert(F, args, layer);
#endif
        }
        SEAM(pb + 5);
#if OPT_GEMM
        if ((PH_MASK & (2 << 6)) && IN(pb + 6)) { moe_up_opt(F, layer);
#ifdef PROBE_DUP_MOE
            launder(F); moe_up_opt(F, layer);
#endif
        }
#else
        if ((PH_MASK & (2 << 6)) && IN(pb + 6)) { moe_up_simple(F, layer); }
#endif
        SEAM(pb + 6);
#if OPT_GEMM
        if ((PH_MASK & (2 << 7)) && IN(pb + 7)) { moe_down_opt(F, layer);
#ifdef PROBE_DUP_MOE
            launder(F); moe_down_opt(F, layer);
#endif
        }
#else
        if ((PH_MASK & (2 << 7)) && IN(pb + 7)) { moe_down_simple(F, layer); }
#endif
        SEAM(pb + 7);
        if ((PH_MASK & (2 << 8)) && IN(pb + 8)) { ln2_pass(F, args, layer, F.gw, F.NGW, NTOK); }
        SEAM(pb + 8);
    }
#endif
#undef IN
#undef SEAM
}

extern "C" void kernel_launch(void* const* d_in, const int* in_sizes, int n_in, void* d_out, int out_size, void* d_ws, size_t ws_size, hipStream_t stream) {
    static int grid = 0;
    if (grid == 0) {
        if (n_in != 19 || out_size != NTOK * DM || ws_size < WS_END) { fprintf(stderr, "kernel_launch: unexpected shapes (n_in %d out %d ws %zu)\n", n_in, out_size, ws_size); grid = -1; return; }
        int dev = 0, cus = 0, per_cu = 0;
        if (hipGetDevice(&dev) != hipSuccess || hipDeviceGetAttribute(&cus, hipDeviceAttributeMultiprocessorCount, dev) != hipSuccess) { grid = -1; return; }
        if (hipFuncSetAttribute((const void*)fwd, hipFuncAttributeMaxDynamicSharedMemorySize, LDS_BYTES) != hipSuccess) { grid = -1; return; }
        if (hipOccupancyMaxActiveBlocksPerMultiprocessor(&per_cu, (const void*)fwd, NTHREADS, LDS_BYTES) != hipSuccess || per_cu < 1) { fprintf(stderr, "kernel_launch: occupancy query says %d\n", per_cu); }
        (void)hipGetLastError();
        grid = cus;
    }
    if (grid < 0) return;
    if (hipMemsetAsync((char*)d_ws + WS_CTL, 0, CTL_ZERO_BYTES, stream) != hipSuccess) return;
    Args a{};
    a.x_prompt = (const float*)d_in[0]; a.x_sample = (const float*)d_in[1]; a.w_in = (const float*)d_in[2]; a.diff_lambda = (const float*)d_in[3]; a.diff_subln = (const float*)d_in[4];
    a.mla_q_norm = (const float*)d_in[5]; a.mla_w_uq = (const float*)d_in[6]; a.mla_kv_norm = (const float*)d_in[7]; a.mla_w_ukv = (const float*)d_in[8]; a.w_out = (const float*)d_in[9];
    a.ln1_g = (const float*)d_in[10]; a.ln1_b = (const float*)d_in[11]; a.moe_w_coarse = (const float*)d_in[12]; a.moe_w_fine = (const float*)d_in[13];
    a.moe_w1 = (const float*)d_in[14]; a.moe_w3 = (const float*)d_in[15]; a.moe_w2 = (const float*)d_in[16]; a.ln2_g = (const float*)d_in[17]; a.ln2_b = (const float*)d_in[18];
    a.out = (float*)d_out; a.ws = (unsigned char*)d_ws; a.pad = 0;
#if MK_ONE_LAUNCH
    a.ph_lo = 0; a.ph_hi = N_PHASES; a.use_bar = 1;
    hipLaunchKernelGGL(fwd, dim3(grid), dim3(NTHREADS), LDS_BYTES, stream, a);
#else
    for (int p = 0; p < N_PHASES; ++p) { a.ph_lo = p; a.ph_hi = p + 1; a.use_bar = 0; hipLaunchKernelGGL(fwd, dim3(grid), dim3(NTHREADS), LDS_BYTES, stream, a); }
#endif
}
```

```cpp
#include <hip/hip_runtime.h>
#include <cstdio>
#include <cstdint>

#ifndef OPT_ATTN
#define OPT_ATTN 1
#endif
#ifndef OPT_GEMM
#define OPT_GEMM 1
#endif
#ifndef MK_ONE_LAUNCH
#define MK_ONE_LAUNCH 1
#endif

#define GAS __attribute__((address_space(1)))
#define LAS __attribute__((address_space(3)))
typedef unsigned short bf16_t;
typedef short bf16x8 __attribute__((ext_vector_type(8)));
typedef float f32x4 __attribute__((ext_vector_type(4)));
typedef float f32x2 __attribute__((ext_vector_type(2)));
typedef float f32x16 __attribute__((ext_vector_type(16)));
typedef unsigned u32x4 __attribute__((ext_vector_type(4)));
typedef unsigned u32x2 __attribute__((ext_vector_type(2)));
typedef GAS unsigned gu32;
#define RLX_AGENT __ATOMIC_RELAXED, __HIP_MEMORY_SCOPE_AGENT
#define LDS_WAIT() asm volatile("s_waitcnt lgkmcnt(0)" ::: "memory")
#define VM_WAIT() asm volatile("s_waitcnt vmcnt(0)" ::: "memory")
#define MFMA32(a, b, c) __builtin_amdgcn_mfma_f32_32x32x16_bf16(a, b, c, 0, 0, 0)
#define MFMA16(a, b, c) __builtin_amdgcn_mfma_f32_16x16x32_bf16(a, b, c, 0, 0, 0)

__device__ __forceinline__ unsigned f2bf(float f) { unsigned u = __builtin_bit_cast(unsigned, f); return (u + 0x7fffu + ((u >> 16) & 1u)) >> 16; }
__device__ __forceinline__ unsigned pk2(float lo, float hi) { typedef float f2_ __attribute__((ext_vector_type(2))); typedef __bf16 b2_ __attribute__((ext_vector_type(2))); f2_ v = {lo, hi}; b2_ b = __builtin_convertvector(v, b2_); return __builtin_bit_cast(unsigned, b); }
__device__ __forceinline__ float bf2f(unsigned short b) { return __builtin_bit_cast(float, (unsigned)b << 16); }
__device__ __forceinline__ int crow(int r, int hi) { return (r & 3) + 8 * (r >> 2) + 4 * hi; }
template <int K> __device__ __forceinline__ float shx(float v) { static_assert(K < 32, "xor 32: use xsum32 / xmax32 / xpair32"); return __uint_as_float((unsigned)__builtin_amdgcn_ds_swizzle((int)__float_as_uint(v), (K << 10) | 0x1f)); }
__device__ __forceinline__ float xsum32(float v) { auto rr = __builtin_amdgcn_permlane32_swap(__float_as_uint(v), __float_as_uint(v), false, false); return __uint_as_float(rr[0]) + __uint_as_float(rr[1]); }
__device__ __forceinline__ float xmax32(float v) { auto rr = __builtin_amdgcn_permlane32_swap(__float_as_uint(v), __float_as_uint(v), false, false); return fmaxf(__uint_as_float(rr[0]), __uint_as_float(rr[1])); }
__device__ __forceinline__ float xpair32(float lo, float hi) { auto rr = __builtin_amdgcn_permlane32_swap(__float_as_uint(lo), __float_as_uint(hi), false, false); return __uint_as_float(rr[0]) + __uint_as_float(rr[1]); }
__device__ __forceinline__ float wave_sum(float v) {
    v += shx<1>(v); v += shx<2>(v); v += shx<4>(v); v += shx<8>(v); v += shx<16>(v);
    return xsum32(v);
}
__device__ __forceinline__ float fast_exp2(float x) { return __builtin_amdgcn_exp2f(x); }

constexpr int NTOK = 65536, DM = 1024, DEPTH = 4;
constexpr int NTOK_P = 32768;
constexpr int HP = 2560;
constexpr int HC_AQ = 0, HC_AK = 256, HC_AV = 512, HC_CQ_LAT = 768, HC_CKV = 1024, HC_KROPE = 1152, HC_CQ = 1280, HC_CK = 1664, HC_CV = 2048;
constexpr int QBP = 768, KVP = 768;
constexpr int MIX_A = 0, MIX_B = 256, MIX_C = 640;
constexpr int NEXP = 32, DEXP = 512;
constexpr float LOG2E = 1.4426950408889634f;
constexpr float SC_A = 0.17677669529663687f * LOG2E;
constexpr float SC_B = 0.10206207261596575f * LOG2E;
constexpr float SC_C = 0.125f * LOG2E;
constexpr float DN_ALPHA = 1.681792830507429f;
constexpr float LN_EPS = 1e-5f, RMS_EPS = 1e-6f;

constexpr size_t MiB = 1u << 20;
constexpr size_t WS_CTL = 0, CTL_ZERO_BYTES = 64 * 1024;
constexpr size_t WS_ROPE32 = 4 * MiB;
constexpr size_t WS_ROPE64 = 5 * MiB;
constexpr size_t WS_WIN = 8 * MiB;
constexpr size_t WS_WOUT = 28 * MiB;
constexpr size_t WS_WUQ = 36 * MiB;
constexpr size_t WS_WUKV = 38 * MiB;
constexpr size_t WS_W13 = 40 * MiB;
constexpr size_t WS_W2 = 104 * MiB;
constexpr size_t WS_XB = 136 * MiB;
constexpr size_t WS_H = 264 * MiB;
constexpr size_t WS_QB = 584 * MiB;
constexpr size_t WS_KVB = 680 * MiB;
constexpr size_t WS_MIX = 776 * MiB;
constexpr size_t WS_RSTD = 904 * MiB;
constexpr size_t WS_LSEC = 905 * MiB;
constexpr size_t WS_TW = 907 * MiB;
constexpr size_t WS_LIST = 908 * MiB;
constexpr size_t WS_LW = 924 * MiB;
constexpr size_t WS_END = 940 * MiB;
constexpr size_t WS_HID = WS_H;
constexpr size_t WS_YB = WS_H + 136 * MiB;
static_assert(WS_YB + 256 * MiB <= WS_KVB + 96 * MiB, "YB overlay");
constexpr int LIST_CAP = 131072;
constexpr int CW_TMO = 0;
constexpr int CW_CNT = 64;
constexpr int CW_BAR = 4096;

constexpr int RING_BYTES = 131072;
constexpr int MISC_OFF = RING_BYTES + 320;
constexpr int LDS_BYTES = 147456;
constexpr int NWAVES = 8, NTHREADS = 512;

#define XB_TMO      128
#define XB_XCNT(j)  (256  + 64 * (j))
#define XB_XSUB(j)  (1280 + 64 * (j))
#define XB_XGEN(j)  (2304 + 64 * (j))
#define XB_TOP      3328
#define XB_TOPGEN   3392
#define XCD_BAR_WORDS 3456
#define XB_SPIN_CAP (1u << 22)
__device__ __forceinline__ unsigned xb_ld(unsigned* p)              { return __hip_atomic_load(p, __ATOMIC_RELAXED, __HIP_MEMORY_SCOPE_AGENT); }
__device__ __forceinline__ unsigned xb_add(unsigned* p, unsigned v) { return __hip_atomic_fetch_add(p, v, __ATOMIC_RELAXED, __HIP_MEMORY_SCOPE_AGENT); }
__device__ __forceinline__ unsigned xb_xcc_id() { return (unsigned)__builtin_amdgcn_s_getreg((3 << 11) | 20) & 0xFu; }
#define XB_SPIN(cond, bar) do { unsigned _sp = 0; while (cond) { __builtin_amdgcn_s_sleep(1); \
    if ((++_sp & 255u) == 0u) { if (xb_ld(&(bar)[XB_TMO])) break; if (_sp > XB_SPIN_CAP) { atomicAdd(&(bar)[XB_TMO], 1u); break; } } } } while (0)
struct XcdBarrier { unsigned* bar; unsigned x; volatile LAS unsigned* st; };
__device__ __forceinline__ XcdBarrier xcd_barrier_post(unsigned* bar, volatile LAS unsigned* st) {
    XcdBarrier b; b.bar = bar; b.x = xb_xcc_id(); b.st = st;
    if (threadIdx.x == 0) (void)xb_add(&bar[XB_XCNT(b.x)], 1u);
    return b;
}
__device__ __forceinline__ void xcd_barrier_complete(unsigned* bar, unsigned x, unsigned& nloc, unsigned& nx) {
    const unsigned G = gridDim.x * gridDim.y * gridDim.z;
    unsigned sum, cnt, mine, sp = 0u;
    for (;;) {
        sum = 0u; cnt = 0u; mine = 0u;
#pragma unroll
        for (unsigned j = 0; j < 16; ++j) { const unsigned c = xb_ld(&bar[XB_XCNT(j)]); sum += c; cnt += (c > 0u) ? 1u : 0u; mine = (j == x) ? c : mine; }
        if (sum == G) break;
        __builtin_amdgcn_s_sleep(1);
        if ((++sp & 255u) == 0u) { if (xb_ld(&bar[XB_TMO])) break; if (sp > XB_SPIN_CAP) { atomicAdd(&bar[XB_TMO], 1u); break; } }
    }
    nloc = mine > 0u ? mine : 1u; nx = cnt > 0u ? cnt : 1u;
}
__device__ __forceinline__ void xcd_barrier(const XcdBarrier& b) {
    asm volatile("s_waitcnt vmcnt(0)" ::: "memory");
    __syncthreads();
    if (threadIdx.x == 0) {
        unsigned* bar = b.bar;
        __builtin_amdgcn_s_waitcnt(0);
        unsigned nloc = b.st[0], nx = b.st[1];
        if (nloc == 0u) { xcd_barrier_complete(bar, b.x, nloc, nx); b.st[0] = nloc; b.st[1] = nx; }
        const unsigned old = xb_add(&bar[XB_XSUB(b.x)], 1u);
        const unsigned gen = old / nloc;
        if (old + 1u == (gen + 1u) * nloc) {
            __builtin_amdgcn_fence(__ATOMIC_RELEASE, "agent");
            asm volatile("s_waitcnt vmcnt(0)" ::: "memory");
            const unsigned og = xb_add(&bar[XB_TOP], 1u);
            const unsigned tg = og / nx;
            if (og + 1u == (tg + 1u) * nx) xb_add(&bar[XB_TOPGEN], 1u);
            else XB_SPIN(xb_ld(&bar[XB_TOPGEN]) == tg, bar);
            __builtin_amdgcn_fence(__ATOMIC_ACQUIRE, "agent");
            xb_add(&bar[XB_XGEN(b.x)], 1u);
            asm volatile("s_waitcnt vmcnt(0)" ::: "memory");
        } else {
            XB_SPIN(xb_ld(&bar[XB_XGEN(b.x)]) == gen, bar);
            __builtin_amdgcn_fence(__ATOMIC_ACQUIRE, "agent");
            asm volatile("s_waitcnt vmcnt(0)" ::: "memory");
        }
    }
    __syncthreads();
}

struct Args {
    const float* x_prompt; const float* x_sample; const float* w_in; const float* diff_lambda; const float* diff_subln; const float* mla_q_norm; const float* mla_w_uq;
    const float* mla_kv_norm; const float* mla_w_ukv; const float* w_out; const float* ln1_g; const float* ln1_b; const float* moe_w_coarse; const float* moe_w_fine;
    const float* moe_w1; const float* moe_w3; const float* moe_w2; const float* ln2_g; const float* ln2_b;
    float* out; unsigned char* ws; int ph_lo, ph_hi, use_bar, pad;
};
struct Frame {
    LAS unsigned char* lds; unsigned char* ldsg;
    int tid, lane, wave, G, gw, NGW, bid;
    gu32* ctl; unsigned char* ws;
};
__device__ __forceinline__ void launder(Frame& F) {
    int wv = F.wave; asm volatile("" : "+s"(wv)); F.wave = wv;
    int t; asm volatile("v_mbcnt_lo_u32_b32 %0, -1, 0\n\tv_mbcnt_hi_u32_b32 %0, -1, %0" : "=v"(t)); F.lane = t; F.tid = wv * 64 + t;
    int b = (int)blockIdx.x; asm volatile("" : "+s"(b)); F.bid = b; F.gw = b * NWAVES + F.wave;
    unsigned char* w = F.ws; asm volatile("" : "+s"(w)); F.ws = w; F.ctl = (gu32*)(w + WS_CTL);
}
struct SeqInfo { int base, len, pos; };
__device__ __forceinline__ SeqInfo seqinfo(int m) { SeqInfo s; if (m < NTOK_P) { s.base = m & ~2047; s.len = 2048; } else { s.base = m & ~4095; s.len = 4096; } s.pos = m - s.base; return s; }

template <class ColMap>
__device__ __forceinline__ void transpose_item(const float* W, int N, bf16_t* WT, int ldd, LAS float* scr, int k0, int n0, const ColMap& cm, const float* kscale, int lane) {
    const int sc = cm(n0 + (lane & 31));
#pragma unroll 8
    for (int i = 0; i < 32; ++i) { const int kk = 2 * i + (lane >> 5); float v = 0.f; if (sc >= 0) { v = W[(size_t)(k0 + kk) * N + sc]; if (kscale) v *= kscale[k0 + kk]; } scr[kk * 33 + (lane & 31)] = v; }
    LDS_WAIT(); asm volatile("" ::: "memory");
    const int c = lane & 7;
#pragma unroll
    for (int j = 0; j < 4; ++j) { const int n = (lane >> 3) + 8 * j; const LAS float* s = scr + (8 * c) * 33 + n;
        u32x4 o; o.x = pk2(s[0 * 33], s[1 * 33]); o.y = pk2(s[2 * 33], s[3 * 33]); o.z = pk2(s[4 * 33], s[5 * 33]); o.w = pk2(s[6 * 33], s[7 * 33]);
        *(u32x4*)(WT + (size_t)(n0 + n) * ldd + k0 + 8 * c) = o; }
    LDS_WAIT(); asm volatile("" ::: "memory");
}
__device__ __forceinline__ void transpose_item_v4(const float* Wsrc, int N, bf16_t* WTdst, int ldd, LAS float* scr, int lane) {
    const int c4 = (lane & 7) * 4, kr = lane >> 3;
    f32x4 t[8];
#pragma unroll
    for (int i = 0; i < 8; ++i) t[i] = *(const f32x4*)(Wsrc + (size_t)(i * 8 + kr) * N + c4);
#pragma unroll
    for (int i = 0; i < 8; ++i) { const int kk = i * 8 + kr; scr[(c4 + 0) * 65 + kk] = t[i].x; scr[(c4 + 1) * 65 + kk] = t[i].y; scr[(c4 + 2) * 65 + kk] = t[i].z; scr[(c4 + 3) * 65 + kk] = t[i].w; }
    LDS_WAIT(); asm volatile("" ::: "memory");
    const int c = lane & 7;
#pragma unroll
    for (int j = 0; j < 4; ++j) { const int n = (lane >> 3) + 8 * j; const LAS float* p = scr + n * 65 + 8 * c;
        u32x4 o; o.x = pk2(p[0], p[1]); o.y = pk2(p[2], p[3]); o.z = pk2(p[4], p[5]); o.w = pk2(p[6], p[7]);
        *(u32x4*)(WTdst + (size_t)n * ldd + 8 * c) = o; }
    LDS_WAIT(); asm volatile("" ::: "memory");
}
struct WinMap {
    __device__ __forceinline__ int operator()(int n) const {
        if (n < 512) { const int t = n & 31; return (n & ~31) + (t >> 1) + 16 * (t & 1); }
        if (n < 1152) return n;
        if (n < 1184) { const int t = n - 1152; return 1152 + (t >> 1) + 16 * (t & 1); }
        if (n < 1280) return -1;
        if (n < 2048) { const int u = n - 1280, t = u & 63; return 1184 + (u & ~63) + (t >> 1) + 32 * (t & 1); }
        if (n < 2432) return 1952 + (n - 2048);
        return -1;
    }
};
struct UqMap { __device__ __forceinline__ int operator()(int n) const { if (n >= 576) return -1; const int h = n / 96, t = n - 96 * h; if (t < 64) return n; const int u = t - 64; return 96 * h + 64 + (u >> 1) + 16 * (u & 1); } };
struct IdMap { __device__ __forceinline__ int operator()(int n) const { return n; } };
struct W13Map { __device__ __forceinline__ int operator()(int n) const { return (n >> 8) * 128 + (n & 127); } };

__device__ __forceinline__ void p0_prologue(Frame& F, const Args& a) {
    LAS float* scr = (LAS float*)(F.lds + F.wave * 16384);
    { float2* r32 = (float2*)(F.ws + WS_ROPE32); float2* r64 = (float2*)(F.ws + WS_ROPE64);
      for (int i = F.gw * 64 + F.lane; i < 4096 * 16; i += F.NGW * 64) { const int pos = i >> 4, j = i & 15; const float inv = 1.0f / powf(10000.0f, (float)(2 * j) / 32.0f); const float ang = (float)pos * inv; r32[i] = make_float2(cosf(ang), sinf(ang)); }
      for (int i = F.gw * 64 + F.lane; i < 4096 * 32; i += F.NGW * 64) { const int pos = i >> 5, j = i & 31; const float inv = 1.0f / powf(10000.0f, (float)(2 * j) / 64.0f); const float ang = (float)pos * inv; r64[i] = make_float2(cosf(ang), sinf(ang)); } }
    constexpr int I_WIN = (1024 / 64) * (2560 / 32), I_WOUT = (1024 / 64) * (1024 / 32), I_UQ = (256 / 64) * (768 / 32), I_UKV = (256 / 64) * (768 / 32);
    constexpr int PER_L = I_WIN + I_WOUT + I_UQ + I_UKV;
    for (int it = F.gw; it < DEPTH * PER_L; it += F.NGW) {
        const int l = it / PER_L; int r = it - l * PER_L;
        if (r < I_WIN) { const int kb = r / 80, nb = r % 80; transpose_item(a.w_in + (size_t)l * 1024 * 2336, 2336, (bf16_t*)(F.ws + WS_WIN) + (size_t)l * 2560 * 1024, 1024, scr, kb * 64, nb * 32, WinMap(), nullptr, F.lane); continue; } r -= I_WIN;
        if (r < I_WOUT) { const int kb = r / 32, nb = r % 32; transpose_item(a.w_out + (size_t)l * 1024 * 1024, 1024, (bf16_t*)(F.ws + WS_WOUT) + (size_t)l * 1024 * 1024, 1024, scr, kb * 64, nb * 32, IdMap(), nullptr, F.lane); continue; } r -= I_WOUT;
        if (r < I_UQ) { const int kb = r / 24, nb = r % 24; transpose_item(a.mla_w_uq + (size_t)l * 256 * 576, 576, (bf16_t*)(F.ws + WS_WUQ) + (size_t)l * 768 * 256, 256, scr, kb * 64, nb * 32, UqMap(), a.mla_q_norm + l * 256, F.lane); continue; } r -= I_UQ;
        { const int kb = r / 24, nb = r % 24; bf16_t* dst = (bf16_t*)(F.ws + WS_WUKV) + (size_t)l * 768 * 256;
          if (kb < 2) transpose_item(a.mla_w_ukv + (size_t)l * 128 * 768, 768, dst, 256, scr, kb * 64, nb * 32, IdMap(), a.mla_kv_norm + l * 128, F.lane);
          else { const int c = F.lane & 7;
#pragma unroll
              for (int j = 0; j < 4; ++j) { const int n = (F.lane >> 3) + 8 * j; *(u32x4*)(dst + (size_t)(nb * 32 + n) * 256 + kb * 64 + 8 * c) = (u32x4){0u, 0u, 0u, 0u}; } } }
    }
    bf16_t* XB = (bf16_t*)(F.ws + WS_XB);
    for (int m = F.gw; m < NTOK; m += F.NGW) {
        const float* src = (m < NTOK_P) ? a.x_prompt + (size_t)m * DM : a.x_sample + (size_t)(m - NTOK_P) * DM;
#pragma unroll
        for (int j = 0; j < 4; ++j) { const f32x4 v = *((const f32x4*)src + F.lane + 64 * j);
            u32x2 w; w.x = pk2(v.x, v.y); w.y = pk2(v.z, v.w); *((u32x2*)(XB + (size_t)m * DM) + F.lane + 64 * j) = w; }
    }
}

template <class Epi, class RowMap>
__device__ __forceinline__ void sg_tile(const bf16_t* A, int lda, const bf16_t* B0, const bf16_t* B1, int ldb, int K, int m0, int c0, const Epi& E, const RowMap& RM, int lane) {
    const int r32 = lane & 31, hi = lane >> 5;
    const bf16_t* ap = A + (size_t)RM.src(m0 + r32) * lda + 8 * hi;
    const bf16_t* b0p = B0 + (size_t)r32 * ldb + 8 * hi;
    const bf16_t* b1p = B1 + (size_t)r32 * ldb + 8 * hi;
    f32x16 acc0 = {}, acc1 = {};
#pragma unroll 4
    for (int k = 0; k < K; k += 16) {
        const bf16x8 af = *(const bf16x8*)(ap + k), bf0 = *(const bf16x8*)(b0p + k), bf1 = *(const bf16x8*)(b1p + k);
        acc0 = MFMA32(bf0, af, acc0); acc1 = MFMA32(bf1, af, acc1);
    }
#pragma unroll
    for (int g = 0; g < 4; ++g) { const f32x4 v0 = {acc0[4 * g], acc0[4 * g + 1], acc0[4 * g + 2], acc0[4 * g + 3]}, v1 = {acc1[4 * g], acc1[4 * g + 1], acc1[4 * g + 2], acc1[4 * g + 3]};
        E.put(m0 + r32, c0, 8 * g + 4 * hi, v0, v1); }
}
struct IdRows { __device__ __forceinline__ int src(int m) const { return m; } };

__device__ __forceinline__ void store_bf8(bf16_t* p, f32x4 a, f32x4 b) { u32x4 w; w.x = pk2(a.x, a.y); w.y = pk2(a.z, a.w); w.z = pk2(b.x, b.y); w.w = pk2(b.z, b.w); *(u32x4*)p = w; }
__device__ __forceinline__ void store_bf4(bf16_t* p, f32x4 v) { u32x2 w; w.x = pk2(v.x, v.y); w.y = pk2(v.z, v.w); *(u32x2*)p = w; }
struct EpiH {
    static constexpr bool INPLACE = false;
    static constexpr bool PERM = true;
    bf16_t* H; const float2* rope32; const float2* rope64;
    __device__ __forceinline__ f32x4 xf(int pos, int col, f32x4 v) const {
        if (col < 512 || (col >= HC_KROPE && col < HC_KROPE + 32)) {
            const int j0 = (col & 31) >> 1; const f32x4 cs = *(const f32x4*)(rope32 + pos * 16 + j0);
            f32x4 o; o.x = v.x * cs.x - v.y * cs.y; o.y = v.x * cs.y + v.y * cs.x; o.z = v.z * cs.z - v.w * cs.w; o.w = v.z * cs.w + v.w * cs.z;
            if (col < 256) o = o * SC_A; v = o;
        } else if (col >= HC_CQ && col < HC_CV) {
            const int j0 = ((col - HC_CQ) & 63) >> 1; const f32x4 cs = *(const f32x4*)(rope64 + pos * 32 + j0);
            f32x4 o; o.x = v.x * cs.x - v.y * cs.y; o.y = v.x * cs.y + v.y * cs.x; o.z = v.z * cs.z - v.w * cs.w; o.w = v.z * cs.w + v.w * cs.z;
            if (col < HC_CK) o = o * SC_C; v = o;
        }
        return v;
    }
    __device__ __forceinline__ void put4(int row, int col, f32x4 v) const { store_bf4(H + (size_t)row * HP + col, xf(seqinfo(row).pos, col, v)); }
    __device__ __forceinline__ void put(int row, int c0, int cc, f32x4 v0, f32x4 v1) const { put4(row, c0 + cc, v0); put4(row, c0 + 32 + cc, v1); }
    template <class U> __device__ __forceinline__ void put8(const U&, int row, int col, f32x4 v0, f32x4 v1) const { const int pos = seqinfo(row).pos; store_bf8(H + (size_t)row * HP + col, xf(pos, col, v0), xf(pos, col + 4, v1)); }
    struct Pre { f32x4 c0, c1; };
    __device__ __forceinline__ static f32x4 rot(f32x4 v, f32x4 cs) { f32x4 o; o.x = v.x * cs.x - v.y * cs.y; o.y = v.x * cs.y + v.y * cs.x; o.z = v.z * cs.z - v.w * cs.w; o.w = v.z * cs.w + v.w * cs.z; return o; }
    template <class U> __device__ __forceinline__ Pre pre(const U&, int row, int col) const { Pre p; p.c0 = (f32x4){0.f, 0.f, 0.f, 0.f}; p.c1 = p.c0; const int pos = seqinfo(row).pos;
        if (col < 512 || (col >= HC_KROPE && col < HC_KROPE + 32)) { const f32x4* t = (const f32x4*)(rope32 + pos * 16 + ((col & 31) >> 1)); p.c0 = t[0]; p.c1 = t[1]; }
        else if (col >= HC_CQ && col < HC_CV) { const f32x4* t = (const f32x4*)(rope64 + pos * 32 + (((col - HC_CQ) & 63) >> 1)); p.c0 = t[0]; p.c1 = t[1]; }
        return p; }
    template <class U> __device__ __forceinline__ void fin8(const U&, int row, int col, f32x4 v0, f32x4 v1, const Pre& p) const {
        if (col < 512 || (col >= HC_KROPE && col < HC_KROPE + 32)) { v0 = rot(v0, p.c0); v1 = rot(v1, p.c1); if (col < 256) { v0 = v0 * SC_A; v1 = v1 * SC_A; } }
        else if (col >= HC_CQ && col < HC_CV) { v0 = rot(v0, p.c0); v1 = rot(v1, p.c1); if (col < HC_CK) { v0 = v0 * SC_C; v1 = v1 * SC_C; } }
        store_bf8(H + (size_t)row * HP + col, v0, v1); }
};
struct EpiUQ {
    static constexpr bool INPLACE = false;
    static constexpr bool PERM = true;
    bf16_t* Q; const float* rstd; const float2* rope32;
    __device__ __forceinline__ f32x4 xf(int row, int col, f32x4 v, float rs) const {
        v = v * rs;
        const int t = col % 96;
        if (t >= 64) { const int pos = seqinfo(row).pos; const int j0 = (t - 64) >> 1; const f32x4 cs = *(const f32x4*)(rope32 + pos * 16 + j0);
            f32x4 o; o.x = v.x * cs.x - v.y * cs.y; o.y = v.x * cs.y + v.y * cs.x; o.z = v.z * cs.z - v.w * cs.w; o.w = v.z * cs.w + v.w * cs.z; v = o; }
        return v * SC_B;
    }
    __device__ __forceinline__ void put4(int row, int col, f32x4 v) const { if (col >= 576) return; store_bf4(Q + (size_t)row * QBP + col, xf(row, col, v, rstd[2 * row])); }
    template <class U> __device__ __forceinline__ void put8(const U&, int row, int col, f32x4 v0, f32x4 v1) const { if (col >= 576) return; const float rs = rstd[2 * row]; store_bf8(Q + (size_t)row * QBP + col, xf(row, col, v0, rs), xf(row, col + 4, v1, rs)); }
    __device__ __forceinline__ void put(int row, int c0, int cc, f32x4 v0, f32x4 v1) const { put4(row, c0 + cc, v0); put4(row, c0 + 32 + cc, v1); }
    struct Pre { float rs; f32x4 c0, c1; };
    template <class U> __device__ __forceinline__ Pre pre(const U&, int row, int col) const { Pre p; p.rs = rstd[2 * row]; p.c0 = (f32x4){0.f, 0.f, 0.f, 0.f}; p.c1 = p.c0;
        if (col < 576 && (col % 96) >= 64) { const f32x4* t = (const f32x4*)(rope32 + seqinfo(row).pos * 16 + (((col % 96) - 64) >> 1)); p.c0 = t[0]; p.c1 = t[1]; }
        return p; }
    template <class U> __device__ __forceinline__ void fin8(const U&, int row, int col, f32x4 v0, f32x4 v1, const Pre& p) const { if (col >= 576) return;
        v0 = v0 * p.rs; v1 = v1 * p.rs; if ((col % 96) >= 64) { v0 = EpiH::rot(v0, p.c0); v1 = EpiH::rot(v1, p.c1); }
        store_bf8(Q + (size_t)row * QBP + col, v0 * SC_B, v1 * SC_B); }
};
struct EpiUKV {
    static constexpr bool INPLACE = false;
    static constexpr bool PERM = true;
    bf16_t* KV; const float* rstd;
    template <class U> __device__ __forceinline__ void put8(const U&, int row, int col, f32x4 v0, f32x4 v1) const { const float rs = rstd[2 * row + 1]; store_bf8(KV + (size_t)row * KVP + col, v0 * rs, v1 * rs); }
    __device__ __forceinline__ void put4(int row, int col, f32x4 v) const { store_bf4(KV + (size_t)row * KVP + col, v * rstd[2 * row + 1]); }
    __device__ __forceinline__ void put(int row, int c0, int cc, f32x4 v0, f32x4 v1) const { put4(row, c0 + cc, v0); put4(row, c0 + 32 + cc, v1); }
    struct Pre { float rs; };
    template <class U> __device__ __forceinline__ Pre pre(const U&, int row, int) const { Pre p; p.rs = rstd[2 * row + 1]; return p; }
    template <class U> __device__ __forceinline__ void fin8(const U&, int row, int col, f32x4 v0, f32x4 v1, const Pre& p) const { store_bf8(KV + (size_t)row * KVP + col, v0 * p.rs, v1 * p.rs); }
};
struct EpiRes {
    static constexpr bool INPLACE = true;
    static constexpr bool PERM = false;
    float* X; const float* xp; const float* xs; float* D;
    template <class U> __device__ __forceinline__ void put4(const U&, int row, int col, f32x4 v) const { put4(row, col, v); }
    __device__ __forceinline__ void put4(int row, int col, f32x4 v) const {
        const f32x4* p = (const f32x4*)(X + (size_t)row * DM + col);
        const f32x4 r = xp ? *(const f32x4*)(((row < NTOK_P) ? xp + (size_t)row * DM : xs + (size_t)(row - NTOK_P) * DM) + col) : *p;
        *(f32x4*)(D + (size_t)row * DM + col) = r * DN_ALPHA + v; }
    __device__ __forceinline__ void put(int row, int c0, int cc, f32x4 v0, f32x4 v1) const { put4(row, c0 + cc, v0); put4(row, c0 + 32 + cc, v1); }
    struct Pre { f32x4 a, b; };
    template <class U> __device__ __forceinline__ Pre pre(const U&, int row, int col) const { Pre p;
        const float* src = xp ? ((row < NTOK_P) ? xp + (size_t)row * DM : xs + (size_t)(row - NTOK_P) * DM) : X + (size_t)row * DM;
        p.a = *(const f32x4*)(src + col); p.b = *(const f32x4*)(src + col + 16); return p; }
    template <class U> __device__ __forceinline__ void fin4x2(const U&, int row, int col, f32x4 v0, f32x4 v1, const Pre& p) const {
        *(f32x4*)(D + (size_t)row * DM + col) = p.a * DN_ALPHA + v0; *(f32x4*)(D + (size_t)row * DM + col + 16) = p.b * DN_ALPHA + v1; }
};
__device__ __forceinline__ float silu_f(float x) { return x / (1.0f + __expf(-x)); }
struct EpiHid {
    static constexpr bool INPLACE = false;
    static constexpr bool PERM = true;
    bf16_t* HID;
    __device__ __forceinline__ f32x4 act(f32x4 g, f32x4 u) const { f32x4 o; o.x = silu_f(g.x) * u.x; o.y = silu_f(g.y) * u.y; o.z = silu_f(g.z) * u.z; o.w = silu_f(g.w) * u.w; return o; }
    template <class U> __device__ __forceinline__ void putp8(const U&, int row, int col, f32x4 g0, f32x4 g1, f32x4 u0, f32x4 u1) const { store_bf8(HID + (size_t)row * DEXP + col, act(g0, u0), act(g1, u1)); }
    __device__ __forceinline__ void putp(int row, int col, f32x4 g, f32x4 u) const { f32x4 o; o.x = silu_f(g.x) * u.x; o.y = silu_f(g.y) * u.y; o.z = silu_f(g.z) * u.z; o.w = silu_f(g.w) * u.w; store_bf4(HID + (size_t)row * DEXP + col, o); }
    __device__ __forceinline__ void put(int row, int c0, int cc, f32x4 v0, f32x4 v1) const { putp(row, c0 + cc, v0, v1); }
};
struct EpiY {
    static constexpr bool INPLACE = false;
    bf16_t* YB; const float* tw; const int* list; int seg0, cnt;
    __device__ __forceinline__ void put4(int row, int col, f32x4 v) const { const int r = row - seg0; if (r >= cnt) return; const int a = list[r]; store_bf4(YB + (size_t)a * DM + col, v * tw[a]); }
    __device__ __forceinline__ void put(int row, int c0, int cc, f32x4 v0, f32x4 v1) const { put4(row, c0 + cc, v0); put4(row, c0 + 32 + cc, v1); }
};

struct EpiYO {
    static constexpr bool INPLACE = false;
    static constexpr bool PERM = true;
    bf16_t* YB; const float* tw; const int* list; const LAS int* seg; const float* lw;
    template <class U> __device__ __forceinline__ void put8(const U& u, int row, int col, f32x4 v0, f32x4 v1) const {
        const int r = row - __builtin_amdgcn_readfirstlane(seg[u.e]); if (r >= __builtin_amdgcn_readfirstlane(seg[33 + u.e])) return; const int a = list[(size_t)u.e * LIST_CAP + r]; const float w = tw[a]; store_bf8(YB + (size_t)a * DM + col, v0 * w, v1 * w); }
    struct Pre { int a; float w; };
    template <class U> __device__ __forceinline__ Pre pre(const U& u, int row, int) const { Pre p; p.a = -1; p.w = 0.f;
        const int r = row - __builtin_amdgcn_readfirstlane(seg[u.e]); if (r < __builtin_amdgcn_readfirstlane(seg[33 + u.e])) { p.a = list[(size_t)u.e * LIST_CAP + r]; p.w = lw[(size_t)u.e * LIST_CAP + r]; } return p; }
    template <class U> __device__ __forceinline__ void fin8(const U&, int, int col, f32x4 v0, f32x4 v1, const Pre& p) const { if (p.a >= 0) store_bf8(YB + (size_t)p.a * DM + col, v0 * p.w, v1 * p.w); }
};
template <class Epi>
__device__ __forceinline__ void sg_phase(Frame& F, const bf16_t* A, int lda, const bf16_t* Bt, int ldb, int M, int N, int K, const Epi& E) {
    const int nN = N / 64, items = (M / 32) * nN;
    for (int it = F.gw; it < items; it += F.NGW) { const int mt = it / nN, nt = it - mt * nN;
        sg_tile(A, lda, Bt + (size_t)(nt * 64) * ldb, Bt + (size_t)(nt * 64 + 32) * ldb, ldb, K, mt * 32, nt * 64, E, IdRows(), F.lane); }
}


namespace pg8 {
constexpr int BM = 256, BK = 64, HALF = 128, HTB = HALF * BK * 2, NXCD = 8, WGM = 8;
__host__ __device__ __forceinline__ int lds_byte(int r, int c) { const int st = (r >> 4) * 2 + (c >> 5), rr = r & 15, cc = c & 31, ob = rr * 64 + cc * 2; return st * 1024 + (ob ^ (((ob >> 9) & 1) << 5)); }
__host__ __device__ __forceinline__ void stage_rc(int b, int& R, int& C) { const int st = b / 1024, sb = b % 1024, swz = sb ^ (((sb >> 9) & 1) << 5); R = (st >> 1) * 16 + swz / 64; C = (st & 1) * 32 + (swz % 64) / 2; }
__host__ __device__ __forceinline__ int perm32(int rho) { const int n = rho >> 4, i = rho & 15; return 8 * (i >> 2) + 4 * n + (i & 3); }
struct Unit { int pm, pn, e; const char* a; const char* b; };
__device__ __forceinline__ bool order_next(int i, int G, int c, int nM, int nN, int& pm, int& pn) {
    const int nwg = nM * nN; const long L = (long)i * G + c; if (L >= nwg) return false;
    int wgid = (int)L; { const int q = nwg / NXCD, r = nwg % NXCD, xcd = wgid % NXCD, off = wgid / NXCD; wgid = (xcd < r ? xcd * (q + 1) : r * (q + 1) + (xcd - r) * q) + off; }
    const int nig = WGM * nN, gid = wgid / nig, fm = gid * WGM, gsz = (nM - fm) < WGM ? (nM - fm) : WGM;
    pm = fm + ((wgid % nig) % gsz); pn = (wgid % nig) / gsz; return true;
}
struct DenseSched {
    const char* A; const char* Bt; int nM, nN, G, c; size_t tstepA, tstepB;
    __device__ __forceinline__ void init(const bf16_t* A_, int lda, const bf16_t* Bt_, int M, int N, int K, int G_, int c_) { A = (const char*)A_; Bt = (const char*)Bt_; nM = M / BM; nN = N / BM; G = G_; c = c_; tstepA = (size_t)BM * lda * 2; tstepB = (size_t)BM * K * 2; }
    __device__ __forceinline__ bool next(int i, Unit& u) const { if (!order_next(i, G, c, nM, nN, u.pm, u.pn)) return false; u.e = 0; u.a = A + (size_t)u.pm * tstepA; u.b = Bt + (size_t)u.pn * tstepB; return true; }
    __device__ __forceinline__ unsigned arow(const Unit&, int) const { return 0u; }
};
struct PanelSched {
    const char* A; const char* Bt; int pm, nN; size_t tstepB;
    __device__ __forceinline__ void init(const bf16_t* A_, int lda, const bf16_t* Bt_, int pm_, int N, int K) { pm = pm_; nN = N / BM; A = (const char*)A_ + (size_t)pm_ * BM * lda * 2; Bt = (const char*)Bt_; tstepB = (size_t)BM * K * 2; }
    __device__ __forceinline__ bool next(int i, Unit& u) const { if (i >= nN) return false; u.pm = pm; int pn = i + (pm % nN); if (pn >= nN) pn -= nN; u.pn = pn; u.e = 0; u.a = A; u.b = Bt + (size_t)pn * tstepB; return true; }
    __device__ __forceinline__ unsigned arow(const Unit&, int) const { return 0u; }
};
template <class Epi, bool PAIR> struct EpiApply;
template <class Epi, class Sched, bool GATHER, bool PAIR>
__device__ __forceinline__ void gemm_phase(LAS unsigned char* lds, int tid, int K, int lda, const Sched& S, const Epi& E) {
    const int wid = __builtin_amdgcn_readfirstlane(tid >> 6), lane = tid & 63, wr = wid >> 2, wc = wid & 3, fr = lane & 15, fq = lane >> 4;
    const int nt = K / BK;
    unsigned voffA[2], voffB[2]; int RA[2], CA[2];
#pragma unroll
    for (int i = 0; i < 2; ++i) { int R, C; stage_rc(tid * 16 + i * 8192, R, C); const int Rb = Epi::PERM ? ((R & ~31) + perm32(R & 31)) : R; RA[i] = R; CA[i] = C;
        voffA[i] = (unsigned)(R * lda + C) * 2u; voffB[i] = (unsigned)(Rb * K + C) * 2u; }
    const size_t kstep = (size_t)(BK * 2);
    const size_t hstepA = (size_t)HALF * lda * 2, hstepB = (size_t)HALF * K * 2;
    const unsigned ldsw = (unsigned)wid * 1024u;
    const int aoff = lds_byte(wr * 64 + fr, fq * 8), boff = lds_byte(wc * 32 + fr, fq * 8);
#define PG8_SA(b, h) (((b) * 2 + (h)) * HTB)
#define PG8_SB(b, h) ((4 + (b) * 2 + (h)) * HTB)
#define PG8_STAGE(bufoff, gbase, voff) do { _Pragma("unroll") for (int _i = 0; _i < 2; ++_i) \
        __builtin_amdgcn_global_load_lds((const unsigned*)((const char*)(gbase) + (voff)[_i]), (LAS unsigned*)(lds + (bufoff) + ldsw + _i * 8192), 16, 0, 0); } while (0)
#define PG8_STAGE_A(bufoff, ab, vg, h, koff) do { if (GATHER) { PG8_STAGE(bufoff, (ab) + (koff), (vg)[h]); } else { PG8_STAGE(bufoff, (ab) + (h) * hstepA + (koff), voffA); } } while (0)
#define PG8_LDA(dst, b, h) do { _Pragma("unroll") for (int m = 0; m < 4; ++m) _Pragma("unroll") for (int k = 0; k < 2; ++k) dst[m][k] = *(const LAS bf16x8*)(lds + PG8_SA(b, h) + aoff + m * 2048 + k * 1024); } while (0)
#define PG8_LDB(dst, b, h) do { _Pragma("unroll") for (int n = 0; n < 2; ++n) _Pragma("unroll") for (int k = 0; k < 2; ++k) dst[n][k] = *(const LAS bf16x8*)(lds + PG8_SB(b, h) + boff + n * 2048 + k * 1024); } while (0)
#define PG8_MMA(ai, bj, At, Bt) do { __builtin_amdgcn_s_setprio(1); _Pragma("unroll") for (int m = 0; m < 4; ++m) _Pragma("unroll") for (int n = 0; n < 2; ++n) _Pragma("unroll") for (int k = 0; k < 2; ++k) \
        acc[ai][bj][m][n] = __builtin_amdgcn_mfma_f32_16x16x32_bf16(Bt[n][k], At[m][k], acc[ai][bj][m][n], 0, 0, 0); __builtin_amdgcn_s_setprio(0); } while (0)
#define PG8_WAIT_V(n) asm volatile("s_waitcnt vmcnt(" #n ")" ::: "memory")
#define PG8_WAIT_L(n) asm volatile("s_waitcnt lgkmcnt(" #n ")" ::: "memory")
#define PG8_BAR __builtin_amdgcn_s_barrier()
#define PG8_SCHED __builtin_amdgcn_sched_barrier(0)
    Unit cur, nxt; int ui = 0;
    if (!S.next(0, cur)) return;
    f32x4 acc[2][2][4][2];
#pragma unroll
    for (int a = 0; a < 2; ++a)
#pragma unroll
        for (int b = 0; b < 2; ++b)
#pragma unroll
            for (int m = 0; m < 4; ++m)
#pragma unroll
                for (int n = 0; n < 2; ++n) acc[a][b][m][n] = (f32x4){0.f, 0.f, 0.f, 0.f};
    bf16x8 At[4][2], B0[2][2], B1[2][2];
    unsigned vgc[2][2] = {{0u, 0u}, {0u, 0u}}, vgn[2][2] = {{0u, 0u}, {0u, 0u}};
    if (GATHER) {
#pragma unroll
        for (int h = 0; h < 2; ++h)
#pragma unroll
            for (int i = 0; i < 2; ++i) vgc[h][i] = S.arow(cur, h * HALF + RA[i]) * (unsigned)(lda * 2) + (unsigned)CA[i] * 2u;
    }
    const char* cA = cur.a; const char* cB = cur.b;
    PG8_STAGE(PG8_SB(0, 0), cB, voffB); PG8_STAGE(PG8_SB(0, 1), cB + hstepB, voffB); PG8_STAGE_A(PG8_SA(0, 0), cA, vgc, 0, 0); PG8_STAGE_A(PG8_SA(0, 1), cA, vgc, 1, 0);
    if (wr == 1) PG8_BAR;
    PG8_WAIT_V(2); PG8_BAR;
    PG8_STAGE(PG8_SB(1, 0), cB + kstep, voffB); PG8_STAGE_A(PG8_SA(1, 0), cA, vgc, 0, kstep); PG8_STAGE(PG8_SB(1, 1), cB + hstepB + kstep, voffB);
    PG8_WAIT_V(6); PG8_BAR;
    for (;;) {
        const bool has_next = S.next(ui + 1, nxt);
        const char* nA = has_next ? nxt.a : cA; const char* nB = has_next ? nxt.b : cB;
        if (GATHER) {
#pragma unroll
            for (int h = 0; h < 2; ++h)
#pragma unroll
                for (int i = 0; i < 2; ++i) vgn[h][i] = has_next ? (S.arow(nxt, h * HALF + RA[i]) * (unsigned)(lda * 2) + (unsigned)CA[i] * 2u) : vgc[h][i];
        }
#pragma clang loop unroll(disable)
        for (int t = 0; t < nt; t += 2) {
            const bool last = (t == nt - 2);
            const size_t k1 = (size_t)(t + 1) * kstep;
            const char* a2 = last ? nA : cA; const char* b2 = last ? nB : cB + (size_t)(t + 2) * kstep; const size_t ka2 = last ? 0 : (size_t)(t + 2) * kstep;
            const char* b3 = b2 + kstep; const size_t ka3 = ka2 + kstep;
            unsigned v2[2][2];
#pragma unroll
            for (int h = 0; h < 2; ++h)
#pragma unroll
                for (int i = 0; i < 2; ++i) v2[h][i] = last ? vgn[h][i] : vgc[h][i];
            PG8_LDB(B0, 0, 0); PG8_LDB(B1, 0, 1); PG8_SCHED; PG8_LDA(At, 0, 0); PG8_STAGE_A(PG8_SA(1, 1), cA, vgc, 1, k1);
            PG8_WAIT_V(8); PG8_WAIT_L(0); PG8_BAR; PG8_MMA(0, 0, At, B0); PG8_MMA(0, 1, At, B1); PG8_BAR; PG8_SCHED;
            PG8_LDA(At, 0, 1); PG8_STAGE(PG8_SB(0, 0), b2, voffB); PG8_STAGE(PG8_SB(0, 1), b2 + hstepB, voffB); PG8_STAGE_A(PG8_SA(0, 0), a2, v2, 0, ka2);
            PG8_WAIT_V(8); PG8_WAIT_L(0); PG8_BAR; PG8_MMA(1, 0, At, B0); PG8_MMA(1, 1, At, B1); PG8_BAR; PG8_SCHED;
            PG8_LDB(B0, 1, 0); PG8_LDB(B1, 1, 1); PG8_SCHED; PG8_LDA(At, 1, 0); PG8_STAGE_A(PG8_SA(0, 1), a2, v2, 1, ka2);
            PG8_WAIT_V(8); PG8_WAIT_L(0); PG8_BAR; PG8_MMA(0, 0, At, B0); PG8_MMA(0, 1, At, B1); PG8_BAR; PG8_SCHED;
            PG8_LDA(At, 1, 1); PG8_STAGE(PG8_SB(1, 0), b3, voffB); PG8_STAGE(PG8_SB(1, 1), b3 + hstepB, voffB); PG8_STAGE_A(PG8_SA(1, 0), a2, v2, 0, ka3);
            PG8_WAIT_V(8); PG8_WAIT_L(0); PG8_BAR; PG8_MMA(1, 0, At, B0); PG8_MMA(1, 1, At, B1); PG8_BAR; PG8_SCHED;
        }
        if (wr == 0) PG8_BAR;
        { int fr_ = fr, fq_ = fq; asm volatile("" : "+v"(fr_), "+v"(fq_));
          EpiApply<Epi, PAIR>::run(E, acc, cur, wr, wc, fr_, fq_);
#ifdef PROBE_DUP_EPI
          if (!Epi::INPLACE) { asm volatile("" : "+v"(fr_), "+v"(fq_)); EpiApply<Epi, PAIR>::run(E, acc, cur, wr, wc, fr_, fq_); }
#endif
          }
        if (!has_next) break;
#pragma unroll
        for (int a = 0; a < 2; ++a)
#pragma unroll
            for (int b = 0; b < 2; ++b)
#pragma unroll
                for (int m = 0; m < 4; ++m)
#pragma unroll
                    for (int n = 0; n < 2; ++n) acc[a][b][m][n] = (f32x4){0.f, 0.f, 0.f, 0.f};
        cur = nxt; cA = nA; cB = nB; ++ui;
        if (GATHER) {
#pragma unroll
            for (int h = 0; h < 2; ++h)
#pragma unroll
                for (int i = 0; i < 2; ++i) vgc[h][i] = vgn[h][i];
        }
        if (wr == 1) PG8_BAR;
    }
    PG8_WAIT_V(0);
    PG8_BAR;
#undef PG8_SA
#undef PG8_SB
#undef PG8_STAGE
#undef PG8_STAGE_A
#undef PG8_LDA
#undef PG8_LDB
#undef PG8_MMA
#undef PG8_WAIT_V
#undef PG8_WAIT_L
#undef PG8_BAR
#undef PG8_SCHED
}
template <class Epi> struct EpiApply<Epi, false> {
    static __device__ __forceinline__ void run(const Epi& E, const f32x4 (&acc)[2][2][4][2], const Unit& u, int wr, int wc, int fr, int fq) {
#pragma unroll
        for (int ai = 0; ai < 2; ++ai) {
            typename Epi::Pre pre[4][2];
#pragma unroll
            for (int m = 0; m < 4; ++m) { const int row = u.pm * BM + ai * HALF + wr * 64 + m * 16 + fr;
#pragma unroll
                for (int bj = 0; bj < 2; ++bj) pre[m][bj] = E.pre(u, row, u.pn * BM + bj * HALF + wc * 32 + (Epi::PERM ? 8 : 4) * fq); }
#pragma unroll
            for (int m = 0; m < 4; ++m) { const int row = u.pm * BM + ai * HALF + wr * 64 + m * 16 + fr;
#pragma unroll
                for (int bj = 0; bj < 2; ++bj) {
                    if constexpr (Epi::PERM) E.fin8(u, row, u.pn * BM + bj * HALF + wc * 32 + 8 * fq, acc[ai][bj][m][0], acc[ai][bj][m][1], pre[m][bj]);
                    else E.fin4x2(u, row, u.pn * BM + bj * HALF + wc * 32 + 4 * fq, acc[ai][bj][m][0], acc[ai][bj][m][1], pre[m][bj]); } }
        }
    }
};
template <class Epi> struct EpiApply<Epi, true> {
    static __device__ __forceinline__ void run(const Epi& E, const f32x4 (&acc)[2][2][4][2], const Unit& u, int wr, int wc, int fr, int fq) {
#pragma unroll
        for (int ai = 0; ai < 2; ++ai)
#pragma unroll
            for (int m = 0; m < 4; ++m) { const int row = u.pm * BM + ai * HALF + wr * 64 + m * 16 + fr;
                E.putp8(u, row, u.pn * HALF + wc * 32 + 8 * fq, acc[ai][0][m][0], acc[ai][0][m][1], acc[ai][1][m][0], acc[ai][1][m][1]); }
    }
};
}

__device__ __forceinline__ void rowstat_pass(Frame& F, int r_first, int r_stride, int r_end) {
    const bf16_t* H = (const bf16_t*)(F.ws + WS_H); float* rstd = (float*)(F.ws + WS_RSTD);
    for (int m = r_first; m < r_end; m += r_stride) {
        const bf16_t* hr = H + (size_t)m * HP;
        const u32x2 q = *((const u32x2*)(hr + HC_CQ_LAT) + F.lane);
        const unsigned kv = *((const unsigned*)(hr + HC_CKV) + F.lane);
        float a0 = bf2f(q.x & 0xffff), a1 = bf2f(q.x >> 16), a2 = bf2f(q.y & 0xffff), a3 = bf2f(q.y >> 16), b0 = bf2f(kv & 0xffff), b1 = bf2f(kv >> 16);
        const float sq = wave_sum(a0 * a0 + a1 * a1 + a2 * a2 + a3 * a3), sk = wave_sum(b0 * b0 + b1 * b1);
        if (F.lane == 0) { rstd[2 * m] = 1.0f / sqrtf(sq * (1.0f / 256.0f) + RMS_EPS); rstd[2 * m + 1] = 1.0f / sqrtf(sk * (1.0f / 128.0f) + RMS_EPS); }
    }
}
__device__ __forceinline__ void red8(float (&v)[8], int lane) {
    float a[4], b[2], c;
#pragma unroll
    for (int i = 0; i < 4; ++i) a[i] = xpair32(v[i], v[i + 4]);
    { const bool up = (lane & 16) != 0;
#pragma unroll
      for (int i = 0; i < 2; ++i) { const float send = up ? a[i] : a[i + 2], keep = up ? a[i + 2] : a[i]; b[i] = keep + shx<16>(send); } }
    { const bool up = (lane & 8) != 0; const float send = up ? b[0] : b[1], keep = up ? b[1] : b[0]; c = keep + shx<8>(send); }
    c += shx<4>(c); c += shx<2>(c); c += shx<1>(c);
#pragma unroll
    for (int i = 0; i < 8; ++i) v[i] = __uint_as_float(__builtin_amdgcn_readlane(__float_as_uint(c), ((i >> 2) & 1) * 32 + ((i >> 1) & 1) * 16 + (i & 1) * 8));
}
__device__ __forceinline__ void red4(float (&v)[4], int lane) {
    float a[2], c;
#pragma unroll
    for (int i = 0; i < 2; ++i) a[i] = xpair32(v[i], v[i + 2]);
    { const bool up = (lane & 16) != 0; const float send = up ? a[0] : a[1], keep = up ? a[1] : a[0]; c = keep + shx<16>(send); }
    c += shx<8>(c); c += shx<4>(c); c += shx<2>(c); c += shx<1>(c);
#pragma unroll
    for (int i = 0; i < 4; ++i) v[i] = __uint_as_float(__builtin_amdgcn_readlane(__float_as_uint(c), ((i >> 1) & 1) * 32 + (i & 1) * 16));
}
__device__ __forceinline__ void ln1_route_pass(Frame& F, const Args& a, int layer, int r_first, int r_stride, int r_end) {
    bf16_t* XB = (bf16_t*)(F.ws + WS_XB); float* tw = (float*)(F.ws + WS_TW); int* list = (int*)(F.ws + WS_LIST);
    const float* g = a.ln1_g + layer * DM; const float* bb = a.ln1_b + layer * DM;
    const float* wc = a.moe_w_coarse + (size_t)layer * DM * 4; const float* wf = a.moe_w_fine + (size_t)layer * 4 * DM * 8;
    for (int q = F.tid; q < 4 * 1024 * 2; q += NTHREADS) { const int hf = q & 1, k = (q >> 1) & 1023, gg = q >> 11; const int l = (k & 255) >> 2, e = k & 3, j = k >> 8;
        *(LAS f32x4*)(F.lds + (size_t)(gg * 2048 + ((j * 4 + e) * 2 + hf) * 64 + l) * 16) = *((const f32x4*)wf + q); }
    f32x4 wcr[4][4];
#pragma unroll
    for (int j = 0; j < 4; ++j)
#pragma unroll
        for (int e = 0; e < 4; ++e) wcr[j][e] = *(const f32x4*)(wc + (size_t)(4 * F.lane + 256 * j + e) * 4);
    __syncthreads();
    LAS int* lcnt = (LAS int*)(F.lds + RING_BYTES + 1024); LAS int* lbase = lcnt + 32; LAS int* rec_er = lcnt + 64; LAS int* rec_a = rec_er + 512; LAS float* rec_w = (LAS float*)(rec_a + 512); float* lw = (float*)(F.ws + WS_LW);
  for (int c_first = r_first; c_first < r_end; c_first += 32 * r_stride) {
    const int c_end = (c_first + 32 * r_stride < r_end) ? c_first + 32 * r_stride : r_end;
    if (F.tid < 32) lcnt[F.tid] = 0;
    for (int q = F.tid; q < 512; q += NTHREADS) rec_a[q] = -1;
    __syncthreads();
    f32x4 vn[2][4];
#pragma unroll
    for (int rr = 0; rr < 2; ++rr) { const int mm = c_first + rr * r_stride; if (mm < c_end) {
#pragma unroll
        for (int j = 0; j < 4; ++j) vn[rr][j] = *((const f32x4*)(a.out + (size_t)mm * DM) + F.lane + 64 * j); } }
    for (int m0 = c_first; m0 < c_end; m0 += 2 * r_stride) {
        f32x4 vc[2][4];
#pragma unroll
        for (int rr = 0; rr < 2; ++rr)
#pragma unroll
            for (int j = 0; j < 4; ++j) vc[rr][j] = vn[rr][j];
#pragma unroll
        for (int rr = 0; rr < 2; ++rr) { const int mm = m0 + (2 + rr) * r_stride; if (mm < c_end) {
#pragma unroll
            for (int j = 0; j < 4; ++j) vn[rr][j] = *((const f32x4*)(a.out + (size_t)mm * DM) + F.lane + 64 * j); } }
#pragma unroll
      for (int rr = 0; rr < 2; ++rr) { const int m = m0 + rr * r_stride; if (m < c_end) {
        f32x4 v[4]; float s = 0.f;
#pragma unroll
        for (int j = 0; j < 4; ++j) { v[j] = vc[rr][j]; s += (v[j].x + v[j].y) + (v[j].z + v[j].w); }
        const float mean = wave_sum(s) * (1.f / DM); float s2 = 0.f;
#pragma unroll
        for (int j = 0; j < 4; ++j) { v[j] = v[j] - mean; s2 += (v[j].x * v[j].x + v[j].y * v[j].y) + (v[j].z * v[j].z + v[j].w * v[j].w); }
        const float rs = 1.f / sqrtf(wave_sum(s2) * (1.f / DM) + LN_EPS);
        float cl[4] = {0.f, 0.f, 0.f, 0.f};
#pragma unroll
        for (int j = 0; j < 4; ++j) { const int c = 4 * F.lane + 256 * j; const f32x4 gg = *(const f32x4*)(g + c), bv = *(const f32x4*)(bb + c); v[j] = v[j] * rs * gg + bv;
            u32x2 w; w.x = pk2(v[j].x, v[j].y); w.y = pk2(v[j].z, v[j].w); *((u32x2*)(XB + (size_t)m * DM) + F.lane + 64 * j) = w;
#pragma unroll
            for (int e = 0; e < 4; ++e) { const f32x4 w4 = wcr[j][e]; const float xe = v[j][e]; cl[0] += xe * w4.x; cl[1] += xe * w4.y; cl[2] += xe * w4.z; cl[3] += xe * w4.w; } }
        red4(cl, F.lane);
        int grp = 0; float cm = cl[0];
#pragma unroll
        for (int e = 1; e < 4; ++e) if (cl[e] > cm) { cm = cl[e]; grp = e; }
        float den = 0.f;
#pragma unroll
        for (int e = 0; e < 4; ++e) den += __expf(cl[e] - cm);
        const float pg = 1.0f / den;
        grp = __builtin_amdgcn_readfirstlane(grp);
        const LAS f32x4* wl = (const LAS f32x4*)(F.lds) + grp * 2048 + F.lane;
        float fl[8] = {0.f, 0.f, 0.f, 0.f, 0.f, 0.f, 0.f, 0.f};
#pragma unroll
        for (int j = 0; j < 4; ++j)
#pragma unroll
            for (int e = 0; e < 4; ++e) { const f32x4 wa = wl[((j * 4 + e) * 2) * 64], wb = wl[((j * 4 + e) * 2 + 1) * 64]; const float xe = v[j][e];
                fl[0] += xe * wa.x; fl[1] += xe * wa.y; fl[2] += xe * wa.z; fl[3] += xe * wa.w; fl[4] += xe * wb.x; fl[5] += xe * wb.y; fl[6] += xe * wb.z; fl[7] += xe * wb.w; }
        red8(fl, F.lane);
        int i0 = 0; float v0 = fl[0];
#pragma unroll
        for (int e = 1; e < 8; ++e) if (fl[e] > v0) { v0 = fl[e]; i0 = e; }
        int i1 = -1; float v1 = -3.0e38f;
#pragma unroll
        for (int e = 0; e < 8; ++e) if (e != i0 && fl[e] > v1) { v1 = fl[e]; i1 = e; }
        const float e1 = __expf(v1 - v0), w0 = pg / (1.0f + e1), w1 = pg * e1 / (1.0f + e1);
        if (F.lane < 2) { const int e = grp * 8 + (F.lane == 0 ? i0 : i1); const int a_id = 2 * m + F.lane;
            const int lr = __hip_atomic_fetch_add(lcnt + e, 1, __ATOMIC_RELAXED, __HIP_MEMORY_SCOPE_WORKGROUP);
            const int ri = (((m - c_first) / r_stride) * NWAVES + F.wave) * 2 + F.lane;
            rec_er[ri] = (e << 16) | lr; rec_a[ri] = a_id; rec_w[ri] = (F.lane == 0) ? w0 : w1; tw[a_id] = (F.lane == 0) ? w0 : w1; }
          } }
    }
    __syncthreads();
    if (F.tid < 32) { const int n = lcnt[F.tid]; lbase[F.tid] = n ? (int)__hip_atomic_fetch_add(F.ctl + CW_CNT + layer * 64 + F.tid, (unsigned)n, RLX_AGENT) : 0; }
    __syncthreads();
    for (int q = F.tid; q < 512; q += NTHREADS) { const int aid = rec_a[q]; if (aid >= 0) { const int er = rec_er[q], e = er >> 16; const size_t li = (size_t)e * LIST_CAP + lbase[e] + (er & 0xffff); list[li] = aid; lw[li] = rec_w[q]; } }
    __syncthreads();
  }
    __syncthreads();
}
__device__ __forceinline__ void ln2_pass(Frame& F, const Args& a, int layer, int r_first, int r_stride, int r_end) {
    bf16_t* XB = (bf16_t*)(F.ws + WS_XB); const bf16_t* YB = (const bf16_t*)(F.ws + WS_YB);
    const float* g = a.ln2_g + layer * DM; const float* bb = a.ln2_b + layer * DM; const float* g1 = a.ln1_g + layer * DM; const float* b1 = a.ln1_b + layer * DM;
    f32x4 xn[2][4]; u32x2 pn[2][4], qn[2][4];
#define LN2_LOAD(rr, mm) do { const bf16_t* y0_ = YB + (size_t)(2 * (mm)) * DM; _Pragma("unroll") for (int j = 0; j < 4; ++j) { xn[rr][j] = *((const f32x4*)(a.out + (size_t)(mm) * DM) + F.lane + 64 * j); \
        pn[rr][j] = *((const u32x2*)y0_ + F.lane + 64 * j); qn[rr][j] = *((const u32x2*)(y0_ + DM) + F.lane + 64 * j); } } while (0)
#pragma unroll
    for (int rr = 0; rr < 2; ++rr) { const int mm = r_first + rr * r_stride; if (mm < r_end) LN2_LOAD(rr, mm); }
    for (int m0 = r_first; m0 < r_end; m0 += 2 * r_stride) {
        f32x4 xc[2][4]; u32x2 pc[2][4], qc[2][4];
#pragma unroll
        for (int rr = 0; rr < 2; ++rr)
#pragma unroll
            for (int j = 0; j < 4; ++j) { xc[rr][j] = xn[rr][j]; pc[rr][j] = pn[rr][j]; qc[rr][j] = qn[rr][j]; }
#pragma unroll
        for (int rr = 0; rr < 2; ++rr) { const int mm = m0 + (2 + rr) * r_stride; if (mm < r_end) LN2_LOAD(rr, mm); }
#pragma unroll
        for (int rr = 0; rr < 2; ++rr) { const int m = m0 + rr * r_stride; if (m < r_end) {
            float* xr = a.out + (size_t)m * DM;
            f32x4 v[4]; float s = 0.f;
            { float s1 = 0.f;
#pragma unroll
              for (int j = 0; j < 4; ++j) { v[j] = xc[rr][j]; s1 += (v[j].x + v[j].y) + (v[j].z + v[j].w); }
              const float mean1 = wave_sum(s1) * (1.f / DM); float q1 = 0.f;
#pragma unroll
              for (int j = 0; j < 4; ++j) { v[j] = v[j] - mean1; q1 += (v[j].x * v[j].x + v[j].y * v[j].y) + (v[j].z * v[j].z + v[j].w * v[j].w); }
              const float rs1 = 1.f / sqrtf(wave_sum(q1) * (1.f / DM) + LN_EPS);
#pragma unroll
              for (int j = 0; j < 4; ++j) { const int c = 4 * F.lane + 256 * j; xc[rr][j] = v[j] * rs1 * *(const f32x4*)(g1 + c) + *(const f32x4*)(b1 + c); } }
#pragma unroll
            for (int j = 0; j < 4; ++j) { v[j] = xc[rr][j] * DN_ALPHA; const u32x2 p = pc[rr][j], q = qc[rr][j];
                v[j].x += bf2f(p.x & 0xffff) + bf2f(q.x & 0xffff); v[j].y += bf2f(p.x >> 16) + bf2f(q.x >> 16); v[j].z += bf2f(p.y & 0xffff) + bf2f(q.y & 0xffff); v[j].w += bf2f(p.y >> 16) + bf2f(q.y >> 16);
                s += (v[j].x + v[j].y) + (v[j].z + v[j].w); }
            const float mean = wave_sum(s) * (1.f / DM); float s2 = 0.f;
#pragma unroll
            for (int j = 0; j < 4; ++j) { v[j] = v[j] - mean; s2 += (v[j].x * v[j].x + v[j].y * v[j].y) + (v[j].z * v[j].z + v[j].w * v[j].w); }
            const float rs = 1.f / sqrtf(wave_sum(s2) * (1.f / DM) + LN_EPS);
#pragma unroll
            for (int j = 0; j < 4; ++j) { const int c = 4 * F.lane + 256 * j; const f32x4 gg = *(const f32x4*)(g + c), bv = *(const f32x4*)(bb + c); v[j] = v[j] * rs * gg + bv;
                *((f32x4*)xr + F.lane + 64 * j) = v[j];
                if (layer + 1 < DEPTH) { u32x2 w; w.x = pk2(v[j].x, v[j].y); w.y = pk2(v[j].z, v[j].w); *((u32x2*)(XB + (size_t)m * DM) + F.lane + 64 * j) = w; } }
        } }
    }
#undef LN2_LOAD
}
__device__ __forceinline__ void moe_convert(Frame& F, const Args& a, int layer) {
    LAS float* scr = (LAS float*)(F.lds + F.wave * 16384);
    constexpr int I_13 = (1024 / 64) * (1024 / 32), I_2 = (512 / 64) * (1024 / 32), PER_E = I_13 + I_2;
    for (int it = F.gw; it < NEXP * PER_E; it += F.NGW) {
        const int e = it / PER_E; int r = it - e * PER_E; const size_t le = (size_t)layer * NEXP + e;
        if (r < I_13) { const int kb = r / 32, nb = r % 32; const float* src = ((nb >> 2) & 1) ? a.moe_w3 : a.moe_w1;
            const int sc0 = ((32 * nb) >> 8) * 128 + ((32 * nb) & 127);
            transpose_item_v4(src + le * 1024 * 512 + (size_t)(kb * 64) * 512 + sc0, 512, (bf16_t*)(F.ws + WS_W13) + (size_t)e * 1024 * 1024 + (size_t)(nb * 32) * 1024 + kb * 64, 1024, scr, F.lane); }
        else { r -= I_13; const int kb = r / 32, nb = r % 32;
            transpose_item_v4(a.moe_w2 + le * 512 * 1024 + (size_t)(kb * 64) * 1024 + nb * 32, 1024, (bf16_t*)(F.ws + WS_W2) + (size_t)e * 1024 * 512 + (size_t)(nb * 32) * 512 + kb * 64, 512, scr, F.lane); }
    }
}

typedef short at_s16x4 __attribute__((ext_vector_type(4)));
typedef LAS const unsigned char* at_lds_cptr;
__device__ __forceinline__ at_s16x4 at_vtr(at_lds_cptr p) { return __builtin_bit_cast(at_s16x4, __builtin_amdgcn_ds_read_tr16_b64_v4i16((LAS at_s16x4*)p)); }
struct RowSrc { const bf16_t* p; long pitch; };
constexpr int SA_P = 0, SA_V = 4096, SA_AL = 12288, SA_RL = 12544;
template <int NC0, int NC1, int MODE>
__device__ __forceinline__ void sattn_core(const bf16x8* qf, RowSrc k0, RowSrc k1, RowSrc vs, int kb_lo, int kb_hi, int qidx0, float lse_ref, LAS unsigned char* scr, int lane, f32x16* o, float& lse_out) {
    const int r32 = lane & 31, hi = lane >> 5;
    LAS bf16_t* Pb = (LAS bf16_t*)(scr + SA_P); LAS bf16_t* Vb = (LAS bf16_t*)(scr + SA_V); LAS float* Al = (LAS float*)(scr + SA_AL);
    float m = -1.0e30f, l = 0.f;
    if (MODE != 1) { o[0] = f32x16{}; o[1] = f32x16{}; }
    bf16x8 kn[NC0 + NC1]; u32x4 vn[4];
#define SA_LOAD(kb_) do { const long key_ = (long)(kb_) * 32 + r32; \
        _Pragma("unroll") for (int c = 0; c < NC0; ++c) kn[c] = *(const bf16x8*)(k0.p + key_ * k0.pitch + 16 * c + 8 * hi); \
        _Pragma("unroll") for (int c = 0; c < NC1; ++c) kn[NC0 + c] = *(const bf16x8*)(k1.p + key_ * k1.pitch + 16 * c + 8 * hi); \
        if (MODE != 1) { _Pragma("unroll") for (int i = 0; i < 4; ++i) { const int idx = i * 64 + lane, kr = idx >> 3, pc = idx & 7; vn[i] = *(const u32x4*)(vs.p + ((long)(kb_) * 32 + kr) * vs.pitch + pc * 8); } } } while (0)
    if (kb_lo < kb_hi) SA_LOAD(kb_lo);
    const at_lds_cptr vtb = (at_lds_cptr)(scr + SA_V) + ((8 * hi + ((lane & 15) >> 2)) * 72 + 16 * ((lane >> 4) & 1) + 4 * (lane & 3)) * 2;
    for (int kb = kb_lo; kb < kb_hi; ++kb) {
        bf16x8 kc[NC0 + NC1]; u32x4 vc[4];
#pragma unroll
        for (int c = 0; c < NC0 + NC1; ++c) kc[c] = kn[c];
#pragma unroll
        for (int i = 0; i < 4; ++i) vc[i] = vn[i];
        if (kb + 1 < kb_hi) SA_LOAD(kb + 1);
        f32x16 s = {};
#pragma unroll
        for (int c = 0; c < NC0 + NC1; ++c) s = MFMA32(kc[c], qf[c], s);
        bool valid[16];
#pragma unroll
        for (int r = 0; r < 16; ++r) { if (MODE == 0) valid[r] = true; else { const int d = kb * 32 + crow(r, hi) - (qidx0 + r32); valid[r] = (d <= 64 && d >= -64); } }
        float p[16];
        if (MODE == 2) {
#pragma unroll
            for (int r = 0; r < 16; ++r) p[r] = valid[r] ? fast_exp2(s[r] - lse_ref) : 0.f;
        } else {
            float mx = -1.0e30f;
#pragma unroll
            for (int r = 0; r < 16; ++r) if (valid[r]) mx = fmaxf(mx, s[r]);
            mx = xmax32(mx);
            const float mn = fmaxf(m, mx), alpha = fast_exp2(m - mn); m = mn;
            float ps = 0.f;
#pragma unroll
            for (int r = 0; r < 16; ++r) { p[r] = valid[r] ? fast_exp2(s[r] - mn) : 0.f; ps += p[r]; }
            l = l * alpha + ps;
            if (MODE == 0) { if (hi == 0) Al[r32] = alpha; }
        }
        if (MODE != 1) {
#pragma unroll
            for (int g = 0; g < 4; ++g) { u32x2 w; w.x = pk2(p[4 * g], p[4 * g + 1]); w.y = pk2(p[4 * g + 2], p[4 * g + 3]); *(LAS u32x2*)(Pb + r32 * 40 + 8 * g + 4 * hi) = w; }
#pragma unroll
            for (int i = 0; i < 4; ++i) { const int idx = i * 64 + lane, kr = idx >> 3, pc = idx & 7; *(LAS u32x4*)(Vb + kr * 72 + pc * 8) = vc[i]; }
            LDS_WAIT();
            if (MODE == 0) {
#pragma unroll
                for (int r = 0; r < 16; ++r) { const float al = Al[crow(r, hi)]; o[0][r] *= al; o[1][r] *= al; }
            }
#pragma unroll
            for (int st = 0; st < 2; ++st) {
                const bf16x8 pf = *(const LAS bf16x8*)(Pb + r32 * 40 + 16 * st + 8 * hi);
#pragma unroll
                for (int db = 0; db < 2; ++db) {
                    const at_s16x4 lo_ = at_vtr(vtb + (16 * st * 72 + 32 * db) * 2), hi_ = at_vtr(vtb + ((16 * st + 4) * 72 + 32 * db) * 2);
                    const bf16x8 vf = {lo_[0], lo_[1], lo_[2], lo_[3], hi_[0], hi_[1], hi_[2], hi_[3]};
                    o[db] = MFMA32(pf, vf, o[db]); }
            }
            LDS_WAIT();
        }
    }
#undef SA_LOAD
    if (MODE != 2) { l = xsum32(l); lse_out = m + __log2f(l); }
    if (MODE == 0) {
        LAS float* Rl = (LAS float*)(scr + SA_RL);
        if (hi == 0) Rl[r32] = 1.0f / l;
        LDS_WAIT();
#pragma unroll
        for (int r = 0; r < 16; ++r) { const float rl = Rl[crow(r, hi)]; o[0][r] *= rl; o[1][r] *= rl; }
        LDS_WAIT();
    }
}

__device__ __forceinline__ void sattn_phase(Frame& F, const Args& a, int layer, int kind_lo) {
    const bf16_t* H = (const bf16_t*)(F.ws + WS_H); const bf16_t* QB = (const bf16_t*)(F.ws + WS_QB); const bf16_t* KVB = (const bf16_t*)(F.ws + WS_KVB);
    bf16_t* MIX = (bf16_t*)(F.ws + WS_MIX); const float* lsec = (const float*)(F.ws + WS_LSEC);
    LAS unsigned char* scr = F.lds + F.wave * 16384;
    const int lane = F.lane, r32 = lane & 31, hi = lane >> 5;
    float lam, lam_init;
    { const float* lv = a.diff_lambda + layer * 128; float d1 = 0.f, d2 = 0.f;
      for (int i = 0; i < 32; ++i) { d1 += lv[i] * lv[32 + i]; d2 += lv[64 + i] * lv[96 + i]; }
      lam_init = 0.8f - 0.6f * expf(-0.3f * (float)layer); lam = expf(d1) - expf(d2) + lam_init; }
    constexpr int NRB = NTOK / 32;
    const int items = NRB * (4 + 6 + 6);
    for (int it = kind_lo * NRB + F.gw; it < items; it += F.NGW) {
        const int kind = it / NRB, rb = it - kind * NRB; const int m0 = rb * 32; const SeqInfo si = seqinfo(m0);
#if !OPT_ATTN
        if (kind < 4) {
            const int h = kind; f32x16 o0[2], o1[2]; float dummy;
            for (int c = 0; c < 2; ++c) {
                bf16x8 qf[2];
#pragma unroll
                for (int d0 = 0; d0 < 2; ++d0) qf[d0] = *(const bf16x8*)(H + (size_t)(m0 + r32) * HP + HC_AQ + h * 64 + c * 32 + 16 * d0 + 8 * hi);
                const RowSrc ks{H + (size_t)si.base * HP + HC_AK + h * 64 + c * 32, HP}, vs{H + (size_t)si.base * HP + HC_AV + h * 64, HP};
                sattn_core<2, 0, 0>(qf, ks, ks, vs, 0, si.len / 32, 0, 0.f, scr, lane, c == 0 ? o0 : o1, dummy);
            }
            const float* sg = a.diff_subln + layer * 64; const float g0 = sg[r32], g1 = sg[32 + r32];
#pragma unroll
            for (int r = 0; r < 16; ++r) { const float x0 = o0[0][r] - lam * o1[0][r], x1 = o0[1][r] - lam * o1[1][r]; float ss = x0 * x0 + x1 * x1;
                ss += shx<1>(ss); ss += shx<2>(ss); ss += shx<4>(ss); ss += shx<8>(ss); ss += shx<16>(ss);
                const float rs = (1.0f - lam_init) / sqrtf(ss * (1.0f / 64.0f) + RMS_EPS);
                bf16_t* op = MIX + (size_t)(m0 + crow(r, hi)) * DM + MIX_A + h * 64 + r32;
                op[0] = (bf16_t)f2bf(x0 * rs * g0); op[32] = (bf16_t)f2bf(x1 * rs * g1); }
        } else if (kind < 10) {
            const int h = kind - 4; f32x16 o[2]; float dummy; bf16x8 qf[6];
#pragma unroll
            for (int d0 = 0; d0 < 6; ++d0) qf[d0] = *(const bf16x8*)(QB + (size_t)(m0 + r32) * QBP + h * 96 + 16 * d0 + 8 * hi);
            const RowSrc k0{KVB + (size_t)si.base * KVP + h * 128, KVP}, k1{H + (size_t)si.base * HP + HC_KROPE, HP}, vs{KVB + (size_t)si.base * KVP + h * 128 + 64, KVP};
            sattn_core<4, 2, 0>(qf, k0, k1, vs, 0, si.len / 32, 0, 0.f, scr, lane, o, dummy);
#pragma unroll
            for (int r = 0; r < 16; ++r) { bf16_t* op = MIX + (size_t)(m0 + crow(r, hi)) * DM + MIX_B + h * 64 + r32; op[0] = (bf16_t)f2bf(o[0][r]); op[32] = (bf16_t)f2bf(o[1][r]); }
        } else
#endif
        {
            const int gj = kind - 10, g = gj >> 1, hh = gj;
            const int dil = (g == 0) ? 1 : (g == 1 ? 4 : 16); const int L = si.len / dil, bpr = L / 32;
            const int w = (m0 - si.base) / 32, rho = w / bpr, ib = w - rho * bpr, i0 = ib * 32;
            const size_t qrow = (size_t)si.base + (size_t)(i0 + r32) * dil + rho;
            bf16x8 qf[4];
#pragma unroll
            for (int d0 = 0; d0 < 4; ++d0) qf[d0] = *(const bf16x8*)(H + qrow * HP + HC_CQ + hh * 64 + 16 * d0 + 8 * hi);
            const int j = gj & 1; const float l0 = lsec[(0 * (size_t)NTOK + qrow) * 2 + j], l1 = lsec[(1 * (size_t)NTOK + qrow) * 2 + j], l2 = lsec[(2 * (size_t)NTOK + qrow) * 2 + j];
            const float lm = fmaxf(l0, fmaxf(l1, l2)); const float lref = lm + __log2f(fast_exp2(l0 - lm) + fast_exp2(l1 - lm) + fast_exp2(l2 - lm));
            const RowSrc ks{H + ((size_t)si.base + rho) * HP + HC_CK + hh * 64, (long)HP * dil}, vs{H + ((size_t)si.base + rho) * HP + HC_CV + hh * 64, (long)HP * dil};
            int kb_lo = ib - 2, kb_hi = ib + 3; if (kb_lo < 0) kb_lo = 0; if (kb_hi > bpr) kb_hi = bpr;
            f32x16 o[2]; float dummy;
            sattn_core<4, 0, 2>(qf, ks, ks, vs, kb_lo, kb_hi, i0, lref, scr, lane, o, dummy);
#pragma unroll
            for (int r = 0; r < 16; ++r) { const size_t orow = (size_t)si.base + (size_t)(i0 + crow(r, hi)) * dil + rho; bf16_t* op = MIX + orow * DM + MIX_C + hh * 64 + r32; op[0] = (bf16_t)f2bf(o[0][r]); op[32] = (bf16_t)f2bf(o[1][r]); }
        }
    }
}
__device__ __forceinline__ void cstat_phase(Frame& F) {
    const bf16_t* H = (const bf16_t*)(F.ws + WS_H); float* lsec = (float*)(F.ws + WS_LSEC);
    LAS unsigned char* scr = F.lds + F.wave * 16384;
    const int lane = F.lane, r32 = lane & 31, hi = lane >> 5;
    constexpr int NRB = NTOK / 32;
    for (int it = F.gw; it < NRB * 6; it += F.NGW) {
        const int gj = it / NRB, rb = it - gj * NRB, g = gj >> 1, j = gj & 1; const int m0 = rb * 32; const SeqInfo si = seqinfo(m0);
        const int dil = (g == 0) ? 1 : (g == 1 ? 4 : 16); const int L = si.len / dil, bpr = L / 32;
        const int w = (m0 - si.base) / 32, rho = w / bpr, ib = w - rho * bpr, i0 = ib * 32;
        const size_t qrow = (size_t)si.base + (size_t)(i0 + r32) * dil + rho;
        bf16x8 qf[4];
#pragma unroll
        for (int d0 = 0; d0 < 4; ++d0) qf[d0] = *(const bf16x8*)(H + qrow * HP + HC_CQ + gj * 64 + 16 * d0 + 8 * hi);
        const RowSrc ks{H + ((size_t)si.base + rho) * HP + HC_CK + gj * 64, (long)HP * dil};
        int kb_lo = ib - 2, kb_hi = ib + 3; if (kb_lo < 0) kb_lo = 0; if (kb_hi > bpr) kb_hi = bpr;
        float lse; sattn_core<4, 0, 1>(qf, ks, ks, ks, kb_lo, kb_hi, i0, 0.f, scr, lane, nullptr, lse);
        if (hi == 0) lsec[((size_t)g * NTOK + qrow) * 2 + j] = lse;
    }
}


namespace at {
typedef short s16x4 __attribute__((ext_vector_type(4)));
typedef short v4i16_t __attribute__((ext_vector_type(4)));
typedef LAS const unsigned char* lds_cptr;
constexpr int LDS_K = 0, NSLOT = 4, VSLOT = 8192;
template <int NC> struct Lay { static constexpr int SLOTK = 2 * NC * 1024, V = NSLOT * SLOTK, WS = V + NSLOT * VSLOT, OST = WS + 8 * 256, STG = (NC > 2) ? 4096 : 8192, TOTAL = OST + 8 * STG; };
static_assert(Lay<2>::TOTAL <= RING_BYTES && Lay<6>::TOTAL <= RING_BYTES, "attention LDS");
constexpr float THR = 8.0f;
__device__ __forceinline__ void glds16(const void* g, unsigned lds_dst) {
    unsigned keep; asm volatile("s_mov_b32 %0, m0\n\ts_mov_b32 m0, %2\n\ts_nop 0\n\tglobal_load_lds_dwordx4 %1, off\n\ts_mov_b32 m0, %0" : "=&s"(keep) : "v"(g), "s"(lds_dst) : "memory"); }
__device__ __forceinline__ s16x4 vtr(lds_cptr p) { return __builtin_bit_cast(s16x4, __builtin_amdgcn_ds_read_tr16_b64_v4i16((LAS v4i16_t*)p)); }
__device__ __forceinline__ unsigned cvtpk(float lo, float hi) { typedef float f2 __attribute__((ext_vector_type(2))); typedef __bf16 b2 __attribute__((ext_vector_type(2))); f2 v = {lo, hi}; b2 b = __builtin_convertvector(v, b2); return __builtin_bit_cast(unsigned, b); }
#define AT_MX3(a, b, c) __builtin_fmaxf(__builtin_fmaxf((a), (b)), (c))
__device__ __forceinline__ float rowmax(const f32x16& p0, const f32x16& p1) {
    float a = AT_MX3(p0[0], p0[1], p1[0]), b = AT_MX3(p0[2], p0[3], p1[1]); a = AT_MX3(a, p1[2], p1[3]);
#pragma unroll
    for (int r = 4; r < 16; r += 4) { a = AT_MX3(a, p0[r], p0[r + 1]); b = AT_MX3(b, p0[r + 2], p0[r + 3]); a = AT_MX3(a, p1[r], p1[r + 1]); b = AT_MX3(b, p1[r + 2], p1[r + 3]); }
    float m = __builtin_fmaxf(a, b); auto rr = __builtin_amdgcn_permlane32_swap(__float_as_uint(m), __float_as_uint(m), false, false);
    return __builtin_fmaxf(__uint_as_float(rr[0]), __uint_as_float(rr[1])); }
#define AT_WAIT_BAR(N) asm volatile("s_waitcnt vmcnt(" #N ") lgkmcnt(0)\n\ts_barrier" ::: "memory")

struct Src { const bf16_t* p; long pitch; };
template <int NC, int NK0, int NK1, bool FAST>
__device__ __forceinline__ void stream(LAS unsigned char* lds, int tid, const bf16_t* qrow, Src k0, Src k1, Src vs, int NT, f32x16& o0, f32x16& o1, f32x4& lsum) {
    asm volatile("" : "+v"(tid));
    constexpr int SLOTK = Lay<NC>::SLOTK, LDS_V = Lay<NC>::V, LDS_WS = Lay<NC>::WS;
    const int lane = tid & 63, r32 = lane & 31, hi = lane >> 5; const int wid = __builtin_amdgcn_readfirstlane(tid >> 6);
    const unsigned lds0 = (unsigned)(uintptr_t)lds;
    LAS float* wsf = (LAS float*)(lds + LDS_WS) + wid * 64;
    constexpr int P0 = NK0 * 16;
    const bool hasA = (NK0 == 8) || (wid < 4), hasB = (NK1 > 0) && (wid < 4);
    const int pA = (NK0 == 8) ? wid : (wid & 3);
    const int rowA = (NK0 == 8) ? pA * 8 + (lane >> 3) : pA * 16 + (lane >> 2);
    const int chA = (NK0 == 8) ? ((lane & 7) ^ ((4 * pA + (lane >> 4)) & 7)) : ((lane & 3) ^ ((lane >> 4) & 3));
    const bf16_t* ksA = k0.p + (long)rowA * k0.pitch + chA * 8;
    const int rowB = (wid & 3) * 16 + (lane >> 2), chB = (lane & 3) ^ ((lane >> 4) & 3);
    const bf16_t* ksB = (NK1 > 0) ? k1.p + (long)rowB * k1.pitch + chB * 8 : k0.p;
    const bf16_t* vsp = vs.p + (long)(16 * (wid & 3) + (lane >> 2)) * vs.pitch + (wid >> 2) * 32 + (lane & 3) * 8;
    const unsigned kdA = lds0 + LDS_K + pA * 1024, kdB = lds0 + LDS_K + (NK0 + (wid & 3)) * 1024, vd = lds0 + LDS_V + wid * 1024;
    const long ktA = 64 * k0.pitch, ktB = 64 * k1.pitch, vt = 64 * vs.pitch;
    const int nd = (hasA ? 1 : 0) + (hasB ? 1 : 0) + 1;
#define AT_DMA_K(t, slot) do { if (hasA) glds16(ksA + (long)(t) * ktA, (unsigned)__builtin_amdgcn_readfirstlane(kdA + (slot) * SLOTK)); if (hasB) glds16(ksB + (long)(t) * ktB, (unsigned)__builtin_amdgcn_readfirstlane(kdB + (slot) * SLOTK)); } while (0)
#define AT_DMA_V(t, slot) glds16(vsp + (long)(t) * vt, (unsigned)__builtin_amdgcn_readfirstlane(vd + (slot) * VSLOT))
    lds_cptr kb[NC];
#pragma unroll
    for (int d0 = 0; d0 < NC; ++d0) { const int c = 2 * d0 + hi;
        if (2 * d0 < NK0) kb[d0] = (lds_cptr)lds + LDS_K + r32 * P0 + ((NK0 == 8) ? (c ^ ((r32 >> 1) & 7)) : (c ^ ((r32 >> 2) & 3))) * 16;
        else kb[d0] = (lds_cptr)lds + LDS_K + NK0 * 1024 + r32 * 64 + ((c - NK0) ^ ((r32 >> 2) & 3)) * 16; }
    const lds_cptr vp0 = (lds_cptr)lds + LDS_V + ((lane >> 4) & 1) * 32 + (lane & 3) * 8 + (4 * hi + ((lane & 15) >> 2)) * 64;
#ifdef PROBE_SEL
    { unsigned long long pc0_, pr0_; asm volatile("s_memtime %0\n\ts_memrealtime %1\n\ts_waitcnt lgkmcnt(0)" : "=s"(pc0_), "=s"(pr0_) :: "memory");
      LAS unsigned long long* ps_ = (LAS unsigned long long*)(lds + RING_BYTES + 8192 + 128) + wid * 2; ps_[0] = pc0_; ps_[1] = pr0_; }
#endif
    AT_DMA_K(0, 0); AT_DMA_V(0, 0); AT_DMA_K(1, 1); AT_DMA_K(2, 2); AT_DMA_V(1, 1);
    bf16x8 qr[NC];
#pragma unroll
    for (int d0 = 0; d0 < NC; ++d0) qr[d0] = *(const bf16x8*)(qrow + 16 * d0 + 8 * hi);
    float mhat = 0.f; f32x16 oa = {}, ob = {}, negm = {}, S0, S1; f32x4 la = {}; u32x4 pw0, pw1, pw2, pw3;
    bf16x8 ones; { const unsigned o_ = (((lane >> 4) & 1) == ((lane >> 3) & 1)) ? 0x3F803F80u : 0u; u32x4 o1_ = {o_, o_, o_, o_}; asm volatile("" : "+v"(o1_)); ones = __builtin_bit_cast(bf16x8, o1_); }
    asm volatile("" : "+v"(negm));
    AT_WAIT_BAR(0);
    __builtin_amdgcn_s_waitcnt(0);
#pragma unroll
    for (int d0 = 0; d0 < NC; ++d0) asm volatile("" : "+v"(qr[d0]));
    bf16x8 kf[2 * NC], vf[8];
#define AT_SB() __builtin_amdgcn_sched_barrier(0)
#define AT_KRD(so_, d0) do { kf[2 * (d0)] = *(const LAS bf16x8*)(kb[d0] + (so_)); kf[2 * (d0) + 1] = *(const LAS bf16x8*)(kb[d0] + (so_) + 32 * ((2 * (d0) < NK0) ? P0 : 64)); } while (0)
#define AT_KHEAD(slot) do { const int kp_ = (slot) * SLOTK; AT_KRD(kp_, 0); if (NC > 1) AT_KRD(kp_, 1); } while (0)
#define AT_VF(i) ({ const s16x4 lo_ = vtr(vp_ + (((i) >> 2) * 4096 + ((i) & 3) * 1024)), hi_ = vtr(vp_ + (((i) >> 2) * 4096 + ((i) & 3) * 1024 + 512)); (bf16x8){lo_[0], lo_[1], lo_[2], lo_[3], hi_[0], hi_[1], hi_[2], hi_[3]}; })
#define AT_VHEAD(slot) do { const lds_cptr vp_ = vp0 + (slot) * VSLOT; vf[0] = AT_VF(0); vf[4] = AT_VF(4); } while (0)
#define AT_QKM(slot) do { const int kp_ = (slot) * SLOTK; \
        _Pragma("unroll") for (int d0 = 0; d0 < NC; ++d0) { if (d0 + 2 < NC) AT_KRD(kp_, d0 + 2); \
            if (d0 == 0) { S0 = MFMA32(kf[0], qr[0], negm); S1 = MFMA32(kf[1], qr[0], negm); } else { S0 = MFMA32(kf[2 * d0], qr[d0], S0); S1 = MFMA32(kf[2 * d0 + 1], qr[d0], S1); } AT_SB(); } } while (0)
#define AT_PVM(slot) do { const lds_cptr vp_ = vp0 + (slot) * VSLOT; \
        vf[1] = AT_VF(1); vf[5] = AT_VF(5); oa = MFMA32(__builtin_bit_cast(bf16x8, pw0), vf[0], oa); ob = MFMA32(__builtin_bit_cast(bf16x8, pw0), vf[4], ob); la = MFMA16(__builtin_bit_cast(bf16x8, pw0), ones, la); AT_SB(); \
        vf[2] = AT_VF(2); vf[6] = AT_VF(6); oa = MFMA32(__builtin_bit_cast(bf16x8, pw1), vf[1], oa); ob = MFMA32(__builtin_bit_cast(bf16x8, pw1), vf[5], ob); la = MFMA16(__builtin_bit_cast(bf16x8, pw1), ones, la); AT_SB(); \
        vf[3] = AT_VF(3); vf[7] = AT_VF(7); oa = MFMA32(__builtin_bit_cast(bf16x8, pw2), vf[2], oa); ob = MFMA32(__builtin_bit_cast(bf16x8, pw2), vf[6], ob); la = MFMA16(__builtin_bit_cast(bf16x8, pw2), ones, la); AT_SB(); \
        oa = MFMA32(__builtin_bit_cast(bf16x8, pw3), vf[3], oa); ob = MFMA32(__builtin_bit_cast(bf16x8, pw3), vf[7], ob); la = MFMA16(__builtin_bit_cast(bf16x8, pw3), ones, la); AT_SB(); } while (0)
    bool resc = false; u32x4 qw0, qw1, qw2, qw3;
#define AT_PIN(x) asm volatile("" : "+v"(x))
#define AT_DECIDE(first) do { const float rm_ = rowmax(S0, S1); resc = false; \
        if ((first) || __any(rm_ > THR)) { const float dl_ = (first) ? rm_ : __builtin_fmaxf(rm_, 0.f); mhat += dl_; \
            _Pragma("unroll") for (int r = 0; r < 16; ++r) { S0[r] -= dl_; S1[r] -= dl_; negm[r] = -mhat; } asm volatile("" : "+v"(negm)); \
            if (!(first)) { const float f_ = fast_exp2(-dl_); if (hi == 0) wsf[r32] = f_; resc = true; } } } while (0)
#define AT_RESC() do { if (resc) { LDS_WAIT(); \
        _Pragma("unroll") for (int r = 0; r < 16; ++r) { const float g_ = wsf[crow(r, hi)]; oa[r] *= g_; ob[r] *= g_; } \
        _Pragma("unroll") for (int v = 0; v < 4; ++v) la[v] *= wsf[4 * (lane >> 4) + 16 * ((lane >> 3) & 1) + v]; LDS_WAIT(); } } while (0)
#define AT_EXP8(S, b, Q) do { \
        _Pragma("unroll") for (int r = 0; r < 8; ++r) S[(b) + r] = fast_exp2(S[(b) + r]); \
        Q = (u32x4){cvtpk(S[(b)], S[(b) + 1]), cvtpk(S[(b) + 2], S[(b) + 3]), cvtpk(S[(b) + 4], S[(b) + 5]), cvtpk(S[(b) + 6], S[(b) + 7])}; AT_PIN(Q); } while (0)
#define AT_EXPALL() do { AT_EXP8(S0, 0, qw0); AT_EXP8(S0, 8, qw1); AT_EXP8(S1, 0, qw2); AT_EXP8(S1, 8, qw3); pw0 = qw0; pw1 = qw1; pw2 = qw2; pw3 = qw3; } while (0)
#define AT_PV_EXP(slot, C0, C1, C2, C3, N0, N1, N2, N3) do { const lds_cptr vp_ = vp0 + (slot) * VSLOT; \
        vf[1] = AT_VF(1); vf[5] = AT_VF(5); oa = MFMA32(__builtin_bit_cast(bf16x8, C0), vf[0], oa); ob = MFMA32(__builtin_bit_cast(bf16x8, C0), vf[4], ob); la = MFMA16(__builtin_bit_cast(bf16x8, C0), ones, la); AT_EXP8(S0, 0, N0); AT_SB(); \
        vf[2] = AT_VF(2); vf[6] = AT_VF(6); oa = MFMA32(__builtin_bit_cast(bf16x8, C1), vf[1], oa); ob = MFMA32(__builtin_bit_cast(bf16x8, C1), vf[5], ob); la = MFMA16(__builtin_bit_cast(bf16x8, C1), ones, la); AT_EXP8(S0, 8, N1); AT_SB(); \
        vf[3] = AT_VF(3); vf[7] = AT_VF(7); oa = MFMA32(__builtin_bit_cast(bf16x8, C2), vf[2], oa); ob = MFMA32(__builtin_bit_cast(bf16x8, C2), vf[6], ob); la = MFMA16(__builtin_bit_cast(bf16x8, C2), ones, la); AT_EXP8(S1, 0, N2); AT_SB(); \
        oa = MFMA32(__builtin_bit_cast(bf16x8, C3), vf[3], oa); ob = MFMA32(__builtin_bit_cast(bf16x8, C3), vf[7], ob); la = MFMA16(__builtin_bit_cast(bf16x8, C3), ones, la); AT_EXP8(S1, 8, N3); AT_SB(); } while (0)
#define AT_STEP_WAIT(t) do { if ((t) + 3 < NT) { if (nd == 3) AT_WAIT_BAR(6); else if (nd == 2) AT_WAIT_BAR(4); else AT_WAIT_BAR(2); } else AT_WAIT_BAR(0); } while (0)
    AT_DMA_K(3, 3); AT_DMA_V(2, 2);
    AT_KHEAD(0); AT_SB();
    AT_QKM(0); AT_DECIDE(true); AT_EXPALL();
    AT_STEP_WAIT(0);
#define AT_STEP(t, C0, C1, C2, C3, N0, N1, N2, N3) do { const int kc_ = (t) & 3, vp1_ = ((t) - 1) & 3; \
        if ((t) + 3 < NT) AT_DMA_K((t) + 3, ((t) + 3) & 3); \
        if ((t) + 2 < NT) AT_DMA_V((t) + 2, ((t) + 2) & 3); \
        AT_KHEAD(kc_); AT_VHEAD(vp1_); AT_SB(); \
        AT_QKM(kc_); \
        if (!FAST) { AT_DECIDE(false); AT_SB(); } \
        AT_PV_EXP(vp1_, C0, C1, C2, C3, N0, N1, N2, N3); \
        if (!FAST) AT_RESC(); \
        AT_STEP_WAIT(t); } while (0)
    int t = 1;
    for (; t + 1 < NT; t += 2) { AT_STEP(t, pw0, pw1, pw2, pw3, qw0, qw1, qw2, qw3); AT_STEP(t + 1, qw0, qw1, qw2, qw3, pw0, pw1, pw2, pw3); }
    if (t < NT) { AT_STEP(t, pw0, pw1, pw2, pw3, qw0, qw1, qw2, qw3); pw0 = qw0; pw1 = qw1; pw2 = qw2; pw3 = qw3; }
#undef AT_STEP
    AT_VHEAD((NT - 1) & 3); AT_SB(); AT_PVM((NT - 1) & 3);
    o0 = oa; o1 = ob; lsum = la;
#ifdef PROBE_SEL
    { unsigned long long pc1_, pr1_; asm volatile("s_memtime %0\n\ts_memrealtime %1\n\ts_waitcnt lgkmcnt(0)" : "=s"(pc1_), "=s"(pr1_) :: "memory");
      const LAS unsigned long long* ps_ = (const LAS unsigned long long*)(lds + RING_BYTES + 8192 + 128) + wid * 2; const unsigned long long pc0_ = ps_[0], pr0_ = ps_[1];
      if (wid == 0) { LAS unsigned long long* pb_ = (LAS unsigned long long*)(lds + RING_BYTES + 8192) + (NC > 2 ? 4 : 0); pb_[0] += pc1_ - pc0_; pb_[1] += pr1_ - pr0_; pb_[2] += (unsigned long long)NT; } }
#endif
#undef AT_DMA_K
#undef AT_DMA_V
#undef AT_SB
#undef AT_KRD
#undef AT_KHEAD
#undef AT_VF
#undef AT_VHEAD
#undef AT_QKM
#undef AT_PVM
#undef AT_PIN
#undef AT_DECIDE
#undef AT_RESC
#undef AT_EXP8
#undef AT_EXPALL
#undef AT_PV_EXP
#undef AT_STEP_WAIT
}
template <int NC>
__device__ __forceinline__ void normalise(LAS unsigned char* lds, int tid, f32x16& o0, f32x16& o1, const f32x4& lsum) {
    const int lane = tid & 63, hi = lane >> 5; const int wid = __builtin_amdgcn_readfirstlane(tid >> 6);
    LAS float* wsf = (LAS float*)(lds + Lay<NC>::WS) + wid * 64;
#pragma unroll
    for (int v = 0; v < 4; ++v) wsf[32 + 4 * (lane >> 4) + 16 * ((lane >> 3) & 1) + v] = 1.0f / lsum[v];
    LDS_WAIT();
#pragma unroll
    for (int r = 0; r < 16; ++r) { const float g = wsf[32 + crow(r, hi)]; o0[r] *= g; o1[r] *= g; }
    LDS_WAIT();
}
}

struct AttnUnitId { int kind, seq, head, qb; };
__device__ __forceinline__ bool attn_unit_at(int i, int G, int bid, AttnUnitId& u) {
    const long L = (long)i * G + bid; if (L >= 2560) return false; int o = (int)L;
    int kind, longs, nh;
    if (o < 512) { kind = 0; longs = 1; nh = 4; } else if (o < 1024) { kind = 0; longs = 0; nh = 4; o -= 512; } else if (o < 1792) { kind = 1; longs = 1; nh = 6; o -= 1024; } else { kind = 1; longs = 0; nh = 6; o -= 1792; }
    const int nqb = longs ? 16 : 8;
    int pair, qb;
    if (G == 256) { const int rnd = o >> 8, b = o & 255, x = b & 7, c = b >> 3;
        const int ppr = 32 / nqb; pair = x + 8 * (rnd * ppr + c / nqb); qb = c % nqb; }
    else { pair = o / nqb; qb = o % nqb; }
    u.kind = kind; u.head = pair % nh; const int sq = pair / nh; u.seq = longs ? 16 + sq : sq; u.qb = qb; return true;
}
template <bool FAST>
__device__ __forceinline__ bool attn_unit(Frame& F, const Args& a, int layer, const AttnUnitId& u, float lam, float lam_init) {
    const bf16_t* H = (const bf16_t*)(F.ws + WS_H); const bf16_t* QB = (const bf16_t*)(F.ws + WS_QB); const bf16_t* KVB = (const bf16_t*)(F.ws + WS_KVB);
    bf16_t* MIX = (bf16_t*)(F.ws + WS_MIX);
    const int wid = F.wave; bool bad = false;
    int tid = F.tid; asm volatile("" : "+v"(tid)); const int lane = tid & 63, r32 = lane & 31, hi = lane >> 5;
    const int len = (u.seq < 16) ? 2048 : 4096, base = (u.seq < 16) ? u.seq * 2048 : NTOK_P + (u.seq - 16) * 4096, NT = len / 64;
    const int m0 = base + u.qb * 256 + wid * 32;
    LAS bf16_t* sb = (LAS bf16_t*)(F.lds + ((u.kind == 0) ? at::Lay<2>::OST + wid * at::Lay<2>::STG : at::Lay<6>::OST + wid * at::Lay<6>::STG));
    LAS float* sf = (LAS float*)sb;
#define AT_BADSUM(ls) (!(ls[0] < 1e30f) | !(ls[1] < 1e30f) | !(ls[2] < 1e30f) | !(ls[3] < 1e30f))
    if (u.kind == 0) {
        f32x16 q0, q1; f32x4 ls;
        { f32x16 p0, p1; const at::Src ks{H + (size_t)base * HP + HC_AK + u.head * 64, HP}, vs{H + (size_t)base * HP + HC_AV + u.head * 64, HP};
          at::stream<2, 4, 0, FAST>(F.lds, tid, H + (size_t)(m0 + r32) * HP + HC_AQ + u.head * 64, ks, ks, vs, NT, p0, p1, ls); bad |= AT_BADSUM(ls); at::normalise<2>(F.lds, tid, p0, p1, ls);
#pragma unroll
          for (int r = 0; r < 16; ++r) { const int row = crow(r, hi); sf[row * 64 + r32] = p0[r]; sf[row * 64 + 32 + r32] = p1[r]; }
          AT_WAIT_BAR(0); }
        { const at::Src ks{H + (size_t)base * HP + HC_AK + u.head * 64 + 32, HP}, vs{H + (size_t)base * HP + HC_AV + u.head * 64, HP};
          at::stream<2, 4, 0, FAST>(F.lds, tid, H + (size_t)(m0 + r32) * HP + HC_AQ + u.head * 64 + 32, ks, ks, vs, NT, q0, q1, ls); bad |= AT_BADSUM(ls); at::normalise<2>(F.lds, tid, q0, q1, ls); }
        float xa[16], xb[16];
#pragma unroll
        for (int r = 0; r < 16; ++r) { const int row = crow(r, hi); xa[r] = sf[row * 64 + r32] - lam * q0[r]; xb[r] = sf[row * 64 + 32 + r32] - lam * q1[r]; }
        LDS_WAIT();
        const float* sg = a.diff_subln + layer * 64; const float g0 = sg[r32] * (1.0f - lam_init), g1 = sg[32 + r32] * (1.0f - lam_init);
#pragma unroll
        for (int r = 0; r < 16; ++r) { const float x0 = xa[r], x1 = xb[r]; float ss = x0 * x0 + x1 * x1;
            ss += shx<1>(ss); ss += shx<2>(ss); ss += shx<4>(ss); ss += shx<8>(ss); ss += shx<16>(ss);
            const float rs = 1.0f / sqrtf(ss * (1.0f / 64.0f) + RMS_EPS); const int row = crow(r, hi);
            sb[row * 64 + r32] = (bf16_t)f2bf(x0 * rs * g0); sb[row * 64 + 32 + r32] = (bf16_t)f2bf(x1 * rs * g1); }
        LDS_WAIT();
#pragma unroll
        for (int it = 0; it < 4; ++it) { const int row = it * 8 + (lane >> 3), ch = lane & 7; *(u32x4*)(MIX + (size_t)(m0 + row) * DM + MIX_A + u.head * 64 + ch * 8) = *(const LAS u32x4*)(sb + row * 64 + ch * 8); }
    } else {
        f32x16 p0, p1; f32x4 ls;
        const at::Src k0{KVB + (size_t)base * KVP + u.head * 128, KVP}, k1{H + (size_t)base * HP + HC_KROPE, HP}, vs{KVB + (size_t)base * KVP + u.head * 128 + 64, KVP};
        at::stream<6, 8, 4, FAST>(F.lds, tid, QB + (size_t)(m0 + r32) * QBP + u.head * 96, k0, k1, vs, NT, p0, p1, ls); bad |= AT_BADSUM(ls); at::normalise<6>(F.lds, tid, p0, p1, ls);
#pragma unroll
        for (int r = 0; r < 16; ++r) { const int row = crow(r, hi); sb[row * 64 + r32] = (bf16_t)f2bf(p0[r]); sb[row * 64 + 32 + r32] = (bf16_t)f2bf(p1[r]); }
        LDS_WAIT();
#pragma unroll
        for (int it = 0; it < 4; ++it) { const int row = it * 8 + (lane >> 3), ch = lane & 7; *(u32x4*)(MIX + (size_t)(m0 + row) * DM + MIX_B + u.head * 64 + ch * 8) = *(const LAS u32x4*)(sb + row * 64 + ch * 8); }
    }
#undef AT_BADSUM
    return bad;
}
constexpr int ATT_FLAG_OFF = RING_BYTES + 8192 + 512;
__device__ __forceinline__ void attn_ab_phase(Frame& F, const Args& a, int layer, int kmask = 3) {
    float lam, lam_init;
    { const float* lv = a.diff_lambda + layer * 128; float d1 = 0.f, d2 = 0.f;
      for (int i = 0; i < 32; ++i) { d1 += lv[i] * lv[32 + i]; d2 += lv[64 + i] * lv[96 + i]; }
      lam_init = 0.8f - 0.6f * expf(-0.3f * (float)layer); lam = expf(d1) - expf(d2) + lam_init;
      lam = __uint_as_float(__builtin_amdgcn_readfirstlane(__float_as_uint(lam))); lam_init = __uint_as_float(__builtin_amdgcn_readfirstlane(__float_as_uint(lam_init))); }
    volatile LAS unsigned* flag = (volatile LAS unsigned*)(F.lds + ATT_FLAG_OFF);
    AttnUnitId u;
    for (int i = 0; attn_unit_at(i, F.G, F.bid, u); ++i) {
        if (!((kmask >> u.kind) & 1)) continue;
        const unsigned ep = (unsigned)(layer * 64 + i + 1);
        const bool bad = attn_unit<true>(F, a, layer, u, lam, lam_init);
        if (__any(bad)) *flag = ep;
        AT_WAIT_BAR(0);
        if ((unsigned)__builtin_amdgcn_readfirstlane(*flag) == ep) {
            launder(F); attn_unit<false>(F, a, layer, u, lam, lam_init);
            AT_WAIT_BAR(0); }
    }
}

struct ListRows { const int* list; int seg0, cnt; __device__ __forceinline__ int src(int m) const { const int r = m - seg0; return (r < cnt) ? (list[r] >> 1) : 0; } };
__device__ __forceinline__ void moe_segments(Frame& F, int layer, LAS int* seg) {
    if (F.tid < 32) seg[33 + F.tid] = (int)__hip_atomic_load(F.ctl + CW_CNT + layer * 64 + F.tid, RLX_AGENT);
    __syncthreads();
    if (F.tid == 0) { int acc = 0; for (int e = 0; e < NEXP; ++e) { seg[e] = acc; acc += (seg[33 + e] + 255) & ~255; } seg[32] = acc; }
    __syncthreads();
}
__device__ __forceinline__ int seg_find(const LAS int* seg, int row) { int e = 0;
#pragma unroll
    for (int s = 16; s > 0; s >>= 1) if (seg[e + s] <= row) e += s;
    return e; }
__device__ __forceinline__ void moe_up_simple(Frame& F, int layer) {
    LAS int* seg = (LAS int*)(F.lds + RING_BYTES); moe_segments(F, layer, seg);
    const bf16_t* XB = (const bf16_t*)(F.ws + WS_XB); const bf16_t* W13 = (const bf16_t*)(F.ws + WS_W13); const int* list = (const int*)(F.ws + WS_LIST);
    const EpiHid E{(bf16_t*)(F.ws + WS_HID)};
    const int items = (seg[32] / 32) * 16;
    for (int it = F.gw; it < items; it += F.NGW) { const int mt = it >> 4, ct = it & 15, m0 = mt * 32, e = seg_find(seg, m0), c0 = ct * 32;
        const ListRows RM{list + (size_t)e * LIST_CAP, seg[e], seg[33 + e]};
        const bf16_t* Bg = W13 + (size_t)e * 1024 * 1024 + (size_t)((c0 >> 7) * 256 + (c0 & 127)) * 1024;
        sg_tile(XB, DM, Bg, Bg + (size_t)128 * 1024, 1024, 1024, m0, c0, E, RM, F.lane); }
    __syncthreads();
}
__device__ __forceinline__ void moe_down_simple(Frame& F, int layer) {
    LAS int* seg = (LAS int*)(F.lds + RING_BYTES); moe_segments(F, layer, seg);
    const bf16_t* HID = (const bf16_t*)(F.ws + WS_HID); const bf16_t* W2 = (const bf16_t*)(F.ws + WS_W2); const int* list = (const int*)(F.ws + WS_LIST);
    const int items = (seg[32] / 32) * 16;
    for (int it = F.gw; it < items; it += F.NGW) { const int mt = it >> 4, ct = it & 15, m0 = mt * 32, e = seg_find(seg, m0), c0 = ct * 64;
        const EpiY E{(bf16_t*)(F.ws + WS_YB), (const float*)(F.ws + WS_TW), list + (size_t)e * LIST_CAP, seg[e], seg[33 + e]};
        const bf16_t* B0 = W2 + (size_t)e * 1024 * 512 + (size_t)c0 * 512;
        sg_tile(HID, DEXP, B0, B0 + (size_t)32 * 512, 512, 512, m0, c0, E, IdRows(), F.lane); }
    __syncthreads();
}


struct MoeUpSched {
    const char* XB; const char* W13; const LAS int* seg; const int* list; int nM, G, c;
    __device__ __forceinline__ bool next(int i, pg8::Unit& u) const { if (!pg8::order_next(i, G, c, nM, 4, u.pm, u.pn)) return false; u.e = __builtin_amdgcn_readfirstlane(seg_find(seg, u.pm * 256)); u.a = XB; u.b = W13 + ((size_t)u.e * 1024 + (size_t)u.pn * 256) * 2048; return true; }
    __device__ __forceinline__ unsigned arow(const pg8::Unit& u, int r) const { const int rr = u.pm * 256 + r - __builtin_amdgcn_readfirstlane(seg[u.e]); return (rr < __builtin_amdgcn_readfirstlane(seg[33 + u.e])) ? (unsigned)(list[(size_t)u.e * LIST_CAP + rr] >> 1) : 0u; }
};
struct MoeDownSched {
    const char* HID; const char* W2; const LAS int* seg; int nM, G, c;
    __device__ __forceinline__ bool next(int i, pg8::Unit& u) const { if (!pg8::order_next(i, G, c, nM, 4, u.pm, u.pn)) return false; u.e = __builtin_amdgcn_readfirstlane(seg_find(seg, u.pm * 256)); u.a = HID + (size_t)u.pm * 256 * DEXP * 2; u.b = W2 + ((size_t)u.e * 1024 + (size_t)u.pn * 256) * 1024; return true; }
    __device__ __forceinline__ unsigned arow(const pg8::Unit&, int) const { return 0u; }
};
__device__ __forceinline__ void moe_up_opt(Frame& F, int layer) {
    LAS int* seg = (LAS int*)(F.lds + RING_BYTES); moe_segments(F, layer, seg);
    const MoeUpSched S{(const char*)(F.ws + WS_XB), (const char*)(F.ws + WS_W13), seg, (const int*)(F.ws + WS_LIST), __builtin_amdgcn_readfirstlane(seg[32]) / 256, F.G, F.bid};
    const EpiHid E{(bf16_t*)(F.ws + WS_HID)};
    pg8::gemm_phase<EpiHid, MoeUpSched, true, true>(F.lds, F.tid, 1024, DM, S, E);
    __syncthreads();
}
__device__ __forceinline__ void moe_down_opt(Frame& F, int layer) {
    LAS int* seg = (LAS int*)(F.lds + RING_BYTES); moe_segments(F, layer, seg);
    const MoeDownSched S{(const char*)(F.ws + WS_HID), (const char*)(F.ws + WS_W2), seg, __builtin_amdgcn_readfirstlane(seg[32]) / 256, F.G, F.bid};
    const EpiYO E{(bf16_t*)(F.ws + WS_YB), (const float*)(F.ws + WS_TW), (const int*)(F.ws + WS_LIST), seg, (const float*)(F.ws + WS_LW)};
    pg8::gemm_phase<EpiYO, MoeDownSched, false, false>(F.lds, F.tid, DEXP, DEXP, S, E);
    __syncthreads();
}
template <class Epi>
__device__ __forceinline__ void pg_phase(Frame& F, const bf16_t* A, int lda, const bf16_t* Bt, int panel, int N, int K, const Epi& E) {
    pg8::PanelSched S; S.init(A, lda, Bt, panel, N, K);
    pg8::gemm_phase<Epi, pg8::PanelSched, false, false>(F.lds, F.tid, K, lda, S, E);
}
__device__ __forceinline__ void local_sync(Frame& F) {
    asm volatile("s_waitcnt vmcnt(0) lgkmcnt(0)" ::: "memory");
    __syncthreads();
    if (F.tid == 0) { __builtin_amdgcn_fence(__ATOMIC_ACQUIRE, "agent"); asm volatile("s_waitcnt vmcnt(0)" ::: "memory"); }
    __syncthreads();
}
template <class Epi>
__device__ __forceinline__ void og_phase(Frame& F, const bf16_t* A, int lda, const bf16_t* Bt, int M, int N, int K, const Epi& E) {
    pg8::DenseSched S; S.init(A, lda, Bt, M, N, K, F.G, F.bid);
    pg8::gemm_phase<Epi, pg8::DenseSched, false, false>(F.lds, F.tid, K, lda, S, E);
}

#ifndef PANEL_PROG
#define PANEL_PROG 1
#endif
#if PANEL_PROG
constexpr int PH_PER_LAYER = 6, N_PHASES = 2 + DEPTH * PH_PER_LAYER;
#else
constexpr int PH_PER_LAYER = 9, N_PHASES = 1 + DEPTH * PH_PER_LAYER;
#endif
__global__ void __launch_bounds__(NTHREADS, 2) fwd(Args args) {
    extern __shared__ __attribute__((aligned(16))) unsigned char lds[];
    Frame F;
    F.lds = (LAS unsigned char*)lds; F.ldsg = lds;
    F.tid = threadIdx.x; F.lane = F.tid & 63; F.wave = __builtin_amdgcn_readfirstlane(F.tid >> 6);
    F.G = gridDim.x; F.bid = blockIdx.x; F.gw = blockIdx.x * NWAVES + F.wave; F.NGW = F.G * NWAVES;
    F.ws = args.ws; F.ctl = (gu32*)(args.ws + WS_CTL);
    volatile LAS unsigned* MISC = (volatile LAS unsigned*)(F.lds + MISC_OFF);
    for (int u = F.tid; u < (LDS_BYTES - RING_BYTES) / 4; u += NTHREADS) ((LAS unsigned*)(F.lds + RING_BYTES))[u] = 0u;
    __syncthreads();
    XcdBarrier bar; bar.bar = (unsigned*)(F.ctl + CW_BAR); bar.x = 0; bar.st = nullptr;
    if (args.use_bar) bar = xcd_barrier_post((unsigned*)(F.ctl + CW_BAR), MISC + 8);
    const int lo = args.ph_lo, hi = args.ph_hi;
#ifndef PH_MASK
#define PH_MASK 0x3ff
#endif
#define IN(k) (lo <= (k) && (k) < hi && (launder(F), true))
#define SEAM(k) do { if (lo <= (k) && (k) + 1 < hi) xcd_barrier(bar); } while (0)
    if ((PH_MASK & 1) && IN(0)) { p0_prologue(F, args);
#ifdef PROBE_DUP_P0
        launder(F); p0_prologue(F, args);
#endif
    }
    SEAM(0);
#if PANEL_PROG
    for (int layer = 0; layer < DEPTH; ++layer) {
        const int pb = 1 + layer * PH_PER_LAYER;
        if (IN(pb + 0)) {
            for (int panel = F.bid; panel < NTOK / 256; panel += F.G) {
                const int r0 = panel * 256;
                if (layer > 0) { ln2_pass(F, args, layer - 1, r0 + F.wave, NWAVES, r0 + 256); local_sync(F); launder(F); }
                { bf16_t* H = (bf16_t*)(F.ws + WS_H); const EpiH E{H, (const float2*)(F.ws + WS_ROPE32), (const float2*)(F.ws + WS_ROPE64)};
                  pg_phase(F, (const bf16_t*)(F.ws + WS_XB), DM, (const bf16_t*)(F.ws + WS_WIN) + (size_t)layer * 2560 * 1024, panel, 2560, 1024, E); }
                local_sync(F); launder(F);
                rowstat_pass(F, r0 + F.wave, NWAVES, r0 + 256);
                local_sync(F); launder(F);
                { bf16_t* H = (bf16_t*)(F.ws + WS_H); const EpiUQ Eq{(bf16_t*)(F.ws + WS_QB), (const float*)(F.ws + WS_RSTD), (const float2*)(F.ws + WS_ROPE32)};
                  pg_phase(F, H + HC_CQ_LAT, HP, (const bf16_t*)(F.ws + WS_WUQ) + (size_t)layer * 768 * 256, panel, 768, 256, Eq); }
                launder(F);
                { bf16_t* H = (bf16_t*)(F.ws + WS_H); const EpiUKV Ek{(bf16_t*)(F.ws + WS_KVB), (const float*)(F.ws + WS_RSTD)};
                  pg_phase(F, H + HC_CKV, HP, (const bf16_t*)(F.ws + WS_WUKV) + (size_t)layer * 768 * 256, panel, 768, 256, Ek); }
                launder(F);
            }
        }
        SEAM(pb + 0);
        if (IN(pb + 1)) { cstat_phase(F); }
        SEAM(pb + 1);
        if (IN(pb + 2)) { attn_ab_phase(F, args, layer); launder(F); sattn_phase(F, args, layer, 10); }
        SEAM(pb + 2);
        if (IN(pb + 3)) {
            for (int panel = F.bid; panel < NTOK / 256; panel += F.G) {
                const int r0 = panel * 256;
                { const EpiRes E{args.out, layer == 0 ? args.x_prompt : nullptr, args.x_sample, args.out};
                  pg_phase(F, (const bf16_t*)(F.ws + WS_MIX), DM, (const bf16_t*)(F.ws + WS_WOUT) + (size_t)layer * 1024 * 1024, panel, 1024, 1024, E); }
                local_sync(F); launder(F);
                ln1_route_pass(F, args, layer, r0 + F.wave, NWAVES, r0 + 256);
                launder(F);
            }
            moe_convert(F, args, layer);
        }
        SEAM(pb + 3);
        if (IN(pb + 4)) { moe_up_opt(F, layer);
#ifdef PROBE_DUP_MOE
            launder(F); moe_up_opt(F, layer);
#endif
        }
        SEAM(pb + 4);
        if (IN(pb + 5)) { moe_down_opt(F, layer);
#ifdef PROBE_DUP_MOE
            launder(F); moe_down_opt(F, layer);
#endif
        }
        SEAM(pb + 5);
    }
    if (IN(1 + DEPTH * PH_PER_LAYER)) { ln2_pass(F, args, DEPTH - 1, F.gw, F.NGW, NTOK); }
#ifdef PROBE_SEL
    __syncthreads(); launder(F);
    if (F.bid == 0 && F.tid == 0) { const LAS unsigned long long* pb_ = (const LAS unsigned long long*)(F.lds + RING_BYTES + 8192);
        const unsigned long long num_ = (PROBE_SEL == 1) ? 10000ull * pb_[4] : (PROBE_SEL == 2) ? 100ull * pb_[4] : (PROBE_SEL == 3) ? 100ull * pb_[0] : 10000ull * pb_[0];
        const unsigned long long den_ = (PROBE_SEL == 1) ? pb_[5] : (PROBE_SEL == 2) ? pb_[6] : (PROBE_SEL == 3) ? pb_[2] : pb_[1];
        const unsigned long long t0_ = __builtin_amdgcn_s_memrealtime();
        while ((__builtin_amdgcn_s_memrealtime() - t0_) * den_ < num_) __builtin_amdgcn_s_sleep(8); }
#endif
#else
    for (int layer = 0; layer < DEPTH; ++layer) {
        const int pb = 1 + layer * PH_PER_LAYER;
        if ((PH_MASK & (2 << 0)) && IN(pb + 0)) {   bf16_t* H = (bf16_t*)(F.ws + WS_H);
            const EpiH E{H, (const float2*)(F.ws + WS_ROPE32), (const float2*)(F.ws + WS_ROPE64)};
#if OPT_GEMM
            og_phase(F, (const bf16_t*)(F.ws + WS_XB), DM, (const bf16_t*)(F.ws + WS_WIN) + (size_t)layer * 2560 * 1024, NTOK, 2560, 1024, E);
#ifdef PROBE_DUP_GEMM
            launder(F); og_phase(F, (const bf16_t*)(F.ws + WS_XB), DM, (const bf16_t*)(F.ws + WS_WIN) + (size_t)layer * 2560 * 1024, NTOK, 2560, 1024, E);
#endif
#else
            sg_phase(F, (const bf16_t*)(F.ws + WS_XB), DM, (const bf16_t*)(F.ws + WS_WIN) + (size_t)layer * 2560 * 1024, 1024, NTOK, 2560, 1024, E);
#endif
        }
        SEAM(pb + 0);
        if ((PH_MASK & (2 << 1)) && IN(pb + 1)) { rowstat_pass(F, F.gw, F.NGW, NTOK); cstat_phase(F);
#ifdef PROBE_DUP_CSTAT
            launder(F); rowstat_pass(F, F.gw, F.NGW, NTOK); cstat_phase(F);
#endif
        }
        SEAM(pb + 1);
        if ((PH_MASK & (2 << 2)) && IN(pb + 2)) {
            bf16_t* H = (bf16_t*)(F.ws + WS_H);
            const EpiUQ Eq{(bf16_t*)(F.ws + WS_QB), (const float*)(F.ws + WS_RSTD), (const float2*)(F.ws + WS_ROPE32)};
#if OPT_GEMM
            og_phase(F, H + HC_CQ_LAT, HP, (const bf16_t*)(F.ws + WS_WUQ) + (size_t)layer * 768 * 256, NTOK, 768, 256, Eq);
            launder(F);
#else
            sg_phase(F, H + HC_CQ_LAT, HP, (const bf16_t*)(F.ws + WS_WUQ) + (size_t)layer * 768 * 256, 256, NTOK, 768, 256, Eq);
#endif
            const EpiUKV Ek{(bf16_t*)(F.ws + WS_KVB), (const float*)(F.ws + WS_RSTD)};
#if OPT_GEMM
            og_phase(F, H + HC_CKV, HP, (const bf16_t*)(F.ws + WS_WUKV) + (size_t)layer * 768 * 256, NTOK, 768, 256, Ek);
#ifdef PROBE_DUP_UP
            launder(F); og_phase(F, H + HC_CQ_LAT, HP, (const bf16_t*)(F.ws + WS_WUQ) + (size_t)layer * 768 * 256, NTOK, 768, 256, Eq);
            launder(F); og_phase(F, H + HC_CKV, HP, (const bf16_t*)(F.ws + WS_WUKV) + (size_t)layer * 768 * 256, NTOK, 768, 256, Ek);
#endif
#else
            sg_phase(F, H + HC_CKV, HP, (const bf16_t*)(F.ws + WS_WUKV) + (size_t)layer * 768 * 256, 256, NTOK, 768, 256, Ek);
#endif
        }
        SEAM(pb + 2);
        if ((PH_MASK & (2 << 3)) && IN(pb + 3)) {
#if OPT_ATTN
            attn_ab_phase(F, args, layer); launder(F);
#ifdef PROBE_DUP_ATTN
            attn_ab_phase(F, args, layer, PROBE_DUP_ATTN); launder(F);
#endif
            sattn_phase(F, args, layer, 10);
#ifdef PROBE_DUP_CFIN
            launder(F); sattn_phase(F, args, layer, 10);
#endif
#else
            sattn_phase(F, args, layer, 0);
#endif
        }
        SEAM(pb + 3);
        if ((PH_MASK & (2 << 4)) && IN(pb + 4)) {
#ifdef PROBE_DUP_WOUT
            { const EpiRes E0{args.out, layer == 0 ? args.x_prompt : nullptr, args.x_sample, (float*)(F.ws + WS_H)};
              og_phase(F, (const bf16_t*)(F.ws + WS_MIX), DM, (const bf16_t*)(F.ws + WS_WOUT) + (size_t)layer * 1024 * 1024, NTOK, 1024, 1024, E0); launder(F); }
#endif
            const EpiRes E{args.out, layer == 0 ? args.x_prompt : nullptr, args.x_sample, args.out};
#if OPT_GEMM
            og_phase(F, (const bf16_t*)(F.ws + WS_MIX), DM, (const bf16_t*)(F.ws + WS_WOUT) + (size_t)layer * 1024 * 1024, NTOK, 1024, 1024, E);
#else
            sg_phase(F, (const bf16_t*)(F.ws + WS_MIX), DM, (const bf16_t*)(F.ws + WS_WOUT) + (size_t)layer * 1024 * 1024, 1024, NTOK, 1024, 1024, E);
#endif
        }
        SEAM(pb + 4);
        if ((PH_MASK & (2 << 5)) && IN(pb + 5)) {
#ifdef PROBE_DUP_LN1
#endif
            ln1_route_pass(F, args, layer, F.gw, F.NGW, NTOK); moe_convert(F, args, layer);
#ifdef PROBE_DUP_CONV
            launder(F); moe_convert(F, args, layer);
#endif
        }
        SEAM(pb + 5);
#if OPT_GEMM
        if ((PH_MASK & (2 << 6)) && IN(pb + 6)) { moe_up_opt(F, layer);
#ifdef PROBE_DUP_MOE
            launder(F); moe_up_opt(F, layer);
#endif
        }
#else
        if ((PH_MASK & (2 << 6)) && IN(pb + 6)) { moe_up_simple(F, layer); }
#endif
        SEAM(pb + 6);
#if OPT_GEMM
        if ((PH_MASK & (2 << 7)) && IN(pb + 7)) { moe_down_opt(F, layer);
#ifdef PROBE_DUP_MOE
            launder(F); moe_down_opt(F, layer);
#endif
        }
#else
        if ((PH_MASK & (2 << 7)) && IN(pb + 7)) { moe_down_simple(F, layer); }
#endif
        SEAM(pb + 7);
        if ((PH_MASK & (2 << 8)) && IN(pb + 8)) { ln2_pass(F, args, layer, F.gw, F.NGW, NTOK); }
        SEAM(pb + 8);
    }
#endif
#undef IN
#undef SEAM
}

extern "C" void kernel_launch(void* const* d_in, const int* in_sizes, int n_in, void* d_out, int out_size, void* d_ws, size_t ws_size, hipStream_t stream) {
    static int grid = 0;
    if (grid == 0) {
        if (n_in != 19 || out_size != NTOK * DM || ws_size < WS_END) { fprintf(stderr, "kernel_launch: unexpected shapes (n_in %d out %d ws %zu)\n", n_in, out_size, ws_size); grid = -1; return; }
        int dev = 0, cus = 0, per_cu = 0;
        if (hipGetDevice(&dev) != hipSuccess || hipDeviceGetAttribute(&cus, hipDeviceAttributeMultiprocessorCount, dev) != hipSuccess) { grid = -1; return; }
        if (hipFuncSetAttribute((const void*)fwd, hipFuncAttributeMaxDynamicSharedMemorySize, LDS_BYTES) != hipSuccess) { grid = -1; return; }
        if (hipOccupancyMaxActiveBlocksPerMultiprocessor(&per_cu, (const void*)fwd, NTHREADS, LDS_BYTES) != hipSuccess || per_cu < 1) { fprintf(stderr, "kernel_launch: occupancy query says %d\n", per_cu); }
        (void)hipGetLastError();
        grid = cus;
    }
    if (grid < 0) return;
    if (hipMemsetAsync((char*)d_ws + WS_CTL, 0, CTL_ZERO_BYTES, stream) != hipSuccess) return;
    Args a{};
    a.x_prompt = (const float*)d_in[0]; a.x_sample = (const float*)d_in[1]; a.w_in = (const float*)d_in[2]; a.diff_lambda = (const float*)d_in[3]; a.diff_subln = (const float*)d_in[4];
    a.mla_q_norm = (const float*)d_in[5]; a.mla_w_uq = (const float*)d_in[6]; a.mla_kv_norm = (const float*)d_in[7]; a.mla_w_ukv = (const float*)d_in[8]; a.w_out = (const float*)d_in[9];
    a.ln1_g = (const float*)d_in[10]; a.ln1_b = (const float*)d_in[11]; a.moe_w_coarse = (const float*)d_in[12]; a.moe_w_fine = (const float*)d_in[13];
    a.moe_w1 = (const float*)d_in[14]; a.moe_w3 = (const float*)d_in[15]; a.moe_w2 = (const float*)d_in[16]; a.ln2_g = (const float*)d_in[17]; a.ln2_b = (const float*)d_in[18];
    a.out = (float*)d_out; a.ws = (unsigned char*)d_ws; a.pad = 0;
#if MK_ONE_LAUNCH
    a.ph_lo = 0; a.ph_hi = N_PHASES; a.use_bar = 1;
    hipLaunchKernelGGL(fwd, dim3(grid), dim3(NTHREADS), LDS_BYTES, stream, a);
#else
    for (int p = 0; p < N_PHASES; ++p) { a.ph_lo = p; a.ph_hi = p + 1; a.use_bar = 0; hipLaunchKernelGGL(fwd, dim3(grid), dim3(NTHREADS), LDS_BYTES, stream, a); }
#endif
}
```

```cpp
#include <hip/hip_runtime.h>
#include <cstdio>
#include <cstdint>

#ifndef OPT_ATTN
#define OPT_ATTN 1
#endif
#ifndef OPT_GEMM
#define OPT_GEMM 1
#endif
#ifndef MK_ONE_LAUNCH
#define MK_ONE_LAUNCH 1
#endif

#define GAS __attribute__((address_space(1)))
#define LAS __attribute__((address_space(3)))
typedef unsigned short bf16_t;
typedef short bf16x8 __attribute__((ext_vector_type(8)));
typedef float f32x4 __attribute__((ext_vector_type(4)));
typedef float f32x2 __attribute__((ext_vector_type(2)));
typedef float f32x16 __attribute__((ext_vector_type(16)));
typedef unsigned u32x4 __attribute__((ext_vector_type(4)));
typedef unsigned u32x2 __attribute__((ext_vector_type(2)));
typedef GAS unsigned gu32;
#define RLX_AGENT __ATOMIC_RELAXED, __HIP_MEMORY_SCOPE_AGENT
#define LDS_WAIT() asm volatile("s_waitcnt lgkmcnt(0)" ::: "memory")
#define VM_WAIT() asm volatile("s_waitcnt vmcnt(0)" ::: "memory")
#define MFMA32(a, b, c) __builtin_amdgcn_mfma_f32_32x32x16_bf16(a, b, c, 0, 0, 0)
#define MFMA16(a, b, c) __builtin_amdgcn_mfma_f32_16x16x32_bf16(a, b, c, 0, 0, 0)

__device__ __forceinline__ unsigned f2bf(float f) { unsigned u = __builtin_bit_cast(unsigned, f); return (u + 0x7fffu + ((u >> 16) & 1u)) >> 16; }
__device__ __forceinline__ unsigned pk2(float lo, float hi) { typedef float f2_ __attribute__((ext_vector_type(2))); typedef __bf16 b2_ __attribute__((ext_vector_type(2))); f2_ v = {lo, hi}; b2_ b = __builtin_convertvector(v, b2_); return __builtin_bit_cast(unsigned, b); }
__device__ __forceinline__ float bf2f(unsigned short b) { return __builtin_bit_cast(float, (unsigned)b << 16); }
__device__ __forceinline__ int crow(int r, int hi) { return (r & 3) + 8 * (r >> 2) + 4 * hi; }
template <int K> __device__ __forceinline__ float shx(float v) { static_assert(K < 32, "xor 32: use xsum32 / xmax32 / xpair32"); return __uint_as_float((unsigned)__builtin_amdgcn_ds_swizzle((int)__float_as_uint(v), (K << 10) | 0x1f)); }
__device__ __forceinline__ float xsum32(float v) { auto rr = __builtin_amdgcn_permlane32_swap(__float_as_uint(v), __float_as_uint(v), false, false); return __uint_as_float(rr[0]) + __uint_as_float(rr[1]); }
__device__ __forceinline__ float xmax32(float v) { auto rr = __builtin_amdgcn_permlane32_swap(__float_as_uint(v), __float_as_uint(v), false, false); return fmaxf(__uint_as_float(rr[0]), __uint_as_float(rr[1])); }
__device__ __forceinline__ float xpair32(float lo, float hi) { auto rr = __builtin_amdgcn_permlane32_swap(__float_as_uint(lo), __float_as_uint(hi), false, false); return __uint_as_float(rr[0]) + __uint_as_float(rr[1]); }
__device__ __forceinline__ float wave_sum(float v) {
    v += shx<1>(v); v += shx<2>(v); v += shx<4>(v); v += shx<8>(v); v += shx<16>(v);
    return xsum32(v);
}
__device__ __forceinline__ float fast_exp2(float x) { return __builtin_amdgcn_exp2f(x); }

constexpr int NTOK = 65536, DM = 1024, DEPTH = 4;
constexpr int NTOK_P = 32768;
constexpr int HP = 2560;
constexpr int HC_AQ = 0, HC_AK = 256, HC_AV = 512, HC_CQ_LAT = 768, HC_CKV = 1024, HC_KROPE = 1152, HC_CQ = 1280, HC_CK = 1664, HC_CV = 2048;
constexpr int QBP = 768, KVP = 768;
constexpr int MIX_A = 0, MIX_B = 256, MIX_C = 640;
constexpr int NEXP = 32, DEXP = 512;
constexpr float LOG2E = 1.4426950408889634f;
constexpr float SC_A = 0.17677669529663687f * LOG2E;
constexpr float SC_B = 0.10206207261596575f * LOG2E;
constexpr float SC_C = 0.125f * LOG2E;
constexpr float DN_ALPHA = 1.681792830507429f;
constexpr float LN_EPS = 1e-5f, RMS_EPS = 1e-6f;

constexpr size_t MiB = 1u << 20;
constexpr size_t WS_CTL = 0, CTL_ZERO_BYTES = 64 * 1024;
constexpr size_t WS_ROPE32 = 4 * MiB;
constexpr size_t WS_ROPE64 = 5 * MiB;
constexpr size_t WS_WIN = 8 * MiB;
constexpr size_t WS_WOUT = 28 * MiB;
constexpr size_t WS_WUQ = 36 * MiB;
constexpr size_t WS_WUKV = 38 * MiB;
constexpr size_t WS_W13 = 40 * MiB;
constexpr size_t WS_W2 = 104 * MiB;
constexpr size_t WS_XB = 136 * MiB;
constexpr size_t WS_H = 264 * MiB;
constexpr size_t WS_QB = 584 * MiB;
constexpr size_t WS_KVB = 680 * MiB;
constexpr size_t WS_MIX = 776 * MiB;
constexpr size_t WS_RSTD = 904 * MiB;
constexpr size_t WS_LSEC = 905 * MiB;
constexpr size_t WS_TW = 907 * MiB;
constexpr size_t WS_LIST = 908 * MiB;
constexpr size_t WS_LW = 924 * MiB;
constexpr size_t WS_END = 940 * MiB;
constexpr size_t WS_HID = WS_H;
constexpr size_t WS_YB = WS_H + 136 * MiB;
static_assert(WS_YB + 256 * MiB <= WS_KVB + 96 * MiB, "YB overlay");
constexpr int LIST_CAP = 131072;
constexpr int CW_TMO = 0;
constexpr int CW_CNT = 64;
constexpr int CW_BAR = 4096;

constexpr int RING_BYTES = 131072;
constexpr int MISC_OFF = RING_BYTES + 320;
constexpr int LDS_BYTES = 147456;
constexpr int NWAVES = 8, NTHREADS = 512;

#define XB_TMO      128
#define XB_XCNT(j)  (256  + 64 * (j))
#define XB_XSUB(j)  (1280 + 64 * (j))
#define XB_XGEN(j)  (2304 + 64 * (j))
#define XB_TOP      3328
#define XB_TOPGEN   3392
#define XCD_BAR_WORDS 3456
#define XB_SPIN_CAP (1u << 22)
__device__ __forceinline__ unsigned xb_ld(unsigned* p)              { return __hip_atomic_load(p, __ATOMIC_RELAXED, __HIP_MEMORY_SCOPE_AGENT); }
__device__ __forceinline__ unsigned xb_add(unsigned* p, unsigned v) { return __hip_atomic_fetch_add(p, v, __ATOMIC_RELAXED, __HIP_MEMORY_SCOPE_AGENT); }
__device__ __forceinline__ unsigned xb_xcc_id() { return (unsigned)__builtin_amdgcn_s_getreg((3 << 11) | 20) & 0xFu; }
#define XB_SPIN(cond, bar) do { unsigned _sp = 0; while (cond) { __builtin_amdgcn_s_sleep(1); \
    if ((++_sp & 255u) == 0u) { if (xb_ld(&(bar)[XB_TMO])) break; if (_sp > XB_SPIN_CAP) { atomicAdd(&(bar)[XB_TMO], 1u); break; } } } } while (0)
struct XcdBarrier { unsigned* bar; unsigned x; volatile LAS unsigned* st; };
__device__ __forceinline__ XcdBarrier xcd_barrier_post(unsigned* bar, volatile LAS unsigned* st) {
    XcdBarrier b; b.bar = bar; b.x = xb_xcc_id(); b.st = st;
    if (threadIdx.x == 0) (void)xb_add(&bar[XB_XCNT(b.x)], 1u);
    return b;
}
__device__ __forceinline__ void xcd_barrier_complete(unsigned* bar, unsigned x, unsigned& nloc, unsigned& nx) {
    const unsigned G = gridDim.x * gridDim.y * gridDim.z;
    unsigned sum, cnt, mine, sp = 0u;
    for (;;) {
        sum = 0u; cnt = 0u; mine = 0u;
#pragma unroll
        for (unsigned j = 0; j < 16; ++j) { const unsigned c = xb_ld(&bar[XB_XCNT(j)]); sum += c; cnt += (c > 0u) ? 1u : 0u; mine = (j == x) ? c : mine; }
        if (sum == G) break;
        __builtin_amdgcn_s_sleep(1);
        if ((++sp & 255u) == 0u) { if (xb_ld(&bar[XB_TMO])) break; if (sp > XB_SPIN_CAP) { atomicAdd(&bar[XB_TMO], 1u); break; } }
    }
    nloc = mine > 0u ? mine : 1u; nx = cnt > 0u ? cnt : 1u;
}
__device__ __forceinline__ void xcd_barrier(const XcdBarrier& b) {
    asm volatile("s_waitcnt vmcnt(0)" ::: "memory");
    __syncthreads();
    if (threadIdx.x == 0) {
        unsigned* bar = b.bar;
        __builtin_amdgcn_s_waitcnt(0);
        unsigned nloc = b.st[0], nx = b.st[1];
        if (nloc == 0u) { xcd_barrier_complete(bar, b.x, nloc, nx); b.st[0] = nloc; b.st[1] = nx; }
        const unsigned old = xb_add(&bar[XB_XSUB(b.x)], 1u);
        const unsigned gen = old / nloc;
        if (old + 1u == (gen + 1u) * nloc) {
            __builtin_amdgcn_fence(__ATOMIC_RELEASE, "agent");
            asm volatile("s_waitcnt vmcnt(0)" ::: "memory");
            const unsigned og = xb_add(&bar[XB_TOP], 1u);
            const unsigned tg = og / nx;
            if (og + 1u == (tg + 1u) * nx) xb_add(&bar[XB_TOPGEN], 1u);
            else XB_SPIN(xb_ld(&bar[XB_TOPGEN]) == tg, bar);
            __builtin_amdgcn_fence(__ATOMIC_ACQUIRE, "agent");
            xb_add(&bar[XB_XGEN(b.x)], 1u);
            asm volatile("s_waitcnt vmcnt(0)" ::: "memory");
        } else {
            XB_SPIN(xb_ld(&bar[XB_XGEN(b.x)]) == gen, bar);
            __builtin_amdgcn_fence(__ATOMIC_ACQUIRE, "agent");
            asm volatile("s_waitcnt vmcnt(0)" ::: "memory");
        }
    }
    __syncthreads();
}

struct Args {
    const float* x_prompt; const float* x_sample; const float* w_in; const float* diff_lambda; const float* diff_subln; const float* mla_q_norm; const float* mla_w_uq;
    const float* mla_kv_norm; const float* mla_w_ukv; const float* w_out; const float* ln1_g; const float* ln1_b; const float* moe_w_coarse; const float* moe_w_fine;
    const float* moe_w1; const float* moe_w3; const float* moe_w2; const float* ln2_g; const float* ln2_b;
    float* out; unsigned char* ws; int ph_lo, ph_hi, use_bar, pad;
};
struct Frame {
    LAS unsigned char* lds; unsigned char* ldsg;
    int tid, lane, wave, G, gw, NGW, bid;
    gu32* ctl; unsigned char* ws;
};
__device__ __forceinline__ void launder(Frame& F) {
    int wv = F.wave; asm volatile("" : "+s"(wv)); F.wave = wv;
    int t; asm volatile("v_mbcnt_lo_u32_b32 %0, -1, 0\n\tv_mbcnt_hi_u32_b32 %0, -1, %0" : "=v"(t)); F.lane = t; F.tid = wv * 64 + t;
    int b = (int)blockIdx.x; asm volatile("" : "+s"(b)); F.bid = b; F.gw = b * NWAVES + F.wave;
    unsigned char* w = F.ws; asm volatile("" : "+s"(w)); F.ws = w; F.ctl = (gu32*)(w + WS_CTL);
}
struct SeqInfo { int base, len, pos; };
__device__ __forceinline__ SeqInfo seqinfo(int m) { SeqInfo s; if (m < NTOK_P) { s.base = m & ~2047; s.len = 2048; } else { s.base = m & ~4095; s.len = 4096; } s.pos = m - s.base; return s; }

template <class ColMap>
__device__ __forceinline__ void transpose_item(const float* W, int N, bf16_t* WT, int ldd, LAS float* scr, int k0, int n0, const ColMap& cm, const float* kscale, int lane) {
    const int sc = cm(n0 + (lane & 31));
#pragma unroll 8
    for (int i = 0; i < 32; ++i) { const int kk = 2 * i + (lane >> 5); float v = 0.f; if (sc >= 0) { v = W[(size_t)(k0 + kk) * N + sc]; if (kscale) v *= kscale[k0 + kk]; } scr[kk * 33 + (lane & 31)] = v; }
    LDS_WAIT(); asm volatile("" ::: "memory");
    const int c = lane & 7;
#pragma unroll
    for (int j = 0; j < 4; ++j) { const int n = (lane >> 3) + 8 * j; const LAS float* s = scr + (8 * c) * 33 + n;
        u32x4 o; o.x = pk2(s[0 * 33], s[1 * 33]); o.y = pk2(s[2 * 33], s[3 * 33]); o.z = pk2(s[4 * 33], s[5 * 33]); o.w = pk2(s[6 * 33], s[7 * 33]);
        *(u32x4*)(WT + (size_t)(n0 + n) * ldd + k0 + 8 * c) = o; }
    LDS_WAIT(); asm volatile("" ::: "memory");
}
__device__ __forceinline__ void transpose_item_v4(const float* Wsrc, int N, bf16_t* WTdst, int ldd, LAS float* scr, int lane) {
    const int c4 = (lane & 7) * 4, kr = lane >> 3;
    f32x4 t[8];
#pragma unroll
    for (int i = 0; i < 8; ++i) t[i] = *(const f32x4*)(Wsrc + (size_t)(i * 8 + kr) * N + c4);
#pragma unroll
    for (int i = 0; i < 8; ++i) { const int kk = i * 8 + kr; scr[(c4 + 0) * 65 + kk] = t[i].x; scr[(c4 + 1) * 65 + kk] = t[i].y; scr[(c4 + 2) * 65 + kk] = t[i].z; scr[(c4 + 3) * 65 + kk] = t[i].w; }
    LDS_WAIT(); asm volatile("" ::: "memory");
    const int c = lane & 7;
#pragma unroll
    for (int j = 0; j < 4; ++j) { const int n = (lane >> 3) + 8 * j; const LAS float* p = scr + n * 65 + 8 * c;
        u32x4 o; o.x = pk2(p[0], p[1]); o.y = pk2(p[2], p[3]); o.z = pk2(p[4], p[5]); o.w = pk2(p[6], p[7]);
        *(u32x4*)(WTdst + (size_t)n * ldd + 8 * c) = o; }
    LDS_WAIT(); asm volatile("" ::: "memory");
}
struct WinMap {
    __device__ __forceinline__ int operator()(int n) const {
        if (n < 512) { const int t = n & 31; return (n & ~31) + (t >> 1) + 16 * (t & 1); }
        if (n < 1152) return n;
        if (n < 1184) { const int t = n - 1152; return 1152 + (t >> 1) + 16 * (t & 1); }
        if (n < 1280) return -1;
        if (n < 2048) { const int u = n - 1280, t = u & 63; return 1184 + (u & ~63) + (t >> 1) + 32 * (t & 1); }
        if (n < 2432) return 1952 + (n - 2048);
        return -1;
    }
};
struct UqMap { __device__ __forceinline__ int operator()(int n) const { if (n >= 576) return -1; const int h = n / 96, t = n - 96 * h; if (t < 64) return n; const int u = t - 64; return 96 * h + 64 + (u >> 1) + 16 * (u & 1); } };
struct IdMap { __device__ __forceinline__ int operator()(int n) const { return n; } };
struct W13Map { __device__ __forceinline__ int operator()(int n) const { return (n >> 8) * 128 + (n & 127); } };

__device__ __forceinline__ void p0_prologue(Frame& F, const Args& a) {
    LAS float* scr = (LAS float*)(F.lds + F.wave * 16384);
    { float2* r32 = (float2*)(F.ws + WS_ROPE32); float2* r64 = (float2*)(F.ws + WS_ROPE64);
      for (int i = F.gw * 64 + F.lane; i < 4096 * 16; i += F.NGW * 64) { const int pos = i >> 4, j = i & 15; const float inv = 1.0f / powf(10000.0f, (float)(2 * j) / 32.0f); const float ang = (float)pos * inv; r32[i] = make_float2(cosf(ang), sinf(ang)); }
      for (int i = F.gw * 64 + F.lane; i < 4096 * 32; i += F.NGW * 64) { const int pos = i >> 5, j = i & 31; const float inv = 1.0f / powf(10000.0f, (float)(2 * j) / 64.0f); const float ang = (float)pos * inv; r64[i] = make_float2(cosf(ang), sinf(ang)); } }
    constexpr int I_WIN = (1024 / 64) * (2560 / 32), I_WOUT = (1024 / 64) * (1024 / 32), I_UQ = (256 / 64) * (768 / 32), I_UKV = (256 / 64) * (768 / 32);
    constexpr int PER_L = I_WIN + I_WOUT + I_UQ + I_UKV;
    for (int it = F.gw; it < DEPTH * PER_L; it += F.NGW) {
        const int l = it / PER_L; int r = it - l * PER_L;
        if (r < I_WIN) { const int kb = r / 80, nb = r % 80; transpose_item(a.w_in + (size_t)l * 1024 * 2336, 2336, (bf16_t*)(F.ws + WS_WIN) + (size_t)l * 2560 * 1024, 1024, scr, kb * 64, nb * 32, WinMap(), nullptr, F.lane); continue; } r -= I_WIN;
        if (r < I_WOUT) { const int kb = r / 32, nb = r % 32; transpose_item(a.w_out + (size_t)l * 1024 * 1024, 1024, (bf16_t*)(F.ws + WS_WOUT) + (size_t)l * 1024 * 1024, 1024, scr, kb * 64, nb * 32, IdMap(), nullptr, F.lane); continue; } r -= I_WOUT;
        if (r < I_UQ) { const int kb = r / 24, nb = r % 24; transpose_item(a.mla_w_uq + (size_t)l * 256 * 576, 576, (bf16_t*)(F.ws + WS_WUQ) + (size_t)l * 768 * 256, 256, scr, kb * 64, nb * 32, UqMap(), a.mla_q_norm + l * 256, F.lane); continue; } r -= I_UQ;
        { const int kb = r / 24, nb = r % 24; bf16_t* dst = (bf16_t*)(F.ws + WS_WUKV) + (size_t)l * 768 * 256;
          if (kb < 2) transpose_item(a.mla_w_ukv + (size_t)l * 128 * 768, 768, dst, 256, scr, kb * 64, nb * 32, IdMap(), a.mla_kv_norm + l * 128, F.lane);
          else { const int c = F.lane & 7;
#pragma unroll
              for (int j = 0; j < 4; ++j) { const int n = (F.lane >> 3) + 8 * j; *(u32x4*)(dst + (size_t)(nb * 32 + n) * 256 + kb * 64 + 8 * c) = (u32x4){0u, 0u, 0u, 0u}; } } }
    }
    bf16_t* XB = (bf16_t*)(F.ws + WS_XB);
    for (int m = F.gw; m < NTOK; m += F.NGW) {
        const float* src = (m < NTOK_P) ? a.x_prompt + (size_t)m * DM : a.x_sample + (size_t)(m - NTOK_P) * DM;
#pragma unroll
        for (int j = 0; j < 4; ++j) { const f32x4 v = *((const f32x4*)src + F.lane + 64 * j);
            u32x2 w; w.x = pk2(v.x, v.y); w.y = pk2(v.z, v.w); *((u32x2*)(XB + (size_t)m * DM) + F.lane + 64 * j) = w; }
    }
}

template <class Epi, class RowMap>
__device__ __forceinline__ void sg_tile(const bf16_t* A, int lda, const bf16_t* B0, const bf16_t* B1, int ldb, int K, int m0, int c0, const Epi& E, const RowMap& RM, int lane) {
    const int r32 = lane & 31, hi = lane >> 5;
    const bf16_t* ap = A + (size_t)RM.src(m0 + r32) * lda + 8 * hi;
    const bf16_t* b0p = B0 + (size_t)r32 * ldb + 8 * hi;
    const bf16_t* b1p = B1 + (size_t)r32 * ldb + 8 * hi;
    f32x16 acc0 = {}, acc1 = {};
#pragma unroll 4
    for (int k = 0; k < K; k += 16) {
        const bf16x8 af = *(const bf16x8*)(ap + k), bf0 = *(const bf16x8*)(b0p + k), bf1 = *(const bf16x8*)(b1p + k);
        acc0 = MFMA32(bf0, af, acc0); acc1 = MFMA32(bf1, af, acc1);
    }
#pragma unroll
    for (int g = 0; g < 4; ++g) { const f32x4 v0 = {acc0[4 * g], acc0[4 * g + 1], acc0[4 * g + 2], acc0[4 * g + 3]}, v1 = {acc1[4 * g], acc1[4 * g + 1], acc1[4 * g + 2], acc1[4 * g + 3]};
        E.put(m0 + r32, c0, 8 * g + 4 * hi, v0, v1); }
}
struct IdRows { __device__ __forceinline__ int src(int m) const { return m; } };

__device__ __forceinline__ void store_bf8(bf16_t* p, f32x4 a, f32x4 b) { u32x4 w; w.x = pk2(a.x, a.y); w.y = pk2(a.z, a.w); w.z = pk2(b.x, b.y); w.w = pk2(b.z, b.w); *(u32x4*)p = w; }
__device__ __forceinline__ void store_bf4(bf16_t* p, f32x4 v) { u32x2 w; w.x = pk2(v.x, v.y); w.y = pk2(v.z, v.w); *(u32x2*)p = w; }
struct EpiH {
    static constexpr bool INPLACE = false;
    static constexpr bool PERM = true;
    bf16_t* H; const float2* rope32; const float2* rope64;
    __device__ __forceinline__ f32x4 xf(int pos, int col, f32x4 v) const {
        if (col < 512 || (col >= HC_KROPE && col < HC_KROPE + 32)) {
            const int j0 = (col & 31) >> 1; const f32x4 cs = *(const f32x4*)(rope32 + pos * 16 + j0);
            f32x4 o; o.x = v.x * cs.x - v.y * cs.y; o.y = v.x * cs.y + v.y * cs.x; o.z = v.z * cs.z - v.w * cs.w; o.w = v.z * cs.w + v.w * cs.z;
            if (col < 256) o = o * SC_A; v = o;
        } else if (col >= HC_CQ && col < HC_CV) {
            const int j0 = ((col - HC_CQ) & 63) >> 1; const f32x4 cs = *(const f32x4*)(rope64 + pos * 32 + j0);
            f32x4 o; o.x = v.x * cs.x - v.y * cs.y; o.y = v.x * cs.y + v.y * cs.x; o.z = v.z * cs.z - v.w * cs.w; o.w = v.z * cs.w + v.w * cs.z;
            if (col < HC_CK) o = o * SC_C; v = o;
        }
        return v;
    }
    __device__ __forceinline__ void put4(int row, int col, f32x4 v) const { store_bf4(H + (size_t)row * HP + col, xf(seqinfo(row).pos, col, v)); }
    __device__ __forceinline__ void put(int row, int c0, int cc, f32x4 v0, f32x4 v1) const { put4(row, c0 + cc, v0); put4(row, c0 + 32 + cc, v1); }
    template <class U> __device__ __forceinline__ void put8(const U&, int row, int col, f32x4 v0, f32x4 v1) const { const int pos = seqinfo(row).pos; store_bf8(H + (size_t)row * HP + col, xf(pos, col, v0), xf(pos, col + 4, v1)); }
    struct Pre { f32x4 c0, c1; };
    __device__ __forceinline__ static f32x4 rot(f32x4 v, f32x4 cs) { f32x4 o; o.x = v.x * cs.x - v.y * cs.y; o.y = v.x * cs.y + v.y * cs.x; o.z = v.z * cs.z - v.w * cs.w; o.w = v.z * cs.w + v.w * cs.z; return o; }
    template <class U> __device__ __forceinline__ Pre pre(const U&, int row, int col) const { Pre p; p.c0 = (f32x4){0.f, 0.f, 0.f, 0.f}; p.c1 = p.c0; const int pos = seqinfo(row).pos;
        if (col < 512 || (col >= HC_KROPE && col < HC_KROPE + 32)) { const f32x4* t = (const f32x4*)(rope32 + pos * 16 + ((col & 31) >> 1)); p.c0 = t[0]; p.c1 = t[1]; }
        else if (col >= HC_CQ && col < HC_CV) { const f32x4* t = (const f32x4*)(rope64 + pos * 32 + (((col - HC_CQ) & 63) >> 1)); p.c0 = t[0]; p.c1 = t[1]; }
        return p; }
    template <class U> __device__ __forceinline__ void fin8(const U&, int row, int col, f32x4 v0, f32x4 v1, const Pre& p) const {
        if (col < 512 || (col >= HC_KROPE && col < HC_KROPE + 32)) { v0 = rot(v0, p.c0); v1 = rot(v1, p.c1); if (col < 256) { v0 = v0 * SC_A; v1 = v1 * SC_A; } }
        else if (col >= HC_CQ && col < HC_CV) { v0 = rot(v0, p.c0); v1 = rot(v1, p.c1); if (col < HC_CK) { v0 = v0 * SC_C; v1 = v1 * SC_C; } }
        store_bf8(H + (size_t)row * HP + col, v0, v1); }
};
struct EpiUQ {
    static constexpr bool INPLACE = false;
    static constexpr bool PERM = true;
    bf16_t* Q; const float* rstd; const float2* rope32;
    __device__ __forceinline__ f32x4 xf(int row, int col, f32x4 v, float rs) const {
        v = v * rs;
        const int t = col % 96;
        if (t >= 64) { const int pos = seqinfo(row).pos; const int j0 = (t - 64) >> 1; const f32x4 cs = *(const f32x4*)(rope32 + pos * 16 + j0);
            f32x4 o; o.x = v.x * cs.x - v.y * cs.y; o.y = v.x * cs.y + v.y * cs.x; o.z = v.z * cs.z - v.w * cs.w; o.w = v.z * cs.w + v.w * cs.z; v = o; }
        return v * SC_B;
    }
    __device__ __forceinline__ void put4(int row, int col, f32x4 v) const { if (col >= 576) return; store_bf4(Q + (size_t)row * QBP + col, xf(row, col, v, rstd[2 * row])); }
    template <class U> __device__ __forceinline__ void put8(const U&, int row, int col, f32x4 v0, f32x4 v1) const { if (col >= 576) return; const float rs = rstd[2 * row]; store_bf8(Q + (size_t)row * QBP + col, xf(row, col, v0, rs), xf(row, col + 4, v1, rs)); }
    __device__ __forceinline__ void put(int row, int c0, int cc, f32x4 v0, f32x4 v1) const { put4(row, c0 + cc, v0); put4(row, c0 + 32 + cc, v1); }
    struct Pre { float rs; f32x4 c0, c1; };
    template <class U> __device__ __forceinline__ Pre pre(const U&, int row, int col) const { Pre p; p.rs = rstd[2 * row]; p.c0 = (f32x4){0.f, 0.f, 0.f, 0.f}; p.c1 = p.c0;
        if (col < 576 && (col % 96) >= 64) { const f32x4* t = (const f32x4*)(rope32 + seqinfo(row).pos * 16 + (((col % 96) - 64) >> 1)); p.c0 = t[0]; p.c1 = t[1]; }
        return p; }
    template <class U> __device__ __forceinline__ void fin8(const U&, int row, int col, f32x4 v0, f32x4 v1, const Pre& p) const { if (col >= 576) return;
        v0 = v0 * p.rs; v1 = v1 * p.rs; if ((col % 96) >= 64) { v0 = EpiH::rot(v0, p.c0); v1 = EpiH::rot(v1, p.c1); }
        store_bf8(Q + (size_t)row * QBP + col, v0 * SC_B, v1 * SC_B); }
};
struct EpiUKV {
    static constexpr bool INPLACE = false;
    static constexpr bool PERM = true;
    bf16_t* KV; const float* rstd;
    template <class U> __device__ __forceinline__ void put8(const U&, int row, int col, f32x4 v0, f32x4 v1) const { const float rs = rstd[2 * row + 1]; store_bf8(KV + (size_t)row * KVP + col, v0 * rs, v1 * rs); }
    __device__ __forceinline__ void put4(int row, int col, f32x4 v) const { store_bf4(KV + (size_t)row * KVP + col, v * rstd[2 * row + 1]); }
    __device__ __forceinline__ void put(int row, int c0, int cc, f32x4 v0, f32x4 v1) const { put4(row, c0 + cc, v0); put4(row, c0 + 32 + cc, v1); }
    struct Pre { float rs; };
    template <class U> __device__ __forceinline__ Pre pre(const U&, int row, int) const { Pre p; p.rs = rstd[2 * row + 1]; return p; }
    template <class U> __device__ __forceinline__ void fin8(const U&, int row, int col, f32x4 v0, f32x4 v1, const Pre& p) const { store_bf8(KV + (size_t)row * KVP + col, v0 * p.rs, v1 * p.rs); }
};
struct EpiRes {
    static constexpr bool INPLACE = false;
    static constexpr bool PERM = false;
    const bf16_t* XR; float* D;
    static __device__ __forceinline__ f32x4 up4(u32x2 w) { f32x4 r; r.x = bf2f(w.x & 0xffff); r.y = bf2f(w.x >> 16); r.z = bf2f(w.y & 0xffff); r.w = bf2f(w.y >> 16); return r; }
    template <class U> __device__ __forceinline__ void put4(const U&, int row, int col, f32x4 v) const { put4(row, col, v); }
    __device__ __forceinline__ void put4(int row, int col, f32x4 v) const {
        const f32x4 r = up4(*(const u32x2*)(XR + (size_t)row * DM + col));
        *(f32x4*)(D + (size_t)row * DM + col) = r * DN_ALPHA + v; }
    __device__ __forceinline__ void put(int row, int c0, int cc, f32x4 v0, f32x4 v1) const { put4(row, c0 + cc, v0); put4(row, c0 + 32 + cc, v1); }
    struct Pre { u32x2 a, b; };
    template <class U> __device__ __forceinline__ Pre pre(const U&, int row, int col) const { Pre p;
        const bf16_t* src = XR + (size_t)row * DM;
        p.a = *(const u32x2*)(src + col); p.b = *(const u32x2*)(src + col + 16); return p; }
    template <class U> __device__ __forceinline__ void fin4x2(const U&, int row, int col, f32x4 v0, f32x4 v1, const Pre& p) const {
        *(f32x4*)(D + (size_t)row * DM + col) = up4(p.a) * DN_ALPHA + v0; *(f32x4*)(D + (size_t)row * DM + col + 16) = up4(p.b) * DN_ALPHA + v1; }
};
__device__ __forceinline__ float silu_f(float x) { return x / (1.0f + __expf(-x)); }
struct EpiHid {
    static constexpr bool INPLACE = false;
    static constexpr bool PERM = true;
    bf16_t* HID;
    __device__ __forceinline__ f32x4 act(f32x4 g, f32x4 u) const { f32x4 o; o.x = silu_f(g.x) * u.x; o.y = silu_f(g.y) * u.y; o.z = silu_f(g.z) * u.z; o.w = silu_f(g.w) * u.w; return o; }
    template <class U> __device__ __forceinline__ void putp8(const U&, int row, int col, f32x4 g0, f32x4 g1, f32x4 u0, f32x4 u1) const { store_bf8(HID + (size_t)row * DEXP + col, act(g0, u0), act(g1, u1)); }
    __device__ __forceinline__ void putp(int row, int col, f32x4 g, f32x4 u) const { f32x4 o; o.x = silu_f(g.x) * u.x; o.y = silu_f(g.y) * u.y; o.z = silu_f(g.z) * u.z; o.w = silu_f(g.w) * u.w; store_bf4(HID + (size_t)row * DEXP + col, o); }
    __device__ __forceinline__ void put(int row, int c0, int cc, f32x4 v0, f32x4 v1) const { putp(row, c0 + cc, v0, v1); }
};
struct EpiY {
    static constexpr bool INPLACE = false;
    bf16_t* YB; const float* tw; const int* list; int seg0, cnt;
    __device__ __forceinline__ void put4(int row, int col, f32x4 v) const { const int r = row - seg0; if (r >= cnt) return; const int a = list[r]; store_bf4(YB + (size_t)a * DM + col, v * tw[a]); }
    __device__ __forceinline__ void put(int row, int c0, int cc, f32x4 v0, f32x4 v1) const { put4(row, c0 + cc, v0); put4(row, c0 + 32 + cc, v1); }
};

struct EpiYO {
    static constexpr bool INPLACE = false;
    static constexpr bool PERM = true;
    bf16_t* YB; const float* tw; const int* list; const LAS int* seg; const float* lw;
    template <class U> __device__ __forceinline__ void put8(const U& u, int row, int col, f32x4 v0, f32x4 v1) const {
        const int r = row - __builtin_amdgcn_readfirstlane(seg[u.e]); if (r >= __builtin_amdgcn_readfirstlane(seg[33 + u.e])) return; const int a = list[(size_t)u.e * LIST_CAP + r]; const float w = tw[a]; store_bf8(YB + (size_t)a * DM + col, v0 * w, v1 * w); }
    struct Pre { int a; float w; };
    template <class U> __device__ __forceinline__ Pre pre(const U& u, int row, int) const { Pre p; p.a = -1; p.w = 0.f;
        const int r = row - __builtin_amdgcn_readfirstlane(seg[u.e]); if (r < __builtin_amdgcn_readfirstlane(seg[33 + u.e])) { p.a = list[(size_t)u.e * LIST_CAP + r]; p.w = lw[(size_t)u.e * LIST_CAP + r]; } return p; }
    template <class U> __device__ __forceinline__ void fin8(const U&, int, int col, f32x4 v0, f32x4 v1, const Pre& p) const { if (p.a >= 0) store_bf8(YB + (size_t)p.a * DM + col, v0 * p.w, v1 * p.w); }
};
template <class Epi>
__device__ __forceinline__ void sg_phase(Frame& F, const bf16_t* A, int lda, const bf16_t* Bt, int ldb, int M, int N, int K, const Epi& E) {
    const int nN = N / 64, items = (M / 32) * nN;
    for (int it = F.gw; it < items; it += F.NGW) { const int mt = it / nN, nt = it - mt * nN;
        sg_tile(A, lda, Bt + (size_t)(nt * 64) * ldb, Bt + (size_t)(nt * 64 + 32) * ldb, ldb, K, mt * 32, nt * 64, E, IdRows(), F.lane); }
}


namespace pg8 {
constexpr int BM = 256, BK = 64, HALF = 128, HTB = HALF * BK * 2, NXCD = 8, WGM = 8;
__host__ __device__ __forceinline__ int lds_byte(int r, int c) { const int st = (r >> 4) * 2 + (c >> 5), rr = r & 15, cc = c & 31, ob = rr * 64 + cc * 2; return st * 1024 + (ob ^ (((ob >> 9) & 1) << 5)); }
__host__ __device__ __forceinline__ void stage_rc(int b, int& R, int& C) { const int st = b / 1024, sb = b % 1024, swz = sb ^ (((sb >> 9) & 1) << 5); R = (st >> 1) * 16 + swz / 64; C = (st & 1) * 32 + (swz % 64) / 2; }
__host__ __device__ __forceinline__ int perm32(int rho) { const int n = rho >> 4, i = rho & 15; return 8 * (i >> 2) + 4 * n + (i & 3); }
struct Unit { int pm, pn, e; const char* a; const char* b; };
__device__ __forceinline__ bool order_next(int i, int G, int c, int nM, int nN, int& pm, int& pn) {
    const int nwg = nM * nN; const long L = (long)i * G + c; if (L >= nwg) return false;
    int wgid = (int)L; { const int q = nwg / NXCD, r = nwg % NXCD, xcd = wgid % NXCD, off = wgid / NXCD; wgid = (xcd < r ? xcd * (q + 1) : r * (q + 1) + (xcd - r) * q) + off; }
    const int nig = WGM * nN, gid = wgid / nig, fm = gid * WGM, gsz = (nM - fm) < WGM ? (nM - fm) : WGM;
    pm = fm + ((wgid % nig) % gsz); pn = (wgid % nig) / gsz; return true;
}
struct DenseSched {
    const char* A; const char* Bt; int nM, nN, G, c; size_t tstepA, tstepB;
    __device__ __forceinline__ void init(const bf16_t* A_, int lda, const bf16_t* Bt_, int M, int N, int K, int G_, int c_) { A = (const char*)A_; Bt = (const char*)Bt_; nM = M / BM; nN = N / BM; G = G_; c = c_; tstepA = (size_t)BM * lda * 2; tstepB = (size_t)BM * K * 2; }
    __device__ __forceinline__ bool next(int i, Unit& u) const { if (!order_next(i, G, c, nM, nN, u.pm, u.pn)) return false; u.e = 0; u.a = A + (size_t)u.pm * tstepA; u.b = Bt + (size_t)u.pn * tstepB; return true; }
    __device__ __forceinline__ unsigned arow(const Unit&, int) const { return 0u; }
};
struct PanelSched {
    const char* A; const char* Bt; int pm, nN; size_t tstepB;
    __device__ __forceinline__ void init(const bf16_t* A_, int lda, const bf16_t* Bt_, int pm_, int N, int K) { pm = pm_; nN = N / BM; A = (const char*)A_ + (size_t)pm_ * BM * lda * 2; Bt = (const char*)Bt_; tstepB = (size_t)BM * K * 2; }
    __device__ __forceinline__ bool next(int i, Unit& u) const { if (i >= nN) return false; u.pm = pm; int pn = i + (pm % nN); if (pn >= nN) pn -= nN; u.pn = pn; u.e = 0; u.a = A; u.b = Bt + (size_t)pn * tstepB; return true; }
    __device__ __forceinline__ unsigned arow(const Unit&, int) const { return 0u; }
};
template <class Epi, bool PAIR> struct EpiApply;
template <class Epi, class Sched, bool GATHER, bool PAIR>
__device__ __forceinline__ void gemm_phase(LAS unsigned char* lds, int tid, int K, int lda, const Sched& S, const Epi& E) {
    const int wid = __builtin_amdgcn_readfirstlane(tid >> 6), lane = tid & 63, wr = wid >> 2, wc = wid & 3, fr = lane & 15, fq = lane >> 4;
    const int nt = K / BK;
    unsigned voffA[2], voffB[2]; int RA[2], CA[2];
#pragma unroll
    for (int i = 0; i < 2; ++i) { int R, C; stage_rc(tid * 16 + i * 8192, R, C); const int Rb = Epi::PERM ? ((R & ~31) + perm32(R & 31)) : R; RA[i] = R; CA[i] = C;
        voffA[i] = (unsigned)(R * lda + C) * 2u; voffB[i] = (unsigned)(Rb * K + C) * 2u; }
    const size_t kstep = (size_t)(BK * 2);
    const size_t hstepA = (size_t)HALF * lda * 2, hstepB = (size_t)HALF * K * 2;
    const unsigned ldsw = (unsigned)wid * 1024u;
    const int aoff = lds_byte(wr * 64 + fr, fq * 8), boff = lds_byte(wc * 32 + fr, fq * 8);
#define PG8_SA(b, h) (((b) * 2 + (h)) * HTB)
#define PG8_SB(b, h) ((4 + (b) * 2 + (h)) * HTB)
#define PG8_STAGE(bufoff, gbase, voff) do { _Pragma("unroll") for (int _i = 0; _i < 2; ++_i) \
        __builtin_amdgcn_global_load_lds((const unsigned*)((const char*)(gbase) + (voff)[_i]), (LAS unsigned*)(lds + (bufoff) + ldsw + _i * 8192), 16, 0, 0); } while (0)
#define PG8_STAGE_A(bufoff, ab, vg, h, koff) do { if (GATHER) { PG8_STAGE(bufoff, (ab) + (koff), (vg)[h]); } else { PG8_STAGE(bufoff, (ab) + (h) * hstepA + (koff), voffA); } } while (0)
#define PG8_LDA(dst, b, h) do { _Pragma("unroll") for (int m = 0; m < 4; ++m) _Pragma("unroll") for (int k = 0; k < 2; ++k) dst[m][k] = *(const LAS bf16x8*)(lds + PG8_SA(b, h) + aoff + m * 2048 + k * 1024); } while (0)
#define PG8_LDB(dst, b, h) do { _Pragma("unroll") for (int n = 0; n < 2; ++n) _Pragma("unroll") for (int k = 0; k < 2; ++k) dst[n][k] = *(const LAS bf16x8*)(lds + PG8_SB(b, h) + boff + n * 2048 + k * 1024); } while (0)
#define PG8_MMA(ai, bj, At, Bt) do { __builtin_amdgcn_s_setprio(1); _Pragma("unroll") for (int m = 0; m < 4; ++m) _Pragma("unroll") for (int n = 0; n < 2; ++n) _Pragma("unroll") for (int k = 0; k < 2; ++k) \
        acc[ai][bj][m][n] = __builtin_amdgcn_mfma_f32_16x16x32_bf16(Bt[n][k], At[m][k], acc[ai][bj][m][n], 0, 0, 0); __builtin_amdgcn_s_setprio(0); } while (0)
#define PG8_WAIT_V(n) asm volatile("s_waitcnt vmcnt(" #n ")" ::: "memory")
#define PG8_WAIT_L(n) asm volatile("s_waitcnt lgkmcnt(" #n ")" ::: "memory")
#define PG8_BAR __builtin_amdgcn_s_barrier()
#define PG8_SCHED __builtin_amdgcn_sched_barrier(0)
    Unit cur, nxt; int ui = 0;
    if (!S.next(0, cur)) return;
    f32x4 acc[2][2][4][2];
#pragma unroll
    for (int a = 0; a < 2; ++a)
#pragma unroll
        for (int b = 0; b < 2; ++b)
#pragma unroll
            for (int m = 0; m < 4; ++m)
#pragma unroll
                for (int n = 0; n < 2; ++n) acc[a][b][m][n] = (f32x4){0.f, 0.f, 0.f, 0.f};
    bf16x8 At[4][2], B0[2][2], B1[2][2];
    unsigned vgc[2][2] = {{0u, 0u}, {0u, 0u}}, vgn[2][2] = {{0u, 0u}, {0u, 0u}};
    if (GATHER) {
#pragma unroll
        for (int h = 0; h < 2; ++h)
#pragma unroll
            for (int i = 0; i < 2; ++i) vgc[h][i] = S.arow(cur, h * HALF + RA[i]) * (unsigned)(lda * 2) + (unsigned)CA[i] * 2u;
    }
    const char* cA = cur.a; const char* cB = cur.b;
    PG8_STAGE(PG8_SB(0, 0), cB, voffB); PG8_STAGE(PG8_SB(0, 1), cB + hstepB, voffB); PG8_STAGE_A(PG8_SA(0, 0), cA, vgc, 0, 0); PG8_STAGE_A(PG8_SA(0, 1), cA, vgc, 1, 0);
    if (wr == 1) PG8_BAR;
    PG8_WAIT_V(2); PG8_BAR;
    PG8_STAGE(PG8_SB(1, 0), cB + kstep, voffB); PG8_STAGE_A(PG8_SA(1, 0), cA, vgc, 0, kstep); PG8_STAGE(PG8_SB(1, 1), cB + hstepB + kstep, voffB);
    PG8_WAIT_V(6); PG8_BAR;
    for (;;) {
        const bool has_next = S.next(ui + 1, nxt);
        const char* nA = has_next ? nxt.a : cA; const char* nB = has_next ? nxt.b : cB;
        if (GATHER) {
#pragma unroll
            for (int h = 0; h < 2; ++h)
#pragma unroll
                for (int i = 0; i < 2; ++i) vgn[h][i] = has_next ? (S.arow(nxt, h * HALF + RA[i]) * (unsigned)(lda * 2) + (unsigned)CA[i] * 2u) : vgc[h][i];
        }
#pragma clang loop unroll(disable)
        for (int t = 0; t < nt; t += 2) {
            const bool last = (t == nt - 2);
            const size_t k1 = (size_t)(t + 1) * kstep;
            const char* a2 = last ? nA : cA; const char* b2 = last ? nB : cB + (size_t)(t + 2) * kstep; const size_t ka2 = last ? 0 : (size_t)(t + 2) * kstep;
            const char* b3 = b2 + kstep; const size_t ka3 = ka2 + kstep;
            unsigned v2[2][2];
#pragma unroll
            for (int h = 0; h < 2; ++h)
#pragma unroll
                for (int i = 0; i < 2; ++i) v2[h][i] = last ? vgn[h][i] : vgc[h][i];
            PG8_LDB(B0, 0, 0); PG8_LDB(B1, 0, 1); PG8_SCHED; PG8_LDA(At, 0, 0); PG8_STAGE_A(PG8_SA(1, 1), cA, vgc, 1, k1);
            PG8_WAIT_V(8); PG8_WAIT_L(0); PG8_BAR; PG8_MMA(0, 0, At, B0); PG8_MMA(0, 1, At, B1); PG8_BAR; PG8_SCHED;
            PG8_LDA(At, 0, 1); PG8_STAGE(PG8_SB(0, 0), b2, voffB); PG8_STAGE(PG8_SB(0, 1), b2 + hstepB, voffB); PG8_STAGE_A(PG8_SA(0, 0), a2, v2, 0, ka2);
            PG8_WAIT_V(8); PG8_WAIT_L(0); PG8_BAR; PG8_MMA(1, 0, At, B0); PG8_MMA(1, 1, At, B1); PG8_BAR; PG8_SCHED;
            PG8_LDB(B0, 1, 0); PG8_LDB(B1, 1, 1); PG8_SCHED; PG8_LDA(At, 1, 0); PG8_STAGE_A(PG8_SA(0, 1), a2, v2, 1, ka2);
            PG8_WAIT_V(8); PG8_WAIT_L(0); PG8_BAR; PG8_MMA(0, 0, At, B0); PG8_MMA(0, 1, At, B1); PG8_BAR; PG8_SCHED;
            PG8_LDA(At, 1, 1); PG8_STAGE(PG8_SB(1, 0), b3, voffB); PG8_STAGE(PG8_SB(1, 1), b3 + hstepB, voffB); PG8_STAGE_A(PG8_SA(1, 0), a2, v2, 0, ka3);
            PG8_WAIT_V(8); PG8_WAIT_L(0); PG8_BAR; PG8_MMA(1, 0, At, B0); PG8_MMA(1, 1, At, B1); PG8_BAR; PG8_SCHED;
        }
        if (wr == 0) PG8_BAR;
        { int fr_ = fr, fq_ = fq; asm volatile("" : "+v"(fr_), "+v"(fq_));
          EpiApply<Epi, PAIR>::run(E, acc, cur, wr, wc, fr_, fq_);
#ifdef PROBE_DUP_EPI
          if (!Epi::INPLACE) { asm volatile("" : "+v"(fr_), "+v"(fq_)); EpiApply<Epi, PAIR>::run(E, acc, cur, wr, wc, fr_, fq_); }
#endif
          }
        if (!has_next) break;
#pragma unroll
        for (int a = 0; a < 2; ++a)
#pragma unroll
            for (int b = 0; b < 2; ++b)
#pragma unroll
                for (int m = 0; m < 4; ++m)
#pragma unroll
                    for (int n = 0; n < 2; ++n) acc[a][b][m][n] = (f32x4){0.f, 0.f, 0.f, 0.f};
        cur = nxt; cA = nA; cB = nB; ++ui;
        if (GATHER) {
#pragma unroll
            for (int h = 0; h < 2; ++h)
#pragma unroll
                for (int i = 0; i < 2; ++i) vgc[h][i] = vgn[h][i];
        }
        if (wr == 1) PG8_BAR;
    }
    PG8_WAIT_V(0);
    PG8_BAR;
#undef PG8_SA
#undef PG8_SB
#undef PG8_STAGE
#undef PG8_STAGE_A
#undef PG8_LDA
#undef PG8_LDB
#undef PG8_MMA
#undef PG8_WAIT_V
#undef PG8_WAIT_L
#undef PG8_BAR
#undef PG8_SCHED
}
template <class Epi> struct EpiApply<Epi, false> {
    static __device__ __forceinline__ void run(const Epi& E, const f32x4 (&acc)[2][2][4][2], const Unit& u, int wr, int wc, int fr, int fq) {
#pragma unroll
        for (int ai = 0; ai < 2; ++ai) {
            typename Epi::Pre pre[4][2];
#pragma unroll
            for (int m = 0; m < 4; ++m) { const int row = u.pm * BM + ai * HALF + wr * 64 + m * 16 + fr;
#pragma unroll
                for (int bj = 0; bj < 2; ++bj) pre[m][bj] = E.pre(u, row, u.pn * BM + bj * HALF + wc * 32 + (Epi::PERM ? 8 : 4) * fq); }
#pragma unroll
            for (int m = 0; m < 4; ++m) { const int row = u.pm * BM + ai * HALF + wr * 64 + m * 16 + fr;
#pragma unroll
                for (int bj = 0; bj < 2; ++bj) {
                    if constexpr (Epi::PERM) E.fin8(u, row, u.pn * BM + bj * HALF + wc * 32 + 8 * fq, acc[ai][bj][m][0], acc[ai][bj][m][1], pre[m][bj]);
                    else E.fin4x2(u, row, u.pn * BM + bj * HALF + wc * 32 + 4 * fq, acc[ai][bj][m][0], acc[ai][bj][m][1], pre[m][bj]); } }
        }
    }
};
template <class Epi> struct EpiApply<Epi, true> {
    static __device__ __forceinline__ void run(const Epi& E, const f32x4 (&acc)[2][2][4][2], const Unit& u, int wr, int wc, int fr, int fq) {
#pragma unroll
        for (int ai = 0; ai < 2; ++ai)
#pragma unroll
            for (int m = 0; m < 4; ++m) { const int row = u.pm * BM + ai * HALF + wr * 64 + m * 16 + fr;
                E.putp8(u, row, u.pn * HALF + wc * 32 + 8 * fq, acc[ai][0][m][0], acc[ai][0][m][1], acc[ai][1][m][0], acc[ai][1][m][1]); }
    }
};
}

__device__ __forceinline__ void rowstat_pass(Frame& F, int r_first, int r_stride, int r_end) {
    const bf16_t* H = (const bf16_t*)(F.ws + WS_H); float* rstd = (float*)(F.ws + WS_RSTD);
    for (int m = r_first; m < r_end; m += r_stride) {
        const bf16_t* hr = H + (size_t)m * HP;
        const u32x2 q = *((const u32x2*)(hr + HC_CQ_LAT) + F.lane);
        const unsigned kv = *((const unsigned*)(hr + HC_CKV) + F.lane);
        float a0 = bf2f(q.x & 0xffff), a1 = bf2f(q.x >> 16), a2 = bf2f(q.y & 0xffff), a3 = bf2f(q.y >> 16), b0 = bf2f(kv & 0xffff), b1 = bf2f(kv >> 16);
        const float sq = wave_sum(a0 * a0 + a1 * a1 + a2 * a2 + a3 * a3), sk = wave_sum(b0 * b0 + b1 * b1);
        if (F.lane == 0) { rstd[2 * m] = 1.0f / sqrtf(sq * (1.0f / 256.0f) + RMS_EPS); rstd[2 * m + 1] = 1.0f / sqrtf(sk * (1.0f / 128.0f) + RMS_EPS); }
    }
}
__device__ __forceinline__ void red8(float (&v)[8], int lane) {
    float a[4], b[2], c;
#pragma unroll
    for (int i = 0; i < 4; ++i) a[i] = xpair32(v[i], v[i + 4]);
    { const bool up = (lane & 16) != 0;
#pragma unroll
      for (int i = 0; i < 2; ++i) { const float send = up ? a[i] : a[i + 2], keep = up ? a[i + 2] : a[i]; b[i] = keep + shx<16>(send); } }
    { const bool up = (lane & 8) != 0; const float send = up ? b[0] : b[1], keep = up ? b[1] : b[0]; c = keep + shx<8>(send); }
    c += shx<4>(c); c += shx<2>(c); c += shx<1>(c);
#pragma unroll
    for (int i = 0; i < 8; ++i) v[i] = __uint_as_float(__builtin_amdgcn_readlane(__float_as_uint(c), ((i >> 2) & 1) * 32 + ((i >> 1) & 1) * 16 + (i & 1) * 8));
}
__device__ __forceinline__ void red4(float (&v)[4], int lane) {
    float a[2], c;
#pragma unroll
    for (int i = 0; i < 2; ++i) a[i] = xpair32(v[i], v[i + 2]);
    { const bool up = (lane & 16) != 0; const float send = up ? a[0] : a[1], keep = up ? a[1] : a[0]; c = keep + shx<16>(send); }
    c += shx<8>(c); c += shx<4>(c); c += shx<2>(c); c += shx<1>(c);
#pragma unroll
    for (int i = 0; i < 4; ++i) v[i] = __uint_as_float(__builtin_amdgcn_readlane(__float_as_uint(c), ((i >> 1) & 1) * 32 + (i & 1) * 16));
}
__device__ __forceinline__ void ln1_route_pass(Frame& F, const Args& a, int layer, int r_first, int r_stride, int r_end) {
    bf16_t* XB = (bf16_t*)(F.ws + WS_XB); float* tw = (float*)(F.ws + WS_TW); int* list = (int*)(F.ws + WS_LIST);
    const float* g = a.ln1_g + layer * DM; const float* bb = a.ln1_b + layer * DM;
    const float* wc = a.moe_w_coarse + (size_t)layer * DM * 4; const float* wf = a.moe_w_fine + (size_t)layer * 4 * DM * 8;
    for (int q = F.tid; q < 4 * 1024 * 2; q += NTHREADS) { const int hf = q & 1, k = (q >> 1) & 1023, gg = q >> 11; const int l = (k & 255) >> 2, e = k & 3, j = k >> 8;
        *(LAS f32x4*)(F.lds + (size_t)(gg * 2048 + ((j * 4 + e) * 2 + hf) * 64 + l) * 16) = *((const f32x4*)wf + q); }
    f32x4 wcr[4][4];
#pragma unroll
    for (int j = 0; j < 4; ++j)
#pragma unroll
        for (int e = 0; e < 4; ++e) wcr[j][e] = *(const f32x4*)(wc + (size_t)(4 * F.lane + 256 * j + e) * 4);
    __syncthreads();
    LAS int* lcnt = (LAS int*)(F.lds + RING_BYTES + 1024); LAS int* lbase = lcnt + 32; LAS int* rec_er = lcnt + 64; LAS int* rec_a = rec_er + 512; LAS float* rec_w = (LAS float*)(rec_a + 512); float* lw = (float*)(F.ws + WS_LW);
  for (int c_first = r_first; c_first < r_end; c_first += 32 * r_stride) {
    const int c_end = (c_first + 32 * r_stride < r_end) ? c_first + 32 * r_stride : r_end;
    if (F.tid < 32) lcnt[F.tid] = 0;
    for (int q = F.tid; q < 512; q += NTHREADS) rec_a[q] = -1;
    __syncthreads();
    f32x4 vn[2][4];
#pragma unroll
    for (int rr = 0; rr < 2; ++rr) { const int mm = c_first + rr * r_stride; if (mm < c_end) {
#pragma unroll
        for (int j = 0; j < 4; ++j) vn[rr][j] = *((const f32x4*)(a.out + (size_t)mm * DM) + F.lane + 64 * j); } }
    for (int m0 = c_first; m0 < c_end; m0 += 2 * r_stride) {
        f32x4 vc[2][4];
#pragma unroll
        for (int rr = 0; rr < 2; ++rr)
#pragma unroll
            for (int j = 0; j < 4; ++j) vc[rr][j] = vn[rr][j];
#pragma unroll
        for (int rr = 0; rr < 2; ++rr) { const int mm = m0 + (2 + rr) * r_stride; if (mm < c_end) {
#pragma unroll
            for (int j = 0; j < 4; ++j) vn[rr][j] = *((const f32x4*)(a.out + (size_t)mm * DM) + F.lane + 64 * j); } }
#pragma unroll
      for (int rr = 0; rr < 2; ++rr) { const int m = m0 + rr * r_stride; if (m < c_end) {
        f32x4 v[4]; float s = 0.f;
#pragma unroll
        for (int j = 0; j < 4; ++j) { v[j] = vc[rr][j]; s += (v[j].x + v[j].y) + (v[j].z + v[j].w); }
        const float mean = wave_sum(s) * (1.f / DM); float s2 = 0.f;
#pragma unroll
        for (int j = 0; j < 4; ++j) { v[j] = v[j] - mean; s2 += (v[j].x * v[j].x + v[j].y * v[j].y) + (v[j].z * v[j].z + v[j].w * v[j].w); }
        const float rs = 1.f / sqrtf(wave_sum(s2) * (1.f / DM) + LN_EPS);
        float cl[4] = {0.f, 0.f, 0.f, 0.f};
#pragma unroll
        for (int j = 0; j < 4; ++j) { const int c = 4 * F.lane + 256 * j; const f32x4 gg = *(const f32x4*)(g + c), bv = *(const f32x4*)(bb + c); v[j] = v[j] * rs * gg + bv;
            u32x2 w; w.x = pk2(v[j].x, v[j].y); w.y = pk2(v[j].z, v[j].w); *((u32x2*)(XB + (size_t)m * DM) + F.lane + 64 * j) = w;
#pragma unroll
            for (int e = 0; e < 4; ++e) { const f32x4 w4 = wcr[j][e]; const float xe = v[j][e]; cl[0] += xe * w4.x; cl[1] += xe * w4.y; cl[2] += xe * w4.z; cl[3] += xe * w4.w; } }
        red4(cl, F.lane);
        int grp = 0; float cm = cl[0];
#pragma unroll
        for (int e = 1; e < 4; ++e) if (cl[e] > cm) { cm = cl[e]; grp = e; }
        float den = 0.f;
#pragma unroll
        for (int e = 0; e < 4; ++e) den += __expf(cl[e] - cm);
        const float pg = 1.0f / den;
        grp = __builtin_amdgcn_readfirstlane(grp);
        const LAS f32x4* wl = (const LAS f32x4*)(F.lds) + grp * 2048 + F.lane;
        float fl[8] = {0.f, 0.f, 0.f, 0.f, 0.f, 0.f, 0.f, 0.f};
#pragma unroll
        for (int j = 0; j < 4; ++j)
#pragma unroll
            for (int e = 0; e < 4; ++e) { const f32x4 wa = wl[((j * 4 + e) * 2) * 64], wb = wl[((j * 4 + e) * 2 + 1) * 64]; const float xe = v[j][e];
                fl[0] += xe * wa.x; fl[1] += xe * wa.y; fl[2] += xe * wa.z; fl[3] += xe * wa.w; fl[4] += xe * wb.x; fl[5] += xe * wb.y; fl[6] += xe * wb.z; fl[7] += xe * wb.w; }
        red8(fl, F.lane);
        int i0 = 0; float v0 = fl[0];
#pragma unroll
        for (int e = 1; e < 8; ++e) if (fl[e] > v0) { v0 = fl[e]; i0 = e; }
        int i1 = -1; float v1 = -3.0e38f;
#pragma unroll
        for (int e = 0; e < 8; ++e) if (e != i0 && fl[e] > v1) { v1 = fl[e]; i1 = e; }
        const float e1 = __expf(v1 - v0), w0 = pg / (1.0f + e1), w1 = pg * e1 / (1.0f + e1);
        if (F.lane < 2) { const int e = grp * 8 + (F.lane == 0 ? i0 : i1); const int a_id = 2 * m + F.lane;
            const int lr = __hip_atomic_fetch_add(lcnt + e, 1, __ATOMIC_RELAXED, __HIP_MEMORY_SCOPE_WORKGROUP);
            const int ri = (((m - c_first) / r_stride) * NWAVES + F.wave) * 2 + F.lane;
            rec_er[ri] = (e << 16) | lr; rec_a[ri] = a_id; rec_w[ri] = (F.lane == 0) ? w0 : w1; tw[a_id] = (F.lane == 0) ? w0 : w1; }
          } }
    }
    __syncthreads();
    if (F.tid < 32) { const int n = lcnt[F.tid]; lbase[F.tid] = n ? (int)__hip_atomic_fetch_add(F.ctl + CW_CNT + layer * 64 + F.tid, (unsigned)n, RLX_AGENT) : 0; }
    __syncthreads();
    for (int q = F.tid; q < 512; q += NTHREADS) { const int aid = rec_a[q]; if (aid >= 0) { const int er = rec_er[q], e = er >> 16; const size_t li = (size_t)e * LIST_CAP + lbase[e] + (er & 0xffff); list[li] = aid; lw[li] = rec_w[q]; } }
    __syncthreads();
  }
    __syncthreads();
}
__device__ __forceinline__ void ln2_pass(Frame& F, const Args& a, int layer, int r_first, int r_stride, int r_end) {
    bf16_t* XB = (bf16_t*)(F.ws + WS_XB); const bf16_t* YB = (const bf16_t*)(F.ws + WS_YB);
    const float* g = a.ln2_g + layer * DM; const float* bb = a.ln2_b + layer * DM;
    u32x2 xn[2][4], pn[2][4], qn[2][4];
#define LN2_LOAD(rr, mm) do { const bf16_t* y0_ = YB + (size_t)(2 * (mm)) * DM; _Pragma("unroll") for (int j = 0; j < 4; ++j) { xn[rr][j] = *((const u32x2*)(XB + (size_t)(mm) * DM) + F.lane + 64 * j); \
        pn[rr][j] = *((const u32x2*)y0_ + F.lane + 64 * j); qn[rr][j] = *((const u32x2*)(y0_ + DM) + F.lane + 64 * j); } } while (0)
#pragma unroll
    for (int rr = 0; rr < 2; ++rr) { const int mm = r_first + rr * r_stride; if (mm < r_end) LN2_LOAD(rr, mm); }
    for (int m0 = r_first; m0 < r_end; m0 += 2 * r_stride) {
        u32x2 xc[2][4], pc[2][4], qc[2][4];
#pragma unroll
        for (int rr = 0; rr < 2; ++rr)
#pragma unroll
            for (int j = 0; j < 4; ++j) { xc[rr][j] = xn[rr][j]; pc[rr][j] = pn[rr][j]; qc[rr][j] = qn[rr][j]; }
#pragma unroll
        for (int rr = 0; rr < 2; ++rr) { const int mm = m0 + (2 + rr) * r_stride; if (mm < r_end) LN2_LOAD(rr, mm); }
#pragma unroll
        for (int rr = 0; rr < 2; ++rr) { const int m = m0 + rr * r_stride; if (m < r_end) {
            float* xr = a.out + (size_t)m * DM;
            f32x4 v[4]; float s = 0.f;
#pragma unroll
            for (int j = 0; j < 4; ++j) { const u32x2 x = xc[rr][j], p = pc[rr][j], q = qc[rr][j];
                v[j].x = bf2f(x.x & 0xffff) * DN_ALPHA + (bf2f(p.x & 0xffff) + bf2f(q.x & 0xffff)); v[j].y = bf2f(x.x >> 16) * DN_ALPHA + (bf2f(p.x >> 16) + bf2f(q.x >> 16));
                v[j].z = bf2f(x.y & 0xffff) * DN_ALPHA + (bf2f(p.y & 0xffff) + bf2f(q.y & 0xffff)); v[j].w = bf2f(x.y >> 16) * DN_ALPHA + (bf2f(p.y >> 16) + bf2f(q.y >> 16));
                s += (v[j].x + v[j].y) + (v[j].z + v[j].w); }
            const float mean = wave_sum(s) * (1.f / DM); float s2 = 0.f;
#pragma unroll
            for (int j = 0; j < 4; ++j) { v[j] = v[j] - mean; s2 += (v[j].x * v[j].x + v[j].y * v[j].y) + (v[j].z * v[j].z + v[j].w * v[j].w); }
            const float rs = 1.f / sqrtf(wave_sum(s2) * (1.f / DM) + LN_EPS);
#pragma unroll
            for (int j = 0; j < 4; ++j) { const int c = 4 * F.lane + 256 * j; const f32x4 gg = *(const f32x4*)(g + c), bv = *(const f32x4*)(bb + c); v[j] = v[j] * rs * gg + bv;
                if (layer + 1 < DEPTH) { u32x2 w; w.x = pk2(v[j].x, v[j].y); w.y = pk2(v[j].z, v[j].w); *((u32x2*)(XB + (size_t)m * DM) + F.lane + 64 * j) = w; }
                else *((f32x4*)xr + F.lane + 64 * j) = v[j]; }
        } }
    }
#undef LN2_LOAD
}
__device__ __forceinline__ void moe_convert(Frame& F, const Args& a, int layer) {
    LAS float* scr = (LAS float*)(F.lds + F.wave * 16384);
    constexpr int I_13 = (1024 / 64) * (1024 / 32), I_2 = (512 / 64) * (1024 / 32), PER_E = I_13 + I_2;
    for (int it = F.gw; it < NEXP * PER_E; it += F.NGW) {
        const int e = it / PER_E; int r = it - e * PER_E; const size_t le = (size_t)layer * NEXP + e;
        if (r < I_13) { const int kb = r / 32, nb = r % 32; const float* src = ((nb >> 2) & 1) ? a.moe_w3 : a.moe_w1;
            const int sc0 = ((32 * nb) >> 8) * 128 + ((32 * nb) & 127);
            transpose_item_v4(src + le * 1024 * 512 + (size_t)(kb * 64) * 512 + sc0, 512, (bf16_t*)(F.ws + WS_W13) + (size_t)e * 1024 * 1024 + (size_t)(nb * 32) * 1024 + kb * 64, 1024, scr, F.lane); }
        else { r -= I_13; const int kb = r / 32, nb = r % 32;
            transpose_item_v4(a.moe_w2 + le * 512 * 1024 + (size_t)(kb * 64) * 1024 + nb * 32, 1024, (bf16_t*)(F.ws + WS_W2) + (size_t)e * 1024 * 512 + (size_t)(nb * 32) * 512 + kb * 64, 512, scr, F.lane); }
    }
}

typedef short at_s16x4 __attribute__((ext_vector_type(4)));
typedef LAS const unsigned char* at_lds_cptr;
__device__ __forceinline__ at_s16x4 at_vtr(at_lds_cptr p) { return __builtin_bit_cast(at_s16x4, __builtin_amdgcn_ds_read_tr16_b64_v4i16((LAS at_s16x4*)p)); }
struct RowSrc { const bf16_t* p; long pitch; };
constexpr int SA_P = 0, SA_V = 4096, SA_AL = 12288, SA_RL = 12544;
template <int NC0, int NC1, int MODE>
__device__ __forceinline__ void sattn_core(const bf16x8* qf, RowSrc k0, RowSrc k1, RowSrc vs, int kb_lo, int kb_hi, int qidx0, float lse_ref, LAS unsigned char* scr, int lane, f32x16* o, float& lse_out) {
    const int r32 = lane & 31, hi = lane >> 5;
    LAS bf16_t* Pb = (LAS bf16_t*)(scr + SA_P); LAS bf16_t* Vb = (LAS bf16_t*)(scr + SA_V); LAS float* Al = (LAS float*)(scr + SA_AL);
    float m = -1.0e30f, l = 0.f;
    if (MODE != 1) { o[0] = f32x16{}; o[1] = f32x16{}; }
    bf16x8 kn[NC0 + NC1]; u32x4 vn[4];
#define SA_LOAD(kb_) do { const long key_ = (long)(kb_) * 32 + r32; \
        _Pragma("unroll") for (int c = 0; c < NC0; ++c) kn[c] = *(const bf16x8*)(k0.p + key_ * k0.pitch + 16 * c + 8 * hi); \
        _Pragma("unroll") for (int c = 0; c < NC1; ++c) kn[NC0 + c] = *(const bf16x8*)(k1.p + key_ * k1.pitch + 16 * c + 8 * hi); \
        if (MODE != 1) { _Pragma("unroll") for (int i = 0; i < 4; ++i) { const int idx = i * 64 + lane, kr = idx >> 3, pc = idx & 7; vn[i] = *(const u32x4*)(vs.p + ((long)(kb_) * 32 + kr) * vs.pitch + pc * 8); } } } while (0)
    if (kb_lo < kb_hi) SA_LOAD(kb_lo);
    const at_lds_cptr vtb = (at_lds_cptr)(scr + SA_V) + ((8 * hi + ((lane & 15) >> 2)) * 72 + 16 * ((lane >> 4) & 1) + 4 * (lane & 3)) * 2;
    for (int kb = kb_lo; kb < kb_hi; ++kb) {
        bf16x8 kc[NC0 + NC1]; u32x4 vc[4];
#pragma unroll
        for (int c = 0; c < NC0 + NC1; ++c) kc[c] = kn[c];
#pragma unroll
        for (int i = 0; i < 4; ++i) vc[i] = vn[i];
        if (kb + 1 < kb_hi) SA_LOAD(kb + 1);
        f32x16 s = {};
#pragma unroll
        for (int c = 0; c < NC0 + NC1; ++c) s = MFMA32(kc[c], qf[c], s);
        bool valid[16];
#pragma unroll
        for (int r = 0; r < 16; ++r) { if (MODE == 0) valid[r] = true; else { const int d = kb * 32 + crow(r, hi) - (qidx0 + r32); valid[r] = (d <= 64 && d >= -64); } }
        float p[16];
        if (MODE == 2) {
#pragma unroll
            for (int r = 0; r < 16; ++r) p[r] = valid[r] ? fast_exp2(s[r] - lse_ref) : 0.f;
        } else {
            float mx = -1.0e30f;
#pragma unroll
            for (int r = 0; r < 16; ++r) if (valid[r]) mx = fmaxf(mx, s[r]);
            mx = xmax32(mx);
            const float mn = fmaxf(m, mx), alpha = fast_exp2(m - mn); m = mn;
            float ps = 0.f;
#pragma unroll
            for (int r = 0; r < 16; ++r) { p[r] = valid[r] ? fast_exp2(s[r] - mn) : 0.f; ps += p[r]; }
            l = l * alpha + ps;
            if (MODE == 0) { if (hi == 0) Al[r32] = alpha; }
        }
        if (MODE != 1) {
#pragma unroll
            for (int g = 0; g < 4; ++g) { u32x2 w; w.x = pk2(p[4 * g], p[4 * g + 1]); w.y = pk2(p[4 * g + 2], p[4 * g + 3]); *(LAS u32x2*)(Pb + r32 * 40 + 8 * g + 4 * hi) = w; }
#pragma unroll
            for (int i = 0; i < 4; ++i) { const int idx = i * 64 + lane, kr = idx >> 3, pc = idx & 7; *(LAS u32x4*)(Vb + kr * 72 + pc * 8) = vc[i]; }
            LDS_WAIT();
            if (MODE == 0) {
#pragma unroll
                for (int r = 0; r < 16; ++r) { const float al = Al[crow(r, hi)]; o[0][r] *= al; o[1][r] *= al; }
            }
#pragma unroll
            for (int st = 0; st < 2; ++st) {
                const bf16x8 pf = *(const LAS bf16x8*)(Pb + r32 * 40 + 16 * st + 8 * hi);
#pragma unroll
                for (int db = 0; db < 2; ++db) {
                    const at_s16x4 lo_ = at_vtr(vtb + (16 * st * 72 + 32 * db) * 2), hi_ = at_vtr(vtb + ((16 * st + 4) * 72 + 32 * db) * 2);
                    const bf16x8 vf = {lo_[0], lo_[1], lo_[2], lo_[3], hi_[0], hi_[1], hi_[2], hi_[3]};
                    o[db] = MFMA32(pf, vf, o[db]); }
            }
            LDS_WAIT();
        }
    }
#undef SA_LOAD
    if (MODE != 2) { l = xsum32(l); lse_out = m + __log2f(l); }
    if (MODE == 0) {
        LAS float* Rl = (LAS float*)(scr + SA_RL);
        if (hi == 0) Rl[r32] = 1.0f / l;
        LDS_WAIT();
#pragma unroll
        for (int r = 0; r < 16; ++r) { const float rl = Rl[crow(r, hi)]; o[0][r] *= rl; o[1][r] *= rl; }
        LDS_WAIT();
    }
}

__device__ __forceinline__ void sattn_phase(Frame& F, const Args& a, int layer, int kind_lo) {
    const bf16_t* H = (const bf16_t*)(F.ws + WS_H); const bf16_t* QB = (const bf16_t*)(F.ws + WS_QB); const bf16_t* KVB = (const bf16_t*)(F.ws + WS_KVB);
    bf16_t* MIX = (bf16_t*)(F.ws + WS_MIX); const float* lsec = (const float*)(F.ws + WS_LSEC);
    LAS unsigned char* scr = F.lds + F.wave * 16384;
    const int lane = F.lane, r32 = lane & 31, hi = lane >> 5;
    float lam, lam_init;
    { const float* lv = a.diff_lambda + layer * 128; float d1 = 0.f, d2 = 0.f;
      for (int i = 0; i < 32; ++i) { d1 += lv[i] * lv[32 + i]; d2 += lv[64 + i] * lv[96 + i]; }
      lam_init = 0.8f - 0.6f * expf(-0.3f * (float)layer); lam = expf(d1) - expf(d2) + lam_init; }
    constexpr int NRB = NTOK / 32;
    const int items = NRB * (4 + 6 + 6);
    for (int it = kind_lo * NRB + F.gw; it < items; it += F.NGW) {
        const int kind = it / NRB, rb = it - kind * NRB; const int m0 = rb * 32; const SeqInfo si = seqinfo(m0);
#if !OPT_ATTN
        if (kind < 4) {
            const int h = kind; f32x16 o0[2], o1[2]; float dummy;
            for (int c = 0; c < 2; ++c) {
                bf16x8 qf[2];
#pragma unroll
                for (int d0 = 0; d0 < 2; ++d0) qf[d0] = *(const bf16x8*)(H + (size_t)(m0 + r32) * HP + HC_AQ + h * 64 + c * 32 + 16 * d0 + 8 * hi);
                const RowSrc ks{H + (size_t)si.base * HP + HC_AK + h * 64 + c * 32, HP}, vs{H + (size_t)si.base * HP + HC_AV + h * 64, HP};
                sattn_core<2, 0, 0>(qf, ks, ks, vs, 0, si.len / 32, 0, 0.f, scr, lane, c == 0 ? o0 : o1, dummy);
            }
            const float* sg = a.diff_subln + layer * 64; const float g0 = sg[r32], g1 = sg[32 + r32];
#pragma unroll
            for (int r = 0; r < 16; ++r) { const float x0 = o0[0][r] - lam * o1[0][r], x1 = o0[1][r] - lam * o1[1][r]; float ss = x0 * x0 + x1 * x1;
                ss += shx<1>(ss); ss += shx<2>(ss); ss += shx<4>(ss); ss += shx<8>(ss); ss += shx<16>(ss);
                const float rs = (1.0f - lam_init) / sqrtf(ss * (1.0f / 64.0f) + RMS_EPS);
                bf16_t* op = MIX + (size_t)(m0 + crow(r, hi)) * DM + MIX_A + h * 64 + r32;
                op[0] = (bf16_t)f2bf(x0 * rs * g0); op[32] = (bf16_t)f2bf(x1 * rs * g1); }
        } else if (kind < 10) {
            const int h = kind - 4; f32x16 o[2]; float dummy; bf16x8 qf[6];
#pragma unroll
            for (int d0 = 0; d0 < 6; ++d0) qf[d0] = *(const bf16x8*)(QB + (size_t)(m0 + r32) * QBP + h * 96 + 16 * d0 + 8 * hi);
            const RowSrc k0{KVB + (size_t)si.base * KVP + h * 128, KVP}, k1{H + (size_t)si.base * HP + HC_KROPE, HP}, vs{KVB + (size_t)si.base * KVP + h * 128 + 64, KVP};
            sattn_core<4, 2, 0>(qf, k0, k1, vs, 0, si.len / 32, 0, 0.f, scr, lane, o, dummy);
#pragma unroll
            for (int r = 0; r < 16; ++r) { bf16_t* op = MIX + (size_t)(m0 + crow(r, hi)) * DM + MIX_B + h * 64 + r32; op[0] = (bf16_t)f2bf(o[0][r]); op[32] = (bf16_t)f2bf(o[1][r]); }
        } else
#endif
        {
            const int gj = kind - 10, g = gj >> 1, hh = gj;
            const int dil = (g == 0) ? 1 : (g == 1 ? 4 : 16); const int L = si.len / dil, bpr = L / 32;
            const int w = (m0 - si.base) / 32, rho = w / bpr, ib = w - rho * bpr, i0 = ib * 32;
            const size_t qrow = (size_t)si.base + (size_t)(i0 + r32) * dil + rho;
            bf16x8 qf[4];
#pragma unroll
            for (int d0 = 0; d0 < 4; ++d0) qf[d0] = *(const bf16x8*)(H + qrow * HP + HC_CQ + hh * 64 + 16 * d0 + 8 * hi);
            const int j = gj & 1; const float l0 = lsec[(0 * (size_t)NTOK + qrow) * 2 + j], l1 = lsec[(1 * (size_t)NTOK + qrow) * 2 + j], l2 = lsec[(2 * (size_t)NTOK + qrow) * 2 + j];
            const float lm = fmaxf(l0, fmaxf(l1, l2)); const float lref = lm + __log2f(fast_exp2(l0 - lm) + fast_exp2(l1 - lm) + fast_exp2(l2 - lm));
            const RowSrc ks{H + ((size_t)si.base + rho) * HP + HC_CK + hh * 64, (long)HP * dil}, vs{H + ((size_t)si.base + rho) * HP + HC_CV + hh * 64, (long)HP * dil};
            int kb_lo = ib - 2, kb_hi = ib + 3; if (kb_lo < 0) kb_lo = 0; if (kb_hi > bpr) kb_hi = bpr;
            f32x16 o[2]; float dummy;
            sattn_core<4, 0, 2>(qf, ks, ks, vs, kb_lo, kb_hi, i0, lref, scr, lane, o, dummy);
#pragma unroll
            for (int r = 0; r < 16; ++r) { const size_t orow = (size_t)si.base + (size_t)(i0 + crow(r, hi)) * dil + rho; bf16_t* op = MIX + orow * DM + MIX_C + hh * 64 + r32; op[0] = (bf16_t)f2bf(o[0][r]); op[32] = (bf16_t)f2bf(o[1][r]); }
        }
    }
}
__device__ __forceinline__ void cstat_phase(Frame& F) {
    const bf16_t* H = (const bf16_t*)(F.ws + WS_H); float* lsec = (float*)(F.ws + WS_LSEC);
    LAS unsigned char* scr = F.lds + F.wave * 16384;
    const int lane = F.lane, r32 = lane & 31, hi = lane >> 5;
    constexpr int NRB = NTOK / 32;
    for (int it = F.gw; it < NRB * 6; it += F.NGW) {
        const int gj = it / NRB, rb = it - gj * NRB, g = gj >> 1, j = gj & 1; const int m0 = rb * 32; const SeqInfo si = seqinfo(m0);
        const int dil = (g == 0) ? 1 : (g == 1 ? 4 : 16); const int L = si.len / dil, bpr = L / 32;
        const int w = (m0 - si.base) / 32, rho = w / bpr, ib = w - rho * bpr, i0 = ib * 32;
        const size_t qrow = (size_t)si.base + (size_t)(i0 + r32) * dil + rho;
        bf16x8 qf[4];
#pragma unroll
        for (int d0 = 0; d0 < 4; ++d0) qf[d0] = *(const bf16x8*)(H + qrow * HP + HC_CQ + gj * 64 + 16 * d0 + 8 * hi);
        const RowSrc ks{H + ((size_t)si.base + rho) * HP + HC_CK + gj * 64, (long)HP * dil};
        int kb_lo = ib - 2, kb_hi = ib + 3; if (kb_lo < 0) kb_lo = 0; if (kb_hi > bpr) kb_hi = bpr;
        float lse; sattn_core<4, 0, 1>(qf, ks, ks, ks, kb_lo, kb_hi, i0, 0.f, scr, lane, nullptr, lse);
        if (hi == 0) lsec[((size_t)g * NTOK + qrow) * 2 + j] = lse;
    }
}


namespace at {
typedef short s16x4 __attribute__((ext_vector_type(4)));
typedef short v4i16_t __attribute__((ext_vector_type(4)));
typedef LAS const unsigned char* lds_cptr;
constexpr int LDS_K = 0, NSLOT = 4, VSLOT = 8192;
template <int NC> struct Lay { static constexpr int SLOTK = 2 * NC * 1024, V = NSLOT * SLOTK, WS = V + NSLOT * VSLOT, OST = WS + 8 * 256, STG = (NC > 2) ? 4096 : 8192, TOTAL = OST + 8 * STG; };
static_assert(Lay<2>::TOTAL <= RING_BYTES && Lay<6>::TOTAL <= RING_BYTES, "attention LDS");
constexpr float THR = 8.0f;
__device__ __forceinline__ void glds16(const void* g, unsigned lds_dst) {
    unsigned keep; asm volatile("s_mov_b32 %0, m0\n\ts_mov_b32 m0, %2\n\ts_nop 0\n\tglobal_load_lds_dwordx4 %1, off\n\ts_mov_b32 m0, %0" : "=&s"(keep) : "v"(g), "s"(lds_dst) : "memory"); }
__device__ __forceinline__ s16x4 vtr(lds_cptr p) { return __builtin_bit_cast(s16x4, __builtin_amdgcn_ds_read_tr16_b64_v4i16((LAS v4i16_t*)p)); }
__device__ __forceinline__ unsigned cvtpk(float lo, float hi) { typedef float f2 __attribute__((ext_vector_type(2))); typedef __bf16 b2 __attribute__((ext_vector_type(2))); f2 v = {lo, hi}; b2 b = __builtin_convertvector(v, b2); return __builtin_bit_cast(unsigned, b); }
#define AT_MX3(a, b, c) __builtin_fmaxf(__builtin_fmaxf((a), (b)), (c))
__device__ __forceinline__ float rowmax(const f32x16& p0, const f32x16& p1) {
    float a = AT_MX3(p0[0], p0[1], p1[0]), b = AT_MX3(p0[2], p0[3], p1[1]); a = AT_MX3(a, p1[2], p1[3]);
#pragma unroll
    for (int r = 4; r < 16; r += 4) { a = AT_MX3(a, p0[r], p0[r + 1]); b = AT_MX3(b, p0[r + 2], p0[r + 3]); a = AT_MX3(a, p1[r], p1[r + 1]); b = AT_MX3(b, p1[r + 2], p1[r + 3]); }
    float m = __builtin_fmaxf(a, b); auto rr = __builtin_amdgcn_permlane32_swap(__float_as_uint(m), __float_as_uint(m), false, false);
    return __builtin_fmaxf(__uint_as_float(rr[0]), __uint_as_float(rr[1])); }
#define AT_WAIT_BAR(N) asm volatile("s_waitcnt vmcnt(" #N ") lgkmcnt(0)\n\ts_barrier" ::: "memory")

struct Src { const bf16_t* p; long pitch; };
template <int NC, int NK0, int NK1, bool FAST>
__device__ __forceinline__ void stream(LAS unsigned char* lds, int tid, const bf16_t* qrow, Src k0, Src k1, Src vs, int NT, f32x16& o0, f32x16& o1, f32x4& lsum) {
    asm volatile("" : "+v"(tid));
    constexpr int SLOTK = Lay<NC>::SLOTK, LDS_V = Lay<NC>::V, LDS_WS = Lay<NC>::WS;
    const int lane = tid & 63, r32 = lane & 31, hi = lane >> 5; const int wid = __builtin_amdgcn_readfirstlane(tid >> 6);
    const unsigned lds0 = (unsigned)(uintptr_t)lds;
    LAS float* wsf = (LAS float*)(lds + LDS_WS) + wid * 64;
    constexpr int P0 = NK0 * 16;
    const bool hasA = (NK0 == 8) || (wid < 4), hasB = (NK1 > 0) && (wid < 4);
    const int pA = (NK0 == 8) ? wid : (wid & 3);
    const int rowA = (NK0 == 8) ? pA * 8 + (lane >> 3) : pA * 16 + (lane >> 2);
    const int chA = (NK0 == 8) ? ((lane & 7) ^ ((4 * pA + (lane >> 4)) & 7)) : ((lane & 3) ^ ((lane >> 4) & 3));
    const bf16_t* ksA = k0.p + (long)rowA * k0.pitch + chA * 8;
    const int rowB = (wid & 3) * 16 + (lane >> 2), chB = (lane & 3) ^ ((lane >> 4) & 3);
    const bf16_t* ksB = (NK1 > 0) ? k1.p + (long)rowB * k1.pitch + chB * 8 : k0.p;
    const bf16_t* vsp = vs.p + (long)(16 * (wid & 3) + (lane >> 2)) * vs.pitch + (wid >> 2) * 32 + (lane & 3) * 8;
    const unsigned kdA = lds0 + LDS_K + pA * 1024, kdB = lds0 + LDS_K + (NK0 + (wid & 3)) * 1024, vd = lds0 + LDS_V + wid * 1024;
    const long ktA = 64 * k0.pitch, ktB = 64 * k1.pitch, vt = 64 * vs.pitch;
    const int nd = (hasA ? 1 : 0) + (hasB ? 1 : 0) + 1;
#define AT_DMA_K(t, slot) do { if (hasA) glds16(ksA + (long)(t) * ktA, (unsigned)__builtin_amdgcn_readfirstlane(kdA + (slot) * SLOTK)); if (hasB) glds16(ksB + (long)(t) * ktB, (unsigned)__builtin_amdgcn_readfirstlane(kdB + (slot) * SLOTK)); } while (0)
#define AT_DMA_V(t, slot) glds16(vsp + (long)(t) * vt, (unsigned)__builtin_amdgcn_readfirstlane(vd + (slot) * VSLOT))
    lds_cptr kb[NC];
#pragma unroll
    for (int d0 = 0; d0 < NC; ++d0) { const int c = 2 * d0 + hi;
        if (2 * d0 < NK0) kb[d0] = (lds_cptr)lds + LDS_K + r32 * P0 + ((NK0 == 8) ? (c ^ ((r32 >> 1) & 7)) : (c ^ ((r32 >> 2) & 3))) * 16;
        else kb[d0] = (lds_cptr)lds + LDS_K + NK0 * 1024 + r32 * 64 + ((c - NK0) ^ ((r32 >> 2) & 3)) * 16; }
    const lds_cptr vp0 = (lds_cptr)lds + LDS_V + ((lane >> 4) & 1) * 32 + (lane & 3) * 8 + (4 * hi + ((lane & 15) >> 2)) * 64;
#ifdef PROBE_SEL
    { unsigned long long pc0_, pr0_; asm volatile("s_memtime %0\n\ts_memrealtime %1\n\ts_waitcnt lgkmcnt(0)" : "=s"(pc0_), "=s"(pr0_) :: "memory");
      LAS unsigned long long* ps_ = (LAS unsigned long long*)(lds + RING_BYTES + 8192 + 128) + wid * 2; ps_[0] = pc0_; ps_[1] = pr0_; }
#endif
    AT_DMA_K(0, 0); AT_DMA_V(0, 0); AT_DMA_K(1, 1); AT_DMA_K(2, 2); AT_DMA_V(1, 1);
    bf16x8 qr[NC];
#pragma unroll
    for (int d0 = 0; d0 < NC; ++d0) qr[d0] = *(const bf16x8*)(qrow + 16 * d0 + 8 * hi);
    float mhat = 0.f; f32x16 oa = {}, ob = {}, negm = {}, S0, S1; f32x4 la = {}; u32x4 pw0, pw1, pw2, pw3;
    bf16x8 ones; { const unsigned o_ = (((lane >> 4) & 1) == ((lane >> 3) & 1)) ? 0x3F803F80u : 0u; u32x4 o1_ = {o_, o_, o_, o_}; asm volatile("" : "+v"(o1_)); ones = __builtin_bit_cast(bf16x8, o1_); }
    asm volatile("" : "+v"(negm));
    AT_WAIT_BAR(0);
    __builtin_amdgcn_s_waitcnt(0);
#pragma unroll
    for (int d0 = 0; d0 < NC; ++d0) asm volatile("" : "+v"(qr[d0]));
    bf16x8 kf[2 * NC], vf[8];
#define AT_SB() __builtin_amdgcn_sched_barrier(0)
#define AT_KRD(so_, d0) do { kf[2 * (d0)] = *(const LAS bf16x8*)(kb[d0] + (so_)); kf[2 * (d0) + 1] = *(const LAS bf16x8*)(kb[d0] + (so_) + 32 * ((2 * (d0) < NK0) ? P0 : 64)); } while (0)
#define AT_KHEAD(slot) do { const int kp_ = (slot) * SLOTK; AT_KRD(kp_, 0); if (NC > 1) AT_KRD(kp_, 1); } while (0)
#define AT_VF(i) ({ const s16x4 lo_ = vtr(vp_ + (((i) >> 2) * 4096 + ((i) & 3) * 1024)), hi_ = vtr(vp_ + (((i) >> 2) * 4096 + ((i) & 3) * 1024 + 512)); (bf16x8){lo_[0], lo_[1], lo_[2], lo_[3], hi_[0], hi_[1], hi_[2], hi_[3]}; })
#define AT_VHEAD(slot) do { const lds_cptr vp_ = vp0 + (slot) * VSLOT; vf[0] = AT_VF(0); vf[4] = AT_VF(4); } while (0)
#define AT_QKM(slot) do { const int kp_ = (slot) * SLOTK; \
        _Pragma("unroll") for (int d0 = 0; d0 < NC; ++d0) { if (d0 + 2 < NC) AT_KRD(kp_, d0 + 2); \
            if (d0 == 0) { S0 = MFMA32(kf[0], qr[0], negm); S1 = MFMA32(kf[1], qr[0], negm); } else { S0 = MFMA32(kf[2 * d0], qr[d0], S0); S1 = MFMA32(kf[2 * d0 + 1], qr[d0], S1); } AT_SB(); } } while (0)
#define AT_PVM(slot) do { const lds_cptr vp_ = vp0 + (slot) * VSLOT; \
        vf[1] = AT_VF(1); vf[5] = AT_VF(5); oa = MFMA32(__builtin_bit_cast(bf16x8, pw0), vf[0], oa); ob = MFMA32(__builtin_bit_cast(bf16x8, pw0), vf[4], ob); la = MFMA16(__builtin_bit_cast(bf16x8, pw0), ones, la); AT_SB(); \
        vf[2] = AT_VF(2); vf[6] = AT_VF(6); oa = MFMA32(__builtin_bit_cast(bf16x8, pw1), vf[1], oa); ob = MFMA32(__builtin_bit_cast(bf16x8, pw1), vf[5], ob); la = MFMA16(__builtin_bit_cast(bf16x8, pw1), ones, la); AT_SB(); \
        vf[3] = AT_VF(3); vf[7] = AT_VF(7); oa = MFMA32(__builtin_bit_cast(bf16x8, pw2), vf[2], oa); ob = MFMA32(__builtin_bit_cast(bf16x8, pw2), vf[6], ob); la = MFMA16(__builtin_bit_cast(bf16x8, pw2), ones, la); AT_SB(); \
        oa = MFMA32(__builtin_bit_cast(bf16x8, pw3), vf[3], oa); ob = MFMA32(__builtin_bit_cast(bf16x8, pw3), vf[7], ob); la = MFMA16(__builtin_bit_cast(bf16x8, pw3), ones, la); AT_SB(); } while (0)
    bool resc = false; u32x4 qw0, qw1, qw2, qw3;
#define AT_PIN(x) asm volatile("" : "+v"(x))
#define AT_DECIDE(first) do { const float rm_ = rowmax(S0, S1); resc = false; \
        if ((first) || __any(rm_ > THR)) { const float dl_ = (first) ? rm_ : __builtin_fmaxf(rm_, 0.f); mhat += dl_; \
            _Pragma("unroll") for (int r = 0; r < 16; ++r) { S0[r] -= dl_; S1[r] -= dl_; negm[r] = -mhat; } asm volatile("" : "+v"(negm)); \
            if (!(first)) { const float f_ = fast_exp2(-dl_); if (hi == 0) wsf[r32] = f_; resc = true; } } } while (0)
#define AT_RESC() do { if (resc) { LDS_WAIT(); \
        _Pragma("unroll") for (int r = 0; r < 16; ++r) { const float g_ = wsf[crow(r, hi)]; oa[r] *= g_; ob[r] *= g_; } \
        _Pragma("unroll") for (int v = 0; v < 4; ++v) la[v] *= wsf[4 * (lane >> 4) + 16 * ((lane >> 3) & 1) + v]; LDS_WAIT(); } } while (0)
#define AT_EXP8(S, b, Q) do { \
        _Pragma("unroll") for (int r = 0; r < 8; ++r) S[(b) + r] = fast_exp2(S[(b) + r]); \
        Q = (u32x4){cvtpk(S[(b)], S[(b) + 1]), cvtpk(S[(b) + 2], S[(b) + 3]), cvtpk(S[(b) + 4], S[(b) + 5]), cvtpk(S[(b) + 6], S[(b) + 7])}; AT_PIN(Q); } while (0)
#define AT_EXPALL() do { AT_EXP8(S0, 0, qw0); AT_EXP8(S0, 8, qw1); AT_EXP8(S1, 0, qw2); AT_EXP8(S1, 8, qw3); pw0 = qw0; pw1 = qw1; pw2 = qw2; pw3 = qw3; } while (0)
#define AT_PV_EXP(slot, C0, C1, C2, C3, N0, N1, N2, N3) do { const lds_cptr vp_ = vp0 + (slot) * VSLOT; \
        vf[1] = AT_VF(1); vf[5] = AT_VF(5); oa = MFMA32(__builtin_bit_cast(bf16x8, C0), vf[0], oa); ob = MFMA32(__builtin_bit_cast(bf16x8, C0), vf[4], ob); la = MFMA16(__builtin_bit_cast(bf16x8, C0), ones, la); AT_EXP8(S0, 0, N0); AT_SB(); \
        vf[2] = AT_VF(2); vf[6] = AT_VF(6); oa = MFMA32(__builtin_bit_cast(bf16x8, C1), vf[1], oa); ob = MFMA32(__builtin_bit_cast(bf16x8, C1), vf[5], ob); la = MFMA16(__builtin_bit_cast(bf16x8, C1), ones, la); AT_EXP8(S0, 8, N1); AT_SB(); \
        vf[3] = AT_VF(3); vf[7] = AT_VF(7); oa = MFMA32(__builtin_bit_cast(bf16x8, C2), vf[2], oa); ob = MFMA32(__builtin_bit_cast(bf16x8, C2), vf[6], ob); la = MFMA16(__builtin_bit_cast(bf16x8, C2), ones, la); AT_EXP8(S1, 0, N2); AT_SB(); \
        oa = MFMA32(__builtin_bit_cast(bf16x8, C3), vf[3], oa); ob = MFMA32(__builtin_bit_cast(bf16x8, C3), vf[7], ob); la = MFMA16(__builtin_bit_cast(bf16x8, C3), ones, la); AT_EXP8(S1, 8, N3); AT_SB(); } while (0)
#define AT_STEP_WAIT(t) do { if ((t) + 3 < NT) { if (nd == 3) AT_WAIT_BAR(6); else if (nd == 2) AT_WAIT_BAR(4); else AT_WAIT_BAR(2); } else AT_WAIT_BAR(0); } while (0)
    AT_DMA_K(3, 3); AT_DMA_V(2, 2);
    AT_KHEAD(0); AT_SB();
    AT_QKM(0); AT_DECIDE(true); AT_EXPALL();
    AT_STEP_WAIT(0);
#define AT_STEP(t, C0, C1, C2, C3, N0, N1, N2, N3) do { const int kc_ = (t) & 3, vp1_ = ((t) - 1) & 3; \
        if ((t) + 3 < NT) AT_DMA_K((t) + 3, ((t) + 3) & 3); \
        if ((t) + 2 < NT) AT_DMA_V((t) + 2, ((t) + 2) & 3); \
        AT_KHEAD(kc_); AT_VHEAD(vp1_); AT_SB(); \
        AT_QKM(kc_); \
        if (!FAST) { AT_DECIDE(false); AT_SB(); } \
        AT_PV_EXP(vp1_, C0, C1, C2, C3, N0, N1, N2, N3); \
        if (!FAST) AT_RESC(); \
        AT_STEP_WAIT(t); } while (0)
    int t = 1;
    for (; t + 1 < NT; t += 2) { AT_STEP(t, pw0, pw1, pw2, pw3, qw0, qw1, qw2, qw3); AT_STEP(t + 1, qw0, qw1, qw2, qw3, pw0, pw1, pw2, pw3); }
    if (t < NT) { AT_STEP(t, pw0, pw1, pw2, pw3, qw0, qw1, qw2, qw3); pw0 = qw0; pw1 = qw1; pw2 = qw2; pw3 = qw3; }
#undef AT_STEP
    AT_VHEAD((NT - 1) & 3); AT_SB(); AT_PVM((NT - 1) & 3);
    o0 = oa; o1 = ob; lsum = la;
#ifdef PROBE_SEL
    { unsigned long long pc1_, pr1_; asm volatile("s_memtime %0\n\ts_memrealtime %1\n\ts_waitcnt lgkmcnt(0)" : "=s"(pc1_), "=s"(pr1_) :: "memory");
      const LAS unsigned long long* ps_ = (const LAS unsigned long long*)(lds + RING_BYTES + 8192 + 128) + wid * 2; const unsigned long long pc0_ = ps_[0], pr0_ = ps_[1];
      if (wid == 0) { LAS unsigned long long* pb_ = (LAS unsigned long long*)(lds + RING_BYTES + 8192) + (NC > 2 ? 4 : 0); pb_[0] += pc1_ - pc0_; pb_[1] += pr1_ - pr0_; pb_[2] += (unsigned long long)NT; } }
#endif
#undef AT_DMA_K
#undef AT_DMA_V
#undef AT_SB
#undef AT_KRD
#undef AT_KHEAD
#undef AT_VF
#undef AT_VHEAD
#undef AT_QKM
#undef AT_PVM
#undef AT_PIN
#undef AT_DECIDE
#undef AT_RESC
#undef AT_EXP8
#undef AT_EXPALL
#undef AT_PV_EXP
#undef AT_STEP_WAIT
}
template <int NC>
__device__ __forceinline__ void normalise(LAS unsigned char* lds, int tid, f32x16& o0, f32x16& o1, const f32x4& lsum) {
    const int lane = tid & 63, hi = lane >> 5; const int wid = __builtin_amdgcn_readfirstlane(tid >> 6);
    LAS float* wsf = (LAS float*)(lds + Lay<NC>::WS) + wid * 64;
#pragma unroll
    for (int v = 0; v < 4; ++v) wsf[32 + 4 * (lane >> 4) + 16 * ((lane >> 3) & 1) + v] = 1.0f / lsum[v];
    LDS_WAIT();
#pragma unroll
    for (int r = 0; r < 16; ++r) { const float g = wsf[32 + crow(r, hi)]; o0[r] *= g; o1[r] *= g; }
    LDS_WAIT();
}
}

struct AttnUnitId { int kind, seq, head, qb; };
__device__ __forceinline__ bool attn_unit_at(int i, int G, int bid, AttnUnitId& u) {
    const long L = (long)i * G + bid; if (L >= 2560) return false; int o = (int)L;
    int kind, longs, nh;
    if (o < 512) { kind = 0; longs = 1; nh = 4; } else if (o < 1024) { kind = 0; longs = 0; nh = 4; o -= 512; } else if (o < 1792) { kind = 1; longs = 1; nh = 6; o -= 1024; } else { kind = 1; longs = 0; nh = 6; o -= 1792; }
    const int nqb = longs ? 16 : 8;
    int pair, qb;
    if (G == 256) { const int rnd = o >> 8, b = o & 255, x = b & 7, c = b >> 3;
        const int ppr = 32 / nqb; pair = x + 8 * (rnd * ppr + c / nqb); qb = c % nqb; }
    else { pair = o / nqb; qb = o % nqb; }
    u.kind = kind; u.head = pair % nh; const int sq = pair / nh; u.seq = longs ? 16 + sq : sq; u.qb = qb; return true;
}
template <bool FAST>
__device__ __forceinline__ bool attn_unit(Frame& F, const Args& a, int layer, const AttnUnitId& u, float lam, float lam_init) {
    const bf16_t* H = (const bf16_t*)(F.ws + WS_H); const bf16_t* QB = (const bf16_t*)(F.ws + WS_QB); const bf16_t* KVB = (const bf16_t*)(F.ws + WS_KVB);
    bf16_t* MIX = (bf16_t*)(F.ws + WS_MIX);
    const int wid = F.wave; bool bad = false;
    int tid = F.tid; asm volatile("" : "+v"(tid)); const int lane = tid & 63, r32 = lane & 31, hi = lane >> 5;
    const int len = (u.seq < 16) ? 2048 : 4096, base = (u.seq < 16) ? u.seq * 2048 : NTOK_P + (u.seq - 16) * 4096, NT = len / 64;
    const int m0 = base + u.qb * 256 + wid * 32;
    LAS bf16_t* sb = (LAS bf16_t*)(F.lds + ((u.kind == 0) ? at::Lay<2>::OST + wid * at::Lay<2>::STG : at::Lay<6>::OST + wid * at::Lay<6>::STG));
    LAS float* sf = (LAS float*)sb;
#define AT_BADSUM(ls) (!(ls[0] < 1e30f) | !(ls[1] < 1e30f) | !(ls[2] < 1e30f) | !(ls[3] < 1e30f))
    if (u.kind == 0) {
        f32x16 q0, q1; f32x4 ls;
        { f32x16 p0, p1; const at::Src ks{H + (size_t)base * HP + HC_AK + u.head * 64, HP}, vs{H + (size_t)base * HP + HC_AV + u.head * 64, HP};
          at::stream<2, 4, 0, FAST>(F.lds, tid, H + (size_t)(m0 + r32) * HP + HC_AQ + u.head * 64, ks, ks, vs, NT, p0, p1, ls); bad |= AT_BADSUM(ls); at::normalise<2>(F.lds, tid, p0, p1, ls);
#pragma unroll
          for (int r = 0; r < 16; ++r) { const int row = crow(r, hi); sf[row * 64 + r32] = p0[r]; sf[row * 64 + 32 + r32] = p1[r]; }
          AT_WAIT_BAR(0); }
        { const at::Src ks{H + (size_t)base * HP + HC_AK + u.head * 64 + 32, HP}, vs{H + (size_t)base * HP + HC_AV + u.head * 64, HP};
          at::stream<2, 4, 0, FAST>(F.lds, tid, H + (size_t)(m0 + r32) * HP + HC_AQ + u.head * 64 + 32, ks, ks, vs, NT, q0, q1, ls); bad |= AT_BADSUM(ls); at::normalise<2>(F.lds, tid, q0, q1, ls); }
        float xa[16], xb[16];
#pragma unroll
        for (int r = 0; r < 16; ++r) { const int row = crow(r, hi); xa[r] = sf[row * 64 + r32] - lam * q0[r]; xb[r] = sf[row * 64 + 32 + r32] - lam * q1[r]; }
        LDS_WAIT();
        const float* sg = a.diff_subln + layer * 64; const float g0 = sg[r32] * (1.0f - lam_init), g1 = sg[32 + r32] * (1.0f - lam_init);
#pragma unroll
        for (int r = 0; r < 16; ++r) { const float x0 = xa[r], x1 = xb[r]; float ss = x0 * x0 + x1 * x1;
            ss += shx<1>(ss); ss += shx<2>(ss); ss += shx<4>(ss); ss += shx<8>(ss); ss += shx<16>(ss);
            const float rs = 1.0f / sqrtf(ss * (1.0f / 64.0f) + RMS_EPS); const int row = crow(r, hi);
            sb[row * 64 + r32] = (bf16_t)f2bf(x0 * rs * g0); sb[row * 64 + 32 + r32] = (bf16_t)f2bf(x1 * rs * g1); }
        LDS_WAIT();
#pragma unroll
        for (int it = 0; it < 4; ++it) { const int row = it * 8 + (lane >> 3), ch = lane & 7; *(u32x4*)(MIX + (size_t)(m0 + row) * DM + MIX_A + u.head * 64 + ch * 8) = *(const LAS u32x4*)(sb + row * 64 + ch * 8); }
    } else {
        f32x16 p0, p1; f32x4 ls;
        const at::Src k0{KVB + (size_t)base * KVP + u.head * 128, KVP}, k1{H + (size_t)base * HP + HC_KROPE, HP}, vs{KVB + (size_t)base * KVP + u.head * 128 + 64, KVP};
        at::stream<6, 8, 4, FAST>(F.lds, tid, QB + (size_t)(m0 + r32) * QBP + u.head * 96, k0, k1, vs, NT, p0, p1, ls); bad |= AT_BADSUM(ls); at::normalise<6>(F.lds, tid, p0, p1, ls);
#pragma unroll
        for (int r = 0; r < 16; ++r) { const int row = crow(r, hi); sb[row * 64 + r32] = (bf16_t)f2bf(p0[r]); sb[row * 64 + 32 + r32] = (bf16_t)f2bf(p1[r]); }
        LDS_WAIT();
#pragma unroll
        for (int it = 0; it < 4; ++it) { const int row = it * 8 + (lane >> 3), ch = lane & 7; *(u32x4*)(MIX + (size_t)(m0 + row) * DM + MIX_B + u.head * 64 + ch * 8) = *(const LAS u32x4*)(sb + row * 64 + ch * 8); }
    }
#undef AT_BADSUM
    return bad;
}
constexpr int ATT_FLAG_OFF = RING_BYTES + 8192 + 512;
__device__ __forceinline__ void attn_ab_phase(Frame& F, const Args& a, int layer, int kmask = 3) {
    float lam, lam_init;
    { const float* lv = a.diff_lambda + layer * 128; float d1 = 0.f, d2 = 0.f;
      for (int i = 0; i < 32; ++i) { d1 += lv[i] * lv[32 + i]; d2 += lv[64 + i] * lv[96 + i]; }
      lam_init = 0.8f - 0.6f * expf(-0.3f * (float)layer); lam = expf(d1) - expf(d2) + lam_init;
      lam = __uint_as_float(__builtin_amdgcn_readfirstlane(__float_as_uint(lam))); lam_init = __uint_as_float(__builtin_amdgcn_readfirstlane(__float_as_uint(lam_init))); }
    volatile LAS unsigned* flag = (volatile LAS unsigned*)(F.lds + ATT_FLAG_OFF);
    AttnUnitId u;
    for (int i = 0; attn_unit_at(i, F.G, F.bid, u); ++i) {
        if (!((kmask >> u.kind) & 1)) continue;
        const unsigned ep = (unsigned)(layer * 64 + i + 1);
        const bool bad = attn_unit<true>(F, a, layer, u, lam, lam_init);
        if (__any(bad)) *flag = ep;
        AT_WAIT_BAR(0);
        if ((unsigned)__builtin_amdgcn_readfirstlane(*flag) == ep) {
            launder(F); attn_unit<false>(F, a, layer, u, lam, lam_init);
            AT_WAIT_BAR(0); }
    }
}

struct ListRows { const int* list; int seg0, cnt; __device__ __forceinline__ int src(int m) const { const int r = m - seg0; return (r < cnt) ? (list[r] >> 1) : 0; } };
__device__ __forceinline__ void moe_segments(Frame& F, int layer, LAS int* seg) {
    if (F.tid < 32) seg[33 + F.tid] = (int)__hip_atomic_load(F.ctl + CW_CNT + layer * 64 + F.tid, RLX_AGENT);
    __syncthreads();
    if (F.tid == 0) { int acc = 0; for (int e = 0; e < NEXP; ++e) { seg[e] = acc; acc += (seg[33 + e] + 255) & ~255; } seg[32] = acc; }
    __syncthreads();
}
__device__ __forceinline__ int seg_find(const LAS int* seg, int row) { int e = 0;
#pragma unroll
    for (int s = 16; s > 0; s >>= 1) if (seg[e + s] <= row) e += s;
    return e; }
__device__ __forceinline__ void moe_up_simple(Frame& F, int layer) {
    LAS int* seg = (LAS int*)(F.lds + RING_BYTES); moe_segments(F, layer, seg);
    const bf16_t* XB = (const bf16_t*)(F.ws + WS_XB); const bf16_t* W13 = (const bf16_t*)(F.ws + WS_W13); const int* list = (const int*)(F.ws + WS_LIST);
    const EpiHid E{(bf16_t*)(F.ws + WS_HID)};
    const int items = (seg[32] / 32) * 16;
    for (int it = F.gw; it < items; it += F.NGW) { const int mt = it >> 4, ct = it & 15, m0 = mt * 32, e = seg_find(seg, m0), c0 = ct * 32;
        const ListRows RM{list + (size_t)e * LIST_CAP, seg[e], seg[33 + e]};
        const bf16_t* Bg = W13 + (size_t)e * 1024 * 1024 + (size_t)((c0 >> 7) * 256 + (c0 & 127)) * 1024;
        sg_tile(XB, DM, Bg, Bg + (size_t)128 * 1024, 1024, 1024, m0, c0, E, RM, F.lane); }
    __syncthreads();
}
__device__ __forceinline__ void moe_down_simple(Frame& F, int layer) {
    LAS int* seg = (LAS int*)(F.lds + RING_BYTES); moe_segments(F, layer, seg);
    const bf16_t* HID = (const bf16_t*)(F.ws + WS_HID); const bf16_t* W2 = (const bf16_t*)(F.ws + WS_W2); const int* list = (const int*)(F.ws + WS_LIST);
    const int items = (seg[32] / 32) * 16;
    for (int it = F.gw; it < items; it += F.NGW) { const int mt = it >> 4, ct = it & 15, m0 = mt * 32, e = seg_find(seg, m0), c0 = ct * 64;
        const EpiY E{(bf16_t*)(F.ws + WS_YB), (const float*)(F.ws + WS_TW), list + (size_t)e * LIST_CAP, seg[e], seg[33 + e]};
        const bf16_t* B0 = W2 + (size_t)e * 1024 * 512 + (size_t)c0 * 512;
        sg_tile(HID, DEXP, B0, B0 + (size_t)32 * 512, 512, 512, m0, c0, E, IdRows(), F.lane); }
    __syncthreads();
}


struct MoeUpSched {
    const char* XB; const char* W13; const LAS int* seg; const int* list; int nM, G, c;
    __device__ __forceinline__ bool next(int i, pg8::Unit& u) const { if (!pg8::order_next(i, G, c, nM, 4, u.pm, u.pn)) return false; u.e = __builtin_amdgcn_readfirstlane(seg_find(seg, u.pm * 256)); u.a = XB; u.b = W13 + ((size_t)u.e * 1024 + (size_t)u.pn * 256) * 2048; return true; }
    __device__ __forceinline__ unsigned arow(const pg8::Unit& u, int r) const { const int rr = u.pm * 256 + r - __builtin_amdgcn_readfirstlane(seg[u.e]); return (rr < __builtin_amdgcn_readfirstlane(seg[33 + u.e])) ? (unsigned)(list[(size_t)u.e * LIST_CAP + rr] >> 1) : 0u; }
};
struct MoeDownSched {
    const char* HID; const char* W2; const LAS int* seg; int nM, G, c;
    __device__ __forceinline__ bool next(int i, pg8::Unit& u) const { if (!pg8::order_next(i, G, c, nM, 4, u.pm, u.pn)) return false; u.e = __builtin_amdgcn_readfirstlane(seg_find(seg, u.pm * 256)); u.a = HID + (size_t)u.pm * 256 * DEXP * 2; u.b = W2 + ((size_t)u.e * 1024 + (size_t)u.pn * 256) * 1024; return true; }
    __device__ __forceinline__ unsigned arow(const pg8::Unit&, int) const { return 0u; }
};
__device__ __forceinline__ void moe_up_opt(Frame& F, int layer) {
    LAS int* seg = (LAS int*)(F.lds + RING_BYTES); moe_segments(F, layer, seg);
    const MoeUpSched S{(const char*)(F.ws + WS_XB), (const char*)(F.ws + WS_W13), seg, (const int*)(F.ws + WS_LIST), __builtin_amdgcn_readfirstlane(seg[32]) / 256, F.G, F.bid};
    const EpiHid E{(bf16_t*)(F.ws + WS_HID)};
    pg8::gemm_phase<EpiHid, MoeUpSched, true, true>(F.lds, F.tid, 1024, DM, S, E);
    __syncthreads();
}
__device__ __forceinline__ void moe_down_opt(Frame& F, int layer) {
    LAS int* seg = (LAS int*)(F.lds + RING_BYTES); moe_segments(F, layer, seg);
    const MoeDownSched S{(const char*)(F.ws + WS_HID), (const char*)(F.ws + WS_W2), seg, __builtin_amdgcn_readfirstlane(seg[32]) / 256, F.G, F.bid};
    const EpiYO E{(bf16_t*)(F.ws + WS_YB), (const float*)(F.ws + WS_TW), (const int*)(F.ws + WS_LIST), seg, (const float*)(F.ws + WS_LW)};
    pg8::gemm_phase<EpiYO, MoeDownSched, false, false>(F.lds, F.tid, DEXP, DEXP, S, E);
    __syncthreads();
}
template <class Epi>
__device__ __forceinline__ void pg_phase(Frame& F, const bf16_t* A, int lda, const bf16_t* Bt, int panel, int N, int K, const Epi& E) {
    pg8::PanelSched S; S.init(A, lda, Bt, panel, N, K);
    pg8::gemm_phase<Epi, pg8::PanelSched, false, false>(F.lds, F.tid, K, lda, S, E);
}
__device__ __forceinline__ void local_sync(Frame& F) {
    asm volatile("s_waitcnt vmcnt(0) lgkmcnt(0)" ::: "memory");
    __syncthreads();
    if (F.tid == 0) { __builtin_amdgcn_fence(__ATOMIC_ACQUIRE, "agent"); asm volatile("s_waitcnt vmcnt(0)" ::: "memory"); }
    __syncthreads();
}
template <class Epi>
__device__ __forceinline__ void og_phase(Frame& F, const bf16_t* A, int lda, const bf16_t* Bt, int M, int N, int K, const Epi& E) {
    pg8::DenseSched S; S.init(A, lda, Bt, M, N, K, F.G, F.bid);
    pg8::gemm_phase<Epi, pg8::DenseSched, false, false>(F.lds, F.tid, K, lda, S, E);
}

#ifndef PANEL_PROG
#define PANEL_PROG 1
#endif
#if PANEL_PROG
constexpr int PH_PER_LAYER = 6, N_PHASES = 2 + DEPTH * PH_PER_LAYER;
#else
constexpr int PH_PER_LAYER = 9, N_PHASES = 1 + DEPTH * PH_PER_LAYER;
#endif
__global__ void __launch_bounds__(NTHREADS, 2) fwd(Args args) {
    extern __shared__ __attribute__((aligned(16))) unsigned char lds[];
    Frame F;
    F.lds = (LAS unsigned char*)lds; F.ldsg = lds;
    F.tid = threadIdx.x; F.lane = F.tid & 63; F.wave = __builtin_amdgcn_readfirstlane(F.tid >> 6);
    F.G = gridDim.x; F.bid = blockIdx.x; F.gw = blockIdx.x * NWAVES + F.wave; F.NGW = F.G * NWAVES;
    F.ws = args.ws; F.ctl = (gu32*)(args.ws + WS_CTL);
    volatile LAS unsigned* MISC = (volatile LAS unsigned*)(F.lds + MISC_OFF);
    for (int u = F.tid; u < (LDS_BYTES - RING_BYTES) / 4; u += NTHREADS) ((LAS unsigned*)(F.lds + RING_BYTES))[u] = 0u;
    __syncthreads();
    XcdBarrier bar; bar.bar = (unsigned*)(F.ctl + CW_BAR); bar.x = 0; bar.st = nullptr;
    if (args.use_bar) bar = xcd_barrier_post((unsigned*)(F.ctl + CW_BAR), MISC + 8);
    const int lo = args.ph_lo, hi = args.ph_hi;
#ifndef PH_MASK
#define PH_MASK 0x3ff
#endif
#define IN(k) (lo <= (k) && (k) < hi && (launder(F), true))
#define SEAM(k) do { if (lo <= (k) && (k) + 1 < hi) xcd_barrier(bar); } while (0)
    if ((PH_MASK & 1) && IN(0)) { p0_prologue(F, args);
#ifdef PROBE_DUP_P0
        launder(F); p0_prologue(F, args);
#endif
    }
    SEAM(0);
#if PANEL_PROG
    for (int layer = 0; layer < DEPTH; ++layer) {
        const int pb = 1 + layer * PH_PER_LAYER;
        if (IN(pb + 0)) {
            for (int panel = F.bid; panel < NTOK / 256; panel += F.G) {
                const int r0 = panel * 256;
                if (layer > 0) { ln2_pass(F, args, layer - 1, r0 + F.wave, NWAVES, r0 + 256); local_sync(F); launder(F); }
                { bf16_t* H = (bf16_t*)(F.ws + WS_H); const EpiH E{H, (const float2*)(F.ws + WS_ROPE32), (const float2*)(F.ws + WS_ROPE64)};
                  pg_phase(F, (const bf16_t*)(F.ws + WS_XB), DM, (const bf16_t*)(F.ws + WS_WIN) + (size_t)layer * 2560 * 1024, panel, 2560, 1024, E); }
                local_sync(F); launder(F);
                rowstat_pass(F, r0 + F.wave, NWAVES, r0 + 256);
                local_sync(F); launder(F);
                { bf16_t* H = (bf16_t*)(F.ws + WS_H); const EpiUQ Eq{(bf16_t*)(F.ws + WS_QB), (const float*)(F.ws + WS_RSTD), (const float2*)(F.ws + WS_ROPE32)};
                  pg_phase(F, H + HC_CQ_LAT, HP, (const bf16_t*)(F.ws + WS_WUQ) + (size_t)layer * 768 * 256, panel, 768, 256, Eq); }
                launder(F);
                { bf16_t* H = (bf16_t*)(F.ws + WS_H); const EpiUKV Ek{(bf16_t*)(F.ws + WS_KVB), (const float*)(F.ws + WS_RSTD)};
                  pg_phase(F, H + HC_CKV, HP, (const bf16_t*)(F.ws + WS_WUKV) + (size_t)layer * 768 * 256, panel, 768, 256, Ek); }
                launder(F);
            }
        }
        SEAM(pb + 0);
        if (IN(pb + 1)) { cstat_phase(F); }
        SEAM(pb + 1);
        if (IN(pb + 2)) { attn_ab_phase(F, args, layer); launder(F); sattn_phase(F, args, layer, 10); }
        SEAM(pb + 2);
        if (IN(pb + 3)) {
            for (int panel = F.bid; panel < NTOK / 256; panel += F.G) {
                const int r0 = panel * 256;
                { const EpiRes E{(const bf16_t*)(F.ws + WS_XB), args.out};
                  pg_phase(F, (const bf16_t*)(F.ws + WS_MIX), DM, (const bf16_t*)(F.ws + WS_WOUT) + (size_t)layer * 1024 * 1024, panel, 1024, 1024, E); }
                local_sync(F); launder(F);
                ln1_route_pass(F, args, layer, r0 + F.wave, NWAVES, r0 + 256);
                launder(F);
            }
            moe_convert(F, args, layer);
        }
        SEAM(pb + 3);
        if (IN(pb + 4)) { moe_up_opt(F, layer);
#ifdef PROBE_DUP_MOE
            launder(F); moe_up_opt(F, layer);
#endif
        }
        SEAM(pb + 4);
        if (IN(pb + 5)) { moe_down_opt(F, layer);
#ifdef PROBE_DUP_MOE
            launder(F); moe_down_opt(F, layer);
#endif
        }
        SEAM(pb + 5);
    }
    if (IN(1 + DEPTH * PH_PER_LAYER)) { ln2_pass(F, args, DEPTH - 1, F.gw, F.NGW, NTOK); }
#ifdef PROBE_SEL
    __syncthreads(); launder(F);
    if (F.bid == 0 && F.tid == 0) { const LAS unsigned long long* pb_ = (const LAS unsigned long long*)(F.lds + RING_BYTES + 8192);
        const unsigned long long num_ = (PROBE_SEL == 1) ? 10000ull * pb_[4] : (PROBE_SEL == 2) ? 100ull * pb_[4] : (PROBE_SEL == 3) ? 100ull * pb_[0] : 10000ull * pb_[0];
        const unsigned long long den_ = (PROBE_SEL == 1) ? pb_[5] : (PROBE_SEL == 2) ? pb_[6] : (PROBE_SEL == 3) ? pb_[2] : pb_[1];
        const unsigned long long t0_ = __builtin_amdgcn_s_memrealtime();
        while ((__builtin_amdgcn_s_memrealtime() - t0_) * den_ < num_) __builtin_amdgcn_s_sleep(8); }
#endif
#else
    for (int layer = 0; layer < DEPTH; ++layer) {
        const int pb = 1 + layer * PH_PER_LAYER;
        if ((PH_MASK & (2 << 0)) && IN(pb + 0)) {   bf16_t* H = (bf16_t*)(F.ws + WS_H);
            const EpiH E{H, (const float2*)(F.ws + WS_ROPE32), (const float2*)(F.ws + WS_ROPE64)};
#if OPT_GEMM
            og_phase(F, (const bf16_t*)(F.ws + WS_XB), DM, (const bf16_t*)(F.ws + WS_WIN) + (size_t)layer * 2560 * 1024, NTOK, 2560, 1024, E);
#ifdef PROBE_DUP_GEMM
            launder(F); og_phase(F, (const bf16_t*)(F.ws + WS_XB), DM, (const bf16_t*)(F.ws + WS_WIN) + (size_t)layer * 2560 * 1024, NTOK, 2560, 1024, E);
#endif
#else
            sg_phase(F, (const bf16_t*)(F.ws + WS_XB), DM, (const bf16_t*)(F.ws + WS_WIN) + (size_t)layer * 2560 * 1024, 1024, NTOK, 2560, 1024, E);
#endif
        }
        SEAM(pb + 0);
        if ((PH_MASK & (2 << 1)) && IN(pb + 1)) { rowstat_pass(F, F.gw, F.NGW, NTOK); cstat_phase(F);
#ifdef PROBE_DUP_CSTAT
            launder(F); rowstat_pass(F, F.gw, F.NGW, NTOK); cstat_phase(F);
#endif
        }
        SEAM(pb + 1);
        if ((PH_MASK & (2 << 2)) && IN(pb + 2)) {
            bf16_t* H = (bf16_t*)(F.ws + WS_H);
            const EpiUQ Eq{(bf16_t*)(F.ws + WS_QB), (const float*)(F.ws + WS_RSTD), (const float2*)(F.ws + WS_ROPE32)};
#if OPT_GEMM
            og_phase(F, H + HC_CQ_LAT, HP, (const bf16_t*)(F.ws + WS_WUQ) + (size_t)layer * 768 * 256, NTOK, 768, 256, Eq);
            launder(F);
#else
            sg_phase(F, H + HC_CQ_LAT, HP, (const bf16_t*)(F.ws + WS_WUQ) + (size_t)layer * 768 * 256, 256, NTOK, 768, 256, Eq);
#endif
            const EpiUKV Ek{(bf16_t*)(F.ws + WS_KVB), (const float*)(F.ws + WS_RSTD)};
#if OPT_GEMM
            og_phase(F, H + HC_CKV, HP, (const bf16_t*)(F.ws + WS_WUKV) + (size_t)layer * 768 * 256, NTOK, 768, 256, Ek);
#ifdef PROBE_DUP_UP
            launder(F); og_phase(F, H + HC_CQ_LAT, HP, (const bf16_t*)(F.ws + WS_WUQ) + (size_t)layer * 768 * 256, NTOK, 768, 256, Eq);
            launder(F); og_phase(F, H + HC_CKV, HP, (const bf16_t*)(F.ws + WS_WUKV) + (size_t)layer * 768 * 256, NTOK, 768, 256, Ek);
#endif
#else
            sg_phase(F, H + HC_CKV, HP, (const bf16_t*)(F.ws + WS_WUKV) + (size_t)layer * 768 * 256, 256, NTOK, 768, 256, Ek);
#endif
        }
        SEAM(pb + 2);
        if ((PH_MASK & (2 << 3)) && IN(pb + 3)) {
#if OPT_ATTN
            attn_ab_phase(F, args, layer); launder(F);
#ifdef PROBE_DUP_ATTN
            attn_ab_phase(F, args, layer, PROBE_DUP_ATTN); launder(F);
#endif
            sattn_phase(F, args, layer, 10);
#ifdef PROBE_DUP_CFIN
            launder(F); sattn_phase(F, args, layer, 10);
#endif
#else
            sattn_phase(F, args, layer, 0);
#endif
        }
        SEAM(pb + 3);
        if ((PH_MASK & (2 << 4)) && IN(pb + 4)) {
#ifdef PROBE_DUP_WOUT
            { const EpiRes E0{(const bf16_t*)(F.ws + WS_XB), (float*)(F.ws + WS_H)};
              og_phase(F, (const bf16_t*)(F.ws + WS_MIX), DM, (const bf16_t*)(F.ws + WS_WOUT) + (size_t)layer * 1024 * 1024, NTOK, 1024, 1024, E0); launder(F); }
#endif
            const EpiRes E{(const bf16_t*)(F.ws + WS_XB), args.out};
#if OPT_GEMM
            og_phase(F, (const bf16_t*)(F.ws + WS_MIX), DM, (const bf16_t*)(F.ws + WS_WOUT) + (size_t)layer * 1024 * 1024, NTOK, 1024, 1024, E);
#else
            sg_phase(F, (const bf16_t*)(F.ws + WS_MIX), DM, (const bf16_t*)(F.ws + WS_WOUT) + (size_t)layer * 1024 * 1024, 1024, NTOK, 1024, 1024, E);
#endif
        }
        SEAM(pb + 4);
        if ((PH_MASK & (2 << 5)) && IN(pb + 5)) {
#ifdef PROBE_DUP_LN1
#endif
            ln1_route_pass(F, args, layer, F.gw, F.NGW, NTOK); moe_convert(F, args, layer);
#ifdef PROBE_DUP_CONV
            launder(F); moe_convert(F, args, layer);
#endif
        }
        SEAM(pb + 5);
#if OPT_GEMM
        if ((PH_MASK & (2 << 6)) && IN(pb + 6)) { moe_up_opt(F, layer);
#ifdef PROBE_DUP_MOE
            launder(F); moe_up_opt(F, layer);
#endif
        }
#else
        if ((PH_MASK & (2 << 6)) && IN(pb + 6)) { moe_up_simple(F, layer); }
#endif
        SEAM(pb + 6);
#if OPT_GEMM
        if ((PH_MASK & (2 << 7)) && IN(pb + 7)) { moe_down_opt(F, layer);
#ifdef PROBE_DUP_MOE
            launder(F); moe_down_opt(F, layer);
#endif
        }
#else
        if ((PH_MASK & (2 << 7)) && IN(pb + 7)) { moe_down_simple(F, layer); }
#endif
        SEAM(pb + 7);
        if ((PH_MASK & (2 << 8)) && IN(pb + 8)) { ln2_pass(F, args, layer, F.gw, F.NGW, NTOK); }
        SEAM(pb + 8);
    }
#endif
#undef IN
#undef SEAM
}

extern "C" void kernel_launch(void* const* d_in, const int* in_sizes, int n_in, void* d_out, int out_size, void* d_ws, size_t ws_size, hipStream_t stream) {
    static int grid = 0;
    if (grid == 0) {
        if (n_in != 19 || out_size != NTOK * DM || ws_size < WS_END) { fprintf(stderr, "kernel_launch: unexpected shapes (n_in %d out %d ws %zu)\n", n_in, out_size, ws_size); grid = -1; return; }
        int dev = 0, cus = 0, per_cu = 0;
        if (hipGetDevice(&dev) != hipSuccess || hipDeviceGetAttribute(&cus, hipDeviceAttributeMultiprocessorCount, dev) != hipSuccess) { grid = -1; return; }
        if (hipFuncSetAttribute((const void*)fwd, hipFuncAttributeMaxDynamicSharedMemorySize, LDS_BYTES) != hipSuccess) { grid = -1; return; }
        if (hipOccupancyMaxActiveBlocksPerMultiprocessor(&per_cu, (const void*)fwd, NTHREADS, LDS_BYTES) != hipSuccess || per_cu < 1) { fprintf(stderr, "kernel_launch: occupancy query says %d\n", per_cu); }
        (void)hipGetLastError();
        grid = cus;
    }
    if (grid < 0) return;
    if (hipMemsetAsync((char*)d_ws + WS_CTL, 0, CTL_ZERO_BYTES, stream) != hipSuccess) return;
    Args a{};
    a.x_prompt = (const float*)d_in[0]; a.x_sample = (const float*)d_in[1]; a.w_in = (const float*)d_in[2]; a.diff_lambda = (const float*)d_in[3]; a.diff_subln = (const float*)d_in[4];
    a.mla_q_norm = (const float*)d_in[5]; a.mla_w_uq = (const float*)d_in[6]; a.mla_kv_norm = (const float*)d_in[7]; a.mla_w_ukv = (const float*)d_in[8]; a.w_out = (const float*)d_in[9];
    a.ln1_g = (const float*)d_in[10]; a.ln1_b = (const float*)d_in[11]; a.moe_w_coarse = (const float*)d_in[12]; a.moe_w_fine = (const float*)d_in[13];
    a.moe_w1 = (const float*)d_in[14]; a.moe_w3 = (const float*)d_in[15]; a.moe_w2 = (const float*)d_in[16]; a.ln2_g = (const float*)d_in[17]; a.ln2_b = (const float*)d_in[18];
    a.out = (float*)d_out; a.ws = (unsigned char*)d_ws; a.pad = 0;
#if MK_ONE_LAUNCH
    a.ph_lo = 0; a.ph_hi = N_PHASES; a.use_bar = 1;
    hipLaunchKernelGGL(fwd, dim3(grid), dim3(NTHREADS), LDS_BYTES, stream, a);
#else
    for (int p = 0; p < N_PHASES; ++p) { a.ph_lo = p; a.ph_hi = p + 1; a.use_bar = 0; hipLaunchKernelGGL(fwd, dim3(grid), dim3(NTHREADS), LDS_BYTES, stream, a); }
#endif
}
```

```cpp
#include <hip/hip_runtime.h>
#include <cstdio>
#include <cstdint>

#ifndef OPT_ATTN
#define OPT_ATTN 1
#endif
#ifndef OPT_GEMM
#define OPT_GEMM 1
#endif
#ifndef MK_ONE_LAUNCH
#define MK_ONE_LAUNCH 1
#endif

#define GAS __attribute__((address_space(1)))
#define LAS __attribute__((address_space(3)))
typedef unsigned short bf16_t;
typedef short bf16x8 __attribute__((ext_vector_type(8)));
typedef float f32x4 __attribute__((ext_vector_type(4)));
typedef float f32x2 __attribute__((ext_vector_type(2)));
typedef float f32x16 __attribute__((ext_vector_type(16)));
typedef unsigned u32x4 __attribute__((ext_vector_type(4)));
typedef unsigned u32x2 __attribute__((ext_vector_type(2)));
typedef GAS unsigned gu32;
#define RLX_AGENT __ATOMIC_RELAXED, __HIP_MEMORY_SCOPE_AGENT
#define LDS_WAIT() asm volatile("s_waitcnt lgkmcnt(0)" ::: "memory")
#define VM_WAIT() asm volatile("s_waitcnt vmcnt(0)" ::: "memory")
#define MFMA32(a, b, c) __builtin_amdgcn_mfma_f32_32x32x16_bf16(a, b, c, 0, 0, 0)
#define MFMA16(a, b, c) __builtin_amdgcn_mfma_f32_16x16x32_bf16(a, b, c, 0, 0, 0)

__device__ __forceinline__ unsigned f2bf(float f) { unsigned u = __builtin_bit_cast(unsigned, f); return (u + 0x7fffu + ((u >> 16) & 1u)) >> 16; }
__device__ __forceinline__ unsigned pk2(float lo, float hi) { typedef float f2_ __attribute__((ext_vector_type(2))); typedef __bf16 b2_ __attribute__((ext_vector_type(2))); f2_ v = {lo, hi}; b2_ b = __builtin_convertvector(v, b2_); return __builtin_bit_cast(unsigned, b); }
__device__ __forceinline__ float bf2f(unsigned short b) { return __builtin_bit_cast(float, (unsigned)b << 16); }
__device__ __forceinline__ int crow(int r, int hi) { return (r & 3) + 8 * (r >> 2) + 4 * hi; }
template <int K> __device__ __forceinline__ float shx(float v) { static_assert(K < 32, "xor 32: use xsum32 / xmax32 / xpair32"); return __uint_as_float((unsigned)__builtin_amdgcn_ds_swizzle((int)__float_as_uint(v), (K << 10) | 0x1f)); }
__device__ __forceinline__ float xsum32(float v) { auto rr = __builtin_amdgcn_permlane32_swap(__float_as_uint(v), __float_as_uint(v), false, false); return __uint_as_float(rr[0]) + __uint_as_float(rr[1]); }
__device__ __forceinline__ float xmax32(float v) { auto rr = __builtin_amdgcn_permlane32_swap(__float_as_uint(v), __float_as_uint(v), false, false); return fmaxf(__uint_as_float(rr[0]), __uint_as_float(rr[1])); }
__device__ __forceinline__ float xpair32(float lo, float hi) { auto rr = __builtin_amdgcn_permlane32_swap(__float_as_uint(lo), __float_as_uint(hi), false, false); return __uint_as_float(rr[0]) + __uint_as_float(rr[1]); }
__device__ __forceinline__ float wave_sum(float v) {
    v += shx<1>(v); v += shx<2>(v); v += shx<4>(v); v += shx<8>(v); v += shx<16>(v);
    return xsum32(v);
}
__device__ __forceinline__ float fast_exp2(float x) { return __builtin_amdgcn_exp2f(x); }

constexpr int NTOK = 65536, DM = 1024, DEPTH = 4;
constexpr int NTOK_P = 32768;
constexpr int HP = 2560;
constexpr int HC_AQ = 0, HC_AK = 256, HC_AV = 512, HC_CQ_LAT = 768, HC_CKV = 1024, HC_KROPE = 1152, HC_CQ = 1280, HC_CK = 1664, HC_CV = 2048;
constexpr int QBP = 768, KVP = 768;
constexpr int MIX_A = 0, MIX_B = 256, MIX_C = 640;
constexpr int NEXP = 32, DEXP = 512;
constexpr float LOG2E = 1.4426950408889634f;
constexpr float SC_A = 0.17677669529663687f * LOG2E;
constexpr float SC_B = 0.10206207261596575f * LOG2E;
constexpr float SC_C = 0.125f * LOG2E;
constexpr float DN_ALPHA = 1.681792830507429f;
constexpr float LN_EPS = 1e-5f, RMS_EPS = 1e-6f;

constexpr size_t MiB = 1u << 20;
constexpr size_t WS_CTL = 0, CTL_ZERO_BYTES = 64 * 1024;
constexpr size_t WS_ROPE32 = 4 * MiB;
constexpr size_t WS_ROPE64 = 5 * MiB;
constexpr size_t WS_WIN = 8 * MiB;
constexpr size_t WS_WOUT = 28 * MiB;
constexpr size_t WS_WUQ = 36 * MiB;
constexpr size_t WS_WUKV = 38 * MiB;
constexpr size_t WS_W13 = 40 * MiB;
constexpr size_t WS_W2 = 104 * MiB;
constexpr size_t WS_XB = 136 * MiB;
constexpr size_t WS_H = 264 * MiB;
constexpr size_t WS_QB = 584 * MiB;
constexpr size_t WS_KVB = 680 * MiB;
constexpr size_t WS_MIX = 776 * MiB;
constexpr size_t WS_RSTD = 904 * MiB;
constexpr size_t WS_LSEC = 905 * MiB;
constexpr size_t WS_TW = 907 * MiB;
constexpr size_t WS_LIST = 908 * MiB;
constexpr size_t WS_LW = 924 * MiB;
constexpr size_t WS_END = 940 * MiB;
constexpr size_t WS_HID = WS_H;
constexpr size_t WS_YB = WS_H + 136 * MiB;
static_assert(WS_YB + 256 * MiB <= WS_KVB + 96 * MiB, "YB overlay");
constexpr int LIST_CAP = 131072;
constexpr int CW_TMO = 0;
constexpr int CW_CNT = 64;
constexpr int CW_BAR = 4096;

constexpr int RING_BYTES = 131072;
constexpr int MISC_OFF = RING_BYTES + 320;
constexpr int LDS_BYTES = 147456;
constexpr int NWAVES = 8, NTHREADS = 512;

#define XB_TMO      128
#define XB_XCNT(j)  (256  + 64 * (j))
#define XB_XSUB(j)  (1280 + 64 * (j))
#define XB_XGEN(j)  (2304 + 64 * (j))
#define XB_TOP      3328
#define XB_TOPGEN   3392
#define XCD_BAR_WORDS 3456
#define XB_SPIN_CAP (1u << 22)
__device__ __forceinline__ unsigned xb_ld(unsigned* p)              { return __hip_atomic_load(p, __ATOMIC_RELAXED, __HIP_MEMORY_SCOPE_AGENT); }
__device__ __forceinline__ unsigned xb_add(unsigned* p, unsigned v) { return __hip_atomic_fetch_add(p, v, __ATOMIC_RELAXED, __HIP_MEMORY_SCOPE_AGENT); }
__device__ __forceinline__ unsigned xb_xcc_id() { return (unsigned)__builtin_amdgcn_s_getreg((3 << 11) | 20) & 0xFu; }
#define XB_SPIN(cond, bar) do { unsigned _sp = 0; while (cond) { __builtin_amdgcn_s_sleep(1); \
    if ((++_sp & 255u) == 0u) { if (xb_ld(&(bar)[XB_TMO])) break; if (_sp > XB_SPIN_CAP) { atomicAdd(&(bar)[XB_TMO], 1u); break; } } } } while (0)
struct XcdBarrier { unsigned* bar; unsigned x; volatile LAS unsigned* st; };
__device__ __forceinline__ XcdBarrier xcd_barrier_post(unsigned* bar, volatile LAS unsigned* st) {
    XcdBarrier b; b.bar = bar; b.x = xb_xcc_id(); b.st = st;
    if (threadIdx.x == 0) (void)xb_add(&bar[XB_XCNT(b.x)], 1u);
    return b;
}
__device__ __forceinline__ void xcd_barrier_complete(unsigned* bar, unsigned x, unsigned& nloc, unsigned& nx) {
    const unsigned G = gridDim.x * gridDim.y * gridDim.z;
    unsigned sum, cnt, mine, sp = 0u;
    for (;;) {
        sum = 0u; cnt = 0u; mine = 0u;
#pragma unroll
        for (unsigned j = 0; j < 16; ++j) { const unsigned c = xb_ld(&bar[XB_XCNT(j)]); sum += c; cnt += (c > 0u) ? 1u : 0u; mine = (j == x) ? c : mine; }
        if (sum == G) break;
        __builtin_amdgcn_s_sleep(1);
        if ((++sp & 255u) == 0u) { if (xb_ld(&bar[XB_TMO])) break; if (sp > XB_SPIN_CAP) { atomicAdd(&bar[XB_TMO], 1u); break; } }
    }
    nloc = mine > 0u ? mine : 1u; nx = cnt > 0u ? cnt : 1u;
}
__device__ __forceinline__ void xcd_barrier(const XcdBarrier& b) {
    asm volatile("s_waitcnt vmcnt(0)" ::: "memory");
    __syncthreads();
    if (threadIdx.x == 0) {
        unsigned* bar = b.bar;
        __builtin_amdgcn_s_waitcnt(0);
        unsigned nloc = b.st[0], nx = b.st[1];
        if (nloc == 0u) { xcd_barrier_complete(bar, b.x, nloc, nx); b.st[0] = nloc; b.st[1] = nx; }
        const unsigned old = xb_add(&bar[XB_XSUB(b.x)], 1u);
        const unsigned gen = old / nloc;
        if (old + 1u == (gen + 1u) * nloc) {
            __builtin_amdgcn_fence(__ATOMIC_RELEASE, "agent");
            asm volatile("s_waitcnt vmcnt(0)" ::: "memory");
            const unsigned og = xb_add(&bar[XB_TOP], 1u);
            const unsigned tg = og / nx;
            if (og + 1u == (tg + 1u) * nx) xb_add(&bar[XB_TOPGEN], 1u);
            else XB_SPIN(xb_ld(&bar[XB_TOPGEN]) == tg, bar);
            __builtin_amdgcn_fence(__ATOMIC_ACQUIRE, "agent");
            xb_add(&bar[XB_XGEN(b.x)], 1u);
            asm volatile("s_waitcnt vmcnt(0)" ::: "memory");
        } else {
            XB_SPIN(xb_ld(&bar[XB_XGEN(b.x)]) == gen, bar);
            __builtin_amdgcn_fence(__ATOMIC_ACQUIRE, "agent");
            asm volatile("s_waitcnt vmcnt(0)" ::: "memory");
        }
    }
    __syncthreads();
}

struct Args {
    const float* x_prompt; const float* x_sample; const float* w_in; const float* diff_lambda; const float* diff_subln; const float* mla_q_norm; const float* mla_w_uq;
    const float* mla_kv_norm; const float* mla_w_ukv; const float* w_out; const float* ln1_g; const float* ln1_b; const float* moe_w_coarse; const float* moe_w_fine;
    const float* moe_w1; const float* moe_w3; const float* moe_w2; const float* ln2_g; const float* ln2_b;
    float* out; unsigned char* ws; int ph_lo, ph_hi, use_bar, pad;
};
struct Frame {
    LAS unsigned char* lds; unsigned char* ldsg;
    int tid, lane, wave, G, gw, NGW, bid;
    gu32* ctl; unsigned char* ws;
};
__device__ __forceinline__ void launder(Frame& F) {
    int wv = F.wave; asm volatile("" : "+s"(wv)); F.wave = wv;
    int t; asm volatile("v_mbcnt_lo_u32_b32 %0, -1, 0\n\tv_mbcnt_hi_u32_b32 %0, -1, %0" : "=v"(t)); F.lane = t; F.tid = wv * 64 + t;
    int b = (int)blockIdx.x; asm volatile("" : "+s"(b)); F.bid = b; F.gw = b * NWAVES + F.wave;
    unsigned char* w = F.ws; asm volatile("" : "+s"(w)); F.ws = w; F.ctl = (gu32*)(w + WS_CTL);
}
struct SeqInfo { int base, len, pos; };
__device__ __forceinline__ SeqInfo seqinfo(int m) { SeqInfo s; if (m < NTOK_P) { s.base = m & ~2047; s.len = 2048; } else { s.base = m & ~4095; s.len = 4096; } s.pos = m - s.base; return s; }

template <class ColMap>
__device__ __forceinline__ void transpose_item(const float* W, int N, bf16_t* WT, int ldd, LAS float* scr, int k0, int n0, const ColMap& cm, const float* kscale, int lane) {
    const int sc = cm(n0 + (lane & 31));
#pragma unroll 8
    for (int i = 0; i < 32; ++i) { const int kk = 2 * i + (lane >> 5); float v = 0.f; if (sc >= 0) { v = W[(size_t)(k0 + kk) * N + sc]; if (kscale) v *= kscale[k0 + kk]; } scr[kk * 33 + (lane & 31)] = v; }
    LDS_WAIT(); asm volatile("" ::: "memory");
    const int c = lane & 7;
#pragma unroll
    for (int j = 0; j < 4; ++j) { const int n = (lane >> 3) + 8 * j; const LAS float* s = scr + (8 * c) * 33 + n;
        u32x4 o; o.x = pk2(s[0 * 33], s[1 * 33]); o.y = pk2(s[2 * 33], s[3 * 33]); o.z = pk2(s[4 * 33], s[5 * 33]); o.w = pk2(s[6 * 33], s[7 * 33]);
        *(u32x4*)(WT + (size_t)(n0 + n) * ldd + k0 + 8 * c) = o; }
    LDS_WAIT(); asm volatile("" ::: "memory");
}
__device__ __forceinline__ void transpose_item_v4(const float* Wsrc, int N, bf16_t* WTdst, int ldd, LAS float* scr, int lane) {
    const int c4 = (lane & 7) * 4, kr = lane >> 3;
    f32x4 t[8];
#pragma unroll
    for (int i = 0; i < 8; ++i) t[i] = *(const f32x4*)(Wsrc + (size_t)(i * 8 + kr) * N + c4);
#pragma unroll
    for (int i = 0; i < 8; ++i) { const int kk = i * 8 + kr; scr[(c4 + 0) * 65 + kk] = t[i].x; scr[(c4 + 1) * 65 + kk] = t[i].y; scr[(c4 + 2) * 65 + kk] = t[i].z; scr[(c4 + 3) * 65 + kk] = t[i].w; }
    LDS_WAIT(); asm volatile("" ::: "memory");
    const int c = lane & 7;
#pragma unroll
    for (int j = 0; j < 4; ++j) { const int n = (lane >> 3) + 8 * j; const LAS float* p = scr + n * 65 + 8 * c;
        u32x4 o; o.x = pk2(p[0], p[1]); o.y = pk2(p[2], p[3]); o.z = pk2(p[4], p[5]); o.w = pk2(p[6], p[7]);
        *(u32x4*)(WTdst + (size_t)n * ldd + 8 * c) = o; }
    LDS_WAIT(); asm volatile("" ::: "memory");
}
struct WinMap {
    __device__ __forceinline__ int operator()(int n) const {
        if (n < 512) { const int t = n & 31; return (n & ~31) + (t >> 1) + 16 * (t & 1); }
        if (n < 1152) return n;
        if (n < 1184) { const int t = n - 1152; return 1152 + (t >> 1) + 16 * (t & 1); }
        if (n < 1280) return -1;
        if (n < 2048) { const int u = n - 1280, t = u & 63; return 1184 + (u & ~63) + (t >> 1) + 32 * (t & 1); }
        if (n < 2432) return 1952 + (n - 2048);
        return -1;
    }
};
struct UqMap { __device__ __forceinline__ int operator()(int n) const { if (n >= 576) return -1; const int h = n / 96, t = n - 96 * h; if (t < 64) return n; const int u = t - 64; return 96 * h + 64 + (u >> 1) + 16 * (u & 1); } };
struct IdMap { __device__ __forceinline__ int operator()(int n) const { return n; } };
struct W13Map { __device__ __forceinline__ int operator()(int n) const { return (n >> 8) * 128 + (n & 127); } };

__device__ __forceinline__ void p0_prologue(Frame& F, const Args& a) {
    LAS float* scr = (LAS float*)(F.lds + F.wave * 16384);
    { float2* r32 = (float2*)(F.ws + WS_ROPE32); float2* r64 = (float2*)(F.ws + WS_ROPE64);
      for (int i = F.gw * 64 + F.lane; i < 4096 * 16; i += F.NGW * 64) { const int pos = i >> 4, j = i & 15; const float inv = 1.0f / powf(10000.0f, (float)(2 * j) / 32.0f); const float ang = (float)pos * inv; r32[i] = make_float2(cosf(ang), sinf(ang)); }
      for (int i = F.gw * 64 + F.lane; i < 4096 * 32; i += F.NGW * 64) { const int pos = i >> 5, j = i & 31; const float inv = 1.0f / powf(10000.0f, (float)(2 * j) / 64.0f); const float ang = (float)pos * inv; r64[i] = make_float2(cosf(ang), sinf(ang)); } }
    constexpr int I_WIN = (1024 / 64) * (2560 / 32), I_WOUT = (1024 / 64) * (1024 / 32), I_UQ = (256 / 64) * (768 / 32), I_UKV = (256 / 64) * (768 / 32);
    constexpr int PER_L = I_WIN + I_WOUT + I_UQ + I_UKV;
    for (int it = F.gw; it < DEPTH * PER_L; it += F.NGW) {
        const int l = it / PER_L; int r = it - l * PER_L;
        if (r < I_WIN) { const int kb = r / 80, nb = r % 80; transpose_item(a.w_in + (size_t)l * 1024 * 2336, 2336, (bf16_t*)(F.ws + WS_WIN) + (size_t)l * 2560 * 1024, 1024, scr, kb * 64, nb * 32, WinMap(), nullptr, F.lane); continue; } r -= I_WIN;
        if (r < I_WOUT) { const int kb = r / 32, nb = r % 32; transpose_item(a.w_out + (size_t)l * 1024 * 1024, 1024, (bf16_t*)(F.ws + WS_WOUT) + (size_t)l * 1024 * 1024, 1024, scr, kb * 64, nb * 32, IdMap(), nullptr, F.lane); continue; } r -= I_WOUT;
        if (r < I_UQ) { const int kb = r / 24, nb = r % 24; transpose_item(a.mla_w_uq + (size_t)l * 256 * 576, 576, (bf16_t*)(F.ws + WS_WUQ) + (size_t)l * 768 * 256, 256, scr, kb * 64, nb * 32, UqMap(), a.mla_q_norm + l * 256, F.lane); continue; } r -= I_UQ;
        { const int kb = r / 24, nb = r % 24; bf16_t* dst = (bf16_t*)(F.ws + WS_WUKV) + (size_t)l * 768 * 256;
          if (kb < 2) transpose_item(a.mla_w_ukv + (size_t)l * 128 * 768, 768, dst, 256, scr, kb * 64, nb * 32, IdMap(), a.mla_kv_norm + l * 128, F.lane);
          else { const int c = F.lane & 7;
#pragma unroll
              for (int j = 0; j < 4; ++j) { const int n = (F.lane >> 3) + 8 * j; *(u32x4*)(dst + (size_t)(nb * 32 + n) * 256 + kb * 64 + 8 * c) = (u32x4){0u, 0u, 0u, 0u}; } } }
    }
    bf16_t* XB = (bf16_t*)(F.ws + WS_XB);
    for (int m = F.gw; m < NTOK; m += F.NGW) {
        const float* src = (m < NTOK_P) ? a.x_prompt + (size_t)m * DM : a.x_sample + (size_t)(m - NTOK_P) * DM;
#pragma unroll
        for (int j = 0; j < 4; ++j) { const f32x4 v = *((const f32x4*)src + F.lane + 64 * j);
            u32x2 w; w.x = pk2(v.x, v.y); w.y = pk2(v.z, v.w); *((u32x2*)(XB + (size_t)m * DM) + F.lane + 64 * j) = w; }
    }
}

template <class Epi, class RowMap>
__device__ __forceinline__ void sg_tile(const bf16_t* A, int lda, const bf16_t* B0, const bf16_t* B1, int ldb, int K, int m0, int c0, const Epi& E, const RowMap& RM, int lane) {
    const int r32 = lane & 31, hi = lane >> 5;
    const bf16_t* ap = A + (size_t)RM.src(m0 + r32) * lda + 8 * hi;
    const bf16_t* b0p = B0 + (size_t)r32 * ldb + 8 * hi;
    const bf16_t* b1p = B1 + (size_t)r32 * ldb + 8 * hi;
    f32x16 acc0 = {}, acc1 = {};
#pragma unroll 4
    for (int k = 0; k < K; k += 16) {
        const bf16x8 af = *(const bf16x8*)(ap + k), bf0 = *(const bf16x8*)(b0p + k), bf1 = *(const bf16x8*)(b1p + k);
        acc0 = MFMA32(bf0, af, acc0); acc1 = MFMA32(bf1, af, acc1);
    }
#pragma unroll
    for (int g = 0; g < 4; ++g) { const f32x4 v0 = {acc0[4 * g], acc0[4 * g + 1], acc0[4 * g + 2], acc0[4 * g + 3]}, v1 = {acc1[4 * g], acc1[4 * g + 1], acc1[4 * g + 2], acc1[4 * g + 3]};
        E.put(m0 + r32, c0, 8 * g + 4 * hi, v0, v1); }
}
struct IdRows { __device__ __forceinline__ int src(int m) const { return m; } };

__device__ __forceinline__ void store_bf8(bf16_t* p, f32x4 a, f32x4 b) { u32x4 w; w.x = pk2(a.x, a.y); w.y = pk2(a.z, a.w); w.z = pk2(b.x, b.y); w.w = pk2(b.z, b.w); *(u32x4*)p = w; }
__device__ __forceinline__ void store_bf4(bf16_t* p, f32x4 v) { u32x2 w; w.x = pk2(v.x, v.y); w.y = pk2(v.z, v.w); *(u32x2*)p = w; }
struct EpiH {
    static constexpr bool INPLACE = false;
    static constexpr bool PERM = true;
    bf16_t* H; const float2* rope32; const float2* rope64;
    __device__ __forceinline__ f32x4 xf(int pos, int col, f32x4 v) const {
        if (col < 512 || (col >= HC_KROPE && col < HC_KROPE + 32)) {
            const int j0 = (col & 31) >> 1; const f32x4 cs = *(const f32x4*)(rope32 + pos * 16 + j0);
            f32x4 o; o.x = v.x * cs.x - v.y * cs.y; o.y = v.x * cs.y + v.y * cs.x; o.z = v.z * cs.z - v.w * cs.w; o.w = v.z * cs.w + v.w * cs.z;
            if (col < 256) o = o * SC_A; v = o;
        } else if (col >= HC_CQ && col < HC_CV) {
            const int j0 = ((col - HC_CQ) & 63) >> 1; const f32x4 cs = *(const f32x4*)(rope64 + pos * 32 + j0);
            f32x4 o; o.x = v.x * cs.x - v.y * cs.y; o.y = v.x * cs.y + v.y * cs.x; o.z = v.z * cs.z - v.w * cs.w; o.w = v.z * cs.w + v.w * cs.z;
            if (col < HC_CK) o = o * SC_C; v = o;
        }
        return v;
    }
    __device__ __forceinline__ void put4(int row, int col, f32x4 v) const { store_bf4(H + (size_t)row * HP + col, xf(seqinfo(row).pos, col, v)); }
    __device__ __forceinline__ void put(int row, int c0, int cc, f32x4 v0, f32x4 v1) const { put4(row, c0 + cc, v0); put4(row, c0 + 32 + cc, v1); }
    template <class U> __device__ __forceinline__ void put8(const U&, int row, int col, f32x4 v0, f32x4 v1) const { const int pos = seqinfo(row).pos; store_bf8(H + (size_t)row * HP + col, xf(pos, col, v0), xf(pos, col + 4, v1)); }
    struct Pre { f32x4 c0, c1; };
    __device__ __forceinline__ static f32x4 rot(f32x4 v, f32x4 cs) { f32x4 o; o.x = v.x * cs.x - v.y * cs.y; o.y = v.x * cs.y + v.y * cs.x; o.z = v.z * cs.z - v.w * cs.w; o.w = v.z * cs.w + v.w * cs.z; return o; }
    template <class U> __device__ __forceinline__ Pre pre(const U&, int row, int col) const { Pre p; p.c0 = (f32x4){0.f, 0.f, 0.f, 0.f}; p.c1 = p.c0; const int pos = seqinfo(row).pos;
        if (col < 512 || (col >= HC_KROPE && col < HC_KROPE + 32)) { const f32x4* t = (const f32x4*)(rope32 + pos * 16 + ((col & 31) >> 1)); p.c0 = t[0]; p.c1 = t[1]; }
        else if (col >= HC_CQ && col < HC_CV) { const f32x4* t = (const f32x4*)(rope64 + pos * 32 + (((col - HC_CQ) & 63) >> 1)); p.c0 = t[0]; p.c1 = t[1]; }
        return p; }
    template <class U> __device__ __forceinline__ void fin8(const U&, int row, int col, f32x4 v0, f32x4 v1, const Pre& p) const {
        if (col < 512 || (col >= HC_KROPE && col < HC_KROPE + 32)) { v0 = rot(v0, p.c0); v1 = rot(v1, p.c1); if (col < 256) { v0 = v0 * SC_A; v1 = v1 * SC_A; } }
        else if (col >= HC_CQ && col < HC_CV) { v0 = rot(v0, p.c0); v1 = rot(v1, p.c1); if (col < HC_CK) { v0 = v0 * SC_C; v1 = v1 * SC_C; } }
        store_bf8(H + (size_t)row * HP + col, v0, v1); }
};
struct EpiUQ {
    static constexpr bool INPLACE = false;
    static constexpr bool PERM = true;
    bf16_t* Q; const float* rstd; const float2* rope32;
    __device__ __forceinline__ f32x4 xf(int row, int col, f32x4 v, float rs) const {
        v = v * rs;
        const int t = col % 96;
        if (t >= 64) { const int pos = seqinfo(row).pos; const int j0 = (t - 64) >> 1; const f32x4 cs = *(const f32x4*)(rope32 + pos * 16 + j0);
            f32x4 o; o.x = v.x * cs.x - v.y * cs.y; o.y = v.x * cs.y + v.y * cs.x; o.z = v.z * cs.z - v.w * cs.w; o.w = v.z * cs.w + v.w * cs.z; v = o; }
        return v * SC_B;
    }
    __device__ __forceinline__ void put4(int row, int col, f32x4 v) const { if (col >= 576) return; store_bf4(Q + (size_t)row * QBP + col, xf(row, col, v, rstd[2 * row])); }
    template <class U> __device__ __forceinline__ void put8(const U&, int row, int col, f32x4 v0, f32x4 v1) const { if (col >= 576) return; const float rs = rstd[2 * row]; store_bf8(Q + (size_t)row * QBP + col, xf(row, col, v0, rs), xf(row, col + 4, v1, rs)); }
    __device__ __forceinline__ void put(int row, int c0, int cc, f32x4 v0, f32x4 v1) const { put4(row, c0 + cc, v0); put4(row, c0 + 32 + cc, v1); }
    struct Pre { float rs; f32x4 c0, c1; };
    template <class U> __device__ __forceinline__ Pre pre(const U&, int row, int col) const { Pre p; p.rs = rstd[2 * row]; p.c0 = (f32x4){0.f, 0.f, 0.f, 0.f}; p.c1 = p.c0;
        if (col < 576 && (col % 96) >= 64) { const f32x4* t = (const f32x4*)(rope32 + seqinfo(row).pos * 16 + (((col % 96) - 64) >> 1)); p.c0 = t[0]; p.c1 = t[1]; }
        return p; }
    template <class U> __device__ __forceinline__ void fin8(const U&, int row, int col, f32x4 v0, f32x4 v1, const Pre& p) const { if (col >= 576) return;
        v0 = v0 * p.rs; v1 = v1 * p.rs; if ((col % 96) >= 64) { v0 = EpiH::rot(v0, p.c0); v1 = EpiH::rot(v1, p.c1); }
        store_bf8(Q + (size_t)row * QBP + col, v0 * SC_B, v1 * SC_B); }
};
struct EpiUKV {
    static constexpr bool INPLACE = false;
    static constexpr bool PERM = true;
    bf16_t* KV; const float* rstd;
    template <class U> __device__ __forceinline__ void put8(const U&, int row, int col, f32x4 v0, f32x4 v1) const { const float rs = rstd[2 * row + 1]; store_bf8(KV + (size_t)row * KVP + col, v0 * rs, v1 * rs); }
    __device__ __forceinline__ void put4(int row, int col, f32x4 v) const { store_bf4(KV + (size_t)row * KVP + col, v * rstd[2 * row + 1]); }
    __device__ __forceinline__ void put(int row, int c0, int cc, f32x4 v0, f32x4 v1) const { put4(row, c0 + cc, v0); put4(row, c0 + 32 + cc, v1); }
    struct Pre { float rs; };
    template <class U> __device__ __forceinline__ Pre pre(const U&, int row, int) const { Pre p; p.rs = rstd[2 * row + 1]; return p; }
    template <class U> __device__ __forceinline__ void fin8(const U&, int row, int col, f32x4 v0, f32x4 v1, const Pre& p) const { store_bf8(KV + (size_t)row * KVP + col, v0 * p.rs, v1 * p.rs); }
};
struct EpiRes {
    static constexpr bool INPLACE = false;
    static constexpr bool PERM = false;
    const bf16_t* XR; float* D;
    static __device__ __forceinline__ f32x4 up4(u32x2 w) { f32x4 r; r.x = bf2f(w.x & 0xffff); r.y = bf2f(w.x >> 16); r.z = bf2f(w.y & 0xffff); r.w = bf2f(w.y >> 16); return r; }
    template <class U> __device__ __forceinline__ void put4(const U&, int row, int col, f32x4 v) const { put4(row, col, v); }
    __device__ __forceinline__ void put4(int row, int col, f32x4 v) const {
        const f32x4 r = up4(*(const u32x2*)(XR + (size_t)row * DM + col));
        *(f32x4*)(D + (size_t)row * DM + col) = r * DN_ALPHA + v; }
    __device__ __forceinline__ void put(int row, int c0, int cc, f32x4 v0, f32x4 v1) const { put4(row, c0 + cc, v0); put4(row, c0 + 32 + cc, v1); }
    struct Pre { u32x2 a, b; };
    template <class U> __device__ __forceinline__ Pre pre(const U&, int row, int col) const { Pre p;
        const bf16_t* src = XR + (size_t)row * DM;
        p.a = *(const u32x2*)(src + col); p.b = *(const u32x2*)(src + col + 16); return p; }
    template <class U> __device__ __forceinline__ void fin4x2(const U&, int row, int col, f32x4 v0, f32x4 v1, const Pre& p) const {
        *(f32x4*)(D + (size_t)row * DM + col) = up4(p.a) * DN_ALPHA + v0; *(f32x4*)(D + (size_t)row * DM + col + 16) = up4(p.b) * DN_ALPHA + v1; }
};
__device__ __forceinline__ float silu_f(float x) { return x / (1.0f + __expf(-x)); }
struct EpiHid {
    static constexpr bool INPLACE = false;
    static constexpr bool PERM = true;
    bf16_t* HID;
    __device__ __forceinline__ f32x4 act(f32x4 g, f32x4 u) const { f32x4 o; o.x = silu_f(g.x) * u.x; o.y = silu_f(g.y) * u.y; o.z = silu_f(g.z) * u.z; o.w = silu_f(g.w) * u.w; return o; }
    template <class U> __device__ __forceinline__ void putp8(const U&, int row, int col, f32x4 g0, f32x4 g1, f32x4 u0, f32x4 u1) const { store_bf8(HID + (size_t)row * DEXP + col, act(g0, u0), act(g1, u1)); }
    __device__ __forceinline__ void putp(int row, int col, f32x4 g, f32x4 u) const { f32x4 o; o.x = silu_f(g.x) * u.x; o.y = silu_f(g.y) * u.y; o.z = silu_f(g.z) * u.z; o.w = silu_f(g.w) * u.w; store_bf4(HID + (size_t)row * DEXP + col, o); }
    __device__ __forceinline__ void put(int row, int c0, int cc, f32x4 v0, f32x4 v1) const { putp(row, c0 + cc, v0, v1); }
};
struct EpiY {
    static constexpr bool INPLACE = false;
    bf16_t* YB; const float* tw; const int* list; int seg0, cnt;
    __device__ __forceinline__ void put4(int row, int col, f32x4 v) const { const int r = row - seg0; if (r >= cnt) return; const int a = list[r]; store_bf4(YB + (size_t)a * DM + col, v * tw[a]); }
    __device__ __forceinline__ void put(int row, int c0, int cc, f32x4 v0, f32x4 v1) const { put4(row, c0 + cc, v0); put4(row, c0 + 32 + cc, v1); }
};

struct EpiYO {
    static constexpr bool INPLACE = false;
    static constexpr bool PERM = true;
    bf16_t* YB; const float* tw; const int* list; const LAS int* seg; const float* lw;
    template <class U> __device__ __forceinline__ void put8(const U& u, int row, int col, f32x4 v0, f32x4 v1) const {
        const int r = row - __builtin_amdgcn_readfirstlane(seg[u.e]); if (r >= __builtin_amdgcn_readfirstlane(seg[33 + u.e])) return; const int a = list[(size_t)u.e * LIST_CAP + r]; const float w = tw[a]; store_bf8(YB + (size_t)a * DM + col, v0 * w, v1 * w); }
    struct Pre { int a; float w; };
    template <class U> __device__ __forceinline__ Pre pre(const U& u, int row, int) const { Pre p; p.a = -1; p.w = 0.f;
        const int r = row - __builtin_amdgcn_readfirstlane(seg[u.e]); if (r < __builtin_amdgcn_readfirstlane(seg[33 + u.e])) { p.a = list[(size_t)u.e * LIST_CAP + r]; p.w = lw[(size_t)u.e * LIST_CAP + r]; } return p; }
    template <class U> __device__ __forceinline__ void fin8(const U&, int, int col, f32x4 v0, f32x4 v1, const Pre& p) const { if (p.a >= 0) store_bf8(YB + (size_t)p.a * DM + col, v0 * p.w, v1 * p.w); }
};
template <class Epi>
__device__ __forceinline__ void sg_phase(Frame& F, const bf16_t* A, int lda, const bf16_t* Bt, int ldb, int M, int N, int K, const Epi& E) {
    const int nN = N / 64, items = (M / 32) * nN;
    for (int it = F.gw; it < items; it += F.NGW) { const int mt = it / nN, nt = it - mt * nN;
        sg_tile(A, lda, Bt + (size_t)(nt * 64) * ldb, Bt + (size_t)(nt * 64 + 32) * ldb, ldb, K, mt * 32, nt * 64, E, IdRows(), F.lane); }
}


namespace pg8 {
constexpr int BM = 256, BK = 64, HALF = 128, HTB = HALF * BK * 2, NXCD = 8, WGM = 8;
__host__ __device__ __forceinline__ int lds_byte(int r, int c) { const int st = (r >> 4) * 2 + (c >> 5), rr = r & 15, cc = c & 31, ob = rr * 64 + cc * 2; return st * 1024 + (ob ^ (((ob >> 9) & 1) << 5)); }
__host__ __device__ __forceinline__ void stage_rc(int b, int& R, int& C) { const int st = b / 1024, sb = b % 1024, swz = sb ^ (((sb >> 9) & 1) << 5); R = (st >> 1) * 16 + swz / 64; C = (st & 1) * 32 + (swz % 64) / 2; }
__host__ __device__ __forceinline__ int perm32(int rho) { const int n = rho >> 4, i = rho & 15; return 8 * (i >> 2) + 4 * n + (i & 3); }
struct Unit { int pm, pn, e; const char* a; const char* b; };
__device__ __forceinline__ bool order_next(int i, int G, int c, int nM, int nN, int& pm, int& pn) {
    const int nwg = nM * nN; const long L = (long)i * G + c; if (L >= nwg) return false;
    int wgid = (int)L; { const int q = nwg / NXCD, r = nwg % NXCD, xcd = wgid % NXCD, off = wgid / NXCD; wgid = (xcd < r ? xcd * (q + 1) : r * (q + 1) + (xcd - r) * q) + off; }
    const int nig = WGM * nN, gid = wgid / nig, fm = gid * WGM, gsz = (nM - fm) < WGM ? (nM - fm) : WGM;
    pm = fm + ((wgid % nig) % gsz); pn = (wgid % nig) / gsz; return true;
}
struct DenseSched {
    const char* A; const char* Bt; int nM, nN, G, c; size_t tstepA, tstepB;
    __device__ __forceinline__ void init(const bf16_t* A_, int lda, const bf16_t* Bt_, int M, int N, int K, int G_, int c_) { A = (const char*)A_; Bt = (const char*)Bt_; nM = M / BM; nN = N / BM; G = G_; c = c_; tstepA = (size_t)BM * lda * 2; tstepB = (size_t)BM * K * 2; }
    __device__ __forceinline__ bool next(int i, Unit& u) const { if (!order_next(i, G, c, nM, nN, u.pm, u.pn)) return false; u.e = 0; u.a = A + (size_t)u.pm * tstepA; u.b = Bt + (size_t)u.pn * tstepB; return true; }
    __device__ __forceinline__ unsigned arow(const Unit&, int) const { return 0u; }
};
struct PanelSched {
    const char* A; const char* Bt; int pm, nN; size_t tstepB;
    __device__ __forceinline__ void init(const bf16_t* A_, int lda, const bf16_t* Bt_, int pm_, int N, int K) { pm = pm_; nN = N / BM; A = (const char*)A_ + (size_t)pm_ * BM * lda * 2; Bt = (const char*)Bt_; tstepB = (size_t)BM * K * 2; }
    __device__ __forceinline__ bool next(int i, Unit& u) const { if (i >= nN) return false; u.pm = pm; int pn = i + (pm % nN); if (pn >= nN) pn -= nN; u.pn = pn; u.e = 0; u.a = A; u.b = Bt + (size_t)pn * tstepB; return true; }
    __device__ __forceinline__ unsigned arow(const Unit&, int) const { return 0u; }
};
template <class Epi, bool PAIR> struct EpiApply;
template <class Epi, class Sched, bool GATHER, bool PAIR>
__device__ __forceinline__ void gemm_phase(LAS unsigned char* lds, int tid, int K, int lda, const Sched& S, const Epi& E) {
    const int wid = __builtin_amdgcn_readfirstlane(tid >> 6), lane = tid & 63, wr = wid >> 2, wc = wid & 3, fr = lane & 15, fq = lane >> 4;
    const int nt = K / BK;
    unsigned voffA[2], voffB[2]; int RA[2], CA[2];
#pragma unroll
    for (int i = 0; i < 2; ++i) { int R, C; stage_rc(tid * 16 + i * 8192, R, C); const int Rb = Epi::PERM ? ((R & ~31) + perm32(R & 31)) : R; RA[i] = R; CA[i] = C;
        voffA[i] = (unsigned)(R * lda + C) * 2u; voffB[i] = (unsigned)(Rb * K + C) * 2u; }
    const size_t kstep = (size_t)(BK * 2);
    const size_t hstepA = (size_t)HALF * lda * 2, hstepB = (size_t)HALF * K * 2;
    const unsigned ldsw = (unsigned)wid * 1024u;
    const int aoff = lds_byte(wr * 64 + fr, fq * 8), boff = lds_byte(wc * 32 + fr, fq * 8);
#define PG8_SA(b, h) (((b) * 2 + (h)) * HTB)
#define PG8_SB(b, h) ((4 + (b) * 2 + (h)) * HTB)
#define PG8_STAGE(bufoff, gbase, voff) do { _Pragma("unroll") for (int _i = 0; _i < 2; ++_i) \
        __builtin_amdgcn_global_load_lds((const unsigned*)((const char*)(gbase) + (voff)[_i]), (LAS unsigned*)(lds + (bufoff) + ldsw + _i * 8192), 16, 0, 0); } while (0)
#define PG8_STAGE_A(bufoff, ab, vg, h, koff) do { if (GATHER) { PG8_STAGE(bufoff, (ab) + (koff), (vg)[h]); } else { PG8_STAGE(bufoff, (ab) + (h) * hstepA + (koff), voffA); } } while (0)
#define PG8_LDA(dst, b, h) do { _Pragma("unroll") for (int m = 0; m < 4; ++m) _Pragma("unroll") for (int k = 0; k < 2; ++k) dst[m][k] = *(const LAS bf16x8*)(lds + PG8_SA(b, h) + aoff + m * 2048 + k * 1024); } while (0)
#define PG8_LDB(dst, b, h) do { _Pragma("unroll") for (int n = 0; n < 2; ++n) _Pragma("unroll") for (int k = 0; k < 2; ++k) dst[n][k] = *(const LAS bf16x8*)(lds + PG8_SB(b, h) + boff + n * 2048 + k * 1024); } while (0)
#define PG8_MMA(ai, bj, At, Bt) do { __builtin_amdgcn_s_setprio(1); _Pragma("unroll") for (int m = 0; m < 4; ++m) _Pragma("unroll") for (int n = 0; n < 2; ++n) _Pragma("unroll") for (int k = 0; k < 2; ++k) \
        acc[ai][bj][m][n] = __builtin_amdgcn_mfma_f32_16x16x32_bf16(Bt[n][k], At[m][k], acc[ai][bj][m][n], 0, 0, 0); __builtin_amdgcn_s_setprio(0); } while (0)
#define PG8_WAIT_V(n) asm volatile("s_waitcnt vmcnt(" #n ")" ::: "memory")
#define PG8_WAIT_L(n) asm volatile("s_waitcnt lgkmcnt(" #n ")" ::: "memory")
#define PG8_BAR __builtin_amdgcn_s_barrier()
#define PG8_SCHED __builtin_amdgcn_sched_barrier(0)
    Unit cur, nxt; int ui = 0;
    if (!S.next(0, cur)) return;
    f32x4 acc[2][2][4][2];
#pragma unroll
    for (int a = 0; a < 2; ++a)
#pragma unroll
        for (int b = 0; b < 2; ++b)
#pragma unroll
            for (int m = 0; m < 4; ++m)
#pragma unroll
                for (int n = 0; n < 2; ++n) acc[a][b][m][n] = (f32x4){0.f, 0.f, 0.f, 0.f};
    bf16x8 At[4][2], B0[2][2], B1[2][2];
    unsigned vgc[2][2] = {{0u, 0u}, {0u, 0u}}, vgn[2][2] = {{0u, 0u}, {0u, 0u}};
    if (GATHER) {
#pragma unroll
        for (int h = 0; h < 2; ++h)
#pragma unroll
            for (int i = 0; i < 2; ++i) vgc[h][i] = S.arow(cur, h * HALF + RA[i]) * (unsigned)(lda * 2) + (unsigned)CA[i] * 2u;
    }
    const char* cA = cur.a; const char* cB = cur.b;
    PG8_STAGE(PG8_SB(0, 0), cB, voffB); PG8_STAGE(PG8_SB(0, 1), cB + hstepB, voffB); PG8_STAGE_A(PG8_SA(0, 0), cA, vgc, 0, 0); PG8_STAGE_A(PG8_SA(0, 1), cA, vgc, 1, 0);
    if (wr == 1) PG8_BAR;
    PG8_WAIT_V(2); PG8_BAR;
    PG8_STAGE(PG8_SB(1, 0), cB + kstep, voffB); PG8_STAGE_A(PG8_SA(1, 0), cA, vgc, 0, kstep); PG8_STAGE(PG8_SB(1, 1), cB + hstepB + kstep, voffB);
    PG8_WAIT_V(6); PG8_BAR;
    for (;;) {
        const bool has_next = S.next(ui + 1, nxt);
        const char* nA = has_next ? nxt.a : cA; const char* nB = has_next ? nxt.b : cB;
        if (GATHER) {
#pragma unroll
            for (int h = 0; h < 2; ++h)
#pragma unroll
                for (int i = 0; i < 2; ++i) vgn[h][i] = has_next ? (S.arow(nxt, h * HALF + RA[i]) * (unsigned)(lda * 2) + (unsigned)CA[i] * 2u) : vgc[h][i];
        }
#pragma clang loop unroll(disable)
        for (int t = 0; t < nt; t += 2) {
            const bool last = (t == nt - 2);
            const size_t k1 = (size_t)(t + 1) * kstep;
            const char* a2 = last ? nA : cA; const char* b2 = last ? nB : cB + (size_t)(t + 2) * kstep; const size_t ka2 = last ? 0 : (size_t)(t + 2) * kstep;
            const char* b3 = b2 + kstep; const size_t ka3 = ka2 + kstep;
            unsigned v2[2][2];
#pragma unroll
            for (int h = 0; h < 2; ++h)
#pragma unroll
                for (int i = 0; i < 2; ++i) v2[h][i] = last ? vgn[h][i] : vgc[h][i];
            PG8_LDB(B0, 0, 0); PG8_LDB(B1, 0, 1); PG8_SCHED; PG8_LDA(At, 0, 0); PG8_STAGE_A(PG8_SA(1, 1), cA, vgc, 1, k1);
            PG8_WAIT_V(8); PG8_WAIT_L(0); PG8_BAR; PG8_MMA(0, 0, At, B0); PG8_MMA(0, 1, At, B1); PG8_BAR; PG8_SCHED;
            PG8_LDA(At, 0, 1); PG8_STAGE(PG8_SB(0, 0), b2, voffB); PG8_STAGE(PG8_SB(0, 1), b2 + hstepB, voffB); PG8_STAGE_A(PG8_SA(0, 0), a2, v2, 0, ka2);
            PG8_WAIT_V(8); PG8_WAIT_L(0); PG8_BAR; PG8_MMA(1, 0, At, B0); PG8_MMA(1, 1, At, B1); PG8_BAR; PG8_SCHED;
            PG8_LDB(B0, 1, 0); PG8_LDB(B1, 1, 1); PG8_SCHED; PG8_LDA(At, 1, 0); PG8_STAGE_A(PG8_SA(0, 1), a2, v2, 1, ka2);
            PG8_WAIT_V(8); PG8_WAIT_L(0); PG8_BAR; PG8_MMA(0, 0, At, B0); PG8_MMA(0, 1, At, B1); PG8_BAR; PG8_SCHED;
            PG8_LDA(At, 1, 1); PG8_STAGE(PG8_SB(1, 0), b3, voffB); PG8_STAGE(PG8_SB(1, 1), b3 + hstepB, voffB); PG8_STAGE_A(PG8_SA(1, 0), a2, v2, 0, ka3);
            PG8_WAIT_V(8); PG8_WAIT_L(0); PG8_BAR; PG8_MMA(1, 0, At, B0); PG8_MMA(1, 1, At, B1); PG8_BAR; PG8_SCHED;
        }
        if (wr == 0) PG8_BAR;
        { int fr_ = fr, fq_ = fq; asm volatile("" : "+v"(fr_), "+v"(fq_));
          EpiApply<Epi, PAIR>::run(E, acc, cur, wr, wc, fr_, fq_);
#ifdef PROBE_DUP_EPI
          if (!Epi::INPLACE) { asm volatile("" : "+v"(fr_), "+v"(fq_)); EpiApply<Epi, PAIR>::run(E, acc, cur, wr, wc, fr_, fq_); }
#endif
          }
        if (!has_next) break;
#pragma unroll
        for (int a = 0; a < 2; ++a)
#pragma unroll
            for (int b = 0; b < 2; ++b)
#pragma unroll
                for (int m = 0; m < 4; ++m)
#pragma unroll
                    for (int n = 0; n < 2; ++n) acc[a][b][m][n] = (f32x4){0.f, 0.f, 0.f, 0.f};
        cur = nxt; cA = nA; cB = nB; ++ui;
        if (GATHER) {
#pragma unroll
            for (int h = 0; h < 2; ++h)
#pragma unroll
                for (int i = 0; i < 2; ++i) vgc[h][i] = vgn[h][i];
        }
        if (wr == 1) PG8_BAR;
    }
    PG8_WAIT_V(0);
    PG8_BAR;
#undef PG8_SA
#undef PG8_SB
#undef PG8_STAGE
#undef PG8_STAGE_A
#undef PG8_LDA
#undef PG8_LDB
#undef PG8_MMA
#undef PG8_WAIT_V
#undef PG8_WAIT_L
#undef PG8_BAR
#undef PG8_SCHED
}
template <class Epi> struct EpiApply<Epi, false> {
    static __device__ __forceinline__ void run(const Epi& E, const f32x4 (&acc)[2][2][4][2], const Unit& u, int wr, int wc, int fr, int fq) {
#pragma unroll
        for (int ai = 0; ai < 2; ++ai) {
            typename Epi::Pre pre[4][2];
#pragma unroll
            for (int m = 0; m < 4; ++m) { const int row = u.pm * BM + ai * HALF + wr * 64 + m * 16 + fr;
#pragma unroll
                for (int bj = 0; bj < 2; ++bj) pre[m][bj] = E.pre(u, row, u.pn * BM + bj * HALF + wc * 32 + (Epi::PERM ? 8 : 4) * fq); }
#pragma unroll
            for (int m = 0; m < 4; ++m) { const int row = u.pm * BM + ai * HALF + wr * 64 + m * 16 + fr;
#pragma unroll
                for (int bj = 0; bj < 2; ++bj) {
                    if constexpr (Epi::PERM) E.fin8(u, row, u.pn * BM + bj * HALF + wc * 32 + 8 * fq, acc[ai][bj][m][0], acc[ai][bj][m][1], pre[m][bj]);
                    else E.fin4x2(u, row, u.pn * BM + bj * HALF + wc * 32 + 4 * fq, acc[ai][bj][m][0], acc[ai][bj][m][1], pre[m][bj]); } }
        }
    }
};
template <class Epi> struct EpiApply<Epi, true> {
    static __device__ __forceinline__ void run(const Epi& E, const f32x4 (&acc)[2][2][4][2], const Unit& u, int wr, int wc, int fr, int fq) {
#pragma unroll
        for (int ai = 0; ai < 2; ++ai)
#pragma unroll
            for (int m = 0; m < 4; ++m) { const int row = u.pm * BM + ai * HALF + wr * 64 + m * 16 + fr;
                E.putp8(u, row, u.pn * HALF + wc * 32 + 8 * fq, acc[ai][0][m][0], acc[ai][0][m][1], acc[ai][1][m][0], acc[ai][1][m][1]); }
    }
};
}

__device__ __forceinline__ void rowstat_pass(Frame& F, int r_first, int r_stride, int r_end) {
    const bf16_t* H = (const bf16_t*)(F.ws + WS_H); float* rstd = (float*)(F.ws + WS_RSTD);
    for (int m = r_first; m < r_end; m += r_stride) {
        const bf16_t* hr = H + (size_t)m * HP;
        const u32x2 q = *((const u32x2*)(hr + HC_CQ_LAT) + F.lane);
        const unsigned kv = *((const unsigned*)(hr + HC_CKV) + F.lane);
        float a0 = bf2f(q.x & 0xffff), a1 = bf2f(q.x >> 16), a2 = bf2f(q.y & 0xffff), a3 = bf2f(q.y >> 16), b0 = bf2f(kv & 0xffff), b1 = bf2f(kv >> 16);
        const float sq = wave_sum(a0 * a0 + a1 * a1 + a2 * a2 + a3 * a3), sk = wave_sum(b0 * b0 + b1 * b1);
        if (F.lane == 0) { rstd[2 * m] = 1.0f / sqrtf(sq * (1.0f / 256.0f) + RMS_EPS); rstd[2 * m + 1] = 1.0f / sqrtf(sk * (1.0f / 128.0f) + RMS_EPS); }
    }
}
__device__ __forceinline__ void red8(float (&v)[8], int lane) {
    float a[4], b[2], c;
#pragma unroll
    for (int i = 0; i < 4; ++i) a[i] = xpair32(v[i], v[i + 4]);
    { const bool up = (lane & 16) != 0;
#pragma unroll
      for (int i = 0; i < 2; ++i) { const float send = up ? a[i] : a[i + 2], keep = up ? a[i + 2] : a[i]; b[i] = keep + shx<16>(send); } }
    { const bool up = (lane & 8) != 0; const float send = up ? b[0] : b[1], keep = up ? b[1] : b[0]; c = keep + shx<8>(send); }
    c += shx<4>(c); c += shx<2>(c); c += shx<1>(c);
#pragma unroll
    for (int i = 0; i < 8; ++i) v[i] = __uint_as_float(__builtin_amdgcn_readlane(__float_as_uint(c), ((i >> 2) & 1) * 32 + ((i >> 1) & 1) * 16 + (i & 1) * 8));
}
__device__ __forceinline__ void red4(float (&v)[4], int lane) {
    float a[2], c;
#pragma unroll
    for (int i = 0; i < 2; ++i) a[i] = xpair32(v[i], v[i + 2]);
    { const bool up = (lane & 16) != 0; const float send = up ? a[0] : a[1], keep = up ? a[1] : a[0]; c = keep + shx<16>(send); }
    c += shx<8>(c); c += shx<4>(c); c += shx<2>(c); c += shx<1>(c);
#pragma unroll
    for (int i = 0; i < 4; ++i) v[i] = __uint_as_float(__builtin_amdgcn_readlane(__float_as_uint(c), ((i >> 1) & 1) * 32 + (i & 1) * 16));
}
__device__ __forceinline__ void ln1_route_pass(Frame& F, const Args& a, int layer, int r_first, int r_stride, int r_end) {
    bf16_t* XB = (bf16_t*)(F.ws + WS_XB); float* tw = (float*)(F.ws + WS_TW); int* list = (int*)(F.ws + WS_LIST);
    const float* g = a.ln1_g + layer * DM; const float* bb = a.ln1_b + layer * DM;
    const float* wc = a.moe_w_coarse + (size_t)layer * DM * 4; const float* wf = a.moe_w_fine + (size_t)layer * 4 * DM * 8;
    for (int q = F.tid; q < 4 * 1024 * 2; q += NTHREADS) { const int hf = q & 1, k = (q >> 1) & 1023, gg = q >> 11; const int l = (k & 255) >> 2, e = k & 3, j = k >> 8;
        *(LAS f32x4*)(F.lds + (size_t)(gg * 2048 + ((j * 4 + e) * 2 + hf) * 64 + l) * 16) = *((const f32x4*)wf + q); }
    f32x4 wcr[4][4];
#pragma unroll
    for (int j = 0; j < 4; ++j)
#pragma unroll
        for (int e = 0; e < 4; ++e) wcr[j][e] = *(const f32x4*)(wc + (size_t)(4 * F.lane + 256 * j + e) * 4);
    __syncthreads();
    LAS int* lcnt = (LAS int*)(F.lds + RING_BYTES + 1024); LAS int* lbase = lcnt + 32; LAS int* rec_er = lcnt + 64; LAS int* rec_a = rec_er + 512; LAS float* rec_w = (LAS float*)(rec_a + 512); float* lw = (float*)(F.ws + WS_LW);
  for (int c_first = r_first; c_first < r_end; c_first += 32 * r_stride) {
    const int c_end = (c_first + 32 * r_stride < r_end) ? c_first + 32 * r_stride : r_end;
    if (F.tid < 32) lcnt[F.tid] = 0;
    for (int q = F.tid; q < 512; q += NTHREADS) rec_a[q] = -1;
    __syncthreads();
    f32x4 vn[2][4];
#pragma unroll
    for (int rr = 0; rr < 2; ++rr) { const int mm = c_first + rr * r_stride; if (mm < c_end) {
#pragma unroll
        for (int j = 0; j < 4; ++j) vn[rr][j] = *((const f32x4*)(a.out + (size_t)mm * DM) + F.lane + 64 * j); } }
    for (int m0 = c_first; m0 < c_end; m0 += 2 * r_stride) {
        f32x4 vc[2][4];
#pragma unroll
        for (int rr = 0; rr < 2; ++rr)
#pragma unroll
            for (int j = 0; j < 4; ++j) vc[rr][j] = vn[rr][j];
#pragma unroll
        for (int rr = 0; rr < 2; ++rr) { const int mm = m0 + (2 + rr) * r_stride; if (mm < c_end) {
#pragma unroll
            for (int j = 0; j < 4; ++j) vn[rr][j] = *((const f32x4*)(a.out + (size_t)mm * DM) + F.lane + 64 * j); } }
#pragma unroll
      for (int rr = 0; rr < 2; ++rr) { const int m = m0 + rr * r_stride; if (m < c_end) {
        f32x4 v[4]; float s = 0.f;
#pragma unroll
        for (int j = 0; j < 4; ++j) { v[j] = vc[rr][j]; s += (v[j].x + v[j].y) + (v[j].z + v[j].w); }
        const float mean = wave_sum(s) * (1.f / DM); float s2 = 0.f;
#pragma unroll
        for (int j = 0; j < 4; ++j) { v[j] = v[j] - mean; s2 += (v[j].x * v[j].x + v[j].y * v[j].y) + (v[j].z * v[j].z + v[j].w * v[j].w); }
        const float rs = 1.f / sqrtf(wave_sum(s2) * (1.f / DM) + LN_EPS);
        float cl[4] = {0.f, 0.f, 0.f, 0.f};
#pragma unroll
        for (int j = 0; j < 4; ++j) { const int c = 4 * F.lane + 256 * j; const f32x4 gg = *(const f32x4*)(g + c), bv = *(const f32x4*)(bb + c); v[j] = v[j] * rs * gg + bv;
            u32x2 w; w.x = pk2(v[j].x, v[j].y); w.y = pk2(v[j].z, v[j].w); *((u32x2*)(XB + (size_t)m * DM) + F.lane + 64 * j) = w;
#pragma unroll
            for (int e = 0; e < 4; ++e) { const f32x4 w4 = wcr[j][e]; const float xe = v[j][e]; cl[0] += xe * w4.x; cl[1] += xe * w4.y; cl[2] += xe * w4.z; cl[3] += xe * w4.w; } }
        red4(cl, F.lane);
        int grp = 0; float cm = cl[0];
#pragma unroll
        for (int e = 1; e < 4; ++e) if (cl[e] > cm) { cm = cl[e]; grp = e; }
        float den = 0.f;
#pragma unroll
        for (int e = 0; e < 4; ++e) den += __expf(cl[e] - cm);
        const float pg = 1.0f / den;
        grp = __builtin_amdgcn_readfirstlane(grp);
        const LAS f32x4* wl = (const LAS f32x4*)(F.lds) + grp * 2048 + F.lane;
        float fl[8] = {0.f, 0.f, 0.f, 0.f, 0.f, 0.f, 0.f, 0.f};
#pragma unroll
        for (int j = 0; j < 4; ++j)
#pragma unroll
            for (int e = 0; e < 4; ++e) { const f32x4 wa = wl[((j * 4 + e) * 2) * 64], wb = wl[((j * 4 + e) * 2 + 1) * 64]; const float xe = v[j][e];
                fl[0] += xe * wa.x; fl[1] += xe * wa.y; fl[2] += xe * wa.z; fl[3] += xe * wa.w; fl[4] += xe * wb.x; fl[5] += xe * wb.y; fl[6] += xe * wb.z; fl[7] += xe * wb.w; }
        red8(fl, F.lane);
        int i0 = 0; float v0 = fl[0];
#pragma unroll
        for (int e = 1; e < 8; ++e) if (fl[e] > v0) { v0 = fl[e]; i0 = e; }
        int i1 = -1; float v1 = -3.0e38f;
#pragma unroll
        for (int e = 0; e < 8; ++e) if (e != i0 && fl[e] > v1) { v1 = fl[e]; i1 = e; }
        const float e1 = __expf(v1 - v0), w0 = pg / (1.0f + e1), w1 = pg * e1 / (1.0f + e1);
        if (F.lane < 2) { const int e = grp * 8 + (F.lane == 0 ? i0 : i1); const int a_id = 2 * m + F.lane;
            const int lr = __hip_atomic_fetch_add(lcnt + e, 1, __ATOMIC_RELAXED, __HIP_MEMORY_SCOPE_WORKGROUP);
            const int ri = (((m - c_first) / r_stride) * NWAVES + F.wave) * 2 + F.lane;
            rec_er[ri] = (e << 16) | lr; rec_a[ri] = a_id; rec_w[ri] = (F.lane == 0) ? w0 : w1; tw[a_id] = (F.lane == 0) ? w0 : w1; }
          } }
    }
    __syncthreads();
    if (F.tid < 32) { const int n = lcnt[F.tid]; lbase[F.tid] = n ? (int)__hip_atomic_fetch_add(F.ctl + CW_CNT + layer * 64 + F.tid, (unsigned)n, RLX_AGENT) : 0; }
    __syncthreads();
    for (int q = F.tid; q < 512; q += NTHREADS) { const int aid = rec_a[q]; if (aid >= 0) { const int er = rec_er[q], e = er >> 16; const size_t li = (size_t)e * LIST_CAP + lbase[e] + (er & 0xffff); list[li] = aid; lw[li] = rec_w[q]; } }
    __syncthreads();
  }
    __syncthreads();
}
__device__ __forceinline__ void ln2_pass(Frame& F, const Args& a, int layer, int r_first, int r_stride, int r_end) {
    bf16_t* XB = (bf16_t*)(F.ws + WS_XB); const bf16_t* YB = (const bf16_t*)(F.ws + WS_YB);
    const float* g = a.ln2_g + layer * DM; const float* bb = a.ln2_b + layer * DM;
    u32x2 xn[2][4], pn[2][4], qn[2][4];
#define LN2_LOAD(rr, mm) do { const bf16_t* y0_ = YB + (size_t)(2 * (mm)) * DM; _Pragma("unroll") for (int j = 0; j < 4; ++j) { xn[rr][j] = *((const u32x2*)(XB + (size_t)(mm) * DM) + F.lane + 64 * j); \
        pn[rr][j] = *((const u32x2*)y0_ + F.lane + 64 * j); qn[rr][j] = *((const u32x2*)(y0_ + DM) + F.lane + 64 * j); } } while (0)
#pragma unroll
    for (int rr = 0; rr < 2; ++rr) { const int mm = r_first + rr * r_stride; if (mm < r_end) LN2_LOAD(rr, mm); }
    for (int m0 = r_first; m0 < r_end; m0 += 2 * r_stride) {
        u32x2 xc[2][4], pc[2][4], qc[2][4];
#pragma unroll
        for (int rr = 0; rr < 2; ++rr)
#pragma unroll
            for (int j = 0; j < 4; ++j) { xc[rr][j] = xn[rr][j]; pc[rr][j] = pn[rr][j]; qc[rr][j] = qn[rr][j]; }
#pragma unroll
        for (int rr = 0; rr < 2; ++rr) { const int mm = m0 + (2 + rr) * r_stride; if (mm < r_end) LN2_LOAD(rr, mm); }
#pragma unroll
        for (int rr = 0; rr < 2; ++rr) { const int m = m0 + rr * r_stride; if (m < r_end) {
            float* xr = a.out + (size_t)m * DM;
            f32x4 v[4]; float s = 0.f;
#pragma unroll
            for (int j = 0; j < 4; ++j) { const u32x2 x = xc[rr][j], p = pc[rr][j], q = qc[rr][j];
                v[j].x = bf2f(x.x & 0xffff) * DN_ALPHA + (bf2f(p.x & 0xffff) + bf2f(q.x & 0xffff)); v[j].y = bf2f(x.x >> 16) * DN_ALPHA + (bf2f(p.x >> 16) + bf2f(q.x >> 16));
                v[j].z = bf2f(x.y & 0xffff) * DN_ALPHA + (bf2f(p.y & 0xffff) + bf2f(q.y & 0xffff)); v[j].w = bf2f(x.y >> 16) * DN_ALPHA + (bf2f(p.y >> 16) + bf2f(q.y >> 16));
                s += (v[j].x + v[j].y) + (v[j].z + v[j].w); }
            const float mean = wave_sum(s) * (1.f / DM); float s2 = 0.f;
#pragma unroll
            for (int j = 0; j < 4; ++j) { v[j] = v[j] - mean; s2 += (v[j].x * v[j].x + v[j].y * v[j].y) + (v[j].z * v[j].z + v[j].w * v[j].w); }
            const float rs = 1.f / sqrtf(wave_sum(s2) * (1.f / DM) + LN_EPS);
#pragma unroll
            for (int j = 0; j < 4; ++j) { const int c = 4 * F.lane + 256 * j; const f32x4 gg = *(const f32x4*)(g + c), bv = *(const f32x4*)(bb + c); v[j] = v[j] * rs * gg + bv;
                if (layer + 1 < DEPTH) { u32x2 w; w.x = pk2(v[j].x, v[j].y); w.y = pk2(v[j].z, v[j].w); *((u32x2*)(XB + (size_t)m * DM) + F.lane + 64 * j) = w; }
                else *((f32x4*)xr + F.lane + 64 * j) = v[j]; }
        } }
    }
#undef LN2_LOAD
}
__device__ __forceinline__ void moe_convert(Frame& F, const Args& a, int layer) {
    LAS float* scr = (LAS float*)(F.lds + F.wave * 16384);
    constexpr int I_13 = (1024 / 64) * (1024 / 32), I_2 = (512 / 64) * (1024 / 32), PER_E = I_13 + I_2;
    for (int it = F.gw; it < NEXP * PER_E; it += F.NGW) {
        const int e = it / PER_E; int r = it - e * PER_E; const size_t le = (size_t)layer * NEXP + e;
        if (r < I_13) { const int kb = r / 32, nb = r % 32; const float* src = ((nb >> 2) & 1) ? a.moe_w3 : a.moe_w1;
            const int sc0 = ((32 * nb) >> 8) * 128 + ((32 * nb) & 127);
            transpose_item_v4(src + le * 1024 * 512 + (size_t)(kb * 64) * 512 + sc0, 512, (bf16_t*)(F.ws + WS_W13) + (size_t)e * 1024 * 1024 + (size_t)(nb * 32) * 1024 + kb * 64, 1024, scr, F.lane); }
        else { r -= I_13; const int kb = r / 32, nb = r % 32;
            transpose_item_v4(a.moe_w2 + le * 512 * 1024 + (size_t)(kb * 64) * 1024 + nb * 32, 1024, (bf16_t*)(F.ws + WS_W2) + (size_t)e * 1024 * 512 + (size_t)(nb * 32) * 512 + kb * 64, 512, scr, F.lane); }
    }
}

typedef short at_s16x4 __attribute__((ext_vector_type(4)));
typedef LAS const unsigned char* at_lds_cptr;
__device__ __forceinline__ at_s16x4 at_vtr(at_lds_cptr p) { return __builtin_bit_cast(at_s16x4, __builtin_amdgcn_ds_read_tr16_b64_v4i16((LAS at_s16x4*)p)); }
struct RowSrc { const bf16_t* p; long pitch; };
constexpr int SA_P = 0, SA_V = 4096, SA_AL = 12288, SA_RL = 12544;
template <int NC0, int NC1, int MODE>
__device__ __forceinline__ void sattn_core(const bf16x8* qf, RowSrc k0, RowSrc k1, RowSrc vs, int kb_lo, int kb_hi, int qidx0, float lse_ref, LAS unsigned char* scr, int lane, f32x16* o, float& lse_out) {
    const int r32 = lane & 31, hi = lane >> 5;
    LAS bf16_t* Pb = (LAS bf16_t*)(scr + SA_P); LAS bf16_t* Vb = (LAS bf16_t*)(scr + SA_V); LAS float* Al = (LAS float*)(scr + SA_AL);
    float m = -1.0e30f, l = 0.f;
    if (MODE != 1) { o[0] = f32x16{}; o[1] = f32x16{}; }
    bf16x8 kn[NC0 + NC1]; u32x4 vn[4];
#define SA_LOAD(kb_) do { const long key_ = (long)(kb_) * 32 + r32; \
        _Pragma("unroll") for (int c = 0; c < NC0; ++c) kn[c] = *(const bf16x8*)(k0.p + key_ * k0.pitch + 16 * c + 8 * hi); \
        _Pragma("unroll") for (int c = 0; c < NC1; ++c) kn[NC0 + c] = *(const bf16x8*)(k1.p + key_ * k1.pitch + 16 * c + 8 * hi); \
        if (MODE != 1) { _Pragma("unroll") for (int i = 0; i < 4; ++i) { const int idx = i * 64 + lane, kr = idx >> 3, pc = idx & 7; vn[i] = *(const u32x4*)(vs.p + ((long)(kb_) * 32 + kr) * vs.pitch + pc * 8); } } } while (0)
    if (kb_lo < kb_hi) SA_LOAD(kb_lo);
    const at_lds_cptr vtb = (at_lds_cptr)(scr + SA_V) + ((8 * hi + ((lane & 15) >> 2)) * 72 + 16 * ((lane >> 4) & 1) + 4 * (lane & 3)) * 2;
    for (int kb = kb_lo; kb < kb_hi; ++kb) {
        bf16x8 kc[NC0 + NC1]; u32x4 vc[4];
#pragma unroll
        for (int c = 0; c < NC0 + NC1; ++c) kc[c] = kn[c];
#pragma unroll
        for (int i = 0; i < 4; ++i) vc[i] = vn[i];
        if (kb + 1 < kb_hi) SA_LOAD(kb + 1);
        f32x16 s = {};
#pragma unroll
        for (int c = 0; c < NC0 + NC1; ++c) s = MFMA32(kc[c], qf[c], s);
        bool valid[16];
#pragma unroll
        for (int r = 0; r < 16; ++r) { if (MODE == 0) valid[r] = true; else { const int d = kb * 32 + crow(r, hi) - (qidx0 + r32); valid[r] = (d <= 64 && d >= -64); } }
        float p[16];
        if (MODE == 2) {
#pragma unroll
            for (int r = 0; r < 16; ++r) p[r] = valid[r] ? fast_exp2(s[r] - lse_ref) : 0.f;
        } else {
            float mx = -1.0e30f;
#pragma unroll
            for (int r = 0; r < 16; ++r) if (valid[r]) mx = fmaxf(mx, s[r]);
            mx = xmax32(mx);
            const float mn = fmaxf(m, mx), alpha = fast_exp2(m - mn); m = mn;
            float ps = 0.f;
#pragma unroll
            for (int r = 0; r < 16; ++r) { p[r] = valid[r] ? fast_exp2(s[r] - mn) : 0.f; ps += p[r]; }
            l = l * alpha + ps;
            if (MODE == 0) { if (hi == 0) Al[r32] = alpha; }
        }
        if (MODE != 1) {
#pragma unroll
            for (int g = 0; g < 4; ++g) { u32x2 w; w.x = pk2(p[4 * g], p[4 * g + 1]); w.y = pk2(p[4 * g + 2], p[4 * g + 3]); *(LAS u32x2*)(Pb + r32 * 40 + 8 * g + 4 * hi) = w; }
#pragma unroll
            for (int i = 0; i < 4; ++i) { const int idx = i * 64 + lane, kr = idx >> 3, pc = idx & 7; *(LAS u32x4*)(Vb + kr * 72 + pc * 8) = vc[i]; }
            LDS_WAIT();
            if (MODE == 0) {
#pragma unroll
                for (int r = 0; r < 16; ++r) { const float al = Al[crow(r, hi)]; o[0][r] *= al; o[1][r] *= al; }
            }
#pragma unroll
            for (int st = 0; st < 2; ++st) {
                const bf16x8 pf = *(const LAS bf16x8*)(Pb + r32 * 40 + 16 * st + 8 * hi);
#pragma unroll
                for (int db = 0; db < 2; ++db) {
                    const at_s16x4 lo_ = at_vtr(vtb + (16 * st * 72 + 32 * db) * 2), hi_ = at_vtr(vtb + ((16 * st + 4) * 72 + 32 * db) * 2);
                    const bf16x8 vf = {lo_[0], lo_[1], lo_[2], lo_[3], hi_[0], hi_[1], hi_[2], hi_[3]};
                    o[db] = MFMA32(pf, vf, o[db]); }
            }
            LDS_WAIT();
        }
    }
#undef SA_LOAD
    if (MODE != 2) { l = xsum32(l); lse_out = m + __log2f(l); }
    if (MODE == 0) {
        LAS float* Rl = (LAS float*)(scr + SA_RL);
        if (hi == 0) Rl[r32] = 1.0f / l;
        LDS_WAIT();
#pragma unroll
        for (int r = 0; r < 16; ++r) { const float rl = Rl[crow(r, hi)]; o[0][r] *= rl; o[1][r] *= rl; }
        LDS_WAIT();
    }
}

__device__ __forceinline__ void sattn_phase(Frame& F, const Args& a, int layer, int kind_lo) {
    const bf16_t* H = (const bf16_t*)(F.ws + WS_H); const bf16_t* QB = (const bf16_t*)(F.ws + WS_QB); const bf16_t* KVB = (const bf16_t*)(F.ws + WS_KVB);
    bf16_t* MIX = (bf16_t*)(F.ws + WS_MIX); const float* lsec = (const float*)(F.ws + WS_LSEC);
    LAS unsigned char* scr = F.lds + F.wave * 16384;
    const int lane = F.lane, r32 = lane & 31, hi = lane >> 5;
    float lam, lam_init;
    { const float* lv = a.diff_lambda + layer * 128; float d1 = 0.f, d2 = 0.f;
      for (int i = 0; i < 32; ++i) { d1 += lv[i] * lv[32 + i]; d2 += lv[64 + i] * lv[96 + i]; }
      lam_init = 0.8f - 0.6f * expf(-0.3f * (float)layer); lam = expf(d1) - expf(d2) + lam_init; }
    constexpr int NRB = NTOK / 32;
    const int items = NRB * (4 + 6 + 6);
    for (int it = kind_lo * NRB + F.gw; it < items; it += F.NGW) {
        const int kind = it / NRB, rb = it - kind * NRB; const int m0 = rb * 32; const SeqInfo si = seqinfo(m0);
#if !OPT_ATTN
        if (kind < 4) {
            const int h = kind; f32x16 o0[2], o1[2]; float dummy;
            for (int c = 0; c < 2; ++c) {
                bf16x8 qf[2];
#pragma unroll
                for (int d0 = 0; d0 < 2; ++d0) qf[d0] = *(const bf16x8*)(H + (size_t)(m0 + r32) * HP + HC_AQ + h * 64 + c * 32 + 16 * d0 + 8 * hi);
                const RowSrc ks{H + (size_t)si.base * HP + HC_AK + h * 64 + c * 32, HP}, vs{H + (size_t)si.base * HP + HC_AV + h * 64, HP};
                sattn_core<2, 0, 0>(qf, ks, ks, vs, 0, si.len / 32, 0, 0.f, scr, lane, c == 0 ? o0 : o1, dummy);
            }
            const float* sg = a.diff_subln + layer * 64; const float g0 = sg[r32], g1 = sg[32 + r32];
#pragma unroll
            for (int r = 0; r < 16; ++r) { const float x0 = o0[0][r] - lam * o1[0][r], x1 = o0[1][r] - lam * o1[1][r]; float ss = x0 * x0 + x1 * x1;
                ss += shx<1>(ss); ss += shx<2>(ss); ss += shx<4>(ss); ss += shx<8>(ss); ss += shx<16>(ss);
                const float rs = (1.0f - lam_init) / sqrtf(ss * (1.0f / 64.0f) + RMS_EPS);
                bf16_t* op = MIX + (size_t)(m0 + crow(r, hi)) * DM + MIX_A + h * 64 + r32;
                op[0] = (bf16_t)f2bf(x0 * rs * g0); op[32] = (bf16_t)f2bf(x1 * rs * g1); }
        } else if (kind < 10) {
            const int h = kind - 4; f32x16 o[2]; float dummy; bf16x8 qf[6];
#pragma unroll
            for (int d0 = 0; d0 < 6; ++d0) qf[d0] = *(const bf16x8*)(QB + (size_t)(m0 + r32) * QBP + h * 96 + 16 * d0 + 8 * hi);
            const RowSrc k0{KVB + (size_t)si.base * KVP + h * 128, KVP}, k1{H + (size_t)si.base * HP + HC_KROPE, HP}, vs{KVB + (size_t)si.base * KVP + h * 128 + 64, KVP};
            sattn_core<4, 2, 0>(qf, k0, k1, vs, 0, si.len / 32, 0, 0.f, scr, lane, o, dummy);
#pragma unroll
            for (int r = 0; r < 16; ++r) { bf16_t* op = MIX + (size_t)(m0 + crow(r, hi)) * DM + MIX_B + h * 64 + r32; op[0] = (bf16_t)f2bf(o[0][r]); op[32] = (bf16_t)f2bf(o[1][r]); }
        } else
#endif
        {
            const int gj = kind - 10, g = gj >> 1, hh = gj;
            const int dil = (g == 0) ? 1 : (g == 1 ? 4 : 16); const int L = si.len / dil, bpr = L / 32;
            const int w = (m0 - si.base) / 32, rho = w / bpr, ib = w - rho * bpr, i0 = ib * 32;
            const size_t qrow = (size_t)si.base + (size_t)(i0 + r32) * dil + rho;
            bf16x8 qf[4];
#pragma unroll
            for (int d0 = 0; d0 < 4; ++d0) qf[d0] = *(const bf16x8*)(H + qrow * HP + HC_CQ + hh * 64 + 16 * d0 + 8 * hi);
            const int j = gj & 1; const float l0 = lsec[(0 * (size_t)NTOK + qrow) * 2 + j], l1 = lsec[(1 * (size_t)NTOK + qrow) * 2 + j], l2 = lsec[(2 * (size_t)NTOK + qrow) * 2 + j];
            const float lm = fmaxf(l0, fmaxf(l1, l2)); const float lref = lm + __log2f(fast_exp2(l0 - lm) + fast_exp2(l1 - lm) + fast_exp2(l2 - lm));
            const RowSrc ks{H + ((size_t)si.base + rho) * HP + HC_CK + hh * 64, (long)HP * dil}, vs{H + ((size_t)si.base + rho) * HP + HC_CV + hh * 64, (long)HP * dil};
            int kb_lo = ib - 2, kb_hi = ib + 3; if (kb_lo < 0) kb_lo = 0; if (kb_hi > bpr) kb_hi = bpr;
            f32x16 o[2]; float dummy;
            sattn_core<4, 0, 2>(qf, ks, ks, vs, kb_lo, kb_hi, i0, lref, scr, lane, o, dummy);
#pragma unroll
            for (int r = 0; r < 16; ++r) { const size_t orow = (size_t)si.base + (size_t)(i0 + crow(r, hi)) * dil + rho; bf16_t* op = MIX + orow * DM + MIX_C + hh * 64 + r32; op[0] = (bf16_t)f2bf(o[0][r]); op[32] = (bf16_t)f2bf(o[1][r]); }
        }
    }
}
__device__ __forceinline__ void cstat_phase(Frame& F) {
    const bf16_t* H = (const bf16_t*)(F.ws + WS_H); float* lsec = (float*)(F.ws + WS_LSEC);
    LAS unsigned char* scr = F.lds + F.wave * 16384;
    const int lane = F.lane, r32 = lane & 31, hi = lane >> 5;
    constexpr int NRB = NTOK / 32;
    for (int it = F.gw; it < NRB * 6; it += F.NGW) {
        const int gj = it / NRB, rb = it - gj * NRB, g = gj >> 1, j = gj & 1; const int m0 = rb * 32; const SeqInfo si = seqinfo(m0);
        const int dil = (g == 0) ? 1 : (g == 1 ? 4 : 16); const int L = si.len / dil, bpr = L / 32;
        const int w = (m0 - si.base) / 32, rho = w / bpr, ib = w - rho * bpr, i0 = ib * 32;
        const size_t qrow = (size_t)si.base + (size_t)(i0 + r32) * dil + rho;
        bf16x8 qf[4];
#pragma unroll
        for (int d0 = 0; d0 < 4; ++d0) qf[d0] = *(const bf16x8*)(H + qrow * HP + HC_CQ + gj * 64 + 16 * d0 + 8 * hi);
        const RowSrc ks{H + ((size_t)si.base + rho) * HP + HC_CK + gj * 64, (long)HP * dil};
        int kb_lo = ib - 2, kb_hi = ib + 3; if (kb_lo < 0) kb_lo = 0; if (kb_hi > bpr) kb_hi = bpr;
        float lse; sattn_core<4, 0, 1>(qf, ks, ks, ks, kb_lo, kb_hi, i0, 0.f, scr, lane, nullptr, lse);
        if (hi == 0) lsec[((size_t)g * NTOK + qrow) * 2 + j] = lse;
    }
}


namespace at {
typedef short s16x4 __attribute__((ext_vector_type(4)));
typedef short v4i16_t __attribute__((ext_vector_type(4)));
typedef LAS const unsigned char* lds_cptr;
constexpr int LDS_K = 0, NSLOT = 4, VSLOT = 8192;
template <int NC> struct Lay { static constexpr int SLOTK = 2 * NC * 1024, V = NSLOT * SLOTK, WS = V + NSLOT * VSLOT, OST = WS + 8 * 256, STG = (NC > 2) ? 4096 : 8192, TOTAL = OST + 8 * STG; };
static_assert(Lay<2>::TOTAL <= RING_BYTES && Lay<6>::TOTAL <= RING_BYTES, "attention LDS");
constexpr float THR = 8.0f;
__device__ __forceinline__ void glds16(const void* g, unsigned lds_dst) {
    unsigned keep; asm volatile("s_mov_b32 %0, m0\n\ts_mov_b32 m0, %2\n\ts_nop 0\n\tglobal_load_lds_dwordx4 %1, off\n\ts_mov_b32 m0, %0" : "=&s"(keep) : "v"(g), "s"(lds_dst) : "memory"); }
__device__ __forceinline__ s16x4 vtr(lds_cptr p) { return __builtin_bit_cast(s16x4, __builtin_amdgcn_ds_read_tr16_b64_v4i16((LAS v4i16_t*)p)); }
__device__ __forceinline__ unsigned cvtpk(float lo, float hi) { typedef float f2 __attribute__((ext_vector_type(2))); typedef __bf16 b2 __attribute__((ext_vector_type(2))); f2 v = {lo, hi}; b2 b = __builtin_convertvector(v, b2); return __builtin_bit_cast(unsigned, b); }
#define AT_MX3(a, b, c) __builtin_fmaxf(__builtin_fmaxf((a), (b)), (c))
__device__ __forceinline__ float rowmax(const f32x16& p0, const f32x16& p1) {
    float a = AT_MX3(p0[0], p0[1], p1[0]), b = AT_MX3(p0[2], p0[3], p1[1]); a = AT_MX3(a, p1[2], p1[3]);
#pragma unroll
    for (int r = 4; r < 16; r += 4) { a = AT_MX3(a, p0[r], p0[r + 1]); b = AT_MX3(b, p0[r + 2], p0[r + 3]); a = AT_MX3(a, p1[r], p1[r + 1]); b = AT_MX3(b, p1[r + 2], p1[r + 3]); }
    float m = __builtin_fmaxf(a, b); auto rr = __builtin_amdgcn_permlane32_swap(__float_as_uint(m), __float_as_uint(m), false, false);
    return __builtin_fmaxf(__uint_as_float(rr[0]), __uint_as_float(rr[1])); }
#define AT_WAIT_BAR(N) asm volatile("s_waitcnt vmcnt(" #N ") lgkmcnt(0)\n\ts_barrier" ::: "memory")

struct Src { const bf16_t* p; long pitch; };
template <int NC, int NK0, int NK1, bool FAST>
__device__ __forceinline__ void stream(LAS unsigned char* lds, int tid, const bf16_t* qrow, Src k0, Src k1, Src vs, int NT, f32x16& o0, f32x16& o1, f32x4& lsum) {
    asm volatile("" : "+v"(tid));
    constexpr int SLOTK = Lay<NC>::SLOTK, LDS_V = Lay<NC>::V, LDS_WS = Lay<NC>::WS;
    const int lane = tid & 63, r32 = lane & 31, hi = lane >> 5; const int wid = __builtin_amdgcn_readfirstlane(tid >> 6);
    const unsigned lds0 = (unsigned)(uintptr_t)lds;
    LAS float* wsf = (LAS float*)(lds + LDS_WS) + wid * 64;
    constexpr int P0 = NK0 * 16;
    const bool hasA = (NK0 == 8) || (wid < 4), hasB = (NK1 > 0) && (wid < 4);
    const int pA = (NK0 == 8) ? wid : (wid & 3);
    const int rowA = (NK0 == 8) ? pA * 8 + (lane >> 3) : pA * 16 + (lane >> 2);
    const int chA = (NK0 == 8) ? ((lane & 7) ^ ((4 * pA + (lane >> 4)) & 7)) : ((lane & 3) ^ ((lane >> 4) & 3));
    const bf16_t* ksA = k0.p + (long)rowA * k0.pitch + chA * 8;
    const int rowB = (wid & 3) * 16 + (lane >> 2), chB = (lane & 3) ^ ((lane >> 4) & 3);
    const bf16_t* ksB = (NK1 > 0) ? k1.p + (long)rowB * k1.pitch + chB * 8 : k0.p;
    const bf16_t* vsp = vs.p + (long)(16 * (wid & 3) + (lane >> 2)) * vs.pitch + (wid >> 2) * 32 + (lane & 3) * 8;
    const unsigned kdA = lds0 + LDS_K + pA * 1024, kdB = lds0 + LDS_K + (NK0 + (wid & 3)) * 1024, vd = lds0 + LDS_V + wid * 1024;
    const long ktA = 64 * k0.pitch, ktB = 64 * k1.pitch, vt = 64 * vs.pitch;
    const int nd = (hasA ? 1 : 0) + (hasB ? 1 : 0) + 1;
#define AT_DMA_K(t, slot) do { if (hasA) glds16(ksA + (long)(t) * ktA, (unsigned)__builtin_amdgcn_readfirstlane(kdA + (slot) * SLOTK)); if (hasB) glds16(ksB + (long)(t) * ktB, (unsigned)__builtin_amdgcn_readfirstlane(kdB + (slot) * SLOTK)); } while (0)
#define AT_DMA_V(t, slot) glds16(vsp + (long)(t) * vt, (unsigned)__builtin_amdgcn_readfirstlane(vd + (slot) * VSLOT))
    lds_cptr kb[NC];
#pragma unroll
    for (int d0 = 0; d0 < NC; ++d0) { const int c = 2 * d0 + hi;
        if (2 * d0 < NK0) kb[d0] = (lds_cptr)lds + LDS_K + r32 * P0 + ((NK0 == 8) ? (c ^ ((r32 >> 1) & 7)) : (c ^ ((r32 >> 2) & 3))) * 16;
        else kb[d0] = (lds_cptr)lds + LDS_K + NK0 * 1024 + r32 * 64 + ((c - NK0) ^ ((r32 >> 2) & 3)) * 16; }
    const lds_cptr vp0 = (lds_cptr)lds + LDS_V + ((lane >> 4) & 1) * 32 + (lane & 3) * 8 + (4 * hi + ((lane & 15) >> 2)) * 64;
#ifdef PROBE_SEL
    { unsigned long long pc0_, pr0_; asm volatile("s_memtime %0\n\ts_memrealtime %1\n\ts_waitcnt lgkmcnt(0)" : "=s"(pc0_), "=s"(pr0_) :: "memory");
      LAS unsigned long long* ps_ = (LAS unsigned long long*)(lds + RING_BYTES + 8192 + 128) + wid * 2; ps_[0] = pc0_; ps_[1] = pr0_; }
#endif
    AT_DMA_K(0, 0); AT_DMA_K(1, 1); AT_DMA_V(0, 0);
    bf16x8 qr[NC];
#pragma unroll
    for (int d0 = 0; d0 < NC; ++d0) qr[d0] = *(const bf16x8*)(qrow + 16 * d0 + 8 * hi);
    float mhat = 0.f; f32x16 oa = {}, ob = {}, negm = {}, S0, S1; f32x4 la = {}; u32x4 pw0, pw1, pw2, pw3;
    bf16x8 ones; { const unsigned o_ = (((lane >> 4) & 1) == ((lane >> 3) & 1)) ? 0x3F803F80u : 0u; u32x4 o1_ = {o_, o_, o_, o_}; asm volatile("" : "+v"(o1_)); ones = __builtin_bit_cast(bf16x8, o1_); }
    asm volatile("" : "+v"(negm));
    AT_WAIT_BAR(0);
    __builtin_amdgcn_s_waitcnt(0);
#pragma unroll
    for (int d0 = 0; d0 < NC; ++d0) asm volatile("" : "+v"(qr[d0]));
    bf16x8 kf[2 * NC], vf[8];
#define AT_SB() __builtin_amdgcn_sched_barrier(0)
#define AT_KRD(so_, d0) do { kf[2 * (d0)] = *(const LAS bf16x8*)(kb[d0] + (so_)); kf[2 * (d0) + 1] = *(const LAS bf16x8*)(kb[d0] + (so_) + 32 * ((2 * (d0) < NK0) ? P0 : 64)); } while (0)
#define AT_KHEAD(slot) do { const int kp_ = (slot) * SLOTK; AT_KRD(kp_, 0); if (NC > 1) AT_KRD(kp_, 1); } while (0)
#define AT_VF(i) ({ const s16x4 lo_ = vtr(vp_ + (((i) >> 2) * 4096 + ((i) & 3) * 1024)), hi_ = vtr(vp_ + (((i) >> 2) * 4096 + ((i) & 3) * 1024 + 512)); (bf16x8){lo_[0], lo_[1], lo_[2], lo_[3], hi_[0], hi_[1], hi_[2], hi_[3]}; })
#define AT_VHEAD(slot) do { const lds_cptr vp_ = vp0 + (slot) * VSLOT; vf[0] = AT_VF(0); vf[4] = AT_VF(4); } while (0)
#define AT_QKM(slot) do { const int kp_ = (slot) * SLOTK; \
        _Pragma("unroll") for (int d0 = 0; d0 < NC; ++d0) { if (d0 + 2 < NC) AT_KRD(kp_, d0 + 2); \
            if (d0 == 0) { S0 = MFMA32(kf[0], qr[0], negm); S1 = MFMA32(kf[1], qr[0], negm); } else { S0 = MFMA32(kf[2 * d0], qr[d0], S0); S1 = MFMA32(kf[2 * d0 + 1], qr[d0], S1); } AT_SB(); } } while (0)
#define AT_PVM(slot) do { const lds_cptr vp_ = vp0 + (slot) * VSLOT; \
        vf[1] = AT_VF(1); vf[5] = AT_VF(5); oa = MFMA32(__builtin_bit_cast(bf16x8, pw0), vf[0], oa); ob = MFMA32(__builtin_bit_cast(bf16x8, pw0), vf[4], ob); la = MFMA16(__builtin_bit_cast(bf16x8, pw0), ones, la); AT_SB(); \
        vf[2] = AT_VF(2); vf[6] = AT_VF(6); oa = MFMA32(__builtin_bit_cast(bf16x8, pw1), vf[1], oa); ob = MFMA32(__builtin_bit_cast(bf16x8, pw1), vf[5], ob); la = MFMA16(__builtin_bit_cast(bf16x8, pw1), ones, la); AT_SB(); \
        vf[3] = AT_VF(3); vf[7] = AT_VF(7); oa = MFMA32(__builtin_bit_cast(bf16x8, pw2), vf[2], oa); ob = MFMA32(__builtin_bit_cast(bf16x8, pw2), vf[6], ob); la = MFMA16(__builtin_bit_cast(bf16x8, pw2), ones, la); AT_SB(); \
        oa = MFMA32(__builtin_bit_cast(bf16x8, pw3), vf[3], oa); ob = MFMA32(__builtin_bit_cast(bf16x8, pw3), vf[7], ob); la = MFMA16(__builtin_bit_cast(bf16x8, pw3), ones, la); AT_SB(); } while (0)
    bool resc = false; u32x4 qw0, qw1, qw2, qw3;
#define AT_PIN(x) asm volatile("" : "+v"(x))
#define AT_DECIDE(first) do { const float rm_ = rowmax(S0, S1); resc = false; \
        if ((first) || __any(rm_ > THR)) { const float dl_ = (first) ? rm_ : __builtin_fmaxf(rm_, 0.f); mhat += dl_; \
            _Pragma("unroll") for (int r = 0; r < 16; ++r) { S0[r] -= dl_; S1[r] -= dl_; negm[r] = -mhat; } asm volatile("" : "+v"(negm)); \
            if (!(first)) { const float f_ = fast_exp2(-dl_); if (hi == 0) wsf[r32] = f_; resc = true; } } } while (0)
#define AT_RESC() do { if (resc) { LDS_WAIT(); \
        _Pragma("unroll") for (int r = 0; r < 16; ++r) { const float g_ = wsf[crow(r, hi)]; oa[r] *= g_; ob[r] *= g_; } \
        _Pragma("unroll") for (int v = 0; v < 4; ++v) la[v] *= wsf[4 * (lane >> 4) + 16 * ((lane >> 3) & 1) + v]; LDS_WAIT(); } } while (0)
#define AT_EXP8(S, b, Q) do { \
        _Pragma("unroll") for (int r = 0; r < 8; ++r) S[(b) + r] = fast_exp2(S[(b) + r]); \
        Q = (u32x4){cvtpk(S[(b)], S[(b) + 1]), cvtpk(S[(b) + 2], S[(b) + 3]), cvtpk(S[(b) + 4], S[(b) + 5]), cvtpk(S[(b) + 6], S[(b) + 7])}; AT_PIN(Q); } while (0)
#define AT_EXPALL() do { AT_EXP8(S0, 0, qw0); AT_EXP8(S0, 8, qw1); AT_EXP8(S1, 0, qw2); AT_EXP8(S1, 8, qw3); pw0 = qw0; pw1 = qw1; pw2 = qw2; pw3 = qw3; } while (0)
#define AT_PV_EXP(slot, C0, C1, C2, C3, N0, N1, N2, N3) do { const lds_cptr vp_ = vp0 + (slot) * VSLOT; \
        vf[1] = AT_VF(1); vf[5] = AT_VF(5); oa = MFMA32(__builtin_bit_cast(bf16x8, C0), vf[0], oa); ob = MFMA32(__builtin_bit_cast(bf16x8, C0), vf[4], ob); la = MFMA16(__builtin_bit_cast(bf16x8, C0), ones, la); AT_EXP8(S0, 0, N0); AT_SB(); \
        vf[2] = AT_VF(2); vf[6] = AT_VF(6); oa = MFMA32(__builtin_bit_cast(bf16x8, C1), vf[1], oa); ob = MFMA32(__builtin_bit_cast(bf16x8, C1), vf[5], ob); la = MFMA16(__builtin_bit_cast(bf16x8, C1), ones, la); AT_EXP8(S0, 8, N1); AT_SB(); \
        vf[3] = AT_VF(3); vf[7] = AT_VF(7); oa = MFMA32(__builtin_bit_cast(bf16x8, C2), vf[2], oa); ob = MFMA32(__builtin_bit_cast(bf16x8, C2), vf[6], ob); la = MFMA16(__builtin_bit_cast(bf16x8, C2), ones, la); AT_EXP8(S1, 0, N2); AT_SB(); \
        oa = MFMA32(__builtin_bit_cast(bf16x8, C3), vf[3], oa); ob = MFMA32(__builtin_bit_cast(bf16x8, C3), vf[7], ob); la = MFMA16(__builtin_bit_cast(bf16x8, C3), ones, la); AT_EXP8(S1, 8, N3); AT_SB(); } while (0)
#define AT_TRIP_WAIT() AT_WAIT_BAR(0)
#define AT_STEP(t, C0, C1, C2, C3, N0, N1, N2, N3) do { const int kc_ = (t) & 3, vp1_ = ((t) - 1) & 3; \
        if ((t) + 2 < NT) AT_DMA_K((t) + 2, ((t) + 2) & 3); \
        if ((t) + 1 < NT) AT_DMA_V((t) + 1, ((t) + 1) & 3); \
        AT_KHEAD(kc_); AT_VHEAD(vp1_); AT_SB(); \
        AT_QKM(kc_); \
        if (!FAST) { AT_DECIDE(false); AT_SB(); } \
        AT_PV_EXP(vp1_, C0, C1, C2, C3, N0, N1, N2, N3); \
        if (!FAST) AT_RESC(); } while (0)
    AT_DMA_K(2, 2); AT_DMA_V(1, 1);
    AT_KHEAD(0); AT_SB();
    AT_QKM(0); AT_DECIDE(true); AT_EXPALL();
    AT_STEP(1, pw0, pw1, pw2, pw3, qw0, qw1, qw2, qw3);
    AT_TRIP_WAIT();
    for (int t = 2; t < NT; t += 2) { AT_STEP(t, qw0, qw1, qw2, qw3, pw0, pw1, pw2, pw3); AT_STEP(t + 1, pw0, pw1, pw2, pw3, qw0, qw1, qw2, qw3); AT_TRIP_WAIT(); }
    pw0 = qw0; pw1 = qw1; pw2 = qw2; pw3 = qw3;
#undef AT_STEP
    AT_VHEAD((NT - 1) & 3); AT_SB(); AT_PVM((NT - 1) & 3);
    o0 = oa; o1 = ob; lsum = la;
#ifdef PROBE_SEL
    { unsigned long long pc1_, pr1_; asm volatile("s_memtime %0\n\ts_memrealtime %1\n\ts_waitcnt lgkmcnt(0)" : "=s"(pc1_), "=s"(pr1_) :: "memory");
      const LAS unsigned long long* ps_ = (const LAS unsigned long long*)(lds + RING_BYTES + 8192 + 128) + wid * 2; const unsigned long long pc0_ = ps_[0], pr0_ = ps_[1];
      if (wid == 0) { LAS unsigned long long* pb_ = (LAS unsigned long long*)(lds + RING_BYTES + 8192) + (NC > 2 ? 4 : 0); pb_[0] += pc1_ - pc0_; pb_[1] += pr1_ - pr0_; pb_[2] += (unsigned long long)NT; } }
#endif
#undef AT_DMA_K
#undef AT_DMA_V
#undef AT_SB
#undef AT_KRD
#undef AT_KHEAD
#undef AT_VF
#undef AT_VHEAD
#undef AT_QKM
#undef AT_PVM
#undef AT_PIN
#undef AT_DECIDE
#undef AT_RESC
#undef AT_EXP8
#undef AT_EXPALL
#undef AT_PV_EXP
#undef AT_TRIP_WAIT
}
template <int NC>
__device__ __forceinline__ void normalise(LAS unsigned char* lds, int tid, f32x16& o0, f32x16& o1, const f32x4& lsum) {
    const int lane = tid & 63, hi = lane >> 5; const int wid = __builtin_amdgcn_readfirstlane(tid >> 6);
    LAS float* wsf = (LAS float*)(lds + Lay<NC>::WS) + wid * 64;
#pragma unroll
    for (int v = 0; v < 4; ++v) wsf[32 + 4 * (lane >> 4) + 16 * ((lane >> 3) & 1) + v] = 1.0f / lsum[v];
    LDS_WAIT();
#pragma unroll
    for (int r = 0; r < 16; ++r) { const float g = wsf[32 + crow(r, hi)]; o0[r] *= g; o1[r] *= g; }
    LDS_WAIT();
}
}

struct AttnUnitId { int kind, seq, head, qb; };
__device__ __forceinline__ bool attn_unit_at(int i, int G, int bid, AttnUnitId& u) {
    const long L = (long)i * G + bid; if (L >= 2560) return false; int o = (int)L;
    int kind, longs, nh;
    if (o < 512) { kind = 0; longs = 1; nh = 4; } else if (o < 1024) { kind = 0; longs = 0; nh = 4; o -= 512; } else if (o < 1792) { kind = 1; longs = 1; nh = 6; o -= 1024; } else { kind = 1; longs = 0; nh = 6; o -= 1792; }
    const int nqb = longs ? 16 : 8;
    int pair, qb;
    if (G == 256) { const int rnd = o >> 8, b = o & 255, x = b & 7, c = b >> 3;
        const int ppr = 32 / nqb; pair = x + 8 * (rnd * ppr + c / nqb); qb = c % nqb; }
    else { pair = o / nqb; qb = o % nqb; }
    u.kind = kind; u.head = pair % nh; const int sq = pair / nh; u.seq = longs ? 16 + sq : sq; u.qb = qb; return true;
}
template <bool FAST>
__device__ __forceinline__ bool attn_unit(Frame& F, const Args& a, int layer, const AttnUnitId& u, float lam, float lam_init) {
    const bf16_t* H = (const bf16_t*)(F.ws + WS_H); const bf16_t* QB = (const bf16_t*)(F.ws + WS_QB); const bf16_t* KVB = (const bf16_t*)(F.ws + WS_KVB);
    bf16_t* MIX = (bf16_t*)(F.ws + WS_MIX);
    const int wid = F.wave; bool bad = false;
    int tid = F.tid; asm volatile("" : "+v"(tid)); const int lane = tid & 63, r32 = lane & 31, hi = lane >> 5;
    const int len = (u.seq < 16) ? 2048 : 4096, base = (u.seq < 16) ? u.seq * 2048 : NTOK_P + (u.seq - 16) * 4096, NT = len / 64;
    const int m0 = base + u.qb * 256 + wid * 32;
    LAS bf16_t* sb = (LAS bf16_t*)(F.lds + ((u.kind == 0) ? at::Lay<2>::OST + wid * at::Lay<2>::STG : at::Lay<6>::OST + wid * at::Lay<6>::STG));
    LAS float* sf = (LAS float*)sb;
#define AT_BADSUM(ls) (!(ls[0] < 1e30f) | !(ls[1] < 1e30f) | !(ls[2] < 1e30f) | !(ls[3] < 1e30f))
    if (u.kind == 0) {
        f32x16 q0, q1; f32x4 ls;
        { f32x16 p0, p1; const at::Src ks{H + (size_t)base * HP + HC_AK + u.head * 64, HP}, vs{H + (size_t)base * HP + HC_AV + u.head * 64, HP};
          at::stream<2, 4, 0, FAST>(F.lds, tid, H + (size_t)(m0 + r32) * HP + HC_AQ + u.head * 64, ks, ks, vs, NT, p0, p1, ls); bad |= AT_BADSUM(ls); at::normalise<2>(F.lds, tid, p0, p1, ls);
#pragma unroll
          for (int r = 0; r < 16; ++r) { const int row = crow(r, hi); sf[row * 64 + r32] = p0[r]; sf[row * 64 + 32 + r32] = p1[r]; }
          AT_WAIT_BAR(0); }
        { const at::Src ks{H + (size_t)base * HP + HC_AK + u.head * 64 + 32, HP}, vs{H + (size_t)base * HP + HC_AV + u.head * 64, HP};
          at::stream<2, 4, 0, FAST>(F.lds, tid, H + (size_t)(m0 + r32) * HP + HC_AQ + u.head * 64 + 32, ks, ks, vs, NT, q0, q1, ls); bad |= AT_BADSUM(ls); at::normalise<2>(F.lds, tid, q0, q1, ls); }
        float xa[16], xb[16];
#pragma unroll
        for (int r = 0; r < 16; ++r) { const int row = crow(r, hi); xa[r] = sf[row * 64 + r32] - lam * q0[r]; xb[r] = sf[row * 64 + 32 + r32] - lam * q1[r]; }
        LDS_WAIT();
        const float* sg = a.diff_subln + layer * 64; const float g0 = sg[r32] * (1.0f - lam_init), g1 = sg[32 + r32] * (1.0f - lam_init);
#pragma unroll
        for (int r = 0; r < 16; ++r) { const float x0 = xa[r], x1 = xb[r]; float ss = x0 * x0 + x1 * x1;
            ss += shx<1>(ss); ss += shx<2>(ss); ss += shx<4>(ss); ss += shx<8>(ss); ss += shx<16>(ss);
            const float rs = 1.0f / sqrtf(ss * (1.0f / 64.0f) + RMS_EPS); const int row = crow(r, hi);
            sb[row * 64 + r32] = (bf16_t)f2bf(x0 * rs * g0); sb[row * 64 + 32 + r32] = (bf16_t)f2bf(x1 * rs * g1); }
        LDS_WAIT();
#pragma unroll
        for (int it = 0; it < 4; ++it) { const int row = it * 8 + (lane >> 3), ch = lane & 7; *(u32x4*)(MIX + (size_t)(m0 + row) * DM + MIX_A + u.head * 64 + ch * 8) = *(const LAS u32x4*)(sb + row * 64 + ch * 8); }
    } else {
        f32x16 p0, p1; f32x4 ls;
        const at::Src k0{KVB + (size_t)base * KVP + u.head * 128, KVP}, k1{H + (size_t)base * HP + HC_KROPE, HP}, vs{KVB + (size_t)base * KVP + u.head * 128 + 64, KVP};
        at::stream<6, 8, 4, FAST>(F.lds, tid, QB + (size_t)(m0 + r32) * QBP + u.head * 96, k0, k1, vs, NT, p0, p1, ls); bad |= AT_BADSUM(ls); at::normalise<6>(F.lds, tid, p0, p1, ls);
#pragma unroll
        for (int r = 0; r < 16; ++r) { const int row = crow(r, hi); sb[row * 64 + r32] = (bf16_t)f2bf(p0[r]); sb[row * 64 + 32 + r32] = (bf16_t)f2bf(p1[r]); }
        LDS_WAIT();
#pragma unroll
        for (int it = 0; it < 4; ++it) { const int row = it * 8 + (lane >> 3), ch = lane & 7; *(u32x4*)(MIX + (size_t)(m0 + row) * DM + MIX_B + u.head * 64 + ch * 8) = *(const LAS u32x4*)(sb + row * 64 + ch * 8); }
    }
#undef AT_BADSUM
    return bad;
}
constexpr int ATT_FLAG_OFF = RING_BYTES + 8192 + 512;
__device__ __forceinline__ void attn_ab_phase(Frame& F, const Args& a, int layer, int kmask = 3) {
    float lam, lam_init;
    { const float* lv = a.diff_lambda + layer * 128; float d1 = 0.f, d2 = 0.f;
      for (int i = 0; i < 32; ++i) { d1 += lv[i] * lv[32 + i]; d2 += lv[64 + i] * lv[96 + i]; }
      lam_init = 0.8f - 0.6f * expf(-0.3f * (float)layer); lam = expf(d1) - expf(d2) + lam_init;
      lam = __uint_as_float(__builtin_amdgcn_readfirstlane(__float_as_uint(lam))); lam_init = __uint_as_float(__builtin_amdgcn_readfirstlane(__float_as_uint(lam_init))); }
    volatile LAS unsigned* flag = (volatile LAS unsigned*)(F.lds + ATT_FLAG_OFF);
    AttnUnitId u;
    for (int i = 0; attn_unit_at(i, F.G, F.bid, u); ++i) {
        if (!((kmask >> u.kind) & 1)) continue;
        const unsigned ep = (unsigned)(layer * 64 + i + 1);
        const bool bad = attn_unit<true>(F, a, layer, u, lam, lam_init);
        if (__any(bad)) *flag = ep;
        AT_WAIT_BAR(0);
        if ((unsigned)__builtin_amdgcn_readfirstlane(*flag) == ep) {
            launder(F); attn_unit<false>(F, a, layer, u, lam, lam_init);
            AT_WAIT_BAR(0); }
    }
}

struct ListRows { const int* list; int seg0, cnt; __device__ __forceinline__ int src(int m) const { const int r = m - seg0; return (r < cnt) ? (list[r] >> 1) : 0; } };
__device__ __forceinline__ void moe_segments(Frame& F, int layer, LAS int* seg) {
    if (F.tid < 32) seg[33 + F.tid] = (int)__hip_atomic_load(F.ctl + CW_CNT + layer * 64 + F.tid, RLX_AGENT);
    __syncthreads();
    if (F.tid == 0) { int acc = 0; for (int e = 0; e < NEXP; ++e) { seg[e] = acc; acc += (seg[33 + e] + 255) & ~255; } seg[32] = acc; }
    __syncthreads();
}
__device__ __forceinline__ int seg_find(const LAS int* seg, int row) { int e = 0;
#pragma unroll
    for (int s = 16; s > 0; s >>= 1) if (seg[e + s] <= row) e += s;
    return e; }
__device__ __forceinline__ void moe_up_simple(Frame& F, int layer) {
    LAS int* seg = (LAS int*)(F.lds + RING_BYTES); moe_segments(F, layer, seg);
    const bf16_t* XB = (const bf16_t*)(F.ws + WS_XB); const bf16_t* W13 = (const bf16_t*)(F.ws + WS_W13); const int* list = (const int*)(F.ws + WS_LIST);
    const EpiHid E{(bf16_t*)(F.ws + WS_HID)};
    const int items = (seg[32] / 32) * 16;
    for (int it = F.gw; it < items; it += F.NGW) { const int mt = it >> 4, ct = it & 15, m0 = mt * 32, e = seg_find(seg, m0), c0 = ct * 32;
        const ListRows RM{list + (size_t)e * LIST_CAP, seg[e], seg[33 + e]};
        const bf16_t* Bg = W13 + (size_t)e * 1024 * 1024 + (size_t)((c0 >> 7) * 256 + (c0 & 127)) * 1024;
        sg_tile(XB, DM, Bg, Bg + (size_t)128 * 1024, 1024, 1024, m0, c0, E, RM, F.lane); }
    __syncthreads();
}
__device__ __forceinline__ void moe_down_simple(Frame& F, int layer) {
    LAS int* seg = (LAS int*)(F.lds + RING_BYTES); moe_segments(F, layer, seg);
    const bf16_t* HID = (const bf16_t*)(F.ws + WS_HID); const bf16_t* W2 = (const bf16_t*)(F.ws + WS_W2); const int* list = (const int*)(F.ws + WS_LIST);
    const int items = (seg[32] / 32) * 16;
    for (int it = F.gw; it < items; it += F.NGW) { const int mt = it >> 4, ct = it & 15, m0 = mt * 32, e = seg_find(seg, m0), c0 = ct * 64;
        const EpiY E{(bf16_t*)(F.ws + WS_YB), (const float*)(F.ws + WS_TW), list + (size_t)e * LIST_CAP, seg[e], seg[33 + e]};
        const bf16_t* B0 = W2 + (size_t)e * 1024 * 512 + (size_t)c0 * 512;
        sg_tile(HID, DEXP, B0, B0 + (size_t)32 * 512, 512, 512, m0, c0, E, IdRows(), F.lane); }
    __syncthreads();
}


struct MoeUpSched {
    const char* XB; const char* W13; const LAS int* seg; const int* list; int nM, G, c;
    __device__ __forceinline__ bool next(int i, pg8::Unit& u) const { if (!pg8::order_next(i, G, c, nM, 4, u.pm, u.pn)) return false; u.e = __builtin_amdgcn_readfirstlane(seg_find(seg, u.pm * 256)); u.a = XB; u.b = W13 + ((size_t)u.e * 1024 + (size_t)u.pn * 256) * 2048; return true; }
    __device__ __forceinline__ unsigned arow(const pg8::Unit& u, int r) const { const int rr = u.pm * 256 + r - __builtin_amdgcn_readfirstlane(seg[u.e]); return (rr < __builtin_amdgcn_readfirstlane(seg[33 + u.e])) ? (unsigned)(list[(size_t)u.e * LIST_CAP + rr] >> 1) : 0u; }
};
struct MoeDownSched {
    const char* HID; const char* W2; const LAS int* seg; int nM, G, c;
    __device__ __forceinline__ bool next(int i, pg8::Unit& u) const { if (!pg8::order_next(i, G, c, nM, 4, u.pm, u.pn)) return false; u.e = __builtin_amdgcn_readfirstlane(seg_find(seg, u.pm * 256)); u.a = HID + (size_t)u.pm * 256 * DEXP * 2; u.b = W2 + ((size_t)u.e * 1024 + (size_t)u.pn * 256) * 1024; return true; }
    __device__ __forceinline__ unsigned arow(const pg8::Unit&, int) const { return 0u; }
};
__device__ __forceinline__ void moe_up_opt(Frame& F, int layer) {
    LAS int* seg = (LAS int*)(F.lds + RING_BYTES); moe_segments(F, layer, seg);
    const MoeUpSched S{(const char*)(F.ws + WS_XB), (const char*)(F.ws + WS_W13), seg, (const int*)(F.ws + WS_LIST), __builtin_amdgcn_readfirstlane(seg[32]) / 256, F.G, F.bid};
    const EpiHid E{(bf16_t*)(F.ws + WS_HID)};
    pg8::gemm_phase<EpiHid, MoeUpSched, true, true>(F.lds, F.tid, 1024, DM, S, E);
    __syncthreads();
}
__device__ __forceinline__ void moe_down_opt(Frame& F, int layer) {
    LAS int* seg = (LAS int*)(F.lds + RING_BYTES); moe_segments(F, layer, seg);
    const MoeDownSched S{(const char*)(F.ws + WS_HID), (const char*)(F.ws + WS_W2), seg, __builtin_amdgcn_readfirstlane(seg[32]) / 256, F.G, F.bid};
    const EpiYO E{(bf16_t*)(F.ws + WS_YB), (const float*)(F.ws + WS_TW), (const int*)(F.ws + WS_LIST), seg, (const float*)(F.ws + WS_LW)};
    pg8::gemm_phase<EpiYO, MoeDownSched, false, false>(F.lds, F.tid, DEXP, DEXP, S, E);
    __syncthreads();
}
template <class Epi>
__device__ __forceinline__ void pg_phase(Frame& F, const bf16_t* A, int lda, const bf16_t* Bt, int panel, int N, int K, const Epi& E) {
    pg8::PanelSched S; S.init(A, lda, Bt, panel, N, K);
    pg8::gemm_phase<Epi, pg8::PanelSched, false, false>(F.lds, F.tid, K, lda, S, E);
}
__device__ __forceinline__ void local_sync(Frame& F) {
    asm volatile("s_waitcnt vmcnt(0) lgkmcnt(0)" ::: "memory");
    __syncthreads();
    if (F.tid == 0) { __builtin_amdgcn_fence(__ATOMIC_ACQUIRE, "agent"); asm volatile("s_waitcnt vmcnt(0)" ::: "memory"); }
    __syncthreads();
}
template <class Epi>
__device__ __forceinline__ void og_phase(Frame& F, const bf16_t* A, int lda, const bf16_t* Bt, int M, int N, int K, const Epi& E) {
    pg8::DenseSched S; S.init(A, lda, Bt, M, N, K, F.G, F.bid);
    pg8::gemm_phase<Epi, pg8::DenseSched, false, false>(F.lds, F.tid, K, lda, S, E);
}

#ifndef PANEL_PROG
#define PANEL_PROG 1
#endif
#if PANEL_PROG
constexpr int PH_PER_LAYER = 6, N_PHASES = 2 + DEPTH * PH_PER_LAYER;
#else
constexpr int PH_PER_LAYER = 9, N_PHASES = 1 + DEPTH * PH_PER_LAYER;
#endif
__global__ void __launch_bounds__(NTHREADS, 2) fwd(Args args) {
    extern __shared__ __attribute__((aligned(16))) unsigned char lds[];
    Frame F;
    F.lds = (LAS unsigned char*)lds; F.ldsg = lds;
    F.tid = threadIdx.x; F.lane = F.tid & 63; F.wave = __builtin_amdgcn_readfirstlane(F.tid >> 6);
    F.G = gridDim.x; F.bid = blockIdx.x; F.gw = blockIdx.x * NWAVES + F.wave; F.NGW = F.G * NWAVES;
    F.ws = args.ws; F.ctl = (gu32*)(args.ws + WS_CTL);
    volatile LAS unsigned* MISC = (volatile LAS unsigned*)(F.lds + MISC_OFF);
    for (int u = F.tid; u < (LDS_BYTES - RING_BYTES) / 4; u += NTHREADS) ((LAS unsigned*)(F.lds + RING_BYTES))[u] = 0u;
    __syncthreads();
    XcdBarrier bar; bar.bar = (unsigned*)(F.ctl + CW_BAR); bar.x = 0; bar.st = nullptr;
    if (args.use_bar) bar = xcd_barrier_post((unsigned*)(F.ctl + CW_BAR), MISC + 8);
    const int lo = args.ph_lo, hi = args.ph_hi;
#ifndef PH_MASK
#define PH_MASK 0x3ff
#endif
#define IN(k) (lo <= (k) && (k) < hi && (launder(F), true))
#define SEAM(k) do { if (lo <= (k) && (k) + 1 < hi) xcd_barrier(bar); } while (0)
    if ((PH_MASK & 1) && IN(0)) { p0_prologue(F, args);
#ifdef PROBE_DUP_P0
        launder(F); p0_prologue(F, args);
#endif
    }
    SEAM(0);
#if PANEL_PROG
    for (int layer = 0; layer < DEPTH; ++layer) {
        const int pb = 1 + layer * PH_PER_LAYER;
        if (IN(pb + 0)) {
            for (int panel = F.bid; panel < NTOK / 256; panel += F.G) {
                const int r0 = panel * 256;
                if (layer > 0) { ln2_pass(F, args, layer - 1, r0 + F.wave, NWAVES, r0 + 256); local_sync(F); launder(F); }
                { bf16_t* H = (bf16_t*)(F.ws + WS_H); const EpiH E{H, (const float2*)(F.ws + WS_ROPE32), (const float2*)(F.ws + WS_ROPE64)};
                  pg_phase(F, (const bf16_t*)(F.ws + WS_XB), DM, (const bf16_t*)(F.ws + WS_WIN) + (size_t)layer * 2560 * 1024, panel, 2560, 1024, E); }
                local_sync(F); launder(F);
                rowstat_pass(F, r0 + F.wave, NWAVES, r0 + 256);
                local_sync(F); launder(F);
                { bf16_t* H = (bf16_t*)(F.ws + WS_H); const EpiUQ Eq{(bf16_t*)(F.ws + WS_QB), (const float*)(F.ws + WS_RSTD), (const float2*)(F.ws + WS_ROPE32)};
                  pg_phase(F, H + HC_CQ_LAT, HP, (const bf16_t*)(F.ws + WS_WUQ) + (size_t)layer * 768 * 256, panel, 768, 256, Eq); }
                launder(F);
                { bf16_t* H = (bf16_t*)(F.ws + WS_H); const EpiUKV Ek{(bf16_t*)(F.ws + WS_KVB), (const float*)(F.ws + WS_RSTD)};
                  pg_phase(F, H + HC_CKV, HP, (const bf16_t*)(F.ws + WS_WUKV) + (size_t)layer * 768 * 256, panel, 768, 256, Ek); }
                launder(F);
            }
        }
        SEAM(pb + 0);
        if (IN(pb + 1)) { cstat_phase(F); }
        SEAM(pb + 1);
        if (IN(pb + 2)) { attn_ab_phase(F, args, layer); launder(F); sattn_phase(F, args, layer, 10); }
        SEAM(pb + 2);
        if (IN(pb + 3)) {
            for (int panel = F.bid; panel < NTOK / 256; panel += F.G) {
                const int r0 = panel * 256;
                { const EpiRes E{(const bf16_t*)(F.ws + WS_XB), args.out};
                  pg_phase(F, (const bf16_t*)(F.ws + WS_MIX), DM, (const bf16_t*)(F.ws + WS_WOUT) + (size_t)layer * 1024 * 1024, panel, 1024, 1024, E); }
                local_sync(F); launder(F);
                ln1_route_pass(F, args, layer, r0 + F.wave, NWAVES, r0 + 256);
                launder(F);
            }
            moe_convert(F, args, layer);
        }
        SEAM(pb + 3);
        if (IN(pb + 4)) { moe_up_opt(F, layer);
#ifdef PROBE_DUP_MOE
            launder(F); moe_up_opt(F, layer);
#endif
        }
        SEAM(pb + 4);
        if (IN(pb + 5)) { moe_down_opt(F, layer);
#ifdef PROBE_DUP_MOE
            launder(F); moe_down_opt(F, layer);
#endif
        }
        SEAM(pb + 5);
    }
    if (IN(1 + DEPTH * PH_PER_LAYER)) { ln2_pass(F, args, DEPTH - 1, F.gw, F.NGW, NTOK); }
#ifdef PROBE_SEL
    __syncthreads(); launder(F);
    if (F.bid == 0 && F.tid == 0) { const LAS unsigned long long* pb_ = (const LAS unsigned long long*)(F.lds + RING_BYTES + 8192);
        const unsigned long long num_ = (PROBE_SEL == 1) ? 10000ull * pb_[4] : (PROBE_SEL == 2) ? 100ull * pb_[4] : (PROBE_SEL == 3) ? 100ull * pb_[0] : 10000ull * pb_[0];
        const unsigned long long den_ = (PROBE_SEL == 1) ? pb_[5] : (PROBE_SEL == 2) ? pb_[6] : (PROBE_SEL == 3) ? pb_[2] : pb_[1];
        const unsigned long long t0_ = __builtin_amdgcn_s_memrealtime();
        while ((__builtin_amdgcn_s_memrealtime() - t0_) * den_ < num_) __builtin_amdgcn_s_sleep(8); }
#endif
#else
    for (int layer = 0; layer < DEPTH; ++layer) {
        const int pb = 1 + layer * PH_PER_LAYER;
        if ((PH_MASK & (2 << 0)) && IN(pb + 0)) {   bf16_t* H = (bf16_t*)(F.ws + WS_H);
            const EpiH E{H, (const float2*)(F.ws + WS_ROPE32), (const float2*)(F.ws + WS_ROPE64)};
#if OPT_GEMM
            og_phase(F, (const bf16_t*)(F.ws + WS_XB), DM, (const bf16_t*)(F.ws + WS_WIN) + (size_t)layer * 2560 * 1024, NTOK, 2560, 1024, E);
#ifdef PROBE_DUP_GEMM
            launder(F); og_phase(F, (const bf16_t*)(F.ws + WS_XB), DM, (const bf16_t*)(F.ws + WS_WIN) + (size_t)layer * 2560 * 1024, NTOK, 2560, 1024, E);
#endif
#else
            sg_phase(F, (const bf16_t*)(F.ws + WS_XB), DM, (const bf16_t*)(F.ws + WS_WIN) + (size_t)layer * 2560 * 1024, 1024, NTOK, 2560, 1024, E);
#endif
        }
        SEAM(pb + 0);
        if ((PH_MASK & (2 << 1)) && IN(pb + 1)) { rowstat_pass(F, F.gw, F.NGW, NTOK); cstat_phase(F);
#ifdef PROBE_DUP_CSTAT
            launder(F); rowstat_pass(F, F.gw, F.NGW, NTOK); cstat_phase(F);
#endif
        }
        SEAM(pb + 1);
        if ((PH_MASK & (2 << 2)) && IN(pb + 2)) {
            bf16_t* H = (bf16_t*)(F.ws + WS_H);
            const EpiUQ Eq{(bf16_t*)(F.ws + WS_QB), (const float*)(F.ws + WS_RSTD), (const float2*)(F.ws + WS_ROPE32)};
#if OPT_GEMM
            og_phase(F, H + HC_CQ_LAT, HP, (const bf16_t*)(F.ws + WS_WUQ) + (size_t)layer * 768 * 256, NTOK, 768, 256, Eq);
            launder(F);
#else
            sg_phase(F, H + HC_CQ_LAT, HP, (const bf16_t*)(F.ws + WS_WUQ) + (size_t)layer * 768 * 256, 256, NTOK, 768, 256, Eq);
#endif
            const EpiUKV Ek{(bf16_t*)(F.ws + WS_KVB), (const float*)(F.ws + WS_RSTD)};
#if OPT_GEMM
            og_phase(F, H + HC_CKV, HP, (const bf16_t*)(F.ws + WS_WUKV) + (size_t)layer * 768 * 256, NTOK, 768, 256, Ek);
#ifdef PROBE_DUP_UP
            launder(F); og_phase(F, H + HC_CQ_LAT, HP, (const bf16_t*)(F.ws + WS_WUQ) + (size_t)layer * 768 * 256, NTOK, 768, 256, Eq);
            launder(F); og_phase(F, H + HC_CKV, HP, (const bf16_t*)(F.ws + WS_WUKV) + (size_t)layer * 768 * 256, NTOK, 768, 256, Ek);
#endif
#else
            sg_phase(F, H + HC_CKV, HP, (const bf16_t*)(F.ws + WS_WUKV) + (size_t)layer * 768 * 256, 256, NTOK, 768, 256, Ek);
#endif
        }
        SEAM(pb + 2);
        if ((PH_MASK & (2 << 3)) && IN(pb + 3)) {
#if OPT_ATTN
            attn_ab_phase(F, args, layer); launder(F);
#ifdef PROBE_DUP_ATTN
            attn_ab_phase(F, args, layer, PROBE_DUP_ATTN); launder(F);
#endif
            sattn_phase(F, args, layer, 10);
#ifdef PROBE_DUP_CFIN
            launder(F); sattn_phase(F, args, layer, 10);
#endif
#else
            sattn_phase(F, args, layer, 0);
#endif
        }
        SEAM(pb + 3);
        if ((PH_MASK & (2 << 4)) && IN(pb + 4)) {
#ifdef PROBE_DUP_WOUT
            { const EpiRes E0{(const bf16_t*)(F.ws + WS_XB), (float*)(F.ws + WS_H)};
              og_phase(F, (const bf16_t*)(F.ws + WS_MIX), DM, (const bf16_t*)(F.ws + WS_WOUT) + (size_t)layer * 1024 * 1024, NTOK, 1024, 1024, E0); launder(F); }
#endif
            const EpiRes E{(const bf16_t*)(F.ws + WS_XB), args.out};
#if OPT_GEMM
            og_phase(F, (const bf16_t*)(F.ws + WS_MIX), DM, (const bf16_t*)(F.ws + WS_WOUT) + (size_t)layer * 1024 * 1024, NTOK, 1024, 1024, E);
#else
            sg_phase(F, (const bf16_t*)(F.ws + WS_MIX), DM, (const bf16_t*)(F.ws + WS_WOUT) + (size_t)layer * 1024 * 1024, 1024, NTOK, 1024, 1024, E);
#endif
        }
        SEAM(pb + 4);
        if ((PH_MASK & (2 << 5)) && IN(pb + 5)) {
#ifdef PROBE_DUP_LN1
#endif
            ln1_route_pass(F, args, layer, F.gw, F.NGW, NTOK); moe_convert(F, args, layer);
#ifdef PROBE_DUP_CONV
            launder(F); moe_convert(F, args, layer);
#endif
        }
        SEAM(pb + 5);
#if OPT_GEMM
        if ((PH_MASK & (2 << 6)) && IN(pb + 6)) { moe_up_opt(F, layer);
#ifdef PROBE_DUP_MOE
            launder(F); moe_up_opt(F, layer);
#endif
        }
#else
        if ((PH_MASK & (2 << 6)) && IN(pb + 6)) { moe_up_simple(F, layer); }
#endif
        SEAM(pb + 6);
#if OPT_GEMM
        if ((PH_MASK & (2 << 7)) && IN(pb + 7)) { moe_down_opt(F, layer);
#ifdef PROBE_DUP_MOE
            launder(F); moe_down_opt(F, layer);
#endif
        }
#else
        if ((PH_MASK & (2 << 7)) && IN(pb + 7)) { moe_down_simple(F, layer); }
#endif
        SEAM(pb + 7);
        if ((PH_MASK & (2 << 8)) && IN(pb + 8)) { ln2_pass(F, args, layer, F.gw, F.NGW, NTOK); }
        SEAM(pb + 8);
    }
#endif
#undef IN
#undef SEAM
}

extern "C" void kernel_launch(void* const* d_in, const int* in_sizes, int n_in, void* d_out, int out_size, void* d_ws, size_t ws_size, hipStream_t stream) {
    static int grid = 0;
    if (grid == 0) {
        if (n_in != 19 || out_size != NTOK * DM || ws_size < WS_END) { fprintf(stderr, "kernel_launch: unexpected shapes (n_in %d out %d ws %zu)\n", n_in, out_size, ws_size); grid = -1; return; }
        int dev = 0, cus = 0, per_cu = 0;
        if (hipGetDevice(&dev) != hipSuccess || hipDeviceGetAttribute(&cus, hipDeviceAttributeMultiprocessorCount, dev) != hipSuccess) { grid = -1; return; }
        if (hipFuncSetAttribute((const void*)fwd, hipFuncAttributeMaxDynamicSharedMemorySize, LDS_BYTES) != hipSuccess) { grid = -1; return; }
        if (hipOccupancyMaxActiveBlocksPerMultiprocessor(&per_cu, (const void*)fwd, NTHREADS, LDS_BYTES) != hipSuccess || per_cu < 1) { fprintf(stderr, "kernel_launch: occupancy query says %d\n", per_cu); }
        (void)hipGetLastError();
        grid = cus;
    }
    if (grid < 0) return;
    if (hipMemsetAsync((char*)d_ws + WS_CTL, 0, CTL_ZERO_BYTES, stream) != hipSuccess) return;
    Args a{};
    a.x_prompt = (const float*)d_in[0]; a.x_sample = (const float*)d_in[1]; a.w_in = (const float*)d_in[2]; a.diff_lambda = (const float*)d_in[3]; a.diff_subln = (const float*)d_in[4];
    a.mla_q_norm = (const float*)d_in[5]; a.mla_w_uq = (const float*)d_in[6]; a.mla_kv_norm = (const float*)d_in[7]; a.mla_w_ukv = (const float*)d_in[8]; a.w_out = (const float*)d_in[9];
    a.ln1_g = (const float*)d_in[10]; a.ln1_b = (const float*)d_in[11]; a.moe_w_coarse = (const float*)d_in[12]; a.moe_w_fine = (const float*)d_in[13];
    a.moe_w1 = (const float*)d_in[14]; a.moe_w3 = (const float*)d_in[15]; a.moe_w2 = (const float*)d_in[16]; a.ln2_g = (const float*)d_in[17]; a.ln2_b = (const float*)d_in[18];
    a.out = (float*)d_out; a.ws = (unsigned char*)d_ws; a.pad = 0;
#if MK_ONE_LAUNCH
    a.ph_lo = 0; a.ph_hi = N_PHASES; a.use_bar = 1;
    hipLaunchKernelGGL(fwd, dim3(grid), dim3(NTHREADS), LDS_BYTES, stream, a);
#else
    for (int p = 0; p < N_PHASES; ++p) { a.ph_lo = p; a.ph_hi = p + 1; a.use_bar = 0; hipLaunchKernelGGL(fwd, dim3(grid), dim3(NTHREADS), LDS_BYTES, stream, a); }
#endif
}
```
